# Optimizing an MI355X kernel written in HIP

```python
import math
import jax, jax.numpy as jnp
from jax import lax
import numpy as np

D_MODEL = 1024
BATCH = 4
SEQ = 4096
DEPTH = 1

ATTN_HEADS = 8
ATTN_KV_HEADS = 2
HEAD_DIM = 64
ATTN_WIDTH = ATTN_HEADS * HEAD_DIM
WINDOW = 128
ATTN_BLOCK = 128
N_BUCKETS = 32
MAX_DISTANCE = 128
SSD_HEADS = 8
SSD_HEAD_DIM = 64
SSD_INNER = SSD_HEADS * SSD_HEAD_DIM
SSD_STATE = 128
SSD_GROUPS = 2
SSD_CONV = 4
SSD_CHUNK = 128
MIX_WIDTH = ATTN_WIDTH + SSD_INNER
PEER_HEADS = 8
N_KEYS = 128
N_EXPERTS = N_KEYS * N_KEYS
PEER_KEY_DIM = 256
PEER_HALF = PEER_KEY_DIM // 2
PEER_TOPK = 16
PEER_BLOCK = 128
EPS = 1e-6

KV_COLS = ATTN_KV_HEADS * HEAD_DIM
XBC_COLS = SSD_INNER + 2 * SSD_GROUPS * SSD_STATE
OFF_K = ATTN_WIDTH
OFF_V = OFF_K + KV_COLS
OFF_Z = OFF_V + KV_COLS
OFF_XBC = OFF_Z + SSD_INNER
OFF_DT = OFF_XBC + XBC_COLS
IN_COLS = OFF_DT + SSD_HEADS

kernel_name = 'hymba_swa_ssd_peer_block'


def rms_norm(x, w):
    xf = x.astype(jnp.float32)
    y = xf * lax.rsqrt(jnp.mean(xf * xf, axis=-1, keepdims=True) + EPS)
    return (y * w.astype(jnp.float32)).astype(x.dtype)


def t5_bucket(dist):
    n = jnp.maximum(dist, 0)
    max_exact = N_BUCKETS // 2
    nf = jnp.maximum(n, 1).astype(jnp.float32)
    large = max_exact + (jnp.log(nf / max_exact) / math.log(MAX_DISTANCE / max_exact)
                         * (N_BUCKETS - max_exact)).astype(jnp.int32)
    large = jnp.minimum(large, N_BUCKETS - 1)
    return jnp.where(n < max_exact, n, large)


def sliding_window_attention(q, k, v, sinks, rel_bias):
    b, s = q.shape[0], q.shape[1]
    nb = s // ATTN_BLOCK
    grp = ATTN_HEADS // ATTN_KV_HEADS
    qb = q.reshape(b, nb, ATTN_BLOCK, ATTN_KV_HEADS, grp, HEAD_DIM)

    def band(t):
        tp = jnp.pad(t, ((0, 0), (ATTN_BLOCK, 0), (0, 0), (0, 0)))
        tp = tp.reshape(b, nb + 1, ATTN_BLOCK, ATTN_KV_HEADS, HEAD_DIM)
        return jnp.concatenate([tp[:, :-1], tp[:, 1:]], axis=2)

    kb, vb = band(k), band(v)
    scores = jnp.einsum('bnqhgd,bnkhd->bnhgqk', qb, kb).astype(jnp.float32) * (HEAD_DIM ** -0.5)
    qi = jnp.arange(ATTN_BLOCK)[:, None]
    kj = jnp.arange(2 * ATTN_BLOCK)[None, :]
    dist = qi + ATTN_BLOCK - kj
    in_window = (dist >= 0) & (dist < WINDOW)
    key_pos = jnp.arange(nb)[:, None, None] * ATTN_BLOCK - ATTN_BLOCK + kj[None]
    valid = in_window[None] & (key_pos >= 0)
    bias = rel_bias[t5_bucket(dist)].astype(jnp.float32)
    bias = bias.transpose(2, 0, 1).reshape(ATTN_KV_HEADS, grp, ATTN_BLOCK, 2 * ATTN_BLOCK)
    scores = jnp.where(valid[None, :, None, None], scores + bias, -jnp.inf)
    sink = sinks.astype(jnp.float32).reshape(ATTN_KV_HEADS, grp)[:, :, None, None]
    m = jnp.maximum(jnp.max(scores, axis=-1, keepdims=True), sink)
    p = jnp.exp(scores - m)
    denom = jnp.sum(p, axis=-1, keepdims=True) + jnp.exp(sink - m)
    probs = (p / denom).astype(v.dtype)
    out = jnp.einsum('bnhgqk,bnkhd->bnqhgd', probs, vb)
    return out.reshape(b, s, ATTN_WIDTH)


def causal_depthwise_conv(x, w, bias):
    kw = w.shape[0]
    y = lax.conv_general_dilated(x, w[:, None, :], window_strides=(1,), padding=[(kw - 1, 0)],
                                 dimension_numbers=('NWC', 'WIO', 'NWC'),
                                 feature_group_count=x.shape[-1])
    return y + bias


def ssd_scan(x, dt, A, Bm, Cm):
    f32 = jnp.float32
    b, s, h, p = x.shape
    c = s // SSD_CHUNK
    L = SSD_CHUNK
    g = SSD_GROUPS
    r = h // g
    X = (x.astype(f32) * dt[..., None]).reshape(b, c, L, g, r, p)
    a = (dt * A).reshape(b, c, L, g, r).transpose(0, 3, 4, 1, 2)
    a_cum = jnp.cumsum(a, axis=-1)
    Bg = Bm.astype(f32).reshape(b, c, L, g, -1)
    Cg = Cm.astype(f32).reshape(b, c, L, g, -1)
    seg = a_cum[..., :, None] - a_cum[..., None, :]
    causal = jnp.tril(jnp.ones((L, L), dtype=bool))
    Lmat = jnp.where(causal, jnp.exp(jnp.where(causal, seg, 0.0)), 0.0)
    CB = jnp.einsum('bclgn,bcsgn->bgcls', Cg, Bg)
    y_diag = jnp.einsum('bgrcls,bcsgrp->bclgrp', CB[:, :, None] * Lmat, X)
    decay_to_end = jnp.exp(a_cum[..., -1:] - a_cum).transpose(0, 3, 4, 1, 2)
    states = jnp.einsum('bclgn,bclgrp->bcgrpn', Bg, X * decay_to_end[..., None])
    chunk_decay = jnp.exp(a_cum[..., -1]).transpose(3, 0, 1, 2)

    def step(h_prev, inp):
        st, dec = inp
        return h_prev * dec[..., None, None] + st, h_prev

    h0 = jnp.zeros((b, g, r, p, Bg.shape[-1]), f32)
    _, prev_states = lax.scan(step, h0, (states.transpose(1, 0, 2, 3, 4, 5), chunk_decay))
    decay_from_start = jnp.exp(a_cum).transpose(0, 3, 4, 1, 2)
    y_off = jnp.einsum('bclgn,cbgrpn->bclgrp', Cg, prev_states) * decay_from_start[..., None]
    return (y_diag + y_off).reshape(b, s, h, p)


def hybrid_mixer(xn, w_in, conv_w, conv_b, dt_bias, a_log, d_skip, ssd_norm_w, sinks, w_out, rel_bias):
    b, s, _ = xn.shape
    proj = xn @ w_in
    q = proj[..., :OFF_K].reshape(b, s, ATTN_HEADS, HEAD_DIM)
    k = proj[..., OFF_K:OFF_V].reshape(b, s, ATTN_KV_HEADS, HEAD_DIM)
    v = proj[..., OFF_V:OFF_Z].reshape(b, s, ATTN_KV_HEADS, HEAD_DIM)
    z = proj[..., OFF_Z:OFF_XBC]
    xbc = proj[..., OFF_XBC:OFF_DT]
    dt_raw = proj[..., OFF_DT:]
    attn_out = sliding_window_attention(q, k, v, sinks, rel_bias)
    xbc = jax.nn.silu(causal_depthwise_conv(xbc, conv_w, conv_b))
    xs = xbc[..., :SSD_INNER].reshape(b, s, SSD_HEADS, SSD_HEAD_DIM)
    Bm = xbc[..., SSD_INNER:SSD_INNER + SSD_GROUPS * SSD_STATE].reshape(b, s, SSD_GROUPS, SSD_STATE)
    Cm = xbc[..., SSD_INNER + SSD_GROUPS * SSD_STATE:].reshape(b, s, SSD_GROUPS, SSD_STATE)
    dt = jax.nn.softplus(dt_raw.astype(jnp.float32) + dt_bias.astype(jnp.float32))
    A = -jnp.exp(a_log.astype(jnp.float32))
    y = ssd_scan(xs, dt, A, Bm, Cm) + d_skip.astype(jnp.float32)[:, None] * xs.astype(jnp.float32)
    y = y.reshape(b, s, SSD_INNER) * jax.nn.silu(z.astype(jnp.float32))
    ssd_out = rms_norm(y, ssd_norm_w).astype(xn.dtype)
    return jnp.concatenate([attn_out, ssd_out], axis=-1) @ w_out


def peer(xn, w_query, sub_keys1, sub_keys2, expert_down, expert_up):
    f32 = jnp.float32
    b, s, d = xn.shape
    q = (xn @ w_query).reshape(b, s, PEER_HEADS, 2, PEER_HALF).astype(f32)
    s1 = jnp.einsum('bshk,nk->bshn', q[..., 0, :], sub_keys1.astype(f32))
    s2 = jnp.einsum('bshk,nk->bshn', q[..., 1, :], sub_keys2.astype(f32))
    v1, i1 = lax.top_k(s1, PEER_TOPK)
    v2, i2 = lax.top_k(s2, PEER_TOPK)
    cand = (v1[..., :, None] + v2[..., None, :]).reshape(b, s, PEER_HEADS, PEER_TOPK * PEER_TOPK)
    cand_idx = (i1[..., :, None] * N_KEYS + i2[..., None, :]).reshape(b, s, PEER_HEADS, PEER_TOPK * PEER_TOPK)
    top_s, pos = lax.top_k(cand, PEER_TOPK)
    idx = jnp.take_along_axis(cand_idx, pos, axis=-1)
    gates = jax.nn.softmax(top_s, axis=-1)
    nblk = s // PEER_BLOCK

    def to_blocks(t):
        return t.reshape((b, nblk, PEER_BLOCK) + t.shape[2:]).swapaxes(0, 1)

    def eval_block(args):
        xb, ib, gb = args
        u = expert_down[ib]
        pre = jnp.einsum('bthkd,btd->bthk', u, xb).astype(f32)
        act = (jax.nn.gelu(pre, approximate=False) * gb).astype(xb.dtype)
        return jnp.einsum('bthk,bthkd->btd', act, expert_up[ib])

    out = lax.map(eval_block, (to_blocks(xn), to_blocks(idx), to_blocks(gates)))
    return out.swapaxes(0, 1).reshape(b, s, d)


def setup_inputs(seed: int = 0) -> dict:
    key = jax.random.key(seed)
    ks = jax.random.split(key, 20)
    f32 = jnp.float32
    nrm = lambda k, shape, scale: (jax.random.normal(k, shape, f32) * scale)
    dt0 = jnp.exp(jax.random.uniform(ks[5], (DEPTH, SSD_HEADS), f32)
                  * (math.log(0.1) - math.log(0.001)) + math.log(0.001))
    return {
        'x': nrm(ks[0], (BATCH, SEQ, D_MODEL), 1.0),
        'norm_mix': 1.0 + nrm(ks[1], (DEPTH, D_MODEL), 0.05),
        'w_in': nrm(ks[2], (DEPTH, D_MODEL, IN_COLS), D_MODEL ** -0.5),
        'conv_w': nrm(ks[3], (DEPTH, SSD_CONV, XBC_COLS), SSD_CONV ** -0.5),
        'conv_b': nrm(ks[4], (DEPTH, XBC_COLS), 0.02),
        'dt_bias': dt0 + jnp.log(-jnp.expm1(-dt0)),
        'a_log': jnp.log(jax.random.uniform(ks[6], (DEPTH, SSD_HEADS), f32, 1.0, 16.0)),
        'd_skip': 1.0 + nrm(ks[7], (DEPTH, SSD_HEADS), 0.1),
        'ssd_norm_w': 1.0 + nrm(ks[8], (DEPTH, SSD_INNER), 0.05),
        'attn_sinks': nrm(ks[9], (DEPTH, ATTN_HEADS), 1.0),
        'w_out': nrm(ks[10], (DEPTH, MIX_WIDTH, D_MODEL), MIX_WIDTH ** -0.5),
        'rel_bias': nrm(ks[11], (N_BUCKETS, ATTN_HEADS), 0.5),
        'norm_ffn': 1.0 + nrm(ks[12], (DEPTH, D_MODEL), 0.05),
        'w_query': nrm(ks[13], (DEPTH, D_MODEL, PEER_HEADS * PEER_KEY_DIM), D_MODEL ** -0.5),
        'sub_keys1': nrm(ks[14], (DEPTH, N_KEYS, PEER_HALF), PEER_HALF ** -0.5),
        'sub_keys2': nrm(ks[15], (DEPTH, N_KEYS, PEER_HALF), PEER_HALF ** -0.5),
        'expert_down': nrm(ks[16], (DEPTH, N_EXPERTS, D_MODEL), D_MODEL ** -0.5),
        'expert_up': nrm(ks[17], (DEPTH, N_EXPERTS, D_MODEL), PEER_HEADS ** -0.5),
        'norm_final': 1.0 + nrm(ks[18], (D_MODEL,), 0.05),
    }


def reference(x, norm_mix, w_in, conv_w, conv_b, dt_bias, a_log, d_skip, ssd_norm_w, attn_sinks,
              w_out, rel_bias, norm_ffn, w_query, sub_keys1, sub_keys2, expert_down, expert_up,
              norm_final):
    h = x
    for l in range(DEPTH):
        h = h + hybrid_mixer(rms_norm(h, norm_mix[l]), w_in[l], conv_w[l], conv_b[l], dt_bias[l],
                             a_log[l], d_skip[l], ssd_norm_w[l], attn_sinks[l], w_out[l], rel_bias)
        h = h + peer(rms_norm(h, norm_ffn[l]), w_query[l], sub_keys1[l], sub_keys2[l],
                     expert_down[l], expert_up[l])
    return rms_norm(h, norm_final)
```

```cpp
#include <hip/hip_runtime.h>
#include <math.h>
#include <stdint.h>

namespace {
constexpr int D_MODEL = 1024, BATCH = 4, SEQ = 4096, T = BATCH * SEQ;
constexpr int IN_COLS = 2312, OFF_K = 512, OFF_V = 640, OFF_Z = 768, OFF_XBC = 1280, OFF_DT = 2304;
constexpr int SSD_INNER = 512;
constexpr float EPS = 1e-6f;
constexpr size_t MiB = 1u << 20;

__constant__ unsigned char c_bucket[128] = {0, 1, 2, 3, 4, 5, 6, 7, 8, 9, 10, 11, 12, 13, 14, 15, 16, 16, 16, 17, 17, 18, 18, 18, 19, 19, 19, 20, 20, 20, 20, 21, 21, 21, 21, 22, 22, 22, 22, 22, 23, 23, 23, 23, 23, 23, 24, 24, 24, 24, 24, 24, 25, 25, 25, 25, 25, 25, 25, 26, 26, 26, 26, 26, 26, 26, 26, 27, 27, 27, 27, 27, 27, 27, 27, 27, 27, 28, 28, 28, 28, 28, 28, 28, 28, 28, 28, 29, 29, 29, 29, 29, 29, 29, 29, 29, 29, 29, 29, 30, 30, 30, 30, 30, 30, 30, 30, 30, 30, 30, 30, 30, 30, 31, 31, 31, 31, 31, 31, 31, 31, 31, 31, 31, 31, 31, 31, 31};

__device__ __forceinline__ float wave_sum(float v) {
#pragma unroll
    for (int o = 1; o < 64; o <<= 1) v += __shfl_xor(v, o);
    return v;
}
__device__ __forceinline__ float silu_f(float x) { return x / (1.f + expf(-x)); }

__global__ __launch_bounds__(256) void k_rmsnorm1024(const float* __restrict__ x, const float* __restrict__ w, float* __restrict__ out, int rows) {
    const int row = (blockIdx.x * 256 + threadIdx.x) >> 6, lane = threadIdx.x & 63;
    if (row >= rows) return;
    const float4* xr = (const float4*)(x + (size_t)row * 1024);
    float4 v[4]; float s = 0.f;
#pragma unroll
    for (int j = 0; j < 4; ++j) { v[j] = xr[j * 64 + lane]; s += v[j].x * v[j].x + v[j].y * v[j].y + v[j].z * v[j].z + v[j].w * v[j].w; }
    const float r = rsqrtf(wave_sum(s) * (1.f / 1024.f) + EPS);
    float4* o = (float4*)(out + (size_t)row * 1024);
#pragma unroll
    for (int j = 0; j < 4; ++j) { const float4 ww = ((const float4*)w)[j * 64 + lane]; float4 r4; r4.x = v[j].x * r * ww.x; r4.y = v[j].y * r * ww.y; r4.z = v[j].z * r * ww.z; r4.w = v[j].w * r * ww.w; o[j * 64 + lane] = r4; }
}

template <bool RES>
__global__ __launch_bounds__(256) void k_gemm_f32(const float* __restrict__ A, const float* __restrict__ B, float* __restrict__ C, const float* __restrict__ R, int M, int N, int K) {
    __shared__ float As[16][68];
    __shared__ float Bs[16][68];
    const int tid = threadIdx.x, tx = tid & 15, ty = tid >> 4;
    const int m0 = blockIdx.y * 64, n0 = blockIdx.x * 64;
    float acc[4][4];
#pragma unroll
    for (int i = 0; i < 4; ++i)
#pragma unroll
        for (int j = 0; j < 4; ++j) acc[i][j] = 0.f;
    const int ar = tid >> 2, ac = (tid & 3) * 4;
    const int br = tid >> 4, bc = (tid & 15) * 4;
    for (int k0 = 0; k0 < K; k0 += 16) {
        const float4 av = *(const float4*)(A + (size_t)(m0 + ar) * K + k0 + ac);
        float4 bv = make_float4(0.f, 0.f, 0.f, 0.f);
        if (n0 + bc < N) bv = *(const float4*)(B + (size_t)(k0 + br) * N + n0 + bc);
        As[ac + 0][ar] = av.x; As[ac + 1][ar] = av.y; As[ac + 2][ar] = av.z; As[ac + 3][ar] = av.w;
        *(float4*)&Bs[br][bc] = bv;
        __syncthreads();
#pragma unroll
        for (int kk = 0; kk < 16; ++kk) {
            const float4 a4 = *(const float4*)&As[kk][ty * 4];
            const float4 b4 = *(const float4*)&Bs[kk][tx * 4];
            const float a[4] = {a4.x, a4.y, a4.z, a4.w}, b[4] = {b4.x, b4.y, b4.z, b4.w};
#pragma unroll
            for (int i = 0; i < 4; ++i)
#pragma unroll
                for (int j = 0; j < 4; ++j) acc[i][j] += a[i] * b[j];
        }
        __syncthreads();
    }
    if (n0 + tx * 4 < N) {
#pragma unroll
        for (int i = 0; i < 4; ++i) {
            const size_t off = (size_t)(m0 + ty * 4 + i) * N + n0 + tx * 4;
            float4 o = make_float4(acc[i][0], acc[i][1], acc[i][2], acc[i][3]);
            if (RES) { const float4 r = *(const float4*)(R + off); o.x += r.x; o.y += r.y; o.z += r.z; o.w += r.w; }
            *(float4*)(C + off) = o;
        }
    }
}

__global__ __launch_bounds__(128) void k_attn(const float* __restrict__ proj, const float* __restrict__ sinks, const float* __restrict__ rel_bias, float* __restrict__ cat) {
    const int g = blockIdx.x * 128 + threadIdx.x;
    const int h = blockIdx.x & 7, t = (blockIdx.x >> 3) * 128 + threadIdx.x;
    (void)g;
    const int pos = t & (SEQ - 1), base = t - pos, hkv = h >> 2;
    float q[64], acc[64];
    const float* qp = proj + (size_t)t * IN_COLS + h * 64;
#pragma unroll
    for (int d = 0; d < 64; ++d) { q[d] = qp[d]; acc[d] = 0.f; }
    float m = sinks[h], l = 1.f;
    const int k_lo = pos - 127 < 0 ? 0 : pos - 127;
    for (int kp = k_lo; kp <= pos; ++kp) {
        const float* kr = proj + (size_t)(base + kp) * IN_COLS + OFF_K + hkv * 64;
        const float* vr = proj + (size_t)(base + kp) * IN_COLS + OFF_V + hkv * 64;
        float s = 0.f;
#pragma unroll
        for (int d = 0; d < 64; ++d) s += q[d] * kr[d];
        s = s * 0.125f + rel_bias[c_bucket[pos - kp] * 8 + h];
        if (s > m) { const float f = expf(m - s); l *= f;
#pragma unroll
            for (int d = 0; d < 64; ++d) acc[d] *= f;
            m = s; }
        const float p = expf(s - m); l += p;
#pragma unroll
        for (int d = 0; d < 64; ++d) acc[d] += p * vr[d];
    }
    const float inv = 1.f / l;
    float* o = cat + (size_t)t * 1024 + h * 64;
#pragma unroll
    for (int d = 0; d < 64; ++d) o[d] = acc[d] * inv;
}

__global__ __launch_bounds__(256) void k_ssd_seq(const float* __restrict__ proj, const float* __restrict__ conv_w, const float* __restrict__ conv_b, const float* __restrict__ dt_bias,
                                                 const float* __restrict__ a_log, const float* __restrict__ d_skip, float* __restrict__ y) {
    __shared__ float sx[64], sB[128], sC[128];
    const int b = blockIdx.x >> 3, h = blockIdx.x & 7, grp = h >> 2, tid = threadIdx.x, p = tid >> 2, nq = tid & 3;
    const float A = -expf(a_log[h]), Dh = d_skip[h], dtb = dt_bias[h];
    float st[32];
#pragma unroll
    for (int i = 0; i < 32; ++i) st[i] = 0.f;
    for (int s = 0; s < SEQ; ++s) {
        const size_t row = (size_t)b * SEQ + s;
        for (int i = tid; i < 320; i += 256) {
            int ch;
            if (i < 64) ch = h * 64 + i; else if (i < 192) ch = 512 + grp * 128 + (i - 64); else ch = 768 + grp * 128 + (i - 192);
            float a = conv_b[ch];
#pragma unroll
            for (int j = 0; j < 4; ++j) { const int ss = s - 3 + j; if (ss >= 0) a += conv_w[j * 1024 + ch] * proj[((size_t)b * SEQ + ss) * IN_COLS + OFF_XBC + ch]; }
            a = silu_f(a);
            if (i < 64) sx[i] = a; else if (i < 192) sB[i - 64] = a; else sC[i - 192] = a;
        }
        __syncthreads();
        const float xr = proj[row * IN_COLS + OFF_DT + h] + dtb;
        const float dt = fmaxf(xr, 0.f) + log1pf(expf(-fabsf(xr)));
        const float dec = expf(dt * A);
        const float xs = sx[p], X = xs * dt;
        float part = 0.f;
#pragma unroll
        for (int i = 0; i < 32; ++i) { st[i] = st[i] * dec + sB[nq * 32 + i] * X; part += sC[nq * 32 + i] * st[i]; }
        part += __shfl_xor(part, 1); part += __shfl_xor(part, 2);
        if (nq == 0) y[row * SSD_INNER + h * 64 + p] = part + Dh * xs;
        __syncthreads();
    }
}

__global__ __launch_bounds__(256) void k_gate_norm(const float* __restrict__ y, const float* __restrict__ proj, const float* __restrict__ w, float* __restrict__ cat) {
    const int row = (blockIdx.x * 256 + threadIdx.x) >> 6, lane = threadIdx.x & 63;
    float v[8]; float s = 0.f;
#pragma unroll
    for (int j = 0; j < 8; ++j) { const int c = j * 64 + lane; const float z = proj[(size_t)row * IN_COLS + OFF_Z + c]; v[j] = y[(size_t)row * SSD_INNER + c] * silu_f(z); s += v[j] * v[j]; }
    const float r = rsqrtf(wave_sum(s) * (1.f / 512.f) + EPS);
#pragma unroll
    for (int j = 0; j < 8; ++j) { const int c = j * 64 + lane; cat[(size_t)row * 1024 + 512 + c] = v[j] * r * w[c]; }
}

__global__ void k_transpose_keys(const float* __restrict__ k1, const float* __restrict__ k2, float* __restrict__ k1t, float* __restrict__ k2t) {
    const int i = blockIdx.x * 256 + threadIdx.x;
    const int n = i >> 7, k = i & 127;
    k1t[k * 128 + n] = k1[i]; k2t[k * 128 + n] = k2[i];
}

__global__ __launch_bounds__(256) void k_peer_topk(const float* __restrict__ q, const float* __restrict__ k1t, const float* __restrict__ k2t, int* __restrict__ idx_out, float* __restrict__ gate_out) {
    const int gw = (blockIdx.x * 256 + threadIdx.x) >> 6, lane = threadIdx.x & 63;
    const float* qrow = q + (size_t)gw * 256;
    float s1a = 0.f, s1b = 0.f, s2a = 0.f, s2b = 0.f;
    for (int k = 0; k < 128; ++k) {
        const float qa = qrow[k], qb = qrow[128 + k];
        s1a += qa * k1t[k * 128 + lane]; s1b += qa * k1t[k * 128 + 64 + lane];
        s2a += qb * k2t[k * 128 + lane]; s2b += qb * k2t[k * 128 + 64 + lane];
    }
    const float NEG = -INFINITY;
    float myv1 = 0.f, myv2 = 0.f; int myi1 = 0, myi2 = 0;
    for (int r = 0; r < 16; ++r) {
        float bv; int bi;
        if (s1a >= s1b) { bv = s1a; bi = lane; } else { bv = s1b; bi = lane + 64; }
#pragma unroll
        for (int o = 32; o >= 1; o >>= 1) { const float ov = __shfl_xor(bv, o); const int oi = __shfl_xor(bi, o); if (ov > bv || (ov == bv && oi < bi)) { bv = ov; bi = oi; } }
        if (lane == r) { myv1 = bv; myi1 = bi; }
        if (bi == lane) s1a = NEG; if (bi == lane + 64) s1b = NEG;
    }
    for (int r = 0; r < 16; ++r) {
        float bv; int bi;
        if (s2a >= s2b) { bv = s2a; bi = lane; } else { bv = s2b; bi = lane + 64; }
#pragma unroll
        for (int o = 32; o >= 1; o >>= 1) { const float ov = __shfl_xor(bv, o); const int oi = __shfl_xor(bi, o); if (ov > bv || (ov == bv && oi < bi)) { bv = ov; bi = oi; } }
        if (lane == r) { myv2 = bv; myi2 = bi; }
        if (bi == lane) s2a = NEG; if (bi == lane + 64) s2b = NEG;
    }
    float cand[4];
#pragma unroll
    for (int c = 0; c < 4; ++c) { const int pos = lane + 64 * c; cand[c] = __shfl(myv1, pos >> 4) + __shfl(myv2, pos & 15); }
    float mys = 0.f; int mypos = 0;
    for (int r = 0; r < 16; ++r) {
        float bv = cand[0]; int bi = lane;
#pragma unroll
        for (int c = 1; c < 4; ++c) if (cand[c] > bv) { bv = cand[c]; bi = lane + 64 * c; }
#pragma unroll
        for (int o = 32; o >= 1; o >>= 1) { const float ov = __shfl_xor(bv, o); const int oi = __shfl_xor(bi, o); if (ov > bv || (ov == bv && oi < bi)) { bv = ov; bi = oi; } }
        if (lane == r) { mys = bv; mypos = bi; }
#pragma unroll
        for (int c = 0; c < 4; ++c) if (bi == lane + 64 * c) cand[c] = NEG;
    }
    const int e1 = __shfl(myi1, mypos >> 4), e2 = __shfl(myi2, mypos & 15);
    const float mx = __shfl(mys, 0);
    float e = lane < 16 ? expf(mys - mx) : 0.f;
    const float sum = wave_sum(e);
    if (lane < 16) { idx_out[(size_t)gw * 16 + lane] = e1 * 128 + e2; gate_out[(size_t)gw * 16 + lane] = e / sum; }
}

__global__ __launch_bounds__(256) void k_peer_eval_final(float* __restrict__ hout, const float* __restrict__ norm_ffn, const float* __restrict__ norm_final, const float* __restrict__ down, const float* __restrict__ up,
                                                         const int* __restrict__ idx, const float* __restrict__ gate) {
    const int t = (blockIdx.x * 256 + threadIdx.x) >> 6, lane = threadIdx.x & 63;
    float4* hr = (float4*)(hout + (size_t)t * 1024);
    float4 hv[4], xn[4], acc[4]; float s = 0.f;
#pragma unroll
    for (int j = 0; j < 4; ++j) { hv[j] = hr[j * 64 + lane]; s += hv[j].x * hv[j].x + hv[j].y * hv[j].y + hv[j].z * hv[j].z + hv[j].w * hv[j].w; acc[j] = make_float4(0.f, 0.f, 0.f, 0.f); }
    const float r = rsqrtf(wave_sum(s) * (1.f / 1024.f) + EPS);
#pragma unroll
    for (int j = 0; j < 4; ++j) { const float4 w = ((const float4*)norm_ffn)[j * 64 + lane]; xn[j].x = hv[j].x * r * w.x; xn[j].y = hv[j].y * r * w.y; xn[j].z = hv[j].z * r * w.z; xn[j].w = hv[j].w * r * w.w; }
    for (int e = 0; e < 128; ++e) {
        const int id = idx[(size_t)t * 128 + e]; const float g = gate[(size_t)t * 128 + e];
        const float4* dr = (const float4*)(down + (size_t)id * 1024);
        float part = 0.f;
#pragma unroll
        for (int j = 0; j < 4; ++j) { const float4 d = dr[j * 64 + lane]; part += d.x * xn[j].x + d.y * xn[j].y + d.z * xn[j].z + d.w * xn[j].w; }
        const float pre = wave_sum(part);
        const float act = 0.5f * pre * (1.f + erff(pre * 0.70710678118654752f)) * g;
        const float4* ur = (const float4*)(up + (size_t)id * 1024);
#pragma unroll
        for (int j = 0; j < 4; ++j) { const float4 u = ur[j * 64 + lane]; acc[j].x += act * u.x; acc[j].y += act * u.y; acc[j].z += act * u.z; acc[j].w += act * u.w; }
    }
    float s2 = 0.f;
#pragma unroll
    for (int j = 0; j < 4; ++j) { acc[j].x += hv[j].x; acc[j].y += hv[j].y; acc[j].z += hv[j].z; acc[j].w += hv[j].w; s2 += acc[j].x * acc[j].x + acc[j].y * acc[j].y + acc[j].z * acc[j].z + acc[j].w * acc[j].w; }
    const float r2 = rsqrtf(wave_sum(s2) * (1.f / 1024.f) + EPS);
#pragma unroll
    for (int j = 0; j < 4; ++j) { const float4 w = ((const float4*)norm_final)[j * 64 + lane]; float4 o; o.x = acc[j].x * r2 * w.x; o.y = acc[j].y * r2 * w.y; o.z = acc[j].z * r2 * w.z; o.w = acc[j].w * r2 * w.w; hr[j * 64 + lane] = o; }
}
}

extern "C" void kernel_launch(void* const* d_in, const int* in_sizes, int n_in, void* d_out, int out_size, void* d_ws, size_t ws_size, hipStream_t stream) {
    const float* x = (const float*)d_in[0];        const float* norm_mix = (const float*)d_in[1];  const float* w_in = (const float*)d_in[2];
    const float* conv_w = (const float*)d_in[3];   const float* conv_b = (const float*)d_in[4];    const float* dt_bias = (const float*)d_in[5];
    const float* a_log = (const float*)d_in[6];    const float* d_skip = (const float*)d_in[7];    const float* ssd_norm_w = (const float*)d_in[8];
    const float* sinks = (const float*)d_in[9];    const float* w_out = (const float*)d_in[10];    const float* rel_bias = (const float*)d_in[11];
    const float* norm_ffn = (const float*)d_in[12]; const float* w_query = (const float*)d_in[13]; const float* sk1 = (const float*)d_in[14];
    const float* sk2 = (const float*)d_in[15];     const float* e_down = (const float*)d_in[16];   const float* e_up = (const float*)d_in[17];
    const float* norm_final = (const float*)d_in[18];
    char* ws = (char*)d_ws; float* out = (float*)d_out;
    float* R0 = (float*)(ws);
    float* R1 = (float*)(ws + 64 * MiB);
    float* Y = (float*)(ws + 209 * MiB);
    float* K1T = (float*)(ws + 241 * MiB);
    float* K2T = K1T + 128 * 128;

    k_rmsnorm1024<<<T / 4, 256, 0, stream>>>(x, norm_mix, R0, T);
    k_gemm_f32<false><<<dim3((IN_COLS + 63) / 64, T / 64), 256, 0, stream>>>(R0, w_in, R1, nullptr, T, IN_COLS, D_MODEL);
    k_attn<<<(T / 128) * 8, 128, 0, stream>>>(R1, sinks, rel_bias, R0);
    k_ssd_seq<<<BATCH * 8, 256, 0, stream>>>(R1, conv_w, conv_b, dt_bias, a_log, d_skip, Y);
    k_gate_norm<<<T / 4, 256, 0, stream>>>(Y, R1, ssd_norm_w, R0);
    k_gemm_f32<true><<<dim3(1024 / 64, T / 64), 256, 0, stream>>>(R0, w_out, out, x, T, 1024, 1024);
    k_rmsnorm1024<<<T / 4, 256, 0, stream>>>(out, norm_ffn, R0, T);
    k_gemm_f32<false><<<dim3(2048 / 64, T / 64), 256, 0, stream>>>(R0, w_query, R1, nullptr, T, 2048, 1024);
    k_transpose_keys<<<64, 256, 0, stream>>>(sk1, sk2, K1T, K2T);
    int* idx = (int*)R0; float* gate = R0 + (size_t)T * 128;
    k_peer_topk<<<T * 8 / 4, 256, 0, stream>>>(R1, K1T, K2T, idx, gate);
    k_peer_eval_final<<<T / 4, 256, 0, stream>>>(out, norm_ffn, norm_final, e_down, e_up, idx, gate);
}
```

```cpp
#include <hip/hip_runtime.h>
#include <cstdio>
#include <cstdint>
#include <math.h>
namespace pg8 {
#define PG8_LAS __attribute__((address_space(3)))
typedef unsigned short bf16_t;
typedef short bf16x8 __attribute__((ext_vector_type(8)));
typedef float f32x4 __attribute__((ext_vector_type(4)));
typedef unsigned u32x4 __attribute__((ext_vector_type(4)));
constexpr int BM = 256, BK = 64, HALF = 128, HTB = HALF * BK * 2  , STAGE_BYTES = 8 * HTB, NXCD = 8, WGM = 8;

__host__ __device__ __forceinline__ int lds_byte(int r, int c) { const int st = (r >> 4) * 2 + (c >> 5), rr = r & 15, cc = c & 31, ob = rr * 64 + cc * 2; return st * 1024 + (ob ^ (((ob >> 9) & 1) << 5)); }
__host__ __device__ __forceinline__ void stage_rc(int b, int& R, int& C) { const int st = b / 1024, sb = b % 1024, swz = sb ^ (((sb >> 9) & 1) << 5); R = (st >> 1) * 16 + swz / 64; C = (st & 1) * 32 + (swz % 64) / 2; }
__host__ __device__ __forceinline__ int perm32(int rho) { const int n = rho >> 4, i = rho & 15; return 8 * (i >> 2) + 4 * n + (i & 3); }

struct Unit { int pm, pn; };
struct Gemm { const bf16_t* A; const bf16_t* Bt; int M, N, K; };

struct StaticOrder {
    int nM, nN, nwg, G, c;
    __host__ __device__ void init(int M, int N, int G_, int c_) { nM = M / BM; nN = N / BM; nwg = nM * nN; G = G_; c = c_; }
    __host__ __device__ bool next(int i, Unit& u) const {
        const long L = (long)i * G + c; if (L >= nwg) return false;
        int wgid = (int)L; { const int q = nwg / NXCD, r = nwg % NXCD, xcd = wgid % NXCD, off = wgid / NXCD; wgid = (xcd < r ? xcd * (q + 1) : r * (q + 1) + (xcd - r) * q) + off; }
        const int nig = WGM * nN, gid = wgid / nig, fm = gid * WGM, gsz = (nM - fm) < WGM ? (nM - fm) : WGM;
        u.pm = fm + ((wgid % nig) % gsz); u.pn = (wgid % nig) / gsz; return true;
    }
    __device__ __forceinline__ void a_ready(const Unit&) const {}
    __device__ __forceinline__ void done(const Unit&) const {}
};

__device__ __forceinline__ unsigned cvt_pk_bf16(float lo, float hi) { unsigned r; asm volatile("v_cvt_pk_bf16_f32 %0, %1, %2" : "=v"(r) : "v"(lo), "v"(hi)); return r; }
typedef float f32x2 __attribute__((ext_vector_type(2)));
__device__ __forceinline__ f32x2 gelu_pk(f32x2 v) {
    const f32x2 av = __builtin_elementwise_abs(v), d = av * 0.2316418882f + 1.0f;
    f32x2 t; t.x = __builtin_amdgcn_rcpf(d.x); t.y = __builtin_amdgcn_rcpf(d.y);
    f32x2 q = t * 0.5307027145f + (-0.7265760135f); q = q * t + 0.7107068705f; q = q * t + (-0.142248368f); q = q * t + 0.127414796f; q = q * t;
    const f32x2 s = (v * v) * (-0.72134752044f);
    f32x2 e; e.x = __builtin_amdgcn_exp2f(s.x); e.y = __builtin_amdgcn_exp2f(s.y);
    const f32x2 m = v * (q * e), r = v - m;
    f32x2 o; o.x = v.x < 0.f ? m.x : r.x; o.y = v.y < 0.f ? m.y : r.y; return o;
}

template <int ACT  > struct EpiBf16 {
    static constexpr bool PERM = true, AFTER_DRAIN = false; static_assert(ACT == 0 || ACT == 1, "EpiBf16: ACT is 0 (none) or 1 (gelu_pk)");
    bf16_t* O; int ldc; const float* bias; int split_cols; size_t split_stride; float scale0;
    __device__ __forceinline__ void operator()(const f32x4 (&acc)[2][2][4][2], const Unit& u, int wr, int wc, int fr, int fq) const {
        const int row0 = u.pm * BM + wr * 64 + fr; int colt = u.pn * BM; bf16_t* base = O;
        float sc = 1.f; if (split_cols) { const int t = colt / split_cols; base += (size_t)t * split_stride; colt -= t * split_cols; if (t == 0) sc = scale0; }
        const int col0 = colt + wc * 32 + 8 * fq, bcol0 = u.pn * BM + wc * 32 + 8 * fq;
        f32x4 bv[2][2];
#pragma unroll
        for (int bj = 0; bj < 2; ++bj)
#pragma unroll
            for (int n = 0; n < 2; ++n) bv[bj][n] = bias ? *(const f32x4*)(bias + bcol0 + bj * HALF + 4 * n) : (f32x4){0.f, 0.f, 0.f, 0.f};
#pragma unroll
        for (int ai = 0; ai < 2; ++ai)
#pragma unroll
            for (int m = 0; m < 4; ++m) { bf16_t* rowp = base + (size_t)(row0 + ai * HALF + m * 16) * ldc + col0;
#pragma unroll
                for (int bj = 0; bj < 2; ++bj) { f32x4 v0 = acc[ai][bj][m][0] + bv[bj][0], v1 = acc[ai][bj][m][1] + bv[bj][1];
                    if (ACT == 1) { f32x2 a = gelu_pk((f32x2){v0[0], v0[1]}), b = gelu_pk((f32x2){v0[2], v0[3]}), c = gelu_pk((f32x2){v1[0], v1[1]}), d = gelu_pk((f32x2){v1[2], v1[3]});
                        v0 = (f32x4){a.x, a.y, b.x, b.y}; v1 = (f32x4){c.x, c.y, d.x, d.y}; }
                    v0 = v0 * sc; v1 = v1 * sc; u32x4 w; w.x = cvt_pk_bf16(v0[0], v0[1]); w.y = cvt_pk_bf16(v0[2], v0[3]); w.z = cvt_pk_bf16(v1[0], v1[1]); w.w = cvt_pk_bf16(v1[2], v1[3]);
                    *(u32x4*)(rowp + bj * HALF) = w; } }
    }
};
template <class Epi, class Sched, bool ALIGN_EPI = false, bool SP2 = false>
__device__ __forceinline__ void gemm_phase(PG8_LAS unsigned char* lds, const Gemm g, const Sched& S, const Epi& E) {
    const int tid = threadIdx.x, wid = __builtin_amdgcn_readfirstlane(tid >> 6), lane = tid & 63, wr = wid >> 2, wc = wid & 3, fr = lane & 15, fq = lane >> 4;
    const int K = g.K, nt = K / BK;
    unsigned voffA[2], voffB[2];
#pragma unroll
    for (int i = 0; i < 2; ++i) { int R, C; stage_rc(tid * 16 + i * 8192, R, C); const int Rb = Epi::PERM ? ((R & ~31) + perm32(R & 31)) : R;
        voffA[i] = (unsigned)(R * K + C) * 2u; voffB[i] = (unsigned)(Rb * K + C) * 2u; }
    const size_t kstep = (size_t)(BK * 2);
    const size_t hstep = (size_t)HALF * K * 2;
    const size_t tstep = 2 * hstep;
    const unsigned ldsw = (unsigned)wid * 1024u;
    const int aoff = lds_byte(wr * 64 + fr, fq * 8), boff = lds_byte(wc * 32 + fr, fq * 8);
#define PG8_SA(b, h) (((b) * 2 + (h)) * HTB)
#define PG8_SB(b, h) ((4 + (b) * 2 + (h)) * HTB)
#define PG8_STAGE(bufoff, gbase, voff) do { _Pragma("unroll") for (int _i = 0; _i < 2; ++_i) \
        __builtin_amdgcn_global_load_lds((const unsigned*)((const char*)(gbase) + (voff)[_i]), (PG8_LAS unsigned*)(lds + (bufoff) + ldsw + _i * 8192), 16, 0, 0); } while (0)
#define PG8_LDA(dst, b, h) do { _Pragma("unroll") for (int m = 0; m < 4; ++m) _Pragma("unroll") for (int k = 0; k < 2; ++k) dst[m][k] = *(const PG8_LAS bf16x8*)(lds + PG8_SA(b, h) + aoff + m * 2048 + k * 1024); } while (0)
#define PG8_LDB(dst, b, h) do { _Pragma("unroll") for (int n = 0; n < 2; ++n) _Pragma("unroll") for (int k = 0; k < 2; ++k) dst[n][k] = *(const PG8_LAS bf16x8*)(lds + PG8_SB(b, h) + boff + n * 2048 + k * 1024); } while (0)
#define PG8_MMA(ai, bj, At, Bt) do { __builtin_amdgcn_s_setprio(1); _Pragma("unroll") for (int m = 0; m < 4; ++m) _Pragma("unroll") for (int n = 0; n < 2; ++n) _Pragma("unroll") for (int k = 0; k < 2; ++k) \
        acc[ai][bj][m][n] = __builtin_amdgcn_mfma_f32_16x16x32_bf16(Bt[n][k], At[m][k], acc[ai][bj][m][n], 0, 0, 0); __builtin_amdgcn_s_setprio(0); } while (0)
#define PG8_WAIT_V(n) asm volatile("s_waitcnt vmcnt(" #n ")" ::: "memory")
#define PG8_WAIT_L(n) asm volatile("s_waitcnt lgkmcnt(" #n ")" ::: "memory")
#define PG8_BAR __builtin_amdgcn_s_barrier()
#define PG8_SCHED __builtin_amdgcn_sched_barrier(0)
    Unit cur, nxt; int ui = 0;
    if (!S.next(0, cur)) return;
    f32x4 acc[2][2][4][2];
#pragma unroll
    for (int a = 0; a < 2; ++a)
#pragma unroll
        for (int b = 0; b < 2; ++b)
#pragma unroll
            for (int m = 0; m < 4; ++m)
#pragma unroll
                for (int n = 0; n < 2; ++n) acc[a][b][m][n] = (f32x4){0.f, 0.f, 0.f, 0.f};
    bf16x8 At[4][2], B0[2][2], B1[2][2];
    const char* cA = (const char*)g.A + (size_t)cur.pm * tstep; const char* cB = (const char*)g.Bt + (size_t)cur.pn * tstep;
    S.a_ready(cur);
    if constexpr (SP2) {
        PG8_STAGE(PG8_SB(0, 0), cB, voffB); PG8_STAGE(PG8_SB(0, 1), cB + hstep, voffB); PG8_STAGE(PG8_SA(0, 0), cA, voffA); PG8_STAGE(PG8_SA(0, 1), cA + hstep, voffA);
        if (wr == 1) PG8_BAR;
        PG8_WAIT_V(2); PG8_BAR;
        PG8_STAGE(PG8_SB(1, 0), cB + kstep, voffB); PG8_STAGE(PG8_SA(1, 0), cA + kstep, voffA); PG8_STAGE(PG8_SB(1, 1), cB + hstep + kstep, voffB);
        PG8_WAIT_V(6); PG8_BAR;
    } else {
        PG8_STAGE(PG8_SB(0, 0), cB, voffB); PG8_STAGE(PG8_SA(0, 0), cA, voffA); PG8_STAGE(PG8_SB(0, 1), cB + hstep, voffB); PG8_STAGE(PG8_SA(0, 1), cA + hstep, voffA);
        if (wr == 1) PG8_BAR;
        PG8_WAIT_V(4); PG8_BAR;
        PG8_STAGE(PG8_SB(1, 0), cB + kstep, voffB); PG8_STAGE(PG8_SA(1, 0), cA + kstep, voffA); PG8_STAGE(PG8_SB(1, 1), cB + hstep + kstep, voffB);
        PG8_WAIT_V(6); PG8_BAR;
    }
    for (;;) {
        const bool has_next = S.next(ui + 1, nxt);
        const char* nA = has_next ? (const char*)g.A + (size_t)nxt.pm * tstep : cA; const char* nB = has_next ? (const char*)g.Bt + (size_t)nxt.pn * tstep : cB;
        for (int t = 0; t < nt; t += 2) {
            const bool last = (t == nt - 2);
            const char* a1 = cA + (size_t)(t + 1) * kstep;
            const char* a2 = last ? nA : cA + (size_t)(t + 2) * kstep; const char* b2 = last ? nB : cB + (size_t)(t + 2) * kstep;
            const char* a3 = a2 + kstep; const char* b3 = b2 + kstep;
            if (last && has_next) S.a_ready(nxt);
            if constexpr (SP2) {
            PG8_LDB(B0, 0, 0); PG8_LDB(B1, 0, 1); PG8_SCHED; PG8_LDA(At, 0, 0); PG8_STAGE(PG8_SA(1, 1), a1 + hstep, voffA);
            PG8_WAIT_V(8); PG8_WAIT_L(0); PG8_BAR; PG8_MMA(0, 0, At, B0); PG8_MMA(0, 1, At, B1); PG8_BAR; PG8_SCHED;
            PG8_LDA(At, 0, 1); PG8_STAGE(PG8_SB(0, 0), b2, voffB); PG8_STAGE(PG8_SB(0, 1), b2 + hstep, voffB); PG8_STAGE(PG8_SA(0, 0), a2, voffA);
            PG8_WAIT_V(8); PG8_WAIT_L(0); PG8_BAR; PG8_MMA(1, 0, At, B0); PG8_MMA(1, 1, At, B1); PG8_BAR; PG8_SCHED;
            PG8_LDB(B0, 1, 0); PG8_LDB(B1, 1, 1); PG8_SCHED; PG8_LDA(At, 1, 0); PG8_STAGE(PG8_SA(0, 1), a2 + hstep, voffA);
            PG8_WAIT_V(8); PG8_WAIT_L(0); PG8_BAR; PG8_MMA(0, 0, At, B0); PG8_MMA(0, 1, At, B1); PG8_BAR; PG8_SCHED;
            PG8_LDA(At, 1, 1); PG8_STAGE(PG8_SB(1, 0), b3, voffB); PG8_STAGE(PG8_SB(1, 1), b3 + hstep, voffB); PG8_STAGE(PG8_SA(1, 0), a3, voffA);
            PG8_WAIT_V(8); PG8_WAIT_L(0); PG8_BAR; PG8_MMA(1, 0, At, B0); PG8_MMA(1, 1, At, B1); PG8_BAR; PG8_SCHED;
            } else {
            PG8_LDB(B0, 0, 0); PG8_SCHED; PG8_LDA(At, 0, 0); PG8_STAGE(PG8_SA(1, 1), a1 + hstep, voffA);
            PG8_WAIT_L(8); PG8_BAR; PG8_WAIT_L(0); PG8_MMA(0, 0, At, B0); PG8_BAR; PG8_SCHED;
            PG8_LDB(B1, 0, 1); PG8_STAGE(PG8_SB(0, 0), b2, voffB);
            PG8_BAR; PG8_WAIT_L(0); PG8_MMA(0, 1, At, B1); PG8_BAR;
            PG8_LDA(At, 0, 1); PG8_STAGE(PG8_SA(0, 0), a2, voffA);
            PG8_BAR; PG8_WAIT_L(0); PG8_MMA(1, 0, At, B0); PG8_BAR; PG8_SCHED;
            PG8_STAGE(PG8_SB(0, 1), b2 + hstep, voffB);
            PG8_WAIT_V(6); PG8_BAR; PG8_MMA(1, 1, At, B1); PG8_BAR;
            PG8_LDB(B0, 1, 0); PG8_SCHED; PG8_LDA(At, 1, 0); PG8_STAGE(PG8_SA(0, 1), a2 + hstep, voffA);
            PG8_WAIT_L(8); PG8_BAR; PG8_WAIT_L(0); PG8_MMA(0, 0, At, B0); PG8_BAR; PG8_SCHED;
            PG8_LDB(B1, 1, 1); PG8_STAGE(PG8_SB(1, 0), b3, voffB);
            PG8_BAR; PG8_WAIT_L(0); PG8_MMA(0, 1, At, B1); PG8_BAR;
            PG8_LDA(At, 1, 1); PG8_STAGE(PG8_SA(1, 0), a3, voffA);
            PG8_BAR; PG8_WAIT_L(0); PG8_MMA(1, 0, At, B0); PG8_BAR; PG8_SCHED;
            PG8_STAGE(PG8_SB(1, 1), b3 + hstep, voffB);
            PG8_WAIT_V(6); PG8_BAR; PG8_MMA(1, 1, At, B1); PG8_BAR;
            }
        }
        if constexpr (ALIGN_EPI) { if (wr == 0) PG8_BAR; }
        if constexpr (!Epi::AFTER_DRAIN) { E(acc, cur, wr, wc, fr, fq); S.done(cur); }
        if (!has_next) break;
#pragma unroll
        for (int a = 0; a < 2; ++a)
#pragma unroll
            for (int b = 0; b < 2; ++b)
#pragma unroll
                for (int m = 0; m < 4; ++m)
#pragma unroll
                    for (int n = 0; n < 2; ++n) acc[a][b][m][n] = (f32x4){0.f, 0.f, 0.f, 0.f};
        cur = nxt; cA = nA; cB = nB; ++ui;
        if constexpr (ALIGN_EPI) { if (wr == 1) PG8_BAR; }
    }
    PG8_WAIT_V(0);
    if constexpr (!ALIGN_EPI) { if (wr == 0) PG8_BAR; }
    PG8_BAR;
    if constexpr (Epi::AFTER_DRAIN) { E.fused(acc, cur, wr, wc, fr, fq, lds, wid, lane); S.done(cur); }
#undef PG8_SA
#undef PG8_SB
#undef PG8_STAGE
#undef PG8_LDA
#undef PG8_LDB
#undef PG8_MMA
#undef PG8_WAIT_V
#undef PG8_WAIT_L
#undef PG8_BAR
#undef PG8_SCHED
}
}

#ifndef PG8_SP2
#define PG8_SP2 true
#endif
#ifndef PG8_ALIGN
#define PG8_ALIGN true
#endif
#define GAS __attribute__((address_space(1)))
#define LAS __attribute__((address_space(3)))
typedef unsigned short bf16;
typedef unsigned v4u __attribute__((ext_vector_type(4)));
typedef float f32x4 __attribute__((ext_vector_type(4)));
typedef short bf16x8 __attribute__((ext_vector_type(8)));
typedef GAS unsigned gu32;
typedef GAS unsigned long long gu64;
#define RLX_AGENT __ATOMIC_RELAXED, __HIP_MEMORY_SCOPE_AGENT
#define LDS_WAIT() asm volatile("s_waitcnt lgkmcnt(0)" ::: "memory")
#define VM_WAIT() asm volatile("s_waitcnt vmcnt(0)" ::: "memory")
__device__ __forceinline__ unsigned long long rt() { return __builtin_amdgcn_s_memrealtime(); }
__device__ __forceinline__ unsigned f2bf(float f) { unsigned u = __builtin_bit_cast(unsigned, f); return (u + 0x7fffu + ((u >> 16) & 1u)) >> 16; }
__device__ __forceinline__ unsigned pk2(float lo, float hi) { return f2bf(lo) | (f2bf(hi) << 16); }

#define XB_TMO      128
#define XB_XCNT(j)  (256  + 64 * (j))
#define XB_XSUB(j)  (1280 + 64 * (j))
#define XB_XGEN(j)  (2304 + 64 * (j))
#define XB_TOP      3328
#define XB_TOPGEN   3392
#define XCD_BAR_WORDS 3456
#define XB_SPIN_CAP (1u << 22)

__device__ __forceinline__ unsigned xb_ld(unsigned* p)              { return __hip_atomic_load(p, __ATOMIC_RELAXED, __HIP_MEMORY_SCOPE_AGENT); }
__device__ __forceinline__ unsigned xb_add(unsigned* p, unsigned v) { return __hip_atomic_fetch_add(p, v, __ATOMIC_RELAXED, __HIP_MEMORY_SCOPE_AGENT); }
__device__ __forceinline__ unsigned xb_xcc_id() { return (unsigned)__builtin_amdgcn_s_getreg((3 << 11) | 20) & 0xFu; }
#define XB_SPIN(cond, bar) do { unsigned _sp = 0; while (cond) { __builtin_amdgcn_s_sleep(1); \
    if ((++_sp & 255u) == 0u) { if (xb_ld(&(bar)[XB_TMO])) break; if (_sp > XB_SPIN_CAP) { atomicAdd(&(bar)[XB_TMO], 1u); break; } } } } while (0)

struct XcdBarrier {
    unsigned* bar; unsigned x;
    volatile LAS unsigned* st;
};

__device__ __forceinline__ XcdBarrier xcd_barrier_post(unsigned* bar, volatile LAS unsigned* st) {
    XcdBarrier b; b.bar = bar; b.x = xb_xcc_id(); b.st = st;
    if (threadIdx.x == 0) (void)xb_add(&bar[XB_XCNT(b.x)], 1u);
    return b;
}
__device__ __forceinline__ void xcd_barrier_complete(unsigned* bar, unsigned x, unsigned& nloc, unsigned& nx) {
    const unsigned G = gridDim.x * gridDim.y * gridDim.z;
    unsigned sum, cnt, mine, sp = 0u;
    for (;;) {
        sum = 0u; cnt = 0u; mine = 0u;
#pragma unroll
        for (unsigned j = 0; j < 16; ++j) { const unsigned c = xb_ld(&bar[XB_XCNT(j)]); sum += c; cnt += (c > 0u) ? 1u : 0u; mine = (j == x) ? c : mine; }
        if (sum == G) break;
        __builtin_amdgcn_s_sleep(1);
        if ((++sp & 255u) == 0u) { if (xb_ld(&bar[XB_TMO])) break; if (sp > XB_SPIN_CAP) { atomicAdd(&bar[XB_TMO], 1u); break; } }
    }
    nloc = mine > 0u ? mine : 1u; nx = cnt > 0u ? cnt : 1u;
}

__device__ __forceinline__ void xcd_barrier(const XcdBarrier& b) {
    asm volatile("s_waitcnt vmcnt(0)" ::: "memory");
    __syncthreads();
    if (threadIdx.x == 0) {
        unsigned* bar = b.bar;
        __builtin_amdgcn_s_waitcnt(0);
        unsigned nloc = b.st[0], nx = b.st[1];
        if (nloc == 0u) { xcd_barrier_complete(bar, b.x, nloc, nx); b.st[0] = nloc; b.st[1] = nx; }
        const unsigned old = xb_add(&bar[XB_XSUB(b.x)], 1u);
        const unsigned gen = old / nloc;
        if (old + 1u == (gen + 1u) * nloc) {
            __builtin_amdgcn_fence(__ATOMIC_RELEASE, "agent");
            asm volatile("s_waitcnt vmcnt(0)" ::: "memory");
            const unsigned og = xb_add(&bar[XB_TOP], 1u);
            const unsigned tg = og / nx;
            if (og + 1u == (tg + 1u) * nx) xb_add(&bar[XB_TOPGEN], 1u);
            else XB_SPIN(xb_ld(&bar[XB_TOPGEN]) == tg, bar);
            __builtin_amdgcn_fence(__ATOMIC_ACQUIRE, "agent");
            xb_add(&bar[XB_XGEN(b.x)], 1u);
            asm volatile("s_waitcnt vmcnt(0)" ::: "memory");
        } else {
            XB_SPIN(xb_ld(&bar[XB_XGEN(b.x)]) == gen, bar);
            __builtin_amdgcn_fence(__ATOMIC_ACQUIRE, "agent");
            asm volatile("s_waitcnt vmcnt(0)" ::: "memory");
        }
    }
    __syncthreads();
}

constexpr int NWAVES = 8;
constexpr int T_ = 16384, SEQ = 4096, DM = 1024, NPROJ = 2304, INC = 2312;
constexpr int PJ_K = 512, PJ_V = 640, PJ_Z = 768, PJ_XBC = 1280;
constexpr float EPS = 1e-6f;
constexpr size_t MiB = 1u << 20;
constexpr size_t WS_CTL = 0, CTL_ZERO_BYTES = 1 * MiB;
constexpr size_t WS_SMALL = 1 * MiB;
constexpr size_t WS_WIN = 2 * MiB, WS_WOUT = 7 * MiB, WS_WQ = 9 * MiB;
constexpr size_t WS_ED = 13 * MiB, WS_EU = 45 * MiB;
constexpr size_t WS_XN = 77 * MiB;
constexpr size_t WS_PROJ = 109 * MiB;
constexpr size_t WS_ST = 181 * MiB;
constexpr size_t WS_IDX = 213 * MiB, WS_GATE = 221 * MiB, WS_SSQ = 229 * MiB, WS_END = 230 * MiB;
constexpr size_t DO_Y = 0, DO_DT = 41 * MiB;
constexpr int CW_BAR = 4096;
constexpr int RING_OFF = 0, RING_BYTES = 131072, LDSCTL_OFF = RING_BYTES, MISC_OFF = LDSCTL_OFF + 320, LDS_BYTES = 147456;

__constant__ unsigned char c_bucket[128] = {0, 1, 2, 3, 4, 5, 6, 7, 8, 9, 10, 11, 12, 13, 14, 15, 16, 16, 16, 17, 17, 18, 18, 18, 19, 19, 19, 20, 20, 20, 20, 21, 21, 21, 21, 22, 22, 22, 22, 22, 23, 23, 23, 23, 23, 23, 24, 24, 24, 24, 24, 24, 25, 25, 25, 25, 25, 25, 25, 26, 26, 26, 26, 26, 26, 26, 26, 27, 27, 27, 27, 27, 27, 27, 27, 27, 27, 28, 28, 28, 28, 28, 28, 28, 28, 28, 28, 29, 29, 29, 29, 29, 29, 29, 29, 29, 29, 29, 29, 30, 30, 30, 30, 30, 30, 30, 30, 30, 30, 30, 30, 30, 30, 31, 31, 31, 31, 31, 31, 31, 31, 31, 31, 31, 31, 31, 31, 31};

struct Frame {
    LAS unsigned char* lds;
    volatile LAS unsigned* MISC;
    gu32* ctl;
    int tid, lane, wave, vcu, G;
};
__device__ __forceinline__ float wave_sum(float v) {
#pragma unroll
    for (int o = 1; o < 64; o <<= 1) v += __shfl_xor(v, o);
    return v;
}
__device__ __forceinline__ float bf2f(unsigned short b) { return __uint_as_float((unsigned)b << 16); }
__device__ __forceinline__ float bflo(unsigned w) { return __uint_as_float(w << 16); }
__device__ __forceinline__ float bfhi(unsigned w) { return __uint_as_float(w & 0xffff0000u); }
__device__ __forceinline__ float silu_f(float x) { return x / (1.f + __expf(-x)); }

__device__ __forceinline__ void p0_transpose_item(const float* W, int ldw, int K, int nblk, bf16* WT, const float* kscale, LAS float* scr, int item, int lane) {
    const int kb = item / nblk, nb = item % nblk, k0 = 64 * kb, n0 = 32 * nb;
#pragma unroll 8
    for (int i = 0; i < 32; ++i) { const int kk = 2 * i + (lane >> 5); float v = W[(size_t)(k0 + kk) * ldw + n0 + (lane & 31)]; if (kscale) v *= kscale[k0 + kk]; scr[kk * 33 + (lane & 31)] = v; }
    LDS_WAIT(); asm volatile("" ::: "memory");
    const int c = lane & 7;
#pragma unroll
    for (int j = 0; j < 4; ++j) { const int n = (lane >> 3) + 8 * j; const LAS float* s = scr + (8 * c) * 33 + n;
        v4u o; o.x = pk2(s[0 * 33], s[1 * 33]); o.y = pk2(s[2 * 33], s[3 * 33]); o.z = pk2(s[4 * 33], s[5 * 33]); o.w = pk2(s[6 * 33], s[7 * 33]);
        *(GAS v4u*)(WT + (size_t)(n0 + n) * K + k0 + 8 * c) = o; }
    LDS_WAIT(); asm volatile("" ::: "memory");
}
struct Ptrs {
    const float *x, *norm_mix, *w_in, *conv_w, *conv_b, *dt_bias, *a_log, *d_skip, *ssd_norm_w, *sinks, *w_out, *rel_bias, *norm_ffn, *w_query, *sk1, *sk2, *e_down, *e_up, *norm_final;
    float* out; unsigned char* ws;
};
__device__ __forceinline__ void p0_prologue(Frame& F, const Ptrs& P) {
    LAS float* scr = (LAS float*)(F.lds + RING_OFF + F.wave * 16384);
    const int gw = F.vcu * NWAVES + F.wave, NGW = F.G * NWAVES;
    bf16* Win_t = (bf16*)(P.ws + WS_WIN); bf16* Wout_t = (bf16*)(P.ws + WS_WOUT); bf16* Wq_t = (bf16*)(P.ws + WS_WQ);
    constexpr int I_IN = 16 * 72, I_OUT = 16 * 32, I_Q = 16 * 64, NITEMS = I_IN + I_OUT + I_Q;
    for (int it = gw; it < NITEMS; it += NGW) {
        int r = it;
        if (r < I_IN) { p0_transpose_item(P.w_in, INC, DM, 72, Win_t, nullptr, scr, r, F.lane); continue; } r -= I_IN;
        if (r < I_OUT) { p0_transpose_item(P.w_out, DM, DM, 32, Wout_t, nullptr, scr, r, F.lane); continue; } r -= I_OUT;
        p0_transpose_item(P.w_query, 2048, DM, 64, Wq_t, P.norm_ffn, scr, r, F.lane);
    }
    { float* K1T = (float*)(P.ws + WS_SMALL); float* K2T = K1T + 16384;
      for (int i = F.vcu * 512 + F.tid; i < 16384; i += F.G * 512) { const int n = i >> 7, k = i & 127; K1T[k * 128 + n] = P.sk1[i]; K2T[k * 128 + n] = P.sk2[i]; } }
    { const float4* nf4 = (const float4*)P.norm_ffn;
      for (int i = F.vcu * 512 + F.tid; i < 2097152; i += F.G * 512) {
        const int c = i & 127;
        const float4 a = ((const float4*)P.e_down)[2 * (size_t)i], b = ((const float4*)P.e_down)[2 * (size_t)i + 1], wa = nf4[2 * c], wb = nf4[2 * c + 1];
        v4u o; o.x = pk2(a.x * wa.x, a.y * wa.y); o.y = pk2(a.z * wa.z, a.w * wa.w); o.z = pk2(b.x * wb.x, b.y * wb.y); o.w = pk2(b.z * wb.z, b.w * wb.w);
        ((v4u*)(P.ws + WS_ED))[i] = o;
        const float4 u0 = ((const float4*)P.e_up)[2 * (size_t)i], u1 = ((const float4*)P.e_up)[2 * (size_t)i + 1];
        v4u q; q.x = pk2(u0.x, u0.y); q.y = pk2(u0.z, u0.w); q.z = pk2(u1.x, u1.y); q.w = pk2(u1.z, u1.w);
        ((v4u*)(P.ws + WS_EU))[i] = q; } }
    __syncthreads();
    { LAS float* Wdt = (LAS float*)(F.lds + RING_OFF);
      for (int i = F.tid; i < 8192; i += 512) Wdt[i] = P.w_in[(size_t)(i >> 3) * INC + NPROJ + (i & 7)];
      __syncthreads();
      bf16* XN = (bf16*)(P.ws + WS_XN); float* DT = (float*)((char*)P.out + DO_DT);
      for (int m = gw; m < T_; m += NGW) {
        const float4* xr = (const float4*)(P.x + (size_t)m * DM);
        float4 v[4]; float s = 0.f;
#pragma unroll
        for (int j = 0; j < 4; ++j) { v[j] = xr[j * 64 + F.lane]; s += v[j].x * v[j].x + v[j].y * v[j].y + v[j].z * v[j].z + v[j].w * v[j].w; }
        const float r = rsqrtf(wave_sum(s) * (1.f / 1024.f) + EPS);
        float d8[8];
#pragma unroll
        for (int q = 0; q < 8; ++q) d8[q] = 0.f;
        unsigned long long* o8 = (unsigned long long*)(XN + (size_t)m * DM);
#pragma unroll
        for (int j = 0; j < 4; ++j) { const float4 w = ((const float4*)P.norm_mix)[j * 64 + F.lane];
            const float e0 = v[j].x * r * w.x, e1 = v[j].y * r * w.y, e2 = v[j].z * r * w.z, e3 = v[j].w * r * w.w;
            o8[j * 64 + F.lane] = (unsigned long long)pk2(e0, e1) | ((unsigned long long)pk2(e2, e3) << 32);
            const float ev[4] = {e0, e1, e2, e3};
#pragma unroll
            for (int e = 0; e < 4; ++e) { const LAS f32x4* wr = (const LAS f32x4*)(Wdt + (size_t)(j * 256 + F.lane * 4 + e) * 8); const f32x4 w0 = wr[0], w1 = wr[1];
                d8[0] += ev[e] * w0.x; d8[1] += ev[e] * w0.y; d8[2] += ev[e] * w0.z; d8[3] += ev[e] * w0.w; d8[4] += ev[e] * w1.x; d8[5] += ev[e] * w1.y; d8[6] += ev[e] * w1.z; d8[7] += ev[e] * w1.w; } }
#pragma unroll
        for (int q = 0; q < 8; ++q) d8[q] = wave_sum(d8[q]);
        if (F.lane == 0) { float4* dp = (float4*)(DT + (size_t)m * 8); dp[0] = make_float4(d8[0], d8[1], d8[2], d8[3]); dp[1] = make_float4(d8[4], d8[5], d8[6], d8[7]); }
      }
      __syncthreads(); }
}

struct EpiResH {
    static constexpr bool PERM = false, AFTER_DRAIN = false;
    const float* X; bf16* HB; float* SSQ;
    __device__ __forceinline__ void operator()(const pg8::f32x4 (&acc)[2][2][4][2], const pg8::Unit& u, int wr, int wc, int fr, int fq) const {
        const int row0 = u.pm * 256 + wr * 64 + fr, col0 = u.pn * 256 + wc * 32 + 4 * fq;
#pragma unroll
        for (int ai = 0; ai < 2; ++ai)
#pragma unroll
            for (int m = 0; m < 4; ++m) { const int row = row0 + ai * 128 + m * 16; float ss = 0.f;
#pragma unroll
                for (int bj = 0; bj < 2; ++bj)
#pragma unroll
                    for (int n = 0; n < 2; ++n) { const size_t off = (size_t)row * DM + col0 + bj * 128 + n * 16;
                        const pg8::f32x4 h = acc[ai][bj][m][n] + *(const pg8::f32x4*)(X + off);
                        ss += h[0] * h[0] + h[1] * h[1] + h[2] * h[2] + h[3] * h[3];
                        *(unsigned long long*)(HB + off) = (unsigned long long)pk2(h[0], h[1]) | ((unsigned long long)pk2(h[2], h[3]) << 32); }
                ss += __shfl_xor(ss, 16); ss += __shfl_xor(ss, 32);
                if (fq == 0) SSQ[(size_t)row * 16 + u.pn * 4 + wc] = ss; }
    }
};

__device__ __forceinline__ void attn_naive(Frame& F, const Ptrs& P) {
    const bf16* PROJ = (const bf16*)(P.ws + WS_PROJ); bf16* CAT = (bf16*)(P.ws + WS_XN);
    for (int vb = F.vcu * 4 + (F.tid >> 7); vb < (T_ / 128) * 8; vb += F.G * 4) {
        const int h = vb & 7, t = (vb >> 3) * 128 + (F.tid & 127), pos = t & (SEQ - 1), base = t - pos, hkv = h >> 2;
        float q[64], acc[64];
        { const v4u* qp = (const v4u*)(PROJ + (size_t)t * NPROJ + h * 64);
#pragma unroll
          for (int c = 0; c < 8; ++c) { const v4u w = qp[c]; q[8 * c] = bflo(w.x); q[8 * c + 1] = bfhi(w.x); q[8 * c + 2] = bflo(w.y); q[8 * c + 3] = bfhi(w.y); q[8 * c + 4] = bflo(w.z); q[8 * c + 5] = bfhi(w.z); q[8 * c + 6] = bflo(w.w); q[8 * c + 7] = bfhi(w.w); } }
#pragma unroll
        for (int d = 0; d < 64; ++d) acc[d] = 0.f;
        float m = P.sinks[h], l = 1.f;
        const int k_lo = pos - 127 < 0 ? 0 : pos - 127;
        for (int kp = k_lo; kp <= pos; ++kp) {
            const v4u* kr = (const v4u*)(PROJ + (size_t)(base + kp) * NPROJ + PJ_K + hkv * 64);
            const v4u* vr = (const v4u*)(PROJ + (size_t)(base + kp) * NPROJ + PJ_V + hkv * 64);
            float s = 0.f;
#pragma unroll
            for (int c = 0; c < 8; ++c) { const v4u w = kr[c];
                s += q[8 * c] * bflo(w.x) + q[8 * c + 1] * bfhi(w.x) + q[8 * c + 2] * bflo(w.y) + q[8 * c + 3] * bfhi(w.y) + q[8 * c + 4] * bflo(w.z) + q[8 * c + 5] * bfhi(w.z) + q[8 * c + 6] * bflo(w.w) + q[8 * c + 7] * bfhi(w.w); }
            s = s * 0.125f + P.rel_bias[c_bucket[pos - kp] * 8 + h];
            if (s > m) { const float f = __expf(m - s); l *= f;
#pragma unroll
                for (int d = 0; d < 64; ++d) acc[d] *= f;
                m = s; }
            const float p = __expf(s - m); l += p;
#pragma unroll
            for (int c = 0; c < 8; ++c) { const v4u w = vr[c];
                acc[8 * c] += p * bflo(w.x); acc[8 * c + 1] += p * bfhi(w.x); acc[8 * c + 2] += p * bflo(w.y); acc[8 * c + 3] += p * bfhi(w.y); acc[8 * c + 4] += p * bflo(w.z); acc[8 * c + 5] += p * bfhi(w.z); acc[8 * c + 6] += p * bflo(w.w); acc[8 * c + 7] += p * bfhi(w.w); }
        }
        const float inv = 1.f / l;
        v4u* o = (v4u*)(CAT + (size_t)t * DM + h * 64);
#pragma unroll
        for (int c = 0; c < 8; ++c) { v4u w; w.x = pk2(acc[8 * c] * inv, acc[8 * c + 1] * inv); w.y = pk2(acc[8 * c + 2] * inv, acc[8 * c + 3] * inv); w.z = pk2(acc[8 * c + 4] * inv, acc[8 * c + 5] * inv); w.w = pk2(acc[8 * c + 6] * inv, acc[8 * c + 7] * inv); o[c] = w; }
    }
}
__device__ __forceinline__ void ssd_seq_naive(Frame& F, const Ptrs& P) {
    if (F.vcu >= 32) return;
    const bf16* PROJ = (const bf16*)(P.ws + WS_PROJ); const float* DT = (const float*)((const char*)P.out + DO_DT); float* Y = (float*)((char*)P.out + DO_Y);
    LAS float* sx = (LAS float*)(F.lds + RING_OFF); LAS float* sB = sx + 64; LAS float* sC = sB + 128;
    const int b = F.vcu >> 3, h = F.vcu & 7, grp = h >> 2, p = F.tid >> 3, nq = F.tid & 7;
    const float A = -__expf(P.a_log[h]), Dh = P.d_skip[h], dtb = P.dt_bias[h];
    float st[16];
#pragma unroll
    for (int i = 0; i < 16; ++i) st[i] = 0.f;
    for (int s = 0; s < SEQ; ++s) {
        const size_t row = (size_t)b * SEQ + s;
        if (F.tid < 320) { const int i = F.tid; int ch;
            if (i < 64) ch = h * 64 + i; else if (i < 192) ch = 512 + grp * 128 + (i - 64); else ch = 768 + grp * 128 + (i - 192);
            float a = P.conv_b[ch];
#pragma unroll
            for (int j = 0; j < 4; ++j) { const int ss = s - 3 + j; if (ss >= 0) a += P.conv_w[j * 1024 + ch] * bf2f(PROJ[((size_t)b * SEQ + ss) * NPROJ + PJ_XBC + ch]); }
            a = silu_f(a);
            if (i < 64) sx[i] = a; else if (i < 192) sB[i - 64] = a; else sC[i - 192] = a; }
        __syncthreads();
        const float xr = DT[row * 8 + h] + dtb;
        const float dt = fmaxf(xr, 0.f) + log1pf(__expf(-fabsf(xr)));
        const float dec = __expf(dt * A);
        const float xs = sx[p], X = xs * dt;
        float part = 0.f;
#pragma unroll
        for (int i = 0; i < 16; ++i) { st[i] = st[i] * dec + sB[nq * 16 + i] * X; part += sC[nq * 16 + i] * st[i]; }
        part += __shfl_xor(part, 1); part += __shfl_xor(part, 2); part += __shfl_xor(part, 4);
        if (nq == 0) Y[row * 512 + h * 64 + p] = part + Dh * xs;
        __syncthreads();
    }
}
__device__ __forceinline__ void gate_norm_naive(Frame& F, const Ptrs& P) {
    const bf16* PROJ = (const bf16*)(P.ws + WS_PROJ); bf16* CAT = (bf16*)(P.ws + WS_XN); const float* Y = (const float*)((const char*)P.out + DO_Y);
    for (int row = F.vcu * NWAVES + F.wave; row < T_; row += F.G * NWAVES) {
        float v[8]; float s = 0.f;
#pragma unroll
        for (int j = 0; j < 8; ++j) { const int c = j * 64 + F.lane; const float z = bf2f(PROJ[(size_t)row * NPROJ + PJ_Z + c]); v[j] = Y[(size_t)row * 512 + c] * silu_f(z); s += v[j] * v[j]; }
        const float r = rsqrtf(wave_sum(s) * (1.f / 512.f) + EPS);
#pragma unroll
        for (int j = 0; j < 8; ++j) { const int c = j * 64 + F.lane; CAT[(size_t)row * DM + 512 + c] = (bf16)f2bf(v[j] * r * P.ssd_norm_w[c]); }
    }
}
__device__ __forceinline__ void topk_naive(Frame& F, const Ptrs& P) {
    const bf16* Q = (const bf16*)(P.ws + WS_PROJ); const float* K1T = (const float*)(P.ws + WS_SMALL); const float* K2T = K1T + 16384; const float* SSQ = (const float*)(P.ws + WS_SSQ);
    int* IDX = (int*)(P.ws + WS_IDX); float* GATE = (float*)(P.ws + WS_GATE);
    const int lane = F.lane;
    for (int gw = F.vcu * NWAVES + F.wave; gw < T_ * 8; gw += F.G * NWAVES) {
        const bf16* qrow = Q + (size_t)gw * 256;
        float s1a = 0.f, s1b = 0.f, s2a = 0.f, s2b = 0.f;
        for (int k = 0; k < 128; ++k) {
            const float qa = bf2f(qrow[k]), qb = bf2f(qrow[128 + k]);
            s1a += qa * K1T[k * 128 + lane]; s1b += qa * K1T[k * 128 + 64 + lane];
            s2a += qb * K2T[k * 128 + lane]; s2b += qb * K2T[k * 128 + 64 + lane];
        }
        const float NEG = -INFINITY;
        float myv1 = 0.f, myv2 = 0.f; int myi1 = 0, myi2 = 0;
        for (int r = 0; r < 16; ++r) {
            float bv; int bi;
            if (s1a >= s1b) { bv = s1a; bi = lane; } else { bv = s1b; bi = lane + 64; }
#pragma unroll
            for (int o = 32; o >= 1; o >>= 1) { const float ov = __shfl_xor(bv, o); const int oi = __shfl_xor(bi, o); if (ov > bv || (ov == bv && oi < bi)) { bv = ov; bi = oi; } }
            if (lane == r) { myv1 = bv; myi1 = bi; }
            if (bi == lane) s1a = NEG; if (bi == lane + 64) s1b = NEG;
        }
        for (int r = 0; r < 16; ++r) {
            float bv; int bi;
            if (s2a >= s2b) { bv = s2a; bi = lane; } else { bv = s2b; bi = lane + 64; }
#pragma unroll
            for (int o = 32; o >= 1; o >>= 1) { const float ov = __shfl_xor(bv, o); const int oi = __shfl_xor(bi, o); if (ov > bv || (ov == bv && oi < bi)) { bv = ov; bi = oi; } }
            if (lane == r) { myv2 = bv; myi2 = bi; }
            if (bi == lane) s2a = NEG; if (bi == lane + 64) s2b = NEG;
        }
        float cand[4];
#pragma unroll
        for (int c = 0; c < 4; ++c) { const int pos = lane + 64 * c; cand[c] = __shfl(myv1, pos >> 4) + __shfl(myv2, pos & 15); }
        float mys = 0.f; int mypos = 0;
        for (int r = 0; r < 16; ++r) {
            float bv = cand[0]; int bi = lane;
#pragma unroll
            for (int c = 1; c < 4; ++c) if (cand[c] > bv) { bv = cand[c]; bi = lane + 64 * c; }
#pragma unroll
            for (int o = 32; o >= 1; o >>= 1) { const float ov = __shfl_xor(bv, o); const int oi = __shfl_xor(bi, o); if (ov > bv || (ov == bv && oi < bi)) { bv = ov; bi = oi; } }
            if (lane == r) { mys = bv; mypos = bi; }
#pragma unroll
            for (int c = 0; c < 4; ++c) if (bi == lane + 64 * c) cand[c] = NEG;
        }
        const int e1 = __shfl(myi1, mypos >> 4), e2 = __shfl(myi2, mypos & 15);
        const int t = gw >> 3;
        float ssq = lane < 16 ? SSQ[(size_t)t * 16 + lane] : 0.f;
        const float rstd = rsqrtf(wave_sum(ssq) * (1.f / 1024.f) + EPS);
        const float mx = __shfl(mys, 0);
        const float e = lane < 16 ? __expf((mys - mx) * rstd) : 0.f;
        const float sum = wave_sum(e);
        if (lane < 16) { IDX[(size_t)gw * 16 + lane] = e1 * 128 + e2; GATE[(size_t)gw * 16 + lane] = e / sum; }
    }
}
__device__ __forceinline__ void peer_eval_naive(Frame& F, const Ptrs& P) {
    const bf16* HB = (const bf16*)(P.ws + WS_ST); const bf16* ED = (const bf16*)(P.ws + WS_ED); const bf16* EU = (const bf16*)(P.ws + WS_EU);
    const int* IDX = (const int*)(P.ws + WS_IDX); const float* GATE = (const float*)(P.ws + WS_GATE);
    const int lane = F.lane;
    for (int t = F.vcu * NWAVES + F.wave; t < T_; t += F.G * NWAVES) {
        float hv[16], xn[16], acc[16]; float s = 0.f;
#pragma unroll
        for (int j = 0; j < 2; ++j) { const v4u w = ((const v4u*)(HB + (size_t)t * DM))[j * 64 + lane];
            hv[8 * j] = bflo(w.x); hv[8 * j + 1] = bfhi(w.x); hv[8 * j + 2] = bflo(w.y); hv[8 * j + 3] = bfhi(w.y); hv[8 * j + 4] = bflo(w.z); hv[8 * j + 5] = bfhi(w.z); hv[8 * j + 6] = bflo(w.w); hv[8 * j + 7] = bfhi(w.w); }
#pragma unroll
        for (int i = 0; i < 16; ++i) { s += hv[i] * hv[i]; acc[i] = 0.f; }
        const float r = rsqrtf(wave_sum(s) * (1.f / 1024.f) + EPS);
#pragma unroll
        for (int i = 0; i < 16; ++i) xn[i] = hv[i] * r;
        for (int e = 0; e < 128; ++e) {
            const int id = IDX[(size_t)t * 128 + e]; const float g = GATE[(size_t)t * 128 + e];
            float part = 0.f;
#pragma unroll
            for (int j = 0; j < 2; ++j) { const v4u w = ((const v4u*)(ED + (size_t)id * DM))[j * 64 + lane];
                part += xn[8 * j] * bflo(w.x) + xn[8 * j + 1] * bfhi(w.x) + xn[8 * j + 2] * bflo(w.y) + xn[8 * j + 3] * bfhi(w.y) + xn[8 * j + 4] * bflo(w.z) + xn[8 * j + 5] * bfhi(w.z) + xn[8 * j + 6] * bflo(w.w) + xn[8 * j + 7] * bfhi(w.w); }
            const float pre = wave_sum(part);
            const float act = 0.5f * pre * (1.f + erff(pre * 0.70710678118654752f)) * g;
#pragma unroll
            for (int j = 0; j < 2; ++j) { const v4u w = ((const v4u*)(EU + (size_t)id * DM))[j * 64 + lane];
                acc[8 * j] += act * bflo(w.x); acc[8 * j + 1] += act * bfhi(w.x); acc[8 * j + 2] += act * bflo(w.y); acc[8 * j + 3] += act * bfhi(w.y); acc[8 * j + 4] += act * bflo(w.z); acc[8 * j + 5] += act * bfhi(w.z); acc[8 * j + 6] += act * bflo(w.w); acc[8 * j + 7] += act * bfhi(w.w); }
        }
        float s2 = 0.f;
#pragma unroll
        for (int i = 0; i < 16; ++i) { acc[i] += hv[i]; s2 += acc[i] * acc[i]; }
        const float r2 = rsqrtf(wave_sum(s2) * (1.f / 1024.f) + EPS);
#pragma unroll
        for (int j = 0; j < 2; ++j) { const int c0 = (j * 64 + lane) * 8; const float4 w0 = *(const float4*)(P.norm_final + c0), w1 = *(const float4*)(P.norm_final + c0 + 4);
            float4* o = (float4*)(P.out + (size_t)t * DM + c0);
            o[0] = make_float4(acc[8 * j] * r2 * w0.x, acc[8 * j + 1] * r2 * w0.y, acc[8 * j + 2] * r2 * w0.z, acc[8 * j + 3] * r2 * w0.w);
            o[1] = make_float4(acc[8 * j + 4] * r2 * w1.x, acc[8 * j + 5] * r2 * w1.y, acc[8 * j + 6] * r2 * w1.z, acc[8 * j + 7] * r2 * w1.w); }
    }
}

struct Args { Ptrs p; };
__global__ void __launch_bounds__(NWAVES * 64, 2) hymba_fwd(Args args) {
    extern __shared__ __attribute__((aligned(16))) unsigned char lds[];
    const Ptrs& P = args.p;
    Frame F;
    F.lds = (LAS unsigned char*)lds;
    F.MISC = (volatile LAS unsigned*)(F.lds + MISC_OFF);
    F.tid = threadIdx.x; F.lane = F.tid & 63; F.wave = __builtin_amdgcn_readfirstlane(F.tid >> 6);
    F.G = gridDim.x; { const int bx = blockIdx.x; F.vcu = (F.G % 8 == 0) ? (bx % 8) * (F.G / 8) + bx / 8 : bx; }
    F.ctl = (gu32*)(P.ws + WS_CTL);
    for (int u = F.tid; u < (LDS_BYTES - LDSCTL_OFF) / 4; u += NWAVES * 64) ((LAS unsigned*)(F.lds + LDSCTL_OFF))[u] = 0u;
    __syncthreads();
    XcdBarrier bar = xcd_barrier_post((unsigned*)(F.ctl + CW_BAR), F.MISC + 8);
#define GRID_BAR() xcd_barrier(bar)

    bf16* XN = (bf16*)(P.ws + WS_XN); bf16* PROJ = (bf16*)(P.ws + WS_PROJ); bf16* HB = (bf16*)(P.ws + WS_ST);
    p0_prologue(F, P);
    GRID_BAR();
    { pg8::Gemm g{XN, (const bf16*)(P.ws + WS_WIN), T_, NPROJ, DM}; pg8::StaticOrder S; S.init(T_, NPROJ, F.G, (int)blockIdx.x);
      pg8::EpiBf16<0> E{PROJ, NPROJ, nullptr, 0, 0, 1.f};
      pg8::gemm_phase<pg8::EpiBf16<0>, pg8::StaticOrder, PG8_ALIGN, PG8_SP2>(F.lds + RING_OFF, g, S, E); }
    GRID_BAR();
    ssd_seq_naive(F, P);
    attn_naive(F, P);
    GRID_BAR();
    gate_norm_naive(F, P);
    GRID_BAR();
    { pg8::Gemm g{XN, (const bf16*)(P.ws + WS_WOUT), T_, DM, DM}; pg8::StaticOrder S; S.init(T_, DM, F.G, (int)blockIdx.x);
      EpiResH E{P.x, HB, (float*)(P.ws + WS_SSQ)};
      pg8::gemm_phase<EpiResH, pg8::StaticOrder, PG8_ALIGN, PG8_SP2>(F.lds + RING_OFF, g, S, E); }
    GRID_BAR();
    { pg8::Gemm g{HB, (const bf16*)(P.ws + WS_WQ), T_, 2048, DM}; pg8::StaticOrder S; S.init(T_, 2048, F.G, (int)blockIdx.x);
      pg8::EpiBf16<0> E{PROJ, 2048, nullptr, 0, 0, 1.f};
      pg8::gemm_phase<pg8::EpiBf16<0>, pg8::StaticOrder, PG8_ALIGN, PG8_SP2>(F.lds + RING_OFF, g, S, E); }
    GRID_BAR();
    topk_naive(F, P);
    GRID_BAR();
    peer_eval_naive(F, P);
}

extern "C" void kernel_launch(void* const* d_in, const int* in_sizes, int n_in, void* d_out, int out_size, void* d_ws, size_t ws_size, hipStream_t stream) {
    static int grid = 0;
    if (grid == 0) {
        if (n_in != 19 || out_size != T_ * DM || ws_size < WS_END) { fprintf(stderr, "kernel_launch: unexpected shapes (n_in %d, out %d, ws %zu)\n", n_in, out_size, ws_size); grid = -1; return; }
        int dev = 0, cus = 0, per_cu = 0;
        if (hipGetDevice(&dev) != hipSuccess || hipDeviceGetAttribute(&cus, hipDeviceAttributeMultiprocessorCount, dev) != hipSuccess) { grid = -1; return; }
        if (hipFuncSetAttribute((const void*)hymba_fwd, hipFuncAttributeMaxDynamicSharedMemorySize, LDS_BYTES) != hipSuccess) { fprintf(stderr, "kernel_launch: hipFuncSetAttribute failed\n"); grid = -1; return; }
        if (hipOccupancyMaxActiveBlocksPerMultiprocessor(&per_cu, (const void*)hymba_fwd, NWAVES * 64, LDS_BYTES) != hipSuccess || per_cu < 1) { fprintf(stderr, "kernel_launch: occupancy query says %d blocks per CU\n", per_cu); grid = -1; (void)hipGetLastError(); return; }
        grid = cus;
    }
    if (grid < 0) return;
    (void)hipMemsetAsync((char*)d_ws + WS_CTL, 0, CTL_ZERO_BYTES, stream);
    Args a{};
    const float** pp = (const float**)&a.p;
    for (int i = 0; i < 19; ++i) pp[i] = (const float*)d_in[i];
    a.p.out = (float*)d_out; a.p.ws = (unsigned char*)d_ws;
    hipLaunchKernelGGL(hymba_fwd, dim3(grid), dim3(NWAVES * 64), LDS_BYTES, stream, a);
}
```

```cpp
#include <hip/hip_runtime.h>
#include <cstdio>
#include <cstdint>
#include <math.h>
namespace pg8 {
#define PG8_LAS __attribute__((address_space(3)))
typedef unsigned short bf16_t;
typedef short bf16x8 __attribute__((ext_vector_type(8)));
typedef float f32x4 __attribute__((ext_vector_type(4)));
typedef unsigned u32x4 __attribute__((ext_vector_type(4)));
constexpr int BM = 256, BK = 64, HALF = 128, HTB = HALF * BK * 2  , STAGE_BYTES = 8 * HTB, NXCD = 8, WGM = 8;

__host__ __device__ __forceinline__ int lds_byte(int r, int c) { const int st = (r >> 4) * 2 + (c >> 5), rr = r & 15, cc = c & 31, ob = rr * 64 + cc * 2; return st * 1024 + (ob ^ (((ob >> 9) & 1) << 5)); }
__host__ __device__ __forceinline__ void stage_rc(int b, int& R, int& C) { const int st = b / 1024, sb = b % 1024, swz = sb ^ (((sb >> 9) & 1) << 5); R = (st >> 1) * 16 + swz / 64; C = (st & 1) * 32 + (swz % 64) / 2; }
__host__ __device__ __forceinline__ int perm32(int rho) { const int n = rho >> 4, i = rho & 15; return 8 * (i >> 2) + 4 * n + (i & 3); }

struct Unit { int pm, pn; };
struct Gemm { const bf16_t* A; const bf16_t* Bt; int M, N, K, wave; };

struct StaticOrder {
    int nM, nN, nwg, G, c;
    __host__ __device__ void init(int M, int N, int G_, int c_) { nM = M / BM; nN = N / BM; nwg = nM * nN; G = G_; c = c_; }
    __host__ __device__ bool next(int i, Unit& u) const {
        const long L = (long)i * G + c; if (L >= nwg) return false;
        int wgid = (int)L; { const int q = nwg / NXCD, r = nwg % NXCD, xcd = wgid % NXCD, off = wgid / NXCD; wgid = (xcd < r ? xcd * (q + 1) : r * (q + 1) + (xcd - r) * q) + off; }
        const int nig = WGM * nN, gid = wgid / nig, fm = gid * WGM, gsz = (nM - fm) < WGM ? (nM - fm) : WGM;
        u.pm = fm + ((wgid % nig) % gsz); u.pn = (wgid % nig) / gsz; return true;
    }
    __device__ __forceinline__ void a_ready(const Unit&) const {}
    __device__ __forceinline__ void done(const Unit&) const {}
};

__device__ __forceinline__ unsigned cvt_pk_bf16(float lo, float hi) { unsigned r; asm volatile("v_cvt_pk_bf16_f32 %0, %1, %2" : "=v"(r) : "v"(lo), "v"(hi)); return r; }
typedef float f32x2 __attribute__((ext_vector_type(2)));
__device__ __forceinline__ f32x2 gelu_pk(f32x2 v) {
    const f32x2 av = __builtin_elementwise_abs(v), d = av * 0.2316418882f + 1.0f;
    f32x2 t; t.x = __builtin_amdgcn_rcpf(d.x); t.y = __builtin_amdgcn_rcpf(d.y);
    f32x2 q = t * 0.5307027145f + (-0.7265760135f); q = q * t + 0.7107068705f; q = q * t + (-0.142248368f); q = q * t + 0.127414796f; q = q * t;
    const f32x2 s = (v * v) * (-0.72134752044f);
    f32x2 e; e.x = __builtin_amdgcn_exp2f(s.x); e.y = __builtin_amdgcn_exp2f(s.y);
    const f32x2 m = v * (q * e), r = v - m;
    f32x2 o; o.x = v.x < 0.f ? m.x : r.x; o.y = v.y < 0.f ? m.y : r.y; return o;
}

template <int ACT  > struct EpiBf16 {
    static constexpr bool PERM = true, AFTER_DRAIN = false; static_assert(ACT == 0 || ACT == 1, "EpiBf16: ACT is 0 (none) or 1 (gelu_pk)");
    bf16_t* O; int ldc; const float* bias; int split_cols; size_t split_stride; float scale0;
    __device__ __forceinline__ void operator()(const f32x4 (&acc)[2][2][4][2], const Unit& u, int wr, int wc, int fr, int fq) const {
        const int row0 = u.pm * BM + wr * 64 + fr; int colt = u.pn * BM; bf16_t* base = O;
        float sc = 1.f; if (split_cols) { const int t = colt / split_cols; base += (size_t)t * split_stride; colt -= t * split_cols; if (t == 0) sc = scale0; }
        const int col0 = colt + wc * 32 + 8 * fq, bcol0 = u.pn * BM + wc * 32 + 8 * fq;
        f32x4 bv[2][2];
#pragma unroll
        for (int bj = 0; bj < 2; ++bj)
#pragma unroll
            for (int n = 0; n < 2; ++n) bv[bj][n] = bias ? *(const f32x4*)(bias + bcol0 + bj * HALF + 4 * n) : (f32x4){0.f, 0.f, 0.f, 0.f};
#pragma unroll
        for (int ai = 0; ai < 2; ++ai)
#pragma unroll
            for (int m = 0; m < 4; ++m) { bf16_t* rowp = base + (size_t)(row0 + ai * HALF + m * 16) * ldc + col0;
#pragma unroll
                for (int bj = 0; bj < 2; ++bj) { f32x4 v0 = acc[ai][bj][m][0] + bv[bj][0], v1 = acc[ai][bj][m][1] + bv[bj][1];
                    if (ACT == 1) { f32x2 a = gelu_pk((f32x2){v0[0], v0[1]}), b = gelu_pk((f32x2){v0[2], v0[3]}), c = gelu_pk((f32x2){v1[0], v1[1]}), d = gelu_pk((f32x2){v1[2], v1[3]});
                        v0 = (f32x4){a.x, a.y, b.x, b.y}; v1 = (f32x4){c.x, c.y, d.x, d.y}; }
                    v0 = v0 * sc; v1 = v1 * sc; u32x4 w; w.x = cvt_pk_bf16(v0[0], v0[1]); w.y = cvt_pk_bf16(v0[2], v0[3]); w.z = cvt_pk_bf16(v1[0], v1[1]); w.w = cvt_pk_bf16(v1[2], v1[3]);
                    *(u32x4*)(rowp + bj * HALF) = w; } }
    }
};
template <class Epi, class Sched, bool ALIGN_EPI = false, bool SP2 = false>
__device__ __forceinline__ void gemm_phase(PG8_LAS unsigned char* lds, const Gemm g, const Sched& S, const Epi& E) {
    int lane_l; asm volatile("v_mbcnt_lo_u32_b32 %0, -1, 0\n\tv_mbcnt_hi_u32_b32 %0, -1, %0" : "=v"(lane_l));
    const int wid = g.wave, lane = lane_l, tid = wid * 64 + lane,
              wr = wid >> 2, wc = wid & 3, fr = lane & 15, fq = lane >> 4;
    const int K = g.K, nt = K / BK;
    unsigned voffA[2], voffB[2];
#pragma unroll
    for (int i = 0; i < 2; ++i) { int R, C; stage_rc(tid * 16 + i * 8192, R, C); const int Rb = Epi::PERM ? ((R & ~31) + perm32(R & 31)) : R;
        voffA[i] = (unsigned)(R * K + C) * 2u; voffB[i] = (unsigned)(Rb * K + C) * 2u; }
    const size_t kstep = (size_t)(BK * 2);
    const size_t hstep = (size_t)HALF * K * 2;
    const size_t tstep = 2 * hstep;
    const unsigned ldsw = (unsigned)wid * 1024u;
    const int aoff = lds_byte(wr * 64 + fr, fq * 8), boff = lds_byte(wc * 32 + fr, fq * 8);
#define PG8_SA(b, h) (((b) * 2 + (h)) * HTB)
#define PG8_SB(b, h) ((4 + (b) * 2 + (h)) * HTB)
#define PG8_STAGE(bufoff, gbase, voff) do { _Pragma("unroll") for (int _i = 0; _i < 2; ++_i) \
        __builtin_amdgcn_global_load_lds((const unsigned*)((const char*)(gbase) + (voff)[_i]), (PG8_LAS unsigned*)(lds + (bufoff) + ldsw + _i * 8192), 16, 0, 0); } while (0)
#define PG8_LDA(dst, b, h) do { _Pragma("unroll") for (int m = 0; m < 4; ++m) _Pragma("unroll") for (int k = 0; k < 2; ++k) dst[m][k] = *(const PG8_LAS bf16x8*)(lds + PG8_SA(b, h) + aoff + m * 2048 + k * 1024); } while (0)
#define PG8_LDB(dst, b, h) do { _Pragma("unroll") for (int n = 0; n < 2; ++n) _Pragma("unroll") for (int k = 0; k < 2; ++k) dst[n][k] = *(const PG8_LAS bf16x8*)(lds + PG8_SB(b, h) + boff + n * 2048 + k * 1024); } while (0)
#define PG8_MMA(ai, bj, At, Bt) do { __builtin_amdgcn_s_setprio(1); _Pragma("unroll") for (int m = 0; m < 4; ++m) _Pragma("unroll") for (int n = 0; n < 2; ++n) _Pragma("unroll") for (int k = 0; k < 2; ++k) \
        acc[ai][bj][m][n] = __builtin_amdgcn_mfma_f32_16x16x32_bf16(Bt[n][k], At[m][k], acc[ai][bj][m][n], 0, 0, 0); __builtin_amdgcn_s_setprio(0); } while (0)
#define PG8_WAIT_V(n) asm volatile("s_waitcnt vmcnt(" #n ")" ::: "memory")
#define PG8_WAIT_L(n) asm volatile("s_waitcnt lgkmcnt(" #n ")" ::: "memory")
#define PG8_BAR __builtin_amdgcn_s_barrier()
#define PG8_SCHED __builtin_amdgcn_sched_barrier(0)
    Unit cur, nxt; int ui = 0;
    if (!S.next(0, cur)) return;
    f32x4 acc[2][2][4][2];
#pragma unroll
    for (int a = 0; a < 2; ++a)
#pragma unroll
        for (int b = 0; b < 2; ++b)
#pragma unroll
            for (int m = 0; m < 4; ++m)
#pragma unroll
                for (int n = 0; n < 2; ++n) acc[a][b][m][n] = (f32x4){0.f, 0.f, 0.f, 0.f};
    bf16x8 At[4][2], B0[2][2], B1[2][2];
    const char* cA = (const char*)g.A + (size_t)cur.pm * tstep; const char* cB = (const char*)g.Bt + (size_t)cur.pn * tstep;
    S.a_ready(cur);
    if constexpr (SP2) {
        PG8_STAGE(PG8_SB(0, 0), cB, voffB); PG8_STAGE(PG8_SB(0, 1), cB + hstep, voffB); PG8_STAGE(PG8_SA(0, 0), cA, voffA); PG8_STAGE(PG8_SA(0, 1), cA + hstep, voffA);
        if (wr == 1) PG8_BAR;
        PG8_WAIT_V(2); PG8_BAR;
        PG8_STAGE(PG8_SB(1, 0), cB + kstep, voffB); PG8_STAGE(PG8_SA(1, 0), cA + kstep, voffA); PG8_STAGE(PG8_SB(1, 1), cB + hstep + kstep, voffB);
        PG8_WAIT_V(6); PG8_BAR;
    } else {
        PG8_STAGE(PG8_SB(0, 0), cB, voffB); PG8_STAGE(PG8_SA(0, 0), cA, voffA); PG8_STAGE(PG8_SB(0, 1), cB + hstep, voffB); PG8_STAGE(PG8_SA(0, 1), cA + hstep, voffA);
        if (wr == 1) PG8_BAR;
        PG8_WAIT_V(4); PG8_BAR;
        PG8_STAGE(PG8_SB(1, 0), cB + kstep, voffB); PG8_STAGE(PG8_SA(1, 0), cA + kstep, voffA); PG8_STAGE(PG8_SB(1, 1), cB + hstep + kstep, voffB);
        PG8_WAIT_V(6); PG8_BAR;
    }
    for (;;) {
        const bool has_next = S.next(ui + 1, nxt);
        const char* nA = has_next ? (const char*)g.A + (size_t)nxt.pm * tstep : cA; const char* nB = has_next ? (const char*)g.Bt + (size_t)nxt.pn * tstep : cB;
        for (int t = 0; t < nt; t += 2) {
            const bool last = (t == nt - 2);
            const char* a1 = cA + (size_t)(t + 1) * kstep;
            const char* a2 = last ? nA : cA + (size_t)(t + 2) * kstep; const char* b2 = last ? nB : cB + (size_t)(t + 2) * kstep;
            const char* a3 = a2 + kstep; const char* b3 = b2 + kstep;
            if (last && has_next) S.a_ready(nxt);
            if constexpr (SP2) {
            PG8_LDB(B0, 0, 0); PG8_LDB(B1, 0, 1); PG8_SCHED; PG8_LDA(At, 0, 0); PG8_STAGE(PG8_SA(1, 1), a1 + hstep, voffA);
            PG8_WAIT_V(8); PG8_WAIT_L(0); PG8_BAR; PG8_MMA(0, 0, At, B0); PG8_MMA(0, 1, At, B1); PG8_BAR; PG8_SCHED;
            PG8_LDA(At, 0, 1); PG8_STAGE(PG8_SB(0, 0), b2, voffB); PG8_STAGE(PG8_SB(0, 1), b2 + hstep, voffB); PG8_STAGE(PG8_SA(0, 0), a2, voffA);
            PG8_WAIT_V(8); PG8_WAIT_L(0); PG8_BAR; PG8_MMA(1, 0, At, B0); PG8_MMA(1, 1, At, B1); PG8_BAR; PG8_SCHED;
            PG8_LDB(B0, 1, 0); PG8_LDB(B1, 1, 1); PG8_SCHED; PG8_LDA(At, 1, 0); PG8_STAGE(PG8_SA(0, 1), a2 + hstep, voffA);
            PG8_WAIT_V(8); PG8_WAIT_L(0); PG8_BAR; PG8_MMA(0, 0, At, B0); PG8_MMA(0, 1, At, B1); PG8_BAR; PG8_SCHED;
            PG8_LDA(At, 1, 1); PG8_STAGE(PG8_SB(1, 0), b3, voffB); PG8_STAGE(PG8_SB(1, 1), b3 + hstep, voffB); PG8_STAGE(PG8_SA(1, 0), a3, voffA);
            PG8_WAIT_V(8); PG8_WAIT_L(0); PG8_BAR; PG8_MMA(1, 0, At, B0); PG8_MMA(1, 1, At, B1); PG8_BAR; PG8_SCHED;
            } else {
            PG8_LDB(B0, 0, 0); PG8_SCHED; PG8_LDA(At, 0, 0); PG8_STAGE(PG8_SA(1, 1), a1 + hstep, voffA);
            PG8_WAIT_L(8); PG8_BAR; PG8_WAIT_L(0); PG8_MMA(0, 0, At, B0); PG8_BAR; PG8_SCHED;
            PG8_LDB(B1, 0, 1); PG8_STAGE(PG8_SB(0, 0), b2, voffB);
            PG8_BAR; PG8_WAIT_L(0); PG8_MMA(0, 1, At, B1); PG8_BAR;
            PG8_LDA(At, 0, 1); PG8_STAGE(PG8_SA(0, 0), a2, voffA);
            PG8_BAR; PG8_WAIT_L(0); PG8_MMA(1, 0, At, B0); PG8_BAR; PG8_SCHED;
            PG8_STAGE(PG8_SB(0, 1), b2 + hstep, voffB);
            PG8_WAIT_V(6); PG8_BAR; PG8_MMA(1, 1, At, B1); PG8_BAR;
            PG8_LDB(B0, 1, 0); PG8_SCHED; PG8_LDA(At, 1, 0); PG8_STAGE(PG8_SA(0, 1), a2 + hstep, voffA);
            PG8_WAIT_L(8); PG8_BAR; PG8_WAIT_L(0); PG8_MMA(0, 0, At, B0); PG8_BAR; PG8_SCHED;
            PG8_LDB(B1, 1, 1); PG8_STAGE(PG8_SB(1, 0), b3, voffB);
            PG8_BAR; PG8_WAIT_L(0); PG8_MMA(0, 1, At, B1); PG8_BAR;
            PG8_LDA(At, 1, 1); PG8_STAGE(PG8_SA(1, 0), a3, voffA);
            PG8_BAR; PG8_WAIT_L(0); PG8_MMA(1, 0, At, B0); PG8_BAR; PG8_SCHED;
            PG8_STAGE(PG8_SB(1, 1), b3 + hstep, voffB);
            PG8_WAIT_V(6); PG8_BAR; PG8_MMA(1, 1, At, B1); PG8_BAR;
            }
        }
        if constexpr (ALIGN_EPI) { if (wr == 0) PG8_BAR; }
        if constexpr (!Epi::AFTER_DRAIN) { E(acc, cur, wr, wc, fr, fq); S.done(cur); }
        if (!has_next) break;
#pragma unroll
        for (int a = 0; a < 2; ++a)
#pragma unroll
            for (int b = 0; b < 2; ++b)
#pragma unroll
                for (int m = 0; m < 4; ++m)
#pragma unroll
                    for (int n = 0; n < 2; ++n) acc[a][b][m][n] = (f32x4){0.f, 0.f, 0.f, 0.f};
        cur = nxt; cA = nA; cB = nB; ++ui;
        if constexpr (ALIGN_EPI) { if (wr == 1) PG8_BAR; }
    }
    PG8_WAIT_V(0);
    if constexpr (!ALIGN_EPI) { if (wr == 0) PG8_BAR; }
    PG8_BAR;
    if constexpr (Epi::AFTER_DRAIN) { E.fused(acc, cur, wr, wc, fr, fq, lds, wid, lane); S.done(cur); }
#undef PG8_SA
#undef PG8_SB
#undef PG8_STAGE
#undef PG8_LDA
#undef PG8_LDB
#undef PG8_MMA
#undef PG8_WAIT_V
#undef PG8_WAIT_L
#undef PG8_BAR
#undef PG8_SCHED
}
}

#ifndef PG8_SP2
#define PG8_SP2 true
#endif
#ifndef PG8_ALIGN
#define PG8_ALIGN true
#endif
#define GAS __attribute__((address_space(1)))
#define LAS __attribute__((address_space(3)))
typedef unsigned short bf16;
typedef unsigned v4u __attribute__((ext_vector_type(4)));
typedef float f32x4 __attribute__((ext_vector_type(4)));
typedef short bf16x8 __attribute__((ext_vector_type(8)));
typedef GAS unsigned gu32;
typedef GAS unsigned long long gu64;
#define RLX_AGENT __ATOMIC_RELAXED, __HIP_MEMORY_SCOPE_AGENT
#define LDS_WAIT() asm volatile("s_waitcnt lgkmcnt(0)" ::: "memory")
#define VM_WAIT() asm volatile("s_waitcnt vmcnt(0)" ::: "memory")
__device__ __forceinline__ unsigned long long rt() { return __builtin_amdgcn_s_memrealtime(); }
__device__ __forceinline__ unsigned f2bf(float f) { unsigned u = __builtin_bit_cast(unsigned, f); return (u + 0x7fffu + ((u >> 16) & 1u)) >> 16; }
__device__ __forceinline__ unsigned pk2(float lo, float hi) { return f2bf(lo) | (f2bf(hi) << 16); }

#define XB_TMO      128
#define XB_XCNT(j)  (256  + 64 * (j))
#define XB_XSUB(j)  (1280 + 64 * (j))
#define XB_XGEN(j)  (2304 + 64 * (j))
#define XB_TOP      3328
#define XB_TOPGEN   3392
#define XCD_BAR_WORDS 3456
#define XB_SPIN_CAP (1u << 22)

__device__ __forceinline__ unsigned xb_ld(unsigned* p)              { return __hip_atomic_load(p, __ATOMIC_RELAXED, __HIP_MEMORY_SCOPE_AGENT); }
__device__ __forceinline__ unsigned xb_add(unsigned* p, unsigned v) { return __hip_atomic_fetch_add(p, v, __ATOMIC_RELAXED, __HIP_MEMORY_SCOPE_AGENT); }
__device__ __forceinline__ unsigned xb_xcc_id() { return (unsigned)__builtin_amdgcn_s_getreg((3 << 11) | 20) & 0xFu; }
#define XB_SPIN(cond, bar) do { unsigned _sp = 0; while (cond) { __builtin_amdgcn_s_sleep(1); \
    if ((++_sp & 255u) == 0u) { if (xb_ld(&(bar)[XB_TMO])) break; if (_sp > XB_SPIN_CAP) { atomicAdd(&(bar)[XB_TMO], 1u); break; } } } } while (0)

struct XcdBarrier {
    unsigned* bar; unsigned x;
    volatile LAS unsigned* st;
};

__device__ __forceinline__ XcdBarrier xcd_barrier_post(unsigned* bar, volatile LAS unsigned* st) {
    XcdBarrier b; b.bar = bar; b.x = xb_xcc_id(); b.st = st;
    if (threadIdx.x == 0) (void)xb_add(&bar[XB_XCNT(b.x)], 1u);
    return b;
}
__device__ __forceinline__ void xcd_barrier_complete(unsigned* bar, unsigned x, unsigned& nloc, unsigned& nx) {
    const unsigned G = gridDim.x * gridDim.y * gridDim.z;
    unsigned sum, cnt, mine, sp = 0u;
    for (;;) {
        sum = 0u; cnt = 0u; mine = 0u;
#pragma unroll
        for (unsigned j = 0; j < 16; ++j) { const unsigned c = xb_ld(&bar[XB_XCNT(j)]); sum += c; cnt += (c > 0u) ? 1u : 0u; mine = (j == x) ? c : mine; }
        if (sum == G) break;
        __builtin_amdgcn_s_sleep(1);
        if ((++sp & 255u) == 0u) { if (xb_ld(&bar[XB_TMO])) break; if (sp > XB_SPIN_CAP) { atomicAdd(&bar[XB_TMO], 1u); break; } }
    }
    nloc = mine > 0u ? mine : 1u; nx = cnt > 0u ? cnt : 1u;
}

__device__ __forceinline__ void xcd_barrier(const XcdBarrier& b) {
    asm volatile("s_waitcnt vmcnt(0)" ::: "memory");
    __syncthreads();
    if (threadIdx.x == 0) {
        unsigned* bar = b.bar;
        __builtin_amdgcn_s_waitcnt(0);
        unsigned nloc = b.st[0], nx = b.st[1];
        if (nloc == 0u) { xcd_barrier_complete(bar, b.x, nloc, nx); b.st[0] = nloc; b.st[1] = nx; }
        const unsigned old = xb_add(&bar[XB_XSUB(b.x)], 1u);
        const unsigned gen = old / nloc;
        if (old + 1u == (gen + 1u) * nloc) {
            __builtin_amdgcn_fence(__ATOMIC_RELEASE, "agent");
            asm volatile("s_waitcnt vmcnt(0)" ::: "memory");
            const unsigned og = xb_add(&bar[XB_TOP], 1u);
            const unsigned tg = og / nx;
            if (og + 1u == (tg + 1u) * nx) xb_add(&bar[XB_TOPGEN], 1u);
            else XB_SPIN(xb_ld(&bar[XB_TOPGEN]) == tg, bar);
            __builtin_amdgcn_fence(__ATOMIC_ACQUIRE, "agent");
            xb_add(&bar[XB_XGEN(b.x)], 1u);
            asm volatile("s_waitcnt vmcnt(0)" ::: "memory");
        } else {
            XB_SPIN(xb_ld(&bar[XB_XGEN(b.x)]) == gen, bar);
            __builtin_amdgcn_fence(__ATOMIC_ACQUIRE, "agent");
            asm volatile("s_waitcnt vmcnt(0)" ::: "memory");
        }
    }
    __syncthreads();
}

constexpr int NWAVES = 8;
constexpr int T_ = 16384, SEQ = 4096, DM = 1024, NPROJ = 2304, INC = 2312;
constexpr int PJ_K = 512, PJ_V = 640, PJ_Z = 768, PJ_XBC = 1280;
constexpr float EPS = 1e-6f;
constexpr size_t MiB = 1u << 20;
constexpr size_t WS_CTL = 0, CTL_ZERO_BYTES = 1 * MiB;
constexpr size_t WS_SMALL = 1 * MiB;
constexpr size_t WS_WIN = 2 * MiB, WS_WOUT = 7 * MiB, WS_WQ = 9 * MiB;
constexpr size_t WS_ED = 13 * MiB, WS_EU = 45 * MiB;
constexpr size_t WS_XN = 77 * MiB;
constexpr size_t WS_PROJ = 109 * MiB;
constexpr size_t WS_ST = 181 * MiB;
constexpr size_t WS_IDX = 213 * MiB, WS_GATE = 221 * MiB, WS_SSQ = 229 * MiB, WS_END = 230 * MiB;
constexpr size_t DO_Y = 0, DO_DT = 41 * MiB;
constexpr size_t WS_CC = 230 * MiB, WS_DT = 238 * MiB, WS_EA = 239 * MiB, WS_CDEC = 240 * MiB, WS_PREV = WS_IDX;
constexpr size_t DO_YPF = 0, DO_YPLAIN = 32 * MiB;
constexpr int CW_BAR = 4096;
constexpr int RING_OFF = 0, RING_BYTES = 131072, LDSCTL_OFF = RING_BYTES, MISC_OFF = LDSCTL_OFF + 320, LDS_BYTES = 147456;

__constant__ unsigned char c_bucket[128] = {0, 1, 2, 3, 4, 5, 6, 7, 8, 9, 10, 11, 12, 13, 14, 15, 16, 16, 16, 17, 17, 18, 18, 18, 19, 19, 19, 20, 20, 20, 20, 21, 21, 21, 21, 22, 22, 22, 22, 22, 23, 23, 23, 23, 23, 23, 24, 24, 24, 24, 24, 24, 25, 25, 25, 25, 25, 25, 25, 26, 26, 26, 26, 26, 26, 26, 26, 27, 27, 27, 27, 27, 27, 27, 27, 27, 27, 28, 28, 28, 28, 28, 28, 28, 28, 28, 28, 29, 29, 29, 29, 29, 29, 29, 29, 29, 29, 29, 29, 30, 30, 30, 30, 30, 30, 30, 30, 30, 30, 30, 30, 30, 30, 31, 31, 31, 31, 31, 31, 31, 31, 31, 31, 31, 31, 31, 31, 31};

struct Frame {
    LAS unsigned char* lds;
    volatile LAS unsigned* MISC;
    gu32* ctl;
    int wave, vcu, G;
};
__device__ __forceinline__ int lane_id() { int l; asm volatile("v_mbcnt_lo_u32_b32 %0, -1, 0\n\tv_mbcnt_hi_u32_b32 %0, -1, %0" : "=v"(l)); return l; }
__device__ __forceinline__ int opq(int x) { asm volatile("" : "+v"(x)); return x; }
template <int M> __device__ __forceinline__ float swz_xor(float v) { return __int_as_float(__builtin_amdgcn_ds_swizzle(__float_as_int(v), (M << 10) | 0x1F)); }
__device__ __forceinline__ float sum_halves(float v) { const auto r = __builtin_amdgcn_permlane32_swap(__float_as_uint(v), __float_as_uint(v), false, false); return __uint_as_float(r[0]) + __uint_as_float(r[1]); }
__device__ __forceinline__ float max_halves(float v) { const auto r = __builtin_amdgcn_permlane32_swap(__float_as_uint(v), __float_as_uint(v), false, false); return fmaxf(__uint_as_float(r[0]), __uint_as_float(r[1])); }
__device__ __forceinline__ int imax_halves(int v) { const auto r = __builtin_amdgcn_permlane32_swap((unsigned)v, (unsigned)v, false, false); return max((int)r[0], (int)r[1]); }
__device__ __forceinline__ float wave_sum(float v) {
    v += swz_xor<1>(v); v += swz_xor<2>(v); v += swz_xor<4>(v); v += swz_xor<8>(v); v += swz_xor<16>(v);
    return sum_halves(v);
}
__device__ __forceinline__ float bf2f(unsigned short b) { return __uint_as_float((unsigned)b << 16); }
__device__ __forceinline__ float bflo(unsigned w) { return __uint_as_float(w << 16); }
__device__ __forceinline__ float bfhi(unsigned w) { return __uint_as_float(w & 0xffff0000u); }
__device__ __forceinline__ float silu_f(float x) { return x / (1.f + __expf(-x)); }

__device__ __forceinline__ void p0_transpose_item(const float* W, int ldw, int K, int nblk, bf16* WT, const float* kscale, LAS float* scr, int item, int lane) {
    const int kb = item / nblk, nb = item % nblk, k0 = 64 * kb, n0 = 32 * nb;
#pragma unroll 8
    for (int i = 0; i < 32; ++i) { const int kk = 2 * i + (lane >> 5); float v = W[(size_t)(k0 + kk) * ldw + n0 + (lane & 31)]; if (kscale) v *= kscale[k0 + kk]; scr[kk * 33 + (lane & 31)] = v; }
    LDS_WAIT(); asm volatile("" ::: "memory");
    const int c = lane & 7;
#pragma unroll
    for (int j = 0; j < 4; ++j) { const int n = (lane >> 3) + 8 * j; const LAS float* s = scr + (8 * c) * 33 + n;
        v4u o; o.x = pk2(s[0 * 33], s[1 * 33]); o.y = pk2(s[2 * 33], s[3 * 33]); o.z = pk2(s[4 * 33], s[5 * 33]); o.w = pk2(s[6 * 33], s[7 * 33]);
        *(GAS v4u*)(WT + (size_t)(n0 + n) * K + k0 + 8 * c) = o; }
    LDS_WAIT(); asm volatile("" ::: "memory");
}
struct Ptrs {
    const float *x, *norm_mix, *w_in, *conv_w, *conv_b, *dt_bias, *a_log, *d_skip, *ssd_norm_w, *sinks, *w_out, *rel_bias, *norm_ffn, *w_query, *sk1, *sk2, *e_down, *e_up, *norm_final;
    float* out; unsigned char* ws;
};
__device__ __forceinline__ void p0_prologue(Frame& F0, const Ptrs& P) {
    const Frame& F = F0; const int lane_ = lane_id(), tid_ = F.wave * 64 + lane_;
    LAS float* scr = (LAS float*)(F.lds + RING_OFF + F.wave * 16384);
    const int gw = F.vcu * NWAVES + F.wave, NGW = F.G * NWAVES;
    bf16* Win_t = (bf16*)(P.ws + WS_WIN); bf16* Wout_t = (bf16*)(P.ws + WS_WOUT); bf16* Wq_t = (bf16*)(P.ws + WS_WQ);
    constexpr int I_IN = 16 * 72, I_OUT = 16 * 32, I_Q = 16 * 64, NITEMS = I_IN + I_OUT + I_Q;
    for (int it = gw; it < NITEMS; it += NGW) {
        int r = it;
        if (r < I_IN) { p0_transpose_item(P.w_in, INC, DM, 72, Win_t, nullptr, scr, r, lane_); continue; } r -= I_IN;
        if (r < I_OUT) { p0_transpose_item(P.w_out, DM, DM, 32, Wout_t, nullptr, scr, r, lane_); continue; } r -= I_OUT;
        p0_transpose_item(P.w_query, 2048, DM, 64, Wq_t, P.norm_ffn, scr, r, lane_);
    }
    { float* K1T = (float*)(P.ws + WS_SMALL); float* K2T = K1T + 16384;
      for (int i = F.vcu * 512 + tid_; i < 16384; i += F.G * 512) { const int n = i >> 7, k = i & 127; K1T[k * 128 + n] = P.sk1[i]; K2T[k * 128 + n] = P.sk2[i]; } }
    { const float4* nf4 = (const float4*)P.norm_ffn;
      for (int i = F.vcu * 512 + tid_; i < 2097152; i += F.G * 512) {
        const int c = i & 127;
        const float4 a = ((const float4*)P.e_down)[2 * (size_t)i], b = ((const float4*)P.e_down)[2 * (size_t)i + 1], wa = nf4[2 * c], wb = nf4[2 * c + 1];
        v4u o; o.x = pk2(a.x * wa.x, a.y * wa.y); o.y = pk2(a.z * wa.z, a.w * wa.w); o.z = pk2(b.x * wb.x, b.y * wb.y); o.w = pk2(b.z * wb.z, b.w * wb.w);
        ((v4u*)(P.ws + WS_ED))[i] = o;
        const float4 u0 = ((const float4*)P.e_up)[2 * (size_t)i], u1 = ((const float4*)P.e_up)[2 * (size_t)i + 1];
        v4u q; q.x = pk2(u0.x, u0.y); q.y = pk2(u0.z, u0.w); q.z = pk2(u1.x, u1.y); q.w = pk2(u1.z, u1.w);
        ((v4u*)(P.ws + WS_EU))[i] = q; } }
    __syncthreads();
    { LAS float* Wdt = (LAS float*)(F.lds + RING_OFF);
      for (int i = tid_; i < 8192; i += 512) Wdt[i] = P.w_in[(size_t)(i >> 3) * INC + NPROJ + (i & 7)];
      __syncthreads();
      bf16* XN = (bf16*)(P.ws + WS_XN); float* DT = (float*)(P.ws + WS_DT);
      for (int m = gw; m < T_; m += NGW) {
        const float4* xr = (const float4*)(P.x + (size_t)m * DM);
        float4 v[4]; float s = 0.f;
#pragma unroll
        for (int j = 0; j < 4; ++j) { v[j] = xr[j * 64 + lane_]; s += v[j].x * v[j].x + v[j].y * v[j].y + v[j].z * v[j].z + v[j].w * v[j].w; }
        const float r = rsqrtf(wave_sum(s) * (1.f / 1024.f) + EPS);
        float d8[8];
#pragma unroll
        for (int q = 0; q < 8; ++q) d8[q] = 0.f;
        unsigned long long* o8 = (unsigned long long*)(XN + (size_t)m * DM);
#pragma unroll
        for (int j = 0; j < 4; ++j) { const float4 w = ((const float4*)P.norm_mix)[j * 64 + lane_];
            const float e0 = v[j].x * r * w.x, e1 = v[j].y * r * w.y, e2 = v[j].z * r * w.z, e3 = v[j].w * r * w.w;
            o8[j * 64 + lane_] = (unsigned long long)pk2(e0, e1) | ((unsigned long long)pk2(e2, e3) << 32);
            const float ev[4] = {e0, e1, e2, e3};
#pragma unroll
            for (int e = 0; e < 4; ++e) { const LAS f32x4* wr = (const LAS f32x4*)(Wdt + (size_t)(j * 256 + lane_ * 4 + e) * 8); const f32x4 w0 = wr[0], w1 = wr[1];
                d8[0] += ev[e] * w0.x; d8[1] += ev[e] * w0.y; d8[2] += ev[e] * w0.z; d8[3] += ev[e] * w0.w; d8[4] += ev[e] * w1.x; d8[5] += ev[e] * w1.y; d8[6] += ev[e] * w1.z; d8[7] += ev[e] * w1.w; } }
#pragma unroll
        for (int q = 0; q < 8; ++q) d8[q] = wave_sum(d8[q]);
        if (lane_ == 0) { float4* dp = (float4*)(DT + (size_t)m * 8); dp[0] = make_float4(d8[0], d8[1], d8[2], d8[3]); dp[1] = make_float4(d8[4], d8[5], d8[6], d8[7]); }
      }
      __syncthreads(); }
}

struct EpiResH {
    static constexpr bool PERM = false, AFTER_DRAIN = false;
    const float* X; bf16* HB; float* SSQ;
    __device__ __forceinline__ void operator()(const pg8::f32x4 (&acc)[2][2][4][2], const pg8::Unit& u, int wr, int wc, int fr, int fq) const {
        const int row0 = u.pm * 256 + wr * 64 + fr, col0 = u.pn * 256 + wc * 32 + 4 * fq;
#pragma unroll
        for (int ai = 0; ai < 2; ++ai)
#pragma unroll
            for (int m = 0; m < 4; ++m) { const int row = row0 + ai * 128 + m * 16; float ss = 0.f;
#pragma unroll
                for (int bj = 0; bj < 2; ++bj)
#pragma unroll
                    for (int n = 0; n < 2; ++n) { const size_t off = (size_t)row * DM + col0 + bj * 128 + n * 16;
                        const pg8::f32x4 h = acc[ai][bj][m][n] + *(const pg8::f32x4*)(X + off);
                        ss += h[0] * h[0] + h[1] * h[1] + h[2] * h[2] + h[3] * h[3];
                        *(unsigned long long*)(HB + off) = (unsigned long long)pk2(h[0], h[1]) | ((unsigned long long)pk2(h[2], h[3]) << 32); }
                ss += swz_xor<16>(ss); ss = sum_halves(ss);
                if (fq == 0) SSQ[(size_t)row * 16 + u.pn * 4 + wc] = ss; }
    }
};

__device__ __forceinline__ void gate_norm_naive(Frame& F, const Ptrs& P) {
    const bf16* PROJ = (const bf16*)(P.ws + WS_PROJ); bf16* CAT = (bf16*)(P.ws + WS_XN); const float* Y = (const float*)((const char*)P.out + DO_YPLAIN);
    const int lane_ = lane_id();
    for (int row = F.vcu * NWAVES + F.wave; row < T_; row += F.G * NWAVES) {
        float v[8]; float s = 0.f;
#pragma unroll
        for (int j = 0; j < 8; ++j) { const int c = j * 64 + lane_; const float z = bf2f(PROJ[(size_t)row * NPROJ + PJ_Z + c]); v[j] = Y[(size_t)row * 512 + c] * silu_f(z); s += v[j] * v[j]; }
        const float r = rsqrtf(wave_sum(s) * (1.f / 512.f) + EPS);
#pragma unroll
        for (int j = 0; j < 8; ++j) { const int c = j * 64 + lane_; CAT[(size_t)row * DM + 512 + c] = (bf16)f2bf(v[j] * r * P.ssd_norm_w[c]); }
    }
}
typedef float f32x16 __attribute__((ext_vector_type(16)));
typedef short s16x4 __attribute__((ext_vector_type(4)));
typedef float f32x2_t __attribute__((ext_vector_type(2)));
typedef __bf16 bf16x2_t __attribute__((ext_vector_type(2)));
#define MFMA32(a, b, c) __builtin_amdgcn_mfma_f32_32x32x16_bf16((a), (b), (c), 0, 0, 0)
__device__ __forceinline__ int crow(int reg, int h) { return (reg & 3) + 8 * (reg >> 2) + 4 * h; }
__device__ __forceinline__ unsigned cvtpk(float lo, float hi) { f32x2_t v = {lo, hi}; bf16x2_t b = __builtin_convertvector(v, bf16x2_t); return __builtin_bit_cast(unsigned, b); }
__device__ __forceinline__ bf16x8 pack8(const f32x16& x, int s) {
    v4u p; p.x = cvtpk(x[8 * s], x[8 * s + 1]); p.y = cvtpk(x[8 * s + 2], x[8 * s + 3]); p.z = cvtpk(x[8 * s + 4], x[8 * s + 5]); p.w = cvtpk(x[8 * s + 6], x[8 * s + 7]);
    return __builtin_bit_cast(bf16x8, p);
}
constexpr float LOG2E = 1.4426950408889634f;
constexpr int LDP = 136;
constexpr int S1_XT = 0, S1_BSN = 17408, S1_CLN = 52224, S1_BNL = 87040, S1_F32 = 121856;

__device__ __forceinline__ void ssd_s1(Frame& F, const Ptrs& P) {
    const bf16* PROJ = (const bf16*)(P.ws + WS_PROJ); const float* DT = (const float*)(P.ws + WS_DT);
    float* EA = (float*)(P.ws + WS_EA); float* CDEC = (float*)(P.ws + WS_CDEC); bf16* CC = (bf16*)(P.ws + WS_CC);
    float* ST = (float*)(P.ws + WS_ST); float* YPF = (float*)((char*)P.out + DO_YPF);
    LAS unsigned char* L = F.lds + RING_OFF;
    LAS bf16* Xt = (LAS bf16*)(L + S1_XT); LAS bf16* Bsn = (LAS bf16*)(L + S1_BSN); LAS bf16* Cln = (LAS bf16*)(L + S1_CLN); LAS bf16* Bnl = (LAS bf16*)(L + S1_BNL);
    LAS float* acum2 = (LAS float*)(L + S1_F32); LAS float* wv = acum2 + 128; LAS float* wend = wv + 128;
    const int lane = lane_id(), r = lane & 31, hh = lane >> 5; const int tid_ = F.wave * 64 + lane;
    for (int u = F.vcu; u < 1024; u += F.G) {
        const int h = u & 7, c = (u >> 3) & 31, b = u >> 8, grp = h >> 2, t0 = b * SEQ + c * 128;
        const float A = -__expf(P.a_log[h]), Dh = P.d_skip[h], dtb = P.dt_bias[h];
        if (F.wave == 0) {
            const float x0 = DT[(size_t)(t0 + 2 * lane) * 8 + h] + dtb, x1 = DT[(size_t)(t0 + 2 * lane + 1) * 8 + h] + dtb;
            const float dt0 = fmaxf(x0, 0.f) + log1pf(__expf(-fabsf(x0))), dt1 = fmaxf(x1, 0.f) + log1pf(__expf(-fabsf(x1)));
            const float a0 = dt0 * A, a1 = dt1 * A;
            float s = a0 + a1;
#pragma unroll
            for (int o = 1; o < 64; o <<= 1) { const float v = __int_as_float(__builtin_amdgcn_ds_bpermute((lane - o) * 4, __float_as_int(s))); if (lane >= o) s += v; }
            const float ac1 = s, ac0 = s - a1, tot = __uint_as_float(__builtin_amdgcn_readlane(__float_as_uint(s), 63));
            acum2[2 * lane] = ac0 * LOG2E; acum2[2 * lane + 1] = ac1 * LOG2E;
            wv[2 * lane] = log2f(dt0) - ac0 * LOG2E; wv[2 * lane + 1] = log2f(dt1) - ac1 * LOG2E;
            wend[2 * lane] = dt0 * exp2f((tot - ac0) * LOG2E); wend[2 * lane + 1] = dt1 * exp2f((tot - ac1) * LOG2E);
            EA[(size_t)(t0 + 2 * lane) * 8 + h] = exp2f(ac0 * LOG2E); EA[(size_t)(t0 + 2 * lane + 1) * 8 + h] = exp2f(ac1 * LOG2E);
            if (lane == 0) CDEC[u] = exp2f(tot * LOG2E);
        }
        __syncthreads();
        if (tid_ < 480) {
            const int cg = tid_ % 40, ph = tid_ / 40;
            int chb; if (cg < 8) chb = h * 64 + cg * 8; else if (cg < 24) chb = 512 + grp * 128 + (cg - 8) * 8; else chb = 768 + grp * 128 + (cg - 24) * 8;
            float w[4][8], bias[8];
#pragma unroll
            for (int j = 0; j < 4; ++j) { const float4 w0 = *(const float4*)(P.conv_w + j * 1024 + chb), w1 = *(const float4*)(P.conv_w + j * 1024 + chb + 4);
                w[j][0] = w0.x; w[j][1] = w0.y; w[j][2] = w0.z; w[j][3] = w0.w; w[j][4] = w1.x; w[j][5] = w1.y; w[j][6] = w1.z; w[j][7] = w1.w; }
            { const float4 b0 = *(const float4*)(P.conv_b + chb), b1 = *(const float4*)(P.conv_b + chb + 4);
              bias[0] = b0.x; bias[1] = b0.y; bias[2] = b0.z; bias[3] = b0.w; bias[4] = b1.x; bias[5] = b1.y; bias[6] = b1.z; bias[7] = b1.w; }
            for (int it = 0; it < 11; ++it) {
                const int l = ph + 12 * it;
                if (l < 128) {
                    float a[8];
#pragma unroll
                    for (int e = 0; e < 8; ++e) a[e] = bias[e];
#pragma unroll
                    for (int j = 0; j < 4; ++j) { const int ss = c * 128 + l - 3 + j;
                        if (ss >= 0) { const v4u raw = *(const v4u*)(PROJ + (size_t)(b * SEQ + ss) * NPROJ + PJ_XBC + chb);
                            a[0] += w[j][0] * bflo(raw.x); a[1] += w[j][1] * bfhi(raw.x); a[2] += w[j][2] * bflo(raw.y); a[3] += w[j][3] * bfhi(raw.y);
                            a[4] += w[j][4] * bflo(raw.z); a[5] += w[j][5] * bfhi(raw.z); a[6] += w[j][6] * bflo(raw.w); a[7] += w[j][7] * bfhi(raw.w); } }
#pragma unroll
                    for (int e = 0; e < 8; ++e) a[e] = silu_f(a[e]);
                    if (cg < 8) {
#pragma unroll
                        for (int e = 0; e < 8; ++e) Xt[(cg * 8 + e) * LDP + l] = (bf16)f2bf(a[e]);
                    } else {
                        v4u o; o.x = pk2(a[0], a[1]); o.y = pk2(a[2], a[3]); o.z = pk2(a[4], a[5]); o.w = pk2(a[6], a[7]);
                        if (cg < 24) { const int n0 = (cg - 8) * 8; *(LAS v4u*)(Bsn + l * LDP + n0) = o; const float we = wend[l];
#pragma unroll
                            for (int e = 0; e < 8; ++e) Bnl[(n0 + e) * LDP + l] = (bf16)f2bf(a[e] * we);
                        } else { const int n0 = (cg - 24) * 8; *(LAS v4u*)(Cln + l * LDP + n0) = o;
                            if ((h & 3) == 0) *(v4u*)(CC + (size_t)(t0 + l) * 256 + grp * 128 + n0) = o; }
                    }
                }
            }
        }
        __syncthreads();
        if (F.wave < 4) {
            const int pt = F.wave >> 1;
#pragma unroll 1
            for (int q = 0; q < 2; ++q) {
                const int lt = (F.wave & 1) ? (1 + q) : (3 * q);
                f32x16 yacc;
#pragma unroll
                for (int i = 0; i < 16; ++i) yacc[i] = 0.f;
                const float al = acum2[32 * lt + r];
                for (int st = 0; st <= lt; ++st) {
                    f32x16 macc;
#pragma unroll
                    for (int i = 0; i < 16; ++i) macc[i] = 0.f;
#pragma unroll
                    for (int kk = 0; kk < 8; ++kk) {
                        const bf16x8 a = *(const LAS bf16x8*)(Bsn + (32 * st + r) * LDP + 16 * kk + 8 * hh);
                        const bf16x8 bb = *(const LAS bf16x8*)(Cln + (32 * lt + r) * LDP + 16 * kk + 8 * hh);
                        macc = MFMA32(a, bb, macc);
                    }
#pragma unroll
                    for (int i = 0; i < 16; ++i) { const int sl = crow(i, hh);
                        float f = exp2f(al + wv[32 * st + sl]);
                        if (st == lt && sl > r) f = 0.f;
                        macc[i] *= f; }
#pragma unroll
                    for (int sg = 0; sg < 2; ++sg) {
                        const bf16x8 bfrag = pack8(macc, sg);
                        const LAS bf16* xb = Xt + (32 * pt + r) * LDP + 32 * st + 16 * sg + 4 * hh;
                        const s16x4 lo = *(const LAS s16x4*)(xb), hi = *(const LAS s16x4*)(xb + 8);
                        const bf16x8 afrag = __builtin_shufflevector(lo, hi, 0, 1, 2, 3, 4, 5, 6, 7);
                        yacc = MFMA32(afrag, bfrag, yacc);
                    }
                }
#pragma unroll
                for (int i = 0; i < 16; ++i) { const int p = 32 * pt + crow(i, hh);
                    const float y = yacc[i] + Dh * bf2f(Xt[p * LDP + 32 * lt + r]);
                    YPF[((((size_t)u * 4 + lt) * 2 + pt) * 16 + i) * 64 + lane] = y; }
            }
        } else {
            const int nt = F.wave - 4;
#pragma unroll 1
            for (int pt = 0; pt < 2; ++pt) {
                f32x16 sacc;
#pragma unroll
                for (int i = 0; i < 16; ++i) sacc[i] = 0.f;
#pragma unroll
                for (int kk = 0; kk < 8; ++kk) {
                    const bf16x8 a = *(const LAS bf16x8*)(Xt + (32 * pt + r) * LDP + 16 * kk + 8 * hh);
                    const bf16x8 bb = *(const LAS bf16x8*)(Bnl + (32 * nt + r) * LDP + 16 * kk + 8 * hh);
                    sacc = MFMA32(a, bb, sacc);
                }
#pragma unroll
                for (int i = 0; i < 16; ++i) ST[((size_t)u * 64 + 32 * pt + crow(i, hh)) * 128 + 32 * nt + r] = sacc[i];
            }
        }
        __syncthreads();
    }
}
__device__ __forceinline__ void ssd_s2(Frame& F, const Ptrs& P) {
    const float* ST = (const float*)(P.ws + WS_ST); const float* CDEC = (const float*)(P.ws + WS_CDEC); unsigned* PREV = (unsigned*)(P.ws + WS_PREV);
    for (int g = F.vcu * 512 + (F.wave * 64 + lane_id()); g < 131072; g += F.G * 512) {
        const int n2 = g & 63, p = (g >> 6) & 63, h = (g >> 12) & 7, b = g >> 15;
        float2 st[32];
#pragma unroll
        for (int c = 0; c < 32; ++c) st[c] = *(const float2*)(ST + ((size_t)(((b * 32 + c) * 8 + h) * 64 + p)) * 128 + 2 * n2);
        float r0 = 0.f, r1 = 0.f;
#pragma unroll
        for (int c = 0; c < 32; ++c) { const size_t u = (size_t)((b * 32 + c) * 8 + h);
            PREV[((u * 64 + p) * 128 + 2 * n2) >> 1] = pk2(r0, r1);
            const float d = CDEC[u]; r0 = r0 * d + st[c].x; r1 = r1 * d + st[c].y; }
    }
}
__device__ __forceinline__ void ssd_s3_plain(Frame& F, const Ptrs& P) {
    const bf16* CC = (const bf16*)(P.ws + WS_CC); const bf16* PREV = (const bf16*)(P.ws + WS_PREV); const float* EA = (const float*)(P.ws + WS_EA);
    const float* YPF = (const float*)((const char*)P.out + DO_YPF); float* Y = (float*)((char*)P.out + DO_YPLAIN);
    const int lane = lane_id(), r = lane & 31, hh = lane >> 5, h = F.wave, grp = h >> 2;
    for (int v = F.vcu; v < 512; v += F.G) {
        const int lt = v & 3, c = (v >> 2) & 31, b = v >> 7;
        const int t = b * SEQ + c * 128 + lt * 32 + r; const size_t u = (size_t)((b * 32 + c) * 8 + h);
        f32x16 acc[2];
#pragma unroll
        for (int i = 0; i < 16; ++i) { acc[0][i] = 0.f; acc[1][i] = 0.f; }
#pragma unroll
        for (int kk = 0; kk < 8; ++kk) {
            const bf16x8 bb = *(const bf16x8*)(CC + (size_t)t * 256 + grp * 128 + 16 * kk + 8 * hh);
#pragma unroll
            for (int pt = 0; pt < 2; ++pt) { const bf16x8 a = *(const bf16x8*)(PREV + (u * 64 + 32 * pt + r) * 128 + 16 * kk + 8 * hh); acc[pt] = MFMA32(a, bb, acc[pt]); }
        }
        const float ea = EA[(size_t)t * 8 + h];
#pragma unroll
        for (int pt = 0; pt < 2; ++pt)
#pragma unroll
            for (int i = 0; i < 16; ++i) { const int p = 32 * pt + crow(i, hh);
                Y[(size_t)t * 512 + h * 64 + p] = acc[pt][i] * ea + YPF[((((size_t)u * 4 + lt) * 2 + pt) * 16 + i) * 64 + lane]; }
    }
}

__device__ __forceinline__ float dot2bf(unsigned a, unsigned b, float c) { return __builtin_amdgcn_fdot2_f32_bf16(__builtin_bit_cast(bf16x2_t, a), __builtin_bit_cast(bf16x2_t, b), c, false); }
__device__ __forceinline__ float dot8bf(const v4u& a, const v4u& b, float c) { c = dot2bf(a.x, b.x, c); c = dot2bf(a.y, b.y, c); c = dot2bf(a.z, b.z, c); return dot2bf(a.w, b.w, c); }
__device__ __forceinline__ float gelu_erf(float v) { return 0.5f * v * (1.f + erff(v * 0.70710678118654752f)); }
#define FMA8(ACC, O, A, W) do { ACC[O] = fmaf(A, bflo(W.x), ACC[O]); ACC[O + 1] = fmaf(A, bfhi(W.x), ACC[O + 1]); ACC[O + 2] = fmaf(A, bflo(W.y), ACC[O + 2]); ACC[O + 3] = fmaf(A, bfhi(W.y), ACC[O + 3]); \
    ACC[O + 4] = fmaf(A, bflo(W.z), ACC[O + 4]); ACC[O + 5] = fmaf(A, bfhi(W.z), ACC[O + 5]); ACC[O + 6] = fmaf(A, bflo(W.w), ACC[O + 6]); ACC[O + 7] = fmaf(A, bfhi(W.w), ACC[O + 7]); } while (0)
__device__ __forceinline__ void peer_eval(Frame& F, const Ptrs& P) {
    const bf16* HB = (const bf16*)(P.ws + WS_ST); const v4u* ED = (const v4u*)(P.ws + WS_ED); const v4u* EU = (const v4u*)(P.ws + WS_EU);
    const int* IDX = (const int*)(P.ws + WS_IDX); const float* GATE = (const float*)(P.ws + WS_GATE);
    LAS float* RM = (LAS float*)(F.lds + RING_OFF) + F.wave * 2112;
    const int lane = lane_id();
    for (int t = F.vcu * NWAVES + F.wave; t < T_; t += F.G * NWAVES) {
        const v4u h0 = ((const v4u*)(HB + (size_t)t * DM))[lane], h1 = ((const v4u*)(HB + (size_t)t * DM))[64 + lane];
        const float ssq = dot8bf(h0, h0, dot8bf(h1, h1, 0.f));
        const float rstd = rsqrtf(wave_sum(ssq) * (1.f / 1024.f) + EPS);
        const int idx_lo = IDX[(size_t)t * 128 + lane], idx_hi = IDX[(size_t)t * 128 + 64 + lane];
        const float g_lo = GATE[(size_t)t * 128 + lane], g_hi = GATE[(size_t)t * 128 + 64 + lane];
        float actg[4] = {0.f, 0.f, 0.f, 0.f};
#pragma unroll
        for (int gq = 0; gq < 4; ++gq) {
            const int idxv = (gq >> 1) ? idx_hi : idx_lo; const int lb = 32 * (gq & 1);
            v4u ra[8], rb[8]; float part[32];
#pragma unroll
            for (int j = 0; j < 8; ++j) { const int id = __builtin_amdgcn_readlane(idxv, lb + j); ra[j] = ED[(size_t)id * 128 + lane]; rb[j] = ED[(size_t)id * 128 + 64 + lane]; }
#pragma unroll
            for (int j = 0; j < 32; ++j) {
                part[j] = dot8bf(ra[j & 7], h0, dot8bf(rb[j & 7], h1, 0.f));
                if (j + 8 < 32) { const int id = __builtin_amdgcn_readlane(idxv, lb + j + 8); ra[j & 7] = ED[(size_t)id * 128 + lane]; rb[j & 7] = ED[(size_t)id * 128 + 64 + lane]; }
                __builtin_amdgcn_sched_barrier(0);
            }
#pragma unroll
            for (int j = 0; j < 32; ++j) RM[j * 65 + lane] = part[j];
            float pre = 0.f;
            { const int row = lane & 31, cb = lane & 32;
#pragma unroll
              for (int k = 0; k < 32; ++k) pre += RM[row * 65 + cb + k]; }
            pre = sum_halves(pre);
            const float gv = __int_as_float(__builtin_amdgcn_ds_bpermute((lb + (lane & 31)) * 4, __float_as_int((gq >> 1) ? g_hi : g_lo)));
            actg[gq] = gelu_erf(pre * rstd) * gv;
            asm volatile("" ::: "memory");
        }
        float acc[16];
#pragma unroll
        for (int i = 0; i < 16; ++i) acc[i] = 0.f;
#pragma unroll
        for (int gq = 0; gq < 4; ++gq) {
            const int idxv = (gq >> 1) ? idx_hi : idx_lo; const int lb = 32 * (gq & 1); const float actv = actg[gq];
            v4u ra[8], rb[8];
#pragma unroll
            for (int j = 0; j < 8; ++j) { const int id = __builtin_amdgcn_readlane(idxv, lb + j); ra[j] = EU[(size_t)id * 128 + lane]; rb[j] = EU[(size_t)id * 128 + 64 + lane]; }
#pragma unroll
            for (int j = 0; j < 32; ++j) {
                const float a = __uint_as_float(__builtin_amdgcn_readlane(__float_as_uint(actv), j));
                FMA8(acc, 0, a, ra[j & 7]); FMA8(acc, 8, a, rb[j & 7]);
                if (j + 8 < 32) { const int id = __builtin_amdgcn_readlane(idxv, lb + j + 8); ra[j & 7] = EU[(size_t)id * 128 + lane]; rb[j & 7] = EU[(size_t)id * 128 + 64 + lane]; }
                __builtin_amdgcn_sched_barrier(0);
            }
        }
        float hv[16];
        hv[0] = bflo(h0.x); hv[1] = bfhi(h0.x); hv[2] = bflo(h0.y); hv[3] = bfhi(h0.y); hv[4] = bflo(h0.z); hv[5] = bfhi(h0.z); hv[6] = bflo(h0.w); hv[7] = bfhi(h0.w);
        hv[8] = bflo(h1.x); hv[9] = bfhi(h1.x); hv[10] = bflo(h1.y); hv[11] = bfhi(h1.y); hv[12] = bflo(h1.z); hv[13] = bfhi(h1.z); hv[14] = bflo(h1.w); hv[15] = bfhi(h1.w);
        float s2 = 0.f;
#pragma unroll
        for (int i = 0; i < 16; ++i) { acc[i] += hv[i]; s2 += acc[i] * acc[i]; }
        const float r2 = rsqrtf(wave_sum(s2) * (1.f / 1024.f) + EPS);
#pragma unroll
        for (int j = 0; j < 2; ++j) { const int c0 = (j * 64 + lane) * 8; const float4 w0 = *(const float4*)(P.norm_final + c0), w1 = *(const float4*)(P.norm_final + c0 + 4);
            float4* o = (float4*)(P.out + (size_t)t * DM + c0);
            o[0] = make_float4(acc[8 * j] * r2 * w0.x, acc[8 * j + 1] * r2 * w0.y, acc[8 * j + 2] * r2 * w0.z, acc[8 * j + 3] * r2 * w0.w);
            o[1] = make_float4(acc[8 * j + 4] * r2 * w1.x, acc[8 * j + 5] * r2 * w1.y, acc[8 * j + 6] * r2 * w1.z, acc[8 * j + 7] * r2 * w1.w); }
    }
}

constexpr int TK_LDK = 136, TK_K2 = 34816, TK_SCR = 69632, TK_SP = 49;
__device__ __forceinline__ int mono_key(float x) { const int b = __float_as_int(x); return b ^ ((b >> 31) & 0x7fffffff); }
__device__ __forceinline__ float unmono(int m) { return __int_as_float(m ^ ((m >> 31) & 0x7fffffff)); }
__device__ __forceinline__ int max3i(int a, int b, int c) { return max(max(a, b), c); }
__device__ __forceinline__ void topk_phase(Frame& F, const Ptrs& P) {
    const bf16* Q = (const bf16*)(P.ws + WS_PROJ); const float* SSQ = (const float*)(P.ws + WS_SSQ);
    int* IDX = (int*)(P.ws + WS_IDX); float* GATE = (float*)(P.ws + WS_GATE);
    LAS unsigned char* L = F.lds + RING_OFF;
    LAS bf16* K1 = (LAS bf16*)L; LAS bf16* K2 = (LAS bf16*)(L + TK_K2);
    const int tid_ = (F.wave * 64 + lane_id());
    for (int i = tid_; i < 16384; i += 512) { const int n = i >> 7, k = i & 127; K1[n * TK_LDK + k] = (bf16)f2bf(P.sk1[i]); K2[n * TK_LDK + k] = (bf16)f2bf(P.sk2[i]); }
    __syncthreads();
    const int lane = tid_ & 63, r = lane & 31, hh = lane >> 5;
    LAS int* scr = (LAS int*)(L + TK_SCR) + F.wave * (32 * TK_SP) + r * TK_SP;
    for (int wq = F.vcu * NWAVES + F.wave; wq < 2048; wq += F.G * NWAVES) {
        const int t = (wq >> 2) * 32 + r;
        float rstd;
        { const float4* sp = (const float4*)(SSQ + (size_t)t * 16); const float4 a = sp[0], b = sp[1], c = sp[2], d = sp[3];
          rstd = rsqrtf(((a.x + a.y + a.z + a.w) + (b.x + b.y + b.z + b.w) + (c.x + c.y + c.z + c.w) + (d.x + d.y + d.z + d.w)) * (1.f / 1024.f) + EPS); }
#pragma unroll 1
        for (int hq = 0; hq < 2; ++hq) {
            const int hd = (wq & 3) * 2 + hq;
#pragma unroll 1
            for (int half = 0; half < 2; ++half) {
                const LAS bf16* Kh = half ? K2 : K1;
                bf16x8 qf[8];
#pragma unroll
                for (int kk = 0; kk < 8; ++kk) qf[kk] = *(const bf16x8*)(Q + (size_t)t * 2048 + hd * 256 + half * 128 + 16 * kk + 8 * hh);
                int key[64];
#pragma unroll
                for (int nt = 0; nt < 4; ++nt) {
                    f32x16 sc;
#pragma unroll
                    for (int i = 0; i < 16; ++i) sc[i] = 0.f;
#pragma unroll
                    for (int kk = 0; kk < 8; ++kk) { const bf16x8 a = *(const LAS bf16x8*)(Kh + (32 * nt + r) * TK_LDK + 16 * kk + 8 * hh); sc = MFMA32(a, qf[kk], sc); }
#pragma unroll
                    for (int i = 0; i < 16; ++i) key[nt * 16 + i] = (mono_key(sc[i]) & ~127) | (127 - (32 * nt + crow(i, hh)));
                }
#pragma unroll 1
                for (int rd = 0; rd < 16; ++rd) {
                    int m0 = max3i(key[0], key[1], key[2]), m1 = max3i(key[3], key[4], key[5]);
#pragma unroll
                    for (int i = 6; i < 60; i += 6) { m0 = max3i(m0, key[i], key[i + 1]); m1 = max3i(m1, key[i + 2], key[i + 3]); m0 = max3i(m0, key[i + 4], key[i + 5]); }
                    m0 = max3i(m0, key[60], key[61]); m1 = max3i(m1, key[62], key[63]);
                    const int lm = max(m0, m1);
                    const int g = imax_halves(lm);
                    if (hh == 0) scr[half * 16 + rd] = g;
#pragma unroll
                    for (int i = 0; i < 64; ++i) key[i] = (key[i] == g) ? (int)0x80000000 : key[i];
                }
            }
            const LAS int* la = scr + hh * 16; const LAS int* lb = scr + (1 - hh) * 16;
            float va[4], vb[16];
#pragma unroll
            for (int i = 0; i < 4; ++i) va[i] = unmono(la[i] & ~127);
#pragma unroll
            for (int j = 0; j < 16; ++j) vb[j] = unmono(lb[j] & ~127);
            int ck[27];
            {
                int q = 0;
#pragma unroll
                for (int i = 0; i < 4; ++i)
#pragma unroll
                    for (int j = i; j < 16; ++j) if ((i + 1) * (j + 1) <= 16) {
                        const int pos = hh ? (j * 16 + i) : (i * 16 + j);
                        int k = (mono_key(va[i] + vb[j]) & ~255) | (255 - pos);
                        if (i == j && hh) k = (int)0x80000000;
                        ck[q++] = k; }
            }
#pragma unroll 1
            for (int rd = 0; rd < 16; ++rd) {
                int m0 = max3i(ck[0], ck[1], ck[2]);
#pragma unroll
                for (int i = 3; i < 27; i += 2) m0 = max3i(m0, ck[i], ck[i + 1]);
                const int g = imax_halves(m0);
                if (hh == 0) scr[32 + rd] = g;
#pragma unroll
                for (int i = 0; i < 27; ++i) ck[i] = (ck[i] == g) ? (int)0x80000000 : ck[i];
            }
            const float vmax = unmono(scr[32] & ~255) * rstd;
            float ev[8]; int id[8]; float esum = 0.f;
#pragma unroll
            for (int q = 0; q < 8; ++q) { const int wk = scr[32 + hh * 8 + q]; const int pos = 255 - (wk & 255);
                const int n1 = 127 - (scr[pos >> 4] & 127), n2 = 127 - (scr[16 + (pos & 15)] & 127);
                id[q] = n1 * 128 + n2;
                ev[q] = exp2f((unmono(wk & ~255) * rstd - vmax) * LOG2E); esum += ev[q]; }
            esum = sum_halves(esum);
            const float inv = 1.f / esum;
            int4* ip = (int4*)(IDX + ((size_t)t * 8 + hd) * 16 + hh * 8); float4* gp = (float4*)(GATE + ((size_t)t * 8 + hd) * 16 + hh * 8);
            ip[0] = make_int4(id[0], id[1], id[2], id[3]); ip[1] = make_int4(id[4], id[5], id[6], id[7]);
            gp[0] = make_float4(ev[0] * inv, ev[1] * inv, ev[2] * inv, ev[3] * inv); gp[1] = make_float4(ev[4] * inv, ev[5] * inv, ev[6] * inv, ev[7] * inv);
        }
    }
    __syncthreads();
}

constexpr int AT_KP = 72, AT_VP = 264;
constexpr int AT_K = 0, AT_VT = 36864, AT_BT = 36864 + 33792;
__device__ __forceinline__ void attn_phase(Frame& F, const Ptrs& P) {
    const bf16* PROJ = (const bf16*)(P.ws + WS_PROJ); bf16* CAT = (bf16*)(P.ws + WS_XN);
    LAS unsigned char* L = F.lds + RING_OFF;
    LAS bf16* Ks = (LAS bf16*)(L + AT_K); LAS bf16* Vt = (LAS bf16*)(L + AT_VT); LAS float* btab = (LAS float*)(L + AT_BT);
    const int lane = lane_id(), tid_ = F.wave * 64 + lane, r = lane & 31, hh = lane >> 5;
    for (int u = F.vcu; u < 256; u += F.G) {
        const int hkv = u & 1, n = (u >> 1) & 31, b = u >> 6;
        const int trow0 = b * SEQ + n * 128;
        for (int i = tid_; i < 2048; i += 512) {
            const int kj = i >> 3, ch = i & 7; const bool ok = (n > 0) || (kj >= 128);
            v4u kv = {0u, 0u, 0u, 0u}, vv = {0u, 0u, 0u, 0u};
            if (ok) { const bf16* rowp = PROJ + (size_t)(trow0 - 128 + kj) * NPROJ + hkv * 64 + ch * 8; kv = *(const v4u*)(rowp + PJ_K); vv = *(const v4u*)(rowp + PJ_V); }
            *(LAS v4u*)(Ks + kj * AT_KP + ch * 8) = kv;
            LAS bf16* vp = Vt + (ch * 8) * AT_VP + kj;
            vp[0] = (bf16)(vv.x & 0xffffu); vp[AT_VP] = (bf16)(vv.x >> 16); vp[2 * AT_VP] = (bf16)(vv.y & 0xffffu); vp[3 * AT_VP] = (bf16)(vv.y >> 16);
            vp[4 * AT_VP] = (bf16)(vv.z & 0xffffu); vp[5 * AT_VP] = (bf16)(vv.z >> 16); vp[6 * AT_VP] = (bf16)(vv.w & 0xffffu); vp[7 * AT_VP] = (bf16)(vv.w >> 16);
        }
        for (int i = tid_; i < 768; i += 512) { const int gg = i / 192, dist = i % 192 - 32;
            btab[i] = (dist >= 0 && dist < 128) ? P.rel_bias[c_bucket[dist & 127] * 8 + hkv * 4 + gg] * LOG2E : 0.f; }
        __syncthreads();
        const int g = F.wave & 3, h = hkv * 4 + g;
        const float sink2 = P.sinks[h] * LOG2E;
#pragma unroll 1
        for (int qq = 0; qq < 2; ++qq) {
            const int qt = (F.wave >> 2) * 2 + qq, t = trow0 + 32 * qt + r;
            bf16x8 qf[4];
#pragma unroll
            for (int kk = 0; kk < 4; ++kk) qf[kk] = *(const bf16x8*)(PROJ + (size_t)t * NPROJ + h * 64 + 16 * kk + 8 * hh);
            f32x16 sc[5];
#pragma unroll
            for (int j = 0; j < 5; ++j) {
#pragma unroll
                for (int i = 0; i < 16; ++i) sc[j][i] = 0.f;
#pragma unroll
                for (int kk = 0; kk < 4; ++kk) { const bf16x8 a = *(const LAS bf16x8*)(Ks + (32 * (qt + j) + r) * AT_KP + 16 * kk + 8 * hh); sc[j] = MFMA32(a, qf[kk], sc[j]); }
            }
            float m = sink2;
            const LAS float* bt = btab + g * 192 + 160 + r - 4 * hh;
#pragma unroll
            for (int j = 0; j < 5; ++j) {
                const bool tile_ok = (n > 0) || (qt + j >= 4);
#pragma unroll
                for (int i = 0; i < 16; ++i) { const int dist = 128 + r - (32 * j + crow(i, hh));
                    const bool ok = tile_ok && (j == 0 ? dist < 128 : (j == 4 ? dist >= 0 : true));
                    const float s = sc[j][i] * (0.125f * LOG2E) + bt[-(32 * j + (i & 3) + 8 * (i >> 2))];
                    sc[j][i] = ok ? s : -INFINITY; m = fmaxf(m, sc[j][i]); }
            }
            m = max_halves(m);
            float l = 0.f;
#pragma unroll
            for (int j = 0; j < 5; ++j)
#pragma unroll
                for (int i = 0; i < 16; ++i) { sc[j][i] = exp2f(sc[j][i] - m); l += sc[j][i]; }
            l = sum_halves(l);
            l += exp2f(sink2 - m);
            const float inv = 1.f / l;
            f32x16 o[2];
#pragma unroll
            for (int i = 0; i < 16; ++i) { o[0][i] = 0.f; o[1][i] = 0.f; }
#pragma unroll
            for (int j = 0; j < 5; ++j)
#pragma unroll
                for (int sg = 0; sg < 2; ++sg) {
                    const bf16x8 pf = pack8(sc[j], sg);
#pragma unroll
                    for (int dt = 0; dt < 2; ++dt) {
                        const LAS bf16* vb = Vt + (32 * dt + r) * AT_VP + 32 * (qt + j) + 16 * sg + 4 * hh;
                        const s16x4 lo = *(const LAS s16x4*)(vb), hi = *(const LAS s16x4*)(vb + 8);
                        o[dt] = MFMA32(__builtin_shufflevector(lo, hi, 0, 1, 2, 3, 4, 5, 6, 7), pf, o[dt]);
                    }
                }
            bf16* op = CAT + (size_t)t * DM + h * 64 + 4 * hh;
#pragma unroll
            for (int dt = 0; dt < 2; ++dt)
#pragma unroll
                for (int g4 = 0; g4 < 4; ++g4)
                    *(unsigned long long*)(op + 32 * dt + 8 * g4) = (unsigned long long)cvtpk(o[dt][4 * g4] * inv, o[dt][4 * g4 + 1] * inv) | ((unsigned long long)cvtpk(o[dt][4 * g4 + 2] * inv, o[dt][4 * g4 + 3] * inv) << 32);
        }
        __syncthreads();
    }
}
struct Args { Ptrs p; };
__global__ void __launch_bounds__(NWAVES * 64, 2) hymba_fwd(Args args) {
    extern __shared__ __attribute__((aligned(16))) unsigned char lds[];
    const Ptrs& P = args.p;
    Frame F;
    F.lds = (LAS unsigned char*)lds;
    F.MISC = (volatile LAS unsigned*)(F.lds + MISC_OFF);
    F.wave = __builtin_amdgcn_readfirstlane(threadIdx.x >> 6);
    F.G = gridDim.x; { const int bx = blockIdx.x; F.vcu = (F.G % 8 == 0) ? (bx % 8) * (F.G / 8) + bx / 8 : bx; }
    F.ctl = (gu32*)(P.ws + WS_CTL);
    for (int u = threadIdx.x; u < (LDS_BYTES - LDSCTL_OFF) / 4; u += NWAVES * 64) ((LAS unsigned*)(F.lds + LDSCTL_OFF))[u] = 0u;
    __syncthreads();
    XcdBarrier bar = xcd_barrier_post((unsigned*)(F.ctl + CW_BAR), F.MISC + 8);
#define GRID_BAR() xcd_barrier(bar)

    bf16* XN = (bf16*)(P.ws + WS_XN); bf16* PROJ = (bf16*)(P.ws + WS_PROJ); bf16* HB = (bf16*)(P.ws + WS_ST);
    p0_prologue(F, P);
    GRID_BAR();
    { pg8::Gemm g{XN, (const bf16*)(P.ws + WS_WIN), T_, NPROJ, DM, F.wave}; pg8::StaticOrder S; S.init(T_, NPROJ, F.G, (int)blockIdx.x);
      pg8::EpiBf16<0> E{PROJ, NPROJ, nullptr, 0, 0, 1.f};
      pg8::gemm_phase<pg8::EpiBf16<0>, pg8::StaticOrder, PG8_ALIGN, PG8_SP2>(F.lds + RING_OFF, g, S, E); }
    GRID_BAR();
    ssd_s1(F, P);
    attn_phase(F, P);
    GRID_BAR();
    ssd_s2(F, P);
    GRID_BAR();
    ssd_s3_plain(F, P);
    GRID_BAR();
    gate_norm_naive(F, P);
    GRID_BAR();
    { pg8::Gemm g{XN, (const bf16*)(P.ws + WS_WOUT), T_, DM, DM, F.wave}; pg8::StaticOrder S; S.init(T_, DM, F.G, (int)blockIdx.x);
      EpiResH E{P.x, HB, (float*)(P.ws + WS_SSQ)};
      pg8::gemm_phase<EpiResH, pg8::StaticOrder, PG8_ALIGN, PG8_SP2>(F.lds + RING_OFF, g, S, E); }
    GRID_BAR();
    { pg8::Gemm g{HB, (const bf16*)(P.ws + WS_WQ), T_, 2048, DM, F.wave}; pg8::StaticOrder S; S.init(T_, 2048, F.G, (int)blockIdx.x);
      pg8::EpiBf16<0> E{PROJ, 2048, nullptr, 0, 0, 1.f};
      pg8::gemm_phase<pg8::EpiBf16<0>, pg8::StaticOrder, PG8_ALIGN, PG8_SP2>(F.lds + RING_OFF, g, S, E); }
    GRID_BAR();
    topk_phase(F, P);
    GRID_BAR();
    peer_eval(F, P);
}

extern "C" void kernel_launch(void* const* d_in, const int* in_sizes, int n_in, void* d_out, int out_size, void* d_ws, size_t ws_size, hipStream_t stream) {
    static int grid = 0;
    if (grid == 0) {
        if (n_in != 19 || out_size != T_ * DM || ws_size < WS_END) { fprintf(stderr, "kernel_launch: unexpected shapes (n_in %d, out %d, ws %zu)\n", n_in, out_size, ws_size); grid = -1; return; }
        int dev = 0, cus = 0, per_cu = 0;
        if (hipGetDevice(&dev) != hipSuccess || hipDeviceGetAttribute(&cus, hipDeviceAttributeMultiprocessorCount, dev) != hipSuccess) { grid = -1; return; }
        if (hipFuncSetAttribute((const void*)hymba_fwd, hipFuncAttributeMaxDynamicSharedMemorySize, LDS_BYTES) != hipSuccess) { fprintf(stderr, "kernel_launch: hipFuncSetAttribute failed\n"); grid = -1; return; }
        if (hipOccupancyMaxActiveBlocksPerMultiprocessor(&per_cu, (const void*)hymba_fwd, NWAVES * 64, LDS_BYTES) != hipSuccess || per_cu < 1) { fprintf(stderr, "kernel_launch: occupancy query says %d blocks per CU\n", per_cu); grid = -1; (void)hipGetLastError(); return; }
        grid = cus;
    }
    if (grid < 0) return;
    (void)hipMemsetAsync((char*)d_ws + WS_CTL, 0, CTL_ZERO_BYTES, stream);
    Args a{};
    const float** pp = (const float**)&a.p;
    for (int i = 0; i < 19; ++i) pp[i] = (const float*)d_in[i];
    a.p.out = (float*)d_out; a.p.ws = (unsigned char*)d_ws;
    hipLaunchKernelGGL(hymba_fwd, dim3(grid), dim3(NWAVES * 64), LDS_BYTES, stream, a);
}
```

```cpp
#include <hip/hip_runtime.h>
#include <cstdio>
#include <cstdint>
#include <math.h>
namespace pg8 {
#define PG8_LAS __attribute__((address_space(3)))
typedef unsigned short bf16_t;
typedef short bf16x8 __attribute__((ext_vector_type(8)));
typedef float f32x4 __attribute__((ext_vector_type(4)));
typedef unsigned u32x4 __attribute__((ext_vector_type(4)));
constexpr int BM = 256, BK = 64, HALF = 128, HTB = HALF * BK * 2  , STAGE_BYTES = 8 * HTB, NXCD = 8, WGM = 8;

__host__ __device__ __forceinline__ int lds_byte(int r, int c) { const int st = (r >> 4) * 2 + (c >> 5), rr = r & 15, cc = c & 31, ob = rr * 64 + cc * 2; return st * 1024 + (ob ^ (((ob >> 9) & 1) << 5)); }
__host__ __device__ __forceinline__ void stage_rc(int b, int& R, int& C) { const int st = b / 1024, sb = b % 1024, swz = sb ^ (((sb >> 9) & 1) << 5); R = (st >> 1) * 16 + swz / 64; C = (st & 1) * 32 + (swz % 64) / 2; }
__host__ __device__ __forceinline__ int perm32(int rho) { const int n = rho >> 4, i = rho & 15; return 8 * (i >> 2) + 4 * n + (i & 3); }

struct Unit { int pm, pn; };
struct Gemm { const bf16_t* A; const bf16_t* Bt; int M, N, K, wave; };

struct StaticOrder {
    int nM, nN, nwg, G, c;
    __host__ __device__ void init(int M, int N, int G_, int c_) { nM = M / BM; nN = N / BM; nwg = nM * nN; G = G_; c = c_; }
    __host__ __device__ bool next(int i, Unit& u) const {
        const long L = (long)i * G + c; if (L >= nwg) return false;
        int wgid = (int)L; { const int q = nwg / NXCD, r = nwg % NXCD, xcd = wgid % NXCD, off = wgid / NXCD; wgid = (xcd < r ? xcd * (q + 1) : r * (q + 1) + (xcd - r) * q) + off; }
        const int nig = WGM * nN, gid = wgid / nig, fm = gid * WGM, gsz = (nM - fm) < WGM ? (nM - fm) : WGM;
        u.pm = fm + ((wgid % nig) % gsz); u.pn = (wgid % nig) / gsz; return true;
    }
    __device__ __forceinline__ void a_ready(const Unit&) const {}
    __device__ __forceinline__ void done(const Unit&) const {}
};

__device__ __forceinline__ unsigned cvt_pk_bf16(float lo, float hi) { unsigned r; asm volatile("v_cvt_pk_bf16_f32 %0, %1, %2" : "=v"(r) : "v"(lo), "v"(hi)); return r; }
typedef float f32x2 __attribute__((ext_vector_type(2)));
__device__ __forceinline__ f32x2 gelu_pk(f32x2 v) {
    const f32x2 av = __builtin_elementwise_abs(v), d = av * 0.2316418882f + 1.0f;
    f32x2 t; t.x = __builtin_amdgcn_rcpf(d.x); t.y = __builtin_amdgcn_rcpf(d.y);
    f32x2 q = t * 0.5307027145f + (-0.7265760135f); q = q * t + 0.7107068705f; q = q * t + (-0.142248368f); q = q * t + 0.127414796f; q = q * t;
    const f32x2 s = (v * v) * (-0.72134752044f);
    f32x2 e; e.x = __builtin_amdgcn_exp2f(s.x); e.y = __builtin_amdgcn_exp2f(s.y);
    const f32x2 m = v * (q * e), r = v - m;
    f32x2 o; o.x = v.x < 0.f ? m.x : r.x; o.y = v.y < 0.f ? m.y : r.y; return o;
}

template <int ACT  > struct EpiBf16 {
    static constexpr bool PERM = true, AFTER_DRAIN = false; static_assert(ACT == 0 || ACT == 1, "EpiBf16: ACT is 0 (none) or 1 (gelu_pk)");
    bf16_t* O; int ldc; const float* bias; int split_cols; size_t split_stride; float scale0;
    __device__ __forceinline__ void operator()(const f32x4 (&acc)[2][2][4][2], const Unit& u, int wr, int wc, int fr, int fq) const {
        const int row0 = u.pm * BM + wr * 64 + fr; int colt = u.pn * BM; bf16_t* base = O;
        float sc = 1.f; if (split_cols) { const int t = colt / split_cols; base += (size_t)t * split_stride; colt -= t * split_cols; if (t == 0) sc = scale0; }
        const int col0 = colt + wc * 32 + 8 * fq, bcol0 = u.pn * BM + wc * 32 + 8 * fq;
        f32x4 bv[2][2];
#pragma unroll
        for (int bj = 0; bj < 2; ++bj)
#pragma unroll
            for (int n = 0; n < 2; ++n) bv[bj][n] = bias ? *(const f32x4*)(bias + bcol0 + bj * HALF + 4 * n) : (f32x4){0.f, 0.f, 0.f, 0.f};
#pragma unroll
        for (int ai = 0; ai < 2; ++ai)
#pragma unroll
            for (int m = 0; m < 4; ++m) { bf16_t* rowp = base + (size_t)(row0 + ai * HALF + m * 16) * ldc + col0;
#pragma unroll
                for (int bj = 0; bj < 2; ++bj) { f32x4 v0 = acc[ai][bj][m][0] + bv[bj][0], v1 = acc[ai][bj][m][1] + bv[bj][1];
                    if (ACT == 1) { f32x2 a = gelu_pk((f32x2){v0[0], v0[1]}), b = gelu_pk((f32x2){v0[2], v0[3]}), c = gelu_pk((f32x2){v1[0], v1[1]}), d = gelu_pk((f32x2){v1[2], v1[3]});
                        v0 = (f32x4){a.x, a.y, b.x, b.y}; v1 = (f32x4){c.x, c.y, d.x, d.y}; }
                    v0 = v0 * sc; v1 = v1 * sc; u32x4 w; w.x = cvt_pk_bf16(v0[0], v0[1]); w.y = cvt_pk_bf16(v0[2], v0[3]); w.z = cvt_pk_bf16(v1[0], v1[1]); w.w = cvt_pk_bf16(v1[2], v1[3]);
                    *(u32x4*)(rowp + bj * HALF) = w; } }
    }
};
template <class Epi, class Sched, bool ALIGN_EPI = false, bool SP2 = false>
__device__ __forceinline__ void gemm_phase(PG8_LAS unsigned char* lds, const Gemm g, const Sched& S, const Epi& E) {
    int lane_l; asm volatile("v_mbcnt_lo_u32_b32 %0, -1, 0\n\tv_mbcnt_hi_u32_b32 %0, -1, %0" : "=v"(lane_l));
    const int wid = g.wave, lane = lane_l, tid = wid * 64 + lane,
              wr = wid >> 2, wc = wid & 3, fr = lane & 15, fq = lane >> 4;
    const int K = g.K, nt = K / BK;
    unsigned voffA[2], voffB[2];
#pragma unroll
    for (int i = 0; i < 2; ++i) { int R, C; stage_rc(tid * 16 + i * 8192, R, C); const int Rb = Epi::PERM ? ((R & ~31) + perm32(R & 31)) : R;
        voffA[i] = (unsigned)(R * K + C) * 2u; voffB[i] = (unsigned)(Rb * K + C) * 2u; }
    const size_t kstep = (size_t)(BK * 2);
    const size_t hstep = (size_t)HALF * K * 2;
    const size_t tstep = 2 * hstep;
    const unsigned ldsw = (unsigned)wid * 1024u;
    const int aoff = lds_byte(wr * 64 + fr, fq * 8), boff = lds_byte(wc * 32 + fr, fq * 8);
#define PG8_SA(b, h) (((b) * 2 + (h)) * HTB)
#define PG8_SB(b, h) ((4 + (b) * 2 + (h)) * HTB)
#define PG8_STAGE(bufoff, gbase, voff) do { _Pragma("unroll") for (int _i = 0; _i < 2; ++_i) \
        __builtin_amdgcn_global_load_lds((const unsigned*)((const char*)(gbase) + (voff)[_i]), (PG8_LAS unsigned*)(lds + (bufoff) + ldsw + _i * 8192), 16, 0, 0); } while (0)
#define PG8_LDA(dst, b, h) do { _Pragma("unroll") for (int m = 0; m < 4; ++m) _Pragma("unroll") for (int k = 0; k < 2; ++k) dst[m][k] = *(const PG8_LAS bf16x8*)(lds + PG8_SA(b, h) + aoff + m * 2048 + k * 1024); } while (0)
#define PG8_LDB(dst, b, h) do { _Pragma("unroll") for (int n = 0; n < 2; ++n) _Pragma("unroll") for (int k = 0; k < 2; ++k) dst[n][k] = *(const PG8_LAS bf16x8*)(lds + PG8_SB(b, h) + boff + n * 2048 + k * 1024); } while (0)
#define PG8_MMA(ai, bj, At, Bt) do { __builtin_amdgcn_s_setprio(1); _Pragma("unroll") for (int m = 0; m < 4; ++m) _Pragma("unroll") for (int n = 0; n < 2; ++n) _Pragma("unroll") for (int k = 0; k < 2; ++k) \
        acc[ai][bj][m][n] = __builtin_amdgcn_mfma_f32_16x16x32_bf16(Bt[n][k], At[m][k], acc[ai][bj][m][n], 0, 0, 0); __builtin_amdgcn_s_setprio(0); } while (0)
#define PG8_WAIT_V(n) asm volatile("s_waitcnt vmcnt(" #n ")" ::: "memory")
#define PG8_WAIT_L(n) asm volatile("s_waitcnt lgkmcnt(" #n ")" ::: "memory")
#define PG8_BAR __builtin_amdgcn_s_barrier()
#define PG8_SCHED __builtin_amdgcn_sched_barrier(0)
    Unit cur, nxt; int ui = 0;
    if (!S.next(0, cur)) return;
    f32x4 acc[2][2][4][2];
#pragma unroll
    for (int a = 0; a < 2; ++a)
#pragma unroll
        for (int b = 0; b < 2; ++b)
#pragma unroll
            for (int m = 0; m < 4; ++m)
#pragma unroll
                for (int n = 0; n < 2; ++n) acc[a][b][m][n] = (f32x4){0.f, 0.f, 0.f, 0.f};
    bf16x8 At[4][2], B0[2][2], B1[2][2];
    const char* cA = (const char*)g.A + (size_t)cur.pm * tstep; const char* cB = (const char*)g.Bt + (size_t)cur.pn * tstep;
    S.a_ready(cur);
    if constexpr (SP2) {
        PG8_STAGE(PG8_SB(0, 0), cB, voffB); PG8_STAGE(PG8_SB(0, 1), cB + hstep, voffB); PG8_STAGE(PG8_SA(0, 0), cA, voffA); PG8_STAGE(PG8_SA(0, 1), cA + hstep, voffA);
        if (wr == 1) PG8_BAR;
        PG8_WAIT_V(2); PG8_BAR;
        PG8_STAGE(PG8_SB(1, 0), cB + kstep, voffB); PG8_STAGE(PG8_SA(1, 0), cA + kstep, voffA); PG8_STAGE(PG8_SB(1, 1), cB + hstep + kstep, voffB);
        PG8_WAIT_V(6); PG8_BAR;
    } else {
        PG8_STAGE(PG8_SB(0, 0), cB, voffB); PG8_STAGE(PG8_SA(0, 0), cA, voffA); PG8_STAGE(PG8_SB(0, 1), cB + hstep, voffB); PG8_STAGE(PG8_SA(0, 1), cA + hstep, voffA);
        if (wr == 1) PG8_BAR;
        PG8_WAIT_V(4); PG8_BAR;
        PG8_STAGE(PG8_SB(1, 0), cB + kstep, voffB); PG8_STAGE(PG8_SA(1, 0), cA + kstep, voffA); PG8_STAGE(PG8_SB(1, 1), cB + hstep + kstep, voffB);
        PG8_WAIT_V(6); PG8_BAR;
    }
    for (;;) {
        const bool has_next = S.next(ui + 1, nxt);
        const char* nA = has_next ? (const char*)g.A + (size_t)nxt.pm * tstep : cA; const char* nB = has_next ? (const char*)g.Bt + (size_t)nxt.pn * tstep : cB;
        for (int t = 0; t < nt; t += 2) {
            const bool last = (t == nt - 2);
            const char* a1 = cA + (size_t)(t + 1) * kstep;
            const char* a2 = last ? nA : cA + (size_t)(t + 2) * kstep; const char* b2 = last ? nB : cB + (size_t)(t + 2) * kstep;
            const char* a3 = a2 + kstep; const char* b3 = b2 + kstep;
            if (last && has_next) S.a_ready(nxt);
            if constexpr (SP2) {
            PG8_LDB(B0, 0, 0); PG8_LDB(B1, 0, 1); PG8_SCHED; PG8_LDA(At, 0, 0); PG8_STAGE(PG8_SA(1, 1), a1 + hstep, voffA);
            PG8_WAIT_V(8); PG8_WAIT_L(0); PG8_BAR; PG8_MMA(0, 0, At, B0); PG8_MMA(0, 1, At, B1); PG8_BAR; PG8_SCHED;
            PG8_LDA(At, 0, 1); PG8_STAGE(PG8_SB(0, 0), b2, voffB); PG8_STAGE(PG8_SB(0, 1), b2 + hstep, voffB); PG8_STAGE(PG8_SA(0, 0), a2, voffA);
            PG8_WAIT_V(8); PG8_WAIT_L(0); PG8_BAR; PG8_MMA(1, 0, At, B0); PG8_MMA(1, 1, At, B1); PG8_BAR; PG8_SCHED;
            PG8_LDB(B0, 1, 0); PG8_LDB(B1, 1, 1); PG8_SCHED; PG8_LDA(At, 1, 0); PG8_STAGE(PG8_SA(0, 1), a2 + hstep, voffA);
            PG8_WAIT_V(8); PG8_WAIT_L(0); PG8_BAR; PG8_MMA(0, 0, At, B0); PG8_MMA(0, 1, At, B1); PG8_BAR; PG8_SCHED;
            PG8_LDA(At, 1, 1); PG8_STAGE(PG8_SB(1, 0), b3, voffB); PG8_STAGE(PG8_SB(1, 1), b3 + hstep, voffB); PG8_STAGE(PG8_SA(1, 0), a3, voffA);
            PG8_WAIT_V(8); PG8_WAIT_L(0); PG8_BAR; PG8_MMA(1, 0, At, B0); PG8_MMA(1, 1, At, B1); PG8_BAR; PG8_SCHED;
            } else {
            PG8_LDB(B0, 0, 0); PG8_SCHED; PG8_LDA(At, 0, 0); PG8_STAGE(PG8_SA(1, 1), a1 + hstep, voffA);
            PG8_WAIT_L(8); PG8_BAR; PG8_WAIT_L(0); PG8_MMA(0, 0, At, B0); PG8_BAR; PG8_SCHED;
            PG8_LDB(B1, 0, 1); PG8_STAGE(PG8_SB(0, 0), b2, voffB);
            PG8_BAR; PG8_WAIT_L(0); PG8_MMA(0, 1, At, B1); PG8_BAR;
            PG8_LDA(At, 0, 1); PG8_STAGE(PG8_SA(0, 0), a2, voffA);
            PG8_BAR; PG8_WAIT_L(0); PG8_MMA(1, 0, At, B0); PG8_BAR; PG8_SCHED;
            PG8_STAGE(PG8_SB(0, 1), b2 + hstep, voffB);
            PG8_WAIT_V(6); PG8_BAR; PG8_MMA(1, 1, At, B1); PG8_BAR;
            PG8_LDB(B0, 1, 0); PG8_SCHED; PG8_LDA(At, 1, 0); PG8_STAGE(PG8_SA(0, 1), a2 + hstep, voffA);
            PG8_WAIT_L(8); PG8_BAR; PG8_WAIT_L(0); PG8_MMA(0, 0, At, B0); PG8_BAR; PG8_SCHED;
            PG8_LDB(B1, 1, 1); PG8_STAGE(PG8_SB(1, 0), b3, voffB);
            PG8_BAR; PG8_WAIT_L(0); PG8_MMA(0, 1, At, B1); PG8_BAR;
            PG8_LDA(At, 1, 1); PG8_STAGE(PG8_SA(1, 0), a3, voffA);
            PG8_BAR; PG8_WAIT_L(0); PG8_MMA(1, 0, At, B0); PG8_BAR; PG8_SCHED;
            PG8_STAGE(PG8_SB(1, 1), b3 + hstep, voffB);
            PG8_WAIT_V(6); PG8_BAR; PG8_MMA(1, 1, At, B1); PG8_BAR;
            }
        }
        if constexpr (ALIGN_EPI) { if (wr == 0) PG8_BAR; }
        if constexpr (!Epi::AFTER_DRAIN) { E(acc, cur, wr, wc, fr, fq); S.done(cur); }
        if (!has_next) break;
#pragma unroll
        for (int a = 0; a < 2; ++a)
#pragma unroll
            for (int b = 0; b < 2; ++b)
#pragma unroll
                for (int m = 0; m < 4; ++m)
#pragma unroll
                    for (int n = 0; n < 2; ++n) acc[a][b][m][n] = (f32x4){0.f, 0.f, 0.f, 0.f};
        cur = nxt; cA = nA; cB = nB; ++ui;
        if constexpr (ALIGN_EPI) { if (wr == 1) PG8_BAR; }
    }
    PG8_WAIT_V(0);
    if constexpr (!ALIGN_EPI) { if (wr == 0) PG8_BAR; }
    PG8_BAR;
    if constexpr (Epi::AFTER_DRAIN) { E.fused(acc, cur, wr, wc, fr, fq, lds, wid, lane); S.done(cur); }
#undef PG8_SA
#undef PG8_SB
#undef PG8_STAGE
#undef PG8_LDA
#undef PG8_LDB
#undef PG8_MMA
#undef PG8_WAIT_V
#undef PG8_WAIT_L
#undef PG8_BAR
#undef PG8_SCHED
}
}

#ifndef PG8_SP2
#define PG8_SP2 true
#endif
#ifndef PG8_ALIGN
#define PG8_ALIGN true
#endif
#define GAS __attribute__((address_space(1)))
#define LAS __attribute__((address_space(3)))
typedef unsigned short bf16;
typedef unsigned v4u __attribute__((ext_vector_type(4)));
typedef float f32x4 __attribute__((ext_vector_type(4)));
typedef short bf16x8 __attribute__((ext_vector_type(8)));
typedef GAS unsigned gu32;
typedef GAS unsigned long long gu64;
#define RLX_AGENT __ATOMIC_RELAXED, __HIP_MEMORY_SCOPE_AGENT
#define LDS_WAIT() asm volatile("s_waitcnt lgkmcnt(0)" ::: "memory")
#define VM_WAIT() asm volatile("s_waitcnt vmcnt(0)" ::: "memory")
__device__ __forceinline__ unsigned long long rt() { return __builtin_amdgcn_s_memrealtime(); }
__device__ __forceinline__ unsigned f2bf(float f) { unsigned u = __builtin_bit_cast(unsigned, f); return (u + 0x7fffu + ((u >> 16) & 1u)) >> 16; }
__device__ __forceinline__ unsigned pk2(float lo, float hi) { return f2bf(lo) | (f2bf(hi) << 16); }

#define XB_TMO      128
#define XB_XCNT(j)  (256  + 64 * (j))
#define XB_XSUB(j)  (1280 + 64 * (j))
#define XB_XGEN(j)  (2304 + 64 * (j))
#define XB_TOP      3328
#define XB_TOPGEN   3392
#define XCD_BAR_WORDS 3456
#define XB_SPIN_CAP (1u << 22)

__device__ __forceinline__ unsigned xb_ld(unsigned* p)              { return __hip_atomic_load(p, __ATOMIC_RELAXED, __HIP_MEMORY_SCOPE_AGENT); }
__device__ __forceinline__ unsigned xb_add(unsigned* p, unsigned v) { return __hip_atomic_fetch_add(p, v, __ATOMIC_RELAXED, __HIP_MEMORY_SCOPE_AGENT); }
__device__ __forceinline__ unsigned xb_xcc_id() { return (unsigned)__builtin_amdgcn_s_getreg((3 << 11) | 20) & 0xFu; }
#define XB_SPIN(cond, bar) do { unsigned _sp = 0; while (cond) { __builtin_amdgcn_s_sleep(1); \
    if ((++_sp & 255u) == 0u) { if (xb_ld(&(bar)[XB_TMO])) break; if (_sp > XB_SPIN_CAP) { atomicAdd(&(bar)[XB_TMO], 1u); break; } } } } while (0)

struct XcdBarrier {
    unsigned* bar; unsigned x;
    volatile LAS unsigned* st;
};

__device__ __forceinline__ XcdBarrier xcd_barrier_post(unsigned* bar, volatile LAS unsigned* st) {
    XcdBarrier b; b.bar = bar; b.x = xb_xcc_id(); b.st = st;
    if (threadIdx.x == 0) (void)xb_add(&bar[XB_XCNT(b.x)], 1u);
    return b;
}
__device__ __forceinline__ void xcd_barrier_complete(unsigned* bar, unsigned x, unsigned& nloc, unsigned& nx) {
    const unsigned G = gridDim.x * gridDim.y * gridDim.z;
    unsigned sum, cnt, mine, sp = 0u;
    for (;;) {
        sum = 0u; cnt = 0u; mine = 0u;
#pragma unroll
        for (unsigned j = 0; j < 16; ++j) { const unsigned c = xb_ld(&bar[XB_XCNT(j)]); sum += c; cnt += (c > 0u) ? 1u : 0u; mine = (j == x) ? c : mine; }
        if (sum == G) break;
        __builtin_amdgcn_s_sleep(1);
        if ((++sp & 255u) == 0u) { if (xb_ld(&bar[XB_TMO])) break; if (sp > XB_SPIN_CAP) { atomicAdd(&bar[XB_TMO], 1u); break; } }
    }
    nloc = mine > 0u ? mine : 1u; nx = cnt > 0u ? cnt : 1u;
}

__device__ __forceinline__ void xcd_barrier(const XcdBarrier& b) {
    asm volatile("s_waitcnt vmcnt(0)" ::: "memory");
    __syncthreads();
    if (threadIdx.x == 0) {
        unsigned* bar = b.bar;
        __builtin_amdgcn_s_waitcnt(0);
        unsigned nloc = b.st[0], nx = b.st[1];
        if (nloc == 0u) { xcd_barrier_complete(bar, b.x, nloc, nx); b.st[0] = nloc; b.st[1] = nx; }
        const unsigned old = xb_add(&bar[XB_XSUB(b.x)], 1u);
        const unsigned gen = old / nloc;
        if (old + 1u == (gen + 1u) * nloc) {
            __builtin_amdgcn_fence(__ATOMIC_RELEASE, "agent");
            asm volatile("s_waitcnt vmcnt(0)" ::: "memory");
            const unsigned og = xb_add(&bar[XB_TOP], 1u);
            const unsigned tg = og / nx;
            if (og + 1u == (tg + 1u) * nx) xb_add(&bar[XB_TOPGEN], 1u);
            else XB_SPIN(xb_ld(&bar[XB_TOPGEN]) == tg, bar);
            __builtin_amdgcn_fence(__ATOMIC_ACQUIRE, "agent");
            xb_add(&bar[XB_XGEN(b.x)], 1u);
            asm volatile("s_waitcnt vmcnt(0)" ::: "memory");
        } else {
            XB_SPIN(xb_ld(&bar[XB_XGEN(b.x)]) == gen, bar);
            __builtin_amdgcn_fence(__ATOMIC_ACQUIRE, "agent");
            asm volatile("s_waitcnt vmcnt(0)" ::: "memory");
        }
    }
    __syncthreads();
}

constexpr int NWAVES = 8;
constexpr int T_ = 16384, SEQ = 4096, DM = 1024, NPROJ = 2304, INC = 2312;
constexpr int PJ_K = 512, PJ_V = 640, PJ_Z = 768, PJ_XBC = 1280;
constexpr float EPS = 1e-6f;
constexpr size_t MiB = 1u << 20;
constexpr size_t WS_CTL = 0, CTL_ZERO_BYTES = 1 * MiB;
constexpr size_t WS_SMALL = 1 * MiB;
constexpr size_t WS_WIN = 2 * MiB, WS_WOUT = 7 * MiB, WS_WQ = 9 * MiB;
constexpr size_t WS_ED = 13 * MiB, WS_EU = 29 * MiB;
constexpr size_t WS_XN = 77 * MiB;
constexpr size_t WS_PROJ = 109 * MiB;
constexpr size_t WS_ST = 181 * MiB;
constexpr size_t WS_IDX = 213 * MiB, WS_GATE = 221 * MiB, WS_SSQ = 229 * MiB, WS_END = 230 * MiB;
constexpr size_t DO_Y = 0, DO_DT = 41 * MiB;
constexpr size_t WS_CC = 230 * MiB, WS_DT = 238 * MiB, WS_EA = 239 * MiB, WS_CDEC = 240 * MiB, WS_PREV = WS_IDX;
constexpr size_t DO_YPF = 0, DO_YPLAIN = 32 * MiB;
constexpr int CW_BAR = 4096;
constexpr int RING_OFF = 0, RING_BYTES = 131072, LDSCTL_OFF = RING_BYTES, MISC_OFF = LDSCTL_OFF + 320, LDS_BYTES = 147456;

__constant__ unsigned char c_bucket[128] = {0, 1, 2, 3, 4, 5, 6, 7, 8, 9, 10, 11, 12, 13, 14, 15, 16, 16, 16, 17, 17, 18, 18, 18, 19, 19, 19, 20, 20, 20, 20, 21, 21, 21, 21, 22, 22, 22, 22, 22, 23, 23, 23, 23, 23, 23, 24, 24, 24, 24, 24, 24, 25, 25, 25, 25, 25, 25, 25, 26, 26, 26, 26, 26, 26, 26, 26, 27, 27, 27, 27, 27, 27, 27, 27, 27, 27, 28, 28, 28, 28, 28, 28, 28, 28, 28, 28, 29, 29, 29, 29, 29, 29, 29, 29, 29, 29, 29, 29, 30, 30, 30, 30, 30, 30, 30, 30, 30, 30, 30, 30, 30, 30, 31, 31, 31, 31, 31, 31, 31, 31, 31, 31, 31, 31, 31, 31, 31};

struct Frame {
    LAS unsigned char* lds;
    volatile LAS unsigned* MISC;
    gu32* ctl;
    int wave, vcu, G;
};
__device__ __forceinline__ int lane_id() { int l; asm volatile("v_mbcnt_lo_u32_b32 %0, -1, 0\n\tv_mbcnt_hi_u32_b32 %0, -1, %0" : "=v"(l)); return l; }
__device__ __forceinline__ int opq(int x) { asm volatile("" : "+v"(x)); return x; }
template <int M> __device__ __forceinline__ float swz_xor(float v) { return __int_as_float(__builtin_amdgcn_ds_swizzle(__float_as_int(v), (M << 10) | 0x1F)); }
__device__ __forceinline__ float sum_halves(float v) { const auto r = __builtin_amdgcn_permlane32_swap(__float_as_uint(v), __float_as_uint(v), false, false); return __uint_as_float(r[0]) + __uint_as_float(r[1]); }
__device__ __forceinline__ float max_halves(float v) { const auto r = __builtin_amdgcn_permlane32_swap(__float_as_uint(v), __float_as_uint(v), false, false); return fmaxf(__uint_as_float(r[0]), __uint_as_float(r[1])); }
__device__ __forceinline__ int imax_halves(int v) { const auto r = __builtin_amdgcn_permlane32_swap((unsigned)v, (unsigned)v, false, false); return max((int)r[0], (int)r[1]); }
__device__ __forceinline__ float wave_sum(float v) {
    v += swz_xor<1>(v); v += swz_xor<2>(v); v += swz_xor<4>(v); v += swz_xor<8>(v); v += swz_xor<16>(v);
    return sum_halves(v);
}
__device__ __forceinline__ float bf2f(unsigned short b) { return __uint_as_float((unsigned)b << 16); }
__device__ __forceinline__ float bflo(unsigned w) { return __uint_as_float(w << 16); }
__device__ __forceinline__ float bfhi(unsigned w) { return __uint_as_float(w & 0xffff0000u); }
__device__ __forceinline__ float silu_f(float x) { return x / (1.f + __expf(-x)); }

__device__ __forceinline__ void p0_transpose_item(const float* W, int ldw, int K, int nblk, bf16* WT, const float* kscale, LAS float* scr, int item, int lane) {
    const int kb = item / nblk, nb = item % nblk, k0 = 64 * kb, n0 = 32 * nb;
#pragma unroll 8
    for (int i = 0; i < 32; ++i) { const int kk = 2 * i + (lane >> 5); float v = W[(size_t)(k0 + kk) * ldw + n0 + (lane & 31)]; if (kscale) v *= kscale[k0 + kk]; scr[kk * 33 + (lane & 31)] = v; }
    LDS_WAIT(); asm volatile("" ::: "memory");
    const int c = lane & 7;
#pragma unroll
    for (int j = 0; j < 4; ++j) { const int n = (lane >> 3) + 8 * j; const LAS float* s = scr + (8 * c) * 33 + n;
        v4u o; o.x = pk2(s[0 * 33], s[1 * 33]); o.y = pk2(s[2 * 33], s[3 * 33]); o.z = pk2(s[4 * 33], s[5 * 33]); o.w = pk2(s[6 * 33], s[7 * 33]);
        *(GAS v4u*)(WT + (size_t)(n0 + n) * K + k0 + 8 * c) = o; }
    LDS_WAIT(); asm volatile("" ::: "memory");
}
struct Ptrs {
    const float *x, *norm_mix, *w_in, *conv_w, *conv_b, *dt_bias, *a_log, *d_skip, *ssd_norm_w, *sinks, *w_out, *rel_bias, *norm_ffn, *w_query, *sk1, *sk2, *e_down, *e_up, *norm_final;
    float* out; unsigned char* ws;
};
__device__ __forceinline__ void p0_prologue(Frame& F0, const Ptrs& P) {
    const Frame& F = F0; const int lane_ = lane_id(), tid_ = F.wave * 64 + lane_;
    LAS float* scr = (LAS float*)(F.lds + RING_OFF + F.wave * 16384);
    const int gw = F.vcu * NWAVES + F.wave, NGW = F.G * NWAVES;
    bf16* Win_t = (bf16*)(P.ws + WS_WIN); bf16* Wout_t = (bf16*)(P.ws + WS_WOUT); bf16* Wq_t = (bf16*)(P.ws + WS_WQ);
    constexpr int I_IN = 16 * 72, I_OUT = 16 * 32, I_Q = 16 * 64, NITEMS = I_IN + I_OUT + I_Q;
    for (int it = gw; it < NITEMS; it += NGW) {
        int r = it;
        if (r < I_IN) { p0_transpose_item(P.w_in, INC, DM, 72, Win_t, nullptr, scr, r, lane_); continue; } r -= I_IN;
        if (r < I_OUT) { p0_transpose_item(P.w_out, DM, DM, 32, Wout_t, nullptr, scr, r, lane_); continue; } r -= I_OUT;
        p0_transpose_item(P.w_query, 2048, DM, 64, Wq_t, P.norm_ffn, scr, r, lane_);
    }
    { float* SC = (float*)(P.ws + WS_SMALL);
      for (int row = gw; row < 32768; row += NGW) {
        const int isup = row >> 14, e = row & 16383;
        const float4* src = (const float4*)((isup ? P.e_up : P.e_down) + (size_t)e * DM) + 4 * lane_;
        float v[16];
#pragma unroll
        for (int q = 0; q < 4; ++q) { const float4 t = src[q]; v[4 * q] = t.x; v[4 * q + 1] = t.y; v[4 * q + 2] = t.z; v[4 * q + 3] = t.w; }
        if (!isup) {
#pragma unroll
            for (int q = 0; q < 4; ++q) { const float4 w = ((const float4*)P.norm_ffn)[4 * lane_ + q]; v[4 * q] *= w.x; v[4 * q + 1] *= w.y; v[4 * q + 2] *= w.z; v[4 * q + 3] *= w.w; } }
        float am = 0.f;
#pragma unroll
        for (int q = 0; q < 16; ++q) am = fmaxf(am, fabsf(v[q]));
        am = fmaxf(am, swz_xor<1>(am)); am = fmaxf(am, swz_xor<2>(am)); am = fmaxf(am, swz_xor<4>(am)); am = fmaxf(am, swz_xor<8>(am)); am = fmaxf(am, swz_xor<16>(am)); am = max_halves(am);
        am = fmaxf(am, 1e-30f);
        const float inv = 448.f / am;
        v4u o; int p;
        p = 0; p = __builtin_amdgcn_cvt_pk_fp8_f32(v[0] * inv, v[1] * inv, p, false); p = __builtin_amdgcn_cvt_pk_fp8_f32(v[2] * inv, v[3] * inv, p, true); o.x = (unsigned)p;
        p = 0; p = __builtin_amdgcn_cvt_pk_fp8_f32(v[4] * inv, v[5] * inv, p, false); p = __builtin_amdgcn_cvt_pk_fp8_f32(v[6] * inv, v[7] * inv, p, true); o.y = (unsigned)p;
        p = 0; p = __builtin_amdgcn_cvt_pk_fp8_f32(v[8] * inv, v[9] * inv, p, false); p = __builtin_amdgcn_cvt_pk_fp8_f32(v[10] * inv, v[11] * inv, p, true); o.z = (unsigned)p;
        p = 0; p = __builtin_amdgcn_cvt_pk_fp8_f32(v[12] * inv, v[13] * inv, p, false); p = __builtin_amdgcn_cvt_pk_fp8_f32(v[14] * inv, v[15] * inv, p, true); o.w = (unsigned)p;
        ((v4u*)(P.ws + WS_ED))[(size_t)row * 64 + lane_] = o;
        if (lane_ == 0) SC[row] = am * (1.f / 448.f);
      } }
    __syncthreads();
    { LAS float* Wdt = (LAS float*)(F.lds + RING_OFF);
      for (int i = tid_; i < 8192; i += 512) Wdt[i] = P.w_in[(size_t)(i >> 3) * INC + NPROJ + (i & 7)];
      __syncthreads();
      bf16* XN = (bf16*)(P.ws + WS_XN); float* DT = (float*)(P.ws + WS_DT);
      for (int m = gw; m < T_; m += NGW) {
        const float4* xr = (const float4*)(P.x + (size_t)m * DM);
        float4 v[4]; float s = 0.f;
#pragma unroll
        for (int j = 0; j < 4; ++j) { v[j] = xr[j * 64 + lane_]; s += v[j].x * v[j].x + v[j].y * v[j].y + v[j].z * v[j].z + v[j].w * v[j].w; }
        const float r = rsqrtf(wave_sum(s) * (1.f / 1024.f) + EPS);
        float d8[8];
#pragma unroll
        for (int q = 0; q < 8; ++q) d8[q] = 0.f;
        unsigned long long* o8 = (unsigned long long*)(XN + (size_t)m * DM);
#pragma unroll
        for (int j = 0; j < 4; ++j) { const float4 w = ((const float4*)P.norm_mix)[j * 64 + lane_];
            const float e0 = v[j].x * r * w.x, e1 = v[j].y * r * w.y, e2 = v[j].z * r * w.z, e3 = v[j].w * r * w.w;
            o8[j * 64 + lane_] = (unsigned long long)pk2(e0, e1) | ((unsigned long long)pk2(e2, e3) << 32);
            const float ev[4] = {e0, e1, e2, e3};
#pragma unroll
            for (int e = 0; e < 4; ++e) { const LAS f32x4* wr = (const LAS f32x4*)(Wdt + (size_t)(j * 256 + lane_ * 4 + e) * 8); const f32x4 w0 = wr[0], w1 = wr[1];
                d8[0] += ev[e] * w0.x; d8[1] += ev[e] * w0.y; d8[2] += ev[e] * w0.z; d8[3] += ev[e] * w0.w; d8[4] += ev[e] * w1.x; d8[5] += ev[e] * w1.y; d8[6] += ev[e] * w1.z; d8[7] += ev[e] * w1.w; } }
#pragma unroll
        for (int q = 0; q < 8; ++q) d8[q] = wave_sum(d8[q]);
        if (lane_ == 0) { float4* dp = (float4*)(DT + (size_t)m * 8); dp[0] = make_float4(d8[0], d8[1], d8[2], d8[3]); dp[1] = make_float4(d8[4], d8[5], d8[6], d8[7]); }
      }
      __syncthreads(); }
}

struct EpiResH {
    static constexpr bool PERM = false, AFTER_DRAIN = false;
    const float* X; bf16* HB; float* SSQ;
    __device__ __forceinline__ void operator()(const pg8::f32x4 (&acc)[2][2][4][2], const pg8::Unit& u, int wr, int wc, int fr, int fq) const {
        const int row0 = u.pm * 256 + wr * 64 + fr, col0 = u.pn * 256 + wc * 32 + 4 * fq;
#pragma unroll
        for (int ai = 0; ai < 2; ++ai)
#pragma unroll
            for (int m = 0; m < 4; ++m) { const int row = row0 + ai * 128 + m * 16; float ss = 0.f;
#pragma unroll
                for (int bj = 0; bj < 2; ++bj)
#pragma unroll
                    for (int n = 0; n < 2; ++n) { const size_t off = (size_t)row * DM + col0 + bj * 128 + n * 16;
                        const pg8::f32x4 h = acc[ai][bj][m][n] + *(const pg8::f32x4*)(X + off);
                        ss += h[0] * h[0] + h[1] * h[1] + h[2] * h[2] + h[3] * h[3];
                        *(unsigned long long*)(HB + off) = (unsigned long long)pk2(h[0], h[1]) | ((unsigned long long)pk2(h[2], h[3]) << 32); }
                ss += swz_xor<16>(ss); ss = sum_halves(ss);
                if (fq == 0) SSQ[(size_t)row * 16 + u.pn * 4 + wc] = ss; }
    }
};

__device__ __forceinline__ void gate_norm_naive(Frame& F, const Ptrs& P) {
    const bf16* PROJ = (const bf16*)(P.ws + WS_PROJ); bf16* CAT = (bf16*)(P.ws + WS_XN); const float* Y = (const float*)((const char*)P.out + DO_YPLAIN);
    const int lane_ = lane_id();
    for (int row = F.vcu * NWAVES + F.wave; row < T_; row += F.G * NWAVES) {
        float v[8]; float s = 0.f;
#pragma unroll
        for (int j = 0; j < 8; ++j) { const int c = j * 64 + lane_; const float z = bf2f(PROJ[(size_t)row * NPROJ + PJ_Z + c]); v[j] = Y[(size_t)row * 512 + c] * silu_f(z); s += v[j] * v[j]; }
        const float r = rsqrtf(wave_sum(s) * (1.f / 512.f) + EPS);
#pragma unroll
        for (int j = 0; j < 8; ++j) { const int c = j * 64 + lane_; CAT[(size_t)row * DM + 512 + c] = (bf16)f2bf(v[j] * r * P.ssd_norm_w[c]); }
    }
}
typedef float f32x16 __attribute__((ext_vector_type(16)));
typedef short s16x4 __attribute__((ext_vector_type(4)));
typedef float f32x2_t __attribute__((ext_vector_type(2)));
typedef __bf16 bf16x2_t __attribute__((ext_vector_type(2)));
#define MFMA32(a, b, c) __builtin_amdgcn_mfma_f32_32x32x16_bf16((a), (b), (c), 0, 0, 0)
__device__ __forceinline__ int crow(int reg, int h) { return (reg & 3) + 8 * (reg >> 2) + 4 * h; }
__device__ __forceinline__ unsigned cvtpk(float lo, float hi) { f32x2_t v = {lo, hi}; bf16x2_t b = __builtin_convertvector(v, bf16x2_t); return __builtin_bit_cast(unsigned, b); }
__device__ __forceinline__ bf16x8 pack8(const f32x16& x, int s) {
    v4u p; p.x = cvtpk(x[8 * s], x[8 * s + 1]); p.y = cvtpk(x[8 * s + 2], x[8 * s + 3]); p.z = cvtpk(x[8 * s + 4], x[8 * s + 5]); p.w = cvtpk(x[8 * s + 6], x[8 * s + 7]);
    return __builtin_bit_cast(bf16x8, p);
}
constexpr float LOG2E = 1.4426950408889634f;
constexpr int LDP = 136;
constexpr int S1_XT = 0, S1_BSN = 17408, S1_CLN = 52224, S1_BNL = 87040, S1_F32 = 121856;

__device__ __forceinline__ void ssd_s1(Frame& F, const Ptrs& P) {
    const bf16* PROJ = (const bf16*)(P.ws + WS_PROJ); const float* DT = (const float*)(P.ws + WS_DT);
    float* EA = (float*)(P.ws + WS_EA); float* CDEC = (float*)(P.ws + WS_CDEC); bf16* CC = (bf16*)(P.ws + WS_CC);
    float* ST = (float*)(P.ws + WS_ST); float* YPF = (float*)((char*)P.out + DO_YPF);
    LAS unsigned char* L = F.lds + RING_OFF;
    LAS bf16* Xt = (LAS bf16*)(L + S1_XT); LAS bf16* Bsn = (LAS bf16*)(L + S1_BSN); LAS bf16* Cln = (LAS bf16*)(L + S1_CLN); LAS bf16* Bnl = (LAS bf16*)(L + S1_BNL);
    LAS float* acum2 = (LAS float*)(L + S1_F32); LAS float* wv = acum2 + 128; LAS float* wend = wv + 128;
    const int lane = lane_id(), r = lane & 31, hh = lane >> 5; const int tid_ = F.wave * 64 + lane;
    for (int u = F.vcu; u < 1024; u += F.G) {
        const int h = u & 7, c = (u >> 3) & 31, b = u >> 8, grp = h >> 2, t0 = b * SEQ + c * 128;
        const float A = -__expf(P.a_log[h]), Dh = P.d_skip[h], dtb = P.dt_bias[h];
        if (F.wave == 0) {
            const float x0 = DT[(size_t)(t0 + 2 * lane) * 8 + h] + dtb, x1 = DT[(size_t)(t0 + 2 * lane + 1) * 8 + h] + dtb;
            const float dt0 = fmaxf(x0, 0.f) + log1pf(__expf(-fabsf(x0))), dt1 = fmaxf(x1, 0.f) + log1pf(__expf(-fabsf(x1)));
            const float a0 = dt0 * A, a1 = dt1 * A;
            float s = a0 + a1;
#pragma unroll
            for (int o = 1; o < 64; o <<= 1) { const float v = __int_as_float(__builtin_amdgcn_ds_bpermute((lane - o) * 4, __float_as_int(s))); if (lane >= o) s += v; }
            const float ac1 = s, ac0 = s - a1, tot = __uint_as_float(__builtin_amdgcn_readlane(__float_as_uint(s), 63));
            acum2[2 * lane] = ac0 * LOG2E; acum2[2 * lane + 1] = ac1 * LOG2E;
            wv[2 * lane] = log2f(dt0) - ac0 * LOG2E; wv[2 * lane + 1] = log2f(dt1) - ac1 * LOG2E;
            wend[2 * lane] = dt0 * exp2f((tot - ac0) * LOG2E); wend[2 * lane + 1] = dt1 * exp2f((tot - ac1) * LOG2E);
            EA[(size_t)(t0 + 2 * lane) * 8 + h] = exp2f(ac0 * LOG2E); EA[(size_t)(t0 + 2 * lane + 1) * 8 + h] = exp2f(ac1 * LOG2E);
            if (lane == 0) CDEC[u] = exp2f(tot * LOG2E);
        }
        __syncthreads();
        if (tid_ < 480) {
            const int cg = tid_ % 40, ph = tid_ / 40;
            int chb; if (cg < 8) chb = h * 64 + cg * 8; else if (cg < 24) chb = 512 + grp * 128 + (cg - 8) * 8; else chb = 768 + grp * 128 + (cg - 24) * 8;
            float w[4][8], bias[8];
#pragma unroll
            for (int j = 0; j < 4; ++j) { const float4 w0 = *(const float4*)(P.conv_w + j * 1024 + chb), w1 = *(const float4*)(P.conv_w + j * 1024 + chb + 4);
                w[j][0] = w0.x; w[j][1] = w0.y; w[j][2] = w0.z; w[j][3] = w0.w; w[j][4] = w1.x; w[j][5] = w1.y; w[j][6] = w1.z; w[j][7] = w1.w; }
            { const float4 b0 = *(const float4*)(P.conv_b + chb), b1 = *(const float4*)(P.conv_b + chb + 4);
              bias[0] = b0.x; bias[1] = b0.y; bias[2] = b0.z; bias[3] = b0.w; bias[4] = b1.x; bias[5] = b1.y; bias[6] = b1.z; bias[7] = b1.w; }
            for (int it = 0; it < 11; ++it) {
                const int l = ph + 12 * it;
                if (l < 128) {
                    float a[8];
#pragma unroll
                    for (int e = 0; e < 8; ++e) a[e] = bias[e];
#pragma unroll
                    for (int j = 0; j < 4; ++j) { const int ss = c * 128 + l - 3 + j;
                        if (ss >= 0) { const v4u raw = *(const v4u*)(PROJ + (size_t)(b * SEQ + ss) * NPROJ + PJ_XBC + chb);
                            a[0] += w[j][0] * bflo(raw.x); a[1] += w[j][1] * bfhi(raw.x); a[2] += w[j][2] * bflo(raw.y); a[3] += w[j][3] * bfhi(raw.y);
                            a[4] += w[j][4] * bflo(raw.z); a[5] += w[j][5] * bfhi(raw.z); a[6] += w[j][6] * bflo(raw.w); a[7] += w[j][7] * bfhi(raw.w); } }
#pragma unroll
                    for (int e = 0; e < 8; ++e) a[e] = silu_f(a[e]);
                    if (cg < 8) {
#pragma unroll
                        for (int e = 0; e < 8; ++e) Xt[(cg * 8 + e) * LDP + l] = (bf16)f2bf(a[e]);
                    } else {
                        v4u o; o.x = pk2(a[0], a[1]); o.y = pk2(a[2], a[3]); o.z = pk2(a[4], a[5]); o.w = pk2(a[6], a[7]);
                        if (cg < 24) { const int n0 = (cg - 8) * 8; *(LAS v4u*)(Bsn + l * LDP + n0) = o; const float we = wend[l];
#pragma unroll
                            for (int e = 0; e < 8; ++e) Bnl[(n0 + e) * LDP + l] = (bf16)f2bf(a[e] * we);
                        } else { const int n0 = (cg - 24) * 8; *(LAS v4u*)(Cln + l * LDP + n0) = o;
                            if ((h & 3) == 0) *(v4u*)(CC + (size_t)(t0 + l) * 256 + grp * 128 + n0) = o; }
                    }
                }
            }
        }
        __syncthreads();
        if (F.wave < 4) {
            const int pt = F.wave >> 1;
#pragma unroll 1
            for (int q = 0; q < 2; ++q) {
                const int lt = (F.wave & 1) ? (1 + q) : (3 * q);
                f32x16 yacc;
#pragma unroll
                for (int i = 0; i < 16; ++i) yacc[i] = 0.f;
                const float al = acum2[32 * lt + r];
                for (int st = 0; st <= lt; ++st) {
                    f32x16 macc;
#pragma unroll
                    for (int i = 0; i < 16; ++i) macc[i] = 0.f;
#pragma unroll
                    for (int kk = 0; kk < 8; ++kk) {
                        const bf16x8 a = *(const LAS bf16x8*)(Bsn + (32 * st + r) * LDP + 16 * kk + 8 * hh);
                        const bf16x8 bb = *(const LAS bf16x8*)(Cln + (32 * lt + r) * LDP + 16 * kk + 8 * hh);
                        macc = MFMA32(a, bb, macc);
                    }
#pragma unroll
                    for (int i = 0; i < 16; ++i) { const int sl = crow(i, hh);
                        float f = exp2f(al + wv[32 * st + sl]);
                        if (st == lt && sl > r) f = 0.f;
                        macc[i] *= f; }
#pragma unroll
                    for (int sg = 0; sg < 2; ++sg) {
                        const bf16x8 bfrag = pack8(macc, sg);
                        const LAS bf16* xb = Xt + (32 * pt + r) * LDP + 32 * st + 16 * sg + 4 * hh;
                        const s16x4 lo = *(const LAS s16x4*)(xb), hi = *(const LAS s16x4*)(xb + 8);
                        const bf16x8 afrag = __builtin_shufflevector(lo, hi, 0, 1, 2, 3, 4, 5, 6, 7);
                        yacc = MFMA32(afrag, bfrag, yacc);
                    }
                }
#pragma unroll
                for (int i = 0; i < 16; ++i) { const int p = 32 * pt + crow(i, hh);
                    const float y = yacc[i] + Dh * bf2f(Xt[p * LDP + 32 * lt + r]);
                    YPF[((((size_t)u * 4 + lt) * 2 + pt) * 16 + i) * 64 + lane] = y; }
            }
        } else {
            const int nt = F.wave - 4;
#pragma unroll 1
            for (int pt = 0; pt < 2; ++pt) {
                f32x16 sacc;
#pragma unroll
                for (int i = 0; i < 16; ++i) sacc[i] = 0.f;
#pragma unroll
                for (int kk = 0; kk < 8; ++kk) {
                    const bf16x8 a = *(const LAS bf16x8*)(Xt + (32 * pt + r) * LDP + 16 * kk + 8 * hh);
                    const bf16x8 bb = *(const LAS bf16x8*)(Bnl + (32 * nt + r) * LDP + 16 * kk + 8 * hh);
                    sacc = MFMA32(a, bb, sacc);
                }
#pragma unroll
                for (int i = 0; i < 16; ++i) ST[((size_t)u * 64 + 32 * pt + crow(i, hh)) * 128 + 32 * nt + r] = sacc[i];
            }
        }
        __syncthreads();
    }
}
__device__ __forceinline__ void ssd_s2(Frame& F, const Ptrs& P) {
    const float* ST = (const float*)(P.ws + WS_ST); const float* CDEC = (const float*)(P.ws + WS_CDEC); unsigned* PREV = (unsigned*)(P.ws + WS_PREV);
    for (int g = F.vcu * 512 + (F.wave * 64 + lane_id()); g < 131072; g += F.G * 512) {
        const int n2 = g & 63, p = (g >> 6) & 63, h = (g >> 12) & 7, b = g >> 15;
        float2 st[32];
#pragma unroll
        for (int c = 0; c < 32; ++c) st[c] = *(const float2*)(ST + ((size_t)(((b * 32 + c) * 8 + h) * 64 + p)) * 128 + 2 * n2);
        float r0 = 0.f, r1 = 0.f;
#pragma unroll
        for (int c = 0; c < 32; ++c) { const size_t u = (size_t)((b * 32 + c) * 8 + h);
            PREV[((u * 64 + p) * 128 + 2 * n2) >> 1] = pk2(r0, r1);
            const float d = CDEC[u]; r0 = r0 * d + st[c].x; r1 = r1 * d + st[c].y; }
    }
}
__device__ __forceinline__ void ssd_s3_plain(Frame& F, const Ptrs& P) {
    const bf16* CC = (const bf16*)(P.ws + WS_CC); const bf16* PREV = (const bf16*)(P.ws + WS_PREV); const float* EA = (const float*)(P.ws + WS_EA);
    const float* YPF = (const float*)((const char*)P.out + DO_YPF); float* Y = (float*)((char*)P.out + DO_YPLAIN);
    const int lane = lane_id(), r = lane & 31, hh = lane >> 5, h = F.wave, grp = h >> 2;
    for (int v = F.vcu; v < 512; v += F.G) {
        const int lt = v & 3, c = (v >> 2) & 31, b = v >> 7;
        const int t = b * SEQ + c * 128 + lt * 32 + r; const size_t u = (size_t)((b * 32 + c) * 8 + h);
        f32x16 acc[2];
#pragma unroll
        for (int i = 0; i < 16; ++i) { acc[0][i] = 0.f; acc[1][i] = 0.f; }
#pragma unroll
        for (int kk = 0; kk < 8; ++kk) {
            const bf16x8 bb = *(const bf16x8*)(CC + (size_t)t * 256 + grp * 128 + 16 * kk + 8 * hh);
#pragma unroll
            for (int pt = 0; pt < 2; ++pt) { const bf16x8 a = *(const bf16x8*)(PREV + (u * 64 + 32 * pt + r) * 128 + 16 * kk + 8 * hh); acc[pt] = MFMA32(a, bb, acc[pt]); }
        }
        const float ea = EA[(size_t)t * 8 + h];
#pragma unroll
        for (int pt = 0; pt < 2; ++pt)
#pragma unroll
            for (int i = 0; i < 16; ++i) { const int p = 32 * pt + crow(i, hh);
                Y[(size_t)t * 512 + h * 64 + p] = acc[pt][i] * ea + YPF[((((size_t)u * 4 + lt) * 2 + pt) * 16 + i) * 64 + lane]; }
    }
}

__device__ __forceinline__ float gelu_erf(float v) { return 0.5f * v * (1.f + erff(v * 0.70710678118654752f)); }
typedef float f32x2v __attribute__((ext_vector_type(2)));
#define CVT8(W, LO) __builtin_amdgcn_cvt_pk_f32_fp8((int)(W), LO)
__device__ __forceinline__ float dot16_fp8(const v4u& q, const float (&h)[16]) {
    float s = 0.f; f32x2v t;
    t = CVT8(q.x, false); s = fmaf(t.x, h[0], s); s = fmaf(t.y, h[1], s); t = CVT8(q.x, true); s = fmaf(t.x, h[2], s); s = fmaf(t.y, h[3], s);
    t = CVT8(q.y, false); s = fmaf(t.x, h[4], s); s = fmaf(t.y, h[5], s); t = CVT8(q.y, true); s = fmaf(t.x, h[6], s); s = fmaf(t.y, h[7], s);
    t = CVT8(q.z, false); s = fmaf(t.x, h[8], s); s = fmaf(t.y, h[9], s); t = CVT8(q.z, true); s = fmaf(t.x, h[10], s); s = fmaf(t.y, h[11], s);
    t = CVT8(q.w, false); s = fmaf(t.x, h[12], s); s = fmaf(t.y, h[13], s); t = CVT8(q.w, true); s = fmaf(t.x, h[14], s); s = fmaf(t.y, h[15], s);
    return s;
}
__device__ __forceinline__ void fma16_fp8(float (&acc)[16], float a, const v4u& q) {
    f32x2v t;
    t = CVT8(q.x, false); acc[0] = fmaf(a, t.x, acc[0]); acc[1] = fmaf(a, t.y, acc[1]); t = CVT8(q.x, true); acc[2] = fmaf(a, t.x, acc[2]); acc[3] = fmaf(a, t.y, acc[3]);
    t = CVT8(q.y, false); acc[4] = fmaf(a, t.x, acc[4]); acc[5] = fmaf(a, t.y, acc[5]); t = CVT8(q.y, true); acc[6] = fmaf(a, t.x, acc[6]); acc[7] = fmaf(a, t.y, acc[7]);
    t = CVT8(q.z, false); acc[8] = fmaf(a, t.x, acc[8]); acc[9] = fmaf(a, t.y, acc[9]); t = CVT8(q.z, true); acc[10] = fmaf(a, t.x, acc[10]); acc[11] = fmaf(a, t.y, acc[11]);
    t = CVT8(q.w, false); acc[12] = fmaf(a, t.x, acc[12]); acc[13] = fmaf(a, t.y, acc[13]); t = CVT8(q.w, true); acc[14] = fmaf(a, t.x, acc[14]); acc[15] = fmaf(a, t.y, acc[15]);
}
constexpr int PE_D = 16;
__device__ __forceinline__ void peer_eval(Frame& F, const Ptrs& P) {
    const bf16* HB = (const bf16*)(P.ws + WS_ST); const v4u* ED = (const v4u*)(P.ws + WS_ED); const v4u* EU = (const v4u*)(P.ws + WS_EU);
    const float* SCD = (const float*)(P.ws + WS_SMALL); const float* SCU = SCD + 16384;
    const int* IDX = (const int*)(P.ws + WS_IDX); const float* GATE = (const float*)(P.ws + WS_GATE);
    LAS float* RM = (LAS float*)(F.lds + RING_OFF) + F.wave * 2112;
    const int lane = lane_id();
    for (int t = F.vcu * NWAVES + F.wave; t < T_; t += F.G * NWAVES) {
        float hv[16];
        { const v4u h0 = ((const v4u*)(HB + (size_t)t * DM))[2 * lane], h1 = ((const v4u*)(HB + (size_t)t * DM))[2 * lane + 1];
          hv[0] = bflo(h0.x); hv[1] = bfhi(h0.x); hv[2] = bflo(h0.y); hv[3] = bfhi(h0.y); hv[4] = bflo(h0.z); hv[5] = bfhi(h0.z); hv[6] = bflo(h0.w); hv[7] = bfhi(h0.w);
          hv[8] = bflo(h1.x); hv[9] = bfhi(h1.x); hv[10] = bflo(h1.y); hv[11] = bfhi(h1.y); hv[12] = bflo(h1.z); hv[13] = bfhi(h1.z); hv[14] = bflo(h1.w); hv[15] = bfhi(h1.w); }
        float ssq = 0.f;
#pragma unroll
        for (int i = 0; i < 16; ++i) ssq = fmaf(hv[i], hv[i], ssq);
        const float rstd = rsqrtf(wave_sum(ssq) * (1.f / 1024.f) + EPS);
        const int idx_lo = IDX[(size_t)t * 128 + lane], idx_hi = IDX[(size_t)t * 128 + 64 + lane];
        const float g_lo = GATE[(size_t)t * 128 + lane], g_hi = GATE[(size_t)t * 128 + 64 + lane];
        const float sd_lo = SCD[idx_lo] * rstd, sd_hi = SCD[idx_hi] * rstd, su_lo = SCU[idx_lo], su_hi = SCU[idx_hi];
        float actg[4] = {0.f, 0.f, 0.f, 0.f};
#pragma unroll
        for (int gq = 0; gq < 4; ++gq) {
            const int idxv = (gq >> 1) ? idx_hi : idx_lo; const int lb = 32 * (gq & 1);
            v4u ra[PE_D]; float part[32];
#pragma unroll
            for (int j = 0; j < PE_D; ++j) { const int id = __builtin_amdgcn_readlane(idxv, lb + j); ra[j] = ED[(size_t)id * 64 + lane]; }
#pragma unroll
            for (int j = 0; j < 32; ++j) {
                part[j] = dot16_fp8(ra[j % PE_D], hv); asm volatile("" : "+v"(part[j]));
                if (j + PE_D < 32) { const int id = __builtin_amdgcn_readlane(idxv, lb + j + PE_D); ra[j % PE_D] = ED[(size_t)id * 64 + lane]; }
                __builtin_amdgcn_sched_barrier(0);
            }
#pragma unroll
            for (int j = 0; j < 32; ++j) RM[j * 65 + lane] = part[j];
            float pre = 0.f;
            { const int row = lane & 31, cb = lane & 32;
#pragma unroll
              for (int k = 0; k < 32; ++k) pre += RM[row * 65 + cb + k]; }
            pre = sum_halves(pre);
            const int srcl = (lb + (lane & 31)) * 4;
            const float gv = __int_as_float(__builtin_amdgcn_ds_bpermute(srcl, __float_as_int((gq >> 1) ? g_hi : g_lo)));
            const float sdv = __int_as_float(__builtin_amdgcn_ds_bpermute(srcl, __float_as_int((gq >> 1) ? sd_hi : sd_lo)));
            const float suv = __int_as_float(__builtin_amdgcn_ds_bpermute(srcl, __float_as_int((gq >> 1) ? su_hi : su_lo)));
            actg[gq] = gelu_erf(pre * sdv) * gv * suv;
            asm volatile("" ::: "memory");
        }
        float acc[16];
#pragma unroll
        for (int i = 0; i < 16; ++i) acc[i] = 0.f;
#pragma unroll
        for (int gq = 0; gq < 4; ++gq) {
            const int idxv = (gq >> 1) ? idx_hi : idx_lo; const int lb = 32 * (gq & 1); const float actv = actg[gq];
            v4u ra[PE_D];
#pragma unroll
            for (int j = 0; j < PE_D; ++j) { const int id = __builtin_amdgcn_readlane(idxv, lb + j); ra[j] = EU[(size_t)id * 64 + lane]; }
#pragma unroll
            for (int j = 0; j < 32; ++j) {
                const float a = __uint_as_float(__builtin_amdgcn_readlane(__float_as_uint(actv), j));
                fma16_fp8(acc, a, ra[j % PE_D]);
                asm volatile("" : "+v"(acc[0]), "+v"(acc[1]), "+v"(acc[2]), "+v"(acc[3]), "+v"(acc[4]), "+v"(acc[5]), "+v"(acc[6]), "+v"(acc[7]), "+v"(acc[8]), "+v"(acc[9]), "+v"(acc[10]), "+v"(acc[11]), "+v"(acc[12]), "+v"(acc[13]), "+v"(acc[14]), "+v"(acc[15]));
                if (j + PE_D < 32) { const int id = __builtin_amdgcn_readlane(idxv, lb + j + PE_D); ra[j % PE_D] = EU[(size_t)id * 64 + lane]; }
                __builtin_amdgcn_sched_barrier(0);
            }
        }
        float s2 = 0.f;
#pragma unroll
        for (int i = 0; i < 16; ++i) { acc[i] += hv[i]; s2 = fmaf(acc[i], acc[i], s2); }
        const float r2 = rsqrtf(wave_sum(s2) * (1.f / 1024.f) + EPS);
        const float4* wf = (const float4*)(P.norm_final) + 4 * lane; float4* o = (float4*)(P.out + (size_t)t * DM) + 4 * lane;
#pragma unroll
        for (int q = 0; q < 4; ++q) { const float4 w = wf[q]; o[q] = make_float4(acc[4 * q] * r2 * w.x, acc[4 * q + 1] * r2 * w.y, acc[4 * q + 2] * r2 * w.z, acc[4 * q + 3] * r2 * w.w); }
    }
}
constexpr int TK_LDK = 136, TK_K2 = 34816, TK_SCR = 69632, TK_SP = 49;
__device__ __forceinline__ int mono_key(float x) { const int b = __float_as_int(x); return b ^ ((b >> 31) & 0x7fffffff); }
__device__ __forceinline__ float unmono(int m) { return __int_as_float(m ^ ((m >> 31) & 0x7fffffff)); }
__device__ __forceinline__ int max3i(int a, int b, int c) { return max(max(a, b), c); }
__device__ __forceinline__ void topk_phase(Frame& F, const Ptrs& P) {
    const bf16* Q = (const bf16*)(P.ws + WS_PROJ); const float* SSQ = (const float*)(P.ws + WS_SSQ);
    int* IDX = (int*)(P.ws + WS_IDX); float* GATE = (float*)(P.ws + WS_GATE);
    LAS unsigned char* L = F.lds + RING_OFF;
    LAS bf16* K1 = (LAS bf16*)L; LAS bf16* K2 = (LAS bf16*)(L + TK_K2);
    const int tid_ = (F.wave * 64 + lane_id());
    for (int i = tid_; i < 16384; i += 512) { const int n = i >> 7, k = i & 127; K1[n * TK_LDK + k] = (bf16)f2bf(P.sk1[i]); K2[n * TK_LDK + k] = (bf16)f2bf(P.sk2[i]); }
    __syncthreads();
    const int lane = tid_ & 63, r = lane & 31, hh = lane >> 5;
    LAS int* scr = (LAS int*)(L + TK_SCR) + F.wave * (32 * TK_SP) + r * TK_SP;
    for (int wq = F.vcu * NWAVES + F.wave; wq < 2048; wq += F.G * NWAVES) {
        const int t = (wq >> 2) * 32 + r;
        float rstd;
        { const float4* sp = (const float4*)(SSQ + (size_t)t * 16); const float4 a = sp[0], b = sp[1], c = sp[2], d = sp[3];
          rstd = rsqrtf(((a.x + a.y + a.z + a.w) + (b.x + b.y + b.z + b.w) + (c.x + c.y + c.z + c.w) + (d.x + d.y + d.z + d.w)) * (1.f / 1024.f) + EPS); }
#pragma unroll 1
        for (int hq = 0; hq < 2; ++hq) {
            const int hd = (wq & 3) * 2 + hq;
#pragma unroll 1
            for (int half = 0; half < 2; ++half) {
                const LAS bf16* Kh = half ? K2 : K1;
                bf16x8 qf[8];
#pragma unroll
                for (int kk = 0; kk < 8; ++kk) qf[kk] = *(const bf16x8*)(Q + (size_t)t * 2048 + hd * 256 + half * 128 + 16 * kk + 8 * hh);
                int key[64];
#pragma unroll
                for (int nt = 0; nt < 4; ++nt) {
                    f32x16 sc;
#pragma unroll
                    for (int i = 0; i < 16; ++i) sc[i] = 0.f;
#pragma unroll
                    for (int kk = 0; kk < 8; ++kk) { const bf16x8 a = *(const LAS bf16x8*)(Kh + (32 * nt + r) * TK_LDK + 16 * kk + 8 * hh); sc = MFMA32(a, qf[kk], sc); }
#pragma unroll
                    for (int i = 0; i < 16; ++i) key[nt * 16 + i] = (mono_key(sc[i]) & ~127) | (127 - (32 * nt + crow(i, hh)));
                }
#pragma unroll 1
                for (int rd = 0; rd < 16; ++rd) {
                    int m0 = max3i(key[0], key[1], key[2]), m1 = max3i(key[3], key[4], key[5]);
#pragma unroll
                    for (int i = 6; i < 60; i += 6) { m0 = max3i(m0, key[i], key[i + 1]); m1 = max3i(m1, key[i + 2], key[i + 3]); m0 = max3i(m0, key[i + 4], key[i + 5]); }
                    m0 = max3i(m0, key[60], key[61]); m1 = max3i(m1, key[62], key[63]);
                    const int lm = max(m0, m1);
                    const int g = imax_halves(lm);
                    if (hh == 0) scr[half * 16 + rd] = g;
#pragma unroll
                    for (int i = 0; i < 64; ++i) key[i] = (key[i] == g) ? (int)0x80000000 : key[i];
                }
            }
            const LAS int* la = scr + hh * 16; const LAS int* lb = scr + (1 - hh) * 16;
            float va[4], vb[16];
#pragma unroll
            for (int i = 0; i < 4; ++i) va[i] = unmono(la[i] & ~127);
#pragma unroll
            for (int j = 0; j < 16; ++j) vb[j] = unmono(lb[j] & ~127);
            int ck[27];
            {
                int q = 0;
#pragma unroll
                for (int i = 0; i < 4; ++i)
#pragma unroll
                    for (int j = i; j < 16; ++j) if ((i + 1) * (j + 1) <= 16) {
                        const int pos = hh ? (j * 16 + i) : (i * 16 + j);
                        int k = (mono_key(va[i] + vb[j]) & ~255) | (255 - pos);
                        if (i == j && hh) k = (int)0x80000000;
                        ck[q++] = k; }
            }
#pragma unroll 1
            for (int rd = 0; rd < 16; ++rd) {
                int m0 = max3i(ck[0], ck[1], ck[2]);
#pragma unroll
                for (int i = 3; i < 27; i += 2) m0 = max3i(m0, ck[i], ck[i + 1]);
                const int g = imax_halves(m0);
                if (hh == 0) scr[32 + rd] = g;
#pragma unroll
                for (int i = 0; i < 27; ++i) ck[i] = (ck[i] == g) ? (int)0x80000000 : ck[i];
            }
            const float vmax = unmono(scr[32] & ~255) * rstd;
            float ev[8]; int id[8]; float esum = 0.f;
#pragma unroll
            for (int q = 0; q < 8; ++q) { const int wk = scr[32 + hh * 8 + q]; const int pos = 255 - (wk & 255);
                const int n1 = 127 - (scr[pos >> 4] & 127), n2 = 127 - (scr[16 + (pos & 15)] & 127);
                id[q] = n1 * 128 + n2;
                ev[q] = exp2f((unmono(wk & ~255) * rstd - vmax) * LOG2E); esum += ev[q]; }
            esum = sum_halves(esum);
            const float inv = 1.f / esum;
            int4* ip = (int4*)(IDX + ((size_t)t * 8 + hd) * 16 + hh * 8); float4* gp = (float4*)(GATE + ((size_t)t * 8 + hd) * 16 + hh * 8);
            ip[0] = make_int4(id[0], id[1], id[2], id[3]); ip[1] = make_int4(id[4], id[5], id[6], id[7]);
            gp[0] = make_float4(ev[0] * inv, ev[1] * inv, ev[2] * inv, ev[3] * inv); gp[1] = make_float4(ev[4] * inv, ev[5] * inv, ev[6] * inv, ev[7] * inv);
        }
    }
    __syncthreads();
}

constexpr int AT_KP = 72, AT_VP = 264;
constexpr int AT_K = 0, AT_VT = 36864, AT_BT = 36864 + 33792;
__device__ __forceinline__ void attn_phase(Frame& F, const Ptrs& P) {
    const bf16* PROJ = (const bf16*)(P.ws + WS_PROJ); bf16* CAT = (bf16*)(P.ws + WS_XN);
    LAS unsigned char* L = F.lds + RING_OFF;
    LAS bf16* Ks = (LAS bf16*)(L + AT_K); LAS bf16* Vt = (LAS bf16*)(L + AT_VT); LAS float* btab = (LAS float*)(L + AT_BT);
    const int lane = lane_id(), tid_ = F.wave * 64 + lane, r = lane & 31, hh = lane >> 5;
    for (int u = F.vcu; u < 256; u += F.G) {
        const int hkv = u & 1, n = (u >> 1) & 31, b = u >> 6;
        const int trow0 = b * SEQ + n * 128;
        for (int i = tid_; i < 2048; i += 512) {
            const int kj = i >> 3, ch = i & 7; const bool ok = (n > 0) || (kj >= 128);
            v4u kv = {0u, 0u, 0u, 0u}, vv = {0u, 0u, 0u, 0u};
            if (ok) { const bf16* rowp = PROJ + (size_t)(trow0 - 128 + kj) * NPROJ + hkv * 64 + ch * 8; kv = *(const v4u*)(rowp + PJ_K); vv = *(const v4u*)(rowp + PJ_V); }
            *(LAS v4u*)(Ks + kj * AT_KP + ch * 8) = kv;
            LAS bf16* vp = Vt + (ch * 8) * AT_VP + kj;
            vp[0] = (bf16)(vv.x & 0xffffu); vp[AT_VP] = (bf16)(vv.x >> 16); vp[2 * AT_VP] = (bf16)(vv.y & 0xffffu); vp[3 * AT_VP] = (bf16)(vv.y >> 16);
            vp[4 * AT_VP] = (bf16)(vv.z & 0xffffu); vp[5 * AT_VP] = (bf16)(vv.z >> 16); vp[6 * AT_VP] = (bf16)(vv.w & 0xffffu); vp[7 * AT_VP] = (bf16)(vv.w >> 16);
        }
        for (int i = tid_; i < 768; i += 512) { const int gg = i / 192, dist = i % 192 - 32;
            btab[i] = (dist >= 0 && dist < 128) ? P.rel_bias[c_bucket[dist & 127] * 8 + hkv * 4 + gg] * LOG2E : 0.f; }
        __syncthreads();
        const int g = F.wave & 3, h = hkv * 4 + g;
        const float sink2 = P.sinks[h] * LOG2E;
#pragma unroll 1
        for (int qq = 0; qq < 2; ++qq) {
            const int qt = (F.wave >> 2) * 2 + qq, t = trow0 + 32 * qt + r;
            bf16x8 qf[4];
#pragma unroll
            for (int kk = 0; kk < 4; ++kk) qf[kk] = *(const bf16x8*)(PROJ + (size_t)t * NPROJ + h * 64 + 16 * kk + 8 * hh);
            f32x16 sc[5];
#pragma unroll
            for (int j = 0; j < 5; ++j) {
#pragma unroll
                for (int i = 0; i < 16; ++i) sc[j][i] = 0.f;
#pragma unroll
                for (int kk = 0; kk < 4; ++kk) { const bf16x8 a = *(const LAS bf16x8*)(Ks + (32 * (qt + j) + r) * AT_KP + 16 * kk + 8 * hh); sc[j] = MFMA32(a, qf[kk], sc[j]); }
            }
            float m = sink2;
            const LAS float* bt = btab + g * 192 + 160 + r - 4 * hh;
#pragma unroll
            for (int j = 0; j < 5; ++j) {
                const bool tile_ok = (n > 0) || (qt + j >= 4);
#pragma unroll
                for (int i = 0; i < 16; ++i) { const int dist = 128 + r - (32 * j + crow(i, hh));
                    const bool ok = tile_ok && (j == 0 ? dist < 128 : (j == 4 ? dist >= 0 : true));
                    const float s = sc[j][i] * (0.125f * LOG2E) + bt[-(32 * j + (i & 3) + 8 * (i >> 2))];
                    sc[j][i] = ok ? s : -INFINITY; m = fmaxf(m, sc[j][i]); }
            }
            m = max_halves(m);
            float l = 0.f;
#pragma unroll
            for (int j = 0; j < 5; ++j)
#pragma unroll
                for (int i = 0; i < 16; ++i) { sc[j][i] = exp2f(sc[j][i] - m); l += sc[j][i]; }
            l = sum_halves(l);
            l += exp2f(sink2 - m);
            const float inv = 1.f / l;
            f32x16 o[2];
#pragma unroll
            for (int i = 0; i < 16; ++i) { o[0][i] = 0.f; o[1][i] = 0.f; }
#pragma unroll
            for (int j = 0; j < 5; ++j)
#pragma unroll
                for (int sg = 0; sg < 2; ++sg) {
                    const bf16x8 pf = pack8(sc[j], sg);
#pragma unroll
                    for (int dt = 0; dt < 2; ++dt) {
                        const LAS bf16* vb = Vt + (32 * dt + r) * AT_VP + 32 * (qt + j) + 16 * sg + 4 * hh;
                        const s16x4 lo = *(const LAS s16x4*)(vb), hi = *(const LAS s16x4*)(vb + 8);
                        o[dt] = MFMA32(__builtin_shufflevector(lo, hi, 0, 1, 2, 3, 4, 5, 6, 7), pf, o[dt]);
                    }
                }
            bf16* op = CAT + (size_t)t * DM + h * 64 + 4 * hh;
#pragma unroll
            for (int dt = 0; dt < 2; ++dt)
#pragma unroll
                for (int g4 = 0; g4 < 4; ++g4)
                    *(unsigned long long*)(op + 32 * dt + 8 * g4) = (unsigned long long)cvtpk(o[dt][4 * g4] * inv, o[dt][4 * g4 + 1] * inv) | ((unsigned long long)cvtpk(o[dt][4 * g4 + 2] * inv, o[dt][4 * g4 + 3] * inv) << 32);
        }
        __syncthreads();
    }
}
struct Args { Ptrs p; };
__global__ void __launch_bounds__(NWAVES * 64, 2) hymba_fwd(Args args) {
    extern __shared__ __attribute__((aligned(16))) unsigned char lds[];
    const Ptrs& P = args.p;
    Frame F;
    F.lds = (LAS unsigned char*)lds;
    F.MISC = (volatile LAS unsigned*)(F.lds + MISC_OFF);
    F.wave = __builtin_amdgcn_readfirstlane(threadIdx.x >> 6);
    F.G = gridDim.x; { const int bx = blockIdx.x; F.vcu = (F.G % 8 == 0) ? (bx % 8) * (F.G / 8) + bx / 8 : bx; }
    F.ctl = (gu32*)(P.ws + WS_CTL);
    for (int u = threadIdx.x; u < (LDS_BYTES - LDSCTL_OFF) / 4; u += NWAVES * 64) ((LAS unsigned*)(F.lds + LDSCTL_OFF))[u] = 0u;
    __syncthreads();
    XcdBarrier bar = xcd_barrier_post((unsigned*)(F.ctl + CW_BAR), F.MISC + 8);
#define GRID_BAR() xcd_barrier(bar)

    bf16* XN = (bf16*)(P.ws + WS_XN); bf16* PROJ = (bf16*)(P.ws + WS_PROJ); bf16* HB = (bf16*)(P.ws + WS_ST);
    p0_prologue(F, P);
    GRID_BAR();
    { pg8::Gemm g{XN, (const bf16*)(P.ws + WS_WIN), T_, NPROJ, DM, F.wave}; pg8::StaticOrder S; S.init(T_, NPROJ, F.G, (int)blockIdx.x);
      pg8::EpiBf16<0> E{PROJ, NPROJ, nullptr, 0, 0, 1.f};
      pg8::gemm_phase<pg8::EpiBf16<0>, pg8::StaticOrder, PG8_ALIGN, PG8_SP2>(F.lds + RING_OFF, g, S, E); }
    GRID_BAR();
    ssd_s1(F, P);
    attn_phase(F, P);
    GRID_BAR();
    ssd_s2(F, P);
    GRID_BAR();
    ssd_s3_plain(F, P);
    GRID_BAR();
    gate_norm_naive(F, P);
    GRID_BAR();
    { pg8::Gemm g{XN, (const bf16*)(P.ws + WS_WOUT), T_, DM, DM, F.wave}; pg8::StaticOrder S; S.init(T_, DM, F.G, (int)blockIdx.x);
      EpiResH E{P.x, HB, (float*)(P.ws + WS_SSQ)};
      pg8::gemm_phase<EpiResH, pg8::StaticOrder, PG8_ALIGN, PG8_SP2>(F.lds + RING_OFF, g, S, E); }
    GRID_BAR();
    { pg8::Gemm g{HB, (const bf16*)(P.ws + WS_WQ), T_, 2048, DM, F.wave}; pg8::StaticOrder S; S.init(T_, 2048, F.G, (int)blockIdx.x);
      pg8::EpiBf16<0> E{PROJ, 2048, nullptr, 0, 0, 1.f};
      pg8::gemm_phase<pg8::EpiBf16<0>, pg8::StaticOrder, PG8_ALIGN, PG8_SP2>(F.lds + RING_OFF, g, S, E); }
    GRID_BAR();
    topk_phase(F, P);
    GRID_BAR();
    peer_eval(F, P);
}

extern "C" void kernel_launch(void* const* d_in, const int* in_sizes, int n_in, void* d_out, int out_size, void* d_ws, size_t ws_size, hipStream_t stream) {
    static int grid = 0;
    if (grid == 0) {
        if (n_in != 19 || out_size != T_ * DM || ws_size < WS_END) { fprintf(stderr, "kernel_launch: unexpected shapes (n_in %d, out %d, ws %zu)\n", n_in, out_size, ws_size); grid = -1; return; }
        int dev = 0, cus = 0, per_cu = 0;
        if (hipGetDevice(&dev) != hipSuccess || hipDeviceGetAttribute(&cus, hipDeviceAttributeMultiprocessorCount, dev) != hipSuccess) { grid = -1; return; }
        if (hipFuncSetAttribute((const void*)hymba_fwd, hipFuncAttributeMaxDynamicSharedMemorySize, LDS_BYTES) != hipSuccess) { fprintf(stderr, "kernel_launch: hipFuncSetAttribute failed\n"); grid = -1; return; }
        if (hipOccupancyMaxActiveBlocksPerMultiprocessor(&per_cu, (const void*)hymba_fwd, NWAVES * 64, LDS_BYTES) != hipSuccess || per_cu < 1) { fprintf(stderr, "kernel_launch: occupancy query says %d blocks per CU\n", per_cu); grid = -1; (void)hipGetLastError(); return; }
        grid = cus;
    }
    if (grid < 0) return;
    (void)hipMemsetAsync((char*)d_ws + WS_CTL, 0, CTL_ZERO_BYTES, stream);
    Args a{};
    const float** pp = (const float**)&a.p;
    for (int i = 0; i < 19; ++i) pp[i] = (const float*)d_in[i];
    a.p.out = (float*)d_out; a.p.ws = (unsigned char*)d_ws;
    hipLaunchKernelGGL(hymba_fwd, dim3(grid), dim3(NWAVES * 64), LDS_BYTES, stream, a);
}
```

```cpp
#include <hip/hip_runtime.h>
#include <cstdio>
#include <cstdint>
#include <math.h>
namespace pg8 {
#define PG8_LAS __attribute__((address_space(3)))
typedef unsigned short bf16_t;
typedef short bf16x8 __attribute__((ext_vector_type(8)));
typedef float f32x4 __attribute__((ext_vector_type(4)));
typedef unsigned u32x4 __attribute__((ext_vector_type(4)));
constexpr int BM = 256, BK = 64, HALF = 128, HTB = HALF * BK * 2  , STAGE_BYTES = 8 * HTB, NXCD = 8, WGM = 8;

__host__ __device__ __forceinline__ int lds_byte(int r, int c) { const int st = (r >> 4) * 2 + (c >> 5), rr = r & 15, cc = c & 31, ob = rr * 64 + cc * 2; return st * 1024 + (ob ^ (((ob >> 9) & 1) << 5)); }
__host__ __device__ __forceinline__ void stage_rc(int b, int& R, int& C) { const int st = b / 1024, sb = b % 1024, swz = sb ^ (((sb >> 9) & 1) << 5); R = (st >> 1) * 16 + swz / 64; C = (st & 1) * 32 + (swz % 64) / 2; }
__host__ __device__ __forceinline__ int perm32(int rho) { const int n = rho >> 4, i = rho & 15; return 8 * (i >> 2) + 4 * n + (i & 3); }

struct Unit { int pm, pn; };
struct Gemm { const bf16_t* A; const bf16_t* Bt; int M, N, K, wave; };

struct StaticOrder {
    int nM, nN, nwg, G, c;
    __host__ __device__ void init(int M, int N, int G_, int c_) { nM = M / BM; nN = N / BM; nwg = nM * nN; G = G_; c = c_; }
    __host__ __device__ bool next(int i, Unit& u) const {
        const long L = (long)i * G + c; if (L >= nwg) return false;
        int wgid = (int)L; { const int q = nwg / NXCD, r = nwg % NXCD, xcd = wgid % NXCD, off = wgid / NXCD; wgid = (xcd < r ? xcd * (q + 1) : r * (q + 1) + (xcd - r) * q) + off; }
        const int nig = WGM * nN, gid = wgid / nig, fm = gid * WGM, gsz = (nM - fm) < WGM ? (nM - fm) : WGM;
        u.pm = fm + ((wgid % nig) % gsz); u.pn = (wgid % nig) / gsz; return true;
    }
    __device__ __forceinline__ void a_ready(const Unit&) const {}
    __device__ __forceinline__ void done(const Unit&) const {}
};

__device__ __forceinline__ unsigned cvt_pk_bf16(float lo, float hi) { unsigned r; asm volatile("v_cvt_pk_bf16_f32 %0, %1, %2" : "=v"(r) : "v"(lo), "v"(hi)); return r; }
typedef float f32x2 __attribute__((ext_vector_type(2)));
__device__ __forceinline__ f32x2 gelu_pk(f32x2 v) {
    const f32x2 av = __builtin_elementwise_abs(v), d = av * 0.2316418882f + 1.0f;
    f32x2 t; t.x = __builtin_amdgcn_rcpf(d.x); t.y = __builtin_amdgcn_rcpf(d.y);
    f32x2 q = t * 0.5307027145f + (-0.7265760135f); q = q * t + 0.7107068705f; q = q * t + (-0.142248368f); q = q * t + 0.127414796f; q = q * t;
    const f32x2 s = (v * v) * (-0.72134752044f);
    f32x2 e; e.x = __builtin_amdgcn_exp2f(s.x); e.y = __builtin_amdgcn_exp2f(s.y);
    const f32x2 m = v * (q * e), r = v - m;
    f32x2 o; o.x = v.x < 0.f ? m.x : r.x; o.y = v.y < 0.f ? m.y : r.y; return o;
}

template <int ACT  > struct EpiBf16 {
    static constexpr bool PERM = true, AFTER_DRAIN = false; static_assert(ACT == 0 || ACT == 1, "EpiBf16: ACT is 0 (none) or 1 (gelu_pk)");
    bf16_t* O; int ldc; const float* bias; int split_cols; size_t split_stride; float scale0;
    __device__ __forceinline__ void operator()(const f32x4 (&acc)[2][2][4][2], const Unit& u, int wr, int wc, int fr, int fq) const {
        const int row0 = u.pm * BM + wr * 64 + fr; int colt = u.pn * BM; bf16_t* base = O;
        float sc = 1.f; if (split_cols) { const int t = colt / split_cols; base += (size_t)t * split_stride; colt -= t * split_cols; if (t == 0) sc = scale0; }
        const int col0 = colt + wc * 32 + 8 * fq, bcol0 = u.pn * BM + wc * 32 + 8 * fq;
        f32x4 bv[2][2];
#pragma unroll
        for (int bj = 0; bj < 2; ++bj)
#pragma unroll
            for (int n = 0; n < 2; ++n) bv[bj][n] = bias ? *(const f32x4*)(bias + bcol0 + bj * HALF + 4 * n) : (f32x4){0.f, 0.f, 0.f, 0.f};
#pragma unroll
        for (int ai = 0; ai < 2; ++ai)
#pragma unroll
            for (int m = 0; m < 4; ++m) { bf16_t* rowp = base + (size_t)(row0 + ai * HALF + m * 16) * ldc + col0;
#pragma unroll
                for (int bj = 0; bj < 2; ++bj) { f32x4 v0 = acc[ai][bj][m][0] + bv[bj][0], v1 = acc[ai][bj][m][1] + bv[bj][1];
                    if (ACT == 1) { f32x2 a = gelu_pk((f32x2){v0[0], v0[1]}), b = gelu_pk((f32x2){v0[2], v0[3]}), c = gelu_pk((f32x2){v1[0], v1[1]}), d = gelu_pk((f32x2){v1[2], v1[3]});
                        v0 = (f32x4){a.x, a.y, b.x, b.y}; v1 = (f32x4){c.x, c.y, d.x, d.y}; }
                    v0 = v0 * sc; v1 = v1 * sc; u32x4 w; w.x = cvt_pk_bf16(v0[0], v0[1]); w.y = cvt_pk_bf16(v0[2], v0[3]); w.z = cvt_pk_bf16(v1[0], v1[1]); w.w = cvt_pk_bf16(v1[2], v1[3]);
                    *(u32x4*)(rowp + bj * HALF) = w; } }
    }
};
template <class Epi, class Sched, bool ALIGN_EPI = false, bool SP2 = false>
__device__ __forceinline__ void gemm_phase(PG8_LAS unsigned char* lds, const Gemm g, const Sched& S, const Epi& E) {
    int lane_l; asm volatile("v_mbcnt_lo_u32_b32 %0, -1, 0\n\tv_mbcnt_hi_u32_b32 %0, -1, %0" : "=v"(lane_l));
    const int wid = g.wave, lane = lane_l, tid = wid * 64 + lane,
              wr = wid >> 2, wc = wid & 3, fr = lane & 15, fq = lane >> 4;
    const int K = g.K, nt = K / BK;
    unsigned voffA[2], voffB[2];
#pragma unroll
    for (int i = 0; i < 2; ++i) { int R, C; stage_rc(tid * 16 + i * 8192, R, C); const int Rb = Epi::PERM ? ((R & ~31) + perm32(R & 31)) : R;
        voffA[i] = (unsigned)(R * K + C) * 2u; voffB[i] = (unsigned)(Rb * K + C) * 2u; }
    const size_t kstep = (size_t)(BK * 2);
    const size_t hstep = (size_t)HALF * K * 2;
    const size_t tstep = 2 * hstep;
    const unsigned ldsw = (unsigned)wid * 1024u;
    const int aoff = lds_byte(wr * 64 + fr, fq * 8), boff = lds_byte(wc * 32 + fr, fq * 8);
#define PG8_SA(b, h) (((b) * 2 + (h)) * HTB)
#define PG8_SB(b, h) ((4 + (b) * 2 + (h)) * HTB)
#define PG8_STAGE(bufoff, gbase, voff) do { _Pragma("unroll") for (int _i = 0; _i < 2; ++_i) \
        __builtin_amdgcn_global_load_lds((const unsigned*)((const char*)(gbase) + (voff)[_i]), (PG8_LAS unsigned*)(lds + (bufoff) + ldsw + _i * 8192), 16, 0, 0); } while (0)
#define PG8_LDA(dst, b, h) do { _Pragma("unroll") for (int m = 0; m < 4; ++m) _Pragma("unroll") for (int k = 0; k < 2; ++k) dst[m][k] = *(const PG8_LAS bf16x8*)(lds + PG8_SA(b, h) + aoff + m * 2048 + k * 1024); } while (0)
#define PG8_LDB(dst, b, h) do { _Pragma("unroll") for (int n = 0; n < 2; ++n) _Pragma("unroll") for (int k = 0; k < 2; ++k) dst[n][k] = *(const PG8_LAS bf16x8*)(lds + PG8_SB(b, h) + boff + n * 2048 + k * 1024); } while (0)
#define PG8_MMA(ai, bj, At, Bt) do { __builtin_amdgcn_s_setprio(1); _Pragma("unroll") for (int m = 0; m < 4; ++m) _Pragma("unroll") for (int n = 0; n < 2; ++n) _Pragma("unroll") for (int k = 0; k < 2; ++k) \
        acc[ai][bj][m][n] = __builtin_amdgcn_mfma_f32_16x16x32_bf16(Bt[n][k], At[m][k], acc[ai][bj][m][n], 0, 0, 0); __builtin_amdgcn_s_setprio(0); } while (0)
#define PG8_WAIT_V(n) asm volatile("s_waitcnt vmcnt(" #n ")" ::: "memory")
#define PG8_WAIT_L(n) asm volatile("s_waitcnt lgkmcnt(" #n ")" ::: "memory")
#define PG8_BAR __builtin_amdgcn_s_barrier()
#define PG8_SCHED __builtin_amdgcn_sched_barrier(0)
    Unit cur, nxt; int ui = 0;
    if (!S.next(0, cur)) return;
    f32x4 acc[2][2][4][2];
#pragma unroll
    for (int a = 0; a < 2; ++a)
#pragma unroll
        for (int b = 0; b < 2; ++b)
#pragma unroll
            for (int m = 0; m < 4; ++m)
#pragma unroll
                for (int n = 0; n < 2; ++n) acc[a][b][m][n] = (f32x4){0.f, 0.f, 0.f, 0.f};
    bf16x8 At[4][2], B0[2][2], B1[2][2];
    const char* cA = (const char*)g.A + (size_t)cur.pm * tstep; const char* cB = (const char*)g.Bt + (size_t)cur.pn * tstep;
    S.a_ready(cur);
    if constexpr (SP2) {
        PG8_STAGE(PG8_SB(0, 0), cB, voffB); PG8_STAGE(PG8_SB(0, 1), cB + hstep, voffB); PG8_STAGE(PG8_SA(0, 0), cA, voffA); PG8_STAGE(PG8_SA(0, 1), cA + hstep, voffA);
        if (wr == 1) PG8_BAR;
        PG8_WAIT_V(2); PG8_BAR;
        PG8_STAGE(PG8_SB(1, 0), cB + kstep, voffB); PG8_STAGE(PG8_SA(1, 0), cA + kstep, voffA); PG8_STAGE(PG8_SB(1, 1), cB + hstep + kstep, voffB);
        PG8_WAIT_V(6); PG8_BAR;
    } else {
        PG8_STAGE(PG8_SB(0, 0), cB, voffB); PG8_STAGE(PG8_SA(0, 0), cA, voffA); PG8_STAGE(PG8_SB(0, 1), cB + hstep, voffB); PG8_STAGE(PG8_SA(0, 1), cA + hstep, voffA);
        if (wr == 1) PG8_BAR;
        PG8_WAIT_V(4); PG8_BAR;
        PG8_STAGE(PG8_SB(1, 0), cB + kstep, voffB); PG8_STAGE(PG8_SA(1, 0), cA + kstep, voffA); PG8_STAGE(PG8_SB(1, 1), cB + hstep + kstep, voffB);
        PG8_WAIT_V(6); PG8_BAR;
    }
    for (;;) {
        const bool has_next = S.next(ui + 1, nxt);
        const char* nA = has_next ? (const char*)g.A + (size_t)nxt.pm * tstep : cA; const char* nB = has_next ? (const char*)g.Bt + (size_t)nxt.pn * tstep : cB;
        for (int t = 0; t < nt; t += 2) {
            const bool last = (t == nt - 2);
            const char* a1 = cA + (size_t)(t + 1) * kstep;
            const char* a2 = last ? nA : cA + (size_t)(t + 2) * kstep; const char* b2 = last ? nB : cB + (size_t)(t + 2) * kstep;
            const char* a3 = a2 + kstep; const char* b3 = b2 + kstep;
            if (last && has_next) S.a_ready(nxt);
            if constexpr (SP2) {
            PG8_LDB(B0, 0, 0); PG8_LDB(B1, 0, 1); PG8_SCHED; PG8_LDA(At, 0, 0); PG8_STAGE(PG8_SA(1, 1), a1 + hstep, voffA);
            PG8_WAIT_V(8); PG8_WAIT_L(0); PG8_BAR; PG8_MMA(0, 0, At, B0); PG8_MMA(0, 1, At, B1); PG8_BAR; PG8_SCHED;
            PG8_LDA(At, 0, 1); PG8_STAGE(PG8_SB(0, 0), b2, voffB); PG8_STAGE(PG8_SB(0, 1), b2 + hstep, voffB); PG8_STAGE(PG8_SA(0, 0), a2, voffA);
            PG8_WAIT_V(8); PG8_WAIT_L(0); PG8_BAR; PG8_MMA(1, 0, At, B0); PG8_MMA(1, 1, At, B1); PG8_BAR; PG8_SCHED;
            PG8_LDB(B0, 1, 0); PG8_LDB(B1, 1, 1); PG8_SCHED; PG8_LDA(At, 1, 0); PG8_STAGE(PG8_SA(0, 1), a2 + hstep, voffA);
            PG8_WAIT_V(8); PG8_WAIT_L(0); PG8_BAR; PG8_MMA(0, 0, At, B0); PG8_MMA(0, 1, At, B1); PG8_BAR; PG8_SCHED;
            PG8_LDA(At, 1, 1); PG8_STAGE(PG8_SB(1, 0), b3, voffB); PG8_STAGE(PG8_SB(1, 1), b3 + hstep, voffB); PG8_STAGE(PG8_SA(1, 0), a3, voffA);
            PG8_WAIT_V(8); PG8_WAIT_L(0); PG8_BAR; PG8_MMA(1, 0, At, B0); PG8_MMA(1, 1, At, B1); PG8_BAR; PG8_SCHED;
            } else {
            PG8_LDB(B0, 0, 0); PG8_SCHED; PG8_LDA(At, 0, 0); PG8_STAGE(PG8_SA(1, 1), a1 + hstep, voffA);
            PG8_WAIT_L(8); PG8_BAR; PG8_WAIT_L(0); PG8_MMA(0, 0, At, B0); PG8_BAR; PG8_SCHED;
            PG8_LDB(B1, 0, 1); PG8_STAGE(PG8_SB(0, 0), b2, voffB);
            PG8_BAR; PG8_WAIT_L(0); PG8_MMA(0, 1, At, B1); PG8_BAR;
            PG8_LDA(At, 0, 1); PG8_STAGE(PG8_SA(0, 0), a2, voffA);
            PG8_BAR; PG8_WAIT_L(0); PG8_MMA(1, 0, At, B0); PG8_BAR; PG8_SCHED;
            PG8_STAGE(PG8_SB(0, 1), b2 + hstep, voffB);
            PG8_WAIT_V(6); PG8_BAR; PG8_MMA(1, 1, At, B1); PG8_BAR;
            PG8_LDB(B0, 1, 0); PG8_SCHED; PG8_LDA(At, 1, 0); PG8_STAGE(PG8_SA(0, 1), a2 + hstep, voffA);
            PG8_WAIT_L(8); PG8_BAR; PG8_WAIT_L(0); PG8_MMA(0, 0, At, B0); PG8_BAR; PG8_SCHED;
            PG8_LDB(B1, 1, 1); PG8_STAGE(PG8_SB(1, 0), b3, voffB);
            PG8_BAR; PG8_WAIT_L(0); PG8_MMA(0, 1, At, B1); PG8_BAR;
            PG8_LDA(At, 1, 1); PG8_STAGE(PG8_SA(1, 0), a3, voffA);
            PG8_BAR; PG8_WAIT_L(0); PG8_MMA(1, 0, At, B0); PG8_BAR; PG8_SCHED;
            PG8_STAGE(PG8_SB(1, 1), b3 + hstep, voffB);
            PG8_WAIT_V(6); PG8_BAR; PG8_MMA(1, 1, At, B1); PG8_BAR;
            }
        }
        if constexpr (ALIGN_EPI) { if (wr == 0) PG8_BAR; }
        if constexpr (!Epi::AFTER_DRAIN) { E(acc, cur, wr, wc, fr, fq); S.done(cur); }
        if (!has_next) break;
#pragma unroll
        for (int a = 0; a < 2; ++a)
#pragma unroll
            for (int b = 0; b < 2; ++b)
#pragma unroll
                for (int m = 0; m < 4; ++m)
#pragma unroll
                    for (int n = 0; n < 2; ++n) acc[a][b][m][n] = (f32x4){0.f, 0.f, 0.f, 0.f};
        cur = nxt; cA = nA; cB = nB; ++ui;
        if constexpr (ALIGN_EPI) { if (wr == 1) PG8_BAR; }
    }
    PG8_WAIT_V(0);
    if constexpr (!ALIGN_EPI) { if (wr == 0) PG8_BAR; }
    PG8_BAR;
    if constexpr (Epi::AFTER_DRAIN) { E.fused(acc, cur, wr, wc, fr, fq, lds, wid, lane); S.done(cur); }
#undef PG8_SA
#undef PG8_SB
#undef PG8_STAGE
#undef PG8_LDA
#undef PG8_LDB
#undef PG8_MMA
#undef PG8_WAIT_V
#undef PG8_WAIT_L
#undef PG8_BAR
#undef PG8_SCHED
}
}

#ifndef PG8_SP2
#define PG8_SP2 true
#endif
#ifndef PG8_ALIGN
#define PG8_ALIGN true
#endif
#define GAS __attribute__((address_space(1)))
#define LAS __attribute__((address_space(3)))
typedef unsigned short bf16;
typedef unsigned v4u __attribute__((ext_vector_type(4)));
typedef float f32x4 __attribute__((ext_vector_type(4)));
typedef short bf16x8 __attribute__((ext_vector_type(8)));
typedef GAS unsigned gu32;
typedef GAS unsigned long long gu64;
#define RLX_AGENT __ATOMIC_RELAXED, __HIP_MEMORY_SCOPE_AGENT
#define LDS_WAIT() asm volatile("s_waitcnt lgkmcnt(0)" ::: "memory")
#define VM_WAIT() asm volatile("s_waitcnt vmcnt(0)" ::: "memory")
__device__ __forceinline__ unsigned long long rt() { return __builtin_amdgcn_s_memrealtime(); }
__device__ __forceinline__ unsigned f2bf(float f) { unsigned u = __builtin_bit_cast(unsigned, f); return (u + 0x7fffu + ((u >> 16) & 1u)) >> 16; }
__device__ __forceinline__ unsigned pk2(float lo, float hi) { return f2bf(lo) | (f2bf(hi) << 16); }

#define XB_TMO      128
#define XB_XCNT(j)  (256  + 64 * (j))
#define XB_XSUB(j)  (1280 + 64 * (j))
#define XB_XGEN(j)  (2304 + 64 * (j))
#define XB_TOP      3328
#define XB_TOPGEN   3392
#define XCD_BAR_WORDS 3456
#define XB_SPIN_CAP (1u << 22)

__device__ __forceinline__ unsigned xb_ld(unsigned* p)              { return __hip_atomic_load(p, __ATOMIC_RELAXED, __HIP_MEMORY_SCOPE_AGENT); }
__device__ __forceinline__ unsigned xb_add(unsigned* p, unsigned v) { return __hip_atomic_fetch_add(p, v, __ATOMIC_RELAXED, __HIP_MEMORY_SCOPE_AGENT); }
__device__ __forceinline__ unsigned xb_xcc_id() { return (unsigned)__builtin_amdgcn_s_getreg((3 << 11) | 20) & 0xFu; }
#define XB_SPIN(cond, bar) do { unsigned _sp = 0; while (cond) { __builtin_amdgcn_s_sleep(1); \
    if ((++_sp & 255u) == 0u) { if (xb_ld(&(bar)[XB_TMO])) break; if (_sp > XB_SPIN_CAP) { atomicAdd(&(bar)[XB_TMO], 1u); break; } } } } while (0)

struct XcdBarrier {
    unsigned* bar; unsigned x;
    volatile LAS unsigned* st;
};

__device__ __forceinline__ XcdBarrier xcd_barrier_post(unsigned* bar, volatile LAS unsigned* st) {
    XcdBarrier b; b.bar = bar; b.x = xb_xcc_id(); b.st = st;
    if (threadIdx.x == 0) (void)xb_add(&bar[XB_XCNT(b.x)], 1u);
    return b;
}
__device__ __forceinline__ void xcd_barrier_complete(unsigned* bar, unsigned x, unsigned& nloc, unsigned& nx) {
    const unsigned G = gridDim.x * gridDim.y * gridDim.z;
    unsigned sum, cnt, mine, sp = 0u;
    for (;;) {
        sum = 0u; cnt = 0u; mine = 0u;
#pragma unroll
        for (unsigned j = 0; j < 16; ++j) { const unsigned c = xb_ld(&bar[XB_XCNT(j)]); sum += c; cnt += (c > 0u) ? 1u : 0u; mine = (j == x) ? c : mine; }
        if (sum == G) break;
        __builtin_amdgcn_s_sleep(1);
        if ((++sp & 255u) == 0u) { if (xb_ld(&bar[XB_TMO])) break; if (sp > XB_SPIN_CAP) { atomicAdd(&bar[XB_TMO], 1u); break; } }
    }
    nloc = mine > 0u ? mine : 1u; nx = cnt > 0u ? cnt : 1u;
}

__device__ __forceinline__ void xcd_barrier(const XcdBarrier& b) {
    asm volatile("s_waitcnt vmcnt(0)" ::: "memory");
    __syncthreads();
    if (threadIdx.x == 0) {
        unsigned* bar = b.bar;
        __builtin_amdgcn_s_waitcnt(0);
        unsigned nloc = b.st[0], nx = b.st[1];
        if (nloc == 0u) { xcd_barrier_complete(bar, b.x, nloc, nx); b.st[0] = nloc; b.st[1] = nx; }
        const unsigned old = xb_add(&bar[XB_XSUB(b.x)], 1u);
        const unsigned gen = old / nloc;
        if (old + 1u == (gen + 1u) * nloc) {
            __builtin_amdgcn_fence(__ATOMIC_RELEASE, "agent");
            asm volatile("s_waitcnt vmcnt(0)" ::: "memory");
            const unsigned og = xb_add(&bar[XB_TOP], 1u);
            const unsigned tg = og / nx;
            if (og + 1u == (tg + 1u) * nx) xb_add(&bar[XB_TOPGEN], 1u);
            else XB_SPIN(xb_ld(&bar[XB_TOPGEN]) == tg, bar);
            __builtin_amdgcn_fence(__ATOMIC_ACQUIRE, "agent");
            xb_add(&bar[XB_XGEN(b.x)], 1u);
            asm volatile("s_waitcnt vmcnt(0)" ::: "memory");
        } else {
            XB_SPIN(xb_ld(&bar[XB_XGEN(b.x)]) == gen, bar);
            __builtin_amdgcn_fence(__ATOMIC_ACQUIRE, "agent");
            asm volatile("s_waitcnt vmcnt(0)" ::: "memory");
        }
    }
    __syncthreads();
}

constexpr int NWAVES = 8;
constexpr int T_ = 16384, SEQ = 4096, DM = 1024, NPROJ = 2304, INC = 2312;
constexpr int PJ_K = 512, PJ_V = 640, PJ_Z = 768, PJ_XBC = 1280;
constexpr float EPS = 1e-6f;
constexpr size_t MiB = 1u << 20;
constexpr size_t WS_CTL = 0, CTL_ZERO_BYTES = 1 * MiB;
constexpr size_t WS_SMALL = 1 * MiB;
constexpr size_t WS_WIN = 2 * MiB, WS_WOUT = 7 * MiB, WS_WQ = 9 * MiB;
constexpr size_t WS_ED = 13 * MiB, WS_EU = 25 * MiB;
constexpr size_t WS_XN = 77 * MiB;
constexpr size_t WS_PROJ = 109 * MiB;
constexpr size_t WS_ST = 181 * MiB;
constexpr size_t WS_IDX = 213 * MiB, WS_GATE = 221 * MiB, WS_SSQ = 229 * MiB, WS_END = 230 * MiB;
constexpr size_t DO_Y = 0, DO_DT = 41 * MiB;
constexpr size_t WS_CC = 230 * MiB, WS_DT = 238 * MiB, WS_EA = 239 * MiB, WS_CDEC = 240 * MiB, WS_PREV = WS_IDX;
constexpr size_t DO_YPF = 0, DO_YPLAIN = 32 * MiB;
constexpr int CW_BAR = 4096;
constexpr int RING_OFF = 0, RING_BYTES = 131072, LDSCTL_OFF = RING_BYTES, MISC_OFF = LDSCTL_OFF + 320, LDS_BYTES = 147456;

__constant__ unsigned char c_bucket[128] = {0, 1, 2, 3, 4, 5, 6, 7, 8, 9, 10, 11, 12, 13, 14, 15, 16, 16, 16, 17, 17, 18, 18, 18, 19, 19, 19, 20, 20, 20, 20, 21, 21, 21, 21, 22, 22, 22, 22, 22, 23, 23, 23, 23, 23, 23, 24, 24, 24, 24, 24, 24, 25, 25, 25, 25, 25, 25, 25, 26, 26, 26, 26, 26, 26, 26, 26, 27, 27, 27, 27, 27, 27, 27, 27, 27, 27, 28, 28, 28, 28, 28, 28, 28, 28, 28, 28, 29, 29, 29, 29, 29, 29, 29, 29, 29, 29, 29, 29, 30, 30, 30, 30, 30, 30, 30, 30, 30, 30, 30, 30, 30, 30, 31, 31, 31, 31, 31, 31, 31, 31, 31, 31, 31, 31, 31, 31, 31};

typedef float v16f __attribute__((ext_vector_type(16)));
typedef float v32f __attribute__((ext_vector_type(32)));
typedef unsigned v6u __attribute__((ext_vector_type(6)));
typedef _Float16 v32h __attribute__((ext_vector_type(32)));
struct Frame {
    LAS unsigned char* lds;
    volatile LAS unsigned* MISC;
    gu32* ctl;
    int wave, vcu, G;
};
__device__ __forceinline__ int lane_id() { int l; asm volatile("v_mbcnt_lo_u32_b32 %0, -1, 0\n\tv_mbcnt_hi_u32_b32 %0, -1, %0" : "=v"(l)); return l; }
__device__ __forceinline__ int opq(int x) { asm volatile("" : "+v"(x)); return x; }
template <int M> __device__ __forceinline__ float swz_xor(float v) { return __int_as_float(__builtin_amdgcn_ds_swizzle(__float_as_int(v), (M << 10) | 0x1F)); }
__device__ __forceinline__ float sum_halves(float v) { const auto r = __builtin_amdgcn_permlane32_swap(__float_as_uint(v), __float_as_uint(v), false, false); return __uint_as_float(r[0]) + __uint_as_float(r[1]); }
__device__ __forceinline__ float max_halves(float v) { const auto r = __builtin_amdgcn_permlane32_swap(__float_as_uint(v), __float_as_uint(v), false, false); return fmaxf(__uint_as_float(r[0]), __uint_as_float(r[1])); }
__device__ __forceinline__ int imax_halves(int v) { const auto r = __builtin_amdgcn_permlane32_swap((unsigned)v, (unsigned)v, false, false); return max((int)r[0], (int)r[1]); }
__device__ __forceinline__ float wave_sum(float v) {
    v += swz_xor<1>(v); v += swz_xor<2>(v); v += swz_xor<4>(v); v += swz_xor<8>(v); v += swz_xor<16>(v);
    return sum_halves(v);
}
__device__ __forceinline__ float bf2f(unsigned short b) { return __uint_as_float((unsigned)b << 16); }
__device__ __forceinline__ float bflo(unsigned w) { return __uint_as_float(w << 16); }
__device__ __forceinline__ float bfhi(unsigned w) { return __uint_as_float(w & 0xffff0000u); }
__device__ __forceinline__ float silu_f(float x) { return x / (1.f + __expf(-x)); }

__device__ __forceinline__ void p0_transpose_item(const float* W, int ldw, int K, int nblk, bf16* WT, const float* kscale, LAS float* scr, int item, int lane) {
    const int kb = item / nblk, nb = item % nblk, k0 = 64 * kb, n0 = 32 * nb;
#pragma unroll 8
    for (int i = 0; i < 32; ++i) { const int kk = 2 * i + (lane >> 5); float v = W[(size_t)(k0 + kk) * ldw + n0 + (lane & 31)]; if (kscale) v *= kscale[k0 + kk]; scr[kk * 33 + (lane & 31)] = v; }
    LDS_WAIT(); asm volatile("" ::: "memory");
    const int c = lane & 7;
#pragma unroll
    for (int j = 0; j < 4; ++j) { const int n = (lane >> 3) + 8 * j; const LAS float* s = scr + (8 * c) * 33 + n;
        v4u o; o.x = pk2(s[0 * 33], s[1 * 33]); o.y = pk2(s[2 * 33], s[3 * 33]); o.z = pk2(s[4 * 33], s[5 * 33]); o.w = pk2(s[6 * 33], s[7 * 33]);
        *(GAS v4u*)(WT + (size_t)(n0 + n) * K + k0 + 8 * c) = o; }
    LDS_WAIT(); asm volatile("" ::: "memory");
}
struct Ptrs {
    const float *x, *norm_mix, *w_in, *conv_w, *conv_b, *dt_bias, *a_log, *d_skip, *ssd_norm_w, *sinks, *w_out, *rel_bias, *norm_ffn, *w_query, *sk1, *sk2, *e_down, *e_up, *norm_final;
    float* out; unsigned char* ws;
};
__device__ __forceinline__ void p0_prologue(Frame& F0, const Ptrs& P) {
    const Frame& F = F0; const int lane_ = lane_id(), tid_ = F.wave * 64 + lane_;
    LAS float* scr = (LAS float*)(F.lds + RING_OFF + F.wave * 16384);
    const int gw = F.vcu * NWAVES + F.wave, NGW = F.G * NWAVES;
    bf16* Win_t = (bf16*)(P.ws + WS_WIN); bf16* Wout_t = (bf16*)(P.ws + WS_WOUT); bf16* Wq_t = (bf16*)(P.ws + WS_WQ);
    constexpr int I_IN = 16 * 72, I_OUT = 16 * 32, I_Q = 16 * 64, NITEMS = I_IN + I_OUT + I_Q;
    for (int it = gw; it < NITEMS; it += NGW) {
        int r = it;
        if (r < I_IN) { p0_transpose_item(P.w_in, INC, DM, 72, Win_t, nullptr, scr, r, lane_); continue; } r -= I_IN;
        if (r < I_OUT) { p0_transpose_item(P.w_out, DM, DM, 32, Wout_t, nullptr, scr, r, lane_); continue; } r -= I_OUT;
        p0_transpose_item(P.w_query, 2048, DM, 64, Wq_t, P.norm_ffn, scr, r, lane_);
    }
    { float* SC = (float*)(P.ws + WS_SMALL); const int l31 = lane_ & 31, hf = lane_ >> 5;
      for (int q = gw; q < 16384; q += NGW) {
        const int row = 2 * q + hf, isup = row >> 14, e = row & 16383;
        const float4* src = (const float4*)((isup ? P.e_up : P.e_down) + (size_t)e * DM) + 8 * l31;
        float v[32];
#pragma unroll
        for (int k = 0; k < 8; ++k) { const float4 t = src[k]; v[4 * k] = t.x; v[4 * k + 1] = t.y; v[4 * k + 2] = t.z; v[4 * k + 3] = t.w; }
        if (!isup) {
#pragma unroll
            for (int k = 0; k < 8; ++k) { const float4 w = ((const float4*)P.norm_ffn)[8 * l31 + k]; v[4 * k] *= w.x; v[4 * k + 1] *= w.y; v[4 * k + 2] *= w.z; v[4 * k + 3] *= w.w; } }
        float am = 0.f;
#pragma unroll
        for (int k = 0; k < 32; ++k) am = fmaxf(am, fabsf(v[k]));
        am = fmaxf(am, swz_xor<1>(am)); am = fmaxf(am, swz_xor<2>(am)); am = fmaxf(am, swz_xor<4>(am)); am = fmaxf(am, swz_xor<8>(am)); am = fmaxf(am, swz_xor<16>(am));
        am = fmaxf(am, 1e-30f);
        const float inv = 7.5f / am;
        v32h xh;
#pragma unroll
        for (int k = 0; k < 32; ++k) xh[k] = (_Float16)(v[k] * inv);
        const v6u pk = __builtin_amdgcn_cvt_scalef32_pk32_fp6_f16(xh, 1.0f);
        unsigned char* dst = P.ws + WS_ED + (size_t)row * 768;
        *(v4u*)(dst + 16 * l31) = (v4u){pk[0], pk[1], pk[2], pk[3]};
        *(unsigned long long*)(dst + 512 + 8 * l31) = (unsigned long long)pk[4] | ((unsigned long long)pk[5] << 32);
        if (l31 == 0) SC[row] = am * (1.f / 7.5f);
      } }
    __syncthreads();
    { LAS float* Wdt = (LAS float*)(F.lds + RING_OFF);
      for (int i = tid_; i < 8192; i += 512) Wdt[i] = P.w_in[(size_t)(i >> 3) * INC + NPROJ + (i & 7)];
      __syncthreads();
      bf16* XN = (bf16*)(P.ws + WS_XN); float* DT = (float*)(P.ws + WS_DT);
      for (int m0 = gw * 2; m0 < T_; m0 += NGW * 2) {
        float4 xv[2][4];
#pragma unroll
        for (int rr = 0; rr < 2; ++rr) { const float4* xr = (const float4*)(P.x + (size_t)(m0 + rr) * DM);
#pragma unroll
            for (int j = 0; j < 4; ++j) xv[rr][j] = xr[j * 64 + lane_]; }
#pragma unroll
        for (int rr = 0; rr < 2; ++rr) { const int m = m0 + rr;
        float4 v[4]; float s = 0.f;
#pragma unroll
        for (int j = 0; j < 4; ++j) { v[j] = xv[rr][j]; s += v[j].x * v[j].x + v[j].y * v[j].y + v[j].z * v[j].z + v[j].w * v[j].w; }
        const float r = rsqrtf(wave_sum(s) * (1.f / 1024.f) + EPS);
        float d8[8];
#pragma unroll
        for (int q = 0; q < 8; ++q) d8[q] = 0.f;
        unsigned long long* o8 = (unsigned long long*)(XN + (size_t)m * DM);
#pragma unroll
        for (int j = 0; j < 4; ++j) { const float4 w = ((const float4*)P.norm_mix)[j * 64 + lane_];
            const float e0 = v[j].x * r * w.x, e1 = v[j].y * r * w.y, e2 = v[j].z * r * w.z, e3 = v[j].w * r * w.w;
            o8[j * 64 + lane_] = (unsigned long long)pk2(e0, e1) | ((unsigned long long)pk2(e2, e3) << 32);
            const float ev[4] = {e0, e1, e2, e3};
#pragma unroll
            for (int e = 0; e < 4; ++e) { const LAS f32x4* wr = (const LAS f32x4*)(Wdt + (size_t)(j * 256 + lane_ * 4 + e) * 8); const f32x4 w0 = wr[0], w1 = wr[1];
                d8[0] += ev[e] * w0.x; d8[1] += ev[e] * w0.y; d8[2] += ev[e] * w0.z; d8[3] += ev[e] * w0.w; d8[4] += ev[e] * w1.x; d8[5] += ev[e] * w1.y; d8[6] += ev[e] * w1.z; d8[7] += ev[e] * w1.w; } }
#pragma unroll
        for (int q = 0; q < 8; ++q) d8[q] = wave_sum(d8[q]);
        if (lane_ == 0) { float4* dp = (float4*)(DT + (size_t)m * 8); dp[0] = make_float4(d8[0], d8[1], d8[2], d8[3]); dp[1] = make_float4(d8[4], d8[5], d8[6], d8[7]); }
        }
      }
      __syncthreads(); }
}

struct EpiResH {
    static constexpr bool PERM = false, AFTER_DRAIN = false;
    const float* X; bf16* HB; float* SSQ;
    __device__ __forceinline__ void operator()(const pg8::f32x4 (&acc)[2][2][4][2], const pg8::Unit& u, int wr, int wc, int fr, int fq) const {
        const int row0 = u.pm * 256 + wr * 64 + fr, col0 = u.pn * 256 + wc * 32 + 4 * fq;
#pragma unroll
        for (int ai = 0; ai < 2; ++ai)
#pragma unroll
            for (int m = 0; m < 4; ++m) { const int row = row0 + ai * 128 + m * 16; float ss = 0.f;
#pragma unroll
                for (int bj = 0; bj < 2; ++bj)
#pragma unroll
                    for (int n = 0; n < 2; ++n) { const size_t off = (size_t)row * DM + col0 + bj * 128 + n * 16;
                        const pg8::f32x4 h = acc[ai][bj][m][n] + *(const pg8::f32x4*)(X + off);
                        ss += h[0] * h[0] + h[1] * h[1] + h[2] * h[2] + h[3] * h[3];
                        *(unsigned long long*)(HB + off) = (unsigned long long)pk2(h[0], h[1]) | ((unsigned long long)pk2(h[2], h[3]) << 32); }
                ss += swz_xor<16>(ss); ss = sum_halves(ss);
                if (fq == 0) SSQ[(size_t)row * 16 + u.pn * 4 + wc] = ss; }
    }
};

typedef float f32x16 __attribute__((ext_vector_type(16)));
typedef short s16x4 __attribute__((ext_vector_type(4)));
typedef float f32x2_t __attribute__((ext_vector_type(2)));
typedef __bf16 bf16x2_t __attribute__((ext_vector_type(2)));
#define MFMA32(a, b, c) __builtin_amdgcn_mfma_f32_32x32x16_bf16((a), (b), (c), 0, 0, 0)
__device__ __forceinline__ int crow(int reg, int h) { return (reg & 3) + 8 * (reg >> 2) + 4 * h; }
__device__ __forceinline__ unsigned cvtpk(float lo, float hi) { f32x2_t v = {lo, hi}; bf16x2_t b = __builtin_convertvector(v, bf16x2_t); return __builtin_bit_cast(unsigned, b); }
__device__ __forceinline__ bf16x8 pack8(const f32x16& x, int s) {
    v4u p; p.x = cvtpk(x[8 * s], x[8 * s + 1]); p.y = cvtpk(x[8 * s + 2], x[8 * s + 3]); p.z = cvtpk(x[8 * s + 4], x[8 * s + 5]); p.w = cvtpk(x[8 * s + 6], x[8 * s + 7]);
    return __builtin_bit_cast(bf16x8, p);
}
constexpr float LOG2E = 1.4426950408889634f;
constexpr int LDP = 136;
constexpr int S1_XT = 0, S1_BSN = 17408, S1_CLN = 52224, S1_BNL = 87040, S1_F32 = 121856;

__device__ __forceinline__ void ssd_s1(Frame& F, const Ptrs& P) {
    const bf16* PROJ = (const bf16*)(P.ws + WS_PROJ); const float* DT = (const float*)(P.ws + WS_DT);
    float* EA = (float*)(P.ws + WS_EA); float* CDEC = (float*)(P.ws + WS_CDEC); bf16* CC = (bf16*)(P.ws + WS_CC);
    float* ST = (float*)(P.ws + WS_ST); float* YPF = (float*)((char*)P.out + DO_YPF);
    LAS unsigned char* L = F.lds + RING_OFF;
    LAS bf16* Xt = (LAS bf16*)(L + S1_XT); LAS bf16* Bsn = (LAS bf16*)(L + S1_BSN); LAS bf16* Cln = (LAS bf16*)(L + S1_CLN); LAS bf16* Bnl = (LAS bf16*)(L + S1_BNL);
    LAS float* acum2 = (LAS float*)(L + S1_F32); LAS float* wv = acum2 + 128; LAS float* wend = wv + 128;
    const int lane = lane_id(), r = lane & 31, hh = lane >> 5; const int tid_ = F.wave * 64 + lane;
    for (int u = F.vcu; u < 1024; u += F.G) {
        const int h = u & 7, c = (u >> 3) & 31, b = u >> 8, grp = h >> 2, t0 = b * SEQ + c * 128;
        const float A = -__expf(P.a_log[h]), Dh = P.d_skip[h], dtb = P.dt_bias[h];
        if (F.wave == 0) {
            const float x0 = DT[(size_t)(t0 + 2 * lane) * 8 + h] + dtb, x1 = DT[(size_t)(t0 + 2 * lane + 1) * 8 + h] + dtb;
            const float dt0 = fmaxf(x0, 0.f) + log1pf(__expf(-fabsf(x0))), dt1 = fmaxf(x1, 0.f) + log1pf(__expf(-fabsf(x1)));
            const float a0 = dt0 * A, a1 = dt1 * A;
            float s = a0 + a1;
#pragma unroll
            for (int o = 1; o < 64; o <<= 1) { const float v = __int_as_float(__builtin_amdgcn_ds_bpermute((lane - o) * 4, __float_as_int(s))); if (lane >= o) s += v; }
            const float ac1 = s, ac0 = s - a1, tot = __uint_as_float(__builtin_amdgcn_readlane(__float_as_uint(s), 63));
            acum2[2 * lane] = ac0 * LOG2E; acum2[2 * lane + 1] = ac1 * LOG2E;
            wv[2 * lane] = log2f(dt0) - ac0 * LOG2E; wv[2 * lane + 1] = log2f(dt1) - ac1 * LOG2E;
            wend[2 * lane] = dt0 * exp2f((tot - ac0) * LOG2E); wend[2 * lane + 1] = dt1 * exp2f((tot - ac1) * LOG2E);
            EA[(size_t)(t0 + 2 * lane) * 8 + h] = exp2f(ac0 * LOG2E); EA[(size_t)(t0 + 2 * lane + 1) * 8 + h] = exp2f(ac1 * LOG2E);
            if (lane == 0) CDEC[u] = exp2f(tot * LOG2E);
        }
        __syncthreads();
        const int tidc = opq(tid_);
        if (tidc < 480) {
            const int cg = tidc % 40, sg = tidc / 40, l0 = 11 * sg;
            int chb; if (cg < 8) chb = h * 64 + cg * 8; else if (cg < 24) chb = 512 + grp * 128 + (cg - 8) * 8; else chb = 768 + grp * 128 + (cg - 24) * 8;
            v4u raw[14];
#pragma unroll
            for (int q = 0; q < 14; ++q) { const int ss = c * 128 + l0 - 3 + q;
                raw[q] = (v4u){0u, 0u, 0u, 0u};
                if (ss >= 0 && l0 - 3 + q < 128) raw[q] = *(const v4u*)(PROJ + (size_t)(b * SEQ + ss) * NPROJ + PJ_XBC + chb); }
            float w[4][8], bias[8];
#pragma unroll
            for (int j = 0; j < 4; ++j) { const float4 w0 = *(const float4*)(P.conv_w + j * 1024 + chb), w1 = *(const float4*)(P.conv_w + j * 1024 + chb + 4);
                w[j][0] = w0.x; w[j][1] = w0.y; w[j][2] = w0.z; w[j][3] = w0.w; w[j][4] = w1.x; w[j][5] = w1.y; w[j][6] = w1.z; w[j][7] = w1.w; }
            { const float4 b0 = *(const float4*)(P.conv_b + chb), b1 = *(const float4*)(P.conv_b + chb + 4);
              bias[0] = b0.x; bias[1] = b0.y; bias[2] = b0.z; bias[3] = b0.w; bias[4] = b1.x; bias[5] = b1.y; bias[6] = b1.z; bias[7] = b1.w; }
#pragma unroll
            for (int it = 0; it < 11; ++it) {
                const int l = l0 + it;
                if (l < 128) {
                    float a[8];
#pragma unroll
                    for (int e = 0; e < 8; ++e) a[e] = bias[e];
#pragma unroll
                    for (int j = 0; j < 4; ++j) { const v4u rw = raw[it + j];
                        a[0] += w[j][0] * bflo(rw.x); a[1] += w[j][1] * bfhi(rw.x); a[2] += w[j][2] * bflo(rw.y); a[3] += w[j][3] * bfhi(rw.y);
                        a[4] += w[j][4] * bflo(rw.z); a[5] += w[j][5] * bfhi(rw.z); a[6] += w[j][6] * bflo(rw.w); a[7] += w[j][7] * bfhi(rw.w); }
#pragma unroll
                    for (int e = 0; e < 8; ++e) a[e] = silu_f(a[e]);
                    if (cg < 8) {
#pragma unroll
                        for (int e = 0; e < 8; ++e) Xt[(cg * 8 + e) * LDP + l] = (bf16)f2bf(a[e]);
                    } else {
                        v4u o; o.x = pk2(a[0], a[1]); o.y = pk2(a[2], a[3]); o.z = pk2(a[4], a[5]); o.w = pk2(a[6], a[7]);
                        if (cg < 24) { const int n0 = (cg - 8) * 8; *(LAS v4u*)(Bsn + l * LDP + n0) = o; const float we = wend[l];
#pragma unroll
                            for (int e = 0; e < 8; ++e) Bnl[(n0 + e) * LDP + l] = (bf16)f2bf(a[e] * we);
                        } else { const int n0 = (cg - 24) * 8; *(LAS v4u*)(Cln + l * LDP + n0) = o;
                            if ((h & 3) == 0) *(v4u*)(CC + (size_t)(t0 + l) * 256 + grp * 128 + n0) = o; }
                    }
                }
            }
        }
        __syncthreads();
        if (F.wave < 4) {
            const int pt = F.wave >> 1;
#pragma unroll 1
            for (int q = 0; q < 2; ++q) {
                const int lt = (F.wave & 1) ? (1 + q) : (3 * q);
                f32x16 yacc;
#pragma unroll
                for (int i = 0; i < 16; ++i) yacc[i] = 0.f;
                const float al = acum2[32 * lt + r];
                for (int st = 0; st <= lt; ++st) {
                    f32x16 macc;
#pragma unroll
                    for (int i = 0; i < 16; ++i) macc[i] = 0.f;
#pragma unroll
                    for (int kk = 0; kk < 8; ++kk) {
                        const bf16x8 a = *(const LAS bf16x8*)(Bsn + (32 * st + r) * LDP + 16 * kk + 8 * hh);
                        const bf16x8 bb = *(const LAS bf16x8*)(Cln + (32 * lt + r) * LDP + 16 * kk + 8 * hh);
                        macc = MFMA32(a, bb, macc);
                    }
#pragma unroll
                    for (int i = 0; i < 16; ++i) { const int sl = crow(i, hh);
                        float f = exp2f(al + wv[32 * st + sl]);
                        if (st == lt && sl > r) f = 0.f;
                        macc[i] *= f; }
#pragma unroll
                    for (int sg = 0; sg < 2; ++sg) {
                        const bf16x8 bfrag = pack8(macc, sg);
                        const LAS bf16* xb = Xt + (32 * pt + r) * LDP + 32 * st + 16 * sg + 4 * hh;
                        const s16x4 lo = *(const LAS s16x4*)(xb), hi = *(const LAS s16x4*)(xb + 8);
                        const bf16x8 afrag = __builtin_shufflevector(lo, hi, 0, 1, 2, 3, 4, 5, 6, 7);
                        yacc = MFMA32(afrag, bfrag, yacc);
                    }
                }
#pragma unroll
                for (int i = 0; i < 16; ++i) { const int p = 32 * pt + crow(i, hh);
                    const float y = yacc[i] + Dh * bf2f(Xt[p * LDP + 32 * lt + r]);
                    YPF[((((size_t)u * 4 + lt) * 2 + pt) * 16 + i) * 64 + lane] = y; }
            }
        } else {
            const int nt = F.wave - 4;
#pragma unroll 1
            for (int pt = 0; pt < 2; ++pt) {
                f32x16 sacc;
#pragma unroll
                for (int i = 0; i < 16; ++i) sacc[i] = 0.f;
#pragma unroll
                for (int kk = 0; kk < 8; ++kk) {
                    const bf16x8 a = *(const LAS bf16x8*)(Xt + (32 * pt + r) * LDP + 16 * kk + 8 * hh);
                    const bf16x8 bb = *(const LAS bf16x8*)(Bnl + (32 * nt + r) * LDP + 16 * kk + 8 * hh);
                    sacc = MFMA32(a, bb, sacc);
                }
#pragma unroll
                for (int i = 0; i < 16; ++i) ST[((size_t)u * 64 + 32 * pt + crow(i, hh)) * 128 + 32 * nt + r] = sacc[i];
            }
        }
        __syncthreads();
    }
}
__device__ __forceinline__ void ssd_s2(Frame& F, const Ptrs& P) {
    const float* ST = (const float*)(P.ws + WS_ST); const float* CDEC = (const float*)(P.ws + WS_CDEC); unsigned* PREV = (unsigned*)(P.ws + WS_PREV);
    for (int g = F.vcu * 512 + (F.wave * 64 + lane_id()); g < 131072; g += F.G * 512) {
        const int n2 = g & 63, p = (g >> 6) & 63, h = (g >> 12) & 7, b = g >> 15;
        float2 st[32];
#pragma unroll
        for (int c = 0; c < 32; ++c) st[c] = *(const float2*)(ST + ((size_t)(((b * 32 + c) * 8 + h) * 64 + p)) * 128 + 2 * n2);
        float r0 = 0.f, r1 = 0.f;
#pragma unroll
        for (int c = 0; c < 32; ++c) { const size_t u = (size_t)((b * 32 + c) * 8 + h);
            PREV[((u * 64 + p) * 128 + 2 * n2) >> 1] = pk2(r0, r1);
            const float d = CDEC[u]; r0 = r0 * d + st[c].x; r1 = r1 * d + st[c].y; }
    }
}
__device__ __forceinline__ void ssd_s3(Frame& F, const Ptrs& P) {
    const bf16* CC = (const bf16*)(P.ws + WS_CC); const bf16* PREV = (const bf16*)(P.ws + WS_PREV); const float* EA = (const float*)(P.ws + WS_EA);
    const float* YPF = (const float*)((const char*)P.out + DO_YPF); const bf16* PROJ = (const bf16*)(P.ws + WS_PROJ); bf16* CAT = (bf16*)(P.ws + WS_XN);
    LAS float* red = (LAS float*)(F.lds + RING_OFF);
    const int lane = lane_id(), r = lane & 31, hh = lane >> 5, h = F.wave, grp = h >> 2;
    for (int v = F.vcu; v < 512; v += F.G) {
        const int lt = v & 3, c = (v >> 2) & 31, b = v >> 7;
        const int t = b * SEQ + c * 128 + lt * 32 + r; const size_t u = (size_t)((b * 32 + c) * 8 + h);
        f32x16 acc[2];
#pragma unroll
        for (int i = 0; i < 16; ++i) { acc[0][i] = 0.f; acc[1][i] = 0.f; }
#pragma unroll
        for (int kk = 0; kk < 8; ++kk) {
            const bf16x8 bb = *(const bf16x8*)(CC + (size_t)t * 256 + grp * 128 + 16 * kk + 8 * hh);
#pragma unroll
            for (int pt = 0; pt < 2; ++pt) { const bf16x8 a = *(const bf16x8*)(PREV + (u * 64 + 32 * pt + r) * 128 + 16 * kk + 8 * hh); acc[pt] = MFMA32(a, bb, acc[pt]); }
        }
        const float ea = EA[(size_t)t * 8 + h];
        float ss = 0.f;
#pragma unroll
        for (int pt = 0; pt < 2; ++pt)
#pragma unroll
            for (int g4 = 0; g4 < 4; ++g4) {
                const unsigned long long zz = *(const unsigned long long*)(PROJ + (size_t)t * NPROJ + PJ_Z + h * 64 + 32 * pt + 8 * g4 + 4 * hh);
                const unsigned z01 = (unsigned)zz, z23 = (unsigned)(zz >> 32);
                const float zf[4] = {bflo(z01), bfhi(z01), bflo(z23), bfhi(z23)};
#pragma unroll
                for (int e = 0; e < 4; ++e) { const int i = 4 * g4 + e;
                    const float y = acc[pt][i] * ea + YPF[((((size_t)u * 4 + lt) * 2 + pt) * 16 + i) * 64 + lane];
                    const float yg = y * silu_f(zf[e]); acc[pt][i] = yg; ss = fmaf(yg, yg, ss); }
            }
        ss = sum_halves(ss);
        if (hh == 0) red[h * 32 + r] = ss;
        __syncthreads();
        float tot = 0.f;
#pragma unroll
        for (int w = 0; w < 8; ++w) tot += red[w * 32 + r];
        const float rn = rsqrtf(tot * (1.f / 512.f) + EPS);
#pragma unroll
        for (int pt = 0; pt < 2; ++pt)
#pragma unroll
            for (int g4 = 0; g4 < 4; ++g4) { const int ch = h * 64 + 32 * pt + 8 * g4 + 4 * hh;
                const float4 w = *(const float4*)(P.ssd_norm_w + ch);
                *(unsigned long long*)(CAT + (size_t)t * DM + 512 + ch) = (unsigned long long)cvtpk(acc[pt][4 * g4] * rn * w.x, acc[pt][4 * g4 + 1] * rn * w.y) | ((unsigned long long)cvtpk(acc[pt][4 * g4 + 2] * rn * w.z, acc[pt][4 * g4 + 3] * rn * w.w) << 32); }
        __syncthreads();
    }
}
__device__ __forceinline__ float gelu_erf(float v) { return 0.5f * v * (1.f + erff(v * 0.70710678118654752f)); }
constexpr int PE_PD = 8;
struct Row6 { v4u a; unsigned long long b; };
#define PE_ID1(P) __builtin_amdgcn_readlane(((P) & 64) ? idx_hi : idx_lo, (P) & 63)
#define PE_LOAD6(SLOT, TAB, IDA, IDB) do { const int id_ = upper ? (IDB) : (IDA); const unsigned char* rp_ = (TAB) + (size_t)id_ * 768; \
        SLOT.a = *(const v4u*)(rp_ + 16 * l31); SLOT.b = *(const unsigned long long*)(rp_ + 512 + 8 * l31); } while (0)
__device__ __forceinline__ v32f dec6(const Row6& r) { const v6u p = {r.a.x, r.a.y, r.a.z, r.a.w, (unsigned)r.b, (unsigned)(r.b >> 32)}; return __builtin_amdgcn_cvt_scalef32_pk32_f32_fp6(p, 1.0f); }
__device__ __forceinline__ void peer_eval(Frame& F, const Ptrs& P) {
    const bf16* HB = (const bf16*)(P.ws + WS_ST); const unsigned char* ED = P.ws + WS_ED; const unsigned char* EU = P.ws + WS_EU;
    const float* SCD = (const float*)(P.ws + WS_SMALL); const float* SCU = SCD + 16384;
    const int* IDX = (const int*)(P.ws + WS_IDX); const float* GATE = (const float*)(P.ws + WS_GATE);
    LAS float* RM = (LAS float*)(F.lds + RING_OFF) + F.wave * 2112;
    const int lane = lane_id(), l31 = lane & 31; const bool upper = lane >= 32;
    const int t0 = F.vcu * NWAVES + F.wave, tstep = F.G * NWAVES;
    if (t0 >= T_) return;
    int idx_lo = IDX[(size_t)t0 * 128 + lane], idx_hi = IDX[(size_t)t0 * 128 + 64 + lane];
    v4u hq[4];
#pragma unroll
    for (int k = 0; k < 4; ++k) hq[k] = ((const v4u*)(HB + (size_t)t0 * DM))[4 * l31 + k];
    float g_lo = GATE[(size_t)t0 * 128 + lane], g_hi = GATE[(size_t)t0 * 128 + 64 + lane];
    float sdr_lo = SCD[idx_lo], sdr_hi = SCD[idx_hi], su_lo = SCU[idx_lo], su_hi = SCU[idx_hi];
    Row6 ra[PE_PD];
#pragma unroll
    for (int j = 0; j < PE_PD; ++j) PE_LOAD6(ra[j], ED, __builtin_amdgcn_readlane(idx_lo, 2 * j), __builtin_amdgcn_readlane(idx_lo, 2 * j + 1));
    for (int t = t0; t < T_; t += tstep) {
        const int tn = (t + tstep < T_) ? t + tstep : t;
        const int nidx_lo = IDX[(size_t)tn * 128 + lane], nidx_hi = IDX[(size_t)tn * 128 + 64 + lane];
        v4u nh[4];
#pragma unroll
        for (int k = 0; k < 4; ++k) nh[k] = ((const v4u*)(HB + (size_t)tn * DM))[4 * l31 + k];
        const float ng_lo = GATE[(size_t)tn * 128 + lane], ng_hi = GATE[(size_t)tn * 128 + 64 + lane];
        float hv[32];
#pragma unroll
        for (int k = 0; k < 4; ++k) { hv[8 * k] = bflo(hq[k].x); hv[8 * k + 1] = bfhi(hq[k].x); hv[8 * k + 2] = bflo(hq[k].y); hv[8 * k + 3] = bfhi(hq[k].y); hv[8 * k + 4] = bflo(hq[k].z); hv[8 * k + 5] = bfhi(hq[k].z); hv[8 * k + 6] = bflo(hq[k].w); hv[8 * k + 7] = bfhi(hq[k].w); }
        float ssq = 0.f;
#pragma unroll
        for (int i = 0; i < 32; ++i) ssq = fmaf(hv[i], hv[i], ssq);
        ssq += swz_xor<1>(ssq); ssq += swz_xor<2>(ssq); ssq += swz_xor<4>(ssq); ssq += swz_xor<8>(ssq); ssq += swz_xor<16>(ssq);
        const float rstd = rsqrtf(ssq * (1.f / 1024.f) + EPS);
        const float sd_lo = sdr_lo * rstd, sd_hi = sdr_hi * rstd;
        float actg[2] = {0.f, 0.f};
#pragma unroll
        for (int g = 0; g < 2; ++g) {
            float part[32];
#pragma unroll
            for (int j = 0; j < 32; ++j) {
                const int q = 32 * g + j;
                { const v32f d = dec6(ra[q % PE_PD]); float s0 = 0.f, s1 = 0.f;
#pragma unroll
                  for (int i = 0; i < 32; i += 2) { s0 = fmaf(d[i], hv[i], s0); s1 = fmaf(d[i + 1], hv[i + 1], s1); }
                  part[j] = s0 + s1; }
                asm volatile("" : "+v"(part[j]));
                if (q + PE_PD < 64) PE_LOAD6(ra[q % PE_PD], ED, PE_ID1(2 * (q + PE_PD)), PE_ID1(2 * (q + PE_PD) + 1));
                else PE_LOAD6(ra[q % PE_PD], EU, PE_ID1(2 * (q + PE_PD - 64)), PE_ID1(2 * (q + PE_PD - 64) + 1));
                __builtin_amdgcn_sched_barrier(0);
            }
#pragma unroll
            for (int j = 0; j < 32; ++j) RM[j * 65 + lane] = part[j];
            float pre = 0.f;
            { const int cb = lane & 32;
#pragma unroll
              for (int k = 0; k < 32; ++k) pre += RM[l31 * 65 + cb + k]; }
            const int srcl = (2 * l31 + (lane >> 5)) * 4;
            const float gv = __int_as_float(__builtin_amdgcn_ds_bpermute(srcl, __float_as_int(g ? g_hi : g_lo)));
            const float sdv = __int_as_float(__builtin_amdgcn_ds_bpermute(srcl, __float_as_int(g ? sd_hi : sd_lo)));
            const float suv = __int_as_float(__builtin_amdgcn_ds_bpermute(srcl, __float_as_int(g ? su_hi : su_lo)));
            actg[g] = gelu_erf(pre * sdv) * gv * suv;
        }
        const float nsd_lo = SCD[nidx_lo], nsd_hi = SCD[nidx_hi], nsu_lo = SCU[nidx_lo], nsu_hi = SCU[nidx_hi];
        float acc[32];
#pragma unroll
        for (int i = 0; i < 32; ++i) acc[i] = 0.f;
#pragma unroll
        for (int g = 0; g < 2; ++g) {
            const float actv = actg[g];
#pragma unroll
            for (int j = 0; j < 32; ++j) {
                const int q = 32 * g + j;
                const float aA = __uint_as_float(__builtin_amdgcn_readlane(__float_as_uint(actv), j)), aB = __uint_as_float(__builtin_amdgcn_readlane(__float_as_uint(actv), j + 32));
                const float a = upper ? aB : aA;
                { const v32f d = dec6(ra[q % PE_PD]);
#pragma unroll
                  for (int i = 0; i < 32; ++i) acc[i] = fmaf(a, d[i], acc[i]); }
                asm volatile("" : "+v"(acc[0]), "+v"(acc[1]), "+v"(acc[2]), "+v"(acc[3]), "+v"(acc[4]), "+v"(acc[5]), "+v"(acc[6]), "+v"(acc[7]), "+v"(acc[8]), "+v"(acc[9]), "+v"(acc[10]), "+v"(acc[11]), "+v"(acc[12]), "+v"(acc[13]), "+v"(acc[14]), "+v"(acc[15]));
                asm volatile("" : "+v"(acc[16]), "+v"(acc[17]), "+v"(acc[18]), "+v"(acc[19]), "+v"(acc[20]), "+v"(acc[21]), "+v"(acc[22]), "+v"(acc[23]), "+v"(acc[24]), "+v"(acc[25]), "+v"(acc[26]), "+v"(acc[27]), "+v"(acc[28]), "+v"(acc[29]), "+v"(acc[30]), "+v"(acc[31]));
                if (q + PE_PD < 64) PE_LOAD6(ra[q % PE_PD], EU, PE_ID1(2 * (q + PE_PD)), PE_ID1(2 * (q + PE_PD) + 1));
                else PE_LOAD6(ra[q % PE_PD], ED, __builtin_amdgcn_readlane(nidx_lo, 2 * (q + PE_PD - 64)), __builtin_amdgcn_readlane(nidx_lo, 2 * (q + PE_PD - 64) + 1));
                __builtin_amdgcn_sched_barrier(0);
            }
        }
        float s2 = 0.f;
#pragma unroll
        for (int i = 0; i < 32; ++i) { acc[i] = sum_halves(acc[i]) + hv[i]; s2 = fmaf(acc[i], acc[i], s2); }
        s2 += swz_xor<1>(s2); s2 += swz_xor<2>(s2); s2 += swz_xor<4>(s2); s2 += swz_xor<8>(s2); s2 += swz_xor<16>(s2);
        const float r2 = rsqrtf(s2 * (1.f / 1024.f) + EPS);
        const float4* wf = (const float4*)(P.norm_final) + 8 * l31 + 4 * (lane >> 5); float4* o = (float4*)(P.out + (size_t)t * DM) + 8 * l31 + 4 * (lane >> 5);
#pragma unroll
        for (int k = 0; k < 4; ++k) { const float4 w = wf[k];
            const float e0 = upper ? acc[16 + 4 * k] : acc[4 * k], e1 = upper ? acc[17 + 4 * k] : acc[4 * k + 1], e2 = upper ? acc[18 + 4 * k] : acc[4 * k + 2], e3 = upper ? acc[19 + 4 * k] : acc[4 * k + 3];
            o[k] = make_float4(e0 * r2 * w.x, e1 * r2 * w.y, e2 * r2 * w.z, e3 * r2 * w.w); }
        idx_lo = nidx_lo; idx_hi = nidx_hi; g_lo = ng_lo; g_hi = ng_hi; sdr_lo = nsd_lo; sdr_hi = nsd_hi; su_lo = nsu_lo; su_hi = nsu_hi;
#pragma unroll
        for (int k = 0; k < 4; ++k) hq[k] = nh[k];
    }
}
constexpr int TK_LDK = 136, TK_K2 = 34816, TK_SCR = 69632, TK_SP = 49;
__device__ __forceinline__ int mono_key(float x) { const int b = __float_as_int(x); return b ^ ((b >> 31) & 0x7fffffff); }
__device__ __forceinline__ float unmono(int m) { return __int_as_float(m ^ ((m >> 31) & 0x7fffffff)); }
__device__ __forceinline__ int max3i(int a, int b, int c) { return max(max(a, b), c); }
__device__ __forceinline__ void topk_phase(Frame& F, const Ptrs& P) {
    const bf16* Q = (const bf16*)(P.ws + WS_PROJ); const float* SSQ = (const float*)(P.ws + WS_SSQ);
    int* IDX = (int*)(P.ws + WS_IDX); float* GATE = (float*)(P.ws + WS_GATE);
    LAS unsigned char* L = F.lds + RING_OFF;
    LAS bf16* K1 = (LAS bf16*)L; LAS bf16* K2 = (LAS bf16*)(L + TK_K2);
    const int tid_ = (F.wave * 64 + lane_id());
    for (int i = tid_; i < 16384; i += 512) { const int n = i >> 7, k = i & 127; K1[n * TK_LDK + k] = (bf16)f2bf(P.sk1[i]); K2[n * TK_LDK + k] = (bf16)f2bf(P.sk2[i]); }
    __syncthreads();
    const int lane = tid_ & 63, r = lane & 31, hh = lane >> 5;
    LAS int* scr = (LAS int*)(L + TK_SCR) + F.wave * (32 * TK_SP) + r * TK_SP;
    for (int wq = F.vcu * NWAVES + F.wave; wq < 2048; wq += F.G * NWAVES) {
        const int t = (wq >> 2) * 32 + r;
        float rstd;
        { const float4* sp = (const float4*)(SSQ + (size_t)t * 16); const float4 a = sp[0], b = sp[1], c = sp[2], d = sp[3];
          rstd = rsqrtf(((a.x + a.y + a.z + a.w) + (b.x + b.y + b.z + b.w) + (c.x + c.y + c.z + c.w) + (d.x + d.y + d.z + d.w)) * (1.f / 1024.f) + EPS); }
#pragma unroll 1
        for (int hq = 0; hq < 2; ++hq) {
            const int hd = (wq & 3) * 2 + hq;
#pragma unroll 1
            for (int half = 0; half < 2; ++half) {
                const LAS bf16* Kh = half ? K2 : K1;
                bf16x8 qf[8];
#pragma unroll
                for (int kk = 0; kk < 8; ++kk) qf[kk] = *(const bf16x8*)(Q + (size_t)t * 2048 + hd * 256 + half * 128 + 16 * kk + 8 * hh);
                int key[64];
#pragma unroll
                for (int nt = 0; nt < 4; ++nt) {
                    f32x16 sc;
#pragma unroll
                    for (int i = 0; i < 16; ++i) sc[i] = 0.f;
#pragma unroll
                    for (int kk = 0; kk < 8; ++kk) { const bf16x8 a = *(const LAS bf16x8*)(Kh + (32 * nt + r) * TK_LDK + 16 * kk + 8 * hh); sc = MFMA32(a, qf[kk], sc); }
#pragma unroll
                    for (int i = 0; i < 16; ++i) key[nt * 16 + i] = (mono_key(sc[i]) & ~127) | (127 - (32 * nt + crow(i, hh)));
                }
#pragma unroll 1
                for (int rd = 0; rd < 16; ++rd) {
                    int m0 = max3i(key[0], key[1], key[2]), m1 = max3i(key[3], key[4], key[5]);
#pragma unroll
                    for (int i = 6; i < 60; i += 6) { m0 = max3i(m0, key[i], key[i + 1]); m1 = max3i(m1, key[i + 2], key[i + 3]); m0 = max3i(m0, key[i + 4], key[i + 5]); }
                    m0 = max3i(m0, key[60], key[61]); m1 = max3i(m1, key[62], key[63]);
                    const int lm = max(m0, m1);
                    const int g = imax_halves(lm);
                    if (hh == 0) scr[half * 16 + rd] = g;
#pragma unroll
                    for (int i = 0; i < 64; ++i) key[i] = (key[i] == g) ? (int)0x80000000 : key[i];
                }
            }
            const LAS int* la = scr + hh * 16; const LAS int* lb = scr + (1 - hh) * 16;
            float va[4], vb[16];
#pragma unroll
            for (int i = 0; i < 4; ++i) va[i] = unmono(la[i] & ~127);
#pragma unroll
            for (int j = 0; j < 16; ++j) vb[j] = unmono(lb[j] & ~127);
            int ck[27];
            {
                int q = 0;
#pragma unroll
                for (int i = 0; i < 4; ++i)
#pragma unroll
                    for (int j = i; j < 16; ++j) if ((i + 1) * (j + 1) <= 16) {
                        const int pos = hh ? (j * 16 + i) : (i * 16 + j);
                        int k = (mono_key(va[i] + vb[j]) & ~255) | (255 - pos);
                        if (i == j && hh) k = (int)0x80000000;
                        ck[q++] = k; }
            }
#pragma unroll 1
            for (int rd = 0; rd < 16; ++rd) {
                int m0 = max3i(ck[0], ck[1], ck[2]);
#pragma unroll
                for (int i = 3; i < 27; i += 2) m0 = max3i(m0, ck[i], ck[i + 1]);
                const int g = imax_halves(m0);
                if (hh == 0) scr[32 + rd] = g;
#pragma unroll
                for (int i = 0; i < 27; ++i) ck[i] = (ck[i] == g) ? (int)0x80000000 : ck[i];
            }
            const float vmax = unmono(scr[32] & ~255) * rstd;
            float ev[8]; int id[8]; float esum = 0.f;
#pragma unroll
            for (int q = 0; q < 8; ++q) { const int wk = scr[32 + hh * 8 + q]; const int pos = 255 - (wk & 255);
                const int n1 = 127 - (scr[pos >> 4] & 127), n2 = 127 - (scr[16 + (pos & 15)] & 127);
                id[q] = n1 * 128 + n2;
                ev[q] = exp2f((unmono(wk & ~255) * rstd - vmax) * LOG2E); esum += ev[q]; }
            esum = sum_halves(esum);
            const float inv = 1.f / esum;
            int4* ip = (int4*)(IDX + ((size_t)t * 8 + hd) * 16 + hh * 8); float4* gp = (float4*)(GATE + ((size_t)t * 8 + hd) * 16 + hh * 8);
            ip[0] = make_int4(id[0], id[1], id[2], id[3]); ip[1] = make_int4(id[4], id[5], id[6], id[7]);
            gp[0] = make_float4(ev[0] * inv, ev[1] * inv, ev[2] * inv, ev[3] * inv); gp[1] = make_float4(ev[4] * inv, ev[5] * inv, ev[6] * inv, ev[7] * inv);
        }
    }
    __syncthreads();
}

constexpr int AT_KP = 72, AT_VP = 264;
constexpr int AT_K = 0, AT_VT = 36864, AT_BT = 36864 + 33792;
__device__ __forceinline__ void attn_phase(Frame& F, const Ptrs& P) {
    const bf16* PROJ = (const bf16*)(P.ws + WS_PROJ); bf16* CAT = (bf16*)(P.ws + WS_XN);
    LAS unsigned char* L = F.lds + RING_OFF;
    LAS bf16* Ks = (LAS bf16*)(L + AT_K); LAS bf16* Vt = (LAS bf16*)(L + AT_VT); LAS float* btab = (LAS float*)(L + AT_BT);
    const int lane = lane_id(), tid_ = F.wave * 64 + lane, r = lane & 31, hh = lane >> 5;
    for (int u = F.vcu; u < 256; u += F.G) {
        const int hkv = u & 1, n = (u >> 1) & 31, b = u >> 6;
        const int trow0 = b * SEQ + n * 128;
        for (int i = tid_; i < 2048; i += 512) {
            const int kj = i >> 3, ch = i & 7; const bool ok = (n > 0) || (kj >= 128);
            v4u kv = {0u, 0u, 0u, 0u}, vv = {0u, 0u, 0u, 0u};
            if (ok) { const bf16* rowp = PROJ + (size_t)(trow0 - 128 + kj) * NPROJ + hkv * 64 + ch * 8; kv = *(const v4u*)(rowp + PJ_K); vv = *(const v4u*)(rowp + PJ_V); }
            *(LAS v4u*)(Ks + kj * AT_KP + ch * 8) = kv;
            LAS bf16* vp = Vt + (ch * 8) * AT_VP + kj;
            vp[0] = (bf16)(vv.x & 0xffffu); vp[AT_VP] = (bf16)(vv.x >> 16); vp[2 * AT_VP] = (bf16)(vv.y & 0xffffu); vp[3 * AT_VP] = (bf16)(vv.y >> 16);
            vp[4 * AT_VP] = (bf16)(vv.z & 0xffffu); vp[5 * AT_VP] = (bf16)(vv.z >> 16); vp[6 * AT_VP] = (bf16)(vv.w & 0xffffu); vp[7 * AT_VP] = (bf16)(vv.w >> 16);
        }
        for (int i = tid_; i < 768; i += 512) { const int gg = i / 192, dist = i % 192 - 32;
            btab[i] = (dist >= 0 && dist < 128) ? P.rel_bias[c_bucket[dist & 127] * 8 + hkv * 4 + gg] * LOG2E : 0.f; }
        __syncthreads();
        const int g = F.wave & 3, h = hkv * 4 + g;
        const float sink2 = P.sinks[h] * LOG2E;
#pragma unroll 1
        for (int qq = 0; qq < 2; ++qq) {
            const int qt = (F.wave >> 2) * 2 + qq, t = trow0 + 32 * qt + r;
            bf16x8 qf[4];
#pragma unroll
            for (int kk = 0; kk < 4; ++kk) qf[kk] = *(const bf16x8*)(PROJ + (size_t)t * NPROJ + h * 64 + 16 * kk + 8 * hh);
            f32x16 sc[5];
#pragma unroll
            for (int j = 0; j < 5; ++j) {
#pragma unroll
                for (int i = 0; i < 16; ++i) sc[j][i] = 0.f;
#pragma unroll
                for (int kk = 0; kk < 4; ++kk) { const bf16x8 a = *(const LAS bf16x8*)(Ks + (32 * (qt + j) + r) * AT_KP + 16 * kk + 8 * hh); sc[j] = MFMA32(a, qf[kk], sc[j]); }
            }
            float m = sink2;
            const LAS float* bt = btab + g * 192 + 160 + r - 4 * hh;
#pragma unroll
            for (int j = 0; j < 5; ++j) {
                const bool tile_ok = (n > 0) || (qt + j >= 4);
#pragma unroll
                for (int i = 0; i < 16; ++i) { const int dist = 128 + r - (32 * j + crow(i, hh));
                    const bool ok = tile_ok && (j == 0 ? dist < 128 : (j == 4 ? dist >= 0 : true));
                    const float s = sc[j][i] * (0.125f * LOG2E) + bt[-(32 * j + (i & 3) + 8 * (i >> 2))];
                    sc[j][i] = ok ? s : -INFINITY; m = fmaxf(m, sc[j][i]); }
            }
            m = max_halves(m);
            float l = 0.f;
#pragma unroll
            for (int j = 0; j < 5; ++j)
#pragma unroll
                for (int i = 0; i < 16; ++i) { sc[j][i] = exp2f(sc[j][i] - m); l += sc[j][i]; }
            l = sum_halves(l);
            l += exp2f(sink2 - m);
            const float inv = 1.f / l;
            f32x16 o[2];
#pragma unroll
            for (int i = 0; i < 16; ++i) { o[0][i] = 0.f; o[1][i] = 0.f; }
#pragma unroll
            for (int j = 0; j < 5; ++j)
#pragma unroll
                for (int sg = 0; sg < 2; ++sg) {
                    const bf16x8 pf = pack8(sc[j], sg);
#pragma unroll
                    for (int dt = 0; dt < 2; ++dt) {
                        const LAS bf16* vb = Vt + (32 * dt + r) * AT_VP + 32 * (qt + j) + 16 * sg + 4 * hh;
                        const s16x4 lo = *(const LAS s16x4*)(vb), hi = *(const LAS s16x4*)(vb + 8);
                        o[dt] = MFMA32(__builtin_shufflevector(lo, hi, 0, 1, 2, 3, 4, 5, 6, 7), pf, o[dt]);
                    }
                }
            bf16* op = CAT + (size_t)t * DM + h * 64 + 4 * hh;
#pragma unroll
            for (int dt = 0; dt < 2; ++dt)
#pragma unroll
                for (int g4 = 0; g4 < 4; ++g4)
                    *(unsigned long long*)(op + 32 * dt + 8 * g4) = (unsigned long long)cvtpk(o[dt][4 * g4] * inv, o[dt][4 * g4 + 1] * inv) | ((unsigned long long)cvtpk(o[dt][4 * g4 + 2] * inv, o[dt][4 * g4 + 3] * inv) << 32);
        }
        __syncthreads();
    }
}
struct Args { Ptrs p; };
__global__ void __launch_bounds__(NWAVES * 64, 2) hymba_fwd(Args args) {
    extern __shared__ __attribute__((aligned(16))) unsigned char lds[];
    const Ptrs& P = args.p;
    Frame F;
    F.lds = (LAS unsigned char*)lds;
    F.MISC = (volatile LAS unsigned*)(F.lds + MISC_OFF);
    F.wave = __builtin_amdgcn_readfirstlane(threadIdx.x >> 6);
    F.G = gridDim.x; { const int bx = blockIdx.x; F.vcu = (F.G % 8 == 0) ? (bx % 8) * (F.G / 8) + bx / 8 : bx; }
    F.ctl = (gu32*)(P.ws + WS_CTL);
    for (int u = threadIdx.x; u < (LDS_BYTES - LDSCTL_OFF) / 4; u += NWAVES * 64) ((LAS unsigned*)(F.lds + LDSCTL_OFF))[u] = 0u;
    __syncthreads();
    XcdBarrier bar = xcd_barrier_post((unsigned*)(F.ctl + CW_BAR), F.MISC + 8);
#define GRID_BAR() xcd_barrier(bar)

    bf16* XN = (bf16*)(P.ws + WS_XN); bf16* PROJ = (bf16*)(P.ws + WS_PROJ); bf16* HB = (bf16*)(P.ws + WS_ST);
    p0_prologue(F, P);
    GRID_BAR();
    { pg8::Gemm g{XN, (const bf16*)(P.ws + WS_WIN), T_, NPROJ, DM, F.wave}; pg8::StaticOrder S; S.init(T_, NPROJ, F.G, (int)blockIdx.x);
      pg8::EpiBf16<0> E{PROJ, NPROJ, nullptr, 0, 0, 1.f};
      pg8::gemm_phase<pg8::EpiBf16<0>, pg8::StaticOrder, PG8_ALIGN, PG8_SP2>(F.lds + RING_OFF, g, S, E); }
    GRID_BAR();
    ssd_s1(F, P);
    attn_phase(F, P);
    GRID_BAR();
    ssd_s2(F, P);
    GRID_BAR();
    ssd_s3(F, P);
    GRID_BAR();
    { pg8::Gemm g{XN, (const bf16*)(P.ws + WS_WOUT), T_, DM, DM, F.wave}; pg8::StaticOrder S; S.init(T_, DM, F.G, (int)blockIdx.x);
      EpiResH E{P.x, HB, (float*)(P.ws + WS_SSQ)};
      pg8::gemm_phase<EpiResH, pg8::StaticOrder, PG8_ALIGN, PG8_SP2>(F.lds + RING_OFF, g, S, E); }
    GRID_BAR();
    { pg8::Gemm g{HB, (const bf16*)(P.ws + WS_WQ), T_, 2048, DM, F.wave}; pg8::StaticOrder S; S.init(T_, 2048, F.G, (int)blockIdx.x);
      pg8::EpiBf16<0> E{PROJ, 2048, nullptr, 0, 0, 1.f};
      pg8::gemm_phase<pg8::EpiBf16<0>, pg8::StaticOrder, PG8_ALIGN, PG8_SP2>(F.lds + RING_OFF, g, S, E); }
    GRID_BAR();
    topk_phase(F, P);
    GRID_BAR();
    peer_eval(F, P);
}

extern "C" void kernel_launch(void* const* d_in, const int* in_sizes, int n_in, void* d_out, int out_size, void* d_ws, size_t ws_size, hipStream_t stream) {
    static int grid = 0;
    if (grid == 0) {
        if (n_in != 19 || out_size != T_ * DM || ws_size < WS_END) { fprintf(stderr, "kernel_launch: unexpected shapes (n_in %d, out %d, ws %zu)\n", n_in, out_size, ws_size); grid = -1; return; }
        int dev = 0, cus = 0, per_cu = 0;
        if (hipGetDevice(&dev) != hipSuccess || hipDeviceGetAttribute(&cus, hipDeviceAttributeMultiprocessorCount, dev) != hipSuccess) { grid = -1; return; }
        if (hipFuncSetAttribute((const void*)hymba_fwd, hipFuncAttributeMaxDynamicSharedMemorySize, LDS_BYTES) != hipSuccess) { fprintf(stderr, "kernel_launch: hipFuncSetAttribute failed\n"); grid = -1; return; }
        if (hipOccupancyMaxActiveBlocksPerMultiprocessor(&per_cu, (const void*)hymba_fwd, NWAVES * 64, LDS_BYTES) != hipSuccess || per_cu < 1) { fprintf(stderr, "kernel_launch: occupancy query says %d blocks per CU\n", per_cu); grid = -1; (void)hipGetLastError(); return; }
        grid = cus;
    }
    if (grid < 0) return;
    (void)hipMemsetAsync((char*)d_ws + WS_CTL, 0, CTL_ZERO_BYTES, stream);
    Args a{};
    const float** pp = (const float**)&a.p;
    for (int i = 0; i < 19; ++i) pp[i] = (const float*)d_in[i];
    a.p.out = (float*)d_out; a.p.ws = (unsigned char*)d_ws;
    hipLaunchKernelGGL(hymba_fwd, dim3(grid), dim3(NWAVES * 64), LDS_BYTES, stream, a);
}
```

```cpp
#include <hip/hip_runtime.h>
#include <cstdio>
#include <cstdint>
#include <math.h>
namespace pg8 {
#define PG8_LAS __attribute__((address_space(3)))
typedef unsigned short bf16_t;
typedef short bf16x8 __attribute__((ext_vector_type(8)));
typedef float f32x4 __attribute__((ext_vector_type(4)));
typedef unsigned u32x4 __attribute__((ext_vector_type(4)));
constexpr int BM = 256, BK = 64, HALF = 128, HTB = HALF * BK * 2  , STAGE_BYTES = 8 * HTB, NXCD = 8, WGM = 8;

__host__ __device__ __forceinline__ int lds_byte(int r, int c) { const int st = (r >> 4) * 2 + (c >> 5), rr = r & 15, cc = c & 31, ob = rr * 64 + cc * 2; return st * 1024 + (ob ^ (((ob >> 9) & 1) << 5)); }
__host__ __device__ __forceinline__ void stage_rc(int b, int& R, int& C) { const int st = b / 1024, sb = b % 1024, swz = sb ^ (((sb >> 9) & 1) << 5); R = (st >> 1) * 16 + swz / 64; C = (st & 1) * 32 + (swz % 64) / 2; }
__host__ __device__ __forceinline__ int perm32(int rho) { const int n = rho >> 4, i = rho & 15; return 8 * (i >> 2) + 4 * n + (i & 3); }

struct Unit { int pm, pn; };
struct Gemm { const bf16_t* A; const bf16_t* Bt; int M, N, K, wave; };

struct StaticOrder {
    int nM, nN, nwg, G, c;
    __host__ __device__ void init(int M, int N, int G_, int c_) { nM = M / BM; nN = N / BM; nwg = nM * nN; G = G_; c = c_; }
    __host__ __device__ bool next(int i, Unit& u) const {
        const long L = (long)i * G + c; if (L >= nwg) return false;
        int wgid = (int)L; { const int q = nwg / NXCD, r = nwg % NXCD, xcd = wgid % NXCD, off = wgid / NXCD; wgid = (xcd < r ? xcd * (q + 1) : r * (q + 1) + (xcd - r) * q) + off; }
        const int nig = WGM * nN, gid = wgid / nig, fm = gid * WGM, gsz = (nM - fm) < WGM ? (nM - fm) : WGM;
        u.pm = fm + ((wgid % nig) % gsz); u.pn = (wgid % nig) / gsz; return true;
    }
    __device__ __forceinline__ void a_ready(const Unit&) const {}
    __device__ __forceinline__ void done(const Unit&) const {}
};

__device__ __forceinline__ unsigned cvt_pk_bf16(float lo, float hi) { unsigned r; asm volatile("v_cvt_pk_bf16_f32 %0, %1, %2" : "=v"(r) : "v"(lo), "v"(hi)); return r; }
typedef float f32x2 __attribute__((ext_vector_type(2)));
__device__ __forceinline__ f32x2 gelu_pk(f32x2 v) {
    const f32x2 av = __builtin_elementwise_abs(v), d = av * 0.2316418882f + 1.0f;
    f32x2 t; t.x = __builtin_amdgcn_rcpf(d.x); t.y = __builtin_amdgcn_rcpf(d.y);
    f32x2 q = t * 0.5307027145f + (-0.7265760135f); q = q * t + 0.7107068705f; q = q * t + (-0.142248368f); q = q * t + 0.127414796f; q = q * t;
    const f32x2 s = (v * v) * (-0.72134752044f);
    f32x2 e; e.x = __builtin_amdgcn_exp2f(s.x); e.y = __builtin_amdgcn_exp2f(s.y);
    const f32x2 m = v * (q * e), r = v - m;
    f32x2 o; o.x = v.x < 0.f ? m.x : r.x; o.y = v.y < 0.f ? m.y : r.y; return o;
}

template <int ACT  > struct EpiBf16 {
    static constexpr bool PERM = true, AFTER_DRAIN = false; static_assert(ACT == 0 || ACT == 1, "EpiBf16: ACT is 0 (none) or 1 (gelu_pk)");
    bf16_t* O; int ldc; const float* bias; int split_cols; size_t split_stride; float scale0;
    __device__ __forceinline__ void operator()(const f32x4 (&acc)[2][2][4][2], const Unit& u, int wr, int wc, int fr, int fq) const {
        const int row0 = u.pm * BM + wr * 64 + fr; int colt = u.pn * BM; bf16_t* base = O;
        float sc = 1.f; if (split_cols) { const int t = colt / split_cols; base += (size_t)t * split_stride; colt -= t * split_cols; if (t == 0) sc = scale0; }
        const int col0 = colt + wc * 32 + 8 * fq, bcol0 = u.pn * BM + wc * 32 + 8 * fq;
        f32x4 bv[2][2];
#pragma unroll
        for (int bj = 0; bj < 2; ++bj)
#pragma unroll
            for (int n = 0; n < 2; ++n) bv[bj][n] = bias ? *(const f32x4*)(bias + bcol0 + bj * HALF + 4 * n) : (f32x4){0.f, 0.f, 0.f, 0.f};
#pragma unroll
        for (int ai = 0; ai < 2; ++ai)
#pragma unroll
            for (int m = 0; m < 4; ++m) { bf16_t* rowp = base + (size_t)(row0 + ai * HALF + m * 16) * ldc + col0;
#pragma unroll
                for (int bj = 0; bj < 2; ++bj) { f32x4 v0 = acc[ai][bj][m][0] + bv[bj][0], v1 = acc[ai][bj][m][1] + bv[bj][1];
                    if (ACT == 1) { f32x2 a = gelu_pk((f32x2){v0[0], v0[1]}), b = gelu_pk((f32x2){v0[2], v0[3]}), c = gelu_pk((f32x2){v1[0], v1[1]}), d = gelu_pk((f32x2){v1[2], v1[3]});
                        v0 = (f32x4){a.x, a.y, b.x, b.y}; v1 = (f32x4){c.x, c.y, d.x, d.y}; }
                    v0 = v0 * sc; v1 = v1 * sc; u32x4 w; w.x = cvt_pk_bf16(v0[0], v0[1]); w.y = cvt_pk_bf16(v0[2], v0[3]); w.z = cvt_pk_bf16(v1[0], v1[1]); w.w = cvt_pk_bf16(v1[2], v1[3]);
                    *(u32x4*)(rowp + bj * HALF) = w; } }
    }
};
template <class Epi, class Sched, bool ALIGN_EPI = false, bool SP2 = false>
__device__ __forceinline__ void gemm_phase(PG8_LAS unsigned char* lds, const Gemm g, const Sched& S, const Epi& E) {
    int lane_l; asm volatile("v_mbcnt_lo_u32_b32 %0, -1, 0\n\tv_mbcnt_hi_u32_b32 %0, -1, %0" : "=v"(lane_l));
    const int wid = g.wave, lane = lane_l, tid = wid * 64 + lane,
              wr = wid >> 2, wc = wid & 3, fr = lane & 15, fq = lane >> 4;
    const int K = g.K, nt = K / BK;
    unsigned voffA[2], voffB[2];
#pragma unroll
    for (int i = 0; i < 2; ++i) { int R, C; stage_rc(tid * 16 + i * 8192, R, C); const int Rb = Epi::PERM ? ((R & ~31) + perm32(R & 31)) : R;
        voffA[i] = (unsigned)(R * K + C) * 2u; voffB[i] = (unsigned)(Rb * K + C) * 2u; }
    const size_t kstep = (size_t)(BK * 2);
    const size_t hstep = (size_t)HALF * K * 2;
    const size_t tstep = 2 * hstep;
    const unsigned ldsw = (unsigned)wid * 1024u;
    const int aoff = lds_byte(wr * 64 + fr, fq * 8), boff = lds_byte(wc * 32 + fr, fq * 8);
#define PG8_SA(b, h) (((b) * 2 + (h)) * HTB)
#define PG8_SB(b, h) ((4 + (b) * 2 + (h)) * HTB)
#define PG8_STAGE(bufoff, gbase, voff) do { _Pragma("unroll") for (int _i = 0; _i < 2; ++_i) \
        __builtin_amdgcn_global_load_lds((const unsigned*)((const char*)(gbase) + (voff)[_i]), (PG8_LAS unsigned*)(lds + (bufoff) + ldsw + _i * 8192), 16, 0, 0); } while (0)
#define PG8_LDA(dst, b, h) do { _Pragma("unroll") for (int m = 0; m < 4; ++m) _Pragma("unroll") for (int k = 0; k < 2; ++k) dst[m][k] = *(const PG8_LAS bf16x8*)(lds + PG8_SA(b, h) + aoff + m * 2048 + k * 1024); } while (0)
#define PG8_LDB(dst, b, h) do { _Pragma("unroll") for (int n = 0; n < 2; ++n) _Pragma("unroll") for (int k = 0; k < 2; ++k) dst[n][k] = *(const PG8_LAS bf16x8*)(lds + PG8_SB(b, h) + boff + n * 2048 + k * 1024); } while (0)
#define PG8_MMA(ai, bj, At, Bt) do { __builtin_amdgcn_s_setprio(1); _Pragma("unroll") for (int m = 0; m < 4; ++m) _Pragma("unroll") for (int n = 0; n < 2; ++n) _Pragma("unroll") for (int k = 0; k < 2; ++k) \
        acc[ai][bj][m][n] = __builtin_amdgcn_mfma_f32_16x16x32_bf16(Bt[n][k], At[m][k], acc[ai][bj][m][n], 0, 0, 0); __builtin_amdgcn_s_setprio(0); } while (0)
#define PG8_WAIT_V(n) asm volatile("s_waitcnt vmcnt(" #n ")" ::: "memory")
#define PG8_WAIT_L(n) asm volatile("s_waitcnt lgkmcnt(" #n ")" ::: "memory")
#define PG8_BAR __builtin_amdgcn_s_barrier()
#define PG8_SCHED __builtin_amdgcn_sched_barrier(0)
    Unit cur, nxt; int ui = 0;
    if (!S.next(0, cur)) return;
    f32x4 acc[2][2][4][2];
#pragma unroll
    for (int a = 0; a < 2; ++a)
#pragma unroll
        for (int b = 0; b < 2; ++b)
#pragma unroll
            for (int m = 0; m < 4; ++m)
#pragma unroll
                for (int n = 0; n < 2; ++n) acc[a][b][m][n] = (f32x4){0.f, 0.f, 0.f, 0.f};
    bf16x8 At[4][2], B0[2][2], B1[2][2];
    const char* cA = (const char*)g.A + (size_t)cur.pm * tstep; const char* cB = (const char*)g.Bt + (size_t)cur.pn * tstep;
    S.a_ready(cur);
    if constexpr (SP2) {
        PG8_STAGE(PG8_SB(0, 0), cB, voffB); PG8_STAGE(PG8_SB(0, 1), cB + hstep, voffB); PG8_STAGE(PG8_SA(0, 0), cA, voffA); PG8_STAGE(PG8_SA(0, 1), cA + hstep, voffA);
        if (wr == 1) PG8_BAR;
        PG8_WAIT_V(2); PG8_BAR;
        PG8_STAGE(PG8_SB(1, 0), cB + kstep, voffB); PG8_STAGE(PG8_SA(1, 0), cA + kstep, voffA); PG8_STAGE(PG8_SB(1, 1), cB + hstep + kstep, voffB);
        PG8_WAIT_V(6); PG8_BAR;
    } else {
        PG8_STAGE(PG8_SB(0, 0), cB, voffB); PG8_STAGE(PG8_SA(0, 0), cA, voffA); PG8_STAGE(PG8_SB(0, 1), cB + hstep, voffB); PG8_STAGE(PG8_SA(0, 1), cA + hstep, voffA);
        if (wr == 1) PG8_BAR;
        PG8_WAIT_V(4); PG8_BAR;
        PG8_STAGE(PG8_SB(1, 0), cB + kstep, voffB); PG8_STAGE(PG8_SA(1, 0), cA + kstep, voffA); PG8_STAGE(PG8_SB(1, 1), cB + hstep + kstep, voffB);
        PG8_WAIT_V(6); PG8_BAR;
    }
    for (;;) {
        const bool has_next = S.next(ui + 1, nxt);
        const char* nA = has_next ? (const char*)g.A + (size_t)nxt.pm * tstep : cA; const char* nB = has_next ? (const char*)g.Bt + (size_t)nxt.pn * tstep : cB;
        for (int t = 0; t < nt; t += 2) {
            const bool last = (t == nt - 2);
            const char* a1 = cA + (size_t)(t + 1) * kstep;
            const char* a2 = last ? nA : cA + (size_t)(t + 2) * kstep; const char* b2 = last ? nB : cB + (size_t)(t + 2) * kstep;
            const char* a3 = a2 + kstep; const char* b3 = b2 + kstep;
            if (last && has_next) S.a_ready(nxt);
            if constexpr (SP2) {
            PG8_LDB(B0, 0, 0); PG8_LDB(B1, 0, 1); PG8_SCHED; PG8_LDA(At, 0, 0); PG8_STAGE(PG8_SA(1, 1), a1 + hstep, voffA);
            PG8_WAIT_V(8); PG8_WAIT_L(0); PG8_BAR; PG8_MMA(0, 0, At, B0); PG8_MMA(0, 1, At, B1); PG8_BAR; PG8_SCHED;
            PG8_LDA(At, 0, 1); PG8_STAGE(PG8_SB(0, 0), b2, voffB); PG8_STAGE(PG8_SB(0, 1), b2 + hstep, voffB); PG8_STAGE(PG8_SA(0, 0), a2, voffA);
            PG8_WAIT_V(8); PG8_WAIT_L(0); PG8_BAR; PG8_MMA(1, 0, At, B0); PG8_MMA(1, 1, At, B1); PG8_BAR; PG8_SCHED;
            PG8_LDB(B0, 1, 0); PG8_LDB(B1, 1, 1); PG8_SCHED; PG8_LDA(At, 1, 0); PG8_STAGE(PG8_SA(0, 1), a2 + hstep, voffA);
            PG8_WAIT_V(8); PG8_WAIT_L(0); PG8_BAR; PG8_MMA(0, 0, At, B0); PG8_MMA(0, 1, At, B1); PG8_BAR; PG8_SCHED;
            PG8_LDA(At, 1, 1); PG8_STAGE(PG8_SB(1, 0), b3, voffB); PG8_STAGE(PG8_SB(1, 1), b3 + hstep, voffB); PG8_STAGE(PG8_SA(1, 0), a3, voffA);
            PG8_WAIT_V(8); PG8_WAIT_L(0); PG8_BAR; PG8_MMA(1, 0, At, B0); PG8_MMA(1, 1, At, B1); PG8_BAR; PG8_SCHED;
            } else {
            PG8_LDB(B0, 0, 0); PG8_SCHED; PG8_LDA(At, 0, 0); PG8_STAGE(PG8_SA(1, 1), a1 + hstep, voffA);
            PG8_WAIT_L(8); PG8_BAR; PG8_WAIT_L(0); PG8_MMA(0, 0, At, B0); PG8_BAR; PG8_SCHED;
            PG8_LDB(B1, 0, 1); PG8_STAGE(PG8_SB(0, 0), b2, voffB);
            PG8_BAR; PG8_WAIT_L(0); PG8_MMA(0, 1, At, B1); PG8_BAR;
            PG8_LDA(At, 0, 1); PG8_STAGE(PG8_SA(0, 0), a2, voffA);
            PG8_BAR; PG8_WAIT_L(0); PG8_MMA(1, 0, At, B0); PG8_BAR; PG8_SCHED;
            PG8_STAGE(PG8_SB(0, 1), b2 + hstep, voffB);
            PG8_WAIT_V(6); PG8_BAR; PG8_MMA(1, 1, At, B1); PG8_BAR;
            PG8_LDB(B0, 1, 0); PG8_SCHED; PG8_LDA(At, 1, 0); PG8_STAGE(PG8_SA(0, 1), a2 + hstep, voffA);
            PG8_WAIT_L(8); PG8_BAR; PG8_WAIT_L(0); PG8_MMA(0, 0, At, B0); PG8_BAR; PG8_SCHED;
            PG8_LDB(B1, 1, 1); PG8_STAGE(PG8_SB(1, 0), b3, voffB);
            PG8_BAR; PG8_WAIT_L(0); PG8_MMA(0, 1, At, B1); PG8_BAR;
            PG8_LDA(At, 1, 1); PG8_STAGE(PG8_SA(1, 0), a3, voffA);
            PG8_BAR; PG8_WAIT_L(0); PG8_MMA(1, 0, At, B0); PG8_BAR; PG8_SCHED;
            PG8_STAGE(PG8_SB(1, 1), b3 + hstep, voffB);
            PG8_WAIT_V(6); PG8_BAR; PG8_MMA(1, 1, At, B1); PG8_BAR;
            }
        }
        if constexpr (ALIGN_EPI) { if (wr == 0) PG8_BAR; }
        if constexpr (!Epi::AFTER_DRAIN) { E(acc, cur, wr, wc, fr, fq); S.done(cur); }
        if (!has_next) break;
#pragma unroll
        for (int a = 0; a < 2; ++a)
#pragma unroll
            for (int b = 0; b < 2; ++b)
#pragma unroll
                for (int m = 0; m < 4; ++m)
#pragma unroll
                    for (int n = 0; n < 2; ++n) acc[a][b][m][n] = (f32x4){0.f, 0.f, 0.f, 0.f};
        cur = nxt; cA = nA; cB = nB; ++ui;
        if constexpr (ALIGN_EPI) { if (wr == 1) PG8_BAR; }
    }
    PG8_WAIT_V(0);
    if constexpr (!ALIGN_EPI) { if (wr == 0) PG8_BAR; }
    PG8_BAR;
    if constexpr (Epi::AFTER_DRAIN) { E.fused(acc, cur, wr, wc, fr, fq, lds, wid, lane); S.done(cur); }
#undef PG8_SA
#undef PG8_SB
#undef PG8_STAGE
#undef PG8_LDA
#undef PG8_LDB
#undef PG8_MMA
#undef PG8_WAIT_V
#undef PG8_WAIT_L
#undef PG8_BAR
#undef PG8_SCHED
}
}

#ifndef PG8_SP2
#define PG8_SP2 true
#endif
#ifndef PG8_ALIGN
#define PG8_ALIGN true
#endif
#define GAS __attribute__((address_space(1)))
#define LAS __attribute__((address_space(3)))
typedef unsigned short bf16;
typedef unsigned v4u __attribute__((ext_vector_type(4)));
typedef float f32x4 __attribute__((ext_vector_type(4)));
typedef short bf16x8 __attribute__((ext_vector_type(8)));
typedef GAS unsigned gu32;
typedef GAS unsigned long long gu64;
#define RLX_AGENT __ATOMIC_RELAXED, __HIP_MEMORY_SCOPE_AGENT
#define LDS_WAIT() asm volatile("s_waitcnt lgkmcnt(0)" ::: "memory")
#define VM_WAIT() asm volatile("s_waitcnt vmcnt(0)" ::: "memory")
__device__ __forceinline__ unsigned long long rt() { return __builtin_amdgcn_s_memrealtime(); }
__device__ __forceinline__ unsigned f2bf(float f) { unsigned u = __builtin_bit_cast(unsigned, f); return (u + 0x7fffu + ((u >> 16) & 1u)) >> 16; }
__device__ __forceinline__ unsigned pk2(float lo, float hi) { return f2bf(lo) | (f2bf(hi) << 16); }

#define XB_TMO      128
#define XB_XCNT(j)  (256  + 64 * (j))
#define XB_XSUB(j)  (1280 + 64 * (j))
#define XB_XGEN(j)  (2304 + 64 * (j))
#define XB_TOP      3328
#define XB_TOPGEN   3392
#define XCD_BAR_WORDS 3456
#define XB_SPIN_CAP (1u << 22)

__device__ __forceinline__ unsigned xb_ld(unsigned* p)              { return __hip_atomic_load(p, __ATOMIC_RELAXED, __HIP_MEMORY_SCOPE_AGENT); }
__device__ __forceinline__ unsigned xb_add(unsigned* p, unsigned v) { return __hip_atomic_fetch_add(p, v, __ATOMIC_RELAXED, __HIP_MEMORY_SCOPE_AGENT); }
__device__ __forceinline__ unsigned xb_xcc_id() { return (unsigned)__builtin_amdgcn_s_getreg((3 << 11) | 20) & 0xFu; }
#define XB_SPIN(cond, bar) do { unsigned _sp = 0; while (cond) { __builtin_amdgcn_s_sleep(1); \
    if ((++_sp & 255u) == 0u) { if (xb_ld(&(bar)[XB_TMO])) break; if (_sp > XB_SPIN_CAP) { atomicAdd(&(bar)[XB_TMO], 1u); break; } } } } while (0)

struct XcdBarrier {
    unsigned* bar; unsigned x;
    volatile LAS unsigned* st;
};

__device__ __forceinline__ XcdBarrier xcd_barrier_post(unsigned* bar, volatile LAS unsigned* st) {
    XcdBarrier b; b.bar = bar; b.x = xb_xcc_id(); b.st = st;
    if (threadIdx.x == 0) (void)xb_add(&bar[XB_XCNT(b.x)], 1u);
    return b;
}
__device__ __forceinline__ void xcd_barrier_complete(unsigned* bar, unsigned x, unsigned& nloc, unsigned& nx) {
    const unsigned G = gridDim.x * gridDim.y * gridDim.z;
    unsigned sum, cnt, mine, sp = 0u;
    for (;;) {
        sum = 0u; cnt = 0u; mine = 0u;
#pragma unroll
        for (unsigned j = 0; j < 16; ++j) { const unsigned c = xb_ld(&bar[XB_XCNT(j)]); sum += c; cnt += (c > 0u) ? 1u : 0u; mine = (j == x) ? c : mine; }
        if (sum == G) break;
        __builtin_amdgcn_s_sleep(1);
        if ((++sp & 255u) == 0u) { if (xb_ld(&bar[XB_TMO])) break; if (sp > XB_SPIN_CAP) { atomicAdd(&bar[XB_TMO], 1u); break; } }
    }
    nloc = mine > 0u ? mine : 1u; nx = cnt > 0u ? cnt : 1u;
}

__device__ __forceinline__ void xcd_barrier(const XcdBarrier& b) {
    asm volatile("s_waitcnt vmcnt(0)" ::: "memory");
    __syncthreads();
    if (threadIdx.x == 0) {
        unsigned* bar = b.bar;
        __builtin_amdgcn_s_waitcnt(0);
        unsigned nloc = b.st[0], nx = b.st[1];
        if (nloc == 0u) { xcd_barrier_complete(bar, b.x, nloc, nx); b.st[0] = nloc; b.st[1] = nx; }
        const unsigned old = xb_add(&bar[XB_XSUB(b.x)], 1u);
        const unsigned gen = old / nloc;
        if (old + 1u == (gen + 1u) * nloc) {
            __builtin_amdgcn_fence(__ATOMIC_RELEASE, "agent");
            asm volatile("s_waitcnt vmcnt(0)" ::: "memory");
            const unsigned og = xb_add(&bar[XB_TOP], 1u);
            const unsigned tg = og / nx;
            if (og + 1u == (tg + 1u) * nx) xb_add(&bar[XB_TOPGEN], 1u);
            else XB_SPIN(xb_ld(&bar[XB_TOPGEN]) == tg, bar);
            __builtin_amdgcn_fence(__ATOMIC_ACQUIRE, "agent");
            xb_add(&bar[XB_XGEN(b.x)], 1u);
            asm volatile("s_waitcnt vmcnt(0)" ::: "memory");
        } else {
            XB_SPIN(xb_ld(&bar[XB_XGEN(b.x)]) == gen, bar);
            __builtin_amdgcn_fence(__ATOMIC_ACQUIRE, "agent");
            asm volatile("s_waitcnt vmcnt(0)" ::: "memory");
        }
    }
    __syncthreads();
}

constexpr int NWAVES = 8;
constexpr int T_ = 16384, SEQ = 4096, DM = 1024, NPROJ = 2304, INC = 2312;
constexpr int PJ_K = 512, PJ_V = 640, PJ_Z = 768, PJ_XBC = 1280;
constexpr float EPS = 1e-6f;
constexpr size_t MiB = 1u << 20;
constexpr size_t WS_CTL = 0, CTL_ZERO_BYTES = 1 * MiB;
constexpr size_t WS_SMALL = 1 * MiB;
constexpr size_t WS_WIN = 2 * MiB, WS_WOUT = 7 * MiB, WS_WQ = 9 * MiB;
constexpr size_t WS_ED = 13 * MiB, WS_EU = 25 * MiB;
constexpr size_t WS_XN = 77 * MiB;
constexpr size_t WS_PROJ = 109 * MiB;
constexpr size_t WS_ST = 181 * MiB;
constexpr size_t WS_IDX = 213 * MiB, WS_GATE = 221 * MiB, WS_SSQ = 229 * MiB, WS_END = 230 * MiB;
constexpr size_t DO_Y = 0, DO_DT = 41 * MiB;
constexpr size_t WS_CC = 230 * MiB, WS_DT = 238 * MiB, WS_EA = 239 * MiB, WS_CDEC = 240 * MiB, WS_PREV = WS_IDX;
constexpr size_t DO_YPF = 0, DO_YPLAIN = 32 * MiB;
constexpr int CW_BAR = 4096;
constexpr int RING_OFF = 0, RING_BYTES = 131072, LDSCTL_OFF = RING_BYTES, MISC_OFF = LDSCTL_OFF + 320, LDS_BYTES = 147456;

__constant__ unsigned char c_bucket[128] = {0, 1, 2, 3, 4, 5, 6, 7, 8, 9, 10, 11, 12, 13, 14, 15, 16, 16, 16, 17, 17, 18, 18, 18, 19, 19, 19, 20, 20, 20, 20, 21, 21, 21, 21, 22, 22, 22, 22, 22, 23, 23, 23, 23, 23, 23, 24, 24, 24, 24, 24, 24, 25, 25, 25, 25, 25, 25, 25, 26, 26, 26, 26, 26, 26, 26, 26, 27, 27, 27, 27, 27, 27, 27, 27, 27, 27, 28, 28, 28, 28, 28, 28, 28, 28, 28, 28, 29, 29, 29, 29, 29, 29, 29, 29, 29, 29, 29, 29, 30, 30, 30, 30, 30, 30, 30, 30, 30, 30, 30, 30, 30, 30, 31, 31, 31, 31, 31, 31, 31, 31, 31, 31, 31, 31, 31, 31, 31};

typedef float v16f __attribute__((ext_vector_type(16)));
typedef float v32f __attribute__((ext_vector_type(32)));
typedef unsigned v6u __attribute__((ext_vector_type(6)));
typedef _Float16 v32h __attribute__((ext_vector_type(32)));
struct Frame {
    LAS unsigned char* lds;
    volatile LAS unsigned* MISC;
    gu32* ctl;
    int wave, vcu, G;
};
__device__ __forceinline__ int lane_id() { int l; asm volatile("v_mbcnt_lo_u32_b32 %0, -1, 0\n\tv_mbcnt_hi_u32_b32 %0, -1, %0" : "=v"(l)); return l; }
__device__ __forceinline__ int opq(int x) { asm volatile("" : "+v"(x)); return x; }
template <int M> __device__ __forceinline__ float swz_xor(float v) { return __int_as_float(__builtin_amdgcn_ds_swizzle(__float_as_int(v), (M << 10) | 0x1F)); }
__device__ __forceinline__ float sum_halves(float v) { const auto r = __builtin_amdgcn_permlane32_swap(__float_as_uint(v), __float_as_uint(v), false, false); return __uint_as_float(r[0]) + __uint_as_float(r[1]); }
__device__ __forceinline__ float max_halves(float v) { const auto r = __builtin_amdgcn_permlane32_swap(__float_as_uint(v), __float_as_uint(v), false, false); return fmaxf(__uint_as_float(r[0]), __uint_as_float(r[1])); }
__device__ __forceinline__ int imax_halves(int v) { const auto r = __builtin_amdgcn_permlane32_swap((unsigned)v, (unsigned)v, false, false); return max((int)r[0], (int)r[1]); }
__device__ __forceinline__ float wave_sum(float v) {
    v += swz_xor<1>(v); v += swz_xor<2>(v); v += swz_xor<4>(v); v += swz_xor<8>(v); v += swz_xor<16>(v);
    return sum_halves(v);
}
__device__ __forceinline__ float bf2f(unsigned short b) { return __uint_as_float((unsigned)b << 16); }
__device__ __forceinline__ float bflo(unsigned w) { return __uint_as_float(w << 16); }
__device__ __forceinline__ float bfhi(unsigned w) { return __uint_as_float(w & 0xffff0000u); }
__device__ __forceinline__ float silu_f(float x) { return x / (1.f + __expf(-x)); }

__device__ __forceinline__ void p0_transpose_item(const float* W, int ldw, int K, int nblk, bf16* WT, const float* kscale, LAS float* scr, int item, int lane) {
    const int kb = item / nblk, nb = item % nblk, k0 = 64 * kb, n0 = 32 * nb;
#pragma unroll 8
    for (int i = 0; i < 32; ++i) { const int kk = 2 * i + (lane >> 5); float v = W[(size_t)(k0 + kk) * ldw + n0 + (lane & 31)]; if (kscale) v *= kscale[k0 + kk]; scr[kk * 33 + (lane & 31)] = v; }
    LDS_WAIT(); asm volatile("" ::: "memory");
    const int c = lane & 7;
#pragma unroll
    for (int j = 0; j < 4; ++j) { const int n = (lane >> 3) + 8 * j; const LAS float* s = scr + (8 * c) * 33 + n;
        v4u o; o.x = pk2(s[0 * 33], s[1 * 33]); o.y = pk2(s[2 * 33], s[3 * 33]); o.z = pk2(s[4 * 33], s[5 * 33]); o.w = pk2(s[6 * 33], s[7 * 33]);
        *(GAS v4u*)(WT + (size_t)(n0 + n) * K + k0 + 8 * c) = o; }
    LDS_WAIT(); asm volatile("" ::: "memory");
}
struct Ptrs {
    const float *x, *norm_mix, *w_in, *conv_w, *conv_b, *dt_bias, *a_log, *d_skip, *ssd_norm_w, *sinks, *w_out, *rel_bias, *norm_ffn, *w_query, *sk1, *sk2, *e_down, *e_up, *norm_final;
    float* out; unsigned char* ws;
};
constexpr int Q_SPLIT = 8192;
__device__ __forceinline__ void quant_fp6(const Ptrs& P, int lane_, int q_lo, int q_hi, int w, int nw) {
    { float* SC = (float*)(P.ws + WS_SMALL); const int l31 = lane_ & 31, hf = lane_ >> 5;
      for (int q = q_lo + w; q < q_hi; q += nw) {
        const int row = 2 * q + hf, isup = row >> 14, e = row & 16383;
        const float4* src = (const float4*)((isup ? P.e_up : P.e_down) + (size_t)e * DM) + 8 * l31;
        float v[32];
#pragma unroll
        for (int k = 0; k < 8; ++k) { const float4 t = src[k]; v[4 * k] = t.x; v[4 * k + 1] = t.y; v[4 * k + 2] = t.z; v[4 * k + 3] = t.w; }
        if (!isup) {
#pragma unroll
            for (int k = 0; k < 8; ++k) { const float4 w = ((const float4*)P.norm_ffn)[8 * l31 + k]; v[4 * k] *= w.x; v[4 * k + 1] *= w.y; v[4 * k + 2] *= w.z; v[4 * k + 3] *= w.w; } }
        float am = 0.f;
#pragma unroll
        for (int k = 0; k < 32; ++k) am = fmaxf(am, fabsf(v[k]));
        am = fmaxf(am, swz_xor<1>(am)); am = fmaxf(am, swz_xor<2>(am)); am = fmaxf(am, swz_xor<4>(am)); am = fmaxf(am, swz_xor<8>(am)); am = fmaxf(am, swz_xor<16>(am));
        am = fmaxf(am, 1e-30f);
        const float inv = 7.5f / am;
        v32h xh;
#pragma unroll
        for (int k = 0; k < 32; ++k) xh[k] = (_Float16)(v[k] * inv);
        const v6u pk = __builtin_amdgcn_cvt_scalef32_pk32_fp6_f16(xh, 1.0f);
        unsigned char* dst = P.ws + WS_ED + (size_t)row * 768;
        *(v4u*)(dst + 16 * l31) = (v4u){pk[0], pk[1], pk[2], pk[3]};
        *(unsigned long long*)(dst + 512 + 8 * l31) = (unsigned long long)pk[4] | ((unsigned long long)pk[5] << 32);
        if (l31 == 0) SC[row] = am * (1.f / 7.5f);
      } }
}
__device__ __forceinline__ void p0_prologue(Frame& F0, const Ptrs& P) {
    const Frame& F = F0; const int lane_ = lane_id(), tid_ = F.wave * 64 + lane_;
    LAS float* scr = (LAS float*)(F.lds + RING_OFF + F.wave * 16384);
    const int gw = F.vcu * NWAVES + F.wave, NGW = F.G * NWAVES;
    bf16* Win_t = (bf16*)(P.ws + WS_WIN); bf16* Wout_t = (bf16*)(P.ws + WS_WOUT); bf16* Wq_t = (bf16*)(P.ws + WS_WQ);
    constexpr int I_IN = 16 * 72, I_OUT = 16 * 32, I_Q = 16 * 64, NITEMS = I_IN + I_OUT + I_Q;
    for (int it = gw; it < NITEMS; it += NGW) {
        int r = it;
        if (r < I_IN) { p0_transpose_item(P.w_in, INC, DM, 72, Win_t, nullptr, scr, r, lane_); continue; } r -= I_IN;
        if (r < I_OUT) { p0_transpose_item(P.w_out, DM, DM, 32, Wout_t, nullptr, scr, r, lane_); continue; } r -= I_OUT;
        p0_transpose_item(P.w_query, 2048, DM, 64, Wq_t, P.norm_ffn, scr, r, lane_);
    }
    quant_fp6(P, lane_, 0, Q_SPLIT, gw, NGW);
    __syncthreads();
    { LAS float* Wdt = (LAS float*)(F.lds + RING_OFF);
      for (int i = tid_; i < 8192; i += 512) Wdt[i] = P.w_in[(size_t)(i >> 3) * INC + NPROJ + (i & 7)];
      __syncthreads();
      bf16* XN = (bf16*)(P.ws + WS_XN); float* DT = (float*)(P.ws + WS_DT);
      for (int m0 = gw * 2; m0 < T_; m0 += NGW * 2) {
        float4 xv[2][4];
#pragma unroll
        for (int rr = 0; rr < 2; ++rr) { const float4* xr = (const float4*)(P.x + (size_t)(m0 + rr) * DM);
#pragma unroll
            for (int j = 0; j < 4; ++j) xv[rr][j] = xr[j * 64 + lane_]; }
#pragma unroll
        for (int rr = 0; rr < 2; ++rr) { const int m = m0 + rr;
        float4 v[4]; float s = 0.f;
#pragma unroll
        for (int j = 0; j < 4; ++j) { v[j] = xv[rr][j]; s += v[j].x * v[j].x + v[j].y * v[j].y + v[j].z * v[j].z + v[j].w * v[j].w; }
        const float r = rsqrtf(wave_sum(s) * (1.f / 1024.f) + EPS);
        float d8[8];
#pragma unroll
        for (int q = 0; q < 8; ++q) d8[q] = 0.f;
        unsigned long long* o8 = (unsigned long long*)(XN + (size_t)m * DM);
#pragma unroll
        for (int j = 0; j < 4; ++j) { const float4 w = ((const float4*)P.norm_mix)[j * 64 + lane_];
            const float e0 = v[j].x * r * w.x, e1 = v[j].y * r * w.y, e2 = v[j].z * r * w.z, e3 = v[j].w * r * w.w;
            o8[j * 64 + lane_] = (unsigned long long)pk2(e0, e1) | ((unsigned long long)pk2(e2, e3) << 32);
            const float ev[4] = {e0, e1, e2, e3};
#pragma unroll
            for (int e = 0; e < 4; ++e) { const LAS f32x4* wr = (const LAS f32x4*)(Wdt + (size_t)(j * 256 + lane_ * 4 + e) * 8); const f32x4 w0 = wr[0], w1 = wr[1];
                d8[0] += ev[e] * w0.x; d8[1] += ev[e] * w0.y; d8[2] += ev[e] * w0.z; d8[3] += ev[e] * w0.w; d8[4] += ev[e] * w1.x; d8[5] += ev[e] * w1.y; d8[6] += ev[e] * w1.z; d8[7] += ev[e] * w1.w; } }
#pragma unroll
        for (int q = 0; q < 8; ++q) d8[q] = wave_sum(d8[q]);
        if (lane_ == 0) { float4* dp = (float4*)(DT + (size_t)m * 8); dp[0] = make_float4(d8[0], d8[1], d8[2], d8[3]); dp[1] = make_float4(d8[4], d8[5], d8[6], d8[7]); }
        }
      }
      __syncthreads(); }
}

struct EpiResH {
    static constexpr bool PERM = false, AFTER_DRAIN = false;
    const float* X; bf16* HB; float* SSQ;
    __device__ __forceinline__ void operator()(const pg8::f32x4 (&acc)[2][2][4][2], const pg8::Unit& u, int wr, int wc, int fr, int fq) const {
        const int row0 = u.pm * 256 + wr * 64 + fr, col0 = u.pn * 256 + wc * 32 + 4 * fq;
#pragma unroll
        for (int ai = 0; ai < 2; ++ai)
#pragma unroll
            for (int m = 0; m < 4; ++m) { const int row = row0 + ai * 128 + m * 16; float ss = 0.f;
#pragma unroll
                for (int bj = 0; bj < 2; ++bj)
#pragma unroll
                    for (int n = 0; n < 2; ++n) { const size_t off = (size_t)row * DM + col0 + bj * 128 + n * 16;
                        const pg8::f32x4 h = acc[ai][bj][m][n] + *(const pg8::f32x4*)(X + off);
                        ss += h[0] * h[0] + h[1] * h[1] + h[2] * h[2] + h[3] * h[3];
                        *(unsigned long long*)(HB + off) = (unsigned long long)pk2(h[0], h[1]) | ((unsigned long long)pk2(h[2], h[3]) << 32); }
                ss += swz_xor<16>(ss); ss = sum_halves(ss);
                if (fq == 0) SSQ[(size_t)row * 16 + u.pn * 4 + wc] = ss; }
    }
};

typedef float f32x16 __attribute__((ext_vector_type(16)));
typedef short s16x4 __attribute__((ext_vector_type(4)));
typedef float f32x2_t __attribute__((ext_vector_type(2)));
typedef __bf16 bf16x2_t __attribute__((ext_vector_type(2)));
#define MFMA32(a, b, c) __builtin_amdgcn_mfma_f32_32x32x16_bf16((a), (b), (c), 0, 0, 0)
__device__ __forceinline__ int crow(int reg, int h) { return (reg & 3) + 8 * (reg >> 2) + 4 * h; }
__device__ __forceinline__ unsigned cvtpk(float lo, float hi) { f32x2_t v = {lo, hi}; bf16x2_t b = __builtin_convertvector(v, bf16x2_t); return __builtin_bit_cast(unsigned, b); }
__device__ __forceinline__ bf16x8 pack8(const f32x16& x, int s) {
    v4u p; p.x = cvtpk(x[8 * s], x[8 * s + 1]); p.y = cvtpk(x[8 * s + 2], x[8 * s + 3]); p.z = cvtpk(x[8 * s + 4], x[8 * s + 5]); p.w = cvtpk(x[8 * s + 6], x[8 * s + 7]);
    return __builtin_bit_cast(bf16x8, p);
}
constexpr float LOG2E = 1.4426950408889634f;
constexpr int LDP = 136;
constexpr int S1_XT = 0, S1_BSN = 17408, S1_CLN = 52224, S1_BNL = 87040, S1_F32 = 121856;

__device__ __forceinline__ void ssd_s1(Frame& F, const Ptrs& P) {
    const bf16* PROJ = (const bf16*)(P.ws + WS_PROJ); const float* DT = (const float*)(P.ws + WS_DT);
    float* EA = (float*)(P.ws + WS_EA); float* CDEC = (float*)(P.ws + WS_CDEC); bf16* CC = (bf16*)(P.ws + WS_CC);
    float* ST = (float*)(P.ws + WS_ST); float* YPF = (float*)((char*)P.out + DO_YPF);
    LAS unsigned char* L = F.lds + RING_OFF;
    LAS bf16* Xt = (LAS bf16*)(L + S1_XT); LAS bf16* Bsn = (LAS bf16*)(L + S1_BSN); LAS bf16* Cln = (LAS bf16*)(L + S1_CLN); LAS bf16* Bnl = (LAS bf16*)(L + S1_BNL);
    LAS float* acum2 = (LAS float*)(L + S1_F32); LAS float* wv = acum2 + 128; LAS float* wend = wv + 128;
    const int lane = lane_id(), r = lane & 31, hh = lane >> 5; const int tid_ = F.wave * 64 + lane;
    for (int u = F.vcu; u < 1024; u += F.G) {
        const int h = u & 7, c = (u >> 3) & 31, b = u >> 8, grp = h >> 2, t0 = b * SEQ + c * 128;
        const float A = -__expf(P.a_log[h]), Dh = P.d_skip[h], dtb = P.dt_bias[h];
        if (F.wave == 0) {
            const float x0 = DT[(size_t)(t0 + 2 * lane) * 8 + h] + dtb, x1 = DT[(size_t)(t0 + 2 * lane + 1) * 8 + h] + dtb;
            const float dt0 = fmaxf(x0, 0.f) + log1pf(__expf(-fabsf(x0))), dt1 = fmaxf(x1, 0.f) + log1pf(__expf(-fabsf(x1)));
            const float a0 = dt0 * A, a1 = dt1 * A;
            float s = a0 + a1;
#pragma unroll
            for (int o = 1; o < 64; o <<= 1) { const float v = __int_as_float(__builtin_amdgcn_ds_bpermute((lane - o) * 4, __float_as_int(s))); if (lane >= o) s += v; }
            const float ac1 = s, ac0 = s - a1, tot = __uint_as_float(__builtin_amdgcn_readlane(__float_as_uint(s), 63));
            acum2[2 * lane] = ac0 * LOG2E; acum2[2 * lane + 1] = ac1 * LOG2E;
            wv[2 * lane] = log2f(dt0) - ac0 * LOG2E; wv[2 * lane + 1] = log2f(dt1) - ac1 * LOG2E;
            wend[2 * lane] = dt0 * exp2f((tot - ac0) * LOG2E); wend[2 * lane + 1] = dt1 * exp2f((tot - ac1) * LOG2E);
            EA[(size_t)(t0 + 2 * lane) * 8 + h] = exp2f(ac0 * LOG2E); EA[(size_t)(t0 + 2 * lane + 1) * 8 + h] = exp2f(ac1 * LOG2E);
            if (lane == 0) CDEC[u] = exp2f(tot * LOG2E);
        }
        __syncthreads();
        const int tidc = opq(tid_);
        if (tidc < 480) {
            const int cg = tidc % 40, sg = tidc / 40, l0 = 11 * sg;
            int chb; if (cg < 8) chb = h * 64 + cg * 8; else if (cg < 24) chb = 512 + grp * 128 + (cg - 8) * 8; else chb = 768 + grp * 128 + (cg - 24) * 8;
            v4u raw[14];
#pragma unroll
            for (int q = 0; q < 14; ++q) { const int ss = c * 128 + l0 - 3 + q;
                raw[q] = (v4u){0u, 0u, 0u, 0u};
                if (ss >= 0 && l0 - 3 + q < 128) raw[q] = *(const v4u*)(PROJ + (size_t)(b * SEQ + ss) * NPROJ + PJ_XBC + chb); }
            float w[4][8], bias[8];
#pragma unroll
            for (int j = 0; j < 4; ++j) { const float4 w0 = *(const float4*)(P.conv_w + j * 1024 + chb), w1 = *(const float4*)(P.conv_w + j * 1024 + chb + 4);
                w[j][0] = w0.x; w[j][1] = w0.y; w[j][2] = w0.z; w[j][3] = w0.w; w[j][4] = w1.x; w[j][5] = w1.y; w[j][6] = w1.z; w[j][7] = w1.w; }
            { const float4 b0 = *(const float4*)(P.conv_b + chb), b1 = *(const float4*)(P.conv_b + chb + 4);
              bias[0] = b0.x; bias[1] = b0.y; bias[2] = b0.z; bias[3] = b0.w; bias[4] = b1.x; bias[5] = b1.y; bias[6] = b1.z; bias[7] = b1.w; }
#pragma unroll
            for (int it = 0; it < 11; ++it) {
                const int l = l0 + it;
                if (l < 128) {
                    float a[8];
#pragma unroll
                    for (int e = 0; e < 8; ++e) a[e] = bias[e];
#pragma unroll
                    for (int j = 0; j < 4; ++j) { const v4u rw = raw[it + j];
                        a[0] += w[j][0] * bflo(rw.x); a[1] += w[j][1] * bfhi(rw.x); a[2] += w[j][2] * bflo(rw.y); a[3] += w[j][3] * bfhi(rw.y);
                        a[4] += w[j][4] * bflo(rw.z); a[5] += w[j][5] * bfhi(rw.z); a[6] += w[j][6] * bflo(rw.w); a[7] += w[j][7] * bfhi(rw.w); }
#pragma unroll
                    for (int e = 0; e < 8; ++e) a[e] = silu_f(a[e]);
                    if (cg < 8) {
#pragma unroll
                        for (int e = 0; e < 8; ++e) Xt[(cg * 8 + e) * LDP + l] = (bf16)f2bf(a[e]);
                    } else {
                        v4u o; o.x = pk2(a[0], a[1]); o.y = pk2(a[2], a[3]); o.z = pk2(a[4], a[5]); o.w = pk2(a[6], a[7]);
                        if (cg < 24) { const int n0 = (cg - 8) * 8; *(LAS v4u*)(Bsn + l * LDP + n0) = o; const float we = wend[l];
#pragma unroll
                            for (int e = 0; e < 8; ++e) Bnl[(n0 + e) * LDP + l] = (bf16)f2bf(a[e] * we);
                        } else { const int n0 = (cg - 24) * 8; *(LAS v4u*)(Cln + l * LDP + n0) = o;
                            if ((h & 3) == 0) *(v4u*)(CC + (size_t)(t0 + l) * 256 + grp * 128 + n0) = o; }
                    }
                }
            }
        }
        __syncthreads();
        if (F.wave < 4) {
            const int pt = F.wave >> 1;
#pragma unroll 1
            for (int q = 0; q < 2; ++q) {
                const int lt = (F.wave & 1) ? (1 + q) : (3 * q);
                f32x16 yacc;
#pragma unroll
                for (int i = 0; i < 16; ++i) yacc[i] = 0.f;
                const float al = acum2[32 * lt + r];
                for (int st = 0; st <= lt; ++st) {
                    f32x16 macc;
#pragma unroll
                    for (int i = 0; i < 16; ++i) macc[i] = 0.f;
#pragma unroll
                    for (int kk = 0; kk < 8; ++kk) {
                        const bf16x8 a = *(const LAS bf16x8*)(Bsn + (32 * st + r) * LDP + 16 * kk + 8 * hh);
                        const bf16x8 bb = *(const LAS bf16x8*)(Cln + (32 * lt + r) * LDP + 16 * kk + 8 * hh);
                        macc = MFMA32(a, bb, macc);
                    }
#pragma unroll
                    for (int i = 0; i < 16; ++i) { const int sl = crow(i, hh);
                        float f = exp2f(al + wv[32 * st + sl]);
                        if (st == lt && sl > r) f = 0.f;
                        macc[i] *= f; }
#pragma unroll
                    for (int sg = 0; sg < 2; ++sg) {
                        const bf16x8 bfrag = pack8(macc, sg);
                        const LAS bf16* xb = Xt + (32 * pt + r) * LDP + 32 * st + 16 * sg + 4 * hh;
                        const s16x4 lo = *(const LAS s16x4*)(xb), hi = *(const LAS s16x4*)(xb + 8);
                        const bf16x8 afrag = __builtin_shufflevector(lo, hi, 0, 1, 2, 3, 4, 5, 6, 7);
                        yacc = MFMA32(afrag, bfrag, yacc);
                    }
                }
#pragma unroll
                for (int i = 0; i < 16; ++i) { const int p = 32 * pt + crow(i, hh);
                    const float y = yacc[i] + Dh * bf2f(Xt[p * LDP + 32 * lt + r]);
                    YPF[((((size_t)u * 4 + lt) * 2 + pt) * 16 + i) * 64 + lane] = y; }
            }
        } else {
            const int nt = F.wave - 4;
#pragma unroll 1
            for (int pt = 0; pt < 2; ++pt) {
                f32x16 sacc;
#pragma unroll
                for (int i = 0; i < 16; ++i) sacc[i] = 0.f;
#pragma unroll
                for (int kk = 0; kk < 8; ++kk) {
                    const bf16x8 a = *(const LAS bf16x8*)(Xt + (32 * pt + r) * LDP + 16 * kk + 8 * hh);
                    const bf16x8 bb = *(const LAS bf16x8*)(Bnl + (32 * nt + r) * LDP + 16 * kk + 8 * hh);
                    sacc = MFMA32(a, bb, sacc);
                }
#pragma unroll
                for (int i = 0; i < 16; ++i) ST[((size_t)u * 64 + 32 * pt + crow(i, hh)) * 128 + 32 * nt + r] = sacc[i];
            }
        }
        __syncthreads();
    }
}
__device__ __forceinline__ void ssd_s2(Frame& F, const Ptrs& P) {
    const float* ST = (const float*)(P.ws + WS_ST); const float* CDEC = (const float*)(P.ws + WS_CDEC); unsigned* PREV = (unsigned*)(P.ws + WS_PREV);
    for (int g = F.vcu * 512 + (F.wave * 64 + lane_id()); g < 131072; g += F.G * 512) {
        const int n2 = g & 63, p = (g >> 6) & 63, h = (g >> 12) & 7, b = g >> 15;
        float2 st[32];
#pragma unroll
        for (int c = 0; c < 32; ++c) st[c] = *(const float2*)(ST + ((size_t)(((b * 32 + c) * 8 + h) * 64 + p)) * 128 + 2 * n2);
        float r0 = 0.f, r1 = 0.f;
#pragma unroll
        for (int c = 0; c < 32; ++c) { const size_t u = (size_t)((b * 32 + c) * 8 + h);
            PREV[((u * 64 + p) * 128 + 2 * n2) >> 1] = pk2(r0, r1);
            const float d = CDEC[u]; r0 = r0 * d + st[c].x; r1 = r1 * d + st[c].y; }
    }
}
__device__ __forceinline__ void ssd_s3(Frame& F, const Ptrs& P) {
    const bf16* CC = (const bf16*)(P.ws + WS_CC); const bf16* PREV = (const bf16*)(P.ws + WS_PREV); const float* EA = (const float*)(P.ws + WS_EA);
    const float* YPF = (const float*)((const char*)P.out + DO_YPF); const bf16* PROJ = (const bf16*)(P.ws + WS_PROJ); bf16* CAT = (bf16*)(P.ws + WS_XN);
    LAS float* red = (LAS float*)(F.lds + RING_OFF);
    const int lane = lane_id(), r = lane & 31, hh = lane >> 5, h = F.wave, grp = h >> 2;
    for (int v = F.vcu; v < 512; v += F.G) {
        const int lt = v & 3, c = (v >> 2) & 31, b = v >> 7;
        const int t = b * SEQ + c * 128 + lt * 32 + r; const size_t u = (size_t)((b * 32 + c) * 8 + h);
        f32x16 acc[2];
#pragma unroll
        for (int i = 0; i < 16; ++i) { acc[0][i] = 0.f; acc[1][i] = 0.f; }
#pragma unroll
        for (int kk = 0; kk < 8; ++kk) {
            const bf16x8 bb = *(const bf16x8*)(CC + (size_t)t * 256 + grp * 128 + 16 * kk + 8 * hh);
#pragma unroll
            for (int pt = 0; pt < 2; ++pt) { const bf16x8 a = *(const bf16x8*)(PREV + (u * 64 + 32 * pt + r) * 128 + 16 * kk + 8 * hh); acc[pt] = MFMA32(a, bb, acc[pt]); }
        }
        const float ea = EA[(size_t)t * 8 + h];
        float ss = 0.f;
#pragma unroll
        for (int pt = 0; pt < 2; ++pt)
#pragma unroll
            for (int g4 = 0; g4 < 4; ++g4) {
                const unsigned long long zz = *(const unsigned long long*)(PROJ + (size_t)t * NPROJ + PJ_Z + h * 64 + 32 * pt + 8 * g4 + 4 * hh);
                const unsigned z01 = (unsigned)zz, z23 = (unsigned)(zz >> 32);
                const float zf[4] = {bflo(z01), bfhi(z01), bflo(z23), bfhi(z23)};
#pragma unroll
                for (int e = 0; e < 4; ++e) { const int i = 4 * g4 + e;
                    const float y = acc[pt][i] * ea + YPF[((((size_t)u * 4 + lt) * 2 + pt) * 16 + i) * 64 + lane];
                    const float yg = y * silu_f(zf[e]); acc[pt][i] = yg; ss = fmaf(yg, yg, ss); }
            }
        ss = sum_halves(ss);
        if (hh == 0) red[h * 32 + r] = ss;
        __syncthreads();
        float tot = 0.f;
#pragma unroll
        for (int w = 0; w < 8; ++w) tot += red[w * 32 + r];
        const float rn = rsqrtf(tot * (1.f / 512.f) + EPS);
#pragma unroll
        for (int pt = 0; pt < 2; ++pt)
#pragma unroll
            for (int g4 = 0; g4 < 4; ++g4) { const int ch = h * 64 + 32 * pt + 8 * g4 + 4 * hh;
                const float4 w = *(const float4*)(P.ssd_norm_w + ch);
                *(unsigned long long*)(CAT + (size_t)t * DM + 512 + ch) = (unsigned long long)cvtpk(acc[pt][4 * g4] * rn * w.x, acc[pt][4 * g4 + 1] * rn * w.y) | ((unsigned long long)cvtpk(acc[pt][4 * g4 + 2] * rn * w.z, acc[pt][4 * g4 + 3] * rn * w.w) << 32); }
        __syncthreads();
    }
}
__device__ __forceinline__ float gelu_erf(float v) { return 0.5f * v * (1.f + erff(v * 0.70710678118654752f)); }
constexpr int PE_PD = 8;
struct Row6 { v4u a; unsigned long long b; };
#define PE_ID1(P) __builtin_amdgcn_readlane(((P) & 64) ? idx_hi : idx_lo, (P) & 63)
#define PE_LOAD6(SLOT, TAB, IDA, IDB) do { const int id_ = upper ? (IDB) : (IDA); const unsigned char* rp_ = (TAB) + (size_t)id_ * 768; \
        SLOT.a = *(const v4u*)(rp_ + 16 * l31); SLOT.b = *(const unsigned long long*)(rp_ + 512 + 8 * l31); } while (0)
__device__ __forceinline__ v32f dec6(const Row6& r) { const v6u p = {r.a.x, r.a.y, r.a.z, r.a.w, (unsigned)r.b, (unsigned)(r.b >> 32)}; return __builtin_amdgcn_cvt_scalef32_pk32_f32_fp6(p, 1.0f); }
__device__ __forceinline__ void peer_eval(Frame& F, const Ptrs& P) {
    const bf16* HB = (const bf16*)(P.ws + WS_ST); const unsigned char* ED = P.ws + WS_ED; const unsigned char* EU = P.ws + WS_EU;
    const float* SCD = (const float*)(P.ws + WS_SMALL); const float* SCU = SCD + 16384;
    const int* IDX = (const int*)(P.ws + WS_IDX); const float* GATE = (const float*)(P.ws + WS_GATE);
    LAS float* RM = (LAS float*)(F.lds + RING_OFF) + F.wave * 2112;
    const int lane = lane_id(), l31 = lane & 31; const bool upper = lane >= 32;
    const int t0 = F.vcu * NWAVES + F.wave, tstep = F.G * NWAVES;
    if (t0 >= T_) return;
    int idx_lo = IDX[(size_t)t0 * 128 + lane], idx_hi = IDX[(size_t)t0 * 128 + 64 + lane];
    v4u hq[4];
#pragma unroll
    for (int k = 0; k < 4; ++k) hq[k] = ((const v4u*)(HB + (size_t)t0 * DM))[4 * l31 + k];
    float g_lo = GATE[(size_t)t0 * 128 + lane], g_hi = GATE[(size_t)t0 * 128 + 64 + lane];
    float sdr_lo = SCD[idx_lo], sdr_hi = SCD[idx_hi], su_lo = SCU[idx_lo], su_hi = SCU[idx_hi];
    Row6 ra[PE_PD];
#pragma unroll
    for (int j = 0; j < PE_PD; ++j) PE_LOAD6(ra[j], ED, __builtin_amdgcn_readlane(idx_lo, 2 * j), __builtin_amdgcn_readlane(idx_lo, 2 * j + 1));
    for (int t = t0; t < T_; t += tstep) {
        const int tn = (t + tstep < T_) ? t + tstep : t;
        const int nidx_lo = IDX[(size_t)tn * 128 + lane], nidx_hi = IDX[(size_t)tn * 128 + 64 + lane];
        v4u nh[4];
#pragma unroll
        for (int k = 0; k < 4; ++k) nh[k] = ((const v4u*)(HB + (size_t)tn * DM))[4 * l31 + k];
        const float ng_lo = GATE[(size_t)tn * 128 + lane], ng_hi = GATE[(size_t)tn * 128 + 64 + lane];
        float hv[32];
#pragma unroll
        for (int k = 0; k < 4; ++k) { hv[8 * k] = bflo(hq[k].x); hv[8 * k + 1] = bfhi(hq[k].x); hv[8 * k + 2] = bflo(hq[k].y); hv[8 * k + 3] = bfhi(hq[k].y); hv[8 * k + 4] = bflo(hq[k].z); hv[8 * k + 5] = bfhi(hq[k].z); hv[8 * k + 6] = bflo(hq[k].w); hv[8 * k + 7] = bfhi(hq[k].w); }
        float ssq = 0.f;
#pragma unroll
        for (int i = 0; i < 32; ++i) ssq = fmaf(hv[i], hv[i], ssq);
        ssq += swz_xor<1>(ssq); ssq += swz_xor<2>(ssq); ssq += swz_xor<4>(ssq); ssq += swz_xor<8>(ssq); ssq += swz_xor<16>(ssq);
        const float rstd = rsqrtf(ssq * (1.f / 1024.f) + EPS);
        const float sd_lo = sdr_lo * rstd, sd_hi = sdr_hi * rstd;
        float actg[2] = {0.f, 0.f};
#pragma unroll
        for (int g = 0; g < 2; ++g) {
            float part[32];
#pragma unroll
            for (int j = 0; j < 32; ++j) {
                const int q = 32 * g + j;
                { const v32f d = dec6(ra[q % PE_PD]); float s0 = 0.f, s1 = 0.f;
#pragma unroll
                  for (int i = 0; i < 32; i += 2) { s0 = fmaf(d[i], hv[i], s0); s1 = fmaf(d[i + 1], hv[i + 1], s1); }
                  part[j] = s0 + s1; }
                asm volatile("" : "+v"(part[j]));
                if (q + PE_PD < 64) PE_LOAD6(ra[q % PE_PD], ED, PE_ID1(2 * (q + PE_PD)), PE_ID1(2 * (q + PE_PD) + 1));
                else PE_LOAD6(ra[q % PE_PD], EU, PE_ID1(2 * (q + PE_PD - 64)), PE_ID1(2 * (q + PE_PD - 64) + 1));
                __builtin_amdgcn_sched_barrier(0);
            }
#pragma unroll
            for (int j = 0; j < 32; ++j) RM[j * 65 + lane] = part[j];
            float pre = 0.f;
            { const int cb = lane & 32;
#pragma unroll
              for (int k = 0; k < 32; ++k) pre += RM[l31 * 65 + cb + k]; }
            const int srcl = (2 * l31 + (lane >> 5)) * 4;
            const float gv = __int_as_float(__builtin_amdgcn_ds_bpermute(srcl, __float_as_int(g ? g_hi : g_lo)));
            const float sdv = __int_as_float(__builtin_amdgcn_ds_bpermute(srcl, __float_as_int(g ? sd_hi : sd_lo)));
            const float suv = __int_as_float(__builtin_amdgcn_ds_bpermute(srcl, __float_as_int(g ? su_hi : su_lo)));
            actg[g] = gelu_erf(pre * sdv) * gv * suv;
        }
        const float nsd_lo = SCD[nidx_lo], nsd_hi = SCD[nidx_hi], nsu_lo = SCU[nidx_lo], nsu_hi = SCU[nidx_hi];
        float acc[32];
#pragma unroll
        for (int i = 0; i < 32; ++i) acc[i] = 0.f;
#pragma unroll
        for (int g = 0; g < 2; ++g) {
            const float actv = actg[g];
#pragma unroll
            for (int j = 0; j < 32; ++j) {
                const int q = 32 * g + j;
                const float aA = __uint_as_float(__builtin_amdgcn_readlane(__float_as_uint(actv), j)), aB = __uint_as_float(__builtin_amdgcn_readlane(__float_as_uint(actv), j + 32));
                const float a = upper ? aB : aA;
                { const v32f d = dec6(ra[q % PE_PD]);
#pragma unroll
                  for (int i = 0; i < 32; ++i) acc[i] = fmaf(a, d[i], acc[i]); }
                asm volatile("" : "+v"(acc[0]), "+v"(acc[1]), "+v"(acc[2]), "+v"(acc[3]), "+v"(acc[4]), "+v"(acc[5]), "+v"(acc[6]), "+v"(acc[7]), "+v"(acc[8]), "+v"(acc[9]), "+v"(acc[10]), "+v"(acc[11]), "+v"(acc[12]), "+v"(acc[13]), "+v"(acc[14]), "+v"(acc[15]));
                asm volatile("" : "+v"(acc[16]), "+v"(acc[17]), "+v"(acc[18]), "+v"(acc[19]), "+v"(acc[20]), "+v"(acc[21]), "+v"(acc[22]), "+v"(acc[23]), "+v"(acc[24]), "+v"(acc[25]), "+v"(acc[26]), "+v"(acc[27]), "+v"(acc[28]), "+v"(acc[29]), "+v"(acc[30]), "+v"(acc[31]));
                if (q + PE_PD < 64) PE_LOAD6(ra[q % PE_PD], EU, PE_ID1(2 * (q + PE_PD)), PE_ID1(2 * (q + PE_PD) + 1));
                else PE_LOAD6(ra[q % PE_PD], ED, __builtin_amdgcn_readlane(nidx_lo, 2 * (q + PE_PD - 64)), __builtin_amdgcn_readlane(nidx_lo, 2 * (q + PE_PD - 64) + 1));
                __builtin_amdgcn_sched_barrier(0);
            }
        }
        float s2 = 0.f;
#pragma unroll
        for (int i = 0; i < 32; ++i) { acc[i] = sum_halves(acc[i]) + hv[i]; s2 = fmaf(acc[i], acc[i], s2); }
        s2 += swz_xor<1>(s2); s2 += swz_xor<2>(s2); s2 += swz_xor<4>(s2); s2 += swz_xor<8>(s2); s2 += swz_xor<16>(s2);
        const float r2 = rsqrtf(s2 * (1.f / 1024.f) + EPS);
        const float4* wf = (const float4*)(P.norm_final) + 8 * l31 + 4 * (lane >> 5); float4* o = (float4*)(P.out + (size_t)t * DM) + 8 * l31 + 4 * (lane >> 5);
#pragma unroll
        for (int k = 0; k < 4; ++k) { const float4 w = wf[k];
            const float e0 = upper ? acc[16 + 4 * k] : acc[4 * k], e1 = upper ? acc[17 + 4 * k] : acc[4 * k + 1], e2 = upper ? acc[18 + 4 * k] : acc[4 * k + 2], e3 = upper ? acc[19 + 4 * k] : acc[4 * k + 3];
            o[k] = make_float4(e0 * r2 * w.x, e1 * r2 * w.y, e2 * r2 * w.z, e3 * r2 * w.w); }
        idx_lo = nidx_lo; idx_hi = nidx_hi; g_lo = ng_lo; g_hi = ng_hi; sdr_lo = nsd_lo; sdr_hi = nsd_hi; su_lo = nsu_lo; su_hi = nsu_hi;
#pragma unroll
        for (int k = 0; k < 4; ++k) hq[k] = nh[k];
    }
}
constexpr int TK_LDK = 136, TK_K2 = 34816, TK_SCR = 69632, TK_SP = 49;
__device__ __forceinline__ int mono_key(float x) { const int b = __float_as_int(x); return b ^ ((b >> 31) & 0x7fffffff); }
__device__ __forceinline__ float unmono(int m) { return __int_as_float(m ^ ((m >> 31) & 0x7fffffff)); }
__device__ __forceinline__ int max3i(int a, int b, int c) { return max(max(a, b), c); }
#define CEX(A, I, J) do { const int hi_ = max(A[I], A[J]), lo_ = min(A[I], A[J]); A[I] = hi_; A[J] = lo_; } while (0)
template <int N, int OFF, int K, int J, int LEN> struct BitonicStep {
    static __device__ __forceinline__ void run(int (&a)[LEN]) {
#pragma unroll
        for (int i = 0; i < N; ++i) { const int l = i ^ J; if (l > i) { if ((i & K) == 0) CEX(a, OFF + i, OFF + l); else CEX(a, OFF + l, OFF + i); } }
        if constexpr (J > 1) BitonicStep<N, OFF, K, (J >> 1), LEN>::run(a);
        else if constexpr (K < N) BitonicStep<N, OFF, (K << 1), K, LEN>::run(a);
    }
};
template <int N, int OFF, int LEN> __device__ __forceinline__ void bitonic_sort_desc(int (&a)[LEN]) { BitonicStep<N, OFF, 2, 1, LEN>::run(a); }
template <int OFF, int LEN> __device__ __forceinline__ void bitonic_merge16_desc(int (&a)[LEN]) { BitonicStep<16, OFF, 16, 8, LEN>::run(a); }
template <int A, int B, int LEN> __device__ __forceinline__ void merge_top16(int (&a)[LEN]) {
#pragma unroll
    for (int i = 0; i < 16; ++i) a[A + i] = max(a[A + i], a[B + 15 - i]);
    bitonic_merge16_desc<A, LEN>(a);
}
template <int LEN> __device__ __forceinline__ void pair_top16(int (&a)[LEN]) {
    int lo[16], up[16];
#pragma unroll
    for (int i = 0; i < 16; ++i) { const auto rr = __builtin_amdgcn_permlane32_swap((unsigned)a[i], (unsigned)a[i], false, false); lo[i] = (int)rr[0]; up[i] = (int)rr[1]; }
#pragma unroll
    for (int i = 0; i < 16; ++i) a[i] = max(lo[i], up[15 - i]);
    bitonic_merge16_desc<0, LEN>(a);
}
__device__ __forceinline__ void topk_phase(Frame& F, const Ptrs& P) {
    const bf16* Q = (const bf16*)(P.ws + WS_PROJ); const float* SSQ = (const float*)(P.ws + WS_SSQ);
    int* IDX = (int*)(P.ws + WS_IDX); float* GATE = (float*)(P.ws + WS_GATE);
    LAS unsigned char* L = F.lds + RING_OFF;
    LAS bf16* K1 = (LAS bf16*)L; LAS bf16* K2 = (LAS bf16*)(L + TK_K2);
    const int tid_ = (F.wave * 64 + lane_id());
    for (int i = tid_; i < 16384; i += 512) { const int n = i >> 7, k = i & 127; K1[n * TK_LDK + k] = (bf16)f2bf(P.sk1[i]); K2[n * TK_LDK + k] = (bf16)f2bf(P.sk2[i]); }
    __syncthreads();
    const int lane = tid_ & 63, r = lane & 31, hh = lane >> 5;
    LAS int* scr = (LAS int*)(L + TK_SCR) + F.wave * (32 * TK_SP) + r * TK_SP;
    for (int wq = F.vcu * NWAVES + F.wave; wq < 2048; wq += F.G * NWAVES) {
        const int t = (wq >> 2) * 32 + r;
        float rstd;
        { const float4* sp = (const float4*)(SSQ + (size_t)t * 16); const float4 a = sp[0], b = sp[1], c = sp[2], d = sp[3];
          rstd = rsqrtf(((a.x + a.y + a.z + a.w) + (b.x + b.y + b.z + b.w) + (c.x + c.y + c.z + c.w) + (d.x + d.y + d.z + d.w)) * (1.f / 1024.f) + EPS); }
#pragma unroll 1
        for (int hq = 0; hq < 2; ++hq) {
            const int hd = (wq & 3) * 2 + hq;
#pragma unroll 1
            for (int half = 0; half < 2; ++half) {
                const LAS bf16* Kh = half ? K2 : K1;
                bf16x8 qf[8];
#pragma unroll
                for (int kk = 0; kk < 8; ++kk) qf[kk] = *(const bf16x8*)(Q + (size_t)t * 2048 + hd * 256 + half * 128 + 16 * kk + 8 * hh);
                int key[64];
#pragma unroll
                for (int nt = 0; nt < 4; ++nt) {
                    f32x16 sc;
#pragma unroll
                    for (int i = 0; i < 16; ++i) sc[i] = 0.f;
#pragma unroll
                    for (int kk = 0; kk < 8; ++kk) { const bf16x8 a = *(const LAS bf16x8*)(Kh + (32 * nt + r) * TK_LDK + 16 * kk + 8 * hh); sc = MFMA32(a, qf[kk], sc); }
#pragma unroll
                    for (int i = 0; i < 16; ++i) key[nt * 16 + i] = (mono_key(sc[i]) & ~127) | (127 - (32 * nt + crow(i, hh)));
                }
                bitonic_sort_desc<16, 0, 64>(key); bitonic_sort_desc<16, 16, 64>(key); bitonic_sort_desc<16, 32, 64>(key); bitonic_sort_desc<16, 48, 64>(key);
                merge_top16<0, 16, 64>(key); merge_top16<32, 48, 64>(key); merge_top16<0, 32, 64>(key);
                pair_top16<64>(key);
                if (hh == 0) {
#pragma unroll
                    for (int i = 0; i < 16; ++i) scr[half * 16 + i] = key[i]; }
            }
            const LAS int* la = scr + hh * 16; const LAS int* lb = scr + (1 - hh) * 16;
            float va[4], vb[16];
#pragma unroll
            for (int i = 0; i < 4; ++i) va[i] = unmono(la[i] & ~127);
#pragma unroll
            for (int j = 0; j < 16; ++j) vb[j] = unmono(lb[j] & ~127);
            int ck[32];
            {
                int q = 0;
#pragma unroll
                for (int i = 0; i < 4; ++i)
#pragma unroll
                    for (int j = i; j < 16; ++j) if ((i + 1) * (j + 1) <= 16) {
                        const int pos = hh ? (j * 16 + i) : (i * 16 + j);
                        int k = (mono_key(va[i] + vb[j]) & ~255) | (255 - pos);
                        if (i == j && hh) k = (int)0x80000000;
                        ck[q++] = k; }
#pragma unroll
                for (int i = 27; i < 32; ++i) ck[i] = (int)0x80000000;
            }
            bitonic_sort_desc<32, 0, 32>(ck);
            pair_top16<32>(ck);
            const float vmax = unmono(ck[0] & ~255) * rstd;
            float ev[8]; int id[8]; float esum = 0.f; const int hm = -hh;
#pragma unroll
            for (int q = 0; q < 8; ++q) { const int wk = ck[q] ^ ((ck[q] ^ ck[8 + q]) & hm); const int pos = 255 - (wk & 255);
                const int n1 = 127 - (scr[pos >> 4] & 127), n2 = 127 - (scr[16 + (pos & 15)] & 127);
                id[q] = n1 * 128 + n2;
                ev[q] = exp2f((unmono(wk & ~255) * rstd - vmax) * LOG2E); esum += ev[q]; }
            esum = sum_halves(esum);
            const float inv = 1.f / esum;
            int4* ip = (int4*)(IDX + ((size_t)t * 8 + hd) * 16 + hh * 8); float4* gp = (float4*)(GATE + ((size_t)t * 8 + hd) * 16 + hh * 8);
            ip[0] = make_int4(id[0], id[1], id[2], id[3]); ip[1] = make_int4(id[4], id[5], id[6], id[7]);
            gp[0] = make_float4(ev[0] * inv, ev[1] * inv, ev[2] * inv, ev[3] * inv); gp[1] = make_float4(ev[4] * inv, ev[5] * inv, ev[6] * inv, ev[7] * inv);
        }
    }
    __syncthreads();
}

constexpr int AT_KP = 72, AT_VP = 264;
constexpr int AT_K = 0, AT_VT = 36864, AT_BT = 36864 + 33792;
__device__ __forceinline__ void attn_phase(Frame& F, const Ptrs& P) {
    const bf16* PROJ = (const bf16*)(P.ws + WS_PROJ); bf16* CAT = (bf16*)(P.ws + WS_XN);
    LAS unsigned char* L = F.lds + RING_OFF;
    LAS bf16* Ks = (LAS bf16*)(L + AT_K); LAS bf16* Vt = (LAS bf16*)(L + AT_VT); LAS float* btab = (LAS float*)(L + AT_BT);
    const int lane = lane_id(), tid_ = F.wave * 64 + lane, r = lane & 31, hh = lane >> 5;
    for (int u = F.vcu; u < 256; u += F.G) {
        const int hkv = u & 1, n = (u >> 1) & 31, b = u >> 6;
        const int trow0 = b * SEQ + n * 128;
        for (int i = tid_; i < 2048; i += 512) {
            const int kj = i >> 3, ch = i & 7; const bool ok = (n > 0) || (kj >= 128);
            v4u kv = {0u, 0u, 0u, 0u}, vv = {0u, 0u, 0u, 0u};
            if (ok) { const bf16* rowp = PROJ + (size_t)(trow0 - 128 + kj) * NPROJ + hkv * 64 + ch * 8; kv = *(const v4u*)(rowp + PJ_K); vv = *(const v4u*)(rowp + PJ_V); }
            *(LAS v4u*)(Ks + kj * AT_KP + ch * 8) = kv;
            LAS bf16* vp = Vt + (ch * 8) * AT_VP + kj;
            vp[0] = (bf16)(vv.x & 0xffffu); vp[AT_VP] = (bf16)(vv.x >> 16); vp[2 * AT_VP] = (bf16)(vv.y & 0xffffu); vp[3 * AT_VP] = (bf16)(vv.y >> 16);
            vp[4 * AT_VP] = (bf16)(vv.z & 0xffffu); vp[5 * AT_VP] = (bf16)(vv.z >> 16); vp[6 * AT_VP] = (bf16)(vv.w & 0xffffu); vp[7 * AT_VP] = (bf16)(vv.w >> 16);
        }
        for (int i = tid_; i < 768; i += 512) { const int gg = i / 192, dist = i % 192 - 32;
            btab[i] = (dist >= 0 && dist < 128) ? P.rel_bias[c_bucket[dist & 127] * 8 + hkv * 4 + gg] * LOG2E : 0.f; }
        __syncthreads();
        const int g = F.wave & 3, h = hkv * 4 + g;
        const float sink2 = P.sinks[h] * LOG2E;
#pragma unroll 1
        for (int qq = 0; qq < 2; ++qq) {
            const int qt = (F.wave >> 2) * 2 + qq, t = trow0 + 32 * qt + r;
            bf16x8 qf[4];
#pragma unroll
            for (int kk = 0; kk < 4; ++kk) qf[kk] = *(const bf16x8*)(PROJ + (size_t)t * NPROJ + h * 64 + 16 * kk + 8 * hh);
            f32x16 sc[5];
#pragma unroll
            for (int j = 0; j < 5; ++j) {
#pragma unroll
                for (int i = 0; i < 16; ++i) sc[j][i] = 0.f;
#pragma unroll
                for (int kk = 0; kk < 4; ++kk) { const bf16x8 a = *(const LAS bf16x8*)(Ks + (32 * (qt + j) + r) * AT_KP + 16 * kk + 8 * hh); sc[j] = MFMA32(a, qf[kk], sc[j]); }
            }
            float m = sink2;
            const LAS float* bt = btab + g * 192 + 160 + r - 4 * hh;
#pragma unroll
            for (int j = 0; j < 5; ++j) {
                const bool tile_ok = (n > 0) || (qt + j >= 4);
#pragma unroll
                for (int i = 0; i < 16; ++i) { const int dist = 128 + r - (32 * j + crow(i, hh));
                    const bool ok = tile_ok && (j == 0 ? dist < 128 : (j == 4 ? dist >= 0 : true));
                    const float s = sc[j][i] * (0.125f * LOG2E) + bt[-(32 * j + (i & 3) + 8 * (i >> 2))];
                    sc[j][i] = ok ? s : -INFINITY; m = fmaxf(m, sc[j][i]); }
            }
            m = max_halves(m);
            float l = 0.f;
#pragma unroll
            for (int j = 0; j < 5; ++j)
#pragma unroll
                for (int i = 0; i < 16; ++i) { sc[j][i] = exp2f(sc[j][i] - m); l += sc[j][i]; }
            l = sum_halves(l);
            l += exp2f(sink2 - m);
            const float inv = 1.f / l;
            f32x16 o[2];
#pragma unroll
            for (int i = 0; i < 16; ++i) { o[0][i] = 0.f; o[1][i] = 0.f; }
#pragma unroll
            for (int j = 0; j < 5; ++j)
#pragma unroll
                for (int sg = 0; sg < 2; ++sg) {
                    const bf16x8 pf = pack8(sc[j], sg);
#pragma unroll
                    for (int dt = 0; dt < 2; ++dt) {
                        const LAS bf16* vb = Vt + (32 * dt + r) * AT_VP + 32 * (qt + j) + 16 * sg + 4 * hh;
                        const s16x4 lo = *(const LAS s16x4*)(vb), hi = *(const LAS s16x4*)(vb + 8);
                        o[dt] = MFMA32(__builtin_shufflevector(lo, hi, 0, 1, 2, 3, 4, 5, 6, 7), pf, o[dt]);
                    }
                }
            bf16* op = CAT + (size_t)t * DM + h * 64 + 4 * hh;
#pragma unroll
            for (int dt = 0; dt < 2; ++dt)
#pragma unroll
                for (int g4 = 0; g4 < 4; ++g4)
                    *(unsigned long long*)(op + 32 * dt + 8 * g4) = (unsigned long long)cvtpk(o[dt][4 * g4] * inv, o[dt][4 * g4 + 1] * inv) | ((unsigned long long)cvtpk(o[dt][4 * g4 + 2] * inv, o[dt][4 * g4 + 3] * inv) << 32);
        }
        __syncthreads();
    }
}
struct Args { Ptrs p; };
__global__ void __launch_bounds__(NWAVES * 64, 2) hymba_fwd(Args args) {
    extern __shared__ __attribute__((aligned(16))) unsigned char lds[];
    const Ptrs& P = args.p;
    Frame F;
    F.lds = (LAS unsigned char*)lds;
    F.MISC = (volatile LAS unsigned*)(F.lds + MISC_OFF);
    F.wave = __builtin_amdgcn_readfirstlane(threadIdx.x >> 6);
    F.G = gridDim.x; { const int bx = blockIdx.x; F.vcu = (F.G % 8 == 0) ? (bx % 8) * (F.G / 8) + bx / 8 : bx; }
    F.ctl = (gu32*)(P.ws + WS_CTL);
    for (int u = threadIdx.x; u < (LDS_BYTES - LDSCTL_OFF) / 4; u += NWAVES * 64) ((LAS unsigned*)(F.lds + LDSCTL_OFF))[u] = 0u;
    __syncthreads();
    XcdBarrier bar = xcd_barrier_post((unsigned*)(F.ctl + CW_BAR), F.MISC + 8);
#define GRID_BAR() xcd_barrier(bar)

    bf16* XN = (bf16*)(P.ws + WS_XN); bf16* PROJ = (bf16*)(P.ws + WS_PROJ); bf16* HB = (bf16*)(P.ws + WS_ST);
    p0_prologue(F, P);
    GRID_BAR();
    { pg8::Gemm g{XN, (const bf16*)(P.ws + WS_WIN), T_, NPROJ, DM, F.wave}; pg8::StaticOrder S; S.init(T_, NPROJ, F.G, (int)blockIdx.x);
      pg8::EpiBf16<0> E{PROJ, NPROJ, nullptr, 0, 0, 1.f};
      pg8::gemm_phase<pg8::EpiBf16<0>, pg8::StaticOrder, PG8_ALIGN, PG8_SP2>(F.lds + RING_OFF, g, S, E); }
    if (F.G == 256 && blockIdx.x >= 64) quant_fp6(P, lane_id(), Q_SPLIT, 16384, ((int)blockIdx.x - 64) * NWAVES + F.wave, 192 * NWAVES);
    else if (F.G != 256) quant_fp6(P, lane_id(), Q_SPLIT, 16384, F.vcu * NWAVES + F.wave, F.G * NWAVES);
    GRID_BAR();
    ssd_s1(F, P);
    attn_phase(F, P);
    GRID_BAR();
    ssd_s2(F, P);
    GRID_BAR();
    ssd_s3(F, P);
    GRID_BAR();
    { pg8::Gemm g{XN, (const bf16*)(P.ws + WS_WOUT), T_, DM, DM, F.wave}; pg8::StaticOrder S; S.init(T_, DM, F.G, (int)blockIdx.x);
      EpiResH E{P.x, HB, (float*)(P.ws + WS_SSQ)};
      pg8::gemm_phase<EpiResH, pg8::StaticOrder, PG8_ALIGN, PG8_SP2>(F.lds + RING_OFF, g, S, E); }
    GRID_BAR();
    { pg8::Gemm g{HB, (const bf16*)(P.ws + WS_WQ), T_, 2048, DM, F.wave}; pg8::StaticOrder S; S.init(T_, 2048, F.G, (int)blockIdx.x);
      pg8::EpiBf16<0> E{PROJ, 2048, nullptr, 0, 0, 1.f};
      pg8::gemm_phase<pg8::EpiBf16<0>, pg8::StaticOrder, PG8_ALIGN, PG8_SP2>(F.lds + RING_OFF, g, S, E); }
    GRID_BAR();
    topk_phase(F, P);
    GRID_BAR();
    peer_eval(F, P);
}

extern "C" void kernel_launch(void* const* d_in, const int* in_sizes, int n_in, void* d_out, int out_size, void* d_ws, size_t ws_size, hipStream_t stream) {
    static int grid = 0;
    if (grid == 0) {
        if (n_in != 19 || out_size != T_ * DM || ws_size < WS_END) { fprintf(stderr, "kernel_launch: unexpected shapes (n_in %d, out %d, ws %zu)\n", n_in, out_size, ws_size); grid = -1; return; }
        int dev = 0, cus = 0, per_cu = 0;
        if (hipGetDevice(&dev) != hipSuccess || hipDeviceGetAttribute(&cus, hipDeviceAttributeMultiprocessorCount, dev) != hipSuccess) { grid = -1; return; }
        if (hipFuncSetAttribute((const void*)hymba_fwd, hipFuncAttributeMaxDynamicSharedMemorySize, LDS_BYTES) != hipSuccess) { fprintf(stderr, "kernel_launch: hipFuncSetAttribute failed\n"); grid = -1; return; }
        if (hipOccupancyMaxActiveBlocksPerMultiprocessor(&per_cu, (const void*)hymba_fwd, NWAVES * 64, LDS_BYTES) != hipSuccess || per_cu < 1) { fprintf(stderr, "kernel_launch: occupancy query says %d blocks per CU\n", per_cu); grid = -1; (void)hipGetLastError(); return; }
        grid = cus;
    }
    if (grid < 0) return;
    (void)hipMemsetAsync((char*)d_ws + WS_CTL, 0, CTL_ZERO_BYTES, stream);
    Args a{};
    const float** pp = (const float**)&a.p;
    for (int i = 0; i < 19; ++i) pp[i] = (const float*)d_in[i];
    a.p.out = (float*)d_out; a.p.ws = (unsigned char*)d_ws;
    hipLaunchKernelGGL(hymba_fwd, dim3(grid), dim3(NWAVES * 64), LDS_BYTES, stream, a);
}
```

```cpp
#include <hip/hip_runtime.h>
#include <cstdio>
#include <cstdint>
#include <math.h>
namespace pg8 {
#define PG8_LAS __attribute__((address_space(3)))
typedef unsigned short bf16_t;
typedef short bf16x8 __attribute__((ext_vector_type(8)));
typedef float f32x4 __attribute__((ext_vector_type(4)));
typedef unsigned u32x4 __attribute__((ext_vector_type(4)));
constexpr int BM = 256, BK = 64, HALF = 128, HTB = HALF * BK * 2  , STAGE_BYTES = 8 * HTB, NXCD = 8, WGM = 8;

__host__ __device__ __forceinline__ int lds_byte(int r, int c) { const int st = (r >> 4) * 2 + (c >> 5), rr = r & 15, cc = c & 31, ob = rr * 64 + cc * 2; return st * 1024 + (ob ^ (((ob >> 9) & 1) << 5)); }
__host__ __device__ __forceinline__ void stage_rc(int b, int& R, int& C) { const int st = b / 1024, sb = b % 1024, swz = sb ^ (((sb >> 9) & 1) << 5); R = (st >> 1) * 16 + swz / 64; C = (st & 1) * 32 + (swz % 64) / 2; }
__host__ __device__ __forceinline__ int perm32(int rho) { const int n = rho >> 4, i = rho & 15; return 8 * (i >> 2) + 4 * n + (i & 3); }

struct Unit { int pm, pn; };
struct Gemm { const bf16_t* A; const bf16_t* Bt; int M, N, K, wave; };

struct StaticOrder {
    int nM, nN, nwg, G, c;
    __host__ __device__ void init(int M, int N, int G_, int c_) { nM = M / BM; nN = N / BM; nwg = nM * nN; G = G_; c = c_; }
    __host__ __device__ bool next(int i, Unit& u) const {
        const long L = (long)i * G + c; if (L >= nwg) return false;
        int wgid = (int)L; { const int q = nwg / NXCD, r = nwg % NXCD, xcd = wgid % NXCD, off = wgid / NXCD; wgid = (xcd < r ? xcd * (q + 1) : r * (q + 1) + (xcd - r) * q) + off; }
        const int nig = WGM * nN, gid = wgid / nig, fm = gid * WGM, gsz = (nM - fm) < WGM ? (nM - fm) : WGM;
        u.pm = fm + ((wgid % nig) % gsz); u.pn = (wgid % nig) / gsz; return true;
    }
    __device__ __forceinline__ void a_ready(const Unit&) const {}
    __device__ __forceinline__ void done(const Unit&) const {}
};

__device__ __forceinline__ unsigned cvt_pk_bf16(float lo, float hi) { unsigned r; asm volatile("v_cvt_pk_bf16_f32 %0, %1, %2" : "=v"(r) : "v"(lo), "v"(hi)); return r; }
typedef float f32x2 __attribute__((ext_vector_type(2)));
__device__ __forceinline__ f32x2 gelu_pk(f32x2 v) {
    const f32x2 av = __builtin_elementwise_abs(v), d = av * 0.2316418882f + 1.0f;
    f32x2 t; t.x = __builtin_amdgcn_rcpf(d.x); t.y = __builtin_amdgcn_rcpf(d.y);
    f32x2 q = t * 0.5307027145f + (-0.7265760135f); q = q * t + 0.7107068705f; q = q * t + (-0.142248368f); q = q * t + 0.127414796f; q = q * t;
    const f32x2 s = (v * v) * (-0.72134752044f);
    f32x2 e; e.x = __builtin_amdgcn_exp2f(s.x); e.y = __builtin_amdgcn_exp2f(s.y);
    const f32x2 m = v * (q * e), r = v - m;
    f32x2 o; o.x = v.x < 0.f ? m.x : r.x; o.y = v.y < 0.f ? m.y : r.y; return o;
}

template <int ACT  > struct EpiBf16 {
    static constexpr bool PERM = true, AFTER_DRAIN = false; static_assert(ACT == 0 || ACT == 1, "EpiBf16: ACT is 0 (none) or 1 (gelu_pk)");
    bf16_t* O; int ldc; const float* bias; int split_cols; size_t split_stride; float scale0;
    __device__ __forceinline__ void operator()(const f32x4 (&acc)[2][2][4][2], const Unit& u, int wr, int wc, int fr, int fq) const {
        const int row0 = u.pm * BM + wr * 64 + fr; int colt = u.pn * BM; bf16_t* base = O;
        float sc = 1.f; if (split_cols) { const int t = colt / split_cols; base += (size_t)t * split_stride; colt -= t * split_cols; if (t == 0) sc = scale0; }
        const int col0 = colt + wc * 32 + 8 * fq, bcol0 = u.pn * BM + wc * 32 + 8 * fq;
        f32x4 bv[2][2];
#pragma unroll
        for (int bj = 0; bj < 2; ++bj)
#pragma unroll
            for (int n = 0; n < 2; ++n) bv[bj][n] = bias ? *(const f32x4*)(bias + bcol0 + bj * HALF + 4 * n) : (f32x4){0.f, 0.f, 0.f, 0.f};
#pragma unroll
        for (int ai = 0; ai < 2; ++ai)
#pragma unroll
            for (int m = 0; m < 4; ++m) { bf16_t* rowp = base + (size_t)(row0 + ai * HALF + m * 16) * ldc + col0;
#pragma unroll
                for (int bj = 0; bj < 2; ++bj) { f32x4 v0 = acc[ai][bj][m][0] + bv[bj][0], v1 = acc[ai][bj][m][1] + bv[bj][1];
                    if (ACT == 1) { f32x2 a = gelu_pk((f32x2){v0[0], v0[1]}), b = gelu_pk((f32x2){v0[2], v0[3]}), c = gelu_pk((f32x2){v1[0], v1[1]}), d = gelu_pk((f32x2){v1[2], v1[3]});
                        v0 = (f32x4){a.x, a.y, b.x, b.y}; v1 = (f32x4){c.x, c.y, d.x, d.y}; }
                    v0 = v0 * sc; v1 = v1 * sc; u32x4 w; w.x = cvt_pk_bf16(v0[0], v0[1]); w.y = cvt_pk_bf16(v0[2], v0[3]); w.z = cvt_pk_bf16(v1[0], v1[1]); w.w = cvt_pk_bf16(v1[2], v1[3]);
                    *(u32x4*)(rowp + bj * HALF) = w; } }
    }
};
template <class Epi, class Sched, bool ALIGN_EPI = false, bool SP2 = false>
__device__ __forceinline__ void gemm_phase(PG8_LAS unsigned char* lds, const Gemm g, const Sched& S, const Epi& E) {
    int lane_l; asm volatile("v_mbcnt_lo_u32_b32 %0, -1, 0\n\tv_mbcnt_hi_u32_b32 %0, -1, %0" : "=v"(lane_l));
    const int wid = g.wave, lane = lane_l, tid = wid * 64 + lane,
              wr = wid >> 2, wc = wid & 3, fr = lane & 15, fq = lane >> 4;
    const int K = g.K, nt = K / BK;
    unsigned voffA[2], voffB[2];
#pragma unroll
    for (int i = 0; i < 2; ++i) { int R, C; stage_rc(tid * 16 + i * 8192, R, C); const int Rb = Epi::PERM ? ((R & ~31) + perm32(R & 31)) : R;
        voffA[i] = (unsigned)(R * K + C) * 2u; voffB[i] = (unsigned)(Rb * K + C) * 2u; }
    const size_t kstep = (size_t)(BK * 2);
    const size_t hstep = (size_t)HALF * K * 2;
    const size_t tstep = 2 * hstep;
    const unsigned ldsw = (unsigned)wid * 1024u;
    const int aoff = lds_byte(wr * 64 + fr, fq * 8), boff = lds_byte(wc * 32 + fr, fq * 8);
#define PG8_SA(b, h) (((b) * 2 + (h)) * HTB)
#define PG8_SB(b, h) ((4 + (b) * 2 + (h)) * HTB)
#define PG8_STAGE(bufoff, gbase, voff) do { _Pragma("unroll") for (int _i = 0; _i < 2; ++_i) \
        __builtin_amdgcn_global_load_lds((const unsigned*)((const char*)(gbase) + (voff)[_i]), (PG8_LAS unsigned*)(lds + (bufoff) + ldsw + _i * 8192), 16, 0, 0); } while (0)
#define PG8_LDA(dst, b, h) do { _Pragma("unroll") for (int m = 0; m < 4; ++m) _Pragma("unroll") for (int k = 0; k < 2; ++k) dst[m][k] = *(const PG8_LAS bf16x8*)(lds + PG8_SA(b, h) + aoff + m * 2048 + k * 1024); } while (0)
#define PG8_LDB(dst, b, h) do { _Pragma("unroll") for (int n = 0; n < 2; ++n) _Pragma("unroll") for (int k = 0; k < 2; ++k) dst[n][k] = *(const PG8_LAS bf16x8*)(lds + PG8_SB(b, h) + boff + n * 2048 + k * 1024); } while (0)
#define PG8_MMA(ai, bj, At, Bt) do { __builtin_amdgcn_s_setprio(1); _Pragma("unroll") for (int m = 0; m < 4; ++m) _Pragma("unroll") for (int n = 0; n < 2; ++n) _Pragma("unroll") for (int k = 0; k < 2; ++k) \
        acc[ai][bj][m][n] = __builtin_amdgcn_mfma_f32_16x16x32_bf16(Bt[n][k], At[m][k], acc[ai][bj][m][n], 0, 0, 0); __builtin_amdgcn_s_setprio(0); } while (0)
#define PG8_WAIT_V(n) asm volatile("s_waitcnt vmcnt(" #n ")" ::: "memory")
#define PG8_WAIT_L(n) asm volatile("s_waitcnt lgkmcnt(" #n ")" ::: "memory")
#define PG8_BAR __builtin_amdgcn_s_barrier()
#define PG8_SCHED __builtin_amdgcn_sched_barrier(0)
    Unit cur, nxt; int ui = 0;
    if (!S.next(0, cur)) return;
    f32x4 acc[2][2][4][2];
#pragma unroll
    for (int a = 0; a < 2; ++a)
#pragma unroll
        for (int b = 0; b < 2; ++b)
#pragma unroll
            for (int m = 0; m < 4; ++m)
#pragma unroll
                for (int n = 0; n < 2; ++n) acc[a][b][m][n] = (f32x4){0.f, 0.f, 0.f, 0.f};
    bf16x8 At[4][2], B0[2][2], B1[2][2];
    const char* cA = (const char*)g.A + (size_t)cur.pm * tstep; const char* cB = (const char*)g.Bt + (size_t)cur.pn * tstep;
    S.a_ready(cur);
    if constexpr (SP2) {
        PG8_STAGE(PG8_SB(0, 0), cB, voffB); PG8_STAGE(PG8_SB(0, 1), cB + hstep, voffB); PG8_STAGE(PG8_SA(0, 0), cA, voffA); PG8_STAGE(PG8_SA(0, 1), cA + hstep, voffA);
        if (wr == 1) PG8_BAR;
        PG8_WAIT_V(2); PG8_BAR;
        PG8_STAGE(PG8_SB(1, 0), cB + kstep, voffB); PG8_STAGE(PG8_SA(1, 0), cA + kstep, voffA); PG8_STAGE(PG8_SB(1, 1), cB + hstep + kstep, voffB);
        PG8_WAIT_V(6); PG8_BAR;
    } else {
        PG8_STAGE(PG8_SB(0, 0), cB, voffB); PG8_STAGE(PG8_SA(0, 0), cA, voffA); PG8_STAGE(PG8_SB(0, 1), cB + hstep, voffB); PG8_STAGE(PG8_SA(0, 1), cA + hstep, voffA);
        if (wr == 1) PG8_BAR;
        PG8_WAIT_V(4); PG8_BAR;
        PG8_STAGE(PG8_SB(1, 0), cB + kstep, voffB); PG8_STAGE(PG8_SA(1, 0), cA + kstep, voffA); PG8_STAGE(PG8_SB(1, 1), cB + hstep + kstep, voffB);
        PG8_WAIT_V(6); PG8_BAR;
    }
    for (;;) {
        const bool has_next = S.next(ui + 1, nxt);
        const char* nA = has_next ? (const char*)g.A + (size_t)nxt.pm * tstep : cA; const char* nB = has_next ? (const char*)g.Bt + (size_t)nxt.pn * tstep : cB;
        for (int t = 0; t < nt; t += 2) {
            const bool last = (t == nt - 2);
            const char* a1 = cA + (size_t)(t + 1) * kstep;
            const char* a2 = last ? nA : cA + (size_t)(t + 2) * kstep; const char* b2 = last ? nB : cB + (size_t)(t + 2) * kstep;
            const char* a3 = a2 + kstep; const char* b3 = b2 + kstep;
            if (last && has_next) S.a_ready(nxt);
            if constexpr (SP2) {
            PG8_LDB(B0, 0, 0); PG8_LDB(B1, 0, 1); PG8_SCHED; PG8_LDA(At, 0, 0); PG8_STAGE(PG8_SA(1, 1), a1 + hstep, voffA);
            PG8_WAIT_V(8); PG8_WAIT_L(0); PG8_BAR; PG8_MMA(0, 0, At, B0); PG8_MMA(0, 1, At, B1); PG8_BAR; PG8_SCHED;
            PG8_LDA(At, 0, 1); PG8_STAGE(PG8_SB(0, 0), b2, voffB); PG8_STAGE(PG8_SB(0, 1), b2 + hstep, voffB); PG8_STAGE(PG8_SA(0, 0), a2, voffA);
            PG8_WAIT_V(8); PG8_WAIT_L(0); PG8_BAR; PG8_MMA(1, 0, At, B0); PG8_MMA(1, 1, At, B1); PG8_BAR; PG8_SCHED;
            PG8_LDB(B0, 1, 0); PG8_LDB(B1, 1, 1); PG8_SCHED; PG8_LDA(At, 1, 0); PG8_STAGE(PG8_SA(0, 1), a2 + hstep, voffA);
            PG8_WAIT_V(8); PG8_WAIT_L(0); PG8_BAR; PG8_MMA(0, 0, At, B0); PG8_MMA(0, 1, At, B1); PG8_BAR; PG8_SCHED;
            PG8_LDA(At, 1, 1); PG8_STAGE(PG8_SB(1, 0), b3, voffB); PG8_STAGE(PG8_SB(1, 1), b3 + hstep, voffB); PG8_STAGE(PG8_SA(1, 0), a3, voffA);
            PG8_WAIT_V(8); PG8_WAIT_L(0); PG8_BAR; PG8_MMA(1, 0, At, B0); PG8_MMA(1, 1, At, B1); PG8_BAR; PG8_SCHED;
            } else {
            PG8_LDB(B0, 0, 0); PG8_SCHED; PG8_LDA(At, 0, 0); PG8_STAGE(PG8_SA(1, 1), a1 + hstep, voffA);
            PG8_WAIT_L(8); PG8_BAR; PG8_WAIT_L(0); PG8_MMA(0, 0, At, B0); PG8_BAR; PG8_SCHED;
            PG8_LDB(B1, 0, 1); PG8_STAGE(PG8_SB(0, 0), b2, voffB);
            PG8_BAR; PG8_WAIT_L(0); PG8_MMA(0, 1, At, B1); PG8_BAR;
            PG8_LDA(At, 0, 1); PG8_STAGE(PG8_SA(0, 0), a2, voffA);
            PG8_BAR; PG8_WAIT_L(0); PG8_MMA(1, 0, At, B0); PG8_BAR; PG8_SCHED;
            PG8_STAGE(PG8_SB(0, 1), b2 + hstep, voffB);
            PG8_WAIT_V(6); PG8_BAR; PG8_MMA(1, 1, At, B1); PG8_BAR;
            PG8_LDB(B0, 1, 0); PG8_SCHED; PG8_LDA(At, 1, 0); PG8_STAGE(PG8_SA(0, 1), a2 + hstep, voffA);
            PG8_WAIT_L(8); PG8_BAR; PG8_WAIT_L(0); PG8_MMA(0, 0, At, B0); PG8_BAR; PG8_SCHED;
            PG8_LDB(B1, 1, 1); PG8_STAGE(PG8_SB(1, 0), b3, voffB);
            PG8_BAR; PG8_WAIT_L(0); PG8_MMA(0, 1, At, B1); PG8_BAR;
            PG8_LDA(At, 1, 1); PG8_STAGE(PG8_SA(1, 0), a3, voffA);
            PG8_BAR; PG8_WAIT_L(0); PG8_MMA(1, 0, At, B0); PG8_BAR; PG8_SCHED;
            PG8_STAGE(PG8_SB(1, 1), b3 + hstep, voffB);
            PG8_WAIT_V(6); PG8_BAR; PG8_MMA(1, 1, At, B1); PG8_BAR;
            }
        }
        if constexpr (ALIGN_EPI) { if (wr == 0) PG8_BAR; }
        if constexpr (!Epi::AFTER_DRAIN) { E(acc, cur, wr, wc, fr, fq); S.done(cur); }
        if (!has_next) break;
#pragma unroll
        for (int a = 0; a < 2; ++a)
#pragma unroll
            for (int b = 0; b < 2; ++b)
#pragma unroll
                for (int m = 0; m < 4; ++m)
#pragma unroll
                    for (int n = 0; n < 2; ++n) acc[a][b][m][n] = (f32x4){0.f, 0.f, 0.f, 0.f};
        cur = nxt; cA = nA; cB = nB; ++ui;
        if constexpr (ALIGN_EPI) { if (wr == 1) PG8_BAR; }
    }
    PG8_WAIT_V(0);
    if constexpr (!ALIGN_EPI) { if (wr == 0) PG8_BAR; }
    PG8_BAR;
    if constexpr (Epi::AFTER_DRAIN) { E.fused(acc, cur, wr, wc, fr, fq, lds, wid, lane); S.done(cur); }
#undef PG8_SA
#undef PG8_SB
#undef PG8_STAGE
#undef PG8_LDA
#undef PG8_LDB
#undef PG8_MMA
#undef PG8_WAIT_V
#undef PG8_WAIT_L
#undef PG8_BAR
#undef PG8_SCHED
}
}

#ifndef PG8_SP2
#define PG8_SP2 true
#endif
#ifndef PG8_ALIGN
#define PG8_ALIGN true
#endif
#define GAS __attribute__((address_space(1)))
#define LAS __attribute__((address_space(3)))
typedef unsigned short bf16;
typedef unsigned v4u __attribute__((ext_vector_type(4)));
typedef float f32x4 __attribute__((ext_vector_type(4)));
typedef short bf16x8 __attribute__((ext_vector_type(8)));
typedef GAS unsigned gu32;
typedef GAS unsigned long long gu64;
#define RLX_AGENT __ATOMIC_RELAXED, __HIP_MEMORY_SCOPE_AGENT
#define LDS_WAIT() asm volatile("s_waitcnt lgkmcnt(0)" ::: "memory")
#define VM_WAIT() asm volatile("s_waitcnt vmcnt(0)" ::: "memory")
__device__ __forceinline__ unsigned long long rt() { return __builtin_amdgcn_s_memrealtime(); }
__device__ __forceinline__ unsigned f2bf(float f) { unsigned u = __builtin_bit_cast(unsigned, f); return (u + 0x7fffu + ((u >> 16) & 1u)) >> 16; }
__device__ __forceinline__ unsigned pk2(float lo, float hi) { return f2bf(lo) | (f2bf(hi) << 16); }

#define XB_TMO      128
#define XB_XCNT(j)  (256  + 64 * (j))
#define XB_XSUB(j)  (1280 + 64 * (j))
#define XB_XGEN(j)  (2304 + 64 * (j))
#define XB_TOP      3328
#define XB_TOPGEN   3392
#define XCD_BAR_WORDS 3456
#define XB_SPIN_CAP (1u << 22)

__device__ __forceinline__ unsigned xb_ld(unsigned* p)              { return __hip_atomic_load(p, __ATOMIC_RELAXED, __HIP_MEMORY_SCOPE_AGENT); }
__device__ __forceinline__ unsigned xb_add(unsigned* p, unsigned v) { return __hip_atomic_fetch_add(p, v, __ATOMIC_RELAXED, __HIP_MEMORY_SCOPE_AGENT); }
__device__ __forceinline__ unsigned xb_xcc_id() { return (unsigned)__builtin_amdgcn_s_getreg((3 << 11) | 20) & 0xFu; }
#define XB_SPIN(cond, bar) do { unsigned _sp = 0; while (cond) { __builtin_amdgcn_s_sleep(1); \
    if ((++_sp & 255u) == 0u) { if (xb_ld(&(bar)[XB_TMO])) break; if (_sp > XB_SPIN_CAP) { atomicAdd(&(bar)[XB_TMO], 1u); break; } } } } while (0)

struct XcdBarrier {
    unsigned* bar; unsigned x;
    volatile LAS unsigned* st;
};

__device__ __forceinline__ XcdBarrier xcd_barrier_post(unsigned* bar, volatile LAS unsigned* st) {
    XcdBarrier b; b.bar = bar; b.x = xb_xcc_id(); b.st = st;
    if (threadIdx.x == 0) (void)xb_add(&bar[XB_XCNT(b.x)], 1u);
    return b;
}
__device__ __forceinline__ void xcd_barrier_complete(unsigned* bar, unsigned x, unsigned& nloc, unsigned& nx) {
    const unsigned G = gridDim.x * gridDim.y * gridDim.z;
    unsigned sum, cnt, mine, sp = 0u;
    for (;;) {
        sum = 0u; cnt = 0u; mine = 0u;
#pragma unroll
        for (unsigned j = 0; j < 16; ++j) { const unsigned c = xb_ld(&bar[XB_XCNT(j)]); sum += c; cnt += (c > 0u) ? 1u : 0u; mine = (j == x) ? c : mine; }
        if (sum == G) break;
        __builtin_amdgcn_s_sleep(1);
        if ((++sp & 255u) == 0u) { if (xb_ld(&bar[XB_TMO])) break; if (sp > XB_SPIN_CAP) { atomicAdd(&bar[XB_TMO], 1u); break; } }
    }
    nloc = mine > 0u ? mine : 1u; nx = cnt > 0u ? cnt : 1u;
}

__device__ __forceinline__ void xcd_barrier(const XcdBarrier& b) {
    asm volatile("s_waitcnt vmcnt(0)" ::: "memory");
    __syncthreads();
    if (threadIdx.x == 0) {
        unsigned* bar = b.bar;
        __builtin_amdgcn_s_waitcnt(0);
        unsigned nloc = b.st[0], nx = b.st[1];
        if (nloc == 0u) { xcd_barrier_complete(bar, b.x, nloc, nx); b.st[0] = nloc; b.st[1] = nx; }
        const unsigned old = xb_add(&bar[XB_XSUB(b.x)], 1u);
        const unsigned gen = old / nloc;
        if (old + 1u == (gen + 1u) * nloc) {
            __builtin_amdgcn_fence(__ATOMIC_RELEASE, "agent");
            asm volatile("s_waitcnt vmcnt(0)" ::: "memory");
            const unsigned og = xb_add(&bar[XB_TOP], 1u);
            const unsigned tg = og / nx;
            if (og + 1u == (tg + 1u) * nx) xb_add(&bar[XB_TOPGEN], 1u);
            else XB_SPIN(xb_ld(&bar[XB_TOPGEN]) == tg, bar);
            __builtin_amdgcn_fence(__ATOMIC_ACQUIRE, "agent");
            xb_add(&bar[XB_XGEN(b.x)], 1u);
            asm volatile("s_waitcnt vmcnt(0)" ::: "memory");
        } else {
            XB_SPIN(xb_ld(&bar[XB_XGEN(b.x)]) == gen, bar);
            __builtin_amdgcn_fence(__ATOMIC_ACQUIRE, "agent");
            asm volatile("s_waitcnt vmcnt(0)" ::: "memory");
        }
    }
    __syncthreads();
}

constexpr int NWAVES = 8;
constexpr int T_ = 16384, SEQ = 4096, DM = 1024, NPROJ = 2304, INC = 2312;
constexpr int PJ_K = 512, PJ_V = 640, PJ_Z = 768, PJ_XBC = 1280;
constexpr float EPS = 1e-6f;
constexpr size_t MiB = 1u << 20;
constexpr size_t WS_CTL = 0, CTL_ZERO_BYTES = 1 * MiB;
constexpr size_t WS_SMALL = 1 * MiB;
constexpr size_t WS_WIN = 2 * MiB, WS_WOUT = 7 * MiB, WS_WQ = 9 * MiB;
constexpr size_t WS_ED = 13 * MiB, WS_EU = 29 * MiB;
constexpr size_t WS_XN = 77 * MiB;
constexpr size_t WS_PROJ = 109 * MiB;
constexpr size_t WS_ST = 181 * MiB;
constexpr size_t WS_IDX = 213 * MiB, WS_GATE = 221 * MiB, WS_SSQ = 229 * MiB, WS_END = 230 * MiB;
constexpr size_t DO_Y = 0, DO_DT = 41 * MiB;
constexpr size_t WS_CC = 230 * MiB, WS_DT = 238 * MiB, WS_EA = 239 * MiB, WS_CDEC = 240 * MiB, WS_PREV = WS_IDX;
constexpr size_t DO_YPF = 0, DO_YPLAIN = 32 * MiB;
constexpr size_t WS_PART = WS_PROJ;
constexpr size_t WS_H8 = WS_XN, WS_HS = WS_DT;
constexpr size_t WS_SSQ2 = WS_EA;
constexpr int CW_BAR = 4096, CW_RANK = 8192;
constexpr int RING_OFF = 0, RING_BYTES = 131072, LDSCTL_OFF = RING_BYTES, MISC_OFF = LDSCTL_OFF + 320, LDS_BYTES = 147456;

__constant__ unsigned char c_bucket[128] = {0, 1, 2, 3, 4, 5, 6, 7, 8, 9, 10, 11, 12, 13, 14, 15, 16, 16, 16, 17, 17, 18, 18, 18, 19, 19, 19, 20, 20, 20, 20, 21, 21, 21, 21, 22, 22, 22, 22, 22, 23, 23, 23, 23, 23, 23, 24, 24, 24, 24, 24, 24, 25, 25, 25, 25, 25, 25, 25, 26, 26, 26, 26, 26, 26, 26, 26, 27, 27, 27, 27, 27, 27, 27, 27, 27, 27, 28, 28, 28, 28, 28, 28, 28, 28, 28, 28, 29, 29, 29, 29, 29, 29, 29, 29, 29, 29, 29, 29, 30, 30, 30, 30, 30, 30, 30, 30, 30, 30, 30, 30, 30, 30, 31, 31, 31, 31, 31, 31, 31, 31, 31, 31, 31, 31, 31, 31, 31};

typedef float v16f __attribute__((ext_vector_type(16)));
typedef float v32f __attribute__((ext_vector_type(32)));
typedef unsigned v6u __attribute__((ext_vector_type(6)));
typedef _Float16 v32h __attribute__((ext_vector_type(32)));
struct Frame {
    LAS unsigned char* lds;
    volatile LAS unsigned* MISC;
    gu32* ctl;
    int wave, vcu, G;
};
__device__ __forceinline__ int lane_id() { int l; asm volatile("v_mbcnt_lo_u32_b32 %0, -1, 0\n\tv_mbcnt_hi_u32_b32 %0, -1, %0" : "=v"(l)); return l; }
__device__ __forceinline__ int opq(int x) { asm volatile("" : "+v"(x)); return x; }
template <int M> __device__ __forceinline__ float swz_xor(float v) { return __int_as_float(__builtin_amdgcn_ds_swizzle(__float_as_int(v), (M << 10) | 0x1F)); }
__device__ __forceinline__ float sum_halves(float v) { const auto r = __builtin_amdgcn_permlane32_swap(__float_as_uint(v), __float_as_uint(v), false, false); return __uint_as_float(r[0]) + __uint_as_float(r[1]); }
__device__ __forceinline__ float max_halves(float v) { const auto r = __builtin_amdgcn_permlane32_swap(__float_as_uint(v), __float_as_uint(v), false, false); return fmaxf(__uint_as_float(r[0]), __uint_as_float(r[1])); }
__device__ __forceinline__ int imax_halves(int v) { const auto r = __builtin_amdgcn_permlane32_swap((unsigned)v, (unsigned)v, false, false); return max((int)r[0], (int)r[1]); }
__device__ __forceinline__ float wave_sum(float v) {
    v += swz_xor<1>(v); v += swz_xor<2>(v); v += swz_xor<4>(v); v += swz_xor<8>(v); v += swz_xor<16>(v);
    return sum_halves(v);
}
__device__ __forceinline__ float bf2f(unsigned short b) { return __uint_as_float((unsigned)b << 16); }
__device__ __forceinline__ float bflo(unsigned w) { return __uint_as_float(w << 16); }
__device__ __forceinline__ float bfhi(unsigned w) { return __uint_as_float(w & 0xffff0000u); }
__device__ __forceinline__ float silu_f(float x) { return x / (1.f + __expf(-x)); }

__device__ __forceinline__ void p0_transpose_item(const float* W, int ldw, int K, int nblk, bf16* WT, const float* kscale, LAS float* scr, int item, int lane) {
    const int kb = item / nblk, nb = item % nblk, k0 = 64 * kb, n0 = 32 * nb;
#pragma unroll 8
    for (int i = 0; i < 32; ++i) { const int kk = 2 * i + (lane >> 5); float v = W[(size_t)(k0 + kk) * ldw + n0 + (lane & 31)]; if (kscale) v *= kscale[k0 + kk]; scr[kk * 33 + (lane & 31)] = v; }
    LDS_WAIT(); asm volatile("" ::: "memory");
    const int c = lane & 7;
#pragma unroll
    for (int j = 0; j < 4; ++j) { const int n = (lane >> 3) + 8 * j; const LAS float* s = scr + (8 * c) * 33 + n;
        v4u o; o.x = pk2(s[0 * 33], s[1 * 33]); o.y = pk2(s[2 * 33], s[3 * 33]); o.z = pk2(s[4 * 33], s[5 * 33]); o.w = pk2(s[6 * 33], s[7 * 33]);
        *(GAS v4u*)(WT + (size_t)(n0 + n) * K + k0 + 8 * c) = o; }
    LDS_WAIT(); asm volatile("" ::: "memory");
}
struct Ptrs {
    const float *x, *norm_mix, *w_in, *conv_w, *conv_b, *dt_bias, *a_log, *d_skip, *ssd_norm_w, *sinks, *w_out, *rel_bias, *norm_ffn, *w_query, *sk1, *sk2, *e_down, *e_up, *norm_final;
    float* out; unsigned char* ws;
};
constexpr int Q_SPLIT = 16384;
__device__ __forceinline__ unsigned pack4_i8(float a, float b, float c, float d) {
    const int ia = __float2int_rn(a), ib = __float2int_rn(b), ic = __float2int_rn(c), id = __float2int_rn(d);
    return (unsigned)(ia & 0xff) | ((unsigned)(ib & 0xff) << 8) | ((unsigned)(ic & 0xff) << 16) | ((unsigned)(id & 0xff) << 24);
}
__device__ __forceinline__ void quant_fp8s(const Ptrs& P, int lane_, int r_lo, int r_hi, int w, int nw) {
    float* SC = (float*)(P.ws + WS_SMALL);
    for (int row = r_lo + w; row < r_hi; row += nw) {
        const int e = row & 16383;
        const float4* src = (const float4*)(P.e_down + (size_t)e * DM) + 4 * lane_;
        float v[16];
#pragma unroll
        for (int q = 0; q < 4; ++q) { const float4 t = src[q]; const float4 w4 = ((const float4*)P.norm_ffn)[4 * lane_ + q]; v[4 * q] = t.x * w4.x; v[4 * q + 1] = t.y * w4.y; v[4 * q + 2] = t.z * w4.z; v[4 * q + 3] = t.w * w4.w; }
        float am = 0.f;
#pragma unroll
        for (int q = 0; q < 16; ++q) am = fmaxf(am, fabsf(v[q]));
        am = fmaxf(am, swz_xor<1>(am)); am = fmaxf(am, swz_xor<2>(am)); am = fmaxf(am, swz_xor<4>(am)); am = fmaxf(am, swz_xor<8>(am)); am = fmaxf(am, swz_xor<16>(am)); am = max_halves(am);
        am = fmaxf(am, 1e-30f);
        const float inv = 127.f / am;
        v4u o; o.x = pack4_i8(v[0] * inv, v[1] * inv, v[2] * inv, v[3] * inv); o.y = pack4_i8(v[4] * inv, v[5] * inv, v[6] * inv, v[7] * inv);
        o.z = pack4_i8(v[8] * inv, v[9] * inv, v[10] * inv, v[11] * inv); o.w = pack4_i8(v[12] * inv, v[13] * inv, v[14] * inv, v[15] * inv);
        *(v4u*)(P.ws + WS_ED + ((size_t)(lane_ >> 3) * 16384 + e) * 128 + (lane_ & 7) * 16) = o;
        if (lane_ == 0) SC[row] = am * (1.f / 127.f);
    }
}
__device__ __forceinline__ void quant_fp6u(const Ptrs& P, int lane_, int q_lo, int q_hi, int w, int nw) {
    { float* SC = (float*)(P.ws + WS_SMALL); const int l31 = lane_ & 31, hf = lane_ >> 5;
      for (int q = q_lo + w; q < q_hi; q += nw) {
        const int e = 2 * q + hf, row = 16384 + e; const int isup = 1;
        const float4* src = (const float4*)((isup ? P.e_up : P.e_down) + (size_t)e * DM) + 8 * l31;
        float v[32];
#pragma unroll
        for (int k = 0; k < 8; ++k) { const float4 t = src[k]; v[4 * k] = t.x; v[4 * k + 1] = t.y; v[4 * k + 2] = t.z; v[4 * k + 3] = t.w; }
        if (!isup) {
#pragma unroll
            for (int k = 0; k < 8; ++k) { const float4 w = ((const float4*)P.norm_ffn)[8 * l31 + k]; v[4 * k] *= w.x; v[4 * k + 1] *= w.y; v[4 * k + 2] *= w.z; v[4 * k + 3] *= w.w; } }
        float am = 0.f;
#pragma unroll
        for (int k = 0; k < 32; ++k) am = fmaxf(am, fabsf(v[k]));
        am = fmaxf(am, swz_xor<1>(am)); am = fmaxf(am, swz_xor<2>(am)); am = fmaxf(am, swz_xor<4>(am)); am = fmaxf(am, swz_xor<8>(am)); am = fmaxf(am, swz_xor<16>(am));
        am = fmaxf(am, 1e-30f);
        const float inv = 7.5f / am;
        v32h xh;
#pragma unroll
        for (int k = 0; k < 32; ++k) xh[k] = (_Float16)(v[k] * inv);
        const v6u pk = __builtin_amdgcn_cvt_scalef32_pk32_fp6_f16(xh, 1.0f);
        unsigned char* dst = P.ws + WS_EU + (size_t)e * 768;
        *(v4u*)(dst + 16 * l31) = (v4u){pk[0], pk[1], pk[2], pk[3]};
        *(unsigned long long*)(dst + 512 + 8 * l31) = (unsigned long long)pk[4] | ((unsigned long long)pk[5] << 32);
        if (l31 == 0) SC[row] = am * (1.f / 7.5f);
      } }
}
__device__ __forceinline__ void p0_prologue(Frame& F0, const Ptrs& P) {
    const Frame& F = F0; const int lane_ = lane_id(), tid_ = F.wave * 64 + lane_;
    LAS float* scr = (LAS float*)(F.lds + RING_OFF + F.wave * 16384);
    const int gw = F.vcu * NWAVES + F.wave, NGW = F.G * NWAVES;
    bf16* Win_t = (bf16*)(P.ws + WS_WIN); bf16* Wout_t = (bf16*)(P.ws + WS_WOUT); bf16* Wq_t = (bf16*)(P.ws + WS_WQ);
    constexpr int I_IN = 16 * 72, I_OUT = 16 * 32, I_Q = 16 * 64, NITEMS = I_IN + I_OUT + I_Q;
    for (int it = gw; it < NITEMS; it += NGW) {
        int r = it;
        if (r < I_IN) { p0_transpose_item(P.w_in, INC, DM, 72, Win_t, nullptr, scr, r, lane_); continue; } r -= I_IN;
        if (r < I_OUT) { p0_transpose_item(P.w_out, DM, DM, 32, Wout_t, nullptr, scr, r, lane_); continue; } r -= I_OUT;
        p0_transpose_item(P.w_query, 2048, DM, 64, Wq_t, P.norm_ffn, scr, r, lane_);
    }
    quant_fp8s(P, lane_, 0, Q_SPLIT, gw, NGW);
    __syncthreads();
    { LAS float* Wdt = (LAS float*)(F.lds + RING_OFF);
      for (int i = tid_; i < 8192; i += 512) Wdt[i] = P.w_in[(size_t)(i >> 3) * INC + NPROJ + (i & 7)];
      __syncthreads();
      bf16* XN = (bf16*)(P.ws + WS_XN); float* DT = (float*)(P.ws + WS_DT);
      for (int m0 = gw * 2; m0 < T_; m0 += NGW * 2) {
        float4 xv[2][4];
#pragma unroll
        for (int rr = 0; rr < 2; ++rr) { const float4* xr = (const float4*)(P.x + (size_t)(m0 + rr) * DM);
#pragma unroll
            for (int j = 0; j < 4; ++j) xv[rr][j] = xr[j * 64 + lane_]; }
#pragma unroll
        for (int rr = 0; rr < 2; ++rr) { const int m = m0 + rr;
        float4 v[4]; float s = 0.f;
#pragma unroll
        for (int j = 0; j < 4; ++j) { v[j] = xv[rr][j]; s += v[j].x * v[j].x + v[j].y * v[j].y + v[j].z * v[j].z + v[j].w * v[j].w; }
        const float r = rsqrtf(wave_sum(s) * (1.f / 1024.f) + EPS);
        float d8[8];
#pragma unroll
        for (int q = 0; q < 8; ++q) d8[q] = 0.f;
        unsigned long long* o8 = (unsigned long long*)(XN + (size_t)m * DM);
#pragma unroll
        for (int j = 0; j < 4; ++j) { const float4 w = ((const float4*)P.norm_mix)[j * 64 + lane_];
            const float e0 = v[j].x * r * w.x, e1 = v[j].y * r * w.y, e2 = v[j].z * r * w.z, e3 = v[j].w * r * w.w;
            o8[j * 64 + lane_] = (unsigned long long)pk2(e0, e1) | ((unsigned long long)pk2(e2, e3) << 32);
            const float ev[4] = {e0, e1, e2, e3};
#pragma unroll
            for (int e = 0; e < 4; ++e) { const LAS f32x4* wr = (const LAS f32x4*)(Wdt + (size_t)(j * 256 + lane_ * 4 + e) * 8); const f32x4 w0 = wr[0], w1 = wr[1];
                d8[0] += ev[e] * w0.x; d8[1] += ev[e] * w0.y; d8[2] += ev[e] * w0.z; d8[3] += ev[e] * w0.w; d8[4] += ev[e] * w1.x; d8[5] += ev[e] * w1.y; d8[6] += ev[e] * w1.z; d8[7] += ev[e] * w1.w; } }
#pragma unroll
        for (int q = 0; q < 8; ++q) d8[q] = wave_sum(d8[q]);
        if (lane_ == 0) { float4* dp = (float4*)(DT + (size_t)m * 8); dp[0] = make_float4(d8[0], d8[1], d8[2], d8[3]); dp[1] = make_float4(d8[4], d8[5], d8[6], d8[7]); }
        }
      }
      __syncthreads(); }
}

struct EpiResH {
    static constexpr bool PERM = false, AFTER_DRAIN = false;
    const float* X; bf16* HB; float* SSQ;
    __device__ __forceinline__ void operator()(const pg8::f32x4 (&acc)[2][2][4][2], const pg8::Unit& u, int wr, int wc, int fr, int fq) const {
        const int row0 = u.pm * 256 + wr * 64 + fr, col0 = u.pn * 256 + wc * 32 + 4 * fq;
#pragma unroll
        for (int ai = 0; ai < 2; ++ai)
#pragma unroll
            for (int m = 0; m < 4; ++m) { const int row = row0 + ai * 128 + m * 16; float ss = 0.f;
#pragma unroll
                for (int bj = 0; bj < 2; ++bj)
#pragma unroll
                    for (int n = 0; n < 2; ++n) { const size_t off = (size_t)row * DM + col0 + bj * 128 + n * 16;
                        const pg8::f32x4 h = acc[ai][bj][m][n] + *(const pg8::f32x4*)(X + off);
                        ss += h[0] * h[0] + h[1] * h[1] + h[2] * h[2] + h[3] * h[3];
                        *(unsigned long long*)(HB + off) = (unsigned long long)pk2(h[0], h[1]) | ((unsigned long long)pk2(h[2], h[3]) << 32); }
                ss += swz_xor<16>(ss); ss = sum_halves(ss);
                if (fq == 0) SSQ[(size_t)row * 16 + u.pn * 4 + wc] = ss; }
    }
};

typedef float f32x16 __attribute__((ext_vector_type(16)));
typedef short s16x4 __attribute__((ext_vector_type(4)));
typedef float f32x2_t __attribute__((ext_vector_type(2)));
typedef __bf16 bf16x2_t __attribute__((ext_vector_type(2)));
#define MFMA32(a, b, c) __builtin_amdgcn_mfma_f32_32x32x16_bf16((a), (b), (c), 0, 0, 0)
__device__ __forceinline__ int crow(int reg, int h) { return (reg & 3) + 8 * (reg >> 2) + 4 * h; }
__device__ __forceinline__ unsigned cvtpk(float lo, float hi) { f32x2_t v = {lo, hi}; bf16x2_t b = __builtin_convertvector(v, bf16x2_t); return __builtin_bit_cast(unsigned, b); }
__device__ __forceinline__ bf16x8 pack8(const f32x16& x, int s) {
    v4u p; p.x = cvtpk(x[8 * s], x[8 * s + 1]); p.y = cvtpk(x[8 * s + 2], x[8 * s + 3]); p.z = cvtpk(x[8 * s + 4], x[8 * s + 5]); p.w = cvtpk(x[8 * s + 6], x[8 * s + 7]);
    return __builtin_bit_cast(bf16x8, p);
}
constexpr float LOG2E = 1.4426950408889634f;
constexpr int LDP = 136;
constexpr int S1_XT = 0, S1_BSN = 17408, S1_CLN = 52224, S1_BNL = 87040, S1_F32 = 121856;

__device__ __forceinline__ float silu_fast(float x) { return x * __builtin_amdgcn_rcpf(1.f + __builtin_amdgcn_exp2f(-x * LOG2E)); }
__device__ __forceinline__ int swz_t(int row, int l) { return row * LDP + ((((l >> 3) ^ (row >> 3)) & 7) | ((l >> 3) & 8)) * 8 + (l & 7); }
__device__ __forceinline__ void ssd_s1(Frame& F, const Ptrs& P) {
    const bf16* PROJ = (const bf16*)(P.ws + WS_PROJ); const float* DT = (const float*)(P.ws + WS_DT);
    float* EA = (float*)(P.ws + WS_EA); float* CDEC = (float*)(P.ws + WS_CDEC); bf16* CC = (bf16*)(P.ws + WS_CC);
    float* ST = (float*)(P.ws + WS_ST); float* YPF = (float*)((char*)P.out + DO_YPF);
    LAS unsigned char* L = F.lds + RING_OFF;
    LAS bf16* Xt = (LAS bf16*)(L + S1_XT); LAS bf16* Bsn = (LAS bf16*)(L + S1_BSN); LAS bf16* Cln = (LAS bf16*)(L + S1_CLN); LAS bf16* Bnl = (LAS bf16*)(L + S1_BNL);
    LAS float* f32base = (LAS float*)(L + S1_F32);
    const int lane = lane_id(); const int tid_ = F.wave * 64 + lane;
    int ui = 0;
    for (int u = F.vcu; u < 1024; u += F.G, ++ui) {
        if ((ui & 3) == 0) {
            __syncthreads();
            const int us = u + F.wave * F.G;
            if (F.wave < 4 && us < 1024) {
                const int h = us & 7, c = (us >> 3) & 31, b = us >> 8, t0 = b * SEQ + c * 128;
                const float A = -__expf(P.a_log[h]), dtb = P.dt_bias[h];
                const int lane = opq(lane_id());
                LAS float* acum2 = f32base + F.wave * 384; LAS float* wv = acum2 + 128; LAS float* wend = wv + 128;
                const float x0 = DT[(size_t)(t0 + 2 * lane) * 8 + h] + dtb, x1 = DT[(size_t)(t0 + 2 * lane + 1) * 8 + h] + dtb;
                const float dt0 = fmaxf(x0, 0.f) + log1pf(__expf(-fabsf(x0))), dt1 = fmaxf(x1, 0.f) + log1pf(__expf(-fabsf(x1)));
                const float a0 = dt0 * A, a1 = dt1 * A;
                float s = a0 + a1;
#pragma unroll
                for (int o = 1; o < 64; o <<= 1) { const float v = __int_as_float(__builtin_amdgcn_ds_bpermute((lane - o) * 4, __float_as_int(s))); if (lane >= o) s += v; }
                const float ac1 = s, ac0 = s - a1, tot = __uint_as_float(__builtin_amdgcn_readlane(__float_as_uint(s), 63));
                acum2[2 * lane] = ac0 * LOG2E; acum2[2 * lane + 1] = ac1 * LOG2E;
                wv[2 * lane] = log2f(dt0) - ac0 * LOG2E; wv[2 * lane + 1] = log2f(dt1) - ac1 * LOG2E;
                wend[2 * lane] = dt0 * exp2f((tot - ac0) * LOG2E); wend[2 * lane + 1] = dt1 * exp2f((tot - ac1) * LOG2E);
                EA[(size_t)(t0 + 2 * lane) * 8 + h] = exp2f(ac0 * LOG2E); EA[(size_t)(t0 + 2 * lane + 1) * 8 + h] = exp2f(ac1 * LOG2E);
                if (lane == 0) CDEC[us] = exp2f(tot * LOG2E);
            }
            __syncthreads();
        }
        const int h = u & 7, c = (u >> 3) & 31, b = u >> 8, grp = h >> 2, t0 = b * SEQ + c * 128;
        const float Dh = P.d_skip[h];
        const LAS float* acum2 = f32base + (ui & 3) * 384; const LAS float* wv = acum2 + 128; const LAS float* wend = wv + 128;
        const int tidc = opq(tid_);
        if (tidc < 440) {
            const int cg = tidc % 40, sg = tidc / 40, l0 = 12 * sg;
            int chb; if (cg < 8) chb = h * 64 + cg * 8; else if (cg < 24) chb = 512 + grp * 128 + (cg - 8) * 8; else chb = 768 + grp * 128 + (cg - 24) * 8;
            v4u raw[15];
#pragma unroll
            for (int q = 0; q < 15; ++q) { const int ss = c * 128 + l0 - 3 + q;
                raw[q] = (v4u){0u, 0u, 0u, 0u};
                if (ss >= 0 && l0 - 3 + q < 128) raw[q] = *(const v4u*)(PROJ + (size_t)(b * SEQ + ss) * NPROJ + PJ_XBC + chb); }
            float w[4][8], bias[8];
#pragma unroll
            for (int j = 0; j < 4; ++j) { const float4 w0 = *(const float4*)(P.conv_w + j * 1024 + chb), w1 = *(const float4*)(P.conv_w + j * 1024 + chb + 4);
                w[j][0] = w0.x; w[j][1] = w0.y; w[j][2] = w0.z; w[j][3] = w0.w; w[j][4] = w1.x; w[j][5] = w1.y; w[j][6] = w1.z; w[j][7] = w1.w; }
            { const float4 b0 = *(const float4*)(P.conv_b + chb), b1 = *(const float4*)(P.conv_b + chb + 4);
              bias[0] = b0.x; bias[1] = b0.y; bias[2] = b0.z; bias[3] = b0.w; bias[4] = b1.x; bias[5] = b1.y; bias[6] = b1.z; bias[7] = b1.w; }
#pragma unroll
            for (int it = 0; it < 12; it += 2) {
                const int l = l0 + it;
                if (l < 128) {
                    float a[8], a2[8];
#pragma unroll
                    for (int e = 0; e < 8; ++e) { a[e] = bias[e]; a2[e] = bias[e]; }
#pragma unroll
                    for (int j = 0; j < 4; ++j) { const v4u rw = raw[it + j], rx = raw[it + 1 + j];
                        a[0] += w[j][0] * bflo(rw.x); a[1] += w[j][1] * bfhi(rw.x); a[2] += w[j][2] * bflo(rw.y); a[3] += w[j][3] * bfhi(rw.y);
                        a[4] += w[j][4] * bflo(rw.z); a[5] += w[j][5] * bfhi(rw.z); a[6] += w[j][6] * bflo(rw.w); a[7] += w[j][7] * bfhi(rw.w);
                        a2[0] += w[j][0] * bflo(rx.x); a2[1] += w[j][1] * bfhi(rx.x); a2[2] += w[j][2] * bflo(rx.y); a2[3] += w[j][3] * bfhi(rx.y);
                        a2[4] += w[j][4] * bflo(rx.z); a2[5] += w[j][5] * bfhi(rx.z); a2[6] += w[j][6] * bflo(rx.w); a2[7] += w[j][7] * bfhi(rx.w); }
#pragma unroll
                    for (int e = 0; e < 8; ++e) { a[e] = silu_fast(a[e]); a2[e] = silu_fast(a2[e]); }
                    if (cg < 8) {
#pragma unroll
                        for (int e = 0; e < 8; ++e) *(LAS unsigned*)(Xt + swz_t(cg * 8 + e, l)) = cvtpk(a[e], a2[e]);
                    } else {
                        v4u o, o2; o.x = cvtpk(a[0], a[1]); o.y = cvtpk(a[2], a[3]); o.z = cvtpk(a[4], a[5]); o.w = cvtpk(a[6], a[7]);
                        o2.x = cvtpk(a2[0], a2[1]); o2.y = cvtpk(a2[2], a2[3]); o2.z = cvtpk(a2[4], a2[5]); o2.w = cvtpk(a2[6], a2[7]);
                        if (cg < 24) { const int n0 = (cg - 8) * 8; *(LAS v4u*)(Bsn + l * LDP + n0) = o; *(LAS v4u*)(Bsn + (l + 1) * LDP + n0) = o2; const float we = wend[l], we2 = wend[l + 1];
#pragma unroll
                            for (int e = 0; e < 8; ++e) *(LAS unsigned*)(Bnl + swz_t(n0 + e, l)) = cvtpk(a[e] * we, a2[e] * we2);
                        } else { const int n0 = (cg - 24) * 8; *(LAS v4u*)(Cln + l * LDP + n0) = o; *(LAS v4u*)(Cln + (l + 1) * LDP + n0) = o2;
                            if ((h & 3) == 0) { *(v4u*)(CC + (size_t)(t0 + l) * 256 + grp * 128 + n0) = o; *(v4u*)(CC + (size_t)(t0 + l + 1) * 256 + grp * 128 + n0) = o2; } }
                    }
                }
            }
        }
        __syncthreads();
        const int ln3 = opq(lane), r = ln3 & 31, hh = ln3 >> 5;
        if (F.wave < 4) {
            const int pt = F.wave >> 1;
#pragma unroll 1
            for (int q = 0; q < 2; ++q) {
                const int lt = (F.wave & 1) ? (1 + q) : (3 * q);
                f32x16 yacc;
#pragma unroll
                for (int i = 0; i < 16; ++i) yacc[i] = 0.f;
                const float al = acum2[32 * lt + r];
                for (int st = 0; st <= lt; ++st) {
                    f32x16 macc;
#pragma unroll
                    for (int i = 0; i < 16; ++i) macc[i] = 0.f;
#pragma unroll
                    for (int kk = 0; kk < 8; ++kk) {
                        const bf16x8 a = *(const LAS bf16x8*)(Bsn + (32 * st + r) * LDP + 16 * kk + 8 * hh);
                        const bf16x8 bb = *(const LAS bf16x8*)(Cln + (32 * lt + r) * LDP + 16 * kk + 8 * hh);
                        macc = MFMA32(a, bb, macc);
                    }
#pragma unroll
                    for (int i = 0; i < 16; ++i) { const int sl = crow(i, hh);
                        float f = __builtin_amdgcn_exp2f(al + wv[32 * st + sl]);
                        if (st == lt && sl > r) f = 0.f;
                        macc[i] *= f; }
#pragma unroll
                    for (int sg = 0; sg < 2; ++sg) {
                        const bf16x8 bfrag = pack8(macc, sg);
                        const int prow = 32 * pt + r, lb = 32 * st + 16 * sg;
                        const s16x4 lo = *(const LAS s16x4*)(Xt + swz_t(prow, lb) + 4 * hh), hi = *(const LAS s16x4*)(Xt + swz_t(prow, lb + 8) + 4 * hh);
                        const bf16x8 afrag = __builtin_shufflevector(lo, hi, 0, 1, 2, 3, 4, 5, 6, 7);
                        yacc = MFMA32(afrag, bfrag, yacc);
                    }
                }
#pragma unroll
                for (int i = 0; i < 16; ++i) { const int p = 32 * pt + crow(i, hh);
                    const float y = yacc[i] + Dh * bf2f(Xt[swz_t(p, 32 * lt + r)]);
                    YPF[((((size_t)u * 4 + lt) * 2 + pt) * 16 + i) * 64 + ln3] = y; }
            }
        } else {
            const int nt = F.wave - 4;
#pragma unroll 1
            for (int pt = 0; pt < 2; ++pt) {
                f32x16 sacc;
#pragma unroll
                for (int i = 0; i < 16; ++i) sacc[i] = 0.f;
#pragma unroll
                for (int kk = 0; kk < 8; ++kk) {
                    const bf16x8 a = *(const LAS bf16x8*)(Xt + swz_t(32 * pt + r, 16 * kk + 8 * hh));
                    const bf16x8 bb = *(const LAS bf16x8*)(Bnl + swz_t(32 * nt + r, 16 * kk + 8 * hh));
                    sacc = MFMA32(a, bb, sacc);
                }
#pragma unroll
                for (int i = 0; i < 16; ++i) ST[((size_t)u * 64 + 32 * pt + crow(i, hh)) * 128 + 32 * nt + r] = sacc[i];
            }
        }
        __syncthreads();
    }
}
__device__ __forceinline__ void ssd_s2(Frame& F, const Ptrs& P) {
    const float* ST = (const float*)(P.ws + WS_ST); const float* CDEC = (const float*)(P.ws + WS_CDEC); unsigned* PREV = (unsigned*)(P.ws + WS_PREV);
    for (int g = F.vcu * 512 + (F.wave * 64 + lane_id()); g < 131072; g += F.G * 512) {
        const int n2 = g & 63, p = (g >> 6) & 63, h = (g >> 12) & 7, b = g >> 15;
        float2 st[32];
#pragma unroll
        for (int c = 0; c < 32; ++c) st[c] = *(const float2*)(ST + ((size_t)(((b * 32 + c) * 8 + h) * 64 + p)) * 128 + 2 * n2);
        float r0 = 0.f, r1 = 0.f;
#pragma unroll
        for (int c = 0; c < 32; ++c) { const size_t u = (size_t)((b * 32 + c) * 8 + h);
            PREV[((u * 64 + p) * 128 + 2 * n2) >> 1] = pk2(r0, r1);
            const float d = CDEC[u]; r0 = r0 * d + st[c].x; r1 = r1 * d + st[c].y; }
    }
}
__device__ __forceinline__ void ssd_s3(Frame& F, const Ptrs& P) {
    const bf16* CC = (const bf16*)(P.ws + WS_CC); const bf16* PREV = (const bf16*)(P.ws + WS_PREV); const float* EA = (const float*)(P.ws + WS_EA);
    const float* YPF = (const float*)((const char*)P.out + DO_YPF); const bf16* PROJ = (const bf16*)(P.ws + WS_PROJ); bf16* CAT = (bf16*)(P.ws + WS_XN);
    LAS float* red = (LAS float*)(F.lds + RING_OFF);
    const int lane = lane_id(), r = lane & 31, hh = lane >> 5, h = F.wave, grp = h >> 2;
    for (int v = F.vcu; v < 512; v += F.G) {
        const int lt = v & 3, c = (v >> 2) & 31, b = v >> 7;
        const int t = b * SEQ + c * 128 + lt * 32 + r; const size_t u = (size_t)((b * 32 + c) * 8 + h);
        float ypf[2][16]; unsigned long long zz[2][4];
#pragma unroll
        for (int pt = 0; pt < 2; ++pt) {
#pragma unroll
            for (int i = 0; i < 16; ++i) ypf[pt][i] = YPF[((((size_t)u * 4 + lt) * 2 + pt) * 16 + i) * 64 + lane];
#pragma unroll
            for (int g4 = 0; g4 < 4; ++g4) zz[pt][g4] = *(const unsigned long long*)(PROJ + (size_t)t * NPROJ + PJ_Z + h * 64 + 32 * pt + 8 * g4 + 4 * hh); }
        const float ea = EA[(size_t)t * 8 + h];
        f32x16 acc[2];
#pragma unroll
        for (int i = 0; i < 16; ++i) { acc[0][i] = 0.f; acc[1][i] = 0.f; }
#pragma unroll
        for (int kk = 0; kk < 8; ++kk) {
            const bf16x8 bb = *(const bf16x8*)(CC + (size_t)t * 256 + grp * 128 + 16 * kk + 8 * hh);
#pragma unroll
            for (int pt = 0; pt < 2; ++pt) { const bf16x8 a = *(const bf16x8*)(PREV + (u * 64 + 32 * pt + r) * 128 + 16 * kk + 8 * hh); acc[pt] = MFMA32(a, bb, acc[pt]); }
        }
        float ss = 0.f;
#pragma unroll
        for (int pt = 0; pt < 2; ++pt)
#pragma unroll
            for (int g4 = 0; g4 < 4; ++g4) {
                const unsigned z01 = (unsigned)zz[pt][g4], z23 = (unsigned)(zz[pt][g4] >> 32);
                const float zf[4] = {bflo(z01), bfhi(z01), bflo(z23), bfhi(z23)};
#pragma unroll
                for (int e = 0; e < 4; ++e) { const int i = 4 * g4 + e;
                    const float y = acc[pt][i] * ea + ypf[pt][i];
                    const float yg = y * silu_fast(zf[e]); acc[pt][i] = yg; ss = fmaf(yg, yg, ss); }
            }
        ss = sum_halves(ss);
        if (hh == 0) red[h * 32 + r] = ss;
        __syncthreads();
        float tot = 0.f;
#pragma unroll
        for (int w = 0; w < 8; ++w) tot += red[w * 32 + r];
        const float rn = rsqrtf(tot * (1.f / 512.f) + EPS);
#pragma unroll
        for (int pt = 0; pt < 2; ++pt)
#pragma unroll
            for (int g4 = 0; g4 < 4; ++g4) { const int ch = h * 64 + 32 * pt + 8 * g4 + 4 * hh;
                const float4 w = *(const float4*)(P.ssd_norm_w + ch);
                *(unsigned long long*)(CAT + (size_t)t * DM + 512 + ch) = (unsigned long long)cvtpk(acc[pt][4 * g4] * rn * w.x, acc[pt][4 * g4 + 1] * rn * w.y) | ((unsigned long long)cvtpk(acc[pt][4 * g4 + 2] * rn * w.z, acc[pt][4 * g4 + 3] * rn * w.w) << 32); }
        __syncthreads();
    }
}
__device__ __forceinline__ float gelu_erf(float v) { return 0.5f * v * (1.f + erff(v * 0.70710678118654752f)); }
typedef float f32x2v __attribute__((ext_vector_type(2)));
#define CVT8(W, LO) __builtin_amdgcn_cvt_pk_f32_fp8((int)(W), LO)
template <int CTRL> __device__ __forceinline__ float dpp_f(float v) { return __int_as_float(__builtin_amdgcn_update_dpp(0, __float_as_int(v), CTRL, 0xF, 0xF, true)); }
__device__ __forceinline__ float sum8_dpp(float s) { s += dpp_f<0xB1>(s); s += dpp_f<0x4E>(s); s += dpp_f<0x141>(s); return s; }
struct PeerPlace { int vx, nx, rank, nloc; };
__device__ __forceinline__ PeerPlace peer_place(Frame& F) {
    __syncthreads();
    if (F.wave == 0 && lane_id() == 0) {
        unsigned* bar = (unsigned*)(F.ctl + CW_BAR); const unsigned x = xb_xcc_id();
        unsigned vx = 0, nx = 0;
        for (unsigned j = 0; j < 16; ++j) { const unsigned c = xb_ld(&bar[XB_XCNT(j)]); if (c) { if (j < x) ++vx; ++nx; } }
        const unsigned rank = xb_add((unsigned*)(F.ctl + CW_RANK) + 64 * x, 1u);
        F.MISC[10] = vx; F.MISC[11] = nx ? nx : 1u; F.MISC[12] = rank; F.MISC[13] = xb_ld(&bar[XB_XCNT(x)]);
    }
    __syncthreads();
    PeerPlace pp; pp.vx = (int)F.MISC[10]; pp.nx = (int)F.MISC[11]; pp.rank = (int)F.MISC[12]; pp.nloc = (int)F.MISC[13]; if (pp.nloc < 1) pp.nloc = 1;
    return pp;
}
__device__ __forceinline__ void h_quant_rows(Frame& F, const Ptrs& P) {
    const bf16* HB = (const bf16*)(P.ws + WS_ST); unsigned char* H8 = P.ws + WS_H8; float* HS = (float*)(P.ws + WS_HS);
    const int lane = lane_id();
    for (int t = F.vcu * NWAVES + F.wave; t < T_; t += F.G * NWAVES) {
        const v4u a0 = ((const v4u*)(HB + (size_t)t * DM))[2 * lane], a1 = ((const v4u*)(HB + (size_t)t * DM))[2 * lane + 1];
        float hf[16];
        hf[0] = bflo(a0.x); hf[1] = bfhi(a0.x); hf[2] = bflo(a0.y); hf[3] = bfhi(a0.y); hf[4] = bflo(a0.z); hf[5] = bfhi(a0.z); hf[6] = bflo(a0.w); hf[7] = bfhi(a0.w);
        hf[8] = bflo(a1.x); hf[9] = bfhi(a1.x); hf[10] = bflo(a1.y); hf[11] = bfhi(a1.y); hf[12] = bflo(a1.z); hf[13] = bfhi(a1.z); hf[14] = bflo(a1.w); hf[15] = bfhi(a1.w);
        float am = 0.f;
#pragma unroll
        for (int i = 0; i < 16; ++i) am = fmaxf(am, fabsf(hf[i]));
        am = fmaxf(am, dpp_f<0xB1>(am)); am = fmaxf(am, dpp_f<0x4E>(am)); am = fmaxf(am, dpp_f<0x141>(am)); am = fmaxf(am, 1e-30f);
        const float inv = 127.f / am;
        v4u o; o.x = pack4_i8(hf[0] * inv, hf[1] * inv, hf[2] * inv, hf[3] * inv); o.y = pack4_i8(hf[4] * inv, hf[5] * inv, hf[6] * inv, hf[7] * inv);
        o.z = pack4_i8(hf[8] * inv, hf[9] * inv, hf[10] * inv, hf[11] * inv); o.w = pack4_i8(hf[12] * inv, hf[13] * inv, hf[14] * inv, hf[15] * inv);
        ((v4u*)(H8 + (size_t)t * 1024))[lane] = o;
        if ((lane & 7) == 0) HS[(size_t)t * 8 + (lane >> 3)] = am * (1.f / 127.f);
    }
}
constexpr int PX_D = 16;
template <int CTRL> __device__ __forceinline__ int dpp_i(int v) { return __builtin_amdgcn_update_dpp(0, v, CTRL, 0xF, 0xF, true); }
#define PX_IDS(NID, LO, HI) _Pragma("unroll") for (int b_ = 0; b_ < PX_D; ++b_) NID[b_] = (__builtin_amdgcn_ds_bpermute((8 * (b_ & 7) + ps) * 4, (b_ & 8) ? (HI) : (LO)) << 7) | (dl << 4)
#define PX_LOADS(BUF, NID) _Pragma("unroll") for (int b_ = 0; b_ < PX_D; ++b_) BUF[b_] = *(const v4u*)(tab + (unsigned)NID[b_])
__device__ __forceinline__ void peer_down_token(const v4u (&cur)[PX_D], const v4u h8v, const float hs, float* prow, int dl, int ps) {
    const int h8[4] = {(int)h8v.x, (int)h8v.y, (int)h8v.z, (int)h8v.w};
    int sm[PX_D];
#pragma unroll
    for (int b = 0; b < PX_D; ++b) { const v4u q = cur[b];
        int acc = __builtin_amdgcn_sdot4((int)q.x, h8[0], 0, false); acc = __builtin_amdgcn_sdot4((int)q.y, h8[1], acc, false);
        acc = __builtin_amdgcn_sdot4((int)q.z, h8[2], acc, false); sm[b] = __builtin_amdgcn_sdot4((int)q.w, h8[3], acc, false); }
    const bool c2 = (dl & 4) != 0, c1 = (dl & 2) != 0, c0 = (dl & 1) != 0;
    int w8[8], w4[4], w2[2];
#pragma unroll
    for (int k = 0; k < 8; ++k) { const int keep = c2 ? sm[8 + k] : sm[k], send = c2 ? sm[k] : sm[8 + k]; w8[k] = keep + dpp_i<0x141>(send); }
#pragma unroll
    for (int k = 0; k < 4; ++k) { const int keep = c1 ? w8[4 + k] : w8[k], send = c1 ? w8[k] : w8[4 + k]; w4[k] = keep + dpp_i<0x4E>(send); }
#pragma unroll
    for (int k = 0; k < 2; ++k) { const int keep = c0 ? w4[2 + k] : w4[k], send = c0 ? w4[k] : w4[2 + k]; w2[k] = keep + dpp_i<0xB1>(send); }
    prow[16 * dl + ps] = (float)w2[0] * hs; prow[16 * dl + 8 + ps] = (float)w2[1] * hs;
}
__device__ __forceinline__ void peer_down(Frame& F, const Ptrs& P, const PeerPlace& pp) {
    const unsigned char* H8 = P.ws + WS_H8; const float* HS = (const float*)(P.ws + WS_HS); const int* IDX = (const int*)(P.ws + WS_IDX); float* PART = (float*)(P.ws + WS_PART);
    const int lane = lane_id(), dl = lane & 7, ps = lane >> 3;
    const int t0 = pp.rank * NWAVES + F.wave, tstep = pp.nloc * NWAVES;
    for (int s = pp.vx; s < 8; s += pp.nx) {
        if (t0 >= T_) continue;
        const unsigned char* tab = P.ws + WS_ED + (size_t)s * 16384 * 128;
        const unsigned char* hbase = H8 + s * 128 + dl * 16;
        v4u bufA[PX_D], bufB[PX_D]; int nid[PX_D];
        { const int i_lo = IDX[(size_t)t0 * 128 + lane], i_hi = IDX[(size_t)t0 * 128 + 64 + lane]; PX_IDS(nid, i_lo, i_hi); PX_LOADS(bufA, nid); }
        const int t1 = (t0 + tstep < T_) ? t0 + tstep : t0;
        int nidx_lo = IDX[(size_t)t1 * 128 + lane], nidx_hi = IDX[(size_t)t1 * 128 + 64 + lane];
        v4u hq0 = *(const v4u*)(hbase + (size_t)t0 * 1024); float hsc = HS[(size_t)t0 * 8 + s];
        for (int t = t0; t < T_; t += 2 * tstep) {
            { const int tn = (t + tstep < T_) ? t + tstep : t, tnn = (tn + tstep < T_) ? tn + tstep : tn;
              PX_IDS(nid, nidx_lo, nidx_hi); PX_LOADS(bufB, nid);
              nidx_lo = IDX[(size_t)tnn * 128 + lane]; nidx_hi = IDX[(size_t)tnn * 128 + 64 + lane];
              const v4u nh0 = *(const v4u*)(hbase + (size_t)tn * 1024); const float nhs = HS[(size_t)tn * 8 + s];
              __builtin_amdgcn_sched_barrier(0);
              peer_down_token(bufA, hq0, hsc, PART + ((size_t)s * T_ + t) * 128, dl, ps);
              hq0 = nh0; hsc = nhs; __builtin_amdgcn_sched_barrier(0); }
            if (t + tstep >= T_) break;
            { const int tc = t + tstep; const int tn = (tc + tstep < T_) ? tc + tstep : tc, tnn = (tn + tstep < T_) ? tn + tstep : tn;
              PX_IDS(nid, nidx_lo, nidx_hi); PX_LOADS(bufA, nid);
              nidx_lo = IDX[(size_t)tnn * 128 + lane]; nidx_hi = IDX[(size_t)tnn * 128 + 64 + lane];
              const v4u nh0 = *(const v4u*)(hbase + (size_t)tn * 1024); const float nhs = HS[(size_t)tn * 8 + s];
              __builtin_amdgcn_sched_barrier(0);
              peer_down_token(bufB, hq0, hsc, PART + ((size_t)s * T_ + tc) * 128, dl, ps);
              hq0 = nh0; hsc = nhs; __builtin_amdgcn_sched_barrier(0); }
        }
    }
}
__device__ __forceinline__ void peer_act(Frame& F, const Ptrs& P) {
    const int* IDX = (const int*)(P.ws + WS_IDX); float* GATE = (float*)(P.ws + WS_GATE); const float* PART = (const float*)(P.ws + WS_PART); const float* SSQ = (const float*)(P.ws + WS_SSQ);
    const float* SCD = (const float*)(P.ws + WS_SMALL); const float* SCU = SCD + 16384;
    const int lane = lane_id();
    for (int w = F.vcu * NWAVES + F.wave; w < T_ * 2; w += F.G * NWAVES) {
        const int t = w >> 1; const size_t pid = (size_t)w * 64 + lane;
        const float ssq = lane < 16 ? SSQ[(size_t)t * 16 + lane] : 0.f;
        const float rstd = rsqrtf(wave_sum(ssq) * (1.f / 1024.f) + EPS);
        float pre = 0.f;
#pragma unroll
        for (int s = 0; s < 8; ++s) pre += PART[(size_t)s * T_ * 128 + pid];
        const int id = IDX[pid];
        GATE[pid] = gelu_erf(pre * SCD[id] * rstd) * GATE[pid] * SCU[id];
    }
}
constexpr int PE_PD = 8;
struct Row6 { v4u a; unsigned long long b; };
#define PE_ID1(P) __builtin_amdgcn_readlane(((P) & 64) ? idx_hi : idx_lo, (P) & 63)
#define PE_LOAD6(SLOT, TAB, IDA, IDB) do { const int id_ = upper ? (IDB) : (IDA); const unsigned char* rp_ = (TAB) + (size_t)id_ * 768; \
        SLOT.a = *(const v4u*)(rp_ + 16 * l31); SLOT.b = *(const unsigned long long*)(rp_ + 512 + 8 * l31); } while (0)
__device__ __forceinline__ v32f dec6(const Row6& r) { const v6u p = {r.a.x, r.a.y, r.a.z, r.a.w, (unsigned)r.b, (unsigned)(r.b >> 32)}; return __builtin_amdgcn_cvt_scalef32_pk32_f32_fp6(p, 1.0f); }
__device__ __forceinline__ void peer_up_tm(Frame& F, const Ptrs& P) {
    const bf16* HB = (const bf16*)(P.ws + WS_ST); const unsigned char* EU = P.ws + WS_EU;
    const int* IDX = (const int*)(P.ws + WS_IDX); const float* GATE = (const float*)(P.ws + WS_GATE); const float* PART = (const float*)(P.ws + WS_PART);
    const float* SCD = (const float*)(P.ws + WS_SMALL); const float* SCU = SCD + 16384;
    const int lane = lane_id(), l31 = lane & 31; const bool upper = lane >= 32;
    const int t0 = F.vcu * NWAVES + F.wave, tstep = F.G * NWAVES;
    if (t0 >= T_) return;
    int idx_lo = IDX[(size_t)t0 * 128 + lane], idx_hi = IDX[(size_t)t0 * 128 + 64 + lane];
    v4u hq[4];
#pragma unroll
    for (int k = 0; k < 4; ++k) hq[k] = ((const v4u*)(HB + (size_t)t0 * DM))[4 * l31 + k];
    float g_lo = GATE[(size_t)t0 * 128 + lane], g_hi = GATE[(size_t)t0 * 128 + 64 + lane];
    float pre_lo = 0.f, pre_hi = 0.f;
#pragma unroll
    for (int s = 0; s < 8; ++s) { pre_lo += PART[((size_t)s * T_ + t0) * 128 + lane]; pre_hi += PART[((size_t)s * T_ + t0) * 128 + 64 + lane]; }
    float sdu_lo = SCD[idx_lo], sdu_hi = SCD[idx_hi], su_lo = SCU[idx_lo], su_hi = SCU[idx_hi];
    Row6 ra[PE_PD];
#pragma unroll
    for (int j = 0; j < PE_PD; ++j) PE_LOAD6(ra[j], EU, __builtin_amdgcn_readlane(idx_lo, 2 * j), __builtin_amdgcn_readlane(idx_lo, 2 * j + 1));
    for (int t = t0; t < T_; t += tstep) {
        const int tn = (t + tstep < T_) ? t + tstep : t;
        const int nidx_lo = IDX[(size_t)tn * 128 + lane], nidx_hi = IDX[(size_t)tn * 128 + 64 + lane];
        v4u nh[4];
#pragma unroll
        for (int k = 0; k < 4; ++k) nh[k] = ((const v4u*)(HB + (size_t)tn * DM))[4 * l31 + k];
        const float ng_lo = GATE[(size_t)tn * 128 + lane], ng_hi = GATE[(size_t)tn * 128 + 64 + lane];
        float npart_lo[8], npart_hi[8];
#pragma unroll
        for (int s = 0; s < 8; ++s) { npart_lo[s] = PART[((size_t)s * T_ + tn) * 128 + lane]; npart_hi[s] = PART[((size_t)s * T_ + tn) * 128 + 64 + lane]; }
        float hv[32];
#pragma unroll
        for (int k = 0; k < 4; ++k) { hv[8 * k] = bflo(hq[k].x); hv[8 * k + 1] = bfhi(hq[k].x); hv[8 * k + 2] = bflo(hq[k].y); hv[8 * k + 3] = bfhi(hq[k].y); hv[8 * k + 4] = bflo(hq[k].z); hv[8 * k + 5] = bfhi(hq[k].z); hv[8 * k + 6] = bflo(hq[k].w); hv[8 * k + 7] = bfhi(hq[k].w); }
        float ssq = 0.f;
#pragma unroll
        for (int i = 0; i < 32; ++i) ssq = fmaf(hv[i], hv[i], ssq);
        ssq += swz_xor<1>(ssq); ssq += swz_xor<2>(ssq); ssq += swz_xor<4>(ssq); ssq += swz_xor<8>(ssq); ssq += swz_xor<16>(ssq);
        const float rstd = rsqrtf(ssq * (1.f / 1024.f) + EPS);
        const float act_lo = gelu_erf(pre_lo * sdu_lo * rstd) * g_lo * su_lo, act_hi = gelu_erf(pre_hi * sdu_hi * rstd) * g_hi * su_hi;
        float acc[32];
#pragma unroll
        for (int i = 0; i < 32; ++i) acc[i] = 0.f;
#pragma unroll
        for (int g = 0; g < 2; ++g) {
            const float actv = g ? act_hi : act_lo;
#pragma unroll
            for (int j = 0; j < 32; ++j) {
                const int q = 32 * g + j;
                const float aA = __uint_as_float(__builtin_amdgcn_readlane(__float_as_uint(actv), 2 * j)), aB = __uint_as_float(__builtin_amdgcn_readlane(__float_as_uint(actv), 2 * j + 1));
                const float a = upper ? aB : aA;
                { const v32f d = dec6(ra[q % PE_PD]);
#pragma unroll
                  for (int i = 0; i < 32; ++i) acc[i] = fmaf(a, d[i], acc[i]); }
                asm volatile("" : "+v"(acc[0]), "+v"(acc[1]), "+v"(acc[2]), "+v"(acc[3]), "+v"(acc[4]), "+v"(acc[5]), "+v"(acc[6]), "+v"(acc[7]), "+v"(acc[8]), "+v"(acc[9]), "+v"(acc[10]), "+v"(acc[11]), "+v"(acc[12]), "+v"(acc[13]), "+v"(acc[14]), "+v"(acc[15]));
                asm volatile("" : "+v"(acc[16]), "+v"(acc[17]), "+v"(acc[18]), "+v"(acc[19]), "+v"(acc[20]), "+v"(acc[21]), "+v"(acc[22]), "+v"(acc[23]), "+v"(acc[24]), "+v"(acc[25]), "+v"(acc[26]), "+v"(acc[27]), "+v"(acc[28]), "+v"(acc[29]), "+v"(acc[30]), "+v"(acc[31]));
                if (q + PE_PD < 64) PE_LOAD6(ra[q % PE_PD], EU, PE_ID1(2 * (q + PE_PD)), PE_ID1(2 * (q + PE_PD) + 1));
                else PE_LOAD6(ra[q % PE_PD], EU, __builtin_amdgcn_readlane(nidx_lo, 2 * (q + PE_PD - 64)), __builtin_amdgcn_readlane(nidx_lo, 2 * (q + PE_PD - 64) + 1));
                __builtin_amdgcn_sched_barrier(0);
            }
        }
        { float a = 0.f, c = 0.f;
#pragma unroll
          for (int s = 0; s < 8; ++s) { a += npart_lo[s]; c += npart_hi[s]; }
          pre_lo = a; pre_hi = c; }
        sdu_lo = SCD[nidx_lo]; sdu_hi = SCD[nidx_hi]; su_lo = SCU[nidx_lo]; su_hi = SCU[nidx_hi];
        float s2 = 0.f;
#pragma unroll
        for (int i = 0; i < 32; ++i) { acc[i] = sum_halves(acc[i]) + hv[i]; s2 = fmaf(acc[i], acc[i], s2); }
        s2 += swz_xor<1>(s2); s2 += swz_xor<2>(s2); s2 += swz_xor<4>(s2); s2 += swz_xor<8>(s2); s2 += swz_xor<16>(s2);
        const float r2 = rsqrtf(s2 * (1.f / 1024.f) + EPS);
        const float4* wf = (const float4*)(P.norm_final) + 8 * l31 + 4 * (lane >> 5); float4* o = (float4*)(P.out + (size_t)t * DM) + 8 * l31 + 4 * (lane >> 5);
#pragma unroll
        for (int k = 0; k < 4; ++k) { const float4 w = wf[k];
            const float e0 = upper ? acc[16 + 4 * k] : acc[4 * k], e1 = upper ? acc[17 + 4 * k] : acc[4 * k + 1], e2 = upper ? acc[18 + 4 * k] : acc[4 * k + 2], e3 = upper ? acc[19 + 4 * k] : acc[4 * k + 3];
            o[k] = make_float4(e0 * r2 * w.x, e1 * r2 * w.y, e2 * r2 * w.z, e3 * r2 * w.w); }
        idx_lo = nidx_lo; idx_hi = nidx_hi; g_lo = ng_lo; g_hi = ng_hi;
#pragma unroll
        for (int k = 0; k < 4; ++k) hq[k] = nh[k];
    }
}
constexpr int TK_LDK = 136, TK_K2 = 34816, TK_SCR = 69632, TK_SP = 49;
__device__ __forceinline__ int mono_key(float x) { const int b = __float_as_int(x); return b ^ ((b >> 31) & 0x7fffffff); }
__device__ __forceinline__ float unmono(int m) { return __int_as_float(m ^ ((m >> 31) & 0x7fffffff)); }
__device__ __forceinline__ int max3i(int a, int b, int c) { return max(max(a, b), c); }
#define CEX(A, I, J) do { const int hi_ = max(A[I], A[J]), lo_ = min(A[I], A[J]); A[I] = hi_; A[J] = lo_; } while (0)
template <int N, int OFF, int K, int J, int LEN> struct BitonicStep {
    static __device__ __forceinline__ void run(int (&a)[LEN]) {
#pragma unroll
        for (int i = 0; i < N; ++i) { const int l = i ^ J; if (l > i) { if ((i & K) == 0) CEX(a, OFF + i, OFF + l); else CEX(a, OFF + l, OFF + i); } }
        if constexpr (J > 1) BitonicStep<N, OFF, K, (J >> 1), LEN>::run(a);
        else if constexpr (K < N) BitonicStep<N, OFF, (K << 1), K, LEN>::run(a);
    }
};
template <int N, int OFF, int LEN> __device__ __forceinline__ void bitonic_sort_desc(int (&a)[LEN]) { BitonicStep<N, OFF, 2, 1, LEN>::run(a); }
template <int OFF, int LEN> __device__ __forceinline__ void bitonic_merge16_desc(int (&a)[LEN]) { BitonicStep<16, OFF, 16, 8, LEN>::run(a); }
template <int A, int B, int LEN> __device__ __forceinline__ void merge_top16(int (&a)[LEN]) {
#pragma unroll
    for (int i = 0; i < 16; ++i) a[A + i] = max(a[A + i], a[B + 15 - i]);
    bitonic_merge16_desc<A, LEN>(a);
}
template <int LEN> __device__ __forceinline__ void pair_top16(int (&a)[LEN]) {
    int lo[16], up[16];
#pragma unroll
    for (int i = 0; i < 16; ++i) { const auto rr = __builtin_amdgcn_permlane32_swap((unsigned)a[i], (unsigned)a[i], false, false); lo[i] = (int)rr[0]; up[i] = (int)rr[1]; }
#pragma unroll
    for (int i = 0; i < 16; ++i) a[i] = max(lo[i], up[15 - i]);
    bitonic_merge16_desc<0, LEN>(a);
}
__device__ __forceinline__ void topk_phase(Frame& F, const Ptrs& P) {
    const bf16* Q = (const bf16*)(P.ws + WS_PROJ); const float* SSQ = (const float*)(P.ws + WS_SSQ);
    int* IDX = (int*)(P.ws + WS_IDX); float* GATE = (float*)(P.ws + WS_GATE);
    LAS unsigned char* L = F.lds + RING_OFF;
    LAS bf16* K1 = (LAS bf16*)L; LAS bf16* K2 = (LAS bf16*)(L + TK_K2);
    const int tid_ = (F.wave * 64 + lane_id());
    for (int i = tid_; i < 16384; i += 512) { const int n = i >> 7, k = i & 127; K1[n * TK_LDK + k] = (bf16)f2bf(P.sk1[i]); K2[n * TK_LDK + k] = (bf16)f2bf(P.sk2[i]); }
    __syncthreads();
    const int lane = tid_ & 63, r = lane & 31, hh = lane >> 5;
    LAS int* scr = (LAS int*)(L + TK_SCR) + F.wave * (32 * TK_SP) + r * TK_SP;
    for (int wq = F.vcu * NWAVES + F.wave; wq < 2048; wq += F.G * NWAVES) {
        const int t = (wq >> 2) * 32 + r;
        float rstd;
        { const float4* sp = (const float4*)(SSQ + (size_t)t * 16); const float4 a = sp[0], b = sp[1], c = sp[2], d = sp[3];
          rstd = rsqrtf(((a.x + a.y + a.z + a.w) + (b.x + b.y + b.z + b.w) + (c.x + c.y + c.z + c.w) + (d.x + d.y + d.z + d.w)) * (1.f / 1024.f) + EPS); }
#pragma unroll 1
        for (int hq = 0; hq < 2; ++hq) {
            const int hd = (wq & 3) * 2 + hq;
#pragma unroll 1
            for (int half = 0; half < 2; ++half) {
                const LAS bf16* Kh = half ? K2 : K1;
                bf16x8 qf[8];
#pragma unroll
                for (int kk = 0; kk < 8; ++kk) qf[kk] = *(const bf16x8*)(Q + (size_t)t * 2048 + hd * 256 + half * 128 + 16 * kk + 8 * hh);
                int key[64];
#pragma unroll
                for (int nt = 0; nt < 4; ++nt) {
                    f32x16 sc;
#pragma unroll
                    for (int i = 0; i < 16; ++i) sc[i] = 0.f;
#pragma unroll
                    for (int kk = 0; kk < 8; ++kk) { const bf16x8 a = *(const LAS bf16x8*)(Kh + (32 * nt + r) * TK_LDK + 16 * kk + 8 * hh); sc = MFMA32(a, qf[kk], sc); }
#pragma unroll
                    for (int i = 0; i < 16; ++i) key[nt * 16 + i] = (mono_key(sc[i]) & ~127) | (127 - (32 * nt + crow(i, hh)));
                }
                bitonic_sort_desc<16, 0, 64>(key); bitonic_sort_desc<16, 16, 64>(key); bitonic_sort_desc<16, 32, 64>(key); bitonic_sort_desc<16, 48, 64>(key);
                merge_top16<0, 16, 64>(key); merge_top16<32, 48, 64>(key); merge_top16<0, 32, 64>(key);
                pair_top16<64>(key);
                if (hh == 0) {
#pragma unroll
                    for (int i = 0; i < 16; ++i) scr[half * 16 + i] = key[i]; }
            }
            const LAS int* la = scr + hh * 16; const LAS int* lb = scr + (1 - hh) * 16;
            float va[4], vb[16];
#pragma unroll
            for (int i = 0; i < 4; ++i) va[i] = unmono(la[i] & ~127);
#pragma unroll
            for (int j = 0; j < 16; ++j) vb[j] = unmono(lb[j] & ~127);
            int ck[32];
            {
                int q = 0;
#pragma unroll
                for (int i = 0; i < 4; ++i)
#pragma unroll
                    for (int j = i; j < 16; ++j) if ((i + 1) * (j + 1) <= 16) {
                        const int pos = hh ? (j * 16 + i) : (i * 16 + j);
                        int k = (mono_key(va[i] + vb[j]) & ~255) | (255 - pos);
                        if (i == j && hh) k = (int)0x80000000;
                        ck[q++] = k; }
#pragma unroll
                for (int i = 27; i < 32; ++i) ck[i] = (int)0x80000000;
            }
            bitonic_sort_desc<32, 0, 32>(ck);
            pair_top16<32>(ck);
            const float vmax = unmono(ck[0] & ~255) * rstd;
            float ev[8]; int id[8]; float esum = 0.f; const int hm = -hh;
#pragma unroll
            for (int q = 0; q < 8; ++q) { const int wk = ck[q] ^ ((ck[q] ^ ck[8 + q]) & hm); const int pos = 255 - (wk & 255);
                const int n1 = 127 - (scr[pos >> 4] & 127), n2 = 127 - (scr[16 + (pos & 15)] & 127);
                id[q] = n1 * 128 + n2;
                ev[q] = exp2f((unmono(wk & ~255) * rstd - vmax) * LOG2E); esum += ev[q]; }
            esum = sum_halves(esum);
            const float inv = 1.f / esum;
            int4* ip = (int4*)(IDX + ((size_t)t * 8 + hd) * 16 + hh * 8); float4* gp = (float4*)(GATE + ((size_t)t * 8 + hd) * 16 + hh * 8);
            ip[0] = make_int4(id[0], id[1], id[2], id[3]); ip[1] = make_int4(id[4], id[5], id[6], id[7]);
            gp[0] = make_float4(ev[0] * inv, ev[1] * inv, ev[2] * inv, ev[3] * inv); gp[1] = make_float4(ev[4] * inv, ev[5] * inv, ev[6] * inv, ev[7] * inv);
        }
    }
    __syncthreads();
}

constexpr int AT_KP = 72, AT_VP = 264;
constexpr int AT_K = 0, AT_VT = 36864, AT_BT = 36864 + 33792;
__device__ __forceinline__ void attn_phase(Frame& F, const Ptrs& P) {
    const bf16* PROJ = (const bf16*)(P.ws + WS_PROJ); bf16* CAT = (bf16*)(P.ws + WS_XN);
    LAS unsigned char* L = F.lds + RING_OFF;
    LAS bf16* Ks = (LAS bf16*)(L + AT_K); LAS bf16* Vt = (LAS bf16*)(L + AT_VT); LAS float* btab = (LAS float*)(L + AT_BT);
    const int lane = lane_id(), tid_ = F.wave * 64 + lane, r = lane & 31, hh = lane >> 5;
    for (int u = F.vcu; u < 256; u += F.G) {
        const int hkv = u & 1, n = (u >> 1) & 31, b = u >> 6;
        const int trow0 = b * SEQ + n * 128;
        for (int i = tid_; i < 2048; i += 512) {
            const int kj = i >> 3, ch = i & 7; const bool ok = (n > 0) || (kj >= 128);
            v4u kv = {0u, 0u, 0u, 0u}, vv = {0u, 0u, 0u, 0u};
            if (ok) { const bf16* rowp = PROJ + (size_t)(trow0 - 128 + kj) * NPROJ + hkv * 64 + ch * 8; kv = *(const v4u*)(rowp + PJ_K); vv = *(const v4u*)(rowp + PJ_V); }
            *(LAS v4u*)(Ks + kj * AT_KP + ch * 8) = kv;
            LAS bf16* vp = Vt + (ch * 8) * AT_VP + kj;
            vp[0] = (bf16)(vv.x & 0xffffu); vp[AT_VP] = (bf16)(vv.x >> 16); vp[2 * AT_VP] = (bf16)(vv.y & 0xffffu); vp[3 * AT_VP] = (bf16)(vv.y >> 16);
            vp[4 * AT_VP] = (bf16)(vv.z & 0xffffu); vp[5 * AT_VP] = (bf16)(vv.z >> 16); vp[6 * AT_VP] = (bf16)(vv.w & 0xffffu); vp[7 * AT_VP] = (bf16)(vv.w >> 16);
        }
        for (int i = tid_; i < 768; i += 512) { const int gg = i / 192, dist = i % 192 - 32;
            btab[i] = (dist >= 0 && dist < 128) ? P.rel_bias[c_bucket[dist & 127] * 8 + hkv * 4 + gg] * LOG2E : 0.f; }
        __syncthreads();
        const int g = F.wave & 3, h = hkv * 4 + g;
        const float sink2 = P.sinks[h] * LOG2E;
#pragma unroll 1
        for (int qq = 0; qq < 2; ++qq) {
            const int qt = (F.wave >> 2) * 2 + qq, t = trow0 + 32 * qt + r;
            bf16x8 qf[4];
#pragma unroll
            for (int kk = 0; kk < 4; ++kk) qf[kk] = *(const bf16x8*)(PROJ + (size_t)t * NPROJ + h * 64 + 16 * kk + 8 * hh);
            f32x16 sc[5];
#pragma unroll
            for (int j = 0; j < 5; ++j) {
#pragma unroll
                for (int i = 0; i < 16; ++i) sc[j][i] = 0.f;
#pragma unroll
                for (int kk = 0; kk < 4; ++kk) { const bf16x8 a = *(const LAS bf16x8*)(Ks + (32 * (qt + j) + r) * AT_KP + 16 * kk + 8 * hh); sc[j] = MFMA32(a, qf[kk], sc[j]); }
            }
            float m = sink2;
            const LAS float* bt = btab + g * 192 + 160 + r - 4 * hh;
#pragma unroll
            for (int j = 0; j < 5; ++j) {
                const bool tile_ok = (n > 0) || (qt + j >= 4);
#pragma unroll
                for (int i = 0; i < 16; ++i) { const int dist = 128 + r - (32 * j + crow(i, hh));
                    const bool ok = tile_ok && (j == 0 ? dist < 128 : (j == 4 ? dist >= 0 : true));
                    const float s = sc[j][i] * (0.125f * LOG2E) + bt[-(32 * j + (i & 3) + 8 * (i >> 2))];
                    sc[j][i] = ok ? s : -INFINITY; m = fmaxf(m, sc[j][i]); }
            }
            m = max_halves(m);
            float l = 0.f;
#pragma unroll
            for (int j = 0; j < 5; ++j)
#pragma unroll
                for (int i = 0; i < 16; ++i) { sc[j][i] = exp2f(sc[j][i] - m); l += sc[j][i]; }
            l = sum_halves(l);
            l += exp2f(sink2 - m);
            const float inv = 1.f / l;
            f32x16 o[2];
#pragma unroll
            for (int i = 0; i < 16; ++i) { o[0][i] = 0.f; o[1][i] = 0.f; }
#pragma unroll
            for (int j = 0; j < 5; ++j)
#pragma unroll
                for (int sg = 0; sg < 2; ++sg) {
                    const bf16x8 pf = pack8(sc[j], sg);
#pragma unroll
                    for (int dt = 0; dt < 2; ++dt) {
                        const LAS bf16* vb = Vt + (32 * dt + r) * AT_VP + 32 * (qt + j) + 16 * sg + 4 * hh;
                        const s16x4 lo = *(const LAS s16x4*)(vb), hi = *(const LAS s16x4*)(vb + 8);
                        o[dt] = MFMA32(__builtin_shufflevector(lo, hi, 0, 1, 2, 3, 4, 5, 6, 7), pf, o[dt]);
                    }
                }
            bf16* op = CAT + (size_t)t * DM + h * 64 + 4 * hh;
#pragma unroll
            for (int dt = 0; dt < 2; ++dt)
#pragma unroll
                for (int g4 = 0; g4 < 4; ++g4)
                    *(unsigned long long*)(op + 32 * dt + 8 * g4) = (unsigned long long)cvtpk(o[dt][4 * g4] * inv, o[dt][4 * g4 + 1] * inv) | ((unsigned long long)cvtpk(o[dt][4 * g4 + 2] * inv, o[dt][4 * g4 + 3] * inv) << 32);
        }
        __syncthreads();
    }
}
struct Args { Ptrs p; };
__global__ void __launch_bounds__(NWAVES * 64, 2) hymba_fwd(Args args) {
    extern __shared__ __attribute__((aligned(16))) unsigned char lds[];
    const Ptrs& P = args.p;
    Frame F;
    F.lds = (LAS unsigned char*)lds;
    F.MISC = (volatile LAS unsigned*)(F.lds + MISC_OFF);
    F.wave = __builtin_amdgcn_readfirstlane(threadIdx.x >> 6);
    F.G = gridDim.x; { const int bx = blockIdx.x; F.vcu = (F.G % 8 == 0) ? (bx % 8) * (F.G / 8) + bx / 8 : bx; }
    F.ctl = (gu32*)(P.ws + WS_CTL);
    for (int u = threadIdx.x; u < (LDS_BYTES - LDSCTL_OFF) / 4; u += NWAVES * 64) ((LAS unsigned*)(F.lds + LDSCTL_OFF))[u] = 0u;
    __syncthreads();
    XcdBarrier bar = xcd_barrier_post((unsigned*)(F.ctl + CW_BAR), F.MISC + 8);
#define GRID_BAR() xcd_barrier(bar)

    bf16* XN = (bf16*)(P.ws + WS_XN); bf16* PROJ = (bf16*)(P.ws + WS_PROJ); bf16* HB = (bf16*)(P.ws + WS_ST);
    p0_prologue(F, P);
    GRID_BAR();
    { pg8::Gemm g{XN, (const bf16*)(P.ws + WS_WIN), T_, NPROJ, DM, F.wave}; pg8::StaticOrder S; S.init(T_, NPROJ, F.G, (int)blockIdx.x);
      pg8::EpiBf16<0> E{PROJ, NPROJ, nullptr, 0, 0, 1.f};
      pg8::gemm_phase<pg8::EpiBf16<0>, pg8::StaticOrder, PG8_ALIGN, PG8_SP2>(F.lds + RING_OFF, g, S, E); }
    if (F.G == 256 && blockIdx.x >= 64) quant_fp6u(P, lane_id(), 0, 8192, ((int)blockIdx.x - 64) * NWAVES + F.wave, 192 * NWAVES);
    else if (F.G != 256) quant_fp6u(P, lane_id(), 0, 8192, F.vcu * NWAVES + F.wave, F.G * NWAVES);
    GRID_BAR();
    ssd_s1(F, P);
    attn_phase(F, P);
    GRID_BAR();
    ssd_s2(F, P);
    GRID_BAR();
    ssd_s3(F, P);
    GRID_BAR();
    { pg8::Gemm g{XN, (const bf16*)(P.ws + WS_WOUT), T_, DM, DM, F.wave}; pg8::StaticOrder S; S.init(T_, DM, F.G, (int)blockIdx.x);
      EpiResH E{P.x, HB, (float*)(P.ws + WS_SSQ)};
      pg8::gemm_phase<EpiResH, pg8::StaticOrder, PG8_ALIGN, PG8_SP2>(F.lds + RING_OFF, g, S, E); }
    GRID_BAR();
    { pg8::Gemm g{HB, (const bf16*)(P.ws + WS_WQ), T_, 2048, DM, F.wave}; pg8::StaticOrder S; S.init(T_, 2048, F.G, (int)blockIdx.x);
      pg8::EpiBf16<0> E{PROJ, 2048, nullptr, 0, 0, 1.f};
      pg8::gemm_phase<pg8::EpiBf16<0>, pg8::StaticOrder, PG8_ALIGN, PG8_SP2>(F.lds + RING_OFF, g, S, E); }
    GRID_BAR();
    topk_phase(F, P);
    h_quant_rows(F, P);
    GRID_BAR();
    { const PeerPlace pp = peer_place(F);
      peer_down(F, P, pp); }
    GRID_BAR();
    peer_up_tm(F, P);
}

extern "C" void kernel_launch(void* const* d_in, const int* in_sizes, int n_in, void* d_out, int out_size, void* d_ws, size_t ws_size, hipStream_t stream) {
    static int grid = 0;
    if (grid == 0) {
        if (n_in != 19 || out_size != T_ * DM || ws_size < WS_END) { fprintf(stderr, "kernel_launch: unexpected shapes (n_in %d, out %d, ws %zu)\n", n_in, out_size, ws_size); grid = -1; return; }
        int dev = 0, cus = 0, per_cu = 0;
        if (hipGetDevice(&dev) != hipSuccess || hipDeviceGetAttribute(&cus, hipDeviceAttributeMultiprocessorCount, dev) != hipSuccess) { grid = -1; return; }
        if (hipFuncSetAttribute((const void*)hymba_fwd, hipFuncAttributeMaxDynamicSharedMemorySize, LDS_BYTES) != hipSuccess) { fprintf(stderr, "kernel_launch: hipFuncSetAttribute failed\n"); grid = -1; return; }
        if (hipOccupancyMaxActiveBlocksPerMultiprocessor(&per_cu, (const void*)hymba_fwd, NWAVES * 64, LDS_BYTES) != hipSuccess || per_cu < 1) { fprintf(stderr, "kernel_launch: occupancy query says %d blocks per CU\n", per_cu); grid = -1; (void)hipGetLastError(); return; }
        grid = cus;
    }
    if (grid < 0) return;
    (void)hipMemsetAsync((char*)d_ws + WS_CTL, 0, CTL_ZERO_BYTES, stream);
    Args a{};
    const float** pp = (const float**)&a.p;
    for (int i = 0; i < 19; ++i) pp[i] = (const float*)d_in[i];
    a.p.out = (float*)d_out; a.p.ws = (unsigned char*)d_ws;
    hipLaunchKernelGGL(hymba_fwd, dim3(grid), dim3(NWAVES * 64), LDS_BYTES, stream, a);
}
```

```cpp
#include <hip/hip_runtime.h>
#include <cstdio>
#include <cstdint>
#include <math.h>
namespace pg8 {
#define PG8_LAS __attribute__((address_space(3)))
typedef unsigned short bf16_t;
typedef short bf16x8 __attribute__((ext_vector_type(8)));
typedef float f32x4 __attribute__((ext_vector_type(4)));
typedef unsigned u32x4 __attribute__((ext_vector_type(4)));
constexpr int BM = 256, BK = 64, HALF = 128, HTB = HALF * BK * 2  , STAGE_BYTES = 8 * HTB, NXCD = 8, WGM = 8;

__host__ __device__ __forceinline__ int lds_byte(int r, int c) { const int st = (r >> 4) * 2 + (c >> 5), rr = r & 15, cc = c & 31, ob = rr * 64 + cc * 2; return st * 1024 + (ob ^ (((ob >> 9) & 1) << 5)); }
__host__ __device__ __forceinline__ void stage_rc(int b, int& R, int& C) { const int st = b / 1024, sb = b % 1024, swz = sb ^ (((sb >> 9) & 1) << 5); R = (st >> 1) * 16 + swz / 64; C = (st & 1) * 32 + (swz % 64) / 2; }
__host__ __device__ __forceinline__ int perm32(int rho) { const int n = rho >> 4, i = rho & 15; return 8 * (i >> 2) + 4 * n + (i & 3); }

struct Unit { int pm, pn; };
struct Gemm { const bf16_t* A; const bf16_t* Bt; int M, N, K, wave; };

struct StaticOrder {
    int nM, nN, nwg, G, c;
    __host__ __device__ void init(int M, int N, int G_, int c_) { nM = M / BM; nN = N / BM; nwg = nM * nN; G = G_; c = c_; }
    __host__ __device__ bool next(int i, Unit& u) const {
        const long L = (long)i * G + c; if (L >= nwg) return false;
        int wgid = (int)L; { const int q = nwg / NXCD, r = nwg % NXCD, xcd = wgid % NXCD, off = wgid / NXCD; wgid = (xcd < r ? xcd * (q + 1) : r * (q + 1) + (xcd - r) * q) + off; }
        const int nig = WGM * nN, gid = wgid / nig, fm = gid * WGM, gsz = (nM - fm) < WGM ? (nM - fm) : WGM;
        u.pm = fm + ((wgid % nig) % gsz); u.pn = (wgid % nig) / gsz; return true;
    }
    __device__ __forceinline__ void a_ready(const Unit&) const {}
    __device__ __forceinline__ void done(const Unit&) const {}
};

__device__ __forceinline__ unsigned cvt_pk_bf16(float lo, float hi) { unsigned r; asm volatile("v_cvt_pk_bf16_f32 %0, %1, %2" : "=v"(r) : "v"(lo), "v"(hi)); return r; }
typedef float f32x2 __attribute__((ext_vector_type(2)));
__device__ __forceinline__ f32x2 gelu_pk(f32x2 v) {
    const f32x2 av = __builtin_elementwise_abs(v), d = av * 0.2316418882f + 1.0f;
    f32x2 t; t.x = __builtin_amdgcn_rcpf(d.x); t.y = __builtin_amdgcn_rcpf(d.y);
    f32x2 q = t * 0.5307027145f + (-0.7265760135f); q = q * t + 0.7107068705f; q = q * t + (-0.142248368f); q = q * t + 0.127414796f; q = q * t;
    const f32x2 s = (v * v) * (-0.72134752044f);
    f32x2 e; e.x = __builtin_amdgcn_exp2f(s.x); e.y = __builtin_amdgcn_exp2f(s.y);
    const f32x2 m = v * (q * e), r = v - m;
    f32x2 o; o.x = v.x < 0.f ? m.x : r.x; o.y = v.y < 0.f ? m.y : r.y; return o;
}

template <int ACT  > struct EpiBf16 {
    static constexpr bool PERM = true, AFTER_DRAIN = false; static_assert(ACT == 0 || ACT == 1, "EpiBf16: ACT is 0 (none) or 1 (gelu_pk)");
    bf16_t* O; int ldc; const float* bias; int split_cols; size_t split_stride; float scale0;
    __device__ __forceinline__ void operator()(const f32x4 (&acc)[2][2][4][2], const Unit& u, int wr, int wc, int fr, int fq) const {
        const int row0 = u.pm * BM + wr * 64 + fr; int colt = u.pn * BM; bf16_t* base = O;
        float sc = 1.f; if (split_cols) { const int t = colt / split_cols; base += (size_t)t * split_stride; colt -= t * split_cols; if (t == 0) sc = scale0; }
        const int col0 = colt + wc * 32 + 8 * fq, bcol0 = u.pn * BM + wc * 32 + 8 * fq;
        f32x4 bv[2][2];
#pragma unroll
        for (int bj = 0; bj < 2; ++bj)
#pragma unroll
            for (int n = 0; n < 2; ++n) bv[bj][n] = bias ? *(const f32x4*)(bias + bcol0 + bj * HALF + 4 * n) : (f32x4){0.f, 0.f, 0.f, 0.f};
#pragma unroll
        for (int ai = 0; ai < 2; ++ai)
#pragma unroll
            for (int m = 0; m < 4; ++m) { bf16_t* rowp = base + (size_t)(row0 + ai * HALF + m * 16) * ldc + col0;
#pragma unroll
                for (int bj = 0; bj < 2; ++bj) { f32x4 v0 = acc[ai][bj][m][0] + bv[bj][0], v1 = acc[ai][bj][m][1] + bv[bj][1];
                    if (ACT == 1) { f32x2 a = gelu_pk((f32x2){v0[0], v0[1]}), b = gelu_pk((f32x2){v0[2], v0[3]}), c = gelu_pk((f32x2){v1[0], v1[1]}), d = gelu_pk((f32x2){v1[2], v1[3]});
                        v0 = (f32x4){a.x, a.y, b.x, b.y}; v1 = (f32x4){c.x, c.y, d.x, d.y}; }
                    v0 = v0 * sc; v1 = v1 * sc; u32x4 w; w.x = cvt_pk_bf16(v0[0], v0[1]); w.y = cvt_pk_bf16(v0[2], v0[3]); w.z = cvt_pk_bf16(v1[0], v1[1]); w.w = cvt_pk_bf16(v1[2], v1[3]);
                    *(u32x4*)(rowp + bj * HALF) = w; } }
    }
};
template <class Epi, class Sched, bool ALIGN_EPI = false, bool SP2 = false>
__device__ __forceinline__ void gemm_phase(PG8_LAS unsigned char* lds, const Gemm g, const Sched& S, const Epi& E) {
    int lane_l; asm volatile("v_mbcnt_lo_u32_b32 %0, -1, 0\n\tv_mbcnt_hi_u32_b32 %0, -1, %0" : "=v"(lane_l));
    const int wid = g.wave, lane = lane_l, tid = wid * 64 + lane,
              wr = wid >> 2, wc = wid & 3, fr = lane & 15, fq = lane >> 4;
    const int K = g.K, nt = K / BK;
    unsigned voffA[2], voffB[2];
#pragma unroll
    for (int i = 0; i < 2; ++i) { int R, C; stage_rc(tid * 16 + i * 8192, R, C); const int Rb = Epi::PERM ? ((R & ~31) + perm32(R & 31)) : R;
        voffA[i] = (unsigned)(R * K + C) * 2u; voffB[i] = (unsigned)(Rb * K + C) * 2u; }
    const size_t kstep = (size_t)(BK * 2);
    const size_t hstep = (size_t)HALF * K * 2;
    const size_t tstep = 2 * hstep;
    const unsigned ldsw = (unsigned)wid * 1024u;
    const int aoff = lds_byte(wr * 64 + fr, fq * 8), boff = lds_byte(wc * 32 + fr, fq * 8);
#define PG8_SA(b, h) (((b) * 2 + (h)) * HTB)
#define PG8_SB(b, h) ((4 + (b) * 2 + (h)) * HTB)
#define PG8_STAGE(bufoff, gbase, voff) do { _Pragma("unroll") for (int _i = 0; _i < 2; ++_i) \
        __builtin_amdgcn_global_load_lds((const unsigned*)((const char*)(gbase) + (voff)[_i]), (PG8_LAS unsigned*)(lds + (bufoff) + ldsw + _i * 8192), 16, 0, 0); } while (0)
#define PG8_LDA(dst, b, h) do { _Pragma("unroll") for (int m = 0; m < 4; ++m) _Pragma("unroll") for (int k = 0; k < 2; ++k) dst[m][k] = *(const PG8_LAS bf16x8*)(lds + PG8_SA(b, h) + aoff + m * 2048 + k * 1024); } while (0)
#define PG8_LDB(dst, b, h) do { _Pragma("unroll") for (int n = 0; n < 2; ++n) _Pragma("unroll") for (int k = 0; k < 2; ++k) dst[n][k] = *(const PG8_LAS bf16x8*)(lds + PG8_SB(b, h) + boff + n * 2048 + k * 1024); } while (0)
#define PG8_MMA(ai, bj, At, Bt) do { __builtin_amdgcn_s_setprio(1); _Pragma("unroll") for (int m = 0; m < 4; ++m) _Pragma("unroll") for (int n = 0; n < 2; ++n) _Pragma("unroll") for (int k = 0; k < 2; ++k) \
        acc[ai][bj][m][n] = __builtin_amdgcn_mfma_f32_16x16x32_bf16(Bt[n][k], At[m][k], acc[ai][bj][m][n], 0, 0, 0); __builtin_amdgcn_s_setprio(0); } while (0)
#define PG8_WAIT_V(n) asm volatile("s_waitcnt vmcnt(" #n ")" ::: "memory")
#define PG8_WAIT_L(n) asm volatile("s_waitcnt lgkmcnt(" #n ")" ::: "memory")
#define PG8_BAR __builtin_amdgcn_s_barrier()
#define PG8_SCHED __builtin_amdgcn_sched_barrier(0)
    Unit cur, nxt; int ui = 0;
    if (!S.next(0, cur)) return;
    f32x4 acc[2][2][4][2];
#pragma unroll
    for (int a = 0; a < 2; ++a)
#pragma unroll
        for (int b = 0; b < 2; ++b)
#pragma unroll
            for (int m = 0; m < 4; ++m)
#pragma unroll
                for (int n = 0; n < 2; ++n) acc[a][b][m][n] = (f32x4){0.f, 0.f, 0.f, 0.f};
    bf16x8 At[4][2], B0[2][2], B1[2][2];
    const char* cA = (const char*)g.A + (size_t)cur.pm * tstep; const char* cB = (const char*)g.Bt + (size_t)cur.pn * tstep;
    S.a_ready(cur);
    if constexpr (SP2) {
        PG8_STAGE(PG8_SB(0, 0), cB, voffB); PG8_STAGE(PG8_SB(0, 1), cB + hstep, voffB); PG8_STAGE(PG8_SA(0, 0), cA, voffA); PG8_STAGE(PG8_SA(0, 1), cA + hstep, voffA);
        if (wr == 1) PG8_BAR;
        PG8_WAIT_V(2); PG8_BAR;
        PG8_STAGE(PG8_SB(1, 0), cB + kstep, voffB); PG8_STAGE(PG8_SA(1, 0), cA + kstep, voffA); PG8_STAGE(PG8_SB(1, 1), cB + hstep + kstep, voffB);
        PG8_WAIT_V(6); PG8_BAR;
    } else {
        PG8_STAGE(PG8_SB(0, 0), cB, voffB); PG8_STAGE(PG8_SA(0, 0), cA, voffA); PG8_STAGE(PG8_SB(0, 1), cB + hstep, voffB); PG8_STAGE(PG8_SA(0, 1), cA + hstep, voffA);
        if (wr == 1) PG8_BAR;
        PG8_WAIT_V(4); PG8_BAR;
        PG8_STAGE(PG8_SB(1, 0), cB + kstep, voffB); PG8_STAGE(PG8_SA(1, 0), cA + kstep, voffA); PG8_STAGE(PG8_SB(1, 1), cB + hstep + kstep, voffB);
        PG8_WAIT_V(6); PG8_BAR;
    }
    for (;;) {
        const bool has_next = S.next(ui + 1, nxt);
        const char* nA = has_next ? (const char*)g.A + (size_t)nxt.pm * tstep : cA; const char* nB = has_next ? (const char*)g.Bt + (size_t)nxt.pn * tstep : cB;
        for (int t = 0; t < nt; t += 2) {
            const bool last = (t == nt - 2);
            const char* a1 = cA + (size_t)(t + 1) * kstep;
            const char* a2 = last ? nA : cA + (size_t)(t + 2) * kstep; const char* b2 = last ? nB : cB + (size_t)(t + 2) * kstep;
            const char* a3 = a2 + kstep; const char* b3 = b2 + kstep;
            if (last && has_next) S.a_ready(nxt);
            if constexpr (SP2) {
            PG8_LDB(B0, 0, 0); PG8_LDB(B1, 0, 1); PG8_SCHED; PG8_LDA(At, 0, 0); PG8_STAGE(PG8_SA(1, 1), a1 + hstep, voffA);
            PG8_WAIT_V(8); PG8_WAIT_L(0); PG8_BAR; PG8_MMA(0, 0, At, B0); PG8_MMA(0, 1, At, B1); PG8_BAR; PG8_SCHED;
            PG8_LDA(At, 0, 1); PG8_STAGE(PG8_SB(0, 0), b2, voffB); PG8_STAGE(PG8_SB(0, 1), b2 + hstep, voffB); PG8_STAGE(PG8_SA(0, 0), a2, voffA);
            PG8_WAIT_V(8); PG8_WAIT_L(0); PG8_BAR; PG8_MMA(1, 0, At, B0); PG8_MMA(1, 1, At, B1); PG8_BAR; PG8_SCHED;
            PG8_LDB(B0, 1, 0); PG8_LDB(B1, 1, 1); PG8_SCHED; PG8_LDA(At, 1, 0); PG8_STAGE(PG8_SA(0, 1), a2 + hstep, voffA);
            PG8_WAIT_V(8); PG8_WAIT_L(0); PG8_BAR; PG8_MMA(0, 0, At, B0); PG8_MMA(0, 1, At, B1); PG8_BAR; PG8_SCHED;
            PG8_LDA(At, 1, 1); PG8_STAGE(PG8_SB(1, 0), b3, voffB); PG8_STAGE(PG8_SB(1, 1), b3 + hstep, voffB); PG8_STAGE(PG8_SA(1, 0), a3, voffA);
            PG8_WAIT_V(8); PG8_WAIT_L(0); PG8_BAR; PG8_MMA(1, 0, At, B0); PG8_MMA(1, 1, At, B1); PG8_BAR; PG8_SCHED;
            } else {
            PG8_LDB(B0, 0, 0); PG8_SCHED; PG8_LDA(At, 0, 0); PG8_STAGE(PG8_SA(1, 1), a1 + hstep, voffA);
            PG8_WAIT_L(8); PG8_BAR; PG8_WAIT_L(0); PG8_MMA(0, 0, At, B0); PG8_BAR; PG8_SCHED;
            PG8_LDB(B1, 0, 1); PG8_STAGE(PG8_SB(0, 0), b2, voffB);
            PG8_BAR; PG8_WAIT_L(0); PG8_MMA(0, 1, At, B1); PG8_BAR;
            PG8_LDA(At, 0, 1); PG8_STAGE(PG8_SA(0, 0), a2, voffA);
            PG8_BAR; PG8_WAIT_L(0); PG8_MMA(1, 0, At, B0); PG8_BAR; PG8_SCHED;
            PG8_STAGE(PG8_SB(0, 1), b2 + hstep, voffB);
            PG8_WAIT_V(6); PG8_BAR; PG8_MMA(1, 1, At, B1); PG8_BAR;
            PG8_LDB(B0, 1, 0); PG8_SCHED; PG8_LDA(At, 1, 0); PG8_STAGE(PG8_SA(0, 1), a2 + hstep, voffA);
            PG8_WAIT_L(8); PG8_BAR; PG8_WAIT_L(0); PG8_MMA(0, 0, At, B0); PG8_BAR; PG8_SCHED;
            PG8_LDB(B1, 1, 1); PG8_STAGE(PG8_SB(1, 0), b3, voffB);
            PG8_BAR; PG8_WAIT_L(0); PG8_MMA(0, 1, At, B1); PG8_BAR;
            PG8_LDA(At, 1, 1); PG8_STAGE(PG8_SA(1, 0), a3, voffA);
            PG8_BAR; PG8_WAIT_L(0); PG8_MMA(1, 0, At, B0); PG8_BAR; PG8_SCHED;
            PG8_STAGE(PG8_SB(1, 1), b3 + hstep, voffB);
            PG8_WAIT_V(6); PG8_BAR; PG8_MMA(1, 1, At, B1); PG8_BAR;
            }
        }
        if constexpr (ALIGN_EPI) { if (wr == 0) PG8_BAR; }
        if constexpr (!Epi::AFTER_DRAIN) { E(acc, cur, wr, wc, fr, fq); S.done(cur); }
        if (!has_next) break;
#pragma unroll
        for (int a = 0; a < 2; ++a)
#pragma unroll
            for (int b = 0; b < 2; ++b)
#pragma unroll
                for (int m = 0; m < 4; ++m)
#pragma unroll
                    for (int n = 0; n < 2; ++n) acc[a][b][m][n] = (f32x4){0.f, 0.f, 0.f, 0.f};
        cur = nxt; cA = nA; cB = nB; ++ui;
        if constexpr (ALIGN_EPI) { if (wr == 1) PG8_BAR; }
    }
    PG8_WAIT_V(0);
    if constexpr (!ALIGN_EPI) { if (wr == 0) PG8_BAR; }
    PG8_BAR;
    if constexpr (Epi::AFTER_DRAIN) { E.fused(acc, cur, wr, wc, fr, fq, lds, wid, lane); S.done(cur); }
#undef PG8_SA
#undef PG8_SB
#undef PG8_STAGE
#undef PG8_LDA
#undef PG8_LDB
#undef PG8_MMA
#undef PG8_WAIT_V
#undef PG8_WAIT_L
#undef PG8_BAR
#undef PG8_SCHED
}
}

#ifndef PG8_SP2
#define PG8_SP2 true
#endif
#ifndef PG8_ALIGN
#define PG8_ALIGN true
#endif
#define GAS __attribute__((address_space(1)))
#define LAS __attribute__((address_space(3)))
typedef unsigned short bf16;
typedef unsigned v4u __attribute__((ext_vector_type(4)));
typedef float f32x4 __attribute__((ext_vector_type(4)));
typedef short bf16x8 __attribute__((ext_vector_type(8)));
typedef GAS unsigned gu32;
typedef GAS unsigned long long gu64;
#define RLX_AGENT __ATOMIC_RELAXED, __HIP_MEMORY_SCOPE_AGENT
#define LDS_WAIT() asm volatile("s_waitcnt lgkmcnt(0)" ::: "memory")
#define VM_WAIT() asm volatile("s_waitcnt vmcnt(0)" ::: "memory")
__device__ __forceinline__ unsigned long long rt() { return __builtin_amdgcn_s_memrealtime(); }
__device__ __forceinline__ unsigned f2bf(float f) { unsigned u = __builtin_bit_cast(unsigned, f); return (u + 0x7fffu + ((u >> 16) & 1u)) >> 16; }
__device__ __forceinline__ unsigned pk2(float lo, float hi) { return f2bf(lo) | (f2bf(hi) << 16); }

#define XB_TMO      128
#define XB_XCNT(j)  (256  + 64 * (j))
#define XB_XSUB(j)  (1280 + 64 * (j))
#define XB_XGEN(j)  (2304 + 64 * (j))
#define XB_TOP      3328
#define XB_TOPGEN   3392
#define XCD_BAR_WORDS 3456
#define XB_SPIN_CAP (1u << 22)

__device__ __forceinline__ unsigned xb_ld(unsigned* p)              { return __hip_atomic_load(p, __ATOMIC_RELAXED, __HIP_MEMORY_SCOPE_AGENT); }
__device__ __forceinline__ unsigned xb_add(unsigned* p, unsigned v) { return __hip_atomic_fetch_add(p, v, __ATOMIC_RELAXED, __HIP_MEMORY_SCOPE_AGENT); }
__device__ __forceinline__ unsigned xb_xcc_id() { return (unsigned)__builtin_amdgcn_s_getreg((3 << 11) | 20) & 0xFu; }
#define XB_SPIN(cond, bar) do { unsigned _sp = 0; while (cond) { __builtin_amdgcn_s_sleep(1); \
    if ((++_sp & 255u) == 0u) { if (xb_ld(&(bar)[XB_TMO])) break; if (_sp > XB_SPIN_CAP) { atomicAdd(&(bar)[XB_TMO], 1u); break; } } } } while (0)

struct XcdBarrier {
    unsigned* bar; unsigned x;
    volatile LAS unsigned* st;
};

__device__ __forceinline__ XcdBarrier xcd_barrier_post(unsigned* bar, volatile LAS unsigned* st) {
    XcdBarrier b; b.bar = bar; b.x = xb_xcc_id(); b.st = st;
    if (threadIdx.x == 0) (void)xb_add(&bar[XB_XCNT(b.x)], 1u);
    return b;
}
__device__ __forceinline__ void xcd_barrier_complete(unsigned* bar, unsigned x, unsigned& nloc, unsigned& nx) {
    const unsigned G = gridDim.x * gridDim.y * gridDim.z;
    unsigned sum, cnt, mine, sp = 0u;
    for (;;) {
        sum = 0u; cnt = 0u; mine = 0u;
#pragma unroll
        for (unsigned j = 0; j < 16; ++j) { const unsigned c = xb_ld(&bar[XB_XCNT(j)]); sum += c; cnt += (c > 0u) ? 1u : 0u; mine = (j == x) ? c : mine; }
        if (sum == G) break;
        __builtin_amdgcn_s_sleep(1);
        if ((++sp & 255u) == 0u) { if (xb_ld(&bar[XB_TMO])) break; if (sp > XB_SPIN_CAP) { atomicAdd(&bar[XB_TMO], 1u); break; } }
    }
    nloc = mine > 0u ? mine : 1u; nx = cnt > 0u ? cnt : 1u;
}

__device__ __forceinline__ void xcd_barrier(const XcdBarrier& b) {
    asm volatile("s_waitcnt vmcnt(0)" ::: "memory");
    __syncthreads();
    if (threadIdx.x == 0) {
        unsigned* bar = b.bar;
        __builtin_amdgcn_s_waitcnt(0);
        unsigned nloc = b.st[0], nx = b.st[1];
        if (nloc == 0u) { xcd_barrier_complete(bar, b.x, nloc, nx); b.st[0] = nloc; b.st[1] = nx; }
        const unsigned old = xb_add(&bar[XB_XSUB(b.x)], 1u);
        const unsigned gen = old / nloc;
        if (old + 1u == (gen + 1u) * nloc) {
            __builtin_amdgcn_fence(__ATOMIC_RELEASE, "agent");
            asm volatile("s_waitcnt vmcnt(0)" ::: "memory");
            const unsigned og = xb_add(&bar[XB_TOP], 1u);
            const unsigned tg = og / nx;
            if (og + 1u == (tg + 1u) * nx) xb_add(&bar[XB_TOPGEN], 1u);
            else XB_SPIN(xb_ld(&bar[XB_TOPGEN]) == tg, bar);
            __builtin_amdgcn_fence(__ATOMIC_ACQUIRE, "agent");
            xb_add(&bar[XB_XGEN(b.x)], 1u);
            asm volatile("s_waitcnt vmcnt(0)" ::: "memory");
        } else {
            XB_SPIN(xb_ld(&bar[XB_XGEN(b.x)]) == gen, bar);
            __builtin_amdgcn_fence(__ATOMIC_ACQUIRE, "agent");
            asm volatile("s_waitcnt vmcnt(0)" ::: "memory");
        }
    }
    __syncthreads();
}

constexpr int NWAVES = 8;
constexpr int T_ = 16384, SEQ = 4096, DM = 1024, NPROJ = 2304, INC = 2312;
constexpr int PJ_K = 512, PJ_V = 640, PJ_Z = 768, PJ_XBC = 1280;
constexpr float EPS = 1e-6f;
constexpr size_t MiB = 1u << 20;
constexpr size_t WS_CTL = 0, CTL_ZERO_BYTES = 1 * MiB;
constexpr size_t WS_SMALL = 1 * MiB;
constexpr size_t WS_WIN = 2 * MiB, WS_WOUT = 7 * MiB, WS_WQ = 9 * MiB;
constexpr size_t WS_ED = 13 * MiB, WS_EU = 29 * MiB;
constexpr size_t WS_XN = 77 * MiB;
constexpr size_t WS_PROJ = 109 * MiB;
constexpr size_t WS_ST = 181 * MiB;
constexpr size_t WS_IDX = 213 * MiB, WS_GATE = 221 * MiB, WS_SSQ = 229 * MiB, WS_END = 230 * MiB;
constexpr size_t DO_Y = 0, DO_DT = 41 * MiB;
constexpr size_t WS_CC = 230 * MiB, WS_DT = 238 * MiB, WS_EA = 239 * MiB, WS_CDEC = 240 * MiB, WS_PREV = WS_IDX;
constexpr size_t DO_YPF = 0, DO_YPLAIN = 32 * MiB;
constexpr size_t WS_PART = WS_PROJ;
constexpr size_t WS_H8 = WS_XN, WS_HS = WS_DT;
constexpr size_t WS_SSQ2 = WS_EA;
constexpr int CW_BAR = 4096, CW_RANK = 8192;
constexpr int RING_OFF = 0, RING_BYTES = 131072, LDSCTL_OFF = RING_BYTES, MISC_OFF = LDSCTL_OFF + 320, LDS_BYTES = 147456;

__constant__ unsigned char c_bucket[128] = {0, 1, 2, 3, 4, 5, 6, 7, 8, 9, 10, 11, 12, 13, 14, 15, 16, 16, 16, 17, 17, 18, 18, 18, 19, 19, 19, 20, 20, 20, 20, 21, 21, 21, 21, 22, 22, 22, 22, 22, 23, 23, 23, 23, 23, 23, 24, 24, 24, 24, 24, 24, 25, 25, 25, 25, 25, 25, 25, 26, 26, 26, 26, 26, 26, 26, 26, 27, 27, 27, 27, 27, 27, 27, 27, 27, 27, 28, 28, 28, 28, 28, 28, 28, 28, 28, 28, 29, 29, 29, 29, 29, 29, 29, 29, 29, 29, 29, 29, 30, 30, 30, 30, 30, 30, 30, 30, 30, 30, 30, 30, 30, 30, 31, 31, 31, 31, 31, 31, 31, 31, 31, 31, 31, 31, 31, 31, 31};

typedef float v16f __attribute__((ext_vector_type(16)));
typedef float v32f __attribute__((ext_vector_type(32)));
typedef unsigned v6u __attribute__((ext_vector_type(6)));
typedef _Float16 v32h __attribute__((ext_vector_type(32)));
struct Frame {
    LAS unsigned char* lds;
    volatile LAS unsigned* MISC;
    gu32* ctl;
    int wave, vcu, G;
};
__device__ __forceinline__ int lane_id() { int l; asm volatile("v_mbcnt_lo_u32_b32 %0, -1, 0\n\tv_mbcnt_hi_u32_b32 %0, -1, %0" : "=v"(l)); return l; }
__device__ __forceinline__ int opq(int x) { asm volatile("" : "+v"(x)); return x; }
template <int M> __device__ __forceinline__ float swz_xor(float v) { return __int_as_float(__builtin_amdgcn_ds_swizzle(__float_as_int(v), (M << 10) | 0x1F)); }
__device__ __forceinline__ float sum_halves(float v) { const auto r = __builtin_amdgcn_permlane32_swap(__float_as_uint(v), __float_as_uint(v), false, false); return __uint_as_float(r[0]) + __uint_as_float(r[1]); }
__device__ __forceinline__ float max_halves(float v) { const auto r = __builtin_amdgcn_permlane32_swap(__float_as_uint(v), __float_as_uint(v), false, false); return fmaxf(__uint_as_float(r[0]), __uint_as_float(r[1])); }
__device__ __forceinline__ int imax_halves(int v) { const auto r = __builtin_amdgcn_permlane32_swap((unsigned)v, (unsigned)v, false, false); return max((int)r[0], (int)r[1]); }
__device__ __forceinline__ float wave_sum(float v) {
    v += swz_xor<1>(v); v += swz_xor<2>(v); v += swz_xor<4>(v); v += swz_xor<8>(v); v += swz_xor<16>(v);
    return sum_halves(v);
}
__device__ __forceinline__ float bf2f(unsigned short b) { return __uint_as_float((unsigned)b << 16); }
__device__ __forceinline__ float bflo(unsigned w) { return __uint_as_float(w << 16); }
__device__ __forceinline__ float bfhi(unsigned w) { return __uint_as_float(w & 0xffff0000u); }
__device__ __forceinline__ float silu_f(float x) { return x / (1.f + __expf(-x)); }

__device__ __forceinline__ void p0_transpose_item(const float* W, int ldw, int K, int nblk, bf16* WT, const float* kscale, LAS float* scr, int item, int lane) {
    const int kb = item / nblk, nb = item % nblk, k0 = 64 * kb, n0 = 32 * nb;
#pragma unroll 8
    for (int i = 0; i < 32; ++i) { const int kk = 2 * i + (lane >> 5); float v = W[(size_t)(k0 + kk) * ldw + n0 + (lane & 31)]; if (kscale) v *= kscale[k0 + kk]; scr[kk * 33 + (lane & 31)] = v; }
    LDS_WAIT(); asm volatile("" ::: "memory");
    const int c = lane & 7;
#pragma unroll
    for (int j = 0; j < 4; ++j) { const int n = (lane >> 3) + 8 * j; const LAS float* s = scr + (8 * c) * 33 + n;
        v4u o; o.x = pk2(s[0 * 33], s[1 * 33]); o.y = pk2(s[2 * 33], s[3 * 33]); o.z = pk2(s[4 * 33], s[5 * 33]); o.w = pk2(s[6 * 33], s[7 * 33]);
        *(GAS v4u*)(WT + (size_t)(n0 + n) * K + k0 + 8 * c) = o; }
    LDS_WAIT(); asm volatile("" ::: "memory");
}
struct Ptrs {
    const float *x, *norm_mix, *w_in, *conv_w, *conv_b, *dt_bias, *a_log, *d_skip, *ssd_norm_w, *sinks, *w_out, *rel_bias, *norm_ffn, *w_query, *sk1, *sk2, *e_down, *e_up, *norm_final;
    float* out; unsigned char* ws;
};
constexpr int Q_SPLIT = 16384;
__device__ __forceinline__ unsigned pack4_i8(float a, float b, float c, float d) {
    const int ia = __float2int_rn(a), ib = __float2int_rn(b), ic = __float2int_rn(c), id = __float2int_rn(d);
    return (unsigned)(ia & 0xff) | ((unsigned)(ib & 0xff) << 8) | ((unsigned)(ic & 0xff) << 16) | ((unsigned)(id & 0xff) << 24);
}
__device__ __forceinline__ void quant_fp8s(const Ptrs& P, int lane_, int r_lo, int r_hi, int w, int nw) {
    float* SC = (float*)(P.ws + WS_SMALL);
    for (int row = r_lo + w; row < r_hi; row += nw) {
        const int e = row & 16383;
        const float4* src = (const float4*)(P.e_down + (size_t)e * DM) + 4 * lane_;
        float v[16];
#pragma unroll
        for (int q = 0; q < 4; ++q) { const float4 t = src[q]; const float4 w4 = ((const float4*)P.norm_ffn)[4 * lane_ + q]; v[4 * q] = t.x * w4.x; v[4 * q + 1] = t.y * w4.y; v[4 * q + 2] = t.z * w4.z; v[4 * q + 3] = t.w * w4.w; }
        float am = 0.f;
#pragma unroll
        for (int q = 0; q < 16; ++q) am = fmaxf(am, fabsf(v[q]));
        am = fmaxf(am, swz_xor<1>(am)); am = fmaxf(am, swz_xor<2>(am)); am = fmaxf(am, swz_xor<4>(am)); am = fmaxf(am, swz_xor<8>(am)); am = fmaxf(am, swz_xor<16>(am)); am = max_halves(am);
        am = fmaxf(am, 1e-30f);
        const float inv = 127.f / am;
        v4u o; o.x = pack4_i8(v[0] * inv, v[1] * inv, v[2] * inv, v[3] * inv); o.y = pack4_i8(v[4] * inv, v[5] * inv, v[6] * inv, v[7] * inv);
        o.z = pack4_i8(v[8] * inv, v[9] * inv, v[10] * inv, v[11] * inv); o.w = pack4_i8(v[12] * inv, v[13] * inv, v[14] * inv, v[15] * inv);
        *(v4u*)(P.ws + WS_ED + ((size_t)(lane_ >> 3) * 16384 + e) * 128 + (lane_ & 7) * 16) = o;
        if (lane_ == 0) SC[row] = am * (1.f / 127.f);
    }
}
__device__ __forceinline__ void quant_fp6u(const Ptrs& P, int lane_, int q_lo, int q_hi, int w, int nw) {
    { float* SC = (float*)(P.ws + WS_SMALL); const int l31 = lane_ & 31, hf = lane_ >> 5;
      for (int q = q_lo + w; q < q_hi; q += nw) {
        const int e = 2 * q + hf, row = 16384 + e; const int isup = 1;
        const float4* src = (const float4*)((isup ? P.e_up : P.e_down) + (size_t)e * DM) + 8 * l31;
        float v[32];
#pragma unroll
        for (int k = 0; k < 8; ++k) { const float4 t = src[k]; v[4 * k] = t.x; v[4 * k + 1] = t.y; v[4 * k + 2] = t.z; v[4 * k + 3] = t.w; }
        if (!isup) {
#pragma unroll
            for (int k = 0; k < 8; ++k) { const float4 w = ((const float4*)P.norm_ffn)[8 * l31 + k]; v[4 * k] *= w.x; v[4 * k + 1] *= w.y; v[4 * k + 2] *= w.z; v[4 * k + 3] *= w.w; } }
        float am = 0.f;
#pragma unroll
        for (int k = 0; k < 32; ++k) am = fmaxf(am, fabsf(v[k]));
        am = fmaxf(am, swz_xor<1>(am)); am = fmaxf(am, swz_xor<2>(am)); am = fmaxf(am, swz_xor<4>(am)); am = fmaxf(am, swz_xor<8>(am)); am = fmaxf(am, swz_xor<16>(am));
        am = fmaxf(am, 1e-30f);
        const float inv = 7.5f / am;
        v32h xh;
#pragma unroll
        for (int k = 0; k < 32; ++k) xh[k] = (_Float16)(v[k] * inv);
        const v6u pk = __builtin_amdgcn_cvt_scalef32_pk32_fp6_f16(xh, 1.0f);
        unsigned char* dst = P.ws + WS_EU + (size_t)e * 768;
        *(v4u*)(dst + 16 * l31) = (v4u){pk[0], pk[1], pk[2], pk[3]};
        *(unsigned long long*)(dst + 512 + 8 * l31) = (unsigned long long)pk[4] | ((unsigned long long)pk[5] << 32);
        if (l31 == 0) SC[row] = am * (1.f / 7.5f);
      } }
}
__device__ __forceinline__ void p0_prologue(Frame& F0, const Ptrs& P) {
    const Frame& F = F0; const int lane_ = lane_id(), tid_ = F.wave * 64 + lane_;
    LAS float* scr = (LAS float*)(F.lds + RING_OFF + F.wave * 16384);
    const int gw = F.vcu * NWAVES + F.wave, NGW = F.G * NWAVES;
    bf16* Win_t = (bf16*)(P.ws + WS_WIN); bf16* Wout_t = (bf16*)(P.ws + WS_WOUT); bf16* Wq_t = (bf16*)(P.ws + WS_WQ);
    constexpr int I_IN = 16 * 72, I_OUT = 16 * 32, I_Q = 16 * 64, NITEMS = I_IN + I_OUT + I_Q;
    for (int it = gw; it < NITEMS; it += NGW) {
        int r = it;
        if (r < I_IN) { p0_transpose_item(P.w_in, INC, DM, 72, Win_t, nullptr, scr, r, lane_); continue; } r -= I_IN;
        if (r < I_OUT) { p0_transpose_item(P.w_out, DM, DM, 32, Wout_t, nullptr, scr, r, lane_); continue; } r -= I_OUT;
        p0_transpose_item(P.w_query, 2048, DM, 64, Wq_t, P.norm_ffn, scr, r, lane_);
    }
    quant_fp8s(P, lane_, 0, Q_SPLIT, gw, NGW);
    __syncthreads();
    { LAS float* Wdt = (LAS float*)(F.lds + RING_OFF);
      for (int i = tid_; i < 8192; i += 512) Wdt[i] = P.w_in[(size_t)(i >> 3) * INC + NPROJ + (i & 7)];
      __syncthreads();
      bf16* XN = (bf16*)(P.ws + WS_XN); float* DT = (float*)(P.ws + WS_DT);
      for (int m0 = gw * 2; m0 < T_; m0 += NGW * 2) {
        float4 xv[2][4];
#pragma unroll
        for (int rr = 0; rr < 2; ++rr) { const float4* xr = (const float4*)(P.x + (size_t)(m0 + rr) * DM);
#pragma unroll
            for (int j = 0; j < 4; ++j) xv[rr][j] = xr[j * 64 + lane_]; }
#pragma unroll
        for (int rr = 0; rr < 2; ++rr) { const int m = m0 + rr;
        float4 v[4]; float s = 0.f;
#pragma unroll
        for (int j = 0; j < 4; ++j) { v[j] = xv[rr][j]; s += v[j].x * v[j].x + v[j].y * v[j].y + v[j].z * v[j].z + v[j].w * v[j].w; }
        const float r = rsqrtf(wave_sum(s) * (1.f / 1024.f) + EPS);
        float d8[8];
#pragma unroll
        for (int q = 0; q < 8; ++q) d8[q] = 0.f;
        unsigned long long* o8 = (unsigned long long*)(XN + (size_t)m * DM);
#pragma unroll
        for (int j = 0; j < 4; ++j) { const float4 w = ((const float4*)P.norm_mix)[j * 64 + lane_];
            const float e0 = v[j].x * r * w.x, e1 = v[j].y * r * w.y, e2 = v[j].z * r * w.z, e3 = v[j].w * r * w.w;
            o8[j * 64 + lane_] = (unsigned long long)pk2(e0, e1) | ((unsigned long long)pk2(e2, e3) << 32);
            const float ev[4] = {e0, e1, e2, e3};
#pragma unroll
            for (int e = 0; e < 4; ++e) { const LAS f32x4* wr = (const LAS f32x4*)(Wdt + (size_t)(j * 256 + lane_ * 4 + e) * 8); const f32x4 w0 = wr[0], w1 = wr[1];
                d8[0] += ev[e] * w0.x; d8[1] += ev[e] * w0.y; d8[2] += ev[e] * w0.z; d8[3] += ev[e] * w0.w; d8[4] += ev[e] * w1.x; d8[5] += ev[e] * w1.y; d8[6] += ev[e] * w1.z; d8[7] += ev[e] * w1.w; } }
#pragma unroll
        for (int q = 0; q < 8; ++q) d8[q] = wave_sum(d8[q]);
        if (lane_ == 0) { float4* dp = (float4*)(DT + (size_t)m * 8); dp[0] = make_float4(d8[0], d8[1], d8[2], d8[3]); dp[1] = make_float4(d8[4], d8[5], d8[6], d8[7]); }
        }
      }
      __syncthreads(); }
}

struct EpiResH {
    static constexpr bool PERM = false, AFTER_DRAIN = false;
    const float* X; bf16* HB; float* SSQ;
    __device__ __forceinline__ void operator()(const pg8::f32x4 (&acc)[2][2][4][2], const pg8::Unit& u, int wr, int wc, int fr, int fq) const {
        const int row0 = u.pm * 256 + wr * 64 + fr, col0 = u.pn * 256 + wc * 32 + 4 * fq;
#pragma unroll
        for (int ai = 0; ai < 2; ++ai)
#pragma unroll
            for (int m = 0; m < 4; ++m) { const int row = row0 + ai * 128 + m * 16; float ss = 0.f;
#pragma unroll
                for (int bj = 0; bj < 2; ++bj)
#pragma unroll
                    for (int n = 0; n < 2; ++n) { const size_t off = (size_t)row * DM + col0 + bj * 128 + n * 16;
                        const pg8::f32x4 h = acc[ai][bj][m][n] + *(const pg8::f32x4*)(X + off);
                        ss += h[0] * h[0] + h[1] * h[1] + h[2] * h[2] + h[3] * h[3];
                        *(unsigned long long*)(HB + off) = (unsigned long long)pk2(h[0], h[1]) | ((unsigned long long)pk2(h[2], h[3]) << 32); }
                ss += swz_xor<16>(ss); ss = sum_halves(ss);
                if (fq == 0) SSQ[(size_t)row * 16 + u.pn * 4 + wc] = ss; }
    }
};

typedef float f32x16 __attribute__((ext_vector_type(16)));
typedef short s16x4 __attribute__((ext_vector_type(4)));
typedef float f32x2_t __attribute__((ext_vector_type(2)));
typedef __bf16 bf16x2_t __attribute__((ext_vector_type(2)));
#define MFMA32(a, b, c) __builtin_amdgcn_mfma_f32_32x32x16_bf16((a), (b), (c), 0, 0, 0)
__device__ __forceinline__ int crow(int reg, int h) { return (reg & 3) + 8 * (reg >> 2) + 4 * h; }
__device__ __forceinline__ unsigned cvtpk(float lo, float hi) { f32x2_t v = {lo, hi}; bf16x2_t b = __builtin_convertvector(v, bf16x2_t); return __builtin_bit_cast(unsigned, b); }
__device__ __forceinline__ bf16x8 pack8(const f32x16& x, int s) {
    v4u p; p.x = cvtpk(x[8 * s], x[8 * s + 1]); p.y = cvtpk(x[8 * s + 2], x[8 * s + 3]); p.z = cvtpk(x[8 * s + 4], x[8 * s + 5]); p.w = cvtpk(x[8 * s + 6], x[8 * s + 7]);
    return __builtin_bit_cast(bf16x8, p);
}
constexpr float LOG2E = 1.4426950408889634f;
constexpr int LDP = 136;
constexpr int S1_XT = 0, S1_BSN = 17408, S1_CLN = 52224, S1_BNL = 87040, S1_F32 = 121856;

__device__ __forceinline__ float silu_fast(float x) { return x * __builtin_amdgcn_rcpf(1.f + __builtin_amdgcn_exp2f(-x * LOG2E)); }
__device__ __forceinline__ int swz_t(int row, int l) { return row * LDP + ((((l >> 3) ^ (row >> 3)) & 7) | ((l >> 3) & 8)) * 8 + (l & 7); }
__device__ __forceinline__ void ssd_s1(Frame& F, const Ptrs& P) {
    const bf16* PROJ = (const bf16*)(P.ws + WS_PROJ); const float* DT = (const float*)(P.ws + WS_DT);
    float* EA = (float*)(P.ws + WS_EA); float* CDEC = (float*)(P.ws + WS_CDEC); bf16* CC = (bf16*)(P.ws + WS_CC);
    float* ST = (float*)(P.ws + WS_ST); float* YPF = (float*)((char*)P.out + DO_YPF);
    LAS unsigned char* L = F.lds + RING_OFF;
    LAS bf16* Xt = (LAS bf16*)(L + S1_XT); LAS bf16* Bsn = (LAS bf16*)(L + S1_BSN); LAS bf16* Cln = (LAS bf16*)(L + S1_CLN); LAS bf16* Bnl = (LAS bf16*)(L + S1_BNL);
    LAS float* f32base = (LAS float*)(L + S1_F32);
    const int lane = lane_id(); const int tid_ = F.wave * 64 + lane;
    int ui = 0;
    for (int u = F.vcu; u < 1024; u += F.G, ++ui) {
        if ((ui & 3) == 0) {
            __syncthreads();
            const int us = u + F.wave * F.G;
            if (F.wave < 4 && us < 1024) {
                const int h = us & 7, c = (us >> 3) & 31, b = us >> 8, t0 = b * SEQ + c * 128;
                const float A = -__expf(P.a_log[h]), dtb = P.dt_bias[h];
                const int lane = opq(lane_id());
                LAS float* acum2 = f32base + F.wave * 384; LAS float* wv = acum2 + 128; LAS float* wend = wv + 128;
                const float x0 = DT[(size_t)(t0 + 2 * lane) * 8 + h] + dtb, x1 = DT[(size_t)(t0 + 2 * lane + 1) * 8 + h] + dtb;
                const float dt0 = fmaxf(x0, 0.f) + log1pf(__expf(-fabsf(x0))), dt1 = fmaxf(x1, 0.f) + log1pf(__expf(-fabsf(x1)));
                const float a0 = dt0 * A, a1 = dt1 * A;
                float s = a0 + a1;
#pragma unroll
                for (int o = 1; o < 64; o <<= 1) { const float v = __int_as_float(__builtin_amdgcn_ds_bpermute((lane - o) * 4, __float_as_int(s))); if (lane >= o) s += v; }
                const float ac1 = s, ac0 = s - a1, tot = __uint_as_float(__builtin_amdgcn_readlane(__float_as_uint(s), 63));
                acum2[2 * lane] = ac0 * LOG2E; acum2[2 * lane + 1] = ac1 * LOG2E;
                wv[2 * lane] = log2f(dt0) - ac0 * LOG2E; wv[2 * lane + 1] = log2f(dt1) - ac1 * LOG2E;
                wend[2 * lane] = dt0 * exp2f((tot - ac0) * LOG2E); wend[2 * lane + 1] = dt1 * exp2f((tot - ac1) * LOG2E);
                EA[(size_t)(t0 + 2 * lane) * 8 + h] = exp2f(ac0 * LOG2E); EA[(size_t)(t0 + 2 * lane + 1) * 8 + h] = exp2f(ac1 * LOG2E);
                if (lane == 0) CDEC[us] = exp2f(tot * LOG2E);
            }
            __syncthreads();
        }
        const int h = u & 7, c = (u >> 3) & 31, b = u >> 8, grp = h >> 2, t0 = b * SEQ + c * 128;
        const float Dh = P.d_skip[h];
        const LAS float* acum2 = f32base + (ui & 3) * 384; const LAS float* wv = acum2 + 128; const LAS float* wend = wv + 128;
        const int tidc = opq(tid_);
        if (tidc < 440) {
            const int cg = tidc % 40, sg = tidc / 40, l0 = 12 * sg;
            int chb; if (cg < 8) chb = h * 64 + cg * 8; else if (cg < 24) chb = 512 + grp * 128 + (cg - 8) * 8; else chb = 768 + grp * 128 + (cg - 24) * 8;
            v4u raw[15];
#pragma unroll
            for (int q = 0; q < 15; ++q) { const int ss = c * 128 + l0 - 3 + q;
                raw[q] = (v4u){0u, 0u, 0u, 0u};
                if (ss >= 0 && l0 - 3 + q < 128) raw[q] = *(const v4u*)(PROJ + (size_t)(b * SEQ + ss) * NPROJ + PJ_XBC + chb); }
            float w[4][8], bias[8];
#pragma unroll
            for (int j = 0; j < 4; ++j) { const float4 w0 = *(const float4*)(P.conv_w + j * 1024 + chb), w1 = *(const float4*)(P.conv_w + j * 1024 + chb + 4);
                w[j][0] = w0.x; w[j][1] = w0.y; w[j][2] = w0.z; w[j][3] = w0.w; w[j][4] = w1.x; w[j][5] = w1.y; w[j][6] = w1.z; w[j][7] = w1.w; }
            { const float4 b0 = *(const float4*)(P.conv_b + chb), b1 = *(const float4*)(P.conv_b + chb + 4);
              bias[0] = b0.x; bias[1] = b0.y; bias[2] = b0.z; bias[3] = b0.w; bias[4] = b1.x; bias[5] = b1.y; bias[6] = b1.z; bias[7] = b1.w; }
#pragma unroll
            for (int it = 0; it < 12; it += 2) {
                const int l = l0 + it;
                if (l < 128) {
                    float a[8], a2[8];
#pragma unroll
                    for (int e = 0; e < 8; ++e) { a[e] = bias[e]; a2[e] = bias[e]; }
#pragma unroll
                    for (int j = 0; j < 4; ++j) { const v4u rw = raw[it + j], rx = raw[it + 1 + j];
                        a[0] += w[j][0] * bflo(rw.x); a[1] += w[j][1] * bfhi(rw.x); a[2] += w[j][2] * bflo(rw.y); a[3] += w[j][3] * bfhi(rw.y);
                        a[4] += w[j][4] * bflo(rw.z); a[5] += w[j][5] * bfhi(rw.z); a[6] += w[j][6] * bflo(rw.w); a[7] += w[j][7] * bfhi(rw.w);
                        a2[0] += w[j][0] * bflo(rx.x); a2[1] += w[j][1] * bfhi(rx.x); a2[2] += w[j][2] * bflo(rx.y); a2[3] += w[j][3] * bfhi(rx.y);
                        a2[4] += w[j][4] * bflo(rx.z); a2[5] += w[j][5] * bfhi(rx.z); a2[6] += w[j][6] * bflo(rx.w); a2[7] += w[j][7] * bfhi(rx.w); }
#pragma unroll
                    for (int e = 0; e < 8; ++e) { a[e] = silu_fast(a[e]); a2[e] = silu_fast(a2[e]); }
                    if (cg < 8) {
#pragma unroll
                        for (int e = 0; e < 8; ++e) *(LAS unsigned*)(Xt + swz_t(cg * 8 + e, l)) = cvtpk(a[e], a2[e]);
                    } else {
                        v4u o, o2; o.x = cvtpk(a[0], a[1]); o.y = cvtpk(a[2], a[3]); o.z = cvtpk(a[4], a[5]); o.w = cvtpk(a[6], a[7]);
                        o2.x = cvtpk(a2[0], a2[1]); o2.y = cvtpk(a2[2], a2[3]); o2.z = cvtpk(a2[4], a2[5]); o2.w = cvtpk(a2[6], a2[7]);
                        if (cg < 24) { const int n0 = (cg - 8) * 8; *(LAS v4u*)(Bsn + l * LDP + n0) = o; *(LAS v4u*)(Bsn + (l + 1) * LDP + n0) = o2; const float we = wend[l], we2 = wend[l + 1];
#pragma unroll
                            for (int e = 0; e < 8; ++e) *(LAS unsigned*)(Bnl + swz_t(n0 + e, l)) = cvtpk(a[e] * we, a2[e] * we2);
                        } else { const int n0 = (cg - 24) * 8; *(LAS v4u*)(Cln + l * LDP + n0) = o; *(LAS v4u*)(Cln + (l + 1) * LDP + n0) = o2;
                            if ((h & 3) == 0) { *(v4u*)(CC + (size_t)(t0 + l) * 256 + grp * 128 + n0) = o; *(v4u*)(CC + (size_t)(t0 + l + 1) * 256 + grp * 128 + n0) = o2; } }
                    }
                }
            }
        }
        __syncthreads();
        const int ln3 = opq(lane), r = ln3 & 31, hh = ln3 >> 5;
        if (F.wave < 4) {
            const int pt = F.wave >> 1;
#pragma unroll 1
            for (int q = 0; q < 2; ++q) {
                const int lt = (F.wave & 1) ? (1 + q) : (3 * q);
                f32x16 yacc;
#pragma unroll
                for (int i = 0; i < 16; ++i) yacc[i] = 0.f;
                const float al = acum2[32 * lt + r];
                for (int st = 0; st <= lt; ++st) {
                    f32x16 macc;
#pragma unroll
                    for (int i = 0; i < 16; ++i) macc[i] = 0.f;
#pragma unroll
                    for (int kk = 0; kk < 8; ++kk) {
                        const bf16x8 a = *(const LAS bf16x8*)(Bsn + (32 * st + r) * LDP + 16 * kk + 8 * hh);
                        const bf16x8 bb = *(const LAS bf16x8*)(Cln + (32 * lt + r) * LDP + 16 * kk + 8 * hh);
                        macc = MFMA32(a, bb, macc);
                    }
#pragma unroll
                    for (int i = 0; i < 16; ++i) { const int sl = crow(i, hh);
                        float f = __builtin_amdgcn_exp2f(al + wv[32 * st + sl]);
                        if (st == lt && sl > r) f = 0.f;
                        macc[i] *= f; }
#pragma unroll
                    for (int sg = 0; sg < 2; ++sg) {
                        const bf16x8 bfrag = pack8(macc, sg);
                        const int prow = 32 * pt + r, lb = 32 * st + 16 * sg;
                        const s16x4 lo = *(const LAS s16x4*)(Xt + swz_t(prow, lb) + 4 * hh), hi = *(const LAS s16x4*)(Xt + swz_t(prow, lb + 8) + 4 * hh);
                        const bf16x8 afrag = __builtin_shufflevector(lo, hi, 0, 1, 2, 3, 4, 5, 6, 7);
                        yacc = MFMA32(afrag, bfrag, yacc);
                    }
                }
#pragma unroll
                for (int i = 0; i < 16; ++i) { const int p = 32 * pt + crow(i, hh);
                    const float y = yacc[i] + Dh * bf2f(Xt[swz_t(p, 32 * lt + r)]);
                    YPF[((((size_t)u * 4 + lt) * 2 + pt) * 16 + i) * 64 + ln3] = y; }
            }
        } else {
            const int nt = F.wave - 4;
#pragma unroll 1
            for (int pt = 0; pt < 2; ++pt) {
                f32x16 sacc;
#pragma unroll
                for (int i = 0; i < 16; ++i) sacc[i] = 0.f;
#pragma unroll
                for (int kk = 0; kk < 8; ++kk) {
                    const bf16x8 a = *(const LAS bf16x8*)(Xt + swz_t(32 * pt + r, 16 * kk + 8 * hh));
                    const bf16x8 bb = *(const LAS bf16x8*)(Bnl + swz_t(32 * nt + r, 16 * kk + 8 * hh));
                    sacc = MFMA32(a, bb, sacc);
                }
#pragma unroll
                for (int i = 0; i < 16; ++i) ST[((size_t)u * 64 + 32 * pt + crow(i, hh)) * 128 + 32 * nt + r] = sacc[i];
            }
        }
        __syncthreads();
    }
}
__device__ __forceinline__ void ssd_s2(Frame& F, const Ptrs& P) {
    const float* ST = (const float*)(P.ws + WS_ST); const float* CDEC = (const float*)(P.ws + WS_CDEC); unsigned* PREV = (unsigned*)(P.ws + WS_PREV);
    for (int g = F.vcu * 512 + (F.wave * 64 + lane_id()); g < 131072; g += F.G * 512) {
        const int n2 = g & 63, p = (g >> 6) & 63, h = (g >> 12) & 7, b = g >> 15;
        float2 st[32];
#pragma unroll
        for (int c = 0; c < 32; ++c) st[c] = *(const float2*)(ST + ((size_t)(((b * 32 + c) * 8 + h) * 64 + p)) * 128 + 2 * n2);
        float r0 = 0.f, r1 = 0.f;
#pragma unroll
        for (int c = 0; c < 32; ++c) { const size_t u = (size_t)((b * 32 + c) * 8 + h);
            PREV[((u * 64 + p) * 128 + 2 * n2) >> 1] = pk2(r0, r1);
            const float d = CDEC[u]; r0 = r0 * d + st[c].x; r1 = r1 * d + st[c].y; }
    }
}
__device__ __forceinline__ void ssd_s3(Frame& F, const Ptrs& P) {
    const bf16* CC = (const bf16*)(P.ws + WS_CC); const bf16* PREV = (const bf16*)(P.ws + WS_PREV); const float* EA = (const float*)(P.ws + WS_EA);
    const float* YPF = (const float*)((const char*)P.out + DO_YPF); const bf16* PROJ = (const bf16*)(P.ws + WS_PROJ); bf16* CAT = (bf16*)(P.ws + WS_XN);
    LAS float* red = (LAS float*)(F.lds + RING_OFF);
    const int lane = lane_id(), r = lane & 31, hh = lane >> 5, h = F.wave, grp = h >> 2;
    for (int v = F.vcu; v < 512; v += F.G) {
        const int lt = v & 3, c = (v >> 2) & 31, b = v >> 7;
        const int t = b * SEQ + c * 128 + lt * 32 + r; const size_t u = (size_t)((b * 32 + c) * 8 + h);
        float ypf[2][16]; unsigned long long zz[2][4];
#pragma unroll
        for (int pt = 0; pt < 2; ++pt) {
#pragma unroll
            for (int i = 0; i < 16; ++i) ypf[pt][i] = YPF[((((size_t)u * 4 + lt) * 2 + pt) * 16 + i) * 64 + lane];
#pragma unroll
            for (int g4 = 0; g4 < 4; ++g4) zz[pt][g4] = *(const unsigned long long*)(PROJ + (size_t)t * NPROJ + PJ_Z + h * 64 + 32 * pt + 8 * g4 + 4 * hh); }
        const float ea = EA[(size_t)t * 8 + h];
        f32x16 acc[2];
#pragma unroll
        for (int i = 0; i < 16; ++i) { acc[0][i] = 0.f; acc[1][i] = 0.f; }
#pragma unroll
        for (int kk = 0; kk < 8; ++kk) {
            const bf16x8 bb = *(const bf16x8*)(CC + (size_t)t * 256 + grp * 128 + 16 * kk + 8 * hh);
#pragma unroll
            for (int pt = 0; pt < 2; ++pt) { const bf16x8 a = *(const bf16x8*)(PREV + (u * 64 + 32 * pt + r) * 128 + 16 * kk + 8 * hh); acc[pt] = MFMA32(a, bb, acc[pt]); }
        }
        float ss = 0.f;
#pragma unroll
        for (int pt = 0; pt < 2; ++pt)
#pragma unroll
            for (int g4 = 0; g4 < 4; ++g4) {
                const unsigned z01 = (unsigned)zz[pt][g4], z23 = (unsigned)(zz[pt][g4] >> 32);
                const float zf[4] = {bflo(z01), bfhi(z01), bflo(z23), bfhi(z23)};
#pragma unroll
                for (int e = 0; e < 4; ++e) { const int i = 4 * g4 + e;
                    const float y = acc[pt][i] * ea + ypf[pt][i];
                    const float yg = y * silu_fast(zf[e]); acc[pt][i] = yg; ss = fmaf(yg, yg, ss); }
            }
        ss = sum_halves(ss);
        if (hh == 0) red[h * 32 + r] = ss;
        __syncthreads();
        float tot = 0.f;
#pragma unroll
        for (int w = 0; w < 8; ++w) tot += red[w * 32 + r];
        const float rn = rsqrtf(tot * (1.f / 512.f) + EPS);
#pragma unroll
        for (int pt = 0; pt < 2; ++pt)
#pragma unroll
            for (int g4 = 0; g4 < 4; ++g4) { const int ch = h * 64 + 32 * pt + 8 * g4 + 4 * hh;
                const float4 w = *(const float4*)(P.ssd_norm_w + ch);
                *(unsigned long long*)(CAT + (size_t)t * DM + 512 + ch) = (unsigned long long)cvtpk(acc[pt][4 * g4] * rn * w.x, acc[pt][4 * g4 + 1] * rn * w.y) | ((unsigned long long)cvtpk(acc[pt][4 * g4 + 2] * rn * w.z, acc[pt][4 * g4 + 3] * rn * w.w) << 32); }
        __syncthreads();
    }
}
__device__ __forceinline__ float gelu_erf(float v) { return 0.5f * v * (1.f + erff(v * 0.70710678118654752f)); }
typedef float f32x2v __attribute__((ext_vector_type(2)));
#define CVT8(W, LO) __builtin_amdgcn_cvt_pk_f32_fp8((int)(W), LO)
template <int CTRL> __device__ __forceinline__ float dpp_f(float v) { return __int_as_float(__builtin_amdgcn_update_dpp(0, __float_as_int(v), CTRL, 0xF, 0xF, true)); }
__device__ __forceinline__ float sum8_dpp(float s) { s += dpp_f<0xB1>(s); s += dpp_f<0x4E>(s); s += dpp_f<0x141>(s); return s; }
struct PeerPlace { int vx, nx, rank, nloc; };
__device__ __forceinline__ PeerPlace peer_place(Frame& F) {
    __syncthreads();
    if (F.wave == 0 && lane_id() == 0) {
        unsigned* bar = (unsigned*)(F.ctl + CW_BAR); const unsigned x = xb_xcc_id();
        unsigned vx = 0, nx = 0;
        for (unsigned j = 0; j < 16; ++j) { const unsigned c = xb_ld(&bar[XB_XCNT(j)]); if (c) { if (j < x) ++vx; ++nx; } }
        const unsigned rank = xb_add((unsigned*)(F.ctl + CW_RANK) + 64 * x, 1u);
        F.MISC[10] = vx; F.MISC[11] = nx ? nx : 1u; F.MISC[12] = rank; F.MISC[13] = xb_ld(&bar[XB_XCNT(x)]);
    }
    __syncthreads();
    PeerPlace pp; pp.vx = (int)F.MISC[10]; pp.nx = (int)F.MISC[11]; pp.rank = (int)F.MISC[12]; pp.nloc = (int)F.MISC[13]; if (pp.nloc < 1) pp.nloc = 1;
    return pp;
}
__device__ __forceinline__ void h_quant_rows(Frame& F, const Ptrs& P) {
    const bf16* HB = (const bf16*)(P.ws + WS_ST); unsigned char* H8 = P.ws + WS_H8; float* HS = (float*)(P.ws + WS_HS);
    const int lane = lane_id();
    for (int t = F.vcu * NWAVES + F.wave; t < T_; t += F.G * NWAVES) {
        const v4u a0 = ((const v4u*)(HB + (size_t)t * DM))[2 * lane], a1 = ((const v4u*)(HB + (size_t)t * DM))[2 * lane + 1];
        float hf[16];
        hf[0] = bflo(a0.x); hf[1] = bfhi(a0.x); hf[2] = bflo(a0.y); hf[3] = bfhi(a0.y); hf[4] = bflo(a0.z); hf[5] = bfhi(a0.z); hf[6] = bflo(a0.w); hf[7] = bfhi(a0.w);
        hf[8] = bflo(a1.x); hf[9] = bfhi(a1.x); hf[10] = bflo(a1.y); hf[11] = bfhi(a1.y); hf[12] = bflo(a1.z); hf[13] = bfhi(a1.z); hf[14] = bflo(a1.w); hf[15] = bfhi(a1.w);
        float am = 0.f;
#pragma unroll
        for (int i = 0; i < 16; ++i) am = fmaxf(am, fabsf(hf[i]));
        am = fmaxf(am, dpp_f<0xB1>(am)); am = fmaxf(am, dpp_f<0x4E>(am)); am = fmaxf(am, dpp_f<0x141>(am)); am = fmaxf(am, 1e-30f);
        const float inv = 127.f / am;
        v4u o; o.x = pack4_i8(hf[0] * inv, hf[1] * inv, hf[2] * inv, hf[3] * inv); o.y = pack4_i8(hf[4] * inv, hf[5] * inv, hf[6] * inv, hf[7] * inv);
        o.z = pack4_i8(hf[8] * inv, hf[9] * inv, hf[10] * inv, hf[11] * inv); o.w = pack4_i8(hf[12] * inv, hf[13] * inv, hf[14] * inv, hf[15] * inv);
        ((v4u*)(H8 + (size_t)t * 1024))[lane] = o;
        if ((lane & 7) == 0) HS[(size_t)t * 8 + (lane >> 3)] = am * (1.f / 127.f);
    }
}
constexpr int PX_D = 16;
template <int CTRL> __device__ __forceinline__ int dpp_i(int v) { return __builtin_amdgcn_update_dpp(0, v, CTRL, 0xF, 0xF, true); }
#define PX_ISSUE(BUF, LO, HI) _Pragma("unroll") for (int b_ = 0; b_ < 8; ++b_) { const unsigned off_ = ((unsigned)__builtin_amdgcn_ds_bpermute((16 * (b_ & 3) + ps) * 4, (b_ & 4) ? (HI) : (LO)) << 7) | (unsigned)(dl << 5); \
        BUF[2 * b_] = *(const v4u*)(tab + off_); BUF[2 * b_ + 1] = *(const v4u*)(tab + off_ + 16); }
__device__ __forceinline__ void peer_down_token(const v4u (&cur)[PX_D], const v4u h8a, const v4u h8b, const float hs, float* prow, int dl, int ps) {
    int sm[8];
#pragma unroll
    for (int b = 0; b < 8; ++b) { const v4u q0 = cur[2 * b], q1 = cur[2 * b + 1];
        int acc = __builtin_amdgcn_sdot4((int)q0.x, (int)h8a.x, 0, false); acc = __builtin_amdgcn_sdot4((int)q0.y, (int)h8a.y, acc, false);
        acc = __builtin_amdgcn_sdot4((int)q0.z, (int)h8a.z, acc, false); acc = __builtin_amdgcn_sdot4((int)q0.w, (int)h8a.w, acc, false);
        acc = __builtin_amdgcn_sdot4((int)q1.x, (int)h8b.x, acc, false); acc = __builtin_amdgcn_sdot4((int)q1.y, (int)h8b.y, acc, false);
        acc = __builtin_amdgcn_sdot4((int)q1.z, (int)h8b.z, acc, false); sm[b] = __builtin_amdgcn_sdot4((int)q1.w, (int)h8b.w, acc, false); }
    const bool c1 = (dl & 2) != 0, c0 = (dl & 1) != 0;
    int w4[4], w2[2];
#pragma unroll
    for (int k = 0; k < 4; ++k) { const int keep = c1 ? sm[4 + k] : sm[k], send = c1 ? sm[k] : sm[4 + k]; w4[k] = keep + dpp_i<0x4E>(send); }
#pragma unroll
    for (int k = 0; k < 2; ++k) { const int keep = c0 ? w4[2 + k] : w4[k], send = c0 ? w4[k] : w4[2 + k]; w2[k] = keep + dpp_i<0xB1>(send); }
    prow[32 * dl + ps] = (float)w2[0] * hs; prow[32 * dl + 16 + ps] = (float)w2[1] * hs;
}
__device__ __forceinline__ void peer_down(Frame& F, const Ptrs& P, const PeerPlace& pp) {
    const unsigned char* H8 = P.ws + WS_H8; const unsigned char* HSb = P.ws + WS_HS; const unsigned char* IDXb = P.ws + WS_IDX; unsigned char* PARTb = P.ws + WS_PART;
    const int lane = lane_id(), dl = lane & 3, ps = lane >> 2;
    const int t0 = pp.rank * NWAVES + F.wave, tstep = pp.nloc * NWAVES;
    for (int s = pp.vx; s < 8; s += pp.nx) {
        if (t0 >= T_) continue;
        const unsigned char* tab = P.ws + WS_ED + (size_t)s * 16384 * 128;
        const unsigned hoff = (unsigned)(s * 128 + dl * 32), ioff = (unsigned)lane * 4u;
        v4u bufA[PX_D], bufB[PX_D];
#define PD_CLAMP(T) ((T) < T_ ? (T) : t0)
#define PD_META(HA, HB_, HSC, TT) do { HA = *(const v4u*)(H8 + ((unsigned)(TT) * 1024u + hoff)); HB_ = *(const v4u*)(H8 + ((unsigned)(TT) * 1024u + hoff + 16u)); HSC = *(const float*)(HSb + ((unsigned)(TT) * 32u + (unsigned)s * 4u)); } while (0)
#define PD_IDX(LO, HI, TT) do { LO = *(const int*)(IDXb + ((unsigned)(TT) * 512u + ioff)); HI = *(const int*)(IDXb + ((unsigned)(TT) * 512u + 256u + ioff)); } while (0)
        int nidx_lo, nidx_hi; PD_IDX(nidx_lo, nidx_hi, t0);
        PX_ISSUE(bufA, nidx_lo, nidx_hi);
        PD_IDX(nidx_lo, nidx_hi, PD_CLAMP(t0 + tstep));
        v4u ha0, ha1, hb0, hb1; float sa, sb; PD_META(ha0, ha1, sa, t0);
        for (int t = t0; t < T_; t += 2 * tstep) {
            { const int tn = PD_CLAMP(t + tstep);
              PX_ISSUE(bufB, nidx_lo, nidx_hi); PD_IDX(nidx_lo, nidx_hi, PD_CLAMP(tn + tstep)); PD_META(hb0, hb1, sb, tn);
              __builtin_amdgcn_sched_barrier(0);
              peer_down_token(bufA, ha0, ha1, sa, (float*)(PARTb + ((unsigned)(s * T_ + t) * 512u)), dl, ps);
              __builtin_amdgcn_sched_barrier(0); }
            if (t + tstep >= T_) break;
            { const int tc = t + tstep, tn = PD_CLAMP(tc + tstep);
              PX_ISSUE(bufA, nidx_lo, nidx_hi); PD_IDX(nidx_lo, nidx_hi, PD_CLAMP(tn + tstep)); PD_META(ha0, ha1, sa, tn);
              __builtin_amdgcn_sched_barrier(0);
              peer_down_token(bufB, hb0, hb1, sb, (float*)(PARTb + ((unsigned)(s * T_ + tc) * 512u)), dl, ps);
              __builtin_amdgcn_sched_barrier(0); }
        }
    }
}
__device__ __forceinline__ void peer_act(Frame& F, const Ptrs& P) {
    const int* IDX = (const int*)(P.ws + WS_IDX); float* GATE = (float*)(P.ws + WS_GATE); const float* PART = (const float*)(P.ws + WS_PART); const float* SSQ = (const float*)(P.ws + WS_SSQ);
    const float* SCD = (const float*)(P.ws + WS_SMALL); const float* SCU = SCD + 16384;
    const int lane = lane_id();
    for (int w = F.vcu * NWAVES + F.wave; w < T_ * 2; w += F.G * NWAVES) {
        const int t = w >> 1; const size_t pid = (size_t)w * 64 + lane;
        const float ssq = lane < 16 ? SSQ[(size_t)t * 16 + lane] : 0.f;
        const float rstd = rsqrtf(wave_sum(ssq) * (1.f / 1024.f) + EPS);
        float pre = 0.f;
#pragma unroll
        for (int s = 0; s < 8; ++s) pre += PART[(size_t)s * T_ * 128 + pid];
        const int id = IDX[pid];
        GATE[pid] = gelu_erf(pre * SCD[id] * rstd) * GATE[pid] * SCU[id];
    }
}
constexpr int PE_PD = 8;
struct Row6 { v4u a; unsigned long long b; };
#define PE_ID1(P) __builtin_amdgcn_readlane(((P) & 64) ? idx_hi : idx_lo, (P) & 63)
#define PE_LOAD6(SLOT, TAB, IDA, IDB) do { const int id_ = upper ? (IDB) : (IDA); const unsigned char* rp_ = (TAB) + (size_t)id_ * 768; \
        SLOT.a = *(const v4u*)(rp_ + 16 * l31); SLOT.b = *(const unsigned long long*)(rp_ + 512 + 8 * l31); } while (0)
__device__ __forceinline__ v32f dec6(const Row6& r) { const v6u p = {r.a.x, r.a.y, r.a.z, r.a.w, (unsigned)r.b, (unsigned)(r.b >> 32)}; return __builtin_amdgcn_cvt_scalef32_pk32_f32_fp6(p, 1.0f); }
__device__ __forceinline__ void peer_up_tm(Frame& F, const Ptrs& P) {
    const bf16* HB = (const bf16*)(P.ws + WS_ST); const unsigned char* EU = P.ws + WS_EU;
    const int* IDX = (const int*)(P.ws + WS_IDX); const float* GATE = (const float*)(P.ws + WS_GATE); const float* PART = (const float*)(P.ws + WS_PART);
    const float* SCD = (const float*)(P.ws + WS_SMALL); const float* SCU = SCD + 16384;
    const int lane = lane_id(), l31 = lane & 31; const bool upper = lane >= 32;
    const int t0 = F.vcu * NWAVES + F.wave, tstep = F.G * NWAVES;
    if (t0 >= T_) return;
    int idx_lo = IDX[(size_t)t0 * 128 + lane], idx_hi = IDX[(size_t)t0 * 128 + 64 + lane];
    v4u hq[4];
#pragma unroll
    for (int k = 0; k < 4; ++k) hq[k] = ((const v4u*)(HB + (size_t)t0 * DM))[4 * l31 + k];
    float g_lo = GATE[(size_t)t0 * 128 + lane], g_hi = GATE[(size_t)t0 * 128 + 64 + lane];
    float pre_lo = 0.f, pre_hi = 0.f;
#pragma unroll
    for (int s = 0; s < 8; ++s) { pre_lo += PART[((size_t)s * T_ + t0) * 128 + lane]; pre_hi += PART[((size_t)s * T_ + t0) * 128 + 64 + lane]; }
    float sdu_lo = SCD[idx_lo], sdu_hi = SCD[idx_hi], su_lo = SCU[idx_lo], su_hi = SCU[idx_hi];
    Row6 ra[PE_PD];
#pragma unroll
    for (int j = 0; j < PE_PD; ++j) PE_LOAD6(ra[j], EU, __builtin_amdgcn_readlane(idx_lo, 2 * j), __builtin_amdgcn_readlane(idx_lo, 2 * j + 1));
    for (int t = t0; t < T_; t += tstep) {
        const int tn = (t + tstep < T_) ? t + tstep : t;
        const int nidx_lo = IDX[(size_t)tn * 128 + lane], nidx_hi = IDX[(size_t)tn * 128 + 64 + lane];
        v4u nh[4];
#pragma unroll
        for (int k = 0; k < 4; ++k) nh[k] = ((const v4u*)(HB + (size_t)tn * DM))[4 * l31 + k];
        const float ng_lo = GATE[(size_t)tn * 128 + lane], ng_hi = GATE[(size_t)tn * 128 + 64 + lane];
        float npart_lo[8], npart_hi[8];
#pragma unroll
        for (int s = 0; s < 8; ++s) { npart_lo[s] = PART[((size_t)s * T_ + tn) * 128 + lane]; npart_hi[s] = PART[((size_t)s * T_ + tn) * 128 + 64 + lane]; }
        float hv[32];
#pragma unroll
        for (int k = 0; k < 4; ++k) { hv[8 * k] = bflo(hq[k].x); hv[8 * k + 1] = bfhi(hq[k].x); hv[8 * k + 2] = bflo(hq[k].y); hv[8 * k + 3] = bfhi(hq[k].y); hv[8 * k + 4] = bflo(hq[k].z); hv[8 * k + 5] = bfhi(hq[k].z); hv[8 * k + 6] = bflo(hq[k].w); hv[8 * k + 7] = bfhi(hq[k].w); }
        float ssq = 0.f;
#pragma unroll
        for (int i = 0; i < 32; ++i) ssq = fmaf(hv[i], hv[i], ssq);
        ssq += swz_xor<1>(ssq); ssq += swz_xor<2>(ssq); ssq += swz_xor<4>(ssq); ssq += swz_xor<8>(ssq); ssq += swz_xor<16>(ssq);
        const float rstd = rsqrtf(ssq * (1.f / 1024.f) + EPS);
        const float act_lo = gelu_erf(pre_lo * sdu_lo * rstd) * g_lo * su_lo, act_hi = gelu_erf(pre_hi * sdu_hi * rstd) * g_hi * su_hi;
        float acc[32];
#pragma unroll
        for (int i = 0; i < 32; ++i) acc[i] = 0.f;
#pragma unroll
        for (int g = 0; g < 2; ++g) {
            const float actv = g ? act_hi : act_lo;
#pragma unroll
            for (int j = 0; j < 32; ++j) {
                const int q = 32 * g + j;
                const float aA = __uint_as_float(__builtin_amdgcn_readlane(__float_as_uint(actv), 2 * j)), aB = __uint_as_float(__builtin_amdgcn_readlane(__float_as_uint(actv), 2 * j + 1));
                const float a = upper ? aB : aA;
                { const v32f d = dec6(ra[q % PE_PD]);
#pragma unroll
                  for (int i = 0; i < 32; ++i) acc[i] = fmaf(a, d[i], acc[i]); }
                asm volatile("" : "+v"(acc[0]), "+v"(acc[1]), "+v"(acc[2]), "+v"(acc[3]), "+v"(acc[4]), "+v"(acc[5]), "+v"(acc[6]), "+v"(acc[7]), "+v"(acc[8]), "+v"(acc[9]), "+v"(acc[10]), "+v"(acc[11]), "+v"(acc[12]), "+v"(acc[13]), "+v"(acc[14]), "+v"(acc[15]));
                asm volatile("" : "+v"(acc[16]), "+v"(acc[17]), "+v"(acc[18]), "+v"(acc[19]), "+v"(acc[20]), "+v"(acc[21]), "+v"(acc[22]), "+v"(acc[23]), "+v"(acc[24]), "+v"(acc[25]), "+v"(acc[26]), "+v"(acc[27]), "+v"(acc[28]), "+v"(acc[29]), "+v"(acc[30]), "+v"(acc[31]));
                if (q + PE_PD < 64) PE_LOAD6(ra[q % PE_PD], EU, PE_ID1(2 * (q + PE_PD)), PE_ID1(2 * (q + PE_PD) + 1));
                else PE_LOAD6(ra[q % PE_PD], EU, __builtin_amdgcn_readlane(nidx_lo, 2 * (q + PE_PD - 64)), __builtin_amdgcn_readlane(nidx_lo, 2 * (q + PE_PD - 64) + 1));
                __builtin_amdgcn_sched_barrier(0);
            }
        }
        { float a = 0.f, c = 0.f;
#pragma unroll
          for (int s = 0; s < 8; ++s) { a += npart_lo[s]; c += npart_hi[s]; }
          pre_lo = a; pre_hi = c; }
        sdu_lo = SCD[nidx_lo]; sdu_hi = SCD[nidx_hi]; su_lo = SCU[nidx_lo]; su_hi = SCU[nidx_hi];
        float s2 = 0.f;
#pragma unroll
        for (int i = 0; i < 32; ++i) { acc[i] = sum_halves(acc[i]) + hv[i]; s2 = fmaf(acc[i], acc[i], s2); }
        s2 += swz_xor<1>(s2); s2 += swz_xor<2>(s2); s2 += swz_xor<4>(s2); s2 += swz_xor<8>(s2); s2 += swz_xor<16>(s2);
        const float r2 = rsqrtf(s2 * (1.f / 1024.f) + EPS);
        const float4* wf = (const float4*)(P.norm_final) + 8 * l31 + 4 * (lane >> 5); float4* o = (float4*)(P.out + (size_t)t * DM) + 8 * l31 + 4 * (lane >> 5);
#pragma unroll
        for (int k = 0; k < 4; ++k) { const float4 w = wf[k];
            const float e0 = upper ? acc[16 + 4 * k] : acc[4 * k], e1 = upper ? acc[17 + 4 * k] : acc[4 * k + 1], e2 = upper ? acc[18 + 4 * k] : acc[4 * k + 2], e3 = upper ? acc[19 + 4 * k] : acc[4 * k + 3];
            o[k] = make_float4(e0 * r2 * w.x, e1 * r2 * w.y, e2 * r2 * w.z, e3 * r2 * w.w); }
        idx_lo = nidx_lo; idx_hi = nidx_hi; g_lo = ng_lo; g_hi = ng_hi;
#pragma unroll
        for (int k = 0; k < 4; ++k) hq[k] = nh[k];
    }
}
constexpr int TK_LDK = 136, TK_K2 = 34816, TK_SCR = 69632, TK_SP = 49;
__device__ __forceinline__ int mono_key(float x) { const int b = __float_as_int(x); return b ^ ((b >> 31) & 0x7fffffff); }
__device__ __forceinline__ float unmono(int m) { return __int_as_float(m ^ ((m >> 31) & 0x7fffffff)); }
__device__ __forceinline__ int max3i(int a, int b, int c) { return max(max(a, b), c); }
#define CEX(A, I, J) do { const int hi_ = max(A[I], A[J]), lo_ = min(A[I], A[J]); A[I] = hi_; A[J] = lo_; } while (0)
template <int N, int OFF, int K, int J, int LEN> struct BitonicStep {
    static __device__ __forceinline__ void run(int (&a)[LEN]) {
#pragma unroll
        for (int i = 0; i < N; ++i) { const int l = i ^ J; if (l > i) { if ((i & K) == 0) CEX(a, OFF + i, OFF + l); else CEX(a, OFF + l, OFF + i); } }
        if constexpr (J > 1) BitonicStep<N, OFF, K, (J >> 1), LEN>::run(a);
        else if constexpr (K < N) BitonicStep<N, OFF, (K << 1), K, LEN>::run(a);
    }
};
template <int N, int OFF, int LEN> __device__ __forceinline__ void bitonic_sort_desc(int (&a)[LEN]) { BitonicStep<N, OFF, 2, 1, LEN>::run(a); }
template <int OFF, int LEN> __device__ __forceinline__ void bitonic_merge16_desc(int (&a)[LEN]) { BitonicStep<16, OFF, 16, 8, LEN>::run(a); }
template <int A, int B, int LEN> __device__ __forceinline__ void merge_top16(int (&a)[LEN]) {
#pragma unroll
    for (int i = 0; i < 16; ++i) a[A + i] = max(a[A + i], a[B + 15 - i]);
    bitonic_merge16_desc<A, LEN>(a);
}
template <int LEN> __device__ __forceinline__ void pair_top16(int (&a)[LEN]) {
    int lo[16], up[16];
#pragma unroll
    for (int i = 0; i < 16; ++i) { const auto rr = __builtin_amdgcn_permlane32_swap((unsigned)a[i], (unsigned)a[i], false, false); lo[i] = (int)rr[0]; up[i] = (int)rr[1]; }
#pragma unroll
    for (int i = 0; i < 16; ++i) a[i] = max(lo[i], up[15 - i]);
    bitonic_merge16_desc<0, LEN>(a);
}
__device__ __forceinline__ void topk_phase(Frame& F, const Ptrs& P) {
    const bf16* Q = (const bf16*)(P.ws + WS_PROJ); const float* SSQ = (const float*)(P.ws + WS_SSQ);
    int* IDX = (int*)(P.ws + WS_IDX); float* GATE = (float*)(P.ws + WS_GATE);
    LAS unsigned char* L = F.lds + RING_OFF;
    LAS bf16* K1 = (LAS bf16*)L; LAS bf16* K2 = (LAS bf16*)(L + TK_K2);
    const int tid_ = (F.wave * 64 + lane_id());
    for (int i = tid_; i < 16384; i += 512) { const int n = i >> 7, k = i & 127; K1[n * TK_LDK + k] = (bf16)f2bf(P.sk1[i]); K2[n * TK_LDK + k] = (bf16)f2bf(P.sk2[i]); }
    __syncthreads();
    const int lane = tid_ & 63, r = lane & 31, hh = lane >> 5;
    LAS int* scr = (LAS int*)(L + TK_SCR) + F.wave * (32 * TK_SP) + r * TK_SP;
    for (int wq = F.vcu * NWAVES + F.wave; wq < 2048; wq += F.G * NWAVES) {
        const int t = (wq >> 2) * 32 + r;
        float rstd;
        { const float4* sp = (const float4*)(SSQ + (size_t)t * 16); const float4 a = sp[0], b = sp[1], c = sp[2], d = sp[3];
          rstd = rsqrtf(((a.x + a.y + a.z + a.w) + (b.x + b.y + b.z + b.w) + (c.x + c.y + c.z + c.w) + (d.x + d.y + d.z + d.w)) * (1.f / 1024.f) + EPS); }
#pragma unroll 1
        for (int hq = 0; hq < 2; ++hq) {
            const int hd = (wq & 3) * 2 + hq;
#pragma unroll 1
            for (int half = 0; half < 2; ++half) {
                const LAS bf16* Kh = half ? K2 : K1;
                bf16x8 qf[8];
#pragma unroll
                for (int kk = 0; kk < 8; ++kk) qf[kk] = *(const bf16x8*)(Q + (size_t)t * 2048 + hd * 256 + half * 128 + 16 * kk + 8 * hh);
                int key[64];
#pragma unroll
                for (int nt = 0; nt < 4; ++nt) {
                    f32x16 sc;
#pragma unroll
                    for (int i = 0; i < 16; ++i) sc[i] = 0.f;
#pragma unroll
                    for (int kk = 0; kk < 8; ++kk) { const bf16x8 a = *(const LAS bf16x8*)(Kh + (32 * nt + r) * TK_LDK + 16 * kk + 8 * hh); sc = MFMA32(a, qf[kk], sc); }
#pragma unroll
                    for (int i = 0; i < 16; ++i) key[nt * 16 + i] = (mono_key(sc[i]) & ~127) | (127 - (32 * nt + crow(i, hh)));
                }
                bitonic_sort_desc<16, 0, 64>(key); bitonic_sort_desc<16, 16, 64>(key); bitonic_sort_desc<16, 32, 64>(key); bitonic_sort_desc<16, 48, 64>(key);
                merge_top16<0, 16, 64>(key); merge_top16<32, 48, 64>(key); merge_top16<0, 32, 64>(key);
                pair_top16<64>(key);
                if (hh == 0) {
#pragma unroll
                    for (int i = 0; i < 16; ++i) scr[half * 16 + i] = key[i]; }
            }
            const LAS int* la = scr + hh * 16; const LAS int* lb = scr + (1 - hh) * 16;
            float va[4], vb[16];
#pragma unroll
            for (int i = 0; i < 4; ++i) va[i] = unmono(la[i] & ~127);
#pragma unroll
            for (int j = 0; j < 16; ++j) vb[j] = unmono(lb[j] & ~127);
            int ck[32];
            {
                int q = 0;
#pragma unroll
                for (int i = 0; i < 4; ++i)
#pragma unroll
                    for (int j = i; j < 16; ++j) if ((i + 1) * (j + 1) <= 16) {
                        const int pos = hh ? (j * 16 + i) : (i * 16 + j);
                        int k = (mono_key(va[i] + vb[j]) & ~255) | (255 - pos);
                        if (i == j && hh) k = (int)0x80000000;
                        ck[q++] = k; }
#pragma unroll
                for (int i = 27; i < 32; ++i) ck[i] = (int)0x80000000;
            }
            bitonic_sort_desc<32, 0, 32>(ck);
            pair_top16<32>(ck);
            const float vmax = unmono(ck[0] & ~255) * rstd;
            float ev[8]; int id[8]; float esum = 0.f; const int hm = -hh;
#pragma unroll
            for (int q = 0; q < 8; ++q) { const int wk = ck[q] ^ ((ck[q] ^ ck[8 + q]) & hm); const int pos = 255 - (wk & 255);
                const int n1 = 127 - (scr[pos >> 4] & 127), n2 = 127 - (scr[16 + (pos & 15)] & 127);
                id[q] = n1 * 128 + n2;
                ev[q] = exp2f((unmono(wk & ~255) * rstd - vmax) * LOG2E); esum += ev[q]; }
            esum = sum_halves(esum);
            const float inv = 1.f / esum;
            int4* ip = (int4*)(IDX + ((size_t)t * 8 + hd) * 16 + hh * 8); float4* gp = (float4*)(GATE + ((size_t)t * 8 + hd) * 16 + hh * 8);
            ip[0] = make_int4(id[0], id[1], id[2], id[3]); ip[1] = make_int4(id[4], id[5], id[6], id[7]);
            gp[0] = make_float4(ev[0] * inv, ev[1] * inv, ev[2] * inv, ev[3] * inv); gp[1] = make_float4(ev[4] * inv, ev[5] * inv, ev[6] * inv, ev[7] * inv);
        }
    }
    __syncthreads();
}

constexpr int AT_KP = 72, AT_VP = 264;
constexpr int AT_K = 0, AT_VT = 36864, AT_BT = 36864 + 33792;
__device__ __forceinline__ void attn_phase(Frame& F, const Ptrs& P) {
    const bf16* PROJ = (const bf16*)(P.ws + WS_PROJ); bf16* CAT = (bf16*)(P.ws + WS_XN);
    LAS unsigned char* L = F.lds + RING_OFF;
    LAS bf16* Ks = (LAS bf16*)(L + AT_K); LAS bf16* Vt = (LAS bf16*)(L + AT_VT); LAS float* btab = (LAS float*)(L + AT_BT);
    const int lane = lane_id(), tid_ = F.wave * 64 + lane, r = lane & 31, hh = lane >> 5;
    for (int u = F.vcu; u < 256; u += F.G) {
        const int hkv = u & 1, n = (u >> 1) & 31, b = u >> 6;
        const int trow0 = b * SEQ + n * 128;
        for (int i = tid_; i < 2048; i += 512) {
            const int kj = i >> 3, ch = i & 7; const bool ok = (n > 0) || (kj >= 128);
            v4u kv = {0u, 0u, 0u, 0u}, vv = {0u, 0u, 0u, 0u};
            if (ok) { const bf16* rowp = PROJ + (size_t)(trow0 - 128 + kj) * NPROJ + hkv * 64 + ch * 8; kv = *(const v4u*)(rowp + PJ_K); vv = *(const v4u*)(rowp + PJ_V); }
            *(LAS v4u*)(Ks + kj * AT_KP + ch * 8) = kv;
            LAS bf16* vp = Vt + (ch * 8) * AT_VP + kj;
            vp[0] = (bf16)(vv.x & 0xffffu); vp[AT_VP] = (bf16)(vv.x >> 16); vp[2 * AT_VP] = (bf16)(vv.y & 0xffffu); vp[3 * AT_VP] = (bf16)(vv.y >> 16);
            vp[4 * AT_VP] = (bf16)(vv.z & 0xffffu); vp[5 * AT_VP] = (bf16)(vv.z >> 16); vp[6 * AT_VP] = (bf16)(vv.w & 0xffffu); vp[7 * AT_VP] = (bf16)(vv.w >> 16);
        }
        for (int i = tid_; i < 768; i += 512) { const int gg = i / 192, dist = i % 192 - 32;
            btab[i] = (dist >= 0 && dist < 128) ? P.rel_bias[c_bucket[dist & 127] * 8 + hkv * 4 + gg] * LOG2E : 0.f; }
        __syncthreads();
        const int g = F.wave & 3, h = hkv * 4 + g;
        const float sink2 = P.sinks[h] * LOG2E;
#pragma unroll 1
        for (int qq = 0; qq < 2; ++qq) {
            const int qt = (F.wave >> 2) * 2 + qq, t = trow0 + 32 * qt + r;
            bf16x8 qf[4];
#pragma unroll
            for (int kk = 0; kk < 4; ++kk) qf[kk] = *(const bf16x8*)(PROJ + (size_t)t * NPROJ + h * 64 + 16 * kk + 8 * hh);
            f32x16 sc[5];
#pragma unroll
            for (int j = 0; j < 5; ++j) {
#pragma unroll
                for (int i = 0; i < 16; ++i) sc[j][i] = 0.f;
#pragma unroll
                for (int kk = 0; kk < 4; ++kk) { const bf16x8 a = *(const LAS bf16x8*)(Ks + (32 * (qt + j) + r) * AT_KP + 16 * kk + 8 * hh); sc[j] = MFMA32(a, qf[kk], sc[j]); }
            }
            float m = sink2;
            const LAS float* bt = btab + g * 192 + 160 + r - 4 * hh;
#pragma unroll
            for (int j = 0; j < 5; ++j) {
                const bool tile_ok = (n > 0) || (qt + j >= 4);
#pragma unroll
                for (int i = 0; i < 16; ++i) { const int dist = 128 + r - (32 * j + crow(i, hh));
                    const bool ok = tile_ok && (j == 0 ? dist < 128 : (j == 4 ? dist >= 0 : true));
                    const float s = sc[j][i] * (0.125f * LOG2E) + bt[-(32 * j + (i & 3) + 8 * (i >> 2))];
                    sc[j][i] = ok ? s : -INFINITY; m = fmaxf(m, sc[j][i]); }
            }
            m = max_halves(m);
            float l = 0.f;
#pragma unroll
            for (int j = 0; j < 5; ++j)
#pragma unroll
                for (int i = 0; i < 16; ++i) { sc[j][i] = exp2f(sc[j][i] - m); l += sc[j][i]; }
            l = sum_halves(l);
            l += exp2f(sink2 - m);
            const float inv = 1.f / l;
            f32x16 o[2];
#pragma unroll
            for (int i = 0; i < 16; ++i) { o[0][i] = 0.f; o[1][i] = 0.f; }
#pragma unroll
            for (int j = 0; j < 5; ++j)
#pragma unroll
                for (int sg = 0; sg < 2; ++sg) {
                    const bf16x8 pf = pack8(sc[j], sg);
#pragma unroll
                    for (int dt = 0; dt < 2; ++dt) {
                        const LAS bf16* vb = Vt + (32 * dt + r) * AT_VP + 32 * (qt + j) + 16 * sg + 4 * hh;
                        const s16x4 lo = *(const LAS s16x4*)(vb), hi = *(const LAS s16x4*)(vb + 8);
                        o[dt] = MFMA32(__builtin_shufflevector(lo, hi, 0, 1, 2, 3, 4, 5, 6, 7), pf, o[dt]);
                    }
                }
            bf16* op = CAT + (size_t)t * DM + h * 64 + 4 * hh;
#pragma unroll
            for (int dt = 0; dt < 2; ++dt)
#pragma unroll
                for (int g4 = 0; g4 < 4; ++g4)
                    *(unsigned long long*)(op + 32 * dt + 8 * g4) = (unsigned long long)cvtpk(o[dt][4 * g4] * inv, o[dt][4 * g4 + 1] * inv) | ((unsigned long long)cvtpk(o[dt][4 * g4 + 2] * inv, o[dt][4 * g4 + 3] * inv) << 32);
        }
        __syncthreads();
    }
}
struct Args { Ptrs p; };
__global__ void __launch_bounds__(NWAVES * 64, 2) hymba_fwd(Args args) {
    extern __shared__ __attribute__((aligned(16))) unsigned char lds[];
    const Ptrs& P = args.p;
    Frame F;
    F.lds = (LAS unsigned char*)lds;
    F.MISC = (volatile LAS unsigned*)(F.lds + MISC_OFF);
    F.wave = __builtin_amdgcn_readfirstlane(threadIdx.x >> 6);
    F.G = gridDim.x; { const int bx = blockIdx.x; F.vcu = (F.G % 8 == 0) ? (bx % 8) * (F.G / 8) + bx / 8 : bx; }
    F.ctl = (gu32*)(P.ws + WS_CTL);
    for (int u = threadIdx.x; u < (LDS_BYTES - LDSCTL_OFF) / 4; u += NWAVES * 64) ((LAS unsigned*)(F.lds + LDSCTL_OFF))[u] = 0u;
    __syncthreads();
    XcdBarrier bar = xcd_barrier_post((unsigned*)(F.ctl + CW_BAR), F.MISC + 8);
#define GRID_BAR() xcd_barrier(bar)

    bf16* XN = (bf16*)(P.ws + WS_XN); bf16* PROJ = (bf16*)(P.ws + WS_PROJ); bf16* HB = (bf16*)(P.ws + WS_ST);
    p0_prologue(F, P);
    GRID_BAR();
    { pg8::Gemm g{XN, (const bf16*)(P.ws + WS_WIN), T_, NPROJ, DM, F.wave}; pg8::StaticOrder S; S.init(T_, NPROJ, F.G, (int)blockIdx.x);
      pg8::EpiBf16<0> E{PROJ, NPROJ, nullptr, 0, 0, 1.f};
      pg8::gemm_phase<pg8::EpiBf16<0>, pg8::StaticOrder, PG8_ALIGN, PG8_SP2>(F.lds + RING_OFF, g, S, E); }
    if (F.G == 256 && blockIdx.x >= 64) quant_fp6u(P, lane_id(), 0, 8192, ((int)blockIdx.x - 64) * NWAVES + F.wave, 192 * NWAVES);
    else if (F.G != 256) quant_fp6u(P, lane_id(), 0, 8192, F.vcu * NWAVES + F.wave, F.G * NWAVES);
    GRID_BAR();
    ssd_s1(F, P);
    attn_phase(F, P);
    GRID_BAR();
    ssd_s2(F, P);
    GRID_BAR();
    ssd_s3(F, P);
    GRID_BAR();
    { pg8::Gemm g{XN, (const bf16*)(P.ws + WS_WOUT), T_, DM, DM, F.wave}; pg8::StaticOrder S; S.init(T_, DM, F.G, (int)blockIdx.x);
      EpiResH E{P.x, HB, (float*)(P.ws + WS_SSQ)};
      pg8::gemm_phase<EpiResH, pg8::StaticOrder, PG8_ALIGN, PG8_SP2>(F.lds + RING_OFF, g, S, E); }
    GRID_BAR();
    { pg8::Gemm g{HB, (const bf16*)(P.ws + WS_WQ), T_, 2048, DM, F.wave}; pg8::StaticOrder S; S.init(T_, 2048, F.G, (int)blockIdx.x);
      pg8::EpiBf16<0> E{PROJ, 2048, nullptr, 0, 0, 1.f};
      pg8::gemm_phase<pg8::EpiBf16<0>, pg8::StaticOrder, PG8_ALIGN, PG8_SP2>(F.lds + RING_OFF, g, S, E); }
    GRID_BAR();
    topk_phase(F, P);
    h_quant_rows(F, P);
    GRID_BAR();
    { const PeerPlace pp = peer_place(F);
      peer_down(F, P, pp); }
    GRID_BAR();
    peer_up_tm(F, P);
}

extern "C" void kernel_launch(void* const* d_in, const int* in_sizes, int n_in, void* d_out, int out_size, void* d_ws, size_t ws_size, hipStream_t stream) {
    static int grid = 0;
    if (grid == 0) {
        if (n_in != 19 || out_size != T_ * DM || ws_size < WS_END) { fprintf(stderr, "kernel_launch: unexpected shapes (n_in %d, out %d, ws %zu)\n", n_in, out_size, ws_size); grid = -1; return; }
        int dev = 0, cus = 0, per_cu = 0;
        if (hipGetDevice(&dev) != hipSuccess || hipDeviceGetAttribute(&cus, hipDeviceAttributeMultiprocessorCount, dev) != hipSuccess) { grid = -1; return; }
        if (hipFuncSetAttribute((const void*)hymba_fwd, hipFuncAttributeMaxDynamicSharedMemorySize, LDS_BYTES) != hipSuccess) { fprintf(stderr, "kernel_launch: hipFuncSetAttribute failed\n"); grid = -1; return; }
        if (hipOccupancyMaxActiveBlocksPerMultiprocessor(&per_cu, (const void*)hymba_fwd, NWAVES * 64, LDS_BYTES) != hipSuccess || per_cu < 1) { fprintf(stderr, "kernel_launch: occupancy query says %d blocks per CU\n", per_cu); grid = -1; (void)hipGetLastError(); return; }
        grid = cus;
    }
    if (grid < 0) return;
    (void)hipMemsetAsync((char*)d_ws + WS_CTL, 0, CTL_ZERO_BYTES, stream);
    Args a{};
    const float** pp = (const float**)&a.p;
    for (int i = 0; i < 19; ++i) pp[i] = (const float*)d_in[i];
    a.p.out = (float*)d_out; a.p.ws = (unsigned char*)d_ws;
    hipLaunchKernelGGL(hymba_fwd, dim3(grid), dim3(NWAVES * 64), LDS_BYTES, stream, a);
}
```

```cpp
#include <hip/hip_runtime.h>
#include <cstdio>
#include <cstdint>
#include <math.h>
namespace pg8 {
#define PG8_LAS __attribute__((address_space(3)))
typedef unsigned short bf16_t;
typedef short bf16x8 __attribute__((ext_vector_type(8)));
typedef float f32x4 __attribute__((ext_vector_type(4)));
typedef unsigned u32x4 __attribute__((ext_vector_type(4)));
constexpr int BM = 256, BK = 64, HALF = 128, HTB = HALF * BK * 2  , STAGE_BYTES = 8 * HTB, NXCD = 8, WGM = 8;

__host__ __device__ __forceinline__ int lds_byte(int r, int c) { const int st = (r >> 4) * 2 + (c >> 5), rr = r & 15, cc = c & 31, ob = rr * 64 + cc * 2; return st * 1024 + (ob ^ (((ob >> 9) & 1) << 5)); }
__host__ __device__ __forceinline__ void stage_rc(int b, int& R, int& C) { const int st = b / 1024, sb = b % 1024, swz = sb ^ (((sb >> 9) & 1) << 5); R = (st >> 1) * 16 + swz / 64; C = (st & 1) * 32 + (swz % 64) / 2; }
__host__ __device__ __forceinline__ int perm32(int rho) { const int n = rho >> 4, i = rho & 15; return 8 * (i >> 2) + 4 * n + (i & 3); }

struct Unit { int pm, pn; };
struct Gemm { const bf16_t* A; const bf16_t* Bt; int M, N, K, wave; };

struct StaticOrder {
    int nM, nN, nwg, G, c;
    __host__ __device__ void init(int M, int N, int G_, int c_) { nM = M / BM; nN = N / BM; nwg = nM * nN; G = G_; c = c_; }
    __host__ __device__ bool next(int i, Unit& u) const {
        const long L = (long)i * G + c; if (L >= nwg) return false;
        int wgid = (int)L; { const int q = nwg / NXCD, r = nwg % NXCD, xcd = wgid % NXCD, off = wgid / NXCD; wgid = (xcd < r ? xcd * (q + 1) : r * (q + 1) + (xcd - r) * q) + off; }
        const int nig = WGM * nN, gid = wgid / nig, fm = gid * WGM, gsz = (nM - fm) < WGM ? (nM - fm) : WGM;
        u.pm = fm + ((wgid % nig) % gsz); u.pn = (wgid % nig) / gsz; return true;
    }
    __device__ __forceinline__ void a_ready(const Unit&) const {}
    __device__ __forceinline__ void done(const Unit&) const {}
};

__device__ __forceinline__ unsigned cvt_pk_bf16(float lo, float hi) { unsigned r; asm volatile("v_cvt_pk_bf16_f32 %0, %1, %2" : "=v"(r) : "v"(lo), "v"(hi)); return r; }
typedef float f32x2 __attribute__((ext_vector_type(2)));
__device__ __forceinline__ f32x2 gelu_pk(f32x2 v) {
    const f32x2 av = __builtin_elementwise_abs(v), d = av * 0.2316418882f + 1.0f;
    f32x2 t; t.x = __builtin_amdgcn_rcpf(d.x); t.y = __builtin_amdgcn_rcpf(d.y);
    f32x2 q = t * 0.5307027145f + (-0.7265760135f); q = q * t + 0.7107068705f; q = q * t + (-0.142248368f); q = q * t + 0.127414796f; q = q * t;
    const f32x2 s = (v * v) * (-0.72134752044f);
    f32x2 e; e.x = __builtin_amdgcn_exp2f(s.x); e.y = __builtin_amdgcn_exp2f(s.y);
    const f32x2 m = v * (q * e), r = v - m;
    f32x2 o; o.x = v.x < 0.f ? m.x : r.x; o.y = v.y < 0.f ? m.y : r.y; return o;
}

template <int ACT  > struct EpiBf16 {
    static constexpr bool PERM = true, AFTER_DRAIN = false; static_assert(ACT == 0 || ACT == 1, "EpiBf16: ACT is 0 (none) or 1 (gelu_pk)");
    bf16_t* O; int ldc; const float* bias; int split_cols; size_t split_stride; float scale0;
    __device__ __forceinline__ void operator()(const f32x4 (&acc)[2][2][4][2], const Unit& u, int wr, int wc, int fr, int fq) const {
        const int row0 = u.pm * BM + wr * 64 + fr; int colt = u.pn * BM; bf16_t* base = O;
        float sc = 1.f; if (split_cols) { const int t = colt / split_cols; base += (size_t)t * split_stride; colt -= t * split_cols; if (t == 0) sc = scale0; }
        const int col0 = colt + wc * 32 + 8 * fq, bcol0 = u.pn * BM + wc * 32 + 8 * fq;
        f32x4 bv[2][2];
#pragma unroll
        for (int bj = 0; bj < 2; ++bj)
#pragma unroll
            for (int n = 0; n < 2; ++n) bv[bj][n] = bias ? *(const f32x4*)(bias + bcol0 + bj * HALF + 4 * n) : (f32x4){0.f, 0.f, 0.f, 0.f};
#pragma unroll
        for (int ai = 0; ai < 2; ++ai)
#pragma unroll
            for (int m = 0; m < 4; ++m) { bf16_t* rowp = base + (size_t)(row0 + ai * HALF + m * 16) * ldc + col0;
#pragma unroll
                for (int bj = 0; bj < 2; ++bj) { f32x4 v0 = acc[ai][bj][m][0] + bv[bj][0], v1 = acc[ai][bj][m][1] + bv[bj][1];
                    if (ACT == 1) { f32x2 a = gelu_pk((f32x2){v0[0], v0[1]}), b = gelu_pk((f32x2){v0[2], v0[3]}), c = gelu_pk((f32x2){v1[0], v1[1]}), d = gelu_pk((f32x2){v1[2], v1[3]});
                        v0 = (f32x4){a.x, a.y, b.x, b.y}; v1 = (f32x4){c.x, c.y, d.x, d.y}; }
                    v0 = v0 * sc; v1 = v1 * sc; u32x4 w; w.x = cvt_pk_bf16(v0[0], v0[1]); w.y = cvt_pk_bf16(v0[2], v0[3]); w.z = cvt_pk_bf16(v1[0], v1[1]); w.w = cvt_pk_bf16(v1[2], v1[3]);
                    *(u32x4*)(rowp + bj * HALF) = w; } }
    }
};
template <class Epi, class Sched, bool ALIGN_EPI = false, bool SP2 = false>
__device__ __forceinline__ void gemm_phase(PG8_LAS unsigned char* lds, const Gemm g, const Sched& S, const Epi& E) {
    int lane_l; asm volatile("v_mbcnt_lo_u32_b32 %0, -1, 0\n\tv_mbcnt_hi_u32_b32 %0, -1, %0" : "=v"(lane_l));
    const int wid = g.wave, lane = lane_l, tid = wid * 64 + lane,
              wr = wid >> 2, wc = wid & 3, fr = lane & 15, fq = lane >> 4;
    const int K = g.K, nt = K / BK;
    unsigned voffA[2], voffB[2];
#pragma unroll
    for (int i = 0; i < 2; ++i) { int R, C; stage_rc(tid * 16 + i * 8192, R, C); const int Rb = Epi::PERM ? ((R & ~31) + perm32(R & 31)) : R;
        voffA[i] = (unsigned)(R * K + C) * 2u; voffB[i] = (unsigned)(Rb * K + C) * 2u; }
    const size_t kstep = (size_t)(BK * 2);
    const size_t hstep = (size_t)HALF * K * 2;
    const size_t tstep = 2 * hstep;
    const unsigned ldsw = (unsigned)wid * 1024u;
    const int aoff = lds_byte(wr * 64 + fr, fq * 8), boff = lds_byte(wc * 32 + fr, fq * 8);
#define PG8_SA(b, h) (((b) * 2 + (h)) * HTB)
#define PG8_SB(b, h) ((4 + (b) * 2 + (h)) * HTB)
#define PG8_STAGE(bufoff, gbase, voff) do { _Pragma("unroll") for (int _i = 0; _i < 2; ++_i) \
        __builtin_amdgcn_global_load_lds((const unsigned*)((const char*)(gbase) + (voff)[_i]), (PG8_LAS unsigned*)(lds + (bufoff) + ldsw + _i * 8192), 16, 0, 0); } while (0)
#define PG8_LDA(dst, b, h) do { _Pragma("unroll") for (int m = 0; m < 4; ++m) _Pragma("unroll") for (int k = 0; k < 2; ++k) dst[m][k] = *(const PG8_LAS bf16x8*)(lds + PG8_SA(b, h) + aoff + m * 2048 + k * 1024); } while (0)
#define PG8_LDB(dst, b, h) do { _Pragma("unroll") for (int n = 0; n < 2; ++n) _Pragma("unroll") for (int k = 0; k < 2; ++k) dst[n][k] = *(const PG8_LAS bf16x8*)(lds + PG8_SB(b, h) + boff + n * 2048 + k * 1024); } while (0)
#define PG8_MMA(ai, bj, At, Bt) do { __builtin_amdgcn_s_setprio(1); _Pragma("unroll") for (int m = 0; m < 4; ++m) _Pragma("unroll") for (int n = 0; n < 2; ++n) _Pragma("unroll") for (int k = 0; k < 2; ++k) \
        acc[ai][bj][m][n] = __builtin_amdgcn_mfma_f32_16x16x32_bf16(Bt[n][k], At[m][k], acc[ai][bj][m][n], 0, 0, 0); __builtin_amdgcn_s_setprio(0); } while (0)
#define PG8_WAIT_V(n) asm volatile("s_waitcnt vmcnt(" #n ")" ::: "memory")
#define PG8_WAIT_L(n) asm volatile("s_waitcnt lgkmcnt(" #n ")" ::: "memory")
#define PG8_BAR __builtin_amdgcn_s_barrier()
#define PG8_SCHED __builtin_amdgcn_sched_barrier(0)
    Unit cur, nxt; int ui = 0;
    if (!S.next(0, cur)) return;
    f32x4 acc[2][2][4][2];
#pragma unroll
    for (int a = 0; a < 2; ++a)
#pragma unroll
        for (int b = 0; b < 2; ++b)
#pragma unroll
            for (int m = 0; m < 4; ++m)
#pragma unroll
                for (int n = 0; n < 2; ++n) acc[a][b][m][n] = (f32x4){0.f, 0.f, 0.f, 0.f};
    bf16x8 At[4][2], B0[2][2], B1[2][2];
    const char* cA = (const char*)g.A + (size_t)cur.pm * tstep; const char* cB = (const char*)g.Bt + (size_t)cur.pn * tstep;
    S.a_ready(cur);
    if constexpr (SP2) {
        PG8_STAGE(PG8_SB(0, 0), cB, voffB); PG8_STAGE(PG8_SB(0, 1), cB + hstep, voffB); PG8_STAGE(PG8_SA(0, 0), cA, voffA); PG8_STAGE(PG8_SA(0, 1), cA + hstep, voffA);
        if (wr == 1) PG8_BAR;
        PG8_WAIT_V(2); PG8_BAR;
        PG8_STAGE(PG8_SB(1, 0), cB + kstep, voffB); PG8_STAGE(PG8_SA(1, 0), cA + kstep, voffA); PG8_STAGE(PG8_SB(1, 1), cB + hstep + kstep, voffB);
        PG8_WAIT_V(6); PG8_BAR;
    } else {
        PG8_STAGE(PG8_SB(0, 0), cB, voffB); PG8_STAGE(PG8_SA(0, 0), cA, voffA); PG8_STAGE(PG8_SB(0, 1), cB + hstep, voffB); PG8_STAGE(PG8_SA(0, 1), cA + hstep, voffA);
        if (wr == 1) PG8_BAR;
        PG8_WAIT_V(4); PG8_BAR;
        PG8_STAGE(PG8_SB(1, 0), cB + kstep, voffB); PG8_STAGE(PG8_SA(1, 0), cA + kstep, voffA); PG8_STAGE(PG8_SB(1, 1), cB + hstep + kstep, voffB);
        PG8_WAIT_V(6); PG8_BAR;
    }
    for (;;) {
        const bool has_next = S.next(ui + 1, nxt);
        const char* nA = has_next ? (const char*)g.A + (size_t)nxt.pm * tstep : cA; const char* nB = has_next ? (const char*)g.Bt + (size_t)nxt.pn * tstep : cB;
        for (int t = 0; t < nt; t += 2) {
            const bool last = (t == nt - 2);
            const char* a1 = cA + (size_t)(t + 1) * kstep;
            const char* a2 = last ? nA : cA + (size_t)(t + 2) * kstep; const char* b2 = last ? nB : cB + (size_t)(t + 2) * kstep;
            const char* a3 = a2 + kstep; const char* b3 = b2 + kstep;
            if (last && has_next) S.a_ready(nxt);
            if constexpr (SP2) {
            PG8_LDB(B0, 0, 0); PG8_LDB(B1, 0, 1); PG8_SCHED; PG8_LDA(At, 0, 0); PG8_STAGE(PG8_SA(1, 1), a1 + hstep, voffA);
            PG8_WAIT_V(8); PG8_WAIT_L(0); PG8_BAR; PG8_MMA(0, 0, At, B0); PG8_MMA(0, 1, At, B1); PG8_BAR; PG8_SCHED;
            PG8_LDA(At, 0, 1); PG8_STAGE(PG8_SB(0, 0), b2, voffB); PG8_STAGE(PG8_SB(0, 1), b2 + hstep, voffB); PG8_STAGE(PG8_SA(0, 0), a2, voffA);
            PG8_WAIT_V(8); PG8_WAIT_L(0); PG8_BAR; PG8_MMA(1, 0, At, B0); PG8_MMA(1, 1, At, B1); PG8_BAR; PG8_SCHED;
            PG8_LDB(B0, 1, 0); PG8_LDB(B1, 1, 1); PG8_SCHED; PG8_LDA(At, 1, 0); PG8_STAGE(PG8_SA(0, 1), a2 + hstep, voffA);
            PG8_WAIT_V(8); PG8_WAIT_L(0); PG8_BAR; PG8_MMA(0, 0, At, B0); PG8_MMA(0, 1, At, B1); PG8_BAR; PG8_SCHED;
            PG8_LDA(At, 1, 1); PG8_STAGE(PG8_SB(1, 0), b3, voffB); PG8_STAGE(PG8_SB(1, 1), b3 + hstep, voffB); PG8_STAGE(PG8_SA(1, 0), a3, voffA);
            PG8_WAIT_V(8); PG8_WAIT_L(0); PG8_BAR; PG8_MMA(1, 0, At, B0); PG8_MMA(1, 1, At, B1); PG8_BAR; PG8_SCHED;
            } else {
            PG8_LDB(B0, 0, 0); PG8_SCHED; PG8_LDA(At, 0, 0); PG8_STAGE(PG8_SA(1, 1), a1 + hstep, voffA);
            PG8_WAIT_L(8); PG8_BAR; PG8_WAIT_L(0); PG8_MMA(0, 0, At, B0); PG8_BAR; PG8_SCHED;
            PG8_LDB(B1, 0, 1); PG8_STAGE(PG8_SB(0, 0), b2, voffB);
            PG8_BAR; PG8_WAIT_L(0); PG8_MMA(0, 1, At, B1); PG8_BAR;
            PG8_LDA(At, 0, 1); PG8_STAGE(PG8_SA(0, 0), a2, voffA);
            PG8_BAR; PG8_WAIT_L(0); PG8_MMA(1, 0, At, B0); PG8_BAR; PG8_SCHED;
            PG8_STAGE(PG8_SB(0, 1), b2 + hstep, voffB);
            PG8_WAIT_V(6); PG8_BAR; PG8_MMA(1, 1, At, B1); PG8_BAR;
            PG8_LDB(B0, 1, 0); PG8_SCHED; PG8_LDA(At, 1, 0); PG8_STAGE(PG8_SA(0, 1), a2 + hstep, voffA);
            PG8_WAIT_L(8); PG8_BAR; PG8_WAIT_L(0); PG8_MMA(0, 0, At, B0); PG8_BAR; PG8_SCHED;
            PG8_LDB(B1, 1, 1); PG8_STAGE(PG8_SB(1, 0), b3, voffB);
            PG8_BAR; PG8_WAIT_L(0); PG8_MMA(0, 1, At, B1); PG8_BAR;
            PG8_LDA(At, 1, 1); PG8_STAGE(PG8_SA(1, 0), a3, voffA);
            PG8_BAR; PG8_WAIT_L(0); PG8_MMA(1, 0, At, B0); PG8_BAR; PG8_SCHED;
            PG8_STAGE(PG8_SB(1, 1), b3 + hstep, voffB);
            PG8_WAIT_V(6); PG8_BAR; PG8_MMA(1, 1, At, B1); PG8_BAR;
            }
        }
        if constexpr (ALIGN_EPI) { if (wr == 0) PG8_BAR; }
        if constexpr (!Epi::AFTER_DRAIN) { E(acc, cur, wr, wc, fr, fq); S.done(cur); }
        if (!has_next) break;
#pragma unroll
        for (int a = 0; a < 2; ++a)
#pragma unroll
            for (int b = 0; b < 2; ++b)
#pragma unroll
                for (int m = 0; m < 4; ++m)
#pragma unroll
                    for (int n = 0; n < 2; ++n) acc[a][b][m][n] = (f32x4){0.f, 0.f, 0.f, 0.f};
        cur = nxt; cA = nA; cB = nB; ++ui;
        if constexpr (ALIGN_EPI) { if (wr == 1) PG8_BAR; }
    }
    PG8_WAIT_V(0);
    if constexpr (!ALIGN_EPI) { if (wr == 0) PG8_BAR; }
    PG8_BAR;
    if constexpr (Epi::AFTER_DRAIN) { E.fused(acc, cur, wr, wc, fr, fq, lds, wid, lane); S.done(cur); }
#undef PG8_SA
#undef PG8_SB
#undef PG8_STAGE
#undef PG8_LDA
#undef PG8_LDB
#undef PG8_MMA
#undef PG8_WAIT_V
#undef PG8_WAIT_L
#undef PG8_BAR
#undef PG8_SCHED
}
}

#ifndef PG8_SP2
#define PG8_SP2 true
#endif
#ifndef PG8_ALIGN
#define PG8_ALIGN true
#endif
#define GAS __attribute__((address_space(1)))
#define LAS __attribute__((address_space(3)))
typedef unsigned short bf16;
typedef unsigned v4u __attribute__((ext_vector_type(4)));
typedef float f32x4 __attribute__((ext_vector_type(4)));
typedef short bf16x8 __attribute__((ext_vector_type(8)));
typedef GAS unsigned gu32;
typedef GAS unsigned long long gu64;
#define RLX_AGENT __ATOMIC_RELAXED, __HIP_MEMORY_SCOPE_AGENT
#define LDS_WAIT() asm volatile("s_waitcnt lgkmcnt(0)" ::: "memory")
#define VM_WAIT() asm volatile("s_waitcnt vmcnt(0)" ::: "memory")
__device__ __forceinline__ unsigned long long rt() { return __builtin_amdgcn_s_memrealtime(); }
__device__ __forceinline__ unsigned f2bf(float f) { unsigned u = __builtin_bit_cast(unsigned, f); return (u + 0x7fffu + ((u >> 16) & 1u)) >> 16; }
__device__ __forceinline__ unsigned pk2(float lo, float hi) { return f2bf(lo) | (f2bf(hi) << 16); }

#define XB_TMO      128
#define XB_XCNT(j)  (256  + 64 * (j))
#define XB_XSUB(j)  (1280 + 64 * (j))
#define XB_XGEN(j)  (2304 + 64 * (j))
#define XB_TOP      3328
#define XB_TOPGEN   3392
#define XCD_BAR_WORDS 3456
#define XB_SPIN_CAP (1u << 22)

__device__ __forceinline__ unsigned xb_ld(unsigned* p)              { return __hip_atomic_load(p, __ATOMIC_RELAXED, __HIP_MEMORY_SCOPE_AGENT); }
__device__ __forceinline__ unsigned xb_add(unsigned* p, unsigned v) { return __hip_atomic_fetch_add(p, v, __ATOMIC_RELAXED, __HIP_MEMORY_SCOPE_AGENT); }
__device__ __forceinline__ unsigned xb_xcc_id() { return (unsigned)__builtin_amdgcn_s_getreg((3 << 11) | 20) & 0xFu; }
#define XB_SPIN(cond, bar) do { unsigned _sp = 0; while (cond) { __builtin_amdgcn_s_sleep(1); \
    if ((++_sp & 255u) == 0u) { if (xb_ld(&(bar)[XB_TMO])) break; if (_sp > XB_SPIN_CAP) { atomicAdd(&(bar)[XB_TMO], 1u); break; } } } } while (0)

struct XcdBarrier {
    unsigned* bar; unsigned x;
    volatile LAS unsigned* st;
};

__device__ __forceinline__ XcdBarrier xcd_barrier_post(unsigned* bar, volatile LAS unsigned* st) {
    XcdBarrier b; b.bar = bar; b.x = xb_xcc_id(); b.st = st;
    if (threadIdx.x == 0) (void)xb_add(&bar[XB_XCNT(b.x)], 1u);
    return b;
}
__device__ __forceinline__ void xcd_barrier_complete(unsigned* bar, unsigned x, unsigned& nloc, unsigned& nx) {
    const unsigned G = gridDim.x * gridDim.y * gridDim.z;
    unsigned sum, cnt, mine, sp = 0u;
    for (;;) {
        sum = 0u; cnt = 0u; mine = 0u;
#pragma unroll
        for (unsigned j = 0; j < 16; ++j) { const unsigned c = xb_ld(&bar[XB_XCNT(j)]); sum += c; cnt += (c > 0u) ? 1u : 0u; mine = (j == x) ? c : mine; }
        if (sum == G) break;
        __builtin_amdgcn_s_sleep(1);
        if ((++sp & 255u) == 0u) { if (xb_ld(&bar[XB_TMO])) break; if (sp > XB_SPIN_CAP) { atomicAdd(&bar[XB_TMO], 1u); break; } }
    }
    nloc = mine > 0u ? mine : 1u; nx = cnt > 0u ? cnt : 1u;
}

__device__ __forceinline__ void xcd_barrier(const XcdBarrier& b) {
    asm volatile("s_waitcnt vmcnt(0)" ::: "memory");
    __syncthreads();
    if (threadIdx.x == 0) {
        unsigned* bar = b.bar;
        __builtin_amdgcn_s_waitcnt(0);
        unsigned nloc = b.st[0], nx = b.st[1];
        if (nloc == 0u) { xcd_barrier_complete(bar, b.x, nloc, nx); b.st[0] = nloc; b.st[1] = nx; }
        const unsigned old = xb_add(&bar[XB_XSUB(b.x)], 1u);
        const unsigned gen = old / nloc;
        if (old + 1u == (gen + 1u) * nloc) {
            __builtin_amdgcn_fence(__ATOMIC_RELEASE, "agent");
            asm volatile("s_waitcnt vmcnt(0)" ::: "memory");
            const unsigned og = xb_add(&bar[XB_TOP], 1u);
            const unsigned tg = og / nx;
            if (og + 1u == (tg + 1u) * nx) xb_add(&bar[XB_TOPGEN], 1u);
            else XB_SPIN(xb_ld(&bar[XB_TOPGEN]) == tg, bar);
            __builtin_amdgcn_fence(__ATOMIC_ACQUIRE, "agent");
            xb_add(&bar[XB_XGEN(b.x)], 1u);
            asm volatile("s_waitcnt vmcnt(0)" ::: "memory");
        } else {
            XB_SPIN(xb_ld(&bar[XB_XGEN(b.x)]) == gen, bar);
            __builtin_amdgcn_fence(__ATOMIC_ACQUIRE, "agent");
            asm volatile("s_waitcnt vmcnt(0)" ::: "memory");
        }
    }
    __syncthreads();
}

constexpr int NWAVES = 8;
constexpr int T_ = 16384, SEQ = 4096, DM = 1024, NPROJ = 2304, INC = 2312;
constexpr int PJ_K = 512, PJ_V = 640, PJ_Z = 768, PJ_XBC = 1280;
constexpr float EPS = 1e-6f;
constexpr size_t MiB = 1u << 20;
constexpr size_t WS_CTL = 0, CTL_ZERO_BYTES = 1 * MiB;
constexpr size_t WS_SMALL = 1 * MiB;
constexpr size_t WS_WIN = 2 * MiB, WS_WOUT = 7 * MiB, WS_WQ = 9 * MiB;
constexpr size_t WS_ED = 13 * MiB, WS_EU = 29 * MiB;
constexpr size_t WS_XN = 77 * MiB;
constexpr size_t WS_PROJ = 109 * MiB;
constexpr size_t WS_ST = 181 * MiB;
constexpr size_t WS_IDX = 213 * MiB, WS_GATE = 221 * MiB, WS_SSQ = 229 * MiB, WS_END = 230 * MiB;
constexpr size_t DO_Y = 0, DO_DT = 41 * MiB;
constexpr size_t WS_CC = 230 * MiB, WS_DT = 238 * MiB, WS_EA = 239 * MiB, WS_CDEC = 240 * MiB, WS_PREV = WS_IDX;
constexpr size_t DO_YPF = 0, DO_YPLAIN = 32 * MiB;
constexpr size_t WS_PART = WS_PROJ;
constexpr size_t WS_H8 = WS_XN, WS_HS = WS_DT;
constexpr size_t WS_SSQ2 = WS_EA;
constexpr int CW_BAR = 4096, CW_RANK = 8192;
constexpr int RING_OFF = 0, RING_BYTES = 147456, LDSCTL_OFF = RING_BYTES, MISC_OFF = LDSCTL_OFF + 320, LDS_BYTES = 163840;

__constant__ unsigned char c_bucket[128] = {0, 1, 2, 3, 4, 5, 6, 7, 8, 9, 10, 11, 12, 13, 14, 15, 16, 16, 16, 17, 17, 18, 18, 18, 19, 19, 19, 20, 20, 20, 20, 21, 21, 21, 21, 22, 22, 22, 22, 22, 23, 23, 23, 23, 23, 23, 24, 24, 24, 24, 24, 24, 25, 25, 25, 25, 25, 25, 25, 26, 26, 26, 26, 26, 26, 26, 26, 27, 27, 27, 27, 27, 27, 27, 27, 27, 27, 28, 28, 28, 28, 28, 28, 28, 28, 28, 28, 29, 29, 29, 29, 29, 29, 29, 29, 29, 29, 29, 29, 30, 30, 30, 30, 30, 30, 30, 30, 30, 30, 30, 30, 30, 30, 31, 31, 31, 31, 31, 31, 31, 31, 31, 31, 31, 31, 31, 31, 31};

typedef float v16f __attribute__((ext_vector_type(16)));
typedef float v32f __attribute__((ext_vector_type(32)));
typedef unsigned v6u __attribute__((ext_vector_type(6)));
typedef _Float16 v32h __attribute__((ext_vector_type(32)));
struct Frame {
    LAS unsigned char* lds;
    volatile LAS unsigned* MISC;
    gu32* ctl;
    int wave, vcu, G;
};
__device__ __forceinline__ int lane_id() { int l; asm volatile("v_mbcnt_lo_u32_b32 %0, -1, 0\n\tv_mbcnt_hi_u32_b32 %0, -1, %0" : "=v"(l)); return l; }
__device__ __forceinline__ int opq(int x) { asm volatile("" : "+v"(x)); return x; }
template <int M> __device__ __forceinline__ float swz_xor(float v) { return __int_as_float(__builtin_amdgcn_ds_swizzle(__float_as_int(v), (M << 10) | 0x1F)); }
__device__ __forceinline__ float sum_halves(float v) { const auto r = __builtin_amdgcn_permlane32_swap(__float_as_uint(v), __float_as_uint(v), false, false); return __uint_as_float(r[0]) + __uint_as_float(r[1]); }
__device__ __forceinline__ float max_halves(float v) { const auto r = __builtin_amdgcn_permlane32_swap(__float_as_uint(v), __float_as_uint(v), false, false); return fmaxf(__uint_as_float(r[0]), __uint_as_float(r[1])); }
__device__ __forceinline__ int imax_halves(int v) { const auto r = __builtin_amdgcn_permlane32_swap((unsigned)v, (unsigned)v, false, false); return max((int)r[0], (int)r[1]); }
__device__ __forceinline__ float wave_sum(float v) {
    v += swz_xor<1>(v); v += swz_xor<2>(v); v += swz_xor<4>(v); v += swz_xor<8>(v); v += swz_xor<16>(v);
    return sum_halves(v);
}
__device__ __forceinline__ float bf2f(unsigned short b) { return __uint_as_float((unsigned)b << 16); }
__device__ __forceinline__ float bflo(unsigned w) { return __uint_as_float(w << 16); }
__device__ __forceinline__ float bfhi(unsigned w) { return __uint_as_float(w & 0xffff0000u); }
__device__ __forceinline__ float silu_f(float x) { return x / (1.f + __expf(-x)); }

__device__ __forceinline__ void p0_transpose_item(const float* W, int ldw, int K, int nblk, bf16* WT, const float* kscale, LAS float* scr, int item, int lane) {
    const int kb = item / nblk, nb = item % nblk, k0 = 64 * kb, n0 = 32 * nb;
#pragma unroll 8
    for (int i = 0; i < 32; ++i) { const int kk = 2 * i + (lane >> 5); float v = W[(size_t)(k0 + kk) * ldw + n0 + (lane & 31)]; if (kscale) v *= kscale[k0 + kk]; scr[kk * 33 + (lane & 31)] = v; }
    LDS_WAIT(); asm volatile("" ::: "memory");
    const int c = lane & 7;
#pragma unroll
    for (int j = 0; j < 4; ++j) { const int n = (lane >> 3) + 8 * j; const LAS float* s = scr + (8 * c) * 33 + n;
        v4u o; o.x = pk2(s[0 * 33], s[1 * 33]); o.y = pk2(s[2 * 33], s[3 * 33]); o.z = pk2(s[4 * 33], s[5 * 33]); o.w = pk2(s[6 * 33], s[7 * 33]);
        *(GAS v4u*)(WT + (size_t)(n0 + n) * K + k0 + 8 * c) = o; }
    LDS_WAIT(); asm volatile("" ::: "memory");
}
struct Ptrs {
    const float *x, *norm_mix, *w_in, *conv_w, *conv_b, *dt_bias, *a_log, *d_skip, *ssd_norm_w, *sinks, *w_out, *rel_bias, *norm_ffn, *w_query, *sk1, *sk2, *e_down, *e_up, *norm_final;
    float* out; unsigned char* ws;
};
constexpr int Q_SPLIT = 16384;
__device__ __forceinline__ unsigned pack4_i8(float a, float b, float c, float d) {
    const int ia = __float2int_rn(a), ib = __float2int_rn(b), ic = __float2int_rn(c), id = __float2int_rn(d);
    return (unsigned)(ia & 0xff) | ((unsigned)(ib & 0xff) << 8) | ((unsigned)(ic & 0xff) << 16) | ((unsigned)(id & 0xff) << 24);
}
__device__ __forceinline__ void quant_fp8s(const Ptrs& P, int lane_, int r_lo, int r_hi, int w, int nw) {
    float* SC = (float*)(P.ws + WS_SMALL);
    for (int row = r_lo + w; row < r_hi; row += nw) {
        const int e = row & 16383;
        const float4* src = (const float4*)(P.e_down + (size_t)e * DM) + 4 * lane_;
        float v[16];
#pragma unroll
        for (int q = 0; q < 4; ++q) { const float4 t = src[q]; const float4 w4 = ((const float4*)P.norm_ffn)[4 * lane_ + q]; v[4 * q] = t.x * w4.x; v[4 * q + 1] = t.y * w4.y; v[4 * q + 2] = t.z * w4.z; v[4 * q + 3] = t.w * w4.w; }
        float am = 0.f;
#pragma unroll
        for (int q = 0; q < 16; ++q) am = fmaxf(am, fabsf(v[q]));
        am = fmaxf(am, swz_xor<1>(am)); am = fmaxf(am, swz_xor<2>(am)); am = fmaxf(am, swz_xor<4>(am)); am = fmaxf(am, swz_xor<8>(am)); am = fmaxf(am, swz_xor<16>(am)); am = max_halves(am);
        am = fmaxf(am, 1e-30f);
        const float inv = 127.f / am;
        v4u o; o.x = pack4_i8(v[0] * inv, v[1] * inv, v[2] * inv, v[3] * inv); o.y = pack4_i8(v[4] * inv, v[5] * inv, v[6] * inv, v[7] * inv);
        o.z = pack4_i8(v[8] * inv, v[9] * inv, v[10] * inv, v[11] * inv); o.w = pack4_i8(v[12] * inv, v[13] * inv, v[14] * inv, v[15] * inv);
        *(v4u*)(P.ws + WS_ED + ((size_t)(lane_ >> 3) * 16384 + e) * 128 + (lane_ & 7) * 16) = o;
        if (lane_ == 0) SC[row] = am * (1.f / 127.f);
    }
}
__device__ __forceinline__ void quant_fp6u(const Ptrs& P, int lane_, int q_lo, int q_hi, int w, int nw) {
    { float* SC = (float*)(P.ws + WS_SMALL); const int l31 = lane_ & 31, hf = lane_ >> 5;
      for (int q = q_lo + w; q < q_hi; q += nw) {
        const int e = 2 * q + hf, row = 16384 + e; const int isup = 1;
        const float4* src = (const float4*)((isup ? P.e_up : P.e_down) + (size_t)e * DM) + 8 * l31;
        float v[32];
#pragma unroll
        for (int k = 0; k < 8; ++k) { const float4 t = src[k]; v[4 * k] = t.x; v[4 * k + 1] = t.y; v[4 * k + 2] = t.z; v[4 * k + 3] = t.w; }
        if (!isup) {
#pragma unroll
            for (int k = 0; k < 8; ++k) { const float4 w = ((const float4*)P.norm_ffn)[8 * l31 + k]; v[4 * k] *= w.x; v[4 * k + 1] *= w.y; v[4 * k + 2] *= w.z; v[4 * k + 3] *= w.w; } }
        float am = 0.f;
#pragma unroll
        for (int k = 0; k < 32; ++k) am = fmaxf(am, fabsf(v[k]));
        am = fmaxf(am, swz_xor<1>(am)); am = fmaxf(am, swz_xor<2>(am)); am = fmaxf(am, swz_xor<4>(am)); am = fmaxf(am, swz_xor<8>(am)); am = fmaxf(am, swz_xor<16>(am));
        am = fmaxf(am, 1e-30f);
        const float inv = 7.5f / am;
        v32h xh;
#pragma unroll
        for (int k = 0; k < 32; ++k) xh[k] = (_Float16)(v[k] * inv);
        const v6u pk = __builtin_amdgcn_cvt_scalef32_pk32_fp6_f16(xh, 1.0f);
        unsigned char* dst = P.ws + WS_EU + (size_t)e * 768;
        *(v4u*)(dst + 16 * l31) = (v4u){pk[0], pk[1], pk[2], pk[3]};
        *(unsigned long long*)(dst + 512 + 8 * l31) = (unsigned long long)pk[4] | ((unsigned long long)pk[5] << 32);
        if (l31 == 0) SC[row] = am * (1.f / 7.5f);
      } }
}
__device__ __forceinline__ void p0_prologue(Frame& F0, const Ptrs& P) {
    const Frame& F = F0; const int lane_ = lane_id(), tid_ = F.wave * 64 + lane_;
    LAS float* scr = (LAS float*)(F.lds + RING_OFF + F.wave * 16384);
    const int gw = F.vcu * NWAVES + F.wave, NGW = F.G * NWAVES;
    bf16* Win_t = (bf16*)(P.ws + WS_WIN); bf16* Wout_t = (bf16*)(P.ws + WS_WOUT); bf16* Wq_t = (bf16*)(P.ws + WS_WQ);
    constexpr int I_IN = 16 * 72, I_OUT = 16 * 32, I_Q = 16 * 64, NITEMS = I_IN + I_OUT + I_Q;
    for (int it = gw; it < NITEMS; it += NGW) {
        int r = it;
        if (r < I_IN) { p0_transpose_item(P.w_in, INC, DM, 72, Win_t, nullptr, scr, r, lane_); continue; } r -= I_IN;
        if (r < I_OUT) { p0_transpose_item(P.w_out, DM, DM, 32, Wout_t, nullptr, scr, r, lane_); continue; } r -= I_OUT;
        p0_transpose_item(P.w_query, 2048, DM, 64, Wq_t, P.norm_ffn, scr, r, lane_);
    }
    quant_fp8s(P, lane_, 0, Q_SPLIT, gw, NGW);
    __syncthreads();
    { LAS float* Wdt = (LAS float*)(F.lds + RING_OFF);
      for (int i = tid_; i < 8192; i += 512) Wdt[i] = P.w_in[(size_t)(i >> 3) * INC + NPROJ + (i & 7)];
      __syncthreads();
      bf16* XN = (bf16*)(P.ws + WS_XN); float* DT = (float*)(P.ws + WS_DT);
      for (int m0 = gw * 2; m0 < T_; m0 += NGW * 2) {
        float4 xv[2][4];
#pragma unroll
        for (int rr = 0; rr < 2; ++rr) { const float4* xr = (const float4*)(P.x + (size_t)(m0 + rr) * DM);
#pragma unroll
            for (int j = 0; j < 4; ++j) xv[rr][j] = xr[j * 64 + lane_]; }
#pragma unroll
        for (int rr = 0; rr < 2; ++rr) { const int m = m0 + rr;
        float4 v[4]; float s = 0.f;
#pragma unroll
        for (int j = 0; j < 4; ++j) { v[j] = xv[rr][j]; s += v[j].x * v[j].x + v[j].y * v[j].y + v[j].z * v[j].z + v[j].w * v[j].w; }
        const float r = rsqrtf(wave_sum(s) * (1.f / 1024.f) + EPS);
        float d8[8];
#pragma unroll
        for (int q = 0; q < 8; ++q) d8[q] = 0.f;
        unsigned long long* o8 = (unsigned long long*)(XN + (size_t)m * DM);
#pragma unroll
        for (int j = 0; j < 4; ++j) { const float4 w = ((const float4*)P.norm_mix)[j * 64 + lane_];
            const float e0 = v[j].x * r * w.x, e1 = v[j].y * r * w.y, e2 = v[j].z * r * w.z, e3 = v[j].w * r * w.w;
            o8[j * 64 + lane_] = (unsigned long long)pk2(e0, e1) | ((unsigned long long)pk2(e2, e3) << 32);
            const float ev[4] = {e0, e1, e2, e3};
#pragma unroll
            for (int e = 0; e < 4; ++e) { const LAS f32x4* wr = (const LAS f32x4*)(Wdt + (size_t)(j * 256 + lane_ * 4 + e) * 8); const f32x4 w0 = wr[0], w1 = wr[1];
                d8[0] += ev[e] * w0.x; d8[1] += ev[e] * w0.y; d8[2] += ev[e] * w0.z; d8[3] += ev[e] * w0.w; d8[4] += ev[e] * w1.x; d8[5] += ev[e] * w1.y; d8[6] += ev[e] * w1.z; d8[7] += ev[e] * w1.w; } }
#pragma unroll
        for (int q = 0; q < 8; ++q) d8[q] = wave_sum(d8[q]);
        if (lane_ == 0) { float4* dp = (float4*)(DT + (size_t)m * 8); dp[0] = make_float4(d8[0], d8[1], d8[2], d8[3]); dp[1] = make_float4(d8[4], d8[5], d8[6], d8[7]); }
        }
      }
      __syncthreads(); }
}

struct EpiResH {
    static constexpr bool PERM = false, AFTER_DRAIN = false;
    const float* X; bf16* HB; float* SSQ;
    __device__ __forceinline__ void operator()(const pg8::f32x4 (&acc)[2][2][4][2], const pg8::Unit& u, int wr, int wc, int fr, int fq) const {
        const int row0 = u.pm * 256 + wr * 64 + fr, col0 = u.pn * 256 + wc * 32 + 4 * fq;
#pragma unroll
        for (int ai = 0; ai < 2; ++ai)
#pragma unroll
            for (int m = 0; m < 4; ++m) { const int row = row0 + ai * 128 + m * 16; float ss = 0.f;
#pragma unroll
                for (int bj = 0; bj < 2; ++bj)
#pragma unroll
                    for (int n = 0; n < 2; ++n) { const size_t off = (size_t)row * DM + col0 + bj * 128 + n * 16;
                        const pg8::f32x4 h = acc[ai][bj][m][n] + *(const pg8::f32x4*)(X + off);
                        ss += h[0] * h[0] + h[1] * h[1] + h[2] * h[2] + h[3] * h[3];
                        *(unsigned long long*)(HB + off) = (unsigned long long)pk2(h[0], h[1]) | ((unsigned long long)pk2(h[2], h[3]) << 32); }
                ss += swz_xor<16>(ss); ss = sum_halves(ss);
                if (fq == 0) SSQ[(size_t)row * 16 + u.pn * 4 + wc] = ss; }
    }
};

typedef float f32x16 __attribute__((ext_vector_type(16)));
typedef short s16x4 __attribute__((ext_vector_type(4)));
typedef float f32x2_t __attribute__((ext_vector_type(2)));
typedef __bf16 bf16x2_t __attribute__((ext_vector_type(2)));
#define MFMA32(a, b, c) __builtin_amdgcn_mfma_f32_32x32x16_bf16((a), (b), (c), 0, 0, 0)
__device__ __forceinline__ int crow(int reg, int h) { return (reg & 3) + 8 * (reg >> 2) + 4 * h; }
__device__ __forceinline__ unsigned cvtpk(float lo, float hi) { f32x2_t v = {lo, hi}; bf16x2_t b = __builtin_convertvector(v, bf16x2_t); return __builtin_bit_cast(unsigned, b); }
__device__ __forceinline__ bf16x8 pack8(const f32x16& x, int s) {
    v4u p; p.x = cvtpk(x[8 * s], x[8 * s + 1]); p.y = cvtpk(x[8 * s + 2], x[8 * s + 3]); p.z = cvtpk(x[8 * s + 4], x[8 * s + 5]); p.w = cvtpk(x[8 * s + 6], x[8 * s + 7]);
    return __builtin_bit_cast(bf16x8, p);
}
constexpr float LOG2E = 1.4426950408889634f;
constexpr int LDP = 136;
constexpr int S1_XT = 0, S1_XTW = 17408, S1_BSN = 34816, S1_CLN = 69632, S1_BNL = 104448, S1_F32 = 139264;

__device__ __forceinline__ float silu_fast(float x) { return x * __builtin_amdgcn_rcpf(1.f + __builtin_amdgcn_exp2f(-x * LOG2E)); }
__device__ __forceinline__ int swz_t(int row, int l) { return row * LDP + ((((l >> 3) ^ (row >> 3)) & 7) | ((l >> 3) & 8)) * 8 + (l & 7); }
#define S1_CONV8(A_, IT_) do { _Pragma("unroll") for (int e_ = 0; e_ < 8; ++e_) A_[e_] = bias[e_]; \
        _Pragma("unroll") for (int j_ = 0; j_ < 4; ++j_) { const v4u rw_ = raw[(IT_) + j_]; \
            A_[0] += w[j_][0] * bflo(rw_.x); A_[1] += w[j_][1] * bfhi(rw_.x); A_[2] += w[j_][2] * bflo(rw_.y); A_[3] += w[j_][3] * bfhi(rw_.y); \
            A_[4] += w[j_][4] * bflo(rw_.z); A_[5] += w[j_][5] * bfhi(rw_.z); A_[6] += w[j_][6] * bflo(rw_.w); A_[7] += w[j_][7] * bfhi(rw_.w); } \
        _Pragma("unroll") for (int e_ = 0; e_ < 8; ++e_) A_[e_] = silu_fast(A_[e_]); } while (0)
#define S1_LOADW(CHB_) do { _Pragma("unroll") for (int j_ = 0; j_ < 4; ++j_) { const float4 w0_ = *(const float4*)(P.conv_w + j_ * 1024 + (CHB_)), w1_ = *(const float4*)(P.conv_w + j_ * 1024 + (CHB_) + 4); \
            w[j_][0] = w0_.x; w[j_][1] = w0_.y; w[j_][2] = w0_.z; w[j_][3] = w0_.w; w[j_][4] = w1_.x; w[j_][5] = w1_.y; w[j_][6] = w1_.z; w[j_][7] = w1_.w; } \
        { const float4 b0_ = *(const float4*)(P.conv_b + (CHB_)), b1_ = *(const float4*)(P.conv_b + (CHB_) + 4); \
          bias[0] = b0_.x; bias[1] = b0_.y; bias[2] = b0_.z; bias[3] = b0_.w; bias[4] = b1_.x; bias[5] = b1_.y; bias[6] = b1_.z; bias[7] = b1_.w; } } while (0)
__device__ __forceinline__ void ssd_s1(Frame& F, const Ptrs& P) {
    const bf16* PROJ = (const bf16*)(P.ws + WS_PROJ); const float* DT = (const float*)(P.ws + WS_DT);
    float* EA = (float*)(P.ws + WS_EA); float* CDEC = (float*)(P.ws + WS_CDEC); bf16* CC = (bf16*)(P.ws + WS_CC);
    float* ST = (float*)(P.ws + WS_ST); float* YPF = (float*)((char*)P.out + DO_YPF);
    LAS unsigned char* L = F.lds + RING_OFF;
    LAS bf16* Xt = (LAS bf16*)(L + S1_XT); LAS bf16* Xtw = (LAS bf16*)(L + S1_XTW); LAS bf16* Bsn = (LAS bf16*)(L + S1_BSN); LAS bf16* Cln = (LAS bf16*)(L + S1_CLN); LAS bf16* Bnl = (LAS bf16*)(L + S1_BNL);
    LAS float* f32base = (LAS float*)(L + S1_F32);
    const int lane = lane_id(); const int tid_ = F.wave * 64 + lane;
    for (int ug = F.vcu; ug < 256; ug += F.G) {
        const int grp = ug & 1, c = (ug >> 1) & 31, b = ug >> 6, t0 = b * SEQ + c * 128;
        __syncthreads();
        if (F.wave < 4) {
            const int h = 4 * grp + F.wave, us = (b * 32 + c) * 8 + h;
            const float A = -__expf(P.a_log[h]), dtb = P.dt_bias[h];
            const int ln = opq(lane_id());
            LAS float* acum2 = f32base + F.wave * 384; LAS float* wv = acum2 + 128; LAS float* wend = wv + 128;
            const float x0 = DT[(size_t)(t0 + 2 * ln) * 8 + h] + dtb, x1 = DT[(size_t)(t0 + 2 * ln + 1) * 8 + h] + dtb;
            const float dt0 = fmaxf(x0, 0.f) + log1pf(__expf(-fabsf(x0))), dt1 = fmaxf(x1, 0.f) + log1pf(__expf(-fabsf(x1)));
            const float a0 = dt0 * A, a1 = dt1 * A;
            float s = a0 + a1;
#pragma unroll
            for (int o = 1; o < 64; o <<= 1) { const float v = __int_as_float(__builtin_amdgcn_ds_bpermute((ln - o) * 4, __float_as_int(s))); if (ln >= o) s += v; }
            const float ac1 = s, ac0 = s - a1, tot = __uint_as_float(__builtin_amdgcn_readlane(__float_as_uint(s), 63));
            acum2[2 * ln] = ac0 * LOG2E; acum2[2 * ln + 1] = ac1 * LOG2E;
            wv[2 * ln] = log2f(dt0) - ac0 * LOG2E; wv[2 * ln + 1] = log2f(dt1) - ac1 * LOG2E;
            wend[2 * ln] = dt0 * exp2f((tot - ac0) * LOG2E); wend[2 * ln + 1] = dt1 * exp2f((tot - ac1) * LOG2E);
            EA[(size_t)(t0 + 2 * ln) * 8 + h] = exp2f(ac0 * LOG2E); EA[(size_t)(t0 + 2 * ln + 1) * 8 + h] = exp2f(ac1 * LOG2E);
            if (ln == 0) CDEC[us] = exp2f(tot * LOG2E);
        }
        __syncthreads();
#pragma unroll 1
        for (int hi = 0; hi < 4; ++hi) {
            const int h = 4 * grp + hi, u = (b * 32 + c) * 8 + h;
            const float Dh = P.d_skip[h];
            const LAS float* acum2 = f32base + hi * 384; const LAS float* wv = acum2 + 128; const LAS float* wend = wv + 128;
            const int tidc = opq(tid_);
            if (hi == 0) {
                if (tidc < 440) {
                    const int cg = tidc % 40, sg = tidc / 40, l0 = 12 * sg;
                    int chb; if (cg < 8) chb = h * 64 + cg * 8; else if (cg < 24) chb = 512 + grp * 128 + (cg - 8) * 8; else chb = 768 + grp * 128 + (cg - 24) * 8;
                    v4u raw[15];
#pragma unroll
                    for (int q = 0; q < 15; ++q) { const int ss = c * 128 + l0 - 3 + q; raw[q] = (v4u){0u, 0u, 0u, 0u};
                        if (ss >= 0 && l0 - 3 + q < 128) raw[q] = *(const v4u*)(PROJ + (size_t)(b * SEQ + ss) * NPROJ + PJ_XBC + chb); }
                    float w[4][8], bias[8]; S1_LOADW(chb);
#pragma unroll
                    for (int it = 0; it < 12; it += 2) {
                        const int l = l0 + it;
                        if (l < 128) {
                            float a[8], a2[8]; S1_CONV8(a, it); S1_CONV8(a2, it + 1);
                            if (cg < 8) { const float we = wend[l], we2 = wend[l + 1];
#pragma unroll
                                for (int e = 0; e < 8; ++e) { *(LAS unsigned*)(Xt + swz_t(cg * 8 + e, l)) = cvtpk(a[e], a2[e]); *(LAS unsigned*)(Xtw + swz_t(cg * 8 + e, l)) = cvtpk(a[e] * we, a2[e] * we2); }
                            } else {
                                v4u o, o2; o.x = cvtpk(a[0], a[1]); o.y = cvtpk(a[2], a[3]); o.z = cvtpk(a[4], a[5]); o.w = cvtpk(a[6], a[7]);
                                o2.x = cvtpk(a2[0], a2[1]); o2.y = cvtpk(a2[2], a2[3]); o2.z = cvtpk(a2[4], a2[5]); o2.w = cvtpk(a2[6], a2[7]);
                                if (cg < 24) { const int n0 = (cg - 8) * 8; *(LAS v4u*)(Bsn + l * LDP + n0) = o; *(LAS v4u*)(Bsn + (l + 1) * LDP + n0) = o2;
#pragma unroll
                                    for (int e = 0; e < 8; ++e) *(LAS unsigned*)(Bnl + swz_t(n0 + e, l)) = cvtpk(a[e], a2[e]);
                                } else { const int n0 = (cg - 24) * 8; *(LAS v4u*)(Cln + l * LDP + n0) = o; *(LAS v4u*)(Cln + (l + 1) * LDP + n0) = o2;
                                    *(v4u*)(CC + (size_t)(t0 + l) * 256 + grp * 128 + n0) = o; *(v4u*)(CC + (size_t)(t0 + l + 1) * 256 + grp * 128 + n0) = o2; }
                            }
                        }
                    }
                }
            } else {
                const int cg = tidc & 7, l = 2 * (tidc >> 3), chb = h * 64 + cg * 8;
                v4u raw[5];
#pragma unroll
                for (int q = 0; q < 5; ++q) { const int ss = c * 128 + l - 3 + q; raw[q] = (v4u){0u, 0u, 0u, 0u};
                    if (ss >= 0) raw[q] = *(const v4u*)(PROJ + (size_t)(b * SEQ + ss) * NPROJ + PJ_XBC + chb); }
                float w[4][8], bias[8]; S1_LOADW(chb);
                float a[8], a2[8]; S1_CONV8(a, 0); S1_CONV8(a2, 1);
                const float we = wend[l], we2 = wend[l + 1];
#pragma unroll
                for (int e = 0; e < 8; ++e) { *(LAS unsigned*)(Xt + swz_t(cg * 8 + e, l)) = cvtpk(a[e], a2[e]); *(LAS unsigned*)(Xtw + swz_t(cg * 8 + e, l)) = cvtpk(a[e] * we, a2[e] * we2); }
            }
            __syncthreads();
            const int ln3 = opq(lane), r = ln3 & 31, hh = ln3 >> 5;
            if (F.wave < 4) {
                const int pt = F.wave >> 1;
#pragma unroll 1
                for (int q = 0; q < 2; ++q) {
                    const int lt = (F.wave & 1) ? (1 + q) : (3 * q);
                    f32x16 yacc;
#pragma unroll
                    for (int i = 0; i < 16; ++i) yacc[i] = 0.f;
                    const float al = acum2[32 * lt + r];
                    for (int st = 0; st <= lt; ++st) {
                        f32x16 macc;
#pragma unroll
                        for (int i = 0; i < 16; ++i) macc[i] = 0.f;
#pragma unroll
                        for (int kk = 0; kk < 8; ++kk) {
                            const bf16x8 a = *(const LAS bf16x8*)(Bsn + (32 * st + r) * LDP + 16 * kk + 8 * hh);
                            const bf16x8 bb = *(const LAS bf16x8*)(Cln + (32 * lt + r) * LDP + 16 * kk + 8 * hh);
                            macc = MFMA32(a, bb, macc);
                        }
#pragma unroll
                        for (int i = 0; i < 16; ++i) { const int sl = crow(i, hh);
                            float f = __builtin_amdgcn_exp2f(al + wv[32 * st + sl]);
                            if (st == lt && sl > r) f = 0.f;
                            macc[i] *= f; }
#pragma unroll
                        for (int sg = 0; sg < 2; ++sg) {
                            const bf16x8 bfrag = pack8(macc, sg);
                            const int prow = 32 * pt + r, lb = 32 * st + 16 * sg;
                            const s16x4 lo = *(const LAS s16x4*)(Xt + swz_t(prow, lb) + 4 * hh), hi2 = *(const LAS s16x4*)(Xt + swz_t(prow, lb + 8) + 4 * hh);
                            const bf16x8 afrag = __builtin_shufflevector(lo, hi2, 0, 1, 2, 3, 4, 5, 6, 7);
                            yacc = MFMA32(afrag, bfrag, yacc);
                        }
                    }
#pragma unroll
                    for (int i = 0; i < 16; ++i) { const int p = 32 * pt + crow(i, hh);
                        const float y = yacc[i] + Dh * bf2f(Xt[swz_t(p, 32 * lt + r)]);
                        YPF[((((size_t)u * 4 + lt) * 2 + pt) * 16 + i) * 64 + ln3] = y; }
                }
            } else {
                const int nt = F.wave - 4;
#pragma unroll 1
                for (int pt = 0; pt < 2; ++pt) {
                    f32x16 sacc;
#pragma unroll
                    for (int i = 0; i < 16; ++i) sacc[i] = 0.f;
#pragma unroll
                    for (int kk = 0; kk < 8; ++kk) {
                        const bf16x8 a = *(const LAS bf16x8*)(Xtw + swz_t(32 * pt + r, 16 * kk + 8 * hh));
                        const bf16x8 bb = *(const LAS bf16x8*)(Bnl + swz_t(32 * nt + r, 16 * kk + 8 * hh));
                        sacc = MFMA32(a, bb, sacc);
                    }
#pragma unroll
                    for (int i = 0; i < 16; ++i) ST[((size_t)u * 64 + 32 * pt + crow(i, hh)) * 128 + 32 * nt + r] = sacc[i];
                }
            }
            __syncthreads();
        }
    }
}
__device__ __forceinline__ void ssd_s2(Frame& F, const Ptrs& P) {
    const float* ST = (const float*)(P.ws + WS_ST); const float* CDEC = (const float*)(P.ws + WS_CDEC); unsigned* PREV = (unsigned*)(P.ws + WS_PREV);
    for (int g = F.vcu * 512 + (F.wave * 64 + lane_id()); g < 131072; g += F.G * 512) {
        const int n2 = g & 63, p = (g >> 6) & 63, h = (g >> 12) & 7, b = g >> 15;
        float2 st[32];
#pragma unroll
        for (int c = 0; c < 32; ++c) st[c] = *(const float2*)(ST + ((size_t)(((b * 32 + c) * 8 + h) * 64 + p)) * 128 + 2 * n2);
        float r0 = 0.f, r1 = 0.f;
#pragma unroll
        for (int c = 0; c < 32; ++c) { const size_t u = (size_t)((b * 32 + c) * 8 + h);
            PREV[((u * 64 + p) * 128 + 2 * n2) >> 1] = pk2(r0, r1);
            const float d = CDEC[u]; r0 = r0 * d + st[c].x; r1 = r1 * d + st[c].y; }
    }
}
__device__ __forceinline__ void ssd_s3(Frame& F, const Ptrs& P) {
    const bf16* CC = (const bf16*)(P.ws + WS_CC); const bf16* PREV = (const bf16*)(P.ws + WS_PREV); const float* EA = (const float*)(P.ws + WS_EA);
    const float* YPF = (const float*)((const char*)P.out + DO_YPF); const bf16* PROJ = (const bf16*)(P.ws + WS_PROJ); bf16* CAT = (bf16*)(P.ws + WS_XN);
    LAS float* red = (LAS float*)(F.lds + RING_OFF);
    const int lane = lane_id(), r = lane & 31, hh = lane >> 5, h = F.wave, grp = h >> 2;
    for (int v = F.vcu; v < 512; v += F.G) {
        const int lt = v & 3, c = (v >> 2) & 31, b = v >> 7;
        const int t = b * SEQ + c * 128 + lt * 32 + r; const size_t u = (size_t)((b * 32 + c) * 8 + h);
        float ypf[2][16]; unsigned long long zz[2][4];
#pragma unroll
        for (int pt = 0; pt < 2; ++pt) {
#pragma unroll
            for (int i = 0; i < 16; ++i) ypf[pt][i] = YPF[((((size_t)u * 4 + lt) * 2 + pt) * 16 + i) * 64 + lane];
#pragma unroll
            for (int g4 = 0; g4 < 4; ++g4) zz[pt][g4] = *(const unsigned long long*)(PROJ + (size_t)t * NPROJ + PJ_Z + h * 64 + 32 * pt + 8 * g4 + 4 * hh); }
        const float ea = EA[(size_t)t * 8 + h];
        f32x16 acc[2];
#pragma unroll
        for (int i = 0; i < 16; ++i) { acc[0][i] = 0.f; acc[1][i] = 0.f; }
#pragma unroll
        for (int kk = 0; kk < 8; ++kk) {
            const bf16x8 bb = *(const bf16x8*)(CC + (size_t)t * 256 + grp * 128 + 16 * kk + 8 * hh);
#pragma unroll
            for (int pt = 0; pt < 2; ++pt) { const bf16x8 a = *(const bf16x8*)(PREV + (u * 64 + 32 * pt + r) * 128 + 16 * kk + 8 * hh); acc[pt] = MFMA32(a, bb, acc[pt]); }
        }
        float ss = 0.f;
#pragma unroll
        for (int pt = 0; pt < 2; ++pt)
#pragma unroll
            for (int g4 = 0; g4 < 4; ++g4) {
                const unsigned z01 = (unsigned)zz[pt][g4], z23 = (unsigned)(zz[pt][g4] >> 32);
                const float zf[4] = {bflo(z01), bfhi(z01), bflo(z23), bfhi(z23)};
#pragma unroll
                for (int e = 0; e < 4; ++e) { const int i = 4 * g4 + e;
                    const float y = acc[pt][i] * ea + ypf[pt][i];
                    const float yg = y * silu_fast(zf[e]); acc[pt][i] = yg; ss = fmaf(yg, yg, ss); }
            }
        ss = sum_halves(ss);
        if (hh == 0) red[h * 32 + r] = ss;
        __syncthreads();
        float tot = 0.f;
#pragma unroll
        for (int w = 0; w < 8; ++w) tot += red[w * 32 + r];
        const float rn = rsqrtf(tot * (1.f / 512.f) + EPS);
#pragma unroll
        for (int pt = 0; pt < 2; ++pt)
#pragma unroll
            for (int g4 = 0; g4 < 4; ++g4) { const int ch = h * 64 + 32 * pt + 8 * g4 + 4 * hh;
                const float4 w = *(const float4*)(P.ssd_norm_w + ch);
                *(unsigned long long*)(CAT + (size_t)t * DM + 512 + ch) = (unsigned long long)cvtpk(acc[pt][4 * g4] * rn * w.x, acc[pt][4 * g4 + 1] * rn * w.y) | ((unsigned long long)cvtpk(acc[pt][4 * g4 + 2] * rn * w.z, acc[pt][4 * g4 + 3] * rn * w.w) << 32); }
        __syncthreads();
    }
}
__device__ __forceinline__ float gelu_erf(float v) { return 0.5f * v * (1.f + erff(v * 0.70710678118654752f)); }
typedef float f32x2v __attribute__((ext_vector_type(2)));
#define CVT8(W, LO) __builtin_amdgcn_cvt_pk_f32_fp8((int)(W), LO)
template <int CTRL> __device__ __forceinline__ float dpp_f(float v) { return __int_as_float(__builtin_amdgcn_update_dpp(0, __float_as_int(v), CTRL, 0xF, 0xF, true)); }
__device__ __forceinline__ float sum8_dpp(float s) { s += dpp_f<0xB1>(s); s += dpp_f<0x4E>(s); s += dpp_f<0x141>(s); return s; }
struct PeerPlace { int vx, nx, rank, nloc; };
__device__ __forceinline__ PeerPlace peer_place(Frame& F) {
    __syncthreads();
    if (F.wave == 0 && lane_id() == 0) {
        unsigned* bar = (unsigned*)(F.ctl + CW_BAR); const unsigned x = xb_xcc_id();
        unsigned vx = 0, nx = 0;
        for (unsigned j = 0; j < 16; ++j) { const unsigned c = xb_ld(&bar[XB_XCNT(j)]); if (c) { if (j < x) ++vx; ++nx; } }
        const unsigned rank = xb_add((unsigned*)(F.ctl + CW_RANK) + 64 * x, 1u);
        F.MISC[10] = vx; F.MISC[11] = nx ? nx : 1u; F.MISC[12] = rank; F.MISC[13] = xb_ld(&bar[XB_XCNT(x)]);
    }
    __syncthreads();
    PeerPlace pp; pp.vx = (int)F.MISC[10]; pp.nx = (int)F.MISC[11]; pp.rank = (int)F.MISC[12]; pp.nloc = (int)F.MISC[13]; if (pp.nloc < 1) pp.nloc = 1;
    return pp;
}
__device__ __forceinline__ void h_quant_rows(Frame& F, const Ptrs& P) {
    const bf16* HB = (const bf16*)(P.ws + WS_ST); unsigned char* H8 = P.ws + WS_H8; float* HS = (float*)(P.ws + WS_HS);
    const int lane = lane_id();
    for (int t = F.vcu * NWAVES + F.wave; t < T_; t += F.G * NWAVES) {
        const v4u a0 = ((const v4u*)(HB + (size_t)t * DM))[2 * lane], a1 = ((const v4u*)(HB + (size_t)t * DM))[2 * lane + 1];
        float hf[16];
        hf[0] = bflo(a0.x); hf[1] = bfhi(a0.x); hf[2] = bflo(a0.y); hf[3] = bfhi(a0.y); hf[4] = bflo(a0.z); hf[5] = bfhi(a0.z); hf[6] = bflo(a0.w); hf[7] = bfhi(a0.w);
        hf[8] = bflo(a1.x); hf[9] = bfhi(a1.x); hf[10] = bflo(a1.y); hf[11] = bfhi(a1.y); hf[12] = bflo(a1.z); hf[13] = bfhi(a1.z); hf[14] = bflo(a1.w); hf[15] = bfhi(a1.w);
        float am = 0.f;
#pragma unroll
        for (int i = 0; i < 16; ++i) am = fmaxf(am, fabsf(hf[i]));
        am = fmaxf(am, dpp_f<0xB1>(am)); am = fmaxf(am, dpp_f<0x4E>(am)); am = fmaxf(am, dpp_f<0x141>(am)); am = fmaxf(am, 1e-30f);
        const float inv = 127.f / am;
        v4u o; o.x = pack4_i8(hf[0] * inv, hf[1] * inv, hf[2] * inv, hf[3] * inv); o.y = pack4_i8(hf[4] * inv, hf[5] * inv, hf[6] * inv, hf[7] * inv);
        o.z = pack4_i8(hf[8] * inv, hf[9] * inv, hf[10] * inv, hf[11] * inv); o.w = pack4_i8(hf[12] * inv, hf[13] * inv, hf[14] * inv, hf[15] * inv);
        ((v4u*)(H8 + (size_t)t * 1024))[lane] = o;
        if ((lane & 7) == 0) HS[(size_t)t * 8 + (lane >> 3)] = am * (1.f / 127.f);
    }
}
constexpr int PX_D = 16;
template <int CTRL> __device__ __forceinline__ int dpp_i(int v) { return __builtin_amdgcn_update_dpp(0, v, CTRL, 0xF, 0xF, true); }
#define PX_ISSUE(BUF, LO, HI) _Pragma("unroll") for (int b_ = 0; b_ < 8; ++b_) { const unsigned off_ = ((unsigned)__builtin_amdgcn_ds_bpermute((16 * (b_ & 3) + ps) * 4, (b_ & 4) ? (HI) : (LO)) << 7) | (unsigned)(dl << 5); \
        BUF[2 * b_] = *(const v4u*)(tab + off_); BUF[2 * b_ + 1] = *(const v4u*)(tab + off_ + 16); }
__device__ __forceinline__ void peer_down_token(const v4u (&cur)[PX_D], const v4u h8a, const v4u h8b, const float hs, float* prow, int dl, int ps) {
    int sm[8];
#pragma unroll
    for (int b = 0; b < 8; ++b) { const v4u q0 = cur[2 * b], q1 = cur[2 * b + 1];
        int acc = __builtin_amdgcn_sdot4((int)q0.x, (int)h8a.x, 0, false); acc = __builtin_amdgcn_sdot4((int)q0.y, (int)h8a.y, acc, false);
        acc = __builtin_amdgcn_sdot4((int)q0.z, (int)h8a.z, acc, false); acc = __builtin_amdgcn_sdot4((int)q0.w, (int)h8a.w, acc, false);
        acc = __builtin_amdgcn_sdot4((int)q1.x, (int)h8b.x, acc, false); acc = __builtin_amdgcn_sdot4((int)q1.y, (int)h8b.y, acc, false);
        acc = __builtin_amdgcn_sdot4((int)q1.z, (int)h8b.z, acc, false); sm[b] = __builtin_amdgcn_sdot4((int)q1.w, (int)h8b.w, acc, false); }
    const bool c1 = (dl & 2) != 0, c0 = (dl & 1) != 0;
    int w4[4], w2[2];
#pragma unroll
    for (int k = 0; k < 4; ++k) { const int keep = c1 ? sm[4 + k] : sm[k], send = c1 ? sm[k] : sm[4 + k]; w4[k] = keep + dpp_i<0x4E>(send); }
#pragma unroll
    for (int k = 0; k < 2; ++k) { const int keep = c0 ? w4[2 + k] : w4[k], send = c0 ? w4[k] : w4[2 + k]; w2[k] = keep + dpp_i<0xB1>(send); }
    prow[32 * dl + ps] = (float)w2[0] * hs; prow[32 * dl + 16 + ps] = (float)w2[1] * hs;
}
__device__ __forceinline__ void peer_down(Frame& F, const Ptrs& P, const PeerPlace& pp) {
    const unsigned char* H8 = P.ws + WS_H8; const unsigned char* HSb = P.ws + WS_HS; const unsigned char* IDXb = P.ws + WS_IDX; unsigned char* PARTb = P.ws + WS_PART;
    const int lane = lane_id(), dl = lane & 3, ps = lane >> 2;
    const int t0 = pp.rank * NWAVES + F.wave, tstep = pp.nloc * NWAVES;
    for (int s = pp.vx; s < 8; s += pp.nx) {
        if (t0 >= T_) continue;
        const unsigned char* tab = P.ws + WS_ED + (size_t)s * 16384 * 128;
        const unsigned hoff = (unsigned)(s * 128 + dl * 32), ioff = (unsigned)lane * 4u;
        v4u bufA[PX_D], bufB[PX_D];
#define PD_CLAMP(T) ((T) < T_ ? (T) : t0)
#define PD_META(HA, HB_, HSC, TT) do { HA = *(const v4u*)(H8 + ((unsigned)(TT) * 1024u + hoff)); HB_ = *(const v4u*)(H8 + ((unsigned)(TT) * 1024u + hoff + 16u)); HSC = *(const float*)(HSb + ((unsigned)(TT) * 32u + (unsigned)s * 4u)); } while (0)
#define PD_IDX(LO, HI, TT) do { LO = *(const int*)(IDXb + ((unsigned)(TT) * 512u + ioff)); HI = *(const int*)(IDXb + ((unsigned)(TT) * 512u + 256u + ioff)); } while (0)
        int nidx_lo, nidx_hi; PD_IDX(nidx_lo, nidx_hi, t0);
        PX_ISSUE(bufA, nidx_lo, nidx_hi);
        PD_IDX(nidx_lo, nidx_hi, PD_CLAMP(t0 + tstep));
        v4u ha0, ha1, hb0, hb1; float sa, sb; PD_META(ha0, ha1, sa, t0);
        for (int t = t0; t < T_; t += 2 * tstep) {
            { const int tn = PD_CLAMP(t + tstep);
              PX_ISSUE(bufB, nidx_lo, nidx_hi); PD_IDX(nidx_lo, nidx_hi, PD_CLAMP(tn + tstep)); PD_META(hb0, hb1, sb, tn);
              __builtin_amdgcn_sched_barrier(0);
              peer_down_token(bufA, ha0, ha1, sa, (float*)(PARTb + ((unsigned)(s * T_ + t) * 512u)), dl, ps);
              __builtin_amdgcn_sched_barrier(0); }
            if (t + tstep >= T_) break;
            { const int tc = t + tstep, tn = PD_CLAMP(tc + tstep);
              PX_ISSUE(bufA, nidx_lo, nidx_hi); PD_IDX(nidx_lo, nidx_hi, PD_CLAMP(tn + tstep)); PD_META(ha0, ha1, sa, tn);
              __builtin_amdgcn_sched_barrier(0);
              peer_down_token(bufB, hb0, hb1, sb, (float*)(PARTb + ((unsigned)(s * T_ + tc) * 512u)), dl, ps);
              __builtin_amdgcn_sched_barrier(0); }
        }
    }
}
__device__ __forceinline__ void peer_act(Frame& F, const Ptrs& P) {
    const int* IDX = (const int*)(P.ws + WS_IDX); float* GATE = (float*)(P.ws + WS_GATE); const float* PART = (const float*)(P.ws + WS_PART); const float* SSQ = (const float*)(P.ws + WS_SSQ);
    const float* SCD = (const float*)(P.ws + WS_SMALL); const float* SCU = SCD + 16384;
    const int lane = lane_id();
    for (int w = F.vcu * NWAVES + F.wave; w < T_ * 2; w += F.G * NWAVES) {
        const int t = w >> 1; const size_t pid = (size_t)w * 64 + lane;
        const float ssq = lane < 16 ? SSQ[(size_t)t * 16 + lane] : 0.f;
        const float rstd = rsqrtf(wave_sum(ssq) * (1.f / 1024.f) + EPS);
        float pre = 0.f;
#pragma unroll
        for (int s = 0; s < 8; ++s) pre += PART[(size_t)s * T_ * 128 + pid];
        const int id = IDX[pid];
        GATE[pid] = gelu_erf(pre * SCD[id] * rstd) * GATE[pid] * SCU[id];
    }
}
constexpr int PE_PD = 8;
struct Row6 { v4u a; unsigned long long b; };
#define PE_ID1(P) __builtin_amdgcn_readlane(((P) & 64) ? idx_hi : idx_lo, (P) & 63)
#define PE_LOAD6(SLOT, TAB, IDA, IDB) do { const int id_ = upper ? (IDB) : (IDA); const unsigned char* rp_ = (TAB) + (size_t)id_ * 768; \
        SLOT.a = *(const v4u*)(rp_ + 16 * l31); SLOT.b = *(const unsigned long long*)(rp_ + 512 + 8 * l31); } while (0)
__device__ __forceinline__ v32f dec6(const Row6& r) { const v6u p = {r.a.x, r.a.y, r.a.z, r.a.w, (unsigned)r.b, (unsigned)(r.b >> 32)}; return __builtin_amdgcn_cvt_scalef32_pk32_f32_fp6(p, 1.0f); }
__device__ __forceinline__ void peer_up_tm(Frame& F, const Ptrs& P) {
    const bf16* HB = (const bf16*)(P.ws + WS_ST); const unsigned char* EU = P.ws + WS_EU;
    const int* IDX = (const int*)(P.ws + WS_IDX); const float* GATE = (const float*)(P.ws + WS_GATE); const float* PART = (const float*)(P.ws + WS_PART);
    const float* SCD = (const float*)(P.ws + WS_SMALL); const float* SCU = SCD + 16384;
    const int lane = lane_id(), l31 = lane & 31; const bool upper = lane >= 32;
    const int t0 = F.vcu * NWAVES + F.wave, tstep = F.G * NWAVES;
    if (t0 >= T_) return;
    int idx_lo = IDX[(size_t)t0 * 128 + lane], idx_hi = IDX[(size_t)t0 * 128 + 64 + lane];
    v4u hq[4];
#pragma unroll
    for (int k = 0; k < 4; ++k) hq[k] = ((const v4u*)(HB + (size_t)t0 * DM))[4 * l31 + k];
    float g_lo = GATE[(size_t)t0 * 128 + lane], g_hi = GATE[(size_t)t0 * 128 + 64 + lane];
    float pre_lo = 0.f, pre_hi = 0.f;
#pragma unroll
    for (int s = 0; s < 8; ++s) { pre_lo += PART[((size_t)s * T_ + t0) * 128 + lane]; pre_hi += PART[((size_t)s * T_ + t0) * 128 + 64 + lane]; }
    float sdu_lo = SCD[idx_lo], sdu_hi = SCD[idx_hi], su_lo = SCU[idx_lo], su_hi = SCU[idx_hi];
    Row6 ra[PE_PD];
#pragma unroll
    for (int j = 0; j < PE_PD; ++j) PE_LOAD6(ra[j], EU, __builtin_amdgcn_readlane(idx_lo, 2 * j), __builtin_amdgcn_readlane(idx_lo, 2 * j + 1));
    for (int t = t0; t < T_; t += tstep) {
        const int tn = (t + tstep < T_) ? t + tstep : t;
        const int nidx_lo = IDX[(size_t)tn * 128 + lane], nidx_hi = IDX[(size_t)tn * 128 + 64 + lane];
        v4u nh[4];
#pragma unroll
        for (int k = 0; k < 4; ++k) nh[k] = ((const v4u*)(HB + (size_t)tn * DM))[4 * l31 + k];
        const float ng_lo = GATE[(size_t)tn * 128 + lane], ng_hi = GATE[(size_t)tn * 128 + 64 + lane];
        float npart_lo[8], npart_hi[8];
#pragma unroll
        for (int s = 0; s < 8; ++s) { npart_lo[s] = PART[((size_t)s * T_ + tn) * 128 + lane]; npart_hi[s] = PART[((size_t)s * T_ + tn) * 128 + 64 + lane]; }
        float hv[32];
#pragma unroll
        for (int k = 0; k < 4; ++k) { hv[8 * k] = bflo(hq[k].x); hv[8 * k + 1] = bfhi(hq[k].x); hv[8 * k + 2] = bflo(hq[k].y); hv[8 * k + 3] = bfhi(hq[k].y); hv[8 * k + 4] = bflo(hq[k].z); hv[8 * k + 5] = bfhi(hq[k].z); hv[8 * k + 6] = bflo(hq[k].w); hv[8 * k + 7] = bfhi(hq[k].w); }
        float ssq = 0.f;
#pragma unroll
        for (int i = 0; i < 32; ++i) ssq = fmaf(hv[i], hv[i], ssq);
        ssq += swz_xor<1>(ssq); ssq += swz_xor<2>(ssq); ssq += swz_xor<4>(ssq); ssq += swz_xor<8>(ssq); ssq += swz_xor<16>(ssq);
        const float rstd = rsqrtf(ssq * (1.f / 1024.f) + EPS);
        const float act_lo = gelu_erf(pre_lo * sdu_lo * rstd) * g_lo * su_lo, act_hi = gelu_erf(pre_hi * sdu_hi * rstd) * g_hi * su_hi;
        float acc[32];
#pragma unroll
        for (int i = 0; i < 32; ++i) acc[i] = 0.f;
#pragma unroll
        for (int g = 0; g < 2; ++g) {
            const float actv = g ? act_hi : act_lo;
#pragma unroll
            for (int j = 0; j < 32; ++j) {
                const int q = 32 * g + j;
                const float aA = __uint_as_float(__builtin_amdgcn_readlane(__float_as_uint(actv), 2 * j)), aB = __uint_as_float(__builtin_amdgcn_readlane(__float_as_uint(actv), 2 * j + 1));
                const float a = upper ? aB : aA;
                { const v32f d = dec6(ra[q % PE_PD]);
#pragma unroll
                  for (int i = 0; i < 32; ++i) acc[i] = fmaf(a, d[i], acc[i]); }
                asm volatile("" : "+v"(acc[0]), "+v"(acc[1]), "+v"(acc[2]), "+v"(acc[3]), "+v"(acc[4]), "+v"(acc[5]), "+v"(acc[6]), "+v"(acc[7]), "+v"(acc[8]), "+v"(acc[9]), "+v"(acc[10]), "+v"(acc[11]), "+v"(acc[12]), "+v"(acc[13]), "+v"(acc[14]), "+v"(acc[15]));
                asm volatile("" : "+v"(acc[16]), "+v"(acc[17]), "+v"(acc[18]), "+v"(acc[19]), "+v"(acc[20]), "+v"(acc[21]), "+v"(acc[22]), "+v"(acc[23]), "+v"(acc[24]), "+v"(acc[25]), "+v"(acc[26]), "+v"(acc[27]), "+v"(acc[28]), "+v"(acc[29]), "+v"(acc[30]), "+v"(acc[31]));
                if (q + PE_PD < 64) PE_LOAD6(ra[q % PE_PD], EU, PE_ID1(2 * (q + PE_PD)), PE_ID1(2 * (q + PE_PD) + 1));
                else PE_LOAD6(ra[q % PE_PD], EU, __builtin_amdgcn_readlane(nidx_lo, 2 * (q + PE_PD - 64)), __builtin_amdgcn_readlane(nidx_lo, 2 * (q + PE_PD - 64) + 1));
                __builtin_amdgcn_sched_barrier(0);
            }
        }
        { float a = 0.f, c = 0.f;
#pragma unroll
          for (int s = 0; s < 8; ++s) { a += npart_lo[s]; c += npart_hi[s]; }
          pre_lo = a; pre_hi = c; }
        sdu_lo = SCD[nidx_lo]; sdu_hi = SCD[nidx_hi]; su_lo = SCU[nidx_lo]; su_hi = SCU[nidx_hi];
        float s2 = 0.f;
#pragma unroll
        for (int i = 0; i < 32; ++i) { acc[i] = sum_halves(acc[i]) + hv[i]; s2 = fmaf(acc[i], acc[i], s2); }
        s2 += swz_xor<1>(s2); s2 += swz_xor<2>(s2); s2 += swz_xor<4>(s2); s2 += swz_xor<8>(s2); s2 += swz_xor<16>(s2);
        const float r2 = rsqrtf(s2 * (1.f / 1024.f) + EPS);
        const float4* wf = (const float4*)(P.norm_final) + 8 * l31 + 4 * (lane >> 5); float4* o = (float4*)(P.out + (size_t)t * DM) + 8 * l31 + 4 * (lane >> 5);
#pragma unroll
        for (int k = 0; k < 4; ++k) { const float4 w = wf[k];
            const float e0 = upper ? acc[16 + 4 * k] : acc[4 * k], e1 = upper ? acc[17 + 4 * k] : acc[4 * k + 1], e2 = upper ? acc[18 + 4 * k] : acc[4 * k + 2], e3 = upper ? acc[19 + 4 * k] : acc[4 * k + 3];
            o[k] = make_float4(e0 * r2 * w.x, e1 * r2 * w.y, e2 * r2 * w.z, e3 * r2 * w.w); }
        idx_lo = nidx_lo; idx_hi = nidx_hi; g_lo = ng_lo; g_hi = ng_hi;
#pragma unroll
        for (int k = 0; k < 4; ++k) hq[k] = nh[k];
    }
}
constexpr int TK_LDK = 136, TK_K2 = 34816, TK_SCR = 69632, TK_SP = 49;
__device__ __forceinline__ int mono_key(float x) { const int b = __float_as_int(x); return b ^ ((b >> 31) & 0x7fffffff); }
__device__ __forceinline__ float unmono(int m) { return __int_as_float(m ^ ((m >> 31) & 0x7fffffff)); }
__device__ __forceinline__ int max3i(int a, int b, int c) { return max(max(a, b), c); }
#define CEX(A, I, J) do { const int hi_ = max(A[I], A[J]), lo_ = min(A[I], A[J]); A[I] = hi_; A[J] = lo_; } while (0)
template <int N, int OFF, int K, int J, int LEN> struct BitonicStep {
    static __device__ __forceinline__ void run(int (&a)[LEN]) {
#pragma unroll
        for (int i = 0; i < N; ++i) { const int l = i ^ J; if (l > i) { if ((i & K) == 0) CEX(a, OFF + i, OFF + l); else CEX(a, OFF + l, OFF + i); } }
        if constexpr (J > 1) BitonicStep<N, OFF, K, (J >> 1), LEN>::run(a);
        else if constexpr (K < N) BitonicStep<N, OFF, (K << 1), K, LEN>::run(a);
    }
};
template <int N, int OFF, int LEN> __device__ __forceinline__ void bitonic_sort_desc(int (&a)[LEN]) { BitonicStep<N, OFF, 2, 1, LEN>::run(a); }
template <int OFF, int LEN> __device__ __forceinline__ void bitonic_merge16_desc(int (&a)[LEN]) { BitonicStep<16, OFF, 16, 8, LEN>::run(a); }
template <int A, int B, int LEN> __device__ __forceinline__ void merge_top16(int (&a)[LEN]) {
#pragma unroll
    for (int i = 0; i < 16; ++i) a[A + i] = max(a[A + i], a[B + 15 - i]);
    bitonic_merge16_desc<A, LEN>(a);
}
template <int LEN> __device__ __forceinline__ void pair_top16(int (&a)[LEN]) {
    int lo[16], up[16];
#pragma unroll
    for (int i = 0; i < 16; ++i) { const auto rr = __builtin_amdgcn_permlane32_swap((unsigned)a[i], (unsigned)a[i], false, false); lo[i] = (int)rr[0]; up[i] = (int)rr[1]; }
#pragma unroll
    for (int i = 0; i < 16; ++i) a[i] = max(lo[i], up[15 - i]);
    bitonic_merge16_desc<0, LEN>(a);
}
__device__ __forceinline__ void topk_phase(Frame& F, const Ptrs& P) {
    const bf16* Q = (const bf16*)(P.ws + WS_PROJ); const float* SSQ = (const float*)(P.ws + WS_SSQ);
    int* IDX = (int*)(P.ws + WS_IDX); float* GATE = (float*)(P.ws + WS_GATE);
    LAS unsigned char* L = F.lds + RING_OFF;
    LAS bf16* K1 = (LAS bf16*)L; LAS bf16* K2 = (LAS bf16*)(L + TK_K2);
    const int tid_ = (F.wave * 64 + lane_id());
    for (int i = tid_; i < 16384; i += 512) { const int n = i >> 7, k = i & 127; K1[n * TK_LDK + k] = (bf16)f2bf(P.sk1[i]); K2[n * TK_LDK + k] = (bf16)f2bf(P.sk2[i]); }
    __syncthreads();
    const int lane = tid_ & 63, r = lane & 31, hh = lane >> 5;
    LAS int* scr = (LAS int*)(L + TK_SCR) + F.wave * (32 * TK_SP) + r * TK_SP;
    for (int wq = F.vcu * NWAVES + F.wave; wq < 2048; wq += F.G * NWAVES) {
        const int t = (wq >> 2) * 32 + r;
        float rstd;
        { const float4* sp = (const float4*)(SSQ + (size_t)t * 16); const float4 a = sp[0], b = sp[1], c = sp[2], d = sp[3];
          rstd = rsqrtf(((a.x + a.y + a.z + a.w) + (b.x + b.y + b.z + b.w) + (c.x + c.y + c.z + c.w) + (d.x + d.y + d.z + d.w)) * (1.f / 1024.f) + EPS); }
#pragma unroll 1
        for (int hq = 0; hq < 2; ++hq) {
            const int hd = (wq & 3) * 2 + hq;
#pragma unroll 1
            for (int half = 0; half < 2; ++half) {
                const LAS bf16* Kh = half ? K2 : K1;
                bf16x8 qf[8];
#pragma unroll
                for (int kk = 0; kk < 8; ++kk) qf[kk] = *(const bf16x8*)(Q + (size_t)t * 2048 + hd * 256 + half * 128 + 16 * kk + 8 * hh);
                int key[64];
#pragma unroll
                for (int nt = 0; nt < 4; ++nt) {
                    f32x16 sc;
#pragma unroll
                    for (int i = 0; i < 16; ++i) sc[i] = 0.f;
#pragma unroll
                    for (int kk = 0; kk < 8; ++kk) { const bf16x8 a = *(const LAS bf16x8*)(Kh + (32 * nt + r) * TK_LDK + 16 * kk + 8 * hh); sc = MFMA32(a, qf[kk], sc); }
#pragma unroll
                    for (int i = 0; i < 16; ++i) key[nt * 16 + i] = (mono_key(sc[i]) & ~127) | (127 - (32 * nt + crow(i, hh)));
                }
                bitonic_sort_desc<16, 0, 64>(key); bitonic_sort_desc<16, 16, 64>(key); bitonic_sort_desc<16, 32, 64>(key); bitonic_sort_desc<16, 48, 64>(key);
                merge_top16<0, 16, 64>(key); merge_top16<32, 48, 64>(key); merge_top16<0, 32, 64>(key);
                pair_top16<64>(key);
                if (hh == 0) {
#pragma unroll
                    for (int i = 0; i < 16; ++i) scr[half * 16 + i] = key[i]; }
            }
            const LAS int* la = scr + hh * 16; const LAS int* lb = scr + (1 - hh) * 16;
            float va[4], vb[16];
#pragma unroll
            for (int i = 0; i < 4; ++i) va[i] = unmono(la[i] & ~127);
#pragma unroll
            for (int j = 0; j < 16; ++j) vb[j] = unmono(lb[j] & ~127);
            int ck[32];
            {
                int q = 0;
#pragma unroll
                for (int i = 0; i < 4; ++i)
#pragma unroll
                    for (int j = i; j < 16; ++j) if ((i + 1) * (j + 1) <= 16) {
                        const int pos = hh ? (j * 16 + i) : (i * 16 + j);
                        int k = (mono_key(va[i] + vb[j]) & ~255) | (255 - pos);
                        if (i == j && hh) k = (int)0x80000000;
                        ck[q++] = k; }
#pragma unroll
                for (int i = 27; i < 32; ++i) ck[i] = (int)0x80000000;
            }
            bitonic_sort_desc<32, 0, 32>(ck);
            pair_top16<32>(ck);
            const float vmax = unmono(ck[0] & ~255) * rstd;
            float ev[8]; int id[8]; float esum = 0.f; const int hm = -hh;
#pragma unroll
            for (int q = 0; q < 8; ++q) { const int wk = ck[q] ^ ((ck[q] ^ ck[8 + q]) & hm); const int pos = 255 - (wk & 255);
                const int n1 = 127 - (scr[pos >> 4] & 127), n2 = 127 - (scr[16 + (pos & 15)] & 127);
                id[q] = n1 * 128 + n2;
                ev[q] = exp2f((unmono(wk & ~255) * rstd - vmax) * LOG2E); esum += ev[q]; }
            esum = sum_halves(esum);
            const float inv = 1.f / esum;
            int4* ip = (int4*)(IDX + ((size_t)t * 8 + hd) * 16 + hh * 8); float4* gp = (float4*)(GATE + ((size_t)t * 8 + hd) * 16 + hh * 8);
            ip[0] = make_int4(id[0], id[1], id[2], id[3]); ip[1] = make_int4(id[4], id[5], id[6], id[7]);
            gp[0] = make_float4(ev[0] * inv, ev[1] * inv, ev[2] * inv, ev[3] * inv); gp[1] = make_float4(ev[4] * inv, ev[5] * inv, ev[6] * inv, ev[7] * inv);
        }
    }
    __syncthreads();
}

constexpr int AT_KP = 72, AT_VP = 264;
constexpr int AT_K = 0, AT_VT = 36864, AT_BT = 36864 + 33792;
__device__ __forceinline__ void attn_phase(Frame& F, const Ptrs& P) {
    const bf16* PROJ = (const bf16*)(P.ws + WS_PROJ); bf16* CAT = (bf16*)(P.ws + WS_XN);
    LAS unsigned char* L = F.lds + RING_OFF;
    LAS bf16* Ks = (LAS bf16*)(L + AT_K); LAS bf16* Vt = (LAS bf16*)(L + AT_VT); LAS float* btab = (LAS float*)(L + AT_BT);
    const int lane = lane_id(), tid_ = F.wave * 64 + lane, r = lane & 31, hh = lane >> 5;
    for (int u = F.vcu; u < 256; u += F.G) {
        const int hkv = u & 1, n = (u >> 1) & 31, b = u >> 6;
        const int trow0 = b * SEQ + n * 128;
        for (int i = tid_; i < 2048; i += 512) {
            const int kj = i >> 3, ch = i & 7; const bool ok = (n > 0) || (kj >= 128);
            v4u kv = {0u, 0u, 0u, 0u}, vv = {0u, 0u, 0u, 0u};
            if (ok) { const bf16* rowp = PROJ + (size_t)(trow0 - 128 + kj) * NPROJ + hkv * 64 + ch * 8; kv = *(const v4u*)(rowp + PJ_K); vv = *(const v4u*)(rowp + PJ_V); }
            *(LAS v4u*)(Ks + kj * AT_KP + ch * 8) = kv;
            LAS bf16* vp = Vt + (ch * 8) * AT_VP + kj;
            vp[0] = (bf16)(vv.x & 0xffffu); vp[AT_VP] = (bf16)(vv.x >> 16); vp[2 * AT_VP] = (bf16)(vv.y & 0xffffu); vp[3 * AT_VP] = (bf16)(vv.y >> 16);
            vp[4 * AT_VP] = (bf16)(vv.z & 0xffffu); vp[5 * AT_VP] = (bf16)(vv.z >> 16); vp[6 * AT_VP] = (bf16)(vv.w & 0xffffu); vp[7 * AT_VP] = (bf16)(vv.w >> 16);
        }
        for (int i = tid_; i < 768; i += 512) { const int gg = i / 192, dist = i % 192 - 32;
            btab[i] = (dist >= 0 && dist < 128) ? P.rel_bias[c_bucket[dist & 127] * 8 + hkv * 4 + gg] * LOG2E : 0.f; }
        __syncthreads();
        const int g = F.wave & 3, h = hkv * 4 + g;
        const float sink2 = P.sinks[h] * LOG2E;
#pragma unroll 1
        for (int qq = 0; qq < 2; ++qq) {
            const int qt = (F.wave >> 2) * 2 + qq, t = trow0 + 32 * qt + r;
            bf16x8 qf[4];
#pragma unroll
            for (int kk = 0; kk < 4; ++kk) qf[kk] = *(const bf16x8*)(PROJ + (size_t)t * NPROJ + h * 64 + 16 * kk + 8 * hh);
            f32x16 sc[5];
#pragma unroll
            for (int j = 0; j < 5; ++j) {
#pragma unroll
                for (int i = 0; i < 16; ++i) sc[j][i] = 0.f;
#pragma unroll
                for (int kk = 0; kk < 4; ++kk) { const bf16x8 a = *(const LAS bf16x8*)(Ks + (32 * (qt + j) + r) * AT_KP + 16 * kk + 8 * hh); sc[j] = MFMA32(a, qf[kk], sc[j]); }
            }
            float m = sink2;
            const LAS float* bt = btab + g * 192 + 160 + r - 4 * hh;
#pragma unroll
            for (int j = 0; j < 5; ++j) {
                const bool tile_ok = (n > 0) || (qt + j >= 4);
#pragma unroll
                for (int i = 0; i < 16; ++i) { const int dist = 128 + r - (32 * j + crow(i, hh));
                    const bool ok = tile_ok && (j == 0 ? dist < 128 : (j == 4 ? dist >= 0 : true));
                    const float s = sc[j][i] * (0.125f * LOG2E) + bt[-(32 * j + (i & 3) + 8 * (i >> 2))];
                    sc[j][i] = ok ? s : -INFINITY; m = fmaxf(m, sc[j][i]); }
            }
            m = max_halves(m);
            float l = 0.f;
#pragma unroll
            for (int j = 0; j < 5; ++j)
#pragma unroll
                for (int i = 0; i < 16; ++i) { sc[j][i] = exp2f(sc[j][i] - m); l += sc[j][i]; }
            l = sum_halves(l);
            l += exp2f(sink2 - m);
            const float inv = 1.f / l;
            f32x16 o[2];
#pragma unroll
            for (int i = 0; i < 16; ++i) { o[0][i] = 0.f; o[1][i] = 0.f; }
#pragma unroll
            for (int j = 0; j < 5; ++j)
#pragma unroll
                for (int sg = 0; sg < 2; ++sg) {
                    const bf16x8 pf = pack8(sc[j], sg);
#pragma unroll
                    for (int dt = 0; dt < 2; ++dt) {
                        const LAS bf16* vb = Vt + (32 * dt + r) * AT_VP + 32 * (qt + j) + 16 * sg + 4 * hh;
                        const s16x4 lo = *(const LAS s16x4*)(vb), hi = *(const LAS s16x4*)(vb + 8);
                        o[dt] = MFMA32(__builtin_shufflevector(lo, hi, 0, 1, 2, 3, 4, 5, 6, 7), pf, o[dt]);
                    }
                }
            bf16* op = CAT + (size_t)t * DM + h * 64 + 4 * hh;
#pragma unroll
            for (int dt = 0; dt < 2; ++dt)
#pragma unroll
                for (int g4 = 0; g4 < 4; ++g4)
                    *(unsigned long long*)(op + 32 * dt + 8 * g4) = (unsigned long long)cvtpk(o[dt][4 * g4] * inv, o[dt][4 * g4 + 1] * inv) | ((unsigned long long)cvtpk(o[dt][4 * g4 + 2] * inv, o[dt][4 * g4 + 3] * inv) << 32);
        }
        __syncthreads();
    }
}
struct Args { Ptrs p; };
__global__ void __launch_bounds__(NWAVES * 64, 2) hymba_fwd(Args args) {
    extern __shared__ __attribute__((aligned(16))) unsigned char lds[];
    const Ptrs& P = args.p;
    Frame F;
    F.lds = (LAS unsigned char*)lds;
    F.MISC = (volatile LAS unsigned*)(F.lds + MISC_OFF);
    F.wave = __builtin_amdgcn_readfirstlane(threadIdx.x >> 6);
    F.G = gridDim.x; { const int bx = blockIdx.x; F.vcu = (F.G % 8 == 0) ? (bx % 8) * (F.G / 8) + bx / 8 : bx; }
    F.ctl = (gu32*)(P.ws + WS_CTL);
    for (int u = threadIdx.x; u < (LDS_BYTES - LDSCTL_OFF) / 4; u += NWAVES * 64) ((LAS unsigned*)(F.lds + LDSCTL_OFF))[u] = 0u;
    __syncthreads();
    XcdBarrier bar = xcd_barrier_post((unsigned*)(F.ctl + CW_BAR), F.MISC + 8);
#define GRID_BAR() xcd_barrier(bar)

    bf16* XN = (bf16*)(P.ws + WS_XN); bf16* PROJ = (bf16*)(P.ws + WS_PROJ); bf16* HB = (bf16*)(P.ws + WS_ST);
    p0_prologue(F, P);
    GRID_BAR();
    { pg8::Gemm g{XN, (const bf16*)(P.ws + WS_WIN), T_, NPROJ, DM, F.wave}; pg8::StaticOrder S; S.init(T_, NPROJ, F.G, (int)blockIdx.x);
      pg8::EpiBf16<0> E{PROJ, NPROJ, nullptr, 0, 0, 1.f};
      pg8::gemm_phase<pg8::EpiBf16<0>, pg8::StaticOrder, PG8_ALIGN, PG8_SP2>(F.lds + RING_OFF, g, S, E); }
    if (F.G == 256 && blockIdx.x >= 64) quant_fp6u(P, lane_id(), 0, 8192, ((int)blockIdx.x - 64) * NWAVES + F.wave, 192 * NWAVES);
    else if (F.G != 256) quant_fp6u(P, lane_id(), 0, 8192, F.vcu * NWAVES + F.wave, F.G * NWAVES);
    GRID_BAR();
    ssd_s1(F, P);
    attn_phase(F, P);
    GRID_BAR();
    ssd_s2(F, P);
    GRID_BAR();
    ssd_s3(F, P);
    GRID_BAR();
    { pg8::Gemm g{XN, (const bf16*)(P.ws + WS_WOUT), T_, DM, DM, F.wave}; pg8::StaticOrder S; S.init(T_, DM, F.G, (int)blockIdx.x);
      EpiResH E{P.x, HB, (float*)(P.ws + WS_SSQ)};
      pg8::gemm_phase<EpiResH, pg8::StaticOrder, PG8_ALIGN, PG8_SP2>(F.lds + RING_OFF, g, S, E); }
    GRID_BAR();
    { pg8::Gemm g{HB, (const bf16*)(P.ws + WS_WQ), T_, 2048, DM, F.wave}; pg8::StaticOrder S; S.init(T_, 2048, F.G, (int)blockIdx.x);
      pg8::EpiBf16<0> E{PROJ, 2048, nullptr, 0, 0, 1.f};
      pg8::gemm_phase<pg8::EpiBf16<0>, pg8::StaticOrder, PG8_ALIGN, PG8_SP2>(F.lds + RING_OFF, g, S, E); }
    GRID_BAR();
    topk_phase(F, P);
    h_quant_rows(F, P);
    GRID_BAR();
    { const PeerPlace pp = peer_place(F);
      peer_down(F, P, pp); }
    GRID_BAR();
    peer_up_tm(F, P);
}

extern "C" void kernel_launch(void* const* d_in, const int* in_sizes, int n_in, void* d_out, int out_size, void* d_ws, size_t ws_size, hipStream_t stream) {
    static int grid = 0;
    if (grid == 0) {
        if (n_in != 19 || out_size != T_ * DM || ws_size < WS_END) { fprintf(stderr, "kernel_launch: unexpected shapes (n_in %d, out %d, ws %zu)\n", n_in, out_size, ws_size); grid = -1; return; }
        int dev = 0, cus = 0, per_cu = 0;
        if (hipGetDevice(&dev) != hipSuccess || hipDeviceGetAttribute(&cus, hipDeviceAttributeMultiprocessorCount, dev) != hipSuccess) { grid = -1; return; }
        if (hipFuncSetAttribute((const void*)hymba_fwd, hipFuncAttributeMaxDynamicSharedMemorySize, LDS_BYTES) != hipSuccess) { fprintf(stderr, "kernel_launch: hipFuncSetAttribute failed\n"); grid = -1; return; }
        if (hipOccupancyMaxActiveBlocksPerMultiprocessor(&per_cu, (const void*)hymba_fwd, NWAVES * 64, LDS_BYTES) != hipSuccess || per_cu < 1) { fprintf(stderr, "kernel_launch: occupancy query says %d blocks per CU\n", per_cu); grid = -1; (void)hipGetLastError(); return; }
        grid = cus;
    }
    if (grid < 0) return;
    (void)hipMemsetAsync((char*)d_ws + WS_CTL, 0, CTL_ZERO_BYTES, stream);
    Args a{};
    const float** pp = (const float**)&a.p;
    for (int i = 0; i < 19; ++i) pp[i] = (const float*)d_in[i];
    a.p.out = (float*)d_out; a.p.ws = (unsigned char*)d_ws;
    hipLaunchKernelGGL(hymba_fwd, dim3(grid), dim3(NWAVES * 64), LDS_BYTES, stream, a);
}
```

```cpp
#include <hip/hip_runtime.h>
#include <cstdio>
#include <cstdint>
#include <math.h>
namespace pg8 {
#define PG8_LAS __attribute__((address_space(3)))
typedef unsigned short bf16_t;
typedef short bf16x8 __attribute__((ext_vector_type(8)));
typedef float f32x4 __attribute__((ext_vector_type(4)));
typedef unsigned u32x4 __attribute__((ext_vector_type(4)));
constexpr int BM = 256, BK = 64, HALF = 128, HTB = HALF * BK * 2  , STAGE_BYTES = 8 * HTB, NXCD = 8, WGM = 8;

__host__ __device__ __forceinline__ int lds_byte(int r, int c) { const int st = (r >> 4) * 2 + (c >> 5), rr = r & 15, cc = c & 31, ob = rr * 64 + cc * 2; return st * 1024 + (ob ^ (((ob >> 9) & 1) << 5)); }
__host__ __device__ __forceinline__ void stage_rc(int b, int& R, int& C) { const int st = b / 1024, sb = b % 1024, swz = sb ^ (((sb >> 9) & 1) << 5); R = (st >> 1) * 16 + swz / 64; C = (st & 1) * 32 + (swz % 64) / 2; }
__host__ __device__ __forceinline__ int perm32(int rho) { const int n = rho >> 4, i = rho & 15; return 8 * (i >> 2) + 4 * n + (i & 3); }

struct Unit { int pm, pn; };
struct Gemm { const bf16_t* A; const bf16_t* Bt; int M, N, K, wave; };

struct StaticOrder {
    int nM, nN, nwg, G, c;
    __host__ __device__ void init(int M, int N, int G_, int c_) { nM = M / BM; nN = N / BM; nwg = nM * nN; G = G_; c = c_; }
    __host__ __device__ bool next(int i, Unit& u) const {
        const long L = (long)i * G + c; if (L >= nwg) return false;
        int wgid = (int)L; { const int q = nwg / NXCD, r = nwg % NXCD, xcd = wgid % NXCD, off = wgid / NXCD; wgid = (xcd < r ? xcd * (q + 1) : r * (q + 1) + (xcd - r) * q) + off; }
        const int nig = WGM * nN, gid = wgid / nig, fm = gid * WGM, gsz = (nM - fm) < WGM ? (nM - fm) : WGM;
        u.pm = fm + ((wgid % nig) % gsz); u.pn = (wgid % nig) / gsz; return true;
    }
    __device__ __forceinline__ void a_ready(const Unit&) const {}
    __device__ __forceinline__ void done(const Unit&) const {}
};

__device__ __forceinline__ unsigned cvt_pk_bf16(float lo, float hi) { unsigned r; asm volatile("v_cvt_pk_bf16_f32 %0, %1, %2" : "=v"(r) : "v"(lo), "v"(hi)); return r; }
typedef float f32x2 __attribute__((ext_vector_type(2)));
__device__ __forceinline__ f32x2 gelu_pk(f32x2 v) {
    const f32x2 av = __builtin_elementwise_abs(v), d = av * 0.2316418882f + 1.0f;
    f32x2 t; t.x = __builtin_amdgcn_rcpf(d.x); t.y = __builtin_amdgcn_rcpf(d.y);
    f32x2 q = t * 0.5307027145f + (-0.7265760135f); q = q * t + 0.7107068705f; q = q * t + (-0.142248368f); q = q * t + 0.127414796f; q = q * t;
    const f32x2 s = (v * v) * (-0.72134752044f);
    f32x2 e; e.x = __builtin_amdgcn_exp2f(s.x); e.y = __builtin_amdgcn_exp2f(s.y);
    const f32x2 m = v * (q * e), r = v - m;
    f32x2 o; o.x = v.x < 0.f ? m.x : r.x; o.y = v.y < 0.f ? m.y : r.y; return o;
}

template <int ACT  > struct EpiBf16 {
    static constexpr bool PERM = true, AFTER_DRAIN = false; static_assert(ACT == 0 || ACT == 1, "EpiBf16: ACT is 0 (none) or 1 (gelu_pk)");
    bf16_t* O; int ldc; const float* bias; int split_cols; size_t split_stride; float scale0;
    __device__ __forceinline__ void operator()(const f32x4 (&acc)[2][2][4][2], const Unit& u, int wr, int wc, int fr, int fq) const {
        const int row0 = u.pm * BM + wr * 64 + fr; int colt = u.pn * BM; bf16_t* base = O;
        float sc = 1.f; if (split_cols) { const int t = colt / split_cols; base += (size_t)t * split_stride; colt -= t * split_cols; if (t == 0) sc = scale0; }
        const int col0 = colt + wc * 32 + 8 * fq, bcol0 = u.pn * BM + wc * 32 + 8 * fq;
        f32x4 bv[2][2];
#pragma unroll
        for (int bj = 0; bj < 2; ++bj)
#pragma unroll
            for (int n = 0; n < 2; ++n) bv[bj][n] = bias ? *(const f32x4*)(bias + bcol0 + bj * HALF + 4 * n) : (f32x4){0.f, 0.f, 0.f, 0.f};
#pragma unroll
        for (int ai = 0; ai < 2; ++ai)
#pragma unroll
            for (int m = 0; m < 4; ++m) { bf16_t* rowp = base + (size_t)(row0 + ai * HALF + m * 16) * ldc + col0;
#pragma unroll
                for (int bj = 0; bj < 2; ++bj) { f32x4 v0 = acc[ai][bj][m][0] + bv[bj][0], v1 = acc[ai][bj][m][1] + bv[bj][1];
                    if (ACT == 1) { f32x2 a = gelu_pk((f32x2){v0[0], v0[1]}), b = gelu_pk((f32x2){v0[2], v0[3]}), c = gelu_pk((f32x2){v1[0], v1[1]}), d = gelu_pk((f32x2){v1[2], v1[3]});
                        v0 = (f32x4){a.x, a.y, b.x, b.y}; v1 = (f32x4){c.x, c.y, d.x, d.y}; }
                    v0 = v0 * sc; v1 = v1 * sc; u32x4 w; w.x = cvt_pk_bf16(v0[0], v0[1]); w.y = cvt_pk_bf16(v0[2], v0[3]); w.z = cvt_pk_bf16(v1[0], v1[1]); w.w = cvt_pk_bf16(v1[2], v1[3]);
                    *(u32x4*)(rowp + bj * HALF) = w; } }
    }
};
template <class Epi, class Sched, bool ALIGN_EPI = false, bool SP2 = false>
__device__ __forceinline__ void gemm_phase(PG8_LAS unsigned char* lds, const Gemm g, const Sched& S, const Epi& E) {
    int lane_l; asm volatile("v_mbcnt_lo_u32_b32 %0, -1, 0\n\tv_mbcnt_hi_u32_b32 %0, -1, %0" : "=v"(lane_l));
    const int wid = g.wave, lane = lane_l, tid = wid * 64 + lane,
              wr = wid >> 2, wc = wid & 3, fr = lane & 15, fq = lane >> 4;
    const int K = g.K, nt = K / BK;
    unsigned voffA[2], voffB[2];
#pragma unroll
    for (int i = 0; i < 2; ++i) { int R, C; stage_rc(tid * 16 + i * 8192, R, C); const int Rb = Epi::PERM ? ((R & ~31) + perm32(R & 31)) : R;
        voffA[i] = (unsigned)(R * K + C) * 2u; voffB[i] = (unsigned)(Rb * K + C) * 2u; }
    const size_t kstep = (size_t)(BK * 2);
    const size_t hstep = (size_t)HALF * K * 2;
    const size_t tstep = 2 * hstep;
    const unsigned ldsw = (unsigned)wid * 1024u;
    const int aoff = lds_byte(wr * 64 + fr, fq * 8), boff = lds_byte(wc * 32 + fr, fq * 8);
#define PG8_SA(b, h) (((b) * 2 + (h)) * HTB)
#define PG8_SB(b, h) ((4 + (b) * 2 + (h)) * HTB)
#define PG8_STAGE(bufoff, gbase, voff) do { _Pragma("unroll") for (int _i = 0; _i < 2; ++_i) \
        __builtin_amdgcn_global_load_lds((const unsigned*)((const char*)(gbase) + (voff)[_i]), (PG8_LAS unsigned*)(lds + (bufoff) + ldsw + _i * 8192), 16, 0, 0); } while (0)
#define PG8_LDA(dst, b, h) do { _Pragma("unroll") for (int m = 0; m < 4; ++m) _Pragma("unroll") for (int k = 0; k < 2; ++k) dst[m][k] = *(const PG8_LAS bf16x8*)(lds + PG8_SA(b, h) + aoff + m * 2048 + k * 1024); } while (0)
#define PG8_LDB(dst, b, h) do { _Pragma("unroll") for (int n = 0; n < 2; ++n) _Pragma("unroll") for (int k = 0; k < 2; ++k) dst[n][k] = *(const PG8_LAS bf16x8*)(lds + PG8_SB(b, h) + boff + n * 2048 + k * 1024); } while (0)
#define PG8_MMA(ai, bj, At, Bt) do { __builtin_amdgcn_s_setprio(1); _Pragma("unroll") for (int m = 0; m < 4; ++m) _Pragma("unroll") for (int n = 0; n < 2; ++n) _Pragma("unroll") for (int k = 0; k < 2; ++k) \
        acc[ai][bj][m][n] = __builtin_amdgcn_mfma_f32_16x16x32_bf16(Bt[n][k], At[m][k], acc[ai][bj][m][n], 0, 0, 0); __builtin_amdgcn_s_setprio(0); } while (0)
#define PG8_WAIT_V(n) asm volatile("s_waitcnt vmcnt(" #n ")" ::: "memory")
#define PG8_WAIT_L(n) asm volatile("s_waitcnt lgkmcnt(" #n ")" ::: "memory")
#define PG8_BAR __builtin_amdgcn_s_barrier()
#define PG8_SCHED __builtin_amdgcn_sched_barrier(0)
    Unit cur, nxt; int ui = 0;
    if (!S.next(0, cur)) return;
    f32x4 acc[2][2][4][2];
#pragma unroll
    for (int a = 0; a < 2; ++a)
#pragma unroll
        for (int b = 0; b < 2; ++b)
#pragma unroll
            for (int m = 0; m < 4; ++m)
#pragma unroll
                for (int n = 0; n < 2; ++n) acc[a][b][m][n] = (f32x4){0.f, 0.f, 0.f, 0.f};
    bf16x8 At[4][2], B0[2][2], B1[2][2];
    const char* cA = (const char*)g.A + (size_t)cur.pm * tstep; const char* cB = (const char*)g.Bt + (size_t)cur.pn * tstep;
    S.a_ready(cur);
    if constexpr (SP2) {
        PG8_STAGE(PG8_SB(0, 0), cB, voffB); PG8_STAGE(PG8_SB(0, 1), cB + hstep, voffB); PG8_STAGE(PG8_SA(0, 0), cA, voffA); PG8_STAGE(PG8_SA(0, 1), cA + hstep, voffA);
        if (wr == 1) PG8_BAR;
        PG8_WAIT_V(2); PG8_BAR;
        PG8_STAGE(PG8_SB(1, 0), cB + kstep, voffB); PG8_STAGE(PG8_SA(1, 0), cA + kstep, voffA); PG8_STAGE(PG8_SB(1, 1), cB + hstep + kstep, voffB);
        PG8_WAIT_V(6); PG8_BAR;
    } else {
        PG8_STAGE(PG8_SB(0, 0), cB, voffB); PG8_STAGE(PG8_SA(0, 0), cA, voffA); PG8_STAGE(PG8_SB(0, 1), cB + hstep, voffB); PG8_STAGE(PG8_SA(0, 1), cA + hstep, voffA);
        if (wr == 1) PG8_BAR;
        PG8_WAIT_V(4); PG8_BAR;
        PG8_STAGE(PG8_SB(1, 0), cB + kstep, voffB); PG8_STAGE(PG8_SA(1, 0), cA + kstep, voffA); PG8_STAGE(PG8_SB(1, 1), cB + hstep + kstep, voffB);
        PG8_WAIT_V(6); PG8_BAR;
    }
    for (;;) {
        const bool has_next = S.next(ui + 1, nxt);
        const char* nA = has_next ? (const char*)g.A + (size_t)nxt.pm * tstep : cA; const char* nB = has_next ? (const char*)g.Bt + (size_t)nxt.pn * tstep : cB;
        for (int t = 0; t < nt; t += 2) {
            const bool last = (t == nt - 2);
            const char* a1 = cA + (size_t)(t + 1) * kstep;
            const char* a2 = last ? nA : cA + (size_t)(t + 2) * kstep; const char* b2 = last ? nB : cB + (size_t)(t + 2) * kstep;
            const char* a3 = a2 + kstep; const char* b3 = b2 + kstep;
            if (last && has_next) S.a_ready(nxt);
            if constexpr (SP2) {
            PG8_LDB(B0, 0, 0); PG8_LDB(B1, 0, 1); PG8_SCHED; PG8_LDA(At, 0, 0); PG8_STAGE(PG8_SA(1, 1), a1 + hstep, voffA);
            PG8_WAIT_V(8); PG8_WAIT_L(0); PG8_BAR; PG8_MMA(0, 0, At, B0); PG8_MMA(0, 1, At, B1); PG8_BAR; PG8_SCHED;
            PG8_LDA(At, 0, 1); PG8_STAGE(PG8_SB(0, 0), b2, voffB); PG8_STAGE(PG8_SB(0, 1), b2 + hstep, voffB); PG8_STAGE(PG8_SA(0, 0), a2, voffA);
            PG8_WAIT_V(8); PG8_WAIT_L(0); PG8_BAR; PG8_MMA(1, 0, At, B0); PG8_MMA(1, 1, At, B1); PG8_BAR; PG8_SCHED;
            PG8_LDB(B0, 1, 0); PG8_LDB(B1, 1, 1); PG8_SCHED; PG8_LDA(At, 1, 0); PG8_STAGE(PG8_SA(0, 1), a2 + hstep, voffA);
            PG8_WAIT_V(8); PG8_WAIT_L(0); PG8_BAR; PG8_MMA(0, 0, At, B0); PG8_MMA(0, 1, At, B1); PG8_BAR; PG8_SCHED;
            PG8_LDA(At, 1, 1); PG8_STAGE(PG8_SB(1, 0), b3, voffB); PG8_STAGE(PG8_SB(1, 1), b3 + hstep, voffB); PG8_STAGE(PG8_SA(1, 0), a3, voffA);
            PG8_WAIT_V(8); PG8_WAIT_L(0); PG8_BAR; PG8_MMA(1, 0, At, B0); PG8_MMA(1, 1, At, B1); PG8_BAR; PG8_SCHED;
            } else {
            PG8_LDB(B0, 0, 0); PG8_SCHED; PG8_LDA(At, 0, 0); PG8_STAGE(PG8_SA(1, 1), a1 + hstep, voffA);
            PG8_WAIT_L(8); PG8_BAR; PG8_WAIT_L(0); PG8_MMA(0, 0, At, B0); PG8_BAR; PG8_SCHED;
            PG8_LDB(B1, 0, 1); PG8_STAGE(PG8_SB(0, 0), b2, voffB);
            PG8_BAR; PG8_WAIT_L(0); PG8_MMA(0, 1, At, B1); PG8_BAR;
            PG8_LDA(At, 0, 1); PG8_STAGE(PG8_SA(0, 0), a2, voffA);
            PG8_BAR; PG8_WAIT_L(0); PG8_MMA(1, 0, At, B0); PG8_BAR; PG8_SCHED;
            PG8_STAGE(PG8_SB(0, 1), b2 + hstep, voffB);
            PG8_WAIT_V(6); PG8_BAR; PG8_MMA(1, 1, At, B1); PG8_BAR;
            PG8_LDB(B0, 1, 0); PG8_SCHED; PG8_LDA(At, 1, 0); PG8_STAGE(PG8_SA(0, 1), a2 + hstep, voffA);
            PG8_WAIT_L(8); PG8_BAR; PG8_WAIT_L(0); PG8_MMA(0, 0, At, B0); PG8_BAR; PG8_SCHED;
            PG8_LDB(B1, 1, 1); PG8_STAGE(PG8_SB(1, 0), b3, voffB);
            PG8_BAR; PG8_WAIT_L(0); PG8_MMA(0, 1, At, B1); PG8_BAR;
            PG8_LDA(At, 1, 1); PG8_STAGE(PG8_SA(1, 0), a3, voffA);
            PG8_BAR; PG8_WAIT_L(0); PG8_MMA(1, 0, At, B0); PG8_BAR; PG8_SCHED;
            PG8_STAGE(PG8_SB(1, 1), b3 + hstep, voffB);
            PG8_WAIT_V(6); PG8_BAR; PG8_MMA(1, 1, At, B1); PG8_BAR;
            }
        }
        if constexpr (ALIGN_EPI) { if (wr == 0) PG8_BAR; }
        if constexpr (!Epi::AFTER_DRAIN) { E(acc, cur, wr, wc, fr, fq); S.done(cur); }
        if (!has_next) break;
#pragma unroll
        for (int a = 0; a < 2; ++a)
#pragma unroll
            for (int b = 0; b < 2; ++b)
#pragma unroll
                for (int m = 0; m < 4; ++m)
#pragma unroll
                    for (int n = 0; n < 2; ++n) acc[a][b][m][n] = (f32x4){0.f, 0.f, 0.f, 0.f};
        cur = nxt; cA = nA; cB = nB; ++ui;
        if constexpr (ALIGN_EPI) { if (wr == 1) PG8_BAR; }
    }
    PG8_WAIT_V(0);
    if constexpr (!ALIGN_EPI) { if (wr == 0) PG8_BAR; }
    PG8_BAR;
    if constexpr (Epi::AFTER_DRAIN) { E.fused(acc, cur, wr, wc, fr, fq, lds, wid, lane); S.done(cur); }
#undef PG8_SA
#undef PG8_SB
#undef PG8_STAGE
#undef PG8_LDA
#undef PG8_LDB
#undef PG8_MMA
#undef PG8_WAIT_V
#undef PG8_WAIT_L
#undef PG8_BAR
#undef PG8_SCHED
}
}

#ifndef PG8_SP2
#define PG8_SP2 true
#endif
#ifndef PG8_ALIGN
#define PG8_ALIGN true
#endif
#define GAS __attribute__((address_space(1)))
#define LAS __attribute__((address_space(3)))
typedef unsigned short bf16;
typedef unsigned v4u __attribute__((ext_vector_type(4)));
typedef float f32x4 __attribute__((ext_vector_type(4)));
typedef short bf16x8 __attribute__((ext_vector_type(8)));
typedef GAS unsigned gu32;
typedef GAS unsigned long long gu64;
#define RLX_AGENT __ATOMIC_RELAXED, __HIP_MEMORY_SCOPE_AGENT
#define LDS_WAIT() asm volatile("s_waitcnt lgkmcnt(0)" ::: "memory")
#define VM_WAIT() asm volatile("s_waitcnt vmcnt(0)" ::: "memory")
__device__ __forceinline__ unsigned long long rt() { return __builtin_amdgcn_s_memrealtime(); }
__device__ __forceinline__ unsigned f2bf(float f) { unsigned u = __builtin_bit_cast(unsigned, f); return (u + 0x7fffu + ((u >> 16) & 1u)) >> 16; }
__device__ __forceinline__ unsigned pk2(float lo, float hi) { return f2bf(lo) | (f2bf(hi) << 16); }

#define XB_TMO      128
#define XB_XCNT(j)  (256  + 64 * (j))
#define XB_XSUB(j)  (1280 + 64 * (j))
#define XB_XGEN(j)  (2304 + 64 * (j))
#define XB_TOP      3328
#define XB_TOPGEN   3392
#define XCD_BAR_WORDS 3456
#define XB_SPIN_CAP (1u << 22)

__device__ __forceinline__ unsigned xb_ld(unsigned* p)              { return __hip_atomic_load(p, __ATOMIC_RELAXED, __HIP_MEMORY_SCOPE_AGENT); }
__device__ __forceinline__ unsigned xb_add(unsigned* p, unsigned v) { return __hip_atomic_fetch_add(p, v, __ATOMIC_RELAXED, __HIP_MEMORY_SCOPE_AGENT); }
__device__ __forceinline__ unsigned xb_xcc_id() { return (unsigned)__builtin_amdgcn_s_getreg((3 << 11) | 20) & 0xFu; }
#define XB_SPIN(cond, bar) do { unsigned _sp = 0; while (cond) { __builtin_amdgcn_s_sleep(1); \
    if ((++_sp & 255u) == 0u) { if (xb_ld(&(bar)[XB_TMO])) break; if (_sp > XB_SPIN_CAP) { atomicAdd(&(bar)[XB_TMO], 1u); break; } } } } while (0)

struct XcdBarrier {
    unsigned* bar; unsigned x;
    volatile LAS unsigned* st;
};

__device__ __forceinline__ XcdBarrier xcd_barrier_post(unsigned* bar, volatile LAS unsigned* st) {
    XcdBarrier b; b.bar = bar; b.x = xb_xcc_id(); b.st = st;
    if (threadIdx.x == 0) (void)xb_add(&bar[XB_XCNT(b.x)], 1u);
    return b;
}
__device__ __forceinline__ void xcd_barrier_complete(unsigned* bar, unsigned x, unsigned& nloc, unsigned& nx) {
    const unsigned G = gridDim.x * gridDim.y * gridDim.z;
    unsigned sum, cnt, mine, sp = 0u;
    for (;;) {
        sum = 0u; cnt = 0u; mine = 0u;
#pragma unroll
        for (unsigned j = 0; j < 16; ++j) { const unsigned c = xb_ld(&bar[XB_XCNT(j)]); sum += c; cnt += (c > 0u) ? 1u : 0u; mine = (j == x) ? c : mine; }
        if (sum == G) break;
        __builtin_amdgcn_s_sleep(1);
        if ((++sp & 255u) == 0u) { if (xb_ld(&bar[XB_TMO])) break; if (sp > XB_SPIN_CAP) { atomicAdd(&bar[XB_TMO], 1u); break; } }
    }
    nloc = mine > 0u ? mine : 1u; nx = cnt > 0u ? cnt : 1u;
}

__device__ __forceinline__ void xcd_barrier(const XcdBarrier& b) {
    asm volatile("s_waitcnt vmcnt(0)" ::: "memory");
    __syncthreads();
    if (threadIdx.x == 0) {
        unsigned* bar = b.bar;
        __builtin_amdgcn_s_waitcnt(0);
        unsigned nloc = b.st[0], nx = b.st[1];
        if (nloc == 0u) { xcd_barrier_complete(bar, b.x, nloc, nx); b.st[0] = nloc; b.st[1] = nx; }
        const unsigned old = xb_add(&bar[XB_XSUB(b.x)], 1u);
        const unsigned gen = old / nloc;
        if (old + 1u == (gen + 1u) * nloc) {
            __builtin_amdgcn_fence(__ATOMIC_RELEASE, "agent");
            asm volatile("s_waitcnt vmcnt(0)" ::: "memory");
            const unsigned og = xb_add(&bar[XB_TOP], 1u);
            const unsigned tg = og / nx;
            if (og + 1u == (tg + 1u) * nx) xb_add(&bar[XB_TOPGEN], 1u);
            else XB_SPIN(xb_ld(&bar[XB_TOPGEN]) == tg, bar);
            __builtin_amdgcn_fence(__ATOMIC_ACQUIRE, "agent");
            xb_add(&bar[XB_XGEN(b.x)], 1u);
            asm volatile("s_waitcnt vmcnt(0)" ::: "memory");
        } else {
            XB_SPIN(xb_ld(&bar[XB_XGEN(b.x)]) == gen, bar);
            __builtin_amdgcn_fence(__ATOMIC_ACQUIRE, "agent");
            asm volatile("s_waitcnt vmcnt(0)" ::: "memory");
        }
    }
    __syncthreads();
}

constexpr int NWAVES = 8;
constexpr int T_ = 16384, SEQ = 4096, DM = 1024, NPROJ = 2304, INC = 2312;
constexpr int PJ_K = 512, PJ_V = 640, PJ_Z = 768, PJ_XBC = 1280;
constexpr float EPS = 1e-6f;
constexpr size_t MiB = 1u << 20;
constexpr size_t WS_CTL = 0, CTL_ZERO_BYTES = 1 * MiB;
constexpr size_t WS_SMALL = 1 * MiB;
constexpr size_t WS_WIN = 2 * MiB, WS_WOUT = 7 * MiB, WS_WQ = 9 * MiB;
constexpr size_t WS_ED = 13 * MiB, WS_EU = 29 * MiB;
constexpr size_t WS_XN = 77 * MiB;
constexpr size_t WS_PROJ = 109 * MiB;
constexpr size_t WS_ST = 181 * MiB;
constexpr size_t WS_IDX = 213 * MiB, WS_GATE = 221 * MiB, WS_SSQ = 229 * MiB, WS_END = 230 * MiB;
constexpr size_t DO_Y = 0, DO_DT = 41 * MiB;
constexpr size_t WS_CC = 230 * MiB, WS_DT = 238 * MiB, WS_EA = 239 * MiB, WS_CDEC = 240 * MiB, WS_PREV = WS_IDX;
constexpr size_t DO_YPF = 0, DO_YPLAIN = 32 * MiB;
constexpr size_t WS_PART = WS_PROJ;
constexpr size_t WS_H8 = WS_XN, WS_HS = WS_DT;
constexpr size_t WS_SSQ2 = WS_EA;
constexpr int CW_BAR = 4096, CW_RANK = 8192;
constexpr int RING_OFF = 0, RING_BYTES = 147456, LDSCTL_OFF = RING_BYTES, MISC_OFF = LDSCTL_OFF + 320, LDS_BYTES = 163840;

__constant__ unsigned char c_bucket[128] = {0, 1, 2, 3, 4, 5, 6, 7, 8, 9, 10, 11, 12, 13, 14, 15, 16, 16, 16, 17, 17, 18, 18, 18, 19, 19, 19, 20, 20, 20, 20, 21, 21, 21, 21, 22, 22, 22, 22, 22, 23, 23, 23, 23, 23, 23, 24, 24, 24, 24, 24, 24, 25, 25, 25, 25, 25, 25, 25, 26, 26, 26, 26, 26, 26, 26, 26, 27, 27, 27, 27, 27, 27, 27, 27, 27, 27, 28, 28, 28, 28, 28, 28, 28, 28, 28, 28, 29, 29, 29, 29, 29, 29, 29, 29, 29, 29, 29, 29, 30, 30, 30, 30, 30, 30, 30, 30, 30, 30, 30, 30, 30, 30, 31, 31, 31, 31, 31, 31, 31, 31, 31, 31, 31, 31, 31, 31, 31};

typedef float v16f __attribute__((ext_vector_type(16)));
typedef float v32f __attribute__((ext_vector_type(32)));
typedef unsigned v6u __attribute__((ext_vector_type(6)));
typedef _Float16 v32h __attribute__((ext_vector_type(32)));
struct Frame {
    LAS unsigned char* lds;
    volatile LAS unsigned* MISC;
    gu32* ctl;
    int wave, vcu, G;
};
__device__ __forceinline__ int lane_id() { int l; asm volatile("v_mbcnt_lo_u32_b32 %0, -1, 0\n\tv_mbcnt_hi_u32_b32 %0, -1, %0" : "=v"(l)); return l; }
__device__ __forceinline__ int opq(int x) { asm volatile("" : "+v"(x)); return x; }
template <int M> __device__ __forceinline__ float swz_xor(float v) { return __int_as_float(__builtin_amdgcn_ds_swizzle(__float_as_int(v), (M << 10) | 0x1F)); }
__device__ __forceinline__ float sum_halves(float v) { const auto r = __builtin_amdgcn_permlane32_swap(__float_as_uint(v), __float_as_uint(v), false, false); return __uint_as_float(r[0]) + __uint_as_float(r[1]); }
__device__ __forceinline__ float max_halves(float v) { const auto r = __builtin_amdgcn_permlane32_swap(__float_as_uint(v), __float_as_uint(v), false, false); return fmaxf(__uint_as_float(r[0]), __uint_as_float(r[1])); }
__device__ __forceinline__ int imax_halves(int v) { const auto r = __builtin_amdgcn_permlane32_swap((unsigned)v, (unsigned)v, false, false); return max((int)r[0], (int)r[1]); }
__device__ __forceinline__ float wave_sum(float v) {
    v += swz_xor<1>(v); v += swz_xor<2>(v); v += swz_xor<4>(v); v += swz_xor<8>(v); v += swz_xor<16>(v);
    return sum_halves(v);
}
__device__ __forceinline__ float bf2f(unsigned short b) { return __uint_as_float((unsigned)b << 16); }
__device__ __forceinline__ float bflo(unsigned w) { return __uint_as_float(w << 16); }
__device__ __forceinline__ float bfhi(unsigned w) { return __uint_as_float(w & 0xffff0000u); }
__device__ __forceinline__ float silu_f(float x) { return x / (1.f + __expf(-x)); }

__device__ __forceinline__ void p0_transpose_item(const float* W, int ldw, int K, int nblk, bf16* WT, const float* kscale, LAS float* scr, int item, int lane) {
    const int kb = item / nblk, nb = item % nblk, k0 = 64 * kb, n0 = 32 * nb;
#pragma unroll 8
    for (int i = 0; i < 32; ++i) { const int kk = 2 * i + (lane >> 5); float v = W[(size_t)(k0 + kk) * ldw + n0 + (lane & 31)]; if (kscale) v *= kscale[k0 + kk]; scr[kk * 33 + (lane & 31)] = v; }
    LDS_WAIT(); asm volatile("" ::: "memory");
    const int c = lane & 7;
#pragma unroll
    for (int j = 0; j < 4; ++j) { const int n = (lane >> 3) + 8 * j; const LAS float* s = scr + (8 * c) * 33 + n;
        v4u o; o.x = pk2(s[0 * 33], s[1 * 33]); o.y = pk2(s[2 * 33], s[3 * 33]); o.z = pk2(s[4 * 33], s[5 * 33]); o.w = pk2(s[6 * 33], s[7 * 33]);
        *(GAS v4u*)(WT + (size_t)(n0 + n) * K + k0 + 8 * c) = o; }
    LDS_WAIT(); asm volatile("" ::: "memory");
}
struct Ptrs {
    const float *x, *norm_mix, *w_in, *conv_w, *conv_b, *dt_bias, *a_log, *d_skip, *ssd_norm_w, *sinks, *w_out, *rel_bias, *norm_ffn, *w_query, *sk1, *sk2, *e_down, *e_up, *norm_final;
    float* out; unsigned char* ws;
};
constexpr int Q_SPLIT = 16384;
__device__ __forceinline__ unsigned pack4_i8(float a, float b, float c, float d) {
    const int ia = __float2int_rn(a), ib = __float2int_rn(b), ic = __float2int_rn(c), id = __float2int_rn(d);
    return (unsigned)(ia & 0xff) | ((unsigned)(ib & 0xff) << 8) | ((unsigned)(ic & 0xff) << 16) | ((unsigned)(id & 0xff) << 24);
}
__device__ __forceinline__ void quant_fp8s(const Ptrs& P, int lane_, int r_lo, int r_hi, int w, int nw) {
    float* SC = (float*)(P.ws + WS_SMALL);
    for (int row = r_lo + w; row < r_hi; row += nw) {
        const int e = row & 16383;
        const float4* src = (const float4*)(P.e_down + (size_t)e * DM) + 4 * lane_;
        float v[16];
#pragma unroll
        for (int q = 0; q < 4; ++q) { const float4 t = src[q]; const float4 w4 = ((const float4*)P.norm_ffn)[4 * lane_ + q]; v[4 * q] = t.x * w4.x; v[4 * q + 1] = t.y * w4.y; v[4 * q + 2] = t.z * w4.z; v[4 * q + 3] = t.w * w4.w; }
        float am = 0.f;
#pragma unroll
        for (int q = 0; q < 16; ++q) am = fmaxf(am, fabsf(v[q]));
        am = fmaxf(am, swz_xor<1>(am)); am = fmaxf(am, swz_xor<2>(am)); am = fmaxf(am, swz_xor<4>(am)); am = fmaxf(am, swz_xor<8>(am)); am = fmaxf(am, swz_xor<16>(am)); am = max_halves(am);
        am = fmaxf(am, 1e-30f);
        const float inv = 127.f / am;
        v4u o; o.x = pack4_i8(v[0] * inv, v[1] * inv, v[2] * inv, v[3] * inv); o.y = pack4_i8(v[4] * inv, v[5] * inv, v[6] * inv, v[7] * inv);
        o.z = pack4_i8(v[8] * inv, v[9] * inv, v[10] * inv, v[11] * inv); o.w = pack4_i8(v[12] * inv, v[13] * inv, v[14] * inv, v[15] * inv);
        *(v4u*)(P.ws + WS_ED + ((size_t)(lane_ >> 3) * 16384 + e) * 128 + (lane_ & 7) * 16) = o;
        if (lane_ == 0) SC[row] = am * (1.f / 127.f);
    }
}
typedef float f32x2q __attribute__((ext_vector_type(2)));
__device__ __forceinline__ void quant_fp6u(const Ptrs& P, int lane_, int q_lo, int q_hi, int w, int nw) {
    { float* SC = (float*)(P.ws + WS_SMALL); const int l31 = lane_ & 31, hf = lane_ >> 5;
      for (int q = q_lo + w; q < q_hi; q += nw) {
        const int e = 2 * q + hf, row = 16384 + e;
        const float4* src = (const float4*)(P.e_up + (size_t)e * DM) + 8 * l31;
        float v[32];
#pragma unroll
        for (int k = 0; k < 8; ++k) { const float4 t = src[k]; v[4 * k] = t.x; v[4 * k + 1] = t.y; v[4 * k + 2] = t.z; v[4 * k + 3] = t.w; }
        float am = 0.f;
#pragma unroll
        for (int k = 0; k < 32; ++k) am = fmaxf(am, fabsf(v[k]));
        am = fmaxf(am, swz_xor<1>(am)); am = fmaxf(am, swz_xor<2>(am)); am = fmaxf(am, swz_xor<4>(am)); am = fmaxf(am, swz_xor<8>(am)); am = fmaxf(am, swz_xor<16>(am));
        am = fmaxf(am, 1e-30f);
        const float inv = 6.0f / am;
        unsigned pk[4];
#pragma unroll
        for (int wd = 0; wd < 4; ++wd) { unsigned p4 = 0u;
            p4 = __builtin_amdgcn_cvt_scalef32_pk_fp4_f32(p4, v[8 * wd] * inv, v[8 * wd + 1] * inv, 1.0f, 0);
            p4 = __builtin_amdgcn_cvt_scalef32_pk_fp4_f32(p4, v[8 * wd + 2] * inv, v[8 * wd + 3] * inv, 1.0f, 1);
            p4 = __builtin_amdgcn_cvt_scalef32_pk_fp4_f32(p4, v[8 * wd + 4] * inv, v[8 * wd + 5] * inv, 1.0f, 2);
            p4 = __builtin_amdgcn_cvt_scalef32_pk_fp4_f32(p4, v[8 * wd + 6] * inv, v[8 * wd + 7] * inv, 1.0f, 3);
            pk[wd] = p4; }
        *(v4u*)(P.ws + WS_EU + (size_t)e * 512 + 16 * l31) = (v4u){pk[0], pk[1], pk[2], pk[3]};
        if (l31 == 0) SC[row] = am * (1.f / 6.0f);
      } }
}
__device__ __forceinline__ void p0_prologue(Frame& F0, const Ptrs& P) {
    const Frame& F = F0; const int lane_ = lane_id(), tid_ = F.wave * 64 + lane_;
    LAS float* scr = (LAS float*)(F.lds + RING_OFF + F.wave * 16384);
    const int gw = F.vcu * NWAVES + F.wave, NGW = F.G * NWAVES;
    bf16* Win_t = (bf16*)(P.ws + WS_WIN); bf16* Wout_t = (bf16*)(P.ws + WS_WOUT); bf16* Wq_t = (bf16*)(P.ws + WS_WQ);
    constexpr int I_IN = 16 * 72, I_OUT = 16 * 32, I_Q = 16 * 64, NITEMS = I_IN + I_OUT + I_Q;
    for (int it = gw; it < NITEMS; it += NGW) {
        int r = it;
        if (r < I_IN) { p0_transpose_item(P.w_in, INC, DM, 72, Win_t, nullptr, scr, r, lane_); continue; } r -= I_IN;
        if (r < I_OUT) { p0_transpose_item(P.w_out, DM, DM, 32, Wout_t, nullptr, scr, r, lane_); continue; } r -= I_OUT;
        p0_transpose_item(P.w_query, 2048, DM, 64, Wq_t, P.norm_ffn, scr, r, lane_);
    }
    quant_fp8s(P, lane_, 0, Q_SPLIT, gw, NGW);
    __syncthreads();
    { LAS float* Wdt = (LAS float*)(F.lds + RING_OFF);
      for (int i = tid_; i < 8192; i += 512) Wdt[i] = P.w_in[(size_t)(i >> 3) * INC + NPROJ + (i & 7)];
      __syncthreads();
      bf16* XN = (bf16*)(P.ws + WS_XN); float* DT = (float*)(P.ws + WS_DT);
      for (int m0 = gw * 2; m0 < T_; m0 += NGW * 2) {
        float4 xv[2][4];
#pragma unroll
        for (int rr = 0; rr < 2; ++rr) { const float4* xr = (const float4*)(P.x + (size_t)(m0 + rr) * DM);
#pragma unroll
            for (int j = 0; j < 4; ++j) xv[rr][j] = xr[j * 64 + lane_]; }
#pragma unroll
        for (int rr = 0; rr < 2; ++rr) { const int m = m0 + rr;
        float4 v[4]; float s = 0.f;
#pragma unroll
        for (int j = 0; j < 4; ++j) { v[j] = xv[rr][j]; s += v[j].x * v[j].x + v[j].y * v[j].y + v[j].z * v[j].z + v[j].w * v[j].w; }
        const float r = rsqrtf(wave_sum(s) * (1.f / 1024.f) + EPS);
        float d8[8];
#pragma unroll
        for (int q = 0; q < 8; ++q) d8[q] = 0.f;
        unsigned long long* o8 = (unsigned long long*)(XN + (size_t)m * DM);
#pragma unroll
        for (int j = 0; j < 4; ++j) { const float4 w = ((const float4*)P.norm_mix)[j * 64 + lane_];
            const float e0 = v[j].x * r * w.x, e1 = v[j].y * r * w.y, e2 = v[j].z * r * w.z, e3 = v[j].w * r * w.w;
            o8[j * 64 + lane_] = (unsigned long long)pk2(e0, e1) | ((unsigned long long)pk2(e2, e3) << 32);
            const float ev[4] = {e0, e1, e2, e3};
#pragma unroll
            for (int e = 0; e < 4; ++e) { const LAS f32x4* wr = (const LAS f32x4*)(Wdt + (size_t)(j * 256 + lane_ * 4 + e) * 8); const f32x4 w0 = wr[0], w1 = wr[1];
                d8[0] += ev[e] * w0.x; d8[1] += ev[e] * w0.y; d8[2] += ev[e] * w0.z; d8[3] += ev[e] * w0.w; d8[4] += ev[e] * w1.x; d8[5] += ev[e] * w1.y; d8[6] += ev[e] * w1.z; d8[7] += ev[e] * w1.w; } }
#pragma unroll
        for (int q = 0; q < 8; ++q) d8[q] = wave_sum(d8[q]);
        if (lane_ == 0) { float4* dp = (float4*)(DT + (size_t)m * 8); dp[0] = make_float4(d8[0], d8[1], d8[2], d8[3]); dp[1] = make_float4(d8[4], d8[5], d8[6], d8[7]); }
        }
      }
      __syncthreads(); }
}

struct EpiResH {
    static constexpr bool PERM = false, AFTER_DRAIN = false;
    const float* X; bf16* HB; float* SSQ;
    __device__ __forceinline__ void operator()(const pg8::f32x4 (&acc)[2][2][4][2], const pg8::Unit& u, int wr, int wc, int fr, int fq) const {
        const int row0 = u.pm * 256 + wr * 64 + fr, col0 = u.pn * 256 + wc * 32 + 4 * fq;
#pragma unroll
        for (int ai = 0; ai < 2; ++ai)
#pragma unroll
            for (int m = 0; m < 4; ++m) { const int row = row0 + ai * 128 + m * 16; float ss = 0.f;
#pragma unroll
                for (int bj = 0; bj < 2; ++bj)
#pragma unroll
                    for (int n = 0; n < 2; ++n) { const size_t off = (size_t)row * DM + col0 + bj * 128 + n * 16;
                        const pg8::f32x4 h = acc[ai][bj][m][n] + *(const pg8::f32x4*)(X + off);
                        ss += h[0] * h[0] + h[1] * h[1] + h[2] * h[2] + h[3] * h[3];
                        *(unsigned long long*)(HB + off) = (unsigned long long)pk2(h[0], h[1]) | ((unsigned long long)pk2(h[2], h[3]) << 32); }
                ss += swz_xor<16>(ss); ss = sum_halves(ss);
                if (fq == 0) SSQ[(size_t)row * 16 + u.pn * 4 + wc] = ss; }
    }
};

typedef float f32x16 __attribute__((ext_vector_type(16)));
typedef short s16x4 __attribute__((ext_vector_type(4)));
typedef float f32x2_t __attribute__((ext_vector_type(2)));
typedef __bf16 bf16x2_t __attribute__((ext_vector_type(2)));
#define MFMA32(a, b, c) __builtin_amdgcn_mfma_f32_32x32x16_bf16((a), (b), (c), 0, 0, 0)
__device__ __forceinline__ int crow(int reg, int h) { return (reg & 3) + 8 * (reg >> 2) + 4 * h; }
__device__ __forceinline__ unsigned cvtpk(float lo, float hi) { f32x2_t v = {lo, hi}; bf16x2_t b = __builtin_convertvector(v, bf16x2_t); return __builtin_bit_cast(unsigned, b); }
__device__ __forceinline__ bf16x8 pack8(const f32x16& x, int s) {
    v4u p; p.x = cvtpk(x[8 * s], x[8 * s + 1]); p.y = cvtpk(x[8 * s + 2], x[8 * s + 3]); p.z = cvtpk(x[8 * s + 4], x[8 * s + 5]); p.w = cvtpk(x[8 * s + 6], x[8 * s + 7]);
    return __builtin_bit_cast(bf16x8, p);
}
constexpr float LOG2E = 1.4426950408889634f;
constexpr int LDP = 136;
constexpr int S1_XT = 0, S1_XTW = 17408, S1_BSN = 34816, S1_CLN = 69632, S1_BNL = 104448, S1_F32 = 139264;

__device__ __forceinline__ float silu_fast(float x) { return x * __builtin_amdgcn_rcpf(1.f + __builtin_amdgcn_exp2f(-x * LOG2E)); }
__device__ __forceinline__ int swz_t(int row, int l) { return row * LDP + ((((l >> 3) ^ (row >> 3)) & 7) | ((l >> 3) & 8)) * 8 + (l & 7); }
#define S1_CONV8(A_, IT_) do { _Pragma("unroll") for (int e_ = 0; e_ < 8; ++e_) A_[e_] = bias[e_]; \
        _Pragma("unroll") for (int j_ = 0; j_ < 4; ++j_) { const v4u rw_ = raw[(IT_) + j_]; \
            A_[0] += w[j_][0] * bflo(rw_.x); A_[1] += w[j_][1] * bfhi(rw_.x); A_[2] += w[j_][2] * bflo(rw_.y); A_[3] += w[j_][3] * bfhi(rw_.y); \
            A_[4] += w[j_][4] * bflo(rw_.z); A_[5] += w[j_][5] * bfhi(rw_.z); A_[6] += w[j_][6] * bflo(rw_.w); A_[7] += w[j_][7] * bfhi(rw_.w); } \
        _Pragma("unroll") for (int e_ = 0; e_ < 8; ++e_) A_[e_] = silu_fast(A_[e_]); } while (0)
#define S1_LOADW(CHB_) do { _Pragma("unroll") for (int j_ = 0; j_ < 4; ++j_) { const float4 w0_ = *(const float4*)(P.conv_w + j_ * 1024 + (CHB_)), w1_ = *(const float4*)(P.conv_w + j_ * 1024 + (CHB_) + 4); \
            w[j_][0] = w0_.x; w[j_][1] = w0_.y; w[j_][2] = w0_.z; w[j_][3] = w0_.w; w[j_][4] = w1_.x; w[j_][5] = w1_.y; w[j_][6] = w1_.z; w[j_][7] = w1_.w; } \
        { const float4 b0_ = *(const float4*)(P.conv_b + (CHB_)), b1_ = *(const float4*)(P.conv_b + (CHB_) + 4); \
          bias[0] = b0_.x; bias[1] = b0_.y; bias[2] = b0_.z; bias[3] = b0_.w; bias[4] = b1_.x; bias[5] = b1_.y; bias[6] = b1_.z; bias[7] = b1_.w; } } while (0)
__device__ __forceinline__ void ssd_s1(Frame& F, const Ptrs& P) {
    const bf16* PROJ = (const bf16*)(P.ws + WS_PROJ); const float* DT = (const float*)(P.ws + WS_DT);
    float* EA = (float*)(P.ws + WS_EA); float* CDEC = (float*)(P.ws + WS_CDEC); bf16* CC = (bf16*)(P.ws + WS_CC);
    float* ST = (float*)(P.ws + WS_ST); float* YPF = (float*)((char*)P.out + DO_YPF);
    LAS unsigned char* L = F.lds + RING_OFF;
    LAS bf16* Xt = (LAS bf16*)(L + S1_XT); LAS bf16* Xtw = (LAS bf16*)(L + S1_XTW); LAS bf16* Bsn = (LAS bf16*)(L + S1_BSN); LAS bf16* Cln = (LAS bf16*)(L + S1_CLN); LAS bf16* Bnl = (LAS bf16*)(L + S1_BNL);
    LAS float* f32base = (LAS float*)(L + S1_F32);
    const int lane = lane_id(); const int tid_ = F.wave * 64 + lane;
    for (int ug = F.vcu; ug < 256; ug += F.G) {
        const int grp = ug & 1, c = (ug >> 1) & 31, b = ug >> 6, t0 = b * SEQ + c * 128;
        __syncthreads();
        if (F.wave < 4) {
            const int h = 4 * grp + F.wave, us = (b * 32 + c) * 8 + h;
            const float A = -__expf(P.a_log[h]), dtb = P.dt_bias[h];
            const int ln = opq(lane_id());
            LAS float* acum2 = f32base + F.wave * 384; LAS float* wv = acum2 + 128; LAS float* wend = wv + 128;
            const float x0 = DT[(size_t)(t0 + 2 * ln) * 8 + h] + dtb, x1 = DT[(size_t)(t0 + 2 * ln + 1) * 8 + h] + dtb;
            const float dt0 = fmaxf(x0, 0.f) + log1pf(__expf(-fabsf(x0))), dt1 = fmaxf(x1, 0.f) + log1pf(__expf(-fabsf(x1)));
            const float a0 = dt0 * A, a1 = dt1 * A;
            float s = a0 + a1;
#pragma unroll
            for (int o = 1; o < 64; o <<= 1) { const float v = __int_as_float(__builtin_amdgcn_ds_bpermute((ln - o) * 4, __float_as_int(s))); if (ln >= o) s += v; }
            const float ac1 = s, ac0 = s - a1, tot = __uint_as_float(__builtin_amdgcn_readlane(__float_as_uint(s), 63));
            acum2[2 * ln] = ac0 * LOG2E; acum2[2 * ln + 1] = ac1 * LOG2E;
            wv[2 * ln] = log2f(dt0) - ac0 * LOG2E; wv[2 * ln + 1] = log2f(dt1) - ac1 * LOG2E;
            wend[2 * ln] = dt0 * exp2f((tot - ac0) * LOG2E); wend[2 * ln + 1] = dt1 * exp2f((tot - ac1) * LOG2E);
            EA[(size_t)(t0 + 2 * ln) * 8 + h] = exp2f(ac0 * LOG2E); EA[(size_t)(t0 + 2 * ln + 1) * 8 + h] = exp2f(ac1 * LOG2E);
            if (ln == 0) CDEC[us] = exp2f(tot * LOG2E);
        }
        __syncthreads();
#pragma unroll 1
        for (int hi = 0; hi < 4; ++hi) {
            const int h = 4 * grp + hi, u = (b * 32 + c) * 8 + h;
            const float Dh = P.d_skip[h];
            const LAS float* acum2 = f32base + hi * 384; const LAS float* wv = acum2 + 128; const LAS float* wend = wv + 128;
            const int tidc = opq(tid_);
            if (hi == 0) {
                if (tidc < 440) {
                    const int cg = tidc % 40, sg = tidc / 40, l0 = 12 * sg;
                    int chb; if (cg < 8) chb = h * 64 + cg * 8; else if (cg < 24) chb = 512 + grp * 128 + (cg - 8) * 8; else chb = 768 + grp * 128 + (cg - 24) * 8;
                    v4u raw[15];
#pragma unroll
                    for (int q = 0; q < 15; ++q) { const int ss = c * 128 + l0 - 3 + q; raw[q] = (v4u){0u, 0u, 0u, 0u};
                        if (ss >= 0 && l0 - 3 + q < 128) raw[q] = *(const v4u*)(PROJ + (size_t)(b * SEQ + ss) * NPROJ + PJ_XBC + chb); }
                    float w[4][8], bias[8]; S1_LOADW(chb);
#pragma unroll
                    for (int it = 0; it < 12; it += 2) {
                        const int l = l0 + it;
                        if (l < 128) {
                            float a[8], a2[8]; S1_CONV8(a, it); S1_CONV8(a2, it + 1);
                            if (cg < 8) { const float we = wend[l], we2 = wend[l + 1];
#pragma unroll
                                for (int e = 0; e < 8; ++e) { *(LAS unsigned*)(Xt + swz_t(cg * 8 + e, l)) = cvtpk(a[e], a2[e]); *(LAS unsigned*)(Xtw + swz_t(cg * 8 + e, l)) = cvtpk(a[e] * we, a2[e] * we2); }
                            } else {
                                v4u o, o2; o.x = cvtpk(a[0], a[1]); o.y = cvtpk(a[2], a[3]); o.z = cvtpk(a[4], a[5]); o.w = cvtpk(a[6], a[7]);
                                o2.x = cvtpk(a2[0], a2[1]); o2.y = cvtpk(a2[2], a2[3]); o2.z = cvtpk(a2[4], a2[5]); o2.w = cvtpk(a2[6], a2[7]);
                                if (cg < 24) { const int n0 = (cg - 8) * 8; *(LAS v4u*)(Bsn + l * LDP + n0) = o; *(LAS v4u*)(Bsn + (l + 1) * LDP + n0) = o2;
#pragma unroll
                                    for (int e = 0; e < 8; ++e) *(LAS unsigned*)(Bnl + swz_t(n0 + e, l)) = cvtpk(a[e], a2[e]);
                                } else { const int n0 = (cg - 24) * 8; *(LAS v4u*)(Cln + l * LDP + n0) = o; *(LAS v4u*)(Cln + (l + 1) * LDP + n0) = o2;
                                    *(v4u*)(CC + (size_t)(t0 + l) * 256 + grp * 128 + n0) = o; *(v4u*)(CC + (size_t)(t0 + l + 1) * 256 + grp * 128 + n0) = o2; }
                            }
                        }
                    }
                }
            } else {
                const int cg = tidc & 7, l = 2 * (tidc >> 3), chb = h * 64 + cg * 8;
                v4u raw[5];
#pragma unroll
                for (int q = 0; q < 5; ++q) { const int ss = c * 128 + l - 3 + q; raw[q] = (v4u){0u, 0u, 0u, 0u};
                    if (ss >= 0) raw[q] = *(const v4u*)(PROJ + (size_t)(b * SEQ + ss) * NPROJ + PJ_XBC + chb); }
                float w[4][8], bias[8]; S1_LOADW(chb);
                float a[8], a2[8]; S1_CONV8(a, 0); S1_CONV8(a2, 1);
                const float we = wend[l], we2 = wend[l + 1];
#pragma unroll
                for (int e = 0; e < 8; ++e) { *(LAS unsigned*)(Xt + swz_t(cg * 8 + e, l)) = cvtpk(a[e], a2[e]); *(LAS unsigned*)(Xtw + swz_t(cg * 8 + e, l)) = cvtpk(a[e] * we, a2[e] * we2); }
            }
            __syncthreads();
            const int ln3 = opq(lane), r = ln3 & 31, hh = ln3 >> 5;
            if (F.wave < 4) {
                const int pt = F.wave >> 1;
#pragma unroll 1
                for (int q = 0; q < 2; ++q) {
                    const int lt = (F.wave & 1) ? (1 + q) : (3 * q);
                    f32x16 yacc;
#pragma unroll
                    for (int i = 0; i < 16; ++i) yacc[i] = 0.f;
                    const float al = acum2[32 * lt + r];
                    for (int st = 0; st <= lt; ++st) {
                        f32x16 macc;
#pragma unroll
                        for (int i = 0; i < 16; ++i) macc[i] = 0.f;
#pragma unroll
                        for (int kk = 0; kk < 8; ++kk) {
                            const bf16x8 a = *(const LAS bf16x8*)(Bsn + (32 * st + r) * LDP + 16 * kk + 8 * hh);
                            const bf16x8 bb = *(const LAS bf16x8*)(Cln + (32 * lt + r) * LDP + 16 * kk + 8 * hh);
                            macc = MFMA32(a, bb, macc);
                        }
#pragma unroll
                        for (int i = 0; i < 16; ++i) { const int sl = crow(i, hh);
                            float f = __builtin_amdgcn_exp2f(al + wv[32 * st + sl]);
                            if (st == lt && sl > r) f = 0.f;
                            macc[i] *= f; }
#pragma unroll
                        for (int sg = 0; sg < 2; ++sg) {
                            const bf16x8 bfrag = pack8(macc, sg);
                            const int prow = 32 * pt + r, lb = 32 * st + 16 * sg;
                            const s16x4 lo = *(const LAS s16x4*)(Xt + swz_t(prow, lb) + 4 * hh), hi2 = *(const LAS s16x4*)(Xt + swz_t(prow, lb + 8) + 4 * hh);
                            const bf16x8 afrag = __builtin_shufflevector(lo, hi2, 0, 1, 2, 3, 4, 5, 6, 7);
                            yacc = MFMA32(afrag, bfrag, yacc);
                        }
                    }
#pragma unroll
                    for (int i = 0; i < 16; ++i) { const int p = 32 * pt + crow(i, hh);
                        const float y = yacc[i] + Dh * bf2f(Xt[swz_t(p, 32 * lt + r)]);
                        YPF[((((size_t)u * 4 + lt) * 2 + pt) * 16 + i) * 64 + ln3] = y; }
                }
            } else {
                const int nt = F.wave - 4;
#pragma unroll 1
                for (int pt = 0; pt < 2; ++pt) {
                    f32x16 sacc;
#pragma unroll
                    for (int i = 0; i < 16; ++i) sacc[i] = 0.f;
#pragma unroll
                    for (int kk = 0; kk < 8; ++kk) {
                        const bf16x8 a = *(const LAS bf16x8*)(Xtw + swz_t(32 * pt + r, 16 * kk + 8 * hh));
                        const bf16x8 bb = *(const LAS bf16x8*)(Bnl + swz_t(32 * nt + r, 16 * kk + 8 * hh));
                        sacc = MFMA32(a, bb, sacc);
                    }
#pragma unroll
                    for (int i = 0; i < 16; ++i) ST[((size_t)u * 64 + 32 * pt + crow(i, hh)) * 128 + 32 * nt + r] = sacc[i];
                }
            }
            __syncthreads();
        }
    }
}
__device__ __forceinline__ void ssd_s2(Frame& F, const Ptrs& P) {
    const float* ST = (const float*)(P.ws + WS_ST); const float* CDEC = (const float*)(P.ws + WS_CDEC); unsigned* PREV = (unsigned*)(P.ws + WS_PREV);
    for (int g = F.vcu * 512 + (F.wave * 64 + lane_id()); g < 131072; g += F.G * 512) {
        const int n2 = g & 63, p = (g >> 6) & 63, h = (g >> 12) & 7, b = g >> 15;
        float2 st[32];
#pragma unroll
        for (int c = 0; c < 32; ++c) st[c] = *(const float2*)(ST + ((size_t)(((b * 32 + c) * 8 + h) * 64 + p)) * 128 + 2 * n2);
        float r0 = 0.f, r1 = 0.f;
#pragma unroll
        for (int c = 0; c < 32; ++c) { const size_t u = (size_t)((b * 32 + c) * 8 + h);
            PREV[((u * 64 + p) * 128 + 2 * n2) >> 1] = pk2(r0, r1);
            const float d = CDEC[u]; r0 = r0 * d + st[c].x; r1 = r1 * d + st[c].y; }
    }
}
__device__ __forceinline__ void ssd_s3(Frame& F, const Ptrs& P) {
    const bf16* CC = (const bf16*)(P.ws + WS_CC); const bf16* PREV = (const bf16*)(P.ws + WS_PREV); const float* EA = (const float*)(P.ws + WS_EA);
    const float* YPF = (const float*)((const char*)P.out + DO_YPF); const bf16* PROJ = (const bf16*)(P.ws + WS_PROJ); bf16* CAT = (bf16*)(P.ws + WS_XN);
    LAS float* red = (LAS float*)(F.lds + RING_OFF);
    const int lane = lane_id(), r = lane & 31, hh = lane >> 5, h = F.wave, grp = h >> 2;
    for (int v = F.vcu; v < 512; v += F.G) {
        const int lt = v & 3, c = (v >> 2) & 31, b = v >> 7;
        const int t = b * SEQ + c * 128 + lt * 32 + r; const size_t u = (size_t)((b * 32 + c) * 8 + h);
        float ypf[2][16]; unsigned long long zz[2][4];
#pragma unroll
        for (int pt = 0; pt < 2; ++pt) {
#pragma unroll
            for (int i = 0; i < 16; ++i) ypf[pt][i] = YPF[((((size_t)u * 4 + lt) * 2 + pt) * 16 + i) * 64 + lane];
#pragma unroll
            for (int g4 = 0; g4 < 4; ++g4) zz[pt][g4] = *(const unsigned long long*)(PROJ + (size_t)t * NPROJ + PJ_Z + h * 64 + 32 * pt + 8 * g4 + 4 * hh); }
        const float ea = EA[(size_t)t * 8 + h];
        f32x16 acc[2];
#pragma unroll
        for (int i = 0; i < 16; ++i) { acc[0][i] = 0.f; acc[1][i] = 0.f; }
#pragma unroll
        for (int kk = 0; kk < 8; ++kk) {
            const bf16x8 bb = *(const bf16x8*)(CC + (size_t)t * 256 + grp * 128 + 16 * kk + 8 * hh);
#pragma unroll
            for (int pt = 0; pt < 2; ++pt) { const bf16x8 a = *(const bf16x8*)(PREV + (u * 64 + 32 * pt + r) * 128 + 16 * kk + 8 * hh); acc[pt] = MFMA32(a, bb, acc[pt]); }
        }
        float ss = 0.f;
#pragma unroll
        for (int pt = 0; pt < 2; ++pt)
#pragma unroll
            for (int g4 = 0; g4 < 4; ++g4) {
                const unsigned z01 = (unsigned)zz[pt][g4], z23 = (unsigned)(zz[pt][g4] >> 32);
                const float zf[4] = {bflo(z01), bfhi(z01), bflo(z23), bfhi(z23)};
#pragma unroll
                for (int e = 0; e < 4; ++e) { const int i = 4 * g4 + e;
                    const float y = acc[pt][i] * ea + ypf[pt][i];
                    const float yg = y * silu_fast(zf[e]); acc[pt][i] = yg; ss = fmaf(yg, yg, ss); }
            }
        ss = sum_halves(ss);
        if (hh == 0) red[h * 32 + r] = ss;
        __syncthreads();
        float tot = 0.f;
#pragma unroll
        for (int w = 0; w < 8; ++w) tot += red[w * 32 + r];
        const float rn = rsqrtf(tot * (1.f / 512.f) + EPS);
#pragma unroll
        for (int pt = 0; pt < 2; ++pt)
#pragma unroll
            for (int g4 = 0; g4 < 4; ++g4) { const int ch = h * 64 + 32 * pt + 8 * g4 + 4 * hh;
                const float4 w = *(const float4*)(P.ssd_norm_w + ch);
                *(unsigned long long*)(CAT + (size_t)t * DM + 512 + ch) = (unsigned long long)cvtpk(acc[pt][4 * g4] * rn * w.x, acc[pt][4 * g4 + 1] * rn * w.y) | ((unsigned long long)cvtpk(acc[pt][4 * g4 + 2] * rn * w.z, acc[pt][4 * g4 + 3] * rn * w.w) << 32); }
        __syncthreads();
    }
}
__device__ __forceinline__ float gelu_erf(float v) { return 0.5f * v * (1.f + erff(v * 0.70710678118654752f)); }
typedef float f32x2v __attribute__((ext_vector_type(2)));
#define CVT8(W, LO) __builtin_amdgcn_cvt_pk_f32_fp8((int)(W), LO)
template <int CTRL> __device__ __forceinline__ float dpp_f(float v) { return __int_as_float(__builtin_amdgcn_update_dpp(0, __float_as_int(v), CTRL, 0xF, 0xF, true)); }
__device__ __forceinline__ float sum8_dpp(float s) { s += dpp_f<0xB1>(s); s += dpp_f<0x4E>(s); s += dpp_f<0x141>(s); return s; }
struct PeerPlace { int vx, nx, rank, nloc; };
__device__ __forceinline__ PeerPlace peer_place(Frame& F) {
    __syncthreads();
    if (F.wave == 0 && lane_id() == 0) {
        unsigned* bar = (unsigned*)(F.ctl + CW_BAR); const unsigned x = xb_xcc_id();
        unsigned vx = 0, nx = 0;
        for (unsigned j = 0; j < 16; ++j) { const unsigned c = xb_ld(&bar[XB_XCNT(j)]); if (c) { if (j < x) ++vx; ++nx; } }
        const unsigned rank = xb_add((unsigned*)(F.ctl + CW_RANK) + 64 * x, 1u);
        F.MISC[10] = vx; F.MISC[11] = nx ? nx : 1u; F.MISC[12] = rank; F.MISC[13] = xb_ld(&bar[XB_XCNT(x)]);
    }
    __syncthreads();
    PeerPlace pp; pp.vx = (int)F.MISC[10]; pp.nx = (int)F.MISC[11]; pp.rank = (int)F.MISC[12]; pp.nloc = (int)F.MISC[13]; if (pp.nloc < 1) pp.nloc = 1;
    return pp;
}
__device__ __forceinline__ void h_quant_rows(Frame& F, const Ptrs& P) {
    const bf16* HB = (const bf16*)(P.ws + WS_ST); unsigned char* H8 = P.ws + WS_H8; float* HS = (float*)(P.ws + WS_HS);
    const int lane = lane_id();
    for (int t = F.vcu * NWAVES + F.wave; t < T_; t += F.G * NWAVES) {
        const v4u a0 = ((const v4u*)(HB + (size_t)t * DM))[2 * lane], a1 = ((const v4u*)(HB + (size_t)t * DM))[2 * lane + 1];
        float hf[16];
        hf[0] = bflo(a0.x); hf[1] = bfhi(a0.x); hf[2] = bflo(a0.y); hf[3] = bfhi(a0.y); hf[4] = bflo(a0.z); hf[5] = bfhi(a0.z); hf[6] = bflo(a0.w); hf[7] = bfhi(a0.w);
        hf[8] = bflo(a1.x); hf[9] = bfhi(a1.x); hf[10] = bflo(a1.y); hf[11] = bfhi(a1.y); hf[12] = bflo(a1.z); hf[13] = bfhi(a1.z); hf[14] = bflo(a1.w); hf[15] = bfhi(a1.w);
        float am = 0.f;
#pragma unroll
        for (int i = 0; i < 16; ++i) am = fmaxf(am, fabsf(hf[i]));
        am = fmaxf(am, dpp_f<0xB1>(am)); am = fmaxf(am, dpp_f<0x4E>(am)); am = fmaxf(am, dpp_f<0x141>(am)); am = fmaxf(am, 1e-30f);
        const float inv = 127.f / am;
        v4u o; o.x = pack4_i8(hf[0] * inv, hf[1] * inv, hf[2] * inv, hf[3] * inv); o.y = pack4_i8(hf[4] * inv, hf[5] * inv, hf[6] * inv, hf[7] * inv);
        o.z = pack4_i8(hf[8] * inv, hf[9] * inv, hf[10] * inv, hf[11] * inv); o.w = pack4_i8(hf[12] * inv, hf[13] * inv, hf[14] * inv, hf[15] * inv);
        ((v4u*)(H8 + (size_t)t * 1024))[lane] = o;
        if ((lane & 7) == 0) HS[(size_t)t * 8 + (lane >> 3)] = am * (1.f / 127.f);
    }
}
constexpr int PX_D = 16;
template <int CTRL> __device__ __forceinline__ int dpp_i(int v) { return __builtin_amdgcn_update_dpp(0, v, CTRL, 0xF, 0xF, true); }
#define PX_ISSUE(BUF, LO, HI) _Pragma("unroll") for (int b_ = 0; b_ < 8; ++b_) { const unsigned off_ = ((unsigned)__builtin_amdgcn_ds_bpermute((16 * (b_ & 3) + ps) * 4, (b_ & 4) ? (HI) : (LO)) << 7) | (unsigned)(dl << 5); \
        BUF[2 * b_] = *(const v4u*)(tab + off_); BUF[2 * b_ + 1] = *(const v4u*)(tab + off_ + 16); }
__device__ __forceinline__ void peer_down_token(const v4u (&cur)[PX_D], const v4u h8a, const v4u h8b, const float hs, float* prow, int dl, int ps) {
    int sm[8];
#pragma unroll
    for (int b = 0; b < 8; ++b) { const v4u q0 = cur[2 * b], q1 = cur[2 * b + 1];
        int acc = __builtin_amdgcn_sdot4((int)q0.x, (int)h8a.x, 0, false); acc = __builtin_amdgcn_sdot4((int)q0.y, (int)h8a.y, acc, false);
        acc = __builtin_amdgcn_sdot4((int)q0.z, (int)h8a.z, acc, false); acc = __builtin_amdgcn_sdot4((int)q0.w, (int)h8a.w, acc, false);
        acc = __builtin_amdgcn_sdot4((int)q1.x, (int)h8b.x, acc, false); acc = __builtin_amdgcn_sdot4((int)q1.y, (int)h8b.y, acc, false);
        acc = __builtin_amdgcn_sdot4((int)q1.z, (int)h8b.z, acc, false); sm[b] = __builtin_amdgcn_sdot4((int)q1.w, (int)h8b.w, acc, false); }
    const bool c1 = (dl & 2) != 0, c0 = (dl & 1) != 0;
    int w4[4], w2[2];
#pragma unroll
    for (int k = 0; k < 4; ++k) { const int keep = c1 ? sm[4 + k] : sm[k], send = c1 ? sm[k] : sm[4 + k]; w4[k] = keep + dpp_i<0x4E>(send); }
#pragma unroll
    for (int k = 0; k < 2; ++k) { const int keep = c0 ? w4[2 + k] : w4[k], send = c0 ? w4[k] : w4[2 + k]; w2[k] = keep + dpp_i<0xB1>(send); }
    prow[32 * dl + ps] = (float)w2[0] * hs; prow[32 * dl + 16 + ps] = (float)w2[1] * hs;
}
__device__ __forceinline__ void peer_down(Frame& F, const Ptrs& P, const PeerPlace& pp) {
    const unsigned char* H8 = P.ws + WS_H8; const unsigned char* HSb = P.ws + WS_HS; const unsigned char* IDXb = P.ws + WS_IDX; unsigned char* PARTb = P.ws + WS_PART;
    const int lane = lane_id(), dl = lane & 3, ps = lane >> 2;
    const int t0 = pp.rank * NWAVES + F.wave, tstep = pp.nloc * NWAVES;
    for (int s = pp.vx; s < 8; s += pp.nx) {
        if (t0 >= T_) continue;
        const unsigned char* tab = P.ws + WS_ED + (size_t)s * 16384 * 128;
        const unsigned hoff = (unsigned)(s * 128 + dl * 32), ioff = (unsigned)lane * 4u;
        v4u bufA[PX_D], bufB[PX_D];
#define PD_CLAMP(T) ((T) < T_ ? (T) : t0)
#define PD_META(HA, HB_, HSC, TT) do { HA = *(const v4u*)(H8 + ((unsigned)(TT) * 1024u + hoff)); HB_ = *(const v4u*)(H8 + ((unsigned)(TT) * 1024u + hoff + 16u)); HSC = *(const float*)(HSb + ((unsigned)(TT) * 32u + (unsigned)s * 4u)); } while (0)
#define PD_IDX(LO, HI, TT) do { LO = *(const int*)(IDXb + ((unsigned)(TT) * 512u + ioff)); HI = *(const int*)(IDXb + ((unsigned)(TT) * 512u + 256u + ioff)); } while (0)
        int nidx_lo, nidx_hi; PD_IDX(nidx_lo, nidx_hi, t0);
        PX_ISSUE(bufA, nidx_lo, nidx_hi);
        PD_IDX(nidx_lo, nidx_hi, PD_CLAMP(t0 + tstep));
        v4u ha0, ha1, hb0, hb1; float sa, sb; PD_META(ha0, ha1, sa, t0);
        for (int t = t0; t < T_; t += 2 * tstep) {
            { const int tn = PD_CLAMP(t + tstep);
              PX_ISSUE(bufB, nidx_lo, nidx_hi); PD_IDX(nidx_lo, nidx_hi, PD_CLAMP(tn + tstep)); PD_META(hb0, hb1, sb, tn);
              __builtin_amdgcn_sched_barrier(0);
              peer_down_token(bufA, ha0, ha1, sa, (float*)(PARTb + ((unsigned)(s * T_ + t) * 512u)), dl, ps);
              __builtin_amdgcn_sched_barrier(0); }
            if (t + tstep >= T_) break;
            { const int tc = t + tstep, tn = PD_CLAMP(tc + tstep);
              PX_ISSUE(bufA, nidx_lo, nidx_hi); PD_IDX(nidx_lo, nidx_hi, PD_CLAMP(tn + tstep)); PD_META(ha0, ha1, sa, tn);
              __builtin_amdgcn_sched_barrier(0);
              peer_down_token(bufB, hb0, hb1, sb, (float*)(PARTb + ((unsigned)(s * T_ + tc) * 512u)), dl, ps);
              __builtin_amdgcn_sched_barrier(0); }
        }
    }
}
__device__ __forceinline__ void peer_act(Frame& F, const Ptrs& P) {
    const int* IDX = (const int*)(P.ws + WS_IDX); float* GATE = (float*)(P.ws + WS_GATE); const float* PART = (const float*)(P.ws + WS_PART); const float* SSQ = (const float*)(P.ws + WS_SSQ);
    const float* SCD = (const float*)(P.ws + WS_SMALL); const float* SCU = SCD + 16384;
    const int lane = lane_id();
    for (int w = F.vcu * NWAVES + F.wave; w < T_ * 2; w += F.G * NWAVES) {
        const int t = w >> 1; const size_t pid = (size_t)w * 64 + lane;
        const float ssq = lane < 16 ? SSQ[(size_t)t * 16 + lane] : 0.f;
        const float rstd = rsqrtf(wave_sum(ssq) * (1.f / 1024.f) + EPS);
        float pre = 0.f;
#pragma unroll
        for (int s = 0; s < 8; ++s) pre += PART[(size_t)s * T_ * 128 + pid];
        const int id = IDX[pid];
        GATE[pid] = gelu_erf(pre * SCD[id] * rstd) * GATE[pid] * SCU[id];
    }
}
constexpr int PE_PD = 8;
#define PE_LOAD4(SLOT, IDV) SLOT = *(const v4u*)(EU + (((unsigned)(IDV) << 9) | l16))
#define PE_BP(ADDR, V) __builtin_amdgcn_ds_bpermute((ADDR), (V))
__device__ __forceinline__ void peer_up_tm(Frame& F, const Ptrs& P) {
    const bf16* HB = (const bf16*)(P.ws + WS_ST); const unsigned char* EU = P.ws + WS_EU;
    const int* IDX = (const int*)(P.ws + WS_IDX); const float* GATE = (const float*)(P.ws + WS_GATE); const float* PART = (const float*)(P.ws + WS_PART);
    const float* SCD = (const float*)(P.ws + WS_SMALL); const float* SCU = SCD + 16384;
    const int lane = lane_id(), l31 = lane & 31; const bool upper = lane >= 32;
    const unsigned l16 = (unsigned)l31 << 4;
    const int bp0 = upper ? 4 : 0;
    const int t0 = F.vcu * NWAVES + F.wave, tstep = F.G * NWAVES;
    if (t0 >= T_) return;
    int idx_lo = IDX[(size_t)t0 * 128 + lane], idx_hi = IDX[(size_t)t0 * 128 + 64 + lane];
    v4u hq[4];
#pragma unroll
    for (int k = 0; k < 4; ++k) hq[k] = ((const v4u*)(HB + (size_t)t0 * DM))[4 * l31 + k];
    float g_lo = GATE[(size_t)t0 * 128 + lane], g_hi = GATE[(size_t)t0 * 128 + 64 + lane];
    float pre_lo = 0.f, pre_hi = 0.f;
#pragma unroll
    for (int s = 0; s < 8; ++s) { pre_lo += PART[((size_t)s * T_ + t0) * 128 + lane]; pre_hi += PART[((size_t)s * T_ + t0) * 128 + 64 + lane]; }
    float sdu_lo = SCD[idx_lo], sdu_hi = SCD[idx_hi], su_lo = SCU[idx_lo], su_hi = SCU[idx_hi];
    v4u ra[PE_PD];
#pragma unroll
    for (int j = 0; j < PE_PD; ++j) { const int id = PE_BP(bp0 + 8 * j, idx_lo); PE_LOAD4(ra[j], id); }
    int id_nx = PE_BP(bp0 + 8 * PE_PD, idx_lo);
    for (int t = t0; t < T_; t += tstep) {
        const int tn = (t + tstep < T_) ? t + tstep : t;
        const int nidx_lo = IDX[(size_t)tn * 128 + lane], nidx_hi = IDX[(size_t)tn * 128 + 64 + lane];
        v4u nh[4];
#pragma unroll
        for (int k = 0; k < 4; ++k) nh[k] = ((const v4u*)(HB + (size_t)tn * DM))[4 * l31 + k];
        const float ng_lo = GATE[(size_t)tn * 128 + lane], ng_hi = GATE[(size_t)tn * 128 + 64 + lane];
        float npart_lo[8], npart_hi[8];
#pragma unroll
        for (int s = 0; s < 8; ++s) { npart_lo[s] = PART[((size_t)s * T_ + tn) * 128 + lane]; npart_hi[s] = PART[((size_t)s * T_ + tn) * 128 + 64 + lane]; }
        float ssq = 0.f;
#pragma unroll
        for (int k = 0; k < 4; ++k) { ssq = fmaf(bflo(hq[k].x), bflo(hq[k].x), ssq); ssq = fmaf(bfhi(hq[k].x), bfhi(hq[k].x), ssq); ssq = fmaf(bflo(hq[k].y), bflo(hq[k].y), ssq); ssq = fmaf(bfhi(hq[k].y), bfhi(hq[k].y), ssq);
            ssq = fmaf(bflo(hq[k].z), bflo(hq[k].z), ssq); ssq = fmaf(bfhi(hq[k].z), bfhi(hq[k].z), ssq); ssq = fmaf(bflo(hq[k].w), bflo(hq[k].w), ssq); ssq = fmaf(bfhi(hq[k].w), bfhi(hq[k].w), ssq); }
        ssq += swz_xor<1>(ssq); ssq += swz_xor<2>(ssq); ssq += swz_xor<4>(ssq); ssq += swz_xor<8>(ssq); ssq += swz_xor<16>(ssq);
        const float rstd = rsqrtf(ssq * (1.f / 1024.f) + EPS);
        const float act_lo = gelu_erf(pre_lo * sdu_lo * rstd) * g_lo * su_lo, act_hi = gelu_erf(pre_hi * sdu_hi * rstd) * g_hi * su_hi;
        f32x2v acc[16];
#pragma unroll
        for (int i = 0; i < 16; ++i) acc[i] = (f32x2v){0.f, 0.f};
        float a_cur = __int_as_float(PE_BP(bp0, __float_as_int(act_lo)));
#pragma unroll
        for (int q = 0; q < 64; ++q) {
            const int qa = q + 1, ql = q + PE_PD + 1;
            float a_nx = 0.f;
            if (qa < 64) a_nx = __int_as_float(PE_BP(bp0 + 8 * (qa & 31), __float_as_int(qa < 32 ? act_lo : act_hi)));
            int id_n2;
            if (ql < 64) id_n2 = PE_BP(bp0 + 8 * (ql & 31), ql < 32 ? idx_lo : idx_hi);
            else id_n2 = PE_BP(bp0 + 8 * ((ql - 64) & 31), nidx_lo);
            __builtin_amdgcn_sched_barrier(0);
            { const f32x2v av = {a_cur, a_cur}; const v4u r = ra[q % PE_PD];
#define PE_FMA4(W, O) acc[O] = __builtin_elementwise_fma(av, (f32x2v)__builtin_amdgcn_cvt_scalef32_pk_f32_fp4(W, 1.0f, 0), acc[O]); acc[O + 1] = __builtin_elementwise_fma(av, (f32x2v)__builtin_amdgcn_cvt_scalef32_pk_f32_fp4(W, 1.0f, 1), acc[O + 1]); \
              acc[O + 2] = __builtin_elementwise_fma(av, (f32x2v)__builtin_amdgcn_cvt_scalef32_pk_f32_fp4(W, 1.0f, 2), acc[O + 2]); acc[O + 3] = __builtin_elementwise_fma(av, (f32x2v)__builtin_amdgcn_cvt_scalef32_pk_f32_fp4(W, 1.0f, 3), acc[O + 3]);
              PE_FMA4(r.x, 0) PE_FMA4(r.y, 4) PE_FMA4(r.z, 8) PE_FMA4(r.w, 12) }
            asm volatile("" : "+v"(acc[0]), "+v"(acc[1]), "+v"(acc[2]), "+v"(acc[3]), "+v"(acc[4]), "+v"(acc[5]), "+v"(acc[6]), "+v"(acc[7]));
            asm volatile("" : "+v"(acc[8]), "+v"(acc[9]), "+v"(acc[10]), "+v"(acc[11]), "+v"(acc[12]), "+v"(acc[13]), "+v"(acc[14]), "+v"(acc[15]));
            PE_LOAD4(ra[q % PE_PD], id_nx);
            id_nx = id_n2; a_cur = a_nx;
            __builtin_amdgcn_sched_barrier(0);
        }
        { float a = 0.f, c = 0.f;
#pragma unroll
          for (int s = 0; s < 8; ++s) { a += npart_lo[s]; c += npart_hi[s]; }
          pre_lo = a; pre_hi = c; }
        sdu_lo = SCD[nidx_lo]; sdu_hi = SCD[nidx_hi]; su_lo = SCU[nidx_lo]; su_hi = SCU[nidx_hi];
        float y[32];
#pragma unroll
        for (int k = 0; k < 4; ++k) { y[8 * k] = bflo(hq[k].x); y[8 * k + 1] = bfhi(hq[k].x); y[8 * k + 2] = bflo(hq[k].y); y[8 * k + 3] = bfhi(hq[k].y); y[8 * k + 4] = bflo(hq[k].z); y[8 * k + 5] = bfhi(hq[k].z); y[8 * k + 6] = bflo(hq[k].w); y[8 * k + 7] = bfhi(hq[k].w); }
        float s2 = 0.f;
#pragma unroll
        for (int i = 0; i < 16; ++i) { y[2 * i] += sum_halves(acc[i][0]); y[2 * i + 1] += sum_halves(acc[i][1]); s2 = fmaf(y[2 * i], y[2 * i], s2); s2 = fmaf(y[2 * i + 1], y[2 * i + 1], s2); }
        s2 += swz_xor<1>(s2); s2 += swz_xor<2>(s2); s2 += swz_xor<4>(s2); s2 += swz_xor<8>(s2); s2 += swz_xor<16>(s2);
        const float r2 = rsqrtf(s2 * (1.f / 1024.f) + EPS);
        const float4* wf = (const float4*)(P.norm_final) + 8 * l31 + 4 * (lane >> 5); float4* o = (float4*)(P.out + (size_t)t * DM) + 8 * l31 + 4 * (lane >> 5);
#pragma unroll
        for (int k = 0; k < 4; ++k) { const float4 w = wf[k];
            const float e0 = upper ? y[16 + 4 * k] : y[4 * k], e1 = upper ? y[17 + 4 * k] : y[4 * k + 1], e2 = upper ? y[18 + 4 * k] : y[4 * k + 2], e3 = upper ? y[19 + 4 * k] : y[4 * k + 3];
            o[k] = make_float4(e0 * r2 * w.x, e1 * r2 * w.y, e2 * r2 * w.z, e3 * r2 * w.w); }
        idx_lo = nidx_lo; idx_hi = nidx_hi; g_lo = ng_lo; g_hi = ng_hi;
#pragma unroll
        for (int k = 0; k < 4; ++k) hq[k] = nh[k];
    }
}
constexpr int TK_LDK = 136, TK_K2 = 34816, TK_SCR = 69632, TK_SP = 49;
__device__ __forceinline__ int mono_key(float x) { const int b = __float_as_int(x); return b ^ ((b >> 31) & 0x7fffffff); }
__device__ __forceinline__ float unmono(int m) { return __int_as_float(m ^ ((m >> 31) & 0x7fffffff)); }
__device__ __forceinline__ int max3i(int a, int b, int c) { return max(max(a, b), c); }
#define CEX(A, I, J) do { const int hi_ = max(A[I], A[J]), lo_ = min(A[I], A[J]); A[I] = hi_; A[J] = lo_; } while (0)
template <int N, int OFF, int K, int J, int LEN> struct BitonicStep {
    static __device__ __forceinline__ void run(int (&a)[LEN]) {
#pragma unroll
        for (int i = 0; i < N; ++i) { const int l = i ^ J; if (l > i) { if ((i & K) == 0) CEX(a, OFF + i, OFF + l); else CEX(a, OFF + l, OFF + i); } }
        if constexpr (J > 1) BitonicStep<N, OFF, K, (J >> 1), LEN>::run(a);
        else if constexpr (K < N) BitonicStep<N, OFF, (K << 1), K, LEN>::run(a);
    }
};
template <int N, int OFF, int LEN> __device__ __forceinline__ void bitonic_sort_desc(int (&a)[LEN]) { BitonicStep<N, OFF, 2, 1, LEN>::run(a); }
template <int OFF, int LEN> __device__ __forceinline__ void bitonic_merge16_desc(int (&a)[LEN]) { BitonicStep<16, OFF, 16, 8, LEN>::run(a); }
template <int A, int B, int LEN> __device__ __forceinline__ void merge_top16(int (&a)[LEN]) {
#pragma unroll
    for (int i = 0; i < 16; ++i) a[A + i] = max(a[A + i], a[B + 15 - i]);
    bitonic_merge16_desc<A, LEN>(a);
}
template <int LEN> __device__ __forceinline__ void pair_top16(int (&a)[LEN]) {
    int lo[16], up[16];
#pragma unroll
    for (int i = 0; i < 16; ++i) { const auto rr = __builtin_amdgcn_permlane32_swap((unsigned)a[i], (unsigned)a[i], false, false); lo[i] = (int)rr[0]; up[i] = (int)rr[1]; }
#pragma unroll
    for (int i = 0; i < 16; ++i) a[i] = max(lo[i], up[15 - i]);
    bitonic_merge16_desc<0, LEN>(a);
}
__device__ __forceinline__ void topk_phase(Frame& F, const Ptrs& P) {
    const bf16* Q = (const bf16*)(P.ws + WS_PROJ); const float* SSQ = (const float*)(P.ws + WS_SSQ);
    int* IDX = (int*)(P.ws + WS_IDX); float* GATE = (float*)(P.ws + WS_GATE);
    LAS unsigned char* L = F.lds + RING_OFF;
    LAS bf16* K1 = (LAS bf16*)L; LAS bf16* K2 = (LAS bf16*)(L + TK_K2);
    const int tid_ = (F.wave * 64 + lane_id());
    for (int i = tid_; i < 16384; i += 512) { const int n = i >> 7, k = i & 127; K1[n * TK_LDK + k] = (bf16)f2bf(P.sk1[i]); K2[n * TK_LDK + k] = (bf16)f2bf(P.sk2[i]); }
    __syncthreads();
    const int lane = tid_ & 63, r = lane & 31, hh = lane >> 5;
    LAS int* scr = (LAS int*)(L + TK_SCR) + F.wave * (32 * TK_SP) + r * TK_SP;
    for (int wq = F.vcu * NWAVES + F.wave; wq < 2048; wq += F.G * NWAVES) {
        const int t = (wq >> 2) * 32 + r;
        float rstd;
        { const float4* sp = (const float4*)(SSQ + (size_t)t * 16); const float4 a = sp[0], b = sp[1], c = sp[2], d = sp[3];
          rstd = rsqrtf(((a.x + a.y + a.z + a.w) + (b.x + b.y + b.z + b.w) + (c.x + c.y + c.z + c.w) + (d.x + d.y + d.z + d.w)) * (1.f / 1024.f) + EPS); }
#pragma unroll 1
        for (int hq = 0; hq < 2; ++hq) {
            const int hd = (wq & 3) * 2 + hq;
#pragma unroll 1
            for (int half = 0; half < 2; ++half) {
                const LAS bf16* Kh = half ? K2 : K1;
                bf16x8 qf[8];
#pragma unroll
                for (int kk = 0; kk < 8; ++kk) qf[kk] = *(const bf16x8*)(Q + (size_t)t * 2048 + hd * 256 + half * 128 + 16 * kk + 8 * hh);
                int key[64];
#pragma unroll
                for (int nt = 0; nt < 4; ++nt) {
                    f32x16 sc;
#pragma unroll
                    for (int i = 0; i < 16; ++i) sc[i] = 0.f;
#pragma unroll
                    for (int kk = 0; kk < 8; ++kk) { const bf16x8 a = *(const LAS bf16x8*)(Kh + (32 * nt + r) * TK_LDK + 16 * kk + 8 * hh); sc = MFMA32(a, qf[kk], sc); }
#pragma unroll
                    for (int i = 0; i < 16; ++i) key[nt * 16 + i] = (mono_key(sc[i]) & ~127) | (127 - (32 * nt + crow(i, hh)));
                }
                bitonic_sort_desc<16, 0, 64>(key); bitonic_sort_desc<16, 16, 64>(key); bitonic_sort_desc<16, 32, 64>(key); bitonic_sort_desc<16, 48, 64>(key);
                merge_top16<0, 16, 64>(key); merge_top16<32, 48, 64>(key); merge_top16<0, 32, 64>(key);
                pair_top16<64>(key);
                if (hh == 0) {
#pragma unroll
                    for (int i = 0; i < 16; ++i) scr[half * 16 + i] = key[i]; }
            }
            const LAS int* la = scr + hh * 16; const LAS int* lb = scr + (1 - hh) * 16;
            float va[4], vb[16];
#pragma unroll
            for (int i = 0; i < 4; ++i) va[i] = unmono(la[i] & ~127);
#pragma unroll
            for (int j = 0; j < 16; ++j) vb[j] = unmono(lb[j] & ~127);
            int ck[32];
            {
                int q = 0;
#pragma unroll
                for (int i = 0; i < 4; ++i)
#pragma unroll
                    for (int j = i; j < 16; ++j) if ((i + 1) * (j + 1) <= 16) {
                        const int pos = hh ? (j * 16 + i) : (i * 16 + j);
                        int k = (mono_key(va[i] + vb[j]) & ~255) | (255 - pos);
                        if (i == j && hh) k = (int)0x80000000;
                        ck[q++] = k; }
#pragma unroll
                for (int i = 27; i < 32; ++i) ck[i] = (int)0x80000000;
            }
            bitonic_sort_desc<32, 0, 32>(ck);
            pair_top16<32>(ck);
            const float vmax = unmono(ck[0] & ~255) * rstd;
            float ev[8]; int id[8]; float esum = 0.f; const int hm = -hh;
#pragma unroll
            for (int q = 0; q < 8; ++q) { const int wk = ck[q] ^ ((ck[q] ^ ck[8 + q]) & hm); const int pos = 255 - (wk & 255);
                const int n1 = 127 - (scr[pos >> 4] & 127), n2 = 127 - (scr[16 + (pos & 15)] & 127);
                id[q] = n1 * 128 + n2;
                ev[q] = exp2f((unmono(wk & ~255) * rstd - vmax) * LOG2E); esum += ev[q]; }
            esum = sum_halves(esum);
            const float inv = 1.f / esum;
            int4* ip = (int4*)(IDX + ((size_t)t * 8 + hd) * 16 + hh * 8); float4* gp = (float4*)(GATE + ((size_t)t * 8 + hd) * 16 + hh * 8);
            ip[0] = make_int4(id[0], id[1], id[2], id[3]); ip[1] = make_int4(id[4], id[5], id[6], id[7]);
            gp[0] = make_float4(ev[0] * inv, ev[1] * inv, ev[2] * inv, ev[3] * inv); gp[1] = make_float4(ev[4] * inv, ev[5] * inv, ev[6] * inv, ev[7] * inv);
        }
    }
    __syncthreads();
}

constexpr int AT_KP = 72, AT_VP = 264;
constexpr int AT_K = 0, AT_VT = 36864, AT_BT = 36864 + 33792;
__device__ __forceinline__ void attn_phase(Frame& F, const Ptrs& P) {
    const bf16* PROJ = (const bf16*)(P.ws + WS_PROJ); bf16* CAT = (bf16*)(P.ws + WS_XN);
    LAS unsigned char* L = F.lds + RING_OFF;
    LAS bf16* Ks = (LAS bf16*)(L + AT_K); LAS bf16* Vt = (LAS bf16*)(L + AT_VT); LAS float* btab = (LAS float*)(L + AT_BT);
    const int lane = lane_id(), tid_ = F.wave * 64 + lane, r = lane & 31, hh = lane >> 5;
    for (int u = F.vcu; u < 256; u += F.G) {
        const int hkv = u & 1, n = (u >> 1) & 31, b = u >> 6;
        const int trow0 = b * SEQ + n * 128;
        for (int i = tid_; i < 2048; i += 512) {
            const int kj = i >> 3, ch = i & 7; const bool ok = (n > 0) || (kj >= 128);
            v4u kv = {0u, 0u, 0u, 0u}, vv = {0u, 0u, 0u, 0u};
            if (ok) { const bf16* rowp = PROJ + (size_t)(trow0 - 128 + kj) * NPROJ + hkv * 64 + ch * 8; kv = *(const v4u*)(rowp + PJ_K); vv = *(const v4u*)(rowp + PJ_V); }
            *(LAS v4u*)(Ks + kj * AT_KP + ch * 8) = kv;
            LAS bf16* vp = Vt + (ch * 8) * AT_VP + kj;
            vp[0] = (bf16)(vv.x & 0xffffu); vp[AT_VP] = (bf16)(vv.x >> 16); vp[2 * AT_VP] = (bf16)(vv.y & 0xffffu); vp[3 * AT_VP] = (bf16)(vv.y >> 16);
            vp[4 * AT_VP] = (bf16)(vv.z & 0xffffu); vp[5 * AT_VP] = (bf16)(vv.z >> 16); vp[6 * AT_VP] = (bf16)(vv.w & 0xffffu); vp[7 * AT_VP] = (bf16)(vv.w >> 16);
        }
        for (int i = tid_; i < 768; i += 512) { const int gg = i / 192, dist = i % 192 - 32;
            btab[i] = (dist >= 0 && dist < 128) ? P.rel_bias[c_bucket[dist & 127] * 8 + hkv * 4 + gg] * LOG2E : 0.f; }
        __syncthreads();
        const int g = F.wave & 3, h = hkv * 4 + g;
        const float sink2 = P.sinks[h] * LOG2E;
#pragma unroll 1
        for (int qq = 0; qq < 2; ++qq) {
            const int qt = (F.wave >> 2) * 2 + qq, t = trow0 + 32 * qt + r;
            bf16x8 qf[4];
#pragma unroll
            for (int kk = 0; kk < 4; ++kk) qf[kk] = *(const bf16x8*)(PROJ + (size_t)t * NPROJ + h * 64 + 16 * kk + 8 * hh);
            f32x16 sc[5];
#pragma unroll
            for (int j = 0; j < 5; ++j) {
#pragma unroll
                for (int i = 0; i < 16; ++i) sc[j][i] = 0.f;
#pragma unroll
                for (int kk = 0; kk < 4; ++kk) { const bf16x8 a = *(const LAS bf16x8*)(Ks + (32 * (qt + j) + r) * AT_KP + 16 * kk + 8 * hh); sc[j] = MFMA32(a, qf[kk], sc[j]); }
            }
            float m = sink2;
            const LAS float* bt = btab + g * 192 + 160 + r - 4 * hh;
#pragma unroll
            for (int j = 0; j < 5; ++j) {
                const bool tile_ok = (n > 0) || (qt + j >= 4);
#pragma unroll
                for (int i = 0; i < 16; ++i) { const int dist = 128 + r - (32 * j + crow(i, hh));
                    const bool ok = tile_ok && (j == 0 ? dist < 128 : (j == 4 ? dist >= 0 : true));
                    const float s = sc[j][i] * (0.125f * LOG2E) + bt[-(32 * j + (i & 3) + 8 * (i >> 2))];
                    sc[j][i] = ok ? s : -INFINITY; m = fmaxf(m, sc[j][i]); }
            }
            m = max_halves(m);
            float l = 0.f;
#pragma unroll
            for (int j = 0; j < 5; ++j)
#pragma unroll
                for (int i = 0; i < 16; ++i) { sc[j][i] = exp2f(sc[j][i] - m); l += sc[j][i]; }
            l = sum_halves(l);
            l += exp2f(sink2 - m);
            const float inv = 1.f / l;
            f32x16 o[2];
#pragma unroll
            for (int i = 0; i < 16; ++i) { o[0][i] = 0.f; o[1][i] = 0.f; }
#pragma unroll
            for (int j = 0; j < 5; ++j)
#pragma unroll
                for (int sg = 0; sg < 2; ++sg) {
                    const bf16x8 pf = pack8(sc[j], sg);
#pragma unroll
                    for (int dt = 0; dt < 2; ++dt) {
                        const LAS bf16* vb = Vt + (32 * dt + r) * AT_VP + 32 * (qt + j) + 16 * sg + 4 * hh;
                        const s16x4 lo = *(const LAS s16x4*)(vb), hi = *(const LAS s16x4*)(vb + 8);
                        o[dt] = MFMA32(__builtin_shufflevector(lo, hi, 0, 1, 2, 3, 4, 5, 6, 7), pf, o[dt]);
                    }
                }
            bf16* op = CAT + (size_t)t * DM + h * 64 + 4 * hh;
#pragma unroll
            for (int dt = 0; dt < 2; ++dt)
#pragma unroll
                for (int g4 = 0; g4 < 4; ++g4)
                    *(unsigned long long*)(op + 32 * dt + 8 * g4) = (unsigned long long)cvtpk(o[dt][4 * g4] * inv, o[dt][4 * g4 + 1] * inv) | ((unsigned long long)cvtpk(o[dt][4 * g4 + 2] * inv, o[dt][4 * g4 + 3] * inv) << 32);
        }
        __syncthreads();
    }
}
struct Args { Ptrs p; };
__global__ void __launch_bounds__(NWAVES * 64, 2) hymba_fwd(Args args) {
    extern __shared__ __attribute__((aligned(16))) unsigned char lds[];
    const Ptrs& P = args.p;
    Frame F;
    F.lds = (LAS unsigned char*)lds;
    F.MISC = (volatile LAS unsigned*)(F.lds + MISC_OFF);
    F.wave = __builtin_amdgcn_readfirstlane(threadIdx.x >> 6);
    F.G = gridDim.x; { const int bx = blockIdx.x; F.vcu = (F.G % 8 == 0) ? (bx % 8) * (F.G / 8) + bx / 8 : bx; }
    F.ctl = (gu32*)(P.ws + WS_CTL);
    for (int u = threadIdx.x; u < (LDS_BYTES - LDSCTL_OFF) / 4; u += NWAVES * 64) ((LAS unsigned*)(F.lds + LDSCTL_OFF))[u] = 0u;
    __syncthreads();
    XcdBarrier bar = xcd_barrier_post((unsigned*)(F.ctl + CW_BAR), F.MISC + 8);
#define GRID_BAR() xcd_barrier(bar)

    bf16* XN = (bf16*)(P.ws + WS_XN); bf16* PROJ = (bf16*)(P.ws + WS_PROJ); bf16* HB = (bf16*)(P.ws + WS_ST);
    p0_prologue(F, P);
    GRID_BAR();
    { pg8::Gemm g{XN, (const bf16*)(P.ws + WS_WIN), T_, NPROJ, DM, F.wave}; pg8::StaticOrder S; S.init(T_, NPROJ, F.G, (int)blockIdx.x);
      pg8::EpiBf16<0> E{PROJ, NPROJ, nullptr, 0, 0, 1.f};
      pg8::gemm_phase<pg8::EpiBf16<0>, pg8::StaticOrder, PG8_ALIGN, PG8_SP2>(F.lds + RING_OFF, g, S, E); }
    if (F.G == 256 && blockIdx.x >= 64) quant_fp6u(P, lane_id(), 0, 8192, ((int)blockIdx.x - 64) * NWAVES + F.wave, 192 * NWAVES);
    else if (F.G != 256) quant_fp6u(P, lane_id(), 0, 8192, F.vcu * NWAVES + F.wave, F.G * NWAVES);
    GRID_BAR();
    ssd_s1(F, P);
    attn_phase(F, P);
    GRID_BAR();
    ssd_s2(F, P);
    GRID_BAR();
    ssd_s3(F, P);
    GRID_BAR();
    { pg8::Gemm g{XN, (const bf16*)(P.ws + WS_WOUT), T_, DM, DM, F.wave}; pg8::StaticOrder S; S.init(T_, DM, F.G, (int)blockIdx.x);
      EpiResH E{P.x, HB, (float*)(P.ws + WS_SSQ)};
      pg8::gemm_phase<EpiResH, pg8::StaticOrder, PG8_ALIGN, PG8_SP2>(F.lds + RING_OFF, g, S, E); }
    GRID_BAR();
    { pg8::Gemm g{HB, (const bf16*)(P.ws + WS_WQ), T_, 2048, DM, F.wave}; pg8::StaticOrder S; S.init(T_, 2048, F.G, (int)blockIdx.x);
      pg8::EpiBf16<0> E{PROJ, 2048, nullptr, 0, 0, 1.f};
      pg8::gemm_phase<pg8::EpiBf16<0>, pg8::StaticOrder, PG8_ALIGN, PG8_SP2>(F.lds + RING_OFF, g, S, E); }
    GRID_BAR();
    topk_phase(F, P);
    h_quant_rows(F, P);
    GRID_BAR();
    { const PeerPlace pp = peer_place(F);
      peer_down(F, P, pp); }
    GRID_BAR();
    peer_up_tm(F, P);
}

extern "C" void kernel_launch(void* const* d_in, const int* in_sizes, int n_in, void* d_out, int out_size, void* d_ws, size_t ws_size, hipStream_t stream) {
    static int grid = 0;
    if (grid == 0) {
        if (n_in != 19 || out_size != T_ * DM || ws_size < WS_END) { fprintf(stderr, "kernel_launch: unexpected shapes (n_in %d, out %d, ws %zu)\n", n_in, out_size, ws_size); grid = -1; return; }
        int dev = 0, cus = 0, per_cu = 0;
        if (hipGetDevice(&dev) != hipSuccess || hipDeviceGetAttribute(&cus, hipDeviceAttributeMultiprocessorCount, dev) != hipSuccess) { grid = -1; return; }
        if (hipFuncSetAttribute((const void*)hymba_fwd, hipFuncAttributeMaxDynamicSharedMemorySize, LDS_BYTES) != hipSuccess) { fprintf(stderr, "kernel_launch: hipFuncSetAttribute failed\n"); grid = -1; return; }
        if (hipOccupancyMaxActiveBlocksPerMultiprocessor(&per_cu, (const void*)hymba_fwd, NWAVES * 64, LDS_BYTES) != hipSuccess || per_cu < 1) { fprintf(stderr, "kernel_launch: occupancy query says %d blocks per CU\n", per_cu); grid = -1; (void)hipGetLastError(); return; }
        grid = cus;
    }
    if (grid < 0) return;
    (void)hipMemsetAsync((char*)d_ws + WS_CTL, 0, CTL_ZERO_BYTES, stream);
    Args a{};
    const float** pp = (const float**)&a.p;
    for (int i = 0; i < 19; ++i) pp[i] = (const float*)d_in[i];
    a.p.out = (float*)d_out; a.p.ws = (unsigned char*)d_ws;
    hipLaunchKernelGGL(hymba_fwd, dim3(grid), dim3(NWAVES * 64), LDS_BYTES, stream, a);
}
```

```cpp
#include <hip/hip_runtime.h>
#include <cstdio>
#include <cstdint>
#include <math.h>
namespace pg8 {
#define PG8_LAS __attribute__((address_space(3)))
typedef unsigned short bf16_t;
typedef short bf16x8 __attribute__((ext_vector_type(8)));
typedef float f32x4 __attribute__((ext_vector_type(4)));
typedef unsigned u32x4 __attribute__((ext_vector_type(4)));
constexpr int BM = 256, BK = 64, HALF = 128, HTB = HALF * BK * 2  , STAGE_BYTES = 8 * HTB, NXCD = 8, WGM = 8;

__host__ __device__ __forceinline__ int lds_byte(int r, int c) { const int st = (r >> 4) * 2 + (c >> 5), rr = r & 15, cc = c & 31, ob = rr * 64 + cc * 2; return st * 1024 + (ob ^ (((ob >> 9) & 1) << 5)); }
__host__ __device__ __forceinline__ void stage_rc(int b, int& R, int& C) { const int st = b / 1024, sb = b % 1024, swz = sb ^ (((sb >> 9) & 1) << 5); R = (st >> 1) * 16 + swz / 64; C = (st & 1) * 32 + (swz % 64) / 2; }
__host__ __device__ __forceinline__ int perm32(int rho) { const int n = rho >> 4, i = rho & 15; return 8 * (i >> 2) + 4 * n + (i & 3); }

struct Unit { int pm, pn; };
struct Gemm { const bf16_t* A; const bf16_t* Bt; int M, N, K, wave; };

struct StaticOrder {
    int nM, nN, nwg, G, c;
    __host__ __device__ void init(int M, int N, int G_, int c_) { nM = M / BM; nN = N / BM; nwg = nM * nN; G = G_; c = c_; }
    __host__ __device__ bool next(int i, Unit& u) const {
        const long L = (long)i * G + c; if (L >= nwg) return false;
        int wgid = (int)L; { const int q = nwg / NXCD, r = nwg % NXCD, xcd = wgid % NXCD, off = wgid / NXCD; wgid = (xcd < r ? xcd * (q + 1) : r * (q + 1) + (xcd - r) * q) + off; }
        const int nig = WGM * nN, gid = wgid / nig, fm = gid * WGM, gsz = (nM - fm) < WGM ? (nM - fm) : WGM;
        u.pm = fm + ((wgid % nig) % gsz); u.pn = (wgid % nig) / gsz; return true;
    }
    __device__ __forceinline__ void a_ready(const Unit&) const {}
    __device__ __forceinline__ void done(const Unit&) const {}
};

__device__ __forceinline__ unsigned cvt_pk_bf16(float lo, float hi) { unsigned r; asm volatile("v_cvt_pk_bf16_f32 %0, %1, %2" : "=v"(r) : "v"(lo), "v"(hi)); return r; }
typedef float f32x2 __attribute__((ext_vector_type(2)));
__device__ __forceinline__ f32x2 gelu_pk(f32x2 v) {
    const f32x2 av = __builtin_elementwise_abs(v), d = av * 0.2316418882f + 1.0f;
    f32x2 t; t.x = __builtin_amdgcn_rcpf(d.x); t.y = __builtin_amdgcn_rcpf(d.y);
    f32x2 q = t * 0.5307027145f + (-0.7265760135f); q = q * t + 0.7107068705f; q = q * t + (-0.142248368f); q = q * t + 0.127414796f; q = q * t;
    const f32x2 s = (v * v) * (-0.72134752044f);
    f32x2 e; e.x = __builtin_amdgcn_exp2f(s.x); e.y = __builtin_amdgcn_exp2f(s.y);
    const f32x2 m = v * (q * e), r = v - m;
    f32x2 o; o.x = v.x < 0.f ? m.x : r.x; o.y = v.y < 0.f ? m.y : r.y; return o;
}

template <int ACT  > struct EpiBf16 {
    static constexpr bool PERM = true, AFTER_DRAIN = false; static_assert(ACT == 0 || ACT == 1, "EpiBf16: ACT is 0 (none) or 1 (gelu_pk)");
    bf16_t* O; int ldc; const float* bias; int split_cols; size_t split_stride; float scale0;
    __device__ __forceinline__ void operator()(const f32x4 (&acc)[2][2][4][2], const Unit& u, int wr, int wc, int fr, int fq) const {
        const int row0 = u.pm * BM + wr * 64 + fr; int colt = u.pn * BM; bf16_t* base = O;
        float sc = 1.f; if (split_cols) { const int t = colt / split_cols; base += (size_t)t * split_stride; colt -= t * split_cols; if (t == 0) sc = scale0; }
        const int col0 = colt + wc * 32 + 8 * fq, bcol0 = u.pn * BM + wc * 32 + 8 * fq;
        f32x4 bv[2][2];
#pragma unroll
        for (int bj = 0; bj < 2; ++bj)
#pragma unroll
            for (int n = 0; n < 2; ++n) bv[bj][n] = bias ? *(const f32x4*)(bias + bcol0 + bj * HALF + 4 * n) : (f32x4){0.f, 0.f, 0.f, 0.f};
#pragma unroll
        for (int ai = 0; ai < 2; ++ai)
#pragma unroll
            for (int m = 0; m < 4; ++m) { bf16_t* rowp = base + (size_t)(row0 + ai * HALF + m * 16) * ldc + col0;
#pragma unroll
                for (int bj = 0; bj < 2; ++bj) { f32x4 v0 = acc[ai][bj][m][0] + bv[bj][0], v1 = acc[ai][bj][m][1] + bv[bj][1];
                    if (ACT == 1) { f32x2 a = gelu_pk((f32x2){v0[0], v0[1]}), b = gelu_pk((f32x2){v0[2], v0[3]}), c = gelu_pk((f32x2){v1[0], v1[1]}), d = gelu_pk((f32x2){v1[2], v1[3]});
                        v0 = (f32x4){a.x, a.y, b.x, b.y}; v1 = (f32x4){c.x, c.y, d.x, d.y}; }
                    v0 = v0 * sc; v1 = v1 * sc; u32x4 w; w.x = cvt_pk_bf16(v0[0], v0[1]); w.y = cvt_pk_bf16(v0[2], v0[3]); w.z = cvt_pk_bf16(v1[0], v1[1]); w.w = cvt_pk_bf16(v1[2], v1[3]);
                    *(u32x4*)(rowp + bj * HALF) = w; } }
    }
};
template <class Epi, class Sched, bool ALIGN_EPI = false, bool SP2 = false>
__device__ __forceinline__ void gemm_phase(PG8_LAS unsigned char* lds, const Gemm g, const Sched& S, const Epi& E) {
    int lane_l; asm volatile("v_mbcnt_lo_u32_b32 %0, -1, 0\n\tv_mbcnt_hi_u32_b32 %0, -1, %0" : "=v"(lane_l));
    const int wid = g.wave, lane = lane_l, tid = wid * 64 + lane,
              wr = wid >> 2, wc = wid & 3, fr = lane & 15, fq = lane >> 4;
    const int K = g.K, nt = K / BK;
    unsigned voffA[2], voffB[2];
#pragma unroll
    for (int i = 0; i < 2; ++i) { int R, C; stage_rc(tid * 16 + i * 8192, R, C); const int Rb = Epi::PERM ? ((R & ~31) + perm32(R & 31)) : R;
        voffA[i] = (unsigned)(R * K + C) * 2u; voffB[i] = (unsigned)(Rb * K + C) * 2u; }
    const size_t kstep = (size_t)(BK * 2);
    const size_t hstep = (size_t)HALF * K * 2;
    const size_t tstep = 2 * hstep;
    const unsigned ldsw = (unsigned)wid * 1024u;
    const int aoff = lds_byte(wr * 64 + fr, fq * 8), boff = lds_byte(wc * 32 + fr, fq * 8);
#define PG8_SA(b, h) (((b) * 2 + (h)) * HTB)
#define PG8_SB(b, h) ((4 + (b) * 2 + (h)) * HTB)
#define PG8_STAGE(bufoff, gbase, voff) do { _Pragma("unroll") for (int _i = 0; _i < 2; ++_i) \
        __builtin_amdgcn_global_load_lds((const unsigned*)((const char*)(gbase) + (voff)[_i]), (PG8_LAS unsigned*)(lds + (bufoff) + ldsw + _i * 8192), 16, 0, 0); } while (0)
#define PG8_LDA(dst, b, h) do { _Pragma("unroll") for (int m = 0; m < 4; ++m) _Pragma("unroll") for (int k = 0; k < 2; ++k) dst[m][k] = *(const PG8_LAS bf16x8*)(lds + PG8_SA(b, h) + aoff + m * 2048 + k * 1024); } while (0)
#define PG8_LDB(dst, b, h) do { _Pragma("unroll") for (int n = 0; n < 2; ++n) _Pragma("unroll") for (int k = 0; k < 2; ++k) dst[n][k] = *(const PG8_LAS bf16x8*)(lds + PG8_SB(b, h) + boff + n * 2048 + k * 1024); } while (0)
#define PG8_MMA(ai, bj, At, Bt) do { __builtin_amdgcn_s_setprio(1); _Pragma("unroll") for (int m = 0; m < 4; ++m) _Pragma("unroll") for (int n = 0; n < 2; ++n) _Pragma("unroll") for (int k = 0; k < 2; ++k) \
        acc[ai][bj][m][n] = __builtin_amdgcn_mfma_f32_16x16x32_bf16(Bt[n][k], At[m][k], acc[ai][bj][m][n], 0, 0, 0); __builtin_amdgcn_s_setprio(0); } while (0)
#define PG8_WAIT_V(n) asm volatile("s_waitcnt vmcnt(" #n ")" ::: "memory")
#define PG8_WAIT_L(n) asm volatile("s_waitcnt lgkmcnt(" #n ")" ::: "memory")
#define PG8_BAR __builtin_amdgcn_s_barrier()
#define PG8_SCHED __builtin_amdgcn_sched_barrier(0)
    Unit cur, nxt; int ui = 0;
    if (!S.next(0, cur)) return;
    f32x4 acc[2][2][4][2];
#pragma unroll
    for (int a = 0; a < 2; ++a)
#pragma unroll
        for (int b = 0; b < 2; ++b)
#pragma unroll
            for (int m = 0; m < 4; ++m)
#pragma unroll
                for (int n = 0; n < 2; ++n) acc[a][b][m][n] = (f32x4){0.f, 0.f, 0.f, 0.f};
    bf16x8 At[4][2], B0[2][2], B1[2][2];
    const char* cA = (const char*)g.A + (size_t)cur.pm * tstep; const char* cB = (const char*)g.Bt + (size_t)cur.pn * tstep;
    S.a_ready(cur);
    if constexpr (SP2) {
        PG8_STAGE(PG8_SB(0, 0), cB, voffB); PG8_STAGE(PG8_SB(0, 1), cB + hstep, voffB); PG8_STAGE(PG8_SA(0, 0), cA, voffA); PG8_STAGE(PG8_SA(0, 1), cA + hstep, voffA);
        if (wr == 1) PG8_BAR;
        PG8_WAIT_V(2); PG8_BAR;
        PG8_STAGE(PG8_SB(1, 0), cB + kstep, voffB); PG8_STAGE(PG8_SA(1, 0), cA + kstep, voffA); PG8_STAGE(PG8_SB(1, 1), cB + hstep + kstep, voffB);
        PG8_WAIT_V(6); PG8_BAR;
    } else {
        PG8_STAGE(PG8_SB(0, 0), cB, voffB); PG8_STAGE(PG8_SA(0, 0), cA, voffA); PG8_STAGE(PG8_SB(0, 1), cB + hstep, voffB); PG8_STAGE(PG8_SA(0, 1), cA + hstep, voffA);
        if (wr == 1) PG8_BAR;
        PG8_WAIT_V(4); PG8_BAR;
        PG8_STAGE(PG8_SB(1, 0), cB + kstep, voffB); PG8_STAGE(PG8_SA(1, 0), cA + kstep, voffA); PG8_STAGE(PG8_SB(1, 1), cB + hstep + kstep, voffB);
        PG8_WAIT_V(6); PG8_BAR;
    }
    for (;;) {
        const bool has_next = S.next(ui + 1, nxt);
        const char* nA = has_next ? (const char*)g.A + (size_t)nxt.pm * tstep : cA; const char* nB = has_next ? (const char*)g.Bt + (size_t)nxt.pn * tstep : cB;
        for (int t = 0; t < nt; t += 2) {
            const bool last = (t == nt - 2);
            const char* a1 = cA + (size_t)(t + 1) * kstep;
            const char* a2 = last ? nA : cA + (size_t)(t + 2) * kstep; const char* b2 = last ? nB : cB + (size_t)(t + 2) * kstep;
            const char* a3 = a2 + kstep; const char* b3 = b2 + kstep;
            if (last && has_next) S.a_ready(nxt);
            if constexpr (SP2) {
            PG8_LDB(B0, 0, 0); PG8_LDB(B1, 0, 1); PG8_SCHED; PG8_LDA(At, 0, 0); PG8_STAGE(PG8_SA(1, 1), a1 + hstep, voffA);
            PG8_WAIT_V(8); PG8_WAIT_L(0); PG8_BAR; PG8_MMA(0, 0, At, B0); PG8_MMA(0, 1, At, B1); PG8_BAR; PG8_SCHED;
            PG8_LDA(At, 0, 1); PG8_STAGE(PG8_SB(0, 0), b2, voffB); PG8_STAGE(PG8_SB(0, 1), b2 + hstep, voffB); PG8_STAGE(PG8_SA(0, 0), a2, voffA);
            PG8_WAIT_V(8); PG8_WAIT_L(0); PG8_BAR; PG8_MMA(1, 0, At, B0); PG8_MMA(1, 1, At, B1); PG8_BAR; PG8_SCHED;
            PG8_LDB(B0, 1, 0); PG8_LDB(B1, 1, 1); PG8_SCHED; PG8_LDA(At, 1, 0); PG8_STAGE(PG8_SA(0, 1), a2 + hstep, voffA);
            PG8_WAIT_V(8); PG8_WAIT_L(0); PG8_BAR; PG8_MMA(0, 0, At, B0); PG8_MMA(0, 1, At, B1); PG8_BAR; PG8_SCHED;
            PG8_LDA(At, 1, 1); PG8_STAGE(PG8_SB(1, 0), b3, voffB); PG8_STAGE(PG8_SB(1, 1), b3 + hstep, voffB); PG8_STAGE(PG8_SA(1, 0), a3, voffA);
            PG8_WAIT_V(8); PG8_WAIT_L(0); PG8_BAR; PG8_MMA(1, 0, At, B0); PG8_MMA(1, 1, At, B1); PG8_BAR; PG8_SCHED;
            } else {
            PG8_LDB(B0, 0, 0); PG8_SCHED; PG8_LDA(At, 0, 0); PG8_STAGE(PG8_SA(1, 1), a1 + hstep, voffA);
            PG8_WAIT_L(8); PG8_BAR; PG8_WAIT_L(0); PG8_MMA(0, 0, At, B0); PG8_BAR; PG8_SCHED;
            PG8_LDB(B1, 0, 1); PG8_STAGE(PG8_SB(0, 0), b2, voffB);
            PG8_BAR; PG8_WAIT_L(0); PG8_MMA(0, 1, At, B1); PG8_BAR;
            PG8_LDA(At, 0, 1); PG8_STAGE(PG8_SA(0, 0), a2, voffA);
            PG8_BAR; PG8_WAIT_L(0); PG8_MMA(1, 0, At, B0); PG8_BAR; PG8_SCHED;
            PG8_STAGE(PG8_SB(0, 1), b2 + hstep, voffB);
            PG8_WAIT_V(6); PG8_BAR; PG8_MMA(1, 1, At, B1); PG8_BAR;
            PG8_LDB(B0, 1, 0); PG8_SCHED; PG8_LDA(At, 1, 0); PG8_STAGE(PG8_SA(0, 1), a2 + hstep, voffA);
            PG8_WAIT_L(8); PG8_BAR; PG8_WAIT_L(0); PG8_MMA(0, 0, At, B0); PG8_BAR; PG8_SCHED;
            PG8_LDB(B1, 1, 1); PG8_STAGE(PG8_SB(1, 0), b3, voffB);
            PG8_BAR; PG8_WAIT_L(0); PG8_MMA(0, 1, At, B1); PG8_BAR;
            PG8_LDA(At, 1, 1); PG8_STAGE(PG8_SA(1, 0), a3, voffA);
            PG8_BAR; PG8_WAIT_L(0); PG8_MMA(1, 0, At, B0); PG8_BAR; PG8_SCHED;
            PG8_STAGE(PG8_SB(1, 1), b3 + hstep, voffB);
            PG8_WAIT_V(6); PG8_BAR; PG8_MMA(1, 1, At, B1); PG8_BAR;
            }
        }
        if constexpr (ALIGN_EPI) { if (wr == 0) PG8_BAR; }
        if constexpr (!Epi::AFTER_DRAIN) { E(acc, cur, wr, wc, fr, fq); S.done(cur); }
        if (!has_next) break;
#pragma unroll
        for (int a = 0; a < 2; ++a)
#pragma unroll
            for (int b = 0; b < 2; ++b)
#pragma unroll
                for (int m = 0; m < 4; ++m)
#pragma unroll
                    for (int n = 0; n < 2; ++n) acc[a][b][m][n] = (f32x4){0.f, 0.f, 0.f, 0.f};
        cur = nxt; cA = nA; cB = nB; ++ui;
        if constexpr (ALIGN_EPI) { if (wr == 1) PG8_BAR; }
    }
    PG8_WAIT_V(0);
    if constexpr (!ALIGN_EPI) { if (wr == 0) PG8_BAR; }
    PG8_BAR;
    if constexpr (Epi::AFTER_DRAIN) { E.fused(acc, cur, wr, wc, fr, fq, lds, wid, lane); S.done(cur); }
#undef PG8_SA
#undef PG8_SB
#undef PG8_STAGE
#undef PG8_LDA
#undef PG8_LDB
#undef PG8_MMA
#undef PG8_WAIT_V
#undef PG8_WAIT_L
#undef PG8_BAR
#undef PG8_SCHED
}
}

#ifndef PG8_SP2
#define PG8_SP2 true
#endif
#ifndef PG8_ALIGN
#define PG8_ALIGN true
#endif
#define GAS __attribute__((address_space(1)))
#define LAS __attribute__((address_space(3)))
typedef unsigned short bf16;
typedef unsigned v4u __attribute__((ext_vector_type(4)));
typedef float f32x4 __attribute__((ext_vector_type(4)));
typedef short bf16x8 __attribute__((ext_vector_type(8)));
typedef GAS unsigned gu32;
typedef GAS unsigned long long gu64;
#define RLX_AGENT __ATOMIC_RELAXED, __HIP_MEMORY_SCOPE_AGENT
#define LDS_WAIT() asm volatile("s_waitcnt lgkmcnt(0)" ::: "memory")
#define VM_WAIT() asm volatile("s_waitcnt vmcnt(0)" ::: "memory")
__device__ __forceinline__ unsigned long long rt() { return __builtin_amdgcn_s_memrealtime(); }
__device__ __forceinline__ unsigned f2bf(float f) { unsigned u = __builtin_bit_cast(unsigned, f); return (u + 0x7fffu + ((u >> 16) & 1u)) >> 16; }
__device__ __forceinline__ unsigned pk2(float lo, float hi) { return f2bf(lo) | (f2bf(hi) << 16); }

#define XB_TMO      128
#define XB_XCNT(j)  (256  + 64 * (j))
#define XB_XSUB(j)  (1280 + 64 * (j))
#define XB_XGEN(j)  (2304 + 64 * (j))
#define XB_TOP      3328
#define XB_TOPGEN   3392
#define XCD_BAR_WORDS 3456
#define XB_SPIN_CAP (1u << 22)

__device__ __forceinline__ unsigned xb_ld(unsigned* p)              { return __hip_atomic_load(p, __ATOMIC_RELAXED, __HIP_MEMORY_SCOPE_AGENT); }
__device__ __forceinline__ unsigned xb_add(unsigned* p, unsigned v) { return __hip_atomic_fetch_add(p, v, __ATOMIC_RELAXED, __HIP_MEMORY_SCOPE_AGENT); }
__device__ __forceinline__ unsigned xb_xcc_id() { return (unsigned)__builtin_amdgcn_s_getreg((3 << 11) | 20) & 0xFu; }
#define XB_SPIN(cond, bar) do { unsigned _sp = 0; while (cond) { __builtin_amdgcn_s_sleep(1); \
    if ((++_sp & 255u) == 0u) { if (xb_ld(&(bar)[XB_TMO])) break; if (_sp > XB_SPIN_CAP) { atomicAdd(&(bar)[XB_TMO], 1u); break; } } } } while (0)

struct XcdBarrier {
    unsigned* bar; unsigned x;
    volatile LAS unsigned* st;
};

__device__ __forceinline__ XcdBarrier xcd_barrier_post(unsigned* bar, volatile LAS unsigned* st) {
    XcdBarrier b; b.bar = bar; b.x = xb_xcc_id(); b.st = st;
    if (threadIdx.x == 0) (void)xb_add(&bar[XB_XCNT(b.x)], 1u);
    return b;
}
__device__ __forceinline__ void xcd_barrier_complete(unsigned* bar, unsigned x, unsigned& nloc, unsigned& nx) {
    const unsigned G = gridDim.x * gridDim.y * gridDim.z;
    unsigned sum, cnt, mine, sp = 0u;
    for (;;) {
        sum = 0u; cnt = 0u; mine = 0u;
#pragma unroll
        for (unsigned j = 0; j < 16; ++j) { const unsigned c = xb_ld(&bar[XB_XCNT(j)]); sum += c; cnt += (c > 0u) ? 1u : 0u; mine = (j == x) ? c : mine; }
        if (sum == G) break;
        __builtin_amdgcn_s_sleep(1);
        if ((++sp & 255u) == 0u) { if (xb_ld(&bar[XB_TMO])) break; if (sp > XB_SPIN_CAP) { atomicAdd(&bar[XB_TMO], 1u); break; } }
    }
    nloc = mine > 0u ? mine : 1u; nx = cnt > 0u ? cnt : 1u;
}

__device__ __forceinline__ void xcd_barrier(const XcdBarrier& b) {
    asm volatile("s_waitcnt vmcnt(0)" ::: "memory");
    __syncthreads();
    if (threadIdx.x == 0) {
        unsigned* bar = b.bar;
        __builtin_amdgcn_s_waitcnt(0);
        unsigned nloc = b.st[0], nx = b.st[1];
        if (nloc == 0u) { xcd_barrier_complete(bar, b.x, nloc, nx); b.st[0] = nloc; b.st[1] = nx; }
        const unsigned old = xb_add(&bar[XB_XSUB(b.x)], 1u);
        const unsigned gen = old / nloc;
        if (old + 1u == (gen + 1u) * nloc) {
            __builtin_amdgcn_fence(__ATOMIC_RELEASE, "agent");
            asm volatile("s_waitcnt vmcnt(0)" ::: "memory");
            const unsigned og = xb_add(&bar[XB_TOP], 1u);
            const unsigned tg = og / nx;
            if (og + 1u == (tg + 1u) * nx) xb_add(&bar[XB_TOPGEN], 1u);
            else XB_SPIN(xb_ld(&bar[XB_TOPGEN]) == tg, bar);
            __builtin_amdgcn_fence(__ATOMIC_ACQUIRE, "agent");
            xb_add(&bar[XB_XGEN(b.x)], 1u);
            asm volatile("s_waitcnt vmcnt(0)" ::: "memory");
        } else {
            XB_SPIN(xb_ld(&bar[XB_XGEN(b.x)]) == gen, bar);
            __builtin_amdgcn_fence(__ATOMIC_ACQUIRE, "agent");
            asm volatile("s_waitcnt vmcnt(0)" ::: "memory");
        }
    }
    __syncthreads();
}

constexpr int NWAVES = 8;
constexpr int T_ = 16384, SEQ = 4096, DM = 1024, NPROJ = 2304, INC = 2312;
constexpr int PJ_K = 512, PJ_V = 640, PJ_Z = 768, PJ_XBC = 1280;
constexpr float EPS = 1e-6f;
constexpr size_t MiB = 1u << 20;
constexpr size_t WS_CTL = 0, CTL_ZERO_BYTES = 1 * MiB;
constexpr size_t WS_SMALL = 1 * MiB;
constexpr size_t WS_WIN = 2 * MiB, WS_WOUT = 7 * MiB, WS_WQ = 9 * MiB;
constexpr size_t WS_ED = 13 * MiB, WS_EU = 29 * MiB;
constexpr size_t WS_XN = 77 * MiB;
constexpr size_t WS_PROJ = 109 * MiB;
constexpr size_t WS_ST = 181 * MiB;
constexpr size_t WS_IDX = 213 * MiB, WS_GATE = 221 * MiB, WS_SSQ = 229 * MiB, WS_END = 230 * MiB;
constexpr size_t DO_Y = 0, DO_DT = 41 * MiB;
constexpr size_t WS_CC = 230 * MiB, WS_DT = 238 * MiB, WS_EA = 239 * MiB, WS_CDEC = 240 * MiB, WS_PREV = WS_IDX;
constexpr size_t DO_YPF = 0, DO_YPLAIN = 32 * MiB;
constexpr size_t WS_PART = WS_PROJ;
constexpr size_t WS_H8 = WS_XN, WS_HS = WS_DT;
constexpr size_t WS_SSQ2 = WS_EA;
constexpr int CW_BAR = 4096, CW_RANK = 8192;
constexpr int RING_OFF = 0, RING_BYTES = 147456, LDSCTL_OFF = RING_BYTES, MISC_OFF = LDSCTL_OFF + 320, LDS_BYTES = 163840;

__constant__ unsigned char c_bucket[128] = {0, 1, 2, 3, 4, 5, 6, 7, 8, 9, 10, 11, 12, 13, 14, 15, 16, 16, 16, 17, 17, 18, 18, 18, 19, 19, 19, 20, 20, 20, 20, 21, 21, 21, 21, 22, 22, 22, 22, 22, 23, 23, 23, 23, 23, 23, 24, 24, 24, 24, 24, 24, 25, 25, 25, 25, 25, 25, 25, 26, 26, 26, 26, 26, 26, 26, 26, 27, 27, 27, 27, 27, 27, 27, 27, 27, 27, 28, 28, 28, 28, 28, 28, 28, 28, 28, 28, 29, 29, 29, 29, 29, 29, 29, 29, 29, 29, 29, 29, 30, 30, 30, 30, 30, 30, 30, 30, 30, 30, 30, 30, 30, 30, 31, 31, 31, 31, 31, 31, 31, 31, 31, 31, 31, 31, 31, 31, 31};

typedef float v16f __attribute__((ext_vector_type(16)));
typedef float v32f __attribute__((ext_vector_type(32)));
typedef unsigned v6u __attribute__((ext_vector_type(6)));
typedef _Float16 v32h __attribute__((ext_vector_type(32)));
struct Frame {
    LAS unsigned char* lds;
    volatile LAS unsigned* MISC;
    gu32* ctl;
    int wave, vcu, G;
};
__device__ __forceinline__ int lane_id() { int l; asm volatile("v_mbcnt_lo_u32_b32 %0, -1, 0\n\tv_mbcnt_hi_u32_b32 %0, -1, %0" : "=v"(l)); return l; }
__device__ __forceinline__ int opq(int x) { asm volatile("" : "+v"(x)); return x; }
template <int M> __device__ __forceinline__ float swz_xor(float v) { return __int_as_float(__builtin_amdgcn_ds_swizzle(__float_as_int(v), (M << 10) | 0x1F)); }
__device__ __forceinline__ float sum_halves(float v) { const auto r = __builtin_amdgcn_permlane32_swap(__float_as_uint(v), __float_as_uint(v), false, false); return __uint_as_float(r[0]) + __uint_as_float(r[1]); }
__device__ __forceinline__ float max_halves(float v) { const auto r = __builtin_amdgcn_permlane32_swap(__float_as_uint(v), __float_as_uint(v), false, false); return fmaxf(__uint_as_float(r[0]), __uint_as_float(r[1])); }
__device__ __forceinline__ int imax_halves(int v) { const auto r = __builtin_amdgcn_permlane32_swap((unsigned)v, (unsigned)v, false, false); return max((int)r[0], (int)r[1]); }
__device__ __forceinline__ float wave_sum(float v) {
    v += swz_xor<1>(v); v += swz_xor<2>(v); v += swz_xor<4>(v); v += swz_xor<8>(v); v += swz_xor<16>(v);
    return sum_halves(v);
}
__device__ __forceinline__ float bf2f(unsigned short b) { return __uint_as_float((unsigned)b << 16); }
__device__ __forceinline__ float bflo(unsigned w) { return __uint_as_float(w << 16); }
__device__ __forceinline__ float bfhi(unsigned w) { return __uint_as_float(w & 0xffff0000u); }
__device__ __forceinline__ float silu_f(float x) { return x / (1.f + __expf(-x)); }

__device__ __forceinline__ void p0_transpose_item(const float* W, int ldw, int K, int nblk, bf16* WT, const float* kscale, LAS float* scr, int item, int lane) {
    const int kb = item / nblk, nb = item % nblk, k0 = 64 * kb, n0 = 32 * nb;
#pragma unroll 8
    for (int i = 0; i < 32; ++i) { const int kk = 2 * i + (lane >> 5); float v = W[(size_t)(k0 + kk) * ldw + n0 + (lane & 31)]; if (kscale) v *= kscale[k0 + kk]; scr[kk * 33 + (lane & 31)] = v; }
    LDS_WAIT(); asm volatile("" ::: "memory");
    const int c = lane & 7;
#pragma unroll
    for (int j = 0; j < 4; ++j) { const int n = (lane >> 3) + 8 * j; const LAS float* s = scr + (8 * c) * 33 + n;
        v4u o; o.x = pk2(s[0 * 33], s[1 * 33]); o.y = pk2(s[2 * 33], s[3 * 33]); o.z = pk2(s[4 * 33], s[5 * 33]); o.w = pk2(s[6 * 33], s[7 * 33]);
        *(GAS v4u*)(WT + (size_t)(n0 + n) * K + k0 + 8 * c) = o; }
    LDS_WAIT(); asm volatile("" ::: "memory");
}
struct Ptrs {
    const float *x, *norm_mix, *w_in, *conv_w, *conv_b, *dt_bias, *a_log, *d_skip, *ssd_norm_w, *sinks, *w_out, *rel_bias, *norm_ffn, *w_query, *sk1, *sk2, *e_down, *e_up, *norm_final;
    float* out; unsigned char* ws;
};
constexpr int Q_SPLIT = 16384;
__device__ __forceinline__ unsigned pack4_i8(float a, float b, float c, float d) {
    const int ia = __float2int_rn(a), ib = __float2int_rn(b), ic = __float2int_rn(c), id = __float2int_rn(d);
    return (unsigned)(ia & 0xff) | ((unsigned)(ib & 0xff) << 8) | ((unsigned)(ic & 0xff) << 16) | ((unsigned)(id & 0xff) << 24);
}
__device__ __forceinline__ unsigned pack8_i4(const float* v, float inv) {
    unsigned o = 0u;
#pragma unroll
    for (int i = 0; i < 8; ++i) { int q = __float2int_rn(v[i] * inv); q = q < -7 ? -7 : (q > 7 ? 7 : q); o |= ((unsigned)q & 15u) << (4 * i); }
    return o;
}
__device__ __forceinline__ void quant_fp8s(const Ptrs& P, int lane_, int r_lo, int r_hi, int w, int nw) {
    float* SC = (float*)(P.ws + WS_SMALL);
    for (int row = r_lo + w; row < r_hi; row += nw) {
        const int e = row & 16383;
        const float4* src = (const float4*)(P.e_down + (size_t)e * DM) + 4 * lane_;
        float v[16];
#pragma unroll
        for (int q = 0; q < 4; ++q) { const float4 t = src[q]; const float4 w4 = ((const float4*)P.norm_ffn)[4 * lane_ + q]; v[4 * q] = t.x * w4.x; v[4 * q + 1] = t.y * w4.y; v[4 * q + 2] = t.z * w4.z; v[4 * q + 3] = t.w * w4.w; }
        float ss = 0.f;
#pragma unroll
        for (int q = 0; q < 16; ++q) ss = fmaf(v[q], v[q], ss);
        const float sc = fmaxf(2.5f * sqrtf(wave_sum(ss) * (1.f / 1024.f)) * (1.f / 7.f), 1e-30f);
        const float inv = 1.f / sc;
        const unsigned long long o = (unsigned long long)pack8_i4(v, inv) | ((unsigned long long)pack8_i4(v + 8, inv) << 32);
        *(unsigned long long*)(P.ws + WS_ED + ((size_t)(lane_ >> 4) * 16384 + e) * 128 + (lane_ & 15) * 8) = o;
        if (lane_ == 0) SC[row] = sc;
    }
}
typedef float f32x2q __attribute__((ext_vector_type(2)));
__device__ __forceinline__ void quant_fp6u(const Ptrs& P, int lane_, int q_lo, int q_hi, int w, int nw) {
    { float* SC = (float*)(P.ws + WS_SMALL); const int l31 = lane_ & 31, hf = lane_ >> 5;
      for (int q = q_lo + w; q < q_hi; q += nw) {
        const int e = 2 * q + hf, row = 16384 + e;
        const float4* src = (const float4*)(P.e_up + (size_t)e * DM) + 8 * l31;
        float v[32];
#pragma unroll
        for (int k = 0; k < 8; ++k) { const float4 t = src[k]; v[4 * k] = t.x; v[4 * k + 1] = t.y; v[4 * k + 2] = t.z; v[4 * k + 3] = t.w; }
        float am = 0.f;
#pragma unroll
        for (int k = 0; k < 32; ++k) am = fmaxf(am, fabsf(v[k]));
        am = fmaxf(am, swz_xor<1>(am)); am = fmaxf(am, swz_xor<2>(am)); am = fmaxf(am, swz_xor<4>(am)); am = fmaxf(am, swz_xor<8>(am)); am = fmaxf(am, swz_xor<16>(am));
        am = fmaxf(am, 1e-30f);
        const float inv = 6.0f / am;
        unsigned pk[4];
#pragma unroll
        for (int wd = 0; wd < 4; ++wd) { unsigned p4 = 0u;
            p4 = __builtin_amdgcn_cvt_scalef32_pk_fp4_f32(p4, v[8 * wd] * inv, v[8 * wd + 1] * inv, 1.0f, 0);
            p4 = __builtin_amdgcn_cvt_scalef32_pk_fp4_f32(p4, v[8 * wd + 2] * inv, v[8 * wd + 3] * inv, 1.0f, 1);
            p4 = __builtin_amdgcn_cvt_scalef32_pk_fp4_f32(p4, v[8 * wd + 4] * inv, v[8 * wd + 5] * inv, 1.0f, 2);
            p4 = __builtin_amdgcn_cvt_scalef32_pk_fp4_f32(p4, v[8 * wd + 6] * inv, v[8 * wd + 7] * inv, 1.0f, 3);
            pk[wd] = p4; }
        *(v4u*)(P.ws + WS_EU + (size_t)e * 512 + 16 * l31) = (v4u){pk[0], pk[1], pk[2], pk[3]};
        if (l31 == 0) SC[row] = am * (1.f / 6.0f);
      } }
}
__device__ __forceinline__ void p0_prologue(Frame& F0, const Ptrs& P) {
    const Frame& F = F0; const int lane_ = lane_id(), tid_ = F.wave * 64 + lane_;
    LAS float* scr = (LAS float*)(F.lds + RING_OFF + F.wave * 16384);
    const int gw = F.vcu * NWAVES + F.wave, NGW = F.G * NWAVES;
    bf16* Win_t = (bf16*)(P.ws + WS_WIN); bf16* Wout_t = (bf16*)(P.ws + WS_WOUT); bf16* Wq_t = (bf16*)(P.ws + WS_WQ);
    constexpr int I_IN = 16 * 72, I_OUT = 16 * 32, I_Q = 16 * 64, NITEMS = I_IN + I_OUT + I_Q;
    for (int it = gw; it < NITEMS; it += NGW) {
        int r = it;
        if (r < I_IN) { p0_transpose_item(P.w_in, INC, DM, 72, Win_t, nullptr, scr, r, lane_); continue; } r -= I_IN;
        if (r < I_OUT) { p0_transpose_item(P.w_out, DM, DM, 32, Wout_t, nullptr, scr, r, lane_); continue; } r -= I_OUT;
        p0_transpose_item(P.w_query, 2048, DM, 64, Wq_t, P.norm_ffn, scr, r, lane_);
    }
    quant_fp8s(P, lane_, 0, Q_SPLIT, gw, NGW);
    __syncthreads();
    { LAS float* Wdt = (LAS float*)(F.lds + RING_OFF);
      for (int i = tid_; i < 8192; i += 512) Wdt[i] = P.w_in[(size_t)(i >> 3) * INC + NPROJ + (i & 7)];
      __syncthreads();
      bf16* XN = (bf16*)(P.ws + WS_XN); float* DT = (float*)(P.ws + WS_DT);
      for (int m0 = gw * 2; m0 < T_; m0 += NGW * 2) {
        float4 xv[2][4];
#pragma unroll
        for (int rr = 0; rr < 2; ++rr) { const float4* xr = (const float4*)(P.x + (size_t)(m0 + rr) * DM);
#pragma unroll
            for (int j = 0; j < 4; ++j) xv[rr][j] = xr[j * 64 + lane_]; }
#pragma unroll
        for (int rr = 0; rr < 2; ++rr) { const int m = m0 + rr;
        float4 v[4]; float s = 0.f;
#pragma unroll
        for (int j = 0; j < 4; ++j) { v[j] = xv[rr][j]; s += v[j].x * v[j].x + v[j].y * v[j].y + v[j].z * v[j].z + v[j].w * v[j].w; }
        const float r = rsqrtf(wave_sum(s) * (1.f / 1024.f) + EPS);
        float d8[8];
#pragma unroll
        for (int q = 0; q < 8; ++q) d8[q] = 0.f;
        unsigned long long* o8 = (unsigned long long*)(XN + (size_t)m * DM);
#pragma unroll
        for (int j = 0; j < 4; ++j) { const float4 w = ((const float4*)P.norm_mix)[j * 64 + lane_];
            const float e0 = v[j].x * r * w.x, e1 = v[j].y * r * w.y, e2 = v[j].z * r * w.z, e3 = v[j].w * r * w.w;
            o8[j * 64 + lane_] = (unsigned long long)pk2(e0, e1) | ((unsigned long long)pk2(e2, e3) << 32);
            const float ev[4] = {e0, e1, e2, e3};
#pragma unroll
            for (int e = 0; e < 4; ++e) { const LAS f32x4* wr = (const LAS f32x4*)(Wdt + (size_t)(j * 256 + lane_ * 4 + e) * 8); const f32x4 w0 = wr[0], w1 = wr[1];
                d8[0] += ev[e] * w0.x; d8[1] += ev[e] * w0.y; d8[2] += ev[e] * w0.z; d8[3] += ev[e] * w0.w; d8[4] += ev[e] * w1.x; d8[5] += ev[e] * w1.y; d8[6] += ev[e] * w1.z; d8[7] += ev[e] * w1.w; } }
#pragma unroll
        for (int q = 0; q < 8; ++q) d8[q] = wave_sum(d8[q]);
        if (lane_ == 0) { float4* dp = (float4*)(DT + (size_t)m * 8); dp[0] = make_float4(d8[0], d8[1], d8[2], d8[3]); dp[1] = make_float4(d8[4], d8[5], d8[6], d8[7]); }
        }
      }
      __syncthreads(); }
}

struct EpiResH {
    static constexpr bool PERM = false, AFTER_DRAIN = false;
    const float* X; bf16* HB; float* SSQ;
    __device__ __forceinline__ void operator()(const pg8::f32x4 (&acc)[2][2][4][2], const pg8::Unit& u, int wr, int wc, int fr, int fq) const {
        const int row0 = u.pm * 256 + wr * 64 + fr, col0 = u.pn * 256 + wc * 32 + 4 * fq;
#pragma unroll
        for (int ai = 0; ai < 2; ++ai)
#pragma unroll
            for (int m = 0; m < 4; ++m) { const int row = row0 + ai * 128 + m * 16; float ss = 0.f;
#pragma unroll
                for (int bj = 0; bj < 2; ++bj)
#pragma unroll
                    for (int n = 0; n < 2; ++n) { const size_t off = (size_t)row * DM + col0 + bj * 128 + n * 16;
                        const pg8::f32x4 h = acc[ai][bj][m][n] + *(const pg8::f32x4*)(X + off);
                        ss += h[0] * h[0] + h[1] * h[1] + h[2] * h[2] + h[3] * h[3];
                        *(unsigned long long*)(HB + off) = (unsigned long long)pk2(h[0], h[1]) | ((unsigned long long)pk2(h[2], h[3]) << 32); }
                ss += swz_xor<16>(ss); ss = sum_halves(ss);
                if (fq == 0) SSQ[(size_t)row * 16 + u.pn * 4 + wc] = ss; }
    }
};

typedef float f32x16 __attribute__((ext_vector_type(16)));
typedef short s16x4 __attribute__((ext_vector_type(4)));
typedef float f32x2_t __attribute__((ext_vector_type(2)));
typedef __bf16 bf16x2_t __attribute__((ext_vector_type(2)));
#define MFMA32(a, b, c) __builtin_amdgcn_mfma_f32_32x32x16_bf16((a), (b), (c), 0, 0, 0)
__device__ __forceinline__ int crow(int reg, int h) { return (reg & 3) + 8 * (reg >> 2) + 4 * h; }
__device__ __forceinline__ unsigned cvtpk(float lo, float hi) { f32x2_t v = {lo, hi}; bf16x2_t b = __builtin_convertvector(v, bf16x2_t); return __builtin_bit_cast(unsigned, b); }
__device__ __forceinline__ bf16x8 pack8(const f32x16& x, int s) {
    v4u p; p.x = cvtpk(x[8 * s], x[8 * s + 1]); p.y = cvtpk(x[8 * s + 2], x[8 * s + 3]); p.z = cvtpk(x[8 * s + 4], x[8 * s + 5]); p.w = cvtpk(x[8 * s + 6], x[8 * s + 7]);
    return __builtin_bit_cast(bf16x8, p);
}
constexpr float LOG2E = 1.4426950408889634f;
constexpr int LDP = 136;
constexpr int S1_XT = 0, S1_XTW = 17408, S1_BSN = 34816, S1_CLN = 69632, S1_BNL = 104448, S1_F32 = 139264;

__device__ __forceinline__ float silu_fast(float x) { return x * __builtin_amdgcn_rcpf(1.f + __builtin_amdgcn_exp2f(-x * LOG2E)); }
__device__ __forceinline__ int swz_t(int row, int l) { return row * LDP + ((((l >> 3) ^ (row >> 3)) & 7) | ((l >> 3) & 8)) * 8 + (l & 7); }
#define S1_CONV8(A_, IT_) do { _Pragma("unroll") for (int e_ = 0; e_ < 8; ++e_) A_[e_] = bias[e_]; \
        _Pragma("unroll") for (int j_ = 0; j_ < 4; ++j_) { const v4u rw_ = raw[(IT_) + j_]; \
            A_[0] += w[j_][0] * bflo(rw_.x); A_[1] += w[j_][1] * bfhi(rw_.x); A_[2] += w[j_][2] * bflo(rw_.y); A_[3] += w[j_][3] * bfhi(rw_.y); \
            A_[4] += w[j_][4] * bflo(rw_.z); A_[5] += w[j_][5] * bfhi(rw_.z); A_[6] += w[j_][6] * bflo(rw_.w); A_[7] += w[j_][7] * bfhi(rw_.w); } \
        _Pragma("unroll") for (int e_ = 0; e_ < 8; ++e_) A_[e_] = silu_fast(A_[e_]); } while (0)
#define S1_LOADW(CHB_) do { _Pragma("unroll") for (int j_ = 0; j_ < 4; ++j_) { const float4 w0_ = *(const float4*)(P.conv_w + j_ * 1024 + (CHB_)), w1_ = *(const float4*)(P.conv_w + j_ * 1024 + (CHB_) + 4); \
            w[j_][0] = w0_.x; w[j_][1] = w0_.y; w[j_][2] = w0_.z; w[j_][3] = w0_.w; w[j_][4] = w1_.x; w[j_][5] = w1_.y; w[j_][6] = w1_.z; w[j_][7] = w1_.w; } \
        { const float4 b0_ = *(const float4*)(P.conv_b + (CHB_)), b1_ = *(const float4*)(P.conv_b + (CHB_) + 4); \
          bias[0] = b0_.x; bias[1] = b0_.y; bias[2] = b0_.z; bias[3] = b0_.w; bias[4] = b1_.x; bias[5] = b1_.y; bias[6] = b1_.z; bias[7] = b1_.w; } } while (0)
__device__ __forceinline__ void ssd_s1(Frame& F, const Ptrs& P) {
    const bf16* PROJ = (const bf16*)(P.ws + WS_PROJ); const float* DT = (const float*)(P.ws + WS_DT);
    float* EA = (float*)(P.ws + WS_EA); float* CDEC = (float*)(P.ws + WS_CDEC); bf16* CC = (bf16*)(P.ws + WS_CC);
    float* ST = (float*)(P.ws + WS_ST); float* YPF = (float*)((char*)P.out + DO_YPF);
    LAS unsigned char* L = F.lds + RING_OFF;
    LAS bf16* Xt = (LAS bf16*)(L + S1_XT); LAS bf16* Xtw = (LAS bf16*)(L + S1_XTW); LAS bf16* Bsn = (LAS bf16*)(L + S1_BSN); LAS bf16* Cln = (LAS bf16*)(L + S1_CLN); LAS bf16* Bnl = (LAS bf16*)(L + S1_BNL);
    LAS float* f32base = (LAS float*)(L + S1_F32);
    const int lane = lane_id(); const int tid_ = F.wave * 64 + lane;
    for (int ug = F.vcu; ug < 256; ug += F.G) {
        const int grp = ug & 1, c = (ug >> 1) & 31, b = ug >> 6, t0 = b * SEQ + c * 128;
        __syncthreads();
        if (F.wave < 4) {
            const int h = 4 * grp + F.wave, us = (b * 32 + c) * 8 + h;
            const float A = -__expf(P.a_log[h]), dtb = P.dt_bias[h];
            const int ln = opq(lane_id());
            LAS float* acum2 = f32base + F.wave * 384; LAS float* wv = acum2 + 128; LAS float* wend = wv + 128;
            const float x0 = DT[(size_t)(t0 + 2 * ln) * 8 + h] + dtb, x1 = DT[(size_t)(t0 + 2 * ln + 1) * 8 + h] + dtb;
            const float dt0 = fmaxf(x0, 0.f) + log1pf(__expf(-fabsf(x0))), dt1 = fmaxf(x1, 0.f) + log1pf(__expf(-fabsf(x1)));
            const float a0 = dt0 * A, a1 = dt1 * A;
            float s = a0 + a1;
#pragma unroll
            for (int o = 1; o < 64; o <<= 1) { const float v = __int_as_float(__builtin_amdgcn_ds_bpermute((ln - o) * 4, __float_as_int(s))); if (ln >= o) s += v; }
            const float ac1 = s, ac0 = s - a1, tot = __uint_as_float(__builtin_amdgcn_readlane(__float_as_uint(s), 63));
            acum2[2 * ln] = ac0 * LOG2E; acum2[2 * ln + 1] = ac1 * LOG2E;
            wv[2 * ln] = log2f(dt0) - ac0 * LOG2E; wv[2 * ln + 1] = log2f(dt1) - ac1 * LOG2E;
            wend[2 * ln] = dt0 * exp2f((tot - ac0) * LOG2E); wend[2 * ln + 1] = dt1 * exp2f((tot - ac1) * LOG2E);
            EA[(size_t)(t0 + 2 * ln) * 8 + h] = exp2f(ac0 * LOG2E); EA[(size_t)(t0 + 2 * ln + 1) * 8 + h] = exp2f(ac1 * LOG2E);
            if (ln == 0) CDEC[us] = exp2f(tot * LOG2E);
        }
        __syncthreads();
#pragma unroll 1
        for (int hi = 0; hi < 4; ++hi) {
            const int h = 4 * grp + hi, u = (b * 32 + c) * 8 + h;
            const float Dh = P.d_skip[h];
            const LAS float* acum2 = f32base + hi * 384; const LAS float* wv = acum2 + 128; const LAS float* wend = wv + 128;
            const int tidc = opq(tid_);
            if (hi == 0) {
                if (tidc < 440) {
                    const int cg = tidc % 40, sg = tidc / 40, l0 = 12 * sg;
                    int chb; if (cg < 8) chb = h * 64 + cg * 8; else if (cg < 24) chb = 512 + grp * 128 + (cg - 8) * 8; else chb = 768 + grp * 128 + (cg - 24) * 8;
                    v4u raw[15];
#pragma unroll
                    for (int q = 0; q < 15; ++q) { const int ss = c * 128 + l0 - 3 + q; raw[q] = (v4u){0u, 0u, 0u, 0u};
                        if (ss >= 0 && l0 - 3 + q < 128) raw[q] = *(const v4u*)(PROJ + (size_t)(b * SEQ + ss) * NPROJ + PJ_XBC + chb); }
                    float w[4][8], bias[8]; S1_LOADW(chb);
#pragma unroll
                    for (int it = 0; it < 12; it += 2) {
                        const int l = l0 + it;
                        if (l < 128) {
                            float a[8], a2[8]; S1_CONV8(a, it); S1_CONV8(a2, it + 1);
                            if (cg < 8) { const float we = wend[l], we2 = wend[l + 1];
#pragma unroll
                                for (int e = 0; e < 8; ++e) { *(LAS unsigned*)(Xt + swz_t(cg * 8 + e, l)) = cvtpk(a[e], a2[e]); *(LAS unsigned*)(Xtw + swz_t(cg * 8 + e, l)) = cvtpk(a[e] * we, a2[e] * we2); }
                            } else {
                                v4u o, o2; o.x = cvtpk(a[0], a[1]); o.y = cvtpk(a[2], a[3]); o.z = cvtpk(a[4], a[5]); o.w = cvtpk(a[6], a[7]);
                                o2.x = cvtpk(a2[0], a2[1]); o2.y = cvtpk(a2[2], a2[3]); o2.z = cvtpk(a2[4], a2[5]); o2.w = cvtpk(a2[6], a2[7]);
                                if (cg < 24) { const int n0 = (cg - 8) * 8; *(LAS v4u*)(Bsn + l * LDP + n0) = o; *(LAS v4u*)(Bsn + (l + 1) * LDP + n0) = o2;
#pragma unroll
                                    for (int e = 0; e < 8; ++e) *(LAS unsigned*)(Bnl + swz_t(n0 + e, l)) = cvtpk(a[e], a2[e]);
                                } else { const int n0 = (cg - 24) * 8; *(LAS v4u*)(Cln + l * LDP + n0) = o; *(LAS v4u*)(Cln + (l + 1) * LDP + n0) = o2;
                                    *(v4u*)(CC + (size_t)(t0 + l) * 256 + grp * 128 + n0) = o; *(v4u*)(CC + (size_t)(t0 + l + 1) * 256 + grp * 128 + n0) = o2; }
                            }
                        }
                    }
                }
            } else {
                const int cg = tidc & 7, l = 2 * (tidc >> 3), chb = h * 64 + cg * 8;
                v4u raw[5];
#pragma unroll
                for (int q = 0; q < 5; ++q) { const int ss = c * 128 + l - 3 + q; raw[q] = (v4u){0u, 0u, 0u, 0u};
                    if (ss >= 0) raw[q] = *(const v4u*)(PROJ + (size_t)(b * SEQ + ss) * NPROJ + PJ_XBC + chb); }
                float w[4][8], bias[8]; S1_LOADW(chb);
                float a[8], a2[8]; S1_CONV8(a, 0); S1_CONV8(a2, 1);
                const float we = wend[l], we2 = wend[l + 1];
#pragma unroll
                for (int e = 0; e < 8; ++e) { *(LAS unsigned*)(Xt + swz_t(cg * 8 + e, l)) = cvtpk(a[e], a2[e]); *(LAS unsigned*)(Xtw + swz_t(cg * 8 + e, l)) = cvtpk(a[e] * we, a2[e] * we2); }
            }
            __syncthreads();
            const int ln3 = opq(lane), r = ln3 & 31, hh = ln3 >> 5;
            if (F.wave < 4) {
                const int pt = F.wave >> 1;
#pragma unroll 1
                for (int q = 0; q < 2; ++q) {
                    const int lt = (F.wave & 1) ? (1 + q) : (3 * q);
                    f32x16 yacc;
#pragma unroll
                    for (int i = 0; i < 16; ++i) yacc[i] = 0.f;
                    const float al = acum2[32 * lt + r];
                    for (int st = 0; st <= lt; ++st) {
                        f32x16 macc;
#pragma unroll
                        for (int i = 0; i < 16; ++i) macc[i] = 0.f;
#pragma unroll
                        for (int kk = 0; kk < 8; ++kk) {
                            const bf16x8 a = *(const LAS bf16x8*)(Bsn + (32 * st + r) * LDP + 16 * kk + 8 * hh);
                            const bf16x8 bb = *(const LAS bf16x8*)(Cln + (32 * lt + r) * LDP + 16 * kk + 8 * hh);
                            macc = MFMA32(a, bb, macc);
                        }
#pragma unroll
                        for (int i = 0; i < 16; ++i) { const int sl = crow(i, hh);
                            float f = __builtin_amdgcn_exp2f(al + wv[32 * st + sl]);
                            if (st == lt && sl > r) f = 0.f;
                            macc[i] *= f; }
#pragma unroll
                        for (int sg = 0; sg < 2; ++sg) {
                            const bf16x8 bfrag = pack8(macc, sg);
                            const int prow = 32 * pt + r, lb = 32 * st + 16 * sg;
                            const s16x4 lo = *(const LAS s16x4*)(Xt + swz_t(prow, lb) + 4 * hh), hi2 = *(const LAS s16x4*)(Xt + swz_t(prow, lb + 8) + 4 * hh);
                            const bf16x8 afrag = __builtin_shufflevector(lo, hi2, 0, 1, 2, 3, 4, 5, 6, 7);
                            yacc = MFMA32(afrag, bfrag, yacc);
                        }
                    }
#pragma unroll
                    for (int i = 0; i < 16; ++i) { const int p = 32 * pt + crow(i, hh);
                        const float y = yacc[i] + Dh * bf2f(Xt[swz_t(p, 32 * lt + r)]);
                        YPF[((((size_t)u * 4 + lt) * 2 + pt) * 16 + i) * 64 + ln3] = y; }
                }
            } else {
                const int nt = F.wave - 4;
#pragma unroll 1
                for (int pt = 0; pt < 2; ++pt) {
                    f32x16 sacc;
#pragma unroll
                    for (int i = 0; i < 16; ++i) sacc[i] = 0.f;
#pragma unroll
                    for (int kk = 0; kk < 8; ++kk) {
                        const bf16x8 a = *(const LAS bf16x8*)(Xtw + swz_t(32 * pt + r, 16 * kk + 8 * hh));
                        const bf16x8 bb = *(const LAS bf16x8*)(Bnl + swz_t(32 * nt + r, 16 * kk + 8 * hh));
                        sacc = MFMA32(a, bb, sacc);
                    }
#pragma unroll
                    for (int i = 0; i < 16; ++i) ST[((size_t)u * 64 + 32 * pt + crow(i, hh)) * 128 + 32 * nt + r] = sacc[i];
                }
            }
            __syncthreads();
        }
    }
}
__device__ __forceinline__ void ssd_s2(Frame& F, const Ptrs& P) {
    const float* ST = (const float*)(P.ws + WS_ST); const float* CDEC = (const float*)(P.ws + WS_CDEC); unsigned* PREV = (unsigned*)(P.ws + WS_PREV);
    for (int g = F.vcu * 512 + (F.wave * 64 + lane_id()); g < 131072; g += F.G * 512) {
        const int n2 = g & 63, p = (g >> 6) & 63, h = (g >> 12) & 7, b = g >> 15;
        float2 st[32];
#pragma unroll
        for (int c = 0; c < 32; ++c) st[c] = *(const float2*)(ST + ((size_t)(((b * 32 + c) * 8 + h) * 64 + p)) * 128 + 2 * n2);
        float r0 = 0.f, r1 = 0.f;
#pragma unroll
        for (int c = 0; c < 32; ++c) { const size_t u = (size_t)((b * 32 + c) * 8 + h);
            PREV[((u * 64 + p) * 128 + 2 * n2) >> 1] = pk2(r0, r1);
            const float d = CDEC[u]; r0 = r0 * d + st[c].x; r1 = r1 * d + st[c].y; }
    }
}
__device__ __forceinline__ void ssd_s3(Frame& F, const Ptrs& P) {
    const bf16* CC = (const bf16*)(P.ws + WS_CC); const bf16* PREV = (const bf16*)(P.ws + WS_PREV); const float* EA = (const float*)(P.ws + WS_EA);
    const float* YPF = (const float*)((const char*)P.out + DO_YPF); const bf16* PROJ = (const bf16*)(P.ws + WS_PROJ); bf16* CAT = (bf16*)(P.ws + WS_XN);
    LAS float* red = (LAS float*)(F.lds + RING_OFF);
    const int lane = lane_id(), r = lane & 31, hh = lane >> 5, h = F.wave, grp = h >> 2;
    for (int v = F.vcu; v < 512; v += F.G) {
        const int lt = v & 3, c = (v >> 2) & 31, b = v >> 7;
        const int t = b * SEQ + c * 128 + lt * 32 + r; const size_t u = (size_t)((b * 32 + c) * 8 + h);
        float ypf[2][16]; unsigned long long zz[2][4];
#pragma unroll
        for (int pt = 0; pt < 2; ++pt) {
#pragma unroll
            for (int i = 0; i < 16; ++i) ypf[pt][i] = YPF[((((size_t)u * 4 + lt) * 2 + pt) * 16 + i) * 64 + lane];
#pragma unroll
            for (int g4 = 0; g4 < 4; ++g4) zz[pt][g4] = *(const unsigned long long*)(PROJ + (size_t)t * NPROJ + PJ_Z + h * 64 + 32 * pt + 8 * g4 + 4 * hh); }
        const float ea = EA[(size_t)t * 8 + h];
        f32x16 acc[2];
#pragma unroll
        for (int i = 0; i < 16; ++i) { acc[0][i] = 0.f; acc[1][i] = 0.f; }
#pragma unroll
        for (int kk = 0; kk < 8; ++kk) {
            const bf16x8 bb = *(const bf16x8*)(CC + (size_t)t * 256 + grp * 128 + 16 * kk + 8 * hh);
#pragma unroll
            for (int pt = 0; pt < 2; ++pt) { const bf16x8 a = *(const bf16x8*)(PREV + (u * 64 + 32 * pt + r) * 128 + 16 * kk + 8 * hh); acc[pt] = MFMA32(a, bb, acc[pt]); }
        }
        float ss = 0.f;
#pragma unroll
        for (int pt = 0; pt < 2; ++pt)
#pragma unroll
            for (int g4 = 0; g4 < 4; ++g4) {
                const unsigned z01 = (unsigned)zz[pt][g4], z23 = (unsigned)(zz[pt][g4] >> 32);
                const float zf[4] = {bflo(z01), bfhi(z01), bflo(z23), bfhi(z23)};
#pragma unroll
                for (int e = 0; e < 4; ++e) { const int i = 4 * g4 + e;
                    const float y = acc[pt][i] * ea + ypf[pt][i];
                    const float yg = y * silu_fast(zf[e]); acc[pt][i] = yg; ss = fmaf(yg, yg, ss); }
            }
        ss = sum_halves(ss);
        if (hh == 0) red[h * 32 + r] = ss;
        __syncthreads();
        float tot = 0.f;
#pragma unroll
        for (int w = 0; w < 8; ++w) tot += red[w * 32 + r];
        const float rn = rsqrtf(tot * (1.f / 512.f) + EPS);
#pragma unroll
        for (int pt = 0; pt < 2; ++pt)
#pragma unroll
            for (int g4 = 0; g4 < 4; ++g4) { const int ch = h * 64 + 32 * pt + 8 * g4 + 4 * hh;
                const float4 w = *(const float4*)(P.ssd_norm_w + ch);
                *(unsigned long long*)(CAT + (size_t)t * DM + 512 + ch) = (unsigned long long)cvtpk(acc[pt][4 * g4] * rn * w.x, acc[pt][4 * g4 + 1] * rn * w.y) | ((unsigned long long)cvtpk(acc[pt][4 * g4 + 2] * rn * w.z, acc[pt][4 * g4 + 3] * rn * w.w) << 32); }
        __syncthreads();
    }
}
__device__ __forceinline__ float gelu_erf(float v) { return 0.5f * v * (1.f + erff(v * 0.70710678118654752f)); }
typedef float f32x2v __attribute__((ext_vector_type(2)));
#define CVT8(W, LO) __builtin_amdgcn_cvt_pk_f32_fp8((int)(W), LO)
template <int CTRL> __device__ __forceinline__ float dpp_f(float v) { return __int_as_float(__builtin_amdgcn_update_dpp(0, __float_as_int(v), CTRL, 0xF, 0xF, true)); }
__device__ __forceinline__ float sum8_dpp(float s) { s += dpp_f<0xB1>(s); s += dpp_f<0x4E>(s); s += dpp_f<0x141>(s); return s; }
struct PeerPlace { int vx, nx, rank, nloc; };
__device__ __forceinline__ PeerPlace peer_place(Frame& F) {
    __syncthreads();
    if (F.wave == 0 && lane_id() == 0) {
        unsigned* bar = (unsigned*)(F.ctl + CW_BAR); const unsigned x = xb_xcc_id();
        unsigned vx = 0, nx = 0;
        for (unsigned j = 0; j < 16; ++j) { const unsigned c = xb_ld(&bar[XB_XCNT(j)]); if (c) { if (j < x) ++vx; ++nx; } }
        const unsigned rank = xb_add((unsigned*)(F.ctl + CW_RANK) + 64 * x, 1u);
        F.MISC[10] = vx; F.MISC[11] = nx ? nx : 1u; F.MISC[12] = rank; F.MISC[13] = xb_ld(&bar[XB_XCNT(x)]);
    }
    __syncthreads();
    PeerPlace pp; pp.vx = (int)F.MISC[10]; pp.nx = (int)F.MISC[11]; pp.rank = (int)F.MISC[12]; pp.nloc = (int)F.MISC[13]; if (pp.nloc < 1) pp.nloc = 1;
    return pp;
}
__device__ __forceinline__ void h_quant_rows(Frame& F, const Ptrs& P) {
    const bf16* HB = (const bf16*)(P.ws + WS_ST); unsigned char* H8 = P.ws + WS_H8; float* HS = (float*)(P.ws + WS_HS);
    const int lane = lane_id();
    for (int t = F.vcu * NWAVES + F.wave; t < T_; t += F.G * NWAVES) {
        const v4u a0 = ((const v4u*)(HB + (size_t)t * DM))[2 * lane], a1 = ((const v4u*)(HB + (size_t)t * DM))[2 * lane + 1];
        float hf[16];
        hf[0] = bflo(a0.x); hf[1] = bfhi(a0.x); hf[2] = bflo(a0.y); hf[3] = bfhi(a0.y); hf[4] = bflo(a0.z); hf[5] = bfhi(a0.z); hf[6] = bflo(a0.w); hf[7] = bfhi(a0.w);
        hf[8] = bflo(a1.x); hf[9] = bfhi(a1.x); hf[10] = bflo(a1.y); hf[11] = bfhi(a1.y); hf[12] = bflo(a1.z); hf[13] = bfhi(a1.z); hf[14] = bflo(a1.w); hf[15] = bfhi(a1.w);
        float am = 0.f;
#pragma unroll
        for (int i = 0; i < 16; ++i) am = fmaxf(am, fabsf(hf[i]));
        am = fmaxf(am, dpp_f<0xB1>(am)); am = fmaxf(am, dpp_f<0x4E>(am)); am = fmaxf(am, dpp_f<0x141>(am)); am = fmaxf(am, dpp_f<0x140>(am)); am = fmaxf(am, 1e-30f);
        const float inv = 119.f / am;
        unsigned hi[2] = {0u, 0u}, lo[2] = {0u, 0u};
#pragma unroll
        for (int i = 0; i < 16; ++i) { const int q = __float2int_rn(hf[i] * inv); const int qh = (q + 8) >> 4, ql = q - 16 * qh;
            hi[i >> 3] |= ((unsigned)qh & 15u) << (4 * (i & 7)); lo[i >> 3] |= ((unsigned)ql & 15u) << (4 * (i & 7)); }
        unsigned char* dst = H8 + (size_t)t * 1024 + (lane >> 4) * 256 + (lane & 15) * 8;
        *(unsigned long long*)dst = (unsigned long long)hi[0] | ((unsigned long long)hi[1] << 32);
        *(unsigned long long*)(dst + 128) = (unsigned long long)lo[0] | ((unsigned long long)lo[1] << 32);
        if ((lane & 15) == 0) HS[(size_t)t * 8 + (lane >> 4)] = am * (1.f / 119.f);
    }
}
constexpr int PX_D = 16;
template <int CTRL> __device__ __forceinline__ int dpp_i(int v) { return __builtin_amdgcn_update_dpp(0, v, CTRL, 0xF, 0xF, true); }
#define PX_ISSUE(BUF, LO, HI) _Pragma("unroll") for (int b_ = 0; b_ < 8; ++b_) { const unsigned off_ = ((unsigned)__builtin_amdgcn_ds_bpermute((16 * (b_ & 3) + ps) * 4, (b_ & 4) ? (HI) : (LO)) << 7) | (unsigned)(dl << 5); \
        BUF[2 * b_] = *(const v4u*)(tab + off_); BUF[2 * b_ + 1] = *(const v4u*)(tab + off_ + 16); }
struct H4 { v4u h0, h1, l0, l1; };
#define PX_DOT8(Q, HH, HL) ah = __builtin_amdgcn_sdot8((int)(Q), (int)(HH), ah, false); al = __builtin_amdgcn_sdot8((int)(Q), (int)(HL), al, false);
__device__ __forceinline__ void peer_down_token(const v4u (&cur)[PX_D], const H4& h, const float hs, float* prow, int dl, int ps) {
    int sm[8];
#pragma unroll
    for (int b = 0; b < 8; ++b) { const v4u q0 = cur[2 * b], q1 = cur[2 * b + 1];
        int ah = 0, al = 0;
        PX_DOT8(q0.x, h.h0.x, h.l0.x) PX_DOT8(q0.y, h.h0.y, h.l0.y) PX_DOT8(q0.z, h.h0.z, h.l0.z) PX_DOT8(q0.w, h.h0.w, h.l0.w)
        PX_DOT8(q1.x, h.h1.x, h.l1.x) PX_DOT8(q1.y, h.h1.y, h.l1.y) PX_DOT8(q1.z, h.h1.z, h.l1.z) PX_DOT8(q1.w, h.h1.w, h.l1.w)
        sm[b] = 16 * ah + al; }
    const bool c1 = (dl & 2) != 0, c0 = (dl & 1) != 0;
    int w4[4], w2[2];
#pragma unroll
    for (int k = 0; k < 4; ++k) { const int keep = c1 ? sm[4 + k] : sm[k], send = c1 ? sm[k] : sm[4 + k]; w4[k] = keep + dpp_i<0x4E>(send); }
#pragma unroll
    for (int k = 0; k < 2; ++k) { const int keep = c0 ? w4[2 + k] : w4[k], send = c0 ? w4[k] : w4[2 + k]; w2[k] = keep + dpp_i<0xB1>(send); }
    prow[32 * dl + ps] = (float)w2[0] * hs; prow[32 * dl + 16 + ps] = (float)w2[1] * hs;
}
__device__ __forceinline__ void peer_down(Frame& F, const Ptrs& P, const PeerPlace& pp) {
    const unsigned char* H8 = P.ws + WS_H8; const unsigned char* HSb = P.ws + WS_HS; const unsigned char* IDXb = P.ws + WS_IDX; unsigned char* PARTb = P.ws + WS_PART;
    const int lane = lane_id(), dl = lane & 3, ps = lane >> 2;
    const int tstep = pp.nloc * NWAVES;
    for (int u = pp.vx; u < 8; u += pp.nx) {
        const int s = u & 3, tend = ((u >> 2) + 1) * (T_ / 2), t0 = (u >> 2) * (T_ / 2) + pp.rank * NWAVES + F.wave;
        if (t0 >= tend) continue;
        const unsigned char* tab = P.ws + WS_ED + (size_t)s * 16384 * 128;
        const unsigned hoff = (unsigned)(s * 256 + dl * 32), ioff = (unsigned)lane * 4u;
        v4u bufA[PX_D], bufB[PX_D];
#define PD_CLAMP(T) ((T) < tend ? (T) : t0)
#define PD_META(H, HSC, TT) do { const unsigned char* hp_ = H8 + ((unsigned)(TT) * 1024u + hoff); H.h0 = *(const v4u*)hp_; H.h1 = *(const v4u*)(hp_ + 16); H.l0 = *(const v4u*)(hp_ + 128); H.l1 = *(const v4u*)(hp_ + 144); \
        HSC = *(const float*)(HSb + ((unsigned)(TT) * 32u + (unsigned)s * 4u)); } while (0)
#define PD_IDX(LO, HI, TT) do { LO = *(const int*)(IDXb + ((unsigned)(TT) * 512u + ioff)); HI = *(const int*)(IDXb + ((unsigned)(TT) * 512u + 256u + ioff)); } while (0)
        int nidx_lo, nidx_hi; PD_IDX(nidx_lo, nidx_hi, t0);
        PX_ISSUE(bufA, nidx_lo, nidx_hi);
        PD_IDX(nidx_lo, nidx_hi, PD_CLAMP(t0 + tstep));
        H4 ha, hb; float sa, sb; PD_META(ha, sa, t0);
        for (int t = t0; t < tend; t += 2 * tstep) {
            { const int tn = PD_CLAMP(t + tstep);
              PX_ISSUE(bufB, nidx_lo, nidx_hi); PD_IDX(nidx_lo, nidx_hi, PD_CLAMP(tn + tstep)); PD_META(hb, sb, tn);
              __builtin_amdgcn_sched_barrier(0);
              peer_down_token(bufA, ha, sa, (float*)(PARTb + ((unsigned)(s * T_ + t) * 512u)), dl, ps);
              __builtin_amdgcn_sched_barrier(0); }
            if (t + tstep >= tend) break;
            { const int tc = t + tstep, tn = PD_CLAMP(tc + tstep);
              PX_ISSUE(bufA, nidx_lo, nidx_hi); PD_IDX(nidx_lo, nidx_hi, PD_CLAMP(tn + tstep)); PD_META(ha, sa, tn);
              __builtin_amdgcn_sched_barrier(0);
              peer_down_token(bufB, hb, sb, (float*)(PARTb + ((unsigned)(s * T_ + tc) * 512u)), dl, ps);
              __builtin_amdgcn_sched_barrier(0); }
        }
    }
}
__device__ __forceinline__ void peer_act(Frame& F, const Ptrs& P) {
    const int* IDX = (const int*)(P.ws + WS_IDX); float* GATE = (float*)(P.ws + WS_GATE); const float* PART = (const float*)(P.ws + WS_PART); const float* SSQ = (const float*)(P.ws + WS_SSQ);
    const float* SCD = (const float*)(P.ws + WS_SMALL); const float* SCU = SCD + 16384;
    const int lane = lane_id();
    for (int w = F.vcu * NWAVES + F.wave; w < T_ * 2; w += F.G * NWAVES) {
        const int t = w >> 1; const size_t pid = (size_t)w * 64 + lane;
        const float ssq = lane < 16 ? SSQ[(size_t)t * 16 + lane] : 0.f;
        const float rstd = rsqrtf(wave_sum(ssq) * (1.f / 1024.f) + EPS);
        float pre = 0.f;
#pragma unroll
        for (int s = 0; s < 4; ++s) pre += PART[(size_t)s * T_ * 128 + pid];
        const int id = IDX[pid];
        GATE[pid] = gelu_erf(pre * SCD[id] * rstd) * GATE[pid] * SCU[id];
    }
}
constexpr int PE_PD = 8;
#define PE_LOAD4(SLOT, IDV) SLOT = *(const v4u*)(EU + (((unsigned)(IDV) << 9) | l16))
#define PE_BP(ADDR, V) __builtin_amdgcn_ds_bpermute((ADDR), (V))
__device__ __forceinline__ void peer_up_tm(Frame& F, const Ptrs& P) {
    const bf16* HB = (const bf16*)(P.ws + WS_ST); const unsigned char* EU = P.ws + WS_EU;
    const int* IDX = (const int*)(P.ws + WS_IDX); const float* GATE = (const float*)(P.ws + WS_GATE); const float* PART = (const float*)(P.ws + WS_PART);
    const float* SCD = (const float*)(P.ws + WS_SMALL); const float* SCU = SCD + 16384;
    const int lane = lane_id(), l31 = lane & 31; const bool upper = lane >= 32;
    const unsigned l16 = (unsigned)l31 << 4;
    const int bp0 = upper ? 4 : 0;
    const int t0 = F.vcu * NWAVES + F.wave, tstep = F.G * NWAVES;
    if (t0 >= T_) return;
    int idx_lo = IDX[(size_t)t0 * 128 + lane], idx_hi = IDX[(size_t)t0 * 128 + 64 + lane];
    v4u hq[4];
#pragma unroll
    for (int k = 0; k < 4; ++k) hq[k] = ((const v4u*)(HB + (size_t)t0 * DM))[4 * l31 + k];
    float g_lo = GATE[(size_t)t0 * 128 + lane], g_hi = GATE[(size_t)t0 * 128 + 64 + lane];
    float pre_lo = 0.f, pre_hi = 0.f;
#pragma unroll
    for (int s = 0; s < 4; ++s) { pre_lo += PART[((size_t)s * T_ + t0) * 128 + lane]; pre_hi += PART[((size_t)s * T_ + t0) * 128 + 64 + lane]; }
    float sdu_lo = SCD[idx_lo], sdu_hi = SCD[idx_hi], su_lo = SCU[idx_lo], su_hi = SCU[idx_hi];
    v4u ra[PE_PD];
#pragma unroll
    for (int j = 0; j < PE_PD; ++j) { const int id = PE_BP(bp0 + 8 * j, idx_lo); PE_LOAD4(ra[j], id); }
    int id_nx = PE_BP(bp0 + 8 * PE_PD, idx_lo);
    for (int t = t0; t < T_; t += tstep) {
        const int tn = (t + tstep < T_) ? t + tstep : t;
        const int nidx_lo = IDX[(size_t)tn * 128 + lane], nidx_hi = IDX[(size_t)tn * 128 + 64 + lane];
        v4u nh[4];
#pragma unroll
        for (int k = 0; k < 4; ++k) nh[k] = ((const v4u*)(HB + (size_t)tn * DM))[4 * l31 + k];
        const float ng_lo = GATE[(size_t)tn * 128 + lane], ng_hi = GATE[(size_t)tn * 128 + 64 + lane];
        float npart_lo[4], npart_hi[4];
#pragma unroll
        for (int s = 0; s < 4; ++s) { npart_lo[s] = PART[((size_t)s * T_ + tn) * 128 + lane]; npart_hi[s] = PART[((size_t)s * T_ + tn) * 128 + 64 + lane]; }
        float ssq = 0.f;
#pragma unroll
        for (int k = 0; k < 4; ++k) { ssq = fmaf(bflo(hq[k].x), bflo(hq[k].x), ssq); ssq = fmaf(bfhi(hq[k].x), bfhi(hq[k].x), ssq); ssq = fmaf(bflo(hq[k].y), bflo(hq[k].y), ssq); ssq = fmaf(bfhi(hq[k].y), bfhi(hq[k].y), ssq);
            ssq = fmaf(bflo(hq[k].z), bflo(hq[k].z), ssq); ssq = fmaf(bfhi(hq[k].z), bfhi(hq[k].z), ssq); ssq = fmaf(bflo(hq[k].w), bflo(hq[k].w), ssq); ssq = fmaf(bfhi(hq[k].w), bfhi(hq[k].w), ssq); }
        ssq += swz_xor<1>(ssq); ssq += swz_xor<2>(ssq); ssq += swz_xor<4>(ssq); ssq += swz_xor<8>(ssq); ssq += swz_xor<16>(ssq);
        const float rstd = rsqrtf(ssq * (1.f / 1024.f) + EPS);
        const float act_lo = gelu_erf(pre_lo * sdu_lo * rstd) * g_lo * su_lo, act_hi = gelu_erf(pre_hi * sdu_hi * rstd) * g_hi * su_hi;
        f32x2v acc[16];
#pragma unroll
        for (int i = 0; i < 16; ++i) acc[i] = (f32x2v){0.f, 0.f};
        float a_cur = __int_as_float(PE_BP(bp0, __float_as_int(act_lo)));
#pragma unroll
        for (int q = 0; q < 64; ++q) {
            const int qa = q + 1, ql = q + PE_PD + 1;
            float a_nx = 0.f;
            if (qa < 64) a_nx = __int_as_float(PE_BP(bp0 + 8 * (qa & 31), __float_as_int(qa < 32 ? act_lo : act_hi)));
            int id_n2;
            if (ql < 64) id_n2 = PE_BP(bp0 + 8 * (ql & 31), ql < 32 ? idx_lo : idx_hi);
            else id_n2 = PE_BP(bp0 + 8 * ((ql - 64) & 31), nidx_lo);
            __builtin_amdgcn_sched_barrier(0);
            { const f32x2v av = {a_cur, a_cur}; const v4u r = ra[q % PE_PD];
#define PE_FMA4(W, O) acc[O] = __builtin_elementwise_fma(av, (f32x2v)__builtin_amdgcn_cvt_scalef32_pk_f32_fp4(W, 1.0f, 0), acc[O]); acc[O + 1] = __builtin_elementwise_fma(av, (f32x2v)__builtin_amdgcn_cvt_scalef32_pk_f32_fp4(W, 1.0f, 1), acc[O + 1]); \
              acc[O + 2] = __builtin_elementwise_fma(av, (f32x2v)__builtin_amdgcn_cvt_scalef32_pk_f32_fp4(W, 1.0f, 2), acc[O + 2]); acc[O + 3] = __builtin_elementwise_fma(av, (f32x2v)__builtin_amdgcn_cvt_scalef32_pk_f32_fp4(W, 1.0f, 3), acc[O + 3]);
              PE_FMA4(r.x, 0) PE_FMA4(r.y, 4) PE_FMA4(r.z, 8) PE_FMA4(r.w, 12) }
            asm volatile("" : "+v"(acc[0]), "+v"(acc[1]), "+v"(acc[2]), "+v"(acc[3]), "+v"(acc[4]), "+v"(acc[5]), "+v"(acc[6]), "+v"(acc[7]));
            asm volatile("" : "+v"(acc[8]), "+v"(acc[9]), "+v"(acc[10]), "+v"(acc[11]), "+v"(acc[12]), "+v"(acc[13]), "+v"(acc[14]), "+v"(acc[15]));
            PE_LOAD4(ra[q % PE_PD], id_nx);
            id_nx = id_n2; a_cur = a_nx;
            __builtin_amdgcn_sched_barrier(0);
        }
        { float a = 0.f, c = 0.f;
#pragma unroll
          for (int s = 0; s < 4; ++s) { a += npart_lo[s]; c += npart_hi[s]; }
          pre_lo = a; pre_hi = c; }
        sdu_lo = SCD[nidx_lo]; sdu_hi = SCD[nidx_hi]; su_lo = SCU[nidx_lo]; su_hi = SCU[nidx_hi];
        float y[32];
#pragma unroll
        for (int k = 0; k < 4; ++k) { y[8 * k] = bflo(hq[k].x); y[8 * k + 1] = bfhi(hq[k].x); y[8 * k + 2] = bflo(hq[k].y); y[8 * k + 3] = bfhi(hq[k].y); y[8 * k + 4] = bflo(hq[k].z); y[8 * k + 5] = bfhi(hq[k].z); y[8 * k + 6] = bflo(hq[k].w); y[8 * k + 7] = bfhi(hq[k].w); }
        float s2 = 0.f;
#pragma unroll
        for (int i = 0; i < 16; ++i) { y[2 * i] += sum_halves(acc[i][0]); y[2 * i + 1] += sum_halves(acc[i][1]); s2 = fmaf(y[2 * i], y[2 * i], s2); s2 = fmaf(y[2 * i + 1], y[2 * i + 1], s2); }
        s2 += swz_xor<1>(s2); s2 += swz_xor<2>(s2); s2 += swz_xor<4>(s2); s2 += swz_xor<8>(s2); s2 += swz_xor<16>(s2);
        const float r2 = rsqrtf(s2 * (1.f / 1024.f) + EPS);
        const float4* wf = (const float4*)(P.norm_final) + 8 * l31 + 4 * (lane >> 5); float4* o = (float4*)(P.out + (size_t)t * DM) + 8 * l31 + 4 * (lane >> 5);
#pragma unroll
        for (int k = 0; k < 4; ++k) { const float4 w = wf[k];
            const float e0 = upper ? y[16 + 4 * k] : y[4 * k], e1 = upper ? y[17 + 4 * k] : y[4 * k + 1], e2 = upper ? y[18 + 4 * k] : y[4 * k + 2], e3 = upper ? y[19 + 4 * k] : y[4 * k + 3];
            o[k] = make_float4(e0 * r2 * w.x, e1 * r2 * w.y, e2 * r2 * w.z, e3 * r2 * w.w); }
        idx_lo = nidx_lo; idx_hi = nidx_hi; g_lo = ng_lo; g_hi = ng_hi;
#pragma unroll
        for (int k = 0; k < 4; ++k) hq[k] = nh[k];
    }
}
constexpr int TK_LDK = 136, TK_K2 = 34816, TK_SCR = 69632, TK_SP = 49;
__device__ __forceinline__ int mono_key(float x) { const int b = __float_as_int(x); return b ^ ((b >> 31) & 0x7fffffff); }
__device__ __forceinline__ float unmono(int m) { return __int_as_float(m ^ ((m >> 31) & 0x7fffffff)); }
__device__ __forceinline__ int max3i(int a, int b, int c) { return max(max(a, b), c); }
#define CEX(A, I, J) do { const int hi_ = max(A[I], A[J]), lo_ = min(A[I], A[J]); A[I] = hi_; A[J] = lo_; } while (0)
template <int N, int OFF, int K, int J, int LEN> struct BitonicStep {
    static __device__ __forceinline__ void run(int (&a)[LEN]) {
#pragma unroll
        for (int i = 0; i < N; ++i) { const int l = i ^ J; if (l > i) { if ((i & K) == 0) CEX(a, OFF + i, OFF + l); else CEX(a, OFF + l, OFF + i); } }
        if constexpr (J > 1) BitonicStep<N, OFF, K, (J >> 1), LEN>::run(a);
        else if constexpr (K < N) BitonicStep<N, OFF, (K << 1), K, LEN>::run(a);
    }
};
template <int N, int OFF, int LEN> __device__ __forceinline__ void bitonic_sort_desc(int (&a)[LEN]) { BitonicStep<N, OFF, 2, 1, LEN>::run(a); }
template <int OFF, int LEN> __device__ __forceinline__ void bitonic_merge16_desc(int (&a)[LEN]) { BitonicStep<16, OFF, 16, 8, LEN>::run(a); }
template <int A, int B, int LEN> __device__ __forceinline__ void merge_top16(int (&a)[LEN]) {
#pragma unroll
    for (int i = 0; i < 16; ++i) a[A + i] = max(a[A + i], a[B + 15 - i]);
    bitonic_merge16_desc<A, LEN>(a);
}
template <int LEN> __device__ __forceinline__ void pair_top16(int (&a)[LEN]) {
    int lo[16], up[16];
#pragma unroll
    for (int i = 0; i < 16; ++i) { const auto rr = __builtin_amdgcn_permlane32_swap((unsigned)a[i], (unsigned)a[i], false, false); lo[i] = (int)rr[0]; up[i] = (int)rr[1]; }
#pragma unroll
    for (int i = 0; i < 16; ++i) a[i] = max(lo[i], up[15 - i]);
    bitonic_merge16_desc<0, LEN>(a);
}
__device__ __forceinline__ void topk_phase(Frame& F, const Ptrs& P) {
    const bf16* Q = (const bf16*)(P.ws + WS_PROJ); const float* SSQ = (const float*)(P.ws + WS_SSQ);
    int* IDX = (int*)(P.ws + WS_IDX); float* GATE = (float*)(P.ws + WS_GATE);
    LAS unsigned char* L = F.lds + RING_OFF;
    LAS bf16* K1 = (LAS bf16*)L; LAS bf16* K2 = (LAS bf16*)(L + TK_K2);
    const int tid_ = (F.wave * 64 + lane_id());
    for (int i = tid_; i < 16384; i += 512) { const int n = i >> 7, k = i & 127; K1[n * TK_LDK + k] = (bf16)f2bf(P.sk1[i]); K2[n * TK_LDK + k] = (bf16)f2bf(P.sk2[i]); }
    __syncthreads();
    const int lane = tid_ & 63, r = lane & 31, hh = lane >> 5;
    LAS int* scr = (LAS int*)(L + TK_SCR) + F.wave * (32 * TK_SP) + r * TK_SP;
    for (int wq = F.vcu * NWAVES + F.wave; wq < 2048; wq += F.G * NWAVES) {
        const int t = (wq >> 2) * 32 + r;
        float rstd;
        { const float4* sp = (const float4*)(SSQ + (size_t)t * 16); const float4 a = sp[0], b = sp[1], c = sp[2], d = sp[3];
          rstd = rsqrtf(((a.x + a.y + a.z + a.w) + (b.x + b.y + b.z + b.w) + (c.x + c.y + c.z + c.w) + (d.x + d.y + d.z + d.w)) * (1.f / 1024.f) + EPS); }
#pragma unroll 1
        for (int hq = 0; hq < 2; ++hq) {
            const int hd = (wq & 3) * 2 + hq;
#pragma unroll 1
            for (int half = 0; half < 2; ++half) {
                const LAS bf16* Kh = half ? K2 : K1;
                bf16x8 qf[8];
#pragma unroll
                for (int kk = 0; kk < 8; ++kk) qf[kk] = *(const bf16x8*)(Q + (size_t)t * 2048 + hd * 256 + half * 128 + 16 * kk + 8 * hh);
                int key[64];
#pragma unroll
                for (int nt = 0; nt < 4; ++nt) {
                    f32x16 sc;
#pragma unroll
                    for (int i = 0; i < 16; ++i) sc[i] = 0.f;
#pragma unroll
                    for (int kk = 0; kk < 8; ++kk) { const bf16x8 a = *(const LAS bf16x8*)(Kh + (32 * nt + r) * TK_LDK + 16 * kk + 8 * hh); sc = MFMA32(a, qf[kk], sc); }
#pragma unroll
                    for (int i = 0; i < 16; ++i) key[nt * 16 + i] = (mono_key(sc[i]) & ~127) | (127 - (32 * nt + crow(i, hh)));
                }
                bitonic_sort_desc<16, 0, 64>(key); bitonic_sort_desc<16, 16, 64>(key); bitonic_sort_desc<16, 32, 64>(key); bitonic_sort_desc<16, 48, 64>(key);
                merge_top16<0, 16, 64>(key); merge_top16<32, 48, 64>(key); merge_top16<0, 32, 64>(key);
                pair_top16<64>(key);
                if (hh == 0) {
#pragma unroll
                    for (int i = 0; i < 16; ++i) scr[half * 16 + i] = key[i]; }
            }
            const LAS int* la = scr + hh * 16; const LAS int* lb = scr + (1 - hh) * 16;
            float va[4], vb[16];
#pragma unroll
            for (int i = 0; i < 4; ++i) va[i] = unmono(la[i] & ~127);
#pragma unroll
            for (int j = 0; j < 16; ++j) vb[j] = unmono(lb[j] & ~127);
            int ck[32];
            {
                int q = 0;
#pragma unroll
                for (int i = 0; i < 4; ++i)
#pragma unroll
                    for (int j = i; j < 16; ++j) if ((i + 1) * (j + 1) <= 16) {
                        const int pos = hh ? (j * 16 + i) : (i * 16 + j);
                        int k = (mono_key(va[i] + vb[j]) & ~255) | (255 - pos);
                        if (i == j && hh) k = (int)0x80000000;
                        ck[q++] = k; }
#pragma unroll
                for (int i = 27; i < 32; ++i) ck[i] = (int)0x80000000;
            }
            bitonic_sort_desc<32, 0, 32>(ck);
            pair_top16<32>(ck);
            const float vmax = unmono(ck[0] & ~255) * rstd;
            float ev[8]; int id[8]; float esum = 0.f; const int hm = -hh;
#pragma unroll
            for (int q = 0; q < 8; ++q) { const int wk = ck[q] ^ ((ck[q] ^ ck[8 + q]) & hm); const int pos = 255 - (wk & 255);
                const int n1 = 127 - (scr[pos >> 4] & 127), n2 = 127 - (scr[16 + (pos & 15)] & 127);
                id[q] = n1 * 128 + n2;
                ev[q] = exp2f((unmono(wk & ~255) * rstd - vmax) * LOG2E); esum += ev[q]; }
            esum = sum_halves(esum);
            const float inv = 1.f / esum;
            int4* ip = (int4*)(IDX + ((size_t)t * 8 + hd) * 16 + hh * 8); float4* gp = (float4*)(GATE + ((size_t)t * 8 + hd) * 16 + hh * 8);
            ip[0] = make_int4(id[0], id[1], id[2], id[3]); ip[1] = make_int4(id[4], id[5], id[6], id[7]);
            gp[0] = make_float4(ev[0] * inv, ev[1] * inv, ev[2] * inv, ev[3] * inv); gp[1] = make_float4(ev[4] * inv, ev[5] * inv, ev[6] * inv, ev[7] * inv);
        }
    }
    __syncthreads();
}

constexpr int AT_KP = 72, AT_VP = 264;
constexpr int AT_K = 0, AT_VT = 36864, AT_BT = 36864 + 33792;
__device__ __forceinline__ void attn_phase(Frame& F, const Ptrs& P) {
    const bf16* PROJ = (const bf16*)(P.ws + WS_PROJ); bf16* CAT = (bf16*)(P.ws + WS_XN);
    LAS unsigned char* L = F.lds + RING_OFF;
    LAS bf16* Ks = (LAS bf16*)(L + AT_K); LAS bf16* Vt = (LAS bf16*)(L + AT_VT); LAS float* btab = (LAS float*)(L + AT_BT);
    const int lane = lane_id(), tid_ = F.wave * 64 + lane, r = lane & 31, hh = lane >> 5;
    for (int u = F.vcu; u < 256; u += F.G) {
        const int hkv = u & 1, n = (u >> 1) & 31, b = u >> 6;
        const int trow0 = b * SEQ + n * 128;
        for (int i = tid_; i < 2048; i += 512) {
            const int kj = i >> 3, ch = i & 7; const bool ok = (n > 0) || (kj >= 128);
            v4u kv = {0u, 0u, 0u, 0u}, vv = {0u, 0u, 0u, 0u};
            if (ok) { const bf16* rowp = PROJ + (size_t)(trow0 - 128 + kj) * NPROJ + hkv * 64 + ch * 8; kv = *(const v4u*)(rowp + PJ_K); vv = *(const v4u*)(rowp + PJ_V); }
            *(LAS v4u*)(Ks + kj * AT_KP + ch * 8) = kv;
            LAS bf16* vp = Vt + (ch * 8) * AT_VP + kj;
            vp[0] = (bf16)(vv.x & 0xffffu); vp[AT_VP] = (bf16)(vv.x >> 16); vp[2 * AT_VP] = (bf16)(vv.y & 0xffffu); vp[3 * AT_VP] = (bf16)(vv.y >> 16);
            vp[4 * AT_VP] = (bf16)(vv.z & 0xffffu); vp[5 * AT_VP] = (bf16)(vv.z >> 16); vp[6 * AT_VP] = (bf16)(vv.w & 0xffffu); vp[7 * AT_VP] = (bf16)(vv.w >> 16);
        }
        for (int i = tid_; i < 768; i += 512) { const int gg = i / 192, dist = i % 192 - 32;
            btab[i] = (dist >= 0 && dist < 128) ? P.rel_bias[c_bucket[dist & 127] * 8 + hkv * 4 + gg] * LOG2E : 0.f; }
        __syncthreads();
        const int g = F.wave & 3, h = hkv * 4 + g;
        const float sink2 = P.sinks[h] * LOG2E;
#pragma unroll 1
        for (int qq = 0; qq < 2; ++qq) {
            const int qt = (F.wave >> 2) * 2 + qq, t = trow0 + 32 * qt + r;
            bf16x8 qf[4];
#pragma unroll
            for (int kk = 0; kk < 4; ++kk) qf[kk] = *(const bf16x8*)(PROJ + (size_t)t * NPROJ + h * 64 + 16 * kk + 8 * hh);
            f32x16 sc[5];
#pragma unroll
            for (int j = 0; j < 5; ++j) {
#pragma unroll
                for (int i = 0; i < 16; ++i) sc[j][i] = 0.f;
#pragma unroll
                for (int kk = 0; kk < 4; ++kk) { const bf16x8 a = *(const LAS bf16x8*)(Ks + (32 * (qt + j) + r) * AT_KP + 16 * kk + 8 * hh); sc[j] = MFMA32(a, qf[kk], sc[j]); }
            }
            float m = sink2;
            const LAS float* bt = btab + g * 192 + 160 + r - 4 * hh;
#pragma unroll
            for (int j = 0; j < 5; ++j) {
                const bool tile_ok = (n > 0) || (qt + j >= 4);
#pragma unroll
                for (int i = 0; i < 16; ++i) { const int dist = 128 + r - (32 * j + crow(i, hh));
                    const bool ok = tile_ok && (j == 0 ? dist < 128 : (j == 4 ? dist >= 0 : true));
                    const float s = sc[j][i] * (0.125f * LOG2E) + bt[-(32 * j + (i & 3) + 8 * (i >> 2))];
                    sc[j][i] = ok ? s : -INFINITY; m = fmaxf(m, sc[j][i]); }
            }
            m = max_halves(m);
            float l = 0.f;
#pragma unroll
            for (int j = 0; j < 5; ++j)
#pragma unroll
                for (int i = 0; i < 16; ++i) { sc[j][i] = exp2f(sc[j][i] - m); l += sc[j][i]; }
            l = sum_halves(l);
            l += exp2f(sink2 - m);
            const float inv = 1.f / l;
            f32x16 o[2];
#pragma unroll
            for (int i = 0; i < 16; ++i) { o[0][i] = 0.f; o[1][i] = 0.f; }
#pragma unroll
            for (int j = 0; j < 5; ++j)
#pragma unroll
                for (int sg = 0; sg < 2; ++sg) {
                    const bf16x8 pf = pack8(sc[j], sg);
#pragma unroll
                    for (int dt = 0; dt < 2; ++dt) {
                        const LAS bf16* vb = Vt + (32 * dt + r) * AT_VP + 32 * (qt + j) + 16 * sg + 4 * hh;
                        const s16x4 lo = *(const LAS s16x4*)(vb), hi = *(const LAS s16x4*)(vb + 8);
                        o[dt] = MFMA32(__builtin_shufflevector(lo, hi, 0, 1, 2, 3, 4, 5, 6, 7), pf, o[dt]);
                    }
                }
            bf16* op = CAT + (size_t)t * DM + h * 64 + 4 * hh;
#pragma unroll
            for (int dt = 0; dt < 2; ++dt)
#pragma unroll
                for (int g4 = 0; g4 < 4; ++g4)
                    *(unsigned long long*)(op + 32 * dt + 8 * g4) = (unsigned long long)cvtpk(o[dt][4 * g4] * inv, o[dt][4 * g4 + 1] * inv) | ((unsigned long long)cvtpk(o[dt][4 * g4 + 2] * inv, o[dt][4 * g4 + 3] * inv) << 32);
        }
        __syncthreads();
    }
}
struct Args { Ptrs p; };
__global__ void __launch_bounds__(NWAVES * 64, 2) hymba_fwd(Args args) {
    extern __shared__ __attribute__((aligned(16))) unsigned char lds[];
    const Ptrs& P = args.p;
    Frame F;
    F.lds = (LAS unsigned char*)lds;
    F.MISC = (volatile LAS unsigned*)(F.lds + MISC_OFF);
    F.wave = __builtin_amdgcn_readfirstlane(threadIdx.x >> 6);
    F.G = gridDim.x; { const int bx = blockIdx.x; F.vcu = (F.G % 8 == 0) ? (bx % 8) * (F.G / 8) + bx / 8 : bx; }
    F.ctl = (gu32*)(P.ws + WS_CTL);
    for (int u = threadIdx.x; u < (LDS_BYTES - LDSCTL_OFF) / 4; u += NWAVES * 64) ((LAS unsigned*)(F.lds + LDSCTL_OFF))[u] = 0u;
    __syncthreads();
    XcdBarrier bar = xcd_barrier_post((unsigned*)(F.ctl + CW_BAR), F.MISC + 8);
#define GRID_BAR() xcd_barrier(bar)

    bf16* XN = (bf16*)(P.ws + WS_XN); bf16* PROJ = (bf16*)(P.ws + WS_PROJ); bf16* HB = (bf16*)(P.ws + WS_ST);
    p0_prologue(F, P);
    GRID_BAR();
    { pg8::Gemm g{XN, (const bf16*)(P.ws + WS_WIN), T_, NPROJ, DM, F.wave}; pg8::StaticOrder S; S.init(T_, NPROJ, F.G, (int)blockIdx.x);
      pg8::EpiBf16<0> E{PROJ, NPROJ, nullptr, 0, 0, 1.f};
      pg8::gemm_phase<pg8::EpiBf16<0>, pg8::StaticOrder, PG8_ALIGN, PG8_SP2>(F.lds + RING_OFF, g, S, E); }
    if (F.G == 256 && blockIdx.x >= 64) quant_fp6u(P, lane_id(), 0, 8192, ((int)blockIdx.x - 64) * NWAVES + F.wave, 192 * NWAVES);
    else if (F.G != 256) quant_fp6u(P, lane_id(), 0, 8192, F.vcu * NWAVES + F.wave, F.G * NWAVES);
    GRID_BAR();
    ssd_s1(F, P);
    attn_phase(F, P);
    GRID_BAR();
    ssd_s2(F, P);
    GRID_BAR();
    ssd_s3(F, P);
    GRID_BAR();
    { pg8::Gemm g{XN, (const bf16*)(P.ws + WS_WOUT), T_, DM, DM, F.wave}; pg8::StaticOrder S; S.init(T_, DM, F.G, (int)blockIdx.x);
      EpiResH E{P.x, HB, (float*)(P.ws + WS_SSQ)};
      pg8::gemm_phase<EpiResH, pg8::StaticOrder, PG8_ALIGN, PG8_SP2>(F.lds + RING_OFF, g, S, E); }
    GRID_BAR();
    { pg8::Gemm g{HB, (const bf16*)(P.ws + WS_WQ), T_, 2048, DM, F.wave}; pg8::StaticOrder S; S.init(T_, 2048, F.G, (int)blockIdx.x);
      pg8::EpiBf16<0> E{PROJ, 2048, nullptr, 0, 0, 1.f};
      pg8::gemm_phase<pg8::EpiBf16<0>, pg8::StaticOrder, PG8_ALIGN, PG8_SP2>(F.lds + RING_OFF, g, S, E); }
    GRID_BAR();
    topk_phase(F, P);
    h_quant_rows(F, P);
    GRID_BAR();
    { const PeerPlace pp = peer_place(F);
      peer_down(F, P, pp); }
    GRID_BAR();
    peer_up_tm(F, P);
}

extern "C" void kernel_launch(void* const* d_in, const int* in_sizes, int n_in, void* d_out, int out_size, void* d_ws, size_t ws_size, hipStream_t stream) {
    static int grid = 0;
    if (grid == 0) {
        if (n_in != 19 || out_size != T_ * DM || ws_size < WS_END) { fprintf(stderr, "kernel_launch: unexpected shapes (n_in %d, out %d, ws %zu)\n", n_in, out_size, ws_size); grid = -1; return; }
        int dev = 0, cus = 0, per_cu = 0;
        if (hipGetDevice(&dev) != hipSuccess || hipDeviceGetAttribute(&cus, hipDeviceAttributeMultiprocessorCount, dev) != hipSuccess) { grid = -1; return; }
        if (hipFuncSetAttribute((const void*)hymba_fwd, hipFuncAttributeMaxDynamicSharedMemorySize, LDS_BYTES) != hipSuccess) { fprintf(stderr, "kernel_launch: hipFuncSetAttribute failed\n"); grid = -1; return; }
        if (hipOccupancyMaxActiveBlocksPerMultiprocessor(&per_cu, (const void*)hymba_fwd, NWAVES * 64, LDS_BYTES) != hipSuccess || per_cu < 1) { fprintf(stderr, "kernel_launch: occupancy query says %d blocks per CU\n", per_cu); grid = -1; (void)hipGetLastError(); return; }
        grid = cus;
    }
    if (grid < 0) return;
    (void)hipMemsetAsync((char*)d_ws + WS_CTL, 0, CTL_ZERO_BYTES, stream);
    Args a{};
    const float** pp = (const float**)&a.p;
    for (int i = 0; i < 19; ++i) pp[i] = (const float*)d_in[i];
    a.p.out = (float*)d_out; a.p.ws = (unsigned char*)d_ws;
    hipLaunchKernelGGL(hymba_fwd, dim3(grid), dim3(NWAVES * 64), LDS_BYTES, stream, a);
}
```

```cpp
#include <hip/hip_runtime.h>
#include <cstdio>
#include <cstdint>
#include <math.h>
namespace pg8 {
#define PG8_LAS __attribute__((address_space(3)))
typedef unsigned short bf16_t;
typedef short bf16x8 __attribute__((ext_vector_type(8)));
typedef float f32x4 __attribute__((ext_vector_type(4)));
typedef unsigned u32x4 __attribute__((ext_vector_type(4)));
constexpr int BM = 256, BK = 64, HALF = 128, HTB = HALF * BK * 2  , STAGE_BYTES = 8 * HTB, NXCD = 8, WGM = 8;

__host__ __device__ __forceinline__ int lds_byte(int r, int c) { const int st = (r >> 4) * 2 + (c >> 5), rr = r & 15, cc = c & 31, ob = rr * 64 + cc * 2; return st * 1024 + (ob ^ (((ob >> 9) & 1) << 5)); }
__host__ __device__ __forceinline__ void stage_rc(int b, int& R, int& C) { const int st = b / 1024, sb = b % 1024, swz = sb ^ (((sb >> 9) & 1) << 5); R = (st >> 1) * 16 + swz / 64; C = (st & 1) * 32 + (swz % 64) / 2; }
__host__ __device__ __forceinline__ int perm32(int rho) { const int n = rho >> 4, i = rho & 15; return 8 * (i >> 2) + 4 * n + (i & 3); }

struct Unit { int pm, pn; };
struct Gemm { const bf16_t* A; const bf16_t* Bt; int M, N, K, wave; };

struct StaticOrder {
    int nM, nN, nwg, G, c;
    __host__ __device__ void init(int M, int N, int G_, int c_) { nM = M / BM; nN = N / BM; nwg = nM * nN; G = G_; c = c_; }
    __host__ __device__ bool next(int i, Unit& u) const {
        const long L = (long)i * G + c; if (L >= nwg) return false;
        int wgid = (int)L; { const int q = nwg / NXCD, r = nwg % NXCD, xcd = wgid % NXCD, off = wgid / NXCD; wgid = (xcd < r ? xcd * (q + 1) : r * (q + 1) + (xcd - r) * q) + off; }
        const int nig = WGM * nN, gid = wgid / nig, fm = gid * WGM, gsz = (nM - fm) < WGM ? (nM - fm) : WGM;
        u.pm = fm + ((wgid % nig) % gsz); u.pn = (wgid % nig) / gsz; return true;
    }
    __device__ __forceinline__ void a_ready(const Unit&) const {}
    __device__ __forceinline__ void done(const Unit&) const {}
};

__device__ __forceinline__ unsigned cvt_pk_bf16(float lo, float hi) { unsigned r; asm volatile("v_cvt_pk_bf16_f32 %0, %1, %2" : "=v"(r) : "v"(lo), "v"(hi)); return r; }
typedef float f32x2 __attribute__((ext_vector_type(2)));
__device__ __forceinline__ f32x2 gelu_pk(f32x2 v) {
    const f32x2 av = __builtin_elementwise_abs(v), d = av * 0.2316418882f + 1.0f;
    f32x2 t; t.x = __builtin_amdgcn_rcpf(d.x); t.y = __builtin_amdgcn_rcpf(d.y);
    f32x2 q = t * 0.5307027145f + (-0.7265760135f); q = q * t + 0.7107068705f; q = q * t + (-0.142248368f); q = q * t + 0.127414796f; q = q * t;
    const f32x2 s = (v * v) * (-0.72134752044f);
    f32x2 e; e.x = __builtin_amdgcn_exp2f(s.x); e.y = __builtin_amdgcn_exp2f(s.y);
    const f32x2 m = v * (q * e), r = v - m;
    f32x2 o; o.x = v.x < 0.f ? m.x : r.x; o.y = v.y < 0.f ? m.y : r.y; return o;
}

template <int ACT  > struct EpiBf16 {
    static constexpr bool PERM = true, AFTER_DRAIN = false; static_assert(ACT == 0 || ACT == 1, "EpiBf16: ACT is 0 (none) or 1 (gelu_pk)");
    bf16_t* O; int ldc; const float* bias; int split_cols; size_t split_stride; float scale0;
    __device__ __forceinline__ void operator()(const f32x4 (&acc)[2][2][4][2], const Unit& u, int wr, int wc, int fr, int fq) const {
        const int row0 = u.pm * BM + wr * 64 + fr; int colt = u.pn * BM; bf16_t* base = O;
        float sc = 1.f; if (split_cols) { const int t = colt / split_cols; base += (size_t)t * split_stride; colt -= t * split_cols; if (t == 0) sc = scale0; }
        const int col0 = colt + wc * 32 + 8 * fq, bcol0 = u.pn * BM + wc * 32 + 8 * fq;
        f32x4 bv[2][2];
#pragma unroll
        for (int bj = 0; bj < 2; ++bj)
#pragma unroll
            for (int n = 0; n < 2; ++n) bv[bj][n] = bias ? *(const f32x4*)(bias + bcol0 + bj * HALF + 4 * n) : (f32x4){0.f, 0.f, 0.f, 0.f};
#pragma unroll
        for (int ai = 0; ai < 2; ++ai)
#pragma unroll
            for (int m = 0; m < 4; ++m) { bf16_t* rowp = base + (size_t)(row0 + ai * HALF + m * 16) * ldc + col0;
#pragma unroll
                for (int bj = 0; bj < 2; ++bj) { f32x4 v0 = acc[ai][bj][m][0] + bv[bj][0], v1 = acc[ai][bj][m][1] + bv[bj][1];
                    if (ACT == 1) { f32x2 a = gelu_pk((f32x2){v0[0], v0[1]}), b = gelu_pk((f32x2){v0[2], v0[3]}), c = gelu_pk((f32x2){v1[0], v1[1]}), d = gelu_pk((f32x2){v1[2], v1[3]});
                        v0 = (f32x4){a.x, a.y, b.x, b.y}; v1 = (f32x4){c.x, c.y, d.x, d.y}; }
                    v0 = v0 * sc; v1 = v1 * sc; u32x4 w; w.x = cvt_pk_bf16(v0[0], v0[1]); w.y = cvt_pk_bf16(v0[2], v0[3]); w.z = cvt_pk_bf16(v1[0], v1[1]); w.w = cvt_pk_bf16(v1[2], v1[3]);
                    *(u32x4*)(rowp + bj * HALF) = w; } }
    }
};
template <class Epi, class Sched, bool ALIGN_EPI = false, bool SP2 = false>
__device__ __forceinline__ void gemm_phase(PG8_LAS unsigned char* lds, const Gemm g, const Sched& S, const Epi& E) {
    int lane_l; asm volatile("v_mbcnt_lo_u32_b32 %0, -1, 0\n\tv_mbcnt_hi_u32_b32 %0, -1, %0" : "=v"(lane_l));
    const int wid = g.wave, lane = lane_l, tid = wid * 64 + lane,
              wr = wid >> 2, wc = wid & 3, fr = lane & 15, fq = lane >> 4;
    const int K = g.K, nt = K / BK;
    unsigned voffA[2], voffB[2];
#pragma unroll
    for (int i = 0; i < 2; ++i) { int R, C; stage_rc(tid * 16 + i * 8192, R, C); const int Rb = Epi::PERM ? ((R & ~31) + perm32(R & 31)) : R;
        voffA[i] = (unsigned)(R * K + C) * 2u; voffB[i] = (unsigned)(Rb * K + C) * 2u; }
    const size_t kstep = (size_t)(BK * 2);
    const size_t hstep = (size_t)HALF * K * 2;
    const size_t tstep = 2 * hstep;
    const unsigned ldsw = (unsigned)wid * 1024u;
    const int aoff = lds_byte(wr * 64 + fr, fq * 8), boff = lds_byte(wc * 32 + fr, fq * 8);
#define PG8_SA(b, h) (((b) * 2 + (h)) * HTB)
#define PG8_SB(b, h) ((4 + (b) * 2 + (h)) * HTB)
#define PG8_STAGE(bufoff, gbase, voff) do { _Pragma("unroll") for (int _i = 0; _i < 2; ++_i) \
        __builtin_amdgcn_global_load_lds((const unsigned*)((const char*)(gbase) + (voff)[_i]), (PG8_LAS unsigned*)(lds + (bufoff) + ldsw + _i * 8192), 16, 0, 0); } while (0)
#define PG8_LDA(dst, b, h) do { _Pragma("unroll") for (int m = 0; m < 4; ++m) _Pragma("unroll") for (int k = 0; k < 2; ++k) dst[m][k] = *(const PG8_LAS bf16x8*)(lds + PG8_SA(b, h) + aoff + m * 2048 + k * 1024); } while (0)
#define PG8_LDB(dst, b, h) do { _Pragma("unroll") for (int n = 0; n < 2; ++n) _Pragma("unroll") for (int k = 0; k < 2; ++k) dst[n][k] = *(const PG8_LAS bf16x8*)(lds + PG8_SB(b, h) + boff + n * 2048 + k * 1024); } while (0)
#define PG8_MMA(ai, bj, At, Bt) do { __builtin_amdgcn_s_setprio(1); _Pragma("unroll") for (int m = 0; m < 4; ++m) _Pragma("unroll") for (int n = 0; n < 2; ++n) _Pragma("unroll") for (int k = 0; k < 2; ++k) \
        acc[ai][bj][m][n] = __builtin_amdgcn_mfma_f32_16x16x32_bf16(Bt[n][k], At[m][k], acc[ai][bj][m][n], 0, 0, 0); __builtin_amdgcn_s_setprio(0); } while (0)
#define PG8_WAIT_V(n) asm volatile("s_waitcnt vmcnt(" #n ")" ::: "memory")
#define PG8_WAIT_L(n) asm volatile("s_waitcnt lgkmcnt(" #n ")" ::: "memory")
#define PG8_BAR __builtin_amdgcn_s_barrier()
#define PG8_SCHED __builtin_amdgcn_sched_barrier(0)
    Unit cur, nxt; int ui = 0;
    if (!S.next(0, cur)) return;
    f32x4 acc[2][2][4][2];
#pragma unroll
    for (int a = 0; a < 2; ++a)
#pragma unroll
        for (int b = 0; b < 2; ++b)
#pragma unroll
            for (int m = 0; m < 4; ++m)
#pragma unroll
                for (int n = 0; n < 2; ++n) acc[a][b][m][n] = (f32x4){0.f, 0.f, 0.f, 0.f};
    bf16x8 At[4][2], B0[2][2], B1[2][2];
    const char* cA = (const char*)g.A + (size_t)cur.pm * tstep; const char* cB = (const char*)g.Bt + (size_t)cur.pn * tstep;
    S.a_ready(cur);
    if constexpr (SP2) {
        PG8_STAGE(PG8_SB(0, 0), cB, voffB); PG8_STAGE(PG8_SB(0, 1), cB + hstep, voffB); PG8_STAGE(PG8_SA(0, 0), cA, voffA); PG8_STAGE(PG8_SA(0, 1), cA + hstep, voffA);
        if (wr == 1) PG8_BAR;
        PG8_WAIT_V(2); PG8_BAR;
        PG8_STAGE(PG8_SB(1, 0), cB + kstep, voffB); PG8_STAGE(PG8_SA(1, 0), cA + kstep, voffA); PG8_STAGE(PG8_SB(1, 1), cB + hstep + kstep, voffB);
        PG8_WAIT_V(6); PG8_BAR;
    } else {
        PG8_STAGE(PG8_SB(0, 0), cB, voffB); PG8_STAGE(PG8_SA(0, 0), cA, voffA); PG8_STAGE(PG8_SB(0, 1), cB + hstep, voffB); PG8_STAGE(PG8_SA(0, 1), cA + hstep, voffA);
        if (wr == 1) PG8_BAR;
        PG8_WAIT_V(4); PG8_BAR;
        PG8_STAGE(PG8_SB(1, 0), cB + kstep, voffB); PG8_STAGE(PG8_SA(1, 0), cA + kstep, voffA); PG8_STAGE(PG8_SB(1, 1), cB + hstep + kstep, voffB);
        PG8_WAIT_V(6); PG8_BAR;
    }
    for (;;) {
        const bool has_next = S.next(ui + 1, nxt);
        const char* nA = has_next ? (const char*)g.A + (size_t)nxt.pm * tstep : cA; const char* nB = has_next ? (const char*)g.Bt + (size_t)nxt.pn * tstep : cB;
        for (int t = 0; t < nt; t += 2) {
            const bool last = (t == nt - 2);
            const char* a1 = cA + (size_t)(t + 1) * kstep;
            const char* a2 = last ? nA : cA + (size_t)(t + 2) * kstep; const char* b2 = last ? nB : cB + (size_t)(t + 2) * kstep;
            const char* a3 = a2 + kstep; const char* b3 = b2 + kstep;
            if (last && has_next) S.a_ready(nxt);
            if constexpr (SP2) {
            PG8_LDB(B0, 0, 0); PG8_LDB(B1, 0, 1); PG8_SCHED; PG8_LDA(At, 0, 0); PG8_STAGE(PG8_SA(1, 1), a1 + hstep, voffA);
            PG8_WAIT_V(8); PG8_WAIT_L(0); PG8_BAR; PG8_MMA(0, 0, At, B0); PG8_MMA(0, 1, At, B1); PG8_BAR; PG8_SCHED;
            PG8_LDA(At, 0, 1); PG8_STAGE(PG8_SB(0, 0), b2, voffB); PG8_STAGE(PG8_SB(0, 1), b2 + hstep, voffB); PG8_STAGE(PG8_SA(0, 0), a2, voffA);
            PG8_WAIT_V(8); PG8_WAIT_L(0); PG8_BAR; PG8_MMA(1, 0, At, B0); PG8_MMA(1, 1, At, B1); PG8_BAR; PG8_SCHED;
            PG8_LDB(B0, 1, 0); PG8_LDB(B1, 1, 1); PG8_SCHED; PG8_LDA(At, 1, 0); PG8_STAGE(PG8_SA(0, 1), a2 + hstep, voffA);
            PG8_WAIT_V(8); PG8_WAIT_L(0); PG8_BAR; PG8_MMA(0, 0, At, B0); PG8_MMA(0, 1, At, B1); PG8_BAR; PG8_SCHED;
            PG8_LDA(At, 1, 1); PG8_STAGE(PG8_SB(1, 0), b3, voffB); PG8_STAGE(PG8_SB(1, 1), b3 + hstep, voffB); PG8_STAGE(PG8_SA(1, 0), a3, voffA);
            PG8_WAIT_V(8); PG8_WAIT_L(0); PG8_BAR; PG8_MMA(1, 0, At, B0); PG8_MMA(1, 1, At, B1); PG8_BAR; PG8_SCHED;
            } else {
            PG8_LDB(B0, 0, 0); PG8_SCHED; PG8_LDA(At, 0, 0); PG8_STAGE(PG8_SA(1, 1), a1 + hstep, voffA);
            PG8_WAIT_L(8); PG8_BAR; PG8_WAIT_L(0); PG8_MMA(0, 0, At, B0); PG8_BAR; PG8_SCHED;
            PG8_LDB(B1, 0, 1); PG8_STAGE(PG8_SB(0, 0), b2, voffB);
            PG8_BAR; PG8_WAIT_L(0); PG8_MMA(0, 1, At, B1); PG8_BAR;
            PG8_LDA(At, 0, 1); PG8_STAGE(PG8_SA(0, 0), a2, voffA);
            PG8_BAR; PG8_WAIT_L(0); PG8_MMA(1, 0, At, B0); PG8_BAR; PG8_SCHED;
            PG8_STAGE(PG8_SB(0, 1), b2 + hstep, voffB);
            PG8_WAIT_V(6); PG8_BAR; PG8_MMA(1, 1, At, B1); PG8_BAR;
            PG8_LDB(B0, 1, 0); PG8_SCHED; PG8_LDA(At, 1, 0); PG8_STAGE(PG8_SA(0, 1), a2 + hstep, voffA);
            PG8_WAIT_L(8); PG8_BAR; PG8_WAIT_L(0); PG8_MMA(0, 0, At, B0); PG8_BAR; PG8_SCHED;
            PG8_LDB(B1, 1, 1); PG8_STAGE(PG8_SB(1, 0), b3, voffB);
            PG8_BAR; PG8_WAIT_L(0); PG8_MMA(0, 1, At, B1); PG8_BAR;
            PG8_LDA(At, 1, 1); PG8_STAGE(PG8_SA(1, 0), a3, voffA);
            PG8_BAR; PG8_WAIT_L(0); PG8_MMA(1, 0, At, B0); PG8_BAR; PG8_SCHED;
            PG8_STAGE(PG8_SB(1, 1), b3 + hstep, voffB);
            PG8_WAIT_V(6); PG8_BAR; PG8_MMA(1, 1, At, B1); PG8_BAR;
            }
        }
        if constexpr (ALIGN_EPI) { if (wr == 0) PG8_BAR; }
        if constexpr (!Epi::AFTER_DRAIN) { E(acc, cur, wr, wc, fr, fq); S.done(cur); }
        if (!has_next) break;
#pragma unroll
        for (int a = 0; a < 2; ++a)
#pragma unroll
            for (int b = 0; b < 2; ++b)
#pragma unroll
                for (int m = 0; m < 4; ++m)
#pragma unroll
                    for (int n = 0; n < 2; ++n) acc[a][b][m][n] = (f32x4){0.f, 0.f, 0.f, 0.f};
        cur = nxt; cA = nA; cB = nB; ++ui;
        if constexpr (ALIGN_EPI) { if (wr == 1) PG8_BAR; }
    }
    PG8_WAIT_V(0);
    if constexpr (!ALIGN_EPI) { if (wr == 0) PG8_BAR; }
    PG8_BAR;
    if constexpr (Epi::AFTER_DRAIN) { E.fused(acc, cur, wr, wc, fr, fq, lds, wid, lane); S.done(cur); }
#undef PG8_SA
#undef PG8_SB
#undef PG8_STAGE
#undef PG8_LDA
#undef PG8_LDB
#undef PG8_MMA
#undef PG8_WAIT_V
#undef PG8_WAIT_L
#undef PG8_BAR
#undef PG8_SCHED
}
}

#ifndef PG8_SP2
#define PG8_SP2 true
#endif
#ifndef PG8_ALIGN
#define PG8_ALIGN true
#endif
#define GAS __attribute__((address_space(1)))
#define LAS __attribute__((address_space(3)))
typedef unsigned short bf16;
typedef unsigned v4u __attribute__((ext_vector_type(4)));
typedef float f32x4 __attribute__((ext_vector_type(4)));
typedef short bf16x8 __attribute__((ext_vector_type(8)));
typedef GAS unsigned gu32;
typedef GAS unsigned long long gu64;
#define RLX_AGENT __ATOMIC_RELAXED, __HIP_MEMORY_SCOPE_AGENT
#define LDS_WAIT() asm volatile("s_waitcnt lgkmcnt(0)" ::: "memory")
#define VM_WAIT() asm volatile("s_waitcnt vmcnt(0)" ::: "memory")
__device__ __forceinline__ unsigned long long rt() { return __builtin_amdgcn_s_memrealtime(); }
__device__ __forceinline__ unsigned f2bf(float f) { unsigned u = __builtin_bit_cast(unsigned, f); return (u + 0x7fffu + ((u >> 16) & 1u)) >> 16; }
__device__ __forceinline__ unsigned pk2(float lo, float hi) { return f2bf(lo) | (f2bf(hi) << 16); }

#define XB_TMO      128
#define XB_XCNT(j)  (256  + 64 * (j))
#define XB_XSUB(j)  (1280 + 64 * (j))
#define XB_XGEN(j)  (2304 + 64 * (j))
#define XB_TOP      3328
#define XB_TOPGEN   3392
#define XCD_BAR_WORDS 3456
#define XB_SPIN_CAP (1u << 22)

__device__ __forceinline__ unsigned xb_ld(unsigned* p)              { return __hip_atomic_load(p, __ATOMIC_RELAXED, __HIP_MEMORY_SCOPE_AGENT); }
__device__ __forceinline__ unsigned xb_add(unsigned* p, unsigned v) { return __hip_atomic_fetch_add(p, v, __ATOMIC_RELAXED, __HIP_MEMORY_SCOPE_AGENT); }
__device__ __forceinline__ unsigned xb_xcc_id() { return (unsigned)__builtin_amdgcn_s_getreg((3 << 11) | 20) & 0xFu; }
#define XB_SPIN(cond, bar) do { unsigned _sp = 0; while (cond) { __builtin_amdgcn_s_sleep(1); \
    if ((++_sp & 255u) == 0u) { if (xb_ld(&(bar)[XB_TMO])) break; if (_sp > XB_SPIN_CAP) { atomicAdd(&(bar)[XB_TMO], 1u); break; } } } } while (0)

struct XcdBarrier {
    unsigned* bar; unsigned x;
    volatile LAS unsigned* st;
};

__device__ __forceinline__ XcdBarrier xcd_barrier_post(unsigned* bar, volatile LAS unsigned* st) {
    XcdBarrier b; b.bar = bar; b.x = xb_xcc_id(); b.st = st;
    if (threadIdx.x == 0) (void)xb_add(&bar[XB_XCNT(b.x)], 1u);
    return b;
}
__device__ __forceinline__ void xcd_barrier_complete(unsigned* bar, unsigned x, unsigned& nloc, unsigned& nx) {
    const unsigned G = gridDim.x * gridDim.y * gridDim.z;
    unsigned sum, cnt, mine, sp = 0u;
    for (;;) {
        sum = 0u; cnt = 0u; mine = 0u;
#pragma unroll
        for (unsigned j = 0; j < 16; ++j) { const unsigned c = xb_ld(&bar[XB_XCNT(j)]); sum += c; cnt += (c > 0u) ? 1u : 0u; mine = (j == x) ? c : mine; }
        if (sum == G) break;
        __builtin_amdgcn_s_sleep(1);
        if ((++sp & 255u) == 0u) { if (xb_ld(&bar[XB_TMO])) break; if (sp > XB_SPIN_CAP) { atomicAdd(&bar[XB_TMO], 1u); break; } }
    }
    nloc = mine > 0u ? mine : 1u; nx = cnt > 0u ? cnt : 1u;
}

__device__ __forceinline__ void xcd_barrier(const XcdBarrier& b) {
    asm volatile("s_waitcnt vmcnt(0)" ::: "memory");
    __syncthreads();
    if (threadIdx.x == 0) {
        unsigned* bar = b.bar;
        __builtin_amdgcn_s_waitcnt(0);
        unsigned nloc = b.st[0], nx = b.st[1];
        if (nloc == 0u) { xcd_barrier_complete(bar, b.x, nloc, nx); b.st[0] = nloc; b.st[1] = nx; }
        const unsigned old = xb_add(&bar[XB_XSUB(b.x)], 1u);
        const unsigned gen = old / nloc;
        if (old + 1u == (gen + 1u) * nloc) {
            __builtin_amdgcn_fence(__ATOMIC_RELEASE, "agent");
            asm volatile("s_waitcnt vmcnt(0)" ::: "memory");
            const unsigned og = xb_add(&bar[XB_TOP], 1u);
            const unsigned tg = og / nx;
            if (og + 1u == (tg + 1u) * nx) xb_add(&bar[XB_TOPGEN], 1u);
            else XB_SPIN(xb_ld(&bar[XB_TOPGEN]) == tg, bar);
            __builtin_amdgcn_fence(__ATOMIC_ACQUIRE, "agent");
            xb_add(&bar[XB_XGEN(b.x)], 1u);
            asm volatile("s_waitcnt vmcnt(0)" ::: "memory");
        } else {
            XB_SPIN(xb_ld(&bar[XB_XGEN(b.x)]) == gen, bar);
            __builtin_amdgcn_fence(__ATOMIC_ACQUIRE, "agent");
            asm volatile("s_waitcnt vmcnt(0)" ::: "memory");
        }
    }
    __syncthreads();
}

constexpr int NWAVES = 8;
constexpr int T_ = 16384, SEQ = 4096, DM = 1024, NPROJ = 2304, INC = 2312;
constexpr int PJ_K = 512, PJ_V = 640, PJ_Z = 768, PJ_XBC = 1280;
constexpr float EPS = 1e-6f;
constexpr size_t MiB = 1u << 20;
constexpr size_t WS_CTL = 0, CTL_ZERO_BYTES = 1 * MiB;
constexpr size_t WS_SMALL = 1 * MiB;
constexpr size_t WS_WIN = 2 * MiB, WS_WOUT = 7 * MiB, WS_WQ = 9 * MiB;
constexpr size_t WS_ED = 13 * MiB, WS_EU = 29 * MiB;
constexpr size_t WS_XN = 77 * MiB;
constexpr size_t WS_PROJ = 109 * MiB;
constexpr size_t WS_ST = 181 * MiB;
constexpr size_t WS_IDX = 213 * MiB, WS_GATE = 221 * MiB, WS_SSQ = 229 * MiB, WS_END = 230 * MiB;
constexpr size_t DO_Y = 0, DO_DT = 41 * MiB;
constexpr size_t WS_CC = 230 * MiB, WS_DT = 238 * MiB, WS_EA = 239 * MiB, WS_CDEC = 240 * MiB, WS_PREV = WS_IDX;
constexpr size_t DO_YPF = 0, DO_YPLAIN = 32 * MiB;
constexpr size_t WS_PART = WS_PROJ;
constexpr size_t WS_H8 = WS_XN, WS_HS = WS_DT;
constexpr size_t WS_SSQ2 = WS_EA;
constexpr int CW_BAR = 4096, CW_RANK = 8192;
constexpr int RING_OFF = 0, RING_BYTES = 147456, LDSCTL_OFF = RING_BYTES, MISC_OFF = LDSCTL_OFF + 320, LDS_BYTES = 163840;

__constant__ unsigned char c_bucket[128] = {0, 1, 2, 3, 4, 5, 6, 7, 8, 9, 10, 11, 12, 13, 14, 15, 16, 16, 16, 17, 17, 18, 18, 18, 19, 19, 19, 20, 20, 20, 20, 21, 21, 21, 21, 22, 22, 22, 22, 22, 23, 23, 23, 23, 23, 23, 24, 24, 24, 24, 24, 24, 25, 25, 25, 25, 25, 25, 25, 26, 26, 26, 26, 26, 26, 26, 26, 27, 27, 27, 27, 27, 27, 27, 27, 27, 27, 28, 28, 28, 28, 28, 28, 28, 28, 28, 28, 29, 29, 29, 29, 29, 29, 29, 29, 29, 29, 29, 29, 30, 30, 30, 30, 30, 30, 30, 30, 30, 30, 30, 30, 30, 30, 31, 31, 31, 31, 31, 31, 31, 31, 31, 31, 31, 31, 31, 31, 31};

typedef float v16f __attribute__((ext_vector_type(16)));
typedef float v32f __attribute__((ext_vector_type(32)));
typedef unsigned v6u __attribute__((ext_vector_type(6)));
typedef _Float16 v32h __attribute__((ext_vector_type(32)));
struct Frame {
    LAS unsigned char* lds;
    volatile LAS unsigned* MISC;
    gu32* ctl;
    int wave, vcu, G;
};
__device__ __forceinline__ int lane_id() { int l; asm volatile("v_mbcnt_lo_u32_b32 %0, -1, 0\n\tv_mbcnt_hi_u32_b32 %0, -1, %0" : "=v"(l)); return l; }
__device__ __forceinline__ int opq(int x) { asm volatile("" : "+v"(x)); return x; }
template <int M> __device__ __forceinline__ float swz_xor(float v) { return __int_as_float(__builtin_amdgcn_ds_swizzle(__float_as_int(v), (M << 10) | 0x1F)); }
__device__ __forceinline__ float sum_halves(float v) { const auto r = __builtin_amdgcn_permlane32_swap(__float_as_uint(v), __float_as_uint(v), false, false); return __uint_as_float(r[0]) + __uint_as_float(r[1]); }
__device__ __forceinline__ float max_halves(float v) { const auto r = __builtin_amdgcn_permlane32_swap(__float_as_uint(v), __float_as_uint(v), false, false); return fmaxf(__uint_as_float(r[0]), __uint_as_float(r[1])); }
__device__ __forceinline__ int imax_halves(int v) { const auto r = __builtin_amdgcn_permlane32_swap((unsigned)v, (unsigned)v, false, false); return max((int)r[0], (int)r[1]); }
__device__ __forceinline__ float wave_sum(float v) {
    v += swz_xor<1>(v); v += swz_xor<2>(v); v += swz_xor<4>(v); v += swz_xor<8>(v); v += swz_xor<16>(v);
    return sum_halves(v);
}
__device__ __forceinline__ float bf2f(unsigned short b) { return __uint_as_float((unsigned)b << 16); }
__device__ __forceinline__ float bflo(unsigned w) { return __uint_as_float(w << 16); }
__device__ __forceinline__ float bfhi(unsigned w) { return __uint_as_float(w & 0xffff0000u); }
__device__ __forceinline__ float silu_f(float x) { return x / (1.f + __expf(-x)); }

__device__ __forceinline__ void p0_transpose_item(const float* W, int ldw, int K, int nblk, bf16* WT, const float* kscale, LAS float* scr, int item, int lane) {
    const int kb = item / nblk, nb = item % nblk, k0 = 64 * kb, n0 = 32 * nb;
#pragma unroll 8
    for (int i = 0; i < 32; ++i) { const int kk = 2 * i + (lane >> 5); float v = W[(size_t)(k0 + kk) * ldw + n0 + (lane & 31)]; if (kscale) v *= kscale[k0 + kk]; scr[kk * 33 + (lane & 31)] = v; }
    LDS_WAIT(); asm volatile("" ::: "memory");
    const int c = lane & 7;
#pragma unroll
    for (int j = 0; j < 4; ++j) { const int n = (lane >> 3) + 8 * j; const LAS float* s = scr + (8 * c) * 33 + n;
        v4u o; o.x = pk2(s[0 * 33], s[1 * 33]); o.y = pk2(s[2 * 33], s[3 * 33]); o.z = pk2(s[4 * 33], s[5 * 33]); o.w = pk2(s[6 * 33], s[7 * 33]);
        *(GAS v4u*)(WT + (size_t)(n0 + n) * K + k0 + 8 * c) = o; }
    LDS_WAIT(); asm volatile("" ::: "memory");
}
struct Ptrs {
    const float *x, *norm_mix, *w_in, *conv_w, *conv_b, *dt_bias, *a_log, *d_skip, *ssd_norm_w, *sinks, *w_out, *rel_bias, *norm_ffn, *w_query, *sk1, *sk2, *e_down, *e_up, *norm_final;
    float* out; unsigned char* ws;
};
constexpr int Q_SPLIT = 16384;
__device__ __forceinline__ unsigned pack4_i8(float a, float b, float c, float d) {
    const int ia = __float2int_rn(a), ib = __float2int_rn(b), ic = __float2int_rn(c), id = __float2int_rn(d);
    return (unsigned)(ia & 0xff) | ((unsigned)(ib & 0xff) << 8) | ((unsigned)(ic & 0xff) << 16) | ((unsigned)(id & 0xff) << 24);
}
__device__ __forceinline__ unsigned pack8_i4(const float* v, float inv) {
    unsigned o = 0u;
#pragma unroll
    for (int i = 0; i < 8; ++i) { int q = __float2int_rn(v[i] * inv); q = q < -7 ? -7 : (q > 7 ? 7 : q); o |= ((unsigned)q & 15u) << (4 * i); }
    return o;
}
__device__ __forceinline__ void quant_fp8s(const Ptrs& P, int lane_, int r_lo, int r_hi, int w, int nw) {
    float* SC = (float*)(P.ws + WS_SMALL);
    for (int row = r_lo + w; row < r_hi; row += nw) {
        const int e = row & 16383;
        const float4* src = (const float4*)(P.e_down + (size_t)e * DM) + 4 * lane_;
        float v[16];
#pragma unroll
        for (int q = 0; q < 4; ++q) { const float4 t = src[q]; const float4 w4 = ((const float4*)P.norm_ffn)[4 * lane_ + q]; v[4 * q] = t.x * w4.x; v[4 * q + 1] = t.y * w4.y; v[4 * q + 2] = t.z * w4.z; v[4 * q + 3] = t.w * w4.w; }
        float ss = 0.f;
#pragma unroll
        for (int q = 0; q < 16; ++q) ss = fmaf(v[q], v[q], ss);
        const float sc = fmaxf(2.5f * sqrtf(wave_sum(ss) * (1.f / 1024.f)) * (1.f / 7.f), 1e-30f);
        const float inv = 1.f / sc;
        const unsigned long long o = (unsigned long long)pack8_i4(v, inv) | ((unsigned long long)pack8_i4(v + 8, inv) << 32);
        *(unsigned long long*)(P.ws + WS_ED + ((size_t)(lane_ >> 4) * 16384 + e) * 128 + (lane_ & 15) * 8) = o;
        if (lane_ == 0) SC[row] = sc;
    }
}
typedef float f32x2q __attribute__((ext_vector_type(2)));
__device__ __forceinline__ void quant_fp6u(const Ptrs& P, int lane_, int q_lo, int q_hi, int w, int nw) {
    { float* SC = (float*)(P.ws + WS_SMALL); const int l31 = lane_ & 31, hf = lane_ >> 5;
      for (int q = q_lo + w; q < q_hi; q += nw) {
        const int e = 2 * q + hf, row = 16384 + e;
        const float4* src = (const float4*)(P.e_up + (size_t)e * DM) + 8 * l31;
        float v[32];
#pragma unroll
        for (int k = 0; k < 8; ++k) { const float4 t = src[k]; v[4 * k] = t.x; v[4 * k + 1] = t.y; v[4 * k + 2] = t.z; v[4 * k + 3] = t.w; }
        float am = 0.f;
#pragma unroll
        for (int k = 0; k < 32; ++k) am = fmaxf(am, fabsf(v[k]));
        am = fmaxf(am, swz_xor<1>(am)); am = fmaxf(am, swz_xor<2>(am)); am = fmaxf(am, swz_xor<4>(am)); am = fmaxf(am, swz_xor<8>(am)); am = fmaxf(am, swz_xor<16>(am));
        am = fmaxf(am, 1e-30f);
        const float inv = 6.0f / am;
        unsigned pk[4];
#pragma unroll
        for (int wd = 0; wd < 4; ++wd) { unsigned p4 = 0u;
            p4 = __builtin_amdgcn_cvt_scalef32_pk_fp4_f32(p4, v[8 * wd] * inv, v[8 * wd + 1] * inv, 1.0f, 0);
            p4 = __builtin_amdgcn_cvt_scalef32_pk_fp4_f32(p4, v[8 * wd + 2] * inv, v[8 * wd + 3] * inv, 1.0f, 1);
            p4 = __builtin_amdgcn_cvt_scalef32_pk_fp4_f32(p4, v[8 * wd + 4] * inv, v[8 * wd + 5] * inv, 1.0f, 2);
            p4 = __builtin_amdgcn_cvt_scalef32_pk_fp4_f32(p4, v[8 * wd + 6] * inv, v[8 * wd + 7] * inv, 1.0f, 3);
            pk[wd] = p4; }
        *(v4u*)(P.ws + WS_EU + (size_t)e * 512 + 16 * l31) = (v4u){pk[0], pk[1], pk[2], pk[3]};
        if (l31 == 0) SC[row] = am * (1.f / 6.0f);
      } }
}
__device__ __forceinline__ void p0_prologue(Frame& F0, const Ptrs& P) {
    const Frame& F = F0; const int lane_ = lane_id(), tid_ = F.wave * 64 + lane_;
    LAS float* scr = (LAS float*)(F.lds + RING_OFF + F.wave * 16384);
    const int gw = F.vcu * NWAVES + F.wave, NGW = F.G * NWAVES;
    bf16* Win_t = (bf16*)(P.ws + WS_WIN); bf16* Wout_t = (bf16*)(P.ws + WS_WOUT); bf16* Wq_t = (bf16*)(P.ws + WS_WQ);
    constexpr int I_IN = 16 * 72, I_OUT = 16 * 32, I_Q = 16 * 64, NITEMS = I_IN + I_OUT + I_Q;
    for (int it = gw; it < NITEMS; it += NGW) {
        int r = it;
        if (r < I_IN) { p0_transpose_item(P.w_in, INC, DM, 72, Win_t, nullptr, scr, r, lane_); continue; } r -= I_IN;
        if (r < I_OUT) { p0_transpose_item(P.w_out, DM, DM, 32, Wout_t, nullptr, scr, r, lane_); continue; } r -= I_OUT;
        p0_transpose_item(P.w_query, 2048, DM, 64, Wq_t, P.norm_ffn, scr, r, lane_);
    }
    quant_fp8s(P, lane_, 0, Q_SPLIT, gw, NGW);
    __syncthreads();
    { LAS float* Wdt = (LAS float*)(F.lds + RING_OFF);
      for (int i = tid_; i < 8192; i += 512) Wdt[i] = P.w_in[(size_t)(i >> 3) * INC + NPROJ + (i & 7)];
      __syncthreads();
      bf16* XN = (bf16*)(P.ws + WS_XN); float* DT = (float*)(P.ws + WS_DT);
      for (int m0 = gw * 2; m0 < T_; m0 += NGW * 2) {
        float4 xv[2][4];
#pragma unroll
        for (int rr = 0; rr < 2; ++rr) { const float4* xr = (const float4*)(P.x + (size_t)(m0 + rr) * DM);
#pragma unroll
            for (int j = 0; j < 4; ++j) xv[rr][j] = xr[j * 64 + lane_]; }
#pragma unroll
        for (int rr = 0; rr < 2; ++rr) { const int m = m0 + rr;
        float4 v[4]; float s = 0.f;
#pragma unroll
        for (int j = 0; j < 4; ++j) { v[j] = xv[rr][j]; s += v[j].x * v[j].x + v[j].y * v[j].y + v[j].z * v[j].z + v[j].w * v[j].w; }
        const float r = rsqrtf(wave_sum(s) * (1.f / 1024.f) + EPS);
        float d8[8];
#pragma unroll
        for (int q = 0; q < 8; ++q) d8[q] = 0.f;
        unsigned long long* o8 = (unsigned long long*)(XN + (size_t)m * DM);
#pragma unroll
        for (int j = 0; j < 4; ++j) { const float4 w = ((const float4*)P.norm_mix)[j * 64 + lane_];
            const float e0 = v[j].x * r * w.x, e1 = v[j].y * r * w.y, e2 = v[j].z * r * w.z, e3 = v[j].w * r * w.w;
            o8[j * 64 + lane_] = (unsigned long long)pk2(e0, e1) | ((unsigned long long)pk2(e2, e3) << 32);
            const float ev[4] = {e0, e1, e2, e3};
#pragma unroll
            for (int e = 0; e < 4; ++e) { const LAS f32x4* wr = (const LAS f32x4*)(Wdt + (size_t)(j * 256 + lane_ * 4 + e) * 8); const f32x4 w0 = wr[0], w1 = wr[1];
                d8[0] += ev[e] * w0.x; d8[1] += ev[e] * w0.y; d8[2] += ev[e] * w0.z; d8[3] += ev[e] * w0.w; d8[4] += ev[e] * w1.x; d8[5] += ev[e] * w1.y; d8[6] += ev[e] * w1.z; d8[7] += ev[e] * w1.w; } }
#pragma unroll
        for (int q = 0; q < 8; ++q) d8[q] = wave_sum(d8[q]);
        if (lane_ == 0) { float4* dp = (float4*)(DT + (size_t)m * 8); dp[0] = make_float4(d8[0], d8[1], d8[2], d8[3]); dp[1] = make_float4(d8[4], d8[5], d8[6], d8[7]); }
        }
      }
      __syncthreads(); }
}

struct EpiResH {
    static constexpr bool PERM = false, AFTER_DRAIN = false;
    const float* X; bf16* HB; float* SSQ;
    __device__ __forceinline__ void operator()(const pg8::f32x4 (&acc)[2][2][4][2], const pg8::Unit& u, int wr, int wc, int fr, int fq) const {
        const int row0 = u.pm * 256 + wr * 64 + fr, col0 = u.pn * 256 + wc * 32 + 4 * fq;
#pragma unroll
        for (int ai = 0; ai < 2; ++ai)
#pragma unroll
            for (int m = 0; m < 4; ++m) { const int row = row0 + ai * 128 + m * 16; float ss = 0.f;
#pragma unroll
                for (int bj = 0; bj < 2; ++bj)
#pragma unroll
                    for (int n = 0; n < 2; ++n) { const size_t off = (size_t)row * DM + col0 + bj * 128 + n * 16;
                        const pg8::f32x4 h = acc[ai][bj][m][n] + *(const pg8::f32x4*)(X + off);
                        ss += h[0] * h[0] + h[1] * h[1] + h[2] * h[2] + h[3] * h[3];
                        *(unsigned long long*)(HB + off) = (unsigned long long)pk2(h[0], h[1]) | ((unsigned long long)pk2(h[2], h[3]) << 32); }
                ss += swz_xor<16>(ss); ss = sum_halves(ss);
                if (fq == 0) SSQ[(size_t)row * 16 + u.pn * 4 + wc] = ss; }
    }
};

typedef float f32x16 __attribute__((ext_vector_type(16)));
typedef short s16x4 __attribute__((ext_vector_type(4)));
typedef float f32x2_t __attribute__((ext_vector_type(2)));
typedef __bf16 bf16x2_t __attribute__((ext_vector_type(2)));
#define MFMA32(a, b, c) __builtin_amdgcn_mfma_f32_32x32x16_bf16((a), (b), (c), 0, 0, 0)
__device__ __forceinline__ int crow(int reg, int h) { return (reg & 3) + 8 * (reg >> 2) + 4 * h; }
__device__ __forceinline__ unsigned cvtpk(float lo, float hi) { f32x2_t v = {lo, hi}; bf16x2_t b = __builtin_convertvector(v, bf16x2_t); return __builtin_bit_cast(unsigned, b); }
__device__ __forceinline__ bf16x8 pack8(const f32x16& x, int s) {
    v4u p; p.x = cvtpk(x[8 * s], x[8 * s + 1]); p.y = cvtpk(x[8 * s + 2], x[8 * s + 3]); p.z = cvtpk(x[8 * s + 4], x[8 * s + 5]); p.w = cvtpk(x[8 * s + 6], x[8 * s + 7]);
    return __builtin_bit_cast(bf16x8, p);
}
constexpr float LOG2E = 1.4426950408889634f;
constexpr int LDP = 136;
constexpr int S1_XT = 0, S1_XTW = 17408, S1_BSN = 34816, S1_CLN = 69632, S1_BNL = 104448, S1_F32 = 139264;

__device__ __forceinline__ float silu_fast(float x) { return x * __builtin_amdgcn_rcpf(1.f + __builtin_amdgcn_exp2f(-x * LOG2E)); }
__device__ __forceinline__ int swz_t(int row, int l) { return row * LDP + ((((l >> 3) ^ (row >> 3)) & 7) | ((l >> 3) & 8)) * 8 + (l & 7); }
#define S1_CONV8(A_, IT_) do { _Pragma("unroll") for (int e_ = 0; e_ < 8; ++e_) A_[e_] = bias[e_]; \
        _Pragma("unroll") for (int j_ = 0; j_ < 4; ++j_) { const v4u rw_ = raw[(IT_) + j_]; \
            A_[0] += w[j_][0] * bflo(rw_.x); A_[1] += w[j_][1] * bfhi(rw_.x); A_[2] += w[j_][2] * bflo(rw_.y); A_[3] += w[j_][3] * bfhi(rw_.y); \
            A_[4] += w[j_][4] * bflo(rw_.z); A_[5] += w[j_][5] * bfhi(rw_.z); A_[6] += w[j_][6] * bflo(rw_.w); A_[7] += w[j_][7] * bfhi(rw_.w); } \
        _Pragma("unroll") for (int e_ = 0; e_ < 8; ++e_) A_[e_] = silu_fast(A_[e_]); } while (0)
#define S1_LOADW(CHB_) do { _Pragma("unroll") for (int j_ = 0; j_ < 4; ++j_) { const float4 w0_ = *(const float4*)(P.conv_w + j_ * 1024 + (CHB_)), w1_ = *(const float4*)(P.conv_w + j_ * 1024 + (CHB_) + 4); \
            w[j_][0] = w0_.x; w[j_][1] = w0_.y; w[j_][2] = w0_.z; w[j_][3] = w0_.w; w[j_][4] = w1_.x; w[j_][5] = w1_.y; w[j_][6] = w1_.z; w[j_][7] = w1_.w; } \
        { const float4 b0_ = *(const float4*)(P.conv_b + (CHB_)), b1_ = *(const float4*)(P.conv_b + (CHB_) + 4); \
          bias[0] = b0_.x; bias[1] = b0_.y; bias[2] = b0_.z; bias[3] = b0_.w; bias[4] = b1_.x; bias[5] = b1_.y; bias[6] = b1_.z; bias[7] = b1_.w; } } while (0)
__device__ __forceinline__ void ssd_s1(Frame& F, const Ptrs& P) {
    const bf16* PROJ = (const bf16*)(P.ws + WS_PROJ); const float* DT = (const float*)(P.ws + WS_DT);
    float* EA = (float*)(P.ws + WS_EA); float* CDEC = (float*)(P.ws + WS_CDEC); bf16* CC = (bf16*)(P.ws + WS_CC);
    float* ST = (float*)(P.ws + WS_ST); float* YPF = (float*)((char*)P.out + DO_YPF);
    LAS unsigned char* L = F.lds + RING_OFF;
    LAS bf16* Xt = (LAS bf16*)(L + S1_XT); LAS bf16* Xtw = (LAS bf16*)(L + S1_XTW); LAS bf16* Bsn = (LAS bf16*)(L + S1_BSN); LAS bf16* Cln = (LAS bf16*)(L + S1_CLN); LAS bf16* Bnl = (LAS bf16*)(L + S1_BNL);
    LAS float* f32base = (LAS float*)(L + S1_F32);
    const int lane = lane_id(); const int tid_ = F.wave * 64 + lane;
    for (int ug = F.vcu; ug < 256; ug += F.G) {
        const int grp = ug & 1, c = (ug >> 1) & 31, b = ug >> 6, t0 = b * SEQ + c * 128;
        __syncthreads();
        if (F.wave < 4) {
            const int h = 4 * grp + F.wave, us = (b * 32 + c) * 8 + h;
            const float A = -__expf(P.a_log[h]), dtb = P.dt_bias[h];
            const int ln = opq(lane_id());
            LAS float* acum2 = f32base + F.wave * 384; LAS float* wv = acum2 + 128; LAS float* wend = wv + 128;
            const float x0 = DT[(size_t)(t0 + 2 * ln) * 8 + h] + dtb, x1 = DT[(size_t)(t0 + 2 * ln + 1) * 8 + h] + dtb;
            const float dt0 = fmaxf(x0, 0.f) + log1pf(__expf(-fabsf(x0))), dt1 = fmaxf(x1, 0.f) + log1pf(__expf(-fabsf(x1)));
            const float a0 = dt0 * A, a1 = dt1 * A;
            float s = a0 + a1;
#pragma unroll
            for (int o = 1; o < 64; o <<= 1) { const float v = __int_as_float(__builtin_amdgcn_ds_bpermute((ln - o) * 4, __float_as_int(s))); if (ln >= o) s += v; }
            const float ac1 = s, ac0 = s - a1, tot = __uint_as_float(__builtin_amdgcn_readlane(__float_as_uint(s), 63));
            acum2[2 * ln] = ac0 * LOG2E; acum2[2 * ln + 1] = ac1 * LOG2E;
            wv[2 * ln] = log2f(dt0) - ac0 * LOG2E; wv[2 * ln + 1] = log2f(dt1) - ac1 * LOG2E;
            wend[2 * ln] = dt0 * exp2f((tot - ac0) * LOG2E); wend[2 * ln + 1] = dt1 * exp2f((tot - ac1) * LOG2E);
            EA[(size_t)(t0 + 2 * ln) * 8 + h] = exp2f(ac0 * LOG2E); EA[(size_t)(t0 + 2 * ln + 1) * 8 + h] = exp2f(ac1 * LOG2E);
            if (ln == 0) CDEC[us] = exp2f(tot * LOG2E);
        }
        __syncthreads();
#pragma unroll 1
        for (int hi = 0; hi < 4; ++hi) {
            const int h = 4 * grp + hi, u = (b * 32 + c) * 8 + h;
            const float Dh = P.d_skip[h];
            const LAS float* acum2 = f32base + hi * 384; const LAS float* wv = acum2 + 128; const LAS float* wend = wv + 128;
            const int tidc = opq(tid_);
            if (hi == 0) {
                if (tidc < 440) {
                    const int cg = tidc % 40, sg = tidc / 40, l0 = 12 * sg;
                    int chb; if (cg < 8) chb = h * 64 + cg * 8; else if (cg < 24) chb = 512 + grp * 128 + (cg - 8) * 8; else chb = 768 + grp * 128 + (cg - 24) * 8;
                    v4u raw[15];
#pragma unroll
                    for (int q = 0; q < 15; ++q) { const int ss = c * 128 + l0 - 3 + q; raw[q] = (v4u){0u, 0u, 0u, 0u};
                        if (ss >= 0 && l0 - 3 + q < 128) raw[q] = *(const v4u*)(PROJ + (size_t)(b * SEQ + ss) * NPROJ + PJ_XBC + chb); }
                    float w[4][8], bias[8]; S1_LOADW(chb);
#pragma unroll
                    for (int it = 0; it < 12; it += 2) {
                        const int l = l0 + it;
                        if (l < 128) {
                            float a[8], a2[8]; S1_CONV8(a, it); S1_CONV8(a2, it + 1);
                            if (cg < 8) { const float we = wend[l], we2 = wend[l + 1];
#pragma unroll
                                for (int e = 0; e < 8; ++e) { *(LAS unsigned*)(Xt + swz_t(cg * 8 + e, l)) = cvtpk(a[e], a2[e]); *(LAS unsigned*)(Xtw + swz_t(cg * 8 + e, l)) = cvtpk(a[e] * we, a2[e] * we2); }
                            } else {
                                v4u o, o2; o.x = cvtpk(a[0], a[1]); o.y = cvtpk(a[2], a[3]); o.z = cvtpk(a[4], a[5]); o.w = cvtpk(a[6], a[7]);
                                o2.x = cvtpk(a2[0], a2[1]); o2.y = cvtpk(a2[2], a2[3]); o2.z = cvtpk(a2[4], a2[5]); o2.w = cvtpk(a2[6], a2[7]);
                                if (cg < 24) { const int n0 = (cg - 8) * 8; *(LAS v4u*)(Bsn + l * LDP + n0) = o; *(LAS v4u*)(Bsn + (l + 1) * LDP + n0) = o2;
#pragma unroll
                                    for (int e = 0; e < 8; ++e) *(LAS unsigned*)(Bnl + swz_t(n0 + e, l)) = cvtpk(a[e], a2[e]);
                                } else { const int n0 = (cg - 24) * 8; *(LAS v4u*)(Cln + l * LDP + n0) = o; *(LAS v4u*)(Cln + (l + 1) * LDP + n0) = o2;
                                    *(v4u*)(CC + (size_t)(t0 + l) * 256 + grp * 128 + n0) = o; *(v4u*)(CC + (size_t)(t0 + l + 1) * 256 + grp * 128 + n0) = o2; }
                            }
                        }
                    }
                }
            } else {
                const int cg = tidc & 7, l = 2 * (tidc >> 3), chb = h * 64 + cg * 8;
                v4u raw[5];
#pragma unroll
                for (int q = 0; q < 5; ++q) { const int ss = c * 128 + l - 3 + q; raw[q] = (v4u){0u, 0u, 0u, 0u};
                    if (ss >= 0) raw[q] = *(const v4u*)(PROJ + (size_t)(b * SEQ + ss) * NPROJ + PJ_XBC + chb); }
                float w[4][8], bias[8]; S1_LOADW(chb);
                float a[8], a2[8]; S1_CONV8(a, 0); S1_CONV8(a2, 1);
                const float we = wend[l], we2 = wend[l + 1];
#pragma unroll
                for (int e = 0; e < 8; ++e) { *(LAS unsigned*)(Xt + swz_t(cg * 8 + e, l)) = cvtpk(a[e], a2[e]); *(LAS unsigned*)(Xtw + swz_t(cg * 8 + e, l)) = cvtpk(a[e] * we, a2[e] * we2); }
            }
            __syncthreads();
            const int ln3 = opq(lane), r = ln3 & 31, hh = ln3 >> 5;
            if (F.wave < 4) {
                const int pt = F.wave >> 1;
#pragma unroll 1
                for (int q = 0; q < 2; ++q) {
                    const int lt = (F.wave & 1) ? (1 + q) : (3 * q);
                    f32x16 yacc;
#pragma unroll
                    for (int i = 0; i < 16; ++i) yacc[i] = 0.f;
                    const float al = acum2[32 * lt + r];
                    bf16x8 cf[8];
#pragma unroll
                    for (int kk = 0; kk < 8; ++kk) cf[kk] = *(const LAS bf16x8*)(Cln + (32 * lt + r) * LDP + 16 * kk + 8 * hh);
#pragma unroll 1
                    for (int st = 0; st <= lt; ++st) {
                        bf16x8 bfr[8];
#pragma unroll
                        for (int kk = 0; kk < 8; ++kk) bfr[kk] = *(const LAS bf16x8*)(Bsn + (32 * st + r) * LDP + 16 * kk + 8 * hh);
                        f32x4 wq[4];
#pragma unroll
                        for (int g4 = 0; g4 < 4; ++g4) wq[g4] = *(const LAS f32x4*)(wv + 32 * st + 8 * g4 + 4 * hh);
                        s16x4 xlo[2], xhi[2];
#pragma unroll
                        for (int sg = 0; sg < 2; ++sg) { const int prow = 32 * pt + r, lb = 32 * st + 16 * sg;
                            xlo[sg] = *(const LAS s16x4*)(Xt + swz_t(prow, lb) + 4 * hh); xhi[sg] = *(const LAS s16x4*)(Xt + swz_t(prow, lb + 8) + 4 * hh); }
                        __builtin_amdgcn_sched_barrier(0);
                        f32x16 macc;
#pragma unroll
                        for (int i = 0; i < 16; ++i) macc[i] = 0.f;
#pragma unroll
                        for (int kk = 0; kk < 8; ++kk) macc = MFMA32(bfr[kk], cf[kk], macc);
#pragma unroll
                        for (int i = 0; i < 16; ++i) { const int sl = crow(i, hh);
                            float f = __builtin_amdgcn_exp2f(al + wq[i >> 2][i & 3]);
                            if (st == lt && sl > r) f = 0.f;
                            macc[i] *= f; }
#pragma unroll
                        for (int sg = 0; sg < 2; ++sg) {
                            const bf16x8 bfrag = pack8(macc, sg);
                            const bf16x8 afrag = __builtin_shufflevector(xlo[sg], xhi[sg], 0, 1, 2, 3, 4, 5, 6, 7);
                            yacc = MFMA32(afrag, bfrag, yacc);
                        }
                    }
                    unsigned short xs16[16];
#pragma unroll
                    for (int i = 0; i < 16; ++i) xs16[i] = *(const LAS unsigned short*)(Xt + swz_t(32 * pt + crow(i, hh), 32 * lt + r));
                    __builtin_amdgcn_sched_barrier(0);
#pragma unroll
                    for (int i = 0; i < 16; ++i) {
                        const float y = yacc[i] + Dh * __uint_as_float((unsigned)xs16[i] << 16);
                        YPF[((((size_t)u * 4 + lt) * 2 + pt) * 16 + i) * 64 + ln3] = y; }
                }
            } else {
                const int nt = F.wave - 4;
#pragma unroll 1
                for (int pt = 0; pt < 2; ++pt) {
                    bf16x8 xa[8], bb[8];
#pragma unroll
                    for (int kk = 0; kk < 8; ++kk) { xa[kk] = *(const LAS bf16x8*)(Xtw + swz_t(32 * pt + r, 16 * kk + 8 * hh)); bb[kk] = *(const LAS bf16x8*)(Bnl + swz_t(32 * nt + r, 16 * kk + 8 * hh)); }
                    __builtin_amdgcn_sched_barrier(0);
                    f32x16 sacc;
#pragma unroll
                    for (int i = 0; i < 16; ++i) sacc[i] = 0.f;
#pragma unroll
                    for (int kk = 0; kk < 8; ++kk) sacc = MFMA32(xa[kk], bb[kk], sacc);
#pragma unroll
                    for (int i = 0; i < 16; ++i) ST[((size_t)u * 64 + 32 * pt + crow(i, hh)) * 128 + 32 * nt + r] = sacc[i];
                }
            }
            __syncthreads();
        }
    }
}
__device__ __forceinline__ void ssd_s2(Frame& F, const Ptrs& P) {
    const float* ST = (const float*)(P.ws + WS_ST); const float* CDEC = (const float*)(P.ws + WS_CDEC); unsigned* PREV = (unsigned*)(P.ws + WS_PREV);
    for (int g = F.vcu * 512 + (F.wave * 64 + lane_id()); g < 131072; g += F.G * 512) {
        const int n2 = g & 63, p = (g >> 6) & 63, h = (g >> 12) & 7, b = g >> 15;
        float2 st[32];
#pragma unroll
        for (int c = 0; c < 32; ++c) st[c] = *(const float2*)(ST + ((size_t)(((b * 32 + c) * 8 + h) * 64 + p)) * 128 + 2 * n2);
        float r0 = 0.f, r1 = 0.f;
#pragma unroll
        for (int c = 0; c < 32; ++c) { const size_t u = (size_t)((b * 32 + c) * 8 + h);
            PREV[((u * 64 + p) * 128 + 2 * n2) >> 1] = pk2(r0, r1);
            const float d = CDEC[u]; r0 = r0 * d + st[c].x; r1 = r1 * d + st[c].y; }
    }
}
__device__ __forceinline__ void ssd_s3(Frame& F, const Ptrs& P) {
    const bf16* CC = (const bf16*)(P.ws + WS_CC); const bf16* PREV = (const bf16*)(P.ws + WS_PREV); const float* EA = (const float*)(P.ws + WS_EA);
    const float* YPF = (const float*)((const char*)P.out + DO_YPF); const bf16* PROJ = (const bf16*)(P.ws + WS_PROJ); bf16* CAT = (bf16*)(P.ws + WS_XN);
    LAS float* red = (LAS float*)(F.lds + RING_OFF);
    const int lane = lane_id(), r = lane & 31, hh = lane >> 5, h = F.wave, grp = h >> 2;
    for (int v = F.vcu; v < 512; v += F.G) {
        const int lt = v & 3, c = (v >> 2) & 31, b = v >> 7;
        const int t = b * SEQ + c * 128 + lt * 32 + r; const size_t u = (size_t)((b * 32 + c) * 8 + h);
        float ypf[2][16]; unsigned long long zz[2][4];
#pragma unroll
        for (int pt = 0; pt < 2; ++pt) {
#pragma unroll
            for (int i = 0; i < 16; ++i) ypf[pt][i] = YPF[((((size_t)u * 4 + lt) * 2 + pt) * 16 + i) * 64 + lane];
#pragma unroll
            for (int g4 = 0; g4 < 4; ++g4) zz[pt][g4] = *(const unsigned long long*)(PROJ + (size_t)t * NPROJ + PJ_Z + h * 64 + 32 * pt + 8 * g4 + 4 * hh); }
        const float ea = EA[(size_t)t * 8 + h];
        f32x16 acc[2];
#pragma unroll
        for (int i = 0; i < 16; ++i) { acc[0][i] = 0.f; acc[1][i] = 0.f; }
#pragma unroll
        for (int kk = 0; kk < 8; ++kk) {
            const bf16x8 bb = *(const bf16x8*)(CC + (size_t)t * 256 + grp * 128 + 16 * kk + 8 * hh);
#pragma unroll
            for (int pt = 0; pt < 2; ++pt) { const bf16x8 a = *(const bf16x8*)(PREV + (u * 64 + 32 * pt + r) * 128 + 16 * kk + 8 * hh); acc[pt] = MFMA32(a, bb, acc[pt]); }
        }
        float ss = 0.f;
#pragma unroll
        for (int pt = 0; pt < 2; ++pt)
#pragma unroll
            for (int g4 = 0; g4 < 4; ++g4) {
                const unsigned z01 = (unsigned)zz[pt][g4], z23 = (unsigned)(zz[pt][g4] >> 32);
                const float zf[4] = {bflo(z01), bfhi(z01), bflo(z23), bfhi(z23)};
#pragma unroll
                for (int e = 0; e < 4; ++e) { const int i = 4 * g4 + e;
                    const float y = acc[pt][i] * ea + ypf[pt][i];
                    const float yg = y * silu_fast(zf[e]); acc[pt][i] = yg; ss = fmaf(yg, yg, ss); }
            }
        ss = sum_halves(ss);
        if (hh == 0) red[h * 32 + r] = ss;
        __syncthreads();
        float tot = 0.f;
#pragma unroll
        for (int w = 0; w < 8; ++w) tot += red[w * 32 + r];
        const float rn = rsqrtf(tot * (1.f / 512.f) + EPS);
#pragma unroll
        for (int pt = 0; pt < 2; ++pt)
#pragma unroll
            for (int g4 = 0; g4 < 4; ++g4) { const int ch = h * 64 + 32 * pt + 8 * g4 + 4 * hh;
                const float4 w = *(const float4*)(P.ssd_norm_w + ch);
                *(unsigned long long*)(CAT + (size_t)t * DM + 512 + ch) = (unsigned long long)cvtpk(acc[pt][4 * g4] * rn * w.x, acc[pt][4 * g4 + 1] * rn * w.y) | ((unsigned long long)cvtpk(acc[pt][4 * g4 + 2] * rn * w.z, acc[pt][4 * g4 + 3] * rn * w.w) << 32); }
        __syncthreads();
    }
}
__device__ __forceinline__ float gelu_erf(float v) { return 0.5f * v * (1.f + erff(v * 0.70710678118654752f)); }
typedef float f32x2v __attribute__((ext_vector_type(2)));
#define CVT8(W, LO) __builtin_amdgcn_cvt_pk_f32_fp8((int)(W), LO)
template <int CTRL> __device__ __forceinline__ float dpp_f(float v) { return __int_as_float(__builtin_amdgcn_update_dpp(0, __float_as_int(v), CTRL, 0xF, 0xF, true)); }
__device__ __forceinline__ float sum8_dpp(float s) { s += dpp_f<0xB1>(s); s += dpp_f<0x4E>(s); s += dpp_f<0x141>(s); return s; }
struct PeerPlace { int vx, nx, rank, nloc; };
__device__ __forceinline__ PeerPlace peer_place(Frame& F) {
    __syncthreads();
    if (F.wave == 0 && lane_id() == 0) {
        unsigned* bar = (unsigned*)(F.ctl + CW_BAR); const unsigned x = xb_xcc_id();
        unsigned vx = 0, nx = 0;
        for (unsigned j = 0; j < 16; ++j) { const unsigned c = xb_ld(&bar[XB_XCNT(j)]); if (c) { if (j < x) ++vx; ++nx; } }
        const unsigned rank = xb_add((unsigned*)(F.ctl + CW_RANK) + 64 * x, 1u);
        F.MISC[10] = vx; F.MISC[11] = nx ? nx : 1u; F.MISC[12] = rank; F.MISC[13] = xb_ld(&bar[XB_XCNT(x)]);
    }
    __syncthreads();
    PeerPlace pp; pp.vx = (int)F.MISC[10]; pp.nx = (int)F.MISC[11]; pp.rank = (int)F.MISC[12]; pp.nloc = (int)F.MISC[13]; if (pp.nloc < 1) pp.nloc = 1;
    return pp;
}
__device__ __forceinline__ void h_quant_rows(Frame& F, const Ptrs& P) {
    const bf16* HB = (const bf16*)(P.ws + WS_ST); unsigned char* H8 = P.ws + WS_H8; float* HS = (float*)(P.ws + WS_HS);
    const int lane = lane_id();
    for (int t = F.vcu * NWAVES + F.wave; t < T_; t += F.G * NWAVES) {
        const v4u a0 = ((const v4u*)(HB + (size_t)t * DM))[2 * lane], a1 = ((const v4u*)(HB + (size_t)t * DM))[2 * lane + 1];
        float hf[16];
        hf[0] = bflo(a0.x); hf[1] = bfhi(a0.x); hf[2] = bflo(a0.y); hf[3] = bfhi(a0.y); hf[4] = bflo(a0.z); hf[5] = bfhi(a0.z); hf[6] = bflo(a0.w); hf[7] = bfhi(a0.w);
        hf[8] = bflo(a1.x); hf[9] = bfhi(a1.x); hf[10] = bflo(a1.y); hf[11] = bfhi(a1.y); hf[12] = bflo(a1.z); hf[13] = bfhi(a1.z); hf[14] = bflo(a1.w); hf[15] = bfhi(a1.w);
        float am = 0.f;
#pragma unroll
        for (int i = 0; i < 16; ++i) am = fmaxf(am, fabsf(hf[i]));
        am = fmaxf(am, dpp_f<0xB1>(am)); am = fmaxf(am, dpp_f<0x4E>(am)); am = fmaxf(am, dpp_f<0x141>(am)); am = fmaxf(am, dpp_f<0x140>(am)); am = fmaxf(am, 1e-30f);
        const float inv = 119.f / am;
        unsigned hi[2] = {0u, 0u}, lo[2] = {0u, 0u};
#pragma unroll
        for (int i = 0; i < 16; ++i) { const int q = __float2int_rn(hf[i] * inv); const int qh = (q + 8) >> 4, ql = q - 16 * qh;
            hi[i >> 3] |= ((unsigned)qh & 15u) << (4 * (i & 7)); lo[i >> 3] |= ((unsigned)ql & 15u) << (4 * (i & 7)); }
        unsigned char* dst = H8 + (size_t)t * 1024 + (lane >> 4) * 256 + (lane & 15) * 8;
        *(unsigned long long*)dst = (unsigned long long)hi[0] | ((unsigned long long)hi[1] << 32);
        *(unsigned long long*)(dst + 128) = (unsigned long long)lo[0] | ((unsigned long long)lo[1] << 32);
        if ((lane & 15) == 0) HS[(size_t)t * 8 + (lane >> 4)] = am * (1.f / 119.f);
    }
}
constexpr int PX_D = 16;
template <int CTRL> __device__ __forceinline__ int dpp_i(int v) { return __builtin_amdgcn_update_dpp(0, v, CTRL, 0xF, 0xF, true); }
#define PX_ISSUE(BUF, LO, HI) _Pragma("unroll") for (int b_ = 0; b_ < 8; ++b_) { const unsigned off_ = ((unsigned)__builtin_amdgcn_ds_bpermute((16 * (b_ & 3) + ps) * 4, (b_ & 4) ? (HI) : (LO)) << 7) | (unsigned)(dl << 5); \
        BUF[2 * b_] = *(const v4u*)(tab + off_); BUF[2 * b_ + 1] = *(const v4u*)(tab + off_ + 16); }
struct H4 { v4u h0, h1, l0, l1; };
#define PX_DOT8(Q, HH, HL) ah = __builtin_amdgcn_sdot8((int)(Q), (int)(HH), ah, false); al = __builtin_amdgcn_sdot8((int)(Q), (int)(HL), al, false);
__device__ __forceinline__ void peer_down_token(const v4u (&cur)[PX_D], const H4& h, const float hs, float* prow, int dl, int ps) {
    int sm[8];
#pragma unroll
    for (int b = 0; b < 8; ++b) { const v4u q0 = cur[2 * b], q1 = cur[2 * b + 1];
        int ah = 0, al = 0;
        PX_DOT8(q0.x, h.h0.x, h.l0.x) PX_DOT8(q0.y, h.h0.y, h.l0.y) PX_DOT8(q0.z, h.h0.z, h.l0.z) PX_DOT8(q0.w, h.h0.w, h.l0.w)
        PX_DOT8(q1.x, h.h1.x, h.l1.x) PX_DOT8(q1.y, h.h1.y, h.l1.y) PX_DOT8(q1.z, h.h1.z, h.l1.z) PX_DOT8(q1.w, h.h1.w, h.l1.w)
        sm[b] = 16 * ah + al; }
    const bool c1 = (dl & 2) != 0, c0 = (dl & 1) != 0;
    int w4[4], w2[2];
#pragma unroll
    for (int k = 0; k < 4; ++k) { const int keep = c1 ? sm[4 + k] : sm[k], send = c1 ? sm[k] : sm[4 + k]; w4[k] = keep + dpp_i<0x4E>(send); }
#pragma unroll
    for (int k = 0; k < 2; ++k) { const int keep = c0 ? w4[2 + k] : w4[k], send = c0 ? w4[k] : w4[2 + k]; w2[k] = keep + dpp_i<0xB1>(send); }
    prow[32 * dl + ps] = (float)w2[0] * hs; prow[32 * dl + 16 + ps] = (float)w2[1] * hs;
}
__device__ __forceinline__ void peer_down(Frame& F, const Ptrs& P, const PeerPlace& pp) {
    const unsigned char* H8 = P.ws + WS_H8; const unsigned char* HSb = P.ws + WS_HS; const unsigned char* IDXb = P.ws + WS_IDX; unsigned char* PARTb = P.ws + WS_PART;
    const int lane = lane_id(), dl = lane & 3, ps = lane >> 2;
    const int tstep = pp.nloc * NWAVES;
    for (int u = pp.vx; u < 8; u += pp.nx) {
        const int s = u & 3, tend = ((u >> 2) + 1) * (T_ / 2), t0 = (u >> 2) * (T_ / 2) + pp.rank * NWAVES + F.wave;
        if (t0 >= tend) continue;
        const unsigned char* tab = P.ws + WS_ED + (size_t)s * 16384 * 128;
        const unsigned hoff = (unsigned)(s * 256 + dl * 32), ioff = (unsigned)lane * 4u;
        v4u bufA[PX_D], bufB[PX_D];
#define PD_CLAMP(T) ((T) < tend ? (T) : t0)
#define PD_META(H, HSC, TT) do { const unsigned char* hp_ = H8 + ((unsigned)(TT) * 1024u + hoff); H.h0 = *(const v4u*)hp_; H.h1 = *(const v4u*)(hp_ + 16); H.l0 = *(const v4u*)(hp_ + 128); H.l1 = *(const v4u*)(hp_ + 144); \
        HSC = *(const float*)(HSb + ((unsigned)(TT) * 32u + (unsigned)s * 4u)); } while (0)
#define PD_IDX(LO, HI, TT) do { LO = *(const int*)(IDXb + ((unsigned)(TT) * 512u + ioff)); HI = *(const int*)(IDXb + ((unsigned)(TT) * 512u + 256u + ioff)); } while (0)
        int nidx_lo, nidx_hi; PD_IDX(nidx_lo, nidx_hi, t0);
        PX_ISSUE(bufA, nidx_lo, nidx_hi);
        PD_IDX(nidx_lo, nidx_hi, PD_CLAMP(t0 + tstep));
        H4 ha, hb; float sa, sb; PD_META(ha, sa, t0);
        for (int t = t0; t < tend; t += 2 * tstep) {
            { const int tn = PD_CLAMP(t + tstep);
              PX_ISSUE(bufB, nidx_lo, nidx_hi); PD_IDX(nidx_lo, nidx_hi, PD_CLAMP(tn + tstep)); PD_META(hb, sb, tn);
              __builtin_amdgcn_sched_barrier(0);
              peer_down_token(bufA, ha, sa, (float*)(PARTb + ((unsigned)(s * T_ + t) * 512u)), dl, ps);
              __builtin_amdgcn_sched_barrier(0); }
            if (t + tstep >= tend) break;
            { const int tc = t + tstep, tn = PD_CLAMP(tc + tstep);
              PX_ISSUE(bufA, nidx_lo, nidx_hi); PD_IDX(nidx_lo, nidx_hi, PD_CLAMP(tn + tstep)); PD_META(ha, sa, tn);
              __builtin_amdgcn_sched_barrier(0);
              peer_down_token(bufB, hb, sb, (float*)(PARTb + ((unsigned)(s * T_ + tc) * 512u)), dl, ps);
              __builtin_amdgcn_sched_barrier(0); }
        }
    }
}
__device__ __forceinline__ void peer_act(Frame& F, const Ptrs& P) {
    const int* IDX = (const int*)(P.ws + WS_IDX); float* GATE = (float*)(P.ws + WS_GATE); const float* PART = (const float*)(P.ws + WS_PART); const float* SSQ = (const float*)(P.ws + WS_SSQ);
    const float* SCD = (const float*)(P.ws + WS_SMALL); const float* SCU = SCD + 16384;
    const int lane = lane_id();
    for (int w = F.vcu * NWAVES + F.wave; w < T_ * 2; w += F.G * NWAVES) {
        const int t = w >> 1; const size_t pid = (size_t)w * 64 + lane;
        const float ssq = lane < 16 ? SSQ[(size_t)t * 16 + lane] : 0.f;
        const float rstd = rsqrtf(wave_sum(ssq) * (1.f / 1024.f) + EPS);
        float pre = 0.f;
#pragma unroll
        for (int s = 0; s < 4; ++s) pre += PART[(size_t)s * T_ * 128 + pid];
        const int id = IDX[pid];
        GATE[pid] = gelu_erf(pre * SCD[id] * rstd) * GATE[pid] * SCU[id];
    }
}
constexpr int PE_PD = 8;
#define PE_LOAD4(SLOT, IDV) SLOT = *(const v4u*)(EU + (((unsigned)(IDV) << 9) | l16))
#define PE_BP(ADDR, V) __builtin_amdgcn_ds_bpermute((ADDR), (V))
__device__ __forceinline__ void peer_up_tm(Frame& F, const Ptrs& P) {
    const bf16* HB = (const bf16*)(P.ws + WS_ST); const unsigned char* EU = P.ws + WS_EU;
    const int* IDX = (const int*)(P.ws + WS_IDX); const float* GATE = (const float*)(P.ws + WS_GATE); const float* PART = (const float*)(P.ws + WS_PART);
    const float* SCD = (const float*)(P.ws + WS_SMALL); const float* SCU = SCD + 16384;
    const int lane = lane_id(), l31 = lane & 31; const bool upper = lane >= 32;
    const unsigned l16 = (unsigned)l31 << 4;
    const int bp0 = upper ? 4 : 0;
    const int t0 = F.vcu * NWAVES + F.wave, tstep = F.G * NWAVES;
    if (t0 >= T_) return;
    int idx_lo = IDX[(size_t)t0 * 128 + lane], idx_hi = IDX[(size_t)t0 * 128 + 64 + lane];
    v4u hq[4];
#pragma unroll
    for (int k = 0; k < 4; ++k) hq[k] = ((const v4u*)(HB + (size_t)t0 * DM))[4 * l31 + k];
    float g_lo = GATE[(size_t)t0 * 128 + lane], g_hi = GATE[(size_t)t0 * 128 + 64 + lane];
    float pre_lo = 0.f, pre_hi = 0.f;
#pragma unroll
    for (int s = 0; s < 4; ++s) { pre_lo += PART[((size_t)s * T_ + t0) * 128 + lane]; pre_hi += PART[((size_t)s * T_ + t0) * 128 + 64 + lane]; }
    float sdu_lo = SCD[idx_lo], sdu_hi = SCD[idx_hi], su_lo = SCU[idx_lo], su_hi = SCU[idx_hi];
    v4u ra[PE_PD];
#pragma unroll
    for (int j = 0; j < PE_PD; ++j) { const int id = PE_BP(bp0 + 8 * j, idx_lo); PE_LOAD4(ra[j], id); }
    int id_nx = PE_BP(bp0 + 8 * PE_PD, idx_lo);
    for (int t = t0; t < T_; t += tstep) {
        const int tn = (t + tstep < T_) ? t + tstep : t;
        const int nidx_lo = IDX[(size_t)tn * 128 + lane], nidx_hi = IDX[(size_t)tn * 128 + 64 + lane];
        v4u nh[4];
#pragma unroll
        for (int k = 0; k < 4; ++k) nh[k] = ((const v4u*)(HB + (size_t)tn * DM))[4 * l31 + k];
        const float ng_lo = GATE[(size_t)tn * 128 + lane], ng_hi = GATE[(size_t)tn * 128 + 64 + lane];
        float npart_lo[4], npart_hi[4];
#pragma unroll
        for (int s = 0; s < 4; ++s) { npart_lo[s] = PART[((size_t)s * T_ + tn) * 128 + lane]; npart_hi[s] = PART[((size_t)s * T_ + tn) * 128 + 64 + lane]; }
        float ssq = 0.f;
#pragma unroll
        for (int k = 0; k < 4; ++k) { ssq = fmaf(bflo(hq[k].x), bflo(hq[k].x), ssq); ssq = fmaf(bfhi(hq[k].x), bfhi(hq[k].x), ssq); ssq = fmaf(bflo(hq[k].y), bflo(hq[k].y), ssq); ssq = fmaf(bfhi(hq[k].y), bfhi(hq[k].y), ssq);
            ssq = fmaf(bflo(hq[k].z), bflo(hq[k].z), ssq); ssq = fmaf(bfhi(hq[k].z), bfhi(hq[k].z), ssq); ssq = fmaf(bflo(hq[k].w), bflo(hq[k].w), ssq); ssq = fmaf(bfhi(hq[k].w), bfhi(hq[k].w), ssq); }
        ssq += swz_xor<1>(ssq); ssq += swz_xor<2>(ssq); ssq += swz_xor<4>(ssq); ssq += swz_xor<8>(ssq); ssq += swz_xor<16>(ssq);
        const float rstd = rsqrtf(ssq * (1.f / 1024.f) + EPS);
        const float act_lo = gelu_erf(pre_lo * sdu_lo * rstd) * g_lo * su_lo, act_hi = gelu_erf(pre_hi * sdu_hi * rstd) * g_hi * su_hi;
        f32x2v acc[16];
#pragma unroll
        for (int i = 0; i < 16; ++i) acc[i] = (f32x2v){0.f, 0.f};
        float a_cur = __int_as_float(PE_BP(bp0, __float_as_int(act_lo)));
#pragma unroll
        for (int q = 0; q < 64; ++q) {
            const int qa = q + 1, ql = q + PE_PD + 1;
            float a_nx = 0.f;
            if (qa < 64) a_nx = __int_as_float(PE_BP(bp0 + 8 * (qa & 31), __float_as_int(qa < 32 ? act_lo : act_hi)));
            int id_n2;
            if (ql < 64) id_n2 = PE_BP(bp0 + 8 * (ql & 31), ql < 32 ? idx_lo : idx_hi);
            else id_n2 = PE_BP(bp0 + 8 * ((ql - 64) & 31), nidx_lo);
            __builtin_amdgcn_sched_barrier(0);
            { const f32x2v av = {a_cur, a_cur}; const v4u r = ra[q % PE_PD];
#define PE_FMA4(W, O) acc[O] = __builtin_elementwise_fma(av, (f32x2v)__builtin_amdgcn_cvt_scalef32_pk_f32_fp4(W, 1.0f, 0), acc[O]); acc[O + 1] = __builtin_elementwise_fma(av, (f32x2v)__builtin_amdgcn_cvt_scalef32_pk_f32_fp4(W, 1.0f, 1), acc[O + 1]); \
              acc[O + 2] = __builtin_elementwise_fma(av, (f32x2v)__builtin_amdgcn_cvt_scalef32_pk_f32_fp4(W, 1.0f, 2), acc[O + 2]); acc[O + 3] = __builtin_elementwise_fma(av, (f32x2v)__builtin_amdgcn_cvt_scalef32_pk_f32_fp4(W, 1.0f, 3), acc[O + 3]);
              PE_FMA4(r.x, 0) PE_FMA4(r.y, 4) PE_FMA4(r.z, 8) PE_FMA4(r.w, 12) }
            asm volatile("" : "+v"(acc[0]), "+v"(acc[1]), "+v"(acc[2]), "+v"(acc[3]), "+v"(acc[4]), "+v"(acc[5]), "+v"(acc[6]), "+v"(acc[7]));
            asm volatile("" : "+v"(acc[8]), "+v"(acc[9]), "+v"(acc[10]), "+v"(acc[11]), "+v"(acc[12]), "+v"(acc[13]), "+v"(acc[14]), "+v"(acc[15]));
            PE_LOAD4(ra[q % PE_PD], id_nx);
            id_nx = id_n2; a_cur = a_nx;
            __builtin_amdgcn_sched_barrier(0);
        }
        { float a = 0.f, c = 0.f;
#pragma unroll
          for (int s = 0; s < 4; ++s) { a += npart_lo[s]; c += npart_hi[s]; }
          pre_lo = a; pre_hi = c; }
        sdu_lo = SCD[nidx_lo]; sdu_hi = SCD[nidx_hi]; su_lo = SCU[nidx_lo]; su_hi = SCU[nidx_hi];
        float y[32];
#pragma unroll
        for (int k = 0; k < 4; ++k) { y[8 * k] = bflo(hq[k].x); y[8 * k + 1] = bfhi(hq[k].x); y[8 * k + 2] = bflo(hq[k].y); y[8 * k + 3] = bfhi(hq[k].y); y[8 * k + 4] = bflo(hq[k].z); y[8 * k + 5] = bfhi(hq[k].z); y[8 * k + 6] = bflo(hq[k].w); y[8 * k + 7] = bfhi(hq[k].w); }
        float s2 = 0.f;
#pragma unroll
        for (int i = 0; i < 16; ++i) { y[2 * i] += sum_halves(acc[i][0]); y[2 * i + 1] += sum_halves(acc[i][1]); s2 = fmaf(y[2 * i], y[2 * i], s2); s2 = fmaf(y[2 * i + 1], y[2 * i + 1], s2); }
        s2 += swz_xor<1>(s2); s2 += swz_xor<2>(s2); s2 += swz_xor<4>(s2); s2 += swz_xor<8>(s2); s2 += swz_xor<16>(s2);
        const float r2 = rsqrtf(s2 * (1.f / 1024.f) + EPS);
        const float4* wf = (const float4*)(P.norm_final) + 8 * l31 + 4 * (lane >> 5); float4* o = (float4*)(P.out + (size_t)t * DM) + 8 * l31 + 4 * (lane >> 5);
#pragma unroll
        for (int k = 0; k < 4; ++k) { const float4 w = wf[k];
            const float e0 = upper ? y[16 + 4 * k] : y[4 * k], e1 = upper ? y[17 + 4 * k] : y[4 * k + 1], e2 = upper ? y[18 + 4 * k] : y[4 * k + 2], e3 = upper ? y[19 + 4 * k] : y[4 * k + 3];
            o[k] = make_float4(e0 * r2 * w.x, e1 * r2 * w.y, e2 * r2 * w.z, e3 * r2 * w.w); }
        idx_lo = nidx_lo; idx_hi = nidx_hi; g_lo = ng_lo; g_hi = ng_hi;
#pragma unroll
        for (int k = 0; k < 4; ++k) hq[k] = nh[k];
    }
}
constexpr int TK_LDK = 136, TK_K2 = 34816, TK_SCR = 69632, TK_SP = 49;
__device__ __forceinline__ int mono_key(float x) { const int b = __float_as_int(x); return b ^ ((b >> 31) & 0x7fffffff); }
__device__ __forceinline__ float unmono(int m) { return __int_as_float(m ^ ((m >> 31) & 0x7fffffff)); }
__device__ __forceinline__ int max3i(int a, int b, int c) { return max(max(a, b), c); }
#define CEX(A, I, J) do { const int hi_ = max(A[I], A[J]), lo_ = min(A[I], A[J]); A[I] = hi_; A[J] = lo_; } while (0)
template <int N, int OFF, int K, int J, int LEN> struct BitonicStep {
    static __device__ __forceinline__ void run(int (&a)[LEN]) {
#pragma unroll
        for (int i = 0; i < N; ++i) { const int l = i ^ J; if (l > i) { if ((i & K) == 0) CEX(a, OFF + i, OFF + l); else CEX(a, OFF + l, OFF + i); } }
        if constexpr (J > 1) BitonicStep<N, OFF, K, (J >> 1), LEN>::run(a);
        else if constexpr (K < N) BitonicStep<N, OFF, (K << 1), K, LEN>::run(a);
    }
};
template <int N, int OFF, int LEN> __device__ __forceinline__ void bitonic_sort_desc(int (&a)[LEN]) { BitonicStep<N, OFF, 2, 1, LEN>::run(a); }
template <int OFF, int LEN> __device__ __forceinline__ void bitonic_merge16_desc(int (&a)[LEN]) { BitonicStep<16, OFF, 16, 8, LEN>::run(a); }
template <int A, int B, int LEN> __device__ __forceinline__ void merge_top16(int (&a)[LEN]) {
#pragma unroll
    for (int i = 0; i < 16; ++i) a[A + i] = max(a[A + i], a[B + 15 - i]);
    bitonic_merge16_desc<A, LEN>(a);
}
template <int LEN> __device__ __forceinline__ void pair_top16(int (&a)[LEN]) {
    int lo[16], up[16];
#pragma unroll
    for (int i = 0; i < 16; ++i) { const auto rr = __builtin_amdgcn_permlane32_swap((unsigned)a[i], (unsigned)a[i], false, false); lo[i] = (int)rr[0]; up[i] = (int)rr[1]; }
#pragma unroll
    for (int i = 0; i < 16; ++i) a[i] = max(lo[i], up[15 - i]);
    bitonic_merge16_desc<0, LEN>(a);
}
__device__ __forceinline__ void topk_half(const bf16x8 (&qf)[8], const LAS bf16* Kh, int r, int hh, int (&key)[64]) {
#pragma unroll
    for (int nt = 0; nt < 4; ++nt) {
        f32x16 sc;
#pragma unroll
        for (int i = 0; i < 16; ++i) sc[i] = 0.f;
#pragma unroll
        for (int kk = 0; kk < 8; ++kk) { const bf16x8 a = *(const LAS bf16x8*)(Kh + (32 * nt + r) * TK_LDK + 16 * kk + 8 * hh); sc = MFMA32(a, qf[kk], sc); }
#pragma unroll
        for (int i = 0; i < 16; ++i) key[nt * 16 + i] = (mono_key(sc[i]) & ~127) | (127 - (32 * nt + crow(i, hh)));
    }
    bitonic_sort_desc<16, 0, 64>(key); bitonic_sort_desc<16, 16, 64>(key); bitonic_sort_desc<16, 32, 64>(key); bitonic_sort_desc<16, 48, 64>(key);
    merge_top16<0, 16, 64>(key); merge_top16<32, 48, 64>(key); merge_top16<0, 32, 64>(key);
    pair_top16<64>(key);
}
__device__ __forceinline__ void topk_finish(const LAS int* scr, int hh, float rstd, int* IDX, float* GATE, int t, int hd) {
    const LAS int* la = scr + hh * 16; const LAS int* lb = scr + (1 - hh) * 16;
    float va[4], vb[16];
#pragma unroll
    for (int i = 0; i < 4; ++i) va[i] = unmono(la[i] & ~127);
#pragma unroll
    for (int j = 0; j < 16; ++j) vb[j] = unmono(lb[j] & ~127);
    int ck[32];
    {
        int q = 0;
#pragma unroll
        for (int i = 0; i < 4; ++i)
#pragma unroll
            for (int j = i; j < 16; ++j) if ((i + 1) * (j + 1) <= 16) {
                const int pos = hh ? (j * 16 + i) : (i * 16 + j);
                int k = (mono_key(va[i] + vb[j]) & ~255) | (255 - pos);
                if (i == j && hh) k = (int)0x80000000;
                ck[q++] = k; }
#pragma unroll
        for (int i = 27; i < 32; ++i) ck[i] = (int)0x80000000;
    }
    bitonic_sort_desc<32, 0, 32>(ck);
    pair_top16<32>(ck);
    const float vmax = unmono(ck[0] & ~255) * rstd;
    float ev[8]; int id[8]; float esum = 0.f; const int hm = -hh;
#pragma unroll
    for (int q = 0; q < 8; ++q) { const int wk = ck[q] ^ ((ck[q] ^ ck[8 + q]) & hm); const int pos = 255 - (wk & 255);
        const int n1 = 127 - (scr[pos >> 4] & 127), n2 = 127 - (scr[16 + (pos & 15)] & 127);
        id[q] = n1 * 128 + n2;
        ev[q] = exp2f((unmono(wk & ~255) * rstd - vmax) * LOG2E); esum += ev[q]; }
    esum = sum_halves(esum);
    const float inv = 1.f / esum;
    int4* ip = (int4*)(IDX + ((size_t)t * 8 + hd) * 16 + hh * 8); float4* gp = (float4*)(GATE + ((size_t)t * 8 + hd) * 16 + hh * 8);
    ip[0] = make_int4(id[0], id[1], id[2], id[3]); ip[1] = make_int4(id[4], id[5], id[6], id[7]);
    gp[0] = make_float4(ev[0] * inv, ev[1] * inv, ev[2] * inv, ev[3] * inv); gp[1] = make_float4(ev[4] * inv, ev[5] * inv, ev[6] * inv, ev[7] * inv);
}
constexpr int TQ_QH = 69632, TQ_QP = 272;
struct OneUnit { pg8::StaticOrder S; int i;
    __device__ __forceinline__ bool next(int j, pg8::Unit& u) const { return j == 0 ? S.next(i, u) : false; }
    __device__ __forceinline__ void a_ready(const pg8::Unit&) const {}
    __device__ __forceinline__ void done(const pg8::Unit&) const {}
};
struct EpiQTopk {
    static constexpr bool PERM = true, AFTER_DRAIN = true;
    const float* sk1; const float* sk2; const float* SSQ; int* IDX; float* GATE;
    __device__ __forceinline__ void dump(const pg8::f32x4 (&acc)[2][2][4][2], int bj, LAS unsigned char* QH, int wr, int wc, int fr, int fq) const {
#pragma unroll
        for (int ai = 0; ai < 2; ++ai)
#pragma unroll
            for (int m = 0; m < 4; ++m) { const pg8::f32x4 v0 = bj ? acc[ai][1][m][0] : acc[ai][0][m][0], v1 = bj ? acc[ai][1][m][1] : acc[ai][0][m][1];
                v4u w; w.x = cvtpk(v0[0], v0[1]); w.y = cvtpk(v0[2], v0[3]); w.z = cvtpk(v1[0], v1[1]); w.w = cvtpk(v1[2], v1[3]);
                *(LAS v4u*)(QH + (128 * ai + 64 * wr + 16 * m + fr) * TQ_QP + (32 * wc + 8 * fq) * 2) = w; }
    }
    __device__ __forceinline__ void fused(const pg8::f32x4 (&acc)[2][2][4][2], const pg8::Unit& u, int wr, int wc, int fr, int fq, LAS unsigned char* L, int wid, int lane) const {
        LAS bf16* K1 = (LAS bf16*)L; LAS bf16* K2 = (LAS bf16*)(L + TK_K2); LAS unsigned char* QH = L + TQ_QH;
        const int tid_ = wid * 64 + lane, r = lane & 31, hh = lane >> 5;
        for (int i = tid_; i < 16384; i += 512) { const int n = i >> 7, k = i & 127; K1[n * TK_LDK + k] = (bf16)f2bf(sk1[i]); K2[n * TK_LDK + k] = (bf16)f2bf(sk2[i]); }
        dump(acc, 0, QH, wr, wc, fr, fq);
        __syncthreads();
        const int t = u.pm * 256 + 32 * wid + r;
        float rstd;
        { const float4* sp = (const float4*)(SSQ + (size_t)t * 16); const float4 a = sp[0], b = sp[1], c = sp[2], d = sp[3];
          rstd = rsqrtf(((a.x + a.y + a.z + a.w) + (b.x + b.y + b.z + b.w) + (c.x + c.y + c.z + c.w) + (d.x + d.y + d.z + d.w)) * (1.f / 1024.f) + EPS); }
        const LAS unsigned char* qrow = QH + (32 * wid + r) * TQ_QP + 16 * hh;
        int key[64], list0[16];
        { bf16x8 qf[8];
#pragma unroll
          for (int kk = 0; kk < 8; ++kk) qf[kk] = *(const LAS bf16x8*)(qrow + 32 * kk);
          topk_half(qf, K1, r, hh, key);
#pragma unroll
          for (int i = 0; i < 16; ++i) list0[i] = key[i]; }
        __syncthreads();
        dump(acc, 1, QH, wr, wc, fr, fq);
        __syncthreads();
        { bf16x8 qf[8];
#pragma unroll
          for (int kk = 0; kk < 8; ++kk) qf[kk] = *(const LAS bf16x8*)(qrow + 32 * kk);
          topk_half(qf, K2, r, hh, key); }
        LAS int* scr = (LAS int*)(QH + 32 * wid * TQ_QP) + r * TK_SP;
        LDS_WAIT();
        if (hh == 0) {
#pragma unroll
            for (int i = 0; i < 16; ++i) { scr[i] = list0[i]; scr[16 + i] = key[i]; } }
        topk_finish(scr, hh, rstd, IDX, GATE, t, u.pn);
        __syncthreads();
    }
};

constexpr int AT_KP = 72, AT_VP = 264;
constexpr int AT_K = 0, AT_VT = 36864, AT_BT = 36864 + 33792;
__device__ __forceinline__ void attn_phase(Frame& F, const Ptrs& P) {
    const bf16* PROJ = (const bf16*)(P.ws + WS_PROJ); bf16* CAT = (bf16*)(P.ws + WS_XN);
    LAS unsigned char* L = F.lds + RING_OFF;
    LAS bf16* Ks = (LAS bf16*)(L + AT_K); LAS bf16* Vt = (LAS bf16*)(L + AT_VT); LAS float* btab = (LAS float*)(L + AT_BT);
    const int lane = lane_id(), tid_ = F.wave * 64 + lane, r = lane & 31, hh = lane >> 5;
    for (int u = F.vcu; u < 256; u += F.G) {
        const int hkv = u & 1, n = (u >> 1) & 31, b = u >> 6;
        const int trow0 = b * SEQ + n * 128;
        for (int i = tid_; i < 2048; i += 512) {
            const int kj = i >> 3, ch = i & 7; const bool ok = (n > 0) || (kj >= 128);
            v4u kv = {0u, 0u, 0u, 0u}, vv = {0u, 0u, 0u, 0u};
            if (ok) { const bf16* rowp = PROJ + (size_t)(trow0 - 128 + kj) * NPROJ + hkv * 64 + ch * 8; kv = *(const v4u*)(rowp + PJ_K); vv = *(const v4u*)(rowp + PJ_V); }
            *(LAS v4u*)(Ks + kj * AT_KP + ch * 8) = kv;
            LAS bf16* vp = Vt + (ch * 8) * AT_VP + kj;
            vp[0] = (bf16)(vv.x & 0xffffu); vp[AT_VP] = (bf16)(vv.x >> 16); vp[2 * AT_VP] = (bf16)(vv.y & 0xffffu); vp[3 * AT_VP] = (bf16)(vv.y >> 16);
            vp[4 * AT_VP] = (bf16)(vv.z & 0xffffu); vp[5 * AT_VP] = (bf16)(vv.z >> 16); vp[6 * AT_VP] = (bf16)(vv.w & 0xffffu); vp[7 * AT_VP] = (bf16)(vv.w >> 16);
        }
        for (int i = tid_; i < 768; i += 512) { const int gg = i / 192, dist = i % 192 - 32;
            btab[i] = (dist >= 0 && dist < 128) ? P.rel_bias[c_bucket[dist & 127] * 8 + hkv * 4 + gg] * LOG2E : 0.f; }
        __syncthreads();
        const int g = F.wave & 3, h = hkv * 4 + g;
        const float sink2 = P.sinks[h] * LOG2E;
#pragma unroll 1
        for (int qq = 0; qq < 2; ++qq) {
            const int qt = (F.wave >> 2) * 2 + qq, t = trow0 + 32 * qt + r;
            bf16x8 qf[4];
#pragma unroll
            for (int kk = 0; kk < 4; ++kk) qf[kk] = *(const bf16x8*)(PROJ + (size_t)t * NPROJ + h * 64 + 16 * kk + 8 * hh);
            f32x16 sc[5];
#pragma unroll
            for (int j = 0; j < 5; ++j) {
#pragma unroll
                for (int i = 0; i < 16; ++i) sc[j][i] = 0.f;
#pragma unroll
                for (int kk = 0; kk < 4; ++kk) { const bf16x8 a = *(const LAS bf16x8*)(Ks + (32 * (qt + j) + r) * AT_KP + 16 * kk + 8 * hh); sc[j] = MFMA32(a, qf[kk], sc[j]); }
            }
            float m = sink2;
            const LAS float* bt = btab + g * 192 + 160 + r - 4 * hh;
#pragma unroll
            for (int j = 0; j < 5; ++j) {
                const bool tile_ok = (n > 0) || (qt + j >= 4);
#pragma unroll
                for (int i = 0; i < 16; ++i) { const int dist = 128 + r - (32 * j + crow(i, hh));
                    const bool ok = tile_ok && (j == 0 ? dist < 128 : (j == 4 ? dist >= 0 : true));
                    const float s = sc[j][i] * (0.125f * LOG2E) + bt[-(32 * j + (i & 3) + 8 * (i >> 2))];
                    sc[j][i] = ok ? s : -INFINITY; m = fmaxf(m, sc[j][i]); }
            }
            m = max_halves(m);
            float l = 0.f;
#pragma unroll
            for (int j = 0; j < 5; ++j)
#pragma unroll
                for (int i = 0; i < 16; ++i) { sc[j][i] = exp2f(sc[j][i] - m); l += sc[j][i]; }
            l = sum_halves(l);
            l += exp2f(sink2 - m);
            const float inv = 1.f / l;
            f32x16 o[2];
#pragma unroll
            for (int i = 0; i < 16; ++i) { o[0][i] = 0.f; o[1][i] = 0.f; }
#pragma unroll
            for (int j = 0; j < 5; ++j)
#pragma unroll
                for (int sg = 0; sg < 2; ++sg) {
                    const bf16x8 pf = pack8(sc[j], sg);
#pragma unroll
                    for (int dt = 0; dt < 2; ++dt) {
                        const LAS bf16* vb = Vt + (32 * dt + r) * AT_VP + 32 * (qt + j) + 16 * sg + 4 * hh;
                        const s16x4 lo = *(const LAS s16x4*)(vb), hi = *(const LAS s16x4*)(vb + 8);
                        o[dt] = MFMA32(__builtin_shufflevector(lo, hi, 0, 1, 2, 3, 4, 5, 6, 7), pf, o[dt]);
                    }
                }
            bf16* op = CAT + (size_t)t * DM + h * 64 + 4 * hh;
#pragma unroll
            for (int dt = 0; dt < 2; ++dt)
#pragma unroll
                for (int g4 = 0; g4 < 4; ++g4)
                    *(unsigned long long*)(op + 32 * dt + 8 * g4) = (unsigned long long)cvtpk(o[dt][4 * g4] * inv, o[dt][4 * g4 + 1] * inv) | ((unsigned long long)cvtpk(o[dt][4 * g4 + 2] * inv, o[dt][4 * g4 + 3] * inv) << 32);
        }
        __syncthreads();
    }
}
struct Args { Ptrs p; };
__global__ void __launch_bounds__(NWAVES * 64, 2) hymba_fwd(Args args) {
    extern __shared__ __attribute__((aligned(16))) unsigned char lds[];
    const Ptrs& P = args.p;
    Frame F;
    F.lds = (LAS unsigned char*)lds;
    F.MISC = (volatile LAS unsigned*)(F.lds + MISC_OFF);
    F.wave = __builtin_amdgcn_readfirstlane(threadIdx.x >> 6);
    F.G = gridDim.x; { const int bx = blockIdx.x; F.vcu = (F.G % 8 == 0) ? (bx % 8) * (F.G / 8) + bx / 8 : bx; }
    F.ctl = (gu32*)(P.ws + WS_CTL);
    for (int u = threadIdx.x; u < (LDS_BYTES - LDSCTL_OFF) / 4; u += NWAVES * 64) ((LAS unsigned*)(F.lds + LDSCTL_OFF))[u] = 0u;
    __syncthreads();
    XcdBarrier bar = xcd_barrier_post((unsigned*)(F.ctl + CW_BAR), F.MISC + 8);
#define GRID_BAR() xcd_barrier(bar)

    bf16* XN = (bf16*)(P.ws + WS_XN); bf16* PROJ = (bf16*)(P.ws + WS_PROJ); bf16* HB = (bf16*)(P.ws + WS_ST);
    p0_prologue(F, P);
    GRID_BAR();
    { pg8::Gemm g{XN, (const bf16*)(P.ws + WS_WIN), T_, NPROJ, DM, F.wave}; pg8::StaticOrder S; S.init(T_, NPROJ, F.G, (int)blockIdx.x);
      pg8::EpiBf16<0> E{PROJ, NPROJ, nullptr, 0, 0, 1.f};
      pg8::gemm_phase<pg8::EpiBf16<0>, pg8::StaticOrder, PG8_ALIGN, PG8_SP2>(F.lds + RING_OFF, g, S, E); }
    if (F.G == 256 && blockIdx.x >= 64) quant_fp6u(P, lane_id(), 0, 8192, ((int)blockIdx.x - 64) * NWAVES + F.wave, 192 * NWAVES);
    else if (F.G != 256) quant_fp6u(P, lane_id(), 0, 8192, F.vcu * NWAVES + F.wave, F.G * NWAVES);
    GRID_BAR();
    ssd_s1(F, P);
    attn_phase(F, P);
    GRID_BAR();
    ssd_s2(F, P);
    GRID_BAR();
    ssd_s3(F, P);
    GRID_BAR();
    { pg8::Gemm g{XN, (const bf16*)(P.ws + WS_WOUT), T_, DM, DM, F.wave}; pg8::StaticOrder S; S.init(T_, DM, F.G, (int)blockIdx.x);
      EpiResH E{P.x, HB, (float*)(P.ws + WS_SSQ)};
      pg8::gemm_phase<EpiResH, pg8::StaticOrder, PG8_ALIGN, PG8_SP2>(F.lds + RING_OFF, g, S, E); }
    GRID_BAR();
    { pg8::Gemm g{HB, (const bf16*)(P.ws + WS_WQ), T_, 2048, DM, F.wave}; pg8::StaticOrder S; S.init(T_, 2048, F.G, (int)blockIdx.x);
      EpiQTopk E{P.sk1, P.sk2, (const float*)(P.ws + WS_SSQ), (int*)(P.ws + WS_IDX), (float*)(P.ws + WS_GATE)};
#pragma unroll 1
      for (int ui = 0; ui < 64; ++ui) { pg8::Unit u0; if (!S.next(ui, u0)) break;
          OneUnit S1{S, ui};
          pg8::gemm_phase<EpiQTopk, OneUnit, PG8_ALIGN, PG8_SP2>(F.lds + RING_OFF, g, S1, E); } }
    h_quant_rows(F, P);
    GRID_BAR();
    { const PeerPlace pp = peer_place(F);
      peer_down(F, P, pp); }
    GRID_BAR();
    peer_up_tm(F, P);
}

extern "C" void kernel_launch(void* const* d_in, const int* in_sizes, int n_in, void* d_out, int out_size, void* d_ws, size_t ws_size, hipStream_t stream) {
    static int grid = 0;
    if (grid == 0) {
        if (n_in != 19 || out_size != T_ * DM || ws_size < WS_END) { fprintf(stderr, "kernel_launch: unexpected shapes (n_in %d, out %d, ws %zu)\n", n_in, out_size, ws_size); grid = -1; return; }
        int dev = 0, cus = 0, per_cu = 0;
        if (hipGetDevice(&dev) != hipSuccess || hipDeviceGetAttribute(&cus, hipDeviceAttributeMultiprocessorCount, dev) != hipSuccess) { grid = -1; return; }
        if (hipFuncSetAttribute((const void*)hymba_fwd, hipFuncAttributeMaxDynamicSharedMemorySize, LDS_BYTES) != hipSuccess) { fprintf(stderr, "kernel_launch: hipFuncSetAttribute failed\n"); grid = -1; return; }
        if (hipOccupancyMaxActiveBlocksPerMultiprocessor(&per_cu, (const void*)hymba_fwd, NWAVES * 64, LDS_BYTES) != hipSuccess || per_cu < 1) { fprintf(stderr, "kernel_launch: occupancy query says %d blocks per CU\n", per_cu); grid = -1; (void)hipGetLastError(); return; }
        grid = cus;
    }
    if (grid < 0) return;
    (void)hipMemsetAsync((char*)d_ws + WS_CTL, 0, CTL_ZERO_BYTES, stream);
    Args a{};
    const float** pp = (const float**)&a.p;
    for (int i = 0; i < 19; ++i) pp[i] = (const float*)d_in[i];
    a.p.out = (float*)d_out; a.p.ws = (unsigned char*)d_ws;
    hipLaunchKernelGGL(hymba_fwd, dim3(grid), dim3(NWAVES * 64), LDS_BYTES, stream, a);
}
```

```cpp
#include <hip/hip_runtime.h>
#include <cstdio>
#include <cstdint>
#include <math.h>
namespace pg8 {
#define PG8_LAS __attribute__((address_space(3)))
typedef unsigned short bf16_t;
typedef short bf16x8 __attribute__((ext_vector_type(8)));
typedef float f32x4 __attribute__((ext_vector_type(4)));
typedef unsigned u32x4 __attribute__((ext_vector_type(4)));
constexpr int BM = 256, BK = 64, HALF = 128, HTB = HALF * BK * 2  , STAGE_BYTES = 8 * HTB, NXCD = 8, WGM = 8;

__host__ __device__ __forceinline__ int lds_byte(int r, int c) { const int st = (r >> 4) * 2 + (c >> 5), rr = r & 15, cc = c & 31, ob = rr * 64 + cc * 2; return st * 1024 + (ob ^ (((ob >> 9) & 1) << 5)); }
__host__ __device__ __forceinline__ void stage_rc(int b, int& R, int& C) { const int st = b / 1024, sb = b % 1024, swz = sb ^ (((sb >> 9) & 1) << 5); R = (st >> 1) * 16 + swz / 64; C = (st & 1) * 32 + (swz % 64) / 2; }
__host__ __device__ __forceinline__ int perm32(int rho) { const int n = rho >> 4, i = rho & 15; return 8 * (i >> 2) + 4 * n + (i & 3); }

struct Unit { int pm, pn; };
struct Gemm { const bf16_t* A; const bf16_t* Bt; int M, N, K, wave; };

struct StaticOrder {
    int nM, nN, nwg, G, c;
    __host__ __device__ void init(int M, int N, int G_, int c_) { nM = M / BM; nN = N / BM; nwg = nM * nN; G = G_; c = c_; }
    __host__ __device__ bool next(int i, Unit& u) const {
        const long L = (long)i * G + c; if (L >= nwg) return false;
        int wgid = (int)L; { const int q = nwg / NXCD, r = nwg % NXCD, xcd = wgid % NXCD, off = wgid / NXCD; wgid = (xcd < r ? xcd * (q + 1) : r * (q + 1) + (xcd - r) * q) + off; }
        const int nig = WGM * nN, gid = wgid / nig, fm = gid * WGM, gsz = (nM - fm) < WGM ? (nM - fm) : WGM;
        u.pm = fm + ((wgid % nig) % gsz); u.pn = (wgid % nig) / gsz; return true;
    }
    __device__ __forceinline__ void a_ready(const Unit&) const {}
    __device__ __forceinline__ void done(const Unit&) const {}
};

__device__ __forceinline__ unsigned cvt_pk_bf16(float lo, float hi) { unsigned r; asm volatile("v_cvt_pk_bf16_f32 %0, %1, %2" : "=v"(r) : "v"(lo), "v"(hi)); return r; }
typedef float f32x2 __attribute__((ext_vector_type(2)));
__device__ __forceinline__ f32x2 gelu_pk(f32x2 v) {
    const f32x2 av = __builtin_elementwise_abs(v), d = av * 0.2316418882f + 1.0f;
    f32x2 t; t.x = __builtin_amdgcn_rcpf(d.x); t.y = __builtin_amdgcn_rcpf(d.y);
    f32x2 q = t * 0.5307027145f + (-0.7265760135f); q = q * t + 0.7107068705f; q = q * t + (-0.142248368f); q = q * t + 0.127414796f; q = q * t;
    const f32x2 s = (v * v) * (-0.72134752044f);
    f32x2 e; e.x = __builtin_amdgcn_exp2f(s.x); e.y = __builtin_amdgcn_exp2f(s.y);
    const f32x2 m = v * (q * e), r = v - m;
    f32x2 o; o.x = v.x < 0.f ? m.x : r.x; o.y = v.y < 0.f ? m.y : r.y; return o;
}

template <int ACT  > struct EpiBf16 {
    static constexpr bool PERM = true, AFTER_DRAIN = false; static_assert(ACT == 0 || ACT == 1, "EpiBf16: ACT is 0 (none) or 1 (gelu_pk)");
    bf16_t* O; int ldc; const float* bias; int split_cols; size_t split_stride; float scale0;
    __device__ __forceinline__ void operator()(const f32x4 (&acc)[2][2][4][2], const Unit& u, int wr, int wc, int fr, int fq) const {
        const int row0 = u.pm * BM + wr * 64 + fr; int colt = u.pn * BM; bf16_t* base = O;
        float sc = 1.f; if (split_cols) { const int t = colt / split_cols; base += (size_t)t * split_stride; colt -= t * split_cols; if (t == 0) sc = scale0; }
        const int col0 = colt + wc * 32 + 8 * fq, bcol0 = u.pn * BM + wc * 32 + 8 * fq;
        f32x4 bv[2][2];
#pragma unroll
        for (int bj = 0; bj < 2; ++bj)
#pragma unroll
            for (int n = 0; n < 2; ++n) bv[bj][n] = bias ? *(const f32x4*)(bias + bcol0 + bj * HALF + 4 * n) : (f32x4){0.f, 0.f, 0.f, 0.f};
#pragma unroll
        for (int ai = 0; ai < 2; ++ai)
#pragma unroll
            for (int m = 0; m < 4; ++m) { bf16_t* rowp = base + (size_t)(row0 + ai * HALF + m * 16) * ldc + col0;
#pragma unroll
                for (int bj = 0; bj < 2; ++bj) { f32x4 v0 = acc[ai][bj][m][0] + bv[bj][0], v1 = acc[ai][bj][m][1] + bv[bj][1];
                    if (ACT == 1) { f32x2 a = gelu_pk((f32x2){v0[0], v0[1]}), b = gelu_pk((f32x2){v0[2], v0[3]}), c = gelu_pk((f32x2){v1[0], v1[1]}), d = gelu_pk((f32x2){v1[2], v1[3]});
                        v0 = (f32x4){a.x, a.y, b.x, b.y}; v1 = (f32x4){c.x, c.y, d.x, d.y}; }
                    v0 = v0 * sc; v1 = v1 * sc; u32x4 w; w.x = cvt_pk_bf16(v0[0], v0[1]); w.y = cvt_pk_bf16(v0[2], v0[3]); w.z = cvt_pk_bf16(v1[0], v1[1]); w.w = cvt_pk_bf16(v1[2], v1[3]);
                    *(u32x4*)(rowp + bj * HALF) = w; } }
    }
};
template <class Epi, class Sched, bool ALIGN_EPI = false, bool SP2 = false>
__device__ __forceinline__ void gemm_phase(PG8_LAS unsigned char* lds, const Gemm g, const Sched& S, const Epi& E) {
    int lane_l; asm volatile("v_mbcnt_lo_u32_b32 %0, -1, 0\n\tv_mbcnt_hi_u32_b32 %0, -1, %0" : "=v"(lane_l));
    const int wid = g.wave, lane = lane_l, tid = wid * 64 + lane,
              wr = wid >> 2, wc = wid & 3, fr = lane & 15, fq = lane >> 4;
    const int K = g.K, nt = K / BK;
    unsigned voffA[2], voffB[2];
#pragma unroll
    for (int i = 0; i < 2; ++i) { int R, C; stage_rc(tid * 16 + i * 8192, R, C); const int Rb = Epi::PERM ? ((R & ~31) + perm32(R & 31)) : R;
        voffA[i] = (unsigned)(R * K + C) * 2u; voffB[i] = (unsigned)(Rb * K + C) * 2u; }
    const size_t kstep = (size_t)(BK * 2);
    const size_t hstep = (size_t)HALF * K * 2;
    const size_t tstep = 2 * hstep;
    const unsigned ldsw = (unsigned)wid * 1024u;
    const int aoff = lds_byte(wr * 64 + fr, fq * 8), boff = lds_byte(wc * 32 + fr, fq * 8);
#define PG8_SA(b, h) (((b) * 2 + (h)) * HTB)
#define PG8_SB(b, h) ((4 + (b) * 2 + (h)) * HTB)
#define PG8_STAGE(bufoff, gbase, voff) do { _Pragma("unroll") for (int _i = 0; _i < 2; ++_i) \
        __builtin_amdgcn_global_load_lds((const unsigned*)((const char*)(gbase) + (voff)[_i]), (PG8_LAS unsigned*)(lds + (bufoff) + ldsw + _i * 8192), 16, 0, 0); } while (0)
#define PG8_LDA(dst, b, h) do { _Pragma("unroll") for (int m = 0; m < 4; ++m) _Pragma("unroll") for (int k = 0; k < 2; ++k) dst[m][k] = *(const PG8_LAS bf16x8*)(lds + PG8_SA(b, h) + aoff + m * 2048 + k * 1024); } while (0)
#define PG8_LDB(dst, b, h) do { _Pragma("unroll") for (int n = 0; n < 2; ++n) _Pragma("unroll") for (int k = 0; k < 2; ++k) dst[n][k] = *(const PG8_LAS bf16x8*)(lds + PG8_SB(b, h) + boff + n * 2048 + k * 1024); } while (0)
#define PG8_MMA(ai, bj, At, Bt) do { __builtin_amdgcn_s_setprio(1); _Pragma("unroll") for (int m = 0; m < 4; ++m) _Pragma("unroll") for (int n = 0; n < 2; ++n) _Pragma("unroll") for (int k = 0; k < 2; ++k) \
        acc[ai][bj][m][n] = __builtin_amdgcn_mfma_f32_16x16x32_bf16(Bt[n][k], At[m][k], acc[ai][bj][m][n], 0, 0, 0); __builtin_amdgcn_s_setprio(0); } while (0)
#define PG8_WAIT_V(n) asm volatile("s_waitcnt vmcnt(" #n ")" ::: "memory")
#define PG8_WAIT_L(n) asm volatile("s_waitcnt lgkmcnt(" #n ")" ::: "memory")
#define PG8_BAR __builtin_amdgcn_s_barrier()
#define PG8_SCHED __builtin_amdgcn_sched_barrier(0)
    Unit cur, nxt; int ui = 0;
    if (!S.next(0, cur)) return;
    f32x4 acc[2][2][4][2];
#pragma unroll
    for (int a = 0; a < 2; ++a)
#pragma unroll
        for (int b = 0; b < 2; ++b)
#pragma unroll
            for (int m = 0; m < 4; ++m)
#pragma unroll
                for (int n = 0; n < 2; ++n) acc[a][b][m][n] = (f32x4){0.f, 0.f, 0.f, 0.f};
    bf16x8 At[4][2], B0[2][2], B1[2][2];
    const char* cA = (const char*)g.A + (size_t)cur.pm * tstep; const char* cB = (const char*)g.Bt + (size_t)cur.pn * tstep;
    S.a_ready(cur);
    if constexpr (SP2) {
        PG8_STAGE(PG8_SB(0, 0), cB, voffB); PG8_STAGE(PG8_SB(0, 1), cB + hstep, voffB); PG8_STAGE(PG8_SA(0, 0), cA, voffA); PG8_STAGE(PG8_SA(0, 1), cA + hstep, voffA);
        if (wr == 1) PG8_BAR;
        PG8_WAIT_V(2); PG8_BAR;
        PG8_STAGE(PG8_SB(1, 0), cB + kstep, voffB); PG8_STAGE(PG8_SA(1, 0), cA + kstep, voffA); PG8_STAGE(PG8_SB(1, 1), cB + hstep + kstep, voffB);
        PG8_WAIT_V(6); PG8_BAR;
    } else {
        PG8_STAGE(PG8_SB(0, 0), cB, voffB); PG8_STAGE(PG8_SA(0, 0), cA, voffA); PG8_STAGE(PG8_SB(0, 1), cB + hstep, voffB); PG8_STAGE(PG8_SA(0, 1), cA + hstep, voffA);
        if (wr == 1) PG8_BAR;
        PG8_WAIT_V(4); PG8_BAR;
        PG8_STAGE(PG8_SB(1, 0), cB + kstep, voffB); PG8_STAGE(PG8_SA(1, 0), cA + kstep, voffA); PG8_STAGE(PG8_SB(1, 1), cB + hstep + kstep, voffB);
        PG8_WAIT_V(6); PG8_BAR;
    }
    for (;;) {
        const bool has_next = S.next(ui + 1, nxt);
        const char* nA = has_next ? (const char*)g.A + (size_t)nxt.pm * tstep : cA; const char* nB = has_next ? (const char*)g.Bt + (size_t)nxt.pn * tstep : cB;
        for (int t = 0; t < nt; t += 2) {
            const bool last = (t == nt - 2);
            const char* a1 = cA + (size_t)(t + 1) * kstep;
            const char* a2 = last ? nA : cA + (size_t)(t + 2) * kstep; const char* b2 = last ? nB : cB + (size_t)(t + 2) * kstep;
            const char* a3 = a2 + kstep; const char* b3 = b2 + kstep;
            if (last && has_next) S.a_ready(nxt);
            if constexpr (SP2) {
            PG8_LDB(B0, 0, 0); PG8_LDB(B1, 0, 1); PG8_SCHED; PG8_LDA(At, 0, 0); PG8_STAGE(PG8_SA(1, 1), a1 + hstep, voffA);
            PG8_WAIT_V(8); PG8_WAIT_L(0); PG8_BAR; PG8_MMA(0, 0, At, B0); PG8_MMA(0, 1, At, B1); PG8_BAR; PG8_SCHED;
            PG8_LDA(At, 0, 1); PG8_STAGE(PG8_SB(0, 0), b2, voffB); PG8_STAGE(PG8_SB(0, 1), b2 + hstep, voffB); PG8_STAGE(PG8_SA(0, 0), a2, voffA);
            PG8_WAIT_V(8); PG8_WAIT_L(0); PG8_BAR; PG8_MMA(1, 0, At, B0); PG8_MMA(1, 1, At, B1); PG8_BAR; PG8_SCHED;
            PG8_LDB(B0, 1, 0); PG8_LDB(B1, 1, 1); PG8_SCHED; PG8_LDA(At, 1, 0); PG8_STAGE(PG8_SA(0, 1), a2 + hstep, voffA);
            PG8_WAIT_V(8); PG8_WAIT_L(0); PG8_BAR; PG8_MMA(0, 0, At, B0); PG8_MMA(0, 1, At, B1); PG8_BAR; PG8_SCHED;
            PG8_LDA(At, 1, 1); PG8_STAGE(PG8_SB(1, 0), b3, voffB); PG8_STAGE(PG8_SB(1, 1), b3 + hstep, voffB); PG8_STAGE(PG8_SA(1, 0), a3, voffA);
            PG8_WAIT_V(8); PG8_WAIT_L(0); PG8_BAR; PG8_MMA(1, 0, At, B0); PG8_MMA(1, 1, At, B1); PG8_BAR; PG8_SCHED;
            } else {
            PG8_LDB(B0, 0, 0); PG8_SCHED; PG8_LDA(At, 0, 0); PG8_STAGE(PG8_SA(1, 1), a1 + hstep, voffA);
            PG8_WAIT_L(8); PG8_BAR; PG8_WAIT_L(0); PG8_MMA(0, 0, At, B0); PG8_BAR; PG8_SCHED;
            PG8_LDB(B1, 0, 1); PG8_STAGE(PG8_SB(0, 0), b2, voffB);
            PG8_BAR; PG8_WAIT_L(0); PG8_MMA(0, 1, At, B1); PG8_BAR;
            PG8_LDA(At, 0, 1); PG8_STAGE(PG8_SA(0, 0), a2, voffA);
            PG8_BAR; PG8_WAIT_L(0); PG8_MMA(1, 0, At, B0); PG8_BAR; PG8_SCHED;
            PG8_STAGE(PG8_SB(0, 1), b2 + hstep, voffB);
            PG8_WAIT_V(6); PG8_BAR; PG8_MMA(1, 1, At, B1); PG8_BAR;
            PG8_LDB(B0, 1, 0); PG8_SCHED; PG8_LDA(At, 1, 0); PG8_STAGE(PG8_SA(0, 1), a2 + hstep, voffA);
            PG8_WAIT_L(8); PG8_BAR; PG8_WAIT_L(0); PG8_MMA(0, 0, At, B0); PG8_BAR; PG8_SCHED;
            PG8_LDB(B1, 1, 1); PG8_STAGE(PG8_SB(1, 0), b3, voffB);
            PG8_BAR; PG8_WAIT_L(0); PG8_MMA(0, 1, At, B1); PG8_BAR;
            PG8_LDA(At, 1, 1); PG8_STAGE(PG8_SA(1, 0), a3, voffA);
            PG8_BAR; PG8_WAIT_L(0); PG8_MMA(1, 0, At, B0); PG8_BAR; PG8_SCHED;
            PG8_STAGE(PG8_SB(1, 1), b3 + hstep, voffB);
            PG8_WAIT_V(6); PG8_BAR; PG8_MMA(1, 1, At, B1); PG8_BAR;
            }
        }
        if constexpr (ALIGN_EPI) { if (wr == 0) PG8_BAR; }
        if constexpr (!Epi::AFTER_DRAIN) { E(acc, cur, wr, wc, fr, fq); S.done(cur); }
        if (!has_next) break;
#pragma unroll
        for (int a = 0; a < 2; ++a)
#pragma unroll
            for (int b = 0; b < 2; ++b)
#pragma unroll
                for (int m = 0; m < 4; ++m)
#pragma unroll
                    for (int n = 0; n < 2; ++n) acc[a][b][m][n] = (f32x4){0.f, 0.f, 0.f, 0.f};
        cur = nxt; cA = nA; cB = nB; ++ui;
        if constexpr (ALIGN_EPI) { if (wr == 1) PG8_BAR; }
    }
    PG8_WAIT_V(0);
    if constexpr (!ALIGN_EPI) { if (wr == 0) PG8_BAR; }
    PG8_BAR;
    if constexpr (Epi::AFTER_DRAIN) { E.fused(acc, cur, wr, wc, fr, fq, lds, wid, lane); S.done(cur); }
#undef PG8_SA
#undef PG8_SB
#undef PG8_STAGE
#undef PG8_LDA
#undef PG8_LDB
#undef PG8_MMA
#undef PG8_WAIT_V
#undef PG8_WAIT_L
#undef PG8_BAR
#undef PG8_SCHED
}
}

#ifndef PG8_SP2
#define PG8_SP2 true
#endif
#ifndef PG8_ALIGN
#define PG8_ALIGN true
#endif
#define GAS __attribute__((address_space(1)))
#define LAS __attribute__((address_space(3)))
typedef unsigned short bf16;
typedef unsigned v4u __attribute__((ext_vector_type(4)));
typedef float f32x4 __attribute__((ext_vector_type(4)));
typedef short bf16x8 __attribute__((ext_vector_type(8)));
typedef GAS unsigned gu32;
typedef GAS unsigned long long gu64;
#define RLX_AGENT __ATOMIC_RELAXED, __HIP_MEMORY_SCOPE_AGENT
#define LDS_WAIT() asm volatile("s_waitcnt lgkmcnt(0)" ::: "memory")
#define VM_WAIT() asm volatile("s_waitcnt vmcnt(0)" ::: "memory")
__device__ __forceinline__ unsigned long long rt() { return __builtin_amdgcn_s_memrealtime(); }
__device__ __forceinline__ unsigned f2bf(float f) { unsigned u = __builtin_bit_cast(unsigned, f); return (u + 0x7fffu + ((u >> 16) & 1u)) >> 16; }
__device__ __forceinline__ unsigned pk2(float lo, float hi) { return f2bf(lo) | (f2bf(hi) << 16); }

#define XB_TMO      128
#define XB_XCNT(j)  (256  + 64 * (j))
#define XB_XSUB(j)  (1280 + 64 * (j))
#define XB_XGEN(j)  (2304 + 64 * (j))
#define XB_TOP      3328
#define XB_TOPGEN   3392
#define XCD_BAR_WORDS 3456
#define XB_SPIN_CAP (1u << 22)

__device__ __forceinline__ unsigned xb_ld(unsigned* p)              { return __hip_atomic_load(p, __ATOMIC_RELAXED, __HIP_MEMORY_SCOPE_AGENT); }
__device__ __forceinline__ unsigned xb_add(unsigned* p, unsigned v) { return __hip_atomic_fetch_add(p, v, __ATOMIC_RELAXED, __HIP_MEMORY_SCOPE_AGENT); }
__device__ __forceinline__ unsigned xb_xcc_id() { return (unsigned)__builtin_amdgcn_s_getreg((3 << 11) | 20) & 0xFu; }
#define XB_SPIN(cond, bar) do { unsigned _sp = 0; while (cond) { __builtin_amdgcn_s_sleep(1); \
    if ((++_sp & 255u) == 0u) { if (xb_ld(&(bar)[XB_TMO])) break; if (_sp > XB_SPIN_CAP) { atomicAdd(&(bar)[XB_TMO], 1u); break; } } } } while (0)

struct XcdBarrier {
    unsigned* bar; unsigned x;
    volatile LAS unsigned* st;
};

__device__ __forceinline__ XcdBarrier xcd_barrier_post(unsigned* bar, volatile LAS unsigned* st) {
    XcdBarrier b; b.bar = bar; b.x = xb_xcc_id(); b.st = st;
    if (threadIdx.x == 0) (void)xb_add(&bar[XB_XCNT(b.x)], 1u);
    return b;
}
__device__ __forceinline__ void xcd_barrier_complete(unsigned* bar, unsigned x, unsigned& nloc, unsigned& nx) {
    const unsigned G = gridDim.x * gridDim.y * gridDim.z;
    unsigned sum, cnt, mine, sp = 0u;
    for (;;) {
        sum = 0u; cnt = 0u; mine = 0u;
#pragma unroll
        for (unsigned j = 0; j < 16; ++j) { const unsigned c = xb_ld(&bar[XB_XCNT(j)]); sum += c; cnt += (c > 0u) ? 1u : 0u; mine = (j == x) ? c : mine; }
        if (sum == G) break;
        __builtin_amdgcn_s_sleep(1);
        if ((++sp & 255u) == 0u) { if (xb_ld(&bar[XB_TMO])) break; if (sp > XB_SPIN_CAP) { atomicAdd(&bar[XB_TMO], 1u); break; } }
    }
    nloc = mine > 0u ? mine : 1u; nx = cnt > 0u ? cnt : 1u;
}

__device__ __forceinline__ void xcd_barrier(const XcdBarrier& b) {
    asm volatile("s_waitcnt vmcnt(0)" ::: "memory");
    __syncthreads();
    if (threadIdx.x == 0) {
        unsigned* bar = b.bar;
        __builtin_amdgcn_s_waitcnt(0);
        unsigned nloc = b.st[0], nx = b.st[1];
        if (nloc == 0u) { xcd_barrier_complete(bar, b.x, nloc, nx); b.st[0] = nloc; b.st[1] = nx; }
        const unsigned old = xb_add(&bar[XB_XSUB(b.x)], 1u);
        const unsigned gen = old / nloc;
        if (old + 1u == (gen + 1u) * nloc) {
            __builtin_amdgcn_fence(__ATOMIC_RELEASE, "agent");
            asm volatile("s_waitcnt vmcnt(0)" ::: "memory");
            const unsigned og = xb_add(&bar[XB_TOP], 1u);
            const unsigned tg = og / nx;
            if (og + 1u == (tg + 1u) * nx) xb_add(&bar[XB_TOPGEN], 1u);
            else XB_SPIN(xb_ld(&bar[XB_TOPGEN]) == tg, bar);
            __builtin_amdgcn_fence(__ATOMIC_ACQUIRE, "agent");
            xb_add(&bar[XB_XGEN(b.x)], 1u);
            asm volatile("s_waitcnt vmcnt(0)" ::: "memory");
        } else {
            XB_SPIN(xb_ld(&bar[XB_XGEN(b.x)]) == gen, bar);
            __builtin_amdgcn_fence(__ATOMIC_ACQUIRE, "agent");
            asm volatile("s_waitcnt vmcnt(0)" ::: "memory");
        }
    }
    __syncthreads();
}

constexpr int NWAVES = 8;
constexpr int T_ = 16384, SEQ = 4096, DM = 1024, NPROJ = 2304, INC = 2312;
constexpr int PJ_K = 512, PJ_V = 640, PJ_Z = 768, PJ_XBC = 1280;
constexpr float EPS = 1e-6f;
constexpr size_t MiB = 1u << 20;
constexpr size_t WS_CTL = 0, CTL_ZERO_BYTES = 1 * MiB;
constexpr size_t WS_SMALL = 1 * MiB;
constexpr size_t WS_WIN = 2 * MiB, WS_WOUT = 7 * MiB, WS_WQ = 9 * MiB;
constexpr size_t WS_ED = 13 * MiB, WS_EU = 29 * MiB;
constexpr size_t WS_XN = 77 * MiB;
constexpr size_t WS_PROJ = 109 * MiB;
constexpr size_t WS_ST = 181 * MiB;
constexpr size_t WS_IDX = 213 * MiB, WS_GATE = 221 * MiB, WS_SSQ = 229 * MiB, WS_END = 230 * MiB;
constexpr size_t DO_Y = 0, DO_DT = 41 * MiB;
constexpr size_t WS_CC = 230 * MiB, WS_DT = 238 * MiB, WS_EA = 239 * MiB, WS_CDEC = 240 * MiB, WS_PREV = WS_IDX;
constexpr size_t DO_YPF = 0, DO_YPLAIN = 32 * MiB;
constexpr size_t WS_PART = WS_PROJ;
constexpr size_t WS_H8 = WS_XN, WS_HS = WS_DT;
constexpr size_t WS_SSQ2 = WS_EA;
constexpr int CW_BAR = 4096, CW_RANK = 8192;
constexpr int RING_OFF = 0, RING_BYTES = 147456, LDSCTL_OFF = RING_BYTES, MISC_OFF = LDSCTL_OFF + 320, LDS_BYTES = 163840;

__constant__ unsigned char c_bucket[128] = {0, 1, 2, 3, 4, 5, 6, 7, 8, 9, 10, 11, 12, 13, 14, 15, 16, 16, 16, 17, 17, 18, 18, 18, 19, 19, 19, 20, 20, 20, 20, 21, 21, 21, 21, 22, 22, 22, 22, 22, 23, 23, 23, 23, 23, 23, 24, 24, 24, 24, 24, 24, 25, 25, 25, 25, 25, 25, 25, 26, 26, 26, 26, 26, 26, 26, 26, 27, 27, 27, 27, 27, 27, 27, 27, 27, 27, 28, 28, 28, 28, 28, 28, 28, 28, 28, 28, 29, 29, 29, 29, 29, 29, 29, 29, 29, 29, 29, 29, 30, 30, 30, 30, 30, 30, 30, 30, 30, 30, 30, 30, 30, 30, 31, 31, 31, 31, 31, 31, 31, 31, 31, 31, 31, 31, 31, 31, 31};

typedef float v16f __attribute__((ext_vector_type(16)));
typedef float v32f __attribute__((ext_vector_type(32)));
typedef unsigned v6u __attribute__((ext_vector_type(6)));
typedef _Float16 v32h __attribute__((ext_vector_type(32)));
struct Frame {
    LAS unsigned char* lds;
    volatile LAS unsigned* MISC;
    gu32* ctl;
    int wave, vcu, G;
};
__device__ __forceinline__ int lane_id() { int l; asm volatile("v_mbcnt_lo_u32_b32 %0, -1, 0\n\tv_mbcnt_hi_u32_b32 %0, -1, %0" : "=v"(l)); return l; }
__device__ __forceinline__ int opq(int x) { asm volatile("" : "+v"(x)); return x; }
template <int M> __device__ __forceinline__ float swz_xor(float v) { return __int_as_float(__builtin_amdgcn_ds_swizzle(__float_as_int(v), (M << 10) | 0x1F)); }
__device__ __forceinline__ float sum_halves(float v) { const auto r = __builtin_amdgcn_permlane32_swap(__float_as_uint(v), __float_as_uint(v), false, false); return __uint_as_float(r[0]) + __uint_as_float(r[1]); }
__device__ __forceinline__ float max_halves(float v) { const auto r = __builtin_amdgcn_permlane32_swap(__float_as_uint(v), __float_as_uint(v), false, false); return fmaxf(__uint_as_float(r[0]), __uint_as_float(r[1])); }
__device__ __forceinline__ int imax_halves(int v) { const auto r = __builtin_amdgcn_permlane32_swap((unsigned)v, (unsigned)v, false, false); return max((int)r[0], (int)r[1]); }
__device__ __forceinline__ float wave_sum(float v) {
    v += swz_xor<1>(v); v += swz_xor<2>(v); v += swz_xor<4>(v); v += swz_xor<8>(v); v += swz_xor<16>(v);
    return sum_halves(v);
}
__device__ __forceinline__ float bf2f(unsigned short b) { return __uint_as_float((unsigned)b << 16); }
__device__ __forceinline__ float bflo(unsigned w) { return __uint_as_float(w << 16); }
__device__ __forceinline__ float bfhi(unsigned w) { return __uint_as_float(w & 0xffff0000u); }
__device__ __forceinline__ float silu_f(float x) { return x / (1.f + __expf(-x)); }

__device__ __forceinline__ void p0_transpose_item(const float* W, int ldw, int K, int nblk, bf16* WT, const float* kscale, LAS float* scr, int item, int lane) {
    const int kb = item / nblk, nb = item % nblk, k0 = 64 * kb, n0 = 32 * nb;
#pragma unroll 8
    for (int i = 0; i < 32; ++i) { const int kk = 2 * i + (lane >> 5); float v = W[(size_t)(k0 + kk) * ldw + n0 + (lane & 31)]; if (kscale) v *= kscale[k0 + kk]; scr[kk * 33 + (lane & 31)] = v; }
    LDS_WAIT(); asm volatile("" ::: "memory");
    const int c = lane & 7;
#pragma unroll
    for (int j = 0; j < 4; ++j) { const int n = (lane >> 3) + 8 * j; const LAS float* s = scr + (8 * c) * 33 + n;
        v4u o; o.x = pk2(s[0 * 33], s[1 * 33]); o.y = pk2(s[2 * 33], s[3 * 33]); o.z = pk2(s[4 * 33], s[5 * 33]); o.w = pk2(s[6 * 33], s[7 * 33]);
        *(GAS v4u*)(WT + (size_t)(n0 + n) * K + k0 + 8 * c) = o; }
    LDS_WAIT(); asm volatile("" ::: "memory");
}
struct Ptrs {
    const float *x, *norm_mix, *w_in, *conv_w, *conv_b, *dt_bias, *a_log, *d_skip, *ssd_norm_w, *sinks, *w_out, *rel_bias, *norm_ffn, *w_query, *sk1, *sk2, *e_down, *e_up, *norm_final;
    float* out; unsigned char* ws;
};
constexpr int Q_SPLIT = 0;
__device__ __forceinline__ unsigned pack4_i8(float a, float b, float c, float d) {
    const int ia = __float2int_rn(a), ib = __float2int_rn(b), ic = __float2int_rn(c), id = __float2int_rn(d);
    return (unsigned)(ia & 0xff) | ((unsigned)(ib & 0xff) << 8) | ((unsigned)(ic & 0xff) << 16) | ((unsigned)(id & 0xff) << 24);
}
__device__ __forceinline__ unsigned pack8_i4(const float* v, float inv) {
    unsigned o = 0u;
#pragma unroll
    for (int i = 0; i < 8; ++i) { int q = __float2int_rn(v[i] * inv); q = q < -7 ? -7 : (q > 7 ? 7 : q); o |= ((unsigned)q & 15u) << (4 * i); }
    return o;
}
__device__ __forceinline__ void quant_fp8s(const Ptrs& P, int lane_, int r_lo, int r_hi, int w, int nw) {
    float* SC = (float*)(P.ws + WS_SMALL);
    for (int row = r_lo + w; row < r_hi; row += nw) {
        const int e = row & 16383;
        const float4* src = (const float4*)(P.e_down + (size_t)e * DM) + 4 * lane_;
        float v[16];
#pragma unroll
        for (int q = 0; q < 4; ++q) { const float4 t = src[q]; const float4 w4 = ((const float4*)P.norm_ffn)[4 * lane_ + q]; v[4 * q] = t.x * w4.x; v[4 * q + 1] = t.y * w4.y; v[4 * q + 2] = t.z * w4.z; v[4 * q + 3] = t.w * w4.w; }
        float ss = 0.f;
#pragma unroll
        for (int q = 0; q < 16; ++q) ss = fmaf(v[q], v[q], ss);
        const float sc = fmaxf(2.5f * sqrtf(wave_sum(ss) * (1.f / 1024.f)) * (1.f / 7.f), 1e-30f);
        const float inv = 1.f / sc;
        const unsigned long long o = (unsigned long long)pack8_i4(v, inv) | ((unsigned long long)pack8_i4(v + 8, inv) << 32);
        *(unsigned long long*)(P.ws + WS_ED + ((size_t)(lane_ >> 4) * 16384 + e) * 128 + (lane_ & 15) * 8) = o;
        if (lane_ == 0) SC[row] = sc;
    }
}
typedef float f32x2q __attribute__((ext_vector_type(2)));
__device__ __forceinline__ void quant_fp6u(const Ptrs& P, int lane_, int q_lo, int q_hi, int w, int nw) {
    { float* SC = (float*)(P.ws + WS_SMALL); const int l31 = lane_ & 31, hf = lane_ >> 5;
      for (int q = q_lo + w; q < q_hi; q += nw) {
        const int e = 2 * q + hf, row = 16384 + e;
        const float4* src = (const float4*)(P.e_up + (size_t)e * DM) + 8 * l31;
        float v[32];
#pragma unroll
        for (int k = 0; k < 8; ++k) { const float4 t = src[k]; v[4 * k] = t.x; v[4 * k + 1] = t.y; v[4 * k + 2] = t.z; v[4 * k + 3] = t.w; }
        float am = 0.f;
#pragma unroll
        for (int k = 0; k < 32; ++k) am = fmaxf(am, fabsf(v[k]));
        am = fmaxf(am, swz_xor<1>(am)); am = fmaxf(am, swz_xor<2>(am)); am = fmaxf(am, swz_xor<4>(am)); am = fmaxf(am, swz_xor<8>(am)); am = fmaxf(am, swz_xor<16>(am));
        am = fmaxf(am, 1e-30f);
        const float inv = 6.0f / am;
        unsigned pk[4];
#pragma unroll
        for (int wd = 0; wd < 4; ++wd) { unsigned p4 = 0u;
            p4 = __builtin_amdgcn_cvt_scalef32_pk_fp4_f32(p4, v[8 * wd] * inv, v[8 * wd + 1] * inv, 1.0f, 0);
            p4 = __builtin_amdgcn_cvt_scalef32_pk_fp4_f32(p4, v[8 * wd + 2] * inv, v[8 * wd + 3] * inv, 1.0f, 1);
            p4 = __builtin_amdgcn_cvt_scalef32_pk_fp4_f32(p4, v[8 * wd + 4] * inv, v[8 * wd + 5] * inv, 1.0f, 2);
            p4 = __builtin_amdgcn_cvt_scalef32_pk_fp4_f32(p4, v[8 * wd + 6] * inv, v[8 * wd + 7] * inv, 1.0f, 3);
            pk[wd] = p4; }
        *(v4u*)(P.ws + WS_EU + (size_t)e * 512 + 16 * l31) = (v4u){pk[0], pk[1], pk[2], pk[3]};
        if (l31 == 0) SC[row] = am * (1.f / 6.0f);
      } }
}
__device__ __forceinline__ void p0_prologue(Frame& F0, const Ptrs& P) {
    const Frame& F = F0; const int lane_ = lane_id(), tid_ = F.wave * 64 + lane_;
    LAS float* scr = (LAS float*)(F.lds + RING_OFF + F.wave * 16384);
    const int gw = F.vcu * NWAVES + F.wave, NGW = F.G * NWAVES;
    bf16* Win_t = (bf16*)(P.ws + WS_WIN); bf16* Wout_t = (bf16*)(P.ws + WS_WOUT); bf16* Wq_t = (bf16*)(P.ws + WS_WQ);
    constexpr int I_IN = 16 * 72;
    for (int it = gw; it < I_IN; it += NGW) p0_transpose_item(P.w_in, INC, DM, 72, Win_t, nullptr, scr, it, lane_);
    (void)Wout_t; (void)Wq_t;
    __syncthreads();
    { LAS float* Wdt = (LAS float*)(F.lds + RING_OFF);
      for (int i = tid_; i < 8192; i += 512) Wdt[i] = P.w_in[(size_t)(i >> 3) * INC + NPROJ + (i & 7)];
      __syncthreads();
      bf16* XN = (bf16*)(P.ws + WS_XN); float* DT = (float*)(P.ws + WS_DT);
      for (int m0 = gw * 2; m0 < T_; m0 += NGW * 2) {
        float4 xv[2][4];
#pragma unroll
        for (int rr = 0; rr < 2; ++rr) { const float4* xr = (const float4*)(P.x + (size_t)(m0 + rr) * DM);
#pragma unroll
            for (int j = 0; j < 4; ++j) xv[rr][j] = xr[j * 64 + lane_]; }
#pragma unroll
        for (int rr = 0; rr < 2; ++rr) { const int m = m0 + rr;
        float4 v[4]; float s = 0.f;
#pragma unroll
        for (int j = 0; j < 4; ++j) { v[j] = xv[rr][j]; s += v[j].x * v[j].x + v[j].y * v[j].y + v[j].z * v[j].z + v[j].w * v[j].w; }
        const float r = rsqrtf(wave_sum(s) * (1.f / 1024.f) + EPS);
        float d8[8];
#pragma unroll
        for (int q = 0; q < 8; ++q) d8[q] = 0.f;
        unsigned long long* o8 = (unsigned long long*)(XN + (size_t)m * DM);
#pragma unroll
        for (int j = 0; j < 4; ++j) { const float4 w = ((const float4*)P.norm_mix)[j * 64 + lane_];
            const float e0 = v[j].x * r * w.x, e1 = v[j].y * r * w.y, e2 = v[j].z * r * w.z, e3 = v[j].w * r * w.w;
            o8[j * 64 + lane_] = (unsigned long long)pk2(e0, e1) | ((unsigned long long)pk2(e2, e3) << 32);
            const float ev[4] = {e0, e1, e2, e3};
#pragma unroll
            for (int e = 0; e < 4; ++e) { const LAS f32x4* wr = (const LAS f32x4*)(Wdt + (size_t)(j * 256 + lane_ * 4 + e) * 8); const f32x4 w0 = wr[0], w1 = wr[1];
                d8[0] += ev[e] * w0.x; d8[1] += ev[e] * w0.y; d8[2] += ev[e] * w0.z; d8[3] += ev[e] * w0.w; d8[4] += ev[e] * w1.x; d8[5] += ev[e] * w1.y; d8[6] += ev[e] * w1.z; d8[7] += ev[e] * w1.w; } }
#pragma unroll
        for (int q = 0; q < 8; ++q) d8[q] = wave_sum(d8[q]);
        if (lane_ == 0) { float4* dp = (float4*)(DT + (size_t)m * 8); dp[0] = make_float4(d8[0], d8[1], d8[2], d8[3]); dp[1] = make_float4(d8[4], d8[5], d8[6], d8[7]); }
        }
      }
      __syncthreads(); }
}

__device__ __forceinline__ void p1_slack(Frame& F0, const Ptrs& P, int w, int nw) {
    const Frame& F = F0; const int lane_ = lane_id();
    LAS float* scr = (LAS float*)(F.lds + RING_OFF + F.wave * 16384);
    bf16* Wout_t = (bf16*)(P.ws + WS_WOUT); bf16* Wq_t = (bf16*)(P.ws + WS_WQ);
    constexpr int I_OUT = 16 * 32, I_Q = 16 * 64;
    for (int it = w; it < I_OUT + I_Q; it += nw) {
        if (it < I_OUT) p0_transpose_item(P.w_out, DM, DM, 32, Wout_t, nullptr, scr, it, lane_);
        else p0_transpose_item(P.w_query, 2048, DM, 64, Wq_t, P.norm_ffn, scr, it - I_OUT, lane_);
    }
    quant_fp6u(P, lane_, 0, 8192, w, nw);
    quant_fp8s(P, lane_, 0, 16384, w, nw);
}
struct EpiResH {
    static constexpr bool PERM = false, AFTER_DRAIN = false;
    const float* X; bf16* HB; float* SSQ;
    __device__ __forceinline__ void operator()(const pg8::f32x4 (&acc)[2][2][4][2], const pg8::Unit& u, int wr, int wc, int fr, int fq) const {
        const int row0 = u.pm * 256 + wr * 64 + fr, col0 = u.pn * 256 + wc * 32 + 4 * fq;
#pragma unroll
        for (int ai = 0; ai < 2; ++ai)
#pragma unroll
            for (int m = 0; m < 4; ++m) { const int row = row0 + ai * 128 + m * 16; float ss = 0.f;
#pragma unroll
                for (int bj = 0; bj < 2; ++bj)
#pragma unroll
                    for (int n = 0; n < 2; ++n) { const size_t off = (size_t)row * DM + col0 + bj * 128 + n * 16;
                        const pg8::f32x4 h = acc[ai][bj][m][n] + *(const pg8::f32x4*)(X + off);
                        ss += h[0] * h[0] + h[1] * h[1] + h[2] * h[2] + h[3] * h[3];
                        *(unsigned long long*)(HB + off) = (unsigned long long)pk2(h[0], h[1]) | ((unsigned long long)pk2(h[2], h[3]) << 32); }
                ss += swz_xor<16>(ss); ss = sum_halves(ss);
                if (fq == 0) SSQ[(size_t)row * 16 + u.pn * 4 + wc] = ss; }
    }
};

typedef float f32x16 __attribute__((ext_vector_type(16)));
typedef short s16x4 __attribute__((ext_vector_type(4)));
typedef float f32x2_t __attribute__((ext_vector_type(2)));
typedef __bf16 bf16x2_t __attribute__((ext_vector_type(2)));
#define MFMA32(a, b, c) __builtin_amdgcn_mfma_f32_32x32x16_bf16((a), (b), (c), 0, 0, 0)
__device__ __forceinline__ int crow(int reg, int h) { return (reg & 3) + 8 * (reg >> 2) + 4 * h; }
__device__ __forceinline__ unsigned cvtpk(float lo, float hi) { f32x2_t v = {lo, hi}; bf16x2_t b = __builtin_convertvector(v, bf16x2_t); return __builtin_bit_cast(unsigned, b); }
__device__ __forceinline__ bf16x8 pack8(const f32x16& x, int s) {
    v4u p; p.x = cvtpk(x[8 * s], x[8 * s + 1]); p.y = cvtpk(x[8 * s + 2], x[8 * s + 3]); p.z = cvtpk(x[8 * s + 4], x[8 * s + 5]); p.w = cvtpk(x[8 * s + 6], x[8 * s + 7]);
    return __builtin_bit_cast(bf16x8, p);
}
constexpr float LOG2E = 1.4426950408889634f;
constexpr int LDP = 136;
constexpr int S1_XT = 0, S1_XTW = 17408, S1_BSN = 34816, S1_CLN = 69632, S1_BNL = 104448, S1_F32 = 139264;

__device__ __forceinline__ float silu_fast(float x) { return x * __builtin_amdgcn_rcpf(1.f + __builtin_amdgcn_exp2f(-x * LOG2E)); }
__device__ __forceinline__ int swz_t(int row, int l) { return row * LDP + ((((l >> 3) ^ (row >> 3)) & 7) | ((l >> 3) & 8)) * 8 + (l & 7); }
#define S1_CONV8(A_, IT_) do { _Pragma("unroll") for (int e_ = 0; e_ < 8; ++e_) A_[e_] = bias[e_]; \
        _Pragma("unroll") for (int j_ = 0; j_ < 4; ++j_) { const v4u rw_ = raw[(IT_) + j_]; \
            A_[0] += w[j_][0] * bflo(rw_.x); A_[1] += w[j_][1] * bfhi(rw_.x); A_[2] += w[j_][2] * bflo(rw_.y); A_[3] += w[j_][3] * bfhi(rw_.y); \
            A_[4] += w[j_][4] * bflo(rw_.z); A_[5] += w[j_][5] * bfhi(rw_.z); A_[6] += w[j_][6] * bflo(rw_.w); A_[7] += w[j_][7] * bfhi(rw_.w); } \
        _Pragma("unroll") for (int e_ = 0; e_ < 8; ++e_) A_[e_] = silu_fast(A_[e_]); } while (0)
#define S1_LOADW(CHB_) do { _Pragma("unroll") for (int j_ = 0; j_ < 4; ++j_) { const float4 w0_ = *(const float4*)(P.conv_w + j_ * 1024 + (CHB_)), w1_ = *(const float4*)(P.conv_w + j_ * 1024 + (CHB_) + 4); \
            w[j_][0] = w0_.x; w[j_][1] = w0_.y; w[j_][2] = w0_.z; w[j_][3] = w0_.w; w[j_][4] = w1_.x; w[j_][5] = w1_.y; w[j_][6] = w1_.z; w[j_][7] = w1_.w; } \
        { const float4 b0_ = *(const float4*)(P.conv_b + (CHB_)), b1_ = *(const float4*)(P.conv_b + (CHB_) + 4); \
          bias[0] = b0_.x; bias[1] = b0_.y; bias[2] = b0_.z; bias[3] = b0_.w; bias[4] = b1_.x; bias[5] = b1_.y; bias[6] = b1_.z; bias[7] = b1_.w; } } while (0)
__device__ __forceinline__ void ssd_s1(Frame& F, const Ptrs& P) {
    const bf16* PROJ = (const bf16*)(P.ws + WS_PROJ); const float* DT = (const float*)(P.ws + WS_DT);
    float* EA = (float*)(P.ws + WS_EA); float* CDEC = (float*)(P.ws + WS_CDEC); bf16* CC = (bf16*)(P.ws + WS_CC);
    float* ST = (float*)(P.ws + WS_ST); float* YPF = (float*)((char*)P.out + DO_YPF);
    LAS unsigned char* L = F.lds + RING_OFF;
    LAS bf16* Xt = (LAS bf16*)(L + S1_XT); LAS bf16* Xtw = (LAS bf16*)(L + S1_XTW); LAS bf16* Bsn = (LAS bf16*)(L + S1_BSN); LAS bf16* Cln = (LAS bf16*)(L + S1_CLN); LAS bf16* Bnl = (LAS bf16*)(L + S1_BNL);
    LAS float* f32base = (LAS float*)(L + S1_F32);
    const int lane = lane_id(); const int tid_ = F.wave * 64 + lane;
    for (int ug = F.vcu; ug < 256; ug += F.G) {
        const int grp = ug & 1, c = (ug >> 1) & 31, b = ug >> 6, t0 = b * SEQ + c * 128;
        __syncthreads();
        if (F.wave < 4) {
            const int h = 4 * grp + F.wave, us = (b * 32 + c) * 8 + h;
            const float A = -__expf(P.a_log[h]), dtb = P.dt_bias[h];
            const int ln = opq(lane_id());
            LAS float* acum2 = f32base + F.wave * 384; LAS float* wv = acum2 + 128; LAS float* wend = wv + 128;
            const float x0 = DT[(size_t)(t0 + 2 * ln) * 8 + h] + dtb, x1 = DT[(size_t)(t0 + 2 * ln + 1) * 8 + h] + dtb;
            const float dt0 = fmaxf(x0, 0.f) + log1pf(__expf(-fabsf(x0))), dt1 = fmaxf(x1, 0.f) + log1pf(__expf(-fabsf(x1)));
            const float a0 = dt0 * A, a1 = dt1 * A;
            float s = a0 + a1;
#pragma unroll
            for (int o = 1; o < 64; o <<= 1) { const float v = __int_as_float(__builtin_amdgcn_ds_bpermute((ln - o) * 4, __float_as_int(s))); if (ln >= o) s += v; }
            const float ac1 = s, ac0 = s - a1, tot = __uint_as_float(__builtin_amdgcn_readlane(__float_as_uint(s), 63));
            acum2[2 * ln] = ac0 * LOG2E; acum2[2 * ln + 1] = ac1 * LOG2E;
            wv[2 * ln] = log2f(dt0) - ac0 * LOG2E; wv[2 * ln + 1] = log2f(dt1) - ac1 * LOG2E;
            wend[2 * ln] = dt0 * exp2f((tot - ac0) * LOG2E); wend[2 * ln + 1] = dt1 * exp2f((tot - ac1) * LOG2E);
            EA[(size_t)(t0 + 2 * ln) * 8 + h] = exp2f(ac0 * LOG2E); EA[(size_t)(t0 + 2 * ln + 1) * 8 + h] = exp2f(ac1 * LOG2E);
            if (ln == 0) CDEC[us] = exp2f(tot * LOG2E);
        }
        __syncthreads();
#pragma unroll 1
        for (int hi = 0; hi < 4; ++hi) {
            const int h = 4 * grp + hi, u = (b * 32 + c) * 8 + h;
            const float Dh = P.d_skip[h];
            const LAS float* acum2 = f32base + hi * 384; const LAS float* wv = acum2 + 128; const LAS float* wend = wv + 128;
            const int tidc = opq(tid_);
            if (hi == 0) {
                if (tidc < 440) {
                    const int cg = tidc % 40, sg = tidc / 40, l0 = 12 * sg;
                    int chb; if (cg < 8) chb = h * 64 + cg * 8; else if (cg < 24) chb = 512 + grp * 128 + (cg - 8) * 8; else chb = 768 + grp * 128 + (cg - 24) * 8;
                    v4u raw[15];
#pragma unroll
                    for (int q = 0; q < 15; ++q) { const int ss = c * 128 + l0 - 3 + q; raw[q] = (v4u){0u, 0u, 0u, 0u};
                        if (ss >= 0 && l0 - 3 + q < 128) raw[q] = *(const v4u*)(PROJ + (size_t)(b * SEQ + ss) * NPROJ + PJ_XBC + chb); }
                    float w[4][8], bias[8]; S1_LOADW(chb);
#pragma unroll
                    for (int it = 0; it < 12; it += 2) {
                        const int l = l0 + it;
                        if (l < 128) {
                            float a[8], a2[8]; S1_CONV8(a, it); S1_CONV8(a2, it + 1);
                            if (cg < 8) { const float we = wend[l], we2 = wend[l + 1];
#pragma unroll
                                for (int e = 0; e < 8; ++e) { *(LAS unsigned*)(Xt + swz_t(cg * 8 + e, l)) = cvtpk(a[e], a2[e]); *(LAS unsigned*)(Xtw + swz_t(cg * 8 + e, l)) = cvtpk(a[e] * we, a2[e] * we2); }
                            } else {
                                v4u o, o2; o.x = cvtpk(a[0], a[1]); o.y = cvtpk(a[2], a[3]); o.z = cvtpk(a[4], a[5]); o.w = cvtpk(a[6], a[7]);
                                o2.x = cvtpk(a2[0], a2[1]); o2.y = cvtpk(a2[2], a2[3]); o2.z = cvtpk(a2[4], a2[5]); o2.w = cvtpk(a2[6], a2[7]);
                                if (cg < 24) { const int n0 = (cg - 8) * 8; *(LAS v4u*)(Bsn + l * LDP + n0) = o; *(LAS v4u*)(Bsn + (l + 1) * LDP + n0) = o2;
#pragma unroll
                                    for (int e = 0; e < 8; ++e) *(LAS unsigned*)(Bnl + swz_t(n0 + e, l)) = cvtpk(a[e], a2[e]);
                                } else { const int n0 = (cg - 24) * 8; *(LAS v4u*)(Cln + l * LDP + n0) = o; *(LAS v4u*)(Cln + (l + 1) * LDP + n0) = o2;
                                    *(v4u*)(CC + (size_t)(t0 + l) * 256 + grp * 128 + n0) = o; *(v4u*)(CC + (size_t)(t0 + l + 1) * 256 + grp * 128 + n0) = o2; }
                            }
                        }
                    }
                }
            } else {
                const int cg = tidc & 7, l = 2 * (tidc >> 3), chb = h * 64 + cg * 8;
                v4u raw[5];
#pragma unroll
                for (int q = 0; q < 5; ++q) { const int ss = c * 128 + l - 3 + q; raw[q] = (v4u){0u, 0u, 0u, 0u};
                    if (ss >= 0) raw[q] = *(const v4u*)(PROJ + (size_t)(b * SEQ + ss) * NPROJ + PJ_XBC + chb); }
                float w[4][8], bias[8]; S1_LOADW(chb);
                float a[8], a2[8]; S1_CONV8(a, 0); S1_CONV8(a2, 1);
                const float we = wend[l], we2 = wend[l + 1];
#pragma unroll
                for (int e = 0; e < 8; ++e) { *(LAS unsigned*)(Xt + swz_t(cg * 8 + e, l)) = cvtpk(a[e], a2[e]); *(LAS unsigned*)(Xtw + swz_t(cg * 8 + e, l)) = cvtpk(a[e] * we, a2[e] * we2); }
            }
            __syncthreads();
            const int ln3 = opq(lane), r = ln3 & 31, hh = ln3 >> 5;
            if (F.wave < 4) {
                const int pt = F.wave >> 1;
#pragma unroll 1
                for (int q = 0; q < 2; ++q) {
                    const int lt = (F.wave & 1) ? (1 + q) : (3 * q);
                    f32x16 yacc;
#pragma unroll
                    for (int i = 0; i < 16; ++i) yacc[i] = 0.f;
                    const float al = acum2[32 * lt + r];
                    bf16x8 cf[8];
#pragma unroll
                    for (int kk = 0; kk < 8; ++kk) cf[kk] = *(const LAS bf16x8*)(Cln + (32 * lt + r) * LDP + 16 * kk + 8 * hh);
#pragma unroll 1
                    for (int st = 0; st <= lt; ++st) {
                        bf16x8 bfr[8];
#pragma unroll
                        for (int kk = 0; kk < 8; ++kk) bfr[kk] = *(const LAS bf16x8*)(Bsn + (32 * st + r) * LDP + 16 * kk + 8 * hh);
                        f32x4 wq[4];
#pragma unroll
                        for (int g4 = 0; g4 < 4; ++g4) wq[g4] = *(const LAS f32x4*)(wv + 32 * st + 8 * g4 + 4 * hh);
                        s16x4 xlo[2], xhi[2];
#pragma unroll
                        for (int sg = 0; sg < 2; ++sg) { const int prow = 32 * pt + r, lb = 32 * st + 16 * sg;
                            xlo[sg] = *(const LAS s16x4*)(Xt + swz_t(prow, lb) + 4 * hh); xhi[sg] = *(const LAS s16x4*)(Xt + swz_t(prow, lb + 8) + 4 * hh); }
                        __builtin_amdgcn_sched_barrier(0);
                        f32x16 macc;
#pragma unroll
                        for (int i = 0; i < 16; ++i) macc[i] = 0.f;
#pragma unroll
                        for (int kk = 0; kk < 8; ++kk) macc = MFMA32(bfr[kk], cf[kk], macc);
#pragma unroll
                        for (int i = 0; i < 16; ++i) { const int sl = crow(i, hh);
                            float f = __builtin_amdgcn_exp2f(al + wq[i >> 2][i & 3]);
                            if (st == lt && sl > r) f = 0.f;
                            macc[i] *= f; }
#pragma unroll
                        for (int sg = 0; sg < 2; ++sg) {
                            const bf16x8 bfrag = pack8(macc, sg);
                            const bf16x8 afrag = __builtin_shufflevector(xlo[sg], xhi[sg], 0, 1, 2, 3, 4, 5, 6, 7);
                            yacc = MFMA32(afrag, bfrag, yacc);
                        }
                    }
                    unsigned short xs16[16];
#pragma unroll
                    for (int i = 0; i < 16; ++i) xs16[i] = *(const LAS unsigned short*)(Xt + swz_t(32 * pt + crow(i, hh), 32 * lt + r));
                    __builtin_amdgcn_sched_barrier(0);
#pragma unroll
                    for (int i = 0; i < 16; ++i) {
                        const float y = yacc[i] + Dh * __uint_as_float((unsigned)xs16[i] << 16);
                        YPF[((((size_t)u * 4 + lt) * 2 + pt) * 16 + i) * 64 + ln3] = y; }
                }
            } else {
                const int nt = F.wave - 4;
#pragma unroll 1
                for (int pt = 0; pt < 2; ++pt) {
                    bf16x8 xa[8], bb[8];
#pragma unroll
                    for (int kk = 0; kk < 8; ++kk) { xa[kk] = *(const LAS bf16x8*)(Xtw + swz_t(32 * pt + r, 16 * kk + 8 * hh)); bb[kk] = *(const LAS bf16x8*)(Bnl + swz_t(32 * nt + r, 16 * kk + 8 * hh)); }
                    __builtin_amdgcn_sched_barrier(0);
                    f32x16 sacc;
#pragma unroll
                    for (int i = 0; i < 16; ++i) sacc[i] = 0.f;
#pragma unroll
                    for (int kk = 0; kk < 8; ++kk) sacc = MFMA32(xa[kk], bb[kk], sacc);
#pragma unroll
                    for (int i = 0; i < 16; ++i) ST[((size_t)u * 64 + 32 * pt + crow(i, hh)) * 128 + 32 * nt + r] = sacc[i];
                }
            }
            __syncthreads();
        }
    }
}
__device__ __forceinline__ void ssd_s2(Frame& F, const Ptrs& P) {
    const float* ST = (const float*)(P.ws + WS_ST); const float* CDEC = (const float*)(P.ws + WS_CDEC); unsigned* PREV = (unsigned*)(P.ws + WS_PREV);
    for (int g = F.vcu * 512 + (F.wave * 64 + lane_id()); g < 131072; g += F.G * 512) {
        const int n2 = g & 63, p = (g >> 6) & 63, h = (g >> 12) & 7, b = g >> 15;
        float2 st[32];
#pragma unroll
        for (int c = 0; c < 32; ++c) st[c] = *(const float2*)(ST + ((size_t)(((b * 32 + c) * 8 + h) * 64 + p)) * 128 + 2 * n2);
        float r0 = 0.f, r1 = 0.f;
#pragma unroll
        for (int c = 0; c < 32; ++c) { const size_t u = (size_t)((b * 32 + c) * 8 + h);
            PREV[((u * 64 + p) * 128 + 2 * n2) >> 1] = pk2(r0, r1);
            const float d = CDEC[u]; r0 = r0 * d + st[c].x; r1 = r1 * d + st[c].y; }
    }
}
__device__ __forceinline__ void ssd_s3(Frame& F, const Ptrs& P) {
    const bf16* CC = (const bf16*)(P.ws + WS_CC); const bf16* PREV = (const bf16*)(P.ws + WS_PREV); const float* EA = (const float*)(P.ws + WS_EA);
    const float* YPF = (const float*)((const char*)P.out + DO_YPF); const bf16* PROJ = (const bf16*)(P.ws + WS_PROJ); bf16* CAT = (bf16*)(P.ws + WS_XN);
    LAS float* red = (LAS float*)(F.lds + RING_OFF);
    const int lane = lane_id(), r = lane & 31, hh = lane >> 5, h = F.wave, grp = h >> 2;
    for (int v = F.vcu; v < 512; v += F.G) {
        const int lt = v & 3, c = (v >> 2) & 31, b = v >> 7;
        const int t = b * SEQ + c * 128 + lt * 32 + r; const size_t u = (size_t)((b * 32 + c) * 8 + h);
        float ypf[2][16]; unsigned long long zz[2][4];
#pragma unroll
        for (int pt = 0; pt < 2; ++pt) {
#pragma unroll
            for (int i = 0; i < 16; ++i) ypf[pt][i] = YPF[((((size_t)u * 4 + lt) * 2 + pt) * 16 + i) * 64 + lane];
#pragma unroll
            for (int g4 = 0; g4 < 4; ++g4) zz[pt][g4] = *(const unsigned long long*)(PROJ + (size_t)t * NPROJ + PJ_Z + h * 64 + 32 * pt + 8 * g4 + 4 * hh); }
        const float ea = EA[(size_t)t * 8 + h];
        f32x16 acc[2];
#pragma unroll
        for (int i = 0; i < 16; ++i) { acc[0][i] = 0.f; acc[1][i] = 0.f; }
#pragma unroll
        for (int kk = 0; kk < 8; ++kk) {
            const bf16x8 bb = *(const bf16x8*)(CC + (size_t)t * 256 + grp * 128 + 16 * kk + 8 * hh);
#pragma unroll
            for (int pt = 0; pt < 2; ++pt) { const bf16x8 a = *(const bf16x8*)(PREV + (u * 64 + 32 * pt + r) * 128 + 16 * kk + 8 * hh); acc[pt] = MFMA32(a, bb, acc[pt]); }
        }
        float ss = 0.f;
#pragma unroll
        for (int pt = 0; pt < 2; ++pt)
#pragma unroll
            for (int g4 = 0; g4 < 4; ++g4) {
                const unsigned z01 = (unsigned)zz[pt][g4], z23 = (unsigned)(zz[pt][g4] >> 32);
                const float zf[4] = {bflo(z01), bfhi(z01), bflo(z23), bfhi(z23)};
#pragma unroll
                for (int e = 0; e < 4; ++e) { const int i = 4 * g4 + e;
                    const float y = acc[pt][i] * ea + ypf[pt][i];
                    const float yg = y * silu_fast(zf[e]); acc[pt][i] = yg; ss = fmaf(yg, yg, ss); }
            }
        ss = sum_halves(ss);
        if (hh == 0) red[h * 32 + r] = ss;
        __syncthreads();
        float tot = 0.f;
#pragma unroll
        for (int w = 0; w < 8; ++w) tot += red[w * 32 + r];
        const float rn = rsqrtf(tot * (1.f / 512.f) + EPS);
#pragma unroll
        for (int pt = 0; pt < 2; ++pt)
#pragma unroll
            for (int g4 = 0; g4 < 4; ++g4) { const int ch = h * 64 + 32 * pt + 8 * g4 + 4 * hh;
                const float4 w = *(const float4*)(P.ssd_norm_w + ch);
                *(unsigned long long*)(CAT + (size_t)t * DM + 512 + ch) = (unsigned long long)cvtpk(acc[pt][4 * g4] * rn * w.x, acc[pt][4 * g4 + 1] * rn * w.y) | ((unsigned long long)cvtpk(acc[pt][4 * g4 + 2] * rn * w.z, acc[pt][4 * g4 + 3] * rn * w.w) << 32); }
        __syncthreads();
    }
}
__device__ __forceinline__ float gelu_erf(float v) { return 0.5f * v * (1.f + erff(v * 0.70710678118654752f)); }
typedef float f32x2v __attribute__((ext_vector_type(2)));
#define CVT8(W, LO) __builtin_amdgcn_cvt_pk_f32_fp8((int)(W), LO)
template <int CTRL> __device__ __forceinline__ float dpp_f(float v) { return __int_as_float(__builtin_amdgcn_update_dpp(0, __float_as_int(v), CTRL, 0xF, 0xF, true)); }
__device__ __forceinline__ float sum8_dpp(float s) { s += dpp_f<0xB1>(s); s += dpp_f<0x4E>(s); s += dpp_f<0x141>(s); return s; }
struct PeerPlace { int vx, nx, rank, nloc; };
__device__ __forceinline__ PeerPlace peer_place(Frame& F) {
    __syncthreads();
    if (F.wave == 0 && lane_id() == 0) {
        unsigned* bar = (unsigned*)(F.ctl + CW_BAR); const unsigned x = xb_xcc_id();
        unsigned vx = 0, nx = 0;
        for (unsigned j = 0; j < 16; ++j) { const unsigned c = xb_ld(&bar[XB_XCNT(j)]); if (c) { if (j < x) ++vx; ++nx; } }
        const unsigned rank = xb_add((unsigned*)(F.ctl + CW_RANK) + 64 * x, 1u);
        F.MISC[10] = vx; F.MISC[11] = nx ? nx : 1u; F.MISC[12] = rank; F.MISC[13] = xb_ld(&bar[XB_XCNT(x)]);
    }
    __syncthreads();
    PeerPlace pp; pp.vx = (int)F.MISC[10]; pp.nx = (int)F.MISC[11]; pp.rank = (int)F.MISC[12]; pp.nloc = (int)F.MISC[13]; if (pp.nloc < 1) pp.nloc = 1;
    return pp;
}
__device__ __forceinline__ void h_quant_rows(Frame& F, const Ptrs& P) {
    const bf16* HB = (const bf16*)(P.ws + WS_ST); unsigned char* H8 = P.ws + WS_H8; float* HS = (float*)(P.ws + WS_HS);
    const int lane = lane_id();
    for (int t = F.vcu * NWAVES + F.wave; t < T_; t += F.G * NWAVES) {
        const v4u a0 = ((const v4u*)(HB + (size_t)t * DM))[2 * lane], a1 = ((const v4u*)(HB + (size_t)t * DM))[2 * lane + 1];
        float hf[16];
        hf[0] = bflo(a0.x); hf[1] = bfhi(a0.x); hf[2] = bflo(a0.y); hf[3] = bfhi(a0.y); hf[4] = bflo(a0.z); hf[5] = bfhi(a0.z); hf[6] = bflo(a0.w); hf[7] = bfhi(a0.w);
        hf[8] = bflo(a1.x); hf[9] = bfhi(a1.x); hf[10] = bflo(a1.y); hf[11] = bfhi(a1.y); hf[12] = bflo(a1.z); hf[13] = bfhi(a1.z); hf[14] = bflo(a1.w); hf[15] = bfhi(a1.w);
        float am = 0.f;
#pragma unroll
        for (int i = 0; i < 16; ++i) am = fmaxf(am, fabsf(hf[i]));
        am = fmaxf(am, dpp_f<0xB1>(am)); am = fmaxf(am, dpp_f<0x4E>(am)); am = fmaxf(am, dpp_f<0x141>(am)); am = fmaxf(am, dpp_f<0x140>(am)); am = fmaxf(am, 1e-30f);
        const float inv = 119.f / am;
        unsigned hi[2] = {0u, 0u}, lo[2] = {0u, 0u};
#pragma unroll
        for (int i = 0; i < 16; ++i) { const int q = __float2int_rn(hf[i] * inv); const int qh = (q + 8) >> 4, ql = q - 16 * qh;
            hi[i >> 3] |= ((unsigned)qh & 15u) << (4 * (i & 7)); lo[i >> 3] |= ((unsigned)ql & 15u) << (4 * (i & 7)); }
        unsigned char* dst = H8 + (size_t)t * 1024 + (lane >> 4) * 256 + (lane & 15) * 8;
        *(unsigned long long*)dst = (unsigned long long)hi[0] | ((unsigned long long)hi[1] << 32);
        *(unsigned long long*)(dst + 128) = (unsigned long long)lo[0] | ((unsigned long long)lo[1] << 32);
        if ((lane & 15) == 0) HS[(size_t)t * 8 + (lane >> 4)] = am * (1.f / 119.f);
    }
}
constexpr int PX_D = 16;
template <int CTRL> __device__ __forceinline__ int dpp_i(int v) { return __builtin_amdgcn_update_dpp(0, v, CTRL, 0xF, 0xF, true); }
#define PX_ISSUE(BUF, LO, HI) _Pragma("unroll") for (int b_ = 0; b_ < 8; ++b_) { const unsigned off_ = ((unsigned)__builtin_amdgcn_ds_bpermute((16 * (b_ & 3) + ps) * 4, (b_ & 4) ? (HI) : (LO)) << 7) | (unsigned)(dl << 5); \
        BUF[2 * b_] = *(const v4u*)(tab + off_); BUF[2 * b_ + 1] = *(const v4u*)(tab + off_ + 16); }
struct H4 { v4u h0, h1, l0, l1; };
#define PX_DOT8(Q, HH, HL) ah = __builtin_amdgcn_sdot8((int)(Q), (int)(HH), ah, false); al = __builtin_amdgcn_sdot8((int)(Q), (int)(HL), al, false);
__device__ __forceinline__ void peer_down_token(const v4u (&cur)[PX_D], const H4& h, const float hs, float* prow, int dl, int ps) {
    int sm[8];
#pragma unroll
    for (int b = 0; b < 8; ++b) { const v4u q0 = cur[2 * b], q1 = cur[2 * b + 1];
        int ah = 0, al = 0;
        PX_DOT8(q0.x, h.h0.x, h.l0.x) PX_DOT8(q0.y, h.h0.y, h.l0.y) PX_DOT8(q0.z, h.h0.z, h.l0.z) PX_DOT8(q0.w, h.h0.w, h.l0.w)
        PX_DOT8(q1.x, h.h1.x, h.l1.x) PX_DOT8(q1.y, h.h1.y, h.l1.y) PX_DOT8(q1.z, h.h1.z, h.l1.z) PX_DOT8(q1.w, h.h1.w, h.l1.w)
        sm[b] = 16 * ah + al; }
    const bool c1 = (dl & 2) != 0, c0 = (dl & 1) != 0;
    int w4[4], w2[2];
#pragma unroll
    for (int k = 0; k < 4; ++k) { const int keep = c1 ? sm[4 + k] : sm[k], send = c1 ? sm[k] : sm[4 + k]; w4[k] = keep + dpp_i<0x4E>(send); }
#pragma unroll
    for (int k = 0; k < 2; ++k) { const int keep = c0 ? w4[2 + k] : w4[k], send = c0 ? w4[k] : w4[2 + k]; w2[k] = keep + dpp_i<0xB1>(send); }
    prow[32 * dl + ps] = (float)w2[0] * hs; prow[32 * dl + 16 + ps] = (float)w2[1] * hs;
}
__device__ __forceinline__ void peer_down(Frame& F, const Ptrs& P, const PeerPlace& pp) {
    const unsigned char* H8 = P.ws + WS_H8; const unsigned char* HSb = P.ws + WS_HS; const unsigned char* IDXb = P.ws + WS_IDX; unsigned char* PARTb = P.ws + WS_PART;
    const int lane = lane_id(), dl = lane & 3, ps = lane >> 2;
    const int tstep = pp.nloc * NWAVES;
    for (int u = pp.vx; u < 8; u += pp.nx) {
        const int s = u & 3, tend = ((u >> 2) + 1) * (T_ / 2), t0 = (u >> 2) * (T_ / 2) + pp.rank * NWAVES + F.wave;
        if (t0 >= tend) continue;
        const unsigned char* tab = P.ws + WS_ED + (size_t)s * 16384 * 128;
        const unsigned hoff = (unsigned)(s * 256 + dl * 32), ioff = (unsigned)lane * 4u;
        v4u bufA[PX_D], bufB[PX_D];
#define PD_CLAMP(T) ((T) < tend ? (T) : t0)
#define PD_META(H, HSC, TT) do { const unsigned char* hp_ = H8 + ((unsigned)(TT) * 1024u + hoff); H.h0 = *(const v4u*)hp_; H.h1 = *(const v4u*)(hp_ + 16); H.l0 = *(const v4u*)(hp_ + 128); H.l1 = *(const v4u*)(hp_ + 144); \
        HSC = *(const float*)(HSb + ((unsigned)(TT) * 32u + (unsigned)s * 4u)); } while (0)
#define PD_IDX(LO, HI, TT) do { LO = *(const int*)(IDXb + ((unsigned)(TT) * 512u + ioff)); HI = *(const int*)(IDXb + ((unsigned)(TT) * 512u + 256u + ioff)); } while (0)
        int nidx_lo, nidx_hi; PD_IDX(nidx_lo, nidx_hi, t0);
        PX_ISSUE(bufA, nidx_lo, nidx_hi);
        PD_IDX(nidx_lo, nidx_hi, PD_CLAMP(t0 + tstep));
        H4 ha, hb; float sa, sb; PD_META(ha, sa, t0);
        for (int t = t0; t < tend; t += 2 * tstep) {
            { const int tn = PD_CLAMP(t + tstep);
              PX_ISSUE(bufB, nidx_lo, nidx_hi); PD_IDX(nidx_lo, nidx_hi, PD_CLAMP(tn + tstep)); PD_META(hb, sb, tn);
              __builtin_amdgcn_sched_barrier(0);
              peer_down_token(bufA, ha, sa, (float*)(PARTb + ((unsigned)(s * T_ + t) * 512u)), dl, ps);
              __builtin_amdgcn_sched_barrier(0); }
            if (t + tstep >= tend) break;
            { const int tc = t + tstep, tn = PD_CLAMP(tc + tstep);
              PX_ISSUE(bufA, nidx_lo, nidx_hi); PD_IDX(nidx_lo, nidx_hi, PD_CLAMP(tn + tstep)); PD_META(ha, sa, tn);
              __builtin_amdgcn_sched_barrier(0);
              peer_down_token(bufB, hb, sb, (float*)(PARTb + ((unsigned)(s * T_ + tc) * 512u)), dl, ps);
              __builtin_amdgcn_sched_barrier(0); }
        }
    }
}
__device__ __forceinline__ void peer_act(Frame& F, const Ptrs& P) {
    const int* IDX = (const int*)(P.ws + WS_IDX); float* GATE = (float*)(P.ws + WS_GATE); const float* PART = (const float*)(P.ws + WS_PART); const float* SSQ = (const float*)(P.ws + WS_SSQ);
    const float* SCD = (const float*)(P.ws + WS_SMALL); const float* SCU = SCD + 16384;
    const int lane = lane_id();
    for (int w = F.vcu * NWAVES + F.wave; w < T_ * 2; w += F.G * NWAVES) {
        const int t = w >> 1; const size_t pid = (size_t)w * 64 + lane;
        const float ssq = lane < 16 ? SSQ[(size_t)t * 16 + lane] : 0.f;
        const float rstd = rsqrtf(wave_sum(ssq) * (1.f / 1024.f) + EPS);
        float pre = 0.f;
#pragma unroll
        for (int s = 0; s < 4; ++s) pre += PART[(size_t)s * T_ * 128 + pid];
        const int id = IDX[pid];
        GATE[pid] = gelu_erf(pre * SCD[id] * rstd) * GATE[pid] * SCU[id];
    }
}
constexpr int PE_PD = 8;
#define PE_LOAD4(SLOT, IDV) SLOT = *(const v4u*)(EU + (((unsigned)(IDV) << 9) | l16))
#define PE_BP(ADDR, V) __builtin_amdgcn_ds_bpermute((ADDR), (V))
__device__ __forceinline__ void peer_up_tm(Frame& F, const Ptrs& P) {
    const bf16* HB = (const bf16*)(P.ws + WS_ST); const unsigned char* EU = P.ws + WS_EU;
    const int* IDX = (const int*)(P.ws + WS_IDX); const float* GATE = (const float*)(P.ws + WS_GATE); const float* PART = (const float*)(P.ws + WS_PART);
    const float* SCD = (const float*)(P.ws + WS_SMALL); const float* SCU = SCD + 16384;
    const int lane = lane_id(), l31 = lane & 31; const bool upper = lane >= 32;
    const unsigned l16 = (unsigned)l31 << 4;
    const int bp0 = upper ? 4 : 0;
    const int t0 = F.vcu * NWAVES + F.wave, tstep = F.G * NWAVES;
    if (t0 >= T_) return;
    int idx_lo = IDX[(size_t)t0 * 128 + lane], idx_hi = IDX[(size_t)t0 * 128 + 64 + lane];
    v4u hq[4];
#pragma unroll
    for (int k = 0; k < 4; ++k) hq[k] = ((const v4u*)(HB + (size_t)t0 * DM))[4 * l31 + k];
    float g_lo = GATE[(size_t)t0 * 128 + lane], g_hi = GATE[(size_t)t0 * 128 + 64 + lane];
    float pre_lo = 0.f, pre_hi = 0.f;
#pragma unroll
    for (int s = 0; s < 4; ++s) { pre_lo += PART[((size_t)s * T_ + t0) * 128 + lane]; pre_hi += PART[((size_t)s * T_ + t0) * 128 + 64 + lane]; }
    float sdu_lo = SCD[idx_lo], sdu_hi = SCD[idx_hi], su_lo = SCU[idx_lo], su_hi = SCU[idx_hi];
    v4u ra[PE_PD];
#pragma unroll
    for (int j = 0; j < PE_PD; ++j) { const int id = PE_BP(bp0 + 8 * j, idx_lo); PE_LOAD4(ra[j], id); }
    int id_nx = PE_BP(bp0 + 8 * PE_PD, idx_lo);
    for (int t = t0; t < T_; t += tstep) {
        const int tn = (t + tstep < T_) ? t + tstep : t;
        const int nidx_lo = IDX[(size_t)tn * 128 + lane], nidx_hi = IDX[(size_t)tn * 128 + 64 + lane];
        v4u nh[4];
#pragma unroll
        for (int k = 0; k < 4; ++k) nh[k] = ((const v4u*)(HB + (size_t)tn * DM))[4 * l31 + k];
        const float ng_lo = GATE[(size_t)tn * 128 + lane], ng_hi = GATE[(size_t)tn * 128 + 64 + lane];
        float npart_lo[4], npart_hi[4];
#pragma unroll
        for (int s = 0; s < 4; ++s) { npart_lo[s] = PART[((size_t)s * T_ + tn) * 128 + lane]; npart_hi[s] = PART[((size_t)s * T_ + tn) * 128 + 64 + lane]; }
        float ssq = 0.f;
#pragma unroll
        for (int k = 0; k < 4; ++k) { ssq = fmaf(bflo(hq[k].x), bflo(hq[k].x), ssq); ssq = fmaf(bfhi(hq[k].x), bfhi(hq[k].x), ssq); ssq = fmaf(bflo(hq[k].y), bflo(hq[k].y), ssq); ssq = fmaf(bfhi(hq[k].y), bfhi(hq[k].y), ssq);
            ssq = fmaf(bflo(hq[k].z), bflo(hq[k].z), ssq); ssq = fmaf(bfhi(hq[k].z), bfhi(hq[k].z), ssq); ssq = fmaf(bflo(hq[k].w), bflo(hq[k].w), ssq); ssq = fmaf(bfhi(hq[k].w), bfhi(hq[k].w), ssq); }
        ssq += swz_xor<1>(ssq); ssq += swz_xor<2>(ssq); ssq += swz_xor<4>(ssq); ssq += swz_xor<8>(ssq); ssq += swz_xor<16>(ssq);
        const float rstd = rsqrtf(ssq * (1.f / 1024.f) + EPS);
        const float act_lo = gelu_erf(pre_lo * sdu_lo * rstd) * g_lo * su_lo, act_hi = gelu_erf(pre_hi * sdu_hi * rstd) * g_hi * su_hi;
        f32x2v acc[16];
#pragma unroll
        for (int i = 0; i < 16; ++i) acc[i] = (f32x2v){0.f, 0.f};
        float a_cur = __int_as_float(PE_BP(bp0, __float_as_int(act_lo)));
#pragma unroll
        for (int q = 0; q < 64; ++q) {
            const int qa = q + 1, ql = q + PE_PD + 1;
            float a_nx = 0.f;
            if (qa < 64) a_nx = __int_as_float(PE_BP(bp0 + 8 * (qa & 31), __float_as_int(qa < 32 ? act_lo : act_hi)));
            int id_n2;
            if (ql < 64) id_n2 = PE_BP(bp0 + 8 * (ql & 31), ql < 32 ? idx_lo : idx_hi);
            else id_n2 = PE_BP(bp0 + 8 * ((ql - 64) & 31), nidx_lo);
            __builtin_amdgcn_sched_barrier(0);
            { const f32x2v av = {a_cur, a_cur}; const v4u r = ra[q % PE_PD];
#define PE_FMA4(W, O) acc[O] = __builtin_elementwise_fma(av, (f32x2v)__builtin_amdgcn_cvt_scalef32_pk_f32_fp4(W, 1.0f, 0), acc[O]); acc[O + 1] = __builtin_elementwise_fma(av, (f32x2v)__builtin_amdgcn_cvt_scalef32_pk_f32_fp4(W, 1.0f, 1), acc[O + 1]); \
              acc[O + 2] = __builtin_elementwise_fma(av, (f32x2v)__builtin_amdgcn_cvt_scalef32_pk_f32_fp4(W, 1.0f, 2), acc[O + 2]); acc[O + 3] = __builtin_elementwise_fma(av, (f32x2v)__builtin_amdgcn_cvt_scalef32_pk_f32_fp4(W, 1.0f, 3), acc[O + 3]);
              PE_FMA4(r.x, 0) PE_FMA4(r.y, 4) PE_FMA4(r.z, 8) PE_FMA4(r.w, 12) }
            asm volatile("" : "+v"(acc[0]), "+v"(acc[1]), "+v"(acc[2]), "+v"(acc[3]), "+v"(acc[4]), "+v"(acc[5]), "+v"(acc[6]), "+v"(acc[7]));
            asm volatile("" : "+v"(acc[8]), "+v"(acc[9]), "+v"(acc[10]), "+v"(acc[11]), "+v"(acc[12]), "+v"(acc[13]), "+v"(acc[14]), "+v"(acc[15]));
            PE_LOAD4(ra[q % PE_PD], id_nx);
            id_nx = id_n2; a_cur = a_nx;
            __builtin_amdgcn_sched_barrier(0);
        }
        { float a = 0.f, c = 0.f;
#pragma unroll
          for (int s = 0; s < 4; ++s) { a += npart_lo[s]; c += npart_hi[s]; }
          pre_lo = a; pre_hi = c; }
        sdu_lo = SCD[nidx_lo]; sdu_hi = SCD[nidx_hi]; su_lo = SCU[nidx_lo]; su_hi = SCU[nidx_hi];
        float y[32];
#pragma unroll
        for (int k = 0; k < 4; ++k) { y[8 * k] = bflo(hq[k].x); y[8 * k + 1] = bfhi(hq[k].x); y[8 * k + 2] = bflo(hq[k].y); y[8 * k + 3] = bfhi(hq[k].y); y[8 * k + 4] = bflo(hq[k].z); y[8 * k + 5] = bfhi(hq[k].z); y[8 * k + 6] = bflo(hq[k].w); y[8 * k + 7] = bfhi(hq[k].w); }
        float s2 = 0.f;
#pragma unroll
        for (int i = 0; i < 16; ++i) { y[2 * i] += sum_halves(acc[i][0]); y[2 * i + 1] += sum_halves(acc[i][1]); s2 = fmaf(y[2 * i], y[2 * i], s2); s2 = fmaf(y[2 * i + 1], y[2 * i + 1], s2); }
        s2 += swz_xor<1>(s2); s2 += swz_xor<2>(s2); s2 += swz_xor<4>(s2); s2 += swz_xor<8>(s2); s2 += swz_xor<16>(s2);
        const float r2 = rsqrtf(s2 * (1.f / 1024.f) + EPS);
        const float4* wf = (const float4*)(P.norm_final) + 8 * l31 + 4 * (lane >> 5); float4* o = (float4*)(P.out + (size_t)t * DM) + 8 * l31 + 4 * (lane >> 5);
#pragma unroll
        for (int k = 0; k < 4; ++k) { const float4 w = wf[k];
            const float e0 = upper ? y[16 + 4 * k] : y[4 * k], e1 = upper ? y[17 + 4 * k] : y[4 * k + 1], e2 = upper ? y[18 + 4 * k] : y[4 * k + 2], e3 = upper ? y[19 + 4 * k] : y[4 * k + 3];
            o[k] = make_float4(e0 * r2 * w.x, e1 * r2 * w.y, e2 * r2 * w.z, e3 * r2 * w.w); }
        idx_lo = nidx_lo; idx_hi = nidx_hi; g_lo = ng_lo; g_hi = ng_hi;
#pragma unroll
        for (int k = 0; k < 4; ++k) hq[k] = nh[k];
    }
}
constexpr int TK_LDK = 136, TK_K2 = 34816, TK_SCR = 69632, TK_SP = 49;
__device__ __forceinline__ int mono_key(float x) { const int b = __float_as_int(x); return b ^ ((b >> 31) & 0x7fffffff); }
__device__ __forceinline__ float unmono(int m) { return __int_as_float(m ^ ((m >> 31) & 0x7fffffff)); }
__device__ __forceinline__ int max3i(int a, int b, int c) { return max(max(a, b), c); }
#define CEX(A, I, J) do { const int hi_ = max(A[I], A[J]), lo_ = min(A[I], A[J]); A[I] = hi_; A[J] = lo_; } while (0)
template <int N, int OFF, int K, int J, int LEN> struct BitonicStep {
    static __device__ __forceinline__ void run(int (&a)[LEN]) {
#pragma unroll
        for (int i = 0; i < N; ++i) { const int l = i ^ J; if (l > i) { if ((i & K) == 0) CEX(a, OFF + i, OFF + l); else CEX(a, OFF + l, OFF + i); } }
        if constexpr (J > 1) BitonicStep<N, OFF, K, (J >> 1), LEN>::run(a);
        else if constexpr (K < N) BitonicStep<N, OFF, (K << 1), K, LEN>::run(a);
    }
};
template <int N, int OFF, int LEN> __device__ __forceinline__ void bitonic_sort_desc(int (&a)[LEN]) { BitonicStep<N, OFF, 2, 1, LEN>::run(a); }
template <int OFF, int LEN> __device__ __forceinline__ void bitonic_merge16_desc(int (&a)[LEN]) { BitonicStep<16, OFF, 16, 8, LEN>::run(a); }
template <int A, int B, int LEN> __device__ __forceinline__ void merge_top16(int (&a)[LEN]) {
#pragma unroll
    for (int i = 0; i < 16; ++i) a[A + i] = max(a[A + i], a[B + 15 - i]);
    bitonic_merge16_desc<A, LEN>(a);
}
template <int LEN> __device__ __forceinline__ void pair_top16(int (&a)[LEN]) {
    int lo[16], up[16];
#pragma unroll
    for (int i = 0; i < 16; ++i) { const auto rr = __builtin_amdgcn_permlane32_swap((unsigned)a[i], (unsigned)a[i], false, false); lo[i] = (int)rr[0]; up[i] = (int)rr[1]; }
#pragma unroll
    for (int i = 0; i < 16; ++i) a[i] = max(lo[i], up[15 - i]);
    bitonic_merge16_desc<0, LEN>(a);
}
__device__ __forceinline__ void topk_half(const bf16x8 (&qf)[8], const LAS bf16* Kh, int r, int hh, int (&key)[64]) {
#pragma unroll
    for (int nt = 0; nt < 4; ++nt) {
        f32x16 sc;
#pragma unroll
        for (int i = 0; i < 16; ++i) sc[i] = 0.f;
#pragma unroll
        for (int kk = 0; kk < 8; ++kk) { const bf16x8 a = *(const LAS bf16x8*)(Kh + (32 * nt + r) * TK_LDK + 16 * kk + 8 * hh); sc = MFMA32(a, qf[kk], sc); }
#pragma unroll
        for (int i = 0; i < 16; ++i) key[nt * 16 + i] = (mono_key(sc[i]) & ~127) | (127 - (32 * nt + crow(i, hh)));
    }
    bitonic_sort_desc<16, 0, 64>(key); bitonic_sort_desc<16, 16, 64>(key); bitonic_sort_desc<16, 32, 64>(key); bitonic_sort_desc<16, 48, 64>(key);
    merge_top16<0, 16, 64>(key); merge_top16<32, 48, 64>(key); merge_top16<0, 32, 64>(key);
    pair_top16<64>(key);
}
__device__ __forceinline__ void topk_finish(const LAS int* scr, int hh, float rstd, int* IDX, float* GATE, int t, int hd) {
    const LAS int* la = scr + hh * 16; const LAS int* lb = scr + (1 - hh) * 16;
    float va[4], vb[16];
#pragma unroll
    for (int i = 0; i < 4; ++i) va[i] = unmono(la[i] & ~127);
#pragma unroll
    for (int j = 0; j < 16; ++j) vb[j] = unmono(lb[j] & ~127);
    int ck[32];
    {
        int q = 0;
#pragma unroll
        for (int i = 0; i < 4; ++i)
#pragma unroll
            for (int j = i; j < 16; ++j) if ((i + 1) * (j + 1) <= 16) {
                const int pos = hh ? (j * 16 + i) : (i * 16 + j);
                int k = (mono_key(va[i] + vb[j]) & ~255) | (255 - pos);
                if (i == j && hh) k = (int)0x80000000;
                ck[q++] = k; }
#pragma unroll
        for (int i = 27; i < 32; ++i) ck[i] = (int)0x80000000;
    }
    bitonic_sort_desc<32, 0, 32>(ck);
    pair_top16<32>(ck);
    const float vmax = unmono(ck[0] & ~255) * rstd;
    float ev[8]; int id[8]; float esum = 0.f; const int hm = -hh;
#pragma unroll
    for (int q = 0; q < 8; ++q) { const int wk = ck[q] ^ ((ck[q] ^ ck[8 + q]) & hm); const int pos = 255 - (wk & 255);
        const int n1 = 127 - (scr[pos >> 4] & 127), n2 = 127 - (scr[16 + (pos & 15)] & 127);
        id[q] = n1 * 128 + n2;
        ev[q] = exp2f((unmono(wk & ~255) * rstd - vmax) * LOG2E); esum += ev[q]; }
    esum = sum_halves(esum);
    const float inv = 1.f / esum;
    int4* ip = (int4*)(IDX + ((size_t)t * 8 + hd) * 16 + hh * 8); float4* gp = (float4*)(GATE + ((size_t)t * 8 + hd) * 16 + hh * 8);
    ip[0] = make_int4(id[0], id[1], id[2], id[3]); ip[1] = make_int4(id[4], id[5], id[6], id[7]);
    gp[0] = make_float4(ev[0] * inv, ev[1] * inv, ev[2] * inv, ev[3] * inv); gp[1] = make_float4(ev[4] * inv, ev[5] * inv, ev[6] * inv, ev[7] * inv);
}
constexpr int TQ_QH = 69632, TQ_QP = 272;
struct OneUnit { pg8::StaticOrder S; int i;
    __device__ __forceinline__ bool next(int j, pg8::Unit& u) const { return j == 0 ? S.next(i, u) : false; }
    __device__ __forceinline__ void a_ready(const pg8::Unit&) const {}
    __device__ __forceinline__ void done(const pg8::Unit&) const {}
};
struct EpiQTopk {
    static constexpr bool PERM = true, AFTER_DRAIN = true;
    const float* sk1; const float* sk2; const float* SSQ; int* IDX; float* GATE;
    __device__ __forceinline__ void dump(const pg8::f32x4 (&acc)[2][2][4][2], int bj, LAS unsigned char* QH, int wr, int wc, int fr, int fq) const {
#pragma unroll
        for (int ai = 0; ai < 2; ++ai)
#pragma unroll
            for (int m = 0; m < 4; ++m) { const pg8::f32x4 v0 = bj ? acc[ai][1][m][0] : acc[ai][0][m][0], v1 = bj ? acc[ai][1][m][1] : acc[ai][0][m][1];
                v4u w; w.x = cvtpk(v0[0], v0[1]); w.y = cvtpk(v0[2], v0[3]); w.z = cvtpk(v1[0], v1[1]); w.w = cvtpk(v1[2], v1[3]);
                *(LAS v4u*)(QH + (128 * ai + 64 * wr + 16 * m + fr) * TQ_QP + (32 * wc + 8 * fq) * 2) = w; }
    }
    __device__ __forceinline__ void fused(const pg8::f32x4 (&acc)[2][2][4][2], const pg8::Unit& u, int wr, int wc, int fr, int fq, LAS unsigned char* L, int wid, int lane) const {
        LAS bf16* K1 = (LAS bf16*)L; LAS bf16* K2 = (LAS bf16*)(L + TK_K2); LAS unsigned char* QH = L + TQ_QH;
        const int tid_ = wid * 64 + lane, r = lane & 31, hh = lane >> 5;
        for (int i = tid_; i < 16384; i += 512) { const int n = i >> 7, k = i & 127; K1[n * TK_LDK + k] = (bf16)f2bf(sk1[i]); K2[n * TK_LDK + k] = (bf16)f2bf(sk2[i]); }
        dump(acc, 0, QH, wr, wc, fr, fq);
        __syncthreads();
        const int t = u.pm * 256 + 32 * wid + r;
        float rstd;
        { const float4* sp = (const float4*)(SSQ + (size_t)t * 16); const float4 a = sp[0], b = sp[1], c = sp[2], d = sp[3];
          rstd = rsqrtf(((a.x + a.y + a.z + a.w) + (b.x + b.y + b.z + b.w) + (c.x + c.y + c.z + c.w) + (d.x + d.y + d.z + d.w)) * (1.f / 1024.f) + EPS); }
        const LAS unsigned char* qrow = QH + (32 * wid + r) * TQ_QP + 16 * hh;
        int key[64], list0[16];
        { bf16x8 qf[8];
#pragma unroll
          for (int kk = 0; kk < 8; ++kk) qf[kk] = *(const LAS bf16x8*)(qrow + 32 * kk);
          topk_half(qf, K1, r, hh, key);
#pragma unroll
          for (int i = 0; i < 16; ++i) list0[i] = key[i]; }
        __syncthreads();
        dump(acc, 1, QH, wr, wc, fr, fq);
        __syncthreads();
        { bf16x8 qf[8];
#pragma unroll
          for (int kk = 0; kk < 8; ++kk) qf[kk] = *(const LAS bf16x8*)(qrow + 32 * kk);
          topk_half(qf, K2, r, hh, key); }
        LAS int* scr = (LAS int*)(QH + 32 * wid * TQ_QP) + r * TK_SP;
        LDS_WAIT();
        if (hh == 0) {
#pragma unroll
            for (int i = 0; i < 16; ++i) { scr[i] = list0[i]; scr[16 + i] = key[i]; } }
        topk_finish(scr, hh, rstd, IDX, GATE, t, u.pn);
        __syncthreads();
    }
};

constexpr int AT_KP = 72, AT_VP = 264;
constexpr int AT_K = 0, AT_VT = 36864, AT_BT = 36864 + 33792;
__device__ __forceinline__ void attn_phase(Frame& F, const Ptrs& P) {
    const bf16* PROJ = (const bf16*)(P.ws + WS_PROJ); bf16* CAT = (bf16*)(P.ws + WS_XN);
    LAS unsigned char* L = F.lds + RING_OFF;
    LAS bf16* Ks = (LAS bf16*)(L + AT_K); LAS bf16* Vt = (LAS bf16*)(L + AT_VT); LAS float* btab = (LAS float*)(L + AT_BT);
    const int lane = lane_id(), tid_ = F.wave * 64 + lane, r = lane & 31, hh = lane >> 5;
    for (int u = F.vcu; u < 256; u += F.G) {
        const int hkv = u & 1, n = (u >> 1) & 31, b = u >> 6;
        const int trow0 = b * SEQ + n * 128;
        for (int i = tid_; i < 2048; i += 512) {
            const int kj = i >> 3, ch = i & 7; const bool ok = (n > 0) || (kj >= 128);
            v4u kv = {0u, 0u, 0u, 0u}, vv = {0u, 0u, 0u, 0u};
            if (ok) { const bf16* rowp = PROJ + (size_t)(trow0 - 128 + kj) * NPROJ + hkv * 64 + ch * 8; kv = *(const v4u*)(rowp + PJ_K); vv = *(const v4u*)(rowp + PJ_V); }
            *(LAS v4u*)(Ks + kj * AT_KP + ch * 8) = kv;
            LAS bf16* vp = Vt + (ch * 8) * AT_VP + kj;
            vp[0] = (bf16)(vv.x & 0xffffu); vp[AT_VP] = (bf16)(vv.x >> 16); vp[2 * AT_VP] = (bf16)(vv.y & 0xffffu); vp[3 * AT_VP] = (bf16)(vv.y >> 16);
            vp[4 * AT_VP] = (bf16)(vv.z & 0xffffu); vp[5 * AT_VP] = (bf16)(vv.z >> 16); vp[6 * AT_VP] = (bf16)(vv.w & 0xffffu); vp[7 * AT_VP] = (bf16)(vv.w >> 16);
        }
        for (int i = tid_; i < 768; i += 512) { const int gg = i / 192, dist = i % 192 - 32;
            btab[i] = (dist >= 0 && dist < 128) ? P.rel_bias[c_bucket[dist & 127] * 8 + hkv * 4 + gg] * LOG2E : 0.f; }
        __syncthreads();
        const int g = F.wave & 3, h = hkv * 4 + g;
        const float sink2 = P.sinks[h] * LOG2E;
#pragma unroll 1
        for (int qq = 0; qq < 2; ++qq) {
            const int qt = (F.wave >> 2) * 2 + qq, t = trow0 + 32 * qt + r;
            bf16x8 qf[4];
#pragma unroll
            for (int kk = 0; kk < 4; ++kk) qf[kk] = *(const bf16x8*)(PROJ + (size_t)t * NPROJ + h * 64 + 16 * kk + 8 * hh);
            f32x16 sc[5];
#pragma unroll
            for (int j = 0; j < 5; ++j) {
#pragma unroll
                for (int i = 0; i < 16; ++i) sc[j][i] = 0.f;
#pragma unroll
                for (int kk = 0; kk < 4; ++kk) { const bf16x8 a = *(const LAS bf16x8*)(Ks + (32 * (qt + j) + r) * AT_KP + 16 * kk + 8 * hh); sc[j] = MFMA32(a, qf[kk], sc[j]); }
            }
            float m = sink2;
            const LAS float* bt = btab + g * 192 + 160 + r - 4 * hh;
#pragma unroll
            for (int j = 0; j < 5; ++j) {
                const bool tile_ok = (n > 0) || (qt + j >= 4);
#pragma unroll
                for (int i = 0; i < 16; ++i) { const int dist = 128 + r - (32 * j + crow(i, hh));
                    const bool ok = tile_ok && (j == 0 ? dist < 128 : (j == 4 ? dist >= 0 : true));
                    const float s = sc[j][i] * (0.125f * LOG2E) + bt[-(32 * j + (i & 3) + 8 * (i >> 2))];
                    sc[j][i] = ok ? s : -INFINITY; m = fmaxf(m, sc[j][i]); }
            }
            m = max_halves(m);
            float l = 0.f;
#pragma unroll
            for (int j = 0; j < 5; ++j)
#pragma unroll
                for (int i = 0; i < 16; ++i) { sc[j][i] = exp2f(sc[j][i] - m); l += sc[j][i]; }
            l = sum_halves(l);
            l += exp2f(sink2 - m);
            const float inv = 1.f / l;
            f32x16 o[2];
#pragma unroll
            for (int i = 0; i < 16; ++i) { o[0][i] = 0.f; o[1][i] = 0.f; }
#pragma unroll
            for (int j = 0; j < 5; ++j)
#pragma unroll
                for (int sg = 0; sg < 2; ++sg) {
                    const bf16x8 pf = pack8(sc[j], sg);
#pragma unroll
                    for (int dt = 0; dt < 2; ++dt) {
                        const LAS bf16* vb = Vt + (32 * dt + r) * AT_VP + 32 * (qt + j) + 16 * sg + 4 * hh;
                        const s16x4 lo = *(const LAS s16x4*)(vb), hi = *(const LAS s16x4*)(vb + 8);
                        o[dt] = MFMA32(__builtin_shufflevector(lo, hi, 0, 1, 2, 3, 4, 5, 6, 7), pf, o[dt]);
                    }
                }
            bf16* op = CAT + (size_t)t * DM + h * 64 + 4 * hh;
#pragma unroll
            for (int dt = 0; dt < 2; ++dt)
#pragma unroll
                for (int g4 = 0; g4 < 4; ++g4)
                    *(unsigned long long*)(op + 32 * dt + 8 * g4) = (unsigned long long)cvtpk(o[dt][4 * g4] * inv, o[dt][4 * g4 + 1] * inv) | ((unsigned long long)cvtpk(o[dt][4 * g4 + 2] * inv, o[dt][4 * g4 + 3] * inv) << 32);
        }
        __syncthreads();
    }
}
struct Args { Ptrs p; };
__global__ void __launch_bounds__(NWAVES * 64, 2) hymba_fwd(Args args) {
    extern __shared__ __attribute__((aligned(16))) unsigned char lds[];
    const Ptrs& P = args.p;
    Frame F;
    F.lds = (LAS unsigned char*)lds;
    F.MISC = (volatile LAS unsigned*)(F.lds + MISC_OFF);
    F.wave = __builtin_amdgcn_readfirstlane(threadIdx.x >> 6);
    F.G = gridDim.x; { const int bx = blockIdx.x; F.vcu = (F.G % 8 == 0) ? (bx % 8) * (F.G / 8) + bx / 8 : bx; }
    F.ctl = (gu32*)(P.ws + WS_CTL);
    for (int u = threadIdx.x; u < (LDS_BYTES - LDSCTL_OFF) / 4; u += NWAVES * 64) ((LAS unsigned*)(F.lds + LDSCTL_OFF))[u] = 0u;
    __syncthreads();
    XcdBarrier bar = xcd_barrier_post((unsigned*)(F.ctl + CW_BAR), F.MISC + 8);
#define GRID_BAR() xcd_barrier(bar)

    bf16* XN = (bf16*)(P.ws + WS_XN); bf16* PROJ = (bf16*)(P.ws + WS_PROJ); bf16* HB = (bf16*)(P.ws + WS_ST);
    p0_prologue(F, P);
    GRID_BAR();
    { pg8::Gemm g{XN, (const bf16*)(P.ws + WS_WIN), T_, NPROJ, DM, F.wave}; pg8::StaticOrder S; S.init(T_, NPROJ, F.G, (int)blockIdx.x);
      pg8::EpiBf16<0> E{PROJ, NPROJ, nullptr, 0, 0, 1.f};
      pg8::gemm_phase<pg8::EpiBf16<0>, pg8::StaticOrder, PG8_ALIGN, PG8_SP2>(F.lds + RING_OFF, g, S, E); }
    if (F.G == 256 && blockIdx.x >= 64) p1_slack(F, P, ((int)blockIdx.x - 64) * NWAVES + F.wave, 192 * NWAVES);
    else if (F.G != 256) p1_slack(F, P, F.vcu * NWAVES + F.wave, F.G * NWAVES);
    GRID_BAR();
    ssd_s1(F, P);
    attn_phase(F, P);
    GRID_BAR();
    ssd_s2(F, P);
    GRID_BAR();
    ssd_s3(F, P);
    GRID_BAR();
    { pg8::Gemm g{XN, (const bf16*)(P.ws + WS_WOUT), T_, DM, DM, F.wave}; pg8::StaticOrder S; S.init(T_, DM, F.G, (int)blockIdx.x);
      EpiResH E{P.x, HB, (float*)(P.ws + WS_SSQ)};
      pg8::gemm_phase<EpiResH, pg8::StaticOrder, PG8_ALIGN, PG8_SP2>(F.lds + RING_OFF, g, S, E); }
    GRID_BAR();
    { pg8::Gemm g{HB, (const bf16*)(P.ws + WS_WQ), T_, 2048, DM, F.wave}; pg8::StaticOrder S; S.init(T_, 2048, F.G, (int)blockIdx.x);
      EpiQTopk E{P.sk1, P.sk2, (const float*)(P.ws + WS_SSQ), (int*)(P.ws + WS_IDX), (float*)(P.ws + WS_GATE)};
#pragma unroll 1
      for (int ui = 0; ui < 64; ++ui) { pg8::Unit u0; if (!S.next(ui, u0)) break;
          OneUnit S1{S, ui};
          pg8::gemm_phase<EpiQTopk, OneUnit, PG8_ALIGN, PG8_SP2>(F.lds + RING_OFF, g, S1, E); } }
    h_quant_rows(F, P);
    GRID_BAR();
    { const PeerPlace pp = peer_place(F);
      peer_down(F, P, pp); }
    GRID_BAR();
    peer_up_tm(F, P);
}

extern "C" void kernel_launch(void* const* d_in, const int* in_sizes, int n_in, void* d_out, int out_size, void* d_ws, size_t ws_size, hipStream_t stream) {
    static int grid = 0;
    if (grid == 0) {
        if (n_in != 19 || out_size != T_ * DM || ws_size < WS_END) { fprintf(stderr, "kernel_launch: unexpected shapes (n_in %d, out %d, ws %zu)\n", n_in, out_size, ws_size); grid = -1; return; }
        int dev = 0, cus = 0, per_cu = 0;
        if (hipGetDevice(&dev) != hipSuccess || hipDeviceGetAttribute(&cus, hipDeviceAttributeMultiprocessorCount, dev) != hipSuccess) { grid = -1; return; }
        if (hipFuncSetAttribute((const void*)hymba_fwd, hipFuncAttributeMaxDynamicSharedMemorySize, LDS_BYTES) != hipSuccess) { fprintf(stderr, "kernel_launch: hipFuncSetAttribute failed\n"); grid = -1; return; }
        if (hipOccupancyMaxActiveBlocksPerMultiprocessor(&per_cu, (const void*)hymba_fwd, NWAVES * 64, LDS_BYTES) != hipSuccess || per_cu < 1) { fprintf(stderr, "kernel_launch: occupancy query says %d blocks per CU\n", per_cu); grid = -1; (void)hipGetLastError(); return; }
        grid = cus;
    }
    if (grid < 0) return;
    (void)hipMemsetAsync((char*)d_ws + WS_CTL, 0, CTL_ZERO_BYTES, stream);
    Args a{};
    const float** pp = (const float**)&a.p;
    for (int i = 0; i < 19; ++i) pp[i] = (const float*)d_in[i];
    a.p.out = (float*)d_out; a.p.ws = (unsigned char*)d_ws;
    hipLaunchKernelGGL(hymba_fwd, dim3(grid), dim3(NWAVES * 64), LDS_BYTES, stream, a);
}
```

```cpp
#include <hip/hip_runtime.h>
#include <cstdio>
#include <cstdint>
#include <math.h>
namespace pg8 {
#define PG8_LAS __attribute__((address_space(3)))
typedef unsigned short bf16_t;
typedef short bf16x8 __attribute__((ext_vector_type(8)));
typedef float f32x4 __attribute__((ext_vector_type(4)));
typedef unsigned u32x4 __attribute__((ext_vector_type(4)));
constexpr int BM = 256, BK = 64, HALF = 128, HTB = HALF * BK * 2  , STAGE_BYTES = 8 * HTB, NXCD = 8, WGM = 8;

__host__ __device__ __forceinline__ int lds_byte(int r, int c) { const int st = (r >> 4) * 2 + (c >> 5), rr = r & 15, cc = c & 31, ob = rr * 64 + cc * 2; return st * 1024 + (ob ^ (((ob >> 9) & 1) << 5)); }
__host__ __device__ __forceinline__ void stage_rc(int b, int& R, int& C) { const int st = b / 1024, sb = b % 1024, swz = sb ^ (((sb >> 9) & 1) << 5); R = (st >> 1) * 16 + swz / 64; C = (st & 1) * 32 + (swz % 64) / 2; }
__host__ __device__ __forceinline__ int perm32(int rho) { const int n = rho >> 4, i = rho & 15; return 8 * (i >> 2) + 4 * n + (i & 3); }

struct Unit { int pm, pn; };
struct Gemm { const bf16_t* A; const bf16_t* Bt; int M, N, K, wave; };

struct StaticOrder {
    int nM, nN, nwg, G, c;
    __host__ __device__ void init(int M, int N, int G_, int c_) { nM = M / BM; nN = N / BM; nwg = nM * nN; G = G_; c = c_; }
    __host__ __device__ bool next(int i, Unit& u) const {
        const long L = (long)i * G + c; if (L >= nwg) return false;
        int wgid = (int)L; { const int q = nwg / NXCD, r = nwg % NXCD, xcd = wgid % NXCD, off = wgid / NXCD; wgid = (xcd < r ? xcd * (q + 1) : r * (q + 1) + (xcd - r) * q) + off; }
        const int nig = WGM * nN, gid = wgid / nig, fm = gid * WGM, gsz = (nM - fm) < WGM ? (nM - fm) : WGM;
        u.pm = fm + ((wgid % nig) % gsz); u.pn = (wgid % nig) / gsz; return true;
    }
    __device__ __forceinline__ void a_ready(const Unit&) const {}
    __device__ __forceinline__ void done(const Unit&) const {}
};

__device__ __forceinline__ unsigned cvt_pk_bf16(float lo, float hi) { unsigned r; asm volatile("v_cvt_pk_bf16_f32 %0, %1, %2" : "=v"(r) : "v"(lo), "v"(hi)); return r; }
typedef float f32x2 __attribute__((ext_vector_type(2)));
__device__ __forceinline__ f32x2 gelu_pk(f32x2 v) {
    const f32x2 av = __builtin_elementwise_abs(v), d = av * 0.2316418882f + 1.0f;
    f32x2 t; t.x = __builtin_amdgcn_rcpf(d.x); t.y = __builtin_amdgcn_rcpf(d.y);
    f32x2 q = t * 0.5307027145f + (-0.7265760135f); q = q * t + 0.7107068705f; q = q * t + (-0.142248368f); q = q * t + 0.127414796f; q = q * t;
    const f32x2 s = (v * v) * (-0.72134752044f);
    f32x2 e; e.x = __builtin_amdgcn_exp2f(s.x); e.y = __builtin_amdgcn_exp2f(s.y);
    const f32x2 m = v * (q * e), r = v - m;
    f32x2 o; o.x = v.x < 0.f ? m.x : r.x; o.y = v.y < 0.f ? m.y : r.y; return o;
}

template <int ACT  > struct EpiBf16 {
    static constexpr bool PERM = true, AFTER_DRAIN = false; static_assert(ACT == 0 || ACT == 1, "EpiBf16: ACT is 0 (none) or 1 (gelu_pk)");
    bf16_t* O; int ldc; const float* bias; int split_cols; size_t split_stride; float scale0;
    __device__ __forceinline__ void operator()(const f32x4 (&acc)[2][2][4][2], const Unit& u, int wr, int wc, int fr, int fq) const {
        const int row0 = u.pm * BM + wr * 64 + fr; int colt = u.pn * BM; bf16_t* base = O;
        float sc = 1.f; if (split_cols) { const int t = colt / split_cols; base += (size_t)t * split_stride; colt -= t * split_cols; if (t == 0) sc = scale0; }
        const int col0 = colt + wc * 32 + 8 * fq, bcol0 = u.pn * BM + wc * 32 + 8 * fq;
        f32x4 bv[2][2];
#pragma unroll
        for (int bj = 0; bj < 2; ++bj)
#pragma unroll
            for (int n = 0; n < 2; ++n) bv[bj][n] = bias ? *(const f32x4*)(bias + bcol0 + bj * HALF + 4 * n) : (f32x4){0.f, 0.f, 0.f, 0.f};
#pragma unroll
        for (int ai = 0; ai < 2; ++ai)
#pragma unroll
            for (int m = 0; m < 4; ++m) { bf16_t* rowp = base + (size_t)(row0 + ai * HALF + m * 16) * ldc + col0;
#pragma unroll
                for (int bj = 0; bj < 2; ++bj) { f32x4 v0 = acc[ai][bj][m][0] + bv[bj][0], v1 = acc[ai][bj][m][1] + bv[bj][1];
                    if (ACT == 1) { f32x2 a = gelu_pk((f32x2){v0[0], v0[1]}), b = gelu_pk((f32x2){v0[2], v0[3]}), c = gelu_pk((f32x2){v1[0], v1[1]}), d = gelu_pk((f32x2){v1[2], v1[3]});
                        v0 = (f32x4){a.x, a.y, b.x, b.y}; v1 = (f32x4){c.x, c.y, d.x, d.y}; }
                    v0 = v0 * sc; v1 = v1 * sc; u32x4 w; w.x = cvt_pk_bf16(v0[0], v0[1]); w.y = cvt_pk_bf16(v0[2], v0[3]); w.z = cvt_pk_bf16(v1[0], v1[1]); w.w = cvt_pk_bf16(v1[2], v1[3]);
                    *(u32x4*)(rowp + bj * HALF) = w; } }
    }
};
template <class Epi, class Sched, bool ALIGN_EPI = false, bool SP2 = false>
__device__ __forceinline__ void gemm_phase(PG8_LAS unsigned char* lds, const Gemm g, const Sched& S, const Epi& E) {
    int lane_l; asm volatile("v_mbcnt_lo_u32_b32 %0, -1, 0\n\tv_mbcnt_hi_u32_b32 %0, -1, %0" : "=v"(lane_l));
    const int wid = g.wave, lane = lane_l, tid = wid * 64 + lane,
              wr = wid >> 2, wc = wid & 3, fr = lane & 15, fq = lane >> 4;
    const int K = g.K, nt = K / BK;
    unsigned voffA[2], voffB[2];
#pragma unroll
    for (int i = 0; i < 2; ++i) { int R, C; stage_rc(tid * 16 + i * 8192, R, C); const int Rb = Epi::PERM ? ((R & ~31) + perm32(R & 31)) : R;
        voffA[i] = (unsigned)(R * K + C) * 2u; voffB[i] = (unsigned)(Rb * K + C) * 2u; }
    const size_t kstep = (size_t)(BK * 2);
    const size_t hstep = (size_t)HALF * K * 2;
    const size_t tstep = 2 * hstep;
    const unsigned ldsw = (unsigned)wid * 1024u;
    const int aoff = lds_byte(wr * 64 + fr, fq * 8), boff = lds_byte(wc * 32 + fr, fq * 8);
#define PG8_SA(b, h) (((b) * 2 + (h)) * HTB)
#define PG8_SB(b, h) ((4 + (b) * 2 + (h)) * HTB)
#define PG8_STAGE(bufoff, gbase, voff) do { _Pragma("unroll") for (int _i = 0; _i < 2; ++_i) \
        __builtin_amdgcn_global_load_lds((const unsigned*)((const char*)(gbase) + (voff)[_i]), (PG8_LAS unsigned*)(lds + (bufoff) + ldsw + _i * 8192), 16, 0, 0); } while (0)
#define PG8_LDA(dst, b, h) do { _Pragma("unroll") for (int m = 0; m < 4; ++m) _Pragma("unroll") for (int k = 0; k < 2; ++k) dst[m][k] = *(const PG8_LAS bf16x8*)(lds + PG8_SA(b, h) + aoff + m * 2048 + k * 1024); } while (0)
#define PG8_LDB(dst, b, h) do { _Pragma("unroll") for (int n = 0; n < 2; ++n) _Pragma("unroll") for (int k = 0; k < 2; ++k) dst[n][k] = *(const PG8_LAS bf16x8*)(lds + PG8_SB(b, h) + boff + n * 2048 + k * 1024); } while (0)
#define PG8_MMA(ai, bj, At, Bt) do { __builtin_amdgcn_s_setprio(1); _Pragma("unroll") for (int m = 0; m < 4; ++m) _Pragma("unroll") for (int n = 0; n < 2; ++n) _Pragma("unroll") for (int k = 0; k < 2; ++k) \
        acc[ai][bj][m][n] = __builtin_amdgcn_mfma_f32_16x16x32_bf16(Bt[n][k], At[m][k], acc[ai][bj][m][n], 0, 0, 0); __builtin_amdgcn_s_setprio(0); } while (0)
#define PG8_WAIT_V(n) asm volatile("s_waitcnt vmcnt(" #n ")" ::: "memory")
#define PG8_WAIT_L(n) asm volatile("s_waitcnt lgkmcnt(" #n ")" ::: "memory")
#define PG8_BAR __builtin_amdgcn_s_barrier()
#define PG8_SCHED __builtin_amdgcn_sched_barrier(0)
    Unit cur, nxt; int ui = 0;
    if (!S.next(0, cur)) return;
    f32x4 acc[2][2][4][2];
#pragma unroll
    for (int a = 0; a < 2; ++a)
#pragma unroll
        for (int b = 0; b < 2; ++b)
#pragma unroll
            for (int m = 0; m < 4; ++m)
#pragma unroll
                for (int n = 0; n < 2; ++n) acc[a][b][m][n] = (f32x4){0.f, 0.f, 0.f, 0.f};
    bf16x8 At[4][2], B0[2][2], B1[2][2];
    const char* cA = (const char*)g.A + (size_t)cur.pm * tstep; const char* cB = (const char*)g.Bt + (size_t)cur.pn * tstep;
    S.a_ready(cur);
    if constexpr (SP2) {
        PG8_STAGE(PG8_SB(0, 0), cB, voffB); PG8_STAGE(PG8_SB(0, 1), cB + hstep, voffB); PG8_STAGE(PG8_SA(0, 0), cA, voffA); PG8_STAGE(PG8_SA(0, 1), cA + hstep, voffA);
        if (wr == 1) PG8_BAR;
        PG8_WAIT_V(2); PG8_BAR;
        PG8_STAGE(PG8_SB(1, 0), cB + kstep, voffB); PG8_STAGE(PG8_SA(1, 0), cA + kstep, voffA); PG8_STAGE(PG8_SB(1, 1), cB + hstep + kstep, voffB);
        PG8_WAIT_V(6); PG8_BAR;
    } else {
        PG8_STAGE(PG8_SB(0, 0), cB, voffB); PG8_STAGE(PG8_SA(0, 0), cA, voffA); PG8_STAGE(PG8_SB(0, 1), cB + hstep, voffB); PG8_STAGE(PG8_SA(0, 1), cA + hstep, voffA);
        if (wr == 1) PG8_BAR;
        PG8_WAIT_V(4); PG8_BAR;
        PG8_STAGE(PG8_SB(1, 0), cB + kstep, voffB); PG8_STAGE(PG8_SA(1, 0), cA + kstep, voffA); PG8_STAGE(PG8_SB(1, 1), cB + hstep + kstep, voffB);
        PG8_WAIT_V(6); PG8_BAR;
    }
    for (;;) {
        const bool has_next = S.next(ui + 1, nxt);
        const char* nA = has_next ? (const char*)g.A + (size_t)nxt.pm * tstep : cA; const char* nB = has_next ? (const char*)g.Bt + (size_t)nxt.pn * tstep : cB;
        for (int t = 0; t < nt; t += 2) {
            const bool last = (t == nt - 2);
            const char* a1 = cA + (size_t)(t + 1) * kstep;
            const char* a2 = last ? nA : cA + (size_t)(t + 2) * kstep; const char* b2 = last ? nB : cB + (size_t)(t + 2) * kstep;
            const char* a3 = a2 + kstep; const char* b3 = b2 + kstep;
            if (last && has_next) S.a_ready(nxt);
            if constexpr (SP2) {
            PG8_LDB(B0, 0, 0); PG8_LDB(B1, 0, 1); PG8_SCHED; PG8_LDA(At, 0, 0); PG8_STAGE(PG8_SA(1, 1), a1 + hstep, voffA);
            PG8_WAIT_V(8); PG8_WAIT_L(0); PG8_BAR; PG8_MMA(0, 0, At, B0); PG8_MMA(0, 1, At, B1); PG8_BAR; PG8_SCHED;
            PG8_LDA(At, 0, 1); PG8_STAGE(PG8_SB(0, 0), b2, voffB); PG8_STAGE(PG8_SB(0, 1), b2 + hstep, voffB); PG8_STAGE(PG8_SA(0, 0), a2, voffA);
            PG8_WAIT_V(8); PG8_WAIT_L(0); PG8_BAR; PG8_MMA(1, 0, At, B0); PG8_MMA(1, 1, At, B1); PG8_BAR; PG8_SCHED;
            PG8_LDB(B0, 1, 0); PG8_LDB(B1, 1, 1); PG8_SCHED; PG8_LDA(At, 1, 0); PG8_STAGE(PG8_SA(0, 1), a2 + hstep, voffA);
            PG8_WAIT_V(8); PG8_WAIT_L(0); PG8_BAR; PG8_MMA(0, 0, At, B0); PG8_MMA(0, 1, At, B1); PG8_BAR; PG8_SCHED;
            PG8_LDA(At, 1, 1); PG8_STAGE(PG8_SB(1, 0), b3, voffB); PG8_STAGE(PG8_SB(1, 1), b3 + hstep, voffB); PG8_STAGE(PG8_SA(1, 0), a3, voffA);
            PG8_WAIT_V(8); PG8_WAIT_L(0); PG8_BAR; PG8_MMA(1, 0, At, B0); PG8_MMA(1, 1, At, B1); PG8_BAR; PG8_SCHED;
            } else {
            PG8_LDB(B0, 0, 0); PG8_SCHED; PG8_LDA(At, 0, 0); PG8_STAGE(PG8_SA(1, 1), a1 + hstep, voffA);
            PG8_WAIT_L(8); PG8_BAR; PG8_WAIT_L(0); PG8_MMA(0, 0, At, B0); PG8_BAR; PG8_SCHED;
            PG8_LDB(B1, 0, 1); PG8_STAGE(PG8_SB(0, 0), b2, voffB);
            PG8_BAR; PG8_WAIT_L(0); PG8_MMA(0, 1, At, B1); PG8_BAR;
            PG8_LDA(At, 0, 1); PG8_STAGE(PG8_SA(0, 0), a2, voffA);
            PG8_BAR; PG8_WAIT_L(0); PG8_MMA(1, 0, At, B0); PG8_BAR; PG8_SCHED;
            PG8_STAGE(PG8_SB(0, 1), b2 + hstep, voffB);
            PG8_WAIT_V(6); PG8_BAR; PG8_MMA(1, 1, At, B1); PG8_BAR;
            PG8_LDB(B0, 1, 0); PG8_SCHED; PG8_LDA(At, 1, 0); PG8_STAGE(PG8_SA(0, 1), a2 + hstep, voffA);
            PG8_WAIT_L(8); PG8_BAR; PG8_WAIT_L(0); PG8_MMA(0, 0, At, B0); PG8_BAR; PG8_SCHED;
            PG8_LDB(B1, 1, 1); PG8_STAGE(PG8_SB(1, 0), b3, voffB);
            PG8_BAR; PG8_WAIT_L(0); PG8_MMA(0, 1, At, B1); PG8_BAR;
            PG8_LDA(At, 1, 1); PG8_STAGE(PG8_SA(1, 0), a3, voffA);
            PG8_BAR; PG8_WAIT_L(0); PG8_MMA(1, 0, At, B0); PG8_BAR; PG8_SCHED;
            PG8_STAGE(PG8_SB(1, 1), b3 + hstep, voffB);
            PG8_WAIT_V(6); PG8_BAR; PG8_MMA(1, 1, At, B1); PG8_BAR;
            }
        }
        if constexpr (ALIGN_EPI) { if (wr == 0) PG8_BAR; }
        if constexpr (!Epi::AFTER_DRAIN) { E(acc, cur, wr, wc, fr, fq); S.done(cur); }
        if (!has_next) break;
#pragma unroll
        for (int a = 0; a < 2; ++a)
#pragma unroll
            for (int b = 0; b < 2; ++b)
#pragma unroll
                for (int m = 0; m < 4; ++m)
#pragma unroll
                    for (int n = 0; n < 2; ++n) acc[a][b][m][n] = (f32x4){0.f, 0.f, 0.f, 0.f};
        cur = nxt; cA = nA; cB = nB; ++ui;
        if constexpr (ALIGN_EPI) { if (wr == 1) PG8_BAR; }
    }
    PG8_WAIT_V(0);
    if constexpr (!ALIGN_EPI) { if (wr == 0) PG8_BAR; }
    PG8_BAR;
    if constexpr (Epi::AFTER_DRAIN) { E.fused(acc, cur, wr, wc, fr, fq, lds, wid, lane); S.done(cur); }
#undef PG8_SA
#undef PG8_SB
#undef PG8_STAGE
#undef PG8_LDA
#undef PG8_LDB
#undef PG8_MMA
#undef PG8_WAIT_V
#undef PG8_WAIT_L
#undef PG8_BAR
#undef PG8_SCHED
}
}

#ifndef PG8_SP2
#define PG8_SP2 true
#endif
#ifndef PG8_ALIGN
#define PG8_ALIGN true
#endif
#define GAS __attribute__((address_space(1)))
#define LAS __attribute__((address_space(3)))
typedef unsigned short bf16;
typedef unsigned v4u __attribute__((ext_vector_type(4)));
typedef float f32x4 __attribute__((ext_vector_type(4)));
typedef short bf16x8 __attribute__((ext_vector_type(8)));
typedef GAS unsigned gu32;
typedef GAS unsigned long long gu64;
#define RLX_AGENT __ATOMIC_RELAXED, __HIP_MEMORY_SCOPE_AGENT
#define LDS_WAIT() asm volatile("s_waitcnt lgkmcnt(0)" ::: "memory")
#define VM_WAIT() asm volatile("s_waitcnt vmcnt(0)" ::: "memory")
__device__ __forceinline__ unsigned long long rt() { return __builtin_amdgcn_s_memrealtime(); }
__device__ __forceinline__ unsigned f2bf(float f) { unsigned u = __builtin_bit_cast(unsigned, f); return (u + 0x7fffu + ((u >> 16) & 1u)) >> 16; }
__device__ __forceinline__ unsigned pk2(float lo, float hi) { return f2bf(lo) | (f2bf(hi) << 16); }

#define XB_TMO      128
#define XB_XCNT(j)  (256  + 64 * (j))
#define XB_XSUB(j)  (1280 + 64 * (j))
#define XB_XGEN(j)  (2304 + 64 * (j))
#define XB_TOP      3328
#define XB_TOPGEN   3392
#define XCD_BAR_WORDS 3456
#define XB_SPIN_CAP (1u << 22)

__device__ __forceinline__ unsigned xb_ld(unsigned* p)              { return __hip_atomic_load(p, __ATOMIC_RELAXED, __HIP_MEMORY_SCOPE_AGENT); }
__device__ __forceinline__ unsigned xb_add(unsigned* p, unsigned v) { return __hip_atomic_fetch_add(p, v, __ATOMIC_RELAXED, __HIP_MEMORY_SCOPE_AGENT); }
__device__ __forceinline__ unsigned xb_xcc_id() { return (unsigned)__builtin_amdgcn_s_getreg((3 << 11) | 20) & 0xFu; }
#define XB_SPIN(cond, bar) do { unsigned _sp = 0; while (cond) { __builtin_amdgcn_s_sleep(1); \
    if ((++_sp & 255u) == 0u) { if (xb_ld(&(bar)[XB_TMO])) break; if (_sp > XB_SPIN_CAP) { atomicAdd(&(bar)[XB_TMO], 1u); break; } } } } while (0)

struct XcdBarrier {
    unsigned* bar; unsigned x;
    volatile LAS unsigned* st;
};

__device__ __forceinline__ XcdBarrier xcd_barrier_post(unsigned* bar, volatile LAS unsigned* st) {
    XcdBarrier b; b.bar = bar; b.x = xb_xcc_id(); b.st = st;
    if (threadIdx.x == 0) (void)xb_add(&bar[XB_XCNT(b.x)], 1u);
    return b;
}
__device__ __forceinline__ void xcd_barrier_complete(unsigned* bar, unsigned x, unsigned& nloc, unsigned& nx) {
    const unsigned G = gridDim.x * gridDim.y * gridDim.z;
    unsigned sum, cnt, mine, sp = 0u;
    for (;;) {
        sum = 0u; cnt = 0u; mine = 0u;
#pragma unroll
        for (unsigned j = 0; j < 16; ++j) { const unsigned c = xb_ld(&bar[XB_XCNT(j)]); sum += c; cnt += (c > 0u) ? 1u : 0u; mine = (j == x) ? c : mine; }
        if (sum == G) break;
        __builtin_amdgcn_s_sleep(1);
        if ((++sp & 255u) == 0u) { if (xb_ld(&bar[XB_TMO])) break; if (sp > XB_SPIN_CAP) { atomicAdd(&bar[XB_TMO], 1u); break; } }
    }
    nloc = mine > 0u ? mine : 1u; nx = cnt > 0u ? cnt : 1u;
}

__device__ __forceinline__ void xcd_barrier(const XcdBarrier& b) {
    asm volatile("s_waitcnt vmcnt(0)" ::: "memory");
    __syncthreads();
    if (threadIdx.x == 0) {
        unsigned* bar = b.bar;
        __builtin_amdgcn_s_waitcnt(0);
        unsigned nloc = b.st[0], nx = b.st[1];
        if (nloc == 0u) { xcd_barrier_complete(bar, b.x, nloc, nx); b.st[0] = nloc; b.st[1] = nx; }
        const unsigned old = xb_add(&bar[XB_XSUB(b.x)], 1u);
        const unsigned gen = old / nloc;
        if (old + 1u == (gen + 1u) * nloc) {
            __builtin_amdgcn_fence(__ATOMIC_RELEASE, "agent");
            asm volatile("s_waitcnt vmcnt(0)" ::: "memory");
            const unsigned og = xb_add(&bar[XB_TOP], 1u);
            const unsigned tg = og / nx;
            if (og + 1u == (tg + 1u) * nx) xb_add(&bar[XB_TOPGEN], 1u);
            else XB_SPIN(xb_ld(&bar[XB_TOPGEN]) == tg, bar);
            __builtin_amdgcn_fence(__ATOMIC_ACQUIRE, "agent");
            xb_add(&bar[XB_XGEN(b.x)], 1u);
            asm volatile("s_waitcnt vmcnt(0)" ::: "memory");
        } else {
            XB_SPIN(xb_ld(&bar[XB_XGEN(b.x)]) == gen, bar);
            __builtin_amdgcn_fence(__ATOMIC_ACQUIRE, "agent");
            asm volatile("s_waitcnt vmcnt(0)" ::: "memory");
        }
    }
    __syncthreads();
}

__device__ __forceinline__ void xcd_arrive(const XcdBarrier& b, volatile LAS unsigned* sx) {
    asm volatile("s_waitcnt vmcnt(0)" ::: "memory");
    __syncthreads();
    if (threadIdx.x == 0) {
        unsigned* bar = b.bar;
        __builtin_amdgcn_s_waitcnt(0);
        unsigned nloc = b.st[0], nx = b.st[1];
        if (nloc == 0u) { xcd_barrier_complete(bar, b.x, nloc, nx); b.st[0] = nloc; b.st[1] = nx; }
        const unsigned old = xb_add(&bar[XB_XSUB(b.x)], 1u);
        const unsigned gen = old / nloc;
        unsigned leader = 0u, key = gen;
        if (old + 1u == (gen + 1u) * nloc) {
            leader = 1u;
            __builtin_amdgcn_fence(__ATOMIC_RELEASE, "agent");
            asm volatile("s_waitcnt vmcnt(0)" ::: "memory");
            const unsigned og = xb_add(&bar[XB_TOP], 1u);
            const unsigned tg = og / nx; key = tg;
            if (og + 1u == (tg + 1u) * nx) xb_add(&bar[XB_TOPGEN], 1u);
        }
        sx[0] = leader; sx[1] = key;
    }
}
__device__ __forceinline__ void xcd_wait(const XcdBarrier& b, volatile LAS unsigned* sx) {
    if (threadIdx.x == 0) {
        unsigned* bar = b.bar;
        const unsigned leader = sx[0], key = sx[1];
        if (leader) {
            XB_SPIN(xb_ld(&bar[XB_TOPGEN]) == key, bar);
            __builtin_amdgcn_fence(__ATOMIC_ACQUIRE, "agent");
            xb_add(&bar[XB_XGEN(b.x)], 1u);
            asm volatile("s_waitcnt vmcnt(0)" ::: "memory");
        } else {
            XB_SPIN(xb_ld(&bar[XB_XGEN(b.x)]) == key, bar);
            __builtin_amdgcn_fence(__ATOMIC_ACQUIRE, "agent");
            asm volatile("s_waitcnt vmcnt(0)" ::: "memory");
        }
    }
    __syncthreads();
}

constexpr int NWAVES = 8;
constexpr int T_ = 16384, SEQ = 4096, DM = 1024, NPROJ = 2304, INC = 2312;
constexpr int PJ_K = 512, PJ_V = 640, PJ_Z = 768, PJ_XBC = 1280;
constexpr float EPS = 1e-6f;
constexpr size_t MiB = 1u << 20;
constexpr size_t WS_CTL = 0, CTL_ZERO_BYTES = 1 * MiB;
constexpr size_t WS_SMALL = 1 * MiB;
constexpr size_t WS_WIN = 2 * MiB, WS_WOUT = 7 * MiB, WS_WQ = 9 * MiB;
constexpr size_t WS_ED = 13 * MiB, WS_EU = 29 * MiB;
constexpr size_t WS_XN = 77 * MiB;
constexpr size_t WS_PROJ = 109 * MiB;
constexpr size_t WS_ST = 181 * MiB;
constexpr size_t WS_IDX = 213 * MiB, WS_GATE = 221 * MiB, WS_SSQ = 229 * MiB, WS_END = 230 * MiB;
constexpr size_t DO_Y = 0, DO_DT = 41 * MiB;
constexpr size_t WS_CC = 230 * MiB, WS_DT = 238 * MiB, WS_EA = 239 * MiB, WS_CDEC = 240 * MiB, WS_PREV = WS_IDX;
constexpr size_t DO_YPF = 0, DO_YPLAIN = 32 * MiB;
constexpr size_t WS_PART = WS_PROJ;
constexpr size_t WS_H8 = WS_XN, WS_HS = WS_DT;
constexpr size_t WS_SSQ2 = WS_EA;
constexpr int CW_BAR = 4096, CW_RANK = 8192;
constexpr int RING_OFF = 0, RING_BYTES = 147456, LDSCTL_OFF = RING_BYTES, MISC_OFF = LDSCTL_OFF + 320, LDS_BYTES = 163840;

__constant__ unsigned char c_bucket[128] = {0, 1, 2, 3, 4, 5, 6, 7, 8, 9, 10, 11, 12, 13, 14, 15, 16, 16, 16, 17, 17, 18, 18, 18, 19, 19, 19, 20, 20, 20, 20, 21, 21, 21, 21, 22, 22, 22, 22, 22, 23, 23, 23, 23, 23, 23, 24, 24, 24, 24, 24, 24, 25, 25, 25, 25, 25, 25, 25, 26, 26, 26, 26, 26, 26, 26, 26, 27, 27, 27, 27, 27, 27, 27, 27, 27, 27, 28, 28, 28, 28, 28, 28, 28, 28, 28, 28, 29, 29, 29, 29, 29, 29, 29, 29, 29, 29, 29, 29, 30, 30, 30, 30, 30, 30, 30, 30, 30, 30, 30, 30, 30, 30, 31, 31, 31, 31, 31, 31, 31, 31, 31, 31, 31, 31, 31, 31, 31};

typedef float v16f __attribute__((ext_vector_type(16)));
typedef float v32f __attribute__((ext_vector_type(32)));
typedef unsigned v6u __attribute__((ext_vector_type(6)));
typedef _Float16 v32h __attribute__((ext_vector_type(32)));
struct Frame {
    LAS unsigned char* lds;
    volatile LAS unsigned* MISC;
    gu32* ctl;
    int wave, vcu, G;
};
__device__ __forceinline__ int lane_id() { int l; asm volatile("v_mbcnt_lo_u32_b32 %0, -1, 0\n\tv_mbcnt_hi_u32_b32 %0, -1, %0" : "=v"(l)); return l; }
__device__ __forceinline__ int opq(int x) { asm volatile("" : "+v"(x)); return x; }
template <int M> __device__ __forceinline__ float swz_xor(float v) { return __int_as_float(__builtin_amdgcn_ds_swizzle(__float_as_int(v), (M << 10) | 0x1F)); }
__device__ __forceinline__ float sum_halves(float v) { const auto r = __builtin_amdgcn_permlane32_swap(__float_as_uint(v), __float_as_uint(v), false, false); return __uint_as_float(r[0]) + __uint_as_float(r[1]); }
__device__ __forceinline__ float max_halves(float v) { const auto r = __builtin_amdgcn_permlane32_swap(__float_as_uint(v), __float_as_uint(v), false, false); return fmaxf(__uint_as_float(r[0]), __uint_as_float(r[1])); }
__device__ __forceinline__ int imax_halves(int v) { const auto r = __builtin_amdgcn_permlane32_swap((unsigned)v, (unsigned)v, false, false); return max((int)r[0], (int)r[1]); }
__device__ __forceinline__ float wave_sum(float v) {
    v += swz_xor<1>(v); v += swz_xor<2>(v); v += swz_xor<4>(v); v += swz_xor<8>(v); v += swz_xor<16>(v);
    return sum_halves(v);
}
__device__ __forceinline__ float bf2f(unsigned short b) { return __uint_as_float((unsigned)b << 16); }
__device__ __forceinline__ float bflo(unsigned w) { return __uint_as_float(w << 16); }
__device__ __forceinline__ float bfhi(unsigned w) { return __uint_as_float(w & 0xffff0000u); }
__device__ __forceinline__ float silu_f(float x) { return x / (1.f + __expf(-x)); }

__device__ __forceinline__ void p0_transpose_item(const float* W, int ldw, int K, int nblk, bf16* WT, const float* kscale, LAS float* scr, int item, int lane) {
    const int kb = item / nblk, nb = item % nblk, k0 = 64 * kb, n0 = 32 * nb;
#pragma unroll 8
    for (int i = 0; i < 32; ++i) { const int kk = 2 * i + (lane >> 5); float v = W[(size_t)(k0 + kk) * ldw + n0 + (lane & 31)]; if (kscale) v *= kscale[k0 + kk]; scr[kk * 33 + (lane & 31)] = v; }
    LDS_WAIT(); asm volatile("" ::: "memory");
    const int c = lane & 7;
#pragma unroll
    for (int j = 0; j < 4; ++j) { const int n = (lane >> 3) + 8 * j; const LAS float* s = scr + (8 * c) * 33 + n;
        v4u o; o.x = pk2(s[0 * 33], s[1 * 33]); o.y = pk2(s[2 * 33], s[3 * 33]); o.z = pk2(s[4 * 33], s[5 * 33]); o.w = pk2(s[6 * 33], s[7 * 33]);
        *(GAS v4u*)(WT + (size_t)(n0 + n) * K + k0 + 8 * c) = o; }
    LDS_WAIT(); asm volatile("" ::: "memory");
}
struct Ptrs {
    const float *x, *norm_mix, *w_in, *conv_w, *conv_b, *dt_bias, *a_log, *d_skip, *ssd_norm_w, *sinks, *w_out, *rel_bias, *norm_ffn, *w_query, *sk1, *sk2, *e_down, *e_up, *norm_final;
    float* out; unsigned char* ws;
};
constexpr int Q_SPLIT = 0;
__device__ __forceinline__ unsigned pack4_i8(float a, float b, float c, float d) {
    const int ia = __float2int_rn(a), ib = __float2int_rn(b), ic = __float2int_rn(c), id = __float2int_rn(d);
    return (unsigned)(ia & 0xff) | ((unsigned)(ib & 0xff) << 8) | ((unsigned)(ic & 0xff) << 16) | ((unsigned)(id & 0xff) << 24);
}
__device__ __forceinline__ unsigned pack8_i4(const float* v, float inv) {
    unsigned o = 0u;
#pragma unroll
    for (int i = 0; i < 8; ++i) { int q = __float2int_rn(v[i] * inv); q = q < -7 ? -7 : (q > 7 ? 7 : q); o |= ((unsigned)q & 15u) << (4 * i); }
    return o;
}
__device__ __forceinline__ void quant_fp8s(const Ptrs& P, int lane_, int r_lo, int r_hi, int w, int nw) {
    float* SC = (float*)(P.ws + WS_SMALL);
    int row = r_lo + w;
    if (row >= r_hi) return;
    float4 nx[4];
#pragma unroll
    for (int q = 0; q < 4; ++q) nx[q] = ((const float4*)(P.e_down + (size_t)(row & 16383) * DM) + 4 * lane_)[q];
    float4 w4[4];
#pragma unroll
    for (int q = 0; q < 4; ++q) w4[q] = ((const float4*)P.norm_ffn)[4 * lane_ + q];
    for (; row < r_hi; row += nw) {
        const int e = row & 16383;
        float v[16];
#pragma unroll
        for (int q = 0; q < 4; ++q) { const float4 t = nx[q]; v[4 * q] = t.x * w4[q].x; v[4 * q + 1] = t.y * w4[q].y; v[4 * q + 2] = t.z * w4[q].z; v[4 * q + 3] = t.w * w4[q].w; }
        { const int rn = (row + nw < r_hi) ? row + nw : row;
#pragma unroll
          for (int q = 0; q < 4; ++q) nx[q] = ((const float4*)(P.e_down + (size_t)(rn & 16383) * DM) + 4 * lane_)[q]; }
        float ss = 0.f;
#pragma unroll
        for (int q = 0; q < 16; ++q) ss = fmaf(v[q], v[q], ss);
        const float sc = fmaxf(2.5f * sqrtf(wave_sum(ss) * (1.f / 1024.f)) * (1.f / 7.f), 1e-30f);
        const float inv = 1.f / sc;
        const unsigned long long o = (unsigned long long)pack8_i4(v, inv) | ((unsigned long long)pack8_i4(v + 8, inv) << 32);
        *(unsigned long long*)(P.ws + WS_ED + ((size_t)(lane_ >> 4) * 16384 + e) * 128 + (lane_ & 15) * 8) = o;
        if (lane_ == 0) SC[row] = sc;
    }
}
typedef float f32x2q __attribute__((ext_vector_type(2)));
__device__ __forceinline__ void quant_fp6u(const Ptrs& P, int lane_, int q_lo, int q_hi, int w, int nw) {
    float* SC = (float*)(P.ws + WS_SMALL); const int l31 = lane_ & 31, hf = lane_ >> 5;
    int q = q_lo + w;
    if (q >= q_hi) return;
    float4 nx[8];
#pragma unroll
    for (int k = 0; k < 8; ++k) nx[k] = ((const float4*)(P.e_up + (size_t)(2 * q + hf) * DM) + 8 * l31)[k];
    for (; q < q_hi; q += nw) {
        const int e = 2 * q + hf, row = 16384 + e;
        float v[32];
#pragma unroll
        for (int k = 0; k < 8; ++k) { const float4 t = nx[k]; v[4 * k] = t.x; v[4 * k + 1] = t.y; v[4 * k + 2] = t.z; v[4 * k + 3] = t.w; }
        { const int qn = (q + nw < q_hi) ? q + nw : q;
#pragma unroll
          for (int k = 0; k < 8; ++k) nx[k] = ((const float4*)(P.e_up + (size_t)(2 * qn + hf) * DM) + 8 * l31)[k]; }
        float am = 0.f;
#pragma unroll
        for (int k = 0; k < 32; ++k) am = fmaxf(am, fabsf(v[k]));
        am = fmaxf(am, swz_xor<1>(am)); am = fmaxf(am, swz_xor<2>(am)); am = fmaxf(am, swz_xor<4>(am)); am = fmaxf(am, swz_xor<8>(am)); am = fmaxf(am, swz_xor<16>(am));
        am = fmaxf(am, 1e-30f);
        const float inv = 6.0f / am;
        unsigned pk[4];
#pragma unroll
        for (int wd = 0; wd < 4; ++wd) { unsigned p4 = 0u;
            p4 = __builtin_amdgcn_cvt_scalef32_pk_fp4_f32(p4, v[8 * wd] * inv, v[8 * wd + 1] * inv, 1.0f, 0);
            p4 = __builtin_amdgcn_cvt_scalef32_pk_fp4_f32(p4, v[8 * wd + 2] * inv, v[8 * wd + 3] * inv, 1.0f, 1);
            p4 = __builtin_amdgcn_cvt_scalef32_pk_fp4_f32(p4, v[8 * wd + 4] * inv, v[8 * wd + 5] * inv, 1.0f, 2);
            p4 = __builtin_amdgcn_cvt_scalef32_pk_fp4_f32(p4, v[8 * wd + 6] * inv, v[8 * wd + 7] * inv, 1.0f, 3);
            pk[wd] = p4; }
        *(v4u*)(P.ws + WS_EU + (size_t)e * 512 + 16 * l31) = (v4u){pk[0], pk[1], pk[2], pk[3]};
        if (l31 == 0) SC[row] = am * (1.f / 6.0f);
    }
}
__device__ __forceinline__ void p0_prologue(Frame& F0, const Ptrs& P) {
    const Frame& F = F0; const int lane_ = lane_id(), tid_ = F.wave * 64 + lane_;
    LAS float* scr = (LAS float*)(F.lds + RING_OFF + F.wave * 16384);
    const int gw = F.vcu * NWAVES + F.wave, NGW = F.G * NWAVES;
    bf16* Win_t = (bf16*)(P.ws + WS_WIN); bf16* Wout_t = (bf16*)(P.ws + WS_WOUT); bf16* Wq_t = (bf16*)(P.ws + WS_WQ);
    constexpr int I_IN = 16 * 72;
    for (int it = gw; it < I_IN; it += NGW) p0_transpose_item(P.w_in, INC, DM, 72, Win_t, nullptr, scr, it, lane_);
    (void)Wout_t; (void)Wq_t;
    __syncthreads();
    { LAS float* Wdt = (LAS float*)(F.lds + RING_OFF);
      for (int i = tid_; i < 8192; i += 512) Wdt[i] = P.w_in[(size_t)(i >> 3) * INC + NPROJ + (i & 7)];
      __syncthreads();
      bf16* XN = (bf16*)(P.ws + WS_XN); float* DT = (float*)(P.ws + WS_DT);
      for (int m0 = gw * 2; m0 < T_; m0 += NGW * 2) {
        float4 xv[2][4];
#pragma unroll
        for (int rr = 0; rr < 2; ++rr) { const float4* xr = (const float4*)(P.x + (size_t)(m0 + rr) * DM);
#pragma unroll
            for (int j = 0; j < 4; ++j) xv[rr][j] = xr[j * 64 + lane_]; }
#pragma unroll
        for (int rr = 0; rr < 2; ++rr) { const int m = m0 + rr;
        float4 v[4]; float s = 0.f;
#pragma unroll
        for (int j = 0; j < 4; ++j) { v[j] = xv[rr][j]; s += v[j].x * v[j].x + v[j].y * v[j].y + v[j].z * v[j].z + v[j].w * v[j].w; }
        const float r = rsqrtf(wave_sum(s) * (1.f / 1024.f) + EPS);
        float d8[8];
#pragma unroll
        for (int q = 0; q < 8; ++q) d8[q] = 0.f;
        unsigned long long* o8 = (unsigned long long*)(XN + (size_t)m * DM);
#pragma unroll
        for (int j = 0; j < 4; ++j) { const float4 w = ((const float4*)P.norm_mix)[j * 64 + lane_];
            const float e0 = v[j].x * r * w.x, e1 = v[j].y * r * w.y, e2 = v[j].z * r * w.z, e3 = v[j].w * r * w.w;
            o8[j * 64 + lane_] = (unsigned long long)pk2(e0, e1) | ((unsigned long long)pk2(e2, e3) << 32);
            const float ev[4] = {e0, e1, e2, e3};
#pragma unroll
            for (int e = 0; e < 4; ++e) { const LAS f32x4* wr = (const LAS f32x4*)(Wdt + (size_t)(j * 256 + lane_ * 4 + e) * 8); const f32x4 w0 = wr[0], w1 = wr[1];
                d8[0] += ev[e] * w0.x; d8[1] += ev[e] * w0.y; d8[2] += ev[e] * w0.z; d8[3] += ev[e] * w0.w; d8[4] += ev[e] * w1.x; d8[5] += ev[e] * w1.y; d8[6] += ev[e] * w1.z; d8[7] += ev[e] * w1.w; } }
#pragma unroll
        for (int q = 0; q < 8; ++q) d8[q] = wave_sum(d8[q]);
        if (lane_ == 0) { float4* dp = (float4*)(DT + (size_t)m * 8); dp[0] = make_float4(d8[0], d8[1], d8[2], d8[3]); dp[1] = make_float4(d8[4], d8[5], d8[6], d8[7]); }
        }
      }
      __syncthreads(); }
}

__device__ __forceinline__ void p1_slack(Frame& F0, const Ptrs& P, int w, int nw) {
    const Frame& F = F0; const int lane_ = lane_id();
    LAS float* scr = (LAS float*)(F.lds + RING_OFF + F.wave * 16384);
    bf16* Wout_t = (bf16*)(P.ws + WS_WOUT); bf16* Wq_t = (bf16*)(P.ws + WS_WQ);
    constexpr int I_OUT = 16 * 32, I_Q = 16 * 64;
    for (int it = w; it < I_OUT + I_Q; it += nw) {
        if (it < I_OUT) p0_transpose_item(P.w_out, DM, DM, 32, Wout_t, nullptr, scr, it, lane_);
        else p0_transpose_item(P.w_query, 2048, DM, 64, Wq_t, P.norm_ffn, scr, it - I_OUT, lane_);
    }
    quant_fp6u(P, lane_, 0, 8192, w, nw);
    quant_fp8s(P, lane_, 0, 16384, w, nw);
}
struct EpiResH {
    static constexpr bool PERM = false, AFTER_DRAIN = false;
    const float* X; bf16* HB; float* SSQ;
    __device__ __forceinline__ void operator()(const pg8::f32x4 (&acc)[2][2][4][2], const pg8::Unit& u, int wr, int wc, int fr, int fq) const {
        const int row0 = u.pm * 256 + wr * 64 + fr, col0 = u.pn * 256 + wc * 32 + 4 * fq;
#pragma unroll
        for (int ai = 0; ai < 2; ++ai)
#pragma unroll
            for (int m = 0; m < 4; ++m) { const int row = row0 + ai * 128 + m * 16; float ss = 0.f;
#pragma unroll
                for (int bj = 0; bj < 2; ++bj)
#pragma unroll
                    for (int n = 0; n < 2; ++n) { const size_t off = (size_t)row * DM + col0 + bj * 128 + n * 16;
                        const pg8::f32x4 h = acc[ai][bj][m][n] + *(const pg8::f32x4*)(X + off);
                        ss += h[0] * h[0] + h[1] * h[1] + h[2] * h[2] + h[3] * h[3];
                        *(unsigned long long*)(HB + off) = (unsigned long long)pk2(h[0], h[1]) | ((unsigned long long)pk2(h[2], h[3]) << 32); }
                ss += swz_xor<16>(ss); ss = sum_halves(ss);
                if (fq == 0) SSQ[(size_t)row * 16 + u.pn * 4 + wc] = ss; }
    }
};

typedef float f32x16 __attribute__((ext_vector_type(16)));
typedef short s16x4 __attribute__((ext_vector_type(4)));
typedef float f32x2_t __attribute__((ext_vector_type(2)));
typedef __bf16 bf16x2_t __attribute__((ext_vector_type(2)));
#define MFMA32(a, b, c) __builtin_amdgcn_mfma_f32_32x32x16_bf16((a), (b), (c), 0, 0, 0)
__device__ __forceinline__ int crow(int reg, int h) { return (reg & 3) + 8 * (reg >> 2) + 4 * h; }
__device__ __forceinline__ unsigned cvtpk(float lo, float hi) { f32x2_t v = {lo, hi}; bf16x2_t b = __builtin_convertvector(v, bf16x2_t); return __builtin_bit_cast(unsigned, b); }
__device__ __forceinline__ bf16x8 pack8(const f32x16& x, int s) {
    v4u p; p.x = cvtpk(x[8 * s], x[8 * s + 1]); p.y = cvtpk(x[8 * s + 2], x[8 * s + 3]); p.z = cvtpk(x[8 * s + 4], x[8 * s + 5]); p.w = cvtpk(x[8 * s + 6], x[8 * s + 7]);
    return __builtin_bit_cast(bf16x8, p);
}
constexpr float LOG2E = 1.4426950408889634f;
constexpr int LDP = 136;
constexpr int S1_XT = 0, S1_XTW = 17408, S1_BSN = 34816, S1_CLN = 69632, S1_BNL = 104448, S1_F32 = 139264;

__device__ __forceinline__ float silu_fast(float x) { return x * __builtin_amdgcn_rcpf(1.f + __builtin_amdgcn_exp2f(-x * LOG2E)); }
__device__ __forceinline__ int swz_t(int row, int l) { return row * LDP + ((((l >> 3) ^ (row >> 3)) & 7) | ((l >> 3) & 8)) * 8 + (l & 7); }
#define S1_CONV8(A_, IT_) do { _Pragma("unroll") for (int e_ = 0; e_ < 8; ++e_) A_[e_] = bias[e_]; \
        _Pragma("unroll") for (int j_ = 0; j_ < 4; ++j_) { const v4u rw_ = raw[(IT_) + j_]; \
            A_[0] += w[j_][0] * bflo(rw_.x); A_[1] += w[j_][1] * bfhi(rw_.x); A_[2] += w[j_][2] * bflo(rw_.y); A_[3] += w[j_][3] * bfhi(rw_.y); \
            A_[4] += w[j_][4] * bflo(rw_.z); A_[5] += w[j_][5] * bfhi(rw_.z); A_[6] += w[j_][6] * bflo(rw_.w); A_[7] += w[j_][7] * bfhi(rw_.w); } \
        _Pragma("unroll") for (int e_ = 0; e_ < 8; ++e_) A_[e_] = silu_fast(A_[e_]); } while (0)
#define S1_LOADW(CHB_) do { _Pragma("unroll") for (int j_ = 0; j_ < 4; ++j_) { const float4 w0_ = *(const float4*)(P.conv_w + j_ * 1024 + (CHB_)), w1_ = *(const float4*)(P.conv_w + j_ * 1024 + (CHB_) + 4); \
            w[j_][0] = w0_.x; w[j_][1] = w0_.y; w[j_][2] = w0_.z; w[j_][3] = w0_.w; w[j_][4] = w1_.x; w[j_][5] = w1_.y; w[j_][6] = w1_.z; w[j_][7] = w1_.w; } \
        { const float4 b0_ = *(const float4*)(P.conv_b + (CHB_)), b1_ = *(const float4*)(P.conv_b + (CHB_) + 4); \
          bias[0] = b0_.x; bias[1] = b0_.y; bias[2] = b0_.z; bias[3] = b0_.w; bias[4] = b1_.x; bias[5] = b1_.y; bias[6] = b1_.z; bias[7] = b1_.w; } } while (0)
__device__ __forceinline__ void ssd_s1(Frame& F, const Ptrs& P) {
    const bf16* PROJ = (const bf16*)(P.ws + WS_PROJ); const float* DT = (const float*)(P.ws + WS_DT);
    float* EA = (float*)(P.ws + WS_EA); float* CDEC = (float*)(P.ws + WS_CDEC); bf16* CC = (bf16*)(P.ws + WS_CC);
    unsigned* ST = (unsigned*)(P.ws + WS_ST); unsigned* YPF = (unsigned*)((char*)P.out + DO_YPF);
    LAS unsigned char* L = F.lds + RING_OFF;
    LAS bf16* Xt = (LAS bf16*)(L + S1_XT); LAS bf16* Xtw = (LAS bf16*)(L + S1_XTW); LAS bf16* Bsn = (LAS bf16*)(L + S1_BSN); LAS bf16* Cln = (LAS bf16*)(L + S1_CLN); LAS bf16* Bnl = (LAS bf16*)(L + S1_BNL);
    LAS float* f32base = (LAS float*)(L + S1_F32);
    const int lane = lane_id(); const int tid_ = F.wave * 64 + lane;
    for (int ug = F.vcu; ug < 256; ug += F.G) {
        const int grp = ug & 1, c = (ug >> 1) & 31, b = ug >> 6, t0 = b * SEQ + c * 128;
        __syncthreads();
        if (F.wave < 4) {
            const int h = 4 * grp + F.wave, us = (b * 32 + c) * 8 + h;
            const float A = -__expf(P.a_log[h]), dtb = P.dt_bias[h];
            const int ln = opq(lane_id());
            LAS float* acum2 = f32base + F.wave * 384; LAS float* wv = acum2 + 128; LAS float* wend = wv + 128;
            const float x0 = DT[(size_t)(t0 + 2 * ln) * 8 + h] + dtb, x1 = DT[(size_t)(t0 + 2 * ln + 1) * 8 + h] + dtb;
            const float dt0 = fmaxf(x0, 0.f) + log1pf(__expf(-fabsf(x0))), dt1 = fmaxf(x1, 0.f) + log1pf(__expf(-fabsf(x1)));
            const float a0 = dt0 * A, a1 = dt1 * A;
            float s = a0 + a1;
#pragma unroll
            for (int o = 1; o < 64; o <<= 1) { const float v = __int_as_float(__builtin_amdgcn_ds_bpermute((ln - o) * 4, __float_as_int(s))); if (ln >= o) s += v; }
            const float ac1 = s, ac0 = s - a1, tot = __uint_as_float(__builtin_amdgcn_readlane(__float_as_uint(s), 63));
            acum2[2 * ln] = ac0 * LOG2E; acum2[2 * ln + 1] = ac1 * LOG2E;
            wv[2 * ln] = log2f(dt0) - ac0 * LOG2E; wv[2 * ln + 1] = log2f(dt1) - ac1 * LOG2E;
            wend[2 * ln] = dt0 * exp2f((tot - ac0) * LOG2E); wend[2 * ln + 1] = dt1 * exp2f((tot - ac1) * LOG2E);
            EA[(size_t)(t0 + 2 * ln) * 8 + h] = exp2f(ac0 * LOG2E); EA[(size_t)(t0 + 2 * ln + 1) * 8 + h] = exp2f(ac1 * LOG2E);
            if (ln == 0) CDEC[us] = exp2f(tot * LOG2E);
        }
        __syncthreads();
#pragma unroll 1
        for (int hi = 0; hi < 4; ++hi) {
            const int h = 4 * grp + hi, u = (b * 32 + c) * 8 + h;
            const float Dh = P.d_skip[h];
            const LAS float* acum2 = f32base + hi * 384; const LAS float* wv = acum2 + 128; const LAS float* wend = wv + 128;
            const int tidc = opq(tid_);
            if (hi == 0) {
                if (tidc < 440) {
                    const int cg = tidc % 40, sg = tidc / 40, l0 = 12 * sg;
                    int chb; if (cg < 8) chb = h * 64 + cg * 8; else if (cg < 24) chb = 512 + grp * 128 + (cg - 8) * 8; else chb = 768 + grp * 128 + (cg - 24) * 8;
                    v4u raw[15];
#pragma unroll
                    for (int q = 0; q < 15; ++q) { const int ss = c * 128 + l0 - 3 + q; raw[q] = (v4u){0u, 0u, 0u, 0u};
                        if (ss >= 0 && l0 - 3 + q < 128) raw[q] = *(const v4u*)(PROJ + (size_t)(b * SEQ + ss) * NPROJ + PJ_XBC + chb); }
                    float w[4][8], bias[8]; S1_LOADW(chb);
#pragma unroll
                    for (int it = 0; it < 12; it += 2) {
                        const int l = l0 + it;
                        if (l < 128) {
                            float a[8], a2[8]; S1_CONV8(a, it); S1_CONV8(a2, it + 1);
                            if (cg < 8) { const float we = wend[l], we2 = wend[l + 1];
#pragma unroll
                                for (int e = 0; e < 8; ++e) { *(LAS unsigned*)(Xt + swz_t(cg * 8 + e, l)) = cvtpk(a[e], a2[e]); *(LAS unsigned*)(Xtw + swz_t(cg * 8 + e, l)) = cvtpk(a[e] * we, a2[e] * we2); }
                            } else {
                                v4u o, o2; o.x = cvtpk(a[0], a[1]); o.y = cvtpk(a[2], a[3]); o.z = cvtpk(a[4], a[5]); o.w = cvtpk(a[6], a[7]);
                                o2.x = cvtpk(a2[0], a2[1]); o2.y = cvtpk(a2[2], a2[3]); o2.z = cvtpk(a2[4], a2[5]); o2.w = cvtpk(a2[6], a2[7]);
                                if (cg < 24) { const int n0 = (cg - 8) * 8; *(LAS v4u*)(Bsn + l * LDP + n0) = o; *(LAS v4u*)(Bsn + (l + 1) * LDP + n0) = o2;
#pragma unroll
                                    for (int e = 0; e < 8; ++e) *(LAS unsigned*)(Bnl + swz_t(n0 + e, l)) = cvtpk(a[e], a2[e]);
                                } else { const int n0 = (cg - 24) * 8; *(LAS v4u*)(Cln + l * LDP + n0) = o; *(LAS v4u*)(Cln + (l + 1) * LDP + n0) = o2;
                                    *(v4u*)(CC + (size_t)(t0 + l) * 256 + grp * 128 + n0) = o; *(v4u*)(CC + (size_t)(t0 + l + 1) * 256 + grp * 128 + n0) = o2; }
                            }
                        }
                    }
                }
            } else {
                const int cg = tidc & 7, l = 2 * (tidc >> 3), chb = h * 64 + cg * 8;
                v4u raw[5];
#pragma unroll
                for (int q = 0; q < 5; ++q) { const int ss = c * 128 + l - 3 + q; raw[q] = (v4u){0u, 0u, 0u, 0u};
                    if (ss >= 0) raw[q] = *(const v4u*)(PROJ + (size_t)(b * SEQ + ss) * NPROJ + PJ_XBC + chb); }
                float w[4][8], bias[8]; S1_LOADW(chb);
                float a[8], a2[8]; S1_CONV8(a, 0); S1_CONV8(a2, 1);
                const float we = wend[l], we2 = wend[l + 1];
#pragma unroll
                for (int e = 0; e < 8; ++e) { *(LAS unsigned*)(Xt + swz_t(cg * 8 + e, l)) = cvtpk(a[e], a2[e]); *(LAS unsigned*)(Xtw + swz_t(cg * 8 + e, l)) = cvtpk(a[e] * we, a2[e] * we2); }
            }
            __syncthreads();
            const int ln3 = opq(lane), r = ln3 & 31, hh = ln3 >> 5;
            if (F.wave < 4) {
                const int pt = F.wave >> 1;
#pragma unroll 1
                for (int q = 0; q < 2; ++q) {
                    const int lt = (F.wave & 1) ? (1 + q) : (3 * q);
                    f32x16 yacc;
#pragma unroll
                    for (int i = 0; i < 16; ++i) yacc[i] = 0.f;
                    const float al = acum2[32 * lt + r];
                    bf16x8 cf[8];
#pragma unroll
                    for (int kk = 0; kk < 8; ++kk) cf[kk] = *(const LAS bf16x8*)(Cln + (32 * lt + r) * LDP + 16 * kk + 8 * hh);
#pragma unroll 1
                    for (int st = 0; st <= lt; ++st) {
                        bf16x8 bfr[8];
#pragma unroll
                        for (int kk = 0; kk < 8; ++kk) bfr[kk] = *(const LAS bf16x8*)(Bsn + (32 * st + r) * LDP + 16 * kk + 8 * hh);
                        f32x4 wq[4];
#pragma unroll
                        for (int g4 = 0; g4 < 4; ++g4) wq[g4] = *(const LAS f32x4*)(wv + 32 * st + 8 * g4 + 4 * hh);
                        s16x4 xlo[2], xhi[2];
#pragma unroll
                        for (int sg = 0; sg < 2; ++sg) { const int prow = 32 * pt + r, lb = 32 * st + 16 * sg;
                            xlo[sg] = *(const LAS s16x4*)(Xt + swz_t(prow, lb) + 4 * hh); xhi[sg] = *(const LAS s16x4*)(Xt + swz_t(prow, lb + 8) + 4 * hh); }
                        __builtin_amdgcn_sched_barrier(0);
                        f32x16 macc;
#pragma unroll
                        for (int i = 0; i < 16; ++i) macc[i] = 0.f;
#pragma unroll
                        for (int kk = 0; kk < 8; ++kk) macc = MFMA32(bfr[kk], cf[kk], macc);
#pragma unroll
                        for (int i = 0; i < 16; ++i) { const int sl = crow(i, hh);
                            float f = __builtin_amdgcn_exp2f(al + wq[i >> 2][i & 3]);
                            if (st == lt && sl > r) f = 0.f;
                            macc[i] *= f; }
#pragma unroll
                        for (int sg = 0; sg < 2; ++sg) {
                            const bf16x8 bfrag = pack8(macc, sg);
                            const bf16x8 afrag = __builtin_shufflevector(xlo[sg], xhi[sg], 0, 1, 2, 3, 4, 5, 6, 7);
                            yacc = MFMA32(afrag, bfrag, yacc);
                        }
                    }
                    unsigned short xs16[16];
#pragma unroll
                    for (int i = 0; i < 16; ++i) xs16[i] = *(const LAS unsigned short*)(Xt + swz_t(32 * pt + crow(i, hh), 32 * lt + r));
                    __builtin_amdgcn_sched_barrier(0);
#pragma unroll
                    for (int i = 0; i < 16; i += 2) {
                        const float y0 = yacc[i] + Dh * __uint_as_float((unsigned)xs16[i] << 16), y1 = yacc[i + 1] + Dh * __uint_as_float((unsigned)xs16[i + 1] << 16);
                        YPF[((((size_t)u * 4 + lt) * 2 + pt) * 8 + (i >> 1)) * 64 + ln3] = cvtpk(y0, y1); }
                }
            } else {
                const int nt = F.wave - 4;
#pragma unroll 1
                for (int pt = 0; pt < 2; ++pt) {
                    bf16x8 xa[8], bb[8];
#pragma unroll
                    for (int kk = 0; kk < 8; ++kk) { xa[kk] = *(const LAS bf16x8*)(Xtw + swz_t(32 * pt + r, 16 * kk + 8 * hh)); bb[kk] = *(const LAS bf16x8*)(Bnl + swz_t(32 * nt + r, 16 * kk + 8 * hh)); }
                    __builtin_amdgcn_sched_barrier(0);
                    f32x16 sacc;
#pragma unroll
                    for (int i = 0; i < 16; ++i) sacc[i] = 0.f;
#pragma unroll
                    for (int kk = 0; kk < 8; ++kk) sacc = MFMA32(xa[kk], bb[kk], sacc);
#pragma unroll
                    for (int i = 0; i < 16; i += 2) ST[((size_t)u * 32 + 16 * pt + (crow(i, hh) >> 1)) * 128 + 32 * nt + r] = cvtpk(sacc[i], sacc[i + 1]);
                }
            }
            __syncthreads();
        }
    }
}
__device__ __forceinline__ void ssd_s2(Frame& F, const Ptrs& P) {
    const unsigned* ST = (const unsigned*)(P.ws + WS_ST); const float* CDEC = (const float*)(P.ws + WS_CDEC); unsigned* PREV = (unsigned*)(P.ws + WS_PREV);
    for (int g = F.vcu * 512 + (F.wave * 64 + lane_id()); g < 65536; g += F.G * 512) {
        const int n2 = g & 63, p2 = (g >> 6) & 31, h = (g >> 11) & 7, b = g >> 14;
        uint2 st[32];
#pragma unroll
        for (int c = 0; c < 32; ++c) st[c] = *(const uint2*)(ST + ((size_t)(((b * 32 + c) * 8 + h) * 32 + p2)) * 128 + 2 * n2);
        float r00 = 0.f, r01 = 0.f, r10 = 0.f, r11 = 0.f;
#pragma unroll
        for (int c = 0; c < 32; ++c) { const size_t u = (size_t)((b * 32 + c) * 8 + h);
            PREV[((u * 64 + 2 * p2) * 128 + 2 * n2) >> 1] = cvtpk(r00, r01); PREV[((u * 64 + 2 * p2 + 1) * 128 + 2 * n2) >> 1] = cvtpk(r10, r11);
            const float d = CDEC[u];
            r00 = r00 * d + bflo(st[c].x); r10 = r10 * d + bfhi(st[c].x); r01 = r01 * d + bflo(st[c].y); r11 = r11 * d + bfhi(st[c].y); }
    }
}
__device__ __forceinline__ void ssd_s3(Frame& F, const Ptrs& P) {
    const bf16* CC = (const bf16*)(P.ws + WS_CC); const bf16* PREV = (const bf16*)(P.ws + WS_PREV); const float* EA = (const float*)(P.ws + WS_EA);
    const unsigned* YPF = (const unsigned*)((const char*)P.out + DO_YPF); const bf16* PROJ = (const bf16*)(P.ws + WS_PROJ); bf16* CAT = (bf16*)(P.ws + WS_XN);
    LAS float* red = (LAS float*)(F.lds + RING_OFF);
    const int lane = lane_id(), r = lane & 31, hh = lane >> 5, h = F.wave, grp = h >> 2;
    for (int v = F.vcu; v < 512; v += F.G) {
        const int lt = v & 3, c = (v >> 2) & 31, b = v >> 7;
        const int t = b * SEQ + c * 128 + lt * 32 + r; const size_t u = (size_t)((b * 32 + c) * 8 + h);
        unsigned ypf[2][8]; unsigned long long zz[2][4];
#pragma unroll
        for (int pt = 0; pt < 2; ++pt) {
#pragma unroll
            for (int i = 0; i < 8; ++i) ypf[pt][i] = YPF[((((size_t)u * 4 + lt) * 2 + pt) * 8 + i) * 64 + lane];
#pragma unroll
            for (int g4 = 0; g4 < 4; ++g4) zz[pt][g4] = *(const unsigned long long*)(PROJ + (size_t)t * NPROJ + PJ_Z + h * 64 + 32 * pt + 8 * g4 + 4 * hh); }
        const float ea = EA[(size_t)t * 8 + h];
        f32x16 acc[2];
#pragma unroll
        for (int i = 0; i < 16; ++i) { acc[0][i] = 0.f; acc[1][i] = 0.f; }
#pragma unroll
        for (int kk = 0; kk < 8; ++kk) {
            const bf16x8 bb = *(const bf16x8*)(CC + (size_t)t * 256 + grp * 128 + 16 * kk + 8 * hh);
#pragma unroll
            for (int pt = 0; pt < 2; ++pt) { const bf16x8 a = *(const bf16x8*)(PREV + (u * 64 + 32 * pt + r) * 128 + 16 * kk + 8 * hh); acc[pt] = MFMA32(a, bb, acc[pt]); }
        }
        float ss = 0.f;
#pragma unroll
        for (int pt = 0; pt < 2; ++pt)
#pragma unroll
            for (int g4 = 0; g4 < 4; ++g4) {
                const unsigned z01 = (unsigned)zz[pt][g4], z23 = (unsigned)(zz[pt][g4] >> 32);
                const float zf[4] = {bflo(z01), bfhi(z01), bflo(z23), bfhi(z23)};
#pragma unroll
                for (int e = 0; e < 4; ++e) { const int i = 4 * g4 + e;
                    const float y = acc[pt][i] * ea + ((i & 1) ? bfhi(ypf[pt][i >> 1]) : bflo(ypf[pt][i >> 1]));
                    const float yg = y * silu_fast(zf[e]); acc[pt][i] = yg; ss = fmaf(yg, yg, ss); }
            }
        ss = sum_halves(ss);
        if (hh == 0) red[h * 32 + r] = ss;
        __syncthreads();
        float tot = 0.f;
#pragma unroll
        for (int w = 0; w < 8; ++w) tot += red[w * 32 + r];
        const float rn = rsqrtf(tot * (1.f / 512.f) + EPS);
#pragma unroll
        for (int pt = 0; pt < 2; ++pt)
#pragma unroll
            for (int g4 = 0; g4 < 4; ++g4) { const int ch = h * 64 + 32 * pt + 8 * g4 + 4 * hh;
                const float4 w = *(const float4*)(P.ssd_norm_w + ch);
                *(unsigned long long*)(CAT + (size_t)t * DM + 512 + ch) = (unsigned long long)cvtpk(acc[pt][4 * g4] * rn * w.x, acc[pt][4 * g4 + 1] * rn * w.y) | ((unsigned long long)cvtpk(acc[pt][4 * g4 + 2] * rn * w.z, acc[pt][4 * g4 + 3] * rn * w.w) << 32); }
        __syncthreads();
    }
}
__device__ __forceinline__ float gelu_erf(float v) { return 0.5f * v * (1.f + erff(v * 0.70710678118654752f)); }
typedef float f32x2v __attribute__((ext_vector_type(2)));
#define CVT8(W, LO) __builtin_amdgcn_cvt_pk_f32_fp8((int)(W), LO)
template <int CTRL> __device__ __forceinline__ float dpp_f(float v) { return __int_as_float(__builtin_amdgcn_update_dpp(0, __float_as_int(v), CTRL, 0xF, 0xF, true)); }
__device__ __forceinline__ float sum8_dpp(float s) { s += dpp_f<0xB1>(s); s += dpp_f<0x4E>(s); s += dpp_f<0x141>(s); return s; }
struct PeerPlace { int vx, nx, rank, nloc; };
__device__ __forceinline__ PeerPlace peer_place(Frame& F) {
    __syncthreads();
    if (F.wave == 0 && lane_id() == 0) {
        unsigned* bar = (unsigned*)(F.ctl + CW_BAR); const unsigned x = xb_xcc_id();
        unsigned vx = 0, nx = 0;
        for (unsigned j = 0; j < 16; ++j) { const unsigned c = xb_ld(&bar[XB_XCNT(j)]); if (c) { if (j < x) ++vx; ++nx; } }
        const unsigned rank = xb_add((unsigned*)(F.ctl + CW_RANK) + 64 * x, 1u);
        F.MISC[10] = vx; F.MISC[11] = nx ? nx : 1u; F.MISC[12] = rank; F.MISC[13] = xb_ld(&bar[XB_XCNT(x)]);
    }
    __syncthreads();
    PeerPlace pp; pp.vx = (int)F.MISC[10]; pp.nx = (int)F.MISC[11]; pp.rank = (int)F.MISC[12]; pp.nloc = (int)F.MISC[13]; if (pp.nloc < 1) pp.nloc = 1;
    return pp;
}
__device__ __forceinline__ void h_quant_rows(Frame& F, const Ptrs& P) {
    const bf16* HB = (const bf16*)(P.ws + WS_ST); unsigned char* H8 = P.ws + WS_H8; float* HS = (float*)(P.ws + WS_HS);
    const int lane = lane_id();
    for (int t = F.vcu * NWAVES + F.wave; t < T_; t += F.G * NWAVES) {
        const v4u a0 = ((const v4u*)(HB + (size_t)t * DM))[2 * lane], a1 = ((const v4u*)(HB + (size_t)t * DM))[2 * lane + 1];
        float hf[16];
        hf[0] = bflo(a0.x); hf[1] = bfhi(a0.x); hf[2] = bflo(a0.y); hf[3] = bfhi(a0.y); hf[4] = bflo(a0.z); hf[5] = bfhi(a0.z); hf[6] = bflo(a0.w); hf[7] = bfhi(a0.w);
        hf[8] = bflo(a1.x); hf[9] = bfhi(a1.x); hf[10] = bflo(a1.y); hf[11] = bfhi(a1.y); hf[12] = bflo(a1.z); hf[13] = bfhi(a1.z); hf[14] = bflo(a1.w); hf[15] = bfhi(a1.w);
        float am = 0.f;
#pragma unroll
        for (int i = 0; i < 16; ++i) am = fmaxf(am, fabsf(hf[i]));
        am = fmaxf(am, dpp_f<0xB1>(am)); am = fmaxf(am, dpp_f<0x4E>(am)); am = fmaxf(am, dpp_f<0x141>(am)); am = fmaxf(am, dpp_f<0x140>(am)); am = fmaxf(am, 1e-30f);
        const float inv = 119.f / am;
        unsigned hi[2] = {0u, 0u}, lo[2] = {0u, 0u};
#pragma unroll
        for (int i = 0; i < 16; ++i) { const int q = __float2int_rn(hf[i] * inv); const int qh = (q + 8) >> 4, ql = q - 16 * qh;
            hi[i >> 3] |= ((unsigned)qh & 15u) << (4 * (i & 7)); lo[i >> 3] |= ((unsigned)ql & 15u) << (4 * (i & 7)); }
        unsigned char* dst = H8 + (size_t)t * 1024 + (lane >> 4) * 256 + (lane & 15) * 8;
        *(unsigned long long*)dst = (unsigned long long)hi[0] | ((unsigned long long)hi[1] << 32);
        *(unsigned long long*)(dst + 128) = (unsigned long long)lo[0] | ((unsigned long long)lo[1] << 32);
        if ((lane & 15) == 0) HS[(size_t)t * 8 + (lane >> 4)] = am * (1.f / 119.f);
    }
}
constexpr int PX_D = 16;
template <int CTRL> __device__ __forceinline__ int dpp_i(int v) { return __builtin_amdgcn_update_dpp(0, v, CTRL, 0xF, 0xF, true); }
#define PX_ISSUE(BUF, LO, HI) _Pragma("unroll") for (int b_ = 0; b_ < 8; ++b_) { const unsigned off_ = ((unsigned)__builtin_amdgcn_ds_bpermute((16 * (b_ & 3) + ps) * 4, (b_ & 4) ? (HI) : (LO)) << 7) | (unsigned)(dl << 5); \
        BUF[2 * b_] = *(const v4u*)(tab + off_); BUF[2 * b_ + 1] = *(const v4u*)(tab + off_ + 16); }
struct H4 { v4u h0, h1, l0, l1; };
#define PX_DOT8(Q, HH, HL) ah = __builtin_amdgcn_sdot8((int)(Q), (int)(HH), ah, false); al = __builtin_amdgcn_sdot8((int)(Q), (int)(HL), al, false);
__device__ __forceinline__ void peer_down_token(const v4u (&cur)[PX_D], const H4& h, const float hs, float* prow, int dl, int ps) {
    int sm[8];
#pragma unroll
    for (int b = 0; b < 8; ++b) { const v4u q0 = cur[2 * b], q1 = cur[2 * b + 1];
        int ah = 0, al = 0;
        PX_DOT8(q0.x, h.h0.x, h.l0.x) PX_DOT8(q0.y, h.h0.y, h.l0.y) PX_DOT8(q0.z, h.h0.z, h.l0.z) PX_DOT8(q0.w, h.h0.w, h.l0.w)
        PX_DOT8(q1.x, h.h1.x, h.l1.x) PX_DOT8(q1.y, h.h1.y, h.l1.y) PX_DOT8(q1.z, h.h1.z, h.l1.z) PX_DOT8(q1.w, h.h1.w, h.l1.w)
        sm[b] = 16 * ah + al; }
    const bool c1 = (dl & 2) != 0, c0 = (dl & 1) != 0;
    int w4[4], w2[2];
#pragma unroll
    for (int k = 0; k < 4; ++k) { const int keep = c1 ? sm[4 + k] : sm[k], send = c1 ? sm[k] : sm[4 + k]; w4[k] = keep + dpp_i<0x4E>(send); }
#pragma unroll
    for (int k = 0; k < 2; ++k) { const int keep = c0 ? w4[2 + k] : w4[k], send = c0 ? w4[k] : w4[2 + k]; w2[k] = keep + dpp_i<0xB1>(send); }
    prow[32 * dl + ps] = (float)w2[0] * hs; prow[32 * dl + 16 + ps] = (float)w2[1] * hs;
}
__device__ __forceinline__ void peer_down(Frame& F, const Ptrs& P, const PeerPlace& pp) {
    const unsigned char* H8 = P.ws + WS_H8; const unsigned char* HSb = P.ws + WS_HS; const unsigned char* IDXb = P.ws + WS_IDX; unsigned char* PARTb = P.ws + WS_PART;
    const int lane = lane_id(), dl = lane & 3, ps = lane >> 2;
    const int tstep = pp.nloc * NWAVES;
    for (int u = pp.vx; u < 8; u += pp.nx) {
        const int s = u & 3, tend = ((u >> 2) + 1) * (T_ / 2), t0 = (u >> 2) * (T_ / 2) + pp.rank * NWAVES + F.wave;
        if (t0 >= tend) continue;
        const unsigned char* tab = P.ws + WS_ED + (size_t)s * 16384 * 128;
        const unsigned hoff = (unsigned)(s * 256 + dl * 32), ioff = (unsigned)lane * 4u;
        v4u bufA[PX_D], bufB[PX_D];
#define PD_CLAMP(T) ((T) < tend ? (T) : t0)
#define PD_META(H, HSC, TT) do { const unsigned char* hp_ = H8 + ((unsigned)(TT) * 1024u + hoff); H.h0 = *(const v4u*)hp_; H.h1 = *(const v4u*)(hp_ + 16); H.l0 = *(const v4u*)(hp_ + 128); H.l1 = *(const v4u*)(hp_ + 144); \
        HSC = *(const float*)(HSb + ((unsigned)(TT) * 32u + (unsigned)s * 4u)); } while (0)
#define PD_IDX(LO, HI, TT) do { LO = *(const int*)(IDXb + ((unsigned)(TT) * 512u + ioff)); HI = *(const int*)(IDXb + ((unsigned)(TT) * 512u + 256u + ioff)); } while (0)
        int nidx_lo, nidx_hi; PD_IDX(nidx_lo, nidx_hi, t0);
        PX_ISSUE(bufA, nidx_lo, nidx_hi);
        PD_IDX(nidx_lo, nidx_hi, PD_CLAMP(t0 + tstep));
        H4 ha, hb; float sa, sb; PD_META(ha, sa, t0);
        for (int t = t0; t < tend; t += 2 * tstep) {
            { const int tn = PD_CLAMP(t + tstep);
              PX_ISSUE(bufB, nidx_lo, nidx_hi); PD_IDX(nidx_lo, nidx_hi, PD_CLAMP(tn + tstep)); PD_META(hb, sb, tn);
              __builtin_amdgcn_sched_barrier(0);
              peer_down_token(bufA, ha, sa, (float*)(PARTb + ((unsigned)(s * T_ + t) * 512u)), dl, ps);
              __builtin_amdgcn_sched_barrier(0); }
            if (t + tstep >= tend) break;
            { const int tc = t + tstep, tn = PD_CLAMP(tc + tstep);
              PX_ISSUE(bufA, nidx_lo, nidx_hi); PD_IDX(nidx_lo, nidx_hi, PD_CLAMP(tn + tstep)); PD_META(ha, sa, tn);
              __builtin_amdgcn_sched_barrier(0);
              peer_down_token(bufB, hb, sb, (float*)(PARTb + ((unsigned)(s * T_ + tc) * 512u)), dl, ps);
              __builtin_amdgcn_sched_barrier(0); }
        }
    }
}
__device__ __forceinline__ void peer_act(Frame& F, const Ptrs& P) {
    const int* IDX = (const int*)(P.ws + WS_IDX); float* GATE = (float*)(P.ws + WS_GATE); const float* PART = (const float*)(P.ws + WS_PART); const float* SSQ = (const float*)(P.ws + WS_SSQ);
    const float* SCD = (const float*)(P.ws + WS_SMALL); const float* SCU = SCD + 16384;
    const int lane = lane_id();
    for (int w = F.vcu * NWAVES + F.wave; w < T_ * 2; w += F.G * NWAVES) {
        const int t = w >> 1; const size_t pid = (size_t)w * 64 + lane;
        const float ssq = lane < 16 ? SSQ[(size_t)t * 16 + lane] : 0.f;
        const float rstd = rsqrtf(wave_sum(ssq) * (1.f / 1024.f) + EPS);
        float pre = 0.f;
#pragma unroll
        for (int s = 0; s < 4; ++s) pre += PART[(size_t)s * T_ * 128 + pid];
        const int id = IDX[pid];
        GATE[pid] = gelu_erf(pre * SCD[id] * rstd) * GATE[pid] * SCU[id];
    }
}
constexpr int PE_PD = 8;
#define PE_LOAD4(SLOT, IDV) SLOT = *(const v4u*)(EU + (((unsigned)(IDV) << 9) | l16))
#define PE_BP(ADDR, V) __builtin_amdgcn_ds_bpermute((ADDR), (V))
__device__ __forceinline__ void peer_up_tm(Frame& F, const Ptrs& P) {
    const bf16* HB = (const bf16*)(P.ws + WS_ST); const unsigned char* EU = P.ws + WS_EU;
    const int* IDX = (const int*)(P.ws + WS_IDX); const float* GATE = (const float*)(P.ws + WS_GATE); const float* PART = (const float*)(P.ws + WS_PART);
    const float* SCD = (const float*)(P.ws + WS_SMALL); const float* SCU = SCD + 16384;
    const int lane = lane_id(), l31 = lane & 31; const bool upper = lane >= 32;
    const unsigned l16 = (unsigned)l31 << 4;
    const int bp0 = upper ? 4 : 0;
    const int t0 = F.vcu * NWAVES + F.wave, tstep = F.G * NWAVES;
    if (t0 >= T_) return;
    int idx_lo = IDX[(size_t)t0 * 128 + lane], idx_hi = IDX[(size_t)t0 * 128 + 64 + lane];
    v4u hq[4];
#pragma unroll
    for (int k = 0; k < 4; ++k) hq[k] = ((const v4u*)(HB + (size_t)t0 * DM))[4 * l31 + k];
    float g_lo = GATE[(size_t)t0 * 128 + lane], g_hi = GATE[(size_t)t0 * 128 + 64 + lane];
    float pre_lo = 0.f, pre_hi = 0.f;
#pragma unroll
    for (int s = 0; s < 4; ++s) { pre_lo += PART[((size_t)s * T_ + t0) * 128 + lane]; pre_hi += PART[((size_t)s * T_ + t0) * 128 + 64 + lane]; }
    float sdu_lo = SCD[idx_lo], sdu_hi = SCD[idx_hi], su_lo = SCU[idx_lo], su_hi = SCU[idx_hi];
    v4u ra[PE_PD];
#pragma unroll
    for (int j = 0; j < PE_PD; ++j) { const int id = PE_BP(bp0 + 8 * j, idx_lo); PE_LOAD4(ra[j], id); }
    int id_nx = PE_BP(bp0 + 8 * PE_PD, idx_lo);
    for (int t = t0; t < T_; t += tstep) {
        const int tn = (t + tstep < T_) ? t + tstep : t;
        const int nidx_lo = IDX[(size_t)tn * 128 + lane], nidx_hi = IDX[(size_t)tn * 128 + 64 + lane];
        v4u nh[4];
#pragma unroll
        for (int k = 0; k < 4; ++k) nh[k] = ((const v4u*)(HB + (size_t)tn * DM))[4 * l31 + k];
        const float ng_lo = GATE[(size_t)tn * 128 + lane], ng_hi = GATE[(size_t)tn * 128 + 64 + lane];
        float npart_lo[4], npart_hi[4];
#pragma unroll
        for (int s = 0; s < 4; ++s) { npart_lo[s] = PART[((size_t)s * T_ + tn) * 128 + lane]; npart_hi[s] = PART[((size_t)s * T_ + tn) * 128 + 64 + lane]; }
        float ssq = 0.f;
#pragma unroll
        for (int k = 0; k < 4; ++k) { ssq = fmaf(bflo(hq[k].x), bflo(hq[k].x), ssq); ssq = fmaf(bfhi(hq[k].x), bfhi(hq[k].x), ssq); ssq = fmaf(bflo(hq[k].y), bflo(hq[k].y), ssq); ssq = fmaf(bfhi(hq[k].y), bfhi(hq[k].y), ssq);
            ssq = fmaf(bflo(hq[k].z), bflo(hq[k].z), ssq); ssq = fmaf(bfhi(hq[k].z), bfhi(hq[k].z), ssq); ssq = fmaf(bflo(hq[k].w), bflo(hq[k].w), ssq); ssq = fmaf(bfhi(hq[k].w), bfhi(hq[k].w), ssq); }
        ssq += swz_xor<1>(ssq); ssq += swz_xor<2>(ssq); ssq += swz_xor<4>(ssq); ssq += swz_xor<8>(ssq); ssq += swz_xor<16>(ssq);
        const float rstd = rsqrtf(ssq * (1.f / 1024.f) + EPS);
        const float act_lo = gelu_erf(pre_lo * sdu_lo * rstd) * g_lo * su_lo, act_hi = gelu_erf(pre_hi * sdu_hi * rstd) * g_hi * su_hi;
        f32x2v acc[16];
#pragma unroll
        for (int i = 0; i < 16; ++i) acc[i] = (f32x2v){0.f, 0.f};
        float a_cur = __int_as_float(PE_BP(bp0, __float_as_int(act_lo)));
#pragma unroll
        for (int q = 0; q < 64; ++q) {
            const int qa = q + 1, ql = q + PE_PD + 1;
            float a_nx = 0.f;
            if (qa < 64) a_nx = __int_as_float(PE_BP(bp0 + 8 * (qa & 31), __float_as_int(qa < 32 ? act_lo : act_hi)));
            int id_n2;
            if (ql < 64) id_n2 = PE_BP(bp0 + 8 * (ql & 31), ql < 32 ? idx_lo : idx_hi);
            else id_n2 = PE_BP(bp0 + 8 * ((ql - 64) & 31), nidx_lo);
            __builtin_amdgcn_sched_barrier(0);
            { const f32x2v av = {a_cur, a_cur}; const v4u r = ra[q % PE_PD];
#define PE_FMA4(W, O) acc[O] = __builtin_elementwise_fma(av, (f32x2v)__builtin_amdgcn_cvt_scalef32_pk_f32_fp4(W, 1.0f, 0), acc[O]); acc[O + 1] = __builtin_elementwise_fma(av, (f32x2v)__builtin_amdgcn_cvt_scalef32_pk_f32_fp4(W, 1.0f, 1), acc[O + 1]); \
              acc[O + 2] = __builtin_elementwise_fma(av, (f32x2v)__builtin_amdgcn_cvt_scalef32_pk_f32_fp4(W, 1.0f, 2), acc[O + 2]); acc[O + 3] = __builtin_elementwise_fma(av, (f32x2v)__builtin_amdgcn_cvt_scalef32_pk_f32_fp4(W, 1.0f, 3), acc[O + 3]);
              PE_FMA4(r.x, 0) PE_FMA4(r.y, 4) PE_FMA4(r.z, 8) PE_FMA4(r.w, 12) }
            asm volatile("" : "+v"(acc[0]), "+v"(acc[1]), "+v"(acc[2]), "+v"(acc[3]), "+v"(acc[4]), "+v"(acc[5]), "+v"(acc[6]), "+v"(acc[7]));
            asm volatile("" : "+v"(acc[8]), "+v"(acc[9]), "+v"(acc[10]), "+v"(acc[11]), "+v"(acc[12]), "+v"(acc[13]), "+v"(acc[14]), "+v"(acc[15]));
            PE_LOAD4(ra[q % PE_PD], id_nx);
            id_nx = id_n2; a_cur = a_nx;
            __builtin_amdgcn_sched_barrier(0);
        }
        { float a = 0.f, c = 0.f;
#pragma unroll
          for (int s = 0; s < 4; ++s) { a += npart_lo[s]; c += npart_hi[s]; }
          pre_lo = a; pre_hi = c; }
        sdu_lo = SCD[nidx_lo]; sdu_hi = SCD[nidx_hi]; su_lo = SCU[nidx_lo]; su_hi = SCU[nidx_hi];
        float y[32];
#pragma unroll
        for (int k = 0; k < 4; ++k) { y[8 * k] = bflo(hq[k].x); y[8 * k + 1] = bfhi(hq[k].x); y[8 * k + 2] = bflo(hq[k].y); y[8 * k + 3] = bfhi(hq[k].y); y[8 * k + 4] = bflo(hq[k].z); y[8 * k + 5] = bfhi(hq[k].z); y[8 * k + 6] = bflo(hq[k].w); y[8 * k + 7] = bfhi(hq[k].w); }
        float s2 = 0.f;
#pragma unroll
        for (int i = 0; i < 16; ++i) { y[2 * i] += sum_halves(acc[i][0]); y[2 * i + 1] += sum_halves(acc[i][1]); s2 = fmaf(y[2 * i], y[2 * i], s2); s2 = fmaf(y[2 * i + 1], y[2 * i + 1], s2); }
        s2 += swz_xor<1>(s2); s2 += swz_xor<2>(s2); s2 += swz_xor<4>(s2); s2 += swz_xor<8>(s2); s2 += swz_xor<16>(s2);
        const float r2 = rsqrtf(s2 * (1.f / 1024.f) + EPS);
        const float4* wf = (const float4*)(P.norm_final) + 8 * l31 + 4 * (lane >> 5); float4* o = (float4*)(P.out + (size_t)t * DM) + 8 * l31 + 4 * (lane >> 5);
#pragma unroll
        for (int k = 0; k < 4; ++k) { const float4 w = wf[k];
            const float e0 = upper ? y[16 + 4 * k] : y[4 * k], e1 = upper ? y[17 + 4 * k] : y[4 * k + 1], e2 = upper ? y[18 + 4 * k] : y[4 * k + 2], e3 = upper ? y[19 + 4 * k] : y[4 * k + 3];
            o[k] = make_float4(e0 * r2 * w.x, e1 * r2 * w.y, e2 * r2 * w.z, e3 * r2 * w.w); }
        idx_lo = nidx_lo; idx_hi = nidx_hi; g_lo = ng_lo; g_hi = ng_hi;
#pragma unroll
        for (int k = 0; k < 4; ++k) hq[k] = nh[k];
    }
}
constexpr int TK_LDK = 136, TK_K2 = 34816, TK_SCR = 69632, TK_SP = 49;
__device__ __forceinline__ int mono_key(float x) { const int b = __float_as_int(x); return b ^ ((b >> 31) & 0x7fffffff); }
__device__ __forceinline__ float unmono(int m) { return __int_as_float(m ^ ((m >> 31) & 0x7fffffff)); }
__device__ __forceinline__ int max3i(int a, int b, int c) { return max(max(a, b), c); }
#define CEX(A, I, J) do { const int hi_ = max(A[I], A[J]), lo_ = min(A[I], A[J]); A[I] = hi_; A[J] = lo_; } while (0)
template <int N, int OFF, int K, int J, int LEN> struct BitonicStep {
    static __device__ __forceinline__ void run(int (&a)[LEN]) {
#pragma unroll
        for (int i = 0; i < N; ++i) { const int l = i ^ J; if (l > i) { if ((i & K) == 0) CEX(a, OFF + i, OFF + l); else CEX(a, OFF + l, OFF + i); } }
        if constexpr (J > 1) BitonicStep<N, OFF, K, (J >> 1), LEN>::run(a);
        else if constexpr (K < N) BitonicStep<N, OFF, (K << 1), K, LEN>::run(a);
    }
};
template <int N, int OFF, int LEN> __device__ __forceinline__ void bitonic_sort_desc(int (&a)[LEN]) { BitonicStep<N, OFF, 2, 1, LEN>::run(a); }
template <int OFF, int LEN> __device__ __forceinline__ void bitonic_merge16_desc(int (&a)[LEN]) { BitonicStep<16, OFF, 16, 8, LEN>::run(a); }
template <int A, int B, int LEN> __device__ __forceinline__ void merge_top16(int (&a)[LEN]) {
#pragma unroll
    for (int i = 0; i < 16; ++i) a[A + i] = max(a[A + i], a[B + 15 - i]);
    bitonic_merge16_desc<A, LEN>(a);
}
template <int LEN> __device__ __forceinline__ void pair_top16(int (&a)[LEN]) {
    int lo[16], up[16];
#pragma unroll
    for (int i = 0; i < 16; ++i) { const auto rr = __builtin_amdgcn_permlane32_swap((unsigned)a[i], (unsigned)a[i], false, false); lo[i] = (int)rr[0]; up[i] = (int)rr[1]; }
#pragma unroll
    for (int i = 0; i < 16; ++i) a[i] = max(lo[i], up[15 - i]);
    bitonic_merge16_desc<0, LEN>(a);
}
__device__ __forceinline__ void topk_half(const bf16x8 (&qf)[8], const LAS bf16* Kh, int r, int hh, int (&key)[64]) {
#pragma unroll
    for (int nt = 0; nt < 4; ++nt) {
        f32x16 sc;
#pragma unroll
        for (int i = 0; i < 16; ++i) sc[i] = 0.f;
#pragma unroll
        for (int kk = 0; kk < 8; ++kk) { const bf16x8 a = *(const LAS bf16x8*)(Kh + (32 * nt + r) * TK_LDK + 16 * kk + 8 * hh); sc = MFMA32(a, qf[kk], sc); }
#pragma unroll
        for (int i = 0; i < 16; ++i) key[nt * 16 + i] = (mono_key(sc[i]) & ~127) | (127 - (32 * nt + crow(i, hh)));
    }
    bitonic_sort_desc<16, 0, 64>(key); bitonic_sort_desc<16, 16, 64>(key); bitonic_sort_desc<16, 32, 64>(key); bitonic_sort_desc<16, 48, 64>(key);
    merge_top16<0, 16, 64>(key); merge_top16<32, 48, 64>(key); merge_top16<0, 32, 64>(key);
    pair_top16<64>(key);
}
__device__ __forceinline__ void topk_finish(const LAS int* scr, int hh, float rstd, int* IDX, float* GATE, int t, int hd) {
    const LAS int* la = scr + hh * 16; const LAS int* lb = scr + (1 - hh) * 16;
    float va[4], vb[16];
#pragma unroll
    for (int i = 0; i < 4; ++i) va[i] = unmono(la[i] & ~127);
#pragma unroll
    for (int j = 0; j < 16; ++j) vb[j] = unmono(lb[j] & ~127);
    int ck[32];
    {
        int q = 0;
#pragma unroll
        for (int i = 0; i < 4; ++i)
#pragma unroll
            for (int j = i; j < 16; ++j) if ((i + 1) * (j + 1) <= 16) {
                const int pos = hh ? (j * 16 + i) : (i * 16 + j);
                int k = (mono_key(va[i] + vb[j]) & ~255) | (255 - pos);
                if (i == j && hh) k = (int)0x80000000;
                ck[q++] = k; }
#pragma unroll
        for (int i = 27; i < 32; ++i) ck[i] = (int)0x80000000;
    }
    bitonic_sort_desc<32, 0, 32>(ck);
    pair_top16<32>(ck);
    const float vmax = unmono(ck[0] & ~255) * rstd;
    float ev[8]; int id[8]; float esum = 0.f; const int hm = -hh;
#pragma unroll
    for (int q = 0; q < 8; ++q) { const int wk = ck[q] ^ ((ck[q] ^ ck[8 + q]) & hm); const int pos = 255 - (wk & 255);
        const int n1 = 127 - (scr[pos >> 4] & 127), n2 = 127 - (scr[16 + (pos & 15)] & 127);
        id[q] = n1 * 128 + n2;
        ev[q] = exp2f((unmono(wk & ~255) * rstd - vmax) * LOG2E); esum += ev[q]; }
    esum = sum_halves(esum);
    const float inv = 1.f / esum;
    int4* ip = (int4*)(IDX + ((size_t)t * 8 + hd) * 16 + hh * 8); float4* gp = (float4*)(GATE + ((size_t)t * 8 + hd) * 16 + hh * 8);
    ip[0] = make_int4(id[0], id[1], id[2], id[3]); ip[1] = make_int4(id[4], id[5], id[6], id[7]);
    gp[0] = make_float4(ev[0] * inv, ev[1] * inv, ev[2] * inv, ev[3] * inv); gp[1] = make_float4(ev[4] * inv, ev[5] * inv, ev[6] * inv, ev[7] * inv);
}
constexpr int TQ_QH = 69632, TQ_QP = 272;
struct OneUnit { pg8::StaticOrder S; int i;
    __device__ __forceinline__ bool next(int j, pg8::Unit& u) const { return j == 0 ? S.next(i, u) : false; }
    __device__ __forceinline__ void a_ready(const pg8::Unit&) const {}
    __device__ __forceinline__ void done(const pg8::Unit&) const {}
};
struct EpiQTopk {
    static constexpr bool PERM = true, AFTER_DRAIN = true;
    const float* sk1; const float* sk2; const float* SSQ; int* IDX; float* GATE;
    __device__ __forceinline__ void dump(const pg8::f32x4 (&acc)[2][2][4][2], int bj, LAS unsigned char* QH, int wr, int wc, int fr, int fq) const {
#pragma unroll
        for (int ai = 0; ai < 2; ++ai)
#pragma unroll
            for (int m = 0; m < 4; ++m) { const pg8::f32x4 v0 = bj ? acc[ai][1][m][0] : acc[ai][0][m][0], v1 = bj ? acc[ai][1][m][1] : acc[ai][0][m][1];
                v4u w; w.x = cvtpk(v0[0], v0[1]); w.y = cvtpk(v0[2], v0[3]); w.z = cvtpk(v1[0], v1[1]); w.w = cvtpk(v1[2], v1[3]);
                *(LAS v4u*)(QH + (128 * ai + 64 * wr + 16 * m + fr) * TQ_QP + (32 * wc + 8 * fq) * 2) = w; }
    }
    __device__ __forceinline__ void fused(const pg8::f32x4 (&acc)[2][2][4][2], const pg8::Unit& u, int wr, int wc, int fr, int fq, LAS unsigned char* L, int wid, int lane) const {
        LAS bf16* K1 = (LAS bf16*)L; LAS bf16* K2 = (LAS bf16*)(L + TK_K2); LAS unsigned char* QH = L + TQ_QH;
        const int tid_ = wid * 64 + lane, r = lane & 31, hh = lane >> 5;
        for (int i = tid_; i < 16384; i += 512) { const int n = i >> 7, k = i & 127; K1[n * TK_LDK + k] = (bf16)f2bf(sk1[i]); K2[n * TK_LDK + k] = (bf16)f2bf(sk2[i]); }
        dump(acc, 0, QH, wr, wc, fr, fq);
        __syncthreads();
        const int t = u.pm * 256 + 32 * wid + r;
        float rstd;
        { const float4* sp = (const float4*)(SSQ + (size_t)t * 16); const float4 a = sp[0], b = sp[1], c = sp[2], d = sp[3];
          rstd = rsqrtf(((a.x + a.y + a.z + a.w) + (b.x + b.y + b.z + b.w) + (c.x + c.y + c.z + c.w) + (d.x + d.y + d.z + d.w)) * (1.f / 1024.f) + EPS); }
        const LAS unsigned char* qrow = QH + (32 * wid + r) * TQ_QP + 16 * hh;
        int key[64], list0[16];
        { bf16x8 qf[8];
#pragma unroll
          for (int kk = 0; kk < 8; ++kk) qf[kk] = *(const LAS bf16x8*)(qrow + 32 * kk);
          topk_half(qf, K1, r, hh, key);
#pragma unroll
          for (int i = 0; i < 16; ++i) list0[i] = key[i]; }
        __syncthreads();
        dump(acc, 1, QH, wr, wc, fr, fq);
        __syncthreads();
        { bf16x8 qf[8];
#pragma unroll
          for (int kk = 0; kk < 8; ++kk) qf[kk] = *(const LAS bf16x8*)(qrow + 32 * kk);
          topk_half(qf, K2, r, hh, key); }
        LAS int* scr = (LAS int*)(QH + 32 * wid * TQ_QP) + r * TK_SP;
        LDS_WAIT();
        if (hh == 0) {
#pragma unroll
            for (int i = 0; i < 16; ++i) { scr[i] = list0[i]; scr[16 + i] = key[i]; } }
        topk_finish(scr, hh, rstd, IDX, GATE, t, u.pn);
        __syncthreads();
    }
};

constexpr int AT_KP = 72, AT_VP = 264;
constexpr int AT_K = 0, AT_VT = 36864, AT_BT = 36864 + 33792;
__device__ __forceinline__ void attn_phase(Frame& F, const Ptrs& P) {
    const bf16* PROJ = (const bf16*)(P.ws + WS_PROJ); bf16* CAT = (bf16*)(P.ws + WS_XN);
    LAS unsigned char* L = F.lds + RING_OFF;
    LAS bf16* Ks = (LAS bf16*)(L + AT_K); LAS bf16* Vt = (LAS bf16*)(L + AT_VT); LAS float* btab = (LAS float*)(L + AT_BT);
    const int lane = lane_id(), tid_ = F.wave * 64 + lane, r = lane & 31, hh = lane >> 5;
    for (int u = F.vcu; u < 256; u += F.G) {
        const int hkv = u & 1, n = (u >> 1) & 31, b = u >> 6;
        const int trow0 = b * SEQ + n * 128;
        for (int i = tid_; i < 2048; i += 512) {
            const int kj = i >> 3, ch = i & 7; const bool ok = (n > 0) || (kj >= 128);
            v4u kv = {0u, 0u, 0u, 0u}, vv = {0u, 0u, 0u, 0u};
            if (ok) { const bf16* rowp = PROJ + (size_t)(trow0 - 128 + kj) * NPROJ + hkv * 64 + ch * 8; kv = *(const v4u*)(rowp + PJ_K); vv = *(const v4u*)(rowp + PJ_V); }
            *(LAS v4u*)(Ks + kj * AT_KP + ch * 8) = kv;
            LAS bf16* vp = Vt + (ch * 8) * AT_VP + kj;
            vp[0] = (bf16)(vv.x & 0xffffu); vp[AT_VP] = (bf16)(vv.x >> 16); vp[2 * AT_VP] = (bf16)(vv.y & 0xffffu); vp[3 * AT_VP] = (bf16)(vv.y >> 16);
            vp[4 * AT_VP] = (bf16)(vv.z & 0xffffu); vp[5 * AT_VP] = (bf16)(vv.z >> 16); vp[6 * AT_VP] = (bf16)(vv.w & 0xffffu); vp[7 * AT_VP] = (bf16)(vv.w >> 16);
        }
        for (int i = tid_; i < 768; i += 512) { const int gg = i / 192, dist = i % 192 - 32;
            btab[i] = (dist >= 0 && dist < 128) ? P.rel_bias[c_bucket[dist & 127] * 8 + hkv * 4 + gg] * LOG2E : 0.f; }
        __syncthreads();
        const int g = F.wave & 3, h = hkv * 4 + g;
        const float sink2 = P.sinks[h] * LOG2E;
#pragma unroll 1
        for (int qq = 0; qq < 2; ++qq) {
            const int qt = (F.wave >> 2) * 2 + qq, t = trow0 + 32 * qt + r;
            bf16x8 qf[4];
#pragma unroll
            for (int kk = 0; kk < 4; ++kk) qf[kk] = *(const bf16x8*)(PROJ + (size_t)t * NPROJ + h * 64 + 16 * kk + 8 * hh);
            f32x16 sc[5];
#pragma unroll
            for (int j = 0; j < 5; ++j) {
#pragma unroll
                for (int i = 0; i < 16; ++i) sc[j][i] = 0.f;
#pragma unroll
                for (int kk = 0; kk < 4; ++kk) { const bf16x8 a = *(const LAS bf16x8*)(Ks + (32 * (qt + j) + r) * AT_KP + 16 * kk + 8 * hh); sc[j] = MFMA32(a, qf[kk], sc[j]); }
            }
            float m = sink2;
            const LAS float* bt = btab + g * 192 + 160 + r - 4 * hh;
#pragma unroll
            for (int j = 0; j < 5; ++j) {
                const bool tile_ok = (n > 0) || (qt + j >= 4);
#pragma unroll
                for (int i = 0; i < 16; ++i) { const int dist = 128 + r - (32 * j + crow(i, hh));
                    const bool ok = tile_ok && (j == 0 ? dist < 128 : (j == 4 ? dist >= 0 : true));
                    const float s = sc[j][i] * (0.125f * LOG2E) + bt[-(32 * j + (i & 3) + 8 * (i >> 2))];
                    sc[j][i] = ok ? s : -INFINITY; m = fmaxf(m, sc[j][i]); }
            }
            m = max_halves(m);
            float l = 0.f;
#pragma unroll
            for (int j = 0; j < 5; ++j)
#pragma unroll
                for (int i = 0; i < 16; ++i) { sc[j][i] = exp2f(sc[j][i] - m); l += sc[j][i]; }
            l = sum_halves(l);
            l += exp2f(sink2 - m);
            const float inv = 1.f / l;
            f32x16 o[2];
#pragma unroll
            for (int i = 0; i < 16; ++i) { o[0][i] = 0.f; o[1][i] = 0.f; }
#pragma unroll
            for (int j = 0; j < 5; ++j)
#pragma unroll
                for (int sg = 0; sg < 2; ++sg) {
                    const bf16x8 pf = pack8(sc[j], sg);
#pragma unroll
                    for (int dt = 0; dt < 2; ++dt) {
                        const LAS bf16* vb = Vt + (32 * dt + r) * AT_VP + 32 * (qt + j) + 16 * sg + 4 * hh;
                        const s16x4 lo = *(const LAS s16x4*)(vb), hi = *(const LAS s16x4*)(vb + 8);
                        o[dt] = MFMA32(__builtin_shufflevector(lo, hi, 0, 1, 2, 3, 4, 5, 6, 7), pf, o[dt]);
                    }
                }
            bf16* op = CAT + (size_t)t * DM + h * 64 + 4 * hh;
#pragma unroll
            for (int dt = 0; dt < 2; ++dt)
#pragma unroll
                for (int g4 = 0; g4 < 4; ++g4)
                    *(unsigned long long*)(op + 32 * dt + 8 * g4) = (unsigned long long)cvtpk(o[dt][4 * g4] * inv, o[dt][4 * g4 + 1] * inv) | ((unsigned long long)cvtpk(o[dt][4 * g4 + 2] * inv, o[dt][4 * g4 + 3] * inv) << 32);
        }
        __syncthreads();
    }
}
struct Args { Ptrs p; };
__global__ void __launch_bounds__(NWAVES * 64, 2) hymba_fwd(Args args) {
    extern __shared__ __attribute__((aligned(16))) unsigned char lds[];
    const Ptrs& P = args.p;
    Frame F;
    F.lds = (LAS unsigned char*)lds;
    F.MISC = (volatile LAS unsigned*)(F.lds + MISC_OFF);
    F.wave = __builtin_amdgcn_readfirstlane(threadIdx.x >> 6);
    F.G = gridDim.x; { const int bx = blockIdx.x; F.vcu = (F.G % 8 == 0) ? (bx % 8) * (F.G / 8) + bx / 8 : bx; }
    F.ctl = (gu32*)(P.ws + WS_CTL);
    for (int u = threadIdx.x; u < (LDS_BYTES - LDSCTL_OFF) / 4; u += NWAVES * 64) ((LAS unsigned*)(F.lds + LDSCTL_OFF))[u] = 0u;
    __syncthreads();
    XcdBarrier bar = xcd_barrier_post((unsigned*)(F.ctl + CW_BAR), F.MISC + 8);
#define GRID_BAR() xcd_barrier(bar)

    bf16* XN = (bf16*)(P.ws + WS_XN); bf16* PROJ = (bf16*)(P.ws + WS_PROJ); bf16* HB = (bf16*)(P.ws + WS_ST);
    p0_prologue(F, P);
    GRID_BAR();
    { pg8::Gemm g{XN, (const bf16*)(P.ws + WS_WIN), T_, NPROJ, DM, F.wave}; pg8::StaticOrder S; S.init(T_, NPROJ, F.G, (int)blockIdx.x);
      pg8::EpiBf16<0> E{PROJ, NPROJ, nullptr, 0, 0, 1.f};
      pg8::gemm_phase<pg8::EpiBf16<0>, pg8::StaticOrder, PG8_ALIGN, PG8_SP2>(F.lds + RING_OFF, g, S, E); }
    if (F.G == 256 && blockIdx.x >= 64) p1_slack(F, P, ((int)blockIdx.x - 64) * NWAVES + F.wave, 192 * NWAVES);
    else if (F.G != 256) p1_slack(F, P, F.vcu * NWAVES + F.wave, F.G * NWAVES);
    GRID_BAR();
    ssd_s1(F, P);
    xcd_arrive(bar, F.MISC + 14);
    attn_phase(F, P);
    xcd_wait(bar, F.MISC + 14);
    ssd_s2(F, P);
    GRID_BAR();
    ssd_s3(F, P);
    GRID_BAR();
    { pg8::Gemm g{XN, (const bf16*)(P.ws + WS_WOUT), T_, DM, DM, F.wave}; pg8::StaticOrder S; S.init(T_, DM, F.G, (int)blockIdx.x);
      EpiResH E{P.x, HB, (float*)(P.ws + WS_SSQ)};
      pg8::gemm_phase<EpiResH, pg8::StaticOrder, PG8_ALIGN, PG8_SP2>(F.lds + RING_OFF, g, S, E); }
    GRID_BAR();
    { pg8::Gemm g{HB, (const bf16*)(P.ws + WS_WQ), T_, 2048, DM, F.wave}; pg8::StaticOrder S; S.init(T_, 2048, F.G, (int)blockIdx.x);
      EpiQTopk E{P.sk1, P.sk2, (const float*)(P.ws + WS_SSQ), (int*)(P.ws + WS_IDX), (float*)(P.ws + WS_GATE)};
#pragma unroll 1
      for (int ui = 0; ui < 64; ++ui) { pg8::Unit u0; if (!S.next(ui, u0)) break;
          OneUnit S1{S, ui};
          pg8::gemm_phase<EpiQTopk, OneUnit, PG8_ALIGN, PG8_SP2>(F.lds + RING_OFF, g, S1, E); } }
    h_quant_rows(F, P);
    GRID_BAR();
    { const PeerPlace pp = peer_place(F);
      peer_down(F, P, pp); }
    GRID_BAR();
    peer_up_tm(F, P);
}

extern "C" void kernel_launch(void* const* d_in, const int* in_sizes, int n_in, void* d_out, int out_size, void* d_ws, size_t ws_size, hipStream_t stream) {
    static int grid = 0;
    if (grid == 0) {
        if (n_in != 19 || out_size != T_ * DM || ws_size < WS_END) { fprintf(stderr, "kernel_launch: unexpected shapes (n_in %d, out %d, ws %zu)\n", n_in, out_size, ws_size); grid = -1; return; }
        int dev = 0, cus = 0, per_cu = 0;
        if (hipGetDevice(&dev) != hipSuccess || hipDeviceGetAttribute(&cus, hipDeviceAttributeMultiprocessorCount, dev) != hipSuccess) { grid = -1; return; }
        if (hipFuncSetAttribute((const void*)hymba_fwd, hipFuncAttributeMaxDynamicSharedMemorySize, LDS_BYTES) != hipSuccess) { fprintf(stderr, "kernel_launch: hipFuncSetAttribute failed\n"); grid = -1; return; }
        if (hipOccupancyMaxActiveBlocksPerMultiprocessor(&per_cu, (const void*)hymba_fwd, NWAVES * 64, LDS_BYTES) != hipSuccess || per_cu < 1) { fprintf(stderr, "kernel_launch: occupancy query says %d blocks per CU\n", per_cu); grid = -1; (void)hipGetLastError(); return; }
        grid = cus;
    }
    if (grid < 0) return;
    (void)hipMemsetAsync((char*)d_ws + WS_CTL, 0, CTL_ZERO_BYTES, stream);
    Args a{};
    const float** pp = (const float**)&a.p;
    for (int i = 0; i < 19; ++i) pp[i] = (const float*)d_in[i];
    a.p.out = (float*)d_out; a.p.ws = (unsigned char*)d_ws;
    hipLaunchKernelGGL(hymba_fwd, dim3(grid), dim3(NWAVES * 64), LDS_BYTES, stream, a);
}
```

```cpp
#include <hip/hip_runtime.h>
#include <cstdio>
#include <cstdint>
#include <math.h>
namespace pg8 {
#define PG8_LAS __attribute__((address_space(3)))
typedef unsigned short bf16_t;
typedef short bf16x8 __attribute__((ext_vector_type(8)));
typedef float f32x4 __attribute__((ext_vector_type(4)));
typedef unsigned u32x4 __attribute__((ext_vector_type(4)));
constexpr int BM = 256, BK = 64, HALF = 128, HTB = HALF * BK * 2  , STAGE_BYTES = 8 * HTB, NXCD = 8, WGM = 8;

__host__ __device__ __forceinline__ int lds_byte(int r, int c) { const int st = (r >> 4) * 2 + (c >> 5), rr = r & 15, cc = c & 31, ob = rr * 64 + cc * 2; return st * 1024 + (ob ^ (((ob >> 9) & 1) << 5)); }
__host__ __device__ __forceinline__ void stage_rc(int b, int& R, int& C) { const int st = b / 1024, sb = b % 1024, swz = sb ^ (((sb >> 9) & 1) << 5); R = (st >> 1) * 16 + swz / 64; C = (st & 1) * 32 + (swz % 64) / 2; }
__host__ __device__ __forceinline__ int perm32(int rho) { const int n = rho >> 4, i = rho & 15; return 8 * (i >> 2) + 4 * n + (i & 3); }

struct Unit { int pm, pn; };
struct Gemm { const bf16_t* A; const bf16_t* Bt; int M, N, K, wave; };

struct StaticOrder {
    int nM, nN, nwg, G, c;
    __host__ __device__ void init(int M, int N, int G_, int c_) { nM = M / BM; nN = N / BM; nwg = nM * nN; G = G_; c = c_; }
    __host__ __device__ bool next(int i, Unit& u) const {
        const long L = (long)i * G + c; if (L >= nwg) return false;
        int wgid = (int)L; { const int q = nwg / NXCD, r = nwg % NXCD, xcd = wgid % NXCD, off = wgid / NXCD; wgid = (xcd < r ? xcd * (q + 1) : r * (q + 1) + (xcd - r) * q) + off; }
        const int nig = WGM * nN, gid = wgid / nig, fm = gid * WGM, gsz = (nM - fm) < WGM ? (nM - fm) : WGM;
        u.pm = fm + ((wgid % nig) % gsz); u.pn = (wgid % nig) / gsz; return true;
    }
    __device__ __forceinline__ void a_ready(const Unit&) const {}
    __device__ __forceinline__ void done(const Unit&) const {}
};

__device__ __forceinline__ unsigned cvt_pk_bf16(float lo, float hi) { unsigned r; asm volatile("v_cvt_pk_bf16_f32 %0, %1, %2" : "=v"(r) : "v"(lo), "v"(hi)); return r; }
typedef float f32x2 __attribute__((ext_vector_type(2)));
__device__ __forceinline__ f32x2 gelu_pk(f32x2 v) {
    const f32x2 av = __builtin_elementwise_abs(v), d = av * 0.2316418882f + 1.0f;
    f32x2 t; t.x = __builtin_amdgcn_rcpf(d.x); t.y = __builtin_amdgcn_rcpf(d.y);
    f32x2 q = t * 0.5307027145f + (-0.7265760135f); q = q * t + 0.7107068705f; q = q * t + (-0.142248368f); q = q * t + 0.127414796f; q = q * t;
    const f32x2 s = (v * v) * (-0.72134752044f);
    f32x2 e; e.x = __builtin_amdgcn_exp2f(s.x); e.y = __builtin_amdgcn_exp2f(s.y);
    const f32x2 m = v * (q * e), r = v - m;
    f32x2 o; o.x = v.x < 0.f ? m.x : r.x; o.y = v.y < 0.f ? m.y : r.y; return o;
}

template <int ACT  > struct EpiBf16 {
    static constexpr bool PERM = true, AFTER_DRAIN = false; static_assert(ACT == 0 || ACT == 1, "EpiBf16: ACT is 0 (none) or 1 (gelu_pk)");
    bf16_t* O; int ldc; const float* bias; int split_cols; size_t split_stride; float scale0;
    __device__ __forceinline__ void operator()(const f32x4 (&acc)[2][2][4][2], const Unit& u, int wr, int wc, int fr, int fq) const {
        const int row0 = u.pm * BM + wr * 64 + fr; int colt = u.pn * BM; bf16_t* base = O;
        float sc = 1.f; if (split_cols) { const int t = colt / split_cols; base += (size_t)t * split_stride; colt -= t * split_cols; if (t == 0) sc = scale0; }
        const int col0 = colt + wc * 32 + 8 * fq, bcol0 = u.pn * BM + wc * 32 + 8 * fq;
        f32x4 bv[2][2];
#pragma unroll
        for (int bj = 0; bj < 2; ++bj)
#pragma unroll
            for (int n = 0; n < 2; ++n) bv[bj][n] = bias ? *(const f32x4*)(bias + bcol0 + bj * HALF + 4 * n) : (f32x4){0.f, 0.f, 0.f, 0.f};
#pragma unroll
        for (int ai = 0; ai < 2; ++ai)
#pragma unroll
            for (int m = 0; m < 4; ++m) { bf16_t* rowp = base + (size_t)(row0 + ai * HALF + m * 16) * ldc + col0;
#pragma unroll
                for (int bj = 0; bj < 2; ++bj) { f32x4 v0 = acc[ai][bj][m][0] + bv[bj][0], v1 = acc[ai][bj][m][1] + bv[bj][1];
                    if (ACT == 1) { f32x2 a = gelu_pk((f32x2){v0[0], v0[1]}), b = gelu_pk((f32x2){v0[2], v0[3]}), c = gelu_pk((f32x2){v1[0], v1[1]}), d = gelu_pk((f32x2){v1[2], v1[3]});
                        v0 = (f32x4){a.x, a.y, b.x, b.y}; v1 = (f32x4){c.x, c.y, d.x, d.y}; }
                    v0 = v0 * sc; v1 = v1 * sc; u32x4 w; w.x = cvt_pk_bf16(v0[0], v0[1]); w.y = cvt_pk_bf16(v0[2], v0[3]); w.z = cvt_pk_bf16(v1[0], v1[1]); w.w = cvt_pk_bf16(v1[2], v1[3]);
                    *(u32x4*)(rowp + bj * HALF) = w; } }
    }
};
template <class Epi, class Sched, bool ALIGN_EPI = false, bool SP2 = false>
__device__ __forceinline__ void gemm_phase(PG8_LAS unsigned char* lds, const Gemm g, const Sched& S, const Epi& E) {
    int lane_l; asm volatile("v_mbcnt_lo_u32_b32 %0, -1, 0\n\tv_mbcnt_hi_u32_b32 %0, -1, %0" : "=v"(lane_l));
    const int wid = g.wave, lane = lane_l, tid = wid * 64 + lane,
              wr = wid >> 2, wc = wid & 3, fr = lane & 15, fq = lane >> 4;
    const int K = g.K, nt = K / BK;
    unsigned voffA[2], voffB[2];
#pragma unroll
    for (int i = 0; i < 2; ++i) { int R, C; stage_rc(tid * 16 + i * 8192, R, C); const int Rb = Epi::PERM ? ((R & ~31) + perm32(R & 31)) : R;
        voffA[i] = (unsigned)(R * K + C) * 2u; voffB[i] = (unsigned)(Rb * K + C) * 2u; }
    const size_t kstep = (size_t)(BK * 2);
    const size_t hstep = (size_t)HALF * K * 2;
    const size_t tstep = 2 * hstep;
    const unsigned ldsw = (unsigned)wid * 1024u;
    const int aoff = lds_byte(wr * 64 + fr, fq * 8), boff = lds_byte(wc * 32 + fr, fq * 8);
#define PG8_SA(b, h) (((b) * 2 + (h)) * HTB)
#define PG8_SB(b, h) ((4 + (b) * 2 + (h)) * HTB)
#define PG8_STAGE(bufoff, gbase, voff) do { _Pragma("unroll") for (int _i = 0; _i < 2; ++_i) \
        __builtin_amdgcn_global_load_lds((const unsigned*)((const char*)(gbase) + (voff)[_i]), (PG8_LAS unsigned*)(lds + (bufoff) + ldsw + _i * 8192), 16, 0, 0); } while (0)
#define PG8_LDA(dst, b, h) do { _Pragma("unroll") for (int m = 0; m < 4; ++m) _Pragma("unroll") for (int k = 0; k < 2; ++k) dst[m][k] = *(const PG8_LAS bf16x8*)(lds + PG8_SA(b, h) + aoff + m * 2048 + k * 1024); } while (0)
#define PG8_LDB(dst, b, h) do { _Pragma("unroll") for (int n = 0; n < 2; ++n) _Pragma("unroll") for (int k = 0; k < 2; ++k) dst[n][k] = *(const PG8_LAS bf16x8*)(lds + PG8_SB(b, h) + boff + n * 2048 + k * 1024); } while (0)
#define PG8_MMA(ai, bj, At, Bt) do { __builtin_amdgcn_s_setprio(1); _Pragma("unroll") for (int m = 0; m < 4; ++m) _Pragma("unroll") for (int n = 0; n < 2; ++n) _Pragma("unroll") for (int k = 0; k < 2; ++k) \
        acc[ai][bj][m][n] = __builtin_amdgcn_mfma_f32_16x16x32_bf16(Bt[n][k], At[m][k], acc[ai][bj][m][n], 0, 0, 0); __builtin_amdgcn_s_setprio(0); } while (0)
#define PG8_WAIT_V(n) asm volatile("s_waitcnt vmcnt(" #n ")" ::: "memory")
#define PG8_WAIT_L(n) asm volatile("s_waitcnt lgkmcnt(" #n ")" ::: "memory")
#define PG8_BAR __builtin_amdgcn_s_barrier()
#define PG8_SCHED __builtin_amdgcn_sched_barrier(0)
    Unit cur, nxt; int ui = 0;
    if (!S.next(0, cur)) return;
    f32x4 acc[2][2][4][2];
#pragma unroll
    for (int a = 0; a < 2; ++a)
#pragma unroll
        for (int b = 0; b < 2; ++b)
#pragma unroll
            for (int m = 0; m < 4; ++m)
#pragma unroll
                for (int n = 0; n < 2; ++n) acc[a][b][m][n] = (f32x4){0.f, 0.f, 0.f, 0.f};
    bf16x8 At[4][2], B0[2][2], B1[2][2];
    const char* cA = (const char*)g.A + (size_t)cur.pm * tstep; const char* cB = (const char*)g.Bt + (size_t)cur.pn * tstep;
    S.a_ready(cur);
    if constexpr (SP2) {
        PG8_STAGE(PG8_SB(0, 0), cB, voffB); PG8_STAGE(PG8_SB(0, 1), cB + hstep, voffB); PG8_STAGE(PG8_SA(0, 0), cA, voffA); PG8_STAGE(PG8_SA(0, 1), cA + hstep, voffA);
        if (wr == 1) PG8_BAR;
        PG8_WAIT_V(2); PG8_BAR;
        PG8_STAGE(PG8_SB(1, 0), cB + kstep, voffB); PG8_STAGE(PG8_SA(1, 0), cA + kstep, voffA); PG8_STAGE(PG8_SB(1, 1), cB + hstep + kstep, voffB);
        PG8_WAIT_V(6); PG8_BAR;
    } else {
        PG8_STAGE(PG8_SB(0, 0), cB, voffB); PG8_STAGE(PG8_SA(0, 0), cA, voffA); PG8_STAGE(PG8_SB(0, 1), cB + hstep, voffB); PG8_STAGE(PG8_SA(0, 1), cA + hstep, voffA);
        if (wr == 1) PG8_BAR;
        PG8_WAIT_V(4); PG8_BAR;
        PG8_STAGE(PG8_SB(1, 0), cB + kstep, voffB); PG8_STAGE(PG8_SA(1, 0), cA + kstep, voffA); PG8_STAGE(PG8_SB(1, 1), cB + hstep + kstep, voffB);
        PG8_WAIT_V(6); PG8_BAR;
    }
    for (;;) {
        const bool has_next = S.next(ui + 1, nxt);
        const char* nA = has_next ? (const char*)g.A + (size_t)nxt.pm * tstep : cA; const char* nB = has_next ? (const char*)g.Bt + (size_t)nxt.pn * tstep : cB;
        for (int t = 0; t < nt; t += 2) {
            const bool last = (t == nt - 2);
            const char* a1 = cA + (size_t)(t + 1) * kstep;
            const char* a2 = last ? nA : cA + (size_t)(t + 2) * kstep; const char* b2 = last ? nB : cB + (size_t)(t + 2) * kstep;
            const char* a3 = a2 + kstep; const char* b3 = b2 + kstep;
            if (last && has_next) S.a_ready(nxt);
            if constexpr (SP2) {
            PG8_LDB(B0, 0, 0); PG8_LDB(B1, 0, 1); PG8_SCHED; PG8_LDA(At, 0, 0); PG8_STAGE(PG8_SA(1, 1), a1 + hstep, voffA);
            PG8_WAIT_V(8); PG8_WAIT_L(0); PG8_BAR; PG8_MMA(0, 0, At, B0); PG8_MMA(0, 1, At, B1); PG8_BAR; PG8_SCHED;
            PG8_LDA(At, 0, 1); PG8_STAGE(PG8_SB(0, 0), b2, voffB); PG8_STAGE(PG8_SB(0, 1), b2 + hstep, voffB); PG8_STAGE(PG8_SA(0, 0), a2, voffA);
            PG8_WAIT_V(8); PG8_WAIT_L(0); PG8_BAR; PG8_MMA(1, 0, At, B0); PG8_MMA(1, 1, At, B1); PG8_BAR; PG8_SCHED;
            PG8_LDB(B0, 1, 0); PG8_LDB(B1, 1, 1); PG8_SCHED; PG8_LDA(At, 1, 0); PG8_STAGE(PG8_SA(0, 1), a2 + hstep, voffA);
            PG8_WAIT_V(8); PG8_WAIT_L(0); PG8_BAR; PG8_MMA(0, 0, At, B0); PG8_MMA(0, 1, At, B1); PG8_BAR; PG8_SCHED;
            PG8_LDA(At, 1, 1); PG8_STAGE(PG8_SB(1, 0), b3, voffB); PG8_STAGE(PG8_SB(1, 1), b3 + hstep, voffB); PG8_STAGE(PG8_SA(1, 0), a3, voffA);
            PG8_WAIT_V(8); PG8_WAIT_L(0); PG8_BAR; PG8_MMA(1, 0, At, B0); PG8_MMA(1, 1, At, B1); PG8_BAR; PG8_SCHED;
            } else {
            PG8_LDB(B0, 0, 0); PG8_SCHED; PG8_LDA(At, 0, 0); PG8_STAGE(PG8_SA(1, 1), a1 + hstep, voffA);
            PG8_WAIT_L(8); PG8_BAR; PG8_WAIT_L(0); PG8_MMA(0, 0, At, B0); PG8_BAR; PG8_SCHED;
            PG8_LDB(B1, 0, 1); PG8_STAGE(PG8_SB(0, 0), b2, voffB);
            PG8_BAR; PG8_WAIT_L(0); PG8_MMA(0, 1, At, B1); PG8_BAR;
            PG8_LDA(At, 0, 1); PG8_STAGE(PG8_SA(0, 0), a2, voffA);
            PG8_BAR; PG8_WAIT_L(0); PG8_MMA(1, 0, At, B0); PG8_BAR; PG8_SCHED;
            PG8_STAGE(PG8_SB(0, 1), b2 + hstep, voffB);
            PG8_WAIT_V(6); PG8_BAR; PG8_MMA(1, 1, At, B1); PG8_BAR;
            PG8_LDB(B0, 1, 0); PG8_SCHED; PG8_LDA(At, 1, 0); PG8_STAGE(PG8_SA(0, 1), a2 + hstep, voffA);
            PG8_WAIT_L(8); PG8_BAR; PG8_WAIT_L(0); PG8_MMA(0, 0, At, B0); PG8_BAR; PG8_SCHED;
            PG8_LDB(B1, 1, 1); PG8_STAGE(PG8_SB(1, 0), b3, voffB);
            PG8_BAR; PG8_WAIT_L(0); PG8_MMA(0, 1, At, B1); PG8_BAR;
            PG8_LDA(At, 1, 1); PG8_STAGE(PG8_SA(1, 0), a3, voffA);
            PG8_BAR; PG8_WAIT_L(0); PG8_MMA(1, 0, At, B0); PG8_BAR; PG8_SCHED;
            PG8_STAGE(PG8_SB(1, 1), b3 + hstep, voffB);
            PG8_WAIT_V(6); PG8_BAR; PG8_MMA(1, 1, At, B1); PG8_BAR;
            }
        }
        if constexpr (ALIGN_EPI) { if (wr == 0) PG8_BAR; }
        if constexpr (!Epi::AFTER_DRAIN) { E(acc, cur, wr, wc, fr, fq); S.done(cur); }
        if (!has_next) break;
#pragma unroll
        for (int a = 0; a < 2; ++a)
#pragma unroll
            for (int b = 0; b < 2; ++b)
#pragma unroll
                for (int m = 0; m < 4; ++m)
#pragma unroll
                    for (int n = 0; n < 2; ++n) acc[a][b][m][n] = (f32x4){0.f, 0.f, 0.f, 0.f};
        cur = nxt; cA = nA; cB = nB; ++ui;
        if constexpr (ALIGN_EPI) { if (wr == 1) PG8_BAR; }
    }
    PG8_WAIT_V(0);
    if constexpr (!ALIGN_EPI) { if (wr == 0) PG8_BAR; }
    PG8_BAR;
    if constexpr (Epi::AFTER_DRAIN) { E.fused(acc, cur, wr, wc, fr, fq, lds, wid, lane); S.done(cur); }
#undef PG8_SA
#undef PG8_SB
#undef PG8_STAGE
#undef PG8_LDA
#undef PG8_LDB
#undef PG8_MMA
#undef PG8_WAIT_V
#undef PG8_WAIT_L
#undef PG8_BAR
#undef PG8_SCHED
}
}

#ifndef PG8_SP2
#define PG8_SP2 true
#endif
#ifndef PG8_ALIGN
#define PG8_ALIGN true
#endif
#define GAS __attribute__((address_space(1)))
#define LAS __attribute__((address_space(3)))
typedef unsigned short bf16;
typedef unsigned v4u __attribute__((ext_vector_type(4)));
typedef float f32x4 __attribute__((ext_vector_type(4)));
typedef short bf16x8 __attribute__((ext_vector_type(8)));
typedef GAS unsigned gu32;
typedef GAS unsigned long long gu64;
#define RLX_AGENT __ATOMIC_RELAXED, __HIP_MEMORY_SCOPE_AGENT
#define LDS_WAIT() asm volatile("s_waitcnt lgkmcnt(0)" ::: "memory")
#define VM_WAIT() asm volatile("s_waitcnt vmcnt(0)" ::: "memory")
__device__ __forceinline__ unsigned long long rt() { return __builtin_amdgcn_s_memrealtime(); }
__device__ __forceinline__ unsigned f2bf(float f) { unsigned u = __builtin_bit_cast(unsigned, f); return (u + 0x7fffu + ((u >> 16) & 1u)) >> 16; }
__device__ __forceinline__ unsigned pk2(float lo, float hi) { return f2bf(lo) | (f2bf(hi) << 16); }

#define XB_TMO      128
#define XB_XCNT(j)  (256  + 64 * (j))
#define XB_XSUB(j)  (1280 + 64 * (j))
#define XB_XGEN(j)  (2304 + 64 * (j))
#define XB_TOP      3328
#define XB_TOPGEN   3392
#define XCD_BAR_WORDS 3456
#define XB_SPIN_CAP (1u << 22)

__device__ __forceinline__ unsigned xb_ld(unsigned* p)              { return __hip_atomic_load(p, __ATOMIC_RELAXED, __HIP_MEMORY_SCOPE_AGENT); }
__device__ __forceinline__ unsigned xb_add(unsigned* p, unsigned v) { return __hip_atomic_fetch_add(p, v, __ATOMIC_RELAXED, __HIP_MEMORY_SCOPE_AGENT); }
__device__ __forceinline__ unsigned xb_xcc_id() { return (unsigned)__builtin_amdgcn_s_getreg((3 << 11) | 20) & 0xFu; }
#define XB_SPIN(cond, bar) do { unsigned _sp = 0; while (cond) { __builtin_amdgcn_s_sleep(1); \
    if ((++_sp & 255u) == 0u) { if (xb_ld(&(bar)[XB_TMO])) break; if (_sp > XB_SPIN_CAP) { atomicAdd(&(bar)[XB_TMO], 1u); break; } } } } while (0)

struct XcdBarrier {
    unsigned* bar; unsigned x;
    volatile LAS unsigned* st;
};

__device__ __forceinline__ XcdBarrier xcd_barrier_post(unsigned* bar, volatile LAS unsigned* st) {
    XcdBarrier b; b.bar = bar; b.x = xb_xcc_id(); b.st = st;
    if (threadIdx.x == 0) (void)xb_add(&bar[XB_XCNT(b.x)], 1u);
    return b;
}
__device__ __forceinline__ void xcd_barrier_complete(unsigned* bar, unsigned x, unsigned& nloc, unsigned& nx) {
    const unsigned G = gridDim.x * gridDim.y * gridDim.z;
    unsigned sum, cnt, mine, sp = 0u;
    for (;;) {
        sum = 0u; cnt = 0u; mine = 0u;
#pragma unroll
        for (unsigned j = 0; j < 16; ++j) { const unsigned c = xb_ld(&bar[XB_XCNT(j)]); sum += c; cnt += (c > 0u) ? 1u : 0u; mine = (j == x) ? c : mine; }
        if (sum == G) break;
        __builtin_amdgcn_s_sleep(1);
        if ((++sp & 255u) == 0u) { if (xb_ld(&bar[XB_TMO])) break; if (sp > XB_SPIN_CAP) { atomicAdd(&bar[XB_TMO], 1u); break; } }
    }
    nloc = mine > 0u ? mine : 1u; nx = cnt > 0u ? cnt : 1u;
}

__device__ __forceinline__ void xcd_barrier(const XcdBarrier& b) {
    asm volatile("s_waitcnt vmcnt(0)" ::: "memory");
    __syncthreads();
    if (threadIdx.x == 0) {
        unsigned* bar = b.bar;
        __builtin_amdgcn_s_waitcnt(0);
        unsigned nloc = b.st[0], nx = b.st[1];
        if (nloc == 0u) { xcd_barrier_complete(bar, b.x, nloc, nx); b.st[0] = nloc; b.st[1] = nx; }
        const unsigned old = xb_add(&bar[XB_XSUB(b.x)], 1u);
        const unsigned gen = old / nloc;
        if (old + 1u == (gen + 1u) * nloc) {
            __builtin_amdgcn_fence(__ATOMIC_RELEASE, "agent");
            asm volatile("s_waitcnt vmcnt(0)" ::: "memory");
            const unsigned og = xb_add(&bar[XB_TOP], 1u);
            const unsigned tg = og / nx;
            if (og + 1u == (tg + 1u) * nx) xb_add(&bar[XB_TOPGEN], 1u);
            else XB_SPIN(xb_ld(&bar[XB_TOPGEN]) == tg, bar);
            __builtin_amdgcn_fence(__ATOMIC_ACQUIRE, "agent");
            xb_add(&bar[XB_XGEN(b.x)], 1u);
            asm volatile("s_waitcnt vmcnt(0)" ::: "memory");
        } else {
            XB_SPIN(xb_ld(&bar[XB_XGEN(b.x)]) == gen, bar);
            __builtin_amdgcn_fence(__ATOMIC_ACQUIRE, "agent");
            asm volatile("s_waitcnt vmcnt(0)" ::: "memory");
        }
    }
    __syncthreads();
}

__device__ __forceinline__ void xcd_arrive(const XcdBarrier& b, volatile LAS unsigned* sx) {
    asm volatile("s_waitcnt vmcnt(0)" ::: "memory");
    __syncthreads();
    if (threadIdx.x == 0) {
        unsigned* bar = b.bar;
        __builtin_amdgcn_s_waitcnt(0);
        unsigned nloc = b.st[0], nx = b.st[1];
        if (nloc == 0u) { xcd_barrier_complete(bar, b.x, nloc, nx); b.st[0] = nloc; b.st[1] = nx; }
        const unsigned old = xb_add(&bar[XB_XSUB(b.x)], 1u);
        const unsigned gen = old / nloc;
        unsigned leader = 0u, key = gen;
        if (old + 1u == (gen + 1u) * nloc) {
            leader = 1u;
            __builtin_amdgcn_fence(__ATOMIC_RELEASE, "agent");
            asm volatile("s_waitcnt vmcnt(0)" ::: "memory");
            const unsigned og = xb_add(&bar[XB_TOP], 1u);
            const unsigned tg = og / nx; key = tg;
            if (og + 1u == (tg + 1u) * nx) xb_add(&bar[XB_TOPGEN], 1u);
        }
        sx[0] = leader; sx[1] = key;
    }
}
__device__ __forceinline__ void xcd_wait(const XcdBarrier& b, volatile LAS unsigned* sx) {
    if (threadIdx.x == 0) {
        unsigned* bar = b.bar;
        const unsigned leader = sx[0], key = sx[1];
        if (leader) {
            XB_SPIN(xb_ld(&bar[XB_TOPGEN]) == key, bar);
            __builtin_amdgcn_fence(__ATOMIC_ACQUIRE, "agent");
            xb_add(&bar[XB_XGEN(b.x)], 1u);
            asm volatile("s_waitcnt vmcnt(0)" ::: "memory");
        } else {
            XB_SPIN(xb_ld(&bar[XB_XGEN(b.x)]) == key, bar);
            __builtin_amdgcn_fence(__ATOMIC_ACQUIRE, "agent");
            asm volatile("s_waitcnt vmcnt(0)" ::: "memory");
        }
    }
    __syncthreads();
}

constexpr int NWAVES = 8;
constexpr int T_ = 16384, SEQ = 4096, DM = 1024, NPROJ = 2304, INC = 2312;
constexpr int PJ_K = 512, PJ_V = 640, PJ_Z = 768, PJ_XBC = 1280;
constexpr float EPS = 1e-6f;
constexpr size_t MiB = 1u << 20;
constexpr size_t WS_CTL = 0, CTL_ZERO_BYTES = 1 * MiB;
constexpr size_t WS_SMALL = 1 * MiB;
constexpr size_t WS_WIN = 2 * MiB, WS_WOUT = 7 * MiB, WS_WQ = 9 * MiB;
constexpr size_t WS_ED = 13 * MiB, WS_EU = 29 * MiB;
constexpr size_t WS_XN = 77 * MiB;
constexpr size_t WS_PROJ = 109 * MiB;
constexpr size_t WS_ST = 181 * MiB;
constexpr size_t WS_IDX = 213 * MiB, WS_GATE = 221 * MiB, WS_SSQ = 229 * MiB, WS_END = 230 * MiB;
constexpr size_t DO_Y = 0, DO_DT = 41 * MiB;
constexpr size_t WS_CC = 230 * MiB, WS_DT = 238 * MiB, WS_EA = 239 * MiB, WS_CDEC = 240 * MiB, WS_PREV = WS_IDX;
constexpr size_t DO_YPF = 0, DO_YPLAIN = 32 * MiB;
constexpr size_t WS_PART = WS_PROJ;
constexpr size_t WS_H8 = WS_XN, WS_HS = WS_DT;
constexpr size_t WS_SSQ2 = WS_EA;
constexpr int CW_BAR = 4096, CW_RANK = 8192;
constexpr int RING_OFF = 0, RING_BYTES = 147456, LDSCTL_OFF = RING_BYTES, MISC_OFF = LDSCTL_OFF + 320, LDS_BYTES = 163840;

__constant__ unsigned char c_bucket[128] = {0, 1, 2, 3, 4, 5, 6, 7, 8, 9, 10, 11, 12, 13, 14, 15, 16, 16, 16, 17, 17, 18, 18, 18, 19, 19, 19, 20, 20, 20, 20, 21, 21, 21, 21, 22, 22, 22, 22, 22, 23, 23, 23, 23, 23, 23, 24, 24, 24, 24, 24, 24, 25, 25, 25, 25, 25, 25, 25, 26, 26, 26, 26, 26, 26, 26, 26, 27, 27, 27, 27, 27, 27, 27, 27, 27, 27, 28, 28, 28, 28, 28, 28, 28, 28, 28, 28, 29, 29, 29, 29, 29, 29, 29, 29, 29, 29, 29, 29, 30, 30, 30, 30, 30, 30, 30, 30, 30, 30, 30, 30, 30, 30, 31, 31, 31, 31, 31, 31, 31, 31, 31, 31, 31, 31, 31, 31, 31};

typedef float v16f __attribute__((ext_vector_type(16)));
typedef float v32f __attribute__((ext_vector_type(32)));
typedef unsigned v6u __attribute__((ext_vector_type(6)));
typedef _Float16 v32h __attribute__((ext_vector_type(32)));
struct Frame {
    LAS unsigned char* lds;
    volatile LAS unsigned* MISC;
    gu32* ctl;
    int wave, vcu, G;
};
__device__ __forceinline__ int lane_id() { int l; asm volatile("v_mbcnt_lo_u32_b32 %0, -1, 0\n\tv_mbcnt_hi_u32_b32 %0, -1, %0" : "=v"(l)); return l; }
__device__ __forceinline__ int opq(int x) { asm volatile("" : "+v"(x)); return x; }
template <int M> __device__ __forceinline__ float swz_xor(float v) { return __int_as_float(__builtin_amdgcn_ds_swizzle(__float_as_int(v), (M << 10) | 0x1F)); }
__device__ __forceinline__ float sum_halves(float v) { const auto r = __builtin_amdgcn_permlane32_swap(__float_as_uint(v), __float_as_uint(v), false, false); return __uint_as_float(r[0]) + __uint_as_float(r[1]); }
__device__ __forceinline__ float max_halves(float v) { const auto r = __builtin_amdgcn_permlane32_swap(__float_as_uint(v), __float_as_uint(v), false, false); return fmaxf(__uint_as_float(r[0]), __uint_as_float(r[1])); }
__device__ __forceinline__ int imax_halves(int v) { const auto r = __builtin_amdgcn_permlane32_swap((unsigned)v, (unsigned)v, false, false); return max((int)r[0], (int)r[1]); }
__device__ __forceinline__ float wave_sum(float v) {
    v += swz_xor<1>(v); v += swz_xor<2>(v); v += swz_xor<4>(v); v += swz_xor<8>(v); v += swz_xor<16>(v);
    return sum_halves(v);
}
__device__ __forceinline__ float bf2f(unsigned short b) { return __uint_as_float((unsigned)b << 16); }
__device__ __forceinline__ float bflo(unsigned w) { return __uint_as_float(w << 16); }
__device__ __forceinline__ float bfhi(unsigned w) { return __uint_as_float(w & 0xffff0000u); }
__device__ __forceinline__ float silu_f(float x) { return x / (1.f + __expf(-x)); }

__device__ __forceinline__ void p0_transpose_item(const float* W, int ldw, int K, int nblk, bf16* WT, const float* kscale, LAS float* scr, int item, int lane) {
    const int kb = item / nblk, nb = item % nblk, k0 = 64 * kb, n0 = 32 * nb;
#pragma unroll 8
    for (int i = 0; i < 32; ++i) { const int kk = 2 * i + (lane >> 5); float v = W[(size_t)(k0 + kk) * ldw + n0 + (lane & 31)]; if (kscale) v *= kscale[k0 + kk]; scr[kk * 33 + (lane & 31)] = v; }
    LDS_WAIT(); asm volatile("" ::: "memory");
    const int c = lane & 7;
#pragma unroll
    for (int j = 0; j < 4; ++j) { const int n = (lane >> 3) + 8 * j; const LAS float* s = scr + (8 * c) * 33 + n;
        v4u o; o.x = pk2(s[0 * 33], s[1 * 33]); o.y = pk2(s[2 * 33], s[3 * 33]); o.z = pk2(s[4 * 33], s[5 * 33]); o.w = pk2(s[6 * 33], s[7 * 33]);
        *(GAS v4u*)(WT + (size_t)(n0 + n) * K + k0 + 8 * c) = o; }
    LDS_WAIT(); asm volatile("" ::: "memory");
}
struct Ptrs {
    const float *x, *norm_mix, *w_in, *conv_w, *conv_b, *dt_bias, *a_log, *d_skip, *ssd_norm_w, *sinks, *w_out, *rel_bias, *norm_ffn, *w_query, *sk1, *sk2, *e_down, *e_up, *norm_final;
    float* out; unsigned char* ws;
};
constexpr int Q_SPLIT = 0;
__device__ __forceinline__ unsigned pack4_i8(float a, float b, float c, float d) {
    const int ia = __float2int_rn(a), ib = __float2int_rn(b), ic = __float2int_rn(c), id = __float2int_rn(d);
    return (unsigned)(ia & 0xff) | ((unsigned)(ib & 0xff) << 8) | ((unsigned)(ic & 0xff) << 16) | ((unsigned)(id & 0xff) << 24);
}
__device__ __forceinline__ unsigned pack8_i4(const float* v, float inv) {
    unsigned o = 0u;
#pragma unroll
    for (int i = 0; i < 8; ++i) { int q = __float2int_rn(v[i] * inv); q = q < -7 ? -7 : (q > 7 ? 7 : q); o |= ((unsigned)q & 15u) << (4 * i); }
    return o;
}
__device__ __forceinline__ void quant_fp8s(const Ptrs& P, int lane_, int r_lo, int r_hi, int w, int nw) {
    float* SC = (float*)(P.ws + WS_SMALL);
    int row = r_lo + w;
    if (row >= r_hi) return;
    float4 nx[4];
#pragma unroll
    for (int q = 0; q < 4; ++q) nx[q] = ((const float4*)(P.e_down + (size_t)(row & 16383) * DM) + 4 * lane_)[q];
    float4 w4[4];
#pragma unroll
    for (int q = 0; q < 4; ++q) w4[q] = ((const float4*)P.norm_ffn)[4 * lane_ + q];
    for (; row < r_hi; row += nw) {
        const int e = row & 16383;
        float v[16];
#pragma unroll
        for (int q = 0; q < 4; ++q) { const float4 t = nx[q]; v[4 * q] = t.x * w4[q].x; v[4 * q + 1] = t.y * w4[q].y; v[4 * q + 2] = t.z * w4[q].z; v[4 * q + 3] = t.w * w4[q].w; }
        { const int rn = (row + nw < r_hi) ? row + nw : row;
#pragma unroll
          for (int q = 0; q < 4; ++q) nx[q] = ((const float4*)(P.e_down + (size_t)(rn & 16383) * DM) + 4 * lane_)[q]; }
        float ss = 0.f;
#pragma unroll
        for (int q = 0; q < 16; ++q) ss = fmaf(v[q], v[q], ss);
        const float sc = fmaxf(2.5f * sqrtf(wave_sum(ss) * (1.f / 1024.f)) * (1.f / 7.f), 1e-30f);
        const float inv = 1.f / sc;
        const unsigned long long o = (unsigned long long)pack8_i4(v, inv) | ((unsigned long long)pack8_i4(v + 8, inv) << 32);
        *(unsigned long long*)(P.ws + WS_ED + ((size_t)(lane_ >> 4) * 16384 + e) * 128 + (lane_ & 15) * 8) = o;
        if (lane_ == 0) SC[row] = sc;
    }
}
typedef float f32x2q __attribute__((ext_vector_type(2)));
__device__ __forceinline__ void quant_fp6u(const Ptrs& P, int lane_, int q_lo, int q_hi, int w, int nw) {
    float* SC = (float*)(P.ws + WS_SMALL); const int l31 = lane_ & 31, hf = lane_ >> 5;
    int q = q_lo + w;
    if (q >= q_hi) return;
    float4 nx[8];
#pragma unroll
    for (int k = 0; k < 8; ++k) nx[k] = ((const float4*)(P.e_up + (size_t)(2 * q + hf) * DM) + 8 * l31)[k];
    for (; q < q_hi; q += nw) {
        const int e = 2 * q + hf, row = 16384 + e;
        float v[32];
#pragma unroll
        for (int k = 0; k < 8; ++k) { const float4 t = nx[k]; v[4 * k] = t.x; v[4 * k + 1] = t.y; v[4 * k + 2] = t.z; v[4 * k + 3] = t.w; }
        { const int qn = (q + nw < q_hi) ? q + nw : q;
#pragma unroll
          for (int k = 0; k < 8; ++k) nx[k] = ((const float4*)(P.e_up + (size_t)(2 * qn + hf) * DM) + 8 * l31)[k]; }
        float am = 0.f;
#pragma unroll
        for (int k = 0; k < 32; ++k) am = fmaxf(am, fabsf(v[k]));
        am = fmaxf(am, swz_xor<1>(am)); am = fmaxf(am, swz_xor<2>(am)); am = fmaxf(am, swz_xor<4>(am)); am = fmaxf(am, swz_xor<8>(am)); am = fmaxf(am, swz_xor<16>(am));
        am = fmaxf(am, 1e-30f);
        const float inv = 6.0f / am;
        unsigned pk[4];
#pragma unroll
        for (int wd = 0; wd < 4; ++wd) { unsigned p4 = 0u;
            p4 = __builtin_amdgcn_cvt_scalef32_pk_fp4_f32(p4, v[8 * wd] * inv, v[8 * wd + 1] * inv, 1.0f, 0);
            p4 = __builtin_amdgcn_cvt_scalef32_pk_fp4_f32(p4, v[8 * wd + 2] * inv, v[8 * wd + 3] * inv, 1.0f, 1);
            p4 = __builtin_amdgcn_cvt_scalef32_pk_fp4_f32(p4, v[8 * wd + 4] * inv, v[8 * wd + 5] * inv, 1.0f, 2);
            p4 = __builtin_amdgcn_cvt_scalef32_pk_fp4_f32(p4, v[8 * wd + 6] * inv, v[8 * wd + 7] * inv, 1.0f, 3);
            pk[wd] = p4; }
        *(v4u*)(P.ws + WS_EU + (size_t)e * 512 + 16 * l31) = (v4u){pk[0], pk[1], pk[2], pk[3]};
        if (l31 == 0) SC[row] = am * (1.f / 6.0f);
    }
}
__device__ __forceinline__ void p0_prologue(Frame& F0, const Ptrs& P) {
    const Frame& F = F0; const int lane_ = lane_id(), tid_ = F.wave * 64 + lane_;
    LAS float* scr = (LAS float*)(F.lds + RING_OFF + F.wave * 16384);
    const int gw = F.vcu * NWAVES + F.wave, NGW = F.G * NWAVES;
    bf16* Win_t = (bf16*)(P.ws + WS_WIN); bf16* Wout_t = (bf16*)(P.ws + WS_WOUT); bf16* Wq_t = (bf16*)(P.ws + WS_WQ);
    constexpr int I_IN = 16 * 72;
    for (int it = gw; it < I_IN; it += NGW) p0_transpose_item(P.w_in, INC, DM, 72, Win_t, nullptr, scr, it, lane_);
    (void)Wout_t; (void)Wq_t;
    __syncthreads();
    { LAS float* Wdt = (LAS float*)(F.lds + RING_OFF);
      for (int i = tid_; i < 8192; i += 512) Wdt[i] = P.w_in[(size_t)(i >> 3) * INC + NPROJ + (i & 7)];
      __syncthreads();
      bf16* XN = (bf16*)(P.ws + WS_XN); float* DT = (float*)(P.ws + WS_DT);
      for (int m0 = gw * 2; m0 < T_; m0 += NGW * 2) {
        float4 xv[2][4];
#pragma unroll
        for (int rr = 0; rr < 2; ++rr) { const float4* xr = (const float4*)(P.x + (size_t)(m0 + rr) * DM);
#pragma unroll
            for (int j = 0; j < 4; ++j) xv[rr][j] = xr[j * 64 + lane_]; }
#pragma unroll
        for (int rr = 0; rr < 2; ++rr) { const int m = m0 + rr;
        float4 v[4]; float s = 0.f;
#pragma unroll
        for (int j = 0; j < 4; ++j) { v[j] = xv[rr][j]; s += v[j].x * v[j].x + v[j].y * v[j].y + v[j].z * v[j].z + v[j].w * v[j].w; }
        const float r = rsqrtf(wave_sum(s) * (1.f / 1024.f) + EPS);
        float d8[8];
#pragma unroll
        for (int q = 0; q < 8; ++q) d8[q] = 0.f;
        unsigned long long* o8 = (unsigned long long*)(XN + (size_t)m * DM);
#pragma unroll
        for (int j = 0; j < 4; ++j) { const float4 w = ((const float4*)P.norm_mix)[j * 64 + lane_];
            const float e0 = v[j].x * r * w.x, e1 = v[j].y * r * w.y, e2 = v[j].z * r * w.z, e3 = v[j].w * r * w.w;
            o8[j * 64 + lane_] = (unsigned long long)pk2(e0, e1) | ((unsigned long long)pk2(e2, e3) << 32);
            const float ev[4] = {e0, e1, e2, e3};
#pragma unroll
            for (int e = 0; e < 4; ++e) { const LAS f32x4* wr = (const LAS f32x4*)(Wdt + (size_t)(j * 256 + lane_ * 4 + e) * 8); const f32x4 w0 = wr[0], w1 = wr[1];
                d8[0] += ev[e] * w0.x; d8[1] += ev[e] * w0.y; d8[2] += ev[e] * w0.z; d8[3] += ev[e] * w0.w; d8[4] += ev[e] * w1.x; d8[5] += ev[e] * w1.y; d8[6] += ev[e] * w1.z; d8[7] += ev[e] * w1.w; } }
#pragma unroll
        for (int q = 0; q < 8; ++q) d8[q] = wave_sum(d8[q]);
        if (lane_ == 0) { float4* dp = (float4*)(DT + (size_t)m * 8); dp[0] = make_float4(d8[0], d8[1], d8[2], d8[3]); dp[1] = make_float4(d8[4], d8[5], d8[6], d8[7]); }
        }
      }
      __syncthreads(); }
}

__device__ __forceinline__ void p1_slack(Frame& F0, const Ptrs& P, int w, int nw) {
    const Frame& F = F0; const int lane_ = lane_id();
    LAS float* scr = (LAS float*)(F.lds + RING_OFF + F.wave * 16384);
    bf16* Wout_t = (bf16*)(P.ws + WS_WOUT); bf16* Wq_t = (bf16*)(P.ws + WS_WQ);
    constexpr int I_OUT = 16 * 32, I_Q = 16 * 64;
    for (int it = w; it < I_OUT + I_Q; it += nw) {
        if (it < I_OUT) p0_transpose_item(P.w_out, DM, DM, 32, Wout_t, nullptr, scr, it, lane_);
        else p0_transpose_item(P.w_query, 2048, DM, 64, Wq_t, P.norm_ffn, scr, it - I_OUT, lane_);
    }
    quant_fp6u(P, lane_, 0, 8192, w, nw);
    quant_fp8s(P, lane_, 0, 16384, w, nw);
}
struct EpiResH {
    static constexpr bool PERM = false, AFTER_DRAIN = false;
    const float* X; bf16* HB; float* SSQ;
    __device__ __forceinline__ void operator()(const pg8::f32x4 (&acc)[2][2][4][2], const pg8::Unit& u, int wr, int wc, int fr, int fq) const {
        const int row0 = u.pm * 256 + wr * 64 + fr, col0 = u.pn * 256 + wc * 32 + 4 * fq;
#pragma unroll
        for (int ai = 0; ai < 2; ++ai)
#pragma unroll
            for (int m = 0; m < 4; ++m) { const int row = row0 + ai * 128 + m * 16; float ss = 0.f;
#pragma unroll
                for (int bj = 0; bj < 2; ++bj)
#pragma unroll
                    for (int n = 0; n < 2; ++n) { const size_t off = (size_t)row * DM + col0 + bj * 128 + n * 16;
                        const pg8::f32x4 h = acc[ai][bj][m][n] + *(const pg8::f32x4*)(X + off);
                        ss += h[0] * h[0] + h[1] * h[1] + h[2] * h[2] + h[3] * h[3];
                        *(unsigned long long*)(HB + off) = (unsigned long long)pk2(h[0], h[1]) | ((unsigned long long)pk2(h[2], h[3]) << 32); }
                ss += swz_xor<16>(ss); ss = sum_halves(ss);
                if (fq == 0) SSQ[(size_t)row * 16 + u.pn * 4 + wc] = ss; }
    }
};

typedef float f32x16 __attribute__((ext_vector_type(16)));
typedef short s16x4 __attribute__((ext_vector_type(4)));
typedef float f32x2_t __attribute__((ext_vector_type(2)));
typedef __bf16 bf16x2_t __attribute__((ext_vector_type(2)));
#define MFMA32(a, b, c) __builtin_amdgcn_mfma_f32_32x32x16_bf16((a), (b), (c), 0, 0, 0)
__device__ __forceinline__ int crow(int reg, int h) { return (reg & 3) + 8 * (reg >> 2) + 4 * h; }
__device__ __forceinline__ unsigned cvtpk(float lo, float hi) { f32x2_t v = {lo, hi}; bf16x2_t b = __builtin_convertvector(v, bf16x2_t); return __builtin_bit_cast(unsigned, b); }
__device__ __forceinline__ bf16x8 pack8(const f32x16& x, int s) {
    v4u p; p.x = cvtpk(x[8 * s], x[8 * s + 1]); p.y = cvtpk(x[8 * s + 2], x[8 * s + 3]); p.z = cvtpk(x[8 * s + 4], x[8 * s + 5]); p.w = cvtpk(x[8 * s + 6], x[8 * s + 7]);
    return __builtin_bit_cast(bf16x8, p);
}
constexpr float LOG2E = 1.4426950408889634f;
constexpr int LDP = 136;
constexpr int S1_XT = 0, S1_XTW = 17408, S1_BSN = 34816, S1_CLN = 69632, S1_BNL = 104448, S1_F32 = 139264;

__device__ __forceinline__ float silu_fast(float x) { return x * __builtin_amdgcn_rcpf(1.f + __builtin_amdgcn_exp2f(-x * LOG2E)); }
__device__ __forceinline__ int swz_t(int row, int l) { return row * LDP + ((((l >> 3) ^ (row >> 3)) & 7) | ((l >> 3) & 8)) * 8 + (l & 7); }
#define S1_CONV8(A_, IT_) do { _Pragma("unroll") for (int e_ = 0; e_ < 8; ++e_) A_[e_] = bias[e_]; \
        _Pragma("unroll") for (int j_ = 0; j_ < 4; ++j_) { const v4u rw_ = raw[(IT_) + j_]; \
            A_[0] += w[j_][0] * bflo(rw_.x); A_[1] += w[j_][1] * bfhi(rw_.x); A_[2] += w[j_][2] * bflo(rw_.y); A_[3] += w[j_][3] * bfhi(rw_.y); \
            A_[4] += w[j_][4] * bflo(rw_.z); A_[5] += w[j_][5] * bfhi(rw_.z); A_[6] += w[j_][6] * bflo(rw_.w); A_[7] += w[j_][7] * bfhi(rw_.w); } \
        _Pragma("unroll") for (int e_ = 0; e_ < 8; ++e_) A_[e_] = silu_fast(A_[e_]); } while (0)
#define S1_LOADW(CHB_) do { _Pragma("unroll") for (int j_ = 0; j_ < 4; ++j_) { const float4 w0_ = *(const float4*)(P.conv_w + j_ * 1024 + (CHB_)), w1_ = *(const float4*)(P.conv_w + j_ * 1024 + (CHB_) + 4); \
            w[j_][0] = w0_.x; w[j_][1] = w0_.y; w[j_][2] = w0_.z; w[j_][3] = w0_.w; w[j_][4] = w1_.x; w[j_][5] = w1_.y; w[j_][6] = w1_.z; w[j_][7] = w1_.w; } \
        { const float4 b0_ = *(const float4*)(P.conv_b + (CHB_)), b1_ = *(const float4*)(P.conv_b + (CHB_) + 4); \
          bias[0] = b0_.x; bias[1] = b0_.y; bias[2] = b0_.z; bias[3] = b0_.w; bias[4] = b1_.x; bias[5] = b1_.y; bias[6] = b1_.z; bias[7] = b1_.w; } } while (0)
__device__ __forceinline__ void ssd_s1(Frame& F, const Ptrs& P) {
    const bf16* PROJ = (const bf16*)(P.ws + WS_PROJ); const float* DT = (const float*)(P.ws + WS_DT);
    float* EA = (float*)(P.ws + WS_EA); float* CDEC = (float*)(P.ws + WS_CDEC); bf16* CC = (bf16*)(P.ws + WS_CC);
    unsigned* ST = (unsigned*)(P.ws + WS_ST); unsigned* YPF = (unsigned*)((char*)P.out + DO_YPF);
    LAS unsigned char* L = F.lds + RING_OFF;
    LAS bf16* Xt = (LAS bf16*)(L + S1_XT); LAS bf16* Xtw = (LAS bf16*)(L + S1_XTW); LAS bf16* Bsn = (LAS bf16*)(L + S1_BSN); LAS bf16* Cln = (LAS bf16*)(L + S1_CLN); LAS bf16* Bnl = (LAS bf16*)(L + S1_BNL);
    LAS float* f32base = (LAS float*)(L + S1_F32);
    const int lane = lane_id(); const int tid_ = F.wave * 64 + lane;
    for (int ug = F.vcu; ug < 256; ug += F.G) {
        const int grp = ug & 1, c = (ug >> 1) & 31, b = ug >> 6, t0 = b * SEQ + c * 128;
        __syncthreads();
        if (F.wave < 4) {
            const int h = 4 * grp + F.wave, us = (b * 32 + c) * 8 + h;
            const float A = -__expf(P.a_log[h]), dtb = P.dt_bias[h];
            const int ln = opq(lane_id());
            LAS float* acum2 = f32base + F.wave * 384; LAS float* wv = acum2 + 128; LAS float* wend = wv + 128;
            const float x0 = DT[(size_t)(t0 + 2 * ln) * 8 + h] + dtb, x1 = DT[(size_t)(t0 + 2 * ln + 1) * 8 + h] + dtb;
            const float dt0 = fmaxf(x0, 0.f) + log1pf(__expf(-fabsf(x0))), dt1 = fmaxf(x1, 0.f) + log1pf(__expf(-fabsf(x1)));
            const float a0 = dt0 * A, a1 = dt1 * A;
            float s = a0 + a1;
#pragma unroll
            for (int o = 1; o < 64; o <<= 1) { const float v = __int_as_float(__builtin_amdgcn_ds_bpermute((ln - o) * 4, __float_as_int(s))); if (ln >= o) s += v; }
            const float ac1 = s, ac0 = s - a1, tot = __uint_as_float(__builtin_amdgcn_readlane(__float_as_uint(s), 63));
            acum2[2 * ln] = ac0 * LOG2E; acum2[2 * ln + 1] = ac1 * LOG2E;
            wv[2 * ln] = log2f(dt0) - ac0 * LOG2E; wv[2 * ln + 1] = log2f(dt1) - ac1 * LOG2E;
            wend[2 * ln] = dt0 * exp2f((tot - ac0) * LOG2E); wend[2 * ln + 1] = dt1 * exp2f((tot - ac1) * LOG2E);
            EA[(size_t)(t0 + 2 * ln) * 8 + h] = exp2f(ac0 * LOG2E); EA[(size_t)(t0 + 2 * ln + 1) * 8 + h] = exp2f(ac1 * LOG2E);
            if (ln == 0) CDEC[us] = exp2f(tot * LOG2E);
        }
        { const int tidc = opq(tid_);
          if (tidc < 440) {
            const int cg = tidc % 40, sg = tidc / 40, l0 = 12 * sg, h0 = 4 * grp;
            int chb; if (cg < 8) chb = h0 * 64 + cg * 8; else if (cg < 24) chb = 512 + grp * 128 + (cg - 8) * 8; else chb = 768 + grp * 128 + (cg - 24) * 8;
            v4u raw[15];
#pragma unroll
            for (int q = 0; q < 15; ++q) { const int ss = c * 128 + l0 - 3 + q; raw[q] = (v4u){0u, 0u, 0u, 0u};
                if (ss >= 0 && l0 - 3 + q < 128) raw[q] = *(const v4u*)(PROJ + (size_t)(b * SEQ + ss) * NPROJ + PJ_XBC + chb); }
            float w[4][8], bias[8]; S1_LOADW(chb);
#pragma unroll
            for (int it = 0; it < 12; it += 2) {
                const int l = l0 + it;
                if (l < 128) {
                    float a[8], a2[8]; S1_CONV8(a, it); S1_CONV8(a2, it + 1);
                    if (cg < 8) {
#pragma unroll
                        for (int e = 0; e < 8; ++e) *(LAS unsigned*)(Xt + swz_t(cg * 8 + e, l)) = cvtpk(a[e], a2[e]);
                    } else {
                        v4u o, o2; o.x = cvtpk(a[0], a[1]); o.y = cvtpk(a[2], a[3]); o.z = cvtpk(a[4], a[5]); o.w = cvtpk(a[6], a[7]);
                        o2.x = cvtpk(a2[0], a2[1]); o2.y = cvtpk(a2[2], a2[3]); o2.z = cvtpk(a2[4], a2[5]); o2.w = cvtpk(a2[6], a2[7]);
                        if (cg < 24) { const int n0 = (cg - 8) * 8; *(LAS v4u*)(Bsn + l * LDP + n0) = o; *(LAS v4u*)(Bsn + (l + 1) * LDP + n0) = o2;
#pragma unroll
                            for (int e = 0; e < 8; ++e) *(LAS unsigned*)(Bnl + swz_t(n0 + e, l)) = cvtpk(a[e], a2[e]);
                        } else { const int n0 = (cg - 24) * 8; *(LAS v4u*)(Cln + l * LDP + n0) = o; *(LAS v4u*)(Cln + (l + 1) * LDP + n0) = o2;
                            *(v4u*)(CC + (size_t)(t0 + l) * 256 + grp * 128 + n0) = o; *(v4u*)(CC + (size_t)(t0 + l + 1) * 256 + grp * 128 + n0) = o2; }
                    }
                }
            }
          } }
        __syncthreads();
#pragma unroll 1
        for (int hi = 0; hi < 4; ++hi) {
            const int h = 4 * grp + hi, u = (b * 32 + c) * 8 + h;
            const float Dh = P.d_skip[h];
            const LAS float* acum2 = f32base + hi * 384; const LAS float* wv = acum2 + 128; const LAS float* wend = wv + 128;
            const LAS bf16* Xc = (hi & 1) ? Xtw : Xt; LAS bf16* Xn = (hi & 1) ? Xt : Xtw;
            const int tidc = opq(tid_);
            const int cgn = tidc & 7, ln_ = 2 * (tidc >> 3), chn = (h + 1) * 64 + cgn * 8;
            v4u raw[5];
#pragma unroll
            for (int q = 0; q < 5; ++q) { const int ss = c * 128 + ln_ - 3 + q; raw[q] = (v4u){0u, 0u, 0u, 0u};
                if (hi < 3 && ss >= 0) raw[q] = *(const v4u*)(PROJ + (size_t)(b * SEQ + ss) * NPROJ + PJ_XBC + chn); }
            const int ln3 = opq(lane), r = ln3 & 31, hh = ln3 >> 5;
            if (F.wave < 4) {
                const int pt = F.wave >> 1;
#pragma unroll 1
                for (int q = 0; q < 2; ++q) {
                    const int lt = (F.wave & 1) ? (1 + q) : (3 * q);
                    f32x16 yacc;
#pragma unroll
                    for (int i = 0; i < 16; ++i) yacc[i] = 0.f;
                    const float al = acum2[32 * lt + r];
                    bf16x8 cf[8];
#pragma unroll
                    for (int kk = 0; kk < 8; ++kk) cf[kk] = *(const LAS bf16x8*)(Cln + (32 * lt + r) * LDP + 16 * kk + 8 * hh);
#pragma unroll 1
                    for (int st = 0; st <= lt; ++st) {
                        bf16x8 bfr[8];
#pragma unroll
                        for (int kk = 0; kk < 8; ++kk) bfr[kk] = *(const LAS bf16x8*)(Bsn + (32 * st + r) * LDP + 16 * kk + 8 * hh);
                        f32x4 wq[4];
#pragma unroll
                        for (int g4 = 0; g4 < 4; ++g4) wq[g4] = *(const LAS f32x4*)(wv + 32 * st + 8 * g4 + 4 * hh);
                        s16x4 xlo[2], xhi[2];
#pragma unroll
                        for (int sg = 0; sg < 2; ++sg) { const int prow = 32 * pt + r, lb = 32 * st + 16 * sg;
                            xlo[sg] = *(const LAS s16x4*)(Xc + swz_t(prow, lb) + 4 * hh); xhi[sg] = *(const LAS s16x4*)(Xc + swz_t(prow, lb + 8) + 4 * hh); }
                        __builtin_amdgcn_sched_barrier(0);
                        f32x16 macc;
#pragma unroll
                        for (int i = 0; i < 16; ++i) macc[i] = 0.f;
#pragma unroll
                        for (int kk = 0; kk < 8; ++kk) macc = MFMA32(bfr[kk], cf[kk], macc);
#pragma unroll
                        for (int i = 0; i < 16; ++i) { const int sl = crow(i, hh);
                            float f = __builtin_amdgcn_exp2f(al + wq[i >> 2][i & 3]);
                            if (st == lt && sl > r) f = 0.f;
                            macc[i] *= f; }
#pragma unroll
                        for (int sg = 0; sg < 2; ++sg) {
                            const bf16x8 bfrag = pack8(macc, sg);
                            const bf16x8 afrag = __builtin_shufflevector(xlo[sg], xhi[sg], 0, 1, 2, 3, 4, 5, 6, 7);
                            yacc = MFMA32(afrag, bfrag, yacc);
                        }
                    }
                    unsigned short xs16[16];
#pragma unroll
                    for (int i = 0; i < 16; ++i) xs16[i] = *(const LAS unsigned short*)(Xc + swz_t(32 * pt + crow(i, hh), 32 * lt + r));
                    __builtin_amdgcn_sched_barrier(0);
#pragma unroll
                    for (int i = 0; i < 16; i += 2) {
                        const float y0 = yacc[i] + Dh * __uint_as_float((unsigned)xs16[i] << 16), y1 = yacc[i + 1] + Dh * __uint_as_float((unsigned)xs16[i + 1] << 16);
                        YPF[((((size_t)u * 4 + lt) * 2 + pt) * 8 + (i >> 1)) * 64 + ln3] = cvtpk(y0, y1); }
                }
            } else {
                const int nt = F.wave - 4;
                bf16x8 bb[8];
                { v4u braw[8]; f32x4 we[8][2];
#pragma unroll
                  for (int kk = 0; kk < 8; ++kk) { braw[kk] = *(const LAS v4u*)(Bnl + swz_t(32 * nt + r, 16 * kk + 8 * hh));
                      we[kk][0] = *(const LAS f32x4*)(wend + 16 * kk + 8 * hh); we[kk][1] = *(const LAS f32x4*)(wend + 16 * kk + 8 * hh + 4); }
#pragma unroll
                  for (int kk = 0; kk < 8; ++kk) { v4u o;
                      o.x = cvtpk(bflo(braw[kk].x) * we[kk][0][0], bfhi(braw[kk].x) * we[kk][0][1]); o.y = cvtpk(bflo(braw[kk].y) * we[kk][0][2], bfhi(braw[kk].y) * we[kk][0][3]);
                      o.z = cvtpk(bflo(braw[kk].z) * we[kk][1][0], bfhi(braw[kk].z) * we[kk][1][1]); o.w = cvtpk(bflo(braw[kk].w) * we[kk][1][2], bfhi(braw[kk].w) * we[kk][1][3]);
                      bb[kk] = __builtin_bit_cast(bf16x8, o); } }
#pragma unroll 1
                for (int pt = 0; pt < 2; ++pt) {
                    bf16x8 xa[8];
#pragma unroll
                    for (int kk = 0; kk < 8; ++kk) xa[kk] = *(const LAS bf16x8*)(Xc + swz_t(32 * pt + r, 16 * kk + 8 * hh));
                    __builtin_amdgcn_sched_barrier(0);
                    f32x16 sacc;
#pragma unroll
                    for (int i = 0; i < 16; ++i) sacc[i] = 0.f;
#pragma unroll
                    for (int kk = 0; kk < 8; ++kk) sacc = MFMA32(xa[kk], bb[kk], sacc);
#pragma unroll
                    for (int i = 0; i < 16; i += 2) ST[((size_t)u * 32 + 16 * pt + (crow(i, hh) >> 1)) * 128 + 32 * nt + r] = cvtpk(sacc[i], sacc[i + 1]);
                }
            }
            if (hi < 3) {
                const int cg = cgn, l = ln_;
                float w[4][8], bias[8]; S1_LOADW(chn);
                float a[8], a2[8]; S1_CONV8(a, 0); S1_CONV8(a2, 1);
#pragma unroll
                for (int e = 0; e < 8; ++e) *(LAS unsigned*)(Xn + swz_t(cg * 8 + e, l)) = cvtpk(a[e], a2[e]);
            }
            __syncthreads();
        }
    }
}
__device__ __forceinline__ void ssd_s2(Frame& F, const Ptrs& P) {
    const unsigned* ST = (const unsigned*)(P.ws + WS_ST); const float* CDEC = (const float*)(P.ws + WS_CDEC); unsigned* PREV = (unsigned*)(P.ws + WS_PREV);
    for (int g = F.vcu * 512 + (F.wave * 64 + lane_id()); g < 65536; g += F.G * 512) {
        const int n2 = g & 63, p2 = (g >> 6) & 31, h = (g >> 11) & 7, b = g >> 14;
        uint2 st[32];
#pragma unroll
        for (int c = 0; c < 32; ++c) st[c] = *(const uint2*)(ST + ((size_t)(((b * 32 + c) * 8 + h) * 32 + p2)) * 128 + 2 * n2);
        float r00 = 0.f, r01 = 0.f, r10 = 0.f, r11 = 0.f;
#pragma unroll
        for (int c = 0; c < 32; ++c) { const size_t u = (size_t)((b * 32 + c) * 8 + h);
            PREV[((u * 64 + 2 * p2) * 128 + 2 * n2) >> 1] = cvtpk(r00, r01); PREV[((u * 64 + 2 * p2 + 1) * 128 + 2 * n2) >> 1] = cvtpk(r10, r11);
            const float d = CDEC[u];
            r00 = r00 * d + bflo(st[c].x); r10 = r10 * d + bfhi(st[c].x); r01 = r01 * d + bflo(st[c].y); r11 = r11 * d + bfhi(st[c].y); }
    }
}
__device__ __forceinline__ void ssd_s3(Frame& F, const Ptrs& P) {
    const bf16* CC = (const bf16*)(P.ws + WS_CC); const bf16* PREV = (const bf16*)(P.ws + WS_PREV); const float* EA = (const float*)(P.ws + WS_EA);
    const unsigned* YPF = (const unsigned*)((const char*)P.out + DO_YPF); const bf16* PROJ = (const bf16*)(P.ws + WS_PROJ); bf16* CAT = (bf16*)(P.ws + WS_XN);
    LAS float* red = (LAS float*)(F.lds + RING_OFF);
    const int lane = lane_id(), r = lane & 31, hh = lane >> 5, h = F.wave, grp = h >> 2;
    for (int v = F.vcu; v < 512; v += F.G) {
        const int lt = v & 3, c = (v >> 2) & 31, b = v >> 7;
        const int t = b * SEQ + c * 128 + lt * 32 + r; const size_t u = (size_t)((b * 32 + c) * 8 + h);
        unsigned ypf[2][8]; unsigned long long zz[2][4];
#pragma unroll
        for (int pt = 0; pt < 2; ++pt) {
#pragma unroll
            for (int i = 0; i < 8; ++i) ypf[pt][i] = YPF[((((size_t)u * 4 + lt) * 2 + pt) * 8 + i) * 64 + lane];
#pragma unroll
            for (int g4 = 0; g4 < 4; ++g4) zz[pt][g4] = *(const unsigned long long*)(PROJ + (size_t)t * NPROJ + PJ_Z + h * 64 + 32 * pt + 8 * g4 + 4 * hh); }
        const float ea = EA[(size_t)t * 8 + h];
        f32x16 acc[2];
#pragma unroll
        for (int i = 0; i < 16; ++i) { acc[0][i] = 0.f; acc[1][i] = 0.f; }
#pragma unroll
        for (int kk = 0; kk < 8; ++kk) {
            const bf16x8 bb = *(const bf16x8*)(CC + (size_t)t * 256 + grp * 128 + 16 * kk + 8 * hh);
#pragma unroll
            for (int pt = 0; pt < 2; ++pt) { const bf16x8 a = *(const bf16x8*)(PREV + (u * 64 + 32 * pt + r) * 128 + 16 * kk + 8 * hh); acc[pt] = MFMA32(a, bb, acc[pt]); }
        }
        float ss = 0.f;
#pragma unroll
        for (int pt = 0; pt < 2; ++pt)
#pragma unroll
            for (int g4 = 0; g4 < 4; ++g4) {
                const unsigned z01 = (unsigned)zz[pt][g4], z23 = (unsigned)(zz[pt][g4] >> 32);
                const float zf[4] = {bflo(z01), bfhi(z01), bflo(z23), bfhi(z23)};
#pragma unroll
                for (int e = 0; e < 4; ++e) { const int i = 4 * g4 + e;
                    const float y = acc[pt][i] * ea + ((i & 1) ? bfhi(ypf[pt][i >> 1]) : bflo(ypf[pt][i >> 1]));
                    const float yg = y * silu_fast(zf[e]); acc[pt][i] = yg; ss = fmaf(yg, yg, ss); }
            }
        ss = sum_halves(ss);
        if (hh == 0) red[h * 32 + r] = ss;
        __syncthreads();
        float tot = 0.f;
#pragma unroll
        for (int w = 0; w < 8; ++w) tot += red[w * 32 + r];
        const float rn = rsqrtf(tot * (1.f / 512.f) + EPS);
#pragma unroll
        for (int pt = 0; pt < 2; ++pt)
#pragma unroll
            for (int g4 = 0; g4 < 4; ++g4) { const int ch = h * 64 + 32 * pt + 8 * g4 + 4 * hh;
                const float4 w = *(const float4*)(P.ssd_norm_w + ch);
                *(unsigned long long*)(CAT + (size_t)t * DM + 512 + ch) = (unsigned long long)cvtpk(acc[pt][4 * g4] * rn * w.x, acc[pt][4 * g4 + 1] * rn * w.y) | ((unsigned long long)cvtpk(acc[pt][4 * g4 + 2] * rn * w.z, acc[pt][4 * g4 + 3] * rn * w.w) << 32); }
        __syncthreads();
    }
}
__device__ __forceinline__ float gelu_erf(float v) { return 0.5f * v * (1.f + erff(v * 0.70710678118654752f)); }
typedef float f32x2v __attribute__((ext_vector_type(2)));
#define CVT8(W, LO) __builtin_amdgcn_cvt_pk_f32_fp8((int)(W), LO)
template <int CTRL> __device__ __forceinline__ float dpp_f(float v) { return __int_as_float(__builtin_amdgcn_update_dpp(0, __float_as_int(v), CTRL, 0xF, 0xF, true)); }
__device__ __forceinline__ float sum8_dpp(float s) { s += dpp_f<0xB1>(s); s += dpp_f<0x4E>(s); s += dpp_f<0x141>(s); return s; }
struct PeerPlace { int vx, nx, rank, nloc; };
__device__ __forceinline__ PeerPlace peer_place(Frame& F) {
    __syncthreads();
    if (F.wave == 0 && lane_id() == 0) {
        unsigned* bar = (unsigned*)(F.ctl + CW_BAR); const unsigned x = xb_xcc_id();
        unsigned vx = 0, nx = 0;
        for (unsigned j = 0; j < 16; ++j) { const unsigned c = xb_ld(&bar[XB_XCNT(j)]); if (c) { if (j < x) ++vx; ++nx; } }
        const unsigned rank = xb_add((unsigned*)(F.ctl + CW_RANK) + 64 * x, 1u);
        F.MISC[10] = vx; F.MISC[11] = nx ? nx : 1u; F.MISC[12] = rank; F.MISC[13] = xb_ld(&bar[XB_XCNT(x)]);
    }
    __syncthreads();
    PeerPlace pp; pp.vx = (int)F.MISC[10]; pp.nx = (int)F.MISC[11]; pp.rank = (int)F.MISC[12]; pp.nloc = (int)F.MISC[13]; if (pp.nloc < 1) pp.nloc = 1;
    return pp;
}
__device__ __forceinline__ void h_quant_rows(Frame& F, const Ptrs& P) {
    const bf16* HB = (const bf16*)(P.ws + WS_ST); unsigned char* H8 = P.ws + WS_H8; float* HS = (float*)(P.ws + WS_HS);
    const int lane = lane_id();
    for (int t = F.vcu * NWAVES + F.wave; t < T_; t += F.G * NWAVES) {
        const v4u a0 = ((const v4u*)(HB + (size_t)t * DM))[2 * lane], a1 = ((const v4u*)(HB + (size_t)t * DM))[2 * lane + 1];
        float hf[16];
        hf[0] = bflo(a0.x); hf[1] = bfhi(a0.x); hf[2] = bflo(a0.y); hf[3] = bfhi(a0.y); hf[4] = bflo(a0.z); hf[5] = bfhi(a0.z); hf[6] = bflo(a0.w); hf[7] = bfhi(a0.w);
        hf[8] = bflo(a1.x); hf[9] = bfhi(a1.x); hf[10] = bflo(a1.y); hf[11] = bfhi(a1.y); hf[12] = bflo(a1.z); hf[13] = bfhi(a1.z); hf[14] = bflo(a1.w); hf[15] = bfhi(a1.w);
        float am = 0.f;
#pragma unroll
        for (int i = 0; i < 16; ++i) am = fmaxf(am, fabsf(hf[i]));
        am = fmaxf(am, dpp_f<0xB1>(am)); am = fmaxf(am, dpp_f<0x4E>(am)); am = fmaxf(am, dpp_f<0x141>(am)); am = fmaxf(am, dpp_f<0x140>(am)); am = fmaxf(am, 1e-30f);
        const float inv = 119.f / am;
        unsigned hi[2] = {0u, 0u}, lo[2] = {0u, 0u};
#pragma unroll
        for (int i = 0; i < 16; ++i) { const int q = __float2int_rn(hf[i] * inv); const int qh = (q + 8) >> 4, ql = q - 16 * qh;
            hi[i >> 3] |= ((unsigned)qh & 15u) << (4 * (i & 7)); lo[i >> 3] |= ((unsigned)ql & 15u) << (4 * (i & 7)); }
        unsigned char* dst = H8 + (size_t)t * 1024 + (lane >> 4) * 256 + (lane & 15) * 8;
        *(unsigned long long*)dst = (unsigned long long)hi[0] | ((unsigned long long)hi[1] << 32);
        *(unsigned long long*)(dst + 128) = (unsigned long long)lo[0] | ((unsigned long long)lo[1] << 32);
        if ((lane & 15) == 0) HS[(size_t)t * 8 + (lane >> 4)] = am * (1.f / 119.f);
    }
}
constexpr int PX_D = 16;
template <int CTRL> __device__ __forceinline__ int dpp_i(int v) { return __builtin_amdgcn_update_dpp(0, v, CTRL, 0xF, 0xF, true); }
#define PX_ISSUE(BUF, LO, HI) _Pragma("unroll") for (int b_ = 0; b_ < 8; ++b_) { const unsigned off_ = ((unsigned)__builtin_amdgcn_ds_bpermute((16 * (b_ & 3) + ps) * 4, (b_ & 4) ? (HI) : (LO)) << 7) | (unsigned)(dl << 5); \
        BUF[2 * b_] = *(const v4u*)(tab + off_); BUF[2 * b_ + 1] = *(const v4u*)(tab + off_ + 16); }
struct H4 { v4u h0, h1, l0, l1; };
#define PX_DOT8(Q, HH, HL) ah = __builtin_amdgcn_sdot8((int)(Q), (int)(HH), ah, false); al = __builtin_amdgcn_sdot8((int)(Q), (int)(HL), al, false);
__device__ __forceinline__ void peer_down_token(const v4u (&cur)[PX_D], const H4& h, const float hs, float* prow, int dl, int ps) {
    int sm[8];
#pragma unroll
    for (int b = 0; b < 8; ++b) { const v4u q0 = cur[2 * b], q1 = cur[2 * b + 1];
        int ah = 0, al = 0;
        PX_DOT8(q0.x, h.h0.x, h.l0.x) PX_DOT8(q0.y, h.h0.y, h.l0.y) PX_DOT8(q0.z, h.h0.z, h.l0.z) PX_DOT8(q0.w, h.h0.w, h.l0.w)
        PX_DOT8(q1.x, h.h1.x, h.l1.x) PX_DOT8(q1.y, h.h1.y, h.l1.y) PX_DOT8(q1.z, h.h1.z, h.l1.z) PX_DOT8(q1.w, h.h1.w, h.l1.w)
        sm[b] = 16 * ah + al; }
    const bool c1 = (dl & 2) != 0, c0 = (dl & 1) != 0;
    int w4[4], w2[2];
#pragma unroll
    for (int k = 0; k < 4; ++k) { const int keep = c1 ? sm[4 + k] : sm[k], send = c1 ? sm[k] : sm[4 + k]; w4[k] = keep + dpp_i<0x4E>(send); }
#pragma unroll
    for (int k = 0; k < 2; ++k) { const int keep = c0 ? w4[2 + k] : w4[k], send = c0 ? w4[k] : w4[2 + k]; w2[k] = keep + dpp_i<0xB1>(send); }
    prow[32 * dl + ps] = (float)w2[0] * hs; prow[32 * dl + 16 + ps] = (float)w2[1] * hs;
}
__device__ __forceinline__ void peer_down(Frame& F, const Ptrs& P, const PeerPlace& pp) {
    const unsigned char* H8 = P.ws + WS_H8; const unsigned char* HSb = P.ws + WS_HS; const unsigned char* IDXb = P.ws + WS_IDX; unsigned char* PARTb = P.ws + WS_PART;
    const int lane = lane_id(), dl = lane & 3, ps = lane >> 2;
    const int tstep = pp.nloc * NWAVES;
    for (int u = pp.vx; u < 8; u += pp.nx) {
        const int s = u & 3, tend = ((u >> 2) + 1) * (T_ / 2), t0 = (u >> 2) * (T_ / 2) + pp.rank * NWAVES + F.wave;
        if (t0 >= tend) continue;
        const unsigned char* tab = P.ws + WS_ED + (size_t)s * 16384 * 128;
        const unsigned hoff = (unsigned)(s * 256 + dl * 32), ioff = (unsigned)lane * 4u;
        v4u bufA[PX_D], bufB[PX_D];
#define PD_CLAMP(T) ((T) < tend ? (T) : t0)
#define PD_META(H, HSC, TT) do { const unsigned char* hp_ = H8 + ((unsigned)(TT) * 1024u + hoff); H.h0 = *(const v4u*)hp_; H.h1 = *(const v4u*)(hp_ + 16); H.l0 = *(const v4u*)(hp_ + 128); H.l1 = *(const v4u*)(hp_ + 144); \
        HSC = *(const float*)(HSb + ((unsigned)(TT) * 32u + (unsigned)s * 4u)); } while (0)
#define PD_IDX(LO, HI, TT) do { LO = *(const int*)(IDXb + ((unsigned)(TT) * 512u + ioff)); HI = *(const int*)(IDXb + ((unsigned)(TT) * 512u + 256u + ioff)); } while (0)
        int nidx_lo, nidx_hi; PD_IDX(nidx_lo, nidx_hi, t0);
        PX_ISSUE(bufA, nidx_lo, nidx_hi);
        PD_IDX(nidx_lo, nidx_hi, PD_CLAMP(t0 + tstep));
        H4 ha, hb; float sa, sb; PD_META(ha, sa, t0);
        for (int t = t0; t < tend; t += 2 * tstep) {
            { const int tn = PD_CLAMP(t + tstep);
              PX_ISSUE(bufB, nidx_lo, nidx_hi); PD_IDX(nidx_lo, nidx_hi, PD_CLAMP(tn + tstep)); PD_META(hb, sb, tn);
              __builtin_amdgcn_sched_barrier(0);
              peer_down_token(bufA, ha, sa, (float*)(PARTb + ((unsigned)(s * T_ + t) * 512u)), dl, ps);
              __builtin_amdgcn_sched_barrier(0); }
            if (t + tstep >= tend) break;
            { const int tc = t + tstep, tn = PD_CLAMP(tc + tstep);
              PX_ISSUE(bufA, nidx_lo, nidx_hi); PD_IDX(nidx_lo, nidx_hi, PD_CLAMP(tn + tstep)); PD_META(ha, sa, tn);
              __builtin_amdgcn_sched_barrier(0);
              peer_down_token(bufB, hb, sb, (float*)(PARTb + ((unsigned)(s * T_ + tc) * 512u)), dl, ps);
              __builtin_amdgcn_sched_barrier(0); }
        }
    }
}
__device__ __forceinline__ void peer_act(Frame& F, const Ptrs& P) {
    const int* IDX = (const int*)(P.ws + WS_IDX); float* GATE = (float*)(P.ws + WS_GATE); const float* PART = (const float*)(P.ws + WS_PART); const float* SSQ = (const float*)(P.ws + WS_SSQ);
    const float* SCD = (const float*)(P.ws + WS_SMALL); const float* SCU = SCD + 16384;
    const int lane = lane_id();
    for (int w = F.vcu * NWAVES + F.wave; w < T_ * 2; w += F.G * NWAVES) {
        const int t = w >> 1; const size_t pid = (size_t)w * 64 + lane;
        const float ssq = lane < 16 ? SSQ[(size_t)t * 16 + lane] : 0.f;
        const float rstd = rsqrtf(wave_sum(ssq) * (1.f / 1024.f) + EPS);
        float pre = 0.f;
#pragma unroll
        for (int s = 0; s < 4; ++s) pre += PART[(size_t)s * T_ * 128 + pid];
        const int id = IDX[pid];
        GATE[pid] = gelu_erf(pre * SCD[id] * rstd) * GATE[pid] * SCU[id];
    }
}
constexpr int PE_PD = 8;
#define PE_LOAD4(SLOT, IDV) SLOT = *(const v4u*)(EU + (((unsigned)(IDV) << 9) | l16))
#define PE_BP(ADDR, V) __builtin_amdgcn_ds_bpermute((ADDR), (V))
__device__ __forceinline__ void peer_up_tm(Frame& F, const Ptrs& P) {
    const bf16* HB = (const bf16*)(P.ws + WS_ST); const unsigned char* EU = P.ws + WS_EU;
    const int* IDX = (const int*)(P.ws + WS_IDX); const float* GATE = (const float*)(P.ws + WS_GATE); const float* PART = (const float*)(P.ws + WS_PART);
    const float* SCD = (const float*)(P.ws + WS_SMALL); const float* SCU = SCD + 16384;
    const int lane = lane_id(), l31 = lane & 31; const bool upper = lane >= 32;
    const unsigned l16 = (unsigned)l31 << 4;
    const int bp0 = upper ? 4 : 0;
    const int t0 = F.vcu * NWAVES + F.wave, tstep = F.G * NWAVES;
    if (t0 >= T_) return;
    int idx_lo = IDX[(size_t)t0 * 128 + lane], idx_hi = IDX[(size_t)t0 * 128 + 64 + lane];
    v4u hq[4];
#pragma unroll
    for (int k = 0; k < 4; ++k) hq[k] = ((const v4u*)(HB + (size_t)t0 * DM))[4 * l31 + k];
    float g_lo = GATE[(size_t)t0 * 128 + lane], g_hi = GATE[(size_t)t0 * 128 + 64 + lane];
    float pre_lo = 0.f, pre_hi = 0.f;
#pragma unroll
    for (int s = 0; s < 4; ++s) { pre_lo += PART[((size_t)s * T_ + t0) * 128 + lane]; pre_hi += PART[((size_t)s * T_ + t0) * 128 + 64 + lane]; }
    float sdu_lo = SCD[idx_lo], sdu_hi = SCD[idx_hi], su_lo = SCU[idx_lo], su_hi = SCU[idx_hi];
    v4u ra[PE_PD];
#pragma unroll
    for (int j = 0; j < PE_PD; ++j) { const int id = PE_BP(bp0 + 8 * j, idx_lo); PE_LOAD4(ra[j], id); }
    int id_nx = PE_BP(bp0 + 8 * PE_PD, idx_lo);
    for (int t = t0; t < T_; t += tstep) {
        const int tn = (t + tstep < T_) ? t + tstep : t;
        const int nidx_lo = IDX[(size_t)tn * 128 + lane], nidx_hi = IDX[(size_t)tn * 128 + 64 + lane];
        v4u nh[4];
#pragma unroll
        for (int k = 0; k < 4; ++k) nh[k] = ((const v4u*)(HB + (size_t)tn * DM))[4 * l31 + k];
        const float ng_lo = GATE[(size_t)tn * 128 + lane], ng_hi = GATE[(size_t)tn * 128 + 64 + lane];
        float npart_lo[4], npart_hi[4];
#pragma unroll
        for (int s = 0; s < 4; ++s) { npart_lo[s] = PART[((size_t)s * T_ + tn) * 128 + lane]; npart_hi[s] = PART[((size_t)s * T_ + tn) * 128 + 64 + lane]; }
        float ssq = 0.f;
#pragma unroll
        for (int k = 0; k < 4; ++k) { ssq = fmaf(bflo(hq[k].x), bflo(hq[k].x), ssq); ssq = fmaf(bfhi(hq[k].x), bfhi(hq[k].x), ssq); ssq = fmaf(bflo(hq[k].y), bflo(hq[k].y), ssq); ssq = fmaf(bfhi(hq[k].y), bfhi(hq[k].y), ssq);
            ssq = fmaf(bflo(hq[k].z), bflo(hq[k].z), ssq); ssq = fmaf(bfhi(hq[k].z), bfhi(hq[k].z), ssq); ssq = fmaf(bflo(hq[k].w), bflo(hq[k].w), ssq); ssq = fmaf(bfhi(hq[k].w), bfhi(hq[k].w), ssq); }
        ssq += swz_xor<1>(ssq); ssq += swz_xor<2>(ssq); ssq += swz_xor<4>(ssq); ssq += swz_xor<8>(ssq); ssq += swz_xor<16>(ssq);
        const float rstd = rsqrtf(ssq * (1.f / 1024.f) + EPS);
        const float act_lo = gelu_erf(pre_lo * sdu_lo * rstd) * g_lo * su_lo, act_hi = gelu_erf(pre_hi * sdu_hi * rstd) * g_hi * su_hi;
        f32x2v acc[16];
#pragma unroll
        for (int i = 0; i < 16; ++i) acc[i] = (f32x2v){0.f, 0.f};
        float a_cur = __int_as_float(PE_BP(bp0, __float_as_int(act_lo)));
#pragma unroll
        for (int q = 0; q < 64; ++q) {
            const int qa = q + 1, ql = q + PE_PD + 1;
            float a_nx = 0.f;
            if (qa < 64) a_nx = __int_as_float(PE_BP(bp0 + 8 * (qa & 31), __float_as_int(qa < 32 ? act_lo : act_hi)));
            int id_n2;
            if (ql < 64) id_n2 = PE_BP(bp0 + 8 * (ql & 31), ql < 32 ? idx_lo : idx_hi);
            else id_n2 = PE_BP(bp0 + 8 * ((ql - 64) & 31), nidx_lo);
            __builtin_amdgcn_sched_barrier(0);
            { const f32x2v av = {a_cur, a_cur}; const v4u r = ra[q % PE_PD];
#define PE_FMA4(W, O) acc[O] = __builtin_elementwise_fma(av, (f32x2v)__builtin_amdgcn_cvt_scalef32_pk_f32_fp4(W, 1.0f, 0), acc[O]); acc[O + 1] = __builtin_elementwise_fma(av, (f32x2v)__builtin_amdgcn_cvt_scalef32_pk_f32_fp4(W, 1.0f, 1), acc[O + 1]); \
              acc[O + 2] = __builtin_elementwise_fma(av, (f32x2v)__builtin_amdgcn_cvt_scalef32_pk_f32_fp4(W, 1.0f, 2), acc[O + 2]); acc[O + 3] = __builtin_elementwise_fma(av, (f32x2v)__builtin_amdgcn_cvt_scalef32_pk_f32_fp4(W, 1.0f, 3), acc[O + 3]);
              PE_FMA4(r.x, 0) PE_FMA4(r.y, 4) PE_FMA4(r.z, 8) PE_FMA4(r.w, 12) }
            asm volatile("" : "+v"(acc[0]), "+v"(acc[1]), "+v"(acc[2]), "+v"(acc[3]), "+v"(acc[4]), "+v"(acc[5]), "+v"(acc[6]), "+v"(acc[7]));
            asm volatile("" : "+v"(acc[8]), "+v"(acc[9]), "+v"(acc[10]), "+v"(acc[11]), "+v"(acc[12]), "+v"(acc[13]), "+v"(acc[14]), "+v"(acc[15]));
            PE_LOAD4(ra[q % PE_PD], id_nx);
            id_nx = id_n2; a_cur = a_nx;
            __builtin_amdgcn_sched_barrier(0);
        }
        { float a = 0.f, c = 0.f;
#pragma unroll
          for (int s = 0; s < 4; ++s) { a += npart_lo[s]; c += npart_hi[s]; }
          pre_lo = a; pre_hi = c; }
        sdu_lo = SCD[nidx_lo]; sdu_hi = SCD[nidx_hi]; su_lo = SCU[nidx_lo]; su_hi = SCU[nidx_hi];
        float y[32];
#pragma unroll
        for (int k = 0; k < 4; ++k) { y[8 * k] = bflo(hq[k].x); y[8 * k + 1] = bfhi(hq[k].x); y[8 * k + 2] = bflo(hq[k].y); y[8 * k + 3] = bfhi(hq[k].y); y[8 * k + 4] = bflo(hq[k].z); y[8 * k + 5] = bfhi(hq[k].z); y[8 * k + 6] = bflo(hq[k].w); y[8 * k + 7] = bfhi(hq[k].w); }
        float s2 = 0.f;
#pragma unroll
        for (int i = 0; i < 16; ++i) { y[2 * i] += sum_halves(acc[i][0]); y[2 * i + 1] += sum_halves(acc[i][1]); s2 = fmaf(y[2 * i], y[2 * i], s2); s2 = fmaf(y[2 * i + 1], y[2 * i + 1], s2); }
        s2 += swz_xor<1>(s2); s2 += swz_xor<2>(s2); s2 += swz_xor<4>(s2); s2 += swz_xor<8>(s2); s2 += swz_xor<16>(s2);
        const float r2 = rsqrtf(s2 * (1.f / 1024.f) + EPS);
        const float4* wf = (const float4*)(P.norm_final) + 8 * l31 + 4 * (lane >> 5); float4* o = (float4*)(P.out + (size_t)t * DM) + 8 * l31 + 4 * (lane >> 5);
#pragma unroll
        for (int k = 0; k < 4; ++k) { const float4 w = wf[k];
            const float e0 = upper ? y[16 + 4 * k] : y[4 * k], e1 = upper ? y[17 + 4 * k] : y[4 * k + 1], e2 = upper ? y[18 + 4 * k] : y[4 * k + 2], e3 = upper ? y[19 + 4 * k] : y[4 * k + 3];
            o[k] = make_float4(e0 * r2 * w.x, e1 * r2 * w.y, e2 * r2 * w.z, e3 * r2 * w.w); }
        idx_lo = nidx_lo; idx_hi = nidx_hi; g_lo = ng_lo; g_hi = ng_hi;
#pragma unroll
        for (int k = 0; k < 4; ++k) hq[k] = nh[k];
    }
}
constexpr int TK_LDK = 136, TK_K2 = 34816, TK_SCR = 69632, TK_SP = 49;
__device__ __forceinline__ int mono_key(float x) { const int b = __float_as_int(x); return b ^ ((b >> 31) & 0x7fffffff); }
__device__ __forceinline__ float unmono(int m) { return __int_as_float(m ^ ((m >> 31) & 0x7fffffff)); }
__device__ __forceinline__ int max3i(int a, int b, int c) { return max(max(a, b), c); }
#define CEX(A, I, J) do { const int hi_ = max(A[I], A[J]), lo_ = min(A[I], A[J]); A[I] = hi_; A[J] = lo_; } while (0)
template <int N, int OFF, int K, int J, int LEN> struct BitonicStep {
    static __device__ __forceinline__ void run(int (&a)[LEN]) {
#pragma unroll
        for (int i = 0; i < N; ++i) { const int l = i ^ J; if (l > i) { if ((i & K) == 0) CEX(a, OFF + i, OFF + l); else CEX(a, OFF + l, OFF + i); } }
        if constexpr (J > 1) BitonicStep<N, OFF, K, (J >> 1), LEN>::run(a);
        else if constexpr (K < N) BitonicStep<N, OFF, (K << 1), K, LEN>::run(a);
    }
};
template <int N, int OFF, int LEN> __device__ __forceinline__ void bitonic_sort_desc(int (&a)[LEN]) { BitonicStep<N, OFF, 2, 1, LEN>::run(a); }
template <int OFF, int LEN> __device__ __forceinline__ void bitonic_merge16_desc(int (&a)[LEN]) { BitonicStep<16, OFF, 16, 8, LEN>::run(a); }
template <int A, int B, int LEN> __device__ __forceinline__ void merge_top16(int (&a)[LEN]) {
#pragma unroll
    for (int i = 0; i < 16; ++i) a[A + i] = max(a[A + i], a[B + 15 - i]);
    bitonic_merge16_desc<A, LEN>(a);
}
template <int LEN> __device__ __forceinline__ void pair_top16(int (&a)[LEN]) {
    int lo[16], up[16];
#pragma unroll
    for (int i = 0; i < 16; ++i) { const auto rr = __builtin_amdgcn_permlane32_swap((unsigned)a[i], (unsigned)a[i], false, false); lo[i] = (int)rr[0]; up[i] = (int)rr[1]; }
#pragma unroll
    for (int i = 0; i < 16; ++i) a[i] = max(lo[i], up[15 - i]);
    bitonic_merge16_desc<0, LEN>(a);
}
__device__ __forceinline__ void topk_half(const bf16x8 (&qf)[8], const LAS bf16* Kh, int r, int hh, int (&key)[64]) {
#pragma unroll
    for (int nt = 0; nt < 4; ++nt) {
        f32x16 sc;
#pragma unroll
        for (int i = 0; i < 16; ++i) sc[i] = 0.f;
#pragma unroll
        for (int kk = 0; kk < 8; ++kk) { const bf16x8 a = *(const LAS bf16x8*)(Kh + (32 * nt + r) * TK_LDK + 16 * kk + 8 * hh); sc = MFMA32(a, qf[kk], sc); }
#pragma unroll
        for (int i = 0; i < 16; ++i) key[nt * 16 + i] = (mono_key(sc[i]) & ~127) | (127 - (32 * nt + crow(i, hh)));
    }
    bitonic_sort_desc<16, 0, 64>(key); bitonic_sort_desc<16, 16, 64>(key); bitonic_sort_desc<16, 32, 64>(key); bitonic_sort_desc<16, 48, 64>(key);
    merge_top16<0, 16, 64>(key); merge_top16<32, 48, 64>(key); merge_top16<0, 32, 64>(key);
    pair_top16<64>(key);
}
__device__ __forceinline__ void topk_finish(const LAS int* scr, int hh, float rstd, int* IDX, float* GATE, int t, int hd) {
    const LAS int* la = scr + hh * 16; const LAS int* lb = scr + (1 - hh) * 16;
    float va[4], vb[16];
#pragma unroll
    for (int i = 0; i < 4; ++i) va[i] = unmono(la[i] & ~127);
#pragma unroll
    for (int j = 0; j < 16; ++j) vb[j] = unmono(lb[j] & ~127);
    int ck[32];
    {
        int q = 0;
#pragma unroll
        for (int i = 0; i < 4; ++i)
#pragma unroll
            for (int j = i; j < 16; ++j) if ((i + 1) * (j + 1) <= 16) {
                const int pos = hh ? (j * 16 + i) : (i * 16 + j);
                int k = (mono_key(va[i] + vb[j]) & ~255) | (255 - pos);
                if (i == j && hh) k = (int)0x80000000;
                ck[q++] = k; }
#pragma unroll
        for (int i = 27; i < 32; ++i) ck[i] = (int)0x80000000;
    }
    bitonic_sort_desc<32, 0, 32>(ck);
    pair_top16<32>(ck);
    const float vmax = unmono(ck[0] & ~255) * rstd;
    float ev[8]; int id[8]; float esum = 0.f; const int hm = -hh;
#pragma unroll
    for (int q = 0; q < 8; ++q) { const int wk = ck[q] ^ ((ck[q] ^ ck[8 + q]) & hm); const int pos = 255 - (wk & 255);
        const int n1 = 127 - (scr[pos >> 4] & 127), n2 = 127 - (scr[16 + (pos & 15)] & 127);
        id[q] = n1 * 128 + n2;
        ev[q] = exp2f((unmono(wk & ~255) * rstd - vmax) * LOG2E); esum += ev[q]; }
    esum = sum_halves(esum);
    const float inv = 1.f / esum;
    int4* ip = (int4*)(IDX + ((size_t)t * 8 + hd) * 16 + hh * 8); float4* gp = (float4*)(GATE + ((size_t)t * 8 + hd) * 16 + hh * 8);
    ip[0] = make_int4(id[0], id[1], id[2], id[3]); ip[1] = make_int4(id[4], id[5], id[6], id[7]);
    gp[0] = make_float4(ev[0] * inv, ev[1] * inv, ev[2] * inv, ev[3] * inv); gp[1] = make_float4(ev[4] * inv, ev[5] * inv, ev[6] * inv, ev[7] * inv);
}
constexpr int TQ_QH = 69632, TQ_QP = 272;
struct OneUnit { pg8::StaticOrder S; int i;
    __device__ __forceinline__ bool next(int j, pg8::Unit& u) const { return j == 0 ? S.next(i, u) : false; }
    __device__ __forceinline__ void a_ready(const pg8::Unit&) const {}
    __device__ __forceinline__ void done(const pg8::Unit&) const {}
};
struct EpiQTopk {
    static constexpr bool PERM = true, AFTER_DRAIN = true;
    const float* sk1; const float* sk2; const float* SSQ; int* IDX; float* GATE;
    __device__ __forceinline__ void dump(const pg8::f32x4 (&acc)[2][2][4][2], int bj, LAS unsigned char* QH, int wr, int wc, int fr, int fq) const {
#pragma unroll
        for (int ai = 0; ai < 2; ++ai)
#pragma unroll
            for (int m = 0; m < 4; ++m) { const pg8::f32x4 v0 = bj ? acc[ai][1][m][0] : acc[ai][0][m][0], v1 = bj ? acc[ai][1][m][1] : acc[ai][0][m][1];
                v4u w; w.x = cvtpk(v0[0], v0[1]); w.y = cvtpk(v0[2], v0[3]); w.z = cvtpk(v1[0], v1[1]); w.w = cvtpk(v1[2], v1[3]);
                *(LAS v4u*)(QH + (128 * ai + 64 * wr + 16 * m + fr) * TQ_QP + (32 * wc + 8 * fq) * 2) = w; }
    }
    __device__ __forceinline__ void fused(const pg8::f32x4 (&acc)[2][2][4][2], const pg8::Unit& u, int wr, int wc, int fr, int fq, LAS unsigned char* L, int wid, int lane) const {
        LAS bf16* K1 = (LAS bf16*)L; LAS bf16* K2 = (LAS bf16*)(L + TK_K2); LAS unsigned char* QH = L + TQ_QH;
        const int tid_ = wid * 64 + lane, r = lane & 31, hh = lane >> 5;
        for (int i = tid_; i < 16384; i += 512) { const int n = i >> 7, k = i & 127; K1[n * TK_LDK + k] = (bf16)f2bf(sk1[i]); K2[n * TK_LDK + k] = (bf16)f2bf(sk2[i]); }
        dump(acc, 0, QH, wr, wc, fr, fq);
        __syncthreads();
        const int t = u.pm * 256 + 32 * wid + r;
        float rstd;
        { const float4* sp = (const float4*)(SSQ + (size_t)t * 16); const float4 a = sp[0], b = sp[1], c = sp[2], d = sp[3];
          rstd = rsqrtf(((a.x + a.y + a.z + a.w) + (b.x + b.y + b.z + b.w) + (c.x + c.y + c.z + c.w) + (d.x + d.y + d.z + d.w)) * (1.f / 1024.f) + EPS); }
        const LAS unsigned char* qrow = QH + (32 * wid + r) * TQ_QP + 16 * hh;
        int key[64], list0[16];
        { bf16x8 qf[8];
#pragma unroll
          for (int kk = 0; kk < 8; ++kk) qf[kk] = *(const LAS bf16x8*)(qrow + 32 * kk);
          topk_half(qf, K1, r, hh, key);
#pragma unroll
          for (int i = 0; i < 16; ++i) list0[i] = key[i]; }
        __syncthreads();
        dump(acc, 1, QH, wr, wc, fr, fq);
        __syncthreads();
        { bf16x8 qf[8];
#pragma unroll
          for (int kk = 0; kk < 8; ++kk) qf[kk] = *(const LAS bf16x8*)(qrow + 32 * kk);
          topk_half(qf, K2, r, hh, key); }
        LAS int* scr = (LAS int*)(QH + 32 * wid * TQ_QP) + r * TK_SP;
        LDS_WAIT();
        if (hh == 0) {
#pragma unroll
            for (int i = 0; i < 16; ++i) { scr[i] = list0[i]; scr[16 + i] = key[i]; } }
        topk_finish(scr, hh, rstd, IDX, GATE, t, u.pn);
        __syncthreads();
    }
};

constexpr int AT_KP = 72, AT_VP = 264;
constexpr int AT_K = 0, AT_VT = 36864, AT_BT = 36864 + 33792;
__device__ __forceinline__ void attn_phase(Frame& F, const Ptrs& P) {
    const bf16* PROJ = (const bf16*)(P.ws + WS_PROJ); bf16* CAT = (bf16*)(P.ws + WS_XN);
    LAS unsigned char* L = F.lds + RING_OFF;
    LAS bf16* Ks = (LAS bf16*)(L + AT_K); LAS bf16* Vt = (LAS bf16*)(L + AT_VT); LAS float* btab = (LAS float*)(L + AT_BT);
    const int lane = lane_id(), tid_ = F.wave * 64 + lane, r = lane & 31, hh = lane >> 5;
    for (int u = F.vcu; u < 256; u += F.G) {
        const int hkv = u & 1, n = (u >> 1) & 31, b = u >> 6;
        const int trow0 = b * SEQ + n * 128;
        for (int i = tid_; i < 2048; i += 512) {
            const int kj = i >> 3, ch = i & 7; const bool ok = (n > 0) || (kj >= 128);
            v4u kv = {0u, 0u, 0u, 0u}, vv = {0u, 0u, 0u, 0u};
            if (ok) { const bf16* rowp = PROJ + (size_t)(trow0 - 128 + kj) * NPROJ + hkv * 64 + ch * 8; kv = *(const v4u*)(rowp + PJ_K); vv = *(const v4u*)(rowp + PJ_V); }
            *(LAS v4u*)(Ks + kj * AT_KP + ch * 8) = kv;
            LAS bf16* vp = Vt + (ch * 8) * AT_VP + kj;
            vp[0] = (bf16)(vv.x & 0xffffu); vp[AT_VP] = (bf16)(vv.x >> 16); vp[2 * AT_VP] = (bf16)(vv.y & 0xffffu); vp[3 * AT_VP] = (bf16)(vv.y >> 16);
            vp[4 * AT_VP] = (bf16)(vv.z & 0xffffu); vp[5 * AT_VP] = (bf16)(vv.z >> 16); vp[6 * AT_VP] = (bf16)(vv.w & 0xffffu); vp[7 * AT_VP] = (bf16)(vv.w >> 16);
        }
        for (int i = tid_; i < 768; i += 512) { const int gg = i / 192, dist = i % 192 - 32;
            btab[i] = (dist >= 0 && dist < 128) ? P.rel_bias[c_bucket[dist & 127] * 8 + hkv * 4 + gg] * LOG2E : 0.f; }
        __syncthreads();
        const int g = F.wave & 3, h = hkv * 4 + g;
        const float sink2 = P.sinks[h] * LOG2E;
#pragma unroll 1
        for (int qq = 0; qq < 2; ++qq) {
            const int qt = (F.wave >> 2) * 2 + qq, t = trow0 + 32 * qt + r;
            bf16x8 qf[4];
#pragma unroll
            for (int kk = 0; kk < 4; ++kk) qf[kk] = *(const bf16x8*)(PROJ + (size_t)t * NPROJ + h * 64 + 16 * kk + 8 * hh);
            f32x16 sc[5];
#pragma unroll
            for (int j = 0; j < 5; ++j) {
#pragma unroll
                for (int i = 0; i < 16; ++i) sc[j][i] = 0.f;
#pragma unroll
                for (int kk = 0; kk < 4; ++kk) { const bf16x8 a = *(const LAS bf16x8*)(Ks + (32 * (qt + j) + r) * AT_KP + 16 * kk + 8 * hh); sc[j] = MFMA32(a, qf[kk], sc[j]); }
            }
            float m = sink2;
            const LAS float* bt = btab + g * 192 + 160 + r - 4 * hh;
#pragma unroll
            for (int j = 0; j < 5; ++j) {
                const bool tile_ok = (n > 0) || (qt + j >= 4);
#pragma unroll
                for (int i = 0; i < 16; ++i) { const int dist = 128 + r - (32 * j + crow(i, hh));
                    const bool ok = tile_ok && (j == 0 ? dist < 128 : (j == 4 ? dist >= 0 : true));
                    const float s = sc[j][i] * (0.125f * LOG2E) + bt[-(32 * j + (i & 3) + 8 * (i >> 2))];
                    sc[j][i] = ok ? s : -INFINITY; m = fmaxf(m, sc[j][i]); }
            }
            m = max_halves(m);
            float l = 0.f;
#pragma unroll
            for (int j = 0; j < 5; ++j)
#pragma unroll
                for (int i = 0; i < 16; ++i) { sc[j][i] = exp2f(sc[j][i] - m); l += sc[j][i]; }
            l = sum_halves(l);
            l += exp2f(sink2 - m);
            const float inv = 1.f / l;
            f32x16 o[2];
#pragma unroll
            for (int i = 0; i < 16; ++i) { o[0][i] = 0.f; o[1][i] = 0.f; }
#pragma unroll
            for (int j = 0; j < 5; ++j)
#pragma unroll
                for (int sg = 0; sg < 2; ++sg) {
                    const bf16x8 pf = pack8(sc[j], sg);
#pragma unroll
                    for (int dt = 0; dt < 2; ++dt) {
                        const LAS bf16* vb = Vt + (32 * dt + r) * AT_VP + 32 * (qt + j) + 16 * sg + 4 * hh;
                        const s16x4 lo = *(const LAS s16x4*)(vb), hi = *(const LAS s16x4*)(vb + 8);
                        o[dt] = MFMA32(__builtin_shufflevector(lo, hi, 0, 1, 2, 3, 4, 5, 6, 7), pf, o[dt]);
                    }
                }
            bf16* op = CAT + (size_t)t * DM + h * 64 + 4 * hh;
#pragma unroll
            for (int dt = 0; dt < 2; ++dt)
#pragma unroll
                for (int g4 = 0; g4 < 4; ++g4)
                    *(unsigned long long*)(op + 32 * dt + 8 * g4) = (unsigned long long)cvtpk(o[dt][4 * g4] * inv, o[dt][4 * g4 + 1] * inv) | ((unsigned long long)cvtpk(o[dt][4 * g4 + 2] * inv, o[dt][4 * g4 + 3] * inv) << 32);
        }
        __syncthreads();
    }
}
struct Args { Ptrs p; };
__global__ void __launch_bounds__(NWAVES * 64, 2) hymba_fwd(Args args) {
    extern __shared__ __attribute__((aligned(16))) unsigned char lds[];
    const Ptrs& P = args.p;
    Frame F;
    F.lds = (LAS unsigned char*)lds;
    F.MISC = (volatile LAS unsigned*)(F.lds + MISC_OFF);
    F.wave = __builtin_amdgcn_readfirstlane(threadIdx.x >> 6);
    F.G = gridDim.x; { const int bx = blockIdx.x; F.vcu = (F.G % 8 == 0) ? (bx % 8) * (F.G / 8) + bx / 8 : bx; }
    F.ctl = (gu32*)(P.ws + WS_CTL);
    for (int u = threadIdx.x; u < (LDS_BYTES - LDSCTL_OFF) / 4; u += NWAVES * 64) ((LAS unsigned*)(F.lds + LDSCTL_OFF))[u] = 0u;
    __syncthreads();
    XcdBarrier bar = xcd_barrier_post((unsigned*)(F.ctl + CW_BAR), F.MISC + 8);
#define GRID_BAR() xcd_barrier(bar)

    bf16* XN = (bf16*)(P.ws + WS_XN); bf16* PROJ = (bf16*)(P.ws + WS_PROJ); bf16* HB = (bf16*)(P.ws + WS_ST);
    p0_prologue(F, P);
    GRID_BAR();
    { pg8::Gemm g{XN, (const bf16*)(P.ws + WS_WIN), T_, NPROJ, DM, F.wave}; pg8::StaticOrder S; S.init(T_, NPROJ, F.G, (int)blockIdx.x);
      pg8::EpiBf16<0> E{PROJ, NPROJ, nullptr, 0, 0, 1.f};
      pg8::gemm_phase<pg8::EpiBf16<0>, pg8::StaticOrder, PG8_ALIGN, PG8_SP2>(F.lds + RING_OFF, g, S, E); }
    if (F.G == 256 && blockIdx.x >= 64) p1_slack(F, P, ((int)blockIdx.x - 64) * NWAVES + F.wave, 192 * NWAVES);
    else if (F.G != 256) p1_slack(F, P, F.vcu * NWAVES + F.wave, F.G * NWAVES);
    GRID_BAR();
    ssd_s1(F, P);
    xcd_arrive(bar, F.MISC + 14);
    attn_phase(F, P);
    xcd_wait(bar, F.MISC + 14);
    ssd_s2(F, P);
    GRID_BAR();
    ssd_s3(F, P);
    GRID_BAR();
    { pg8::Gemm g{XN, (const bf16*)(P.ws + WS_WOUT), T_, DM, DM, F.wave}; pg8::StaticOrder S; S.init(T_, DM, F.G, (int)blockIdx.x);
      EpiResH E{P.x, HB, (float*)(P.ws + WS_SSQ)};
      pg8::gemm_phase<EpiResH, pg8::StaticOrder, PG8_ALIGN, PG8_SP2>(F.lds + RING_OFF, g, S, E); }
    GRID_BAR();
    { pg8::Gemm g{HB, (const bf16*)(P.ws + WS_WQ), T_, 2048, DM, F.wave}; pg8::StaticOrder S; S.init(T_, 2048, F.G, (int)blockIdx.x);
      EpiQTopk E{P.sk1, P.sk2, (const float*)(P.ws + WS_SSQ), (int*)(P.ws + WS_IDX), (float*)(P.ws + WS_GATE)};
#pragma unroll 1
      for (int ui = 0; ui < 64; ++ui) { pg8::Unit u0; if (!S.next(ui, u0)) break;
          OneUnit S1{S, ui};
          pg8::gemm_phase<EpiQTopk, OneUnit, PG8_ALIGN, PG8_SP2>(F.lds + RING_OFF, g, S1, E); } }
    h_quant_rows(F, P);
    GRID_BAR();
    { const PeerPlace pp = peer_place(F);
      peer_down(F, P, pp); }
    GRID_BAR();
    peer_up_tm(F, P);
}

extern "C" void kernel_launch(void* const* d_in, const int* in_sizes, int n_in, void* d_out, int out_size, void* d_ws, size_t ws_size, hipStream_t stream) {
    static int grid = 0;
    if (grid == 0) {
        if (n_in != 19 || out_size != T_ * DM || ws_size < WS_END) { fprintf(stderr, "kernel_launch: unexpected shapes (n_in %d, out %d, ws %zu)\n", n_in, out_size, ws_size); grid = -1; return; }
        int dev = 0, cus = 0, per_cu = 0;
        if (hipGetDevice(&dev) != hipSuccess || hipDeviceGetAttribute(&cus, hipDeviceAttributeMultiprocessorCount, dev) != hipSuccess) { grid = -1; return; }
        if (hipFuncSetAttribute((const void*)hymba_fwd, hipFuncAttributeMaxDynamicSharedMemorySize, LDS_BYTES) != hipSuccess) { fprintf(stderr, "kernel_launch: hipFuncSetAttribute failed\n"); grid = -1; return; }
        if (hipOccupancyMaxActiveBlocksPerMultiprocessor(&per_cu, (const void*)hymba_fwd, NWAVES * 64, LDS_BYTES) != hipSuccess || per_cu < 1) { fprintf(stderr, "kernel_launch: occupancy query says %d blocks per CU\n", per_cu); grid = -1; (void)hipGetLastError(); return; }
        grid = cus;
    }
    if (grid < 0) return;
    (void)hipMemsetAsync((char*)d_ws + WS_CTL, 0, CTL_ZERO_BYTES, stream);
    Args a{};
    const float** pp = (const float**)&a.p;
    for (int i = 0; i < 19; ++i) pp[i] = (const float*)d_in[i];
    a.p.out = (float*)d_out; a.p.ws = (unsigned char*)d_ws;
    hipLaunchKernelGGL(hymba_fwd, dim3(grid), dim3(NWAVES * 64), LDS_BYTES, stream, a);
}
```

```cpp
#include <hip/hip_runtime.h>
#include <cstdio>
#include <cstdint>
#include <math.h>
namespace pg8 {
#define PG8_LAS __attribute__((address_space(3)))
typedef unsigned short bf16_t;
typedef short bf16x8 __attribute__((ext_vector_type(8)));
typedef float f32x4 __attribute__((ext_vector_type(4)));
typedef unsigned u32x4 __attribute__((ext_vector_type(4)));
constexpr int BM = 256, BK = 64, HALF = 128, HTB = HALF * BK * 2  , STAGE_BYTES = 8 * HTB, NXCD = 8, WGM = 8;

__host__ __device__ __forceinline__ int lds_byte(int r, int c) { const int st = (r >> 4) * 2 + (c >> 5), rr = r & 15, cc = c & 31, ob = rr * 64 + cc * 2; return st * 1024 + (ob ^ (((ob >> 9) & 1) << 5)); }
__host__ __device__ __forceinline__ void stage_rc(int b, int& R, int& C) { const int st = b / 1024, sb = b % 1024, swz = sb ^ (((sb >> 9) & 1) << 5); R = (st >> 1) * 16 + swz / 64; C = (st & 1) * 32 + (swz % 64) / 2; }
__host__ __device__ __forceinline__ int perm32(int rho) { const int n = rho >> 4, i = rho & 15; return 8 * (i >> 2) + 4 * n + (i & 3); }

struct Unit { int pm, pn; };
struct Gemm { const bf16_t* A; const bf16_t* Bt; int M, N, K, wave; };

struct StaticOrder {
    int nM, nN, nwg, G, c;
    __host__ __device__ void init(int M, int N, int G_, int c_) { nM = M / BM; nN = N / BM; nwg = nM * nN; G = G_; c = c_; }
    __host__ __device__ bool next(int i, Unit& u) const {
        const long L = (long)i * G + c; if (L >= nwg) return false;
        int wgid = (int)L; { const int q = nwg / NXCD, r = nwg % NXCD, xcd = wgid % NXCD, off = wgid / NXCD; wgid = (xcd < r ? xcd * (q + 1) : r * (q + 1) + (xcd - r) * q) + off; }
        const int nig = WGM * nN, gid = wgid / nig, fm = gid * WGM, gsz = (nM - fm) < WGM ? (nM - fm) : WGM;
        u.pm = fm + ((wgid % nig) % gsz); u.pn = (wgid % nig) / gsz; return true;
    }
    __device__ __forceinline__ void a_ready(const Unit&) const {}
    __device__ __forceinline__ void done(const Unit&) const {}
};

__device__ __forceinline__ unsigned cvt_pk_bf16(float lo, float hi) { unsigned r; asm volatile("v_cvt_pk_bf16_f32 %0, %1, %2" : "=v"(r) : "v"(lo), "v"(hi)); return r; }
typedef float f32x2 __attribute__((ext_vector_type(2)));
__device__ __forceinline__ f32x2 gelu_pk(f32x2 v) {
    const f32x2 av = __builtin_elementwise_abs(v), d = av * 0.2316418882f + 1.0f;
    f32x2 t; t.x = __builtin_amdgcn_rcpf(d.x); t.y = __builtin_amdgcn_rcpf(d.y);
    f32x2 q = t * 0.5307027145f + (-0.7265760135f); q = q * t + 0.7107068705f; q = q * t + (-0.142248368f); q = q * t + 0.127414796f; q = q * t;
    const f32x2 s = (v * v) * (-0.72134752044f);
    f32x2 e; e.x = __builtin_amdgcn_exp2f(s.x); e.y = __builtin_amdgcn_exp2f(s.y);
    const f32x2 m = v * (q * e), r = v - m;
    f32x2 o; o.x = v.x < 0.f ? m.x : r.x; o.y = v.y < 0.f ? m.y : r.y; return o;
}

template <int ACT  > struct EpiBf16 {
    static constexpr bool PERM = true, AFTER_DRAIN = false; static_assert(ACT == 0 || ACT == 1, "EpiBf16: ACT is 0 (none) or 1 (gelu_pk)");
    bf16_t* O; int ldc; const float* bias; int split_cols; size_t split_stride; float scale0;
    __device__ __forceinline__ void operator()(const f32x4 (&acc)[2][2][4][2], const Unit& u, int wr, int wc, int fr, int fq) const {
        const int row0 = u.pm * BM + wr * 64 + fr; int colt = u.pn * BM; bf16_t* base = O;
        float sc = 1.f; if (split_cols) { const int t = colt / split_cols; base += (size_t)t * split_stride; colt -= t * split_cols; if (t == 0) sc = scale0; }
        const int col0 = colt + wc * 32 + 8 * fq, bcol0 = u.pn * BM + wc * 32 + 8 * fq;
        f32x4 bv[2][2];
#pragma unroll
        for (int bj = 0; bj < 2; ++bj)
#pragma unroll
            for (int n = 0; n < 2; ++n) bv[bj][n] = bias ? *(const f32x4*)(bias + bcol0 + bj * HALF + 4 * n) : (f32x4){0.f, 0.f, 0.f, 0.f};
#pragma unroll
        for (int ai = 0; ai < 2; ++ai)
#pragma unroll
            for (int m = 0; m < 4; ++m) { bf16_t* rowp = base + (size_t)(row0 + ai * HALF + m * 16) * ldc + col0;
#pragma unroll
                for (int bj = 0; bj < 2; ++bj) { f32x4 v0 = acc[ai][bj][m][0] + bv[bj][0], v1 = acc[ai][bj][m][1] + bv[bj][1];
                    if (ACT == 1) { f32x2 a = gelu_pk((f32x2){v0[0], v0[1]}), b = gelu_pk((f32x2){v0[2], v0[3]}), c = gelu_pk((f32x2){v1[0], v1[1]}), d = gelu_pk((f32x2){v1[2], v1[3]});
                        v0 = (f32x4){a.x, a.y, b.x, b.y}; v1 = (f32x4){c.x, c.y, d.x, d.y}; }
                    v0 = v0 * sc; v1 = v1 * sc; u32x4 w; w.x = cvt_pk_bf16(v0[0], v0[1]); w.y = cvt_pk_bf16(v0[2], v0[3]); w.z = cvt_pk_bf16(v1[0], v1[1]); w.w = cvt_pk_bf16(v1[2], v1[3]);
                    *(u32x4*)(rowp + bj * HALF) = w; } }
    }
};
template <class Epi, class Sched, bool ALIGN_EPI = false, bool SP2 = false>
__device__ __forceinline__ void gemm_phase(PG8_LAS unsigned char* lds, const Gemm g, const Sched& S, const Epi& E) {
    int lane_l; asm volatile("v_mbcnt_lo_u32_b32 %0, -1, 0\n\tv_mbcnt_hi_u32_b32 %0, -1, %0" : "=v"(lane_l));
    const int wid = g.wave, lane = lane_l, tid = wid * 64 + lane,
              wr = wid >> 2, wc = wid & 3, fr = lane & 15, fq = lane >> 4;
    const int K = g.K, nt = K / BK;
    unsigned voffA[2], voffB[2];
#pragma unroll
    for (int i = 0; i < 2; ++i) { int R, C; stage_rc(tid * 16 + i * 8192, R, C); const int Rb = Epi::PERM ? ((R & ~31) + perm32(R & 31)) : R;
        voffA[i] = (unsigned)(R * K + C) * 2u; voffB[i] = (unsigned)(Rb * K + C) * 2u; }
    const size_t kstep = (size_t)(BK * 2);
    const size_t hstep = (size_t)HALF * K * 2;
    const size_t tstep = 2 * hstep;
    const unsigned ldsw = (unsigned)wid * 1024u;
    const int aoff = lds_byte(wr * 64 + fr, fq * 8), boff = lds_byte(wc * 32 + fr, fq * 8);
#define PG8_SA(b, h) (((b) * 2 + (h)) * HTB)
#define PG8_SB(b, h) ((4 + (b) * 2 + (h)) * HTB)
#define PG8_STAGE(bufoff, gbase, voff) do { _Pragma("unroll") for (int _i = 0; _i < 2; ++_i) \
        __builtin_amdgcn_global_load_lds((const unsigned*)((const char*)(gbase) + (voff)[_i]), (PG8_LAS unsigned*)(lds + (bufoff) + ldsw + _i * 8192), 16, 0, 0); } while (0)
#define PG8_LDA(dst, b, h) do { _Pragma("unroll") for (int m = 0; m < 4; ++m) _Pragma("unroll") for (int k = 0; k < 2; ++k) dst[m][k] = *(const PG8_LAS bf16x8*)(lds + PG8_SA(b, h) + aoff + m * 2048 + k * 1024); } while (0)
#define PG8_LDB(dst, b, h) do { _Pragma("unroll") for (int n = 0; n < 2; ++n) _Pragma("unroll") for (int k = 0; k < 2; ++k) dst[n][k] = *(const PG8_LAS bf16x8*)(lds + PG8_SB(b, h) + boff + n * 2048 + k * 1024); } while (0)
#define PG8_MMA(ai, bj, At, Bt) do { __builtin_amdgcn_s_setprio(1); _Pragma("unroll") for (int m = 0; m < 4; ++m) _Pragma("unroll") for (int n = 0; n < 2; ++n) _Pragma("unroll") for (int k = 0; k < 2; ++k) \
        acc[ai][bj][m][n] = __builtin_amdgcn_mfma_f32_16x16x32_bf16(Bt[n][k], At[m][k], acc[ai][bj][m][n], 0, 0, 0); __builtin_amdgcn_s_setprio(0); } while (0)
#define PG8_WAIT_V(n) asm volatile("s_waitcnt vmcnt(" #n ")" ::: "memory")
#define PG8_WAIT_L(n) asm volatile("s_waitcnt lgkmcnt(" #n ")" ::: "memory")
#define PG8_BAR __builtin_amdgcn_s_barrier()
#define PG8_SCHED __builtin_amdgcn_sched_barrier(0)
    Unit cur, nxt; int ui = 0;
    if (!S.next(0, cur)) return;
    f32x4 acc[2][2][4][2];
#pragma unroll
    for (int a = 0; a < 2; ++a)
#pragma unroll
        for (int b = 0; b < 2; ++b)
#pragma unroll
            for (int m = 0; m < 4; ++m)
#pragma unroll
                for (int n = 0; n < 2; ++n) acc[a][b][m][n] = (f32x4){0.f, 0.f, 0.f, 0.f};
    bf16x8 At[4][2], B0[2][2], B1[2][2];
    const char* cA = (const char*)g.A + (size_t)cur.pm * tstep; const char* cB = (const char*)g.Bt + (size_t)cur.pn * tstep;
    S.a_ready(cur);
    if constexpr (SP2) {
        PG8_STAGE(PG8_SB(0, 0), cB, voffB); PG8_STAGE(PG8_SB(0, 1), cB + hstep, voffB); PG8_STAGE(PG8_SA(0, 0), cA, voffA); PG8_STAGE(PG8_SA(0, 1), cA + hstep, voffA);
        if (wr == 1) PG8_BAR;
        PG8_WAIT_V(2); PG8_BAR;
        PG8_STAGE(PG8_SB(1, 0), cB + kstep, voffB); PG8_STAGE(PG8_SA(1, 0), cA + kstep, voffA); PG8_STAGE(PG8_SB(1, 1), cB + hstep + kstep, voffB);
        PG8_WAIT_V(6); PG8_BAR;
    } else {
        PG8_STAGE(PG8_SB(0, 0), cB, voffB); PG8_STAGE(PG8_SA(0, 0), cA, voffA); PG8_STAGE(PG8_SB(0, 1), cB + hstep, voffB); PG8_STAGE(PG8_SA(0, 1), cA + hstep, voffA);
        if (wr == 1) PG8_BAR;
        PG8_WAIT_V(4); PG8_BAR;
        PG8_STAGE(PG8_SB(1, 0), cB + kstep, voffB); PG8_STAGE(PG8_SA(1, 0), cA + kstep, voffA); PG8_STAGE(PG8_SB(1, 1), cB + hstep + kstep, voffB);
        PG8_WAIT_V(6); PG8_BAR;
    }
    for (;;) {
        const bool has_next = S.next(ui + 1, nxt);
        const char* nA = has_next ? (const char*)g.A + (size_t)nxt.pm * tstep : cA; const char* nB = has_next ? (const char*)g.Bt + (size_t)nxt.pn * tstep : cB;
        for (int t = 0; t < nt; t += 2) {
            const bool last = (t == nt - 2);
            const char* a1 = cA + (size_t)(t + 1) * kstep;
            const char* a2 = last ? nA : cA + (size_t)(t + 2) * kstep; const char* b2 = last ? nB : cB + (size_t)(t + 2) * kstep;
            const char* a3 = a2 + kstep; const char* b3 = b2 + kstep;
            if (last && has_next) S.a_ready(nxt);
            if constexpr (SP2) {
            PG8_LDB(B0, 0, 0); PG8_LDB(B1, 0, 1); PG8_SCHED; PG8_LDA(At, 0, 0); PG8_STAGE(PG8_SA(1, 1), a1 + hstep, voffA);
            PG8_WAIT_V(8); PG8_WAIT_L(0); PG8_BAR; PG8_MMA(0, 0, At, B0); PG8_MMA(0, 1, At, B1); PG8_BAR; PG8_SCHED;
            PG8_LDA(At, 0, 1); PG8_STAGE(PG8_SB(0, 0), b2, voffB); PG8_STAGE(PG8_SB(0, 1), b2 + hstep, voffB); PG8_STAGE(PG8_SA(0, 0), a2, voffA);
            PG8_WAIT_V(8); PG8_WAIT_L(0); PG8_BAR; PG8_MMA(1, 0, At, B0); PG8_MMA(1, 1, At, B1); PG8_BAR; PG8_SCHED;
            PG8_LDB(B0, 1, 0); PG8_LDB(B1, 1, 1); PG8_SCHED; PG8_LDA(At, 1, 0); PG8_STAGE(PG8_SA(0, 1), a2 + hstep, voffA);
            PG8_WAIT_V(8); PG8_WAIT_L(0); PG8_BAR; PG8_MMA(0, 0, At, B0); PG8_MMA(0, 1, At, B1); PG8_BAR; PG8_SCHED;
            PG8_LDA(At, 1, 1); PG8_STAGE(PG8_SB(1, 0), b3, voffB); PG8_STAGE(PG8_SB(1, 1), b3 + hstep, voffB); PG8_STAGE(PG8_SA(1, 0), a3, voffA);
            PG8_WAIT_V(8); PG8_WAIT_L(0); PG8_BAR; PG8_MMA(1, 0, At, B0); PG8_MMA(1, 1, At, B1); PG8_BAR; PG8_SCHED;
            } else {
            PG8_LDB(B0, 0, 0); PG8_SCHED; PG8_LDA(At, 0, 0); PG8_STAGE(PG8_SA(1, 1), a1 + hstep, voffA);
            PG8_WAIT_L(8); PG8_BAR; PG8_WAIT_L(0); PG8_MMA(0, 0, At, B0); PG8_BAR; PG8_SCHED;
            PG8_LDB(B1, 0, 1); PG8_STAGE(PG8_SB(0, 0), b2, voffB);
            PG8_BAR; PG8_WAIT_L(0); PG8_MMA(0, 1, At, B1); PG8_BAR;
            PG8_LDA(At, 0, 1); PG8_STAGE(PG8_SA(0, 0), a2, voffA);
            PG8_BAR; PG8_WAIT_L(0); PG8_MMA(1, 0, At, B0); PG8_BAR; PG8_SCHED;
            PG8_STAGE(PG8_SB(0, 1), b2 + hstep, voffB);
            PG8_WAIT_V(6); PG8_BAR; PG8_MMA(1, 1, At, B1); PG8_BAR;
            PG8_LDB(B0, 1, 0); PG8_SCHED; PG8_LDA(At, 1, 0); PG8_STAGE(PG8_SA(0, 1), a2 + hstep, voffA);
            PG8_WAIT_L(8); PG8_BAR; PG8_WAIT_L(0); PG8_MMA(0, 0, At, B0); PG8_BAR; PG8_SCHED;
            PG8_LDB(B1, 1, 1); PG8_STAGE(PG8_SB(1, 0), b3, voffB);
            PG8_BAR; PG8_WAIT_L(0); PG8_MMA(0, 1, At, B1); PG8_BAR;
            PG8_LDA(At, 1, 1); PG8_STAGE(PG8_SA(1, 0), a3, voffA);
            PG8_BAR; PG8_WAIT_L(0); PG8_MMA(1, 0, At, B0); PG8_BAR; PG8_SCHED;
            PG8_STAGE(PG8_SB(1, 1), b3 + hstep, voffB);
            PG8_WAIT_V(6); PG8_BAR; PG8_MMA(1, 1, At, B1); PG8_BAR;
            }
        }
        if constexpr (ALIGN_EPI) { if (wr == 0) PG8_BAR; }
        if constexpr (!Epi::AFTER_DRAIN) { E(acc, cur, wr, wc, fr, fq); S.done(cur); }
        if (!has_next) break;
#pragma unroll
        for (int a = 0; a < 2; ++a)
#pragma unroll
            for (int b = 0; b < 2; ++b)
#pragma unroll
                for (int m = 0; m < 4; ++m)
#pragma unroll
                    for (int n = 0; n < 2; ++n) acc[a][b][m][n] = (f32x4){0.f, 0.f, 0.f, 0.f};
        cur = nxt; cA = nA; cB = nB; ++ui;
        if constexpr (ALIGN_EPI) { if (wr == 1) PG8_BAR; }
    }
    PG8_WAIT_V(0);
    if constexpr (!ALIGN_EPI) { if (wr == 0) PG8_BAR; }
    PG8_BAR;
    if constexpr (Epi::AFTER_DRAIN) { E.fused(acc, cur, wr, wc, fr, fq, lds, wid, lane); S.done(cur); }
#undef PG8_SA
#undef PG8_SB
#undef PG8_STAGE
#undef PG8_LDA
#undef PG8_LDB
#undef PG8_MMA
#undef PG8_WAIT_V
#undef PG8_WAIT_L
#undef PG8_BAR
#undef PG8_SCHED
}
}

#ifndef PG8_SP2
#define PG8_SP2 true
#endif
#ifndef PG8_ALIGN
#define PG8_ALIGN true
#endif
#define GAS __attribute__((address_space(1)))
#define LAS __attribute__((address_space(3)))
typedef unsigned short bf16;
typedef unsigned v4u __attribute__((ext_vector_type(4)));
typedef float f32x4 __attribute__((ext_vector_type(4)));
typedef short bf16x8 __attribute__((ext_vector_type(8)));
typedef GAS unsigned gu32;
typedef GAS unsigned long long gu64;
#define RLX_AGENT __ATOMIC_RELAXED, __HIP_MEMORY_SCOPE_AGENT
#define LDS_WAIT() asm volatile("s_waitcnt lgkmcnt(0)" ::: "memory")
#define VM_WAIT() asm volatile("s_waitcnt vmcnt(0)" ::: "memory")
__device__ __forceinline__ unsigned long long rt() { return __builtin_amdgcn_s_memrealtime(); }
__device__ __forceinline__ unsigned f2bf(float f) { unsigned u = __builtin_bit_cast(unsigned, f); return (u + 0x7fffu + ((u >> 16) & 1u)) >> 16; }
__device__ __forceinline__ unsigned pk2(float lo, float hi) { return f2bf(lo) | (f2bf(hi) << 16); }

#define XB_TMO      128
#define XB_XCNT(j)  (256  + 64 * (j))
#define XB_XSUB(j)  (1280 + 64 * (j))
#define XB_XGEN(j)  (2304 + 64 * (j))
#define XB_TOP      3328
#define XB_TOPGEN   3392
#define XCD_BAR_WORDS 3456
#define XB_SPIN_CAP (1u << 22)

__device__ __forceinline__ unsigned xb_ld(unsigned* p)              { return __hip_atomic_load(p, __ATOMIC_RELAXED, __HIP_MEMORY_SCOPE_AGENT); }
__device__ __forceinline__ unsigned xb_add(unsigned* p, unsigned v) { return __hip_atomic_fetch_add(p, v, __ATOMIC_RELAXED, __HIP_MEMORY_SCOPE_AGENT); }
__device__ __forceinline__ unsigned xb_xcc_id() { return (unsigned)__builtin_amdgcn_s_getreg((3 << 11) | 20) & 0xFu; }
#define XB_SPIN(cond, bar) do { unsigned _sp = 0; while (cond) { __builtin_amdgcn_s_sleep(1); \
    if ((++_sp & 255u) == 0u) { if (xb_ld(&(bar)[XB_TMO])) break; if (_sp > XB_SPIN_CAP) { atomicAdd(&(bar)[XB_TMO], 1u); break; } } } } while (0)

struct XcdBarrier {
    unsigned* bar; unsigned x;
    volatile LAS unsigned* st;
};

__device__ __forceinline__ XcdBarrier xcd_barrier_post(unsigned* bar, volatile LAS unsigned* st) {
    XcdBarrier b; b.bar = bar; b.x = xb_xcc_id(); b.st = st;
    if (threadIdx.x == 0) (void)xb_add(&bar[XB_XCNT(b.x)], 1u);
    return b;
}
__device__ __forceinline__ void xcd_barrier_complete(unsigned* bar, unsigned x, unsigned& nloc, unsigned& nx) {
    const unsigned G = gridDim.x * gridDim.y * gridDim.z;
    unsigned sum, cnt, mine, sp = 0u;
    for (;;) {
        sum = 0u; cnt = 0u; mine = 0u;
#pragma unroll
        for (unsigned j = 0; j < 16; ++j) { const unsigned c = xb_ld(&bar[XB_XCNT(j)]); sum += c; cnt += (c > 0u) ? 1u : 0u; mine = (j == x) ? c : mine; }
        if (sum == G) break;
        __builtin_amdgcn_s_sleep(1);
        if ((++sp & 255u) == 0u) { if (xb_ld(&bar[XB_TMO])) break; if (sp > XB_SPIN_CAP) { atomicAdd(&bar[XB_TMO], 1u); break; } }
    }
    nloc = mine > 0u ? mine : 1u; nx = cnt > 0u ? cnt : 1u;
}

__device__ __forceinline__ void xcd_barrier(const XcdBarrier& b) {
    asm volatile("s_waitcnt vmcnt(0)" ::: "memory");
    __syncthreads();
    if (threadIdx.x == 0) {
        unsigned* bar = b.bar;
        __builtin_amdgcn_s_waitcnt(0);
        unsigned nloc = b.st[0], nx = b.st[1];
        if (nloc == 0u) { xcd_barrier_complete(bar, b.x, nloc, nx); b.st[0] = nloc; b.st[1] = nx; }
        const unsigned old = xb_add(&bar[XB_XSUB(b.x)], 1u);
        const unsigned gen = old / nloc;
        if (old + 1u == (gen + 1u) * nloc) {
            __builtin_amdgcn_fence(__ATOMIC_RELEASE, "agent");
            asm volatile("s_waitcnt vmcnt(0)" ::: "memory");
            const unsigned og = xb_add(&bar[XB_TOP], 1u);
            const unsigned tg = og / nx;
            if (og + 1u == (tg + 1u) * nx) xb_add(&bar[XB_TOPGEN], 1u);
            else XB_SPIN(xb_ld(&bar[XB_TOPGEN]) == tg, bar);
            __builtin_amdgcn_fence(__ATOMIC_ACQUIRE, "agent");
            xb_add(&bar[XB_XGEN(b.x)], 1u);
            asm volatile("s_waitcnt vmcnt(0)" ::: "memory");
        } else {
            XB_SPIN(xb_ld(&bar[XB_XGEN(b.x)]) == gen, bar);
            __builtin_amdgcn_fence(__ATOMIC_ACQUIRE, "agent");
            asm volatile("s_waitcnt vmcnt(0)" ::: "memory");
        }
    }
    __syncthreads();
}

__device__ __forceinline__ void xcd_arrive(const XcdBarrier& b, volatile LAS unsigned* sx) {
    asm volatile("s_waitcnt vmcnt(0)" ::: "memory");
    __syncthreads();
    if (threadIdx.x == 0) {
        unsigned* bar = b.bar;
        __builtin_amdgcn_s_waitcnt(0);
        unsigned nloc = b.st[0], nx = b.st[1];
        if (nloc == 0u) { xcd_barrier_complete(bar, b.x, nloc, nx); b.st[0] = nloc; b.st[1] = nx; }
        const unsigned old = xb_add(&bar[XB_XSUB(b.x)], 1u);
        const unsigned gen = old / nloc;
        unsigned leader = 0u, key = gen;
        if (old + 1u == (gen + 1u) * nloc) {
            leader = 1u;
            __builtin_amdgcn_fence(__ATOMIC_RELEASE, "agent");
            asm volatile("s_waitcnt vmcnt(0)" ::: "memory");
            const unsigned og = xb_add(&bar[XB_TOP], 1u);
            const unsigned tg = og / nx; key = tg;
            if (og + 1u == (tg + 1u) * nx) xb_add(&bar[XB_TOPGEN], 1u);
        }
        sx[0] = leader; sx[1] = key;
    }
}
__device__ __forceinline__ void xcd_wait(const XcdBarrier& b, volatile LAS unsigned* sx) {
    if (threadIdx.x == 0) {
        unsigned* bar = b.bar;
        const unsigned leader = sx[0], key = sx[1];
        if (leader) {
            XB_SPIN(xb_ld(&bar[XB_TOPGEN]) == key, bar);
            __builtin_amdgcn_fence(__ATOMIC_ACQUIRE, "agent");
            xb_add(&bar[XB_XGEN(b.x)], 1u);
            asm volatile("s_waitcnt vmcnt(0)" ::: "memory");
        } else {
            XB_SPIN(xb_ld(&bar[XB_XGEN(b.x)]) == key, bar);
            __builtin_amdgcn_fence(__ATOMIC_ACQUIRE, "agent");
            asm volatile("s_waitcnt vmcnt(0)" ::: "memory");
        }
    }
    __syncthreads();
}

constexpr int NWAVES = 8;
constexpr int T_ = 16384, SEQ = 4096, DM = 1024, NPROJ = 2304, INC = 2312;
constexpr int PJ_K = 512, PJ_V = 640, PJ_Z = 768, PJ_XBC = 1280;
constexpr float EPS = 1e-6f;
constexpr size_t MiB = 1u << 20;
constexpr size_t WS_CTL = 0, CTL_ZERO_BYTES = 1 * MiB;
constexpr size_t WS_SMALL = 1 * MiB;
constexpr size_t WS_WIN = 2 * MiB, WS_WOUT = 7 * MiB, WS_WQ = 9 * MiB;
constexpr size_t WS_ED = 13 * MiB, WS_EU = 29 * MiB;
constexpr size_t WS_XN = 77 * MiB;
constexpr size_t WS_PROJ = 109 * MiB;
constexpr size_t WS_ST = 181 * MiB;
constexpr size_t WS_IDX = 213 * MiB, WS_GATE = 221 * MiB, WS_SSQ = 229 * MiB, WS_END = 230 * MiB;
constexpr size_t DO_Y = 0, DO_DT = 41 * MiB;
constexpr size_t WS_CC = 230 * MiB, WS_DT = 238 * MiB, WS_EA = 239 * MiB, WS_CDEC = 240 * MiB, WS_PREV = WS_IDX;
constexpr size_t DO_YPF = 0, DO_YPLAIN = 32 * MiB;
constexpr size_t WS_PART = WS_PROJ;
constexpr size_t WS_H8 = WS_XN, WS_HS = WS_DT;
constexpr size_t WS_SSQ2 = WS_EA;
constexpr int CW_BAR = 4096, CW_RANK = 8192;
constexpr int RING_OFF = 0, RING_BYTES = 147456, LDSCTL_OFF = RING_BYTES, MISC_OFF = LDSCTL_OFF + 320, LDS_BYTES = 163840;

__constant__ unsigned char c_bucket[128] = {0, 1, 2, 3, 4, 5, 6, 7, 8, 9, 10, 11, 12, 13, 14, 15, 16, 16, 16, 17, 17, 18, 18, 18, 19, 19, 19, 20, 20, 20, 20, 21, 21, 21, 21, 22, 22, 22, 22, 22, 23, 23, 23, 23, 23, 23, 24, 24, 24, 24, 24, 24, 25, 25, 25, 25, 25, 25, 25, 26, 26, 26, 26, 26, 26, 26, 26, 27, 27, 27, 27, 27, 27, 27, 27, 27, 27, 28, 28, 28, 28, 28, 28, 28, 28, 28, 28, 29, 29, 29, 29, 29, 29, 29, 29, 29, 29, 29, 29, 30, 30, 30, 30, 30, 30, 30, 30, 30, 30, 30, 30, 30, 30, 31, 31, 31, 31, 31, 31, 31, 31, 31, 31, 31, 31, 31, 31, 31};

typedef float v16f __attribute__((ext_vector_type(16)));
typedef float v32f __attribute__((ext_vector_type(32)));
typedef unsigned v6u __attribute__((ext_vector_type(6)));
typedef _Float16 v32h __attribute__((ext_vector_type(32)));
struct Frame {
    LAS unsigned char* lds;
    volatile LAS unsigned* MISC;
    gu32* ctl;
    int wave, vcu, G;
};
__device__ __forceinline__ int lane_id() { int l; asm volatile("v_mbcnt_lo_u32_b32 %0, -1, 0\n\tv_mbcnt_hi_u32_b32 %0, -1, %0" : "=v"(l)); return l; }
__device__ __forceinline__ int opq(int x) { asm volatile("" : "+v"(x)); return x; }
template <int M> __device__ __forceinline__ float swz_xor(float v) { return __int_as_float(__builtin_amdgcn_ds_swizzle(__float_as_int(v), (M << 10) | 0x1F)); }
__device__ __forceinline__ float sum_halves(float v) { const auto r = __builtin_amdgcn_permlane32_swap(__float_as_uint(v), __float_as_uint(v), false, false); return __uint_as_float(r[0]) + __uint_as_float(r[1]); }
__device__ __forceinline__ float max_halves(float v) { const auto r = __builtin_amdgcn_permlane32_swap(__float_as_uint(v), __float_as_uint(v), false, false); return fmaxf(__uint_as_float(r[0]), __uint_as_float(r[1])); }
__device__ __forceinline__ int imax_halves(int v) { const auto r = __builtin_amdgcn_permlane32_swap((unsigned)v, (unsigned)v, false, false); return max((int)r[0], (int)r[1]); }
__device__ __forceinline__ float wave_sum(float v) {
    v += swz_xor<1>(v); v += swz_xor<2>(v); v += swz_xor<4>(v); v += swz_xor<8>(v); v += swz_xor<16>(v);
    return sum_halves(v);
}
__device__ __forceinline__ float bf2f(unsigned short b) { return __uint_as_float((unsigned)b << 16); }
__device__ __forceinline__ float bflo(unsigned w) { return __uint_as_float(w << 16); }
__device__ __forceinline__ float bfhi(unsigned w) { return __uint_as_float(w & 0xffff0000u); }
__device__ __forceinline__ float silu_f(float x) { return x / (1.f + __expf(-x)); }

__device__ __forceinline__ void p0_transpose_item(const float* W, int ldw, int K, int nblk, bf16* WT, const float* kscale, LAS float* scr, int item, int lane) {
    const int kb = item / nblk, nb = item % nblk, k0 = 64 * kb, n0 = 32 * nb;
    float ks_[32];
#pragma unroll
    for (int i = 0; i < 32; ++i) ks_[i] = kscale ? kscale[k0 + 2 * i + (lane >> 5)] : 1.f;
    float vv_[32];
#pragma unroll
    for (int i = 0; i < 32; ++i) vv_[i] = W[(size_t)(k0 + 2 * i + (lane >> 5)) * ldw + n0 + (lane & 31)];
#pragma unroll
    for (int i = 0; i < 32; ++i) scr[(2 * i + (lane >> 5)) * 33 + (lane & 31)] = vv_[i] * ks_[i];
#pragma unroll 1
    for (int i = 32; i < 32; ++i) { const int kk = 2 * i + (lane >> 5); float v = W[(size_t)(k0 + kk) * ldw + n0 + (lane & 31)]; if (kscale) v *= kscale[k0 + kk]; scr[kk * 33 + (lane & 31)] = v; }
    LDS_WAIT(); asm volatile("" ::: "memory");
    const int c = lane & 7;
#pragma unroll
    for (int j = 0; j < 4; ++j) { const int n = (lane >> 3) + 8 * j; const LAS float* s = scr + (8 * c) * 33 + n;
        v4u o; o.x = pk2(s[0 * 33], s[1 * 33]); o.y = pk2(s[2 * 33], s[3 * 33]); o.z = pk2(s[4 * 33], s[5 * 33]); o.w = pk2(s[6 * 33], s[7 * 33]);
        *(GAS v4u*)(WT + (size_t)(n0 + n) * K + k0 + 8 * c) = o; }
    LDS_WAIT(); asm volatile("" ::: "memory");
}
struct Ptrs {
    const float *x, *norm_mix, *w_in, *conv_w, *conv_b, *dt_bias, *a_log, *d_skip, *ssd_norm_w, *sinks, *w_out, *rel_bias, *norm_ffn, *w_query, *sk1, *sk2, *e_down, *e_up, *norm_final;
    float* out; unsigned char* ws;
};
constexpr int Q_SPLIT = 0;
__device__ __forceinline__ unsigned pack4_i8(float a, float b, float c, float d) {
    const int ia = __float2int_rn(a), ib = __float2int_rn(b), ic = __float2int_rn(c), id = __float2int_rn(d);
    return (unsigned)(ia & 0xff) | ((unsigned)(ib & 0xff) << 8) | ((unsigned)(ic & 0xff) << 16) | ((unsigned)(id & 0xff) << 24);
}
__device__ __forceinline__ unsigned pack8_i4(const float* v, float inv) {
    unsigned o = 0u;
#pragma unroll
    for (int i = 0; i < 8; ++i) { int q = __float2int_rn(v[i] * inv); q = q < -7 ? -7 : (q > 7 ? 7 : q); o |= ((unsigned)q & 15u) << (4 * i); }
    return o;
}
__device__ __forceinline__ void quant_fp8s(const Ptrs& P, int lane_, int r_lo, int r_hi, int w, int nw) {
    float* SC = (float*)(P.ws + WS_SMALL);
    int row = r_lo + w;
    if (row >= r_hi) return;
    float4 nx[4];
#pragma unroll
    for (int q = 0; q < 4; ++q) nx[q] = ((const float4*)(P.e_down + (size_t)(row & 16383) * DM) + 4 * lane_)[q];
    float4 w4[4];
#pragma unroll
    for (int q = 0; q < 4; ++q) w4[q] = ((const float4*)P.norm_ffn)[4 * lane_ + q];
    for (; row < r_hi; row += nw) {
        const int e = row & 16383;
        float v[16];
#pragma unroll
        for (int q = 0; q < 4; ++q) { const float4 t = nx[q]; v[4 * q] = t.x * w4[q].x; v[4 * q + 1] = t.y * w4[q].y; v[4 * q + 2] = t.z * w4[q].z; v[4 * q + 3] = t.w * w4[q].w; }
        { const int rn = (row + nw < r_hi) ? row + nw : row;
#pragma unroll
          for (int q = 0; q < 4; ++q) nx[q] = ((const float4*)(P.e_down + (size_t)(rn & 16383) * DM) + 4 * lane_)[q]; }
        float ss = 0.f;
#pragma unroll
        for (int q = 0; q < 16; ++q) ss = fmaf(v[q], v[q], ss);
        const float sc = fmaxf(2.5f * sqrtf(wave_sum(ss) * (1.f / 1024.f)) * (1.f / 7.f), 1e-30f);
        const float inv = 1.f / sc;
        const unsigned long long o = (unsigned long long)pack8_i4(v, inv) | ((unsigned long long)pack8_i4(v + 8, inv) << 32);
        *(unsigned long long*)(P.ws + WS_ED + ((size_t)(lane_ >> 4) * 16384 + e) * 128 + (lane_ & 15) * 8) = o;
        if (lane_ == 0) SC[row] = sc;
    }
}
typedef float f32x2q __attribute__((ext_vector_type(2)));
__device__ __forceinline__ void quant_fp6u(const Ptrs& P, int lane_, int q_lo, int q_hi, int w, int nw) {
    float* SC = (float*)(P.ws + WS_SMALL);
    int e = 2 * q_lo + w; const int e_hi = 2 * q_hi;
    if (e >= e_hi) return;
    float4 nx[4];
#pragma unroll
    for (int k = 0; k < 4; ++k) nx[k] = ((const float4*)(P.e_up + (size_t)e * DM) + 4 * lane_)[k];
    for (; e < e_hi; e += nw) {
        float v[16];
#pragma unroll
        for (int k = 0; k < 4; ++k) { const float4 t = nx[k]; v[4 * k] = t.x; v[4 * k + 1] = t.y; v[4 * k + 2] = t.z; v[4 * k + 3] = t.w; }
        { const int en = (e + nw < e_hi) ? e + nw : e;
#pragma unroll
          for (int k = 0; k < 4; ++k) nx[k] = ((const float4*)(P.e_up + (size_t)en * DM) + 4 * lane_)[k]; }
        float am = 0.f;
#pragma unroll
        for (int k = 0; k < 16; ++k) am = fmaxf(am, fabsf(v[k]));
        am = fmaxf(am, swz_xor<1>(am)); am = fmaxf(am, swz_xor<2>(am)); am = fmaxf(am, swz_xor<4>(am)); am = fmaxf(am, swz_xor<8>(am)); am = fmaxf(am, swz_xor<16>(am)); am = max_halves(am);
        am = fmaxf(am, 1e-30f);
        const float inv = 6.0f / am;
        unsigned pk[2];
#pragma unroll
        for (int wd = 0; wd < 2; ++wd) { unsigned p4 = 0u;
            p4 = __builtin_amdgcn_cvt_scalef32_pk_fp4_f32(p4, v[8 * wd] * inv, v[8 * wd + 1] * inv, 1.0f, 0);
            p4 = __builtin_amdgcn_cvt_scalef32_pk_fp4_f32(p4, v[8 * wd + 2] * inv, v[8 * wd + 3] * inv, 1.0f, 1);
            p4 = __builtin_amdgcn_cvt_scalef32_pk_fp4_f32(p4, v[8 * wd + 4] * inv, v[8 * wd + 5] * inv, 1.0f, 2);
            p4 = __builtin_amdgcn_cvt_scalef32_pk_fp4_f32(p4, v[8 * wd + 6] * inv, v[8 * wd + 7] * inv, 1.0f, 3);
            pk[wd] = p4; }
        *(unsigned long long*)(P.ws + WS_EU + (size_t)e * 512 + 8 * lane_) = (unsigned long long)pk[0] | ((unsigned long long)pk[1] << 32);
        if (lane_ == 0) SC[16384 + e] = am * (1.f / 6.0f);
    }
}
__device__ __forceinline__ void p0_prologue(Frame& F0, const Ptrs& P) {
    const Frame& F = F0; const int lane_ = lane_id(), tid_ = F.wave * 64 + lane_;
    LAS float* scr = (LAS float*)(F.lds + RING_OFF + F.wave * 16384);
    const int gw = F.vcu * NWAVES + F.wave, NGW = F.G * NWAVES;
    bf16* Win_t = (bf16*)(P.ws + WS_WIN); bf16* Wout_t = (bf16*)(P.ws + WS_WOUT); bf16* Wq_t = (bf16*)(P.ws + WS_WQ);
    constexpr int I_IN = 16 * 72;
    for (int it = gw; it < I_IN; it += NGW) p0_transpose_item(P.w_in, INC, DM, 72, Win_t, nullptr, scr, it, lane_);
    (void)Wout_t; (void)Wq_t;
    __syncthreads();
    { LAS float* Wdt = (LAS float*)(F.lds + RING_OFF);
      for (int i = tid_; i < 8192; i += 512) Wdt[i] = P.w_in[(size_t)(i >> 3) * INC + NPROJ + (i & 7)];
      __syncthreads();
      bf16* XN = (bf16*)(P.ws + WS_XN); float* DT = (float*)(P.ws + WS_DT);
      for (int m0 = gw * 2; m0 < T_; m0 += NGW * 2) {
        float4 xv[2][4];
#pragma unroll
        for (int rr = 0; rr < 2; ++rr) { const float4* xr = (const float4*)(P.x + (size_t)(m0 + rr) * DM);
#pragma unroll
            for (int j = 0; j < 4; ++j) xv[rr][j] = xr[j * 64 + lane_]; }
#pragma unroll
        for (int rr = 0; rr < 2; ++rr) { const int m = m0 + rr;
        float4 v[4]; float s = 0.f;
#pragma unroll
        for (int j = 0; j < 4; ++j) { v[j] = xv[rr][j]; s += v[j].x * v[j].x + v[j].y * v[j].y + v[j].z * v[j].z + v[j].w * v[j].w; }
        const float r = rsqrtf(wave_sum(s) * (1.f / 1024.f) + EPS);
        float d8[8];
#pragma unroll
        for (int q = 0; q < 8; ++q) d8[q] = 0.f;
        unsigned long long* o8 = (unsigned long long*)(XN + (size_t)m * DM);
#pragma unroll
        for (int j = 0; j < 4; ++j) { const float4 w = ((const float4*)P.norm_mix)[j * 64 + lane_];
            const float e0 = v[j].x * r * w.x, e1 = v[j].y * r * w.y, e2 = v[j].z * r * w.z, e3 = v[j].w * r * w.w;
            o8[j * 64 + lane_] = (unsigned long long)pk2(e0, e1) | ((unsigned long long)pk2(e2, e3) << 32);
            const float ev[4] = {e0, e1, e2, e3};
#pragma unroll
            for (int e = 0; e < 4; ++e) { const LAS f32x4* wr = (const LAS f32x4*)(Wdt + (size_t)(j * 256 + lane_ * 4 + e) * 8); const f32x4 w0 = wr[0], w1 = wr[1];
                d8[0] += ev[e] * w0.x; d8[1] += ev[e] * w0.y; d8[2] += ev[e] * w0.z; d8[3] += ev[e] * w0.w; d8[4] += ev[e] * w1.x; d8[5] += ev[e] * w1.y; d8[6] += ev[e] * w1.z; d8[7] += ev[e] * w1.w; } }
#pragma unroll
        for (int q = 0; q < 8; ++q) d8[q] = wave_sum(d8[q]);
        if (lane_ == 0) { float4* dp = (float4*)(DT + (size_t)m * 8); dp[0] = make_float4(d8[0], d8[1], d8[2], d8[3]); dp[1] = make_float4(d8[4], d8[5], d8[6], d8[7]); }
        }
      }
      __syncthreads(); }
}

__device__ __forceinline__ void p1_slack(Frame& F0, const Ptrs& P, int w, int nw) {
    const Frame& F = F0; const int lane_ = lane_id();
    LAS float* scr = (LAS float*)(F.lds + RING_OFF + F.wave * 16384);
    bf16* Wout_t = (bf16*)(P.ws + WS_WOUT); bf16* Wq_t = (bf16*)(P.ws + WS_WQ);
    constexpr int I_OUT = 16 * 32, I_Q = 16 * 64;
    for (int it = w; it < I_OUT + I_Q; it += nw) {
        if (it < I_OUT) p0_transpose_item(P.w_out, DM, DM, 32, Wout_t, nullptr, scr, it, lane_);
        else p0_transpose_item(P.w_query, 2048, DM, 64, Wq_t, P.norm_ffn, scr, it - I_OUT, lane_);
    }
    quant_fp6u(P, lane_, 0, 8192, w, nw);
    quant_fp8s(P, lane_, 0, 16384, w, nw);
}
struct EpiResH {
    static constexpr bool PERM = false, AFTER_DRAIN = false;
    const float* X; bf16* HB; float* SSQ;
    __device__ __forceinline__ void operator()(const pg8::f32x4 (&acc)[2][2][4][2], const pg8::Unit& u, int wr, int wc, int fr, int fq) const {
        const int row0 = u.pm * 256 + wr * 64 + fr, col0 = u.pn * 256 + wc * 32 + 4 * fq;
#pragma unroll
        for (int ai = 0; ai < 2; ++ai)
#pragma unroll
            for (int m = 0; m < 4; ++m) { const int row = row0 + ai * 128 + m * 16; float ss = 0.f;
#pragma unroll
                for (int bj = 0; bj < 2; ++bj)
#pragma unroll
                    for (int n = 0; n < 2; ++n) { const size_t off = (size_t)row * DM + col0 + bj * 128 + n * 16;
                        const pg8::f32x4 h = acc[ai][bj][m][n] + *(const pg8::f32x4*)(X + off);
                        ss += h[0] * h[0] + h[1] * h[1] + h[2] * h[2] + h[3] * h[3];
                        *(unsigned long long*)(HB + off) = (unsigned long long)pk2(h[0], h[1]) | ((unsigned long long)pk2(h[2], h[3]) << 32); }
                ss += swz_xor<16>(ss); ss = sum_halves(ss);
                if (fq == 0) SSQ[(size_t)row * 16 + u.pn * 4 + wc] = ss; }
    }
};

typedef float f32x16 __attribute__((ext_vector_type(16)));
typedef short s16x4 __attribute__((ext_vector_type(4)));
typedef float f32x2_t __attribute__((ext_vector_type(2)));
typedef __bf16 bf16x2_t __attribute__((ext_vector_type(2)));
#define MFMA32(a, b, c) __builtin_amdgcn_mfma_f32_32x32x16_bf16((a), (b), (c), 0, 0, 0)
__device__ __forceinline__ int crow(int reg, int h) { return (reg & 3) + 8 * (reg >> 2) + 4 * h; }
__device__ __forceinline__ unsigned cvtpk(float lo, float hi) { f32x2_t v = {lo, hi}; bf16x2_t b = __builtin_convertvector(v, bf16x2_t); return __builtin_bit_cast(unsigned, b); }
__device__ __forceinline__ bf16x8 pack8(const f32x16& x, int s) {
    v4u p; p.x = cvtpk(x[8 * s], x[8 * s + 1]); p.y = cvtpk(x[8 * s + 2], x[8 * s + 3]); p.z = cvtpk(x[8 * s + 4], x[8 * s + 5]); p.w = cvtpk(x[8 * s + 6], x[8 * s + 7]);
    return __builtin_bit_cast(bf16x8, p);
}
constexpr float LOG2E = 1.4426950408889634f;
constexpr int LDP = 136;
constexpr int S1_XT = 0, S1_XTW = 17408, S1_BSN = 34816, S1_CLN = 69632, S1_BNL = 104448, S1_F32 = 139264;

__device__ __forceinline__ float silu_fast(float x) { return x * __builtin_amdgcn_rcpf(1.f + __builtin_amdgcn_exp2f(-x * LOG2E)); }
__device__ __forceinline__ int swz_t(int row, int l) { return row * LDP + ((((l >> 3) ^ (row >> 3)) & 7) | ((l >> 3) & 8)) * 8 + (l & 7); }
#define S1_CONV8(A_, IT_) do { _Pragma("unroll") for (int e_ = 0; e_ < 8; ++e_) A_[e_] = bias[e_]; \
        _Pragma("unroll") for (int j_ = 0; j_ < 4; ++j_) { const v4u rw_ = raw[(IT_) + j_]; \
            A_[0] += w[j_][0] * bflo(rw_.x); A_[1] += w[j_][1] * bfhi(rw_.x); A_[2] += w[j_][2] * bflo(rw_.y); A_[3] += w[j_][3] * bfhi(rw_.y); \
            A_[4] += w[j_][4] * bflo(rw_.z); A_[5] += w[j_][5] * bfhi(rw_.z); A_[6] += w[j_][6] * bflo(rw_.w); A_[7] += w[j_][7] * bfhi(rw_.w); } \
        _Pragma("unroll") for (int e_ = 0; e_ < 8; ++e_) A_[e_] = silu_fast(A_[e_]); } while (0)
#define S1_LOADW(CHB_) do { _Pragma("unroll") for (int j_ = 0; j_ < 4; ++j_) { const float4 w0_ = *(const float4*)(P.conv_w + j_ * 1024 + (CHB_)), w1_ = *(const float4*)(P.conv_w + j_ * 1024 + (CHB_) + 4); \
            w[j_][0] = w0_.x; w[j_][1] = w0_.y; w[j_][2] = w0_.z; w[j_][3] = w0_.w; w[j_][4] = w1_.x; w[j_][5] = w1_.y; w[j_][6] = w1_.z; w[j_][7] = w1_.w; } \
        { const float4 b0_ = *(const float4*)(P.conv_b + (CHB_)), b1_ = *(const float4*)(P.conv_b + (CHB_) + 4); \
          bias[0] = b0_.x; bias[1] = b0_.y; bias[2] = b0_.z; bias[3] = b0_.w; bias[4] = b1_.x; bias[5] = b1_.y; bias[6] = b1_.z; bias[7] = b1_.w; } } while (0)
__device__ __forceinline__ void ssd_s1(Frame& F, const Ptrs& P) {
    const bf16* PROJ = (const bf16*)(P.ws + WS_PROJ); const float* DT = (const float*)(P.ws + WS_DT);
    float* EA = (float*)(P.ws + WS_EA); float* CDEC = (float*)(P.ws + WS_CDEC); bf16* CC = (bf16*)(P.ws + WS_CC);
    unsigned* ST = (unsigned*)(P.ws + WS_ST); unsigned* YPF = (unsigned*)((char*)P.out + DO_YPF);
    LAS unsigned char* L = F.lds + RING_OFF;
    LAS bf16* Xt = (LAS bf16*)(L + S1_XT); LAS bf16* Xtw = (LAS bf16*)(L + S1_XTW); LAS bf16* Bsn = (LAS bf16*)(L + S1_BSN); LAS bf16* Cln = (LAS bf16*)(L + S1_CLN); LAS bf16* Bnl = (LAS bf16*)(L + S1_BNL);
    LAS float* f32base = (LAS float*)(L + S1_F32);
    const int lane = lane_id(); const int tid_ = F.wave * 64 + lane;
    for (int ug = F.vcu; ug < 256; ug += F.G) {
        const int grp = ug & 1, c = (ug >> 1) & 31, b = ug >> 6, t0 = b * SEQ + c * 128;
        __syncthreads();
        if (F.wave < 4) {
            const int h = 4 * grp + F.wave, us = (b * 32 + c) * 8 + h;
            const float A = -__expf(P.a_log[h]), dtb = P.dt_bias[h];
            const int ln = opq(lane_id());
            LAS float* acum2 = f32base + F.wave * 384; LAS float* wv = acum2 + 128; LAS float* wend = wv + 128;
            const float x0 = DT[(size_t)(t0 + 2 * ln) * 8 + h] + dtb, x1 = DT[(size_t)(t0 + 2 * ln + 1) * 8 + h] + dtb;
            const float dt0 = fmaxf(x0, 0.f) + log1pf(__expf(-fabsf(x0))), dt1 = fmaxf(x1, 0.f) + log1pf(__expf(-fabsf(x1)));
            const float a0 = dt0 * A, a1 = dt1 * A;
            float s = a0 + a1;
#pragma unroll
            for (int o = 1; o < 64; o <<= 1) { const float v = __int_as_float(__builtin_amdgcn_ds_bpermute((ln - o) * 4, __float_as_int(s))); if (ln >= o) s += v; }
            const float ac1 = s, ac0 = s - a1, tot = __uint_as_float(__builtin_amdgcn_readlane(__float_as_uint(s), 63));
            acum2[2 * ln] = ac0 * LOG2E; acum2[2 * ln + 1] = ac1 * LOG2E;
            wv[2 * ln] = log2f(dt0) - ac0 * LOG2E; wv[2 * ln + 1] = log2f(dt1) - ac1 * LOG2E;
            wend[2 * ln] = dt0 * exp2f((tot - ac0) * LOG2E); wend[2 * ln + 1] = dt1 * exp2f((tot - ac1) * LOG2E);
            EA[(size_t)(t0 + 2 * ln) * 8 + h] = exp2f(ac0 * LOG2E); EA[(size_t)(t0 + 2 * ln + 1) * 8 + h] = exp2f(ac1 * LOG2E);
            if (ln == 0) CDEC[us] = exp2f(tot * LOG2E);
        }
        { const int tidc = opq(tid_);
          if (tidc < 440) {
            const int cg = tidc % 40, sg = tidc / 40, l0 = 12 * sg, h0 = 4 * grp;
            int chb; if (cg < 8) chb = h0 * 64 + cg * 8; else if (cg < 24) chb = 512 + grp * 128 + (cg - 8) * 8; else chb = 768 + grp * 128 + (cg - 24) * 8;
            v4u raw[15];
#pragma unroll
            for (int q = 0; q < 15; ++q) { const int ss = c * 128 + l0 - 3 + q; raw[q] = (v4u){0u, 0u, 0u, 0u};
                if (ss >= 0 && l0 - 3 + q < 128) raw[q] = *(const v4u*)(PROJ + (size_t)(b * SEQ + ss) * NPROJ + PJ_XBC + chb); }
            float w[4][8], bias[8]; S1_LOADW(chb);
#pragma unroll
            for (int it = 0; it < 12; it += 2) {
                const int l = l0 + it;
                if (l < 128) {
                    float a[8], a2[8]; S1_CONV8(a, it); S1_CONV8(a2, it + 1);
                    if (cg < 8) {
#pragma unroll
                        for (int e = 0; e < 8; ++e) *(LAS unsigned*)(Xt + swz_t(cg * 8 + e, l)) = cvtpk(a[e], a2[e]);
                    } else {
                        v4u o, o2; o.x = cvtpk(a[0], a[1]); o.y = cvtpk(a[2], a[3]); o.z = cvtpk(a[4], a[5]); o.w = cvtpk(a[6], a[7]);
                        o2.x = cvtpk(a2[0], a2[1]); o2.y = cvtpk(a2[2], a2[3]); o2.z = cvtpk(a2[4], a2[5]); o2.w = cvtpk(a2[6], a2[7]);
                        if (cg < 24) { const int n0 = (cg - 8) * 8; *(LAS v4u*)(Bsn + l * LDP + n0) = o; *(LAS v4u*)(Bsn + (l + 1) * LDP + n0) = o2;
#pragma unroll
                            for (int e = 0; e < 8; ++e) *(LAS unsigned*)(Bnl + swz_t(n0 + e, l)) = cvtpk(a[e], a2[e]);
                        } else { const int n0 = (cg - 24) * 8; *(LAS v4u*)(Cln + l * LDP + n0) = o; *(LAS v4u*)(Cln + (l + 1) * LDP + n0) = o2;
                            *(v4u*)(CC + (size_t)(t0 + l) * 256 + grp * 128 + n0) = o; *(v4u*)(CC + (size_t)(t0 + l + 1) * 256 + grp * 128 + n0) = o2; }
                    }
                }
            }
          } }
        __syncthreads();
#pragma unroll 1
        for (int hi = 0; hi < 4; ++hi) {
            const int h = 4 * grp + hi, u = (b * 32 + c) * 8 + h;
            const float Dh = P.d_skip[h];
            const LAS float* acum2 = f32base + hi * 384; const LAS float* wv = acum2 + 128; const LAS float* wend = wv + 128;
            const LAS bf16* Xc = (hi & 1) ? Xtw : Xt; LAS bf16* Xn = (hi & 1) ? Xt : Xtw;
            const int tidc = opq(tid_);
            const int cgn = tidc & 7, ln_ = 2 * (tidc >> 3), chn = (h + 1) * 64 + cgn * 8;
            v4u raw[5];
#pragma unroll
            for (int q = 0; q < 5; ++q) { const int ss = c * 128 + ln_ - 3 + q; raw[q] = (v4u){0u, 0u, 0u, 0u};
                if (hi < 3 && ss >= 0) raw[q] = *(const v4u*)(PROJ + (size_t)(b * SEQ + ss) * NPROJ + PJ_XBC + chn); }
            const int ln3 = opq(lane), r = ln3 & 31, hh = ln3 >> 5;
            if (F.wave < 4) {
                const int pt = F.wave >> 1;
#pragma unroll 1
                for (int q = 0; q < 2; ++q) {
                    const int lt = (F.wave & 1) ? (1 + q) : (3 * q);
                    f32x16 yacc;
#pragma unroll
                    for (int i = 0; i < 16; ++i) yacc[i] = 0.f;
                    const float al = acum2[32 * lt + r];
                    bf16x8 cf[8];
#pragma unroll
                    for (int kk = 0; kk < 8; ++kk) cf[kk] = *(const LAS bf16x8*)(Cln + (32 * lt + r) * LDP + 16 * kk + 8 * hh);
#pragma unroll 1
                    for (int st = 0; st <= lt; ++st) {
                        bf16x8 bfr[8];
#pragma unroll
                        for (int kk = 0; kk < 8; ++kk) bfr[kk] = *(const LAS bf16x8*)(Bsn + (32 * st + r) * LDP + 16 * kk + 8 * hh);
                        f32x4 wq[4];
#pragma unroll
                        for (int g4 = 0; g4 < 4; ++g4) wq[g4] = *(const LAS f32x4*)(wv + 32 * st + 8 * g4 + 4 * hh);
                        s16x4 xlo[2], xhi[2];
#pragma unroll
                        for (int sg = 0; sg < 2; ++sg) { const int prow = 32 * pt + r, lb = 32 * st + 16 * sg;
                            xlo[sg] = *(const LAS s16x4*)(Xc + swz_t(prow, lb) + 4 * hh); xhi[sg] = *(const LAS s16x4*)(Xc + swz_t(prow, lb + 8) + 4 * hh); }
                        __builtin_amdgcn_sched_barrier(0);
                        f32x16 macc;
#pragma unroll
                        for (int i = 0; i < 16; ++i) macc[i] = 0.f;
#pragma unroll
                        for (int kk = 0; kk < 8; ++kk) macc = MFMA32(bfr[kk], cf[kk], macc);
#pragma unroll
                        for (int i = 0; i < 16; ++i) { const int sl = crow(i, hh);
                            float f = __builtin_amdgcn_exp2f(al + wq[i >> 2][i & 3]);
                            if (st == lt && sl > r) f = 0.f;
                            macc[i] *= f; }
#pragma unroll
                        for (int sg = 0; sg < 2; ++sg) {
                            const bf16x8 bfrag = pack8(macc, sg);
                            const bf16x8 afrag = __builtin_shufflevector(xlo[sg], xhi[sg], 0, 1, 2, 3, 4, 5, 6, 7);
                            yacc = MFMA32(afrag, bfrag, yacc);
                        }
                    }
                    unsigned short xs16[16];
#pragma unroll
                    for (int i = 0; i < 16; ++i) xs16[i] = *(const LAS unsigned short*)(Xc + swz_t(32 * pt + crow(i, hh), 32 * lt + r));
                    __builtin_amdgcn_sched_barrier(0);
#pragma unroll
                    for (int i = 0; i < 16; i += 2) {
                        const float y0 = yacc[i] + Dh * __uint_as_float((unsigned)xs16[i] << 16), y1 = yacc[i + 1] + Dh * __uint_as_float((unsigned)xs16[i + 1] << 16);
                        YPF[((((size_t)u * 4 + lt) * 2 + pt) * 8 + (i >> 1)) * 64 + ln3] = cvtpk(y0, y1); }
                }
            } else {
                const int nt = F.wave - 4;
                bf16x8 bb[8];
                { v4u braw[8]; f32x4 we[8][2];
#pragma unroll
                  for (int kk = 0; kk < 8; ++kk) { braw[kk] = *(const LAS v4u*)(Bnl + swz_t(32 * nt + r, 16 * kk + 8 * hh));
                      we[kk][0] = *(const LAS f32x4*)(wend + 16 * kk + 8 * hh); we[kk][1] = *(const LAS f32x4*)(wend + 16 * kk + 8 * hh + 4); }
#pragma unroll
                  for (int kk = 0; kk < 8; ++kk) { v4u o;
                      o.x = cvtpk(bflo(braw[kk].x) * we[kk][0][0], bfhi(braw[kk].x) * we[kk][0][1]); o.y = cvtpk(bflo(braw[kk].y) * we[kk][0][2], bfhi(braw[kk].y) * we[kk][0][3]);
                      o.z = cvtpk(bflo(braw[kk].z) * we[kk][1][0], bfhi(braw[kk].z) * we[kk][1][1]); o.w = cvtpk(bflo(braw[kk].w) * we[kk][1][2], bfhi(braw[kk].w) * we[kk][1][3]);
                      bb[kk] = __builtin_bit_cast(bf16x8, o); } }
#pragma unroll 1
                for (int pt = 0; pt < 2; ++pt) {
                    bf16x8 xa[8];
#pragma unroll
                    for (int kk = 0; kk < 8; ++kk) xa[kk] = *(const LAS bf16x8*)(Xc + swz_t(32 * pt + r, 16 * kk + 8 * hh));
                    __builtin_amdgcn_sched_barrier(0);
                    f32x16 sacc;
#pragma unroll
                    for (int i = 0; i < 16; ++i) sacc[i] = 0.f;
#pragma unroll
                    for (int kk = 0; kk < 8; ++kk) sacc = MFMA32(xa[kk], bb[kk], sacc);
#pragma unroll
                    for (int i = 0; i < 16; i += 2) ST[((size_t)u * 32 + 16 * pt + (crow(i, hh) >> 1)) * 128 + 32 * nt + r] = cvtpk(sacc[i], sacc[i + 1]);
                }
            }
            if (hi < 3) {
                const int cg = cgn, l = ln_;
                float w[4][8], bias[8]; S1_LOADW(chn);
                float a[8], a2[8]; S1_CONV8(a, 0); S1_CONV8(a2, 1);
#pragma unroll
                for (int e = 0; e < 8; ++e) *(LAS unsigned*)(Xn + swz_t(cg * 8 + e, l)) = cvtpk(a[e], a2[e]);
            }
            __syncthreads();
        }
    }
}
__device__ __forceinline__ void ssd_s2(Frame& F, const Ptrs& P) {
    const unsigned* ST = (const unsigned*)(P.ws + WS_ST); const float* CDEC = (const float*)(P.ws + WS_CDEC); unsigned* PREV = (unsigned*)(P.ws + WS_PREV);
    for (int g = F.vcu * 512 + (F.wave * 64 + lane_id()); g < 65536; g += F.G * 512) {
        const int n2 = g & 63, p2 = (g >> 6) & 31, h = (g >> 11) & 7, b = g >> 14;
        uint2 st[32];
#pragma unroll
        for (int c = 0; c < 32; ++c) st[c] = *(const uint2*)(ST + ((size_t)(((b * 32 + c) * 8 + h) * 32 + p2)) * 128 + 2 * n2);
        float r00 = 0.f, r01 = 0.f, r10 = 0.f, r11 = 0.f;
#pragma unroll
        for (int c = 0; c < 32; ++c) { const size_t u = (size_t)((b * 32 + c) * 8 + h);
            PREV[((u * 64 + 2 * p2) * 128 + 2 * n2) >> 1] = cvtpk(r00, r01); PREV[((u * 64 + 2 * p2 + 1) * 128 + 2 * n2) >> 1] = cvtpk(r10, r11);
            const float d = CDEC[u];
            r00 = r00 * d + bflo(st[c].x); r10 = r10 * d + bfhi(st[c].x); r01 = r01 * d + bflo(st[c].y); r11 = r11 * d + bfhi(st[c].y); }
    }
}
__device__ __forceinline__ void ssd_s3(Frame& F, const Ptrs& P) {
    const bf16* CC = (const bf16*)(P.ws + WS_CC); const bf16* PREV = (const bf16*)(P.ws + WS_PREV); const float* EA = (const float*)(P.ws + WS_EA);
    const unsigned* YPF = (const unsigned*)((const char*)P.out + DO_YPF); const bf16* PROJ = (const bf16*)(P.ws + WS_PROJ); bf16* CAT = (bf16*)(P.ws + WS_XN);
    LAS float* red = (LAS float*)(F.lds + RING_OFF);
    const int lane = lane_id(), r = lane & 31, hh = lane >> 5, h = F.wave, grp = h >> 2;
    for (int v2 = F.vcu; v2 < 256; v2 += F.G) {
        const int lp = v2 & 1, c = (v2 >> 1) & 31, b = v2 >> 6;
        const size_t u = (size_t)((b * 32 + c) * 8 + h);
        bf16x8 af[2][8];
#pragma unroll
        for (int pt = 0; pt < 2; ++pt)
#pragma unroll
            for (int kk = 0; kk < 8; ++kk) af[pt][kk] = *(const bf16x8*)(PREV + (u * 64 + 32 * pt + r) * 128 + 16 * kk + 8 * hh);
#pragma unroll 1
        for (int li = 0; li < 2; ++li) {
            const int lt = 2 * lp + li;
            const int t = b * SEQ + c * 128 + lt * 32 + r;
            unsigned ypf[2][8]; unsigned long long zz[2][4];
#pragma unroll
            for (int pt = 0; pt < 2; ++pt) {
#pragma unroll
                for (int i = 0; i < 8; ++i) ypf[pt][i] = YPF[((((size_t)u * 4 + lt) * 2 + pt) * 8 + i) * 64 + lane];
#pragma unroll
                for (int g4 = 0; g4 < 4; ++g4) zz[pt][g4] = *(const unsigned long long*)(PROJ + (size_t)t * NPROJ + PJ_Z + h * 64 + 32 * pt + 8 * g4 + 4 * hh); }
            const float ea = EA[(size_t)t * 8 + h];
            bf16x8 bb[8];
#pragma unroll
            for (int kk = 0; kk < 8; ++kk) bb[kk] = *(const bf16x8*)(CC + (size_t)t * 256 + grp * 128 + 16 * kk + 8 * hh);
            f32x16 acc[2];
#pragma unroll
            for (int i = 0; i < 16; ++i) { acc[0][i] = 0.f; acc[1][i] = 0.f; }
#pragma unroll
            for (int kk = 0; kk < 8; ++kk) { acc[0] = MFMA32(af[0][kk], bb[kk], acc[0]); acc[1] = MFMA32(af[1][kk], bb[kk], acc[1]); }
            float ss = 0.f;
#pragma unroll
            for (int pt = 0; pt < 2; ++pt)
#pragma unroll
                for (int g4 = 0; g4 < 4; ++g4) {
                    const unsigned z01 = (unsigned)zz[pt][g4], z23 = (unsigned)(zz[pt][g4] >> 32);
                    const float zf[4] = {bflo(z01), bfhi(z01), bflo(z23), bfhi(z23)};
#pragma unroll
                    for (int e = 0; e < 4; ++e) { const int i = 4 * g4 + e;
                        const float y = acc[pt][i] * ea + ((i & 1) ? bfhi(ypf[pt][i >> 1]) : bflo(ypf[pt][i >> 1]));
                        const float yg = y * silu_fast(zf[e]); acc[pt][i] = yg; ss = fmaf(yg, yg, ss); }
                }
            ss = sum_halves(ss);
            LAS float* rd = red + li * 256;
            if (hh == 0) rd[h * 32 + r] = ss;
            __syncthreads();
            float tot = 0.f;
#pragma unroll
            for (int w = 0; w < 8; ++w) tot += rd[w * 32 + r];
            const float rn = rsqrtf(tot * (1.f / 512.f) + EPS);
#pragma unroll
            for (int pt = 0; pt < 2; ++pt)
#pragma unroll
                for (int g4 = 0; g4 < 4; ++g4) { const int ch = h * 64 + 32 * pt + 8 * g4 + 4 * hh;
                    const float4 w = *(const float4*)(P.ssd_norm_w + ch);
                    *(unsigned long long*)(CAT + (size_t)t * DM + 512 + ch) = (unsigned long long)cvtpk(acc[pt][4 * g4] * rn * w.x, acc[pt][4 * g4 + 1] * rn * w.y) | ((unsigned long long)cvtpk(acc[pt][4 * g4 + 2] * rn * w.z, acc[pt][4 * g4 + 3] * rn * w.w) << 32); }
        }
        __syncthreads();
    }
}
__device__ __forceinline__ float gelu_erf(float v) { return 0.5f * v * (1.f + erff(v * 0.70710678118654752f)); }
typedef float f32x2v __attribute__((ext_vector_type(2)));
#define CVT8(W, LO) __builtin_amdgcn_cvt_pk_f32_fp8((int)(W), LO)
template <int CTRL> __device__ __forceinline__ float dpp_f(float v) { return __int_as_float(__builtin_amdgcn_update_dpp(0, __float_as_int(v), CTRL, 0xF, 0xF, true)); }
__device__ __forceinline__ float sum8_dpp(float s) { s += dpp_f<0xB1>(s); s += dpp_f<0x4E>(s); s += dpp_f<0x141>(s); return s; }
struct PeerPlace { int vx, nx, rank, nloc; };
__device__ __forceinline__ PeerPlace peer_place(Frame& F) {
    __syncthreads();
    if (F.wave == 0 && lane_id() == 0) {
        unsigned* bar = (unsigned*)(F.ctl + CW_BAR); const unsigned x = xb_xcc_id();
        unsigned vx = 0, nx = 0;
        for (unsigned j = 0; j < 16; ++j) { const unsigned c = xb_ld(&bar[XB_XCNT(j)]); if (c) { if (j < x) ++vx; ++nx; } }
        const unsigned rank = xb_add((unsigned*)(F.ctl + CW_RANK) + 64 * x, 1u);
        F.MISC[10] = vx; F.MISC[11] = nx ? nx : 1u; F.MISC[12] = rank; F.MISC[13] = xb_ld(&bar[XB_XCNT(x)]);
    }
    __syncthreads();
    PeerPlace pp; pp.vx = (int)F.MISC[10]; pp.nx = (int)F.MISC[11]; pp.rank = (int)F.MISC[12]; pp.nloc = (int)F.MISC[13]; if (pp.nloc < 1) pp.nloc = 1;
    return pp;
}
__device__ __forceinline__ void h_quant_rows(Frame& F, const Ptrs& P) {
    const bf16* HB = (const bf16*)(P.ws + WS_ST); unsigned char* H8 = P.ws + WS_H8; float* HS = (float*)(P.ws + WS_HS);
    const int lane = lane_id();
    for (int t = F.vcu * NWAVES + F.wave; t < T_; t += F.G * NWAVES) {
        const v4u a0 = ((const v4u*)(HB + (size_t)t * DM))[2 * lane], a1 = ((const v4u*)(HB + (size_t)t * DM))[2 * lane + 1];
        float hf[16];
        hf[0] = bflo(a0.x); hf[1] = bfhi(a0.x); hf[2] = bflo(a0.y); hf[3] = bfhi(a0.y); hf[4] = bflo(a0.z); hf[5] = bfhi(a0.z); hf[6] = bflo(a0.w); hf[7] = bfhi(a0.w);
        hf[8] = bflo(a1.x); hf[9] = bfhi(a1.x); hf[10] = bflo(a1.y); hf[11] = bfhi(a1.y); hf[12] = bflo(a1.z); hf[13] = bfhi(a1.z); hf[14] = bflo(a1.w); hf[15] = bfhi(a1.w);
        float am = 0.f;
#pragma unroll
        for (int i = 0; i < 16; ++i) am = fmaxf(am, fabsf(hf[i]));
        am = fmaxf(am, dpp_f<0xB1>(am)); am = fmaxf(am, dpp_f<0x4E>(am)); am = fmaxf(am, dpp_f<0x141>(am)); am = fmaxf(am, dpp_f<0x140>(am)); am = fmaxf(am, 1e-30f);
        const float inv = 119.f / am;
        unsigned hi[2] = {0u, 0u}, lo[2] = {0u, 0u};
#pragma unroll
        for (int i = 0; i < 16; ++i) { const int q = __float2int_rn(hf[i] * inv); const int qh = (q + 8) >> 4, ql = q - 16 * qh;
            hi[i >> 3] |= ((unsigned)qh & 15u) << (4 * (i & 7)); lo[i >> 3] |= ((unsigned)ql & 15u) << (4 * (i & 7)); }
        unsigned char* dst = H8 + (size_t)t * 1024 + (lane >> 4) * 256 + (lane & 15) * 8;
        *(unsigned long long*)dst = (unsigned long long)hi[0] | ((unsigned long long)hi[1] << 32);
        *(unsigned long long*)(dst + 128) = (unsigned long long)lo[0] | ((unsigned long long)lo[1] << 32);
        if ((lane & 15) == 0) HS[(size_t)t * 8 + (lane >> 4)] = am * (1.f / 119.f);
    }
}
constexpr int PX_D = 16;
template <int CTRL> __device__ __forceinline__ int dpp_i(int v) { return __builtin_amdgcn_update_dpp(0, v, CTRL, 0xF, 0xF, true); }
#define PX_ISSUE(BUF, LO, HI) _Pragma("unroll") for (int b_ = 0; b_ < 8; ++b_) { const unsigned off_ = ((unsigned)__builtin_amdgcn_ds_bpermute((16 * (b_ & 3) + ps) * 4, (b_ & 4) ? (HI) : (LO)) << 7) | (unsigned)(dl << 5); \
        BUF[2 * b_] = *(const v4u*)(tab + off_); BUF[2 * b_ + 1] = *(const v4u*)(tab + off_ + 16); }
struct H4 { v4u h0, h1, l0, l1; };
#define PX_DOT8(Q, HH, HL) ah = __builtin_amdgcn_sdot8((int)(Q), (int)(HH), ah, false); al = __builtin_amdgcn_sdot8((int)(Q), (int)(HL), al, false);
__device__ __forceinline__ void peer_down_token(const v4u (&cur)[PX_D], const H4& h, const float hs, float* prow, int dl, int ps) {
    int sm[8];
#pragma unroll
    for (int b = 0; b < 8; ++b) { const v4u q0 = cur[2 * b], q1 = cur[2 * b + 1];
        int ah = 0, al = 0;
        PX_DOT8(q0.x, h.h0.x, h.l0.x) PX_DOT8(q0.y, h.h0.y, h.l0.y) PX_DOT8(q0.z, h.h0.z, h.l0.z) PX_DOT8(q0.w, h.h0.w, h.l0.w)
        PX_DOT8(q1.x, h.h1.x, h.l1.x) PX_DOT8(q1.y, h.h1.y, h.l1.y) PX_DOT8(q1.z, h.h1.z, h.l1.z) PX_DOT8(q1.w, h.h1.w, h.l1.w)
        sm[b] = 16 * ah + al; }
    const bool c1 = (dl & 2) != 0, c0 = (dl & 1) != 0;
    int w4[4], w2[2];
#pragma unroll
    for (int k = 0; k < 4; ++k) { const int keep = c1 ? sm[4 + k] : sm[k], send = c1 ? sm[k] : sm[4 + k]; w4[k] = keep + dpp_i<0x4E>(send); }
#pragma unroll
    for (int k = 0; k < 2; ++k) { const int keep = c0 ? w4[2 + k] : w4[k], send = c0 ? w4[k] : w4[2 + k]; w2[k] = keep + dpp_i<0xB1>(send); }
    prow[32 * dl + ps] = (float)w2[0] * hs; prow[32 * dl + 16 + ps] = (float)w2[1] * hs;
}
__device__ __forceinline__ void peer_down(Frame& F, const Ptrs& P, const PeerPlace& pp) {
    const unsigned char* H8 = P.ws + WS_H8; const unsigned char* HSb = P.ws + WS_HS; const unsigned char* IDXb = P.ws + WS_IDX; unsigned char* PARTb = P.ws + WS_PART;
    const int lane = lane_id(), dl = lane & 3, ps = lane >> 2;
    const int tstep = pp.nloc * NWAVES;
    for (int u = pp.vx; u < 8; u += pp.nx) {
        const int s = u & 3, tend = ((u >> 2) + 1) * (T_ / 2), t0 = (u >> 2) * (T_ / 2) + pp.rank * NWAVES + F.wave;
        if (t0 >= tend) continue;
        const unsigned char* tab = P.ws + WS_ED + (size_t)s * 16384 * 128;
        const unsigned hoff = (unsigned)(s * 256 + dl * 32), ioff = (unsigned)lane * 4u;
        v4u bufA[PX_D], bufB[PX_D];
#define PD_CLAMP(T) ((T) < tend ? (T) : t0)
#define PD_META(H, HSC, TT) do { const unsigned char* hp_ = H8 + ((unsigned)(TT) * 1024u + hoff); H.h0 = *(const v4u*)hp_; H.h1 = *(const v4u*)(hp_ + 16); H.l0 = *(const v4u*)(hp_ + 128); H.l1 = *(const v4u*)(hp_ + 144); \
        HSC = *(const float*)(HSb + ((unsigned)(TT) * 32u + (unsigned)s * 4u)); } while (0)
#define PD_IDX(LO, HI, TT) do { LO = *(const int*)(IDXb + ((unsigned)(TT) * 512u + ioff)); HI = *(const int*)(IDXb + ((unsigned)(TT) * 512u + 256u + ioff)); } while (0)
        int nidx_lo, nidx_hi; PD_IDX(nidx_lo, nidx_hi, t0);
        PX_ISSUE(bufA, nidx_lo, nidx_hi);
        PD_IDX(nidx_lo, nidx_hi, PD_CLAMP(t0 + tstep));
        H4 ha, hb; float sa, sb; PD_META(ha, sa, t0);
        for (int t = t0; t < tend; t += 2 * tstep) {
            { const int tn = PD_CLAMP(t + tstep);
              PX_ISSUE(bufB, nidx_lo, nidx_hi); PD_IDX(nidx_lo, nidx_hi, PD_CLAMP(tn + tstep)); PD_META(hb, sb, tn);
              __builtin_amdgcn_sched_barrier(0);
              peer_down_token(bufA, ha, sa, (float*)(PARTb + ((unsigned)(s * T_ + t) * 512u)), dl, ps);
              __builtin_amdgcn_sched_barrier(0); }
            if (t + tstep >= tend) break;
            { const int tc = t + tstep, tn = PD_CLAMP(tc + tstep);
              PX_ISSUE(bufA, nidx_lo, nidx_hi); PD_IDX(nidx_lo, nidx_hi, PD_CLAMP(tn + tstep)); PD_META(ha, sa, tn);
              __builtin_amdgcn_sched_barrier(0);
              peer_down_token(bufB, hb, sb, (float*)(PARTb + ((unsigned)(s * T_ + tc) * 512u)), dl, ps);
              __builtin_amdgcn_sched_barrier(0); }
        }
    }
}
__device__ __forceinline__ void peer_act(Frame& F, const Ptrs& P) {
    const int* IDX = (const int*)(P.ws + WS_IDX); float* GATE = (float*)(P.ws + WS_GATE); const float* PART = (const float*)(P.ws + WS_PART); const float* SSQ = (const float*)(P.ws + WS_SSQ);
    const float* SCD = (const float*)(P.ws + WS_SMALL); const float* SCU = SCD + 16384;
    const int lane = lane_id();
    for (int w = F.vcu * NWAVES + F.wave; w < T_ * 2; w += F.G * NWAVES) {
        const int t = w >> 1; const size_t pid = (size_t)w * 64 + lane;
        const float ssq = lane < 16 ? SSQ[(size_t)t * 16 + lane] : 0.f;
        const float rstd = rsqrtf(wave_sum(ssq) * (1.f / 1024.f) + EPS);
        float pre = 0.f;
#pragma unroll
        for (int s = 0; s < 4; ++s) pre += PART[(size_t)s * T_ * 128 + pid];
        const int id = IDX[pid];
        GATE[pid] = gelu_erf(pre * SCD[id] * rstd) * GATE[pid] * SCU[id];
    }
}
constexpr int PE_PD = 8;
#define PE_LOAD4(SLOT, IDV) SLOT = *(const v4u*)(EU + (((unsigned)(IDV) << 9) | l16))
#define PE_BP(ADDR, V) __builtin_amdgcn_ds_bpermute((ADDR), (V))
__device__ __forceinline__ void peer_up_tm(Frame& F, const Ptrs& P) {
    const bf16* HB = (const bf16*)(P.ws + WS_ST); const unsigned char* EU = P.ws + WS_EU;
    const int* IDX = (const int*)(P.ws + WS_IDX); const float* GATE = (const float*)(P.ws + WS_GATE); const float* PART = (const float*)(P.ws + WS_PART);
    const float* SCD = (const float*)(P.ws + WS_SMALL); const float* SCU = SCD + 16384;
    const int lane = lane_id(), l31 = lane & 31; const bool upper = lane >= 32;
    const unsigned l16 = (unsigned)l31 << 4;
    const int bp0 = upper ? 4 : 0;
    const int t0 = F.vcu * NWAVES + F.wave, tstep = F.G * NWAVES;
    if (t0 >= T_) return;
    int idx_lo = IDX[(size_t)t0 * 128 + lane], idx_hi = IDX[(size_t)t0 * 128 + 64 + lane];
    v4u hq[4];
#pragma unroll
    for (int k = 0; k < 4; ++k) hq[k] = ((const v4u*)(HB + (size_t)t0 * DM))[4 * l31 + k];
    float g_lo = GATE[(size_t)t0 * 128 + lane], g_hi = GATE[(size_t)t0 * 128 + 64 + lane];
    float pre_lo = 0.f, pre_hi = 0.f;
#pragma unroll
    for (int s = 0; s < 4; ++s) { pre_lo += PART[((size_t)s * T_ + t0) * 128 + lane]; pre_hi += PART[((size_t)s * T_ + t0) * 128 + 64 + lane]; }
    float sdu_lo = SCD[idx_lo], sdu_hi = SCD[idx_hi], su_lo = SCU[idx_lo], su_hi = SCU[idx_hi];
    v4u ra[PE_PD];
#pragma unroll
    for (int j = 0; j < PE_PD; ++j) { const int id = PE_BP(bp0 + 8 * j, idx_lo); PE_LOAD4(ra[j], id); }
    int id_nx = PE_BP(bp0 + 8 * PE_PD, idx_lo);
    for (int t = t0; t < T_; t += tstep) {
        const int tn = (t + tstep < T_) ? t + tstep : t;
        const int nidx_lo = IDX[(size_t)tn * 128 + lane], nidx_hi = IDX[(size_t)tn * 128 + 64 + lane];
        v4u nh[4];
#pragma unroll
        for (int k = 0; k < 4; ++k) nh[k] = ((const v4u*)(HB + (size_t)tn * DM))[4 * l31 + k];
        const float ng_lo = GATE[(size_t)tn * 128 + lane], ng_hi = GATE[(size_t)tn * 128 + 64 + lane];
        float npart_lo[4], npart_hi[4];
#pragma unroll
        for (int s = 0; s < 4; ++s) { npart_lo[s] = PART[((size_t)s * T_ + tn) * 128 + lane]; npart_hi[s] = PART[((size_t)s * T_ + tn) * 128 + 64 + lane]; }
        float ssq = 0.f;
#pragma unroll
        for (int k = 0; k < 4; ++k) { ssq = fmaf(bflo(hq[k].x), bflo(hq[k].x), ssq); ssq = fmaf(bfhi(hq[k].x), bfhi(hq[k].x), ssq); ssq = fmaf(bflo(hq[k].y), bflo(hq[k].y), ssq); ssq = fmaf(bfhi(hq[k].y), bfhi(hq[k].y), ssq);
            ssq = fmaf(bflo(hq[k].z), bflo(hq[k].z), ssq); ssq = fmaf(bfhi(hq[k].z), bfhi(hq[k].z), ssq); ssq = fmaf(bflo(hq[k].w), bflo(hq[k].w), ssq); ssq = fmaf(bfhi(hq[k].w), bfhi(hq[k].w), ssq); }
        ssq += swz_xor<1>(ssq); ssq += swz_xor<2>(ssq); ssq += swz_xor<4>(ssq); ssq += swz_xor<8>(ssq); ssq += swz_xor<16>(ssq);
        const float rstd = rsqrtf(ssq * (1.f / 1024.f) + EPS);
        const float act_lo = gelu_erf(pre_lo * sdu_lo * rstd) * g_lo * su_lo, act_hi = gelu_erf(pre_hi * sdu_hi * rstd) * g_hi * su_hi;
        f32x2v acc[16];
#pragma unroll
        for (int i = 0; i < 16; ++i) acc[i] = (f32x2v){0.f, 0.f};
        float a_cur = __int_as_float(PE_BP(bp0, __float_as_int(act_lo)));
#pragma unroll
        for (int q = 0; q < 64; ++q) {
            const int qa = q + 1, ql = q + PE_PD + 1;
            float a_nx = 0.f;
            if (qa < 64) a_nx = __int_as_float(PE_BP(bp0 + 8 * (qa & 31), __float_as_int(qa < 32 ? act_lo : act_hi)));
            int id_n2;
            if (ql < 64) id_n2 = PE_BP(bp0 + 8 * (ql & 31), ql < 32 ? idx_lo : idx_hi);
            else id_n2 = PE_BP(bp0 + 8 * ((ql - 64) & 31), nidx_lo);
            __builtin_amdgcn_sched_barrier(0);
            { const f32x2v av = {a_cur, a_cur}; const v4u r = ra[q % PE_PD];
#define PE_FMA4(W, O) acc[O] = __builtin_elementwise_fma(av, (f32x2v)__builtin_amdgcn_cvt_scalef32_pk_f32_fp4(W, 1.0f, 0), acc[O]); acc[O + 1] = __builtin_elementwise_fma(av, (f32x2v)__builtin_amdgcn_cvt_scalef32_pk_f32_fp4(W, 1.0f, 1), acc[O + 1]); \
              acc[O + 2] = __builtin_elementwise_fma(av, (f32x2v)__builtin_amdgcn_cvt_scalef32_pk_f32_fp4(W, 1.0f, 2), acc[O + 2]); acc[O + 3] = __builtin_elementwise_fma(av, (f32x2v)__builtin_amdgcn_cvt_scalef32_pk_f32_fp4(W, 1.0f, 3), acc[O + 3]);
              PE_FMA4(r.x, 0) PE_FMA4(r.y, 4) PE_FMA4(r.z, 8) PE_FMA4(r.w, 12) }
            asm volatile("" : "+v"(acc[0]), "+v"(acc[1]), "+v"(acc[2]), "+v"(acc[3]), "+v"(acc[4]), "+v"(acc[5]), "+v"(acc[6]), "+v"(acc[7]));
            asm volatile("" : "+v"(acc[8]), "+v"(acc[9]), "+v"(acc[10]), "+v"(acc[11]), "+v"(acc[12]), "+v"(acc[13]), "+v"(acc[14]), "+v"(acc[15]));
            PE_LOAD4(ra[q % PE_PD], id_nx);
            id_nx = id_n2; a_cur = a_nx;
            __builtin_amdgcn_sched_barrier(0);
        }
        { float a = 0.f, c = 0.f;
#pragma unroll
          for (int s = 0; s < 4; ++s) { a += npart_lo[s]; c += npart_hi[s]; }
          pre_lo = a; pre_hi = c; }
        sdu_lo = SCD[nidx_lo]; sdu_hi = SCD[nidx_hi]; su_lo = SCU[nidx_lo]; su_hi = SCU[nidx_hi];
        float y[32];
#pragma unroll
        for (int k = 0; k < 4; ++k) { y[8 * k] = bflo(hq[k].x); y[8 * k + 1] = bfhi(hq[k].x); y[8 * k + 2] = bflo(hq[k].y); y[8 * k + 3] = bfhi(hq[k].y); y[8 * k + 4] = bflo(hq[k].z); y[8 * k + 5] = bfhi(hq[k].z); y[8 * k + 6] = bflo(hq[k].w); y[8 * k + 7] = bfhi(hq[k].w); }
        float s2 = 0.f;
#pragma unroll
        for (int i = 0; i < 16; ++i) { y[2 * i] += sum_halves(acc[i][0]); y[2 * i + 1] += sum_halves(acc[i][1]); s2 = fmaf(y[2 * i], y[2 * i], s2); s2 = fmaf(y[2 * i + 1], y[2 * i + 1], s2); }
        s2 += swz_xor<1>(s2); s2 += swz_xor<2>(s2); s2 += swz_xor<4>(s2); s2 += swz_xor<8>(s2); s2 += swz_xor<16>(s2);
        const float r2 = rsqrtf(s2 * (1.f / 1024.f) + EPS);
        const float4* wf = (const float4*)(P.norm_final) + 8 * l31 + 4 * (lane >> 5); float4* o = (float4*)(P.out + (size_t)t * DM) + 8 * l31 + 4 * (lane >> 5);
#pragma unroll
        for (int k = 0; k < 4; ++k) { const float4 w = wf[k];
            const float e0 = upper ? y[16 + 4 * k] : y[4 * k], e1 = upper ? y[17 + 4 * k] : y[4 * k + 1], e2 = upper ? y[18 + 4 * k] : y[4 * k + 2], e3 = upper ? y[19 + 4 * k] : y[4 * k + 3];
            o[k] = make_float4(e0 * r2 * w.x, e1 * r2 * w.y, e2 * r2 * w.z, e3 * r2 * w.w); }
        idx_lo = nidx_lo; idx_hi = nidx_hi; g_lo = ng_lo; g_hi = ng_hi;
#pragma unroll
        for (int k = 0; k < 4; ++k) hq[k] = nh[k];
    }
}
constexpr int TK_LDK = 136, TK_K2 = 34816, TK_SCR = 69632, TK_SP = 49;
__device__ __forceinline__ int mono_key(float x) { const int b = __float_as_int(x); return b ^ ((b >> 31) & 0x7fffffff); }
__device__ __forceinline__ float unmono(int m) { return __int_as_float(m ^ ((m >> 31) & 0x7fffffff)); }
__device__ __forceinline__ int max3i(int a, int b, int c) { return max(max(a, b), c); }
#define CEX(A, I, J) do { const int hi_ = max(A[I], A[J]), lo_ = min(A[I], A[J]); A[I] = hi_; A[J] = lo_; } while (0)
template <int N, int OFF, int K, int J, int LEN> struct BitonicStep {
    static __device__ __forceinline__ void run(int (&a)[LEN]) {
#pragma unroll
        for (int i = 0; i < N; ++i) { const int l = i ^ J; if (l > i) { if ((i & K) == 0) CEX(a, OFF + i, OFF + l); else CEX(a, OFF + l, OFF + i); } }
        if constexpr (J > 1) BitonicStep<N, OFF, K, (J >> 1), LEN>::run(a);
        else if constexpr (K < N) BitonicStep<N, OFF, (K << 1), K, LEN>::run(a);
    }
};
template <int N, int OFF, int LEN> __device__ __forceinline__ void bitonic_sort_desc(int (&a)[LEN]) { BitonicStep<N, OFF, 2, 1, LEN>::run(a); }
template <int OFF, int LEN> __device__ __forceinline__ void bitonic_merge16_desc(int (&a)[LEN]) { BitonicStep<16, OFF, 16, 8, LEN>::run(a); }
template <int A, int B, int LEN> __device__ __forceinline__ void merge_top16(int (&a)[LEN]) {
#pragma unroll
    for (int i = 0; i < 16; ++i) a[A + i] = max(a[A + i], a[B + 15 - i]);
    bitonic_merge16_desc<A, LEN>(a);
}
template <int LEN> __device__ __forceinline__ void pair_top16(int (&a)[LEN]) {
    int lo[16], up[16];
#pragma unroll
    for (int i = 0; i < 16; ++i) { const auto rr = __builtin_amdgcn_permlane32_swap((unsigned)a[i], (unsigned)a[i], false, false); lo[i] = (int)rr[0]; up[i] = (int)rr[1]; }
#pragma unroll
    for (int i = 0; i < 16; ++i) a[i] = max(lo[i], up[15 - i]);
    bitonic_merge16_desc<0, LEN>(a);
}
__device__ __forceinline__ void topk_half(const bf16x8 (&qf)[8], const LAS bf16* Kh, int r, int hh, int (&key)[64]) {
#pragma unroll
    for (int nt = 0; nt < 4; ++nt) {
        f32x16 sc;
#pragma unroll
        for (int i = 0; i < 16; ++i) sc[i] = 0.f;
#pragma unroll
        for (int kk = 0; kk < 8; ++kk) { const bf16x8 a = *(const LAS bf16x8*)(Kh + (32 * nt + r) * TK_LDK + 16 * kk + 8 * hh); sc = MFMA32(a, qf[kk], sc); }
#pragma unroll
        for (int i = 0; i < 16; ++i) key[nt * 16 + i] = (mono_key(sc[i]) & ~127) | (127 - (32 * nt + crow(i, hh)));
    }
    bitonic_sort_desc<16, 0, 64>(key); bitonic_sort_desc<16, 16, 64>(key); bitonic_sort_desc<16, 32, 64>(key); bitonic_sort_desc<16, 48, 64>(key);
    merge_top16<0, 16, 64>(key); merge_top16<32, 48, 64>(key); merge_top16<0, 32, 64>(key);
    pair_top16<64>(key);
}
__device__ __forceinline__ void topk_finish(const LAS int* scr, int hh, float rstd, int* IDX, float* GATE, int t, int hd) {
    const LAS int* la = scr + hh * 16; const LAS int* lb = scr + (1 - hh) * 16;
    float va[4], vb[16];
#pragma unroll
    for (int i = 0; i < 4; ++i) va[i] = unmono(la[i] & ~127);
#pragma unroll
    for (int j = 0; j < 16; ++j) vb[j] = unmono(lb[j] & ~127);
    int ck[32];
    {
        int q = 0;
#pragma unroll
        for (int i = 0; i < 4; ++i)
#pragma unroll
            for (int j = i; j < 16; ++j) if ((i + 1) * (j + 1) <= 16) {
                const int pos = hh ? (j * 16 + i) : (i * 16 + j);
                int k = (mono_key(va[i] + vb[j]) & ~255) | (255 - pos);
                if (i == j && hh) k = (int)0x80000000;
                ck[q++] = k; }
#pragma unroll
        for (int i = 27; i < 32; ++i) ck[i] = (int)0x80000000;
    }
    bitonic_sort_desc<32, 0, 32>(ck);
    pair_top16<32>(ck);
    const float vmax = unmono(ck[0] & ~255) * rstd;
    float ev[8]; int id[8]; float esum = 0.f; const int hm = -hh;
#pragma unroll
    for (int q = 0; q < 8; ++q) { const int wk = ck[q] ^ ((ck[q] ^ ck[8 + q]) & hm); const int pos = 255 - (wk & 255);
        const int n1 = 127 - (scr[pos >> 4] & 127), n2 = 127 - (scr[16 + (pos & 15)] & 127);
        id[q] = n1 * 128 + n2;
        ev[q] = exp2f((unmono(wk & ~255) * rstd - vmax) * LOG2E); esum += ev[q]; }
    esum = sum_halves(esum);
    const float inv = 1.f / esum;
    int4* ip = (int4*)(IDX + ((size_t)t * 8 + hd) * 16 + hh * 8); float4* gp = (float4*)(GATE + ((size_t)t * 8 + hd) * 16 + hh * 8);
    ip[0] = make_int4(id[0], id[1], id[2], id[3]); ip[1] = make_int4(id[4], id[5], id[6], id[7]);
    gp[0] = make_float4(ev[0] * inv, ev[1] * inv, ev[2] * inv, ev[3] * inv); gp[1] = make_float4(ev[4] * inv, ev[5] * inv, ev[6] * inv, ev[7] * inv);
}
constexpr int TQ_QH = 69632, TQ_QP = 272;
struct OneUnit { pg8::StaticOrder S; int i;
    __device__ __forceinline__ bool next(int j, pg8::Unit& u) const { return j == 0 ? S.next(i, u) : false; }
    __device__ __forceinline__ void a_ready(const pg8::Unit&) const {}
    __device__ __forceinline__ void done(const pg8::Unit&) const {}
};
struct EpiQTopk {
    static constexpr bool PERM = true, AFTER_DRAIN = true;
    const float* sk1; const float* sk2; const float* SSQ; int* IDX; float* GATE;
    __device__ __forceinline__ void dump(const pg8::f32x4 (&acc)[2][2][4][2], int bj, LAS unsigned char* QH, int wr, int wc, int fr, int fq) const {
#pragma unroll
        for (int ai = 0; ai < 2; ++ai)
#pragma unroll
            for (int m = 0; m < 4; ++m) { const pg8::f32x4 v0 = bj ? acc[ai][1][m][0] : acc[ai][0][m][0], v1 = bj ? acc[ai][1][m][1] : acc[ai][0][m][1];
                v4u w; w.x = cvtpk(v0[0], v0[1]); w.y = cvtpk(v0[2], v0[3]); w.z = cvtpk(v1[0], v1[1]); w.w = cvtpk(v1[2], v1[3]);
                *(LAS v4u*)(QH + (128 * ai + 64 * wr + 16 * m + fr) * TQ_QP + (32 * wc + 8 * fq) * 2) = w; }
    }
    __device__ __forceinline__ void fused(const pg8::f32x4 (&acc)[2][2][4][2], const pg8::Unit& u, int wr, int wc, int fr, int fq, LAS unsigned char* L, int wid, int lane) const {
        LAS bf16* K1 = (LAS bf16*)L; LAS bf16* K2 = (LAS bf16*)(L + TK_K2); LAS unsigned char* QH = L + TQ_QH;
        const int tid_ = wid * 64 + lane, r = lane & 31, hh = lane >> 5;
        for (int i = tid_; i < 16384; i += 512) { const int n = i >> 7, k = i & 127; K1[n * TK_LDK + k] = (bf16)f2bf(sk1[i]); K2[n * TK_LDK + k] = (bf16)f2bf(sk2[i]); }
        dump(acc, 0, QH, wr, wc, fr, fq);
        __syncthreads();
        const int t = u.pm * 256 + 32 * wid + r;
        float rstd;
        { const float4* sp = (const float4*)(SSQ + (size_t)t * 16); const float4 a = sp[0], b = sp[1], c = sp[2], d = sp[3];
          rstd = rsqrtf(((a.x + a.y + a.z + a.w) + (b.x + b.y + b.z + b.w) + (c.x + c.y + c.z + c.w) + (d.x + d.y + d.z + d.w)) * (1.f / 1024.f) + EPS); }
        const LAS unsigned char* qrow = QH + (32 * wid + r) * TQ_QP + 16 * hh;
        int key[64], list0[16];
        { bf16x8 qf[8];
#pragma unroll
          for (int kk = 0; kk < 8; ++kk) qf[kk] = *(const LAS bf16x8*)(qrow + 32 * kk);
          topk_half(qf, K1, r, hh, key);
#pragma unroll
          for (int i = 0; i < 16; ++i) list0[i] = key[i]; }
        __syncthreads();
        dump(acc, 1, QH, wr, wc, fr, fq);
        __syncthreads();
        { bf16x8 qf[8];
#pragma unroll
          for (int kk = 0; kk < 8; ++kk) qf[kk] = *(const LAS bf16x8*)(qrow + 32 * kk);
          topk_half(qf, K2, r, hh, key); }
        LAS int* scr = (LAS int*)(QH + 32 * wid * TQ_QP) + r * TK_SP;
        LDS_WAIT();
        if (hh == 0) {
#pragma unroll
            for (int i = 0; i < 16; ++i) { scr[i] = list0[i]; scr[16 + i] = key[i]; } }
        topk_finish(scr, hh, rstd, IDX, GATE, t, u.pn);
        __syncthreads();
    }
};

constexpr int AT_KP = 72, AT_VP = 264;
constexpr int AT_K = 0, AT_VT = 36864, AT_BT = 36864 + 33792;
__device__ __forceinline__ void attn_phase(Frame& F, const Ptrs& P) {
    const bf16* PROJ = (const bf16*)(P.ws + WS_PROJ); bf16* CAT = (bf16*)(P.ws + WS_XN);
    LAS unsigned char* L = F.lds + RING_OFF;
    LAS bf16* Ks = (LAS bf16*)(L + AT_K); LAS bf16* Vt = (LAS bf16*)(L + AT_VT); LAS float* btab = (LAS float*)(L + AT_BT);
    const int lane = lane_id(), tid_ = F.wave * 64 + lane, r = lane & 31, hh = lane >> 5;
    for (int u = F.vcu; u < 256; u += F.G) {
        const int hkv = u & 1, n = (u >> 1) & 31, b = u >> 6;
        const int trow0 = b * SEQ + n * 128;
        for (int i = tid_; i < 2048; i += 512) {
            const int kj = i >> 3, ch = i & 7; const bool ok = (n > 0) || (kj >= 128);
            v4u kv = {0u, 0u, 0u, 0u}, vv = {0u, 0u, 0u, 0u};
            if (ok) { const bf16* rowp = PROJ + (size_t)(trow0 - 128 + kj) * NPROJ + hkv * 64 + ch * 8; kv = *(const v4u*)(rowp + PJ_K); vv = *(const v4u*)(rowp + PJ_V); }
            *(LAS v4u*)(Ks + kj * AT_KP + ch * 8) = kv;
            LAS bf16* vp = Vt + (ch * 8) * AT_VP + kj;
            vp[0] = (bf16)(vv.x & 0xffffu); vp[AT_VP] = (bf16)(vv.x >> 16); vp[2 * AT_VP] = (bf16)(vv.y & 0xffffu); vp[3 * AT_VP] = (bf16)(vv.y >> 16);
            vp[4 * AT_VP] = (bf16)(vv.z & 0xffffu); vp[5 * AT_VP] = (bf16)(vv.z >> 16); vp[6 * AT_VP] = (bf16)(vv.w & 0xffffu); vp[7 * AT_VP] = (bf16)(vv.w >> 16);
        }
        for (int i = tid_; i < 768; i += 512) { const int gg = i / 192, dist = i % 192 - 32;
            btab[i] = (dist >= 0 && dist < 128) ? P.rel_bias[c_bucket[dist & 127] * 8 + hkv * 4 + gg] * LOG2E : 0.f; }
        __syncthreads();
        const int g = F.wave & 3, h = hkv * 4 + g;
        const float sink2 = P.sinks[h] * LOG2E;
#pragma unroll 1
        for (int qq = 0; qq < 2; ++qq) {
            const int qt = (F.wave >> 2) * 2 + qq, t = trow0 + 32 * qt + r;
            bf16x8 qf[4];
#pragma unroll
            for (int kk = 0; kk < 4; ++kk) qf[kk] = *(const bf16x8*)(PROJ + (size_t)t * NPROJ + h * 64 + 16 * kk + 8 * hh);
            f32x16 sc[5];
#pragma unroll
            for (int j = 0; j < 5; ++j) {
#pragma unroll
                for (int i = 0; i < 16; ++i) sc[j][i] = 0.f;
#pragma unroll
                for (int kk = 0; kk < 4; ++kk) { const bf16x8 a = *(const LAS bf16x8*)(Ks + (32 * (qt + j) + r) * AT_KP + 16 * kk + 8 * hh); sc[j] = MFMA32(a, qf[kk], sc[j]); }
            }
            float m = sink2;
            const LAS float* bt = btab + g * 192 + 160 + r - 4 * hh;
#pragma unroll
            for (int j = 0; j < 5; ++j) {
                const bool tile_ok = (n > 0) || (qt + j >= 4);
#pragma unroll
                for (int i = 0; i < 16; ++i) { const int dist = 128 + r - (32 * j + crow(i, hh));
                    const bool ok = tile_ok && (j == 0 ? dist < 128 : (j == 4 ? dist >= 0 : true));
                    const float s = sc[j][i] * (0.125f * LOG2E) + bt[-(32 * j + (i & 3) + 8 * (i >> 2))];
                    sc[j][i] = ok ? s : -INFINITY; m = fmaxf(m, sc[j][i]); }
            }
            m = max_halves(m);
            float l = 0.f;
#pragma unroll
            for (int j = 0; j < 5; ++j)
#pragma unroll
                for (int i = 0; i < 16; ++i) { sc[j][i] = exp2f(sc[j][i] - m); l += sc[j][i]; }
            l = sum_halves(l);
            l += exp2f(sink2 - m);
            const float inv = 1.f / l;
            f32x16 o[2];
#pragma unroll
            for (int i = 0; i < 16; ++i) { o[0][i] = 0.f; o[1][i] = 0.f; }
#pragma unroll
            for (int j = 0; j < 5; ++j)
#pragma unroll
                for (int sg = 0; sg < 2; ++sg) {
                    const bf16x8 pf = pack8(sc[j], sg);
#pragma unroll
                    for (int dt = 0; dt < 2; ++dt) {
                        const LAS bf16* vb = Vt + (32 * dt + r) * AT_VP + 32 * (qt + j) + 16 * sg + 4 * hh;
                        const s16x4 lo = *(const LAS s16x4*)(vb), hi = *(const LAS s16x4*)(vb + 8);
                        o[dt] = MFMA32(__builtin_shufflevector(lo, hi, 0, 1, 2, 3, 4, 5, 6, 7), pf, o[dt]);
                    }
                }
            bf16* op = CAT + (size_t)t * DM + h * 64 + 4 * hh;
#pragma unroll
            for (int dt = 0; dt < 2; ++dt)
#pragma unroll
                for (int g4 = 0; g4 < 4; ++g4)
                    *(unsigned long long*)(op + 32 * dt + 8 * g4) = (unsigned long long)cvtpk(o[dt][4 * g4] * inv, o[dt][4 * g4 + 1] * inv) | ((unsigned long long)cvtpk(o[dt][4 * g4 + 2] * inv, o[dt][4 * g4 + 3] * inv) << 32);
        }
        __syncthreads();
    }
}
struct Args { Ptrs p; };
__global__ void __launch_bounds__(NWAVES * 64, 2) hymba_fwd(Args args) {
    extern __shared__ __attribute__((aligned(16))) unsigned char lds[];
    const Ptrs& P = args.p;
    Frame F;
    F.lds = (LAS unsigned char*)lds;
    F.MISC = (volatile LAS unsigned*)(F.lds + MISC_OFF);
    F.wave = __builtin_amdgcn_readfirstlane(threadIdx.x >> 6);
    F.G = gridDim.x; { const int bx = blockIdx.x; F.vcu = (F.G % 8 == 0) ? (bx % 8) * (F.G / 8) + bx / 8 : bx; }
    F.ctl = (gu32*)(P.ws + WS_CTL);
    for (int u = threadIdx.x; u < (LDS_BYTES - LDSCTL_OFF) / 4; u += NWAVES * 64) ((LAS unsigned*)(F.lds + LDSCTL_OFF))[u] = 0u;
    __syncthreads();
    XcdBarrier bar = xcd_barrier_post((unsigned*)(F.ctl + CW_BAR), F.MISC + 8);
#define GRID_BAR() xcd_barrier(bar)

    bf16* XN = (bf16*)(P.ws + WS_XN); bf16* PROJ = (bf16*)(P.ws + WS_PROJ); bf16* HB = (bf16*)(P.ws + WS_ST);
    p0_prologue(F, P);
    GRID_BAR();
    { pg8::Gemm g{XN, (const bf16*)(P.ws + WS_WIN), T_, NPROJ, DM, F.wave}; pg8::StaticOrder S; S.init(T_, NPROJ, F.G, (int)blockIdx.x);
      pg8::EpiBf16<0> E{PROJ, NPROJ, nullptr, 0, 0, 1.f};
      pg8::gemm_phase<pg8::EpiBf16<0>, pg8::StaticOrder, PG8_ALIGN, PG8_SP2>(F.lds + RING_OFF, g, S, E); }
    if (F.G == 256 && blockIdx.x >= 64) p1_slack(F, P, ((int)blockIdx.x - 64) * NWAVES + F.wave, 192 * NWAVES);
    else if (F.G != 256) p1_slack(F, P, F.vcu * NWAVES + F.wave, F.G * NWAVES);
    GRID_BAR();
    ssd_s1(F, P);
    xcd_arrive(bar, F.MISC + 14);
    attn_phase(F, P);
    xcd_wait(bar, F.MISC + 14);
    ssd_s2(F, P);
    GRID_BAR();
    ssd_s3(F, P);
    GRID_BAR();
    { pg8::Gemm g{XN, (const bf16*)(P.ws + WS_WOUT), T_, DM, DM, F.wave}; pg8::StaticOrder S; S.init(T_, DM, F.G, (int)blockIdx.x);
      EpiResH E{P.x, HB, (float*)(P.ws + WS_SSQ)};
      pg8::gemm_phase<EpiResH, pg8::StaticOrder, PG8_ALIGN, PG8_SP2>(F.lds + RING_OFF, g, S, E); }
    GRID_BAR();
    { pg8::Gemm g{HB, (const bf16*)(P.ws + WS_WQ), T_, 2048, DM, F.wave}; pg8::StaticOrder S; S.init(T_, 2048, F.G, (int)blockIdx.x);
      EpiQTopk E{P.sk1, P.sk2, (const float*)(P.ws + WS_SSQ), (int*)(P.ws + WS_IDX), (float*)(P.ws + WS_GATE)};
#pragma unroll 1
      for (int ui = 0; ui < 64; ++ui) { pg8::Unit u0; if (!S.next(ui, u0)) break;
          OneUnit S1{S, ui};
          pg8::gemm_phase<EpiQTopk, OneUnit, PG8_ALIGN, PG8_SP2>(F.lds + RING_OFF, g, S1, E); } }
    h_quant_rows(F, P);
    GRID_BAR();
    { const PeerPlace pp = peer_place(F);
      peer_down(F, P, pp); }
    GRID_BAR();
    peer_up_tm(F, P);
}

extern "C" void kernel_launch(void* const* d_in, const int* in_sizes, int n_in, void* d_out, int out_size, void* d_ws, size_t ws_size, hipStream_t stream) {
    static int grid = 0;
    if (grid == 0) {
        if (n_in != 19 || out_size != T_ * DM || ws_size < WS_END) { fprintf(stderr, "kernel_launch: unexpected shapes (n_in %d, out %d, ws %zu)\n", n_in, out_size, ws_size); grid = -1; return; }
        int dev = 0, cus = 0, per_cu = 0;
        if (hipGetDevice(&dev) != hipSuccess || hipDeviceGetAttribute(&cus, hipDeviceAttributeMultiprocessorCount, dev) != hipSuccess) { grid = -1; return; }
        if (hipFuncSetAttribute((const void*)hymba_fwd, hipFuncAttributeMaxDynamicSharedMemorySize, LDS_BYTES) != hipSuccess) { fprintf(stderr, "kernel_launch: hipFuncSetAttribute failed\n"); grid = -1; return; }
        if (hipOccupancyMaxActiveBlocksPerMultiprocessor(&per_cu, (const void*)hymba_fwd, NWAVES * 64, LDS_BYTES) != hipSuccess || per_cu < 1) { fprintf(stderr, "kernel_launch: occupancy query says %d blocks per CU\n", per_cu); grid = -1; (void)hipGetLastError(); return; }
        grid = cus;
    }
    if (grid < 0) return;
    (void)hipMemsetAsync((char*)d_ws + WS_CTL, 0, CTL_ZERO_BYTES, stream);
    Args a{};
    const float** pp = (const float**)&a.p;
    for (int i = 0; i < 19; ++i) pp[i] = (const float*)d_in[i];
    a.p.out = (float*)d_out; a.p.ws = (unsigned char*)d_ws;
    hipLaunchKernelGGL(hymba_fwd, dim3(grid), dim3(NWAVES * 64), LDS_BYTES, stream, a);
}
```

```cpp
#include <hip/hip_runtime.h>
#include <cstdio>
#include <cstdint>
#include <math.h>
namespace pg8 {
#define PG8_LAS __attribute__((address_space(3)))
typedef unsigned short bf16_t;
typedef short bf16x8 __attribute__((ext_vector_type(8)));
typedef float f32x4 __attribute__((ext_vector_type(4)));
typedef unsigned u32x4 __attribute__((ext_vector_type(4)));
constexpr int BM = 256, BK = 64, HALF = 128, HTB = HALF * BK * 2  , STAGE_BYTES = 8 * HTB, NXCD = 8, WGM = 8;

__host__ __device__ __forceinline__ int lds_byte(int r, int c) { const int st = (r >> 4) * 2 + (c >> 5), rr = r & 15, cc = c & 31, ob = rr * 64 + cc * 2; return st * 1024 + (ob ^ (((ob >> 9) & 1) << 5)); }
__host__ __device__ __forceinline__ void stage_rc(int b, int& R, int& C) { const int st = b / 1024, sb = b % 1024, swz = sb ^ (((sb >> 9) & 1) << 5); R = (st >> 1) * 16 + swz / 64; C = (st & 1) * 32 + (swz % 64) / 2; }
__host__ __device__ __forceinline__ int perm32(int rho) { const int n = rho >> 4, i = rho & 15; return 8 * (i >> 2) + 4 * n + (i & 3); }

struct Unit { int pm, pn; };
struct Gemm { const bf16_t* A; const bf16_t* Bt; int M, N, K, wave; };

struct StaticOrder {
    int nM, nN, nwg, G, c;
    __host__ __device__ void init(int M, int N, int G_, int c_) { nM = M / BM; nN = N / BM; nwg = nM * nN; G = G_; c = c_; }
    __host__ __device__ bool next(int i, Unit& u) const {
        const long L = (long)i * G + c; if (L >= nwg) return false;
        int wgid = (int)L; { const int q = nwg / NXCD, r = nwg % NXCD, xcd = wgid % NXCD, off = wgid / NXCD; wgid = (xcd < r ? xcd * (q + 1) : r * (q + 1) + (xcd - r) * q) + off; }
        const int nig = WGM * nN, gid = wgid / nig, fm = gid * WGM, gsz = (nM - fm) < WGM ? (nM - fm) : WGM;
        u.pm = fm + ((wgid % nig) % gsz); u.pn = (wgid % nig) / gsz; return true;
    }
    __device__ __forceinline__ void a_ready(const Unit&) const {}
    __device__ __forceinline__ void done(const Unit&) const {}
};

__device__ __forceinline__ unsigned cvt_pk_bf16(float lo, float hi) { unsigned r; asm volatile("v_cvt_pk_bf16_f32 %0, %1, %2" : "=v"(r) : "v"(lo), "v"(hi)); return r; }
typedef float f32x2 __attribute__((ext_vector_type(2)));
__device__ __forceinline__ f32x2 gelu_pk(f32x2 v) {
    const f32x2 av = __builtin_elementwise_abs(v), d = av * 0.2316418882f + 1.0f;
    f32x2 t; t.x = __builtin_amdgcn_rcpf(d.x); t.y = __builtin_amdgcn_rcpf(d.y);
    f32x2 q = t * 0.5307027145f + (-0.7265760135f); q = q * t + 0.7107068705f; q = q * t + (-0.142248368f); q = q * t + 0.127414796f; q = q * t;
    const f32x2 s = (v * v) * (-0.72134752044f);
    f32x2 e; e.x = __builtin_amdgcn_exp2f(s.x); e.y = __builtin_amdgcn_exp2f(s.y);
    const f32x2 m = v * (q * e), r = v - m;
    f32x2 o; o.x = v.x < 0.f ? m.x : r.x; o.y = v.y < 0.f ? m.y : r.y; return o;
}

template <int ACT  > struct EpiBf16 {
    static constexpr bool PERM = true, AFTER_DRAIN = false; static_assert(ACT == 0 || ACT == 1, "EpiBf16: ACT is 0 (none) or 1 (gelu_pk)");
    bf16_t* O; int ldc; const float* bias; int split_cols; size_t split_stride; float scale0;
    __device__ __forceinline__ void operator()(const f32x4 (&acc)[2][2][4][2], const Unit& u, int wr, int wc, int fr, int fq) const {
        const int row0 = u.pm * BM + wr * 64 + fr; int colt = u.pn * BM; bf16_t* base = O;
        float sc = 1.f; if (split_cols) { const int t = colt / split_cols; base += (size_t)t * split_stride; colt -= t * split_cols; if (t == 0) sc = scale0; }
        const int col0 = colt + wc * 32 + 8 * fq, bcol0 = u.pn * BM + wc * 32 + 8 * fq;
        f32x4 bv[2][2];
#pragma unroll
        for (int bj = 0; bj < 2; ++bj)
#pragma unroll
            for (int n = 0; n < 2; ++n) bv[bj][n] = bias ? *(const f32x4*)(bias + bcol0 + bj * HALF + 4 * n) : (f32x4){0.f, 0.f, 0.f, 0.f};
#pragma unroll
        for (int ai = 0; ai < 2; ++ai)
#pragma unroll
            for (int m = 0; m < 4; ++m) { bf16_t* rowp = base + (size_t)(row0 + ai * HALF + m * 16) * ldc + col0;
#pragma unroll
                for (int bj = 0; bj < 2; ++bj) { f32x4 v0 = acc[ai][bj][m][0] + bv[bj][0], v1 = acc[ai][bj][m][1] + bv[bj][1];
                    if (ACT == 1) { f32x2 a = gelu_pk((f32x2){v0[0], v0[1]}), b = gelu_pk((f32x2){v0[2], v0[3]}), c = gelu_pk((f32x2){v1[0], v1[1]}), d = gelu_pk((f32x2){v1[2], v1[3]});
                        v0 = (f32x4){a.x, a.y, b.x, b.y}; v1 = (f32x4){c.x, c.y, d.x, d.y}; }
                    v0 = v0 * sc; v1 = v1 * sc; u32x4 w; w.x = cvt_pk_bf16(v0[0], v0[1]); w.y = cvt_pk_bf16(v0[2], v0[3]); w.z = cvt_pk_bf16(v1[0], v1[1]); w.w = cvt_pk_bf16(v1[2], v1[3]);
                    *(u32x4*)(rowp + bj * HALF) = w; } }
    }
};
template <class Epi, class Sched, bool ALIGN_EPI = false, bool SP2 = false>
__device__ __forceinline__ void gemm_phase(PG8_LAS unsigned char* lds, const Gemm g, const Sched& S, const Epi& E) {
    int lane_l; asm volatile("v_mbcnt_lo_u32_b32 %0, -1, 0\n\tv_mbcnt_hi_u32_b32 %0, -1, %0" : "=v"(lane_l));
    const int wid = g.wave, lane = lane_l, tid = wid * 64 + lane,
              wr = wid >> 2, wc = wid & 3, fr = lane & 15, fq = lane >> 4;
    const int K = g.K, nt = K / BK;
    unsigned voffA[2], voffB[2];
#pragma unroll
    for (int i = 0; i < 2; ++i) { int R, C; stage_rc(tid * 16 + i * 8192, R, C); const int Rb = Epi::PERM ? ((R & ~31) + perm32(R & 31)) : R;
        voffA[i] = (unsigned)(R * K + C) * 2u; voffB[i] = (unsigned)(Rb * K + C) * 2u; }
    const size_t kstep = (size_t)(BK * 2);
    const size_t hstep = (size_t)HALF * K * 2;
    const size_t tstep = 2 * hstep;
    const unsigned ldsw = (unsigned)wid * 1024u;
    const int aoff = lds_byte(wr * 64 + fr, fq * 8), boff = lds_byte(wc * 32 + fr, fq * 8);
#define PG8_SA(b, h) (((b) * 2 + (h)) * HTB)
#define PG8_SB(b, h) ((4 + (b) * 2 + (h)) * HTB)
#define PG8_STAGE(bufoff, gbase, voff) do { _Pragma("unroll") for (int _i = 0; _i < 2; ++_i) \
        __builtin_amdgcn_global_load_lds((const unsigned*)((const char*)(gbase) + (voff)[_i]), (PG8_LAS unsigned*)(lds + (bufoff) + ldsw + _i * 8192), 16, 0, 0); } while (0)
#define PG8_LDA(dst, b, h) do { _Pragma("unroll") for (int m = 0; m < 4; ++m) _Pragma("unroll") for (int k = 0; k < 2; ++k) dst[m][k] = *(const PG8_LAS bf16x8*)(lds + PG8_SA(b, h) + aoff + m * 2048 + k * 1024); } while (0)
#define PG8_LDB(dst, b, h) do { _Pragma("unroll") for (int n = 0; n < 2; ++n) _Pragma("unroll") for (int k = 0; k < 2; ++k) dst[n][k] = *(const PG8_LAS bf16x8*)(lds + PG8_SB(b, h) + boff + n * 2048 + k * 1024); } while (0)
#define PG8_MMA(ai, bj, At, Bt) do { __builtin_amdgcn_s_setprio(1); _Pragma("unroll") for (int m = 0; m < 4; ++m) _Pragma("unroll") for (int n = 0; n < 2; ++n) _Pragma("unroll") for (int k = 0; k < 2; ++k) \
        acc[ai][bj][m][n] = __builtin_amdgcn_mfma_f32_16x16x32_bf16(Bt[n][k], At[m][k], acc[ai][bj][m][n], 0, 0, 0); __builtin_amdgcn_s_setprio(0); } while (0)
#define PG8_WAIT_V(n) asm volatile("s_waitcnt vmcnt(" #n ")" ::: "memory")
#define PG8_WAIT_L(n) asm volatile("s_waitcnt lgkmcnt(" #n ")" ::: "memory")
#define PG8_BAR __builtin_amdgcn_s_barrier()
#define PG8_SCHED __builtin_amdgcn_sched_barrier(0)
    Unit cur, nxt; int ui = 0;
    if (!S.next(0, cur)) return;
    f32x4 acc[2][2][4][2];
#pragma unroll
    for (int a = 0; a < 2; ++a)
#pragma unroll
        for (int b = 0; b < 2; ++b)
#pragma unroll
            for (int m = 0; m < 4; ++m)
#pragma unroll
                for (int n = 0; n < 2; ++n) acc[a][b][m][n] = (f32x4){0.f, 0.f, 0.f, 0.f};
    bf16x8 At[4][2], B0[2][2], B1[2][2];
    const char* cA = (const char*)g.A + (size_t)cur.pm * tstep; const char* cB = (const char*)g.Bt + (size_t)cur.pn * tstep;
    S.a_ready(cur);
    if constexpr (SP2) {
        PG8_STAGE(PG8_SB(0, 0), cB, voffB); PG8_STAGE(PG8_SB(0, 1), cB + hstep, voffB); PG8_STAGE(PG8_SA(0, 0), cA, voffA); PG8_STAGE(PG8_SA(0, 1), cA + hstep, voffA);
        if (wr == 1) PG8_BAR;
        PG8_WAIT_V(2); PG8_BAR;
        PG8_STAGE(PG8_SB(1, 0), cB + kstep, voffB); PG8_STAGE(PG8_SA(1, 0), cA + kstep, voffA); PG8_STAGE(PG8_SB(1, 1), cB + hstep + kstep, voffB);
        PG8_WAIT_V(6); PG8_BAR;
    } else {
        PG8_STAGE(PG8_SB(0, 0), cB, voffB); PG8_STAGE(PG8_SA(0, 0), cA, voffA); PG8_STAGE(PG8_SB(0, 1), cB + hstep, voffB); PG8_STAGE(PG8_SA(0, 1), cA + hstep, voffA);
        if (wr == 1) PG8_BAR;
        PG8_WAIT_V(4); PG8_BAR;
        PG8_STAGE(PG8_SB(1, 0), cB + kstep, voffB); PG8_STAGE(PG8_SA(1, 0), cA + kstep, voffA); PG8_STAGE(PG8_SB(1, 1), cB + hstep + kstep, voffB);
        PG8_WAIT_V(6); PG8_BAR;
    }
    for (;;) {
        const bool has_next = S.next(ui + 1, nxt);
        const char* nA = has_next ? (const char*)g.A + (size_t)nxt.pm * tstep : cA; const char* nB = has_next ? (const char*)g.Bt + (size_t)nxt.pn * tstep : cB;
        for (int t = 0; t < nt; t += 2) {
            const bool last = (t == nt - 2);
            const char* a1 = cA + (size_t)(t + 1) * kstep;
            const char* a2 = last ? nA : cA + (size_t)(t + 2) * kstep; const char* b2 = last ? nB : cB + (size_t)(t + 2) * kstep;
            const char* a3 = a2 + kstep; const char* b3 = b2 + kstep;
            if (last && has_next) S.a_ready(nxt);
            if constexpr (SP2) {
            PG8_LDB(B0, 0, 0); PG8_LDB(B1, 0, 1); PG8_SCHED; PG8_LDA(At, 0, 0); PG8_STAGE(PG8_SA(1, 1), a1 + hstep, voffA);
            PG8_WAIT_V(8); PG8_WAIT_L(0); PG8_BAR; PG8_MMA(0, 0, At, B0); PG8_MMA(0, 1, At, B1); PG8_BAR; PG8_SCHED;
            PG8_LDA(At, 0, 1); PG8_STAGE(PG8_SB(0, 0), b2, voffB); PG8_STAGE(PG8_SB(0, 1), b2 + hstep, voffB); PG8_STAGE(PG8_SA(0, 0), a2, voffA);
            PG8_WAIT_V(8); PG8_WAIT_L(0); PG8_BAR; PG8_MMA(1, 0, At, B0); PG8_MMA(1, 1, At, B1); PG8_BAR; PG8_SCHED;
            PG8_LDB(B0, 1, 0); PG8_LDB(B1, 1, 1); PG8_SCHED; PG8_LDA(At, 1, 0); PG8_STAGE(PG8_SA(0, 1), a2 + hstep, voffA);
            PG8_WAIT_V(8); PG8_WAIT_L(0); PG8_BAR; PG8_MMA(0, 0, At, B0); PG8_MMA(0, 1, At, B1); PG8_BAR; PG8_SCHED;
            PG8_LDA(At, 1, 1); PG8_STAGE(PG8_SB(1, 0), b3, voffB); PG8_STAGE(PG8_SB(1, 1), b3 + hstep, voffB); PG8_STAGE(PG8_SA(1, 0), a3, voffA);
            PG8_WAIT_V(8); PG8_WAIT_L(0); PG8_BAR; PG8_MMA(1, 0, At, B0); PG8_MMA(1, 1, At, B1); PG8_BAR; PG8_SCHED;
            } else {
            PG8_LDB(B0, 0, 0); PG8_SCHED; PG8_LDA(At, 0, 0); PG8_STAGE(PG8_SA(1, 1), a1 + hstep, voffA);
            PG8_WAIT_L(8); PG8_BAR; PG8_WAIT_L(0); PG8_MMA(0, 0, At, B0); PG8_BAR; PG8_SCHED;
            PG8_LDB(B1, 0, 1); PG8_STAGE(PG8_SB(0, 0), b2, voffB);
            PG8_BAR; PG8_WAIT_L(0); PG8_MMA(0, 1, At, B1); PG8_BAR;
            PG8_LDA(At, 0, 1); PG8_STAGE(PG8_SA(0, 0), a2, voffA);
            PG8_BAR; PG8_WAIT_L(0); PG8_MMA(1, 0, At, B0); PG8_BAR; PG8_SCHED;
            PG8_STAGE(PG8_SB(0, 1), b2 + hstep, voffB);
            PG8_WAIT_V(6); PG8_BAR; PG8_MMA(1, 1, At, B1); PG8_BAR;
            PG8_LDB(B0, 1, 0); PG8_SCHED; PG8_LDA(At, 1, 0); PG8_STAGE(PG8_SA(0, 1), a2 + hstep, voffA);
            PG8_WAIT_L(8); PG8_BAR; PG8_WAIT_L(0); PG8_MMA(0, 0, At, B0); PG8_BAR; PG8_SCHED;
            PG8_LDB(B1, 1, 1); PG8_STAGE(PG8_SB(1, 0), b3, voffB);
            PG8_BAR; PG8_WAIT_L(0); PG8_MMA(0, 1, At, B1); PG8_BAR;
            PG8_LDA(At, 1, 1); PG8_STAGE(PG8_SA(1, 0), a3, voffA);
            PG8_BAR; PG8_WAIT_L(0); PG8_MMA(1, 0, At, B0); PG8_BAR; PG8_SCHED;
            PG8_STAGE(PG8_SB(1, 1), b3 + hstep, voffB);
            PG8_WAIT_V(6); PG8_BAR; PG8_MMA(1, 1, At, B1); PG8_BAR;
            }
        }
        if constexpr (ALIGN_EPI) { if (wr == 0) PG8_BAR; }
        if constexpr (!Epi::AFTER_DRAIN) { E(acc, cur, wr, wc, fr, fq); S.done(cur); }
        if (!has_next) break;
#pragma unroll
        for (int a = 0; a < 2; ++a)
#pragma unroll
            for (int b = 0; b < 2; ++b)
#pragma unroll
                for (int m = 0; m < 4; ++m)
#pragma unroll
                    for (int n = 0; n < 2; ++n) acc[a][b][m][n] = (f32x4){0.f, 0.f, 0.f, 0.f};
        cur = nxt; cA = nA; cB = nB; ++ui;
        if constexpr (ALIGN_EPI) { if (wr == 1) PG8_BAR; }
    }
    PG8_WAIT_V(0);
    if constexpr (!ALIGN_EPI) { if (wr == 0) PG8_BAR; }
    PG8_BAR;
    if constexpr (Epi::AFTER_DRAIN) { E.fused(acc, cur, wr, wc, fr, fq, lds, wid, lane); S.done(cur); }
#undef PG8_SA
#undef PG8_SB
#undef PG8_STAGE
#undef PG8_LDA
#undef PG8_LDB
#undef PG8_MMA
#undef PG8_WAIT_V
#undef PG8_WAIT_L
#undef PG8_BAR
#undef PG8_SCHED
}
}

#ifndef PG8_SP2
#define PG8_SP2 true
#endif
#ifndef PG8_ALIGN
#define PG8_ALIGN true
#endif
#define GAS __attribute__((address_space(1)))
#define LAS __attribute__((address_space(3)))
typedef unsigned short bf16;
typedef unsigned v4u __attribute__((ext_vector_type(4)));
typedef float f32x4 __attribute__((ext_vector_type(4)));
typedef short bf16x8 __attribute__((ext_vector_type(8)));
typedef GAS unsigned gu32;
typedef GAS unsigned long long gu64;
#define RLX_AGENT __ATOMIC_RELAXED, __HIP_MEMORY_SCOPE_AGENT
#define LDS_WAIT() asm volatile("s_waitcnt lgkmcnt(0)" ::: "memory")
#define VM_WAIT() asm volatile("s_waitcnt vmcnt(0)" ::: "memory")
__device__ __forceinline__ unsigned long long rt() { return __builtin_amdgcn_s_memrealtime(); }
__device__ __forceinline__ unsigned f2bf(float f) { unsigned u = __builtin_bit_cast(unsigned, f); return (u + 0x7fffu + ((u >> 16) & 1u)) >> 16; }
__device__ __forceinline__ unsigned pk2(float lo, float hi) { return f2bf(lo) | (f2bf(hi) << 16); }

#define XB_TMO      128
#define XB_XCNT(j)  (256  + 64 * (j))
#define XB_XSUB(j)  (1280 + 64 * (j))
#define XB_XGEN(j)  (2304 + 64 * (j))
#define XB_TOP      3328
#define XB_TOPGEN   3392
#define XCD_BAR_WORDS 3456
#define XB_SPIN_CAP (1u << 22)

__device__ __forceinline__ unsigned xb_ld(unsigned* p)              { return __hip_atomic_load(p, __ATOMIC_RELAXED, __HIP_MEMORY_SCOPE_AGENT); }
__device__ __forceinline__ unsigned xb_add(unsigned* p, unsigned v) { return __hip_atomic_fetch_add(p, v, __ATOMIC_RELAXED, __HIP_MEMORY_SCOPE_AGENT); }
__device__ __forceinline__ unsigned xb_xcc_id() { return (unsigned)__builtin_amdgcn_s_getreg((3 << 11) | 20) & 0xFu; }
#define XB_SPIN(cond, bar) do { unsigned _sp = 0; while (cond) { __builtin_amdgcn_s_sleep(1); \
    if ((++_sp & 255u) == 0u) { if (xb_ld(&(bar)[XB_TMO])) break; if (_sp > XB_SPIN_CAP) { atomicAdd(&(bar)[XB_TMO], 1u); break; } } } } while (0)

struct XcdBarrier {
    unsigned* bar; unsigned x;
    volatile LAS unsigned* st;
};

__device__ __forceinline__ XcdBarrier xcd_barrier_post(unsigned* bar, volatile LAS unsigned* st) {
    XcdBarrier b; b.bar = bar; b.x = xb_xcc_id(); b.st = st;
    if (threadIdx.x == 0) (void)xb_add(&bar[XB_XCNT(b.x)], 1u);
    return b;
}
__device__ __forceinline__ void xcd_barrier_complete(unsigned* bar, unsigned x, unsigned& nloc, unsigned& nx) {
    const unsigned G = gridDim.x * gridDim.y * gridDim.z;
    unsigned sum, cnt, mine, sp = 0u;
    for (;;) {
        sum = 0u; cnt = 0u; mine = 0u;
#pragma unroll
        for (unsigned j = 0; j < 16; ++j) { const unsigned c = xb_ld(&bar[XB_XCNT(j)]); sum += c; cnt += (c > 0u) ? 1u : 0u; mine = (j == x) ? c : mine; }
        if (sum == G) break;
        __builtin_amdgcn_s_sleep(1);
        if ((++sp & 255u) == 0u) { if (xb_ld(&bar[XB_TMO])) break; if (sp > XB_SPIN_CAP) { atomicAdd(&bar[XB_TMO], 1u); break; } }
    }
    nloc = mine > 0u ? mine : 1u; nx = cnt > 0u ? cnt : 1u;
}

__device__ __forceinline__ void xcd_barrier(const XcdBarrier& b) {
    asm volatile("s_waitcnt vmcnt(0)" ::: "memory");
    __syncthreads();
    if (threadIdx.x == 0) {
        unsigned* bar = b.bar;
        __builtin_amdgcn_s_waitcnt(0);
        unsigned nloc = b.st[0], nx = b.st[1];
        if (nloc == 0u) { xcd_barrier_complete(bar, b.x, nloc, nx); b.st[0] = nloc; b.st[1] = nx; }
        const unsigned old = xb_add(&bar[XB_XSUB(b.x)], 1u);
        const unsigned gen = old / nloc;
        if (old + 1u == (gen + 1u) * nloc) {
            __builtin_amdgcn_fence(__ATOMIC_RELEASE, "agent");
            asm volatile("s_waitcnt vmcnt(0)" ::: "memory");
            const unsigned og = xb_add(&bar[XB_TOP], 1u);
            const unsigned tg = og / nx;
            if (og + 1u == (tg + 1u) * nx) xb_add(&bar[XB_TOPGEN], 1u);
            else XB_SPIN(xb_ld(&bar[XB_TOPGEN]) == tg, bar);
            __builtin_amdgcn_fence(__ATOMIC_ACQUIRE, "agent");
            xb_add(&bar[XB_XGEN(b.x)], 1u);
            asm volatile("s_waitcnt vmcnt(0)" ::: "memory");
        } else {
            XB_SPIN(xb_ld(&bar[XB_XGEN(b.x)]) == gen, bar);
            __builtin_amdgcn_fence(__ATOMIC_ACQUIRE, "agent");
            asm volatile("s_waitcnt vmcnt(0)" ::: "memory");
        }
    }
    __syncthreads();
}

__device__ __forceinline__ void xcd_arrive(const XcdBarrier& b, volatile LAS unsigned* sx) {
    asm volatile("s_waitcnt vmcnt(0)" ::: "memory");
    __syncthreads();
    if (threadIdx.x == 0) {
        unsigned* bar = b.bar;
        __builtin_amdgcn_s_waitcnt(0);
        unsigned nloc = b.st[0], nx = b.st[1];
        if (nloc == 0u) { xcd_barrier_complete(bar, b.x, nloc, nx); b.st[0] = nloc; b.st[1] = nx; }
        const unsigned old = xb_add(&bar[XB_XSUB(b.x)], 1u);
        const unsigned gen = old / nloc;
        unsigned leader = 0u, key = gen;
        if (old + 1u == (gen + 1u) * nloc) {
            leader = 1u;
            __builtin_amdgcn_fence(__ATOMIC_RELEASE, "agent");
            asm volatile("s_waitcnt vmcnt(0)" ::: "memory");
            const unsigned og = xb_add(&bar[XB_TOP], 1u);
            const unsigned tg = og / nx; key = tg;
            if (og + 1u == (tg + 1u) * nx) xb_add(&bar[XB_TOPGEN], 1u);
        }
        sx[0] = leader; sx[1] = key;
    }
}
__device__ __forceinline__ void xcd_wait(const XcdBarrier& b, volatile LAS unsigned* sx) {
    if (threadIdx.x == 0) {
        unsigned* bar = b.bar;
        const unsigned leader = sx[0], key = sx[1];
        if (leader) {
            XB_SPIN(xb_ld(&bar[XB_TOPGEN]) == key, bar);
            __builtin_amdgcn_fence(__ATOMIC_ACQUIRE, "agent");
            xb_add(&bar[XB_XGEN(b.x)], 1u);
            asm volatile("s_waitcnt vmcnt(0)" ::: "memory");
        } else {
            XB_SPIN(xb_ld(&bar[XB_XGEN(b.x)]) == key, bar);
            __builtin_amdgcn_fence(__ATOMIC_ACQUIRE, "agent");
            asm volatile("s_waitcnt vmcnt(0)" ::: "memory");
        }
    }
    __syncthreads();
}

constexpr int NWAVES = 8;
constexpr int T_ = 16384, SEQ = 4096, DM = 1024, NPROJ = 2304, INC = 2312;
constexpr int PJ_K = 512, PJ_V = 640, PJ_Z = 768, PJ_XBC = 1280;
constexpr float EPS = 1e-6f;
constexpr size_t MiB = 1u << 20;
constexpr size_t WS_CTL = 0, CTL_ZERO_BYTES = 1 * MiB;
constexpr size_t WS_KEYB = 1 * MiB + 256 * 1024;
constexpr size_t WS_SMALL = 1 * MiB;
constexpr size_t WS_WIN = 2 * MiB, WS_WOUT = 7 * MiB, WS_WQ = 9 * MiB;
constexpr size_t WS_ED = 13 * MiB, WS_EU = 29 * MiB;
constexpr size_t WS_XN = 77 * MiB;
constexpr size_t WS_PROJ = 109 * MiB;
constexpr size_t WS_ST = 181 * MiB;
constexpr size_t WS_IDX = 213 * MiB, WS_GATE = 221 * MiB, WS_SSQ = 229 * MiB, WS_END = 230 * MiB;
constexpr size_t DO_Y = 0, DO_DT = 41 * MiB;
constexpr size_t WS_CC = 230 * MiB, WS_DT = 238 * MiB, WS_EA = 239 * MiB, WS_CDEC = 240 * MiB, WS_PREV = WS_IDX;
constexpr size_t DO_YPF = 0, DO_YPLAIN = 32 * MiB;
constexpr size_t WS_PART = WS_PROJ;
constexpr size_t WS_H8 = WS_XN, WS_HS = WS_DT;
constexpr size_t WS_SSQ2 = WS_EA;
constexpr int CW_BAR = 4096, CW_RANK = 8192;
constexpr int RING_OFF = 0, RING_BYTES = 147456, LDSCTL_OFF = RING_BYTES, MISC_OFF = LDSCTL_OFF + 320, LDS_BYTES = 163840;

__constant__ unsigned char c_bucket[128] = {0, 1, 2, 3, 4, 5, 6, 7, 8, 9, 10, 11, 12, 13, 14, 15, 16, 16, 16, 17, 17, 18, 18, 18, 19, 19, 19, 20, 20, 20, 20, 21, 21, 21, 21, 22, 22, 22, 22, 22, 23, 23, 23, 23, 23, 23, 24, 24, 24, 24, 24, 24, 25, 25, 25, 25, 25, 25, 25, 26, 26, 26, 26, 26, 26, 26, 26, 27, 27, 27, 27, 27, 27, 27, 27, 27, 27, 28, 28, 28, 28, 28, 28, 28, 28, 28, 28, 29, 29, 29, 29, 29, 29, 29, 29, 29, 29, 29, 29, 30, 30, 30, 30, 30, 30, 30, 30, 30, 30, 30, 30, 30, 30, 31, 31, 31, 31, 31, 31, 31, 31, 31, 31, 31, 31, 31, 31, 31};

typedef float v16f __attribute__((ext_vector_type(16)));
typedef float v32f __attribute__((ext_vector_type(32)));
typedef unsigned v6u __attribute__((ext_vector_type(6)));
typedef _Float16 v32h __attribute__((ext_vector_type(32)));
struct Frame {
    LAS unsigned char* lds;
    volatile LAS unsigned* MISC;
    gu32* ctl;
    int wave, vcu, G;
};
__device__ __forceinline__ int lane_id() { int l; asm volatile("v_mbcnt_lo_u32_b32 %0, -1, 0\n\tv_mbcnt_hi_u32_b32 %0, -1, %0" : "=v"(l)); return l; }
__device__ __forceinline__ int opq(int x) { asm volatile("" : "+v"(x)); return x; }
template <int M> __device__ __forceinline__ float swz_xor(float v) { return __int_as_float(__builtin_amdgcn_ds_swizzle(__float_as_int(v), (M << 10) | 0x1F)); }
__device__ __forceinline__ float sum_halves(float v) { const auto r = __builtin_amdgcn_permlane32_swap(__float_as_uint(v), __float_as_uint(v), false, false); return __uint_as_float(r[0]) + __uint_as_float(r[1]); }
__device__ __forceinline__ float max_halves(float v) { const auto r = __builtin_amdgcn_permlane32_swap(__float_as_uint(v), __float_as_uint(v), false, false); return fmaxf(__uint_as_float(r[0]), __uint_as_float(r[1])); }
__device__ __forceinline__ int imax_halves(int v) { const auto r = __builtin_amdgcn_permlane32_swap((unsigned)v, (unsigned)v, false, false); return max((int)r[0], (int)r[1]); }
__device__ __forceinline__ float wave_sum(float v) {
    v += swz_xor<1>(v); v += swz_xor<2>(v); v += swz_xor<4>(v); v += swz_xor<8>(v); v += swz_xor<16>(v);
    return sum_halves(v);
}
__device__ __forceinline__ float bf2f(unsigned short b) { return __uint_as_float((unsigned)b << 16); }
__device__ __forceinline__ float bflo(unsigned w) { return __uint_as_float(w << 16); }
__device__ __forceinline__ float bfhi(unsigned w) { return __uint_as_float(w & 0xffff0000u); }
__device__ __forceinline__ float silu_f(float x) { return x / (1.f + __expf(-x)); }

__device__ __forceinline__ void p0_transpose_item(const float* W, int ldw, int K, int nblk, bf16* WT, const float* kscale, LAS float* scr, int item, int lane) {
    const int kb = item / nblk, nb = item % nblk, k0 = 64 * kb, n0 = 32 * nb;
    float ks_[32];
#pragma unroll
    for (int i = 0; i < 32; ++i) ks_[i] = kscale ? kscale[k0 + 2 * i + (lane >> 5)] : 1.f;
    float vv_[32];
#pragma unroll
    for (int i = 0; i < 32; ++i) vv_[i] = W[(size_t)(k0 + 2 * i + (lane >> 5)) * ldw + n0 + (lane & 31)];
#pragma unroll
    for (int i = 0; i < 32; ++i) scr[(2 * i + (lane >> 5)) * 33 + (lane & 31)] = vv_[i] * ks_[i];
#pragma unroll 1
    for (int i = 32; i < 32; ++i) { const int kk = 2 * i + (lane >> 5); float v = W[(size_t)(k0 + kk) * ldw + n0 + (lane & 31)]; if (kscale) v *= kscale[k0 + kk]; scr[kk * 33 + (lane & 31)] = v; }
    LDS_WAIT(); asm volatile("" ::: "memory");
    const int c = lane & 7;
#pragma unroll
    for (int j = 0; j < 4; ++j) { const int n = (lane >> 3) + 8 * j; const LAS float* s = scr + (8 * c) * 33 + n;
        v4u o; o.x = pk2(s[0 * 33], s[1 * 33]); o.y = pk2(s[2 * 33], s[3 * 33]); o.z = pk2(s[4 * 33], s[5 * 33]); o.w = pk2(s[6 * 33], s[7 * 33]);
        *(GAS v4u*)(WT + (size_t)(n0 + n) * K + k0 + 8 * c) = o; }
    LDS_WAIT(); asm volatile("" ::: "memory");
}
struct Ptrs {
    const float *x, *norm_mix, *w_in, *conv_w, *conv_b, *dt_bias, *a_log, *d_skip, *ssd_norm_w, *sinks, *w_out, *rel_bias, *norm_ffn, *w_query, *sk1, *sk2, *e_down, *e_up, *norm_final;
    float* out; unsigned char* ws;
};
constexpr int Q_SPLIT = 0;
__device__ __forceinline__ unsigned pack4_i8(float a, float b, float c, float d) {
    const int ia = __float2int_rn(a), ib = __float2int_rn(b), ic = __float2int_rn(c), id = __float2int_rn(d);
    return (unsigned)(ia & 0xff) | ((unsigned)(ib & 0xff) << 8) | ((unsigned)(ic & 0xff) << 16) | ((unsigned)(id & 0xff) << 24);
}
__device__ __forceinline__ unsigned pack8_i4(const float* v, float inv) {
    unsigned o = 0u;
#pragma unroll
    for (int i = 0; i < 8; ++i) { int q = __float2int_rn(v[i] * inv); q = q < -7 ? -7 : (q > 7 ? 7 : q); o |= ((unsigned)q & 15u) << (4 * i); }
    return o;
}
__device__ __forceinline__ void quant_fp8s(const Ptrs& P, int lane_, int r_lo, int r_hi, int w, int nw) {
    float* SC = (float*)(P.ws + WS_SMALL);
    int row = r_lo + w;
    if (row >= r_hi) return;
    float4 nx[4];
#pragma unroll
    for (int q = 0; q < 4; ++q) nx[q] = ((const float4*)(P.e_down + (size_t)(row & 16383) * DM) + 4 * lane_)[q];
    float4 w4[4];
#pragma unroll
    for (int q = 0; q < 4; ++q) w4[q] = ((const float4*)P.norm_ffn)[4 * lane_ + q];
    for (; row < r_hi; row += nw) {
        const int e = row & 16383;
        float v[16];
#pragma unroll
        for (int q = 0; q < 4; ++q) { const float4 t = nx[q]; v[4 * q] = t.x * w4[q].x; v[4 * q + 1] = t.y * w4[q].y; v[4 * q + 2] = t.z * w4[q].z; v[4 * q + 3] = t.w * w4[q].w; }
        { const int rn = (row + nw < r_hi) ? row + nw : row;
#pragma unroll
          for (int q = 0; q < 4; ++q) nx[q] = ((const float4*)(P.e_down + (size_t)(rn & 16383) * DM) + 4 * lane_)[q]; }
        float ss = 0.f;
#pragma unroll
        for (int q = 0; q < 16; ++q) ss = fmaf(v[q], v[q], ss);
        const float sc = fmaxf(2.5f * sqrtf(wave_sum(ss) * (1.f / 1024.f)) * (1.f / 7.f), 1e-30f);
        const float inv = 1.f / sc;
        const unsigned long long o = (unsigned long long)pack8_i4(v, inv) | ((unsigned long long)pack8_i4(v + 8, inv) << 32);
        *(unsigned long long*)(P.ws + WS_ED + ((size_t)(lane_ >> 4) * 16384 + e) * 128 + (lane_ & 15) * 8) = o;
        if (lane_ == 0) SC[row] = sc;
    }
}
typedef float f32x2q __attribute__((ext_vector_type(2)));
__device__ __forceinline__ void quant_fp6u(const Ptrs& P, int lane_, int q_lo, int q_hi, int w, int nw) {
    float* SC = (float*)(P.ws + WS_SMALL);
    int e = 2 * q_lo + w; const int e_hi = 2 * q_hi;
    if (e >= e_hi) return;
    float4 nx[4];
#pragma unroll
    for (int k = 0; k < 4; ++k) nx[k] = ((const float4*)(P.e_up + (size_t)e * DM) + 4 * lane_)[k];
    for (; e < e_hi; e += nw) {
        float v[16];
#pragma unroll
        for (int k = 0; k < 4; ++k) { const float4 t = nx[k]; v[4 * k] = t.x; v[4 * k + 1] = t.y; v[4 * k + 2] = t.z; v[4 * k + 3] = t.w; }
        { const int en = (e + nw < e_hi) ? e + nw : e;
#pragma unroll
          for (int k = 0; k < 4; ++k) nx[k] = ((const float4*)(P.e_up + (size_t)en * DM) + 4 * lane_)[k]; }
        float am = 0.f;
#pragma unroll
        for (int k = 0; k < 16; ++k) am = fmaxf(am, fabsf(v[k]));
        am = fmaxf(am, swz_xor<1>(am)); am = fmaxf(am, swz_xor<2>(am)); am = fmaxf(am, swz_xor<4>(am)); am = fmaxf(am, swz_xor<8>(am)); am = fmaxf(am, swz_xor<16>(am)); am = max_halves(am);
        am = fmaxf(am, 1e-30f);
        const float inv = 6.0f / am;
        unsigned pk[2];
#pragma unroll
        for (int wd = 0; wd < 2; ++wd) { unsigned p4 = 0u;
            p4 = __builtin_amdgcn_cvt_scalef32_pk_fp4_f32(p4, v[8 * wd] * inv, v[8 * wd + 1] * inv, 1.0f, 0);
            p4 = __builtin_amdgcn_cvt_scalef32_pk_fp4_f32(p4, v[8 * wd + 2] * inv, v[8 * wd + 3] * inv, 1.0f, 1);
            p4 = __builtin_amdgcn_cvt_scalef32_pk_fp4_f32(p4, v[8 * wd + 4] * inv, v[8 * wd + 5] * inv, 1.0f, 2);
            p4 = __builtin_amdgcn_cvt_scalef32_pk_fp4_f32(p4, v[8 * wd + 6] * inv, v[8 * wd + 7] * inv, 1.0f, 3);
            pk[wd] = p4; }
        *(unsigned long long*)(P.ws + WS_EU + (size_t)e * 512 + 8 * lane_) = (unsigned long long)pk[0] | ((unsigned long long)pk[1] << 32);
        if (lane_ == 0) SC[16384 + e] = am * (1.f / 6.0f);
    }
}
__device__ __forceinline__ void p0_prologue(Frame& F0, const Ptrs& P) {
    const Frame& F = F0; const int lane_ = lane_id(), tid_ = F.wave * 64 + lane_;
    LAS float* scr = (LAS float*)(F.lds + RING_OFF + F.wave * 16384);
    const int gw = F.vcu * NWAVES + F.wave, NGW = F.G * NWAVES;
    bf16* Win_t = (bf16*)(P.ws + WS_WIN); bf16* Wout_t = (bf16*)(P.ws + WS_WOUT); bf16* Wq_t = (bf16*)(P.ws + WS_WQ);
    constexpr int I_IN = 16 * 72;
    for (int it = gw; it < I_IN; it += NGW) p0_transpose_item(P.w_in, INC, DM, 72, Win_t, nullptr, scr, it, lane_);
    (void)Wout_t; (void)Wq_t;
    __syncthreads();
    { LAS float* Wdt = (LAS float*)(F.lds + RING_OFF);
      { float wd_[16];
#pragma unroll
        for (int q = 0; q < 16; ++q) { const int i = tid_ + 512 * q; wd_[q] = P.w_in[(size_t)(i >> 3) * INC + NPROJ + (i & 7)]; }
#pragma unroll
        for (int q = 0; q < 16; ++q) Wdt[tid_ + 512 * q] = wd_[q]; }
      __syncthreads();
      bf16* XN = (bf16*)(P.ws + WS_XN); float* DT = (float*)(P.ws + WS_DT);
      float4 nmw[4];
#pragma unroll
      for (int j = 0; j < 4; ++j) nmw[j] = ((const float4*)P.norm_mix)[j * 64 + lane_];
      float4 xnx[2][4];
      if (gw * 2 < T_) {
#pragma unroll
        for (int rr = 0; rr < 2; ++rr)
#pragma unroll
            for (int j = 0; j < 4; ++j) xnx[rr][j] = ((const float4*)(P.x + (size_t)(gw * 2 + rr) * DM))[j * 64 + lane_]; }
      for (int m0 = gw * 2; m0 < T_; m0 += NGW * 2) {
        float4 xv[2][4];
#pragma unroll
        for (int rr = 0; rr < 2; ++rr)
#pragma unroll
            for (int j = 0; j < 4; ++j) xv[rr][j] = xnx[rr][j];
        { const int mn = (m0 + NGW * 2 < T_) ? m0 + NGW * 2 : m0;
#pragma unroll
          for (int rr = 0; rr < 2; ++rr)
#pragma unroll
              for (int j = 0; j < 4; ++j) xnx[rr][j] = ((const float4*)(P.x + (size_t)(mn + rr) * DM))[j * 64 + lane_]; }
#pragma unroll
        for (int rr = 0; rr < 2; ++rr) { const int m = m0 + rr;
        float4 v[4]; float s = 0.f;
#pragma unroll
        for (int j = 0; j < 4; ++j) { v[j] = xv[rr][j]; s += v[j].x * v[j].x + v[j].y * v[j].y + v[j].z * v[j].z + v[j].w * v[j].w; }
        const float r = rsqrtf(wave_sum(s) * (1.f / 1024.f) + EPS);
        float d8[8];
#pragma unroll
        for (int q = 0; q < 8; ++q) d8[q] = 0.f;
        unsigned long long* o8 = (unsigned long long*)(XN + (size_t)m * DM);
#pragma unroll
        for (int j = 0; j < 4; ++j) { const float4 w = nmw[j];
            const float e0 = v[j].x * r * w.x, e1 = v[j].y * r * w.y, e2 = v[j].z * r * w.z, e3 = v[j].w * r * w.w;
            o8[j * 64 + lane_] = (unsigned long long)pk2(e0, e1) | ((unsigned long long)pk2(e2, e3) << 32);
            const float ev[4] = {e0, e1, e2, e3};
#pragma unroll
            for (int e = 0; e < 4; ++e) { const LAS f32x4* wr = (const LAS f32x4*)(Wdt + (size_t)(j * 256 + lane_ * 4 + e) * 8); const f32x4 w0 = wr[0], w1 = wr[1];
                d8[0] += ev[e] * w0.x; d8[1] += ev[e] * w0.y; d8[2] += ev[e] * w0.z; d8[3] += ev[e] * w0.w; d8[4] += ev[e] * w1.x; d8[5] += ev[e] * w1.y; d8[6] += ev[e] * w1.z; d8[7] += ev[e] * w1.w; } }
#pragma unroll
        for (int q = 0; q < 8; ++q) d8[q] = wave_sum(d8[q]);
        if (lane_ == 0) { float4* dp = (float4*)(DT + (size_t)m * 8); dp[0] = make_float4(d8[0], d8[1], d8[2], d8[3]); dp[1] = make_float4(d8[4], d8[5], d8[6], d8[7]); }
        }
      }
      __syncthreads(); }
}

__device__ __forceinline__ void p1_slack(Frame& F0, const Ptrs& P, int w, int nw) {
    const Frame& F = F0; const int lane_ = lane_id();
    LAS float* scr = (LAS float*)(F.lds + RING_OFF + F.wave * 16384);
    bf16* Wout_t = (bf16*)(P.ws + WS_WOUT); bf16* Wq_t = (bf16*)(P.ws + WS_WQ);
    constexpr int I_OUT = 16 * 32, I_Q = 16 * 64;
    for (int it = w; it < I_OUT + I_Q; it += nw) {
        if (it < I_OUT) p0_transpose_item(P.w_out, DM, DM, 32, Wout_t, nullptr, scr, it, lane_);
        else p0_transpose_item(P.w_query, 2048, DM, 64, Wq_t, P.norm_ffn, scr, it - I_OUT, lane_);
    }
    { unsigned long long* KB = (unsigned long long*)(P.ws + WS_KEYB);
      for (int i = w * 64 + lane_; i < 8192; i += nw * 64) { const float4 t = (i < 4096) ? ((const float4*)P.sk1)[i] : ((const float4*)P.sk2)[i - 4096];
          KB[i] = (unsigned long long)pk2(t.x, t.y) | ((unsigned long long)pk2(t.z, t.w) << 32); } }
    quant_fp6u(P, lane_, 0, 8192, w, nw);
    quant_fp8s(P, lane_, 0, 16384, w, nw);
}
struct EpiResH {
    static constexpr bool PERM = false, AFTER_DRAIN = false;
    const float* X; bf16* HB; float* SSQ;
    __device__ __forceinline__ void operator()(const pg8::f32x4 (&acc)[2][2][4][2], const pg8::Unit& u, int wr, int wc, int fr, int fq) const {
        const int row0 = u.pm * 256 + wr * 64 + fr, col0 = u.pn * 256 + wc * 32 + 4 * fq;
#pragma unroll
        for (int ai = 0; ai < 2; ++ai)
#pragma unroll
            for (int m = 0; m < 4; ++m) { const int row = row0 + ai * 128 + m * 16; float ss = 0.f;
#pragma unroll
                for (int bj = 0; bj < 2; ++bj)
#pragma unroll
                    for (int n = 0; n < 2; ++n) { const size_t off = (size_t)row * DM + col0 + bj * 128 + n * 16;
                        const pg8::f32x4 h = acc[ai][bj][m][n] + *(const pg8::f32x4*)(X + off);
                        ss += h[0] * h[0] + h[1] * h[1] + h[2] * h[2] + h[3] * h[3];
                        *(unsigned long long*)(HB + off) = (unsigned long long)pk2(h[0], h[1]) | ((unsigned long long)pk2(h[2], h[3]) << 32); }
                ss += swz_xor<16>(ss); ss = sum_halves(ss);
                if (fq == 0) SSQ[(size_t)row * 16 + u.pn * 4 + wc] = ss; }
    }
};

typedef float f32x16 __attribute__((ext_vector_type(16)));
typedef short s16x4 __attribute__((ext_vector_type(4)));
typedef float f32x2_t __attribute__((ext_vector_type(2)));
typedef __bf16 bf16x2_t __attribute__((ext_vector_type(2)));
#define MFMA32(a, b, c) __builtin_amdgcn_mfma_f32_32x32x16_bf16((a), (b), (c), 0, 0, 0)
__device__ __forceinline__ int crow(int reg, int h) { return (reg & 3) + 8 * (reg >> 2) + 4 * h; }
__device__ __forceinline__ unsigned cvtpk(float lo, float hi) { f32x2_t v = {lo, hi}; bf16x2_t b = __builtin_convertvector(v, bf16x2_t); return __builtin_bit_cast(unsigned, b); }
__device__ __forceinline__ bf16x8 pack8(const f32x16& x, int s) {
    v4u p; p.x = cvtpk(x[8 * s], x[8 * s + 1]); p.y = cvtpk(x[8 * s + 2], x[8 * s + 3]); p.z = cvtpk(x[8 * s + 4], x[8 * s + 5]); p.w = cvtpk(x[8 * s + 6], x[8 * s + 7]);
    return __builtin_bit_cast(bf16x8, p);
}
constexpr float LOG2E = 1.4426950408889634f;
constexpr int LDP = 136;
constexpr int S1_XT = 0, S1_XTW = 17408, S1_BSN = 34816, S1_CLN = 69632, S1_BNL = 104448, S1_F32 = 139264;

__device__ __forceinline__ float silu_fast(float x) { return x * __builtin_amdgcn_rcpf(1.f + __builtin_amdgcn_exp2f(-x * LOG2E)); }
__device__ __forceinline__ int swz_t(int row, int l) { return row * LDP + ((((l >> 3) ^ (row >> 3)) & 7) | ((l >> 3) & 8)) * 8 + (l & 7); }
#define S1_CONV8(A_, IT_) do { _Pragma("unroll") for (int e_ = 0; e_ < 8; ++e_) A_[e_] = bias[e_]; \
        _Pragma("unroll") for (int j_ = 0; j_ < 4; ++j_) { const v4u rw_ = raw[(IT_) + j_]; \
            A_[0] += w[j_][0] * bflo(rw_.x); A_[1] += w[j_][1] * bfhi(rw_.x); A_[2] += w[j_][2] * bflo(rw_.y); A_[3] += w[j_][3] * bfhi(rw_.y); \
            A_[4] += w[j_][4] * bflo(rw_.z); A_[5] += w[j_][5] * bfhi(rw_.z); A_[6] += w[j_][6] * bflo(rw_.w); A_[7] += w[j_][7] * bfhi(rw_.w); } \
        _Pragma("unroll") for (int e_ = 0; e_ < 8; ++e_) A_[e_] = silu_fast(A_[e_]); } while (0)
#define S1_LOADW(CHB_) do { _Pragma("unroll") for (int j_ = 0; j_ < 4; ++j_) { const float4 w0_ = *(const float4*)(P.conv_w + j_ * 1024 + (CHB_)), w1_ = *(const float4*)(P.conv_w + j_ * 1024 + (CHB_) + 4); \
            w[j_][0] = w0_.x; w[j_][1] = w0_.y; w[j_][2] = w0_.z; w[j_][3] = w0_.w; w[j_][4] = w1_.x; w[j_][5] = w1_.y; w[j_][6] = w1_.z; w[j_][7] = w1_.w; } \
        { const float4 b0_ = *(const float4*)(P.conv_b + (CHB_)), b1_ = *(const float4*)(P.conv_b + (CHB_) + 4); \
          bias[0] = b0_.x; bias[1] = b0_.y; bias[2] = b0_.z; bias[3] = b0_.w; bias[4] = b1_.x; bias[5] = b1_.y; bias[6] = b1_.z; bias[7] = b1_.w; } } while (0)
__device__ __forceinline__ void ssd_s1(Frame& F, const Ptrs& P) {
    const bf16* PROJ = (const bf16*)(P.ws + WS_PROJ); const float* DT = (const float*)(P.ws + WS_DT);
    float* EA = (float*)(P.ws + WS_EA); float* CDEC = (float*)(P.ws + WS_CDEC); bf16* CC = (bf16*)(P.ws + WS_CC);
    unsigned* ST = (unsigned*)(P.ws + WS_ST); unsigned* YPF = (unsigned*)((char*)P.out + DO_YPF);
    LAS unsigned char* L = F.lds + RING_OFF;
    LAS bf16* Xt = (LAS bf16*)(L + S1_XT); LAS bf16* Xtw = (LAS bf16*)(L + S1_XTW); LAS bf16* Bsn = (LAS bf16*)(L + S1_BSN); LAS bf16* Cln = (LAS bf16*)(L + S1_CLN); LAS bf16* Bnl = (LAS bf16*)(L + S1_BNL);
    LAS float* f32base = (LAS float*)(L + S1_F32);
    const int lane = lane_id(); const int tid_ = F.wave * 64 + lane;
    for (int ug = F.vcu; ug < 256; ug += F.G) {
        const int grp = ug & 1, c = (ug >> 1) & 31, b = ug >> 6, t0 = b * SEQ + c * 128;
        __syncthreads();
        if (F.wave < 4) {
            const int h = 4 * grp + F.wave, us = (b * 32 + c) * 8 + h;
            const float A = -__expf(P.a_log[h]), dtb = P.dt_bias[h];
            const int ln = opq(lane_id());
            LAS float* acum2 = f32base + F.wave * 384; LAS float* wv = acum2 + 128; LAS float* wend = wv + 128;
            const float x0 = DT[(size_t)(t0 + 2 * ln) * 8 + h] + dtb, x1 = DT[(size_t)(t0 + 2 * ln + 1) * 8 + h] + dtb;
            const float dt0 = fmaxf(x0, 0.f) + log1pf(__expf(-fabsf(x0))), dt1 = fmaxf(x1, 0.f) + log1pf(__expf(-fabsf(x1)));
            const float a0 = dt0 * A, a1 = dt1 * A;
            float s = a0 + a1;
#pragma unroll
            for (int o = 1; o < 64; o <<= 1) { const float v = __int_as_float(__builtin_amdgcn_ds_bpermute((ln - o) * 4, __float_as_int(s))); if (ln >= o) s += v; }
            const float ac1 = s, ac0 = s - a1, tot = __uint_as_float(__builtin_amdgcn_readlane(__float_as_uint(s), 63));
            acum2[2 * ln] = ac0 * LOG2E; acum2[2 * ln + 1] = ac1 * LOG2E;
            wv[2 * ln] = log2f(dt0) - ac0 * LOG2E; wv[2 * ln + 1] = log2f(dt1) - ac1 * LOG2E;
            wend[2 * ln] = dt0 * exp2f((tot - ac0) * LOG2E); wend[2 * ln + 1] = dt1 * exp2f((tot - ac1) * LOG2E);
            EA[(size_t)(t0 + 2 * ln) * 8 + h] = exp2f(ac0 * LOG2E); EA[(size_t)(t0 + 2 * ln + 1) * 8 + h] = exp2f(ac1 * LOG2E);
            if (ln == 0) CDEC[us] = exp2f(tot * LOG2E);
        }
        { const int tidc = opq(tid_);
          if (tidc < 440) {
            const int cg = tidc % 40, sg = tidc / 40, l0 = 12 * sg, h0 = 4 * grp;
            int chb; if (cg < 8) chb = h0 * 64 + cg * 8; else if (cg < 24) chb = 512 + grp * 128 + (cg - 8) * 8; else chb = 768 + grp * 128 + (cg - 24) * 8;
            v4u raw[15];
#pragma unroll
            for (int q = 0; q < 15; ++q) { const int ss = c * 128 + l0 - 3 + q; raw[q] = (v4u){0u, 0u, 0u, 0u};
                if (ss >= 0 && l0 - 3 + q < 128) raw[q] = *(const v4u*)(PROJ + (size_t)(b * SEQ + ss) * NPROJ + PJ_XBC + chb); }
            float w[4][8], bias[8]; S1_LOADW(chb);
#pragma unroll
            for (int it = 0; it < 12; it += 2) {
                const int l = l0 + it;
                if (l < 128) {
                    float a[8], a2[8]; S1_CONV8(a, it); S1_CONV8(a2, it + 1);
                    if (cg < 8) {
#pragma unroll
                        for (int e = 0; e < 8; ++e) *(LAS unsigned*)(Xt + swz_t(cg * 8 + e, l)) = cvtpk(a[e], a2[e]);
                    } else {
                        v4u o, o2; o.x = cvtpk(a[0], a[1]); o.y = cvtpk(a[2], a[3]); o.z = cvtpk(a[4], a[5]); o.w = cvtpk(a[6], a[7]);
                        o2.x = cvtpk(a2[0], a2[1]); o2.y = cvtpk(a2[2], a2[3]); o2.z = cvtpk(a2[4], a2[5]); o2.w = cvtpk(a2[6], a2[7]);
                        if (cg < 24) { const int n0 = (cg - 8) * 8; *(LAS v4u*)(Bsn + l * LDP + n0) = o; *(LAS v4u*)(Bsn + (l + 1) * LDP + n0) = o2;
#pragma unroll
                            for (int e = 0; e < 8; ++e) *(LAS unsigned*)(Bnl + swz_t(n0 + e, l)) = cvtpk(a[e], a2[e]);
                        } else { const int n0 = (cg - 24) * 8; *(LAS v4u*)(Cln + l * LDP + n0) = o; *(LAS v4u*)(Cln + (l + 1) * LDP + n0) = o2;
                            *(v4u*)(CC + (size_t)(t0 + l) * 256 + grp * 128 + n0) = o; *(v4u*)(CC + (size_t)(t0 + l + 1) * 256 + grp * 128 + n0) = o2; }
                    }
                }
            }
          } }
        __syncthreads();
#pragma unroll 1
        for (int hi = 0; hi < 4; ++hi) {
            const int h = 4 * grp + hi, u = (b * 32 + c) * 8 + h;
            const float Dh = P.d_skip[h];
            const LAS float* acum2 = f32base + hi * 384; const LAS float* wv = acum2 + 128; const LAS float* wend = wv + 128;
            const LAS bf16* Xc = (hi & 1) ? Xtw : Xt; LAS bf16* Xn = (hi & 1) ? Xt : Xtw;
            const int tidc = opq(tid_);
            const int cgn = tidc & 7, ln_ = 2 * (tidc >> 3), chn = (h + 1) * 64 + cgn * 8;
            v4u raw[5];
#pragma unroll
            for (int q = 0; q < 5; ++q) { const int ss = c * 128 + ln_ - 3 + q; raw[q] = (v4u){0u, 0u, 0u, 0u};
                if (hi < 3 && ss >= 0) raw[q] = *(const v4u*)(PROJ + (size_t)(b * SEQ + ss) * NPROJ + PJ_XBC + chn); }
            const int ln3 = opq(lane), r = ln3 & 31, hh = ln3 >> 5;
            if (F.wave < 4) {
                const int pt = F.wave >> 1;
#pragma unroll 1
                for (int q = 0; q < 2; ++q) {
                    const int lt = (F.wave & 1) ? (1 + q) : (3 * q);
                    f32x16 yacc;
#pragma unroll
                    for (int i = 0; i < 16; ++i) yacc[i] = 0.f;
                    const float al = acum2[32 * lt + r];
                    bf16x8 cf[8];
#pragma unroll
                    for (int kk = 0; kk < 8; ++kk) cf[kk] = *(const LAS bf16x8*)(Cln + (32 * lt + r) * LDP + 16 * kk + 8 * hh);
#pragma unroll 1
                    for (int st = 0; st <= lt; ++st) {
                        bf16x8 bfr[8];
#pragma unroll
                        for (int kk = 0; kk < 8; ++kk) bfr[kk] = *(const LAS bf16x8*)(Bsn + (32 * st + r) * LDP + 16 * kk + 8 * hh);
                        f32x4 wq[4];
#pragma unroll
                        for (int g4 = 0; g4 < 4; ++g4) wq[g4] = *(const LAS f32x4*)(wv + 32 * st + 8 * g4 + 4 * hh);
                        s16x4 xlo[2], xhi[2];
#pragma unroll
                        for (int sg = 0; sg < 2; ++sg) { const int prow = 32 * pt + r, lb = 32 * st + 16 * sg;
                            xlo[sg] = *(const LAS s16x4*)(Xc + swz_t(prow, lb) + 4 * hh); xhi[sg] = *(const LAS s16x4*)(Xc + swz_t(prow, lb + 8) + 4 * hh); }
                        __builtin_amdgcn_sched_barrier(0);
                        f32x16 macc;
#pragma unroll
                        for (int i = 0; i < 16; ++i) macc[i] = 0.f;
#pragma unroll
                        for (int kk = 0; kk < 8; ++kk) macc = MFMA32(bfr[kk], cf[kk], macc);
#pragma unroll
                        for (int i = 0; i < 16; ++i) { const int sl = crow(i, hh);
                            float f = __builtin_amdgcn_exp2f(al + wq[i >> 2][i & 3]);
                            if (st == lt && sl > r) f = 0.f;
                            macc[i] *= f; }
#pragma unroll
                        for (int sg = 0; sg < 2; ++sg) {
                            const bf16x8 bfrag = pack8(macc, sg);
                            const bf16x8 afrag = __builtin_shufflevector(xlo[sg], xhi[sg], 0, 1, 2, 3, 4, 5, 6, 7);
                            yacc = MFMA32(afrag, bfrag, yacc);
                        }
                    }
                    unsigned short xs16[16];
#pragma unroll
                    for (int i = 0; i < 16; ++i) xs16[i] = *(const LAS unsigned short*)(Xc + swz_t(32 * pt + crow(i, hh), 32 * lt + r));
                    __builtin_amdgcn_sched_barrier(0);
#pragma unroll
                    for (int i = 0; i < 16; i += 2) {
                        const float y0 = yacc[i] + Dh * __uint_as_float((unsigned)xs16[i] << 16), y1 = yacc[i + 1] + Dh * __uint_as_float((unsigned)xs16[i + 1] << 16);
                        YPF[((((size_t)u * 4 + lt) * 2 + pt) * 8 + (i >> 1)) * 64 + ln3] = cvtpk(y0, y1); }
                }
            } else {
                const int nt = F.wave - 4;
                bf16x8 bb[8];
                { v4u braw[8]; f32x4 we[8][2];
#pragma unroll
                  for (int kk = 0; kk < 8; ++kk) { braw[kk] = *(const LAS v4u*)(Bnl + swz_t(32 * nt + r, 16 * kk + 8 * hh));
                      we[kk][0] = *(const LAS f32x4*)(wend + 16 * kk + 8 * hh); we[kk][1] = *(const LAS f32x4*)(wend + 16 * kk + 8 * hh + 4); }
#pragma unroll
                  for (int kk = 0; kk < 8; ++kk) { v4u o;
                      o.x = cvtpk(bflo(braw[kk].x) * we[kk][0][0], bfhi(braw[kk].x) * we[kk][0][1]); o.y = cvtpk(bflo(braw[kk].y) * we[kk][0][2], bfhi(braw[kk].y) * we[kk][0][3]);
                      o.z = cvtpk(bflo(braw[kk].z) * we[kk][1][0], bfhi(braw[kk].z) * we[kk][1][1]); o.w = cvtpk(bflo(braw[kk].w) * we[kk][1][2], bfhi(braw[kk].w) * we[kk][1][3]);
                      bb[kk] = __builtin_bit_cast(bf16x8, o); } }
#pragma unroll 1
                for (int pt = 0; pt < 2; ++pt) {
                    bf16x8 xa[8];
#pragma unroll
                    for (int kk = 0; kk < 8; ++kk) xa[kk] = *(const LAS bf16x8*)(Xc + swz_t(32 * pt + r, 16 * kk + 8 * hh));
                    __builtin_amdgcn_sched_barrier(0);
                    f32x16 sacc;
#pragma unroll
                    for (int i = 0; i < 16; ++i) sacc[i] = 0.f;
#pragma unroll
                    for (int kk = 0; kk < 8; ++kk) sacc = MFMA32(xa[kk], bb[kk], sacc);
#pragma unroll
                    for (int i = 0; i < 16; i += 2) ST[((size_t)u * 32 + 16 * pt + (crow(i, hh) >> 1)) * 128 + 32 * nt + r] = cvtpk(sacc[i], sacc[i + 1]);
                }
            }
            if (hi < 3) {
                const int cg = cgn, l = ln_;
                float w[4][8], bias[8]; S1_LOADW(chn);
                float a[8], a2[8]; S1_CONV8(a, 0); S1_CONV8(a2, 1);
#pragma unroll
                for (int e = 0; e < 8; ++e) *(LAS unsigned*)(Xn + swz_t(cg * 8 + e, l)) = cvtpk(a[e], a2[e]);
            }
            __syncthreads();
        }
    }
}
__device__ __forceinline__ void ssd_s2(Frame& F, const Ptrs& P) {
    const unsigned* ST = (const unsigned*)(P.ws + WS_ST); const float* CDEC = (const float*)(P.ws + WS_CDEC); unsigned* PREV = (unsigned*)(P.ws + WS_PREV);
    for (int g = F.vcu * 512 + (F.wave * 64 + lane_id()); g < 65536; g += F.G * 512) {
        const int n2 = g & 63, p2 = (g >> 6) & 31, h = (g >> 11) & 7, b = g >> 14;
        uint2 st[32];
#pragma unroll
        for (int c = 0; c < 32; ++c) st[c] = *(const uint2*)(ST + ((size_t)(((b * 32 + c) * 8 + h) * 32 + p2)) * 128 + 2 * n2);
        float r00 = 0.f, r01 = 0.f, r10 = 0.f, r11 = 0.f;
#pragma unroll
        for (int c = 0; c < 32; ++c) { const size_t u = (size_t)((b * 32 + c) * 8 + h);
            PREV[((u * 64 + 2 * p2) * 128 + 2 * n2) >> 1] = cvtpk(r00, r01); PREV[((u * 64 + 2 * p2 + 1) * 128 + 2 * n2) >> 1] = cvtpk(r10, r11);
            const float d = CDEC[u];
            r00 = r00 * d + bflo(st[c].x); r10 = r10 * d + bfhi(st[c].x); r01 = r01 * d + bflo(st[c].y); r11 = r11 * d + bfhi(st[c].y); }
    }
}
__device__ __forceinline__ void ssd_s3(Frame& F, const Ptrs& P) {
    const bf16* CC = (const bf16*)(P.ws + WS_CC); const bf16* PREV = (const bf16*)(P.ws + WS_PREV); const float* EA = (const float*)(P.ws + WS_EA);
    const unsigned* YPF = (const unsigned*)((const char*)P.out + DO_YPF); const bf16* PROJ = (const bf16*)(P.ws + WS_PROJ); bf16* CAT = (bf16*)(P.ws + WS_XN);
    LAS float* red = (LAS float*)(F.lds + RING_OFF);
    const int lane = lane_id(), r = lane & 31, hh = lane >> 5, h = F.wave, grp = h >> 2;
    for (int v2 = F.vcu; v2 < 256; v2 += F.G) {
        const int lp = v2 & 1, c = (v2 >> 1) & 31, b = v2 >> 6;
        const size_t u = (size_t)((b * 32 + c) * 8 + h);
        bf16x8 af[2][8];
#pragma unroll
        for (int pt = 0; pt < 2; ++pt)
#pragma unroll
            for (int kk = 0; kk < 8; ++kk) af[pt][kk] = *(const bf16x8*)(PREV + (u * 64 + 32 * pt + r) * 128 + 16 * kk + 8 * hh);
#pragma unroll 1
        for (int li = 0; li < 2; ++li) {
            const int lt = 2 * lp + li;
            const int t = b * SEQ + c * 128 + lt * 32 + r;
            unsigned ypf[2][8]; unsigned long long zz[2][4];
#pragma unroll
            for (int pt = 0; pt < 2; ++pt) {
#pragma unroll
                for (int i = 0; i < 8; ++i) ypf[pt][i] = YPF[((((size_t)u * 4 + lt) * 2 + pt) * 8 + i) * 64 + lane];
#pragma unroll
                for (int g4 = 0; g4 < 4; ++g4) zz[pt][g4] = *(const unsigned long long*)(PROJ + (size_t)t * NPROJ + PJ_Z + h * 64 + 32 * pt + 8 * g4 + 4 * hh); }
            const float ea = EA[(size_t)t * 8 + h];
            bf16x8 bb[8];
#pragma unroll
            for (int kk = 0; kk < 8; ++kk) bb[kk] = *(const bf16x8*)(CC + (size_t)t * 256 + grp * 128 + 16 * kk + 8 * hh);
            f32x16 acc[2];
#pragma unroll
            for (int i = 0; i < 16; ++i) { acc[0][i] = 0.f; acc[1][i] = 0.f; }
#pragma unroll
            for (int kk = 0; kk < 8; ++kk) { acc[0] = MFMA32(af[0][kk], bb[kk], acc[0]); acc[1] = MFMA32(af[1][kk], bb[kk], acc[1]); }
            float ss = 0.f;
#pragma unroll
            for (int pt = 0; pt < 2; ++pt)
#pragma unroll
                for (int g4 = 0; g4 < 4; ++g4) {
                    const unsigned z01 = (unsigned)zz[pt][g4], z23 = (unsigned)(zz[pt][g4] >> 32);
                    const float zf[4] = {bflo(z01), bfhi(z01), bflo(z23), bfhi(z23)};
#pragma unroll
                    for (int e = 0; e < 4; ++e) { const int i = 4 * g4 + e;
                        const float y = acc[pt][i] * ea + ((i & 1) ? bfhi(ypf[pt][i >> 1]) : bflo(ypf[pt][i >> 1]));
                        const float yg = y * silu_fast(zf[e]); acc[pt][i] = yg; ss = fmaf(yg, yg, ss); }
                }
            ss = sum_halves(ss);
            LAS float* rd = red + li * 256;
            if (hh == 0) rd[h * 32 + r] = ss;
            __syncthreads();
            float tot = 0.f;
#pragma unroll
            for (int w = 0; w < 8; ++w) tot += rd[w * 32 + r];
            const float rn = rsqrtf(tot * (1.f / 512.f) + EPS);
#pragma unroll
            for (int pt = 0; pt < 2; ++pt)
#pragma unroll
                for (int g4 = 0; g4 < 4; ++g4) { const int ch = h * 64 + 32 * pt + 8 * g4 + 4 * hh;
                    const float4 w = *(const float4*)(P.ssd_norm_w + ch);
                    *(unsigned long long*)(CAT + (size_t)t * DM + 512 + ch) = (unsigned long long)cvtpk(acc[pt][4 * g4] * rn * w.x, acc[pt][4 * g4 + 1] * rn * w.y) | ((unsigned long long)cvtpk(acc[pt][4 * g4 + 2] * rn * w.z, acc[pt][4 * g4 + 3] * rn * w.w) << 32); }
        }
        __syncthreads();
    }
}
__device__ __forceinline__ float gelu_erf(float v) { return 0.5f * v * (1.f + erff(v * 0.70710678118654752f)); }
typedef float f32x2v __attribute__((ext_vector_type(2)));
#define CVT8(W, LO) __builtin_amdgcn_cvt_pk_f32_fp8((int)(W), LO)
template <int CTRL> __device__ __forceinline__ float dpp_f(float v) { return __int_as_float(__builtin_amdgcn_update_dpp(0, __float_as_int(v), CTRL, 0xF, 0xF, true)); }
__device__ __forceinline__ float sum8_dpp(float s) { s += dpp_f<0xB1>(s); s += dpp_f<0x4E>(s); s += dpp_f<0x141>(s); return s; }
struct PeerPlace { int vx, nx, rank, nloc; };
__device__ __forceinline__ PeerPlace peer_place(Frame& F) {
    __syncthreads();
    if (F.wave == 0 && lane_id() == 0) {
        unsigned* bar = (unsigned*)(F.ctl + CW_BAR); const unsigned x = xb_xcc_id();
        unsigned vx = 0, nx = 0;
        for (unsigned j = 0; j < 16; ++j) { const unsigned c = xb_ld(&bar[XB_XCNT(j)]); if (c) { if (j < x) ++vx; ++nx; } }
        const unsigned rank = xb_add((unsigned*)(F.ctl + CW_RANK) + 64 * x, 1u);
        F.MISC[10] = vx; F.MISC[11] = nx ? nx : 1u; F.MISC[12] = rank; F.MISC[13] = xb_ld(&bar[XB_XCNT(x)]);
    }
    __syncthreads();
    PeerPlace pp; pp.vx = (int)F.MISC[10]; pp.nx = (int)F.MISC[11]; pp.rank = (int)F.MISC[12]; pp.nloc = (int)F.MISC[13]; if (pp.nloc < 1) pp.nloc = 1;
    return pp;
}
__device__ __forceinline__ void h_quant_rows(Frame& F, const Ptrs& P) {
    const bf16* HB = (const bf16*)(P.ws + WS_ST); unsigned char* H8 = P.ws + WS_H8; float* HS = (float*)(P.ws + WS_HS);
    const int lane = lane_id();
    for (int t = F.vcu * NWAVES + F.wave; t < T_; t += F.G * NWAVES) {
        const v4u a0 = ((const v4u*)(HB + (size_t)t * DM))[2 * lane], a1 = ((const v4u*)(HB + (size_t)t * DM))[2 * lane + 1];
        float hf[16];
        hf[0] = bflo(a0.x); hf[1] = bfhi(a0.x); hf[2] = bflo(a0.y); hf[3] = bfhi(a0.y); hf[4] = bflo(a0.z); hf[5] = bfhi(a0.z); hf[6] = bflo(a0.w); hf[7] = bfhi(a0.w);
        hf[8] = bflo(a1.x); hf[9] = bfhi(a1.x); hf[10] = bflo(a1.y); hf[11] = bfhi(a1.y); hf[12] = bflo(a1.z); hf[13] = bfhi(a1.z); hf[14] = bflo(a1.w); hf[15] = bfhi(a1.w);
        float am = 0.f;
#pragma unroll
        for (int i = 0; i < 16; ++i) am = fmaxf(am, fabsf(hf[i]));
        am = fmaxf(am, dpp_f<0xB1>(am)); am = fmaxf(am, dpp_f<0x4E>(am)); am = fmaxf(am, dpp_f<0x141>(am)); am = fmaxf(am, dpp_f<0x140>(am)); am = fmaxf(am, 1e-30f);
        const float inv = 119.f / am;
        unsigned hi[2] = {0u, 0u}, lo[2] = {0u, 0u};
#pragma unroll
        for (int i = 0; i < 16; ++i) { const int q = __float2int_rn(hf[i] * inv); const int qh = (q + 8) >> 4, ql = q - 16 * qh;
            hi[i >> 3] |= ((unsigned)qh & 15u) << (4 * (i & 7)); lo[i >> 3] |= ((unsigned)ql & 15u) << (4 * (i & 7)); }
        unsigned char* dst = H8 + (size_t)t * 1024 + (lane >> 4) * 256 + (lane & 15) * 8;
        *(unsigned long long*)dst = (unsigned long long)hi[0] | ((unsigned long long)hi[1] << 32);
        *(unsigned long long*)(dst + 128) = (unsigned long long)lo[0] | ((unsigned long long)lo[1] << 32);
        if ((lane & 15) == 0) HS[(size_t)t * 8 + (lane >> 4)] = am * (1.f / 119.f);
    }
}
constexpr int PX_D = 16;
template <int CTRL> __device__ __forceinline__ int dpp_i(int v) { return __builtin_amdgcn_update_dpp(0, v, CTRL, 0xF, 0xF, true); }
#define PX_ISSUE(BUF, LO, HI) _Pragma("unroll") for (int b_ = 0; b_ < 8; ++b_) { const unsigned off_ = ((unsigned)__builtin_amdgcn_ds_bpermute((16 * (b_ & 3) + ps) * 4, (b_ & 4) ? (HI) : (LO)) << 7) | (unsigned)(dl << 5); \
        BUF[2 * b_] = *(const v4u*)(tab + off_); BUF[2 * b_ + 1] = *(const v4u*)(tab + off_ + 16); }
struct H4 { v4u h0, h1, l0, l1; };
#define PX_DOT8(Q, HH, HL) ah = __builtin_amdgcn_sdot8((int)(Q), (int)(HH), ah, false); al = __builtin_amdgcn_sdot8((int)(Q), (int)(HL), al, false);
__device__ __forceinline__ void peer_down_token(const v4u (&cur)[PX_D], const H4& h, const float hs, float* prow, int dl, int ps) {
    int sm[8];
#pragma unroll
    for (int b = 0; b < 8; ++b) { const v4u q0 = cur[2 * b], q1 = cur[2 * b + 1];
        int ah = 0, al = 0;
        PX_DOT8(q0.x, h.h0.x, h.l0.x) PX_DOT8(q0.y, h.h0.y, h.l0.y) PX_DOT8(q0.z, h.h0.z, h.l0.z) PX_DOT8(q0.w, h.h0.w, h.l0.w)
        PX_DOT8(q1.x, h.h1.x, h.l1.x) PX_DOT8(q1.y, h.h1.y, h.l1.y) PX_DOT8(q1.z, h.h1.z, h.l1.z) PX_DOT8(q1.w, h.h1.w, h.l1.w)
        sm[b] = 16 * ah + al; }
    const bool c1 = (dl & 2) != 0, c0 = (dl & 1) != 0;
    int w4[4], w2[2];
#pragma unroll
    for (int k = 0; k < 4; ++k) { const int keep = c1 ? sm[4 + k] : sm[k], send = c1 ? sm[k] : sm[4 + k]; w4[k] = keep + dpp_i<0x4E>(send); }
#pragma unroll
    for (int k = 0; k < 2; ++k) { const int keep = c0 ? w4[2 + k] : w4[k], send = c0 ? w4[k] : w4[2 + k]; w2[k] = keep + dpp_i<0xB1>(send); }
    prow[32 * dl + ps] = (float)w2[0] * hs; prow[32 * dl + 16 + ps] = (float)w2[1] * hs;
}
__device__ __forceinline__ void peer_down(Frame& F, const Ptrs& P, const PeerPlace& pp) {
    const unsigned char* H8 = P.ws + WS_H8; const unsigned char* HSb = P.ws + WS_HS; const unsigned char* IDXb = P.ws + WS_IDX; unsigned char* PARTb = P.ws + WS_PART;
    const int lane = lane_id(), dl = lane & 3, ps = lane >> 2;
    const int tstep = pp.nloc * NWAVES;
    for (int u = pp.vx; u < 8; u += pp.nx) {
        const int s = u & 3, tend = ((u >> 2) + 1) * (T_ / 2), t0 = (u >> 2) * (T_ / 2) + pp.rank * NWAVES + F.wave;
        if (t0 >= tend) continue;
        const unsigned char* tab = P.ws + WS_ED + (size_t)s * 16384 * 128;
        const unsigned hoff = (unsigned)(s * 256 + dl * 32), ioff = (unsigned)lane * 4u;
        v4u bufA[PX_D], bufB[PX_D];
#define PD_CLAMP(T) ((T) < tend ? (T) : t0)
#define PD_META(H, HSC, TT) do { const unsigned char* hp_ = H8 + ((unsigned)(TT) * 1024u + hoff); H.h0 = *(const v4u*)hp_; H.h1 = *(const v4u*)(hp_ + 16); H.l0 = *(const v4u*)(hp_ + 128); H.l1 = *(const v4u*)(hp_ + 144); \
        HSC = *(const float*)(HSb + ((unsigned)(TT) * 32u + (unsigned)s * 4u)); } while (0)
#define PD_IDX(LO, HI, TT) do { LO = *(const int*)(IDXb + ((unsigned)(TT) * 512u + ioff)); HI = *(const int*)(IDXb + ((unsigned)(TT) * 512u + 256u + ioff)); } while (0)
        int nidx_lo, nidx_hi; PD_IDX(nidx_lo, nidx_hi, t0);
        PX_ISSUE(bufA, nidx_lo, nidx_hi);
        PD_IDX(nidx_lo, nidx_hi, PD_CLAMP(t0 + tstep));
        H4 ha, hb; float sa, sb; PD_META(ha, sa, t0);
        for (int t = t0; t < tend; t += 2 * tstep) {
            { const int tn = PD_CLAMP(t + tstep);
              PX_ISSUE(bufB, nidx_lo, nidx_hi); PD_IDX(nidx_lo, nidx_hi, PD_CLAMP(tn + tstep)); PD_META(hb, sb, tn);
              __builtin_amdgcn_sched_barrier(0);
              peer_down_token(bufA, ha, sa, (float*)(PARTb + ((unsigned)(s * T_ + t) * 512u)), dl, ps);
              __builtin_amdgcn_sched_barrier(0); }
            if (t + tstep >= tend) break;
            { const int tc = t + tstep, tn = PD_CLAMP(tc + tstep);
              PX_ISSUE(bufA, nidx_lo, nidx_hi); PD_IDX(nidx_lo, nidx_hi, PD_CLAMP(tn + tstep)); PD_META(ha, sa, tn);
              __builtin_amdgcn_sched_barrier(0);
              peer_down_token(bufB, hb, sb, (float*)(PARTb + ((unsigned)(s * T_ + tc) * 512u)), dl, ps);
              __builtin_amdgcn_sched_barrier(0); }
        }
    }
}
__device__ __forceinline__ void peer_act(Frame& F, const Ptrs& P) {
    const int* IDX = (const int*)(P.ws + WS_IDX); float* GATE = (float*)(P.ws + WS_GATE); const float* PART = (const float*)(P.ws + WS_PART); const float* SSQ = (const float*)(P.ws + WS_SSQ);
    const float* SCD = (const float*)(P.ws + WS_SMALL); const float* SCU = SCD + 16384;
    const int lane = lane_id();
    for (int w = F.vcu * NWAVES + F.wave; w < T_ * 2; w += F.G * NWAVES) {
        const int t = w >> 1; const size_t pid = (size_t)w * 64 + lane;
        const float ssq = lane < 16 ? SSQ[(size_t)t * 16 + lane] : 0.f;
        const float rstd = rsqrtf(wave_sum(ssq) * (1.f / 1024.f) + EPS);
        float pre = 0.f;
#pragma unroll
        for (int s = 0; s < 4; ++s) pre += PART[(size_t)s * T_ * 128 + pid];
        const int id = IDX[pid];
        GATE[pid] = gelu_erf(pre * SCD[id] * rstd) * GATE[pid] * SCU[id];
    }
}
constexpr int PE_PD = 8;
#define PE_LOAD4(SLOT, IDV) SLOT = *(const v4u*)(EU + (((unsigned)(IDV) << 9) | l16))
#define PE_BP(ADDR, V) __builtin_amdgcn_ds_bpermute((ADDR), (V))
__device__ __forceinline__ void peer_up_tm(Frame& F, const Ptrs& P) {
    const bf16* HB = (const bf16*)(P.ws + WS_ST); const unsigned char* EU = P.ws + WS_EU;
    const int* IDX = (const int*)(P.ws + WS_IDX); const float* GATE = (const float*)(P.ws + WS_GATE); const float* PART = (const float*)(P.ws + WS_PART);
    const float* SCD = (const float*)(P.ws + WS_SMALL); const float* SCU = SCD + 16384;
    const int lane = lane_id(), l31 = lane & 31; const bool upper = lane >= 32;
    const unsigned l16 = (unsigned)l31 << 4;
    const int bp0 = upper ? 4 : 0;
    const int t0 = F.vcu * NWAVES + F.wave, tstep = F.G * NWAVES;
    if (t0 >= T_) return;
    int idx_lo = IDX[(size_t)t0 * 128 + lane], idx_hi = IDX[(size_t)t0 * 128 + 64 + lane];
    v4u hq[4];
#pragma unroll
    for (int k = 0; k < 4; ++k) hq[k] = ((const v4u*)(HB + (size_t)t0 * DM))[4 * l31 + k];
    float g_lo = GATE[(size_t)t0 * 128 + lane], g_hi = GATE[(size_t)t0 * 128 + 64 + lane];
    float pre_lo = 0.f, pre_hi = 0.f;
#pragma unroll
    for (int s = 0; s < 4; ++s) { pre_lo += PART[((size_t)s * T_ + t0) * 128 + lane]; pre_hi += PART[((size_t)s * T_ + t0) * 128 + 64 + lane]; }
    float sdu_lo = SCD[idx_lo], sdu_hi = SCD[idx_hi], su_lo = SCU[idx_lo], su_hi = SCU[idx_hi];
    v4u ra[PE_PD];
#pragma unroll
    for (int j = 0; j < PE_PD; ++j) { const int id = PE_BP(bp0 + 8 * j, idx_lo); PE_LOAD4(ra[j], id); }
    int id_nx = PE_BP(bp0 + 8 * PE_PD, idx_lo);
    for (int t = t0; t < T_; t += tstep) {
        const int tn = (t + tstep < T_) ? t + tstep : t;
        const int nidx_lo = IDX[(size_t)tn * 128 + lane], nidx_hi = IDX[(size_t)tn * 128 + 64 + lane];
        v4u nh[4];
#pragma unroll
        for (int k = 0; k < 4; ++k) nh[k] = ((const v4u*)(HB + (size_t)tn * DM))[4 * l31 + k];
        const float ng_lo = GATE[(size_t)tn * 128 + lane], ng_hi = GATE[(size_t)tn * 128 + 64 + lane];
        float npart_lo[4], npart_hi[4];
#pragma unroll
        for (int s = 0; s < 4; ++s) { npart_lo[s] = PART[((size_t)s * T_ + tn) * 128 + lane]; npart_hi[s] = PART[((size_t)s * T_ + tn) * 128 + 64 + lane]; }
        float ssq = 0.f;
#pragma unroll
        for (int k = 0; k < 4; ++k) { ssq = fmaf(bflo(hq[k].x), bflo(hq[k].x), ssq); ssq = fmaf(bfhi(hq[k].x), bfhi(hq[k].x), ssq); ssq = fmaf(bflo(hq[k].y), bflo(hq[k].y), ssq); ssq = fmaf(bfhi(hq[k].y), bfhi(hq[k].y), ssq);
            ssq = fmaf(bflo(hq[k].z), bflo(hq[k].z), ssq); ssq = fmaf(bfhi(hq[k].z), bfhi(hq[k].z), ssq); ssq = fmaf(bflo(hq[k].w), bflo(hq[k].w), ssq); ssq = fmaf(bfhi(hq[k].w), bfhi(hq[k].w), ssq); }
        ssq += swz_xor<1>(ssq); ssq += swz_xor<2>(ssq); ssq += swz_xor<4>(ssq); ssq += swz_xor<8>(ssq); ssq += swz_xor<16>(ssq);
        const float rstd = rsqrtf(ssq * (1.f / 1024.f) + EPS);
        const float act_lo = gelu_erf(pre_lo * sdu_lo * rstd) * g_lo * su_lo, act_hi = gelu_erf(pre_hi * sdu_hi * rstd) * g_hi * su_hi;
        f32x2v acc[16];
#pragma unroll
        for (int i = 0; i < 16; ++i) acc[i] = (f32x2v){0.f, 0.f};
        float a_cur = __int_as_float(PE_BP(bp0, __float_as_int(act_lo)));
#pragma unroll
        for (int q = 0; q < 64; ++q) {
            const int qa = q + 1, ql = q + PE_PD + 1;
            float a_nx = 0.f;
            if (qa < 64) a_nx = __int_as_float(PE_BP(bp0 + 8 * (qa & 31), __float_as_int(qa < 32 ? act_lo : act_hi)));
            int id_n2;
            if (ql < 64) id_n2 = PE_BP(bp0 + 8 * (ql & 31), ql < 32 ? idx_lo : idx_hi);
            else id_n2 = PE_BP(bp0 + 8 * ((ql - 64) & 31), nidx_lo);
            __builtin_amdgcn_sched_barrier(0);
            { const f32x2v av = {a_cur, a_cur}; const v4u r = ra[q % PE_PD];
#define PE_FMA4(W, O) acc[O] = __builtin_elementwise_fma(av, (f32x2v)__builtin_amdgcn_cvt_scalef32_pk_f32_fp4(W, 1.0f, 0), acc[O]); acc[O + 1] = __builtin_elementwise_fma(av, (f32x2v)__builtin_amdgcn_cvt_scalef32_pk_f32_fp4(W, 1.0f, 1), acc[O + 1]); \
              acc[O + 2] = __builtin_elementwise_fma(av, (f32x2v)__builtin_amdgcn_cvt_scalef32_pk_f32_fp4(W, 1.0f, 2), acc[O + 2]); acc[O + 3] = __builtin_elementwise_fma(av, (f32x2v)__builtin_amdgcn_cvt_scalef32_pk_f32_fp4(W, 1.0f, 3), acc[O + 3]);
              PE_FMA4(r.x, 0) PE_FMA4(r.y, 4) PE_FMA4(r.z, 8) PE_FMA4(r.w, 12) }
            asm volatile("" : "+v"(acc[0]), "+v"(acc[1]), "+v"(acc[2]), "+v"(acc[3]), "+v"(acc[4]), "+v"(acc[5]), "+v"(acc[6]), "+v"(acc[7]));
            asm volatile("" : "+v"(acc[8]), "+v"(acc[9]), "+v"(acc[10]), "+v"(acc[11]), "+v"(acc[12]), "+v"(acc[13]), "+v"(acc[14]), "+v"(acc[15]));
            PE_LOAD4(ra[q % PE_PD], id_nx);
            id_nx = id_n2; a_cur = a_nx;
            __builtin_amdgcn_sched_barrier(0);
        }
        { float a = 0.f, c = 0.f;
#pragma unroll
          for (int s = 0; s < 4; ++s) { a += npart_lo[s]; c += npart_hi[s]; }
          pre_lo = a; pre_hi = c; }
        sdu_lo = SCD[nidx_lo]; sdu_hi = SCD[nidx_hi]; su_lo = SCU[nidx_lo]; su_hi = SCU[nidx_hi];
        float y[32];
#pragma unroll
        for (int k = 0; k < 4; ++k) { y[8 * k] = bflo(hq[k].x); y[8 * k + 1] = bfhi(hq[k].x); y[8 * k + 2] = bflo(hq[k].y); y[8 * k + 3] = bfhi(hq[k].y); y[8 * k + 4] = bflo(hq[k].z); y[8 * k + 5] = bfhi(hq[k].z); y[8 * k + 6] = bflo(hq[k].w); y[8 * k + 7] = bfhi(hq[k].w); }
        float s2 = 0.f;
#pragma unroll
        for (int i = 0; i < 16; ++i) { y[2 * i] += sum_halves(acc[i][0]); y[2 * i + 1] += sum_halves(acc[i][1]); s2 = fmaf(y[2 * i], y[2 * i], s2); s2 = fmaf(y[2 * i + 1], y[2 * i + 1], s2); }
        s2 += swz_xor<1>(s2); s2 += swz_xor<2>(s2); s2 += swz_xor<4>(s2); s2 += swz_xor<8>(s2); s2 += swz_xor<16>(s2);
        const float r2 = rsqrtf(s2 * (1.f / 1024.f) + EPS);
        const float4* wf = (const float4*)(P.norm_final) + 8 * l31 + 4 * (lane >> 5); float4* o = (float4*)(P.out + (size_t)t * DM) + 8 * l31 + 4 * (lane >> 5);
#pragma unroll
        for (int k = 0; k < 4; ++k) { const float4 w = wf[k];
            const float e0 = upper ? y[16 + 4 * k] : y[4 * k], e1 = upper ? y[17 + 4 * k] : y[4 * k + 1], e2 = upper ? y[18 + 4 * k] : y[4 * k + 2], e3 = upper ? y[19 + 4 * k] : y[4 * k + 3];
            o[k] = make_float4(e0 * r2 * w.x, e1 * r2 * w.y, e2 * r2 * w.z, e3 * r2 * w.w); }
        idx_lo = nidx_lo; idx_hi = nidx_hi; g_lo = ng_lo; g_hi = ng_hi;
#pragma unroll
        for (int k = 0; k < 4; ++k) hq[k] = nh[k];
    }
}
constexpr int TK_LDK = 136, TK_K2 = 34816, TK_SCR = 69632, TK_SP = 49;
__device__ __forceinline__ int mono_key(float x) { const int b = __float_as_int(x); return b ^ ((b >> 31) & 0x7fffffff); }
__device__ __forceinline__ float unmono(int m) { return __int_as_float(m ^ ((m >> 31) & 0x7fffffff)); }
__device__ __forceinline__ int max3i(int a, int b, int c) { return max(max(a, b), c); }
#define CEX(A, I, J) do { const int hi_ = max(A[I], A[J]), lo_ = min(A[I], A[J]); A[I] = hi_; A[J] = lo_; } while (0)
template <int N, int OFF, int K, int J, int LEN> struct BitonicStep {
    static __device__ __forceinline__ void run(int (&a)[LEN]) {
#pragma unroll
        for (int i = 0; i < N; ++i) { const int l = i ^ J; if (l > i) { if ((i & K) == 0) CEX(a, OFF + i, OFF + l); else CEX(a, OFF + l, OFF + i); } }
        if constexpr (J > 1) BitonicStep<N, OFF, K, (J >> 1), LEN>::run(a);
        else if constexpr (K < N) BitonicStep<N, OFF, (K << 1), K, LEN>::run(a);
    }
};
template <int N, int OFF, int LEN> __device__ __forceinline__ void bitonic_sort_desc(int (&a)[LEN]) { BitonicStep<N, OFF, 2, 1, LEN>::run(a); }
template <int OFF, int LEN> __device__ __forceinline__ void bitonic_merge16_desc(int (&a)[LEN]) { BitonicStep<16, OFF, 16, 8, LEN>::run(a); }
template <int A, int B, int LEN> __device__ __forceinline__ void merge_top16(int (&a)[LEN]) {
#pragma unroll
    for (int i = 0; i < 16; ++i) a[A + i] = max(a[A + i], a[B + 15 - i]);
    bitonic_merge16_desc<A, LEN>(a);
}
template <int LEN> __device__ __forceinline__ void pair_top16(int (&a)[LEN]) {
    int lo[16], up[16];
#pragma unroll
    for (int i = 0; i < 16; ++i) { const auto rr = __builtin_amdgcn_permlane32_swap((unsigned)a[i], (unsigned)a[i], false, false); lo[i] = (int)rr[0]; up[i] = (int)rr[1]; }
#pragma unroll
    for (int i = 0; i < 16; ++i) a[i] = max(lo[i], up[15 - i]);
    bitonic_merge16_desc<0, LEN>(a);
}
__device__ __forceinline__ void topk_half(const bf16x8 (&qf)[8], const LAS bf16* Kh, int r, int hh, int (&key)[64]) {
#pragma unroll
    for (int nt = 0; nt < 4; ++nt) {
        f32x16 sc;
#pragma unroll
        for (int i = 0; i < 16; ++i) sc[i] = 0.f;
#pragma unroll
        for (int kk = 0; kk < 8; ++kk) { const bf16x8 a = *(const LAS bf16x8*)(Kh + (32 * nt + r) * TK_LDK + 16 * kk + 8 * hh); sc = MFMA32(a, qf[kk], sc); }
#pragma unroll
        for (int i = 0; i < 16; ++i) key[nt * 16 + i] = (mono_key(sc[i]) & ~127) | (127 - (32 * nt + crow(i, hh)));
    }
    bitonic_sort_desc<16, 0, 64>(key); bitonic_sort_desc<16, 16, 64>(key); bitonic_sort_desc<16, 32, 64>(key); bitonic_sort_desc<16, 48, 64>(key);
    merge_top16<0, 16, 64>(key); merge_top16<32, 48, 64>(key); merge_top16<0, 32, 64>(key);
    pair_top16<64>(key);
}
__device__ __forceinline__ void topk_finish(const LAS int* scr, int hh, float rstd, int* IDX, float* GATE, int t, int hd) {
    const LAS int* la = scr + hh * 16; const LAS int* lb = scr + (1 - hh) * 16;
    float va[4], vb[16];
#pragma unroll
    for (int i = 0; i < 4; ++i) va[i] = unmono(la[i] & ~127);
#pragma unroll
    for (int j = 0; j < 16; ++j) vb[j] = unmono(lb[j] & ~127);
    int ck[32];
    {
        int q = 0;
#pragma unroll
        for (int i = 0; i < 4; ++i)
#pragma unroll
            for (int j = i; j < 16; ++j) if ((i + 1) * (j + 1) <= 16) {
                const int pos = hh ? (j * 16 + i) : (i * 16 + j);
                int k = (mono_key(va[i] + vb[j]) & ~255) | (255 - pos);
                if (i == j && hh) k = (int)0x80000000;
                ck[q++] = k; }
#pragma unroll
        for (int i = 27; i < 32; ++i) ck[i] = (int)0x80000000;
    }
    bitonic_sort_desc<32, 0, 32>(ck);
    pair_top16<32>(ck);
    const float vmax = unmono(ck[0] & ~255) * rstd;
    float ev[8]; int id[8]; float esum = 0.f; const int hm = -hh;
#pragma unroll
    for (int q = 0; q < 8; ++q) { const int wk = ck[q] ^ ((ck[q] ^ ck[8 + q]) & hm); const int pos = 255 - (wk & 255);
        const int n1 = 127 - (scr[pos >> 4] & 127), n2 = 127 - (scr[16 + (pos & 15)] & 127);
        id[q] = n1 * 128 + n2;
        ev[q] = exp2f((unmono(wk & ~255) * rstd - vmax) * LOG2E); esum += ev[q]; }
    esum = sum_halves(esum);
    const float inv = 1.f / esum;
    int4* ip = (int4*)(IDX + ((size_t)t * 8 + hd) * 16 + hh * 8); float4* gp = (float4*)(GATE + ((size_t)t * 8 + hd) * 16 + hh * 8);
    ip[0] = make_int4(id[0], id[1], id[2], id[3]); ip[1] = make_int4(id[4], id[5], id[6], id[7]);
    gp[0] = make_float4(ev[0] * inv, ev[1] * inv, ev[2] * inv, ev[3] * inv); gp[1] = make_float4(ev[4] * inv, ev[5] * inv, ev[6] * inv, ev[7] * inv);
}
constexpr int TQ_QH = 69632, TQ_QP = 272;
struct OneUnit { pg8::StaticOrder S; int i;
    __device__ __forceinline__ bool next(int j, pg8::Unit& u) const { return j == 0 ? S.next(i, u) : false; }
    __device__ __forceinline__ void a_ready(const pg8::Unit&) const {}
    __device__ __forceinline__ void done(const pg8::Unit&) const {}
};
struct EpiQTopk {
    static constexpr bool PERM = true, AFTER_DRAIN = true;
    const unsigned char* KB; const float* SSQ; int* IDX; float* GATE;
    __device__ __forceinline__ void dump(const pg8::f32x4 (&acc)[2][2][4][2], int bj, LAS unsigned char* QH, int wr, int wc, int fr, int fq) const {
#pragma unroll
        for (int ai = 0; ai < 2; ++ai)
#pragma unroll
            for (int m = 0; m < 4; ++m) { const pg8::f32x4 v0 = bj ? acc[ai][1][m][0] : acc[ai][0][m][0], v1 = bj ? acc[ai][1][m][1] : acc[ai][0][m][1];
                v4u w; w.x = cvtpk(v0[0], v0[1]); w.y = cvtpk(v0[2], v0[3]); w.z = cvtpk(v1[0], v1[1]); w.w = cvtpk(v1[2], v1[3]);
                *(LAS v4u*)(QH + (128 * ai + 64 * wr + 16 * m + fr) * TQ_QP + (32 * wc + 8 * fq) * 2) = w; }
    }
    __device__ __forceinline__ void fused(const pg8::f32x4 (&acc)[2][2][4][2], const pg8::Unit& u, int wr, int wc, int fr, int fq, LAS unsigned char* L, int wid, int lane) const {
        LAS bf16* K1 = (LAS bf16*)L; LAS bf16* K2 = (LAS bf16*)(L + TK_K2); LAS unsigned char* QH = L + TQ_QH;
        const int tid_ = wid * 64 + lane, r = lane & 31, hh = lane >> 5;
        { v4u kq[8];
#pragma unroll
          for (int q = 0; q < 8; ++q) kq[q] = ((const v4u*)KB)[tid_ + 512 * q];
          dump(acc, 0, QH, wr, wc, fr, fq);
#pragma unroll
          for (int q = 0; q < 8; ++q) { const int j = tid_ + 512 * q, n = (j >> 4) & 127, k8 = j & 15; *(LAS v4u*)(((j >> 11) ? K2 : K1) + n * TK_LDK + 8 * k8) = kq[q]; } }
        __syncthreads();
        const int t = u.pm * 256 + 32 * wid + r;
        float rstd;
        { const float4* sp = (const float4*)(SSQ + (size_t)t * 16); const float4 a = sp[0], b = sp[1], c = sp[2], d = sp[3];
          rstd = rsqrtf(((a.x + a.y + a.z + a.w) + (b.x + b.y + b.z + b.w) + (c.x + c.y + c.z + c.w) + (d.x + d.y + d.z + d.w)) * (1.f / 1024.f) + EPS); }
        const LAS unsigned char* qrow = QH + (32 * wid + r) * TQ_QP + 16 * hh;
        int key[64], list0[16];
        { bf16x8 qf[8];
#pragma unroll
          for (int kk = 0; kk < 8; ++kk) qf[kk] = *(const LAS bf16x8*)(qrow + 32 * kk);
          topk_half(qf, K1, r, hh, key);
#pragma unroll
          for (int i = 0; i < 16; ++i) list0[i] = key[i]; }
        __syncthreads();
        dump(acc, 1, QH, wr, wc, fr, fq);
        __syncthreads();
        { bf16x8 qf[8];
#pragma unroll
          for (int kk = 0; kk < 8; ++kk) qf[kk] = *(const LAS bf16x8*)(qrow + 32 * kk);
          topk_half(qf, K2, r, hh, key); }
        LAS int* scr = (LAS int*)(QH + 32 * wid * TQ_QP) + r * TK_SP;
        LDS_WAIT();
        if (hh == 0) {
#pragma unroll
            for (int i = 0; i < 16; ++i) { scr[i] = list0[i]; scr[16 + i] = key[i]; } }
        topk_finish(scr, hh, rstd, IDX, GATE, t, u.pn);
        __syncthreads();
    }
};

constexpr int AT_KP = 72, AT_VP = 264;
constexpr int AT_K = 0, AT_VT = 36864, AT_BT = 36864 + 33792;
__device__ __forceinline__ void attn_phase(Frame& F, const Ptrs& P) {
    const bf16* PROJ = (const bf16*)(P.ws + WS_PROJ); bf16* CAT = (bf16*)(P.ws + WS_XN);
    LAS unsigned char* L = F.lds + RING_OFF;
    LAS bf16* Ks = (LAS bf16*)(L + AT_K); LAS bf16* Vt = (LAS bf16*)(L + AT_VT); LAS float* btab = (LAS float*)(L + AT_BT);
    const int lane = lane_id(), tid_ = F.wave * 64 + lane, r = lane & 31, hh = lane >> 5;
    for (int u = F.vcu; u < 256; u += F.G) {
        const int hkv = u & 1, n = (u >> 1) & 31, b = u >> 6;
        const int trow0 = b * SEQ + n * 128;
        v4u kvq[4], vvq[4];
#pragma unroll
        for (int q = 0; q < 4; ++q) { const int i = tid_ + 512 * q, kj = i >> 3, ch = i & 7; const bool ok = (n > 0) || (kj >= 128);
            kvq[q] = (v4u){0u, 0u, 0u, 0u}; vvq[q] = (v4u){0u, 0u, 0u, 0u};
            if (ok) { const bf16* rowp = PROJ + (size_t)(trow0 - 128 + kj) * NPROJ + hkv * 64 + ch * 8; kvq[q] = *(const v4u*)(rowp + PJ_K); vvq[q] = *(const v4u*)(rowp + PJ_V); } }
#pragma unroll
        for (int q = 0; q < 4; ++q) {
            const int i = tid_ + 512 * q, kj = i >> 3, ch = i & 7;
            const v4u kv = kvq[q], vv = vvq[q];
            *(LAS v4u*)(Ks + kj * AT_KP + ch * 8) = kv;
            LAS bf16* vp = Vt + (ch * 8) * AT_VP + kj;
            vp[0] = (bf16)(vv.x & 0xffffu); vp[AT_VP] = (bf16)(vv.x >> 16); vp[2 * AT_VP] = (bf16)(vv.y & 0xffffu); vp[3 * AT_VP] = (bf16)(vv.y >> 16);
            vp[4 * AT_VP] = (bf16)(vv.z & 0xffffu); vp[5 * AT_VP] = (bf16)(vv.z >> 16); vp[6 * AT_VP] = (bf16)(vv.w & 0xffffu); vp[7 * AT_VP] = (bf16)(vv.w >> 16);
        }
        for (int i = tid_; i < 768; i += 512) { const int gg = i / 192, dist = i % 192 - 32;
            btab[i] = (dist >= 0 && dist < 128) ? P.rel_bias[c_bucket[dist & 127] * 8 + hkv * 4 + gg] * LOG2E : 0.f; }
        __syncthreads();
        const int g = F.wave & 3, h = hkv * 4 + g;
        const float sink2 = P.sinks[h] * LOG2E;
#pragma unroll 1
        for (int qq = 0; qq < 2; ++qq) {
            const int qt = (F.wave >> 2) * 2 + qq, t = trow0 + 32 * qt + r;
            bf16x8 qf[4];
#pragma unroll
            for (int kk = 0; kk < 4; ++kk) qf[kk] = *(const bf16x8*)(PROJ + (size_t)t * NPROJ + h * 64 + 16 * kk + 8 * hh);
            f32x16 sc[5];
#pragma unroll
            for (int j = 0; j < 5; ++j) {
#pragma unroll
                for (int i = 0; i < 16; ++i) sc[j][i] = 0.f;
#pragma unroll
                for (int kk = 0; kk < 4; ++kk) { const bf16x8 a = *(const LAS bf16x8*)(Ks + (32 * (qt + j) + r) * AT_KP + 16 * kk + 8 * hh); sc[j] = MFMA32(a, qf[kk], sc[j]); }
            }
            float m = sink2;
            const LAS float* bt = btab + g * 192 + 160 + r - 4 * hh;
#pragma unroll
            for (int j = 0; j < 5; ++j) {
                const bool tile_ok = (n > 0) || (qt + j >= 4);
#pragma unroll
                for (int i = 0; i < 16; ++i) { const int dist = 128 + r - (32 * j + crow(i, hh));
                    const bool ok = tile_ok && (j == 0 ? dist < 128 : (j == 4 ? dist >= 0 : true));
                    const float s = sc[j][i] * (0.125f * LOG2E) + bt[-(32 * j + (i & 3) + 8 * (i >> 2))];
                    sc[j][i] = ok ? s : -INFINITY; m = fmaxf(m, sc[j][i]); }
            }
            m = max_halves(m);
            float l = 0.f;
#pragma unroll
            for (int j = 0; j < 5; ++j)
#pragma unroll
                for (int i = 0; i < 16; ++i) { sc[j][i] = exp2f(sc[j][i] - m); l += sc[j][i]; }
            l = sum_halves(l);
            l += exp2f(sink2 - m);
            const float inv = 1.f / l;
            f32x16 o[2];
#pragma unroll
            for (int i = 0; i < 16; ++i) { o[0][i] = 0.f; o[1][i] = 0.f; }
#pragma unroll
            for (int j = 0; j < 5; ++j)
#pragma unroll
                for (int sg = 0; sg < 2; ++sg) {
                    const bf16x8 pf = pack8(sc[j], sg);
#pragma unroll
                    for (int dt = 0; dt < 2; ++dt) {
                        const LAS bf16* vb = Vt + (32 * dt + r) * AT_VP + 32 * (qt + j) + 16 * sg + 4 * hh;
                        const s16x4 lo = *(const LAS s16x4*)(vb), hi = *(const LAS s16x4*)(vb + 8);
                        o[dt] = MFMA32(__builtin_shufflevector(lo, hi, 0, 1, 2, 3, 4, 5, 6, 7), pf, o[dt]);
                    }
                }
            bf16* op = CAT + (size_t)t * DM + h * 64 + 4 * hh;
#pragma unroll
            for (int dt = 0; dt < 2; ++dt)
#pragma unroll
                for (int g4 = 0; g4 < 4; ++g4)
                    *(unsigned long long*)(op + 32 * dt + 8 * g4) = (unsigned long long)cvtpk(o[dt][4 * g4] * inv, o[dt][4 * g4 + 1] * inv) | ((unsigned long long)cvtpk(o[dt][4 * g4 + 2] * inv, o[dt][4 * g4 + 3] * inv) << 32);
        }
        __syncthreads();
    }
}
struct Args { Ptrs p; };
__global__ void __launch_bounds__(NWAVES * 64, 2) hymba_fwd(Args args) {
    extern __shared__ __attribute__((aligned(16))) unsigned char lds[];
    const Ptrs& P = args.p;
    Frame F;
    F.lds = (LAS unsigned char*)lds;
    F.MISC = (volatile LAS unsigned*)(F.lds + MISC_OFF);
    F.wave = __builtin_amdgcn_readfirstlane(threadIdx.x >> 6);
    F.G = gridDim.x; { const int bx = blockIdx.x; F.vcu = (F.G % 8 == 0) ? (bx % 8) * (F.G / 8) + bx / 8 : bx; }
    F.ctl = (gu32*)(P.ws + WS_CTL);
    for (int u = threadIdx.x; u < (LDS_BYTES - LDSCTL_OFF) / 4; u += NWAVES * 64) ((LAS unsigned*)(F.lds + LDSCTL_OFF))[u] = 0u;
    __syncthreads();
    XcdBarrier bar = xcd_barrier_post((unsigned*)(F.ctl + CW_BAR), F.MISC + 8);
#define GRID_BAR() xcd_barrier(bar)

    bf16* XN = (bf16*)(P.ws + WS_XN); bf16* PROJ = (bf16*)(P.ws + WS_PROJ); bf16* HB = (bf16*)(P.ws + WS_ST);
    p0_prologue(F, P);
    GRID_BAR();
    { pg8::Gemm g{XN, (const bf16*)(P.ws + WS_WIN), T_, NPROJ, DM, F.wave}; pg8::StaticOrder S; S.init(T_, NPROJ, F.G, (int)blockIdx.x);
      pg8::EpiBf16<0> E{PROJ, NPROJ, nullptr, 0, 0, 1.f};
      pg8::gemm_phase<pg8::EpiBf16<0>, pg8::StaticOrder, PG8_ALIGN, PG8_SP2>(F.lds + RING_OFF, g, S, E); }
    if (F.G == 256 && blockIdx.x >= 64) p1_slack(F, P, ((int)blockIdx.x - 64) * NWAVES + F.wave, 192 * NWAVES);
    else if (F.G != 256) p1_slack(F, P, F.vcu * NWAVES + F.wave, F.G * NWAVES);
    GRID_BAR();
    ssd_s1(F, P);
    xcd_arrive(bar, F.MISC + 14);
    attn_phase(F, P);
    xcd_wait(bar, F.MISC + 14);
    ssd_s2(F, P);
    GRID_BAR();
    ssd_s3(F, P);
    GRID_BAR();
    { pg8::Gemm g{XN, (const bf16*)(P.ws + WS_WOUT), T_, DM, DM, F.wave}; pg8::StaticOrder S; S.init(T_, DM, F.G, (int)blockIdx.x);
      EpiResH E{P.x, HB, (float*)(P.ws + WS_SSQ)};
      pg8::gemm_phase<EpiResH, pg8::StaticOrder, PG8_ALIGN, PG8_SP2>(F.lds + RING_OFF, g, S, E); }
    GRID_BAR();
    { pg8::Gemm g{HB, (const bf16*)(P.ws + WS_WQ), T_, 2048, DM, F.wave}; pg8::StaticOrder S; S.init(T_, 2048, F.G, (int)blockIdx.x);
      EpiQTopk E{P.ws + WS_KEYB, (const float*)(P.ws + WS_SSQ), (int*)(P.ws + WS_IDX), (float*)(P.ws + WS_GATE)};
#pragma unroll 1
      for (int ui = 0; ui < 64; ++ui) { pg8::Unit u0; if (!S.next(ui, u0)) break;
          OneUnit S1{S, ui};
          pg8::gemm_phase<EpiQTopk, OneUnit, PG8_ALIGN, PG8_SP2>(F.lds + RING_OFF, g, S1, E); } }
    h_quant_rows(F, P);
    GRID_BAR();
    { const PeerPlace pp = peer_place(F);
      peer_down(F, P, pp); }
    GRID_BAR();
    peer_up_tm(F, P);
}

extern "C" void kernel_launch(void* const* d_in, const int* in_sizes, int n_in, void* d_out, int out_size, void* d_ws, size_t ws_size, hipStream_t stream) {
    static int grid = 0;
    if (grid == 0) {
        if (n_in != 19 || out_size != T_ * DM || ws_size < WS_END) { fprintf(stderr, "kernel_launch: unexpected shapes (n_in %d, out %d, ws %zu)\n", n_in, out_size, ws_size); grid = -1; return; }
        int dev = 0, cus = 0, per_cu = 0;
        if (hipGetDevice(&dev) != hipSuccess || hipDeviceGetAttribute(&cus, hipDeviceAttributeMultiprocessorCount, dev) != hipSuccess) { grid = -1; return; }
        if (hipFuncSetAttribute((const void*)hymba_fwd, hipFuncAttributeMaxDynamicSharedMemorySize, LDS_BYTES) != hipSuccess) { fprintf(stderr, "kernel_launch: hipFuncSetAttribute failed\n"); grid = -1; return; }
        if (hipOccupancyMaxActiveBlocksPerMultiprocessor(&per_cu, (const void*)hymba_fwd, NWAVES * 64, LDS_BYTES) != hipSuccess || per_cu < 1) { fprintf(stderr, "kernel_launch: occupancy query says %d blocks per CU\n", per_cu); grid = -1; (void)hipGetLastError(); return; }
        grid = cus;
    }
    if (grid < 0) return;
    (void)hipMemsetAsync((char*)d_ws + WS_CTL, 0, CTL_ZERO_BYTES, stream);
    Args a{};
    const float** pp = (const float**)&a.p;
    for (int i = 0; i < 19; ++i) pp[i] = (const float*)d_in[i];
    a.p.out = (float*)d_out; a.p.ws = (unsigned char*)d_ws;
    hipLaunchKernelGGL(hymba_fwd, dim3(grid), dim3(NWAVES * 64), LDS_BYTES, stream, a);
}
```

```cpp
#include <hip/hip_runtime.h>
#include <cstdio>
#include <cstdint>
#include <math.h>
namespace pg8 {
#define PG8_LAS __attribute__((address_space(3)))
typedef unsigned short bf16_t;
typedef short bf16x8 __attribute__((ext_vector_type(8)));
typedef float f32x4 __attribute__((ext_vector_type(4)));
typedef unsigned u32x4 __attribute__((ext_vector_type(4)));
constexpr int BM = 256, BK = 64, HALF = 128, HTB = HALF * BK * 2  , STAGE_BYTES = 8 * HTB, NXCD = 8, WGM = 8;

__host__ __device__ __forceinline__ int lds_byte(int r, int c) { const int st = (r >> 4) * 2 + (c >> 5), rr = r & 15, cc = c & 31, ob = rr * 64 + cc * 2; return st * 1024 + (ob ^ (((ob >> 9) & 1) << 5)); }
__host__ __device__ __forceinline__ void stage_rc(int b, int& R, int& C) { const int st = b / 1024, sb = b % 1024, swz = sb ^ (((sb >> 9) & 1) << 5); R = (st >> 1) * 16 + swz / 64; C = (st & 1) * 32 + (swz % 64) / 2; }
__host__ __device__ __forceinline__ int perm32(int rho) { const int n = rho >> 4, i = rho & 15; return 8 * (i >> 2) + 4 * n + (i & 3); }

struct Unit { int pm, pn; };
struct Gemm { const bf16_t* A; const bf16_t* Bt; int M, N, K, wave; };

struct StaticOrder {
    int nM, nN, nwg, G, c;
    __host__ __device__ void init(int M, int N, int G_, int c_) { nM = M / BM; nN = N / BM; nwg = nM * nN; G = G_; c = c_; }
    __host__ __device__ bool next(int i, Unit& u) const {
        const long L = (long)i * G + c; if (L >= nwg) return false;
        int wgid = (int)L; { const int q = nwg / NXCD, r = nwg % NXCD, xcd = wgid % NXCD, off = wgid / NXCD; wgid = (xcd < r ? xcd * (q + 1) : r * (q + 1) + (xcd - r) * q) + off; }
        const int nig = WGM * nN, gid = wgid / nig, fm = gid * WGM, gsz = (nM - fm) < WGM ? (nM - fm) : WGM;
        u.pm = fm + ((wgid % nig) % gsz); u.pn = (wgid % nig) / gsz; return true;
    }
    __device__ __forceinline__ void a_ready(const Unit&) const {}
    __device__ __forceinline__ void done(const Unit&) const {}
};

__device__ __forceinline__ unsigned cvt_pk_bf16(float lo, float hi) { unsigned r; asm volatile("v_cvt_pk_bf16_f32 %0, %1, %2" : "=v"(r) : "v"(lo), "v"(hi)); return r; }
typedef float f32x2 __attribute__((ext_vector_type(2)));
__device__ __forceinline__ f32x2 gelu_pk(f32x2 v) {
    const f32x2 av = __builtin_elementwise_abs(v), d = av * 0.2316418882f + 1.0f;
    f32x2 t; t.x = __builtin_amdgcn_rcpf(d.x); t.y = __builtin_amdgcn_rcpf(d.y);
    f32x2 q = t * 0.5307027145f + (-0.7265760135f); q = q * t + 0.7107068705f; q = q * t + (-0.142248368f); q = q * t + 0.127414796f; q = q * t;
    const f32x2 s = (v * v) * (-0.72134752044f);
    f32x2 e; e.x = __builtin_amdgcn_exp2f(s.x); e.y = __builtin_amdgcn_exp2f(s.y);
    const f32x2 m = v * (q * e), r = v - m;
    f32x2 o; o.x = v.x < 0.f ? m.x : r.x; o.y = v.y < 0.f ? m.y : r.y; return o;
}

template <int ACT  > struct EpiBf16 {
    static constexpr bool PERM = true, AFTER_DRAIN = false; static_assert(ACT == 0 || ACT == 1, "EpiBf16: ACT is 0 (none) or 1 (gelu_pk)");
    bf16_t* O; int ldc; const float* bias; int split_cols; size_t split_stride; float scale0;
    __device__ __forceinline__ void operator()(const f32x4 (&acc)[2][2][4][2], const Unit& u, int wr, int wc, int fr, int fq) const {
        const int row0 = u.pm * BM + wr * 64 + fr; int colt = u.pn * BM; bf16_t* base = O;
        float sc = 1.f; if (split_cols) { const int t = colt / split_cols; base += (size_t)t * split_stride; colt -= t * split_cols; if (t == 0) sc = scale0; }
        const int col0 = colt + wc * 32 + 8 * fq, bcol0 = u.pn * BM + wc * 32 + 8 * fq;
        f32x4 bv[2][2];
#pragma unroll
        for (int bj = 0; bj < 2; ++bj)
#pragma unroll
            for (int n = 0; n < 2; ++n) bv[bj][n] = bias ? *(const f32x4*)(bias + bcol0 + bj * HALF + 4 * n) : (f32x4){0.f, 0.f, 0.f, 0.f};
#pragma unroll
        for (int ai = 0; ai < 2; ++ai)
#pragma unroll
            for (int m = 0; m < 4; ++m) { bf16_t* rowp = base + (size_t)(row0 + ai * HALF + m * 16) * ldc + col0;
#pragma unroll
                for (int bj = 0; bj < 2; ++bj) { f32x4 v0 = acc[ai][bj][m][0] + bv[bj][0], v1 = acc[ai][bj][m][1] + bv[bj][1];
                    if (ACT == 1) { f32x2 a = gelu_pk((f32x2){v0[0], v0[1]}), b = gelu_pk((f32x2){v0[2], v0[3]}), c = gelu_pk((f32x2){v1[0], v1[1]}), d = gelu_pk((f32x2){v1[2], v1[3]});
                        v0 = (f32x4){a.x, a.y, b.x, b.y}; v1 = (f32x4){c.x, c.y, d.x, d.y}; }
                    v0 = v0 * sc; v1 = v1 * sc; u32x4 w; w.x = cvt_pk_bf16(v0[0], v0[1]); w.y = cvt_pk_bf16(v0[2], v0[3]); w.z = cvt_pk_bf16(v1[0], v1[1]); w.w = cvt_pk_bf16(v1[2], v1[3]);
                    *(u32x4*)(rowp + bj * HALF) = w; } }
    }
};
template <class Epi, class Sched, bool ALIGN_EPI = false, bool SP2 = false>
__device__ __forceinline__ void gemm_phase(PG8_LAS unsigned char* lds, const Gemm g, const Sched& S, const Epi& E) {
    int lane_l; asm volatile("v_mbcnt_lo_u32_b32 %0, -1, 0\n\tv_mbcnt_hi_u32_b32 %0, -1, %0" : "=v"(lane_l));
    const int wid = g.wave, lane = lane_l, tid = wid * 64 + lane,
              wr = wid >> 2, wc = wid & 3, fr = lane & 15, fq = lane >> 4;
    const int K = g.K, nt = K / BK;
    unsigned voffA[2], voffB[2];
#pragma unroll
    for (int i = 0; i < 2; ++i) { int R, C; stage_rc(tid * 16 + i * 8192, R, C); const int Rb = Epi::PERM ? ((R & ~31) + perm32(R & 31)) : R;
        voffA[i] = (unsigned)(R * K + C) * 2u; voffB[i] = (unsigned)(Rb * K + C) * 2u; }
    const size_t kstep = (size_t)(BK * 2);
    const size_t hstep = (size_t)HALF * K * 2;
    const size_t tstep = 2 * hstep;
    const unsigned ldsw = (unsigned)wid * 1024u;
    const int aoff = lds_byte(wr * 64 + fr, fq * 8), boff = lds_byte(wc * 32 + fr, fq * 8);
#define PG8_SA(b, h) (((b) * 2 + (h)) * HTB)
#define PG8_SB(b, h) ((4 + (b) * 2 + (h)) * HTB)
#define PG8_STAGE(bufoff, gbase, voff) do { _Pragma("unroll") for (int _i = 0; _i < 2; ++_i) \
        __builtin_amdgcn_global_load_lds((const unsigned*)((const char*)(gbase) + (voff)[_i]), (PG8_LAS unsigned*)(lds + (bufoff) + ldsw + _i * 8192), 16, 0, 0); } while (0)
#define PG8_LDA(dst, b, h) do { _Pragma("unroll") for (int m = 0; m < 4; ++m) _Pragma("unroll") for (int k = 0; k < 2; ++k) dst[m][k] = *(const PG8_LAS bf16x8*)(lds + PG8_SA(b, h) + aoff + m * 2048 + k * 1024); } while (0)
#define PG8_LDB(dst, b, h) do { _Pragma("unroll") for (int n = 0; n < 2; ++n) _Pragma("unroll") for (int k = 0; k < 2; ++k) dst[n][k] = *(const PG8_LAS bf16x8*)(lds + PG8_SB(b, h) + boff + n * 2048 + k * 1024); } while (0)
#define PG8_MMA(ai, bj, At, Bt) do { __builtin_amdgcn_s_setprio(1); _Pragma("unroll") for (int m = 0; m < 4; ++m) _Pragma("unroll") for (int n = 0; n < 2; ++n) _Pragma("unroll") for (int k = 0; k < 2; ++k) \
        acc[ai][bj][m][n] = __builtin_amdgcn_mfma_f32_16x16x32_bf16(Bt[n][k], At[m][k], acc[ai][bj][m][n], 0, 0, 0); __builtin_amdgcn_s_setprio(0); } while (0)
#define PG8_WAIT_V(n) asm volatile("s_waitcnt vmcnt(" #n ")" ::: "memory")
#define PG8_WAIT_L(n) asm volatile("s_waitcnt lgkmcnt(" #n ")" ::: "memory")
#define PG8_BAR __builtin_amdgcn_s_barrier()
#define PG8_SCHED __builtin_amdgcn_sched_barrier(0)
    Unit cur, nxt; int ui = 0;
    if (!S.next(0, cur)) return;
    f32x4 acc[2][2][4][2];
#pragma unroll
    for (int a = 0; a < 2; ++a)
#pragma unroll
        for (int b = 0; b < 2; ++b)
#pragma unroll
            for (int m = 0; m < 4; ++m)
#pragma unroll
                for (int n = 0; n < 2; ++n) acc[a][b][m][n] = (f32x4){0.f, 0.f, 0.f, 0.f};
    bf16x8 At[4][2], B0[2][2], B1[2][2];
    const char* cA = (const char*)g.A + (size_t)cur.pm * tstep; const char* cB = (const char*)g.Bt + (size_t)cur.pn * tstep;
    S.a_ready(cur);
    if constexpr (SP2) {
        PG8_STAGE(PG8_SB(0, 0), cB, voffB); PG8_STAGE(PG8_SB(0, 1), cB + hstep, voffB); PG8_STAGE(PG8_SA(0, 0), cA, voffA); PG8_STAGE(PG8_SA(0, 1), cA + hstep, voffA);
        if (wr == 1) PG8_BAR;
        PG8_WAIT_V(2); PG8_BAR;
        PG8_STAGE(PG8_SB(1, 0), cB + kstep, voffB); PG8_STAGE(PG8_SA(1, 0), cA + kstep, voffA); PG8_STAGE(PG8_SB(1, 1), cB + hstep + kstep, voffB);
        PG8_WAIT_V(6); PG8_BAR;
    } else {
        PG8_STAGE(PG8_SB(0, 0), cB, voffB); PG8_STAGE(PG8_SA(0, 0), cA, voffA); PG8_STAGE(PG8_SB(0, 1), cB + hstep, voffB); PG8_STAGE(PG8_SA(0, 1), cA + hstep, voffA);
        if (wr == 1) PG8_BAR;
        PG8_WAIT_V(4); PG8_BAR;
        PG8_STAGE(PG8_SB(1, 0), cB + kstep, voffB); PG8_STAGE(PG8_SA(1, 0), cA + kstep, voffA); PG8_STAGE(PG8_SB(1, 1), cB + hstep + kstep, voffB);
        PG8_WAIT_V(6); PG8_BAR;
    }
    for (;;) {
        const bool has_next = S.next(ui + 1, nxt);
        const char* nA = has_next ? (const char*)g.A + (size_t)nxt.pm * tstep : cA; const char* nB = has_next ? (const char*)g.Bt + (size_t)nxt.pn * tstep : cB;
        for (int t = 0; t < nt; t += 2) {
            const bool last = (t == nt - 2);
            const char* a1 = cA + (size_t)(t + 1) * kstep;
            const char* a2 = last ? nA : cA + (size_t)(t + 2) * kstep; const char* b2 = last ? nB : cB + (size_t)(t + 2) * kstep;
            const char* a3 = a2 + kstep; const char* b3 = b2 + kstep;
            if (last && has_next) S.a_ready(nxt);
            if constexpr (SP2) {
            PG8_LDB(B0, 0, 0); PG8_LDB(B1, 0, 1); PG8_SCHED; PG8_LDA(At, 0, 0); PG8_STAGE(PG8_SA(1, 1), a1 + hstep, voffA);
            PG8_WAIT_V(8); PG8_WAIT_L(0); PG8_BAR; PG8_MMA(0, 0, At, B0); PG8_MMA(0, 1, At, B1); PG8_BAR; PG8_SCHED;
            PG8_LDA(At, 0, 1); PG8_STAGE(PG8_SB(0, 0), b2, voffB); PG8_STAGE(PG8_SB(0, 1), b2 + hstep, voffB); PG8_STAGE(PG8_SA(0, 0), a2, voffA);
            PG8_WAIT_V(8); PG8_WAIT_L(0); PG8_BAR; PG8_MMA(1, 0, At, B0); PG8_MMA(1, 1, At, B1); PG8_BAR; PG8_SCHED;
            PG8_LDB(B0, 1, 0); PG8_LDB(B1, 1, 1); PG8_SCHED; PG8_LDA(At, 1, 0); PG8_STAGE(PG8_SA(0, 1), a2 + hstep, voffA);
            PG8_WAIT_V(8); PG8_WAIT_L(0); PG8_BAR; PG8_MMA(0, 0, At, B0); PG8_MMA(0, 1, At, B1); PG8_BAR; PG8_SCHED;
            PG8_LDA(At, 1, 1); PG8_STAGE(PG8_SB(1, 0), b3, voffB); PG8_STAGE(PG8_SB(1, 1), b3 + hstep, voffB); PG8_STAGE(PG8_SA(1, 0), a3, voffA);
            PG8_WAIT_V(8); PG8_WAIT_L(0); PG8_BAR; PG8_MMA(1, 0, At, B0); PG8_MMA(1, 1, At, B1); PG8_BAR; PG8_SCHED;
            } else {
            PG8_LDB(B0, 0, 0); PG8_SCHED; PG8_LDA(At, 0, 0); PG8_STAGE(PG8_SA(1, 1), a1 + hstep, voffA);
            PG8_WAIT_L(8); PG8_BAR; PG8_WAIT_L(0); PG8_MMA(0, 0, At, B0); PG8_BAR; PG8_SCHED;
            PG8_LDB(B1, 0, 1); PG8_STAGE(PG8_SB(0, 0), b2, voffB);
            PG8_BAR; PG8_WAIT_L(0); PG8_MMA(0, 1, At, B1); PG8_BAR;
            PG8_LDA(At, 0, 1); PG8_STAGE(PG8_SA(0, 0), a2, voffA);
            PG8_BAR; PG8_WAIT_L(0); PG8_MMA(1, 0, At, B0); PG8_BAR; PG8_SCHED;
            PG8_STAGE(PG8_SB(0, 1), b2 + hstep, voffB);
            PG8_WAIT_V(6); PG8_BAR; PG8_MMA(1, 1, At, B1); PG8_BAR;
            PG8_LDB(B0, 1, 0); PG8_SCHED; PG8_LDA(At, 1, 0); PG8_STAGE(PG8_SA(0, 1), a2 + hstep, voffA);
            PG8_WAIT_L(8); PG8_BAR; PG8_WAIT_L(0); PG8_MMA(0, 0, At, B0); PG8_BAR; PG8_SCHED;
            PG8_LDB(B1, 1, 1); PG8_STAGE(PG8_SB(1, 0), b3, voffB);
            PG8_BAR; PG8_WAIT_L(0); PG8_MMA(0, 1, At, B1); PG8_BAR;
            PG8_LDA(At, 1, 1); PG8_STAGE(PG8_SA(1, 0), a3, voffA);
            PG8_BAR; PG8_WAIT_L(0); PG8_MMA(1, 0, At, B0); PG8_BAR; PG8_SCHED;
            PG8_STAGE(PG8_SB(1, 1), b3 + hstep, voffB);
            PG8_WAIT_V(6); PG8_BAR; PG8_MMA(1, 1, At, B1); PG8_BAR;
            }
        }
        if constexpr (ALIGN_EPI) { if (wr == 0) PG8_BAR; }
        if constexpr (!Epi::AFTER_DRAIN) { E(acc, cur, wr, wc, fr, fq); S.done(cur); }
        if (!has_next) break;
#pragma unroll
        for (int a = 0; a < 2; ++a)
#pragma unroll
            for (int b = 0; b < 2; ++b)
#pragma unroll
                for (int m = 0; m < 4; ++m)
#pragma unroll
                    for (int n = 0; n < 2; ++n) acc[a][b][m][n] = (f32x4){0.f, 0.f, 0.f, 0.f};
        cur = nxt; cA = nA; cB = nB; ++ui;
        if constexpr (ALIGN_EPI) { if (wr == 1) PG8_BAR; }
    }
    PG8_WAIT_V(0);
    if constexpr (!ALIGN_EPI) { if (wr == 0) PG8_BAR; }
    PG8_BAR;
    if constexpr (Epi::AFTER_DRAIN) { E.fused(acc, cur, wr, wc, fr, fq, lds, wid, lane); S.done(cur); }
#undef PG8_SA
#undef PG8_SB
#undef PG8_STAGE
#undef PG8_LDA
#undef PG8_LDB
#undef PG8_MMA
#undef PG8_WAIT_V
#undef PG8_WAIT_L
#undef PG8_BAR
#undef PG8_SCHED
}
}

#ifndef PG8_SP2
#define PG8_SP2 true
#endif
#ifndef PG8_ALIGN
#define PG8_ALIGN true
#endif
#define GAS __attribute__((address_space(1)))
#define LAS __attribute__((address_space(3)))
typedef unsigned short bf16;
typedef unsigned v4u __attribute__((ext_vector_type(4)));
typedef float f32x4 __attribute__((ext_vector_type(4)));
typedef short bf16x8 __attribute__((ext_vector_type(8)));
typedef GAS unsigned gu32;
typedef GAS unsigned long long gu64;
#define RLX_AGENT __ATOMIC_RELAXED, __HIP_MEMORY_SCOPE_AGENT
#define LDS_WAIT() asm volatile("s_waitcnt lgkmcnt(0)" ::: "memory")
#define VM_WAIT() asm volatile("s_waitcnt vmcnt(0)" ::: "memory")
__device__ __forceinline__ unsigned long long rt() { return __builtin_amdgcn_s_memrealtime(); }
__device__ __forceinline__ unsigned f2bf(float f) { unsigned u = __builtin_bit_cast(unsigned, f); return (u + 0x7fffu + ((u >> 16) & 1u)) >> 16; }
__device__ __forceinline__ unsigned pk2(float lo, float hi) { return f2bf(lo) | (f2bf(hi) << 16); }

#define XB_TMO      128
#define XB_XCNT(j)  (256  + 64 * (j))
#define XB_XSUB(j)  (1280 + 64 * (j))
#define XB_XGEN(j)  (2304 + 64 * (j))
#define XB_TOP      3328
#define XB_TOPGEN   3392
#define XCD_BAR_WORDS 3456
#define XB_SPIN_CAP (1u << 22)

__device__ __forceinline__ unsigned xb_ld(unsigned* p)              { return __hip_atomic_load(p, __ATOMIC_RELAXED, __HIP_MEMORY_SCOPE_AGENT); }
__device__ __forceinline__ unsigned xb_add(unsigned* p, unsigned v) { return __hip_atomic_fetch_add(p, v, __ATOMIC_RELAXED, __HIP_MEMORY_SCOPE_AGENT); }
__device__ __forceinline__ unsigned xb_xcc_id() { return (unsigned)__builtin_amdgcn_s_getreg((3 << 11) | 20) & 0xFu; }
#define XB_SPIN(cond, bar) do { unsigned _sp = 0; while (cond) { __builtin_amdgcn_s_sleep(1); \
    if ((++_sp & 255u) == 0u) { if (xb_ld(&(bar)[XB_TMO])) break; if (_sp > XB_SPIN_CAP) { atomicAdd(&(bar)[XB_TMO], 1u); break; } } } } while (0)

struct XcdBarrier {
    unsigned* bar; unsigned x;
    volatile LAS unsigned* st;
};

__device__ __forceinline__ XcdBarrier xcd_barrier_post(unsigned* bar, volatile LAS unsigned* st) {
    XcdBarrier b; b.bar = bar; b.x = xb_xcc_id(); b.st = st;
    if (threadIdx.x == 0) (void)xb_add(&bar[XB_XCNT(b.x)], 1u);
    return b;
}
__device__ __forceinline__ void xcd_barrier_complete(unsigned* bar, unsigned x, unsigned& nloc, unsigned& nx) {
    const unsigned G = gridDim.x * gridDim.y * gridDim.z;
    unsigned sum, cnt, mine, sp = 0u;
    for (;;) {
        sum = 0u; cnt = 0u; mine = 0u;
#pragma unroll
        for (unsigned j = 0; j < 16; ++j) { const unsigned c = xb_ld(&bar[XB_XCNT(j)]); sum += c; cnt += (c > 0u) ? 1u : 0u; mine = (j == x) ? c : mine; }
        if (sum == G) break;
        __builtin_amdgcn_s_sleep(1);
        if ((++sp & 255u) == 0u) { if (xb_ld(&bar[XB_TMO])) break; if (sp > XB_SPIN_CAP) { atomicAdd(&bar[XB_TMO], 1u); break; } }
    }
    nloc = mine > 0u ? mine : 1u; nx = cnt > 0u ? cnt : 1u;
}

__device__ __forceinline__ void xcd_barrier(const XcdBarrier& b) {
    asm volatile("s_waitcnt vmcnt(0)" ::: "memory");
    __syncthreads();
    if (threadIdx.x == 0) {
        unsigned* bar = b.bar;
        __builtin_amdgcn_s_waitcnt(0);
        unsigned nloc = b.st[0], nx = b.st[1];
        if (nloc == 0u) { xcd_barrier_complete(bar, b.x, nloc, nx); b.st[0] = nloc; b.st[1] = nx; }
        const unsigned old = xb_add(&bar[XB_XSUB(b.x)], 1u);
        const unsigned gen = old / nloc;
        if (old + 1u == (gen + 1u) * nloc) {
            __builtin_amdgcn_fence(__ATOMIC_RELEASE, "agent");
            asm volatile("s_waitcnt vmcnt(0)" ::: "memory");
            const unsigned og = xb_add(&bar[XB_TOP], 1u);
            const unsigned tg = og / nx;
            if (og + 1u == (tg + 1u) * nx) xb_add(&bar[XB_TOPGEN], 1u);
            else XB_SPIN(xb_ld(&bar[XB_TOPGEN]) == tg, bar);
            __builtin_amdgcn_fence(__ATOMIC_ACQUIRE, "agent");
            xb_add(&bar[XB_XGEN(b.x)], 1u);
            asm volatile("s_waitcnt vmcnt(0)" ::: "memory");
        } else {
            XB_SPIN(xb_ld(&bar[XB_XGEN(b.x)]) == gen, bar);
            __builtin_amdgcn_fence(__ATOMIC_ACQUIRE, "agent");
            asm volatile("s_waitcnt vmcnt(0)" ::: "memory");
        }
    }
    __syncthreads();
}

__device__ __forceinline__ void xcd_arrive(const XcdBarrier& b, volatile LAS unsigned* sx) {
    asm volatile("s_waitcnt vmcnt(0)" ::: "memory");
    __syncthreads();
    if (threadIdx.x == 0) {
        unsigned* bar = b.bar;
        __builtin_amdgcn_s_waitcnt(0);
        unsigned nloc = b.st[0], nx = b.st[1];
        if (nloc == 0u) { xcd_barrier_complete(bar, b.x, nloc, nx); b.st[0] = nloc; b.st[1] = nx; }
        const unsigned old = xb_add(&bar[XB_XSUB(b.x)], 1u);
        const unsigned gen = old / nloc;
        unsigned leader = 0u, key = gen;
        if (old + 1u == (gen + 1u) * nloc) {
            leader = 1u;
            __builtin_amdgcn_fence(__ATOMIC_RELEASE, "agent");
            asm volatile("s_waitcnt vmcnt(0)" ::: "memory");
            const unsigned og = xb_add(&bar[XB_TOP], 1u);
            const unsigned tg = og / nx; key = tg;
            if (og + 1u == (tg + 1u) * nx) xb_add(&bar[XB_TOPGEN], 1u);
        }
        sx[0] = leader; sx[1] = key;
    }
}
__device__ __forceinline__ void xcd_wait(const XcdBarrier& b, volatile LAS unsigned* sx) {
    if (threadIdx.x == 0) {
        unsigned* bar = b.bar;
        const unsigned leader = sx[0], key = sx[1];
        if (leader) {
            XB_SPIN(xb_ld(&bar[XB_TOPGEN]) == key, bar);
            __builtin_amdgcn_fence(__ATOMIC_ACQUIRE, "agent");
            xb_add(&bar[XB_XGEN(b.x)], 1u);
            asm volatile("s_waitcnt vmcnt(0)" ::: "memory");
        } else {
            XB_SPIN(xb_ld(&bar[XB_XGEN(b.x)]) == key, bar);
            __builtin_amdgcn_fence(__ATOMIC_ACQUIRE, "agent");
            asm volatile("s_waitcnt vmcnt(0)" ::: "memory");
        }
    }
    __syncthreads();
}

constexpr int NWAVES = 8;
constexpr int T_ = 16384, SEQ = 4096, DM = 1024, NPROJ = 2304, INC = 2312;
constexpr int PJ_K = 512, PJ_V = 640, PJ_Z = 768, PJ_XBC = 1280;
constexpr float EPS = 1e-6f;
constexpr size_t MiB = 1u << 20;
constexpr size_t WS_CTL = 0, CTL_ZERO_BYTES = 1 * MiB;
constexpr size_t WS_KEYB = 1 * MiB + 256 * 1024;
constexpr size_t WS_BTAB = 1 * MiB + 384 * 1024;
constexpr size_t WS_SMALL = 1 * MiB;
constexpr size_t WS_WIN = 2 * MiB, WS_WOUT = 7 * MiB, WS_WQ = 9 * MiB;
constexpr size_t WS_ED = 13 * MiB, WS_EU = 29 * MiB;
constexpr size_t WS_XN = 77 * MiB;
constexpr size_t WS_PROJ = 109 * MiB;
constexpr size_t WS_ST = 181 * MiB;
constexpr size_t WS_IDX = 213 * MiB, WS_GATE = 221 * MiB, WS_SSQ = 229 * MiB, WS_END = 230 * MiB;
constexpr size_t DO_Y = 0, DO_DT = 41 * MiB;
constexpr size_t WS_CC = 230 * MiB, WS_DT = 238 * MiB, WS_EA = 239 * MiB, WS_CDEC = 240 * MiB, WS_PREV = WS_IDX;
constexpr size_t DO_YPF = 0, DO_YPLAIN = 32 * MiB;
constexpr size_t WS_PART = WS_PROJ;
constexpr size_t WS_H8 = WS_XN, WS_HS = WS_DT;
constexpr size_t WS_SSQ2 = WS_EA;
constexpr int CW_BAR = 4096, CW_RANK = 8192;
constexpr int RING_OFF = 0, RING_BYTES = 147456, LDSCTL_OFF = RING_BYTES, MISC_OFF = LDSCTL_OFF + 320, LDS_BYTES = 163840;

__constant__ unsigned char c_bucket[128] = {0, 1, 2, 3, 4, 5, 6, 7, 8, 9, 10, 11, 12, 13, 14, 15, 16, 16, 16, 17, 17, 18, 18, 18, 19, 19, 19, 20, 20, 20, 20, 21, 21, 21, 21, 22, 22, 22, 22, 22, 23, 23, 23, 23, 23, 23, 24, 24, 24, 24, 24, 24, 25, 25, 25, 25, 25, 25, 25, 26, 26, 26, 26, 26, 26, 26, 26, 27, 27, 27, 27, 27, 27, 27, 27, 27, 27, 28, 28, 28, 28, 28, 28, 28, 28, 28, 28, 29, 29, 29, 29, 29, 29, 29, 29, 29, 29, 29, 29, 30, 30, 30, 30, 30, 30, 30, 30, 30, 30, 30, 30, 30, 30, 31, 31, 31, 31, 31, 31, 31, 31, 31, 31, 31, 31, 31, 31, 31};

typedef float v16f __attribute__((ext_vector_type(16)));
typedef float v32f __attribute__((ext_vector_type(32)));
typedef unsigned v6u __attribute__((ext_vector_type(6)));
typedef _Float16 v32h __attribute__((ext_vector_type(32)));
struct Frame {
    LAS unsigned char* lds;
    volatile LAS unsigned* MISC;
    gu32* ctl;
    int wave, vcu, G;
};
__device__ __forceinline__ int lane_id() { int l; asm volatile("v_mbcnt_lo_u32_b32 %0, -1, 0\n\tv_mbcnt_hi_u32_b32 %0, -1, %0" : "=v"(l)); return l; }
__device__ __forceinline__ int opq(int x) { asm volatile("" : "+v"(x)); return x; }
template <int M> __device__ __forceinline__ float swz_xor(float v) { return __int_as_float(__builtin_amdgcn_ds_swizzle(__float_as_int(v), (M << 10) | 0x1F)); }
__device__ __forceinline__ float sum_halves(float v) { const auto r = __builtin_amdgcn_permlane32_swap(__float_as_uint(v), __float_as_uint(v), false, false); return __uint_as_float(r[0]) + __uint_as_float(r[1]); }
__device__ __forceinline__ float max_halves(float v) { const auto r = __builtin_amdgcn_permlane32_swap(__float_as_uint(v), __float_as_uint(v), false, false); return fmaxf(__uint_as_float(r[0]), __uint_as_float(r[1])); }
__device__ __forceinline__ int imax_halves(int v) { const auto r = __builtin_amdgcn_permlane32_swap((unsigned)v, (unsigned)v, false, false); return max((int)r[0], (int)r[1]); }
__device__ __forceinline__ float wave_sum(float v) {
    v += swz_xor<1>(v); v += swz_xor<2>(v); v += swz_xor<4>(v); v += swz_xor<8>(v); v += swz_xor<16>(v);
    return sum_halves(v);
}
__device__ __forceinline__ float bf2f(unsigned short b) { return __uint_as_float((unsigned)b << 16); }
__device__ __forceinline__ float bflo(unsigned w) { return __uint_as_float(w << 16); }
__device__ __forceinline__ float bfhi(unsigned w) { return __uint_as_float(w & 0xffff0000u); }
__device__ __forceinline__ float silu_f(float x) { return x / (1.f + __expf(-x)); }

__device__ __forceinline__ void p0_transpose_item(const float* W, int ldw, int K, int nblk, bf16* WT, const float* kscale, LAS float* scr, int item, int lane) {
    const int kb = item / nblk, nb = item % nblk, k0 = 64 * kb, n0 = 32 * nb;
    float ks_[32];
#pragma unroll
    for (int i = 0; i < 32; ++i) ks_[i] = kscale ? kscale[k0 + 2 * i + (lane >> 5)] : 1.f;
    float vv_[32];
#pragma unroll
    for (int i = 0; i < 32; ++i) vv_[i] = W[(size_t)(k0 + 2 * i + (lane >> 5)) * ldw + n0 + (lane & 31)];
#pragma unroll
    for (int i = 0; i < 32; ++i) scr[(2 * i + (lane >> 5)) * 33 + (lane & 31)] = vv_[i] * ks_[i];
#pragma unroll 1
    for (int i = 32; i < 32; ++i) { const int kk = 2 * i + (lane >> 5); float v = W[(size_t)(k0 + kk) * ldw + n0 + (lane & 31)]; if (kscale) v *= kscale[k0 + kk]; scr[kk * 33 + (lane & 31)] = v; }
    LDS_WAIT(); asm volatile("" ::: "memory");
    const int c = lane & 7;
#pragma unroll
    for (int j = 0; j < 4; ++j) { const int n = (lane >> 3) + 8 * j; const LAS float* s = scr + (8 * c) * 33 + n;
        v4u o; o.x = pk2(s[0 * 33], s[1 * 33]); o.y = pk2(s[2 * 33], s[3 * 33]); o.z = pk2(s[4 * 33], s[5 * 33]); o.w = pk2(s[6 * 33], s[7 * 33]);
        *(GAS v4u*)(WT + (size_t)(n0 + n) * K + k0 + 8 * c) = o; }
    LDS_WAIT(); asm volatile("" ::: "memory");
}
struct Ptrs {
    const float *x, *norm_mix, *w_in, *conv_w, *conv_b, *dt_bias, *a_log, *d_skip, *ssd_norm_w, *sinks, *w_out, *rel_bias, *norm_ffn, *w_query, *sk1, *sk2, *e_down, *e_up, *norm_final;
    float* out; unsigned char* ws;
};
constexpr int Q_SPLIT = 0;
__device__ __forceinline__ unsigned pack4_i8(float a, float b, float c, float d) {
    const int ia = __float2int_rn(a), ib = __float2int_rn(b), ic = __float2int_rn(c), id = __float2int_rn(d);
    return (unsigned)(ia & 0xff) | ((unsigned)(ib & 0xff) << 8) | ((unsigned)(ic & 0xff) << 16) | ((unsigned)(id & 0xff) << 24);
}
__device__ __forceinline__ unsigned pack8_i4(const float* v, float inv) {
    unsigned o = 0u;
#pragma unroll
    for (int i = 0; i < 8; ++i) { int q = __float2int_rn(v[i] * inv); q = q < -7 ? -7 : (q > 7 ? 7 : q); o |= ((unsigned)q & 15u) << (4 * i); }
    return o;
}
__device__ __forceinline__ void quant_fp8s(const Ptrs& P, int lane_, int r_lo, int r_hi, int w, int nw) {
    float* SC = (float*)(P.ws + WS_SMALL);
    int row = r_lo + w;
    if (row >= r_hi) return;
    float4 nx[4];
#pragma unroll
    for (int q = 0; q < 4; ++q) nx[q] = ((const float4*)(P.e_down + (size_t)(row & 16383) * DM) + 4 * lane_)[q];
    float4 w4[4];
#pragma unroll
    for (int q = 0; q < 4; ++q) w4[q] = ((const float4*)P.norm_ffn)[4 * lane_ + q];
    for (; row < r_hi; row += nw) {
        const int e = row & 16383;
        float v[16];
#pragma unroll
        for (int q = 0; q < 4; ++q) { const float4 t = nx[q]; v[4 * q] = t.x * w4[q].x; v[4 * q + 1] = t.y * w4[q].y; v[4 * q + 2] = t.z * w4[q].z; v[4 * q + 3] = t.w * w4[q].w; }
        { const int rn = (row + nw < r_hi) ? row + nw : row;
#pragma unroll
          for (int q = 0; q < 4; ++q) nx[q] = ((const float4*)(P.e_down + (size_t)(rn & 16383) * DM) + 4 * lane_)[q]; }
        float ss = 0.f;
#pragma unroll
        for (int q = 0; q < 16; ++q) ss = fmaf(v[q], v[q], ss);
        const float sc = fmaxf(2.5f * sqrtf(wave_sum(ss) * (1.f / 1024.f)) * (1.f / 7.f), 1e-30f);
        const float inv = 1.f / sc;
        const unsigned long long o = (unsigned long long)pack8_i4(v, inv) | ((unsigned long long)pack8_i4(v + 8, inv) << 32);
        *(unsigned long long*)(P.ws + WS_ED + ((size_t)(lane_ >> 4) * 16384 + e) * 128 + (lane_ & 15) * 8) = o;
        if (lane_ == 0) SC[row] = sc;
    }
}
typedef float f32x2q __attribute__((ext_vector_type(2)));
__device__ __forceinline__ void quant_fp6u(const Ptrs& P, int lane_, int q_lo, int q_hi, int w, int nw) {
    float* SC = (float*)(P.ws + WS_SMALL);
    int e = 2 * q_lo + w; const int e_hi = 2 * q_hi;
    if (e >= e_hi) return;
    float4 nx[4];
#pragma unroll
    for (int k = 0; k < 4; ++k) nx[k] = ((const float4*)(P.e_up + (size_t)e * DM) + 4 * lane_)[k];
    for (; e < e_hi; e += nw) {
        float v[16];
#pragma unroll
        for (int k = 0; k < 4; ++k) { const float4 t = nx[k]; v[4 * k] = t.x; v[4 * k + 1] = t.y; v[4 * k + 2] = t.z; v[4 * k + 3] = t.w; }
        { const int en = (e + nw < e_hi) ? e + nw : e;
#pragma unroll
          for (int k = 0; k < 4; ++k) nx[k] = ((const float4*)(P.e_up + (size_t)en * DM) + 4 * lane_)[k]; }
        float am = 0.f;
#pragma unroll
        for (int k = 0; k < 16; ++k) am = fmaxf(am, fabsf(v[k]));
        am = fmaxf(am, swz_xor<1>(am)); am = fmaxf(am, swz_xor<2>(am)); am = fmaxf(am, swz_xor<4>(am)); am = fmaxf(am, swz_xor<8>(am)); am = fmaxf(am, swz_xor<16>(am)); am = max_halves(am);
        am = fmaxf(am, 1e-30f);
        const float inv = 6.0f / am;
        unsigned pk[2];
#pragma unroll
        for (int wd = 0; wd < 2; ++wd) { unsigned p4 = 0u;
            p4 = __builtin_amdgcn_cvt_scalef32_pk_fp4_f32(p4, v[8 * wd] * inv, v[8 * wd + 1] * inv, 1.0f, 0);
            p4 = __builtin_amdgcn_cvt_scalef32_pk_fp4_f32(p4, v[8 * wd + 2] * inv, v[8 * wd + 3] * inv, 1.0f, 1);
            p4 = __builtin_amdgcn_cvt_scalef32_pk_fp4_f32(p4, v[8 * wd + 4] * inv, v[8 * wd + 5] * inv, 1.0f, 2);
            p4 = __builtin_amdgcn_cvt_scalef32_pk_fp4_f32(p4, v[8 * wd + 6] * inv, v[8 * wd + 7] * inv, 1.0f, 3);
            pk[wd] = p4; }
        *(unsigned long long*)(P.ws + WS_EU + (size_t)e * 512 + 8 * lane_) = (unsigned long long)pk[0] | ((unsigned long long)pk[1] << 32);
        if (lane_ == 0) SC[16384 + e] = am * (1.f / 6.0f);
    }
}
__device__ __forceinline__ void p0_prologue(Frame& F0, const Ptrs& P) {
    const Frame& F = F0; const int lane_ = lane_id(), tid_ = F.wave * 64 + lane_;
    LAS float* scr = (LAS float*)(F.lds + RING_OFF + F.wave * 16384);
    const int gw = F.vcu * NWAVES + F.wave, NGW = F.G * NWAVES;
    bf16* Win_t = (bf16*)(P.ws + WS_WIN); bf16* Wout_t = (bf16*)(P.ws + WS_WOUT); bf16* Wq_t = (bf16*)(P.ws + WS_WQ);
    constexpr int I_IN = 16 * 72;
    for (int it = gw; it < I_IN; it += NGW) p0_transpose_item(P.w_in, INC, DM, 72, Win_t, nullptr, scr, it, lane_);
    (void)Wout_t; (void)Wq_t;
    __syncthreads();
    { LAS float* Wdt = (LAS float*)(F.lds + RING_OFF);
      { float wd_[16];
#pragma unroll
        for (int q = 0; q < 16; ++q) { const int i = tid_ + 512 * q; wd_[q] = P.w_in[(size_t)(i >> 3) * INC + NPROJ + (i & 7)]; }
#pragma unroll
        for (int q = 0; q < 16; ++q) Wdt[tid_ + 512 * q] = wd_[q]; }
      __syncthreads();
      bf16* XN = (bf16*)(P.ws + WS_XN); float* DT = (float*)(P.ws + WS_DT);
      float4 nmw[4];
#pragma unroll
      for (int j = 0; j < 4; ++j) nmw[j] = ((const float4*)P.norm_mix)[j * 64 + lane_];
      float4 xnx[2][4];
      if (gw * 2 < T_) {
#pragma unroll
        for (int rr = 0; rr < 2; ++rr)
#pragma unroll
            for (int j = 0; j < 4; ++j) xnx[rr][j] = ((const float4*)(P.x + (size_t)(gw * 2 + rr) * DM))[j * 64 + lane_]; }
      for (int m0 = gw * 2; m0 < T_; m0 += NGW * 2) {
        float4 xv[2][4];
#pragma unroll
        for (int rr = 0; rr < 2; ++rr)
#pragma unroll
            for (int j = 0; j < 4; ++j) xv[rr][j] = xnx[rr][j];
        { const int mn = (m0 + NGW * 2 < T_) ? m0 + NGW * 2 : m0;
#pragma unroll
          for (int rr = 0; rr < 2; ++rr)
#pragma unroll
              for (int j = 0; j < 4; ++j) xnx[rr][j] = ((const float4*)(P.x + (size_t)(mn + rr) * DM))[j * 64 + lane_]; }
#pragma unroll
        for (int rr = 0; rr < 2; ++rr) { const int m = m0 + rr;
        float4 v[4]; float s = 0.f;
#pragma unroll
        for (int j = 0; j < 4; ++j) { v[j] = xv[rr][j]; s += v[j].x * v[j].x + v[j].y * v[j].y + v[j].z * v[j].z + v[j].w * v[j].w; }
        const float r = rsqrtf(wave_sum(s) * (1.f / 1024.f) + EPS);
        float d8[8];
#pragma unroll
        for (int q = 0; q < 8; ++q) d8[q] = 0.f;
        unsigned long long* o8 = (unsigned long long*)(XN + (size_t)m * DM);
#pragma unroll
        for (int j = 0; j < 4; ++j) { const float4 w = nmw[j];
            const float e0 = v[j].x * r * w.x, e1 = v[j].y * r * w.y, e2 = v[j].z * r * w.z, e3 = v[j].w * r * w.w;
            o8[j * 64 + lane_] = (unsigned long long)pk2(e0, e1) | ((unsigned long long)pk2(e2, e3) << 32);
            const float ev[4] = {e0, e1, e2, e3};
#pragma unroll
            for (int e = 0; e < 4; ++e) { const LAS f32x4* wr = (const LAS f32x4*)(Wdt + (size_t)(j * 256 + lane_ * 4 + e) * 8); const f32x4 w0 = wr[0], w1 = wr[1];
                d8[0] += ev[e] * w0.x; d8[1] += ev[e] * w0.y; d8[2] += ev[e] * w0.z; d8[3] += ev[e] * w0.w; d8[4] += ev[e] * w1.x; d8[5] += ev[e] * w1.y; d8[6] += ev[e] * w1.z; d8[7] += ev[e] * w1.w; } }
#pragma unroll
        for (int q = 0; q < 8; ++q) d8[q] = wave_sum(d8[q]);
        if (lane_ == 0) { float4* dp = (float4*)(DT + (size_t)m * 8); dp[0] = make_float4(d8[0], d8[1], d8[2], d8[3]); dp[1] = make_float4(d8[4], d8[5], d8[6], d8[7]); }
        }
      }
      __syncthreads(); }
}

__device__ __forceinline__ void p1_slack(Frame& F0, const Ptrs& P, int w, int nw) {
    const Frame& F = F0; const int lane_ = lane_id();
    LAS float* scr = (LAS float*)(F.lds + RING_OFF + F.wave * 16384);
    bf16* Wout_t = (bf16*)(P.ws + WS_WOUT); bf16* Wq_t = (bf16*)(P.ws + WS_WQ);
    constexpr int I_OUT = 16 * 32, I_Q = 16 * 64;
    for (int it = w; it < I_OUT + I_Q; it += nw) {
        if (it < I_OUT) p0_transpose_item(P.w_out, DM, DM, 32, Wout_t, nullptr, scr, it, lane_);
        else p0_transpose_item(P.w_query, 2048, DM, 64, Wq_t, P.norm_ffn, scr, it - I_OUT, lane_);
    }
    { unsigned long long* KB = (unsigned long long*)(P.ws + WS_KEYB);
      for (int i = w * 64 + lane_; i < 8192; i += nw * 64) { const float4 t = (i < 4096) ? ((const float4*)P.sk1)[i] : ((const float4*)P.sk2)[i - 4096];
          KB[i] = (unsigned long long)pk2(t.x, t.y) | ((unsigned long long)pk2(t.z, t.w) << 32); } }
    { float* BT = (float*)(P.ws + WS_BTAB);
      for (int i = w * 64 + lane_; i < 1536; i += nw * 64) { const int hkv = i / 768, rr = i % 768, gg = rr / 192, dist = rr % 192 - 32;
          BT[i] = (dist >= 0 && dist < 128) ? P.rel_bias[c_bucket[dist & 127] * 8 + hkv * 4 + gg] * 1.4426950408889634f : 0.f; } }
    quant_fp6u(P, lane_, 0, 8192, w, nw);
    quant_fp8s(P, lane_, 0, 16384, w, nw);
}
struct EpiResH {
    static constexpr bool PERM = false, AFTER_DRAIN = false;
    const float* X; bf16* HB; float* SSQ;
    __device__ __forceinline__ void ldx(pg8::f32x4 (&d)[4], int row, int col0) const {
#pragma unroll
        for (int bj = 0; bj < 2; ++bj)
#pragma unroll
            for (int n = 0; n < 2; ++n) d[bj * 2 + n] = *(const pg8::f32x4*)(X + (size_t)row * DM + col0 + bj * 128 + n * 16);
    }
    __device__ __forceinline__ void operator()(const pg8::f32x4 (&acc)[2][2][4][2], const pg8::Unit& u, int wr, int wc, int fr, int fq) const {
        const int row0 = u.pm * 256 + wr * 64 + fr, col0 = u.pn * 256 + wc * 32 + 4 * fq;
        pg8::f32x4 xq[2][4];
        ldx(xq[0], row0, col0);
#pragma unroll
        for (int g = 0; g < 8; ++g) { const int ai = g >> 2, m = g & 3, row = row0 + ai * 128 + m * 16;
            if (g + 1 < 8) ldx(xq[(g + 1) & 1], row0 + ((g + 1) >> 2) * 128 + ((g + 1) & 3) * 16, col0);
            float ss = 0.f;
#pragma unroll
            for (int bj = 0; bj < 2; ++bj)
#pragma unroll
                for (int n = 0; n < 2; ++n) { const size_t off = (size_t)row * DM + col0 + bj * 128 + n * 16;
                    const pg8::f32x4 h = acc[ai][bj][m][n] + xq[g & 1][bj * 2 + n];
                    ss += h[0] * h[0] + h[1] * h[1] + h[2] * h[2] + h[3] * h[3];
                    *(unsigned long long*)(HB + off) = (unsigned long long)pk2(h[0], h[1]) | ((unsigned long long)pk2(h[2], h[3]) << 32); }
            ss += swz_xor<16>(ss); ss = sum_halves(ss);
            if (fq == 0) SSQ[(size_t)row * 16 + u.pn * 4 + wc] = ss; }
    }
};

typedef float f32x16 __attribute__((ext_vector_type(16)));
typedef short s16x4 __attribute__((ext_vector_type(4)));
typedef float f32x2_t __attribute__((ext_vector_type(2)));
typedef __bf16 bf16x2_t __attribute__((ext_vector_type(2)));
#define MFMA32(a, b, c) __builtin_amdgcn_mfma_f32_32x32x16_bf16((a), (b), (c), 0, 0, 0)
__device__ __forceinline__ int crow(int reg, int h) { return (reg & 3) + 8 * (reg >> 2) + 4 * h; }
__device__ __forceinline__ unsigned cvtpk(float lo, float hi) { f32x2_t v = {lo, hi}; bf16x2_t b = __builtin_convertvector(v, bf16x2_t); return __builtin_bit_cast(unsigned, b); }
__device__ __forceinline__ bf16x8 pack8(const f32x16& x, int s) {
    v4u p; p.x = cvtpk(x[8 * s], x[8 * s + 1]); p.y = cvtpk(x[8 * s + 2], x[8 * s + 3]); p.z = cvtpk(x[8 * s + 4], x[8 * s + 5]); p.w = cvtpk(x[8 * s + 6], x[8 * s + 7]);
    return __builtin_bit_cast(bf16x8, p);
}
constexpr float LOG2E = 1.4426950408889634f;
constexpr int LDP = 136;
constexpr int S1_XT = 0, S1_XTW = 17408, S1_BSN = 34816, S1_CLN = 69632, S1_BNL = 104448, S1_F32 = 139264;

__device__ __forceinline__ float silu_fast(float x) { return x * __builtin_amdgcn_rcpf(1.f + __builtin_amdgcn_exp2f(-x * LOG2E)); }
__device__ __forceinline__ int swz_t(int row, int l) { return row * LDP + ((((l >> 3) ^ (row >> 3)) & 7) | ((l >> 3) & 8)) * 8 + (l & 7); }
#define S1_CONV8(A_, IT_) do { _Pragma("unroll") for (int e_ = 0; e_ < 8; ++e_) A_[e_] = bias[e_]; \
        _Pragma("unroll") for (int j_ = 0; j_ < 4; ++j_) { const v4u rw_ = raw[(IT_) + j_]; \
            A_[0] += w[j_][0] * bflo(rw_.x); A_[1] += w[j_][1] * bfhi(rw_.x); A_[2] += w[j_][2] * bflo(rw_.y); A_[3] += w[j_][3] * bfhi(rw_.y); \
            A_[4] += w[j_][4] * bflo(rw_.z); A_[5] += w[j_][5] * bfhi(rw_.z); A_[6] += w[j_][6] * bflo(rw_.w); A_[7] += w[j_][7] * bfhi(rw_.w); } \
        _Pragma("unroll") for (int e_ = 0; e_ < 8; ++e_) A_[e_] = silu_fast(A_[e_]); } while (0)
#define S1_LOADW(CHB_) do { _Pragma("unroll") for (int j_ = 0; j_ < 4; ++j_) { const float4 w0_ = *(const float4*)(P.conv_w + j_ * 1024 + (CHB_)), w1_ = *(const float4*)(P.conv_w + j_ * 1024 + (CHB_) + 4); \
            w[j_][0] = w0_.x; w[j_][1] = w0_.y; w[j_][2] = w0_.z; w[j_][3] = w0_.w; w[j_][4] = w1_.x; w[j_][5] = w1_.y; w[j_][6] = w1_.z; w[j_][7] = w1_.w; } \
        { const float4 b0_ = *(const float4*)(P.conv_b + (CHB_)), b1_ = *(const float4*)(P.conv_b + (CHB_) + 4); \
          bias[0] = b0_.x; bias[1] = b0_.y; bias[2] = b0_.z; bias[3] = b0_.w; bias[4] = b1_.x; bias[5] = b1_.y; bias[6] = b1_.z; bias[7] = b1_.w; } } while (0)
__device__ __forceinline__ void ssd_s1(Frame& F, const Ptrs& P) {
    const bf16* PROJ = (const bf16*)(P.ws + WS_PROJ); const float* DT = (const float*)(P.ws + WS_DT);
    float* EA = (float*)(P.ws + WS_EA); float* CDEC = (float*)(P.ws + WS_CDEC); bf16* CC = (bf16*)(P.ws + WS_CC);
    unsigned* ST = (unsigned*)(P.ws + WS_ST); unsigned* YPF = (unsigned*)((char*)P.out + DO_YPF);
    LAS unsigned char* L = F.lds + RING_OFF;
    LAS bf16* Xt = (LAS bf16*)(L + S1_XT); LAS bf16* Xtw = (LAS bf16*)(L + S1_XTW); LAS bf16* Bsn = (LAS bf16*)(L + S1_BSN); LAS bf16* Cln = (LAS bf16*)(L + S1_CLN); LAS bf16* Bnl = (LAS bf16*)(L + S1_BNL);
    LAS float* f32base = (LAS float*)(L + S1_F32);
    const int lane = lane_id(); const int tid_ = F.wave * 64 + lane;
    for (int ug = F.vcu; ug < 256; ug += F.G) {
        const int grp = ug & 1, c = (ug >> 1) & 31, b = ug >> 6, t0 = b * SEQ + c * 128;
        __syncthreads();
        if (F.wave < 4) {
            const int h = 4 * grp + F.wave, us = (b * 32 + c) * 8 + h;
            const float A = -__expf(P.a_log[h]), dtb = P.dt_bias[h];
            const int ln = opq(lane_id());
            LAS float* acum2 = f32base + F.wave * 384; LAS float* wv = acum2 + 128; LAS float* wend = wv + 128;
            const float x0 = DT[(size_t)(t0 + 2 * ln) * 8 + h] + dtb, x1 = DT[(size_t)(t0 + 2 * ln + 1) * 8 + h] + dtb;
            const float dt0 = fmaxf(x0, 0.f) + log1pf(__expf(-fabsf(x0))), dt1 = fmaxf(x1, 0.f) + log1pf(__expf(-fabsf(x1)));
            const float a0 = dt0 * A, a1 = dt1 * A;
            float s = a0 + a1;
#pragma unroll
            for (int o = 1; o < 64; o <<= 1) { const float v = __int_as_float(__builtin_amdgcn_ds_bpermute((ln - o) * 4, __float_as_int(s))); if (ln >= o) s += v; }
            const float ac1 = s, ac0 = s - a1, tot = __uint_as_float(__builtin_amdgcn_readlane(__float_as_uint(s), 63));
            acum2[2 * ln] = ac0 * LOG2E; acum2[2 * ln + 1] = ac1 * LOG2E;
            wv[2 * ln] = log2f(dt0) - ac0 * LOG2E; wv[2 * ln + 1] = log2f(dt1) - ac1 * LOG2E;
            wend[2 * ln] = dt0 * exp2f((tot - ac0) * LOG2E); wend[2 * ln + 1] = dt1 * exp2f((tot - ac1) * LOG2E);
            EA[(size_t)(t0 + 2 * ln) * 8 + h] = exp2f(ac0 * LOG2E); EA[(size_t)(t0 + 2 * ln + 1) * 8 + h] = exp2f(ac1 * LOG2E);
            if (ln == 0) CDEC[us] = exp2f(tot * LOG2E);
        }
        { const int tidc = opq(tid_);
          if (tidc < 440) {
            const int cg = tidc % 40, sg = tidc / 40, l0 = 12 * sg, h0 = 4 * grp;
            int chb; if (cg < 8) chb = h0 * 64 + cg * 8; else if (cg < 24) chb = 512 + grp * 128 + (cg - 8) * 8; else chb = 768 + grp * 128 + (cg - 24) * 8;
            v4u raw[15];
#pragma unroll
            for (int q = 0; q < 15; ++q) { const int ss = c * 128 + l0 - 3 + q; raw[q] = (v4u){0u, 0u, 0u, 0u};
                if (ss >= 0 && l0 - 3 + q < 128) raw[q] = *(const v4u*)(PROJ + (size_t)(b * SEQ + ss) * NPROJ + PJ_XBC + chb); }
            float w[4][8], bias[8]; S1_LOADW(chb);
#pragma unroll
            for (int it = 0; it < 12; it += 2) {
                const int l = l0 + it;
                if (l < 128) {
                    float a[8], a2[8]; S1_CONV8(a, it); S1_CONV8(a2, it + 1);
                    if (cg < 8) {
#pragma unroll
                        for (int e = 0; e < 8; ++e) *(LAS unsigned*)(Xt + swz_t(cg * 8 + e, l)) = cvtpk(a[e], a2[e]);
                    } else {
                        v4u o, o2; o.x = cvtpk(a[0], a[1]); o.y = cvtpk(a[2], a[3]); o.z = cvtpk(a[4], a[5]); o.w = cvtpk(a[6], a[7]);
                        o2.x = cvtpk(a2[0], a2[1]); o2.y = cvtpk(a2[2], a2[3]); o2.z = cvtpk(a2[4], a2[5]); o2.w = cvtpk(a2[6], a2[7]);
                        if (cg < 24) { const int n0 = (cg - 8) * 8; *(LAS v4u*)(Bsn + l * LDP + n0) = o; *(LAS v4u*)(Bsn + (l + 1) * LDP + n0) = o2;
#pragma unroll
                            for (int e = 0; e < 8; ++e) *(LAS unsigned*)(Bnl + swz_t(n0 + e, l)) = cvtpk(a[e], a2[e]);
                        } else { const int n0 = (cg - 24) * 8; *(LAS v4u*)(Cln + l * LDP + n0) = o; *(LAS v4u*)(Cln + (l + 1) * LDP + n0) = o2;
                            *(v4u*)(CC + (size_t)(t0 + l) * 256 + grp * 128 + n0) = o; *(v4u*)(CC + (size_t)(t0 + l + 1) * 256 + grp * 128 + n0) = o2; }
                    }
                }
            }
          } }
        __syncthreads();
#pragma unroll 1
        for (int hi = 0; hi < 4; ++hi) {
            const int h = 4 * grp + hi, u = (b * 32 + c) * 8 + h;
            const float Dh = P.d_skip[h];
            const LAS float* acum2 = f32base + hi * 384; const LAS float* wv = acum2 + 128; const LAS float* wend = wv + 128;
            const LAS bf16* Xc = (hi & 1) ? Xtw : Xt; LAS bf16* Xn = (hi & 1) ? Xt : Xtw;
            const int tidc = opq(tid_);
            const int cgn = tidc & 7, ln_ = 2 * (tidc >> 3), chn = (h + 1) * 64 + cgn * 8;
            v4u raw[5];
#pragma unroll
            for (int q = 0; q < 5; ++q) { const int ss = c * 128 + ln_ - 3 + q; raw[q] = (v4u){0u, 0u, 0u, 0u};
                if (hi < 3 && ss >= 0) raw[q] = *(const v4u*)(PROJ + (size_t)(b * SEQ + ss) * NPROJ + PJ_XBC + chn); }
            const int ln3 = opq(lane), r = ln3 & 31, hh = ln3 >> 5;
            if (F.wave < 4) {
                const int pt = F.wave >> 1;
#pragma unroll 1
                for (int q = 0; q < 2; ++q) {
                    const int lt = (F.wave & 1) ? (1 + q) : (3 * q);
                    f32x16 yacc;
#pragma unroll
                    for (int i = 0; i < 16; ++i) yacc[i] = 0.f;
                    const float al = acum2[32 * lt + r];
                    bf16x8 cf[8];
#pragma unroll
                    for (int kk = 0; kk < 8; ++kk) cf[kk] = *(const LAS bf16x8*)(Cln + (32 * lt + r) * LDP + 16 * kk + 8 * hh);
#pragma unroll 1
                    for (int st = 0; st <= lt; ++st) {
                        bf16x8 bfr[8];
#pragma unroll
                        for (int kk = 0; kk < 8; ++kk) bfr[kk] = *(const LAS bf16x8*)(Bsn + (32 * st + r) * LDP + 16 * kk + 8 * hh);
                        f32x4 wq[4];
#pragma unroll
                        for (int g4 = 0; g4 < 4; ++g4) wq[g4] = *(const LAS f32x4*)(wv + 32 * st + 8 * g4 + 4 * hh);
                        s16x4 xlo[2], xhi[2];
#pragma unroll
                        for (int sg = 0; sg < 2; ++sg) { const int prow = 32 * pt + r, lb = 32 * st + 16 * sg;
                            xlo[sg] = *(const LAS s16x4*)(Xc + swz_t(prow, lb) + 4 * hh); xhi[sg] = *(const LAS s16x4*)(Xc + swz_t(prow, lb + 8) + 4 * hh); }
                        __builtin_amdgcn_sched_barrier(0);
                        f32x16 macc;
#pragma unroll
                        for (int i = 0; i < 16; ++i) macc[i] = 0.f;
#pragma unroll
                        for (int kk = 0; kk < 8; ++kk) macc = MFMA32(bfr[kk], cf[kk], macc);
#pragma unroll
                        for (int i = 0; i < 16; ++i) { const int sl = crow(i, hh);
                            float f = __builtin_amdgcn_exp2f(al + wq[i >> 2][i & 3]);
                            if (st == lt && sl > r) f = 0.f;
                            macc[i] *= f; }
#pragma unroll
                        for (int sg = 0; sg < 2; ++sg) {
                            const bf16x8 bfrag = pack8(macc, sg);
                            const bf16x8 afrag = __builtin_shufflevector(xlo[sg], xhi[sg], 0, 1, 2, 3, 4, 5, 6, 7);
                            yacc = MFMA32(afrag, bfrag, yacc);
                        }
                    }
                    unsigned short xs16[16];
#pragma unroll
                    for (int i = 0; i < 16; ++i) xs16[i] = *(const LAS unsigned short*)(Xc + swz_t(32 * pt + crow(i, hh), 32 * lt + r));
                    __builtin_amdgcn_sched_barrier(0);
#pragma unroll
                    for (int i = 0; i < 16; i += 2) {
                        const float y0 = yacc[i] + Dh * __uint_as_float((unsigned)xs16[i] << 16), y1 = yacc[i + 1] + Dh * __uint_as_float((unsigned)xs16[i + 1] << 16);
                        YPF[((((size_t)u * 4 + lt) * 2 + pt) * 8 + (i >> 1)) * 64 + ln3] = cvtpk(y0, y1); }
                }
            } else {
                const int nt = F.wave - 4;
                bf16x8 bb[8];
                { v4u braw[8]; f32x4 we[8][2];
#pragma unroll
                  for (int kk = 0; kk < 8; ++kk) { braw[kk] = *(const LAS v4u*)(Bnl + swz_t(32 * nt + r, 16 * kk + 8 * hh));
                      we[kk][0] = *(const LAS f32x4*)(wend + 16 * kk + 8 * hh); we[kk][1] = *(const LAS f32x4*)(wend + 16 * kk + 8 * hh + 4); }
#pragma unroll
                  for (int kk = 0; kk < 8; ++kk) { v4u o;
                      o.x = cvtpk(bflo(braw[kk].x) * we[kk][0][0], bfhi(braw[kk].x) * we[kk][0][1]); o.y = cvtpk(bflo(braw[kk].y) * we[kk][0][2], bfhi(braw[kk].y) * we[kk][0][3]);
                      o.z = cvtpk(bflo(braw[kk].z) * we[kk][1][0], bfhi(braw[kk].z) * we[kk][1][1]); o.w = cvtpk(bflo(braw[kk].w) * we[kk][1][2], bfhi(braw[kk].w) * we[kk][1][3]);
                      bb[kk] = __builtin_bit_cast(bf16x8, o); } }
#pragma unroll 1
                for (int pt = 0; pt < 2; ++pt) {
                    bf16x8 xa[8];
#pragma unroll
                    for (int kk = 0; kk < 8; ++kk) xa[kk] = *(const LAS bf16x8*)(Xc + swz_t(32 * pt + r, 16 * kk + 8 * hh));
                    __builtin_amdgcn_sched_barrier(0);
                    f32x16 sacc;
#pragma unroll
                    for (int i = 0; i < 16; ++i) sacc[i] = 0.f;
#pragma unroll
                    for (int kk = 0; kk < 8; ++kk) sacc = MFMA32(xa[kk], bb[kk], sacc);
#pragma unroll
                    for (int i = 0; i < 16; i += 2) ST[((size_t)u * 32 + 16 * pt + (crow(i, hh) >> 1)) * 128 + 32 * nt + r] = cvtpk(sacc[i], sacc[i + 1]);
                }
            }
            if (hi < 3) {
                const int cg = cgn, l = ln_;
                float w[4][8], bias[8]; S1_LOADW(chn);
                float a[8], a2[8]; S1_CONV8(a, 0); S1_CONV8(a2, 1);
#pragma unroll
                for (int e = 0; e < 8; ++e) *(LAS unsigned*)(Xn + swz_t(cg * 8 + e, l)) = cvtpk(a[e], a2[e]);
            }
            __syncthreads();
        }
    }
}
__device__ __forceinline__ void ssd_s2(Frame& F, const Ptrs& P) {
    const unsigned* ST = (const unsigned*)(P.ws + WS_ST); const float* CDEC = (const float*)(P.ws + WS_CDEC); unsigned* PREV = (unsigned*)(P.ws + WS_PREV);
    for (int g = F.vcu * 512 + (F.wave * 64 + lane_id()); g < 65536; g += F.G * 512) {
        const int n2 = g & 63, p2 = (g >> 6) & 31, h = (g >> 11) & 7, b = g >> 14;
        uint2 st[32];
#pragma unroll
        for (int c = 0; c < 32; ++c) st[c] = *(const uint2*)(ST + ((size_t)(((b * 32 + c) * 8 + h) * 32 + p2)) * 128 + 2 * n2);
        float r00 = 0.f, r01 = 0.f, r10 = 0.f, r11 = 0.f;
#pragma unroll
        for (int c = 0; c < 32; ++c) { const size_t u = (size_t)((b * 32 + c) * 8 + h);
            PREV[((u * 64 + 2 * p2) * 128 + 2 * n2) >> 1] = cvtpk(r00, r01); PREV[((u * 64 + 2 * p2 + 1) * 128 + 2 * n2) >> 1] = cvtpk(r10, r11);
            const float d = CDEC[u];
            r00 = r00 * d + bflo(st[c].x); r10 = r10 * d + bfhi(st[c].x); r01 = r01 * d + bflo(st[c].y); r11 = r11 * d + bfhi(st[c].y); }
    }
}
__device__ __forceinline__ void ssd_s3(Frame& F, const Ptrs& P) {
    const bf16* CC = (const bf16*)(P.ws + WS_CC); const bf16* PREV = (const bf16*)(P.ws + WS_PREV); const float* EA = (const float*)(P.ws + WS_EA);
    const unsigned* YPF = (const unsigned*)((const char*)P.out + DO_YPF); const bf16* PROJ = (const bf16*)(P.ws + WS_PROJ); bf16* CAT = (bf16*)(P.ws + WS_XN);
    LAS float* red = (LAS float*)(F.lds + RING_OFF);
    const int lane = lane_id(), r = lane & 31, hh = lane >> 5, h = F.wave, grp = h >> 2;
    for (int v2 = F.vcu; v2 < 256; v2 += F.G) {
        const int lp = v2 & 1, c = (v2 >> 1) & 31, b = v2 >> 6;
        const size_t u = (size_t)((b * 32 + c) * 8 + h);
        bf16x8 af[2][8];
#pragma unroll
        for (int pt = 0; pt < 2; ++pt)
#pragma unroll
            for (int kk = 0; kk < 8; ++kk) af[pt][kk] = *(const bf16x8*)(PREV + (u * 64 + 32 * pt + r) * 128 + 16 * kk + 8 * hh);
#pragma unroll 1
        for (int li = 0; li < 2; ++li) {
            const int lt = 2 * lp + li;
            const int t = b * SEQ + c * 128 + lt * 32 + r;
            unsigned ypf[2][8]; unsigned long long zz[2][4];
#pragma unroll
            for (int pt = 0; pt < 2; ++pt) {
#pragma unroll
                for (int i = 0; i < 8; ++i) ypf[pt][i] = YPF[((((size_t)u * 4 + lt) * 2 + pt) * 8 + i) * 64 + lane];
#pragma unroll
                for (int g4 = 0; g4 < 4; ++g4) zz[pt][g4] = *(const unsigned long long*)(PROJ + (size_t)t * NPROJ + PJ_Z + h * 64 + 32 * pt + 8 * g4 + 4 * hh); }
            const float ea = EA[(size_t)t * 8 + h];
            bf16x8 bb[8];
#pragma unroll
            for (int kk = 0; kk < 8; ++kk) bb[kk] = *(const bf16x8*)(CC + (size_t)t * 256 + grp * 128 + 16 * kk + 8 * hh);
            f32x16 acc[2];
#pragma unroll
            for (int i = 0; i < 16; ++i) { acc[0][i] = 0.f; acc[1][i] = 0.f; }
#pragma unroll
            for (int kk = 0; kk < 8; ++kk) { acc[0] = MFMA32(af[0][kk], bb[kk], acc[0]); acc[1] = MFMA32(af[1][kk], bb[kk], acc[1]); }
            float ss = 0.f;
#pragma unroll
            for (int pt = 0; pt < 2; ++pt)
#pragma unroll
                for (int g4 = 0; g4 < 4; ++g4) {
                    const unsigned z01 = (unsigned)zz[pt][g4], z23 = (unsigned)(zz[pt][g4] >> 32);
                    const float zf[4] = {bflo(z01), bfhi(z01), bflo(z23), bfhi(z23)};
#pragma unroll
                    for (int e = 0; e < 4; ++e) { const int i = 4 * g4 + e;
                        const float y = acc[pt][i] * ea + ((i & 1) ? bfhi(ypf[pt][i >> 1]) : bflo(ypf[pt][i >> 1]));
                        const float yg = y * silu_fast(zf[e]); acc[pt][i] = yg; ss = fmaf(yg, yg, ss); }
                }
            ss = sum_halves(ss);
            LAS float* rd = red + li * 256;
            if (hh == 0) rd[h * 32 + r] = ss;
            __syncthreads();
            float tot = 0.f;
#pragma unroll
            for (int w = 0; w < 8; ++w) tot += rd[w * 32 + r];
            const float rn = rsqrtf(tot * (1.f / 512.f) + EPS);
#pragma unroll
            for (int pt = 0; pt < 2; ++pt)
#pragma unroll
                for (int g4 = 0; g4 < 4; ++g4) { const int ch = h * 64 + 32 * pt + 8 * g4 + 4 * hh;
                    const float4 w = *(const float4*)(P.ssd_norm_w + ch);
                    *(unsigned long long*)(CAT + (size_t)t * DM + 512 + ch) = (unsigned long long)cvtpk(acc[pt][4 * g4] * rn * w.x, acc[pt][4 * g4 + 1] * rn * w.y) | ((unsigned long long)cvtpk(acc[pt][4 * g4 + 2] * rn * w.z, acc[pt][4 * g4 + 3] * rn * w.w) << 32); }
        }
        __syncthreads();
    }
}
__device__ __forceinline__ float gelu_erf(float v) { return 0.5f * v * (1.f + erff(v * 0.70710678118654752f)); }
typedef float f32x2v __attribute__((ext_vector_type(2)));
#define CVT8(W, LO) __builtin_amdgcn_cvt_pk_f32_fp8((int)(W), LO)
template <int CTRL> __device__ __forceinline__ float dpp_f(float v) { return __int_as_float(__builtin_amdgcn_update_dpp(0, __float_as_int(v), CTRL, 0xF, 0xF, true)); }
__device__ __forceinline__ float sum8_dpp(float s) { s += dpp_f<0xB1>(s); s += dpp_f<0x4E>(s); s += dpp_f<0x141>(s); return s; }
struct PeerPlace { int vx, nx, rank, nloc; };
__device__ __forceinline__ PeerPlace peer_place(Frame& F) {
    __syncthreads();
    if (F.wave == 0 && lane_id() == 0) {
        unsigned* bar = (unsigned*)(F.ctl + CW_BAR); const unsigned x = xb_xcc_id();
        unsigned vx = 0, nx = 0;
        for (unsigned j = 0; j < 16; ++j) { const unsigned c = xb_ld(&bar[XB_XCNT(j)]); if (c) { if (j < x) ++vx; ++nx; } }
        const unsigned rank = xb_add((unsigned*)(F.ctl + CW_RANK) + 64 * x, 1u);
        F.MISC[10] = vx; F.MISC[11] = nx ? nx : 1u; F.MISC[12] = rank; F.MISC[13] = xb_ld(&bar[XB_XCNT(x)]);
    }
    __syncthreads();
    PeerPlace pp; pp.vx = (int)F.MISC[10]; pp.nx = (int)F.MISC[11]; pp.rank = (int)F.MISC[12]; pp.nloc = (int)F.MISC[13]; if (pp.nloc < 1) pp.nloc = 1;
    return pp;
}
__device__ __forceinline__ void h_quant_rows(Frame& F, const Ptrs& P) {
    const bf16* HB = (const bf16*)(P.ws + WS_ST); unsigned char* H8 = P.ws + WS_H8; float* HS = (float*)(P.ws + WS_HS);
    const int lane = lane_id();
    for (int t = F.vcu * NWAVES + F.wave; t < T_; t += F.G * NWAVES) {
        const v4u a0 = ((const v4u*)(HB + (size_t)t * DM))[2 * lane], a1 = ((const v4u*)(HB + (size_t)t * DM))[2 * lane + 1];
        float hf[16];
        hf[0] = bflo(a0.x); hf[1] = bfhi(a0.x); hf[2] = bflo(a0.y); hf[3] = bfhi(a0.y); hf[4] = bflo(a0.z); hf[5] = bfhi(a0.z); hf[6] = bflo(a0.w); hf[7] = bfhi(a0.w);
        hf[8] = bflo(a1.x); hf[9] = bfhi(a1.x); hf[10] = bflo(a1.y); hf[11] = bfhi(a1.y); hf[12] = bflo(a1.z); hf[13] = bfhi(a1.z); hf[14] = bflo(a1.w); hf[15] = bfhi(a1.w);
        float am = 0.f;
#pragma unroll
        for (int i = 0; i < 16; ++i) am = fmaxf(am, fabsf(hf[i]));
        am = fmaxf(am, dpp_f<0xB1>(am)); am = fmaxf(am, dpp_f<0x4E>(am)); am = fmaxf(am, dpp_f<0x141>(am)); am = fmaxf(am, dpp_f<0x140>(am)); am = fmaxf(am, 1e-30f);
        const float inv = 119.f / am;
        unsigned hi[2] = {0u, 0u}, lo[2] = {0u, 0u};
#pragma unroll
        for (int i = 0; i < 16; ++i) { const int q = __float2int_rn(hf[i] * inv); const int qh = (q + 8) >> 4, ql = q - 16 * qh;
            hi[i >> 3] |= ((unsigned)qh & 15u) << (4 * (i & 7)); lo[i >> 3] |= ((unsigned)ql & 15u) << (4 * (i & 7)); }
        unsigned char* dst = H8 + (size_t)t * 1024 + (lane >> 4) * 256 + (lane & 15) * 8;
        *(unsigned long long*)dst = (unsigned long long)hi[0] | ((unsigned long long)hi[1] << 32);
        *(unsigned long long*)(dst + 128) = (unsigned long long)lo[0] | ((unsigned long long)lo[1] << 32);
        if ((lane & 15) == 0) HS[(size_t)t * 8 + (lane >> 4)] = am * (1.f / 119.f);
    }
}
constexpr int PX_D = 16;
template <int CTRL> __device__ __forceinline__ int dpp_i(int v) { return __builtin_amdgcn_update_dpp(0, v, CTRL, 0xF, 0xF, true); }
#define PX_ISSUE(BUF, LO, HI) _Pragma("unroll") for (int b_ = 0; b_ < 8; ++b_) { const unsigned off_ = ((unsigned)__builtin_amdgcn_ds_bpermute((16 * (b_ & 3) + ps) * 4, (b_ & 4) ? (HI) : (LO)) << 7) | (unsigned)(dl << 5); \
        BUF[2 * b_] = *(const v4u*)(tab + off_); BUF[2 * b_ + 1] = *(const v4u*)(tab + off_ + 16); }
struct H4 { v4u h0, h1, l0, l1; };
#define PX_DOT8(Q, HH, HL) ah = __builtin_amdgcn_sdot8((int)(Q), (int)(HH), ah, false); al = __builtin_amdgcn_sdot8((int)(Q), (int)(HL), al, false);
__device__ __forceinline__ void peer_down_token(const v4u (&cur)[PX_D], const H4& h, const float hs, unsigned* prow, int dl, int ps) {
    int sm[8];
#pragma unroll
    for (int b = 0; b < 8; ++b) { const v4u q0 = cur[2 * b], q1 = cur[2 * b + 1];
        int ah = 0, al = 0;
        PX_DOT8(q0.x, h.h0.x, h.l0.x) PX_DOT8(q0.y, h.h0.y, h.l0.y) PX_DOT8(q0.z, h.h0.z, h.l0.z) PX_DOT8(q0.w, h.h0.w, h.l0.w)
        PX_DOT8(q1.x, h.h1.x, h.l1.x) PX_DOT8(q1.y, h.h1.y, h.l1.y) PX_DOT8(q1.z, h.h1.z, h.l1.z) PX_DOT8(q1.w, h.h1.w, h.l1.w)
        sm[b] = 16 * ah + al; }
    const bool c1 = (dl & 2) != 0, c0 = (dl & 1) != 0;
    int w4[4], w2[2];
#pragma unroll
    for (int k = 0; k < 4; ++k) { const int keep = c1 ? sm[4 + k] : sm[k], send = c1 ? sm[k] : sm[4 + k]; w4[k] = keep + dpp_i<0x4E>(send); }
#pragma unroll
    for (int k = 0; k < 2; ++k) { const int keep = c0 ? w4[2 + k] : w4[k], send = c0 ? w4[k] : w4[2 + k]; w2[k] = keep + dpp_i<0xB1>(send); }
    const float f0 = (float)w2[0] * hs, f1 = (float)w2[1] * hs;
    const float g0 = dpp_f<0x4E>(f0), g1 = dpp_f<0x4E>(f1);
    if (dl < 2) { prow[32 * dl + ps] = cvtpk(f0, g0); prow[32 * dl + 16 + ps] = cvtpk(f1, g1); }
}
__device__ __forceinline__ void peer_down(Frame& F, const Ptrs& P, const PeerPlace& pp) {
    const unsigned char* H8 = P.ws + WS_H8; const unsigned char* HSb = P.ws + WS_HS; const unsigned char* IDXb = P.ws + WS_IDX; unsigned char* PARTb = P.ws + WS_PART;
    const int lane = lane_id(), dl = lane & 3, ps = lane >> 2;
    const int tstep = pp.nloc * NWAVES;
    for (int u = pp.vx; u < 8; u += pp.nx) {
        const int s = u & 3, tend = ((u >> 2) + 1) * (T_ / 2), t0 = (u >> 2) * (T_ / 2) + pp.rank * NWAVES + F.wave;
        if (t0 >= tend) continue;
        const unsigned char* tab = P.ws + WS_ED + (size_t)s * 16384 * 128;
        const unsigned hoff = (unsigned)(s * 256 + dl * 32), ioff = (unsigned)lane * 4u;
        v4u bufA[PX_D], bufB[PX_D];
#define PD_CLAMP(T) ((T) < tend ? (T) : t0)
#define PD_META(H, HSC, TT) do { const unsigned char* hp_ = H8 + ((unsigned)(TT) * 1024u + hoff); H.h0 = *(const v4u*)hp_; H.h1 = *(const v4u*)(hp_ + 16); H.l0 = *(const v4u*)(hp_ + 128); H.l1 = *(const v4u*)(hp_ + 144); \
        HSC = *(const float*)(HSb + ((unsigned)(TT) * 32u + (unsigned)s * 4u)); } while (0)
#define PD_IDX(LO, HI, TT) do { LO = *(const int*)(IDXb + ((unsigned)(TT) * 512u + ioff)); HI = *(const int*)(IDXb + ((unsigned)(TT) * 512u + 256u + ioff)); } while (0)
        int nidx_lo, nidx_hi; PD_IDX(nidx_lo, nidx_hi, t0);
        PX_ISSUE(bufA, nidx_lo, nidx_hi);
        PD_IDX(nidx_lo, nidx_hi, PD_CLAMP(t0 + tstep));
        H4 ha, hb; float sa, sb; PD_META(ha, sa, t0);
        for (int t = t0; t < tend; t += 2 * tstep) {
            { const int tn = PD_CLAMP(t + tstep);
              PX_ISSUE(bufB, nidx_lo, nidx_hi); PD_IDX(nidx_lo, nidx_hi, PD_CLAMP(tn + tstep)); PD_META(hb, sb, tn);
              __builtin_amdgcn_sched_barrier(0);
              peer_down_token(bufA, ha, sa, (unsigned*)(PARTb + ((unsigned)(s * T_ + t) * 256u)), dl, ps);
              __builtin_amdgcn_sched_barrier(0); }
            if (t + tstep >= tend) break;
            { const int tc = t + tstep, tn = PD_CLAMP(tc + tstep);
              PX_ISSUE(bufA, nidx_lo, nidx_hi); PD_IDX(nidx_lo, nidx_hi, PD_CLAMP(tn + tstep)); PD_META(ha, sa, tn);
              __builtin_amdgcn_sched_barrier(0);
              peer_down_token(bufB, hb, sb, (unsigned*)(PARTb + ((unsigned)(s * T_ + tc) * 256u)), dl, ps);
              __builtin_amdgcn_sched_barrier(0); }
        }
    }
}
constexpr int PE_PD = 8;
#define PE_LOAD4(SLOT, IDV) SLOT = *(const v4u*)(EU + (((unsigned)(IDV) << 9) | l16))
#define PE_BP(ADDR, V) __builtin_amdgcn_ds_bpermute((ADDR), (V))
__device__ __forceinline__ void peer_up_tm(Frame& F, const Ptrs& P) {
    const bf16* HB = (const bf16*)(P.ws + WS_ST); const unsigned char* EU = P.ws + WS_EU;
    const int* IDX = (const int*)(P.ws + WS_IDX); const float* GATE = (const float*)(P.ws + WS_GATE); const unsigned* PART = (const unsigned*)(P.ws + WS_PART);
    const float* SCD = (const float*)(P.ws + WS_SMALL); const float* SCU = SCD + 16384;
    const int lane = lane_id(), l31 = lane & 31; const bool upper = lane >= 32;
    const unsigned l16 = (unsigned)l31 << 4;
    const int bp0 = upper ? 4 : 0;
    const int t0 = F.vcu * NWAVES + F.wave, tstep = F.G * NWAVES;
    if (t0 >= T_) return;
    float4 nfw[4];
#pragma unroll
    for (int k = 0; k < 4; ++k) nfw[k] = ((const float4*)(P.norm_final) + 8 * l31 + 4 * (lane >> 5))[k];
    int idx_lo = IDX[(size_t)t0 * 128 + lane], idx_hi = IDX[(size_t)t0 * 128 + 64 + lane];
    v4u hq[4];
#pragma unroll
    for (int k = 0; k < 4; ++k) hq[k] = ((const v4u*)(HB + (size_t)t0 * DM))[4 * l31 + k];
    float g_lo = GATE[(size_t)t0 * 128 + lane], g_hi = GATE[(size_t)t0 * 128 + 64 + lane];
    float pre_lo = 0.f, pre_hi = 0.f;
#pragma unroll
    for (int s = 0; s < 4; ++s) { const unsigned pp_ = PART[((size_t)s * T_ + t0) * 64 + lane]; pre_lo += bflo(pp_); pre_hi += bfhi(pp_); }
    float sdu_lo = SCD[idx_lo], sdu_hi = SCD[idx_hi], su_lo = SCU[idx_lo], su_hi = SCU[idx_hi];
    v4u ra[PE_PD];
#pragma unroll
    for (int j = 0; j < PE_PD; ++j) { const int id = PE_BP(bp0 + 8 * j, idx_lo); PE_LOAD4(ra[j], id); }
    int id_nx = PE_BP(bp0 + 8 * PE_PD, idx_lo);
    for (int t = t0; t < T_; t += tstep) {
        const int tn = (t + tstep < T_) ? t + tstep : t;
        const int nidx_lo = IDX[(size_t)tn * 128 + lane], nidx_hi = IDX[(size_t)tn * 128 + 64 + lane];
        v4u nh[4];
#pragma unroll
        for (int k = 0; k < 4; ++k) nh[k] = ((const v4u*)(HB + (size_t)tn * DM))[4 * l31 + k];
        const float ng_lo = GATE[(size_t)tn * 128 + lane], ng_hi = GATE[(size_t)tn * 128 + 64 + lane];
        unsigned npart[4];
#pragma unroll
        for (int s = 0; s < 4; ++s) npart[s] = PART[((size_t)s * T_ + tn) * 64 + lane];
        float ssq = 0.f;
#pragma unroll
        for (int k = 0; k < 4; ++k) { ssq = fmaf(bflo(hq[k].x), bflo(hq[k].x), ssq); ssq = fmaf(bfhi(hq[k].x), bfhi(hq[k].x), ssq); ssq = fmaf(bflo(hq[k].y), bflo(hq[k].y), ssq); ssq = fmaf(bfhi(hq[k].y), bfhi(hq[k].y), ssq);
            ssq = fmaf(bflo(hq[k].z), bflo(hq[k].z), ssq); ssq = fmaf(bfhi(hq[k].z), bfhi(hq[k].z), ssq); ssq = fmaf(bflo(hq[k].w), bflo(hq[k].w), ssq); ssq = fmaf(bfhi(hq[k].w), bfhi(hq[k].w), ssq); }
        ssq += swz_xor<1>(ssq); ssq += swz_xor<2>(ssq); ssq += swz_xor<4>(ssq); ssq += swz_xor<8>(ssq); ssq += swz_xor<16>(ssq);
        const float rstd = rsqrtf(ssq * (1.f / 1024.f) + EPS);
        const float act_lo = gelu_erf(pre_lo * sdu_lo * rstd) * g_lo * su_lo, act_hi = gelu_erf(pre_hi * sdu_hi * rstd) * g_hi * su_hi;
        float nsdu_lo = 0.f, nsdu_hi = 0.f, nsu_lo = 0.f, nsu_hi = 0.f;
        f32x2v acc[16];
#pragma unroll
        for (int i = 0; i < 16; ++i) acc[i] = (f32x2v){0.f, 0.f};
        float a_cur = __int_as_float(PE_BP(bp0, __float_as_int(act_lo)));
#pragma unroll
        for (int q = 0; q < 64; ++q) {
            const int qa = q + 1, ql = q + PE_PD + 1;
            float a_nx = 0.f;
            if (qa < 64) a_nx = __int_as_float(PE_BP(bp0 + 8 * (qa & 31), __float_as_int(qa < 32 ? act_lo : act_hi)));
            int id_n2;
            if (ql < 64) id_n2 = PE_BP(bp0 + 8 * (ql & 31), ql < 32 ? idx_lo : idx_hi);
            else id_n2 = PE_BP(bp0 + 8 * ((ql - 64) & 31), nidx_lo);
            __builtin_amdgcn_sched_barrier(0);
            { const f32x2v av = {a_cur, a_cur}; const v4u r = ra[q % PE_PD];
#define PE_FMA4(W, O) acc[O] = __builtin_elementwise_fma(av, (f32x2v)__builtin_amdgcn_cvt_scalef32_pk_f32_fp4(W, 1.0f, 0), acc[O]); acc[O + 1] = __builtin_elementwise_fma(av, (f32x2v)__builtin_amdgcn_cvt_scalef32_pk_f32_fp4(W, 1.0f, 1), acc[O + 1]); \
              acc[O + 2] = __builtin_elementwise_fma(av, (f32x2v)__builtin_amdgcn_cvt_scalef32_pk_f32_fp4(W, 1.0f, 2), acc[O + 2]); acc[O + 3] = __builtin_elementwise_fma(av, (f32x2v)__builtin_amdgcn_cvt_scalef32_pk_f32_fp4(W, 1.0f, 3), acc[O + 3]);
              PE_FMA4(r.x, 0) PE_FMA4(r.y, 4) PE_FMA4(r.z, 8) PE_FMA4(r.w, 12) }
            asm volatile("" : "+v"(acc[0]), "+v"(acc[1]), "+v"(acc[2]), "+v"(acc[3]), "+v"(acc[4]), "+v"(acc[5]), "+v"(acc[6]), "+v"(acc[7]));
            asm volatile("" : "+v"(acc[8]), "+v"(acc[9]), "+v"(acc[10]), "+v"(acc[11]), "+v"(acc[12]), "+v"(acc[13]), "+v"(acc[14]), "+v"(acc[15]));
            PE_LOAD4(ra[q % PE_PD], id_nx);
            if (q == 24) { nsdu_lo = SCD[nidx_lo]; nsdu_hi = SCD[nidx_hi]; nsu_lo = SCU[nidx_lo]; nsu_hi = SCU[nidx_hi]; }
            id_nx = id_n2; a_cur = a_nx;
            __builtin_amdgcn_sched_barrier(0);
        }
        { float a = 0.f, c = 0.f;
#pragma unroll
          for (int s = 0; s < 4; ++s) { a += bflo(npart[s]); c += bfhi(npart[s]); }
          pre_lo = a; pre_hi = c; }
        sdu_lo = nsdu_lo; sdu_hi = nsdu_hi; su_lo = nsu_lo; su_hi = nsu_hi;
        float y[32];
#pragma unroll
        for (int k = 0; k < 4; ++k) { y[8 * k] = bflo(hq[k].x); y[8 * k + 1] = bfhi(hq[k].x); y[8 * k + 2] = bflo(hq[k].y); y[8 * k + 3] = bfhi(hq[k].y); y[8 * k + 4] = bflo(hq[k].z); y[8 * k + 5] = bfhi(hq[k].z); y[8 * k + 6] = bflo(hq[k].w); y[8 * k + 7] = bfhi(hq[k].w); }
        float s2 = 0.f;
#pragma unroll
        for (int i = 0; i < 16; ++i) { y[2 * i] += sum_halves(acc[i][0]); y[2 * i + 1] += sum_halves(acc[i][1]); s2 = fmaf(y[2 * i], y[2 * i], s2); s2 = fmaf(y[2 * i + 1], y[2 * i + 1], s2); }
        s2 += swz_xor<1>(s2); s2 += swz_xor<2>(s2); s2 += swz_xor<4>(s2); s2 += swz_xor<8>(s2); s2 += swz_xor<16>(s2);
        const float r2 = rsqrtf(s2 * (1.f / 1024.f) + EPS);
        float4* o = (float4*)(P.out + (size_t)t * DM) + 8 * l31 + 4 * (lane >> 5);
#pragma unroll
        for (int k = 0; k < 4; ++k) { const float4 w = nfw[k];
            const float e0 = upper ? y[16 + 4 * k] : y[4 * k], e1 = upper ? y[17 + 4 * k] : y[4 * k + 1], e2 = upper ? y[18 + 4 * k] : y[4 * k + 2], e3 = upper ? y[19 + 4 * k] : y[4 * k + 3];
            o[k] = make_float4(e0 * r2 * w.x, e1 * r2 * w.y, e2 * r2 * w.z, e3 * r2 * w.w); }
        idx_lo = nidx_lo; idx_hi = nidx_hi; g_lo = ng_lo; g_hi = ng_hi;
#pragma unroll
        for (int k = 0; k < 4; ++k) hq[k] = nh[k];
    }
}
constexpr int TK_LDK = 136, TK_K2 = 34816, TK_SCR = 69632, TK_SP = 49;
__device__ __forceinline__ int mono_key(float x) { const int b = __float_as_int(x); return b ^ ((b >> 31) & 0x7fffffff); }
__device__ __forceinline__ float unmono(int m) { return __int_as_float(m ^ ((m >> 31) & 0x7fffffff)); }
__device__ __forceinline__ int max3i(int a, int b, int c) { return max(max(a, b), c); }
#define CEX(A, I, J) do { const int hi_ = max(A[I], A[J]), lo_ = min(A[I], A[J]); A[I] = hi_; A[J] = lo_; } while (0)
template <int N, int OFF, int K, int J, int LEN> struct BitonicStep {
    static __device__ __forceinline__ void run(int (&a)[LEN]) {
#pragma unroll
        for (int i = 0; i < N; ++i) { const int l = i ^ J; if (l > i) { if ((i & K) == 0) CEX(a, OFF + i, OFF + l); else CEX(a, OFF + l, OFF + i); } }
        if constexpr (J > 1) BitonicStep<N, OFF, K, (J >> 1), LEN>::run(a);
        else if constexpr (K < N) BitonicStep<N, OFF, (K << 1), K, LEN>::run(a);
    }
};
template <int N, int OFF, int LEN> __device__ __forceinline__ void bitonic_sort_desc(int (&a)[LEN]) { BitonicStep<N, OFF, 2, 1, LEN>::run(a); }
template <int OFF, int LEN> __device__ __forceinline__ void bitonic_merge16_desc(int (&a)[LEN]) { BitonicStep<16, OFF, 16, 8, LEN>::run(a); }
template <int A, int B, int LEN> __device__ __forceinline__ void merge_top16(int (&a)[LEN]) {
#pragma unroll
    for (int i = 0; i < 16; ++i) a[A + i] = max(a[A + i], a[B + 15 - i]);
    bitonic_merge16_desc<A, LEN>(a);
}
template <int LEN> __device__ __forceinline__ void pair_top16(int (&a)[LEN]) {
    int lo[16], up[16];
#pragma unroll
    for (int i = 0; i < 16; ++i) { const auto rr = __builtin_amdgcn_permlane32_swap((unsigned)a[i], (unsigned)a[i], false, false); lo[i] = (int)rr[0]; up[i] = (int)rr[1]; }
#pragma unroll
    for (int i = 0; i < 16; ++i) a[i] = max(lo[i], up[15 - i]);
    bitonic_merge16_desc<0, LEN>(a);
}
__device__ __forceinline__ void topk_half(const bf16x8 (&qf)[8], const LAS bf16* Kh, int r, int hh, int (&key)[64]) {
#pragma unroll
    for (int nt = 0; nt < 4; ++nt) {
        f32x16 sc;
#pragma unroll
        for (int i = 0; i < 16; ++i) sc[i] = 0.f;
#pragma unroll
        for (int kk = 0; kk < 8; ++kk) { const bf16x8 a = *(const LAS bf16x8*)(Kh + (32 * nt + r) * TK_LDK + 16 * kk + 8 * hh); sc = MFMA32(a, qf[kk], sc); }
#pragma unroll
        for (int i = 0; i < 16; ++i) key[nt * 16 + i] = (mono_key(sc[i]) & ~127) | (127 - (32 * nt + crow(i, hh)));
    }
    bitonic_sort_desc<16, 0, 64>(key); bitonic_sort_desc<16, 16, 64>(key); bitonic_sort_desc<16, 32, 64>(key); bitonic_sort_desc<16, 48, 64>(key);
    merge_top16<0, 16, 64>(key); merge_top16<32, 48, 64>(key); merge_top16<0, 32, 64>(key);
    pair_top16<64>(key);
}
__device__ __forceinline__ void topk_finish(const LAS int* scr, int hh, float rstd, int* IDX, float* GATE, int t, int hd) {
    const LAS int* la = scr + hh * 16; const LAS int* lb = scr + (1 - hh) * 16;
    float va[4], vb[16];
#pragma unroll
    for (int i = 0; i < 4; ++i) va[i] = unmono(la[i] & ~127);
#pragma unroll
    for (int j = 0; j < 16; ++j) vb[j] = unmono(lb[j] & ~127);
    int ck[32];
    {
        int q = 0;
#pragma unroll
        for (int i = 0; i < 4; ++i)
#pragma unroll
            for (int j = i; j < 16; ++j) if ((i + 1) * (j + 1) <= 16) {
                const int pos = hh ? (j * 16 + i) : (i * 16 + j);
                int k = (mono_key(va[i] + vb[j]) & ~255) | (255 - pos);
                if (i == j && hh) k = (int)0x80000000;
                ck[q++] = k; }
#pragma unroll
        for (int i = 27; i < 32; ++i) ck[i] = (int)0x80000000;
    }
    bitonic_sort_desc<32, 0, 32>(ck);
    pair_top16<32>(ck);
    const float vmax = unmono(ck[0] & ~255) * rstd;
    float ev[8]; int id[8]; float esum = 0.f; const int hm = -hh;
#pragma unroll
    for (int q = 0; q < 8; ++q) { const int wk = ck[q] ^ ((ck[q] ^ ck[8 + q]) & hm); const int pos = 255 - (wk & 255);
        const int n1 = 127 - (scr[pos >> 4] & 127), n2 = 127 - (scr[16 + (pos & 15)] & 127);
        id[q] = n1 * 128 + n2;
        ev[q] = exp2f((unmono(wk & ~255) * rstd - vmax) * LOG2E); esum += ev[q]; }
    esum = sum_halves(esum);
    const float inv = 1.f / esum;
    int4* ip = (int4*)(IDX + ((size_t)t * 8 + hd) * 16 + hh * 8); float4* gp = (float4*)(GATE + ((size_t)t * 8 + hd) * 16 + hh * 8);
    ip[0] = make_int4(id[0], id[1], id[2], id[3]); ip[1] = make_int4(id[4], id[5], id[6], id[7]);
    gp[0] = make_float4(ev[0] * inv, ev[1] * inv, ev[2] * inv, ev[3] * inv); gp[1] = make_float4(ev[4] * inv, ev[5] * inv, ev[6] * inv, ev[7] * inv);
}
constexpr int TQ_QH = 69632, TQ_QP = 272;
struct OneUnit { pg8::StaticOrder S; int i;
    __device__ __forceinline__ bool next(int j, pg8::Unit& u) const { return j == 0 ? S.next(i, u) : false; }
    __device__ __forceinline__ void a_ready(const pg8::Unit&) const {}
    __device__ __forceinline__ void done(const pg8::Unit&) const {}
};
struct EpiQTopk {
    static constexpr bool PERM = true, AFTER_DRAIN = true;
    const unsigned char* KB; const float* SSQ; int* IDX; float* GATE;
    __device__ __forceinline__ void dump(const pg8::f32x4 (&acc)[2][2][4][2], int bj, LAS unsigned char* QH, int wr, int wc, int fr, int fq) const {
#pragma unroll
        for (int ai = 0; ai < 2; ++ai)
#pragma unroll
            for (int m = 0; m < 4; ++m) { const pg8::f32x4 v0 = bj ? acc[ai][1][m][0] : acc[ai][0][m][0], v1 = bj ? acc[ai][1][m][1] : acc[ai][0][m][1];
                v4u w; w.x = cvtpk(v0[0], v0[1]); w.y = cvtpk(v0[2], v0[3]); w.z = cvtpk(v1[0], v1[1]); w.w = cvtpk(v1[2], v1[3]);
                *(LAS v4u*)(QH + (128 * ai + 64 * wr + 16 * m + fr) * TQ_QP + (32 * wc + 8 * fq) * 2) = w; }
    }
    __device__ __forceinline__ void fused(const pg8::f32x4 (&acc)[2][2][4][2], const pg8::Unit& u, int wr, int wc, int fr, int fq, LAS unsigned char* L, int wid, int lane) const {
        LAS bf16* K1 = (LAS bf16*)L; LAS bf16* K2 = (LAS bf16*)(L + TK_K2); LAS unsigned char* QH = L + TQ_QH;
        const int tid_ = wid * 64 + lane, r = lane & 31, hh = lane >> 5;
        { v4u kq[8];
#pragma unroll
          for (int q = 0; q < 8; ++q) kq[q] = ((const v4u*)KB)[tid_ + 512 * q];
          dump(acc, 0, QH, wr, wc, fr, fq);
#pragma unroll
          for (int q = 0; q < 8; ++q) { const int j = tid_ + 512 * q, n = (j >> 4) & 127, k8 = j & 15; *(LAS v4u*)(((j >> 11) ? K2 : K1) + n * TK_LDK + 8 * k8) = kq[q]; } }
        __syncthreads();
        const int t = u.pm * 256 + 32 * wid + r;
        float rstd;
        { const float4* sp = (const float4*)(SSQ + (size_t)t * 16); const float4 a = sp[0], b = sp[1], c = sp[2], d = sp[3];
          rstd = rsqrtf(((a.x + a.y + a.z + a.w) + (b.x + b.y + b.z + b.w) + (c.x + c.y + c.z + c.w) + (d.x + d.y + d.z + d.w)) * (1.f / 1024.f) + EPS); }
        const LAS unsigned char* qrow = QH + (32 * wid + r) * TQ_QP + 16 * hh;
        int key[64], list0[16];
        { bf16x8 qf[8];
#pragma unroll
          for (int kk = 0; kk < 8; ++kk) qf[kk] = *(const LAS bf16x8*)(qrow + 32 * kk);
          topk_half(qf, K1, r, hh, key);
#pragma unroll
          for (int i = 0; i < 16; ++i) list0[i] = key[i]; }
        __syncthreads();
        dump(acc, 1, QH, wr, wc, fr, fq);
        __syncthreads();
        { bf16x8 qf[8];
#pragma unroll
          for (int kk = 0; kk < 8; ++kk) qf[kk] = *(const LAS bf16x8*)(qrow + 32 * kk);
          topk_half(qf, K2, r, hh, key); }
        LAS int* scr = (LAS int*)(QH + 32 * wid * TQ_QP) + r * TK_SP;
        LDS_WAIT();
        if (hh == 0) {
#pragma unroll
            for (int i = 0; i < 16; ++i) { scr[i] = list0[i]; scr[16 + i] = key[i]; } }
        topk_finish(scr, hh, rstd, IDX, GATE, t, u.pn);
        __syncthreads();
    }
};

constexpr int AT_KP = 72, AT_VP = 264;
constexpr int AT_K = 0, AT_VT = 36864, AT_BT = 36864 + 33792;
__device__ __forceinline__ void attn_phase(Frame& F, const Ptrs& P) {
    const bf16* PROJ = (const bf16*)(P.ws + WS_PROJ); bf16* CAT = (bf16*)(P.ws + WS_XN);
    LAS unsigned char* L = F.lds + RING_OFF;
    LAS bf16* Ks = (LAS bf16*)(L + AT_K); LAS bf16* Vt = (LAS bf16*)(L + AT_VT); LAS float* btab = (LAS float*)(L + AT_BT);
    const int lane = lane_id(), tid_ = F.wave * 64 + lane, r = lane & 31, hh = lane >> 5;
    for (int u = F.vcu; u < 256; u += F.G) {
        const int hkv = u & 1, n = (u >> 1) & 31, b = u >> 6;
        const int trow0 = b * SEQ + n * 128;
        v4u kvq[4], vvq[4];
#pragma unroll
        for (int q = 0; q < 4; ++q) { const int i = tid_ + 512 * q, kj = i >> 3, ch = i & 7; const bool ok = (n > 0) || (kj >= 128);
            kvq[q] = (v4u){0u, 0u, 0u, 0u}; vvq[q] = (v4u){0u, 0u, 0u, 0u};
            if (ok) { const bf16* rowp = PROJ + (size_t)(trow0 - 128 + kj) * NPROJ + hkv * 64 + ch * 8; kvq[q] = *(const v4u*)(rowp + PJ_K); vvq[q] = *(const v4u*)(rowp + PJ_V); } }
#pragma unroll
        for (int q = 0; q < 4; ++q) {
            const int i = tid_ + 512 * q, kj = i >> 3, ch = i & 7;
            const v4u kv = kvq[q], vv = vvq[q];
            *(LAS v4u*)(Ks + kj * AT_KP + ch * 8) = kv;
            LAS bf16* vp = Vt + (ch * 8) * AT_VP + kj;
            vp[0] = (bf16)(vv.x & 0xffffu); vp[AT_VP] = (bf16)(vv.x >> 16); vp[2 * AT_VP] = (bf16)(vv.y & 0xffffu); vp[3 * AT_VP] = (bf16)(vv.y >> 16);
            vp[4 * AT_VP] = (bf16)(vv.z & 0xffffu); vp[5 * AT_VP] = (bf16)(vv.z >> 16); vp[6 * AT_VP] = (bf16)(vv.w & 0xffffu); vp[7 * AT_VP] = (bf16)(vv.w >> 16);
        }
        { const float* BT = (const float*)(P.ws + WS_BTAB) + hkv * 768;
          const float b0 = BT[tid_], b1 = (tid_ < 256) ? BT[512 + tid_] : 0.f;
          btab[tid_] = b0; if (tid_ < 256) btab[512 + tid_] = b1; }
        __syncthreads();
        const int g = F.wave & 3, h = hkv * 4 + g;
        const float sink2 = P.sinks[h] * LOG2E;
#pragma unroll 1
        for (int qq = 0; qq < 2; ++qq) {
            const int qt = (F.wave >> 2) * 2 + qq, t = trow0 + 32 * qt + r;
            bf16x8 qf[4];
#pragma unroll
            for (int kk = 0; kk < 4; ++kk) qf[kk] = *(const bf16x8*)(PROJ + (size_t)t * NPROJ + h * 64 + 16 * kk + 8 * hh);
            f32x16 sc[5];
#pragma unroll
            for (int j = 0; j < 5; ++j) {
#pragma unroll
                for (int i = 0; i < 16; ++i) sc[j][i] = 0.f;
#pragma unroll
                for (int kk = 0; kk < 4; ++kk) { const bf16x8 a = *(const LAS bf16x8*)(Ks + (32 * (qt + j) + r) * AT_KP + 16 * kk + 8 * hh); sc[j] = MFMA32(a, qf[kk], sc[j]); }
            }
            float m = sink2;
            const LAS float* bt = btab + g * 192 + 160 + r - 4 * hh;
#pragma unroll
            for (int j = 0; j < 5; ++j) {
                const bool tile_ok = (n > 0) || (qt + j >= 4);
#pragma unroll
                for (int i = 0; i < 16; ++i) { const int dist = 128 + r - (32 * j + crow(i, hh));
                    const bool ok = tile_ok && (j == 0 ? dist < 128 : (j == 4 ? dist >= 0 : true));
                    const float s = sc[j][i] * (0.125f * LOG2E) + bt[-(32 * j + (i & 3) + 8 * (i >> 2))];
                    sc[j][i] = ok ? s : -INFINITY; m = fmaxf(m, sc[j][i]); }
            }
            m = max_halves(m);
            float l = 0.f;
#pragma unroll
            for (int j = 0; j < 5; ++j)
#pragma unroll
                for (int i = 0; i < 16; ++i) { sc[j][i] = exp2f(sc[j][i] - m); l += sc[j][i]; }
            l = sum_halves(l);
            l += exp2f(sink2 - m);
            const float inv = 1.f / l;
            f32x16 o[2];
#pragma unroll
            for (int i = 0; i < 16; ++i) { o[0][i] = 0.f; o[1][i] = 0.f; }
#pragma unroll
            for (int j = 0; j < 5; ++j)
#pragma unroll
                for (int sg = 0; sg < 2; ++sg) {
                    const bf16x8 pf = pack8(sc[j], sg);
#pragma unroll
                    for (int dt = 0; dt < 2; ++dt) {
                        const LAS bf16* vb = Vt + (32 * dt + r) * AT_VP + 32 * (qt + j) + 16 * sg + 4 * hh;
                        const s16x4 lo = *(const LAS s16x4*)(vb), hi = *(const LAS s16x4*)(vb + 8);
                        o[dt] = MFMA32(__builtin_shufflevector(lo, hi, 0, 1, 2, 3, 4, 5, 6, 7), pf, o[dt]);
                    }
                }
            bf16* op = CAT + (size_t)t * DM + h * 64 + 4 * hh;
#pragma unroll
            for (int dt = 0; dt < 2; ++dt)
#pragma unroll
                for (int g4 = 0; g4 < 4; ++g4)
                    *(unsigned long long*)(op + 32 * dt + 8 * g4) = (unsigned long long)cvtpk(o[dt][4 * g4] * inv, o[dt][4 * g4 + 1] * inv) | ((unsigned long long)cvtpk(o[dt][4 * g4 + 2] * inv, o[dt][4 * g4 + 3] * inv) << 32);
        }
        __syncthreads();
    }
}
struct Args { Ptrs p; };
__global__ void __launch_bounds__(NWAVES * 64, 2) hymba_fwd(Args args) {
    extern __shared__ __attribute__((aligned(16))) unsigned char lds[];
    const Ptrs& P = args.p;
    Frame F;
    F.lds = (LAS unsigned char*)lds;
    F.MISC = (volatile LAS unsigned*)(F.lds + MISC_OFF);
    F.wave = __builtin_amdgcn_readfirstlane(threadIdx.x >> 6);
    F.G = gridDim.x; { const int bx = blockIdx.x; F.vcu = (F.G % 8 == 0) ? (bx % 8) * (F.G / 8) + bx / 8 : bx; }
    F.ctl = (gu32*)(P.ws + WS_CTL);
    for (int u = threadIdx.x; u < (LDS_BYTES - LDSCTL_OFF) / 4; u += NWAVES * 64) ((LAS unsigned*)(F.lds + LDSCTL_OFF))[u] = 0u;
    __syncthreads();
    XcdBarrier bar = xcd_barrier_post((unsigned*)(F.ctl + CW_BAR), F.MISC + 8);
#define GRID_BAR() xcd_barrier(bar)

    bf16* XN = (bf16*)(P.ws + WS_XN); bf16* PROJ = (bf16*)(P.ws + WS_PROJ); bf16* HB = (bf16*)(P.ws + WS_ST);
    p0_prologue(F, P);
    GRID_BAR();
    { pg8::Gemm g{XN, (const bf16*)(P.ws + WS_WIN), T_, NPROJ, DM, F.wave}; pg8::StaticOrder S; S.init(T_, NPROJ, F.G, (int)blockIdx.x);
      pg8::EpiBf16<0> E{PROJ, NPROJ, nullptr, 0, 0, 1.f};
      pg8::gemm_phase<pg8::EpiBf16<0>, pg8::StaticOrder, PG8_ALIGN, PG8_SP2>(F.lds + RING_OFF, g, S, E); }
    if (F.G == 256 && blockIdx.x >= 64) p1_slack(F, P, ((int)blockIdx.x - 64) * NWAVES + F.wave, 192 * NWAVES);
    else if (F.G != 256) p1_slack(F, P, F.vcu * NWAVES + F.wave, F.G * NWAVES);
    GRID_BAR();
    ssd_s1(F, P);
    xcd_arrive(bar, F.MISC + 14);
    attn_phase(F, P);
    xcd_wait(bar, F.MISC + 14);
    ssd_s2(F, P);
    GRID_BAR();
    ssd_s3(F, P);
    GRID_BAR();
    { pg8::Gemm g{XN, (const bf16*)(P.ws + WS_WOUT), T_, DM, DM, F.wave}; pg8::StaticOrder S; S.init(T_, DM, F.G, (int)blockIdx.x);
      EpiResH E{P.x, HB, (float*)(P.ws + WS_SSQ)};
      pg8::gemm_phase<EpiResH, pg8::StaticOrder, PG8_ALIGN, PG8_SP2>(F.lds + RING_OFF, g, S, E); }
    GRID_BAR();
    { pg8::Gemm g{HB, (const bf16*)(P.ws + WS_WQ), T_, 2048, DM, F.wave}; pg8::StaticOrder S; S.init(T_, 2048, F.G, (int)blockIdx.x);
      EpiQTopk E{P.ws + WS_KEYB, (const float*)(P.ws + WS_SSQ), (int*)(P.ws + WS_IDX), (float*)(P.ws + WS_GATE)};
#pragma unroll 1
      for (int ui = 0; ui < 64; ++ui) { pg8::Unit u0; if (!S.next(ui, u0)) break;
          OneUnit S1{S, ui};
          pg8::gemm_phase<EpiQTopk, OneUnit, PG8_ALIGN, PG8_SP2>(F.lds + RING_OFF, g, S1, E); } }
    h_quant_rows(F, P);
    GRID_BAR();
    { const PeerPlace pp = peer_place(F);
      peer_down(F, P, pp); }
    GRID_BAR();
    peer_up_tm(F, P);
}

extern "C" void kernel_launch(void* const* d_in, const int* in_sizes, int n_in, void* d_out, int out_size, void* d_ws, size_t ws_size, hipStream_t stream) {
    static int grid = 0;
    if (grid == 0) {
        if (n_in != 19 || out_size != T_ * DM || ws_size < WS_END) { fprintf(stderr, "kernel_launch: unexpected shapes (n_in %d, out %d, ws %zu)\n", n_in, out_size, ws_size); grid = -1; return; }
        int dev = 0, cus = 0, per_cu = 0;
        if (hipGetDevice(&dev) != hipSuccess || hipDeviceGetAttribute(&cus, hipDeviceAttributeMultiprocessorCount, dev) != hipSuccess) { grid = -1; return; }
        if (hipFuncSetAttribute((const void*)hymba_fwd, hipFuncAttributeMaxDynamicSharedMemorySize, LDS_BYTES) != hipSuccess) { fprintf(stderr, "kernel_launch: hipFuncSetAttribute failed\n"); grid = -1; return; }
        if (hipOccupancyMaxActiveBlocksPerMultiprocessor(&per_cu, (const void*)hymba_fwd, NWAVES * 64, LDS_BYTES) != hipSuccess || per_cu < 1) { fprintf(stderr, "kernel_launch: occupancy query says %d blocks per CU\n", per_cu); grid = -1; (void)hipGetLastError(); return; }
        grid = cus;
    }
    if (grid < 0) return;
    (void)hipMemsetAsync((char*)d_ws + WS_CTL, 0, CTL_ZERO_BYTES, stream);
    Args a{};
    const float** pp = (const float**)&a.p;
    for (int i = 0; i < 19; ++i) pp[i] = (const float*)d_in[i];
    a.p.out = (float*)d_out; a.p.ws = (unsigned char*)d_ws;
    hipLaunchKernelGGL(hymba_fwd, dim3(grid), dim3(NWAVES * 64), LDS_BYTES, stream, a);
}
```

```cpp
#include <hip/hip_runtime.h>
#include <cstdio>
#include <cstdint>
#include <math.h>
namespace pg8 {
#define PG8_LAS __attribute__((address_space(3)))
typedef unsigned short bf16_t;
typedef short bf16x8 __attribute__((ext_vector_type(8)));
typedef float f32x4 __attribute__((ext_vector_type(4)));
typedef unsigned u32x4 __attribute__((ext_vector_type(4)));
constexpr int BM = 256, BK = 64, HALF = 128, HTB = HALF * BK * 2  , STAGE_BYTES = 8 * HTB, NXCD = 8, WGM = 8;

__host__ __device__ __forceinline__ int lds_byte(int r, int c) { const int st = (r >> 4) * 2 + (c >> 5), rr = r & 15, cc = c & 31, ob = rr * 64 + cc * 2; return st * 1024 + (ob ^ (((ob >> 9) & 1) << 5)); }
__host__ __device__ __forceinline__ void stage_rc(int b, int& R, int& C) { const int st = b / 1024, sb = b % 1024, swz = sb ^ (((sb >> 9) & 1) << 5); R = (st >> 1) * 16 + swz / 64; C = (st & 1) * 32 + (swz % 64) / 2; }
__host__ __device__ __forceinline__ int perm32(int rho) { const int n = rho >> 4, i = rho & 15; return 8 * (i >> 2) + 4 * n + (i & 3); }

struct Unit { int pm, pn; };
struct Gemm { const bf16_t* A; const bf16_t* Bt; int M, N, K, wave; };

struct StaticOrder {
    int nM, nN, nwg, G, c;
    __host__ __device__ void init(int M, int N, int G_, int c_) { nM = M / BM; nN = N / BM; nwg = nM * nN; G = G_; c = c_; }
    __host__ __device__ bool next(int i, Unit& u) const {
        const long L = (long)i * G + c; if (L >= nwg) return false;
        int wgid = (int)L; { const int q = nwg / NXCD, r = nwg % NXCD, xcd = wgid % NXCD, off = wgid / NXCD; wgid = (xcd < r ? xcd * (q + 1) : r * (q + 1) + (xcd - r) * q) + off; }
        const int nig = WGM * nN, gid = wgid / nig, fm = gid * WGM, gsz = (nM - fm) < WGM ? (nM - fm) : WGM;
        u.pm = fm + ((wgid % nig) % gsz); u.pn = (wgid % nig) / gsz; return true;
    }
    __device__ __forceinline__ void a_ready(const Unit&) const {}
    __device__ __forceinline__ void done(const Unit&) const {}
};

__device__ __forceinline__ unsigned cvt_pk_bf16(float lo, float hi) { unsigned r; asm volatile("v_cvt_pk_bf16_f32 %0, %1, %2" : "=v"(r) : "v"(lo), "v"(hi)); return r; }
typedef float f32x2 __attribute__((ext_vector_type(2)));
__device__ __forceinline__ f32x2 gelu_pk(f32x2 v) {
    const f32x2 av = __builtin_elementwise_abs(v), d = av * 0.2316418882f + 1.0f;
    f32x2 t; t.x = __builtin_amdgcn_rcpf(d.x); t.y = __builtin_amdgcn_rcpf(d.y);
    f32x2 q = t * 0.5307027145f + (-0.7265760135f); q = q * t + 0.7107068705f; q = q * t + (-0.142248368f); q = q * t + 0.127414796f; q = q * t;
    const f32x2 s = (v * v) * (-0.72134752044f);
    f32x2 e; e.x = __builtin_amdgcn_exp2f(s.x); e.y = __builtin_amdgcn_exp2f(s.y);
    const f32x2 m = v * (q * e), r = v - m;
    f32x2 o; o.x = v.x < 0.f ? m.x : r.x; o.y = v.y < 0.f ? m.y : r.y; return o;
}

template <int ACT  > struct EpiBf16 {
    static constexpr bool PERM = true, AFTER_DRAIN = false; static_assert(ACT == 0 || ACT == 1, "EpiBf16: ACT is 0 (none) or 1 (gelu_pk)");
    bf16_t* O; int ldc; const float* bias; int split_cols; size_t split_stride; float scale0;
    __device__ __forceinline__ void operator()(const f32x4 (&acc)[2][2][4][2], const Unit& u, int wr, int wc, int fr, int fq) const {
        const int row0 = u.pm * BM + wr * 64 + fr; int colt = u.pn * BM; bf16_t* base = O;
        float sc = 1.f; if (split_cols) { const int t = colt / split_cols; base += (size_t)t * split_stride; colt -= t * split_cols; if (t == 0) sc = scale0; }
        const int col0 = colt + wc * 32 + 8 * fq, bcol0 = u.pn * BM + wc * 32 + 8 * fq;
        f32x4 bv[2][2];
#pragma unroll
        for (int bj = 0; bj < 2; ++bj)
#pragma unroll
            for (int n = 0; n < 2; ++n) bv[bj][n] = bias ? *(const f32x4*)(bias + bcol0 + bj * HALF + 4 * n) : (f32x4){0.f, 0.f, 0.f, 0.f};
#pragma unroll
        for (int ai = 0; ai < 2; ++ai)
#pragma unroll
            for (int m = 0; m < 4; ++m) { bf16_t* rowp = base + (size_t)(row0 + ai * HALF + m * 16) * ldc + col0;
#pragma unroll
                for (int bj = 0; bj < 2; ++bj) { f32x4 v0 = acc[ai][bj][m][0] + bv[bj][0], v1 = acc[ai][bj][m][1] + bv[bj][1];
                    if (ACT == 1) { f32x2 a = gelu_pk((f32x2){v0[0], v0[1]}), b = gelu_pk((f32x2){v0[2], v0[3]}), c = gelu_pk((f32x2){v1[0], v1[1]}), d = gelu_pk((f32x2){v1[2], v1[3]});
                        v0 = (f32x4){a.x, a.y, b.x, b.y}; v1 = (f32x4){c.x, c.y, d.x, d.y}; }
                    v0 = v0 * sc; v1 = v1 * sc; u32x4 w; w.x = cvt_pk_bf16(v0[0], v0[1]); w.y = cvt_pk_bf16(v0[2], v0[3]); w.z = cvt_pk_bf16(v1[0], v1[1]); w.w = cvt_pk_bf16(v1[2], v1[3]);
                    *(u32x4*)(rowp + bj * HALF) = w; } }
    }
};
template <class Epi, class Sched, bool ALIGN_EPI = false, bool SP2 = false>
__device__ __forceinline__ void gemm_phase(PG8_LAS unsigned char* lds, const Gemm g, const Sched& S, const Epi& E) {
    int lane_l; asm volatile("v_mbcnt_lo_u32_b32 %0, -1, 0\n\tv_mbcnt_hi_u32_b32 %0, -1, %0" : "=v"(lane_l));
    const int wid = g.wave, lane = lane_l, tid = wid * 64 + lane,
              wr = wid >> 2, wc = wid & 3, fr = lane & 15, fq = lane >> 4;
    const int K = g.K, nt = K / BK;
    unsigned voffA[2], voffB[2];
#pragma unroll
    for (int i = 0; i < 2; ++i) { int R, C; stage_rc(tid * 16 + i * 8192, R, C); const int Rb = Epi::PERM ? ((R & ~31) + perm32(R & 31)) : R;
        voffA[i] = (unsigned)(R * K + C) * 2u; voffB[i] = (unsigned)(Rb * K + C) * 2u; }
    const size_t kstep = (size_t)(BK * 2);
    const size_t hstep = (size_t)HALF * K * 2;
    const size_t tstep = 2 * hstep;
    const unsigned ldsw = (unsigned)wid * 1024u;
    const int aoff = lds_byte(wr * 64 + fr, fq * 8), boff = lds_byte(wc * 32 + fr, fq * 8);
#define PG8_SA(b, h) (((b) * 2 + (h)) * HTB)
#define PG8_SB(b, h) ((4 + (b) * 2 + (h)) * HTB)
#define PG8_STAGE(bufoff, gbase, voff) do { _Pragma("unroll") for (int _i = 0; _i < 2; ++_i) \
        __builtin_amdgcn_global_load_lds((const unsigned*)((const char*)(gbase) + (voff)[_i]), (PG8_LAS unsigned*)(lds + (bufoff) + ldsw + _i * 8192), 16, 0, 0); } while (0)
#define PG8_LDA(dst, b, h) do { _Pragma("unroll") for (int m = 0; m < 4; ++m) _Pragma("unroll") for (int k = 0; k < 2; ++k) dst[m][k] = *(const PG8_LAS bf16x8*)(lds + PG8_SA(b, h) + aoff + m * 2048 + k * 1024); } while (0)
#define PG8_LDB(dst, b, h) do { _Pragma("unroll") for (int n = 0; n < 2; ++n) _Pragma("unroll") for (int k = 0; k < 2; ++k) dst[n][k] = *(const PG8_LAS bf16x8*)(lds + PG8_SB(b, h) + boff + n * 2048 + k * 1024); } while (0)
#define PG8_MMA(ai, bj, At, Bt) do { __builtin_amdgcn_s_setprio(1); _Pragma("unroll") for (int m = 0; m < 4; ++m) _Pragma("unroll") for (int n = 0; n < 2; ++n) _Pragma("unroll") for (int k = 0; k < 2; ++k) \
        acc[ai][bj][m][n] = __builtin_amdgcn_mfma_f32_16x16x32_bf16(Bt[n][k], At[m][k], acc[ai][bj][m][n], 0, 0, 0); __builtin_amdgcn_s_setprio(0); } while (0)
#define PG8_WAIT_V(n) asm volatile("s_waitcnt vmcnt(" #n ")" ::: "memory")
#define PG8_WAIT_L(n) asm volatile("s_waitcnt lgkmcnt(" #n ")" ::: "memory")
#define PG8_BAR __builtin_amdgcn_s_barrier()
#define PG8_SCHED __builtin_amdgcn_sched_barrier(0)
    Unit cur, nxt; int ui = 0;
    if (!S.next(0, cur)) return;
    f32x4 acc[2][2][4][2];
#pragma unroll
    for (int a = 0; a < 2; ++a)
#pragma unroll
        for (int b = 0; b < 2; ++b)
#pragma unroll
            for (int m = 0; m < 4; ++m)
#pragma unroll
                for (int n = 0; n < 2; ++n) acc[a][b][m][n] = (f32x4){0.f, 0.f, 0.f, 0.f};
    bf16x8 At[4][2], B0[2][2], B1[2][2];
    const char* cA = (const char*)g.A + (size_t)cur.pm * tstep; const char* cB = (const char*)g.Bt + (size_t)cur.pn * tstep;
    S.a_ready(cur);
    if constexpr (SP2) {
        PG8_STAGE(PG8_SB(0, 0), cB, voffB); PG8_STAGE(PG8_SB(0, 1), cB + hstep, voffB); PG8_STAGE(PG8_SA(0, 0), cA, voffA); PG8_STAGE(PG8_SA(0, 1), cA + hstep, voffA);
        if (wr == 1) PG8_BAR;
        PG8_WAIT_V(2); PG8_BAR;
        PG8_STAGE(PG8_SB(1, 0), cB + kstep, voffB); PG8_STAGE(PG8_SA(1, 0), cA + kstep, voffA); PG8_STAGE(PG8_SB(1, 1), cB + hstep + kstep, voffB);
        PG8_WAIT_V(6); PG8_BAR;
    } else {
        PG8_STAGE(PG8_SB(0, 0), cB, voffB); PG8_STAGE(PG8_SA(0, 0), cA, voffA); PG8_STAGE(PG8_SB(0, 1), cB + hstep, voffB); PG8_STAGE(PG8_SA(0, 1), cA + hstep, voffA);
        if (wr == 1) PG8_BAR;
        PG8_WAIT_V(4); PG8_BAR;
        PG8_STAGE(PG8_SB(1, 0), cB + kstep, voffB); PG8_STAGE(PG8_SA(1, 0), cA + kstep, voffA); PG8_STAGE(PG8_SB(1, 1), cB + hstep + kstep, voffB);
        PG8_WAIT_V(6); PG8_BAR;
    }
    for (;;) {
        const bool has_next = S.next(ui + 1, nxt);
        const char* nA = has_next ? (const char*)g.A + (size_t)nxt.pm * tstep : cA; const char* nB = has_next ? (const char*)g.Bt + (size_t)nxt.pn * tstep : cB;
        for (int t = 0; t < nt; t += 2) {
            const bool last = (t == nt - 2);
            const char* a1 = cA + (size_t)(t + 1) * kstep;
            const char* a2 = last ? nA : cA + (size_t)(t + 2) * kstep; const char* b2 = last ? nB : cB + (size_t)(t + 2) * kstep;
            const char* a3 = a2 + kstep; const char* b3 = b2 + kstep;
            if (last && has_next) S.a_ready(nxt);
            if constexpr (SP2) {
            PG8_LDB(B0, 0, 0); PG8_LDB(B1, 0, 1); PG8_SCHED; PG8_LDA(At, 0, 0); PG8_STAGE(PG8_SA(1, 1), a1 + hstep, voffA);
            PG8_WAIT_V(8); PG8_WAIT_L(0); PG8_BAR; PG8_MMA(0, 0, At, B0); PG8_MMA(0, 1, At, B1); PG8_BAR; PG8_SCHED;
            PG8_LDA(At, 0, 1); PG8_STAGE(PG8_SB(0, 0), b2, voffB); PG8_STAGE(PG8_SB(0, 1), b2 + hstep, voffB); PG8_STAGE(PG8_SA(0, 0), a2, voffA);
            PG8_WAIT_V(8); PG8_WAIT_L(0); PG8_BAR; PG8_MMA(1, 0, At, B0); PG8_MMA(1, 1, At, B1); PG8_BAR; PG8_SCHED;
            PG8_LDB(B0, 1, 0); PG8_LDB(B1, 1, 1); PG8_SCHED; PG8_LDA(At, 1, 0); PG8_STAGE(PG8_SA(0, 1), a2 + hstep, voffA);
            PG8_WAIT_V(8); PG8_WAIT_L(0); PG8_BAR; PG8_MMA(0, 0, At, B0); PG8_MMA(0, 1, At, B1); PG8_BAR; PG8_SCHED;
            PG8_LDA(At, 1, 1); PG8_STAGE(PG8_SB(1, 0), b3, voffB); PG8_STAGE(PG8_SB(1, 1), b3 + hstep, voffB); PG8_STAGE(PG8_SA(1, 0), a3, voffA);
            PG8_WAIT_V(8); PG8_WAIT_L(0); PG8_BAR; PG8_MMA(1, 0, At, B0); PG8_MMA(1, 1, At, B1); PG8_BAR; PG8_SCHED;
            } else {
            PG8_LDB(B0, 0, 0); PG8_SCHED; PG8_LDA(At, 0, 0); PG8_STAGE(PG8_SA(1, 1), a1 + hstep, voffA);
            PG8_WAIT_L(8); PG8_BAR; PG8_WAIT_L(0); PG8_MMA(0, 0, At, B0); PG8_BAR; PG8_SCHED;
            PG8_LDB(B1, 0, 1); PG8_STAGE(PG8_SB(0, 0), b2, voffB);
            PG8_BAR; PG8_WAIT_L(0); PG8_MMA(0, 1, At, B1); PG8_BAR;
            PG8_LDA(At, 0, 1); PG8_STAGE(PG8_SA(0, 0), a2, voffA);
            PG8_BAR; PG8_WAIT_L(0); PG8_MMA(1, 0, At, B0); PG8_BAR; PG8_SCHED;
            PG8_STAGE(PG8_SB(0, 1), b2 + hstep, voffB);
            PG8_WAIT_V(6); PG8_BAR; PG8_MMA(1, 1, At, B1); PG8_BAR;
            PG8_LDB(B0, 1, 0); PG8_SCHED; PG8_LDA(At, 1, 0); PG8_STAGE(PG8_SA(0, 1), a2 + hstep, voffA);
            PG8_WAIT_L(8); PG8_BAR; PG8_WAIT_L(0); PG8_MMA(0, 0, At, B0); PG8_BAR; PG8_SCHED;
            PG8_LDB(B1, 1, 1); PG8_STAGE(PG8_SB(1, 0), b3, voffB);
            PG8_BAR; PG8_WAIT_L(0); PG8_MMA(0, 1, At, B1); PG8_BAR;
            PG8_LDA(At, 1, 1); PG8_STAGE(PG8_SA(1, 0), a3, voffA);
            PG8_BAR; PG8_WAIT_L(0); PG8_MMA(1, 0, At, B0); PG8_BAR; PG8_SCHED;
            PG8_STAGE(PG8_SB(1, 1), b3 + hstep, voffB);
            PG8_WAIT_V(6); PG8_BAR; PG8_MMA(1, 1, At, B1); PG8_BAR;
            }
        }
        if constexpr (ALIGN_EPI) { if (wr == 0) PG8_BAR; }
        if constexpr (!Epi::AFTER_DRAIN) { E(acc, cur, wr, wc, fr, fq); S.done(cur); }
        if (!has_next) break;
#pragma unroll
        for (int a = 0; a < 2; ++a)
#pragma unroll
            for (int b = 0; b < 2; ++b)
#pragma unroll
                for (int m = 0; m < 4; ++m)
#pragma unroll
                    for (int n = 0; n < 2; ++n) acc[a][b][m][n] = (f32x4){0.f, 0.f, 0.f, 0.f};
        cur = nxt; cA = nA; cB = nB; ++ui;
        if constexpr (ALIGN_EPI) { if (wr == 1) PG8_BAR; }
    }
    PG8_WAIT_V(0);
    if constexpr (!ALIGN_EPI) { if (wr == 0) PG8_BAR; }
    PG8_BAR;
    if constexpr (Epi::AFTER_DRAIN) { E.fused(acc, cur, wr, wc, fr, fq, lds, wid, lane); S.done(cur); }
#undef PG8_SA
#undef PG8_SB
#undef PG8_STAGE
#undef PG8_LDA
#undef PG8_LDB
#undef PG8_MMA
#undef PG8_WAIT_V
#undef PG8_WAIT_L
#undef PG8_BAR
#undef PG8_SCHED
}
}

#ifndef PG8_SP2
#define PG8_SP2 true
#endif
#ifndef PG8_ALIGN
#define PG8_ALIGN true
#endif
#define GAS __attribute__((address_space(1)))
#define LAS __attribute__((address_space(3)))
typedef unsigned short bf16;
typedef unsigned v4u __attribute__((ext_vector_type(4)));
typedef float f32x4 __attribute__((ext_vector_type(4)));
typedef short bf16x8 __attribute__((ext_vector_type(8)));
typedef GAS unsigned gu32;
typedef GAS unsigned long long gu64;
#define RLX_AGENT __ATOMIC_RELAXED, __HIP_MEMORY_SCOPE_AGENT
#define LDS_WAIT() asm volatile("s_waitcnt lgkmcnt(0)" ::: "memory")
#define VM_WAIT() asm volatile("s_waitcnt vmcnt(0)" ::: "memory")
__device__ __forceinline__ unsigned long long rt() { return __builtin_amdgcn_s_memrealtime(); }
__device__ __forceinline__ unsigned f2bf(float f) { unsigned u = __builtin_bit_cast(unsigned, f); return (u + 0x7fffu + ((u >> 16) & 1u)) >> 16; }
__device__ __forceinline__ unsigned pk2(float lo, float hi) { return f2bf(lo) | (f2bf(hi) << 16); }

#define XB_TMO      128
#define XB_XCNT(j)  (256  + 64 * (j))
#define XB_XSUB(j)  (1280 + 64 * (j))
#define XB_XGEN(j)  (2304 + 64 * (j))
#define XB_TOP      3328
#define XB_TOPGEN   3392
#define XCD_BAR_WORDS 3456
#define XB_SPIN_CAP (1u << 22)

__device__ __forceinline__ unsigned xb_ld(unsigned* p)              { return __hip_atomic_load(p, __ATOMIC_RELAXED, __HIP_MEMORY_SCOPE_AGENT); }
__device__ __forceinline__ unsigned xb_add(unsigned* p, unsigned v) { return __hip_atomic_fetch_add(p, v, __ATOMIC_RELAXED, __HIP_MEMORY_SCOPE_AGENT); }
__device__ __forceinline__ unsigned xb_xcc_id() { return (unsigned)__builtin_amdgcn_s_getreg((3 << 11) | 20) & 0xFu; }
#define XB_SPIN(cond, bar) do { unsigned _sp = 0; while (cond) { __builtin_amdgcn_s_sleep(1); \
    if ((++_sp & 255u) == 0u) { if (xb_ld(&(bar)[XB_TMO])) break; if (_sp > XB_SPIN_CAP) { atomicAdd(&(bar)[XB_TMO], 1u); break; } } } } while (0)

struct XcdBarrier {
    unsigned* bar; unsigned x;
    volatile LAS unsigned* st;
};

__device__ __forceinline__ XcdBarrier xcd_barrier_post(unsigned* bar, volatile LAS unsigned* st) {
    XcdBarrier b; b.bar = bar; b.x = xb_xcc_id(); b.st = st;
    if (threadIdx.x == 0) (void)xb_add(&bar[XB_XCNT(b.x)], 1u);
    return b;
}
__device__ __forceinline__ void xcd_barrier_complete(unsigned* bar, unsigned x, unsigned& nloc, unsigned& nx) {
    const unsigned G = gridDim.x * gridDim.y * gridDim.z;
    unsigned sum, cnt, mine, sp = 0u;
    for (;;) {
        sum = 0u; cnt = 0u; mine = 0u;
#pragma unroll
        for (unsigned j = 0; j < 16; ++j) { const unsigned c = xb_ld(&bar[XB_XCNT(j)]); sum += c; cnt += (c > 0u) ? 1u : 0u; mine = (j == x) ? c : mine; }
        if (sum == G) break;
        __builtin_amdgcn_s_sleep(1);
        if ((++sp & 255u) == 0u) { if (xb_ld(&bar[XB_TMO])) break; if (sp > XB_SPIN_CAP) { atomicAdd(&bar[XB_TMO], 1u); break; } }
    }
    nloc = mine > 0u ? mine : 1u; nx = cnt > 0u ? cnt : 1u;
}

__device__ __forceinline__ void xcd_barrier(const XcdBarrier& b) {
    asm volatile("s_waitcnt vmcnt(0)" ::: "memory");
    __syncthreads();
    if (threadIdx.x == 0) {
        unsigned* bar = b.bar;
        __builtin_amdgcn_s_waitcnt(0);
        unsigned nloc = b.st[0], nx = b.st[1];
        if (nloc == 0u) { xcd_barrier_complete(bar, b.x, nloc, nx); b.st[0] = nloc; b.st[1] = nx; }
        const unsigned old = xb_add(&bar[XB_XSUB(b.x)], 1u);
        const unsigned gen = old / nloc;
        if (old + 1u == (gen + 1u) * nloc) {
            __builtin_amdgcn_fence(__ATOMIC_RELEASE, "agent");
            asm volatile("s_waitcnt vmcnt(0)" ::: "memory");
            const unsigned og = xb_add(&bar[XB_TOP], 1u);
            const unsigned tg = og / nx;
            if (og + 1u == (tg + 1u) * nx) xb_add(&bar[XB_TOPGEN], 1u);
            else XB_SPIN(xb_ld(&bar[XB_TOPGEN]) == tg, bar);
            __builtin_amdgcn_fence(__ATOMIC_ACQUIRE, "agent");
            xb_add(&bar[XB_XGEN(b.x)], 1u);
            asm volatile("s_waitcnt vmcnt(0)" ::: "memory");
        } else {
            XB_SPIN(xb_ld(&bar[XB_XGEN(b.x)]) == gen, bar);
            __builtin_amdgcn_fence(__ATOMIC_ACQUIRE, "agent");
            asm volatile("s_waitcnt vmcnt(0)" ::: "memory");
        }
    }
    __syncthreads();
}

__device__ __forceinline__ void xcd_arrive(const XcdBarrier& b, volatile LAS unsigned* sx) {
    asm volatile("s_waitcnt vmcnt(0)" ::: "memory");
    __syncthreads();
    if (threadIdx.x == 0) {
        unsigned* bar = b.bar;
        __builtin_amdgcn_s_waitcnt(0);
        unsigned nloc = b.st[0], nx = b.st[1];
        if (nloc == 0u) { xcd_barrier_complete(bar, b.x, nloc, nx); b.st[0] = nloc; b.st[1] = nx; }
        const unsigned old = xb_add(&bar[XB_XSUB(b.x)], 1u);
        const unsigned gen = old / nloc;
        unsigned leader = 0u, key = gen;
        if (old + 1u == (gen + 1u) * nloc) {
            leader = 1u;
            __builtin_amdgcn_fence(__ATOMIC_RELEASE, "agent");
            asm volatile("s_waitcnt vmcnt(0)" ::: "memory");
            const unsigned og = xb_add(&bar[XB_TOP], 1u);
            const unsigned tg = og / nx; key = tg;
            if (og + 1u == (tg + 1u) * nx) xb_add(&bar[XB_TOPGEN], 1u);
        }
        sx[0] = leader; sx[1] = key;
    }
}
__device__ __forceinline__ void xcd_wait(const XcdBarrier& b, volatile LAS unsigned* sx) {
    if (threadIdx.x == 0) {
        unsigned* bar = b.bar;
        const unsigned leader = sx[0], key = sx[1];
        if (leader) {
            XB_SPIN(xb_ld(&bar[XB_TOPGEN]) == key, bar);
            __builtin_amdgcn_fence(__ATOMIC_ACQUIRE, "agent");
            xb_add(&bar[XB_XGEN(b.x)], 1u);
            asm volatile("s_waitcnt vmcnt(0)" ::: "memory");
        } else {
            XB_SPIN(xb_ld(&bar[XB_XGEN(b.x)]) == key, bar);
            __builtin_amdgcn_fence(__ATOMIC_ACQUIRE, "agent");
            asm volatile("s_waitcnt vmcnt(0)" ::: "memory");
        }
    }
    __syncthreads();
}

constexpr int NWAVES = 8;
constexpr int T_ = 16384, SEQ = 4096, DM = 1024, NPROJ = 2304, INC = 2312;
constexpr int PJ_K = 512, PJ_V = 640, PJ_Z = 768, PJ_XBC = 1280;
constexpr float EPS = 1e-6f;
constexpr size_t MiB = 1u << 20;
constexpr size_t WS_CTL = 0, CTL_ZERO_BYTES = 1 * MiB;
constexpr size_t WS_KEYB = 1 * MiB + 256 * 1024;
constexpr size_t WS_BTAB = 1 * MiB + 384 * 1024;
constexpr size_t WS_SMALL = 1 * MiB;
constexpr size_t WS_WIN = 2 * MiB, WS_WOUT = 7 * MiB, WS_WQ = 9 * MiB;
constexpr size_t WS_ED = 13 * MiB, WS_EU = 29 * MiB;
constexpr size_t WS_XN = 77 * MiB;
constexpr size_t WS_PROJ = 109 * MiB;
constexpr size_t WS_ST = 181 * MiB;
constexpr size_t WS_IDX = 213 * MiB, WS_GATE = 221 * MiB, WS_SSQ = 229 * MiB, WS_END = 230 * MiB;
constexpr size_t DO_Y = 0, DO_DT = 41 * MiB;
constexpr size_t WS_CC = 230 * MiB, WS_DT = 238 * MiB, WS_EA = 239 * MiB, WS_CDEC = 240 * MiB, WS_PREV = WS_IDX;
constexpr size_t DO_YPF = 0, DO_YPLAIN = 32 * MiB;
constexpr size_t WS_PART = WS_PROJ;
constexpr size_t WS_H8 = WS_XN, WS_HS = WS_DT;
constexpr size_t WS_SSQ2 = WS_EA;
constexpr int CW_BAR = 4096, CW_RANK = 8192;
constexpr int RING_OFF = 0, RING_BYTES = 147456, LDSCTL_OFF = RING_BYTES, MISC_OFF = LDSCTL_OFF + 320, LDS_BYTES = 163840;

__constant__ unsigned char c_bucket[128] = {0, 1, 2, 3, 4, 5, 6, 7, 8, 9, 10, 11, 12, 13, 14, 15, 16, 16, 16, 17, 17, 18, 18, 18, 19, 19, 19, 20, 20, 20, 20, 21, 21, 21, 21, 22, 22, 22, 22, 22, 23, 23, 23, 23, 23, 23, 24, 24, 24, 24, 24, 24, 25, 25, 25, 25, 25, 25, 25, 26, 26, 26, 26, 26, 26, 26, 26, 27, 27, 27, 27, 27, 27, 27, 27, 27, 27, 28, 28, 28, 28, 28, 28, 28, 28, 28, 28, 29, 29, 29, 29, 29, 29, 29, 29, 29, 29, 29, 29, 30, 30, 30, 30, 30, 30, 30, 30, 30, 30, 30, 30, 30, 30, 31, 31, 31, 31, 31, 31, 31, 31, 31, 31, 31, 31, 31, 31, 31};

typedef float v16f __attribute__((ext_vector_type(16)));
typedef float v32f __attribute__((ext_vector_type(32)));
typedef unsigned v6u __attribute__((ext_vector_type(6)));
typedef _Float16 v32h __attribute__((ext_vector_type(32)));
struct Frame {
    LAS unsigned char* lds;
    volatile LAS unsigned* MISC;
    gu32* ctl;
    int wave, vcu, G;
};
__device__ __forceinline__ int lane_id() { int l; asm volatile("v_mbcnt_lo_u32_b32 %0, -1, 0\n\tv_mbcnt_hi_u32_b32 %0, -1, %0" : "=v"(l)); return l; }
__device__ __forceinline__ int opq(int x) { asm volatile("" : "+v"(x)); return x; }
template <int M> __device__ __forceinline__ float swz_xor(float v) { return __int_as_float(__builtin_amdgcn_ds_swizzle(__float_as_int(v), (M << 10) | 0x1F)); }
__device__ __forceinline__ float sum_halves(float v) { const auto r = __builtin_amdgcn_permlane32_swap(__float_as_uint(v), __float_as_uint(v), false, false); return __uint_as_float(r[0]) + __uint_as_float(r[1]); }
__device__ __forceinline__ float max_halves(float v) { const auto r = __builtin_amdgcn_permlane32_swap(__float_as_uint(v), __float_as_uint(v), false, false); return fmaxf(__uint_as_float(r[0]), __uint_as_float(r[1])); }
__device__ __forceinline__ int imax_halves(int v) { const auto r = __builtin_amdgcn_permlane32_swap((unsigned)v, (unsigned)v, false, false); return max((int)r[0], (int)r[1]); }
__device__ __forceinline__ float wave_sum(float v) {
    v += swz_xor<1>(v); v += swz_xor<2>(v); v += swz_xor<4>(v); v += swz_xor<8>(v); v += swz_xor<16>(v);
    return sum_halves(v);
}
__device__ __forceinline__ float bf2f(unsigned short b) { return __uint_as_float((unsigned)b << 16); }
__device__ __forceinline__ float bflo(unsigned w) { return __uint_as_float(w << 16); }
__device__ __forceinline__ float bfhi(unsigned w) { return __uint_as_float(w & 0xffff0000u); }
__device__ __forceinline__ float silu_f(float x) { return x / (1.f + __expf(-x)); }

__device__ __forceinline__ void p0_transpose_item(const float* W, int ldw, int K, int nblk, bf16* WT, const float* kscale, LAS float* scr, int item, int lane) {
    const int kb = item / nblk, nb = item % nblk, k0 = 64 * kb, n0 = 32 * nb;
    float ks_[32];
#pragma unroll
    for (int i = 0; i < 32; ++i) ks_[i] = kscale ? kscale[k0 + 2 * i + (lane >> 5)] : 1.f;
    float vv_[32];
#pragma unroll
    for (int i = 0; i < 32; ++i) vv_[i] = W[(size_t)(k0 + 2 * i + (lane >> 5)) * ldw + n0 + (lane & 31)];
#pragma unroll
    for (int i = 0; i < 32; ++i) scr[(2 * i + (lane >> 5)) * 33 + (lane & 31)] = vv_[i] * ks_[i];
#pragma unroll 1
    for (int i = 32; i < 32; ++i) { const int kk = 2 * i + (lane >> 5); float v = W[(size_t)(k0 + kk) * ldw + n0 + (lane & 31)]; if (kscale) v *= kscale[k0 + kk]; scr[kk * 33 + (lane & 31)] = v; }
    LDS_WAIT(); asm volatile("" ::: "memory");
    const int c = lane & 7;
#pragma unroll
    for (int j = 0; j < 4; ++j) { const int n = (lane >> 3) + 8 * j; const LAS float* s = scr + (8 * c) * 33 + n;
        v4u o; o.x = pk2(s[0 * 33], s[1 * 33]); o.y = pk2(s[2 * 33], s[3 * 33]); o.z = pk2(s[4 * 33], s[5 * 33]); o.w = pk2(s[6 * 33], s[7 * 33]);
        *(GAS v4u*)(WT + (size_t)(n0 + n) * K + k0 + 8 * c) = o; }
    LDS_WAIT(); asm volatile("" ::: "memory");
}
struct Ptrs {
    const float *x, *norm_mix, *w_in, *conv_w, *conv_b, *dt_bias, *a_log, *d_skip, *ssd_norm_w, *sinks, *w_out, *rel_bias, *norm_ffn, *w_query, *sk1, *sk2, *e_down, *e_up, *norm_final;
    float* out; unsigned char* ws;
};
constexpr int Q_SPLIT = 0;
__device__ __forceinline__ unsigned pack4_i8(float a, float b, float c, float d) {
    const int ia = __float2int_rn(a), ib = __float2int_rn(b), ic = __float2int_rn(c), id = __float2int_rn(d);
    return (unsigned)(ia & 0xff) | ((unsigned)(ib & 0xff) << 8) | ((unsigned)(ic & 0xff) << 16) | ((unsigned)(id & 0xff) << 24);
}
__device__ __forceinline__ unsigned pack8_i4(const float* v, float inv) {
    unsigned o = 0u;
#pragma unroll
    for (int i = 0; i < 8; ++i) { int q = __float2int_rn(v[i] * inv); q = q < -7 ? -7 : (q > 7 ? 7 : q); o |= ((unsigned)q & 15u) << (4 * i); }
    return o;
}
__device__ __forceinline__ void quant_fp8s(const Ptrs& P, int lane_, int r_lo, int r_hi, int w, int nw) {
    float* SC = (float*)(P.ws + WS_SMALL);
    int row = r_lo + w;
    if (row >= r_hi) return;
    float4 nx[4];
#pragma unroll
    for (int q = 0; q < 4; ++q) nx[q] = ((const float4*)(P.e_down + (size_t)(row & 16383) * DM) + 4 * lane_)[q];
    float4 w4[4];
#pragma unroll
    for (int q = 0; q < 4; ++q) w4[q] = ((const float4*)P.norm_ffn)[4 * lane_ + q];
    for (; row < r_hi; row += nw) {
        const int e = row & 16383;
        float v[16];
#pragma unroll
        for (int q = 0; q < 4; ++q) { const float4 t = nx[q]; v[4 * q] = t.x * w4[q].x; v[4 * q + 1] = t.y * w4[q].y; v[4 * q + 2] = t.z * w4[q].z; v[4 * q + 3] = t.w * w4[q].w; }
        { const int rn = (row + nw < r_hi) ? row + nw : row;
#pragma unroll
          for (int q = 0; q < 4; ++q) nx[q] = ((const float4*)(P.e_down + (size_t)(rn & 16383) * DM) + 4 * lane_)[q]; }
        float ss = 0.f;
#pragma unroll
        for (int q = 0; q < 16; ++q) ss = fmaf(v[q], v[q], ss);
        const float sc = fmaxf(2.5f * sqrtf(wave_sum(ss) * (1.f / 1024.f)) * (1.f / 7.f), 1e-30f);
        const float inv = 1.f / sc;
        const unsigned long long o = (unsigned long long)pack8_i4(v, inv) | ((unsigned long long)pack8_i4(v + 8, inv) << 32);
        *(unsigned long long*)(P.ws + WS_ED + ((size_t)(lane_ >> 4) * 16384 + e) * 128 + (lane_ & 15) * 8) = o;
        if (lane_ == 0) SC[row] = sc;
    }
}
typedef float f32x2q __attribute__((ext_vector_type(2)));
__device__ __forceinline__ void quant_fp6u(const Ptrs& P, int lane_, int q_lo, int q_hi, int w, int nw) {
    float* SC = (float*)(P.ws + WS_SMALL);
    int e = 2 * q_lo + w; const int e_hi = 2 * q_hi;
    if (e >= e_hi) return;
    float4 nx[4];
#pragma unroll
    for (int k = 0; k < 4; ++k) nx[k] = ((const float4*)(P.e_up + (size_t)e * DM) + 4 * lane_)[k];
    for (; e < e_hi; e += nw) {
        float v[16];
#pragma unroll
        for (int k = 0; k < 4; ++k) { const float4 t = nx[k]; v[4 * k] = t.x; v[4 * k + 1] = t.y; v[4 * k + 2] = t.z; v[4 * k + 3] = t.w; }
        { const int en = (e + nw < e_hi) ? e + nw : e;
#pragma unroll
          for (int k = 0; k < 4; ++k) nx[k] = ((const float4*)(P.e_up + (size_t)en * DM) + 4 * lane_)[k]; }
        float am = 0.f;
#pragma unroll
        for (int k = 0; k < 16; ++k) am = fmaxf(am, fabsf(v[k]));
        am = fmaxf(am, swz_xor<1>(am)); am = fmaxf(am, swz_xor<2>(am)); am = fmaxf(am, swz_xor<4>(am)); am = fmaxf(am, swz_xor<8>(am)); am = fmaxf(am, swz_xor<16>(am)); am = max_halves(am);
        am = fmaxf(am, 1e-30f);
        const float inv = 6.0f / am;
        unsigned pk[2];
#pragma unroll
        for (int wd = 0; wd < 2; ++wd) { unsigned p4 = 0u;
            p4 = __builtin_amdgcn_cvt_scalef32_pk_fp4_f32(p4, v[8 * wd] * inv, v[8 * wd + 1] * inv, 1.0f, 0);
            p4 = __builtin_amdgcn_cvt_scalef32_pk_fp4_f32(p4, v[8 * wd + 2] * inv, v[8 * wd + 3] * inv, 1.0f, 1);
            p4 = __builtin_amdgcn_cvt_scalef32_pk_fp4_f32(p4, v[8 * wd + 4] * inv, v[8 * wd + 5] * inv, 1.0f, 2);
            p4 = __builtin_amdgcn_cvt_scalef32_pk_fp4_f32(p4, v[8 * wd + 6] * inv, v[8 * wd + 7] * inv, 1.0f, 3);
            pk[wd] = p4; }
        *(unsigned long long*)(P.ws + WS_EU + (size_t)e * 512 + 8 * lane_) = (unsigned long long)pk[0] | ((unsigned long long)pk[1] << 32);
        if (lane_ == 0) SC[16384 + e] = am * (1.f / 6.0f);
    }
}
__device__ __forceinline__ void p0_prologue(Frame& F0, const Ptrs& P) {
    const Frame& F = F0; const int lane_ = lane_id(), tid_ = F.wave * 64 + lane_;
    LAS float* scr = (LAS float*)(F.lds + RING_OFF + F.wave * 16384);
    const int gw = F.vcu * NWAVES + F.wave, NGW = F.G * NWAVES;
    bf16* Win_t = (bf16*)(P.ws + WS_WIN); bf16* Wout_t = (bf16*)(P.ws + WS_WOUT); bf16* Wq_t = (bf16*)(P.ws + WS_WQ);
    constexpr int I_IN = 16 * 72;
    for (int it = gw; it < I_IN; it += NGW) p0_transpose_item(P.w_in, INC, DM, 72, Win_t, nullptr, scr, it, lane_);
    (void)Wout_t; (void)Wq_t;
    __syncthreads();
    { LAS float* Wdt = (LAS float*)(F.lds + RING_OFF);
      { float wd_[16];
#pragma unroll
        for (int q = 0; q < 16; ++q) { const int i = tid_ + 512 * q; wd_[q] = P.w_in[(size_t)(i >> 3) * INC + NPROJ + (i & 7)]; }
#pragma unroll
        for (int q = 0; q < 16; ++q) Wdt[tid_ + 512 * q] = wd_[q]; }
      __syncthreads();
      bf16* XN = (bf16*)(P.ws + WS_XN); float* DT = (float*)(P.ws + WS_DT);
      float4 nmw[4];
#pragma unroll
      for (int j = 0; j < 4; ++j) nmw[j] = ((const float4*)P.norm_mix)[j * 64 + lane_];
      float4 xnx[2][4];
      if (gw * 2 < T_) {
#pragma unroll
        for (int rr = 0; rr < 2; ++rr)
#pragma unroll
            for (int j = 0; j < 4; ++j) xnx[rr][j] = ((const float4*)(P.x + (size_t)(gw * 2 + rr) * DM))[j * 64 + lane_]; }
      for (int m0 = gw * 2; m0 < T_; m0 += NGW * 2) {
        float4 xv[2][4];
#pragma unroll
        for (int rr = 0; rr < 2; ++rr)
#pragma unroll
            for (int j = 0; j < 4; ++j) xv[rr][j] = xnx[rr][j];
        { const int mn = (m0 + NGW * 2 < T_) ? m0 + NGW * 2 : m0;
#pragma unroll
          for (int rr = 0; rr < 2; ++rr)
#pragma unroll
              for (int j = 0; j < 4; ++j) xnx[rr][j] = ((const float4*)(P.x + (size_t)(mn + rr) * DM))[j * 64 + lane_]; }
#pragma unroll
        for (int rr = 0; rr < 2; ++rr) { const int m = m0 + rr;
        float4 v[4]; float s = 0.f;
#pragma unroll
        for (int j = 0; j < 4; ++j) { v[j] = xv[rr][j]; s += v[j].x * v[j].x + v[j].y * v[j].y + v[j].z * v[j].z + v[j].w * v[j].w; }
        const float r = rsqrtf(wave_sum(s) * (1.f / 1024.f) + EPS);
        float d8[8];
#pragma unroll
        for (int q = 0; q < 8; ++q) d8[q] = 0.f;
        unsigned long long* o8 = (unsigned long long*)(XN + (size_t)m * DM);
#pragma unroll
        for (int j = 0; j < 4; ++j) { const float4 w = nmw[j];
            const float e0 = v[j].x * r * w.x, e1 = v[j].y * r * w.y, e2 = v[j].z * r * w.z, e3 = v[j].w * r * w.w;
            o8[j * 64 + lane_] = (unsigned long long)pk2(e0, e1) | ((unsigned long long)pk2(e2, e3) << 32);
            const float ev[4] = {e0, e1, e2, e3};
#pragma unroll
            for (int e = 0; e < 4; ++e) { const LAS f32x4* wr = (const LAS f32x4*)(Wdt + (size_t)(j * 256 + lane_ * 4 + e) * 8); const f32x4 w0 = wr[0], w1 = wr[1];
                d8[0] += ev[e] * w0.x; d8[1] += ev[e] * w0.y; d8[2] += ev[e] * w0.z; d8[3] += ev[e] * w0.w; d8[4] += ev[e] * w1.x; d8[5] += ev[e] * w1.y; d8[6] += ev[e] * w1.z; d8[7] += ev[e] * w1.w; } }
#pragma unroll
        for (int q = 0; q < 8; ++q) d8[q] = wave_sum(d8[q]);
        if (lane_ == 0) { float4* dp = (float4*)(DT + (size_t)m * 8); dp[0] = make_float4(d8[0], d8[1], d8[2], d8[3]); dp[1] = make_float4(d8[4], d8[5], d8[6], d8[7]); }
        }
      }
      __syncthreads(); }
}

__device__ __forceinline__ void p1_slack(Frame& F0, const Ptrs& P, int w, int nw) {
    const Frame& F = F0; const int lane_ = lane_id();
    LAS float* scr = (LAS float*)(F.lds + RING_OFF + F.wave * 16384);
    bf16* Wout_t = (bf16*)(P.ws + WS_WOUT); bf16* Wq_t = (bf16*)(P.ws + WS_WQ);
    constexpr int I_OUT = 16 * 32, I_Q = 16 * 64;
    for (int it = w; it < I_OUT + I_Q; it += nw) {
        if (it < I_OUT) p0_transpose_item(P.w_out, DM, DM, 32, Wout_t, nullptr, scr, it, lane_);
        else p0_transpose_item(P.w_query, 2048, DM, 64, Wq_t, P.norm_ffn, scr, it - I_OUT, lane_);
    }
    { unsigned long long* KB = (unsigned long long*)(P.ws + WS_KEYB);
      for (int i = w * 64 + lane_; i < 8192; i += nw * 64) { const float4 t = (i < 4096) ? ((const float4*)P.sk1)[i] : ((const float4*)P.sk2)[i - 4096];
          KB[i] = (unsigned long long)pk2(t.x, t.y) | ((unsigned long long)pk2(t.z, t.w) << 32); } }
    { float* BT = (float*)(P.ws + WS_BTAB);
      for (int i = w * 64 + lane_; i < 1536; i += nw * 64) { const int hkv = i / 768, rr = i % 768, gg = rr / 192, dist = rr % 192 - 32;
          BT[i] = (dist >= 0 && dist < 128) ? P.rel_bias[c_bucket[dist & 127] * 8 + hkv * 4 + gg] * 1.4426950408889634f : 0.f; } }
    quant_fp6u(P, lane_, 0, 8192, w, nw);
    quant_fp8s(P, lane_, 0, 16384, w, nw);
}
struct EpiResH {
    static constexpr bool PERM = false, AFTER_DRAIN = false;
    const float* X; bf16* HB; float* SSQ;
    __device__ __forceinline__ void ldx(pg8::f32x4 (&d)[4], int row, int col0) const {
#pragma unroll
        for (int bj = 0; bj < 2; ++bj)
#pragma unroll
            for (int n = 0; n < 2; ++n) d[bj * 2 + n] = *(const pg8::f32x4*)(X + (size_t)row * DM + col0 + bj * 128 + n * 16);
    }
    __device__ __forceinline__ void operator()(const pg8::f32x4 (&acc)[2][2][4][2], const pg8::Unit& u, int wr, int wc, int fr, int fq) const {
        const int row0 = u.pm * 256 + wr * 64 + fr, col0 = u.pn * 256 + wc * 32 + 4 * fq;
        pg8::f32x4 xq[2][4];
        ldx(xq[0], row0, col0);
#pragma unroll
        for (int g = 0; g < 8; ++g) { const int ai = g >> 2, m = g & 3, row = row0 + ai * 128 + m * 16;
            if (g + 1 < 8) ldx(xq[(g + 1) & 1], row0 + ((g + 1) >> 2) * 128 + ((g + 1) & 3) * 16, col0);
            float ss = 0.f;
#pragma unroll
            for (int bj = 0; bj < 2; ++bj)
#pragma unroll
                for (int n = 0; n < 2; ++n) { const size_t off = (size_t)row * DM + col0 + bj * 128 + n * 16;
                    const pg8::f32x4 h = acc[ai][bj][m][n] + xq[g & 1][bj * 2 + n];
                    ss += h[0] * h[0] + h[1] * h[1] + h[2] * h[2] + h[3] * h[3];
                    *(unsigned long long*)(HB + off) = (unsigned long long)pk2(h[0], h[1]) | ((unsigned long long)pk2(h[2], h[3]) << 32); }
            ss += swz_xor<16>(ss); ss = sum_halves(ss);
            if (fq == 0) SSQ[(size_t)row * 16 + u.pn * 4 + wc] = ss; }
    }
};

typedef float f32x16 __attribute__((ext_vector_type(16)));
typedef short s16x4 __attribute__((ext_vector_type(4)));
typedef float f32x2_t __attribute__((ext_vector_type(2)));
typedef __bf16 bf16x2_t __attribute__((ext_vector_type(2)));
#define MFMA32(a, b, c) __builtin_amdgcn_mfma_f32_32x32x16_bf16((a), (b), (c), 0, 0, 0)
__device__ __forceinline__ int crow(int reg, int h) { return (reg & 3) + 8 * (reg >> 2) + 4 * h; }
__device__ __forceinline__ unsigned cvtpk(float lo, float hi) { f32x2_t v = {lo, hi}; bf16x2_t b = __builtin_convertvector(v, bf16x2_t); return __builtin_bit_cast(unsigned, b); }
__device__ __forceinline__ bf16x8 pack8(const f32x16& x, int s) {
    v4u p; p.x = cvtpk(x[8 * s], x[8 * s + 1]); p.y = cvtpk(x[8 * s + 2], x[8 * s + 3]); p.z = cvtpk(x[8 * s + 4], x[8 * s + 5]); p.w = cvtpk(x[8 * s + 6], x[8 * s + 7]);
    return __builtin_bit_cast(bf16x8, p);
}
constexpr float LOG2E = 1.4426950408889634f;
constexpr int LDP = 136;
constexpr int S1_XT = 0, S1_XTW = 17408, S1_BSN = 34816, S1_CLN = 69632, S1_BNL = 104448, S1_F32 = 139264;

__device__ __forceinline__ float silu_fast(float x) { return x * __builtin_amdgcn_rcpf(1.f + __builtin_amdgcn_exp2f(-x * LOG2E)); }
__device__ __forceinline__ int swz_t(int row, int l) { return row * LDP + ((((l >> 3) ^ (row >> 3)) & 7) | ((l >> 3) & 8)) * 8 + (l & 7); }
#define S1_CONV8(A_, IT_) do { _Pragma("unroll") for (int e_ = 0; e_ < 8; ++e_) A_[e_] = bias[e_]; \
        _Pragma("unroll") for (int j_ = 0; j_ < 4; ++j_) { const v4u rw_ = raw[(IT_) + j_]; \
            A_[0] += w[j_][0] * bflo(rw_.x); A_[1] += w[j_][1] * bfhi(rw_.x); A_[2] += w[j_][2] * bflo(rw_.y); A_[3] += w[j_][3] * bfhi(rw_.y); \
            A_[4] += w[j_][4] * bflo(rw_.z); A_[5] += w[j_][5] * bfhi(rw_.z); A_[6] += w[j_][6] * bflo(rw_.w); A_[7] += w[j_][7] * bfhi(rw_.w); } \
        _Pragma("unroll") for (int e_ = 0; e_ < 8; ++e_) A_[e_] = silu_fast(A_[e_]); } while (0)
#define S1_LOADW(CHB_) do { _Pragma("unroll") for (int j_ = 0; j_ < 4; ++j_) { const float4 w0_ = *(const float4*)(P.conv_w + j_ * 1024 + (CHB_)), w1_ = *(const float4*)(P.conv_w + j_ * 1024 + (CHB_) + 4); \
            w[j_][0] = w0_.x; w[j_][1] = w0_.y; w[j_][2] = w0_.z; w[j_][3] = w0_.w; w[j_][4] = w1_.x; w[j_][5] = w1_.y; w[j_][6] = w1_.z; w[j_][7] = w1_.w; } \
        { const float4 b0_ = *(const float4*)(P.conv_b + (CHB_)), b1_ = *(const float4*)(P.conv_b + (CHB_) + 4); \
          bias[0] = b0_.x; bias[1] = b0_.y; bias[2] = b0_.z; bias[3] = b0_.w; bias[4] = b1_.x; bias[5] = b1_.y; bias[6] = b1_.z; bias[7] = b1_.w; } } while (0)
__device__ __forceinline__ void ssd_s1(Frame& F, const Ptrs& P) {
    const bf16* PROJ = (const bf16*)(P.ws + WS_PROJ); const float* DT = (const float*)(P.ws + WS_DT);
    float* EA = (float*)(P.ws + WS_EA); float* CDEC = (float*)(P.ws + WS_CDEC); bf16* CC = (bf16*)(P.ws + WS_CC);
    unsigned* ST = (unsigned*)(P.ws + WS_ST); unsigned* YPF = (unsigned*)((char*)P.out + DO_YPF);
    LAS unsigned char* L = F.lds + RING_OFF;
    LAS bf16* Xt = (LAS bf16*)(L + S1_XT); LAS bf16* Xtw = (LAS bf16*)(L + S1_XTW); LAS bf16* Bsn = (LAS bf16*)(L + S1_BSN); LAS bf16* Cln = (LAS bf16*)(L + S1_CLN); LAS bf16* Bnl = (LAS bf16*)(L + S1_BNL);
    LAS float* f32base = (LAS float*)(L + S1_F32);
    const int lane = lane_id(); const int tid_ = F.wave * 64 + lane;
    for (int ug = F.vcu; ug < 256; ug += F.G) {
        const int grp = ug & 1, c = (ug >> 1) & 31, b = ug >> 6, t0 = b * SEQ + c * 128;
        __syncthreads();
        if (F.wave < 4) {
            const int h = 4 * grp + F.wave, us = (b * 32 + c) * 8 + h;
            const float A = -__expf(P.a_log[h]), dtb = P.dt_bias[h];
            const int ln = opq(lane_id());
            LAS float* acum2 = f32base + F.wave * 384; LAS float* wv = acum2 + 128; LAS float* wend = wv + 128;
            const float x0 = DT[(size_t)(t0 + 2 * ln) * 8 + h] + dtb, x1 = DT[(size_t)(t0 + 2 * ln + 1) * 8 + h] + dtb;
            const float dt0 = fmaxf(x0, 0.f) + log1pf(__expf(-fabsf(x0))), dt1 = fmaxf(x1, 0.f) + log1pf(__expf(-fabsf(x1)));
            const float a0 = dt0 * A, a1 = dt1 * A;
            float s = a0 + a1;
#pragma unroll
            for (int o = 1; o < 64; o <<= 1) { const float v = __int_as_float(__builtin_amdgcn_ds_bpermute((ln - o) * 4, __float_as_int(s))); if (ln >= o) s += v; }
            const float ac1 = s, ac0 = s - a1, tot = __uint_as_float(__builtin_amdgcn_readlane(__float_as_uint(s), 63));
            acum2[2 * ln] = ac0 * LOG2E; acum2[2 * ln + 1] = ac1 * LOG2E;
            wv[2 * ln] = log2f(dt0) - ac0 * LOG2E; wv[2 * ln + 1] = log2f(dt1) - ac1 * LOG2E;
            wend[2 * ln] = dt0 * exp2f((tot - ac0) * LOG2E); wend[2 * ln + 1] = dt1 * exp2f((tot - ac1) * LOG2E);
            EA[(size_t)(t0 + 2 * ln) * 8 + h] = exp2f(ac0 * LOG2E); EA[(size_t)(t0 + 2 * ln + 1) * 8 + h] = exp2f(ac1 * LOG2E);
            if (ln == 0) CDEC[us] = exp2f(tot * LOG2E);
        }
        { const int tidc = opq(tid_);
          if (tidc < 440) {
            const int cg = tidc % 40, sg = tidc / 40, l0 = 12 * sg, h0 = 4 * grp;
            int chb; if (cg < 8) chb = h0 * 64 + cg * 8; else if (cg < 24) chb = 512 + grp * 128 + (cg - 8) * 8; else chb = 768 + grp * 128 + (cg - 24) * 8;
            v4u raw[15];
#pragma unroll
            for (int q = 0; q < 15; ++q) { const int ss = c * 128 + l0 - 3 + q; raw[q] = (v4u){0u, 0u, 0u, 0u};
                if (ss >= 0 && l0 - 3 + q < 128) raw[q] = *(const v4u*)(PROJ + (size_t)(b * SEQ + ss) * NPROJ + PJ_XBC + chb); }
            float w[4][8], bias[8]; S1_LOADW(chb);
#pragma unroll
            for (int it = 0; it < 12; it += 2) {
                const int l = l0 + it;
                if (l < 128) {
                    float a[8], a2[8]; S1_CONV8(a, it); S1_CONV8(a2, it + 1);
                    if (cg < 8) {
#pragma unroll
                        for (int e = 0; e < 8; ++e) *(LAS unsigned*)(Xt + swz_t(cg * 8 + e, l)) = cvtpk(a[e], a2[e]);
                    } else {
                        v4u o, o2; o.x = cvtpk(a[0], a[1]); o.y = cvtpk(a[2], a[3]); o.z = cvtpk(a[4], a[5]); o.w = cvtpk(a[6], a[7]);
                        o2.x = cvtpk(a2[0], a2[1]); o2.y = cvtpk(a2[2], a2[3]); o2.z = cvtpk(a2[4], a2[5]); o2.w = cvtpk(a2[6], a2[7]);
                        if (cg < 24) { const int n0 = (cg - 8) * 8; *(LAS v4u*)(Bsn + l * LDP + n0) = o; *(LAS v4u*)(Bsn + (l + 1) * LDP + n0) = o2;
#pragma unroll
                            for (int e = 0; e < 8; ++e) *(LAS unsigned*)(Bnl + swz_t(n0 + e, l)) = cvtpk(a[e], a2[e]);
                        } else { const int n0 = (cg - 24) * 8; *(LAS v4u*)(Cln + l * LDP + n0) = o; *(LAS v4u*)(Cln + (l + 1) * LDP + n0) = o2;
                            *(v4u*)(CC + (size_t)(t0 + l) * 256 + grp * 128 + n0) = o; *(v4u*)(CC + (size_t)(t0 + l + 1) * 256 + grp * 128 + n0) = o2; }
                    }
                }
            }
          } }
        __syncthreads();
#pragma unroll 1
        for (int hi = 0; hi < 4; ++hi) {
            const int h = 4 * grp + hi, u = (b * 32 + c) * 8 + h;
            const float Dh = P.d_skip[h];
            const LAS float* acum2 = f32base + hi * 384; const LAS float* wv = acum2 + 128; const LAS float* wend = wv + 128;
            const LAS bf16* Xc = (hi & 1) ? Xtw : Xt; LAS bf16* Xn = (hi & 1) ? Xt : Xtw;
            const int tidc = opq(tid_);
            const int cgn = tidc & 7, ln_ = 2 * (tidc >> 3), chn = (h + 1) * 64 + cgn * 8;
            v4u raw[5];
#pragma unroll
            for (int q = 0; q < 5; ++q) { const int ss = c * 128 + ln_ - 3 + q; raw[q] = (v4u){0u, 0u, 0u, 0u};
                if (hi < 3 && ss >= 0) raw[q] = *(const v4u*)(PROJ + (size_t)(b * SEQ + ss) * NPROJ + PJ_XBC + chn); }
            float4 wq4[4][2], bq4[2];
            { const int chw = (hi < 3) ? chn : chn - 64;
#pragma unroll
              for (int j = 0; j < 4; ++j) { wq4[j][0] = *(const float4*)(P.conv_w + j * 1024 + chw); wq4[j][1] = *(const float4*)(P.conv_w + j * 1024 + chw + 4); }
              bq4[0] = *(const float4*)(P.conv_b + chw); bq4[1] = *(const float4*)(P.conv_b + chw + 4); }
            const int ln3 = opq(lane), r = ln3 & 31, hh = ln3 >> 5;
            if (F.wave < 4) {
                const int pt = F.wave >> 1;
#pragma unroll 1
                for (int q = 0; q < 2; ++q) {
                    const int lt = (F.wave & 1) ? (1 + q) : (3 * q);
                    f32x16 yacc;
#pragma unroll
                    for (int i = 0; i < 16; ++i) yacc[i] = 0.f;
                    const float al = acum2[32 * lt + r];
                    bf16x8 cf[8];
#pragma unroll
                    for (int kk = 0; kk < 8; ++kk) cf[kk] = *(const LAS bf16x8*)(Cln + (32 * lt + r) * LDP + 16 * kk + 8 * hh);
#pragma unroll 1
                    for (int st = 0; st <= lt; ++st) {
                        bf16x8 bfr[8];
#pragma unroll
                        for (int kk = 0; kk < 8; ++kk) bfr[kk] = *(const LAS bf16x8*)(Bsn + (32 * st + r) * LDP + 16 * kk + 8 * hh);
                        f32x4 wq[4];
#pragma unroll
                        for (int g4 = 0; g4 < 4; ++g4) wq[g4] = *(const LAS f32x4*)(wv + 32 * st + 8 * g4 + 4 * hh);
                        s16x4 xlo[2], xhi[2];
#pragma unroll
                        for (int sg = 0; sg < 2; ++sg) { const int prow = 32 * pt + r, lb = 32 * st + 16 * sg;
                            xlo[sg] = *(const LAS s16x4*)(Xc + swz_t(prow, lb) + 4 * hh); xhi[sg] = *(const LAS s16x4*)(Xc + swz_t(prow, lb + 8) + 4 * hh); }
                        __builtin_amdgcn_sched_barrier(0);
                        f32x16 macc;
#pragma unroll
                        for (int i = 0; i < 16; ++i) macc[i] = 0.f;
#pragma unroll
                        for (int kk = 0; kk < 8; ++kk) macc = MFMA32(bfr[kk], cf[kk], macc);
#pragma unroll
                        for (int i = 0; i < 16; ++i) { const int sl = crow(i, hh);
                            float f = __builtin_amdgcn_exp2f(al + wq[i >> 2][i & 3]);
                            if (st == lt && sl > r) f = 0.f;
                            macc[i] *= f; }
#pragma unroll
                        for (int sg = 0; sg < 2; ++sg) {
                            const bf16x8 bfrag = pack8(macc, sg);
                            const bf16x8 afrag = __builtin_shufflevector(xlo[sg], xhi[sg], 0, 1, 2, 3, 4, 5, 6, 7);
                            yacc = MFMA32(afrag, bfrag, yacc);
                        }
                    }
                    unsigned short xs16[16];
#pragma unroll
                    for (int i = 0; i < 16; ++i) xs16[i] = *(const LAS unsigned short*)(Xc + swz_t(32 * pt + crow(i, hh), 32 * lt + r));
                    __builtin_amdgcn_sched_barrier(0);
#pragma unroll
                    for (int i = 0; i < 16; i += 2) {
                        const float y0 = yacc[i] + Dh * __uint_as_float((unsigned)xs16[i] << 16), y1 = yacc[i + 1] + Dh * __uint_as_float((unsigned)xs16[i + 1] << 16);
                        YPF[((((size_t)u * 4 + lt) * 2 + pt) * 8 + (i >> 1)) * 64 + ln3] = cvtpk(y0, y1); }
                }
            } else {
                const int nt = F.wave - 4;
                bf16x8 bb[8];
                { v4u braw[8]; f32x4 we[8][2];
#pragma unroll
                  for (int kk = 0; kk < 8; ++kk) { braw[kk] = *(const LAS v4u*)(Bnl + swz_t(32 * nt + r, 16 * kk + 8 * hh));
                      we[kk][0] = *(const LAS f32x4*)(wend + 16 * kk + 8 * hh); we[kk][1] = *(const LAS f32x4*)(wend + 16 * kk + 8 * hh + 4); }
#pragma unroll
                  for (int kk = 0; kk < 8; ++kk) { v4u o;
                      o.x = cvtpk(bflo(braw[kk].x) * we[kk][0][0], bfhi(braw[kk].x) * we[kk][0][1]); o.y = cvtpk(bflo(braw[kk].y) * we[kk][0][2], bfhi(braw[kk].y) * we[kk][0][3]);
                      o.z = cvtpk(bflo(braw[kk].z) * we[kk][1][0], bfhi(braw[kk].z) * we[kk][1][1]); o.w = cvtpk(bflo(braw[kk].w) * we[kk][1][2], bfhi(braw[kk].w) * we[kk][1][3]);
                      bb[kk] = __builtin_bit_cast(bf16x8, o); } }
#pragma unroll 1
                for (int pt = 0; pt < 2; ++pt) {
                    bf16x8 xa[8];
#pragma unroll
                    for (int kk = 0; kk < 8; ++kk) xa[kk] = *(const LAS bf16x8*)(Xc + swz_t(32 * pt + r, 16 * kk + 8 * hh));
                    __builtin_amdgcn_sched_barrier(0);
                    f32x16 sacc;
#pragma unroll
                    for (int i = 0; i < 16; ++i) sacc[i] = 0.f;
#pragma unroll
                    for (int kk = 0; kk < 8; ++kk) sacc = MFMA32(xa[kk], bb[kk], sacc);
#pragma unroll
                    for (int i = 0; i < 16; i += 2) ST[((size_t)u * 32 + 16 * pt + (crow(i, hh) >> 1)) * 128 + 32 * nt + r] = cvtpk(sacc[i], sacc[i + 1]);
                }
            }
            if (hi < 3) {
                const int cg = cgn, l = ln_;
                float w[4][8], bias[8];
#pragma unroll
                for (int j = 0; j < 4; ++j) { w[j][0] = wq4[j][0].x; w[j][1] = wq4[j][0].y; w[j][2] = wq4[j][0].z; w[j][3] = wq4[j][0].w; w[j][4] = wq4[j][1].x; w[j][5] = wq4[j][1].y; w[j][6] = wq4[j][1].z; w[j][7] = wq4[j][1].w; }
                bias[0] = bq4[0].x; bias[1] = bq4[0].y; bias[2] = bq4[0].z; bias[3] = bq4[0].w; bias[4] = bq4[1].x; bias[5] = bq4[1].y; bias[6] = bq4[1].z; bias[7] = bq4[1].w;
                float a[8], a2[8]; S1_CONV8(a, 0); S1_CONV8(a2, 1);
#pragma unroll
                for (int e = 0; e < 8; ++e) *(LAS unsigned*)(Xn + swz_t(cg * 8 + e, l)) = cvtpk(a[e], a2[e]);
            }
            __syncthreads();
        }
    }
}
__device__ __forceinline__ void ssd_s2(Frame& F, const Ptrs& P) {
    const unsigned* ST = (const unsigned*)(P.ws + WS_ST); const float* CDEC = (const float*)(P.ws + WS_CDEC); unsigned* PREV = (unsigned*)(P.ws + WS_PREV);
    for (int g = F.vcu * 512 + (F.wave * 64 + lane_id()); g < 65536; g += F.G * 512) {
        const int n2 = g & 63, p2 = (g >> 6) & 31, h = (g >> 11) & 7, b = g >> 14;
        uint2 st[32];
#pragma unroll
        for (int c = 0; c < 32; ++c) st[c] = *(const uint2*)(ST + ((size_t)(((b * 32 + c) * 8 + h) * 32 + p2)) * 128 + 2 * n2);
        float r00 = 0.f, r01 = 0.f, r10 = 0.f, r11 = 0.f;
#pragma unroll
        for (int c = 0; c < 32; ++c) { const size_t u = (size_t)((b * 32 + c) * 8 + h);
            PREV[((u * 64 + 2 * p2) * 128 + 2 * n2) >> 1] = cvtpk(r00, r01); PREV[((u * 64 + 2 * p2 + 1) * 128 + 2 * n2) >> 1] = cvtpk(r10, r11);
            const float d = CDEC[u];
            r00 = r00 * d + bflo(st[c].x); r10 = r10 * d + bfhi(st[c].x); r01 = r01 * d + bflo(st[c].y); r11 = r11 * d + bfhi(st[c].y); }
    }
}
__device__ __forceinline__ void ssd_s3(Frame& F, const Ptrs& P) {
    const bf16* CC = (const bf16*)(P.ws + WS_CC); const bf16* PREV = (const bf16*)(P.ws + WS_PREV); const float* EA = (const float*)(P.ws + WS_EA);
    const unsigned* YPF = (const unsigned*)((const char*)P.out + DO_YPF); const bf16* PROJ = (const bf16*)(P.ws + WS_PROJ); bf16* CAT = (bf16*)(P.ws + WS_XN);
    LAS float* red = (LAS float*)(F.lds + RING_OFF);
    const int lane = lane_id(), r = lane & 31, hh = lane >> 5, h = F.wave, grp = h >> 2;
    for (int v2 = F.vcu; v2 < 256; v2 += F.G) {
        const int lp = v2 & 1, c = (v2 >> 1) & 31, b = v2 >> 6;
        const size_t u = (size_t)((b * 32 + c) * 8 + h);
        bf16x8 af[2][8];
#pragma unroll
        for (int pt = 0; pt < 2; ++pt)
#pragma unroll
            for (int kk = 0; kk < 8; ++kk) af[pt][kk] = *(const bf16x8*)(PREV + (u * 64 + 32 * pt + r) * 128 + 16 * kk + 8 * hh);
#pragma unroll 1
        for (int li = 0; li < 2; ++li) {
            const int lt = 2 * lp + li;
            const int t = b * SEQ + c * 128 + lt * 32 + r;
            unsigned ypf[2][8]; unsigned long long zz[2][4];
#pragma unroll
            for (int pt = 0; pt < 2; ++pt) {
#pragma unroll
                for (int i = 0; i < 8; ++i) ypf[pt][i] = YPF[((((size_t)u * 4 + lt) * 2 + pt) * 8 + i) * 64 + lane];
#pragma unroll
                for (int g4 = 0; g4 < 4; ++g4) zz[pt][g4] = *(const unsigned long long*)(PROJ + (size_t)t * NPROJ + PJ_Z + h * 64 + 32 * pt + 8 * g4 + 4 * hh); }
            const float ea = EA[(size_t)t * 8 + h];
            bf16x8 bb[8];
#pragma unroll
            for (int kk = 0; kk < 8; ++kk) bb[kk] = *(const bf16x8*)(CC + (size_t)t * 256 + grp * 128 + 16 * kk + 8 * hh);
            f32x16 acc[2];
#pragma unroll
            for (int i = 0; i < 16; ++i) { acc[0][i] = 0.f; acc[1][i] = 0.f; }
#pragma unroll
            for (int kk = 0; kk < 8; ++kk) { acc[0] = MFMA32(af[0][kk], bb[kk], acc[0]); acc[1] = MFMA32(af[1][kk], bb[kk], acc[1]); }
            float ss = 0.f;
#pragma unroll
            for (int pt = 0; pt < 2; ++pt)
#pragma unroll
                for (int g4 = 0; g4 < 4; ++g4) {
                    const unsigned z01 = (unsigned)zz[pt][g4], z23 = (unsigned)(zz[pt][g4] >> 32);
                    const float zf[4] = {bflo(z01), bfhi(z01), bflo(z23), bfhi(z23)};
#pragma unroll
                    for (int e = 0; e < 4; ++e) { const int i = 4 * g4 + e;
                        const float y = acc[pt][i] * ea + ((i & 1) ? bfhi(ypf[pt][i >> 1]) : bflo(ypf[pt][i >> 1]));
                        const float yg = y * silu_fast(zf[e]); acc[pt][i] = yg; ss = fmaf(yg, yg, ss); }
                }
            ss = sum_halves(ss);
            LAS float* rd = red + li * 256;
            if (hh == 0) rd[h * 32 + r] = ss;
            __syncthreads();
            float tot = 0.f;
#pragma unroll
            for (int w = 0; w < 8; ++w) tot += rd[w * 32 + r];
            const float rn = rsqrtf(tot * (1.f / 512.f) + EPS);
#pragma unroll
            for (int pt = 0; pt < 2; ++pt)
#pragma unroll
                for (int g4 = 0; g4 < 4; ++g4) { const int ch = h * 64 + 32 * pt + 8 * g4 + 4 * hh;
                    const float4 w = *(const float4*)(P.ssd_norm_w + ch);
                    *(unsigned long long*)(CAT + (size_t)t * DM + 512 + ch) = (unsigned long long)cvtpk(acc[pt][4 * g4] * rn * w.x, acc[pt][4 * g4 + 1] * rn * w.y) | ((unsigned long long)cvtpk(acc[pt][4 * g4 + 2] * rn * w.z, acc[pt][4 * g4 + 3] * rn * w.w) << 32); }
        }
        __syncthreads();
    }
}
__device__ __forceinline__ float gelu_erf(float v) { return 0.5f * v * (1.f + erff(v * 0.70710678118654752f)); }
typedef float f32x2v __attribute__((ext_vector_type(2)));
#define CVT8(W, LO) __builtin_amdgcn_cvt_pk_f32_fp8((int)(W), LO)
template <int CTRL> __device__ __forceinline__ float dpp_f(float v) { return __int_as_float(__builtin_amdgcn_update_dpp(0, __float_as_int(v), CTRL, 0xF, 0xF, true)); }
__device__ __forceinline__ float sum8_dpp(float s) { s += dpp_f<0xB1>(s); s += dpp_f<0x4E>(s); s += dpp_f<0x141>(s); return s; }
struct PeerPlace { int vx, nx, rank, nloc; };
__device__ __forceinline__ PeerPlace peer_place(Frame& F) {
    __syncthreads();
    if (F.wave == 0 && lane_id() == 0) {
        unsigned* bar = (unsigned*)(F.ctl + CW_BAR); const unsigned x = xb_xcc_id();
        unsigned vx = 0, nx = 0;
        for (unsigned j = 0; j < 16; ++j) { const unsigned c = xb_ld(&bar[XB_XCNT(j)]); if (c) { if (j < x) ++vx; ++nx; } }
        const unsigned rank = xb_add((unsigned*)(F.ctl + CW_RANK) + 64 * x, 1u);
        F.MISC[10] = vx; F.MISC[11] = nx ? nx : 1u; F.MISC[12] = rank; F.MISC[13] = xb_ld(&bar[XB_XCNT(x)]);
    }
    __syncthreads();
    PeerPlace pp; pp.vx = (int)F.MISC[10]; pp.nx = (int)F.MISC[11]; pp.rank = (int)F.MISC[12]; pp.nloc = (int)F.MISC[13]; if (pp.nloc < 1) pp.nloc = 1;
    return pp;
}
__device__ __forceinline__ void h_quant_rows(Frame& F, const Ptrs& P) {
    const bf16* HB = (const bf16*)(P.ws + WS_ST); unsigned char* H8 = P.ws + WS_H8; float* HS = (float*)(P.ws + WS_HS);
    const int lane = lane_id();
    for (int t = F.vcu * NWAVES + F.wave; t < T_; t += F.G * NWAVES) {
        const v4u a0 = ((const v4u*)(HB + (size_t)t * DM))[2 * lane], a1 = ((const v4u*)(HB + (size_t)t * DM))[2 * lane + 1];
        float hf[16];
        hf[0] = bflo(a0.x); hf[1] = bfhi(a0.x); hf[2] = bflo(a0.y); hf[3] = bfhi(a0.y); hf[4] = bflo(a0.z); hf[5] = bfhi(a0.z); hf[6] = bflo(a0.w); hf[7] = bfhi(a0.w);
        hf[8] = bflo(a1.x); hf[9] = bfhi(a1.x); hf[10] = bflo(a1.y); hf[11] = bfhi(a1.y); hf[12] = bflo(a1.z); hf[13] = bfhi(a1.z); hf[14] = bflo(a1.w); hf[15] = bfhi(a1.w);
        float am = 0.f;
#pragma unroll
        for (int i = 0; i < 16; ++i) am = fmaxf(am, fabsf(hf[i]));
        am = fmaxf(am, dpp_f<0xB1>(am)); am = fmaxf(am, dpp_f<0x4E>(am)); am = fmaxf(am, dpp_f<0x141>(am)); am = fmaxf(am, dpp_f<0x140>(am)); am = fmaxf(am, 1e-30f);
        const float inv = 119.f / am;
        unsigned hi[2] = {0u, 0u}, lo[2] = {0u, 0u};
#pragma unroll
        for (int i = 0; i < 16; ++i) { const int q = __float2int_rn(hf[i] * inv); const int qh = (q + 8) >> 4, ql = q - 16 * qh;
            hi[i >> 3] |= ((unsigned)qh & 15u) << (4 * (i & 7)); lo[i >> 3] |= ((unsigned)ql & 15u) << (4 * (i & 7)); }
        unsigned char* dst = H8 + (size_t)t * 1024 + (lane >> 4) * 256 + (lane & 15) * 8;
        *(unsigned long long*)dst = (unsigned long long)hi[0] | ((unsigned long long)hi[1] << 32);
        *(unsigned long long*)(dst + 128) = (unsigned long long)lo[0] | ((unsigned long long)lo[1] << 32);
        if ((lane & 15) == 0) HS[(size_t)t * 8 + (lane >> 4)] = am * (1.f / 119.f);
    }
}
constexpr int PX_D = 16;
template <int CTRL> __device__ __forceinline__ int dpp_i(int v) { return __builtin_amdgcn_update_dpp(0, v, CTRL, 0xF, 0xF, true); }
#define PX_ISSUE(BUF, LO, HI) _Pragma("unroll") for (int b_ = 0; b_ < 8; ++b_) { const unsigned off_ = ((unsigned)__builtin_amdgcn_ds_bpermute((16 * (b_ & 3) + ps) * 4, (b_ & 4) ? (HI) : (LO)) << 7) | (unsigned)(dl << 5); \
        BUF[2 * b_] = *(const v4u*)(tab + off_); BUF[2 * b_ + 1] = *(const v4u*)(tab + off_ + 16); }
struct H4 { v4u h0, h1, l0, l1; };
#define PX_DOT8(Q, HH, HL) ah = __builtin_amdgcn_sdot8((int)(Q), (int)(HH), ah, false); al = __builtin_amdgcn_sdot8((int)(Q), (int)(HL), al, false);
__device__ __forceinline__ void peer_down_token(const v4u (&cur)[PX_D], const H4& h, const float hs, unsigned* prow, int dl, int ps) {
    int sm[8];
#pragma unroll
    for (int b = 0; b < 8; ++b) { const v4u q0 = cur[2 * b], q1 = cur[2 * b + 1];
        int ah = 0, al = 0;
        PX_DOT8(q0.x, h.h0.x, h.l0.x) PX_DOT8(q0.y, h.h0.y, h.l0.y) PX_DOT8(q0.z, h.h0.z, h.l0.z) PX_DOT8(q0.w, h.h0.w, h.l0.w)
        PX_DOT8(q1.x, h.h1.x, h.l1.x) PX_DOT8(q1.y, h.h1.y, h.l1.y) PX_DOT8(q1.z, h.h1.z, h.l1.z) PX_DOT8(q1.w, h.h1.w, h.l1.w)
        sm[b] = 16 * ah + al; }
    const bool c1 = (dl & 2) != 0, c0 = (dl & 1) != 0;
    int w4[4], w2[2];
#pragma unroll
    for (int k = 0; k < 4; ++k) { const int keep = c1 ? sm[4 + k] : sm[k], send = c1 ? sm[k] : sm[4 + k]; w4[k] = keep + dpp_i<0x4E>(send); }
#pragma unroll
    for (int k = 0; k < 2; ++k) { const int keep = c0 ? w4[2 + k] : w4[k], send = c0 ? w4[k] : w4[2 + k]; w2[k] = keep + dpp_i<0xB1>(send); }
    const float f0 = (float)w2[0] * hs, f1 = (float)w2[1] * hs;
    const float g0 = dpp_f<0x4E>(f0), g1 = dpp_f<0x4E>(f1);
    if (dl < 2) { prow[32 * dl + ps] = cvtpk(f0, g0); prow[32 * dl + 16 + ps] = cvtpk(f1, g1); }
}
__device__ __forceinline__ void peer_down(Frame& F, const Ptrs& P, const PeerPlace& pp) {
    const unsigned char* H8 = P.ws + WS_H8; const unsigned char* HSb = P.ws + WS_HS; const unsigned char* IDXb = P.ws + WS_IDX; unsigned char* PARTb = P.ws + WS_PART;
    const int lane = lane_id(), dl = lane & 3, ps = lane >> 2;
    const int tstep = pp.nloc * NWAVES;
    for (int u = pp.vx; u < 8; u += pp.nx) {
        const int s = u & 3, tend = ((u >> 2) + 1) * (T_ / 2), t0 = (u >> 2) * (T_ / 2) + pp.rank * NWAVES + F.wave;
        if (t0 >= tend) continue;
        const unsigned char* tab = P.ws + WS_ED + (size_t)s * 16384 * 128;
        const unsigned hoff = (unsigned)(s * 256 + dl * 32), ioff = (unsigned)lane * 4u;
        v4u bufA[PX_D], bufB[PX_D];
#define PD_CLAMP(T) ((T) < tend ? (T) : t0)
#define PD_META(H, HSC, TT) do { const unsigned char* hp_ = H8 + ((unsigned)(TT) * 1024u + hoff); H.h0 = *(const v4u*)hp_; H.h1 = *(const v4u*)(hp_ + 16); H.l0 = *(const v4u*)(hp_ + 128); H.l1 = *(const v4u*)(hp_ + 144); \
        HSC = *(const float*)(HSb + ((unsigned)(TT) * 32u + (unsigned)s * 4u)); } while (0)
#define PD_IDX(LO, HI, TT) do { LO = *(const int*)(IDXb + ((unsigned)(TT) * 512u + ioff)); HI = *(const int*)(IDXb + ((unsigned)(TT) * 512u + 256u + ioff)); } while (0)
        int nidx_lo, nidx_hi; PD_IDX(nidx_lo, nidx_hi, t0);
        PX_ISSUE(bufA, nidx_lo, nidx_hi);
        PD_IDX(nidx_lo, nidx_hi, PD_CLAMP(t0 + tstep));
        H4 ha, hb; float sa, sb; PD_META(ha, sa, t0);
        for (int t = t0; t < tend; t += 2 * tstep) {
            { const int tn = PD_CLAMP(t + tstep);
              PX_ISSUE(bufB, nidx_lo, nidx_hi); PD_IDX(nidx_lo, nidx_hi, PD_CLAMP(tn + tstep)); PD_META(hb, sb, tn);
              __builtin_amdgcn_sched_barrier(0);
              peer_down_token(bufA, ha, sa, (unsigned*)(PARTb + ((unsigned)(s * T_ + t) * 256u)), dl, ps);
              __builtin_amdgcn_sched_barrier(0); }
            if (t + tstep >= tend) break;
            { const int tc = t + tstep, tn = PD_CLAMP(tc + tstep);
              PX_ISSUE(bufA, nidx_lo, nidx_hi); PD_IDX(nidx_lo, nidx_hi, PD_CLAMP(tn + tstep)); PD_META(ha, sa, tn);
              __builtin_amdgcn_sched_barrier(0);
              peer_down_token(bufB, hb, sb, (unsigned*)(PARTb + ((unsigned)(s * T_ + tc) * 256u)), dl, ps);
              __builtin_amdgcn_sched_barrier(0); }
        }
    }
}
constexpr int PE_PD = 8;
#define PE_LOAD4(SLOT, IDV) SLOT = *(const v4u*)(EU + (((unsigned)(IDV) << 9) | l16))
#define PE_BP(ADDR, V) __builtin_amdgcn_ds_bpermute((ADDR), (V))
__device__ __forceinline__ void peer_up_tm(Frame& F, const Ptrs& P) {
    const bf16* HB = (const bf16*)(P.ws + WS_ST); const unsigned char* EU = P.ws + WS_EU;
    const int* IDX = (const int*)(P.ws + WS_IDX); const float* GATE = (const float*)(P.ws + WS_GATE); const unsigned* PART = (const unsigned*)(P.ws + WS_PART);
    const float* SCD = (const float*)(P.ws + WS_SMALL); const float* SCU = SCD + 16384;
    const int lane = lane_id(), l31 = lane & 31; const bool upper = lane >= 32;
    const unsigned l16 = (unsigned)l31 << 4;
    const int bp0 = upper ? 4 : 0;
    const int t0 = F.vcu * NWAVES + F.wave, tstep = F.G * NWAVES;
    if (t0 >= T_) return;
    float4 nfw[4];
#pragma unroll
    for (int k = 0; k < 4; ++k) nfw[k] = ((const float4*)(P.norm_final) + 8 * l31 + 4 * (lane >> 5))[k];
    int idx_lo = IDX[(size_t)t0 * 128 + lane], idx_hi = IDX[(size_t)t0 * 128 + 64 + lane];
    v4u hq[4];
#pragma unroll
    for (int k = 0; k < 4; ++k) hq[k] = ((const v4u*)(HB + (size_t)t0 * DM))[4 * l31 + k];
    float g_lo = GATE[(size_t)t0 * 128 + lane], g_hi = GATE[(size_t)t0 * 128 + 64 + lane];
    float pre_lo = 0.f, pre_hi = 0.f;
#pragma unroll
    for (int s = 0; s < 4; ++s) { const unsigned pp_ = PART[((size_t)s * T_ + t0) * 64 + lane]; pre_lo += bflo(pp_); pre_hi += bfhi(pp_); }
    float sdu_lo = SCD[idx_lo], sdu_hi = SCD[idx_hi], su_lo = SCU[idx_lo], su_hi = SCU[idx_hi];
    v4u ra[PE_PD];
#pragma unroll
    for (int j = 0; j < PE_PD; ++j) { const int id = PE_BP(bp0 + 8 * j, idx_lo); PE_LOAD4(ra[j], id); }
    int id_nx = PE_BP(bp0 + 8 * PE_PD, idx_lo);
    for (int t = t0; t < T_; t += tstep) {
        const int tn = (t + tstep < T_) ? t + tstep : t;
        const int nidx_lo = IDX[(size_t)tn * 128 + lane], nidx_hi = IDX[(size_t)tn * 128 + 64 + lane];
        v4u nh[4];
#pragma unroll
        for (int k = 0; k < 4; ++k) nh[k] = ((const v4u*)(HB + (size_t)tn * DM))[4 * l31 + k];
        const float ng_lo = GATE[(size_t)tn * 128 + lane], ng_hi = GATE[(size_t)tn * 128 + 64 + lane];
        unsigned npart[4];
#pragma unroll
        for (int s = 0; s < 4; ++s) npart[s] = PART[((size_t)s * T_ + tn) * 64 + lane];
        float ssq = 0.f;
#pragma unroll
        for (int k = 0; k < 4; ++k) { ssq = fmaf(bflo(hq[k].x), bflo(hq[k].x), ssq); ssq = fmaf(bfhi(hq[k].x), bfhi(hq[k].x), ssq); ssq = fmaf(bflo(hq[k].y), bflo(hq[k].y), ssq); ssq = fmaf(bfhi(hq[k].y), bfhi(hq[k].y), ssq);
            ssq = fmaf(bflo(hq[k].z), bflo(hq[k].z), ssq); ssq = fmaf(bfhi(hq[k].z), bfhi(hq[k].z), ssq); ssq = fmaf(bflo(hq[k].w), bflo(hq[k].w), ssq); ssq = fmaf(bfhi(hq[k].w), bfhi(hq[k].w), ssq); }
        ssq += swz_xor<1>(ssq); ssq += swz_xor<2>(ssq); ssq += swz_xor<4>(ssq); ssq += swz_xor<8>(ssq); ssq += swz_xor<16>(ssq);
        const float rstd = rsqrtf(ssq * (1.f / 1024.f) + EPS);
        const float act_lo = gelu_erf(pre_lo * sdu_lo * rstd) * g_lo * su_lo, act_hi = gelu_erf(pre_hi * sdu_hi * rstd) * g_hi * su_hi;
        float nsdu_lo = 0.f, nsdu_hi = 0.f, nsu_lo = 0.f, nsu_hi = 0.f;
        f32x2v acc[16];
#pragma unroll
        for (int i = 0; i < 16; ++i) acc[i] = (f32x2v){0.f, 0.f};
        float a_cur = __int_as_float(PE_BP(bp0, __float_as_int(act_lo)));
#pragma unroll
        for (int q = 0; q < 64; ++q) {
            const int qa = q + 1, ql = q + PE_PD + 1;
            float a_nx = 0.f;
            if (qa < 64) a_nx = __int_as_float(PE_BP(bp0 + 8 * (qa & 31), __float_as_int(qa < 32 ? act_lo : act_hi)));
            int id_n2;
            if (ql < 64) id_n2 = PE_BP(bp0 + 8 * (ql & 31), ql < 32 ? idx_lo : idx_hi);
            else id_n2 = PE_BP(bp0 + 8 * ((ql - 64) & 31), nidx_lo);
            __builtin_amdgcn_sched_barrier(0);
            { const f32x2v av = {a_cur, a_cur}; const v4u r = ra[q % PE_PD];
#define PE_FMA4(W, O) acc[O] = __builtin_elementwise_fma(av, (f32x2v)__builtin_amdgcn_cvt_scalef32_pk_f32_fp4(W, 1.0f, 0), acc[O]); acc[O + 1] = __builtin_elementwise_fma(av, (f32x2v)__builtin_amdgcn_cvt_scalef32_pk_f32_fp4(W, 1.0f, 1), acc[O + 1]); \
              acc[O + 2] = __builtin_elementwise_fma(av, (f32x2v)__builtin_amdgcn_cvt_scalef32_pk_f32_fp4(W, 1.0f, 2), acc[O + 2]); acc[O + 3] = __builtin_elementwise_fma(av, (f32x2v)__builtin_amdgcn_cvt_scalef32_pk_f32_fp4(W, 1.0f, 3), acc[O + 3]);
              PE_FMA4(r.x, 0) PE_FMA4(r.y, 4) PE_FMA4(r.z, 8) PE_FMA4(r.w, 12) }
            asm volatile("" : "+v"(acc[0]), "+v"(acc[1]), "+v"(acc[2]), "+v"(acc[3]), "+v"(acc[4]), "+v"(acc[5]), "+v"(acc[6]), "+v"(acc[7]));
            asm volatile("" : "+v"(acc[8]), "+v"(acc[9]), "+v"(acc[10]), "+v"(acc[11]), "+v"(acc[12]), "+v"(acc[13]), "+v"(acc[14]), "+v"(acc[15]));
            PE_LOAD4(ra[q % PE_PD], id_nx);
            if (q == 24) { nsdu_lo = SCD[nidx_lo]; nsdu_hi = SCD[nidx_hi]; nsu_lo = SCU[nidx_lo]; nsu_hi = SCU[nidx_hi]; }
            id_nx = id_n2; a_cur = a_nx;
            __builtin_amdgcn_sched_barrier(0);
        }
        { float a = 0.f, c = 0.f;
#pragma unroll
          for (int s = 0; s < 4; ++s) { a += bflo(npart[s]); c += bfhi(npart[s]); }
          pre_lo = a; pre_hi = c; }
        sdu_lo = nsdu_lo; sdu_hi = nsdu_hi; su_lo = nsu_lo; su_hi = nsu_hi;
        float y[32];
#pragma unroll
        for (int k = 0; k < 4; ++k) { y[8 * k] = bflo(hq[k].x); y[8 * k + 1] = bfhi(hq[k].x); y[8 * k + 2] = bflo(hq[k].y); y[8 * k + 3] = bfhi(hq[k].y); y[8 * k + 4] = bflo(hq[k].z); y[8 * k + 5] = bfhi(hq[k].z); y[8 * k + 6] = bflo(hq[k].w); y[8 * k + 7] = bfhi(hq[k].w); }
        float s2 = 0.f;
#pragma unroll
        for (int i = 0; i < 16; ++i) { y[2 * i] += sum_halves(acc[i][0]); y[2 * i + 1] += sum_halves(acc[i][1]); s2 = fmaf(y[2 * i], y[2 * i], s2); s2 = fmaf(y[2 * i + 1], y[2 * i + 1], s2); }
        s2 += swz_xor<1>(s2); s2 += swz_xor<2>(s2); s2 += swz_xor<4>(s2); s2 += swz_xor<8>(s2); s2 += swz_xor<16>(s2);
        const float r2 = rsqrtf(s2 * (1.f / 1024.f) + EPS);
        float4* o = (float4*)(P.out + (size_t)t * DM) + 8 * l31 + 4 * (lane >> 5);
#pragma unroll
        for (int k = 0; k < 4; ++k) { const float4 w = nfw[k];
            const float e0 = upper ? y[16 + 4 * k] : y[4 * k], e1 = upper ? y[17 + 4 * k] : y[4 * k + 1], e2 = upper ? y[18 + 4 * k] : y[4 * k + 2], e3 = upper ? y[19 + 4 * k] : y[4 * k + 3];
            o[k] = make_float4(e0 * r2 * w.x, e1 * r2 * w.y, e2 * r2 * w.z, e3 * r2 * w.w); }
        idx_lo = nidx_lo; idx_hi = nidx_hi; g_lo = ng_lo; g_hi = ng_hi;
#pragma unroll
        for (int k = 0; k < 4; ++k) hq[k] = nh[k];
    }
}
constexpr int TK_LDK = 136, TK_K2 = 34816, TK_SCR = 69632, TK_SP = 49;
__device__ __forceinline__ int mono_key(float x) { const int b = __float_as_int(x); return b ^ ((b >> 31) & 0x7fffffff); }
__device__ __forceinline__ float unmono(int m) { return __int_as_float(m ^ ((m >> 31) & 0x7fffffff)); }
__device__ __forceinline__ int max3i(int a, int b, int c) { return max(max(a, b), c); }
#define CEX(A, I, J) do { const int hi_ = max(A[I], A[J]), lo_ = min(A[I], A[J]); A[I] = hi_; A[J] = lo_; } while (0)
template <int N, int OFF, int K, int J, int LEN> struct BitonicStep {
    static __device__ __forceinline__ void run(int (&a)[LEN]) {
#pragma unroll
        for (int i = 0; i < N; ++i) { const int l = i ^ J; if (l > i) { if ((i & K) == 0) CEX(a, OFF + i, OFF + l); else CEX(a, OFF + l, OFF + i); } }
        if constexpr (J > 1) BitonicStep<N, OFF, K, (J >> 1), LEN>::run(a);
        else if constexpr (K < N) BitonicStep<N, OFF, (K << 1), K, LEN>::run(a);
    }
};
template <int N, int OFF, int LEN> __device__ __forceinline__ void bitonic_sort_desc(int (&a)[LEN]) { BitonicStep<N, OFF, 2, 1, LEN>::run(a); }
template <int OFF, int LEN> __device__ __forceinline__ void bitonic_merge16_desc(int (&a)[LEN]) { BitonicStep<16, OFF, 16, 8, LEN>::run(a); }
template <int OFF, int LEN> __device__ __forceinline__ void oem_sort16_desc(int (&a)[LEN]) {
    constexpr unsigned char Pn[63][2] = {{0, 1}, {2, 3}, {0, 2}, {1, 3}, {1, 2}, {4, 5}, {6, 7}, {4, 6}, {5, 7}, {5, 6}, {0, 4}, {2, 6}, {2, 4}, {1, 5}, {3, 7}, {3, 5}, {1, 2}, {3, 4}, {5, 6}, {8, 9}, {10, 11}, {8, 10}, {9, 11}, {9, 10}, {12, 13}, {14, 15}, {12, 14}, {13, 15}, {13, 14}, {8, 12}, {10, 14}, {10, 12}, {9, 13}, {11, 15}, {11, 13}, {9, 10}, {11, 12}, {13, 14}, {0, 8}, {4, 12}, {4, 8}, {2, 10}, {6, 14}, {6, 10}, {2, 4}, {6, 8}, {10, 12}, {1, 9}, {5, 13}, {5, 9}, {3, 11}, {7, 15}, {7, 11}, {3, 5}, {7, 9}, {11, 13}, {1, 2}, {3, 4}, {5, 6}, {7, 8}, {9, 10}, {11, 12}, {13, 14}};
#pragma unroll
    for (int k = 0; k < 63; ++k) CEX(a, OFF + Pn[k][0], OFF + Pn[k][1]);
}
template <int LEN> __device__ __forceinline__ void oem_sort32_desc(int (&a)[LEN]) {
    constexpr unsigned char Pn[191][2] = {{0, 1}, {2, 3}, {0, 2}, {1, 3}, {1, 2}, {4, 5}, {6, 7}, {4, 6}, {5, 7}, {5, 6}, {0, 4}, {2, 6}, {2, 4}, {1, 5}, {3, 7}, {3, 5}, {1, 2}, {3, 4}, {5, 6}, {8, 9}, {10, 11}, {8, 10}, {9, 11}, {9, 10}, {12, 13}, {14, 15}, {12, 14}, {13, 15}, {13, 14}, {8, 12}, {10, 14}, {10, 12}, {9, 13}, {11, 15}, {11, 13}, {9, 10}, {11, 12}, {13, 14}, {0, 8}, {4, 12}, {4, 8}, {2, 10}, {6, 14}, {6, 10}, {2, 4}, {6, 8}, {10, 12}, {1, 9}, {5, 13}, {5, 9}, {3, 11}, {7, 15}, {7, 11}, {3, 5}, {7, 9}, {11, 13}, {1, 2}, {3, 4}, {5, 6}, {7, 8}, {9, 10}, {11, 12}, {13, 14}, {16, 17}, {18, 19}, {16, 18}, {17, 19}, {17, 18}, {20, 21}, {22, 23}, {20, 22}, {21, 23}, {21, 22}, {16, 20}, {18, 22}, {18, 20}, {17, 21}, {19, 23}, {19, 21}, {17, 18}, {19, 20}, {21, 22}, {24, 25}, {26, 27}, {24, 26}, {25, 27}, {25, 26}, {28, 29}, {30, 31}, {28, 30}, {29, 31}, {29, 30}, {24, 28}, {26, 30}, {26, 28}, {25, 29}, {27, 31}, {27, 29}, {25, 26}, {27, 28}, {29, 30}, {16, 24}, {20, 28}, {20, 24}, {18, 26}, {22, 30}, {22, 26}, {18, 20}, {22, 24}, {26, 28}, {17, 25}, {21, 29}, {21, 25}, {19, 27}, {23, 31}, {23, 27}, {19, 21}, {23, 25}, {27, 29}, {17, 18}, {19, 20}, {21, 22}, {23, 24}, {25, 26}, {27, 28}, {29, 30}, {0, 16}, {8, 24}, {8, 16}, {4, 20}, {12, 28}, {12, 20}, {4, 8}, {12, 16}, {20, 24}, {2, 18}, {10, 26}, {10, 18}, {6, 22}, {14, 30}, {14, 22}, {6, 10}, {14, 18}, {22, 26}, {2, 4}, {6, 8}, {10, 12}, {14, 16}, {18, 20}, {22, 24}, {26, 28}, {1, 17}, {9, 25}, {9, 17}, {5, 21}, {13, 29}, {13, 21}, {5, 9}, {13, 17}, {21, 25}, {3, 19}, {11, 27}, {11, 19}, {7, 23}, {15, 31}, {15, 23}, {7, 11}, {15, 19}, {23, 27}, {3, 5}, {7, 9}, {11, 13}, {15, 17}, {19, 21}, {23, 25}, {27, 29}, {1, 2}, {3, 4}, {5, 6}, {7, 8}, {9, 10}, {11, 12}, {13, 14}, {15, 16}, {17, 18}, {19, 20}, {21, 22}, {23, 24}, {25, 26}, {27, 28}, {29, 30}};
#pragma unroll
    for (int k = 0; k < 191; ++k) CEX(a, Pn[k][0], Pn[k][1]);
}
template <int A, int B, int LEN> __device__ __forceinline__ void merge_top16(int (&a)[LEN]) {
#pragma unroll
    for (int i = 0; i < 16; ++i) a[A + i] = max(a[A + i], a[B + 15 - i]);
    bitonic_merge16_desc<A, LEN>(a);
}
template <int LEN> __device__ __forceinline__ void pair_top16(int (&a)[LEN]) {
    int lo[16], up[16];
#pragma unroll
    for (int i = 0; i < 16; ++i) { const auto rr = __builtin_amdgcn_permlane32_swap((unsigned)a[i], (unsigned)a[i], false, false); lo[i] = (int)rr[0]; up[i] = (int)rr[1]; }
#pragma unroll
    for (int i = 0; i < 16; ++i) a[i] = max(lo[i], up[15 - i]);
    bitonic_merge16_desc<0, LEN>(a);
}
__device__ __forceinline__ void topk_half(const bf16x8 (&qf)[8], const LAS bf16* Kh, int r, int hh, int (&key)[64]) {
#pragma unroll
    for (int nt = 0; nt < 4; ++nt) {
        f32x16 sc;
#pragma unroll
        for (int i = 0; i < 16; ++i) sc[i] = 0.f;
#pragma unroll
        for (int kk = 0; kk < 8; ++kk) { const bf16x8 a = *(const LAS bf16x8*)(Kh + (32 * nt + r) * TK_LDK + 16 * kk + 8 * hh); sc = MFMA32(a, qf[kk], sc); }
#pragma unroll
        for (int i = 0; i < 16; ++i) key[nt * 16 + i] = (mono_key(sc[i]) & ~127) | (127 - (32 * nt + crow(i, hh)));
    }
    oem_sort16_desc<0, 64>(key); oem_sort16_desc<16, 64>(key); oem_sort16_desc<32, 64>(key); oem_sort16_desc<48, 64>(key);
    merge_top16<0, 16, 64>(key); merge_top16<32, 48, 64>(key); merge_top16<0, 32, 64>(key);
    pair_top16<64>(key);
}
__device__ __forceinline__ void topk_finish(const LAS int* scr, int hh, float rstd, int* IDX, float* GATE, int t, int hd) {
    const LAS int* la = scr + hh * 16; const LAS int* lb = scr + (1 - hh) * 16;
    float va[4], vb[16];
#pragma unroll
    for (int i = 0; i < 4; ++i) va[i] = unmono(la[i] & ~127);
#pragma unroll
    for (int j = 0; j < 16; ++j) vb[j] = unmono(lb[j] & ~127);
    int ck[32];
    {
        int q = 0;
#pragma unroll
        for (int i = 0; i < 4; ++i)
#pragma unroll
            for (int j = i; j < 16; ++j) if ((i + 1) * (j + 1) <= 16) {
                const int pos = hh ? (j * 16 + i) : (i * 16 + j);
                int k = (mono_key(va[i] + vb[j]) & ~255) | (255 - pos);
                if (i == j && hh) k = (int)0x80000000;
                ck[q++] = k; }
#pragma unroll
        for (int i = 27; i < 32; ++i) ck[i] = (int)0x80000000;
    }
    oem_sort32_desc<32>(ck);
    pair_top16<32>(ck);
    const float vmax = unmono(ck[0] & ~255) * rstd;
    float ev[8]; int id[8]; float esum = 0.f; const int hm = -hh;
#pragma unroll
    for (int q = 0; q < 8; ++q) { const int wk = ck[q] ^ ((ck[q] ^ ck[8 + q]) & hm); const int pos = 255 - (wk & 255);
        const int n1 = 127 - (scr[pos >> 4] & 127), n2 = 127 - (scr[16 + (pos & 15)] & 127);
        id[q] = n1 * 128 + n2;
        ev[q] = exp2f((unmono(wk & ~255) * rstd - vmax) * LOG2E); esum += ev[q]; }
    esum = sum_halves(esum);
    const float inv = 1.f / esum;
    int4* ip = (int4*)(IDX + ((size_t)t * 8 + hd) * 16 + hh * 8); float4* gp = (float4*)(GATE + ((size_t)t * 8 + hd) * 16 + hh * 8);
    ip[0] = make_int4(id[0], id[1], id[2], id[3]); ip[1] = make_int4(id[4], id[5], id[6], id[7]);
    gp[0] = make_float4(ev[0] * inv, ev[1] * inv, ev[2] * inv, ev[3] * inv); gp[1] = make_float4(ev[4] * inv, ev[5] * inv, ev[6] * inv, ev[7] * inv);
}
constexpr int TQ_QH = 69632, TQ_QP = 272;
struct OneUnit { pg8::StaticOrder S; int i;
    __device__ __forceinline__ bool next(int j, pg8::Unit& u) const { return j == 0 ? S.next(i, u) : false; }
    __device__ __forceinline__ void a_ready(const pg8::Unit&) const {}
    __device__ __forceinline__ void done(const pg8::Unit&) const {}
};
struct EpiQTopk {
    static constexpr bool PERM = true, AFTER_DRAIN = true;
    const unsigned char* KB; const float* SSQ; int* IDX; float* GATE;
    __device__ __forceinline__ void dump(const pg8::f32x4 (&acc)[2][2][4][2], int bj, LAS unsigned char* QH, int wr, int wc, int fr, int fq) const {
#pragma unroll
        for (int ai = 0; ai < 2; ++ai)
#pragma unroll
            for (int m = 0; m < 4; ++m) { const pg8::f32x4 v0 = bj ? acc[ai][1][m][0] : acc[ai][0][m][0], v1 = bj ? acc[ai][1][m][1] : acc[ai][0][m][1];
                v4u w; w.x = cvtpk(v0[0], v0[1]); w.y = cvtpk(v0[2], v0[3]); w.z = cvtpk(v1[0], v1[1]); w.w = cvtpk(v1[2], v1[3]);
                *(LAS v4u*)(QH + (128 * ai + 64 * wr + 16 * m + fr) * TQ_QP + (32 * wc + 8 * fq) * 2) = w; }
    }
    __device__ __forceinline__ void fused(const pg8::f32x4 (&acc)[2][2][4][2], const pg8::Unit& u, int wr, int wc, int fr, int fq, LAS unsigned char* L, int wid, int lane) const {
        LAS bf16* K1 = (LAS bf16*)L; LAS bf16* K2 = (LAS bf16*)(L + TK_K2); LAS unsigned char* QH = L + TQ_QH;
        const int tid_ = wid * 64 + lane, r = lane & 31, hh = lane >> 5;
        { v4u kq[8];
#pragma unroll
          for (int q = 0; q < 8; ++q) kq[q] = ((const v4u*)KB)[tid_ + 512 * q];
          dump(acc, 0, QH, wr, wc, fr, fq);
#pragma unroll
          for (int q = 0; q < 8; ++q) { const int j = tid_ + 512 * q, n = (j >> 4) & 127, k8 = j & 15; *(LAS v4u*)(((j >> 11) ? K2 : K1) + n * TK_LDK + 8 * k8) = kq[q]; } }
        __syncthreads();
        const int t = u.pm * 256 + 32 * wid + r;
        float rstd;
        { const float4* sp = (const float4*)(SSQ + (size_t)t * 16); const float4 a = sp[0], b = sp[1], c = sp[2], d = sp[3];
          rstd = rsqrtf(((a.x + a.y + a.z + a.w) + (b.x + b.y + b.z + b.w) + (c.x + c.y + c.z + c.w) + (d.x + d.y + d.z + d.w)) * (1.f / 1024.f) + EPS); }
        const LAS unsigned char* qrow = QH + (32 * wid + r) * TQ_QP + 16 * hh;
        int key[64], list0[16];
        { bf16x8 qf[8];
#pragma unroll
          for (int kk = 0; kk < 8; ++kk) qf[kk] = *(const LAS bf16x8*)(qrow + 32 * kk);
          topk_half(qf, K1, r, hh, key);
#pragma unroll
          for (int i = 0; i < 16; ++i) list0[i] = key[i]; }
        __syncthreads();
        dump(acc, 1, QH, wr, wc, fr, fq);
        __syncthreads();
        { bf16x8 qf[8];
#pragma unroll
          for (int kk = 0; kk < 8; ++kk) qf[kk] = *(const LAS bf16x8*)(qrow + 32 * kk);
          topk_half(qf, K2, r, hh, key); }
        LAS int* scr = (LAS int*)(QH + 32 * wid * TQ_QP) + r * TK_SP;
        LDS_WAIT();
        if (hh == 0) {
#pragma unroll
            for (int i = 0; i < 16; ++i) { scr[i] = list0[i]; scr[16 + i] = key[i]; } }
        topk_finish(scr, hh, rstd, IDX, GATE, t, u.pn);
        __syncthreads();
    }
};

constexpr int AT_KP = 72, AT_VP = 264;
constexpr int AT_K = 0, AT_VT = 36864, AT_BT = 36864 + 33792;
__device__ __forceinline__ void attn_phase(Frame& F, const Ptrs& P) {
    const bf16* PROJ = (const bf16*)(P.ws + WS_PROJ); bf16* CAT = (bf16*)(P.ws + WS_XN);
    LAS unsigned char* L = F.lds + RING_OFF;
    LAS bf16* Ks = (LAS bf16*)(L + AT_K); LAS bf16* Vt = (LAS bf16*)(L + AT_VT); LAS float* btab = (LAS float*)(L + AT_BT);
    const int lane = lane_id(), tid_ = F.wave * 64 + lane, r = lane & 31, hh = lane >> 5;
    for (int u = F.vcu; u < 256; u += F.G) {
        const int hkv = u & 1, n = (u >> 1) & 31, b = u >> 6;
        const int trow0 = b * SEQ + n * 128;
        v4u kvq[4], vvq[4];
#pragma unroll
        for (int q = 0; q < 4; ++q) { const int i = tid_ + 512 * q, kj = i >> 3, ch = i & 7; const bool ok = (n > 0) || (kj >= 128);
            kvq[q] = (v4u){0u, 0u, 0u, 0u}; vvq[q] = (v4u){0u, 0u, 0u, 0u};
            if (ok) { const bf16* rowp = PROJ + (size_t)(trow0 - 128 + kj) * NPROJ + hkv * 64 + ch * 8; kvq[q] = *(const v4u*)(rowp + PJ_K); vvq[q] = *(const v4u*)(rowp + PJ_V); } }
#pragma unroll
        for (int q = 0; q < 4; ++q) {
            const int i = tid_ + 512 * q, kj = i >> 3, ch = i & 7;
            const v4u kv = kvq[q], vv = vvq[q];
            *(LAS v4u*)(Ks + kj * AT_KP + ch * 8) = kv;
            LAS bf16* vp = Vt + (ch * 8) * AT_VP + kj;
            vp[0] = (bf16)(vv.x & 0xffffu); vp[AT_VP] = (bf16)(vv.x >> 16); vp[2 * AT_VP] = (bf16)(vv.y & 0xffffu); vp[3 * AT_VP] = (bf16)(vv.y >> 16);
            vp[4 * AT_VP] = (bf16)(vv.z & 0xffffu); vp[5 * AT_VP] = (bf16)(vv.z >> 16); vp[6 * AT_VP] = (bf16)(vv.w & 0xffffu); vp[7 * AT_VP] = (bf16)(vv.w >> 16);
        }
        { const float* BT = (const float*)(P.ws + WS_BTAB) + hkv * 768;
          const float b0 = BT[tid_], b1 = (tid_ < 256) ? BT[512 + tid_] : 0.f;
          btab[tid_] = b0; if (tid_ < 256) btab[512 + tid_] = b1; }
        __syncthreads();
        const int g = F.wave & 3, h = hkv * 4 + g;
        const float sink2 = P.sinks[h] * LOG2E;
        bf16x8 qf[4], qfn[4];
#pragma unroll
        for (int kk = 0; kk < 4; ++kk) { qf[kk] = *(const bf16x8*)(PROJ + (size_t)(trow0 + 32 * ((F.wave >> 2) * 2) + r) * NPROJ + h * 64 + 16 * kk + 8 * hh);
            qfn[kk] = *(const bf16x8*)(PROJ + (size_t)(trow0 + 32 * ((F.wave >> 2) * 2 + 1) + r) * NPROJ + h * 64 + 16 * kk + 8 * hh); }
#pragma unroll 1
        for (int qq = 0; qq < 2; ++qq) {
            const int qt = (F.wave >> 2) * 2 + qq, t = trow0 + 32 * qt + r;
            f32x16 sc[5];
#pragma unroll
            for (int j = 0; j < 5; ++j) {
#pragma unroll
                for (int i = 0; i < 16; ++i) sc[j][i] = 0.f;
#pragma unroll
                for (int kk = 0; kk < 4; ++kk) { const bf16x8 a = *(const LAS bf16x8*)(Ks + (32 * (qt + j) + r) * AT_KP + 16 * kk + 8 * hh); sc[j] = MFMA32(a, qf[kk], sc[j]); }
            }
            float m = sink2;
            const LAS float* bt = btab + g * 192 + 160 + r - 4 * hh;
#pragma unroll
            for (int j = 0; j < 5; ++j) {
                const bool tile_ok = (n > 0) || (qt + j >= 4);
#pragma unroll
                for (int i = 0; i < 16; ++i) { const int dist = 128 + r - (32 * j + crow(i, hh));
                    const bool ok = tile_ok && (j == 0 ? dist < 128 : (j == 4 ? dist >= 0 : true));
                    const float s = sc[j][i] * (0.125f * LOG2E) + bt[-(32 * j + (i & 3) + 8 * (i >> 2))];
                    sc[j][i] = ok ? s : -INFINITY; m = fmaxf(m, sc[j][i]); }
            }
            m = max_halves(m);
            float l = 0.f;
#pragma unroll
            for (int j = 0; j < 5; ++j)
#pragma unroll
                for (int i = 0; i < 16; ++i) { sc[j][i] = exp2f(sc[j][i] - m); l += sc[j][i]; }
            l = sum_halves(l);
            l += exp2f(sink2 - m);
            const float inv = 1.f / l;
            f32x16 o[2];
#pragma unroll
            for (int i = 0; i < 16; ++i) { o[0][i] = 0.f; o[1][i] = 0.f; }
#pragma unroll
            for (int j = 0; j < 5; ++j)
#pragma unroll
                for (int sg = 0; sg < 2; ++sg) {
                    const bf16x8 pf = pack8(sc[j], sg);
#pragma unroll
                    for (int dt = 0; dt < 2; ++dt) {
                        const LAS bf16* vb = Vt + (32 * dt + r) * AT_VP + 32 * (qt + j) + 16 * sg + 4 * hh;
                        const s16x4 lo = *(const LAS s16x4*)(vb), hi = *(const LAS s16x4*)(vb + 8);
                        o[dt] = MFMA32(__builtin_shufflevector(lo, hi, 0, 1, 2, 3, 4, 5, 6, 7), pf, o[dt]);
                    }
                }
            bf16* op = CAT + (size_t)t * DM + h * 64 + 4 * hh;
#pragma unroll
            for (int dt = 0; dt < 2; ++dt)
#pragma unroll
                for (int g4 = 0; g4 < 4; ++g4)
                    *(unsigned long long*)(op + 32 * dt + 8 * g4) = (unsigned long long)cvtpk(o[dt][4 * g4] * inv, o[dt][4 * g4 + 1] * inv) | ((unsigned long long)cvtpk(o[dt][4 * g4 + 2] * inv, o[dt][4 * g4 + 3] * inv) << 32);
#pragma unroll
            for (int kk = 0; kk < 4; ++kk) qf[kk] = qfn[kk];
        }
        __syncthreads();
    }
}
struct Args { Ptrs p; };
__global__ void __launch_bounds__(NWAVES * 64, 2) hymba_fwd(Args args) {
    extern __shared__ __attribute__((aligned(16))) unsigned char lds[];
    const Ptrs& P = args.p;
    Frame F;
    F.lds = (LAS unsigned char*)lds;
    F.MISC = (volatile LAS unsigned*)(F.lds + MISC_OFF);
    F.wave = __builtin_amdgcn_readfirstlane(threadIdx.x >> 6);
    F.G = gridDim.x; { const int bx = blockIdx.x; F.vcu = (F.G % 8 == 0) ? (bx % 8) * (F.G / 8) + bx / 8 : bx; }
    F.ctl = (gu32*)(P.ws + WS_CTL);
    for (int u = threadIdx.x; u < (LDS_BYTES - LDSCTL_OFF) / 4; u += NWAVES * 64) ((LAS unsigned*)(F.lds + LDSCTL_OFF))[u] = 0u;
    __syncthreads();
    XcdBarrier bar = xcd_barrier_post((unsigned*)(F.ctl + CW_BAR), F.MISC + 8);
#define GRID_BAR() xcd_barrier(bar)

    bf16* XN = (bf16*)(P.ws + WS_XN); bf16* PROJ = (bf16*)(P.ws + WS_PROJ); bf16* HB = (bf16*)(P.ws + WS_ST);
    p0_prologue(F, P);
    GRID_BAR();
    { pg8::Gemm g{XN, (const bf16*)(P.ws + WS_WIN), T_, NPROJ, DM, F.wave}; pg8::StaticOrder S; S.init(T_, NPROJ, F.G, (int)blockIdx.x);
      pg8::EpiBf16<0> E{PROJ, NPROJ, nullptr, 0, 0, 1.f};
      pg8::gemm_phase<pg8::EpiBf16<0>, pg8::StaticOrder, PG8_ALIGN, PG8_SP2>(F.lds + RING_OFF, g, S, E); }
    if (F.G == 256 && blockIdx.x >= 64) p1_slack(F, P, ((int)blockIdx.x - 64) * NWAVES + F.wave, 192 * NWAVES);
    else if (F.G != 256) p1_slack(F, P, F.vcu * NWAVES + F.wave, F.G * NWAVES);
    GRID_BAR();
    ssd_s1(F, P);
    xcd_arrive(bar, F.MISC + 14);
    attn_phase(F, P);
    xcd_wait(bar, F.MISC + 14);
    ssd_s2(F, P);
    GRID_BAR();
    ssd_s3(F, P);
    GRID_BAR();
    { pg8::Gemm g{XN, (const bf16*)(P.ws + WS_WOUT), T_, DM, DM, F.wave}; pg8::StaticOrder S; S.init(T_, DM, F.G, (int)blockIdx.x);
      EpiResH E{P.x, HB, (float*)(P.ws + WS_SSQ)};
      pg8::gemm_phase<EpiResH, pg8::StaticOrder, PG8_ALIGN, PG8_SP2>(F.lds + RING_OFF, g, S, E); }
    GRID_BAR();
    { pg8::Gemm g{HB, (const bf16*)(P.ws + WS_WQ), T_, 2048, DM, F.wave}; pg8::StaticOrder S; S.init(T_, 2048, F.G, (int)blockIdx.x);
      EpiQTopk E{P.ws + WS_KEYB, (const float*)(P.ws + WS_SSQ), (int*)(P.ws + WS_IDX), (float*)(P.ws + WS_GATE)};
#pragma unroll 1
      for (int ui = 0; ui < 64; ++ui) { pg8::Unit u0; if (!S.next(ui, u0)) break;
          OneUnit S1{S, ui};
          pg8::gemm_phase<EpiQTopk, OneUnit, PG8_ALIGN, PG8_SP2>(F.lds + RING_OFF, g, S1, E); } }
    h_quant_rows(F, P);
    GRID_BAR();
    { const PeerPlace pp = peer_place(F);
      peer_down(F, P, pp); }
    GRID_BAR();
    peer_up_tm(F, P);
}

extern "C" void kernel_launch(void* const* d_in, const int* in_sizes, int n_in, void* d_out, int out_size, void* d_ws, size_t ws_size, hipStream_t stream) {
    static int grid = 0;
    if (grid == 0) {
        if (n_in != 19 || out_size != T_ * DM || ws_size < WS_END) { fprintf(stderr, "kernel_launch: unexpected shapes (n_in %d, out %d, ws %zu)\n", n_in, out_size, ws_size); grid = -1; return; }
        int dev = 0, cus = 0, per_cu = 0;
        if (hipGetDevice(&dev) != hipSuccess || hipDeviceGetAttribute(&cus, hipDeviceAttributeMultiprocessorCount, dev) != hipSuccess) { grid = -1; return; }
        if (hipFuncSetAttribute((const void*)hymba_fwd, hipFuncAttributeMaxDynamicSharedMemorySize, LDS_BYTES) != hipSuccess) { fprintf(stderr, "kernel_launch: hipFuncSetAttribute failed\n"); grid = -1; return; }
        if (hipOccupancyMaxActiveBlocksPerMultiprocessor(&per_cu, (const void*)hymba_fwd, NWAVES * 64, LDS_BYTES) != hipSuccess || per_cu < 1) { fprintf(stderr, "kernel_launch: occupancy query says %d blocks per CU\n", per_cu); grid = -1; (void)hipGetLastError(); return; }
        grid = cus;
    }
    if (grid < 0) return;
    (void)hipMemsetAsync((char*)d_ws + WS_CTL, 0, CTL_ZERO_BYTES, stream);
    Args a{};
    const float** pp = (const float**)&a.p;
    for (int i = 0; i < 19; ++i) pp[i] = (const float*)d_in[i];
    a.p.out = (float*)d_out; a.p.ws = (unsigned char*)d_ws;
    hipLaunchKernelGGL(hymba_fwd, dim3(grid), dim3(NWAVES * 64), LDS_BYTES, stream, a);
}
```

```cpp
#include <hip/hip_runtime.h>
#include <cstdio>
#include <cstdint>
#include <math.h>
namespace pg8 {
#define PG8_LAS __attribute__((address_space(3)))
typedef unsigned short bf16_t;
typedef short bf16x8 __attribute__((ext_vector_type(8)));
typedef float f32x4 __attribute__((ext_vector_type(4)));
typedef unsigned u32x4 __attribute__((ext_vector_type(4)));
constexpr int BM = 256, BK = 64, HALF = 128, HTB = HALF * BK * 2  , STAGE_BYTES = 8 * HTB, NXCD = 8, WGM = 8;

__host__ __device__ __forceinline__ int lds_byte(int r, int c) { const int st = (r >> 4) * 2 + (c >> 5), rr = r & 15, cc = c & 31, ob = rr * 64 + cc * 2; return st * 1024 + (ob ^ (((ob >> 9) & 1) << 5)); }
__host__ __device__ __forceinline__ void stage_rc(int b, int& R, int& C) { const int st = b / 1024, sb = b % 1024, swz = sb ^ (((sb >> 9) & 1) << 5); R = (st >> 1) * 16 + swz / 64; C = (st & 1) * 32 + (swz % 64) / 2; }
__host__ __device__ __forceinline__ int perm32(int rho) { const int n = rho >> 4, i = rho & 15; return 8 * (i >> 2) + 4 * n + (i & 3); }

struct Unit { int pm, pn; };
struct Gemm { const bf16_t* A; const bf16_t* Bt; int M, N, K, wave; };

struct StaticOrder {
    int nM, nN, nwg, G, c;
    __host__ __device__ void init(int M, int N, int G_, int c_) { nM = M / BM; nN = N / BM; nwg = nM * nN; G = G_; c = c_; }
    __host__ __device__ bool next(int i, Unit& u) const {
        const long L = (long)i * G + c; if (L >= nwg) return false;
        int wgid = (int)L; { const int q = nwg / NXCD, r = nwg % NXCD, xcd = wgid % NXCD, off = wgid / NXCD; wgid = (xcd < r ? xcd * (q + 1) : r * (q + 1) + (xcd - r) * q) + off; }
        const int nig = WGM * nN, gid = wgid / nig, fm = gid * WGM, gsz = (nM - fm) < WGM ? (nM - fm) : WGM;
        u.pm = fm + ((wgid % nig) % gsz); u.pn = (wgid % nig) / gsz; return true;
    }
    __device__ __forceinline__ void a_ready(const Unit&) const {}
    __device__ __forceinline__ void done(const Unit&) const {}
};

__device__ __forceinline__ unsigned cvt_pk_bf16(float lo, float hi) { unsigned r; asm volatile("v_cvt_pk_bf16_f32 %0, %1, %2" : "=v"(r) : "v"(lo), "v"(hi)); return r; }
typedef float f32x2 __attribute__((ext_vector_type(2)));
__device__ __forceinline__ f32x2 gelu_pk(f32x2 v) {
    const f32x2 av = __builtin_elementwise_abs(v), d = av * 0.2316418882f + 1.0f;
    f32x2 t; t.x = __builtin_amdgcn_rcpf(d.x); t.y = __builtin_amdgcn_rcpf(d.y);
    f32x2 q = t * 0.5307027145f + (-0.7265760135f); q = q * t + 0.7107068705f; q = q * t + (-0.142248368f); q = q * t + 0.127414796f; q = q * t;
    const f32x2 s = (v * v) * (-0.72134752044f);
    f32x2 e; e.x = __builtin_amdgcn_exp2f(s.x); e.y = __builtin_amdgcn_exp2f(s.y);
    const f32x2 m = v * (q * e), r = v - m;
    f32x2 o; o.x = v.x < 0.f ? m.x : r.x; o.y = v.y < 0.f ? m.y : r.y; return o;
}

template <int ACT  > struct EpiBf16 {
    static constexpr bool PERM = true, AFTER_DRAIN = false; static_assert(ACT == 0 || ACT == 1, "EpiBf16: ACT is 0 (none) or 1 (gelu_pk)");
    bf16_t* O; int ldc; const float* bias; int split_cols; size_t split_stride; float scale0;
    __device__ __forceinline__ void operator()(const f32x4 (&acc)[2][2][4][2], const Unit& u, int wr, int wc, int fr, int fq) const {
        const int row0 = u.pm * BM + wr * 64 + fr; int colt = u.pn * BM; bf16_t* base = O;
        float sc = 1.f; if (split_cols) { const int t = colt / split_cols; base += (size_t)t * split_stride; colt -= t * split_cols; if (t == 0) sc = scale0; }
        const int col0 = colt + wc * 32 + 8 * fq, bcol0 = u.pn * BM + wc * 32 + 8 * fq;
        f32x4 bv[2][2];
#pragma unroll
        for (int bj = 0; bj < 2; ++bj)
#pragma unroll
            for (int n = 0; n < 2; ++n) bv[bj][n] = bias ? *(const f32x4*)(bias + bcol0 + bj * HALF + 4 * n) : (f32x4){0.f, 0.f, 0.f, 0.f};
#pragma unroll
        for (int ai = 0; ai < 2; ++ai)
#pragma unroll
            for (int m = 0; m < 4; ++m) { bf16_t* rowp = base + (size_t)(row0 + ai * HALF + m * 16) * ldc + col0;
#pragma unroll
                for (int bj = 0; bj < 2; ++bj) { f32x4 v0 = acc[ai][bj][m][0] + bv[bj][0], v1 = acc[ai][bj][m][1] + bv[bj][1];
                    if (ACT == 1) { f32x2 a = gelu_pk((f32x2){v0[0], v0[1]}), b = gelu_pk((f32x2){v0[2], v0[3]}), c = gelu_pk((f32x2){v1[0], v1[1]}), d = gelu_pk((f32x2){v1[2], v1[3]});
                        v0 = (f32x4){a.x, a.y, b.x, b.y}; v1 = (f32x4){c.x, c.y, d.x, d.y}; }
                    v0 = v0 * sc; v1 = v1 * sc; u32x4 w; w.x = cvt_pk_bf16(v0[0], v0[1]); w.y = cvt_pk_bf16(v0[2], v0[3]); w.z = cvt_pk_bf16(v1[0], v1[1]); w.w = cvt_pk_bf16(v1[2], v1[3]);
                    *(u32x4*)(rowp + bj * HALF) = w; } }
    }
};
template <class Epi, class Sched, bool ALIGN_EPI = false, bool SP2 = false>
__device__ __forceinline__ void gemm_phase(PG8_LAS unsigned char* lds, const Gemm g, const Sched& S, const Epi& E) {
    int lane_l; asm volatile("v_mbcnt_lo_u32_b32 %0, -1, 0\n\tv_mbcnt_hi_u32_b32 %0, -1, %0" : "=v"(lane_l));
    const int wid = g.wave, lane = lane_l, tid = wid * 64 + lane,
              wr = wid >> 2, wc = wid & 3, fr = lane & 15, fq = lane >> 4;
    const int K = g.K, nt = K / BK;
    unsigned voffA[2], voffB[2];
#pragma unroll
    for (int i = 0; i < 2; ++i) { int R, C; stage_rc(tid * 16 + i * 8192, R, C); const int Rb = Epi::PERM ? ((R & ~31) + perm32(R & 31)) : R;
        voffA[i] = (unsigned)(R * K + C) * 2u; voffB[i] = (unsigned)(Rb * K + C) * 2u; }
    const size_t kstep = (size_t)(BK * 2);
    const size_t hstep = (size_t)HALF * K * 2;
    const size_t tstep = 2 * hstep;
    const unsigned ldsw = (unsigned)wid * 1024u;
    const int aoff = lds_byte(wr * 64 + fr, fq * 8), boff = lds_byte(wc * 32 + fr, fq * 8);
#define PG8_SA(b, h) (((b) * 2 + (h)) * HTB)
#define PG8_SB(b, h) ((4 + (b) * 2 + (h)) * HTB)
#define PG8_STAGE(bufoff, gbase, voff) do { _Pragma("unroll") for (int _i = 0; _i < 2; ++_i) \
        __builtin_amdgcn_global_load_lds((const unsigned*)((const char*)(gbase) + (voff)[_i]), (PG8_LAS unsigned*)(lds + (bufoff) + ldsw + _i * 8192), 16, 0, 0); } while (0)
#define PG8_LDA(dst, b, h) do { _Pragma("unroll") for (int m = 0; m < 4; ++m) _Pragma("unroll") for (int k = 0; k < 2; ++k) dst[m][k] = *(const PG8_LAS bf16x8*)(lds + PG8_SA(b, h) + aoff + m * 2048 + k * 1024); } while (0)
#define PG8_LDB(dst, b, h) do { _Pragma("unroll") for (int n = 0; n < 2; ++n) _Pragma("unroll") for (int k = 0; k < 2; ++k) dst[n][k] = *(const PG8_LAS bf16x8*)(lds + PG8_SB(b, h) + boff + n * 2048 + k * 1024); } while (0)
#define PG8_MMA(ai, bj, At, Bt) do { __builtin_amdgcn_s_setprio(1); _Pragma("unroll") for (int m = 0; m < 4; ++m) _Pragma("unroll") for (int n = 0; n < 2; ++n) _Pragma("unroll") for (int k = 0; k < 2; ++k) \
        acc[ai][bj][m][n] = __builtin_amdgcn_mfma_f32_16x16x32_bf16(Bt[n][k], At[m][k], acc[ai][bj][m][n], 0, 0, 0); __builtin_amdgcn_s_setprio(0); } while (0)
#define PG8_WAIT_V(n) asm volatile("s_waitcnt vmcnt(" #n ")" ::: "memory")
#define PG8_WAIT_L(n) asm volatile("s_waitcnt lgkmcnt(" #n ")" ::: "memory")
#define PG8_BAR __builtin_amdgcn_s_barrier()
#define PG8_SCHED __builtin_amdgcn_sched_barrier(0)
    Unit cur, nxt; int ui = 0;
    if (!S.next(0, cur)) return;
    f32x4 acc[2][2][4][2];
#pragma unroll
    for (int a = 0; a < 2; ++a)
#pragma unroll
        for (int b = 0; b < 2; ++b)
#pragma unroll
            for (int m = 0; m < 4; ++m)
#pragma unroll
                for (int n = 0; n < 2; ++n) acc[a][b][m][n] = (f32x4){0.f, 0.f, 0.f, 0.f};
    bf16x8 At[4][2], B0[2][2], B1[2][2];
    const char* cA = (const char*)g.A + (size_t)cur.pm * tstep; const char* cB = (const char*)g.Bt + (size_t)cur.pn * tstep;
    S.a_ready(cur);
    if constexpr (SP2) {
        PG8_STAGE(PG8_SB(0, 0), cB, voffB); PG8_STAGE(PG8_SB(0, 1), cB + hstep, voffB); PG8_STAGE(PG8_SA(0, 0), cA, voffA); PG8_STAGE(PG8_SA(0, 1), cA + hstep, voffA);
        if (wr == 1) PG8_BAR;
        PG8_WAIT_V(2); PG8_BAR;
        PG8_STAGE(PG8_SB(1, 0), cB + kstep, voffB); PG8_STAGE(PG8_SA(1, 0), cA + kstep, voffA); PG8_STAGE(PG8_SB(1, 1), cB + hstep + kstep, voffB);
        PG8_WAIT_V(6); PG8_BAR;
    } else {
        PG8_STAGE(PG8_SB(0, 0), cB, voffB); PG8_STAGE(PG8_SA(0, 0), cA, voffA); PG8_STAGE(PG8_SB(0, 1), cB + hstep, voffB); PG8_STAGE(PG8_SA(0, 1), cA + hstep, voffA);
        if (wr == 1) PG8_BAR;
        PG8_WAIT_V(4); PG8_BAR;
        PG8_STAGE(PG8_SB(1, 0), cB + kstep, voffB); PG8_STAGE(PG8_SA(1, 0), cA + kstep, voffA); PG8_STAGE(PG8_SB(1, 1), cB + hstep + kstep, voffB);
        PG8_WAIT_V(6); PG8_BAR;
    }
    for (;;) {
        const bool has_next = S.next(ui + 1, nxt);
        const char* nA = has_next ? (const char*)g.A + (size_t)nxt.pm * tstep : cA; const char* nB = has_next ? (const char*)g.Bt + (size_t)nxt.pn * tstep : cB;
        for (int t = 0; t < nt; t += 2) {
            const bool last = (t == nt - 2);
            const char* a1 = cA + (size_t)(t + 1) * kstep;
            const char* a2 = last ? nA : cA + (size_t)(t + 2) * kstep; const char* b2 = last ? nB : cB + (size_t)(t + 2) * kstep;
            const char* a3 = a2 + kstep; const char* b3 = b2 + kstep;
            if (last && has_next) S.a_ready(nxt);
            if constexpr (SP2) {
            PG8_LDB(B0, 0, 0); PG8_LDB(B1, 0, 1); PG8_SCHED; PG8_LDA(At, 0, 0); PG8_STAGE(PG8_SA(1, 1), a1 + hstep, voffA);
            PG8_WAIT_V(8); PG8_WAIT_L(0); PG8_BAR; PG8_MMA(0, 0, At, B0); PG8_MMA(0, 1, At, B1); PG8_BAR; PG8_SCHED;
            PG8_LDA(At, 0, 1); PG8_STAGE(PG8_SB(0, 0), b2, voffB); PG8_STAGE(PG8_SB(0, 1), b2 + hstep, voffB); PG8_STAGE(PG8_SA(0, 0), a2, voffA);
            PG8_WAIT_V(8); PG8_WAIT_L(0); PG8_BAR; PG8_MMA(1, 0, At, B0); PG8_MMA(1, 1, At, B1); PG8_BAR; PG8_SCHED;
            PG8_LDB(B0, 1, 0); PG8_LDB(B1, 1, 1); PG8_SCHED; PG8_LDA(At, 1, 0); PG8_STAGE(PG8_SA(0, 1), a2 + hstep, voffA);
            PG8_WAIT_V(8); PG8_WAIT_L(0); PG8_BAR; PG8_MMA(0, 0, At, B0); PG8_MMA(0, 1, At, B1); PG8_BAR; PG8_SCHED;
            PG8_LDA(At, 1, 1); PG8_STAGE(PG8_SB(1, 0), b3, voffB); PG8_STAGE(PG8_SB(1, 1), b3 + hstep, voffB); PG8_STAGE(PG8_SA(1, 0), a3, voffA);
            PG8_WAIT_V(8); PG8_WAIT_L(0); PG8_BAR; PG8_MMA(1, 0, At, B0); PG8_MMA(1, 1, At, B1); PG8_BAR; PG8_SCHED;
            } else {
            PG8_LDB(B0, 0, 0); PG8_SCHED; PG8_LDA(At, 0, 0); PG8_STAGE(PG8_SA(1, 1), a1 + hstep, voffA);
            PG8_WAIT_L(8); PG8_BAR; PG8_WAIT_L(0); PG8_MMA(0, 0, At, B0); PG8_BAR; PG8_SCHED;
            PG8_LDB(B1, 0, 1); PG8_STAGE(PG8_SB(0, 0), b2, voffB);
            PG8_BAR; PG8_WAIT_L(0); PG8_MMA(0, 1, At, B1); PG8_BAR;
            PG8_LDA(At, 0, 1); PG8_STAGE(PG8_SA(0, 0), a2, voffA);
            PG8_BAR; PG8_WAIT_L(0); PG8_MMA(1, 0, At, B0); PG8_BAR; PG8_SCHED;
            PG8_STAGE(PG8_SB(0, 1), b2 + hstep, voffB);
            PG8_WAIT_V(6); PG8_BAR; PG8_MMA(1, 1, At, B1); PG8_BAR;
            PG8_LDB(B0, 1, 0); PG8_SCHED; PG8_LDA(At, 1, 0); PG8_STAGE(PG8_SA(0, 1), a2 + hstep, voffA);
            PG8_WAIT_L(8); PG8_BAR; PG8_WAIT_L(0); PG8_MMA(0, 0, At, B0); PG8_BAR; PG8_SCHED;
            PG8_LDB(B1, 1, 1); PG8_STAGE(PG8_SB(1, 0), b3, voffB);
            PG8_BAR; PG8_WAIT_L(0); PG8_MMA(0, 1, At, B1); PG8_BAR;
            PG8_LDA(At, 1, 1); PG8_STAGE(PG8_SA(1, 0), a3, voffA);
            PG8_BAR; PG8_WAIT_L(0); PG8_MMA(1, 0, At, B0); PG8_BAR; PG8_SCHED;
            PG8_STAGE(PG8_SB(1, 1), b3 + hstep, voffB);
            PG8_WAIT_V(6); PG8_BAR; PG8_MMA(1, 1, At, B1); PG8_BAR;
            }
        }
        if constexpr (ALIGN_EPI) { if (wr == 0) PG8_BAR; }
        if constexpr (!Epi::AFTER_DRAIN) { E(acc, cur, wr, wc, fr, fq); S.done(cur); }
        if (!has_next) break;
#pragma unroll
        for (int a = 0; a < 2; ++a)
#pragma unroll
            for (int b = 0; b < 2; ++b)
#pragma unroll
                for (int m = 0; m < 4; ++m)
#pragma unroll
                    for (int n = 0; n < 2; ++n) acc[a][b][m][n] = (f32x4){0.f, 0.f, 0.f, 0.f};
        cur = nxt; cA = nA; cB = nB; ++ui;
        if constexpr (ALIGN_EPI) { if (wr == 1) PG8_BAR; }
    }
    PG8_WAIT_V(0);
    if constexpr (!ALIGN_EPI) { if (wr == 0) PG8_BAR; }
    PG8_BAR;
    if constexpr (Epi::AFTER_DRAIN) { E.fused(acc, cur, wr, wc, fr, fq, lds, wid, lane); S.done(cur); }
#undef PG8_SA
#undef PG8_SB
#undef PG8_STAGE
#undef PG8_LDA
#undef PG8_LDB
#undef PG8_MMA
#undef PG8_WAIT_V
#undef PG8_WAIT_L
#undef PG8_BAR
#undef PG8_SCHED
}
}

#ifndef PG8_SP2
#define PG8_SP2 true
#endif
#ifndef PG8_ALIGN
#define PG8_ALIGN true
#endif
#define GAS __attribute__((address_space(1)))
#define LAS __attribute__((address_space(3)))
typedef unsigned short bf16;
typedef unsigned v4u __attribute__((ext_vector_type(4)));
typedef float f32x4 __attribute__((ext_vector_type(4)));
typedef short bf16x8 __attribute__((ext_vector_type(8)));
typedef GAS unsigned gu32;
typedef GAS unsigned long long gu64;
#define RLX_AGENT __ATOMIC_RELAXED, __HIP_MEMORY_SCOPE_AGENT
#define LDS_WAIT() asm volatile("s_waitcnt lgkmcnt(0)" ::: "memory")
#define VM_WAIT() asm volatile("s_waitcnt vmcnt(0)" ::: "memory")
__device__ __forceinline__ unsigned long long rt() { return __builtin_amdgcn_s_memrealtime(); }
__device__ __forceinline__ unsigned f2bf(float f) { unsigned u = __builtin_bit_cast(unsigned, f); return (u + 0x7fffu + ((u >> 16) & 1u)) >> 16; }
__device__ __forceinline__ unsigned pk2(float lo, float hi) { return f2bf(lo) | (f2bf(hi) << 16); }

#define XB_TMO      128
#define XB_XCNT(j)  (256  + 64 * (j))
#define XB_XSUB(j)  (1280 + 64 * (j))
#define XB_XGEN(j)  (2304 + 64 * (j))
#define XB_TOP      3328
#define XB_TOPGEN   3392
#define XCD_BAR_WORDS 3456
#define XB_SPIN_CAP (1u << 22)

__device__ __forceinline__ unsigned xb_ld(unsigned* p)              { return __hip_atomic_load(p, __ATOMIC_RELAXED, __HIP_MEMORY_SCOPE_AGENT); }
__device__ __forceinline__ unsigned xb_add(unsigned* p, unsigned v) { return __hip_atomic_fetch_add(p, v, __ATOMIC_RELAXED, __HIP_MEMORY_SCOPE_AGENT); }
__device__ __forceinline__ unsigned xb_xcc_id() { return (unsigned)__builtin_amdgcn_s_getreg((3 << 11) | 20) & 0xFu; }
#define XB_SPIN(cond, bar) do { unsigned _sp = 0; while (cond) { __builtin_amdgcn_s_sleep(1); \
    if ((++_sp & 255u) == 0u) { if (xb_ld(&(bar)[XB_TMO])) break; if (_sp > XB_SPIN_CAP) { atomicAdd(&(bar)[XB_TMO], 1u); break; } } } } while (0)

struct XcdBarrier {
    unsigned* bar; unsigned x;
    volatile LAS unsigned* st;
};

__device__ __forceinline__ XcdBarrier xcd_barrier_post(unsigned* bar, volatile LAS unsigned* st) {
    XcdBarrier b; b.bar = bar; b.x = xb_xcc_id(); b.st = st;
    if (threadIdx.x == 0) (void)xb_add(&bar[XB_XCNT(b.x)], 1u);
    return b;
}
__device__ __forceinline__ void xcd_barrier_complete(unsigned* bar, unsigned x, unsigned& nloc, unsigned& nx) {
    const unsigned G = gridDim.x * gridDim.y * gridDim.z;
    unsigned sum, cnt, mine, sp = 0u;
    for (;;) {
        sum = 0u; cnt = 0u; mine = 0u;
#pragma unroll
        for (unsigned j = 0; j < 16; ++j) { const unsigned c = xb_ld(&bar[XB_XCNT(j)]); sum += c; cnt += (c > 0u) ? 1u : 0u; mine = (j == x) ? c : mine; }
        if (sum == G) break;
        __builtin_amdgcn_s_sleep(1);
        if ((++sp & 255u) == 0u) { if (xb_ld(&bar[XB_TMO])) break; if (sp > XB_SPIN_CAP) { atomicAdd(&bar[XB_TMO], 1u); break; } }
    }
    nloc = mine > 0u ? mine : 1u; nx = cnt > 0u ? cnt : 1u;
}

__device__ __forceinline__ void xcd_barrier(const XcdBarrier& b) {
    asm volatile("s_waitcnt vmcnt(0)" ::: "memory");
    __syncthreads();
    if (threadIdx.x == 0) {
        unsigned* bar = b.bar;
        __builtin_amdgcn_s_waitcnt(0);
        unsigned nloc = b.st[0], nx = b.st[1];
        if (nloc == 0u) { xcd_barrier_complete(bar, b.x, nloc, nx); b.st[0] = nloc; b.st[1] = nx; }
        const unsigned old = xb_add(&bar[XB_XSUB(b.x)], 1u);
        const unsigned gen = old / nloc;
        if (old + 1u == (gen + 1u) * nloc) {
            __builtin_amdgcn_fence(__ATOMIC_RELEASE, "agent");
            asm volatile("s_waitcnt vmcnt(0)" ::: "memory");
            const unsigned og = xb_add(&bar[XB_TOP], 1u);
            const unsigned tg = og / nx;
            if (og + 1u == (tg + 1u) * nx) xb_add(&bar[XB_TOPGEN], 1u);
            else XB_SPIN(xb_ld(&bar[XB_TOPGEN]) == tg, bar);
            __builtin_amdgcn_fence(__ATOMIC_ACQUIRE, "agent");
            asm volatile("s_waitcnt vmcnt(0)" ::: "memory");
        } else {
            XB_SPIN(xb_ld(&bar[XB_TOPGEN]) == gen, bar);
            __builtin_amdgcn_fence(__ATOMIC_ACQUIRE, "agent");
            asm volatile("s_waitcnt vmcnt(0)" ::: "memory");
        }
    }
    __syncthreads();
}

__device__ __forceinline__ void xcd_arrive(const XcdBarrier& b, volatile LAS unsigned* sx) {
    asm volatile("s_waitcnt vmcnt(0)" ::: "memory");
    __syncthreads();
    if (threadIdx.x == 0) {
        unsigned* bar = b.bar;
        __builtin_amdgcn_s_waitcnt(0);
        unsigned nloc = b.st[0], nx = b.st[1];
        if (nloc == 0u) { xcd_barrier_complete(bar, b.x, nloc, nx); b.st[0] = nloc; b.st[1] = nx; }
        const unsigned old = xb_add(&bar[XB_XSUB(b.x)], 1u);
        const unsigned gen = old / nloc;
        unsigned leader = 0u, key = gen;
        if (old + 1u == (gen + 1u) * nloc) {
            leader = 1u;
            __builtin_amdgcn_fence(__ATOMIC_RELEASE, "agent");
            asm volatile("s_waitcnt vmcnt(0)" ::: "memory");
            const unsigned og = xb_add(&bar[XB_TOP], 1u);
            const unsigned tg = og / nx; key = tg;
            if (og + 1u == (tg + 1u) * nx) xb_add(&bar[XB_TOPGEN], 1u);
        }
        sx[0] = leader; sx[1] = key;
    }
}
__device__ __forceinline__ void xcd_wait(const XcdBarrier& b, volatile LAS unsigned* sx) {
    if (threadIdx.x == 0) {
        unsigned* bar = b.bar;
        const unsigned leader = sx[0], key = sx[1];
        if (leader) {
            XB_SPIN(xb_ld(&bar[XB_TOPGEN]) == key, bar);
            __builtin_amdgcn_fence(__ATOMIC_ACQUIRE, "agent");
            asm volatile("s_waitcnt vmcnt(0)" ::: "memory");
        } else {
            XB_SPIN(xb_ld(&bar[XB_TOPGEN]) == key, bar);
            __builtin_amdgcn_fence(__ATOMIC_ACQUIRE, "agent");
            asm volatile("s_waitcnt vmcnt(0)" ::: "memory");
        }
    }
    __syncthreads();
}

constexpr int NWAVES = 8;
constexpr int T_ = 16384, SEQ = 4096, DM = 1024, NPROJ = 2304, INC = 2312;
constexpr int PJ_K = 512, PJ_V = 640, PJ_Z = 768, PJ_XBC = 1280;
constexpr float EPS = 1e-6f;
constexpr size_t MiB = 1u << 20;
constexpr size_t WS_CTL = 0, CTL_ZERO_BYTES = 1 * MiB;
constexpr size_t WS_KEYB = 1 * MiB + 256 * 1024;
constexpr size_t WS_BTAB = 1 * MiB + 384 * 1024;
constexpr size_t WS_SMALL = 1 * MiB;
constexpr size_t WS_WIN = 2 * MiB, WS_WOUT = 7 * MiB, WS_WQ = 9 * MiB;
constexpr size_t WS_ED = 13 * MiB, WS_EU = 29 * MiB;
constexpr size_t WS_XN = 77 * MiB;
constexpr size_t WS_PROJ = 109 * MiB;
constexpr size_t WS_ST = 181 * MiB;
constexpr size_t WS_IDX = 213 * MiB, WS_GATE = 221 * MiB, WS_SSQ = 229 * MiB, WS_END = 230 * MiB;
constexpr size_t DO_Y = 0, DO_DT = 41 * MiB;
constexpr size_t WS_CC = 230 * MiB, WS_DT = 238 * MiB, WS_EA = 239 * MiB, WS_CDEC = 240 * MiB, WS_PREV = WS_IDX;
constexpr size_t DO_YPF = 0, DO_YPLAIN = 32 * MiB;
constexpr size_t WS_PART = WS_PROJ;
constexpr size_t WS_H8 = WS_XN, WS_HS = WS_DT;
constexpr size_t WS_SSQ2 = WS_EA;
constexpr int CW_BAR = 4096, CW_RANK = 8192;
constexpr int RING_OFF = 0, RING_BYTES = 147456, LDSCTL_OFF = RING_BYTES, MISC_OFF = LDSCTL_OFF + 320, LDS_BYTES = 163840;

__constant__ unsigned char c_bucket[128] = {0, 1, 2, 3, 4, 5, 6, 7, 8, 9, 10, 11, 12, 13, 14, 15, 16, 16, 16, 17, 17, 18, 18, 18, 19, 19, 19, 20, 20, 20, 20, 21, 21, 21, 21, 22, 22, 22, 22, 22, 23, 23, 23, 23, 23, 23, 24, 24, 24, 24, 24, 24, 25, 25, 25, 25, 25, 25, 25, 26, 26, 26, 26, 26, 26, 26, 26, 27, 27, 27, 27, 27, 27, 27, 27, 27, 27, 28, 28, 28, 28, 28, 28, 28, 28, 28, 28, 29, 29, 29, 29, 29, 29, 29, 29, 29, 29, 29, 29, 30, 30, 30, 30, 30, 30, 30, 30, 30, 30, 30, 30, 30, 30, 31, 31, 31, 31, 31, 31, 31, 31, 31, 31, 31, 31, 31, 31, 31};

typedef float v16f __attribute__((ext_vector_type(16)));
typedef float v32f __attribute__((ext_vector_type(32)));
typedef unsigned v6u __attribute__((ext_vector_type(6)));
typedef _Float16 v32h __attribute__((ext_vector_type(32)));
struct Frame {
    LAS unsigned char* lds;
    volatile LAS unsigned* MISC;
    gu32* ctl;
    int wave, vcu, G;
};
__device__ __forceinline__ int lane_id() { int l; asm volatile("v_mbcnt_lo_u32_b32 %0, -1, 0\n\tv_mbcnt_hi_u32_b32 %0, -1, %0" : "=v"(l)); return l; }
__device__ __forceinline__ int opq(int x) { asm volatile("" : "+v"(x)); return x; }
template <int M> __device__ __forceinline__ float swz_xor(float v) { return __int_as_float(__builtin_amdgcn_ds_swizzle(__float_as_int(v), (M << 10) | 0x1F)); }
__device__ __forceinline__ float sum_halves(float v) { const auto r = __builtin_amdgcn_permlane32_swap(__float_as_uint(v), __float_as_uint(v), false, false); return __uint_as_float(r[0]) + __uint_as_float(r[1]); }
__device__ __forceinline__ float max_halves(float v) { const auto r = __builtin_amdgcn_permlane32_swap(__float_as_uint(v), __float_as_uint(v), false, false); return fmaxf(__uint_as_float(r[0]), __uint_as_float(r[1])); }
__device__ __forceinline__ int imax_halves(int v) { const auto r = __builtin_amdgcn_permlane32_swap((unsigned)v, (unsigned)v, false, false); return max((int)r[0], (int)r[1]); }
__device__ __forceinline__ float wave_sum(float v) {
    v += swz_xor<1>(v); v += swz_xor<2>(v); v += swz_xor<4>(v); v += swz_xor<8>(v); v += swz_xor<16>(v);
    return sum_halves(v);
}
__device__ __forceinline__ float bf2f(unsigned short b) { return __uint_as_float((unsigned)b << 16); }
__device__ __forceinline__ float bflo(unsigned w) { return __uint_as_float(w << 16); }
__device__ __forceinline__ float bfhi(unsigned w) { return __uint_as_float(w & 0xffff0000u); }
__device__ __forceinline__ float silu_f(float x) { return x / (1.f + __expf(-x)); }

__device__ __forceinline__ void p0_transpose_item(const float* W, int ldw, int K, int nblk, bf16* WT, const float* kscale, LAS float* scr, int item, int lane) {
    const int kb = item / nblk, nb = item % nblk, k0 = 64 * kb, n0 = 32 * nb;
    float ks_[32];
#pragma unroll
    for (int i = 0; i < 32; ++i) ks_[i] = kscale ? kscale[k0 + 2 * i + (lane >> 5)] : 1.f;
    float vv_[32];
#pragma unroll
    for (int i = 0; i < 32; ++i) vv_[i] = W[(size_t)(k0 + 2 * i + (lane >> 5)) * ldw + n0 + (lane & 31)];
#pragma unroll
    for (int i = 0; i < 32; ++i) scr[(2 * i + (lane >> 5)) * 33 + (lane & 31)] = vv_[i] * ks_[i];
#pragma unroll 1
    for (int i = 32; i < 32; ++i) { const int kk = 2 * i + (lane >> 5); float v = W[(size_t)(k0 + kk) * ldw + n0 + (lane & 31)]; if (kscale) v *= kscale[k0 + kk]; scr[kk * 33 + (lane & 31)] = v; }
    LDS_WAIT(); asm volatile("" ::: "memory");
    const int c = lane & 7;
#pragma unroll
    for (int j = 0; j < 4; ++j) { const int n = (lane >> 3) + 8 * j; const LAS float* s = scr + (8 * c) * 33 + n;
        v4u o; o.x = pk2(s[0 * 33], s[1 * 33]); o.y = pk2(s[2 * 33], s[3 * 33]); o.z = pk2(s[4 * 33], s[5 * 33]); o.w = pk2(s[6 * 33], s[7 * 33]);
        *(GAS v4u*)(WT + (size_t)(n0 + n) * K + k0 + 8 * c) = o; }
    LDS_WAIT(); asm volatile("" ::: "memory");
}
struct Ptrs {
    const float *x, *norm_mix, *w_in, *conv_w, *conv_b, *dt_bias, *a_log, *d_skip, *ssd_norm_w, *sinks, *w_out, *rel_bias, *norm_ffn, *w_query, *sk1, *sk2, *e_down, *e_up, *norm_final;
    float* out; unsigned char* ws;
};
constexpr int Q_SPLIT = 0;
__device__ __forceinline__ unsigned pack4_i8(float a, float b, float c, float d) {
    const int ia = __float2int_rn(a), ib = __float2int_rn(b), ic = __float2int_rn(c), id = __float2int_rn(d);
    return (unsigned)(ia & 0xff) | ((unsigned)(ib & 0xff) << 8) | ((unsigned)(ic & 0xff) << 16) | ((unsigned)(id & 0xff) << 24);
}
__device__ __forceinline__ unsigned pack8_i4(const float* v, float inv) {
    unsigned o = 0u;
#pragma unroll
    for (int i = 0; i < 8; ++i) { int q = __float2int_rn(v[i] * inv); q = q < -7 ? -7 : (q > 7 ? 7 : q); o |= ((unsigned)q & 15u) << (4 * i); }
    return o;
}
__device__ __forceinline__ void quant_fp8s(const Ptrs& P, int lane_, int r_lo, int r_hi, int w, int nw) {
    float* SC = (float*)(P.ws + WS_SMALL);
    int row = r_lo + w;
    if (row >= r_hi) return;
    float4 nx[4];
#pragma unroll
    for (int q = 0; q < 4; ++q) nx[q] = ((const float4*)(P.e_down + (size_t)(row & 16383) * DM) + 4 * lane_)[q];
    float4 w4[4];
#pragma unroll
    for (int q = 0; q < 4; ++q) w4[q] = ((const float4*)P.norm_ffn)[4 * lane_ + q];
    for (; row < r_hi; row += nw) {
        const int e = row & 16383;
        float v[16];
#pragma unroll
        for (int q = 0; q < 4; ++q) { const float4 t = nx[q]; v[4 * q] = t.x * w4[q].x; v[4 * q + 1] = t.y * w4[q].y; v[4 * q + 2] = t.z * w4[q].z; v[4 * q + 3] = t.w * w4[q].w; }
        { const int rn = (row + nw < r_hi) ? row + nw : row;
#pragma unroll
          for (int q = 0; q < 4; ++q) nx[q] = ((const float4*)(P.e_down + (size_t)(rn & 16383) * DM) + 4 * lane_)[q]; }
        float ss = 0.f;
#pragma unroll
        for (int q = 0; q < 16; ++q) ss = fmaf(v[q], v[q], ss);
        const float sc = fmaxf(2.5f * sqrtf(wave_sum(ss) * (1.f / 1024.f)) * (1.f / 7.f), 1e-30f);
        const float inv = 1.f / sc;
        const unsigned long long o = (unsigned long long)pack8_i4(v, inv) | ((unsigned long long)pack8_i4(v + 8, inv) << 32);
        *(unsigned long long*)(P.ws + WS_ED + ((size_t)(lane_ >> 4) * 16384 + e) * 128 + (lane_ & 15) * 8) = o;
        if (lane_ == 0) SC[row] = sc;
    }
}
typedef float f32x2q __attribute__((ext_vector_type(2)));
__device__ __forceinline__ void quant_fp6u(const Ptrs& P, int lane_, int q_lo, int q_hi, int w, int nw) {
    float* SC = (float*)(P.ws + WS_SMALL);
    int e = 2 * q_lo + w; const int e_hi = 2 * q_hi;
    if (e >= e_hi) return;
    float4 nx[4];
#pragma unroll
    for (int k = 0; k < 4; ++k) nx[k] = ((const float4*)(P.e_up + (size_t)e * DM) + 4 * lane_)[k];
    for (; e < e_hi; e += nw) {
        float v[16];
#pragma unroll
        for (int k = 0; k < 4; ++k) { const float4 t = nx[k]; v[4 * k] = t.x; v[4 * k + 1] = t.y; v[4 * k + 2] = t.z; v[4 * k + 3] = t.w; }
        { const int en = (e + nw < e_hi) ? e + nw : e;
#pragma unroll
          for (int k = 0; k < 4; ++k) nx[k] = ((const float4*)(P.e_up + (size_t)en * DM) + 4 * lane_)[k]; }
        float am = 0.f;
#pragma unroll
        for (int k = 0; k < 16; ++k) am = fmaxf(am, fabsf(v[k]));
        am = fmaxf(am, swz_xor<1>(am)); am = fmaxf(am, swz_xor<2>(am)); am = fmaxf(am, swz_xor<4>(am)); am = fmaxf(am, swz_xor<8>(am)); am = fmaxf(am, swz_xor<16>(am)); am = max_halves(am);
        am = fmaxf(am, 1e-30f);
        const float inv = 6.0f / am;
        unsigned pk[2];
#pragma unroll
        for (int wd = 0; wd < 2; ++wd) { unsigned p4 = 0u;
            p4 = __builtin_amdgcn_cvt_scalef32_pk_fp4_f32(p4, v[8 * wd] * inv, v[8 * wd + 1] * inv, 1.0f, 0);
            p4 = __builtin_amdgcn_cvt_scalef32_pk_fp4_f32(p4, v[8 * wd + 2] * inv, v[8 * wd + 3] * inv, 1.0f, 1);
            p4 = __builtin_amdgcn_cvt_scalef32_pk_fp4_f32(p4, v[8 * wd + 4] * inv, v[8 * wd + 5] * inv, 1.0f, 2);
            p4 = __builtin_amdgcn_cvt_scalef32_pk_fp4_f32(p4, v[8 * wd + 6] * inv, v[8 * wd + 7] * inv, 1.0f, 3);
            pk[wd] = p4; }
        *(unsigned long long*)(P.ws + WS_EU + (size_t)e * 512 + 8 * lane_) = (unsigned long long)pk[0] | ((unsigned long long)pk[1] << 32);
        if (lane_ == 0) SC[16384 + e] = am * (1.f / 6.0f);
    }
}
__device__ __forceinline__ void p0_prologue(Frame& F0, const Ptrs& P) {
    const Frame& F = F0; const int lane_ = lane_id(), tid_ = F.wave * 64 + lane_;
    LAS float* scr = (LAS float*)(F.lds + RING_OFF + F.wave * 16384);
    const int gw = F.vcu * NWAVES + F.wave, NGW = F.G * NWAVES;
    bf16* Win_t = (bf16*)(P.ws + WS_WIN); bf16* Wout_t = (bf16*)(P.ws + WS_WOUT); bf16* Wq_t = (bf16*)(P.ws + WS_WQ);
    constexpr int I_IN = 16 * 72;
    for (int it = gw; it < I_IN; it += NGW) p0_transpose_item(P.w_in, INC, DM, 72, Win_t, nullptr, scr, it, lane_);
    (void)Wout_t; (void)Wq_t;
    __syncthreads();
    { LAS float* Wdt = (LAS float*)(F.lds + RING_OFF);
      { float wd_[16];
#pragma unroll
        for (int q = 0; q < 16; ++q) { const int i = tid_ + 512 * q; wd_[q] = P.w_in[(size_t)(i >> 3) * INC + NPROJ + (i & 7)]; }
#pragma unroll
        for (int q = 0; q < 16; ++q) Wdt[tid_ + 512 * q] = wd_[q]; }
      __syncthreads();
      bf16* XN = (bf16*)(P.ws + WS_XN); float* DT = (float*)(P.ws + WS_DT);
      float4 nmw[4];
#pragma unroll
      for (int j = 0; j < 4; ++j) nmw[j] = ((const float4*)P.norm_mix)[j * 64 + lane_];
      float4 xnx[2][4];
      if (gw * 2 < T_) {
#pragma unroll
        for (int rr = 0; rr < 2; ++rr)
#pragma unroll
            for (int j = 0; j < 4; ++j) xnx[rr][j] = ((const float4*)(P.x + (size_t)(gw * 2 + rr) * DM))[j * 64 + lane_]; }
      for (int m0 = gw * 2; m0 < T_; m0 += NGW * 2) {
        float4 xv[2][4];
#pragma unroll
        for (int rr = 0; rr < 2; ++rr)
#pragma unroll
            for (int j = 0; j < 4; ++j) xv[rr][j] = xnx[rr][j];
        { const int mn = (m0 + NGW * 2 < T_) ? m0 + NGW * 2 : m0;
#pragma unroll
          for (int rr = 0; rr < 2; ++rr)
#pragma unroll
              for (int j = 0; j < 4; ++j) xnx[rr][j] = ((const float4*)(P.x + (size_t)(mn + rr) * DM))[j * 64 + lane_]; }
#pragma unroll
        for (int rr = 0; rr < 2; ++rr) { const int m = m0 + rr;
        float4 v[4]; float s = 0.f;
#pragma unroll
        for (int j = 0; j < 4; ++j) { v[j] = xv[rr][j]; s += v[j].x * v[j].x + v[j].y * v[j].y + v[j].z * v[j].z + v[j].w * v[j].w; }
        const float r = rsqrtf(wave_sum(s) * (1.f / 1024.f) + EPS);
        float d8[8];
#pragma unroll
        for (int q = 0; q < 8; ++q) d8[q] = 0.f;
        unsigned long long* o8 = (unsigned long long*)(XN + (size_t)m * DM);
#pragma unroll
        for (int j = 0; j < 4; ++j) { const float4 w = nmw[j];
            const float e0 = v[j].x * r * w.x, e1 = v[j].y * r * w.y, e2 = v[j].z * r * w.z, e3 = v[j].w * r * w.w;
            o8[j * 64 + lane_] = (unsigned long long)pk2(e0, e1) | ((unsigned long long)pk2(e2, e3) << 32);
            const float ev[4] = {e0, e1, e2, e3};
#pragma unroll
            for (int e = 0; e < 4; ++e) { const LAS f32x4* wr = (const LAS f32x4*)(Wdt + (size_t)(j * 256 + lane_ * 4 + e) * 8); const f32x4 w0 = wr[0], w1 = wr[1];
                d8[0] += ev[e] * w0.x; d8[1] += ev[e] * w0.y; d8[2] += ev[e] * w0.z; d8[3] += ev[e] * w0.w; d8[4] += ev[e] * w1.x; d8[5] += ev[e] * w1.y; d8[6] += ev[e] * w1.z; d8[7] += ev[e] * w1.w; } }
#pragma unroll
        for (int q = 0; q < 8; ++q) d8[q] = wave_sum(d8[q]);
        if (lane_ == 0) { float4* dp = (float4*)(DT + (size_t)m * 8); dp[0] = make_float4(d8[0], d8[1], d8[2], d8[3]); dp[1] = make_float4(d8[4], d8[5], d8[6], d8[7]); }
        }
      }
      __syncthreads(); }
}

__device__ __forceinline__ void p1_slack(Frame& F0, const Ptrs& P, int w, int nw) {
    const Frame& F = F0; const int lane_ = lane_id();
    LAS float* scr = (LAS float*)(F.lds + RING_OFF + F.wave * 16384);
    bf16* Wout_t = (bf16*)(P.ws + WS_WOUT); bf16* Wq_t = (bf16*)(P.ws + WS_WQ);
    constexpr int I_OUT = 16 * 32, I_Q = 16 * 64;
    for (int it = w; it < I_OUT + I_Q; it += nw) {
        if (it < I_OUT) p0_transpose_item(P.w_out, DM, DM, 32, Wout_t, nullptr, scr, it, lane_);
        else p0_transpose_item(P.w_query, 2048, DM, 64, Wq_t, P.norm_ffn, scr, it - I_OUT, lane_);
    }
    { unsigned long long* KB = (unsigned long long*)(P.ws + WS_KEYB);
      for (int i = w * 64 + lane_; i < 8192; i += nw * 64) { const float4 t = (i < 4096) ? ((const float4*)P.sk1)[i] : ((const float4*)P.sk2)[i - 4096];
          KB[i] = (unsigned long long)pk2(t.x, t.y) | ((unsigned long long)pk2(t.z, t.w) << 32); } }
    { float* BT = (float*)(P.ws + WS_BTAB);
      for (int i = w * 64 + lane_; i < 1536; i += nw * 64) { const int hkv = i / 768, rr = i % 768, gg = rr / 192, dist = rr % 192 - 32;
          BT[i] = (dist >= 0 && dist < 128) ? P.rel_bias[c_bucket[dist & 127] * 8 + hkv * 4 + gg] * 1.4426950408889634f : 0.f; } }
    quant_fp6u(P, lane_, 0, 8192, w, nw);
    quant_fp8s(P, lane_, 0, 16384, w, nw);
}
struct EpiResH {
    static constexpr bool PERM = false, AFTER_DRAIN = false;
    const float* X; bf16* HB; float* SSQ;
    __device__ __forceinline__ void ldx(pg8::f32x4 (&d)[4], int row, int col0) const {
#pragma unroll
        for (int bj = 0; bj < 2; ++bj)
#pragma unroll
            for (int n = 0; n < 2; ++n) d[bj * 2 + n] = *(const pg8::f32x4*)(X + (size_t)row * DM + col0 + bj * 128 + n * 16);
    }
    __device__ __forceinline__ void operator()(const pg8::f32x4 (&acc)[2][2][4][2], const pg8::Unit& u, int wr, int wc, int fr, int fq) const {
        const int row0 = u.pm * 256 + wr * 64 + fr, col0 = u.pn * 256 + wc * 32 + 4 * fq;
        pg8::f32x4 xq[2][4];
        ldx(xq[0], row0, col0);
#pragma unroll
        for (int g = 0; g < 8; ++g) { const int ai = g >> 2, m = g & 3, row = row0 + ai * 128 + m * 16;
            if (g + 1 < 8) ldx(xq[(g + 1) & 1], row0 + ((g + 1) >> 2) * 128 + ((g + 1) & 3) * 16, col0);
            float ss = 0.f;
#pragma unroll
            for (int bj = 0; bj < 2; ++bj)
#pragma unroll
                for (int n = 0; n < 2; ++n) { const size_t off = (size_t)row * DM + col0 + bj * 128 + n * 16;
                    const pg8::f32x4 h = acc[ai][bj][m][n] + xq[g & 1][bj * 2 + n];
                    ss += h[0] * h[0] + h[1] * h[1] + h[2] * h[2] + h[3] * h[3];
                    *(unsigned long long*)(HB + off) = (unsigned long long)pk2(h[0], h[1]) | ((unsigned long long)pk2(h[2], h[3]) << 32); }
            ss += swz_xor<16>(ss); ss = sum_halves(ss);
            if (fq == 0) SSQ[(size_t)row * 16 + u.pn * 4 + wc] = ss; }
    }
};

typedef float f32x16 __attribute__((ext_vector_type(16)));
typedef short s16x4 __attribute__((ext_vector_type(4)));
typedef float f32x2_t __attribute__((ext_vector_type(2)));
typedef __bf16 bf16x2_t __attribute__((ext_vector_type(2)));
#define MFMA32(a, b, c) __builtin_amdgcn_mfma_f32_32x32x16_bf16((a), (b), (c), 0, 0, 0)
__device__ __forceinline__ int crow(int reg, int h) { return (reg & 3) + 8 * (reg >> 2) + 4 * h; }
__device__ __forceinline__ unsigned cvtpk(float lo, float hi) { f32x2_t v = {lo, hi}; bf16x2_t b = __builtin_convertvector(v, bf16x2_t); return __builtin_bit_cast(unsigned, b); }
__device__ __forceinline__ bf16x8 pack8(const f32x16& x, int s) {
    v4u p; p.x = cvtpk(x[8 * s], x[8 * s + 1]); p.y = cvtpk(x[8 * s + 2], x[8 * s + 3]); p.z = cvtpk(x[8 * s + 4], x[8 * s + 5]); p.w = cvtpk(x[8 * s + 6], x[8 * s + 7]);
    return __builtin_bit_cast(bf16x8, p);
}
constexpr float LOG2E = 1.4426950408889634f;
constexpr int LDP = 136;
constexpr int S1_XT = 0, S1_XTW = 17408, S1_BSN = 34816, S1_CLN = 69632, S1_BNL = 104448, S1_F32 = 139264;

__device__ __forceinline__ float silu_fast(float x) { return x * __builtin_amdgcn_rcpf(1.f + __builtin_amdgcn_exp2f(-x * LOG2E)); }
__device__ __forceinline__ int swz_t(int row, int l) { return row * LDP + ((((l >> 3) ^ (row >> 3)) & 7) | ((l >> 3) & 8)) * 8 + (l & 7); }
#define S1_CONV8(A_, IT_) do { _Pragma("unroll") for (int e_ = 0; e_ < 8; ++e_) A_[e_] = bias[e_]; \
        _Pragma("unroll") for (int j_ = 0; j_ < 4; ++j_) { const v4u rw_ = raw[(IT_) + j_]; \
            A_[0] += w[j_][0] * bflo(rw_.x); A_[1] += w[j_][1] * bfhi(rw_.x); A_[2] += w[j_][2] * bflo(rw_.y); A_[3] += w[j_][3] * bfhi(rw_.y); \
            A_[4] += w[j_][4] * bflo(rw_.z); A_[5] += w[j_][5] * bfhi(rw_.z); A_[6] += w[j_][6] * bflo(rw_.w); A_[7] += w[j_][7] * bfhi(rw_.w); } \
        _Pragma("unroll") for (int e_ = 0; e_ < 8; ++e_) A_[e_] = silu_fast(A_[e_]); } while (0)
#define S1_LOADW(CHB_) do { _Pragma("unroll") for (int j_ = 0; j_ < 4; ++j_) { const float4 w0_ = *(const float4*)(P.conv_w + j_ * 1024 + (CHB_)), w1_ = *(const float4*)(P.conv_w + j_ * 1024 + (CHB_) + 4); \
            w[j_][0] = w0_.x; w[j_][1] = w0_.y; w[j_][2] = w0_.z; w[j_][3] = w0_.w; w[j_][4] = w1_.x; w[j_][5] = w1_.y; w[j_][6] = w1_.z; w[j_][7] = w1_.w; } \
        { const float4 b0_ = *(const float4*)(P.conv_b + (CHB_)), b1_ = *(const float4*)(P.conv_b + (CHB_) + 4); \
          bias[0] = b0_.x; bias[1] = b0_.y; bias[2] = b0_.z; bias[3] = b0_.w; bias[4] = b1_.x; bias[5] = b1_.y; bias[6] = b1_.z; bias[7] = b1_.w; } } while (0)
__device__ __forceinline__ void ssd_s1(Frame& F, const Ptrs& P) {
    const bf16* PROJ = (const bf16*)(P.ws + WS_PROJ); const float* DT = (const float*)(P.ws + WS_DT);
    float* EA = (float*)(P.ws + WS_EA); float* CDEC = (float*)(P.ws + WS_CDEC); bf16* CC = (bf16*)(P.ws + WS_CC);
    unsigned* ST = (unsigned*)(P.ws + WS_ST); unsigned* YPF = (unsigned*)((char*)P.out + DO_YPF);
    LAS unsigned char* L = F.lds + RING_OFF;
    LAS bf16* Xt = (LAS bf16*)(L + S1_XT); LAS bf16* Xtw = (LAS bf16*)(L + S1_XTW); LAS bf16* Bsn = (LAS bf16*)(L + S1_BSN); LAS bf16* Cln = (LAS bf16*)(L + S1_CLN); LAS bf16* Bnl = (LAS bf16*)(L + S1_BNL);
    LAS float* f32base = (LAS float*)(L + S1_F32);
    const int lane = lane_id(); const int tid_ = F.wave * 64 + lane;
    for (int ug = F.vcu; ug < 256; ug += F.G) {
        const int grp = ug & 1, c = (ug >> 1) & 31, b = ug >> 6, t0 = b * SEQ + c * 128;
        __syncthreads();
        if (F.wave < 4) {
            const int h = 4 * grp + F.wave, us = (b * 32 + c) * 8 + h;
            const float A = -__expf(P.a_log[h]), dtb = P.dt_bias[h];
            const int ln = opq(lane_id());
            LAS float* acum2 = f32base + F.wave * 384; LAS float* wv = acum2 + 128; LAS float* wend = wv + 128;
            const float x0 = DT[(size_t)(t0 + 2 * ln) * 8 + h] + dtb, x1 = DT[(size_t)(t0 + 2 * ln + 1) * 8 + h] + dtb;
            const float dt0 = fmaxf(x0, 0.f) + log1pf(__expf(-fabsf(x0))), dt1 = fmaxf(x1, 0.f) + log1pf(__expf(-fabsf(x1)));
            const float a0 = dt0 * A, a1 = dt1 * A;
            float s = a0 + a1;
#pragma unroll
            for (int o = 1; o < 64; o <<= 1) { const float v = __int_as_float(__builtin_amdgcn_ds_bpermute((ln - o) * 4, __float_as_int(s))); if (ln >= o) s += v; }
            const float ac1 = s, ac0 = s - a1, tot = __uint_as_float(__builtin_amdgcn_readlane(__float_as_uint(s), 63));
            acum2[2 * ln] = ac0 * LOG2E; acum2[2 * ln + 1] = ac1 * LOG2E;
            wv[2 * ln] = log2f(dt0) - ac0 * LOG2E; wv[2 * ln + 1] = log2f(dt1) - ac1 * LOG2E;
            wend[2 * ln] = dt0 * exp2f((tot - ac0) * LOG2E); wend[2 * ln + 1] = dt1 * exp2f((tot - ac1) * LOG2E);
            EA[(size_t)(t0 + 2 * ln) * 8 + h] = exp2f(ac0 * LOG2E); EA[(size_t)(t0 + 2 * ln + 1) * 8 + h] = exp2f(ac1 * LOG2E);
            if (ln == 0) CDEC[us] = exp2f(tot * LOG2E);
        }
        { const int tidc = opq(tid_);
          if (tidc < 440) {
            const int cg = tidc % 40, sg = tidc / 40, l0 = 12 * sg, h0 = 4 * grp;
            int chb; if (cg < 8) chb = h0 * 64 + cg * 8; else if (cg < 24) chb = 512 + grp * 128 + (cg - 8) * 8; else chb = 768 + grp * 128 + (cg - 24) * 8;
            v4u raw[15];
#pragma unroll
            for (int q = 0; q < 15; ++q) { const int ss = c * 128 + l0 - 3 + q; raw[q] = (v4u){0u, 0u, 0u, 0u};
                if (ss >= 0 && l0 - 3 + q < 128) raw[q] = *(const v4u*)(PROJ + (size_t)(b * SEQ + ss) * NPROJ + PJ_XBC + chb); }
            float w[4][8], bias[8]; S1_LOADW(chb);
#pragma unroll
            for (int it = 0; it < 12; it += 2) {
                const int l = l0 + it;
                if (l < 128) {
                    float a[8], a2[8]; S1_CONV8(a, it); S1_CONV8(a2, it + 1);
                    if (cg < 8) {
#pragma unroll
                        for (int e = 0; e < 8; ++e) *(LAS unsigned*)(Xt + swz_t(cg * 8 + e, l)) = cvtpk(a[e], a2[e]);
                    } else {
                        v4u o, o2; o.x = cvtpk(a[0], a[1]); o.y = cvtpk(a[2], a[3]); o.z = cvtpk(a[4], a[5]); o.w = cvtpk(a[6], a[7]);
                        o2.x = cvtpk(a2[0], a2[1]); o2.y = cvtpk(a2[2], a2[3]); o2.z = cvtpk(a2[4], a2[5]); o2.w = cvtpk(a2[6], a2[7]);
                        if (cg < 24) { const int n0 = (cg - 8) * 8; *(LAS v4u*)(Bsn + l * LDP + n0) = o; *(LAS v4u*)(Bsn + (l + 1) * LDP + n0) = o2;
#pragma unroll
                            for (int e = 0; e < 8; ++e) *(LAS unsigned*)(Bnl + swz_t(n0 + e, l)) = cvtpk(a[e], a2[e]);
                        } else { const int n0 = (cg - 24) * 8; *(LAS v4u*)(Cln + l * LDP + n0) = o; *(LAS v4u*)(Cln + (l + 1) * LDP + n0) = o2;
                            *(v4u*)(CC + (size_t)(t0 + l) * 256 + grp * 128 + n0) = o; *(v4u*)(CC + (size_t)(t0 + l + 1) * 256 + grp * 128 + n0) = o2; }
                    }
                }
            }
          } }
        __syncthreads();
#pragma unroll 1
        for (int hi = 0; hi < 4; ++hi) {
            const int h = 4 * grp + hi, u = (b * 32 + c) * 8 + h;
            const float Dh = P.d_skip[h];
            const LAS float* acum2 = f32base + hi * 384; const LAS float* wv = acum2 + 128; const LAS float* wend = wv + 128;
            const LAS bf16* Xc = (hi & 1) ? Xtw : Xt; LAS bf16* Xn = (hi & 1) ? Xt : Xtw;
            const int tidc = opq(tid_);
            const int cgn = tidc & 7, ln_ = 2 * (tidc >> 3), chn = (h + 1) * 64 + cgn * 8;
            v4u raw[5];
#pragma unroll
            for (int q = 0; q < 5; ++q) { const int ss = c * 128 + ln_ - 3 + q; raw[q] = (v4u){0u, 0u, 0u, 0u};
                if (hi < 3 && ss >= 0) raw[q] = *(const v4u*)(PROJ + (size_t)(b * SEQ + ss) * NPROJ + PJ_XBC + chn); }
            float4 wq4[4][2], bq4[2];
            { const int chw = (hi < 3) ? chn : chn - 64;
#pragma unroll
              for (int j = 0; j < 4; ++j) { wq4[j][0] = *(const float4*)(P.conv_w + j * 1024 + chw); wq4[j][1] = *(const float4*)(P.conv_w + j * 1024 + chw + 4); }
              bq4[0] = *(const float4*)(P.conv_b + chw); bq4[1] = *(const float4*)(P.conv_b + chw + 4); }
            const int ln3 = opq(lane), r = ln3 & 31, hh = ln3 >> 5;
            if (F.wave < 4) {
                const int pt = F.wave >> 1;
#pragma unroll 1
                for (int q = 0; q < 2; ++q) {
                    const int lt = (F.wave & 1) ? (1 + q) : (3 * q);
                    f32x16 yacc;
#pragma unroll
                    for (int i = 0; i < 16; ++i) yacc[i] = 0.f;
                    const float al = acum2[32 * lt + r];
                    bf16x8 cf[8];
#pragma unroll
                    for (int kk = 0; kk < 8; ++kk) cf[kk] = *(const LAS bf16x8*)(Cln + (32 * lt + r) * LDP + 16 * kk + 8 * hh);
#pragma unroll 1
                    for (int st = 0; st <= lt; ++st) {
                        bf16x8 bfr[8];
#pragma unroll
                        for (int kk = 0; kk < 8; ++kk) bfr[kk] = *(const LAS bf16x8*)(Bsn + (32 * st + r) * LDP + 16 * kk + 8 * hh);
                        f32x4 wq[4];
#pragma unroll
                        for (int g4 = 0; g4 < 4; ++g4) wq[g4] = *(const LAS f32x4*)(wv + 32 * st + 8 * g4 + 4 * hh);
                        s16x4 xlo[2], xhi[2];
#pragma unroll
                        for (int sg = 0; sg < 2; ++sg) { const int prow = 32 * pt + r, lb = 32 * st + 16 * sg;
                            xlo[sg] = *(const LAS s16x4*)(Xc + swz_t(prow, lb) + 4 * hh); xhi[sg] = *(const LAS s16x4*)(Xc + swz_t(prow, lb + 8) + 4 * hh); }
                        __builtin_amdgcn_sched_barrier(0);
                        f32x16 macc;
#pragma unroll
                        for (int i = 0; i < 16; ++i) macc[i] = 0.f;
#pragma unroll
                        for (int kk = 0; kk < 8; ++kk) macc = MFMA32(bfr[kk], cf[kk], macc);
#pragma unroll
                        for (int i = 0; i < 16; ++i) { const int sl = crow(i, hh);
                            float f = __builtin_amdgcn_exp2f(al + wq[i >> 2][i & 3]);
                            if (st == lt && sl > r) f = 0.f;
                            macc[i] *= f; }
#pragma unroll
                        for (int sg = 0; sg < 2; ++sg) {
                            const bf16x8 bfrag = pack8(macc, sg);
                            const bf16x8 afrag = __builtin_shufflevector(xlo[sg], xhi[sg], 0, 1, 2, 3, 4, 5, 6, 7);
                            yacc = MFMA32(afrag, bfrag, yacc);
                        }
                    }
                    unsigned short xs16[16];
#pragma unroll
                    for (int i = 0; i < 16; ++i) xs16[i] = *(const LAS unsigned short*)(Xc + swz_t(32 * pt + crow(i, hh), 32 * lt + r));
                    __builtin_amdgcn_sched_barrier(0);
#pragma unroll
                    for (int i = 0; i < 16; i += 2) {
                        const float y0 = yacc[i] + Dh * __uint_as_float((unsigned)xs16[i] << 16), y1 = yacc[i + 1] + Dh * __uint_as_float((unsigned)xs16[i + 1] << 16);
                        YPF[((((size_t)u * 4 + lt) * 2 + pt) * 8 + (i >> 1)) * 64 + ln3] = cvtpk(y0, y1); }
                }
            } else {
                const int nt = F.wave - 4;
                bf16x8 bb[8];
                { v4u braw[8]; f32x4 we[8][2];
#pragma unroll
                  for (int kk = 0; kk < 8; ++kk) { braw[kk] = *(const LAS v4u*)(Bnl + swz_t(32 * nt + r, 16 * kk + 8 * hh));
                      we[kk][0] = *(const LAS f32x4*)(wend + 16 * kk + 8 * hh); we[kk][1] = *(const LAS f32x4*)(wend + 16 * kk + 8 * hh + 4); }
#pragma unroll
                  for (int kk = 0; kk < 8; ++kk) { v4u o;
                      o.x = cvtpk(bflo(braw[kk].x) * we[kk][0][0], bfhi(braw[kk].x) * we[kk][0][1]); o.y = cvtpk(bflo(braw[kk].y) * we[kk][0][2], bfhi(braw[kk].y) * we[kk][0][3]);
                      o.z = cvtpk(bflo(braw[kk].z) * we[kk][1][0], bfhi(braw[kk].z) * we[kk][1][1]); o.w = cvtpk(bflo(braw[kk].w) * we[kk][1][2], bfhi(braw[kk].w) * we[kk][1][3]);
                      bb[kk] = __builtin_bit_cast(bf16x8, o); } }
#pragma unroll 1
                for (int pt = 0; pt < 2; ++pt) {
                    bf16x8 xa[8];
#pragma unroll
                    for (int kk = 0; kk < 8; ++kk) xa[kk] = *(const LAS bf16x8*)(Xc + swz_t(32 * pt + r, 16 * kk + 8 * hh));
                    __builtin_amdgcn_sched_barrier(0);
                    f32x16 sacc;
#pragma unroll
                    for (int i = 0; i < 16; ++i) sacc[i] = 0.f;
#pragma unroll
                    for (int kk = 0; kk < 8; ++kk) sacc = MFMA32(xa[kk], bb[kk], sacc);
#pragma unroll
                    for (int i = 0; i < 16; i += 2) ST[((size_t)u * 32 + 16 * pt + (crow(i, hh) >> 1)) * 128 + 32 * nt + r] = cvtpk(sacc[i], sacc[i + 1]);
                }
            }
            if (hi < 3) {
                const int cg = cgn, l = ln_;
                float w[4][8], bias[8];
#pragma unroll
                for (int j = 0; j < 4; ++j) { w[j][0] = wq4[j][0].x; w[j][1] = wq4[j][0].y; w[j][2] = wq4[j][0].z; w[j][3] = wq4[j][0].w; w[j][4] = wq4[j][1].x; w[j][5] = wq4[j][1].y; w[j][6] = wq4[j][1].z; w[j][7] = wq4[j][1].w; }
                bias[0] = bq4[0].x; bias[1] = bq4[0].y; bias[2] = bq4[0].z; bias[3] = bq4[0].w; bias[4] = bq4[1].x; bias[5] = bq4[1].y; bias[6] = bq4[1].z; bias[7] = bq4[1].w;
                float a[8], a2[8]; S1_CONV8(a, 0); S1_CONV8(a2, 1);
#pragma unroll
                for (int e = 0; e < 8; ++e) *(LAS unsigned*)(Xn + swz_t(cg * 8 + e, l)) = cvtpk(a[e], a2[e]);
            }
            __syncthreads();
        }
    }
}
__device__ __forceinline__ void ssd_s2(Frame& F, const Ptrs& P) {
    const unsigned* ST = (const unsigned*)(P.ws + WS_ST); const float* CDEC = (const float*)(P.ws + WS_CDEC); unsigned* PREV = (unsigned*)(P.ws + WS_PREV);
    for (int g = F.vcu * 512 + (F.wave * 64 + lane_id()); g < 65536; g += F.G * 512) {
        const int n2 = g & 63, p2 = (g >> 6) & 31, h = (g >> 11) & 7, b = g >> 14;
        uint2 st[32];
#pragma unroll
        for (int c = 0; c < 32; ++c) st[c] = *(const uint2*)(ST + ((size_t)(((b * 32 + c) * 8 + h) * 32 + p2)) * 128 + 2 * n2);
        float r00 = 0.f, r01 = 0.f, r10 = 0.f, r11 = 0.f;
#pragma unroll
        for (int c = 0; c < 32; ++c) { const size_t u = (size_t)((b * 32 + c) * 8 + h);
            PREV[((u * 64 + 2 * p2) * 128 + 2 * n2) >> 1] = cvtpk(r00, r01); PREV[((u * 64 + 2 * p2 + 1) * 128 + 2 * n2) >> 1] = cvtpk(r10, r11);
            const float d = CDEC[u];
            r00 = r00 * d + bflo(st[c].x); r10 = r10 * d + bfhi(st[c].x); r01 = r01 * d + bflo(st[c].y); r11 = r11 * d + bfhi(st[c].y); }
    }
}
__device__ __forceinline__ void ssd_s3(Frame& F, const Ptrs& P) {
    const bf16* CC = (const bf16*)(P.ws + WS_CC); const bf16* PREV = (const bf16*)(P.ws + WS_PREV); const float* EA = (const float*)(P.ws + WS_EA);
    const unsigned* YPF = (const unsigned*)((const char*)P.out + DO_YPF); const bf16* PROJ = (const bf16*)(P.ws + WS_PROJ); bf16* CAT = (bf16*)(P.ws + WS_XN);
    LAS float* red = (LAS float*)(F.lds + RING_OFF);
    const int lane = lane_id(), r = lane & 31, hh = lane >> 5, h = F.wave, grp = h >> 2;
    for (int v2 = F.vcu; v2 < 256; v2 += F.G) {
        const int lp = v2 & 1, c = (v2 >> 1) & 31, b = v2 >> 6;
        const size_t u = (size_t)((b * 32 + c) * 8 + h);
        bf16x8 af[2][8];
#pragma unroll
        for (int pt = 0; pt < 2; ++pt)
#pragma unroll
            for (int kk = 0; kk < 8; ++kk) af[pt][kk] = *(const bf16x8*)(PREV + (u * 64 + 32 * pt + r) * 128 + 16 * kk + 8 * hh);
#pragma unroll 1
        for (int li = 0; li < 2; ++li) {
            const int lt = 2 * lp + li;
            const int t = b * SEQ + c * 128 + lt * 32 + r;
            unsigned ypf[2][8]; unsigned long long zz[2][4];
#pragma unroll
            for (int pt = 0; pt < 2; ++pt) {
#pragma unroll
                for (int i = 0; i < 8; ++i) ypf[pt][i] = YPF[((((size_t)u * 4 + lt) * 2 + pt) * 8 + i) * 64 + lane];
#pragma unroll
                for (int g4 = 0; g4 < 4; ++g4) zz[pt][g4] = *(const unsigned long long*)(PROJ + (size_t)t * NPROJ + PJ_Z + h * 64 + 32 * pt + 8 * g4 + 4 * hh); }
            const float ea = EA[(size_t)t * 8 + h];
            bf16x8 bb[8];
#pragma unroll
            for (int kk = 0; kk < 8; ++kk) bb[kk] = *(const bf16x8*)(CC + (size_t)t * 256 + grp * 128 + 16 * kk + 8 * hh);
            f32x16 acc[2];
#pragma unroll
            for (int i = 0; i < 16; ++i) { acc[0][i] = 0.f; acc[1][i] = 0.f; }
#pragma unroll
            for (int kk = 0; kk < 8; ++kk) { acc[0] = MFMA32(af[0][kk], bb[kk], acc[0]); acc[1] = MFMA32(af[1][kk], bb[kk], acc[1]); }
            float ss = 0.f;
#pragma unroll
            for (int pt = 0; pt < 2; ++pt)
#pragma unroll
                for (int g4 = 0; g4 < 4; ++g4) {
                    const unsigned z01 = (unsigned)zz[pt][g4], z23 = (unsigned)(zz[pt][g4] >> 32);
                    const float zf[4] = {bflo(z01), bfhi(z01), bflo(z23), bfhi(z23)};
#pragma unroll
                    for (int e = 0; e < 4; ++e) { const int i = 4 * g4 + e;
                        const float y = acc[pt][i] * ea + ((i & 1) ? bfhi(ypf[pt][i >> 1]) : bflo(ypf[pt][i >> 1]));
                        const float yg = y * silu_fast(zf[e]); acc[pt][i] = yg; ss = fmaf(yg, yg, ss); }
                }
            ss = sum_halves(ss);
            LAS float* rd = red + li * 256;
            if (hh == 0) rd[h * 32 + r] = ss;
            __syncthreads();
            float tot = 0.f;
#pragma unroll
            for (int w = 0; w < 8; ++w) tot += rd[w * 32 + r];
            const float rn = rsqrtf(tot * (1.f / 512.f) + EPS);
#pragma unroll
            for (int pt = 0; pt < 2; ++pt)
#pragma unroll
                for (int g4 = 0; g4 < 4; ++g4) { const int ch = h * 64 + 32 * pt + 8 * g4 + 4 * hh;
                    const float4 w = *(const float4*)(P.ssd_norm_w + ch);
                    *(unsigned long long*)(CAT + (size_t)t * DM + 512 + ch) = (unsigned long long)cvtpk(acc[pt][4 * g4] * rn * w.x, acc[pt][4 * g4 + 1] * rn * w.y) | ((unsigned long long)cvtpk(acc[pt][4 * g4 + 2] * rn * w.z, acc[pt][4 * g4 + 3] * rn * w.w) << 32); }
        }
        __syncthreads();
    }
}
__device__ __forceinline__ float gelu_erf(float v) { return 0.5f * v * (1.f + erff(v * 0.70710678118654752f)); }
typedef float f32x2v __attribute__((ext_vector_type(2)));
#define CVT8(W, LO) __builtin_amdgcn_cvt_pk_f32_fp8((int)(W), LO)
template <int CTRL> __device__ __forceinline__ float dpp_f(float v) { return __int_as_float(__builtin_amdgcn_update_dpp(0, __float_as_int(v), CTRL, 0xF, 0xF, true)); }
__device__ __forceinline__ float sum8_dpp(float s) { s += dpp_f<0xB1>(s); s += dpp_f<0x4E>(s); s += dpp_f<0x141>(s); return s; }
struct PeerPlace { int vx, nx, rank, nloc; };
__device__ __forceinline__ PeerPlace peer_place(Frame& F) {
    __syncthreads();
    if (F.wave == 0 && lane_id() == 0) {
        unsigned* bar = (unsigned*)(F.ctl + CW_BAR); const unsigned x = xb_xcc_id();
        unsigned vx = 0, nx = 0;
        for (unsigned j = 0; j < 16; ++j) { const unsigned c = xb_ld(&bar[XB_XCNT(j)]); if (c) { if (j < x) ++vx; ++nx; } }
        const unsigned rank = xb_add((unsigned*)(F.ctl + CW_RANK) + 64 * x, 1u);
        F.MISC[10] = vx; F.MISC[11] = nx ? nx : 1u; F.MISC[12] = rank; F.MISC[13] = xb_ld(&bar[XB_XCNT(x)]);
    }
    __syncthreads();
    PeerPlace pp; pp.vx = (int)F.MISC[10]; pp.nx = (int)F.MISC[11]; pp.rank = (int)F.MISC[12]; pp.nloc = (int)F.MISC[13]; if (pp.nloc < 1) pp.nloc = 1;
    return pp;
}
__device__ __forceinline__ void h_quant_rows(Frame& F, const Ptrs& P) {
    const bf16* HB = (const bf16*)(P.ws + WS_ST); unsigned char* H8 = P.ws + WS_H8; float* HS = (float*)(P.ws + WS_HS);
    const int lane = lane_id();
    for (int t = F.vcu * NWAVES + F.wave; t < T_; t += F.G * NWAVES) {
        const v4u a0 = ((const v4u*)(HB + (size_t)t * DM))[2 * lane], a1 = ((const v4u*)(HB + (size_t)t * DM))[2 * lane + 1];
        float hf[16];
        hf[0] = bflo(a0.x); hf[1] = bfhi(a0.x); hf[2] = bflo(a0.y); hf[3] = bfhi(a0.y); hf[4] = bflo(a0.z); hf[5] = bfhi(a0.z); hf[6] = bflo(a0.w); hf[7] = bfhi(a0.w);
        hf[8] = bflo(a1.x); hf[9] = bfhi(a1.x); hf[10] = bflo(a1.y); hf[11] = bfhi(a1.y); hf[12] = bflo(a1.z); hf[13] = bfhi(a1.z); hf[14] = bflo(a1.w); hf[15] = bfhi(a1.w);
        float am = 0.f;
#pragma unroll
        for (int i = 0; i < 16; ++i) am = fmaxf(am, fabsf(hf[i]));
        am = fmaxf(am, dpp_f<0xB1>(am)); am = fmaxf(am, dpp_f<0x4E>(am)); am = fmaxf(am, dpp_f<0x141>(am)); am = fmaxf(am, dpp_f<0x140>(am)); am = fmaxf(am, 1e-30f);
        const float inv = 119.f / am;
        unsigned hi[2] = {0u, 0u}, lo[2] = {0u, 0u};
#pragma unroll
        for (int i = 0; i < 16; ++i) { const int q = __float2int_rn(hf[i] * inv); const int qh = (q + 8) >> 4, ql = q - 16 * qh;
            hi[i >> 3] |= ((unsigned)qh & 15u) << (4 * (i & 7)); lo[i >> 3] |= ((unsigned)ql & 15u) << (4 * (i & 7)); }
        unsigned char* dst = H8 + (size_t)t * 1024 + (lane >> 4) * 256 + (lane & 15) * 8;
        *(unsigned long long*)dst = (unsigned long long)hi[0] | ((unsigned long long)hi[1] << 32);
        *(unsigned long long*)(dst + 128) = (unsigned long long)lo[0] | ((unsigned long long)lo[1] << 32);
        if ((lane & 15) == 0) HS[(size_t)t * 8 + (lane >> 4)] = am * (1.f / 119.f);
    }
}
constexpr int PX_D = 16;
template <int CTRL> __device__ __forceinline__ int dpp_i(int v) { return __builtin_amdgcn_update_dpp(0, v, CTRL, 0xF, 0xF, true); }
#define PX_ISSUE(BUF, LO, HI) _Pragma("unroll") for (int b_ = 0; b_ < 8; ++b_) { const unsigned off_ = ((unsigned)__builtin_amdgcn_ds_bpermute((16 * (b_ & 3) + ps) * 4, (b_ & 4) ? (HI) : (LO)) << 7) | (unsigned)(dl << 5); \
        BUF[2 * b_] = *(const v4u*)(tab + off_); BUF[2 * b_ + 1] = *(const v4u*)(tab + off_ + 16); }
struct H4 { v4u h0, h1, l0, l1; };
#define PX_DOT8(Q, HH, HL) ah = __builtin_amdgcn_sdot8((int)(Q), (int)(HH), ah, false); al = __builtin_amdgcn_sdot8((int)(Q), (int)(HL), al, false);
__device__ __forceinline__ void peer_down_token(const v4u (&cur)[PX_D], const H4& h, const float hs, unsigned* prow, int dl, int ps) {
    int sm[8];
#pragma unroll
    for (int b = 0; b < 8; ++b) { const v4u q0 = cur[2 * b], q1 = cur[2 * b + 1];
        int ah = 0, al = 0;
        PX_DOT8(q0.x, h.h0.x, h.l0.x) PX_DOT8(q0.y, h.h0.y, h.l0.y) PX_DOT8(q0.z, h.h0.z, h.l0.z) PX_DOT8(q0.w, h.h0.w, h.l0.w)
        PX_DOT8(q1.x, h.h1.x, h.l1.x) PX_DOT8(q1.y, h.h1.y, h.l1.y) PX_DOT8(q1.z, h.h1.z, h.l1.z) PX_DOT8(q1.w, h.h1.w, h.l1.w)
        sm[b] = 16 * ah + al; }
    const bool c1 = (dl & 2) != 0, c0 = (dl & 1) != 0;
    int w4[4], w2[2];
#pragma unroll
    for (int k = 0; k < 4; ++k) { const int keep = c1 ? sm[4 + k] : sm[k], send = c1 ? sm[k] : sm[4 + k]; w4[k] = keep + dpp_i<0x4E>(send); }
#pragma unroll
    for (int k = 0; k < 2; ++k) { const int keep = c0 ? w4[2 + k] : w4[k], send = c0 ? w4[k] : w4[2 + k]; w2[k] = keep + dpp_i<0xB1>(send); }
    const float f0 = (float)w2[0] * hs, f1 = (float)w2[1] * hs;
    const float g0 = dpp_f<0x4E>(f0), g1 = dpp_f<0x4E>(f1);
    if (dl < 2) { prow[32 * dl + ps] = cvtpk(f0, g0); prow[32 * dl + 16 + ps] = cvtpk(f1, g1); }
}
__device__ __forceinline__ void peer_down(Frame& F, const Ptrs& P, const PeerPlace& pp) {
    const unsigned char* H8 = P.ws + WS_H8; const unsigned char* HSb = P.ws + WS_HS; const unsigned char* IDXb = P.ws + WS_IDX; unsigned char* PARTb = P.ws + WS_PART;
    const int lane = lane_id(), dl = lane & 3, ps = lane >> 2;
    const int tstep = pp.nloc * NWAVES;
    for (int u = pp.vx; u < 8; u += pp.nx) {
        const int s = u & 3, tend = ((u >> 2) + 1) * (T_ / 2), t0 = (u >> 2) * (T_ / 2) + pp.rank * NWAVES + F.wave;
        if (t0 >= tend) continue;
        const unsigned char* tab = P.ws + WS_ED + (size_t)s * 16384 * 128;
        const unsigned hoff = (unsigned)(s * 256 + dl * 32), ioff = (unsigned)lane * 4u;
        v4u bufA[PX_D], bufB[PX_D];
#define PD_CLAMP(T) ((T) < tend ? (T) : t0)
#define PD_META(H, HSC, TT) do { const unsigned char* hp_ = H8 + ((unsigned)(TT) * 1024u + hoff); H.h0 = *(const v4u*)hp_; H.h1 = *(const v4u*)(hp_ + 16); H.l0 = *(const v4u*)(hp_ + 128); H.l1 = *(const v4u*)(hp_ + 144); \
        HSC = *(const float*)(HSb + ((unsigned)(TT) * 32u + (unsigned)s * 4u)); } while (0)
#define PD_IDX(LO, HI, TT) do { LO = *(const int*)(IDXb + ((unsigned)(TT) * 512u + ioff)); HI = *(const int*)(IDXb + ((unsigned)(TT) * 512u + 256u + ioff)); } while (0)
        int nidx_lo, nidx_hi; PD_IDX(nidx_lo, nidx_hi, t0);
        PX_ISSUE(bufA, nidx_lo, nidx_hi);
        PD_IDX(nidx_lo, nidx_hi, PD_CLAMP(t0 + tstep));
        H4 ha, hb; float sa, sb; PD_META(ha, sa, t0);
        for (int t = t0; t < tend; t += 2 * tstep) {
            { const int tn = PD_CLAMP(t + tstep);
              PX_ISSUE(bufB, nidx_lo, nidx_hi); PD_IDX(nidx_lo, nidx_hi, PD_CLAMP(tn + tstep)); PD_META(hb, sb, tn);
              __builtin_amdgcn_sched_barrier(0);
              peer_down_token(bufA, ha, sa, (unsigned*)(PARTb + ((unsigned)(s * T_ + t) * 256u)), dl, ps);
              __builtin_amdgcn_sched_barrier(0); }
            if (t + tstep >= tend) break;
            { const int tc = t + tstep, tn = PD_CLAMP(tc + tstep);
              PX_ISSUE(bufA, nidx_lo, nidx_hi); PD_IDX(nidx_lo, nidx_hi, PD_CLAMP(tn + tstep)); PD_META(ha, sa, tn);
              __builtin_amdgcn_sched_barrier(0);
              peer_down_token(bufB, hb, sb, (unsigned*)(PARTb + ((unsigned)(s * T_ + tc) * 256u)), dl, ps);
              __builtin_amdgcn_sched_barrier(0); }
        }
    }
}
constexpr int PE_PD = 8;
#define PE_LOAD4(SLOT, IDV) SLOT = *(const v4u*)(EU + (((unsigned)(IDV) << 9) | l16))
#define PE_BP(ADDR, V) __builtin_amdgcn_ds_bpermute((ADDR), (V))
__device__ __forceinline__ void peer_up_tm(Frame& F, const Ptrs& P) {
    const bf16* HB = (const bf16*)(P.ws + WS_ST); const unsigned char* EU = P.ws + WS_EU;
    const int* IDX = (const int*)(P.ws + WS_IDX); const float* GATE = (const float*)(P.ws + WS_GATE); const unsigned* PART = (const unsigned*)(P.ws + WS_PART);
    const float* SCD = (const float*)(P.ws + WS_SMALL); const float* SCU = SCD + 16384;
    const int lane = lane_id(), l31 = lane & 31; const bool upper = lane >= 32;
    const unsigned l16 = (unsigned)l31 << 4;
    const int bp0 = upper ? 4 : 0;
    const int t0 = F.vcu * NWAVES + F.wave, tstep = F.G * NWAVES;
    if (t0 >= T_) return;
    float4 nfw[4];
#pragma unroll
    for (int k = 0; k < 4; ++k) nfw[k] = ((const float4*)(P.norm_final) + 8 * l31 + 4 * (lane >> 5))[k];
    int idx_lo = IDX[(size_t)t0 * 128 + lane], idx_hi = IDX[(size_t)t0 * 128 + 64 + lane];
    v4u hq[4];
#pragma unroll
    for (int k = 0; k < 4; ++k) hq[k] = ((const v4u*)(HB + (size_t)t0 * DM))[4 * l31 + k];
    float g_lo = GATE[(size_t)t0 * 128 + lane], g_hi = GATE[(size_t)t0 * 128 + 64 + lane];
    float pre_lo = 0.f, pre_hi = 0.f;
#pragma unroll
    for (int s = 0; s < 4; ++s) { const unsigned pp_ = PART[((size_t)s * T_ + t0) * 64 + lane]; pre_lo += bflo(pp_); pre_hi += bfhi(pp_); }
    float sdu_lo = SCD[idx_lo], sdu_hi = SCD[idx_hi], su_lo = SCU[idx_lo], su_hi = SCU[idx_hi];
    v4u ra[PE_PD];
#pragma unroll
    for (int j = 0; j < PE_PD; ++j) { const int id = PE_BP(bp0 + 8 * j, idx_lo); PE_LOAD4(ra[j], id); }
    int id_nx = PE_BP(bp0 + 8 * PE_PD, idx_lo);
    for (int t = t0; t < T_; t += tstep) {
        const int tn = (t + tstep < T_) ? t + tstep : t;
        const int nidx_lo = IDX[(size_t)tn * 128 + lane], nidx_hi = IDX[(size_t)tn * 128 + 64 + lane];
        v4u nh[4];
#pragma unroll
        for (int k = 0; k < 4; ++k) nh[k] = ((const v4u*)(HB + (size_t)tn * DM))[4 * l31 + k];
        const float ng_lo = GATE[(size_t)tn * 128 + lane], ng_hi = GATE[(size_t)tn * 128 + 64 + lane];
        unsigned npart[4];
#pragma unroll
        for (int s = 0; s < 4; ++s) npart[s] = PART[((size_t)s * T_ + tn) * 64 + lane];
        float ssq = 0.f;
#pragma unroll
        for (int k = 0; k < 4; ++k) { ssq = fmaf(bflo(hq[k].x), bflo(hq[k].x), ssq); ssq = fmaf(bfhi(hq[k].x), bfhi(hq[k].x), ssq); ssq = fmaf(bflo(hq[k].y), bflo(hq[k].y), ssq); ssq = fmaf(bfhi(hq[k].y), bfhi(hq[k].y), ssq);
            ssq = fmaf(bflo(hq[k].z), bflo(hq[k].z), ssq); ssq = fmaf(bfhi(hq[k].z), bfhi(hq[k].z), ssq); ssq = fmaf(bflo(hq[k].w), bflo(hq[k].w), ssq); ssq = fmaf(bfhi(hq[k].w), bfhi(hq[k].w), ssq); }
        ssq += swz_xor<1>(ssq); ssq += swz_xor<2>(ssq); ssq += swz_xor<4>(ssq); ssq += swz_xor<8>(ssq); ssq += swz_xor<16>(ssq);
        const float rstd = rsqrtf(ssq * (1.f / 1024.f) + EPS);
        const float act_lo = gelu_erf(pre_lo * sdu_lo * rstd) * g_lo * su_lo, act_hi = gelu_erf(pre_hi * sdu_hi * rstd) * g_hi * su_hi;
        float nsdu_lo = 0.f, nsdu_hi = 0.f, nsu_lo = 0.f, nsu_hi = 0.f;
        f32x2v acc[16];
#pragma unroll
        for (int i = 0; i < 16; ++i) acc[i] = (f32x2v){0.f, 0.f};
        float a_cur = __int_as_float(PE_BP(bp0, __float_as_int(act_lo)));
#pragma unroll
        for (int q = 0; q < 64; ++q) {
            const int qa = q + 1, ql = q + PE_PD + 1;
            float a_nx = 0.f;
            if (qa < 64) a_nx = __int_as_float(PE_BP(bp0 + 8 * (qa & 31), __float_as_int(qa < 32 ? act_lo : act_hi)));
            int id_n2;
            if (ql < 64) id_n2 = PE_BP(bp0 + 8 * (ql & 31), ql < 32 ? idx_lo : idx_hi);
            else id_n2 = PE_BP(bp0 + 8 * ((ql - 64) & 31), nidx_lo);
            __builtin_amdgcn_sched_barrier(0);
            { const f32x2v av = {a_cur, a_cur}; const v4u r = ra[q % PE_PD];
#define PE_FMA4(W, O) acc[O] = __builtin_elementwise_fma(av, (f32x2v)__builtin_amdgcn_cvt_scalef32_pk_f32_fp4(W, 1.0f, 0), acc[O]); acc[O + 1] = __builtin_elementwise_fma(av, (f32x2v)__builtin_amdgcn_cvt_scalef32_pk_f32_fp4(W, 1.0f, 1), acc[O + 1]); \
              acc[O + 2] = __builtin_elementwise_fma(av, (f32x2v)__builtin_amdgcn_cvt_scalef32_pk_f32_fp4(W, 1.0f, 2), acc[O + 2]); acc[O + 3] = __builtin_elementwise_fma(av, (f32x2v)__builtin_amdgcn_cvt_scalef32_pk_f32_fp4(W, 1.0f, 3), acc[O + 3]);
              PE_FMA4(r.x, 0) PE_FMA4(r.y, 4) PE_FMA4(r.z, 8) PE_FMA4(r.w, 12) }
            asm volatile("" : "+v"(acc[0]), "+v"(acc[1]), "+v"(acc[2]), "+v"(acc[3]), "+v"(acc[4]), "+v"(acc[5]), "+v"(acc[6]), "+v"(acc[7]));
            asm volatile("" : "+v"(acc[8]), "+v"(acc[9]), "+v"(acc[10]), "+v"(acc[11]), "+v"(acc[12]), "+v"(acc[13]), "+v"(acc[14]), "+v"(acc[15]));
            PE_LOAD4(ra[q % PE_PD], id_nx);
            if (q == 24) { nsdu_lo = SCD[nidx_lo]; nsdu_hi = SCD[nidx_hi]; nsu_lo = SCU[nidx_lo]; nsu_hi = SCU[nidx_hi]; }
            id_nx = id_n2; a_cur = a_nx;
            __builtin_amdgcn_sched_barrier(0);
        }
        { float a = 0.f, c = 0.f;
#pragma unroll
          for (int s = 0; s < 4; ++s) { a += bflo(npart[s]); c += bfhi(npart[s]); }
          pre_lo = a; pre_hi = c; }
        sdu_lo = nsdu_lo; sdu_hi = nsdu_hi; su_lo = nsu_lo; su_hi = nsu_hi;
        float y[32];
#pragma unroll
        for (int k = 0; k < 4; ++k) { y[8 * k] = bflo(hq[k].x); y[8 * k + 1] = bfhi(hq[k].x); y[8 * k + 2] = bflo(hq[k].y); y[8 * k + 3] = bfhi(hq[k].y); y[8 * k + 4] = bflo(hq[k].z); y[8 * k + 5] = bfhi(hq[k].z); y[8 * k + 6] = bflo(hq[k].w); y[8 * k + 7] = bfhi(hq[k].w); }
        float s2 = 0.f;
#pragma unroll
        for (int i = 0; i < 16; ++i) { y[2 * i] += sum_halves(acc[i][0]); y[2 * i + 1] += sum_halves(acc[i][1]); s2 = fmaf(y[2 * i], y[2 * i], s2); s2 = fmaf(y[2 * i + 1], y[2 * i + 1], s2); }
        s2 += swz_xor<1>(s2); s2 += swz_xor<2>(s2); s2 += swz_xor<4>(s2); s2 += swz_xor<8>(s2); s2 += swz_xor<16>(s2);
        const float r2 = rsqrtf(s2 * (1.f / 1024.f) + EPS);
        float4* o = (float4*)(P.out + (size_t)t * DM) + 8 * l31 + 4 * (lane >> 5);
#pragma unroll
        for (int k = 0; k < 4; ++k) { const float4 w = nfw[k];
            const float e0 = upper ? y[16 + 4 * k] : y[4 * k], e1 = upper ? y[17 + 4 * k] : y[4 * k + 1], e2 = upper ? y[18 + 4 * k] : y[4 * k + 2], e3 = upper ? y[19 + 4 * k] : y[4 * k + 3];
            o[k] = make_float4(e0 * r2 * w.x, e1 * r2 * w.y, e2 * r2 * w.z, e3 * r2 * w.w); }
        idx_lo = nidx_lo; idx_hi = nidx_hi; g_lo = ng_lo; g_hi = ng_hi;
#pragma unroll
        for (int k = 0; k < 4; ++k) hq[k] = nh[k];
    }
}
constexpr int TK_LDK = 136, TK_K2 = 34816, TK_SCR = 69632, TK_SP = 49;
__device__ __forceinline__ int mono_key(float x) { const int b = __float_as_int(x); return b ^ ((b >> 31) & 0x7fffffff); }
__device__ __forceinline__ float unmono(int m) { return __int_as_float(m ^ ((m >> 31) & 0x7fffffff)); }
__device__ __forceinline__ int max3i(int a, int b, int c) { return max(max(a, b), c); }
#define CEX(A, I, J) do { const int hi_ = max(A[I], A[J]), lo_ = min(A[I], A[J]); A[I] = hi_; A[J] = lo_; } while (0)
template <int N, int OFF, int K, int J, int LEN> struct BitonicStep {
    static __device__ __forceinline__ void run(int (&a)[LEN]) {
#pragma unroll
        for (int i = 0; i < N; ++i) { const int l = i ^ J; if (l > i) { if ((i & K) == 0) CEX(a, OFF + i, OFF + l); else CEX(a, OFF + l, OFF + i); } }
        if constexpr (J > 1) BitonicStep<N, OFF, K, (J >> 1), LEN>::run(a);
        else if constexpr (K < N) BitonicStep<N, OFF, (K << 1), K, LEN>::run(a);
    }
};
template <int N, int OFF, int LEN> __device__ __forceinline__ void bitonic_sort_desc(int (&a)[LEN]) { BitonicStep<N, OFF, 2, 1, LEN>::run(a); }
template <int OFF, int LEN> __device__ __forceinline__ void bitonic_merge16_desc(int (&a)[LEN]) { BitonicStep<16, OFF, 16, 8, LEN>::run(a); }
template <int OFF, int LEN> __device__ __forceinline__ void oem_sort16_desc(int (&a)[LEN]) {
    constexpr unsigned char Pn[63][2] = {{0, 1}, {2, 3}, {0, 2}, {1, 3}, {1, 2}, {4, 5}, {6, 7}, {4, 6}, {5, 7}, {5, 6}, {0, 4}, {2, 6}, {2, 4}, {1, 5}, {3, 7}, {3, 5}, {1, 2}, {3, 4}, {5, 6}, {8, 9}, {10, 11}, {8, 10}, {9, 11}, {9, 10}, {12, 13}, {14, 15}, {12, 14}, {13, 15}, {13, 14}, {8, 12}, {10, 14}, {10, 12}, {9, 13}, {11, 15}, {11, 13}, {9, 10}, {11, 12}, {13, 14}, {0, 8}, {4, 12}, {4, 8}, {2, 10}, {6, 14}, {6, 10}, {2, 4}, {6, 8}, {10, 12}, {1, 9}, {5, 13}, {5, 9}, {3, 11}, {7, 15}, {7, 11}, {3, 5}, {7, 9}, {11, 13}, {1, 2}, {3, 4}, {5, 6}, {7, 8}, {9, 10}, {11, 12}, {13, 14}};
#pragma unroll
    for (int k = 0; k < 63; ++k) CEX(a, OFF + Pn[k][0], OFF + Pn[k][1]);
}
template <int LEN> __device__ __forceinline__ void oem_sort32_desc(int (&a)[LEN]) {
    constexpr unsigned char Pn[191][2] = {{0, 1}, {2, 3}, {0, 2}, {1, 3}, {1, 2}, {4, 5}, {6, 7}, {4, 6}, {5, 7}, {5, 6}, {0, 4}, {2, 6}, {2, 4}, {1, 5}, {3, 7}, {3, 5}, {1, 2}, {3, 4}, {5, 6}, {8, 9}, {10, 11}, {8, 10}, {9, 11}, {9, 10}, {12, 13}, {14, 15}, {12, 14}, {13, 15}, {13, 14}, {8, 12}, {10, 14}, {10, 12}, {9, 13}, {11, 15}, {11, 13}, {9, 10}, {11, 12}, {13, 14}, {0, 8}, {4, 12}, {4, 8}, {2, 10}, {6, 14}, {6, 10}, {2, 4}, {6, 8}, {10, 12}, {1, 9}, {5, 13}, {5, 9}, {3, 11}, {7, 15}, {7, 11}, {3, 5}, {7, 9}, {11, 13}, {1, 2}, {3, 4}, {5, 6}, {7, 8}, {9, 10}, {11, 12}, {13, 14}, {16, 17}, {18, 19}, {16, 18}, {17, 19}, {17, 18}, {20, 21}, {22, 23}, {20, 22}, {21, 23}, {21, 22}, {16, 20}, {18, 22}, {18, 20}, {17, 21}, {19, 23}, {19, 21}, {17, 18}, {19, 20}, {21, 22}, {24, 25}, {26, 27}, {24, 26}, {25, 27}, {25, 26}, {28, 29}, {30, 31}, {28, 30}, {29, 31}, {29, 30}, {24, 28}, {26, 30}, {26, 28}, {25, 29}, {27, 31}, {27, 29}, {25, 26}, {27, 28}, {29, 30}, {16, 24}, {20, 28}, {20, 24}, {18, 26}, {22, 30}, {22, 26}, {18, 20}, {22, 24}, {26, 28}, {17, 25}, {21, 29}, {21, 25}, {19, 27}, {23, 31}, {23, 27}, {19, 21}, {23, 25}, {27, 29}, {17, 18}, {19, 20}, {21, 22}, {23, 24}, {25, 26}, {27, 28}, {29, 30}, {0, 16}, {8, 24}, {8, 16}, {4, 20}, {12, 28}, {12, 20}, {4, 8}, {12, 16}, {20, 24}, {2, 18}, {10, 26}, {10, 18}, {6, 22}, {14, 30}, {14, 22}, {6, 10}, {14, 18}, {22, 26}, {2, 4}, {6, 8}, {10, 12}, {14, 16}, {18, 20}, {22, 24}, {26, 28}, {1, 17}, {9, 25}, {9, 17}, {5, 21}, {13, 29}, {13, 21}, {5, 9}, {13, 17}, {21, 25}, {3, 19}, {11, 27}, {11, 19}, {7, 23}, {15, 31}, {15, 23}, {7, 11}, {15, 19}, {23, 27}, {3, 5}, {7, 9}, {11, 13}, {15, 17}, {19, 21}, {23, 25}, {27, 29}, {1, 2}, {3, 4}, {5, 6}, {7, 8}, {9, 10}, {11, 12}, {13, 14}, {15, 16}, {17, 18}, {19, 20}, {21, 22}, {23, 24}, {25, 26}, {27, 28}, {29, 30}};
#pragma unroll
    for (int k = 0; k < 191; ++k) CEX(a, Pn[k][0], Pn[k][1]);
}
template <int A, int B, int LEN> __device__ __forceinline__ void merge_top16(int (&a)[LEN]) {
#pragma unroll
    for (int i = 0; i < 16; ++i) a[A + i] = max(a[A + i], a[B + 15 - i]);
    bitonic_merge16_desc<A, LEN>(a);
}
template <int LEN> __device__ __forceinline__ void pair_top16(int (&a)[LEN]) {
    int lo[16], up[16];
#pragma unroll
    for (int i = 0; i < 16; ++i) { const auto rr = __builtin_amdgcn_permlane32_swap((unsigned)a[i], (unsigned)a[i], false, false); lo[i] = (int)rr[0]; up[i] = (int)rr[1]; }
#pragma unroll
    for (int i = 0; i < 16; ++i) a[i] = max(lo[i], up[15 - i]);
    bitonic_merge16_desc<0, LEN>(a);
}
__device__ __forceinline__ void topk_half(const bf16x8 (&qf)[8], const LAS bf16* Kh, int r, int hh, int (&key)[64]) {
#pragma unroll
    for (int nt = 0; nt < 4; ++nt) {
        f32x16 sc;
#pragma unroll
        for (int i = 0; i < 16; ++i) sc[i] = 0.f;
#pragma unroll
        for (int kk = 0; kk < 8; ++kk) { const bf16x8 a = *(const LAS bf16x8*)(Kh + (32 * nt + r) * TK_LDK + 16 * kk + 8 * hh); sc = MFMA32(a, qf[kk], sc); }
#pragma unroll
        for (int i = 0; i < 16; ++i) key[nt * 16 + i] = (mono_key(sc[i]) & ~127) | (127 - (32 * nt + crow(i, hh)));
    }
    oem_sort16_desc<0, 64>(key); oem_sort16_desc<16, 64>(key); oem_sort16_desc<32, 64>(key); oem_sort16_desc<48, 64>(key);
    merge_top16<0, 16, 64>(key); merge_top16<32, 48, 64>(key); merge_top16<0, 32, 64>(key);
    pair_top16<64>(key);
}
__device__ __forceinline__ void topk_finish(const LAS int* scr, int hh, float rstd, int* IDX, float* GATE, int t, int hd) {
    const LAS int* la = scr + hh * 16; const LAS int* lb = scr + (1 - hh) * 16;
    float va[4], vb[16];
#pragma unroll
    for (int i = 0; i < 4; ++i) va[i] = unmono(la[i] & ~127);
#pragma unroll
    for (int j = 0; j < 16; ++j) vb[j] = unmono(lb[j] & ~127);
    int ck[32];
    {
        int q = 0;
#pragma unroll
        for (int i = 0; i < 4; ++i)
#pragma unroll
            for (int j = i; j < 16; ++j) if ((i + 1) * (j + 1) <= 16) {
                const int pos = hh ? (j * 16 + i) : (i * 16 + j);
                int k = (mono_key(va[i] + vb[j]) & ~255) | (255 - pos);
                if (i == j && hh) k = (int)0x80000000;
                ck[q++] = k; }
#pragma unroll
        for (int i = 27; i < 32; ++i) ck[i] = (int)0x80000000;
    }
    oem_sort32_desc<32>(ck);
    pair_top16<32>(ck);
    const float vmax = unmono(ck[0] & ~255) * rstd;
    float ev[8]; int id[8]; float esum = 0.f; const int hm = -hh;
#pragma unroll
    for (int q = 0; q < 8; ++q) { const int wk = ck[q] ^ ((ck[q] ^ ck[8 + q]) & hm); const int pos = 255 - (wk & 255);
        const int n1 = 127 - (scr[pos >> 4] & 127), n2 = 127 - (scr[16 + (pos & 15)] & 127);
        id[q] = n1 * 128 + n2;
        ev[q] = exp2f((unmono(wk & ~255) * rstd - vmax) * LOG2E); esum += ev[q]; }
    esum = sum_halves(esum);
    const float inv = 1.f / esum;
    int4* ip = (int4*)(IDX + ((size_t)t * 8 + hd) * 16 + hh * 8); float4* gp = (float4*)(GATE + ((size_t)t * 8 + hd) * 16 + hh * 8);
    ip[0] = make_int4(id[0], id[1], id[2], id[3]); ip[1] = make_int4(id[4], id[5], id[6], id[7]);
    gp[0] = make_float4(ev[0] * inv, ev[1] * inv, ev[2] * inv, ev[3] * inv); gp[1] = make_float4(ev[4] * inv, ev[5] * inv, ev[6] * inv, ev[7] * inv);
}
constexpr int TQ_QH = 69632, TQ_QP = 272;
struct OneUnit { pg8::StaticOrder S; int i;
    __device__ __forceinline__ bool next(int j, pg8::Unit& u) const { return j == 0 ? S.next(i, u) : false; }
    __device__ __forceinline__ void a_ready(const pg8::Unit&) const {}
    __device__ __forceinline__ void done(const pg8::Unit&) const {}
};
struct EpiQTopk {
    static constexpr bool PERM = true, AFTER_DRAIN = true;
    const unsigned char* KB; const float* SSQ; int* IDX; float* GATE;
    __device__ __forceinline__ void dump(const pg8::f32x4 (&acc)[2][2][4][2], int bj, LAS unsigned char* QH, int wr, int wc, int fr, int fq) const {
#pragma unroll
        for (int ai = 0; ai < 2; ++ai)
#pragma unroll
            for (int m = 0; m < 4; ++m) { const pg8::f32x4 v0 = bj ? acc[ai][1][m][0] : acc[ai][0][m][0], v1 = bj ? acc[ai][1][m][1] : acc[ai][0][m][1];
                v4u w; w.x = cvtpk(v0[0], v0[1]); w.y = cvtpk(v0[2], v0[3]); w.z = cvtpk(v1[0], v1[1]); w.w = cvtpk(v1[2], v1[3]);
                *(LAS v4u*)(QH + (128 * ai + 64 * wr + 16 * m + fr) * TQ_QP + (32 * wc + 8 * fq) * 2) = w; }
    }
    __device__ __forceinline__ void fused(const pg8::f32x4 (&acc)[2][2][4][2], const pg8::Unit& u, int wr, int wc, int fr, int fq, LAS unsigned char* L, int wid, int lane) const {
        LAS bf16* K1 = (LAS bf16*)L; LAS bf16* K2 = (LAS bf16*)(L + TK_K2); LAS unsigned char* QH = L + TQ_QH;
        const int tid_ = wid * 64 + lane, r = lane & 31, hh = lane >> 5;
        { v4u kq[8];
#pragma unroll
          for (int q = 0; q < 8; ++q) kq[q] = ((const v4u*)KB)[tid_ + 512 * q];
          dump(acc, 0, QH, wr, wc, fr, fq);
#pragma unroll
          for (int q = 0; q < 8; ++q) { const int j = tid_ + 512 * q, n = (j >> 4) & 127, k8 = j & 15; *(LAS v4u*)(((j >> 11) ? K2 : K1) + n * TK_LDK + 8 * k8) = kq[q]; } }
        __syncthreads();
        const int t = u.pm * 256 + 32 * wid + r;
        float rstd;
        { const float4* sp = (const float4*)(SSQ + (size_t)t * 16); const float4 a = sp[0], b = sp[1], c = sp[2], d = sp[3];
          rstd = rsqrtf(((a.x + a.y + a.z + a.w) + (b.x + b.y + b.z + b.w) + (c.x + c.y + c.z + c.w) + (d.x + d.y + d.z + d.w)) * (1.f / 1024.f) + EPS); }
        const LAS unsigned char* qrow = QH + (32 * wid + r) * TQ_QP + 16 * hh;
        int key[64], list0[16];
        { bf16x8 qf[8];
#pragma unroll
          for (int kk = 0; kk < 8; ++kk) qf[kk] = *(const LAS bf16x8*)(qrow + 32 * kk);
          topk_half(qf, K1, r, hh, key);
#pragma unroll
          for (int i = 0; i < 16; ++i) list0[i] = key[i]; }
        __syncthreads();
        dump(acc, 1, QH, wr, wc, fr, fq);
        __syncthreads();
        { bf16x8 qf[8];
#pragma unroll
          for (int kk = 0; kk < 8; ++kk) qf[kk] = *(const LAS bf16x8*)(qrow + 32 * kk);
          topk_half(qf, K2, r, hh, key); }
        LAS int* scr = (LAS int*)(QH + 32 * wid * TQ_QP) + r * TK_SP;
        LDS_WAIT();
        if (hh == 0) {
#pragma unroll
            for (int i = 0; i < 16; ++i) { scr[i] = list0[i]; scr[16 + i] = key[i]; } }
        topk_finish(scr, hh, rstd, IDX, GATE, t, u.pn);
        __syncthreads();
    }
};

constexpr int AT_KP = 72, AT_VP = 264;
constexpr int AT_K = 0, AT_VT = 36864, AT_BT = 36864 + 33792;
__device__ __forceinline__ void attn_phase(Frame& F, const Ptrs& P) {
    const bf16* PROJ = (const bf16*)(P.ws + WS_PROJ); bf16* CAT = (bf16*)(P.ws + WS_XN);
    LAS unsigned char* L = F.lds + RING_OFF;
    LAS bf16* Ks = (LAS bf16*)(L + AT_K); LAS bf16* Vt = (LAS bf16*)(L + AT_VT); LAS float* btab = (LAS float*)(L + AT_BT);
    const int lane = lane_id(), tid_ = F.wave * 64 + lane, r = lane & 31, hh = lane >> 5;
    for (int u = F.vcu; u < 256; u += F.G) {
        const int hkv = u & 1, n = (u >> 1) & 31, b = u >> 6;
        const int trow0 = b * SEQ + n * 128;
        v4u kvq[4], vvq[4];
#pragma unroll
        for (int q = 0; q < 4; ++q) { const int i = tid_ + 512 * q, kj = i >> 3, ch = i & 7; const bool ok = (n > 0) || (kj >= 128);
            kvq[q] = (v4u){0u, 0u, 0u, 0u}; vvq[q] = (v4u){0u, 0u, 0u, 0u};
            if (ok) { const bf16* rowp = PROJ + (size_t)(trow0 - 128 + kj) * NPROJ + hkv * 64 + ch * 8; kvq[q] = *(const v4u*)(rowp + PJ_K); vvq[q] = *(const v4u*)(rowp + PJ_V); } }
#pragma unroll
        for (int q = 0; q < 4; ++q) {
            const int i = tid_ + 512 * q, kj = i >> 3, ch = i & 7;
            const v4u kv = kvq[q], vv = vvq[q];
            *(LAS v4u*)(Ks + kj * AT_KP + ch * 8) = kv;
            LAS bf16* vp = Vt + (ch * 8) * AT_VP + kj;
            vp[0] = (bf16)(vv.x & 0xffffu); vp[AT_VP] = (bf16)(vv.x >> 16); vp[2 * AT_VP] = (bf16)(vv.y & 0xffffu); vp[3 * AT_VP] = (bf16)(vv.y >> 16);
            vp[4 * AT_VP] = (bf16)(vv.z & 0xffffu); vp[5 * AT_VP] = (bf16)(vv.z >> 16); vp[6 * AT_VP] = (bf16)(vv.w & 0xffffu); vp[7 * AT_VP] = (bf16)(vv.w >> 16);
        }
        { const float* BT = (const float*)(P.ws + WS_BTAB) + hkv * 768;
          const float b0 = BT[tid_], b1 = (tid_ < 256) ? BT[512 + tid_] : 0.f;
          btab[tid_] = b0; if (tid_ < 256) btab[512 + tid_] = b1; }
        __syncthreads();
        const int g = F.wave & 3, h = hkv * 4 + g;
        const float sink2 = P.sinks[h] * LOG2E;
        bf16x8 qf[4], qfn[4];
#pragma unroll
        for (int kk = 0; kk < 4; ++kk) { qf[kk] = *(const bf16x8*)(PROJ + (size_t)(trow0 + 32 * ((F.wave >> 2) * 2) + r) * NPROJ + h * 64 + 16 * kk + 8 * hh);
            qfn[kk] = *(const bf16x8*)(PROJ + (size_t)(trow0 + 32 * ((F.wave >> 2) * 2 + 1) + r) * NPROJ + h * 64 + 16 * kk + 8 * hh); }
#pragma unroll 1
        for (int qq = 0; qq < 2; ++qq) {
            const int qt = (F.wave >> 2) * 2 + qq, t = trow0 + 32 * qt + r;
            f32x16 sc[5];
#pragma unroll
            for (int j = 0; j < 5; ++j) {
#pragma unroll
                for (int i = 0; i < 16; ++i) sc[j][i] = 0.f;
#pragma unroll
                for (int kk = 0; kk < 4; ++kk) { const bf16x8 a = *(const LAS bf16x8*)(Ks + (32 * (qt + j) + r) * AT_KP + 16 * kk + 8 * hh); sc[j] = MFMA32(a, qf[kk], sc[j]); }
            }
            float m = sink2;
            const LAS float* bt = btab + g * 192 + 160 + r - 4 * hh;
#pragma unroll
            for (int j = 0; j < 5; ++j) {
                const bool tile_ok = (n > 0) || (qt + j >= 4);
#pragma unroll
                for (int i = 0; i < 16; ++i) { const int dist = 128 + r - (32 * j + crow(i, hh));
                    const bool ok = tile_ok && (j == 0 ? dist < 128 : (j == 4 ? dist >= 0 : true));
                    const float s = sc[j][i] * (0.125f * LOG2E) + bt[-(32 * j + (i & 3) + 8 * (i >> 2))];
                    sc[j][i] = ok ? s : -INFINITY; m = fmaxf(m, sc[j][i]); }
            }
            m = max_halves(m);
            float l = 0.f;
#pragma unroll
            for (int j = 0; j < 5; ++j)
#pragma unroll
                for (int i = 0; i < 16; ++i) { sc[j][i] = exp2f(sc[j][i] - m); l += sc[j][i]; }
            l = sum_halves(l);
            l += exp2f(sink2 - m);
            const float inv = 1.f / l;
            f32x16 o[2];
#pragma unroll
            for (int i = 0; i < 16; ++i) { o[0][i] = 0.f; o[1][i] = 0.f; }
#pragma unroll
            for (int j = 0; j < 5; ++j)
#pragma unroll
                for (int sg = 0; sg < 2; ++sg) {
                    const bf16x8 pf = pack8(sc[j], sg);
#pragma unroll
                    for (int dt = 0; dt < 2; ++dt) {
                        const LAS bf16* vb = Vt + (32 * dt + r) * AT_VP + 32 * (qt + j) + 16 * sg + 4 * hh;
                        const s16x4 lo = *(const LAS s16x4*)(vb), hi = *(const LAS s16x4*)(vb + 8);
                        o[dt] = MFMA32(__builtin_shufflevector(lo, hi, 0, 1, 2, 3, 4, 5, 6, 7), pf, o[dt]);
                    }
                }
            bf16* op = CAT + (size_t)t * DM + h * 64 + 4 * hh;
#pragma unroll
            for (int dt = 0; dt < 2; ++dt)
#pragma unroll
                for (int g4 = 0; g4 < 4; ++g4)
                    *(unsigned long long*)(op + 32 * dt + 8 * g4) = (unsigned long long)cvtpk(o[dt][4 * g4] * inv, o[dt][4 * g4 + 1] * inv) | ((unsigned long long)cvtpk(o[dt][4 * g4 + 2] * inv, o[dt][4 * g4 + 3] * inv) << 32);
#pragma unroll
            for (int kk = 0; kk < 4; ++kk) qf[kk] = qfn[kk];
        }
        __syncthreads();
    }
}
struct Args { Ptrs p; };
__global__ void __launch_bounds__(NWAVES * 64, 2) hymba_fwd(Args args) {
    extern __shared__ __attribute__((aligned(16))) unsigned char lds[];
    const Ptrs& P = args.p;
    Frame F;
    F.lds = (LAS unsigned char*)lds;
    F.MISC = (volatile LAS unsigned*)(F.lds + MISC_OFF);
    F.wave = __builtin_amdgcn_readfirstlane(threadIdx.x >> 6);
    F.G = gridDim.x; { const int bx = blockIdx.x; F.vcu = (F.G % 8 == 0) ? (bx % 8) * (F.G / 8) + bx / 8 : bx; }
    F.ctl = (gu32*)(P.ws + WS_CTL);
    for (int u = threadIdx.x; u < (LDS_BYTES - LDSCTL_OFF) / 4; u += NWAVES * 64) ((LAS unsigned*)(F.lds + LDSCTL_OFF))[u] = 0u;
    __syncthreads();
    XcdBarrier bar = xcd_barrier_post((unsigned*)(F.ctl + CW_BAR), F.MISC + 8);
#define GRID_BAR() xcd_barrier(bar)

    bf16* XN = (bf16*)(P.ws + WS_XN); bf16* PROJ = (bf16*)(P.ws + WS_PROJ); bf16* HB = (bf16*)(P.ws + WS_ST);
    p0_prologue(F, P);
    GRID_BAR();
    { pg8::Gemm g{XN, (const bf16*)(P.ws + WS_WIN), T_, NPROJ, DM, F.wave}; pg8::StaticOrder S; S.init(T_, NPROJ, F.G, (int)blockIdx.x);
      pg8::EpiBf16<0> E{PROJ, NPROJ, nullptr, 0, 0, 1.f};
      pg8::gemm_phase<pg8::EpiBf16<0>, pg8::StaticOrder, PG8_ALIGN, PG8_SP2>(F.lds + RING_OFF, g, S, E); }
    if (F.G == 256 && blockIdx.x >= 64) p1_slack(F, P, ((int)blockIdx.x - 64) * NWAVES + F.wave, 192 * NWAVES);
    else if (F.G != 256) p1_slack(F, P, F.vcu * NWAVES + F.wave, F.G * NWAVES);
    GRID_BAR();
    ssd_s1(F, P);
    xcd_arrive(bar, F.MISC + 14);
    attn_phase(F, P);
    xcd_wait(bar, F.MISC + 14);
    ssd_s2(F, P);
    GRID_BAR();
    ssd_s3(F, P);
    GRID_BAR();
    { pg8::Gemm g{XN, (const bf16*)(P.ws + WS_WOUT), T_, DM, DM, F.wave}; pg8::StaticOrder S; S.init(T_, DM, F.G, (int)blockIdx.x);
      EpiResH E{P.x, HB, (float*)(P.ws + WS_SSQ)};
      pg8::gemm_phase<EpiResH, pg8::StaticOrder, PG8_ALIGN, PG8_SP2>(F.lds + RING_OFF, g, S, E); }
    GRID_BAR();
    { pg8::Gemm g{HB, (const bf16*)(P.ws + WS_WQ), T_, 2048, DM, F.wave}; pg8::StaticOrder S; S.init(T_, 2048, F.G, (int)blockIdx.x);
      EpiQTopk E{P.ws + WS_KEYB, (const float*)(P.ws + WS_SSQ), (int*)(P.ws + WS_IDX), (float*)(P.ws + WS_GATE)};
#pragma unroll 1
      for (int ui = 0; ui < 64; ++ui) { pg8::Unit u0; if (!S.next(ui, u0)) break;
          OneUnit S1{S, ui};
          pg8::gemm_phase<EpiQTopk, OneUnit, PG8_ALIGN, PG8_SP2>(F.lds + RING_OFF, g, S1, E); } }
    h_quant_rows(F, P);
    GRID_BAR();
    { const PeerPlace pp = peer_place(F);
      peer_down(F, P, pp); }
    GRID_BAR();
    peer_up_tm(F, P);
}

extern "C" void kernel_launch(void* const* d_in, const int* in_sizes, int n_in, void* d_out, int out_size, void* d_ws, size_t ws_size, hipStream_t stream) {
    static int grid = 0;
    if (grid == 0) {
        if (n_in != 19 || out_size != T_ * DM || ws_size < WS_END) { fprintf(stderr, "kernel_launch: unexpected shapes (n_in %d, out %d, ws %zu)\n", n_in, out_size, ws_size); grid = -1; return; }
        int dev = 0, cus = 0, per_cu = 0;
        if (hipGetDevice(&dev) != hipSuccess || hipDeviceGetAttribute(&cus, hipDeviceAttributeMultiprocessorCount, dev) != hipSuccess) { grid = -1; return; }
        if (hipFuncSetAttribute((const void*)hymba_fwd, hipFuncAttributeMaxDynamicSharedMemorySize, LDS_BYTES) != hipSuccess) { fprintf(stderr, "kernel_launch: hipFuncSetAttribute failed\n"); grid = -1; return; }
        if (hipOccupancyMaxActiveBlocksPerMultiprocessor(&per_cu, (const void*)hymba_fwd, NWAVES * 64, LDS_BYTES) != hipSuccess || per_cu < 1) { fprintf(stderr, "kernel_launch: occupancy query says %d blocks per CU\n", per_cu); grid = -1; (void)hipGetLastError(); return; }
        grid = cus;
    }
    if (grid < 0) return;
    (void)hipMemsetAsync((char*)d_ws + WS_CTL, 0, CTL_ZERO_BYTES, stream);
    Args a{};
    const float** pp = (const float**)&a.p;
    for (int i = 0; i < 19; ++i) pp[i] = (const float*)d_in[i];
    a.p.out = (float*)d_out; a.p.ws = (unsigned char*)d_ws;
    hipLaunchKernelGGL(hymba_fwd, dim3(grid), dim3(NWAVES * 64), LDS_BYTES, stream, a);
}
```

```cpp
#include <hip/hip_runtime.h>
#include <cstdio>
#include <cstdint>
#include <math.h>
namespace pg8 {
#define PG8_LAS __attribute__((address_space(3)))
typedef unsigned short bf16_t;
typedef short bf16x8 __attribute__((ext_vector_type(8)));
typedef float f32x4 __attribute__((ext_vector_type(4)));
typedef unsigned u32x4 __attribute__((ext_vector_type(4)));
constexpr int BM = 256, BK = 64, HALF = 128, HTB = HALF * BK * 2  , STAGE_BYTES = 8 * HTB, NXCD = 8, WGM = 8;

__host__ __device__ __forceinline__ int lds_byte(int r, int c) { const int st = (r >> 4) * 2 + (c >> 5), rr = r & 15, cc = c & 31, ob = rr * 64 + cc * 2; return st * 1024 + (ob ^ (((ob >> 9) & 1) << 5)); }
__host__ __device__ __forceinline__ void stage_rc(int b, int& R, int& C) { const int st = b / 1024, sb = b % 1024, swz = sb ^ (((sb >> 9) & 1) << 5); R = (st >> 1) * 16 + swz / 64; C = (st & 1) * 32 + (swz % 64) / 2; }
__host__ __device__ __forceinline__ int perm32(int rho) { const int n = rho >> 4, i = rho & 15; return 8 * (i >> 2) + 4 * n + (i & 3); }

struct Unit { int pm, pn; };
struct Gemm { const bf16_t* A; const bf16_t* Bt; int M, N, K, wave; };

struct StaticOrder {
    int nM, nN, nwg, G, c;
    __host__ __device__ void init(int M, int N, int G_, int c_) { nM = M / BM; nN = N / BM; nwg = nM * nN; G = G_; c = c_; }
    __host__ __device__ bool next(int i, Unit& u) const {
        const long L = (long)i * G + c; if (L >= nwg) return false;
        int wgid = (int)L; { const int q = nwg / NXCD, r = nwg % NXCD, xcd = wgid % NXCD, off = wgid / NXCD; wgid = (xcd < r ? xcd * (q + 1) : r * (q + 1) + (xcd - r) * q) + off; }
        const int nig = WGM * nN, gid = wgid / nig, fm = gid * WGM, gsz = (nM - fm) < WGM ? (nM - fm) : WGM;
        u.pm = fm + ((wgid % nig) % gsz); u.pn = (wgid % nig) / gsz; return true;
    }
    __device__ __forceinline__ void a_ready(const Unit&) const {}
    __device__ __forceinline__ void done(const Unit&) const {}
};

__device__ __forceinline__ unsigned cvt_pk_bf16(float lo, float hi) { unsigned r; asm volatile("v_cvt_pk_bf16_f32 %0, %1, %2" : "=v"(r) : "v"(lo), "v"(hi)); return r; }
typedef float f32x2 __attribute__((ext_vector_type(2)));
__device__ __forceinline__ f32x2 gelu_pk(f32x2 v) {
    const f32x2 av = __builtin_elementwise_abs(v), d = av * 0.2316418882f + 1.0f;
    f32x2 t; t.x = __builtin_amdgcn_rcpf(d.x); t.y = __builtin_amdgcn_rcpf(d.y);
    f32x2 q = t * 0.5307027145f + (-0.7265760135f); q = q * t + 0.7107068705f; q = q * t + (-0.142248368f); q = q * t + 0.127414796f; q = q * t;
    const f32x2 s = (v * v) * (-0.72134752044f);
    f32x2 e; e.x = __builtin_amdgcn_exp2f(s.x); e.y = __builtin_amdgcn_exp2f(s.y);
    const f32x2 m = v * (q * e), r = v - m;
    f32x2 o; o.x = v.x < 0.f ? m.x : r.x; o.y = v.y < 0.f ? m.y : r.y; return o;
}

template <int ACT  > struct EpiBf16 {
    static constexpr bool PERM = true, AFTER_DRAIN = false; static_assert(ACT == 0 || ACT == 1, "EpiBf16: ACT is 0 (none) or 1 (gelu_pk)");
    bf16_t* O; int ldc; const float* bias; int split_cols; size_t split_stride; float scale0;
    __device__ __forceinline__ void operator()(const f32x4 (&acc)[2][2][4][2], const Unit& u, int wr, int wc, int fr, int fq) const {
        const int row0 = u.pm * BM + wr * 64 + fr; int colt = u.pn * BM; bf16_t* base = O;
        float sc = 1.f; if (split_cols) { const int t = colt / split_cols; base += (size_t)t * split_stride; colt -= t * split_cols; if (t == 0) sc = scale0; }
        const int col0 = colt + wc * 32 + 8 * fq, bcol0 = u.pn * BM + wc * 32 + 8 * fq;
        f32x4 bv[2][2];
#pragma unroll
        for (int bj = 0; bj < 2; ++bj)
#pragma unroll
            for (int n = 0; n < 2; ++n) bv[bj][n] = bias ? *(const f32x4*)(bias + bcol0 + bj * HALF + 4 * n) : (f32x4){0.f, 0.f, 0.f, 0.f};
#pragma unroll
        for (int ai = 0; ai < 2; ++ai)
#pragma unroll
            for (int m = 0; m < 4; ++m) { bf16_t* rowp = base + (size_t)(row0 + ai * HALF + m * 16) * ldc + col0;
#pragma unroll
                for (int bj = 0; bj < 2; ++bj) { f32x4 v0 = acc[ai][bj][m][0] + bv[bj][0], v1 = acc[ai][bj][m][1] + bv[bj][1];
                    if (ACT == 1) { f32x2 a = gelu_pk((f32x2){v0[0], v0[1]}), b = gelu_pk((f32x2){v0[2], v0[3]}), c = gelu_pk((f32x2){v1[0], v1[1]}), d = gelu_pk((f32x2){v1[2], v1[3]});
                        v0 = (f32x4){a.x, a.y, b.x, b.y}; v1 = (f32x4){c.x, c.y, d.x, d.y}; }
                    v0 = v0 * sc; v1 = v1 * sc; u32x4 w; w.x = cvt_pk_bf16(v0[0], v0[1]); w.y = cvt_pk_bf16(v0[2], v0[3]); w.z = cvt_pk_bf16(v1[0], v1[1]); w.w = cvt_pk_bf16(v1[2], v1[3]);
                    *(u32x4*)(rowp + bj * HALF) = w; } }
    }
};
template <class Epi, class Sched, bool ALIGN_EPI = false, bool SP2 = false>
__device__ __forceinline__ void gemm_phase(PG8_LAS unsigned char* lds, const Gemm g, const Sched& S, const Epi& E) {
    int lane_l; asm volatile("v_mbcnt_lo_u32_b32 %0, -1, 0\n\tv_mbcnt_hi_u32_b32 %0, -1, %0" : "=v"(lane_l));
    const int wid = g.wave, lane = lane_l, tid = wid * 64 + lane,
              wr = wid >> 2, wc = wid & 3, fr = lane & 15, fq = lane >> 4;
    const int K = g.K, nt = K / BK;
    unsigned voffA[2], voffB[2];
#pragma unroll
    for (int i = 0; i < 2; ++i) { int R, C; stage_rc(tid * 16 + i * 8192, R, C); const int Rb = Epi::PERM ? ((R & ~31) + perm32(R & 31)) : R;
        voffA[i] = (unsigned)(R * K + C) * 2u; voffB[i] = (unsigned)(Rb * K + C) * 2u; }
    const size_t kstep = (size_t)(BK * 2);
    const size_t hstep = (size_t)HALF * K * 2;
    const size_t tstep = 2 * hstep;
    const unsigned ldsw = (unsigned)wid * 1024u;
    const int aoff = lds_byte(wr * 64 + fr, fq * 8), boff = lds_byte(wc * 32 + fr, fq * 8);
#define PG8_SA(b, h) (((b) * 2 + (h)) * HTB)
#define PG8_SB(b, h) ((4 + (b) * 2 + (h)) * HTB)
#define PG8_STAGE(bufoff, gbase, voff) do { _Pragma("unroll") for (int _i = 0; _i < 2; ++_i) \
        __builtin_amdgcn_global_load_lds((const unsigned*)((const char*)(gbase) + (voff)[_i]), (PG8_LAS unsigned*)(lds + (bufoff) + ldsw + _i * 8192), 16, 0, 0); } while (0)
#define PG8_LDA(dst, b, h) do { _Pragma("unroll") for (int m = 0; m < 4; ++m) _Pragma("unroll") for (int k = 0; k < 2; ++k) dst[m][k] = *(const PG8_LAS bf16x8*)(lds + PG8_SA(b, h) + aoff + m * 2048 + k * 1024); } while (0)
#define PG8_LDB(dst, b, h) do { _Pragma("unroll") for (int n = 0; n < 2; ++n) _Pragma("unroll") for (int k = 0; k < 2; ++k) dst[n][k] = *(const PG8_LAS bf16x8*)(lds + PG8_SB(b, h) + boff + n * 2048 + k * 1024); } while (0)
#define PG8_MMA(ai, bj, At, Bt) do { __builtin_amdgcn_s_setprio(1); _Pragma("unroll") for (int m = 0; m < 4; ++m) _Pragma("unroll") for (int n = 0; n < 2; ++n) _Pragma("unroll") for (int k = 0; k < 2; ++k) \
        acc[ai][bj][m][n] = __builtin_amdgcn_mfma_f32_16x16x32_bf16(Bt[n][k], At[m][k], acc[ai][bj][m][n], 0, 0, 0); __builtin_amdgcn_s_setprio(0); } while (0)
#define PG8_WAIT_V(n) asm volatile("s_waitcnt vmcnt(" #n ")" ::: "memory")
#define PG8_WAIT_L(n) asm volatile("s_waitcnt lgkmcnt(" #n ")" ::: "memory")
#define PG8_BAR __builtin_amdgcn_s_barrier()
#define PG8_SCHED __builtin_amdgcn_sched_barrier(0)
    Unit cur, nxt; int ui = 0;
    if (!S.next(0, cur)) return;
    f32x4 acc[2][2][4][2];
#pragma unroll
    for (int a = 0; a < 2; ++a)
#pragma unroll
        for (int b = 0; b < 2; ++b)
#pragma unroll
            for (int m = 0; m < 4; ++m)
#pragma unroll
                for (int n = 0; n < 2; ++n) acc[a][b][m][n] = (f32x4){0.f, 0.f, 0.f, 0.f};
    bf16x8 At[4][2], B0[2][2], B1[2][2];
    const char* cA = (const char*)g.A + (size_t)cur.pm * tstep; const char* cB = (const char*)g.Bt + (size_t)cur.pn * tstep;
    S.a_ready(cur);
    if constexpr (SP2) {
        PG8_STAGE(PG8_SB(0, 0), cB, voffB); PG8_STAGE(PG8_SB(0, 1), cB + hstep, voffB); PG8_STAGE(PG8_SA(0, 0), cA, voffA); PG8_STAGE(PG8_SA(0, 1), cA + hstep, voffA);
        if (wr == 1) PG8_BAR;
        PG8_WAIT_V(2); PG8_BAR;
        PG8_STAGE(PG8_SB(1, 0), cB + kstep, voffB); PG8_STAGE(PG8_SA(1, 0), cA + kstep, voffA); PG8_STAGE(PG8_SB(1, 1), cB + hstep + kstep, voffB);
        PG8_WAIT_V(6); PG8_BAR;
    } else {
        PG8_STAGE(PG8_SB(0, 0), cB, voffB); PG8_STAGE(PG8_SA(0, 0), cA, voffA); PG8_STAGE(PG8_SB(0, 1), cB + hstep, voffB); PG8_STAGE(PG8_SA(0, 1), cA + hstep, voffA);
        if (wr == 1) PG8_BAR;
        PG8_WAIT_V(4); PG8_BAR;
        PG8_STAGE(PG8_SB(1, 0), cB + kstep, voffB); PG8_STAGE(PG8_SA(1, 0), cA + kstep, voffA); PG8_STAGE(PG8_SB(1, 1), cB + hstep + kstep, voffB);
        PG8_WAIT_V(6); PG8_BAR;
    }
    for (;;) {
        const bool has_next = S.next(ui + 1, nxt);
        const char* nA = has_next ? (const char*)g.A + (size_t)nxt.pm * tstep : cA; const char* nB = has_next ? (const char*)g.Bt + (size_t)nxt.pn * tstep : cB;
        for (int t = 0; t < nt; t += 2) {
            const bool last = (t == nt - 2);
            const char* a1 = cA + (size_t)(t + 1) * kstep;
            const char* a2 = last ? nA : cA + (size_t)(t + 2) * kstep; const char* b2 = last ? nB : cB + (size_t)(t + 2) * kstep;
            const char* a3 = a2 + kstep; const char* b3 = b2 + kstep;
            if (last && has_next) S.a_ready(nxt);
            if constexpr (SP2) {
            PG8_LDB(B0, 0, 0); PG8_LDB(B1, 0, 1); PG8_SCHED; PG8_LDA(At, 0, 0); PG8_STAGE(PG8_SA(1, 1), a1 + hstep, voffA);
            PG8_WAIT_V(8); PG8_WAIT_L(0); PG8_BAR; PG8_MMA(0, 0, At, B0); PG8_MMA(0, 1, At, B1); PG8_BAR; PG8_SCHED;
            PG8_LDA(At, 0, 1); PG8_STAGE(PG8_SB(0, 0), b2, voffB); PG8_STAGE(PG8_SB(0, 1), b2 + hstep, voffB); PG8_STAGE(PG8_SA(0, 0), a2, voffA);
            PG8_WAIT_V(8); PG8_WAIT_L(0); PG8_BAR; PG8_MMA(1, 0, At, B0); PG8_MMA(1, 1, At, B1); PG8_BAR; PG8_SCHED;
            PG8_LDB(B0, 1, 0); PG8_LDB(B1, 1, 1); PG8_SCHED; PG8_LDA(At, 1, 0); PG8_STAGE(PG8_SA(0, 1), a2 + hstep, voffA);
            PG8_WAIT_V(8); PG8_WAIT_L(0); PG8_BAR; PG8_MMA(0, 0, At, B0); PG8_MMA(0, 1, At, B1); PG8_BAR; PG8_SCHED;
            PG8_LDA(At, 1, 1); PG8_STAGE(PG8_SB(1, 0), b3, voffB); PG8_STAGE(PG8_SB(1, 1), b3 + hstep, voffB); PG8_STAGE(PG8_SA(1, 0), a3, voffA);
            PG8_WAIT_V(8); PG8_WAIT_L(0); PG8_BAR; PG8_MMA(1, 0, At, B0); PG8_MMA(1, 1, At, B1); PG8_BAR; PG8_SCHED;
            } else {
            PG8_LDB(B0, 0, 0); PG8_SCHED; PG8_LDA(At, 0, 0); PG8_STAGE(PG8_SA(1, 1), a1 + hstep, voffA);
            PG8_WAIT_L(8); PG8_BAR; PG8_WAIT_L(0); PG8_MMA(0, 0, At, B0); PG8_BAR; PG8_SCHED;
            PG8_LDB(B1, 0, 1); PG8_STAGE(PG8_SB(0, 0), b2, voffB);
            PG8_BAR; PG8_WAIT_L(0); PG8_MMA(0, 1, At, B1); PG8_BAR;
            PG8_LDA(At, 0, 1); PG8_STAGE(PG8_SA(0, 0), a2, voffA);
            PG8_BAR; PG8_WAIT_L(0); PG8_MMA(1, 0, At, B0); PG8_BAR; PG8_SCHED;
            PG8_STAGE(PG8_SB(0, 1), b2 + hstep, voffB);
            PG8_WAIT_V(6); PG8_BAR; PG8_MMA(1, 1, At, B1); PG8_BAR;
            PG8_LDB(B0, 1, 0); PG8_SCHED; PG8_LDA(At, 1, 0); PG8_STAGE(PG8_SA(0, 1), a2 + hstep, voffA);
            PG8_WAIT_L(8); PG8_BAR; PG8_WAIT_L(0); PG8_MMA(0, 0, At, B0); PG8_BAR; PG8_SCHED;
            PG8_LDB(B1, 1, 1); PG8_STAGE(PG8_SB(1, 0), b3, voffB);
            PG8_BAR; PG8_WAIT_L(0); PG8_MMA(0, 1, At, B1); PG8_BAR;
            PG8_LDA(At, 1, 1); PG8_STAGE(PG8_SA(1, 0), a3, voffA);
            PG8_BAR; PG8_WAIT_L(0); PG8_MMA(1, 0, At, B0); PG8_BAR; PG8_SCHED;
            PG8_STAGE(PG8_SB(1, 1), b3 + hstep, voffB);
            PG8_WAIT_V(6); PG8_BAR; PG8_MMA(1, 1, At, B1); PG8_BAR;
            }
        }
        if constexpr (ALIGN_EPI) { if (wr == 0) PG8_BAR; }
        if constexpr (!Epi::AFTER_DRAIN) { E(acc, cur, wr, wc, fr, fq); S.done(cur); }
        if (!has_next) break;
#pragma unroll
        for (int a = 0; a < 2; ++a)
#pragma unroll
            for (int b = 0; b < 2; ++b)
#pragma unroll
                for (int m = 0; m < 4; ++m)
#pragma unroll
                    for (int n = 0; n < 2; ++n) acc[a][b][m][n] = (f32x4){0.f, 0.f, 0.f, 0.f};
        cur = nxt; cA = nA; cB = nB; ++ui;
        if constexpr (ALIGN_EPI) { if (wr == 1) PG8_BAR; }
    }
    PG8_WAIT_V(0);
    if constexpr (!ALIGN_EPI) { if (wr == 0) PG8_BAR; }
    PG8_BAR;
    if constexpr (Epi::AFTER_DRAIN) { E.fused(acc, cur, wr, wc, fr, fq, lds, wid, lane); S.done(cur); }
#undef PG8_SA
#undef PG8_SB
#undef PG8_STAGE
#undef PG8_LDA
#undef PG8_LDB
#undef PG8_MMA
#undef PG8_WAIT_V
#undef PG8_WAIT_L
#undef PG8_BAR
#undef PG8_SCHED
}
}

#ifndef PG8_SP2
#define PG8_SP2 true
#endif
#ifndef PG8_ALIGN
#define PG8_ALIGN true
#endif
#define GAS __attribute__((address_space(1)))
#define LAS __attribute__((address_space(3)))
typedef unsigned short bf16;
typedef unsigned v4u __attribute__((ext_vector_type(4)));
typedef float f32x4 __attribute__((ext_vector_type(4)));
typedef short bf16x8 __attribute__((ext_vector_type(8)));
typedef GAS unsigned gu32;
typedef GAS unsigned long long gu64;
#define RLX_AGENT __ATOMIC_RELAXED, __HIP_MEMORY_SCOPE_AGENT
#define LDS_WAIT() asm volatile("s_waitcnt lgkmcnt(0)" ::: "memory")
#define VM_WAIT() asm volatile("s_waitcnt vmcnt(0)" ::: "memory")
__device__ __forceinline__ unsigned long long rt() { return __builtin_amdgcn_s_memrealtime(); }
__device__ __forceinline__ unsigned f2bf(float f) { unsigned u = __builtin_bit_cast(unsigned, f); return (u + 0x7fffu + ((u >> 16) & 1u)) >> 16; }
__device__ __forceinline__ unsigned pk2(float lo, float hi) { return f2bf(lo) | (f2bf(hi) << 16); }

#define XB_TMO      128
#define XB_XCNT(j)  (256  + 64 * (j))
#define XB_XSUB(j)  (1280 + 64 * (j))
#define XB_XGEN(j)  (2304 + 64 * (j))
#define XB_TOP      3328
#define XB_TOPGEN   3392
#define XCD_BAR_WORDS 3456
#define XB_SPIN_CAP (1u << 22)

__device__ __forceinline__ unsigned xb_ld(unsigned* p)              { return __hip_atomic_load(p, __ATOMIC_RELAXED, __HIP_MEMORY_SCOPE_AGENT); }
__device__ __forceinline__ unsigned xb_add(unsigned* p, unsigned v) { return __hip_atomic_fetch_add(p, v, __ATOMIC_RELAXED, __HIP_MEMORY_SCOPE_AGENT); }
__device__ __forceinline__ unsigned xb_xcc_id() { return (unsigned)__builtin_amdgcn_s_getreg((3 << 11) | 20) & 0xFu; }
#define XB_SPIN(cond, bar) do { unsigned _sp = 0; while (cond) { __builtin_amdgcn_s_sleep(1); \
    if ((++_sp & 255u) == 0u) { if (xb_ld(&(bar)[XB_TMO])) break; if (_sp > XB_SPIN_CAP) { atomicAdd(&(bar)[XB_TMO], 1u); break; } } } } while (0)

struct XcdBarrier {
    unsigned* bar; unsigned x;
    volatile LAS unsigned* st;
};

__device__ __forceinline__ XcdBarrier xcd_barrier_post(unsigned* bar, volatile LAS unsigned* st) {
    XcdBarrier b; b.bar = bar; b.x = xb_xcc_id(); b.st = st;
    if (threadIdx.x == 0) (void)xb_add(&bar[XB_XCNT(b.x)], 1u);
    return b;
}
__device__ __forceinline__ void xcd_barrier_complete(unsigned* bar, unsigned x, unsigned& nloc, unsigned& nx) {
    const unsigned G = gridDim.x * gridDim.y * gridDim.z;
    unsigned sum, cnt, mine, sp = 0u;
    for (;;) {
        sum = 0u; cnt = 0u; mine = 0u;
#pragma unroll
        for (unsigned j = 0; j < 16; ++j) { const unsigned c = xb_ld(&bar[XB_XCNT(j)]); sum += c; cnt += (c > 0u) ? 1u : 0u; mine = (j == x) ? c : mine; }
        if (sum == G) break;
        __builtin_amdgcn_s_sleep(1);
        if ((++sp & 255u) == 0u) { if (xb_ld(&bar[XB_TMO])) break; if (sp > XB_SPIN_CAP) { atomicAdd(&bar[XB_TMO], 1u); break; } }
    }
    nloc = mine > 0u ? mine : 1u; nx = cnt > 0u ? cnt : 1u;
}

__device__ __forceinline__ void xcd_barrier(const XcdBarrier& b) {
    asm volatile("s_waitcnt vmcnt(0)" ::: "memory");
    __syncthreads();
    if (threadIdx.x == 0) {
        unsigned* bar = b.bar;
        __builtin_amdgcn_s_waitcnt(0);
        unsigned nloc = b.st[0], nx = b.st[1];
        if (nloc == 0u) { xcd_barrier_complete(bar, b.x, nloc, nx); b.st[0] = nloc; b.st[1] = nx; }
        const unsigned old = xb_add(&bar[XB_XSUB(b.x)], 1u);
        const unsigned gen = old / nloc;
        if (old + 1u == (gen + 1u) * nloc) {
            __builtin_amdgcn_fence(__ATOMIC_RELEASE, "agent");
            asm volatile("s_waitcnt vmcnt(0)" ::: "memory");
            const unsigned og = xb_add(&bar[XB_TOP], 1u);
            const unsigned tg = og / nx;
            if (og + 1u == (tg + 1u) * nx) xb_add(&bar[XB_TOPGEN], 1u);
            else XB_SPIN(xb_ld(&bar[XB_TOPGEN]) == tg, bar);
            __builtin_amdgcn_fence(__ATOMIC_ACQUIRE, "agent");
            asm volatile("s_waitcnt vmcnt(0)" ::: "memory");
        } else {
            XB_SPIN(xb_ld(&bar[XB_TOPGEN]) == gen, bar);
            __builtin_amdgcn_fence(__ATOMIC_ACQUIRE, "agent");
            asm volatile("s_waitcnt vmcnt(0)" ::: "memory");
        }
    }
    __syncthreads();
}

__device__ __forceinline__ void xcd_arrive(const XcdBarrier& b, volatile LAS unsigned* sx) {
    asm volatile("s_waitcnt vmcnt(0)" ::: "memory");
    __syncthreads();
    if (threadIdx.x == 0) {
        unsigned* bar = b.bar;
        __builtin_amdgcn_s_waitcnt(0);
        unsigned nloc = b.st[0], nx = b.st[1];
        if (nloc == 0u) { xcd_barrier_complete(bar, b.x, nloc, nx); b.st[0] = nloc; b.st[1] = nx; }
        const unsigned old = xb_add(&bar[XB_XSUB(b.x)], 1u);
        const unsigned gen = old / nloc;
        unsigned leader = 0u, key = gen;
        if (old + 1u == (gen + 1u) * nloc) {
            leader = 1u;
            __builtin_amdgcn_fence(__ATOMIC_RELEASE, "agent");
            asm volatile("s_waitcnt vmcnt(0)" ::: "memory");
            const unsigned og = xb_add(&bar[XB_TOP], 1u);
            const unsigned tg = og / nx; key = tg;
            if (og + 1u == (tg + 1u) * nx) xb_add(&bar[XB_TOPGEN], 1u);
        }
        sx[0] = leader; sx[1] = key;
    }
}
__device__ __forceinline__ void xcd_wait(const XcdBarrier& b, volatile LAS unsigned* sx) {
    if (threadIdx.x == 0) {
        unsigned* bar = b.bar;
        const unsigned leader = sx[0], key = sx[1];
        if (leader) {
            XB_SPIN(xb_ld(&bar[XB_TOPGEN]) == key, bar);
            __builtin_amdgcn_fence(__ATOMIC_ACQUIRE, "agent");
            asm volatile("s_waitcnt vmcnt(0)" ::: "memory");
        } else {
            XB_SPIN(xb_ld(&bar[XB_TOPGEN]) == key, bar);
            __builtin_amdgcn_fence(__ATOMIC_ACQUIRE, "agent");
            asm volatile("s_waitcnt vmcnt(0)" ::: "memory");
        }
    }
    __syncthreads();
}

constexpr int NWAVES = 8;
constexpr int T_ = 16384, SEQ = 4096, DM = 1024, NPROJ = 2304, INC = 2312;
constexpr int PJ_K = 512, PJ_V = 640, PJ_Z = 768, PJ_XBC = 1280;
constexpr float EPS = 1e-6f;
constexpr size_t MiB = 1u << 20;
constexpr size_t WS_CTL = 0, CTL_ZERO_BYTES = 1 * MiB;
constexpr size_t WS_KEYB = 1 * MiB + 256 * 1024;
constexpr size_t WS_BTAB = 1 * MiB + 384 * 1024;
constexpr size_t WS_SMALL = 1 * MiB;
constexpr size_t WS_WIN = 2 * MiB, WS_WOUT = 7 * MiB, WS_WQ = 9 * MiB;
constexpr size_t WS_ED = 13 * MiB, WS_EU = 29 * MiB;
constexpr size_t WS_XN = 77 * MiB;
constexpr size_t WS_PROJ = 109 * MiB;
constexpr size_t WS_ST = 181 * MiB;
constexpr size_t WS_IDX = 213 * MiB, WS_GATE = 221 * MiB, WS_SSQ = 229 * MiB, WS_END = 230 * MiB;
constexpr size_t DO_Y = 0, DO_DT = 41 * MiB;
constexpr size_t WS_CC = 230 * MiB, WS_DT = 238 * MiB, WS_EA = 239 * MiB, WS_CDEC = 240 * MiB, WS_PREV = WS_IDX;
constexpr size_t DO_YPF = 0, DO_YPLAIN = 32 * MiB;
constexpr size_t WS_PART = WS_PROJ;
constexpr size_t WS_H8 = WS_XN, WS_HS = WS_DT;
constexpr size_t WS_SSQ2 = WS_EA;
constexpr int CW_BAR = 4096, CW_RANK = 8192;
constexpr int RING_OFF = 0, RING_BYTES = 147456, LDSCTL_OFF = RING_BYTES, MISC_OFF = LDSCTL_OFF + 320, LDS_BYTES = 163840;

__constant__ unsigned char c_bucket[128] = {0, 1, 2, 3, 4, 5, 6, 7, 8, 9, 10, 11, 12, 13, 14, 15, 16, 16, 16, 17, 17, 18, 18, 18, 19, 19, 19, 20, 20, 20, 20, 21, 21, 21, 21, 22, 22, 22, 22, 22, 23, 23, 23, 23, 23, 23, 24, 24, 24, 24, 24, 24, 25, 25, 25, 25, 25, 25, 25, 26, 26, 26, 26, 26, 26, 26, 26, 27, 27, 27, 27, 27, 27, 27, 27, 27, 27, 28, 28, 28, 28, 28, 28, 28, 28, 28, 28, 29, 29, 29, 29, 29, 29, 29, 29, 29, 29, 29, 29, 30, 30, 30, 30, 30, 30, 30, 30, 30, 30, 30, 30, 30, 30, 31, 31, 31, 31, 31, 31, 31, 31, 31, 31, 31, 31, 31, 31, 31};

typedef float v16f __attribute__((ext_vector_type(16)));
typedef float v32f __attribute__((ext_vector_type(32)));
typedef unsigned v6u __attribute__((ext_vector_type(6)));
typedef _Float16 v32h __attribute__((ext_vector_type(32)));
struct Frame {
    LAS unsigned char* lds;
    volatile LAS unsigned* MISC;
    gu32* ctl;
    int wave, vcu, G;
};
__device__ __forceinline__ int lane_id() { int l; asm volatile("v_mbcnt_lo_u32_b32 %0, -1, 0\n\tv_mbcnt_hi_u32_b32 %0, -1, %0" : "=v"(l)); return l; }
__device__ __forceinline__ int opq(int x) { asm volatile("" : "+v"(x)); return x; }
template <int M> __device__ __forceinline__ float swz_xor(float v) { return __int_as_float(__builtin_amdgcn_ds_swizzle(__float_as_int(v), (M << 10) | 0x1F)); }
__device__ __forceinline__ float sum_halves(float v) { const auto r = __builtin_amdgcn_permlane32_swap(__float_as_uint(v), __float_as_uint(v), false, false); return __uint_as_float(r[0]) + __uint_as_float(r[1]); }
__device__ __forceinline__ float max_halves(float v) { const auto r = __builtin_amdgcn_permlane32_swap(__float_as_uint(v), __float_as_uint(v), false, false); return fmaxf(__uint_as_float(r[0]), __uint_as_float(r[1])); }
__device__ __forceinline__ int imax_halves(int v) { const auto r = __builtin_amdgcn_permlane32_swap((unsigned)v, (unsigned)v, false, false); return max((int)r[0], (int)r[1]); }
__device__ __forceinline__ float wave_sum(float v) {
    v += swz_xor<1>(v); v += swz_xor<2>(v); v += swz_xor<4>(v); v += swz_xor<8>(v); v += swz_xor<16>(v);
    return sum_halves(v);
}
__device__ __forceinline__ float bf2f(unsigned short b) { return __uint_as_float((unsigned)b << 16); }
__device__ __forceinline__ float bflo(unsigned w) { return __uint_as_float(w << 16); }
__device__ __forceinline__ float bfhi(unsigned w) { return __uint_as_float(w & 0xffff0000u); }
__device__ __forceinline__ float silu_f(float x) { return x / (1.f + __expf(-x)); }

__device__ __forceinline__ void p0_transpose_item(const float* W, int ldw, int K, int nblk, bf16* WT, const float* kscale, LAS float* scr, int item, int lane) {
    const int kb = item / nblk, nb = item % nblk, k0 = 64 * kb, n0 = 32 * nb;
    float ks_[32];
#pragma unroll
    for (int i = 0; i < 32; ++i) ks_[i] = kscale ? kscale[k0 + 2 * i + (lane >> 5)] : 1.f;
    float vv_[32];
#pragma unroll
    for (int i = 0; i < 32; ++i) vv_[i] = W[(size_t)(k0 + 2 * i + (lane >> 5)) * ldw + n0 + (lane & 31)];
#pragma unroll
    for (int i = 0; i < 32; ++i) scr[(2 * i + (lane >> 5)) * 33 + (lane & 31)] = vv_[i] * ks_[i];
#pragma unroll 1
    for (int i = 32; i < 32; ++i) { const int kk = 2 * i + (lane >> 5); float v = W[(size_t)(k0 + kk) * ldw + n0 + (lane & 31)]; if (kscale) v *= kscale[k0 + kk]; scr[kk * 33 + (lane & 31)] = v; }
    LDS_WAIT(); asm volatile("" ::: "memory");
    const int c = lane & 7;
#pragma unroll
    for (int j = 0; j < 4; ++j) { const int n = (lane >> 3) + 8 * j; const LAS float* s = scr + (8 * c) * 33 + n;
        v4u o; o.x = pk2(s[0 * 33], s[1 * 33]); o.y = pk2(s[2 * 33], s[3 * 33]); o.z = pk2(s[4 * 33], s[5 * 33]); o.w = pk2(s[6 * 33], s[7 * 33]);
        *(GAS v4u*)(WT + (size_t)(n0 + n) * K + k0 + 8 * c) = o; }
    LDS_WAIT(); asm volatile("" ::: "memory");
}
struct Ptrs {
    const float *x, *norm_mix, *w_in, *conv_w, *conv_b, *dt_bias, *a_log, *d_skip, *ssd_norm_w, *sinks, *w_out, *rel_bias, *norm_ffn, *w_query, *sk1, *sk2, *e_down, *e_up, *norm_final;
    float* out; unsigned char* ws;
};
constexpr int Q_SPLIT = 0;
__device__ __forceinline__ unsigned pack4_i8(float a, float b, float c, float d) {
    const int ia = __float2int_rn(a), ib = __float2int_rn(b), ic = __float2int_rn(c), id = __float2int_rn(d);
    return (unsigned)(ia & 0xff) | ((unsigned)(ib & 0xff) << 8) | ((unsigned)(ic & 0xff) << 16) | ((unsigned)(id & 0xff) << 24);
}
__device__ __forceinline__ unsigned pack8_i4(const float* v, float inv) {
    unsigned o = 0u;
#pragma unroll
    for (int i = 0; i < 8; ++i) { int q = __float2int_rn(v[i] * inv); q = q < -7 ? -7 : (q > 7 ? 7 : q); o |= ((unsigned)q & 15u) << (4 * i); }
    return o;
}
__device__ __forceinline__ void quant_fp8s(const Ptrs& P, int lane_, int r_lo, int r_hi, int w, int nw) {
    float* SC = (float*)(P.ws + WS_SMALL);
    int row = r_lo + w;
    if (row >= r_hi) return;
    float4 w4[4];
#pragma unroll
    for (int q = 0; q < 4; ++q) w4[q] = ((const float4*)P.norm_ffn)[4 * lane_ + q];
    float4 ba[4], bb[4];
#define QD_LOAD(B_, R_) do { const int rl_ = ((R_) < r_hi) ? (R_) : (r_lo + w); _Pragma("unroll") for (int q = 0; q < 4; ++q) B_[q] = ((const float4*)(P.e_down + (size_t)(rl_ & 16383) * DM) + 4 * lane_)[q]; } while (0)
#define QD_STORE() do { *(unsigned long long*)(P.ws + WS_ED + ((size_t)(lane_ >> 4) * 16384 + (prow & 16383)) * 128 + (lane_ & 15) * 8) = po; if (lane_ == 0) SC[prow] = psc; } while (0)
#define QD_WORK(B_, R_) do { float v[16]; \
        _Pragma("unroll") for (int q = 0; q < 4; ++q) { const float4 t = B_[q]; v[4 * q] = t.x * w4[q].x; v[4 * q + 1] = t.y * w4[q].y; v[4 * q + 2] = t.z * w4[q].z; v[4 * q + 3] = t.w * w4[q].w; } \
        float ss = 0.f; _Pragma("unroll") for (int q = 0; q < 16; ++q) ss = fmaf(v[q], v[q], ss); \
        const float sc = fmaxf(2.5f * sqrtf(wave_sum(ss) * (1.f / 1024.f)) * (1.f / 7.f), 1e-30f); const float inv = 1.f / sc; \
        po = (unsigned long long)pack8_i4(v, inv) | ((unsigned long long)pack8_i4(v + 8, inv) << 32); psc = sc; prow = (R_); } while (0)
    unsigned long long po; float psc; int prow;
    QD_LOAD(ba, row);
    QD_LOAD(bb, row + nw);
    __builtin_amdgcn_sched_barrier(0);
    QD_WORK(ba, row);
    row += nw;
    while (row < r_hi) {
        QD_STORE();
        QD_LOAD(ba, row + nw);
        __builtin_amdgcn_sched_barrier(0);
        QD_WORK(bb, row);
        __builtin_amdgcn_sched_barrier(0);
        row += nw; if (row >= r_hi) break;
        QD_STORE();
        QD_LOAD(bb, row + nw);
        __builtin_amdgcn_sched_barrier(0);
        QD_WORK(ba, row);
        __builtin_amdgcn_sched_barrier(0);
        row += nw;
    }
    QD_STORE();
#undef QD_LOAD
#undef QD_STORE
#undef QD_WORK
}
typedef float f32x2q __attribute__((ext_vector_type(2)));
__device__ __forceinline__ void quant_fp6u(const Ptrs& P, int lane_, int q_lo, int q_hi, int w, int nw) {
    float* SC = (float*)(P.ws + WS_SMALL);
    int e = 2 * q_lo + w; const int e_hi = 2 * q_hi;
    if (e >= e_hi) return;
    float4 ba[4], bb[4];
#define QU_LOAD(B_, E_) do { const int el_ = ((E_) < e_hi) ? (E_) : (2 * q_lo + w); _Pragma("unroll") for (int k = 0; k < 4; ++k) B_[k] = ((const float4*)(P.e_up + (size_t)el_ * DM) + 4 * lane_)[k]; } while (0)
#define QU_STORE() do { *(unsigned long long*)(P.ws + WS_EU + (size_t)pe * 512 + 8 * lane_) = po; if (lane_ == 0) SC[16384 + pe] = psc; } while (0)
#define QU_WORK(B_, E_) do { float v[16]; \
        _Pragma("unroll") for (int k = 0; k < 4; ++k) { const float4 t = B_[k]; v[4 * k] = t.x; v[4 * k + 1] = t.y; v[4 * k + 2] = t.z; v[4 * k + 3] = t.w; } \
        float am = 0.f; _Pragma("unroll") for (int k = 0; k < 16; ++k) am = fmaxf(am, fabsf(v[k])); \
        am = fmaxf(am, swz_xor<1>(am)); am = fmaxf(am, swz_xor<2>(am)); am = fmaxf(am, swz_xor<4>(am)); am = fmaxf(am, swz_xor<8>(am)); am = fmaxf(am, swz_xor<16>(am)); am = max_halves(am); \
        am = fmaxf(am, 1e-30f); const float inv = 6.0f / am; unsigned pk[2]; \
        _Pragma("unroll") for (int wd = 0; wd < 2; ++wd) { unsigned p4 = 0u; \
            p4 = __builtin_amdgcn_cvt_scalef32_pk_fp4_f32(p4, v[8 * wd] * inv, v[8 * wd + 1] * inv, 1.0f, 0); \
            p4 = __builtin_amdgcn_cvt_scalef32_pk_fp4_f32(p4, v[8 * wd + 2] * inv, v[8 * wd + 3] * inv, 1.0f, 1); \
            p4 = __builtin_amdgcn_cvt_scalef32_pk_fp4_f32(p4, v[8 * wd + 4] * inv, v[8 * wd + 5] * inv, 1.0f, 2); \
            p4 = __builtin_amdgcn_cvt_scalef32_pk_fp4_f32(p4, v[8 * wd + 6] * inv, v[8 * wd + 7] * inv, 1.0f, 3); \
            pk[wd] = p4; } \
        po = (unsigned long long)pk[0] | ((unsigned long long)pk[1] << 32); psc = am * (1.f / 6.0f); pe = (E_); } while (0)
    unsigned long long po; float psc; int pe;
    QU_LOAD(ba, e);
    QU_LOAD(bb, e + nw);
    __builtin_amdgcn_sched_barrier(0);
    QU_WORK(ba, e);
    __builtin_amdgcn_sched_barrier(0);
    e += nw;
    while (e < e_hi) {
        QU_STORE();
        QU_LOAD(ba, e + nw);
        __builtin_amdgcn_sched_barrier(0);
        QU_WORK(bb, e);
        __builtin_amdgcn_sched_barrier(0);
        e += nw; if (e >= e_hi) break;
        QU_STORE();
        QU_LOAD(bb, e + nw);
        __builtin_amdgcn_sched_barrier(0);
        QU_WORK(ba, e);
        __builtin_amdgcn_sched_barrier(0);
        e += nw;
    }
    QU_STORE();
#undef QU_LOAD
#undef QU_STORE
#undef QU_WORK
}
__device__ __forceinline__ void p0_prologue(Frame& F0, const Ptrs& P) {
    const Frame& F = F0; const int lane_ = lane_id(), tid_ = F.wave * 64 + lane_;
    LAS float* scr = (LAS float*)(F.lds + RING_OFF + F.wave * 16384);
    const int gw = F.vcu * NWAVES + F.wave, NGW = F.G * NWAVES;
    bf16* Win_t = (bf16*)(P.ws + WS_WIN); bf16* Wout_t = (bf16*)(P.ws + WS_WOUT); bf16* Wq_t = (bf16*)(P.ws + WS_WQ);
    constexpr int I_IN = 16 * 72;
    for (int it = gw; it < I_IN; it += NGW) p0_transpose_item(P.w_in, INC, DM, 72, Win_t, nullptr, scr, it, lane_);
    (void)Wout_t; (void)Wq_t;
    __syncthreads();
    { LAS float* Wdt = (LAS float*)(F.lds + RING_OFF);
      { float wd_[16];
#pragma unroll
        for (int q = 0; q < 16; ++q) { const int i = tid_ + 512 * q; wd_[q] = P.w_in[(size_t)(i >> 3) * INC + NPROJ + (i & 7)]; }
#pragma unroll
        for (int q = 0; q < 16; ++q) Wdt[tid_ + 512 * q] = wd_[q]; }
      __syncthreads();
      bf16* XN = (bf16*)(P.ws + WS_XN); float* DT = (float*)(P.ws + WS_DT);
      float4 nmw[4];
#pragma unroll
      for (int j = 0; j < 4; ++j) nmw[j] = ((const float4*)P.norm_mix)[j * 64 + lane_];
      float4 xnx[2][4];
      if (gw * 2 < T_) {
#pragma unroll
        for (int rr = 0; rr < 2; ++rr)
#pragma unroll
            for (int j = 0; j < 4; ++j) xnx[rr][j] = ((const float4*)(P.x + (size_t)(gw * 2 + rr) * DM))[j * 64 + lane_]; }
      for (int m0 = gw * 2; m0 < T_; m0 += NGW * 2) {
        float4 xv[2][4];
#pragma unroll
        for (int rr = 0; rr < 2; ++rr)
#pragma unroll
            for (int j = 0; j < 4; ++j) xv[rr][j] = xnx[rr][j];
        { const int mn = (m0 + NGW * 2 < T_) ? m0 + NGW * 2 : m0;
#pragma unroll
          for (int rr = 0; rr < 2; ++rr)
#pragma unroll
              for (int j = 0; j < 4; ++j) xnx[rr][j] = ((const float4*)(P.x + (size_t)(mn + rr) * DM))[j * 64 + lane_]; }
#pragma unroll
        for (int rr = 0; rr < 2; ++rr) { const int m = m0 + rr;
        float4 v[4]; float s = 0.f;
#pragma unroll
        for (int j = 0; j < 4; ++j) { v[j] = xv[rr][j]; s += v[j].x * v[j].x + v[j].y * v[j].y + v[j].z * v[j].z + v[j].w * v[j].w; }
        const float r = rsqrtf(wave_sum(s) * (1.f / 1024.f) + EPS);
        float d8[8];
#pragma unroll
        for (int q = 0; q < 8; ++q) d8[q] = 0.f;
        unsigned long long* o8 = (unsigned long long*)(XN + (size_t)m * DM);
#pragma unroll
        for (int j = 0; j < 4; ++j) { const float4 w = nmw[j];
            const float e0 = v[j].x * r * w.x, e1 = v[j].y * r * w.y, e2 = v[j].z * r * w.z, e3 = v[j].w * r * w.w;
            o8[j * 64 + lane_] = (unsigned long long)pk2(e0, e1) | ((unsigned long long)pk2(e2, e3) << 32);
            const float ev[4] = {e0, e1, e2, e3};
#pragma unroll
            for (int e = 0; e < 4; ++e) { const LAS f32x4* wr = (const LAS f32x4*)(Wdt + (size_t)(j * 256 + lane_ * 4 + e) * 8); const f32x4 w0 = wr[0], w1 = wr[1];
                d8[0] += ev[e] * w0.x; d8[1] += ev[e] * w0.y; d8[2] += ev[e] * w0.z; d8[3] += ev[e] * w0.w; d8[4] += ev[e] * w1.x; d8[5] += ev[e] * w1.y; d8[6] += ev[e] * w1.z; d8[7] += ev[e] * w1.w; } }
#pragma unroll
        for (int q = 0; q < 8; ++q) d8[q] = wave_sum(d8[q]);
        if (lane_ == 0) { float4* dp = (float4*)(DT + (size_t)m * 8); dp[0] = make_float4(d8[0], d8[1], d8[2], d8[3]); dp[1] = make_float4(d8[4], d8[5], d8[6], d8[7]); }
        }
      }
      __syncthreads(); }
}

__device__ __forceinline__ void p1_slack(Frame& F0, const Ptrs& P, int w, int nw) {
    const Frame& F = F0; const int lane_ = lane_id();
    LAS float* scr = (LAS float*)(F.lds + RING_OFF + F.wave * 16384);
    bf16* Wout_t = (bf16*)(P.ws + WS_WOUT); bf16* Wq_t = (bf16*)(P.ws + WS_WQ);
    constexpr int I_OUT = 16 * 32, I_Q = 16 * 64;
    for (int it = w; it < I_OUT + I_Q; it += nw) {
        if (it < I_OUT) p0_transpose_item(P.w_out, DM, DM, 32, Wout_t, nullptr, scr, it, lane_);
        else p0_transpose_item(P.w_query, 2048, DM, 64, Wq_t, P.norm_ffn, scr, it - I_OUT, lane_);
    }
    { unsigned long long* KB = (unsigned long long*)(P.ws + WS_KEYB);
      for (int i = w * 64 + lane_; i < 8192; i += nw * 64) { const float4 t = (i < 4096) ? ((const float4*)P.sk1)[i] : ((const float4*)P.sk2)[i - 4096];
          KB[i] = (unsigned long long)pk2(t.x, t.y) | ((unsigned long long)pk2(t.z, t.w) << 32); } }
    { float* BT = (float*)(P.ws + WS_BTAB);
      for (int i = w * 64 + lane_; i < 1536; i += nw * 64) { const int hkv = i / 768, rr = i % 768, gg = rr / 192, dist = rr % 192 - 32;
          BT[i] = (dist >= 0 && dist < 128) ? P.rel_bias[c_bucket[dist & 127] * 8 + hkv * 4 + gg] * 1.4426950408889634f : 0.f; } }
    quant_fp6u(P, lane_, 0, 8192, w, nw);
    quant_fp8s(P, lane_, 0, 16384, w, nw);
}
struct EpiResH {
    static constexpr bool PERM = false, AFTER_DRAIN = false;
    const float* X; bf16* HB; float* SSQ;
    __device__ __forceinline__ void ldx(pg8::f32x4 (&d)[4], int row, int col0) const {
#pragma unroll
        for (int bj = 0; bj < 2; ++bj)
#pragma unroll
            for (int n = 0; n < 2; ++n) d[bj * 2 + n] = *(const pg8::f32x4*)(X + (size_t)row * DM + col0 + bj * 128 + n * 16);
    }
    __device__ __forceinline__ void operator()(const pg8::f32x4 (&acc)[2][2][4][2], const pg8::Unit& u, int wr, int wc, int fr, int fq) const {
        const int row0 = u.pm * 256 + wr * 64 + fr, col0 = u.pn * 256 + wc * 32 + 4 * fq;
        pg8::f32x4 xq[2][4];
        ldx(xq[0], row0, col0);
#pragma unroll
        for (int g = 0; g < 8; ++g) { const int ai = g >> 2, m = g & 3, row = row0 + ai * 128 + m * 16;
            if (g + 1 < 8) ldx(xq[(g + 1) & 1], row0 + ((g + 1) >> 2) * 128 + ((g + 1) & 3) * 16, col0);
            float ss = 0.f;
#pragma unroll
            for (int bj = 0; bj < 2; ++bj)
#pragma unroll
                for (int n = 0; n < 2; ++n) { const size_t off = (size_t)row * DM + col0 + bj * 128 + n * 16;
                    const pg8::f32x4 h = acc[ai][bj][m][n] + xq[g & 1][bj * 2 + n];
                    ss += h[0] * h[0] + h[1] * h[1] + h[2] * h[2] + h[3] * h[3];
                    *(unsigned long long*)(HB + off) = (unsigned long long)pk2(h[0], h[1]) | ((unsigned long long)pk2(h[2], h[3]) << 32); }
            ss += swz_xor<16>(ss); ss = sum_halves(ss);
            if (fq == 0) SSQ[(size_t)row * 16 + u.pn * 4 + wc] = ss; }
    }
};

typedef float f32x16 __attribute__((ext_vector_type(16)));
typedef short s16x4 __attribute__((ext_vector_type(4)));
typedef float f32x2_t __attribute__((ext_vector_type(2)));
typedef __bf16 bf16x2_t __attribute__((ext_vector_type(2)));
#define MFMA32(a, b, c) __builtin_amdgcn_mfma_f32_32x32x16_bf16((a), (b), (c), 0, 0, 0)
__device__ __forceinline__ int crow(int reg, int h) { return (reg & 3) + 8 * (reg >> 2) + 4 * h; }
__device__ __forceinline__ unsigned cvtpk(float lo, float hi) { f32x2_t v = {lo, hi}; bf16x2_t b = __builtin_convertvector(v, bf16x2_t); return __builtin_bit_cast(unsigned, b); }
__device__ __forceinline__ bf16x8 pack8(const f32x16& x, int s) {
    v4u p; p.x = cvtpk(x[8 * s], x[8 * s + 1]); p.y = cvtpk(x[8 * s + 2], x[8 * s + 3]); p.z = cvtpk(x[8 * s + 4], x[8 * s + 5]); p.w = cvtpk(x[8 * s + 6], x[8 * s + 7]);
    return __builtin_bit_cast(bf16x8, p);
}
constexpr float LOG2E = 1.4426950408889634f;
constexpr int LDP = 136;
constexpr int S1_XT = 0, S1_XTW = 17408, S1_BSN = 34816, S1_CLN = 69632, S1_BNL = 104448, S1_F32 = 139264;

__device__ __forceinline__ float silu_fast(float x) { return x * __builtin_amdgcn_rcpf(1.f + __builtin_amdgcn_exp2f(-x * LOG2E)); }
__device__ __forceinline__ int swz_t(int row, int l) { return row * LDP + ((((l >> 3) ^ (row >> 3)) & 7) | ((l >> 3) & 8)) * 8 + (l & 7); }
#define S1_CONV8(A_, IT_) do { _Pragma("unroll") for (int e_ = 0; e_ < 8; ++e_) A_[e_] = bias[e_]; \
        _Pragma("unroll") for (int j_ = 0; j_ < 4; ++j_) { const v4u rw_ = raw[(IT_) + j_]; \
            A_[0] += w[j_][0] * bflo(rw_.x); A_[1] += w[j_][1] * bfhi(rw_.x); A_[2] += w[j_][2] * bflo(rw_.y); A_[3] += w[j_][3] * bfhi(rw_.y); \
            A_[4] += w[j_][4] * bflo(rw_.z); A_[5] += w[j_][5] * bfhi(rw_.z); A_[6] += w[j_][6] * bflo(rw_.w); A_[7] += w[j_][7] * bfhi(rw_.w); } \
        _Pragma("unroll") for (int e_ = 0; e_ < 8; ++e_) A_[e_] = silu_fast(A_[e_]); } while (0)
#define S1_LOADW(CHB_) do { _Pragma("unroll") for (int j_ = 0; j_ < 4; ++j_) { const float4 w0_ = *(const float4*)(P.conv_w + j_ * 1024 + (CHB_)), w1_ = *(const float4*)(P.conv_w + j_ * 1024 + (CHB_) + 4); \
            w[j_][0] = w0_.x; w[j_][1] = w0_.y; w[j_][2] = w0_.z; w[j_][3] = w0_.w; w[j_][4] = w1_.x; w[j_][5] = w1_.y; w[j_][6] = w1_.z; w[j_][7] = w1_.w; } \
        { const float4 b0_ = *(const float4*)(P.conv_b + (CHB_)), b1_ = *(const float4*)(P.conv_b + (CHB_) + 4); \
          bias[0] = b0_.x; bias[1] = b0_.y; bias[2] = b0_.z; bias[3] = b0_.w; bias[4] = b1_.x; bias[5] = b1_.y; bias[6] = b1_.z; bias[7] = b1_.w; } } while (0)
__device__ __forceinline__ void ssd_s1(Frame& F, const Ptrs& P) {
    const bf16* PROJ = (const bf16*)(P.ws + WS_PROJ); const float* DT = (const float*)(P.ws + WS_DT);
    float* EA = (float*)(P.ws + WS_EA); float* CDEC = (float*)(P.ws + WS_CDEC); bf16* CC = (bf16*)(P.ws + WS_CC);
    unsigned* ST = (unsigned*)(P.ws + WS_ST); unsigned* YPF = (unsigned*)((char*)P.out + DO_YPF);
    LAS unsigned char* L = F.lds + RING_OFF;
    LAS bf16* Xt = (LAS bf16*)(L + S1_XT); LAS bf16* Xtw = (LAS bf16*)(L + S1_XTW); LAS bf16* Bsn = (LAS bf16*)(L + S1_BSN); LAS bf16* Cln = (LAS bf16*)(L + S1_CLN); LAS bf16* Bnl = (LAS bf16*)(L + S1_BNL);
    LAS float* f32base = (LAS float*)(L + S1_F32);
    const int lane = lane_id(); const int tid_ = F.wave * 64 + lane;
    for (int ug = F.vcu; ug < 256; ug += F.G) {
        const int grp = ug & 1, c = (ug >> 1) & 31, b = ug >> 6, t0 = b * SEQ + c * 128;
        __syncthreads();
        if (F.wave < 4) {
            const int h = 4 * grp + F.wave, us = (b * 32 + c) * 8 + h;
            const float A = -__expf(P.a_log[h]), dtb = P.dt_bias[h];
            const int ln = opq(lane_id());
            LAS float* acum2 = f32base + F.wave * 384; LAS float* wv = acum2 + 128; LAS float* wend = wv + 128;
            const float x0 = DT[(size_t)(t0 + 2 * ln) * 8 + h] + dtb, x1 = DT[(size_t)(t0 + 2 * ln + 1) * 8 + h] + dtb;
            const float dt0 = fmaxf(x0, 0.f) + log1pf(__expf(-fabsf(x0))), dt1 = fmaxf(x1, 0.f) + log1pf(__expf(-fabsf(x1)));
            const float a0 = dt0 * A, a1 = dt1 * A;
            float s = a0 + a1;
#pragma unroll
            for (int o = 1; o < 64; o <<= 1) { const float v = __int_as_float(__builtin_amdgcn_ds_bpermute((ln - o) * 4, __float_as_int(s))); if (ln >= o) s += v; }
            const float ac1 = s, ac0 = s - a1, tot = __uint_as_float(__builtin_amdgcn_readlane(__float_as_uint(s), 63));
            acum2[2 * ln] = ac0 * LOG2E; acum2[2 * ln + 1] = ac1 * LOG2E;
            wv[2 * ln] = log2f(dt0) - ac0 * LOG2E; wv[2 * ln + 1] = log2f(dt1) - ac1 * LOG2E;
            wend[2 * ln] = dt0 * exp2f((tot - ac0) * LOG2E); wend[2 * ln + 1] = dt1 * exp2f((tot - ac1) * LOG2E);
            EA[(size_t)(t0 + 2 * ln) * 8 + h] = exp2f(ac0 * LOG2E); EA[(size_t)(t0 + 2 * ln + 1) * 8 + h] = exp2f(ac1 * LOG2E);
            if (ln == 0) CDEC[us] = exp2f(tot * LOG2E);
        }
        { const int tidc = opq(tid_);
          if (tidc < 440) {
            const int cg = tidc % 40, sg = tidc / 40, l0 = 12 * sg, h0 = 4 * grp;
            int chb; if (cg < 8) chb = h0 * 64 + cg * 8; else if (cg < 24) chb = 512 + grp * 128 + (cg - 8) * 8; else chb = 768 + grp * 128 + (cg - 24) * 8;
            v4u raw[15];
#pragma unroll
            for (int q = 0; q < 15; ++q) { const int ss = c * 128 + l0 - 3 + q; raw[q] = (v4u){0u, 0u, 0u, 0u};
                if (ss >= 0 && l0 - 3 + q < 128) raw[q] = *(const v4u*)(PROJ + (size_t)(b * SEQ + ss) * NPROJ + PJ_XBC + chb); }
            float w[4][8], bias[8]; S1_LOADW(chb);
#pragma unroll
            for (int it = 0; it < 12; it += 2) {
                const int l = l0 + it;
                if (l < 128) {
                    float a[8], a2[8]; S1_CONV8(a, it); S1_CONV8(a2, it + 1);
                    if (cg < 8) {
#pragma unroll
                        for (int e = 0; e < 8; ++e) *(LAS unsigned*)(Xt + swz_t(cg * 8 + e, l)) = cvtpk(a[e], a2[e]);
                    } else {
                        v4u o, o2; o.x = cvtpk(a[0], a[1]); o.y = cvtpk(a[2], a[3]); o.z = cvtpk(a[4], a[5]); o.w = cvtpk(a[6], a[7]);
                        o2.x = cvtpk(a2[0], a2[1]); o2.y = cvtpk(a2[2], a2[3]); o2.z = cvtpk(a2[4], a2[5]); o2.w = cvtpk(a2[6], a2[7]);
                        if (cg < 24) { const int n0 = (cg - 8) * 8; *(LAS v4u*)(Bsn + l * LDP + n0) = o; *(LAS v4u*)(Bsn + (l + 1) * LDP + n0) = o2;
#pragma unroll
                            for (int e = 0; e < 8; ++e) *(LAS unsigned*)(Bnl + swz_t(n0 + e, l)) = cvtpk(a[e], a2[e]);
                        } else { const int n0 = (cg - 24) * 8; *(LAS v4u*)(Cln + l * LDP + n0) = o; *(LAS v4u*)(Cln + (l + 1) * LDP + n0) = o2;
                            *(v4u*)(CC + (size_t)(t0 + l) * 256 + grp * 128 + n0) = o; *(v4u*)(CC + (size_t)(t0 + l + 1) * 256 + grp * 128 + n0) = o2; }
                    }
                }
            }
          } }
        __syncthreads();
#pragma unroll 1
        for (int hi = 0; hi < 4; ++hi) {
            const int h = 4 * grp + hi, u = (b * 32 + c) * 8 + h;
            const float Dh = P.d_skip[h];
            const LAS float* acum2 = f32base + hi * 384; const LAS float* wv = acum2 + 128; const LAS float* wend = wv + 128;
            const LAS bf16* Xc = (hi & 1) ? Xtw : Xt; LAS bf16* Xn = (hi & 1) ? Xt : Xtw;
            const int tidc = opq(tid_);
            const int cgn = tidc & 7, ln_ = 2 * (tidc >> 3), chn = (h + 1) * 64 + cgn * 8;
            v4u raw[5];
#pragma unroll
            for (int q = 0; q < 5; ++q) { const int ss = c * 128 + ln_ - 3 + q; raw[q] = (v4u){0u, 0u, 0u, 0u};
                if (hi < 3 && ss >= 0) raw[q] = *(const v4u*)(PROJ + (size_t)(b * SEQ + ss) * NPROJ + PJ_XBC + chn); }
            float4 wq4[4][2], bq4[2];
            { const int chw = (hi < 3) ? chn : chn - 64;
#pragma unroll
              for (int j = 0; j < 4; ++j) { wq4[j][0] = *(const float4*)(P.conv_w + j * 1024 + chw); wq4[j][1] = *(const float4*)(P.conv_w + j * 1024 + chw + 4); }
              bq4[0] = *(const float4*)(P.conv_b + chw); bq4[1] = *(const float4*)(P.conv_b + chw + 4); }
            const int ln3 = opq(lane), r = ln3 & 31, hh = ln3 >> 5;
            if (F.wave < 4) {
                const int pt = F.wave >> 1;
#pragma unroll 1
                for (int q = 0; q < 2; ++q) {
                    const int lt = (F.wave & 1) ? (1 + q) : (3 * q);
                    f32x16 yacc;
#pragma unroll
                    for (int i = 0; i < 16; ++i) yacc[i] = 0.f;
                    const float al = acum2[32 * lt + r];
                    bf16x8 cf[8];
#pragma unroll
                    for (int kk = 0; kk < 8; ++kk) cf[kk] = *(const LAS bf16x8*)(Cln + (32 * lt + r) * LDP + 16 * kk + 8 * hh);
#pragma unroll 1
                    for (int st = 0; st <= lt; ++st) {
                        bf16x8 bfr[8];
#pragma unroll
                        for (int kk = 0; kk < 8; ++kk) bfr[kk] = *(const LAS bf16x8*)(Bsn + (32 * st + r) * LDP + 16 * kk + 8 * hh);
                        f32x4 wq[4];
#pragma unroll
                        for (int g4 = 0; g4 < 4; ++g4) wq[g4] = *(const LAS f32x4*)(wv + 32 * st + 8 * g4 + 4 * hh);
                        s16x4 xlo[2], xhi[2];
#pragma unroll
                        for (int sg = 0; sg < 2; ++sg) { const int prow = 32 * pt + r, lb = 32 * st + 16 * sg;
                            xlo[sg] = *(const LAS s16x4*)(Xc + swz_t(prow, lb) + 4 * hh); xhi[sg] = *(const LAS s16x4*)(Xc + swz_t(prow, lb + 8) + 4 * hh); }
                        __builtin_amdgcn_sched_barrier(0);
                        f32x16 macc;
#pragma unroll
                        for (int i = 0; i < 16; ++i) macc[i] = 0.f;
#pragma unroll
                        for (int kk = 0; kk < 8; ++kk) macc = MFMA32(bfr[kk], cf[kk], macc);
#pragma unroll
                        for (int i = 0; i < 16; ++i) { const int sl = crow(i, hh);
                            float f = __builtin_amdgcn_exp2f(al + wq[i >> 2][i & 3]);
                            if (st == lt && sl > r) f = 0.f;
                            macc[i] *= f; }
#pragma unroll
                        for (int sg = 0; sg < 2; ++sg) {
                            const bf16x8 bfrag = pack8(macc, sg);
                            const bf16x8 afrag = __builtin_shufflevector(xlo[sg], xhi[sg], 0, 1, 2, 3, 4, 5, 6, 7);
                            yacc = MFMA32(afrag, bfrag, yacc);
                        }
                    }
                    unsigned short xs16[16];
#pragma unroll
                    for (int i = 0; i < 16; ++i) xs16[i] = *(const LAS unsigned short*)(Xc + swz_t(32 * pt + crow(i, hh), 32 * lt + r));
                    __builtin_amdgcn_sched_barrier(0);
#pragma unroll
                    for (int i = 0; i < 16; i += 2) {
                        const float y0 = yacc[i] + Dh * __uint_as_float((unsigned)xs16[i] << 16), y1 = yacc[i + 1] + Dh * __uint_as_float((unsigned)xs16[i + 1] << 16);
                        YPF[((((size_t)u * 4 + lt) * 2 + pt) * 8 + (i >> 1)) * 64 + ln3] = cvtpk(y0, y1); }
                }
            } else {
                const int nt = F.wave - 4;
                bf16x8 bb[8];
                { v4u braw[8]; f32x4 we[8][2];
#pragma unroll
                  for (int kk = 0; kk < 8; ++kk) { braw[kk] = *(const LAS v4u*)(Bnl + swz_t(32 * nt + r, 16 * kk + 8 * hh));
                      we[kk][0] = *(const LAS f32x4*)(wend + 16 * kk + 8 * hh); we[kk][1] = *(const LAS f32x4*)(wend + 16 * kk + 8 * hh + 4); }
#pragma unroll
                  for (int kk = 0; kk < 8; ++kk) { v4u o;
                      o.x = cvtpk(bflo(braw[kk].x) * we[kk][0][0], bfhi(braw[kk].x) * we[kk][0][1]); o.y = cvtpk(bflo(braw[kk].y) * we[kk][0][2], bfhi(braw[kk].y) * we[kk][0][3]);
                      o.z = cvtpk(bflo(braw[kk].z) * we[kk][1][0], bfhi(braw[kk].z) * we[kk][1][1]); o.w = cvtpk(bflo(braw[kk].w) * we[kk][1][2], bfhi(braw[kk].w) * we[kk][1][3]);
                      bb[kk] = __builtin_bit_cast(bf16x8, o); } }
#pragma unroll 1
                for (int pt = 0; pt < 2; ++pt) {
                    bf16x8 xa[8];
#pragma unroll
                    for (int kk = 0; kk < 8; ++kk) xa[kk] = *(const LAS bf16x8*)(Xc + swz_t(32 * pt + r, 16 * kk + 8 * hh));
                    __builtin_amdgcn_sched_barrier(0);
                    f32x16 sacc;
#pragma unroll
                    for (int i = 0; i < 16; ++i) sacc[i] = 0.f;
#pragma unroll
                    for (int kk = 0; kk < 8; ++kk) sacc = MFMA32(xa[kk], bb[kk], sacc);
#pragma unroll
                    for (int i = 0; i < 16; i += 2) ST[((size_t)u * 32 + 16 * pt + (crow(i, hh) >> 1)) * 128 + 32 * nt + r] = cvtpk(sacc[i], sacc[i + 1]);
                }
            }
            if (hi < 3) {
                const int cg = cgn, l = ln_;
                float w[4][8], bias[8];
#pragma unroll
                for (int j = 0; j < 4; ++j) { w[j][0] = wq4[j][0].x; w[j][1] = wq4[j][0].y; w[j][2] = wq4[j][0].z; w[j][3] = wq4[j][0].w; w[j][4] = wq4[j][1].x; w[j][5] = wq4[j][1].y; w[j][6] = wq4[j][1].z; w[j][7] = wq4[j][1].w; }
                bias[0] = bq4[0].x; bias[1] = bq4[0].y; bias[2] = bq4[0].z; bias[3] = bq4[0].w; bias[4] = bq4[1].x; bias[5] = bq4[1].y; bias[6] = bq4[1].z; bias[7] = bq4[1].w;
                float a[8], a2[8]; S1_CONV8(a, 0); S1_CONV8(a2, 1);
#pragma unroll
                for (int e = 0; e < 8; ++e) *(LAS unsigned*)(Xn + swz_t(cg * 8 + e, l)) = cvtpk(a[e], a2[e]);
            }
            __syncthreads();
        }
    }
}
__device__ __forceinline__ void ssd_s2(Frame& F, const Ptrs& P) {
    const unsigned* ST = (const unsigned*)(P.ws + WS_ST); const float* CDEC = (const float*)(P.ws + WS_CDEC); unsigned* PREV = (unsigned*)(P.ws + WS_PREV);
    for (int g = F.vcu * 512 + (F.wave * 64 + lane_id()); g < 65536; g += F.G * 512) {
        const int n2 = g & 63, p2 = (g >> 6) & 31, h = (g >> 11) & 7, b = g >> 14;
        uint2 st[32];
#pragma unroll
        for (int c = 0; c < 32; ++c) st[c] = *(const uint2*)(ST + ((size_t)(((b * 32 + c) * 8 + h) * 32 + p2)) * 128 + 2 * n2);
        float r00 = 0.f, r01 = 0.f, r10 = 0.f, r11 = 0.f;
#pragma unroll
        for (int c = 0; c < 32; ++c) { const size_t u = (size_t)((b * 32 + c) * 8 + h);
            PREV[((u * 64 + 2 * p2) * 128 + 2 * n2) >> 1] = cvtpk(r00, r01); PREV[((u * 64 + 2 * p2 + 1) * 128 + 2 * n2) >> 1] = cvtpk(r10, r11);
            const float d = CDEC[u];
            r00 = r00 * d + bflo(st[c].x); r10 = r10 * d + bfhi(st[c].x); r01 = r01 * d + bflo(st[c].y); r11 = r11 * d + bfhi(st[c].y); }
    }
}
__device__ __forceinline__ void ssd_s3(Frame& F, const Ptrs& P) {
    const bf16* CC = (const bf16*)(P.ws + WS_CC); const bf16* PREV = (const bf16*)(P.ws + WS_PREV); const float* EA = (const float*)(P.ws + WS_EA);
    const unsigned* YPF = (const unsigned*)((const char*)P.out + DO_YPF); const bf16* PROJ = (const bf16*)(P.ws + WS_PROJ); bf16* CAT = (bf16*)(P.ws + WS_XN);
    LAS float* red = (LAS float*)(F.lds + RING_OFF);
    const int lane = lane_id(), r = lane & 31, hh = lane >> 5, h = F.wave, grp = h >> 2;
    for (int v2 = F.vcu; v2 < 256; v2 += F.G) {
        const int lp = v2 & 1, c = (v2 >> 1) & 31, b = v2 >> 6;
        const size_t u = (size_t)((b * 32 + c) * 8 + h);
        bf16x8 af[2][8];
#pragma unroll
        for (int pt = 0; pt < 2; ++pt)
#pragma unroll
            for (int kk = 0; kk < 8; ++kk) af[pt][kk] = *(const bf16x8*)(PREV + (u * 64 + 32 * pt + r) * 128 + 16 * kk + 8 * hh);
#pragma unroll 1
        for (int li = 0; li < 2; ++li) {
            const int lt = 2 * lp + li;
            const int t = b * SEQ + c * 128 + lt * 32 + r;
            unsigned ypf[2][8]; unsigned long long zz[2][4];
#pragma unroll
            for (int pt = 0; pt < 2; ++pt) {
#pragma unroll
                for (int i = 0; i < 8; ++i) ypf[pt][i] = YPF[((((size_t)u * 4 + lt) * 2 + pt) * 8 + i) * 64 + lane];
#pragma unroll
                for (int g4 = 0; g4 < 4; ++g4) zz[pt][g4] = *(const unsigned long long*)(PROJ + (size_t)t * NPROJ + PJ_Z + h * 64 + 32 * pt + 8 * g4 + 4 * hh); }
            const float ea = EA[(size_t)t * 8 + h];
            bf16x8 bb[8];
#pragma unroll
            for (int kk = 0; kk < 8; ++kk) bb[kk] = *(const bf16x8*)(CC + (size_t)t * 256 + grp * 128 + 16 * kk + 8 * hh);
            f32x16 acc[2];
#pragma unroll
            for (int i = 0; i < 16; ++i) { acc[0][i] = 0.f; acc[1][i] = 0.f; }
#pragma unroll
            for (int kk = 0; kk < 8; ++kk) { acc[0] = MFMA32(af[0][kk], bb[kk], acc[0]); acc[1] = MFMA32(af[1][kk], bb[kk], acc[1]); }
            float ss = 0.f;
#pragma unroll
            for (int pt = 0; pt < 2; ++pt)
#pragma unroll
                for (int g4 = 0; g4 < 4; ++g4) {
                    const unsigned z01 = (unsigned)zz[pt][g4], z23 = (unsigned)(zz[pt][g4] >> 32);
                    const float zf[4] = {bflo(z01), bfhi(z01), bflo(z23), bfhi(z23)};
#pragma unroll
                    for (int e = 0; e < 4; ++e) { const int i = 4 * g4 + e;
                        const float y = acc[pt][i] * ea + ((i & 1) ? bfhi(ypf[pt][i >> 1]) : bflo(ypf[pt][i >> 1]));
                        const float yg = y * silu_fast(zf[e]); acc[pt][i] = yg; ss = fmaf(yg, yg, ss); }
                }
            ss = sum_halves(ss);
            LAS float* rd = red + li * 256;
            if (hh == 0) rd[h * 32 + r] = ss;
            __syncthreads();
            float tot = 0.f;
#pragma unroll
            for (int w = 0; w < 8; ++w) tot += rd[w * 32 + r];
            const float rn = rsqrtf(tot * (1.f / 512.f) + EPS);
#pragma unroll
            for (int pt = 0; pt < 2; ++pt)
#pragma unroll
                for (int g4 = 0; g4 < 4; ++g4) { const int ch = h * 64 + 32 * pt + 8 * g4 + 4 * hh;
                    const float4 w = *(const float4*)(P.ssd_norm_w + ch);
                    *(unsigned long long*)(CAT + (size_t)t * DM + 512 + ch) = (unsigned long long)cvtpk(acc[pt][4 * g4] * rn * w.x, acc[pt][4 * g4 + 1] * rn * w.y) | ((unsigned long long)cvtpk(acc[pt][4 * g4 + 2] * rn * w.z, acc[pt][4 * g4 + 3] * rn * w.w) << 32); }
        }
        __syncthreads();
    }
}
__device__ __forceinline__ float gelu_erf(float v) { return 0.5f * v * (1.f + erff(v * 0.70710678118654752f)); }
typedef float f32x2v __attribute__((ext_vector_type(2)));
#define CVT8(W, LO) __builtin_amdgcn_cvt_pk_f32_fp8((int)(W), LO)
template <int CTRL> __device__ __forceinline__ float dpp_f(float v) { return __int_as_float(__builtin_amdgcn_update_dpp(0, __float_as_int(v), CTRL, 0xF, 0xF, true)); }
__device__ __forceinline__ float sum8_dpp(float s) { s += dpp_f<0xB1>(s); s += dpp_f<0x4E>(s); s += dpp_f<0x141>(s); return s; }
struct PeerPlace { int vx, nx, rank, nloc; };
__device__ __forceinline__ PeerPlace peer_place(Frame& F) {
    __syncthreads();
    if (F.wave == 0 && lane_id() == 0) {
        unsigned* bar = (unsigned*)(F.ctl + CW_BAR); const unsigned x = xb_xcc_id();
        unsigned vx = 0, nx = 0;
        for (unsigned j = 0; j < 16; ++j) { const unsigned c = xb_ld(&bar[XB_XCNT(j)]); if (c) { if (j < x) ++vx; ++nx; } }
        const unsigned rank = xb_add((unsigned*)(F.ctl + CW_RANK) + 64 * x, 1u);
        F.MISC[10] = vx; F.MISC[11] = nx ? nx : 1u; F.MISC[12] = rank; F.MISC[13] = xb_ld(&bar[XB_XCNT(x)]);
    }
    __syncthreads();
    PeerPlace pp; pp.vx = (int)F.MISC[10]; pp.nx = (int)F.MISC[11]; pp.rank = (int)F.MISC[12]; pp.nloc = (int)F.MISC[13]; if (pp.nloc < 1) pp.nloc = 1;
    return pp;
}
__device__ __forceinline__ void h_quant_rows(Frame& F, const Ptrs& P) {
    const bf16* HB = (const bf16*)(P.ws + WS_ST); unsigned char* H8 = P.ws + WS_H8; float* HS = (float*)(P.ws + WS_HS);
    const int lane = lane_id();
    for (int t = F.vcu * NWAVES + F.wave; t < T_; t += F.G * NWAVES) {
        const v4u a0 = ((const v4u*)(HB + (size_t)t * DM))[2 * lane], a1 = ((const v4u*)(HB + (size_t)t * DM))[2 * lane + 1];
        float hf[16];
        hf[0] = bflo(a0.x); hf[1] = bfhi(a0.x); hf[2] = bflo(a0.y); hf[3] = bfhi(a0.y); hf[4] = bflo(a0.z); hf[5] = bfhi(a0.z); hf[6] = bflo(a0.w); hf[7] = bfhi(a0.w);
        hf[8] = bflo(a1.x); hf[9] = bfhi(a1.x); hf[10] = bflo(a1.y); hf[11] = bfhi(a1.y); hf[12] = bflo(a1.z); hf[13] = bfhi(a1.z); hf[14] = bflo(a1.w); hf[15] = bfhi(a1.w);
        float am = 0.f;
#pragma unroll
        for (int i = 0; i < 16; ++i) am = fmaxf(am, fabsf(hf[i]));
        am = fmaxf(am, dpp_f<0xB1>(am)); am = fmaxf(am, dpp_f<0x4E>(am)); am = fmaxf(am, dpp_f<0x141>(am)); am = fmaxf(am, dpp_f<0x140>(am)); am = fmaxf(am, 1e-30f);
        const float inv = 119.f / am;
        unsigned hi[2] = {0u, 0u}, lo[2] = {0u, 0u};
#pragma unroll
        for (int i = 0; i < 16; ++i) { const int q = __float2int_rn(hf[i] * inv); const int qh = (q + 8) >> 4, ql = q - 16 * qh;
            hi[i >> 3] |= ((unsigned)qh & 15u) << (4 * (i & 7)); lo[i >> 3] |= ((unsigned)ql & 15u) << (4 * (i & 7)); }
        unsigned char* dst = H8 + (size_t)t * 1024 + (lane >> 4) * 256 + (lane & 15) * 8;
        *(unsigned long long*)dst = (unsigned long long)hi[0] | ((unsigned long long)hi[1] << 32);
        *(unsigned long long*)(dst + 128) = (unsigned long long)lo[0] | ((unsigned long long)lo[1] << 32);
        if ((lane & 15) == 0) HS[(size_t)t * 8 + (lane >> 4)] = am * (1.f / 119.f);
    }
}
constexpr int PX_D = 16;
template <int CTRL> __device__ __forceinline__ int dpp_i(int v) { return __builtin_amdgcn_update_dpp(0, v, CTRL, 0xF, 0xF, true); }
#define PX_ISSUE(BUF, LO, HI) _Pragma("unroll") for (int b_ = 0; b_ < 8; ++b_) { const unsigned off_ = ((unsigned)__builtin_amdgcn_ds_bpermute((16 * (b_ & 3) + ps) * 4, (b_ & 4) ? (HI) : (LO)) << 7) | (unsigned)(dl << 5); \
        BUF[2 * b_] = *(const v4u*)(tab + off_); BUF[2 * b_ + 1] = *(const v4u*)(tab + off_ + 16); }
struct H4 { v4u h0, h1, l0, l1; };
#define PX_DOT8(Q, HH, HL) ah = __builtin_amdgcn_sdot8((int)(Q), (int)(HH), ah, false); al = __builtin_amdgcn_sdot8((int)(Q), (int)(HL), al, false);
__device__ __forceinline__ void peer_down_token(const v4u (&cur)[PX_D], const H4& h, const float hs, unsigned* prow, int dl, int ps) {
    int sm[8];
#pragma unroll
    for (int b = 0; b < 8; ++b) { const v4u q0 = cur[2 * b], q1 = cur[2 * b + 1];
        int ah = 0, al = 0;
        PX_DOT8(q0.x, h.h0.x, h.l0.x) PX_DOT8(q0.y, h.h0.y, h.l0.y) PX_DOT8(q0.z, h.h0.z, h.l0.z) PX_DOT8(q0.w, h.h0.w, h.l0.w)
        PX_DOT8(q1.x, h.h1.x, h.l1.x) PX_DOT8(q1.y, h.h1.y, h.l1.y) PX_DOT8(q1.z, h.h1.z, h.l1.z) PX_DOT8(q1.w, h.h1.w, h.l1.w)
        sm[b] = 16 * ah + al; }
    const bool c1 = (dl & 2) != 0, c0 = (dl & 1) != 0;
    int w4[4], w2[2];
#pragma unroll
    for (int k = 0; k < 4; ++k) { const int keep = c1 ? sm[4 + k] : sm[k], send = c1 ? sm[k] : sm[4 + k]; w4[k] = keep + dpp_i<0x4E>(send); }
#pragma unroll
    for (int k = 0; k < 2; ++k) { const int keep = c0 ? w4[2 + k] : w4[k], send = c0 ? w4[k] : w4[2 + k]; w2[k] = keep + dpp_i<0xB1>(send); }
    const float f0 = (float)w2[0] * hs, f1 = (float)w2[1] * hs;
    const float g0 = dpp_f<0x4E>(f0), g1 = dpp_f<0x4E>(f1);
    if (dl < 2) { prow[32 * dl + ps] = cvtpk(f0, g0); prow[32 * dl + 16 + ps] = cvtpk(f1, g1); }
}
__device__ __forceinline__ void peer_down(Frame& F, const Ptrs& P, const PeerPlace& pp) {
    const unsigned char* H8 = P.ws + WS_H8; const unsigned char* HSb = P.ws + WS_HS; const unsigned char* IDXb = P.ws + WS_IDX; unsigned char* PARTb = P.ws + WS_PART;
    const int lane = lane_id(), dl = lane & 3, ps = lane >> 2;
    const int tstep = pp.nloc * NWAVES;
    for (int u = pp.vx; u < 8; u += pp.nx) {
        const int s = u & 3, tend = ((u >> 2) + 1) * (T_ / 2), t0 = (u >> 2) * (T_ / 2) + pp.rank * NWAVES + F.wave;
        if (t0 >= tend) continue;
        const unsigned char* tab = P.ws + WS_ED + (size_t)s * 16384 * 128;
        const unsigned hoff = (unsigned)(s * 256 + dl * 32), ioff = (unsigned)lane * 4u;
        v4u bufA[PX_D], bufB[PX_D];
#define PD_CLAMP(T) ((T) < tend ? (T) : t0)
#define PD_META(H, HSC, TT) do { const unsigned char* hp_ = H8 + ((unsigned)(TT) * 1024u + hoff); H.h0 = *(const v4u*)hp_; H.h1 = *(const v4u*)(hp_ + 16); H.l0 = *(const v4u*)(hp_ + 128); H.l1 = *(const v4u*)(hp_ + 144); \
        HSC = *(const float*)(HSb + ((unsigned)(TT) * 32u + (unsigned)s * 4u)); } while (0)
#define PD_IDX(LO, HI, TT) do { LO = *(const int*)(IDXb + ((unsigned)(TT) * 512u + ioff)); HI = *(const int*)(IDXb + ((unsigned)(TT) * 512u + 256u + ioff)); } while (0)
        int nidx_lo, nidx_hi; PD_IDX(nidx_lo, nidx_hi, t0);
        PX_ISSUE(bufA, nidx_lo, nidx_hi);
        PD_IDX(nidx_lo, nidx_hi, PD_CLAMP(t0 + tstep));
        H4 ha, hb; float sa, sb; PD_META(ha, sa, t0);
        for (int t = t0; t < tend; t += 2 * tstep) {
            { const int tn = PD_CLAMP(t + tstep);
              PX_ISSUE(bufB, nidx_lo, nidx_hi); PD_IDX(nidx_lo, nidx_hi, PD_CLAMP(tn + tstep)); PD_META(hb, sb, tn);
              __builtin_amdgcn_sched_barrier(0);
              peer_down_token(bufA, ha, sa, (unsigned*)(PARTb + ((unsigned)(s * T_ + t) * 256u)), dl, ps);
              __builtin_amdgcn_sched_barrier(0); }
            if (t + tstep >= tend) break;
            { const int tc = t + tstep, tn = PD_CLAMP(tc + tstep);
              PX_ISSUE(bufA, nidx_lo, nidx_hi); PD_IDX(nidx_lo, nidx_hi, PD_CLAMP(tn + tstep)); PD_META(ha, sa, tn);
              __builtin_amdgcn_sched_barrier(0);
              peer_down_token(bufB, hb, sb, (unsigned*)(PARTb + ((unsigned)(s * T_ + tc) * 256u)), dl, ps);
              __builtin_amdgcn_sched_barrier(0); }
        }
    }
}
constexpr int PE_PD = 8;
#define PE_LOAD4(SLOT, IDV) SLOT = *(const v4u*)(EU + (((unsigned)(IDV) << 9) | l16))
#define PE_BP(ADDR, V) __builtin_amdgcn_ds_bpermute((ADDR), (V))
__device__ __forceinline__ void peer_up_tm(Frame& F, const Ptrs& P) {
    const bf16* HB = (const bf16*)(P.ws + WS_ST); const unsigned char* EU = P.ws + WS_EU;
    const int* IDX = (const int*)(P.ws + WS_IDX); const float* GATE = (const float*)(P.ws + WS_GATE); const unsigned* PART = (const unsigned*)(P.ws + WS_PART);
    const float* SCD = (const float*)(P.ws + WS_SMALL); const float* SCU = SCD + 16384;
    const int lane = lane_id(), l31 = lane & 31; const bool upper = lane >= 32;
    const unsigned l16 = (unsigned)l31 << 4;
    const int bp0 = upper ? 4 : 0;
    const int t0 = F.vcu * NWAVES + F.wave, tstep = F.G * NWAVES;
    if (t0 >= T_) return;
    float4 nfw[4];
#pragma unroll
    for (int k = 0; k < 4; ++k) nfw[k] = ((const float4*)(P.norm_final) + 8 * l31 + 4 * (lane >> 5))[k];
    int idx_lo = IDX[(size_t)t0 * 128 + lane], idx_hi = IDX[(size_t)t0 * 128 + 64 + lane];
    v4u hq[4];
#pragma unroll
    for (int k = 0; k < 4; ++k) hq[k] = ((const v4u*)(HB + (size_t)t0 * DM))[4 * l31 + k];
    float g_lo = GATE[(size_t)t0 * 128 + lane], g_hi = GATE[(size_t)t0 * 128 + 64 + lane];
    float pre_lo = 0.f, pre_hi = 0.f;
#pragma unroll
    for (int s = 0; s < 4; ++s) { const unsigned pp_ = PART[((size_t)s * T_ + t0) * 64 + lane]; pre_lo += bflo(pp_); pre_hi += bfhi(pp_); }
    float sdu_lo = SCD[idx_lo], sdu_hi = SCD[idx_hi], su_lo = SCU[idx_lo], su_hi = SCU[idx_hi];
    v4u ra[PE_PD];
#pragma unroll
    for (int j = 0; j < PE_PD; ++j) { const int id = PE_BP(bp0 + 8 * j, idx_lo); PE_LOAD4(ra[j], id); }
    int id_nx = PE_BP(bp0 + 8 * PE_PD, idx_lo);
    for (int t = t0; t < T_; t += tstep) {
        const int tn = (t + tstep < T_) ? t + tstep : t;
        const int nidx_lo = IDX[(size_t)tn * 128 + lane], nidx_hi = IDX[(size_t)tn * 128 + 64 + lane];
        v4u nh[4];
#pragma unroll
        for (int k = 0; k < 4; ++k) nh[k] = ((const v4u*)(HB + (size_t)tn * DM))[4 * l31 + k];
        const float ng_lo = GATE[(size_t)tn * 128 + lane], ng_hi = GATE[(size_t)tn * 128 + 64 + lane];
        unsigned npart[4];
#pragma unroll
        for (int s = 0; s < 4; ++s) npart[s] = PART[((size_t)s * T_ + tn) * 64 + lane];
        float ssq = 0.f;
#pragma unroll
        for (int k = 0; k < 4; ++k) { ssq = fmaf(bflo(hq[k].x), bflo(hq[k].x), ssq); ssq = fmaf(bfhi(hq[k].x), bfhi(hq[k].x), ssq); ssq = fmaf(bflo(hq[k].y), bflo(hq[k].y), ssq); ssq = fmaf(bfhi(hq[k].y), bfhi(hq[k].y), ssq);
            ssq = fmaf(bflo(hq[k].z), bflo(hq[k].z), ssq); ssq = fmaf(bfhi(hq[k].z), bfhi(hq[k].z), ssq); ssq = fmaf(bflo(hq[k].w), bflo(hq[k].w), ssq); ssq = fmaf(bfhi(hq[k].w), bfhi(hq[k].w), ssq); }
        ssq += swz_xor<1>(ssq); ssq += swz_xor<2>(ssq); ssq += swz_xor<4>(ssq); ssq += swz_xor<8>(ssq); ssq += swz_xor<16>(ssq);
        const float rstd = rsqrtf(ssq * (1.f / 1024.f) + EPS);
        const float act_lo = gelu_erf(pre_lo * sdu_lo * rstd) * g_lo * su_lo, act_hi = gelu_erf(pre_hi * sdu_hi * rstd) * g_hi * su_hi;
        float nsdu_lo = 0.f, nsdu_hi = 0.f, nsu_lo = 0.f, nsu_hi = 0.f;
        f32x2v acc[16];
#pragma unroll
        for (int i = 0; i < 16; ++i) acc[i] = (f32x2v){0.f, 0.f};
        float a_cur = __int_as_float(PE_BP(bp0, __float_as_int(act_lo)));
#pragma unroll
        for (int q = 0; q < 64; ++q) {
            const int qa = q + 1, ql = q + PE_PD + 1;
            float a_nx = 0.f;
            if (qa < 64) a_nx = __int_as_float(PE_BP(bp0 + 8 * (qa & 31), __float_as_int(qa < 32 ? act_lo : act_hi)));
            int id_n2;
            if (ql < 64) id_n2 = PE_BP(bp0 + 8 * (ql & 31), ql < 32 ? idx_lo : idx_hi);
            else id_n2 = PE_BP(bp0 + 8 * ((ql - 64) & 31), nidx_lo);
            __builtin_amdgcn_sched_barrier(0);
            { const f32x2v av = {a_cur, a_cur}; const v4u r = ra[q % PE_PD];
#define PE_FMA4(W, O) acc[O] = __builtin_elementwise_fma(av, (f32x2v)__builtin_amdgcn_cvt_scalef32_pk_f32_fp4(W, 1.0f, 0), acc[O]); acc[O + 1] = __builtin_elementwise_fma(av, (f32x2v)__builtin_amdgcn_cvt_scalef32_pk_f32_fp4(W, 1.0f, 1), acc[O + 1]); \
              acc[O + 2] = __builtin_elementwise_fma(av, (f32x2v)__builtin_amdgcn_cvt_scalef32_pk_f32_fp4(W, 1.0f, 2), acc[O + 2]); acc[O + 3] = __builtin_elementwise_fma(av, (f32x2v)__builtin_amdgcn_cvt_scalef32_pk_f32_fp4(W, 1.0f, 3), acc[O + 3]);
              PE_FMA4(r.x, 0) PE_FMA4(r.y, 4) PE_FMA4(r.z, 8) PE_FMA4(r.w, 12) }
            asm volatile("" : "+v"(acc[0]), "+v"(acc[1]), "+v"(acc[2]), "+v"(acc[3]), "+v"(acc[4]), "+v"(acc[5]), "+v"(acc[6]), "+v"(acc[7]));
            asm volatile("" : "+v"(acc[8]), "+v"(acc[9]), "+v"(acc[10]), "+v"(acc[11]), "+v"(acc[12]), "+v"(acc[13]), "+v"(acc[14]), "+v"(acc[15]));
            PE_LOAD4(ra[q % PE_PD], id_nx);
            if (q == 24) { nsdu_lo = SCD[nidx_lo]; nsdu_hi = SCD[nidx_hi]; nsu_lo = SCU[nidx_lo]; nsu_hi = SCU[nidx_hi]; }
            id_nx = id_n2; a_cur = a_nx;
            __builtin_amdgcn_sched_barrier(0);
        }
        { float a = 0.f, c = 0.f;
#pragma unroll
          for (int s = 0; s < 4; ++s) { a += bflo(npart[s]); c += bfhi(npart[s]); }
          pre_lo = a; pre_hi = c; }
        sdu_lo = nsdu_lo; sdu_hi = nsdu_hi; su_lo = nsu_lo; su_hi = nsu_hi;
        float y[32];
#pragma unroll
        for (int k = 0; k < 4; ++k) { y[8 * k] = bflo(hq[k].x); y[8 * k + 1] = bfhi(hq[k].x); y[8 * k + 2] = bflo(hq[k].y); y[8 * k + 3] = bfhi(hq[k].y); y[8 * k + 4] = bflo(hq[k].z); y[8 * k + 5] = bfhi(hq[k].z); y[8 * k + 6] = bflo(hq[k].w); y[8 * k + 7] = bfhi(hq[k].w); }
        float s2 = 0.f;
#pragma unroll
        for (int i = 0; i < 16; ++i) { y[2 * i] += sum_halves(acc[i][0]); y[2 * i + 1] += sum_halves(acc[i][1]); s2 = fmaf(y[2 * i], y[2 * i], s2); s2 = fmaf(y[2 * i + 1], y[2 * i + 1], s2); }
        s2 += swz_xor<1>(s2); s2 += swz_xor<2>(s2); s2 += swz_xor<4>(s2); s2 += swz_xor<8>(s2); s2 += swz_xor<16>(s2);
        const float r2 = rsqrtf(s2 * (1.f / 1024.f) + EPS);
        float4* o = (float4*)(P.out + (size_t)t * DM) + 8 * l31 + 4 * (lane >> 5);
#pragma unroll
        for (int k = 0; k < 4; ++k) { const float4 w = nfw[k];
            const float e0 = upper ? y[16 + 4 * k] : y[4 * k], e1 = upper ? y[17 + 4 * k] : y[4 * k + 1], e2 = upper ? y[18 + 4 * k] : y[4 * k + 2], e3 = upper ? y[19 + 4 * k] : y[4 * k + 3];
            o[k] = make_float4(e0 * r2 * w.x, e1 * r2 * w.y, e2 * r2 * w.z, e3 * r2 * w.w); }
        idx_lo = nidx_lo; idx_hi = nidx_hi; g_lo = ng_lo; g_hi = ng_hi;
#pragma unroll
        for (int k = 0; k < 4; ++k) hq[k] = nh[k];
    }
}
constexpr int TK_LDK = 136, TK_K2 = 34816, TK_SCR = 69632, TK_SP = 49;
__device__ __forceinline__ int mono_key(float x) { const int b = __float_as_int(x); return b ^ ((b >> 31) & 0x7fffffff); }
__device__ __forceinline__ float unmono(int m) { return __int_as_float(m ^ ((m >> 31) & 0x7fffffff)); }
__device__ __forceinline__ int max3i(int a, int b, int c) { return max(max(a, b), c); }
#define CEX(A, I, J) do { const int hi_ = max(A[I], A[J]), lo_ = min(A[I], A[J]); A[I] = hi_; A[J] = lo_; } while (0)
template <int N, int OFF, int K, int J, int LEN> struct BitonicStep {
    static __device__ __forceinline__ void run(int (&a)[LEN]) {
#pragma unroll
        for (int i = 0; i < N; ++i) { const int l = i ^ J; if (l > i) { if ((i & K) == 0) CEX(a, OFF + i, OFF + l); else CEX(a, OFF + l, OFF + i); } }
        if constexpr (J > 1) BitonicStep<N, OFF, K, (J >> 1), LEN>::run(a);
        else if constexpr (K < N) BitonicStep<N, OFF, (K << 1), K, LEN>::run(a);
    }
};
template <int N, int OFF, int LEN> __device__ __forceinline__ void bitonic_sort_desc(int (&a)[LEN]) { BitonicStep<N, OFF, 2, 1, LEN>::run(a); }
template <int OFF, int LEN> __device__ __forceinline__ void bitonic_merge16_desc(int (&a)[LEN]) { BitonicStep<16, OFF, 16, 8, LEN>::run(a); }
template <int OFF, int LEN> __device__ __forceinline__ void oem_sort16_desc(int (&a)[LEN]) {
    constexpr unsigned char Pn[63][2] = {{0, 1}, {2, 3}, {0, 2}, {1, 3}, {1, 2}, {4, 5}, {6, 7}, {4, 6}, {5, 7}, {5, 6}, {0, 4}, {2, 6}, {2, 4}, {1, 5}, {3, 7}, {3, 5}, {1, 2}, {3, 4}, {5, 6}, {8, 9}, {10, 11}, {8, 10}, {9, 11}, {9, 10}, {12, 13}, {14, 15}, {12, 14}, {13, 15}, {13, 14}, {8, 12}, {10, 14}, {10, 12}, {9, 13}, {11, 15}, {11, 13}, {9, 10}, {11, 12}, {13, 14}, {0, 8}, {4, 12}, {4, 8}, {2, 10}, {6, 14}, {6, 10}, {2, 4}, {6, 8}, {10, 12}, {1, 9}, {5, 13}, {5, 9}, {3, 11}, {7, 15}, {7, 11}, {3, 5}, {7, 9}, {11, 13}, {1, 2}, {3, 4}, {5, 6}, {7, 8}, {9, 10}, {11, 12}, {13, 14}};
#pragma unroll
    for (int k = 0; k < 63; ++k) CEX(a, OFF + Pn[k][0], OFF + Pn[k][1]);
}
template <int LEN> __device__ __forceinline__ void oem_sort32_desc(int (&a)[LEN]) {
    constexpr unsigned char Pn[191][2] = {{0, 1}, {2, 3}, {0, 2}, {1, 3}, {1, 2}, {4, 5}, {6, 7}, {4, 6}, {5, 7}, {5, 6}, {0, 4}, {2, 6}, {2, 4}, {1, 5}, {3, 7}, {3, 5}, {1, 2}, {3, 4}, {5, 6}, {8, 9}, {10, 11}, {8, 10}, {9, 11}, {9, 10}, {12, 13}, {14, 15}, {12, 14}, {13, 15}, {13, 14}, {8, 12}, {10, 14}, {10, 12}, {9, 13}, {11, 15}, {11, 13}, {9, 10}, {11, 12}, {13, 14}, {0, 8}, {4, 12}, {4, 8}, {2, 10}, {6, 14}, {6, 10}, {2, 4}, {6, 8}, {10, 12}, {1, 9}, {5, 13}, {5, 9}, {3, 11}, {7, 15}, {7, 11}, {3, 5}, {7, 9}, {11, 13}, {1, 2}, {3, 4}, {5, 6}, {7, 8}, {9, 10}, {11, 12}, {13, 14}, {16, 17}, {18, 19}, {16, 18}, {17, 19}, {17, 18}, {20, 21}, {22, 23}, {20, 22}, {21, 23}, {21, 22}, {16, 20}, {18, 22}, {18, 20}, {17, 21}, {19, 23}, {19, 21}, {17, 18}, {19, 20}, {21, 22}, {24, 25}, {26, 27}, {24, 26}, {25, 27}, {25, 26}, {28, 29}, {30, 31}, {28, 30}, {29, 31}, {29, 30}, {24, 28}, {26, 30}, {26, 28}, {25, 29}, {27, 31}, {27, 29}, {25, 26}, {27, 28}, {29, 30}, {16, 24}, {20, 28}, {20, 24}, {18, 26}, {22, 30}, {22, 26}, {18, 20}, {22, 24}, {26, 28}, {17, 25}, {21, 29}, {21, 25}, {19, 27}, {23, 31}, {23, 27}, {19, 21}, {23, 25}, {27, 29}, {17, 18}, {19, 20}, {21, 22}, {23, 24}, {25, 26}, {27, 28}, {29, 30}, {0, 16}, {8, 24}, {8, 16}, {4, 20}, {12, 28}, {12, 20}, {4, 8}, {12, 16}, {20, 24}, {2, 18}, {10, 26}, {10, 18}, {6, 22}, {14, 30}, {14, 22}, {6, 10}, {14, 18}, {22, 26}, {2, 4}, {6, 8}, {10, 12}, {14, 16}, {18, 20}, {22, 24}, {26, 28}, {1, 17}, {9, 25}, {9, 17}, {5, 21}, {13, 29}, {13, 21}, {5, 9}, {13, 17}, {21, 25}, {3, 19}, {11, 27}, {11, 19}, {7, 23}, {15, 31}, {15, 23}, {7, 11}, {15, 19}, {23, 27}, {3, 5}, {7, 9}, {11, 13}, {15, 17}, {19, 21}, {23, 25}, {27, 29}, {1, 2}, {3, 4}, {5, 6}, {7, 8}, {9, 10}, {11, 12}, {13, 14}, {15, 16}, {17, 18}, {19, 20}, {21, 22}, {23, 24}, {25, 26}, {27, 28}, {29, 30}};
#pragma unroll
    for (int k = 0; k < 191; ++k) CEX(a, Pn[k][0], Pn[k][1]);
}
template <int A, int B, int LEN> __device__ __forceinline__ void merge_top16(int (&a)[LEN]) {
#pragma unroll
    for (int i = 0; i < 16; ++i) a[A + i] = max(a[A + i], a[B + 15 - i]);
    bitonic_merge16_desc<A, LEN>(a);
}
template <int LEN> __device__ __forceinline__ void pair_top16(int (&a)[LEN]) {
    int lo[16], up[16];
#pragma unroll
    for (int i = 0; i < 16; ++i) { const auto rr = __builtin_amdgcn_permlane32_swap((unsigned)a[i], (unsigned)a[i], false, false); lo[i] = (int)rr[0]; up[i] = (int)rr[1]; }
#pragma unroll
    for (int i = 0; i < 16; ++i) a[i] = max(lo[i], up[15 - i]);
    bitonic_merge16_desc<0, LEN>(a);
}
__device__ __forceinline__ void topk_half(const bf16x8 (&qf)[8], const LAS bf16* Kh, int r, int hh, int (&key)[64]) {
#pragma unroll
    for (int nt = 0; nt < 4; ++nt) {
        f32x16 sc;
#pragma unroll
        for (int i = 0; i < 16; ++i) sc[i] = 0.f;
#pragma unroll
        for (int kk = 0; kk < 8; ++kk) { const bf16x8 a = *(const LAS bf16x8*)(Kh + (32 * nt + r) * TK_LDK + 16 * kk + 8 * hh); sc = MFMA32(a, qf[kk], sc); }
#pragma unroll
        for (int i = 0; i < 16; ++i) key[nt * 16 + i] = (mono_key(sc[i]) & ~127) | (127 - (32 * nt + crow(i, hh)));
    }
    oem_sort16_desc<0, 64>(key); oem_sort16_desc<16, 64>(key); oem_sort16_desc<32, 64>(key); oem_sort16_desc<48, 64>(key);
    merge_top16<0, 16, 64>(key); merge_top16<32, 48, 64>(key); merge_top16<0, 32, 64>(key);
    pair_top16<64>(key);
}
__device__ __forceinline__ void topk_finish(const LAS int* scr, int hh, float rstd, int* IDX, float* GATE, int t, int hd) {
    const LAS int* la = scr + hh * 16; const LAS int* lb = scr + (1 - hh) * 16;
    float va[4], vb[16];
#pragma unroll
    for (int i = 0; i < 4; ++i) va[i] = unmono(la[i] & ~127);
#pragma unroll
    for (int j = 0; j < 16; ++j) vb[j] = unmono(lb[j] & ~127);
    int ck[32];
    {
        int q = 0;
#pragma unroll
        for (int i = 0; i < 4; ++i)
#pragma unroll
            for (int j = i; j < 16; ++j) if ((i + 1) * (j + 1) <= 16) {
                const int pos = hh ? (j * 16 + i) : (i * 16 + j);
                int k = (mono_key(va[i] + vb[j]) & ~255) | (255 - pos);
                if (i == j && hh) k = (int)0x80000000;
                ck[q++] = k; }
#pragma unroll
        for (int i = 27; i < 32; ++i) ck[i] = (int)0x80000000;
    }
    oem_sort32_desc<32>(ck);
    pair_top16<32>(ck);
    const float vmax = unmono(ck[0] & ~255) * rstd;
    float ev[8]; int id[8]; float esum = 0.f; const int hm = -hh;
#pragma unroll
    for (int q = 0; q < 8; ++q) { const int wk = ck[q] ^ ((ck[q] ^ ck[8 + q]) & hm); const int pos = 255 - (wk & 255);
        const int n1 = 127 - (scr[pos >> 4] & 127), n2 = 127 - (scr[16 + (pos & 15)] & 127);
        id[q] = n1 * 128 + n2;
        ev[q] = exp2f((unmono(wk & ~255) * rstd - vmax) * LOG2E); esum += ev[q]; }
    esum = sum_halves(esum);
    const float inv = 1.f / esum;
    int4* ip = (int4*)(IDX + ((size_t)t * 8 + hd) * 16 + hh * 8); float4* gp = (float4*)(GATE + ((size_t)t * 8 + hd) * 16 + hh * 8);
    ip[0] = make_int4(id[0], id[1], id[2], id[3]); ip[1] = make_int4(id[4], id[5], id[6], id[7]);
    gp[0] = make_float4(ev[0] * inv, ev[1] * inv, ev[2] * inv, ev[3] * inv); gp[1] = make_float4(ev[4] * inv, ev[5] * inv, ev[6] * inv, ev[7] * inv);
}
constexpr int TQ_QH = 69632, TQ_QP = 272;
struct OneUnit { pg8::StaticOrder S; int i;
    __device__ __forceinline__ bool next(int j, pg8::Unit& u) const { return j == 0 ? S.next(i, u) : false; }
    __device__ __forceinline__ void a_ready(const pg8::Unit&) const {}
    __device__ __forceinline__ void done(const pg8::Unit&) const {}
};
struct EpiQTopk {
    static constexpr bool PERM = true, AFTER_DRAIN = true;
    const unsigned char* KB; const float* SSQ; int* IDX; float* GATE;
    __device__ __forceinline__ void dump(const pg8::f32x4 (&acc)[2][2][4][2], int bj, LAS unsigned char* QH, int wr, int wc, int fr, int fq) const {
#pragma unroll
        for (int ai = 0; ai < 2; ++ai)
#pragma unroll
            for (int m = 0; m < 4; ++m) { const pg8::f32x4 v0 = bj ? acc[ai][1][m][0] : acc[ai][0][m][0], v1 = bj ? acc[ai][1][m][1] : acc[ai][0][m][1];
                v4u w; w.x = cvtpk(v0[0], v0[1]); w.y = cvtpk(v0[2], v0[3]); w.z = cvtpk(v1[0], v1[1]); w.w = cvtpk(v1[2], v1[3]);
                *(LAS v4u*)(QH + (128 * ai + 64 * wr + 16 * m + fr) * TQ_QP + (32 * wc + 8 * fq) * 2) = w; }
    }
    __device__ __forceinline__ void fused(const pg8::f32x4 (&acc)[2][2][4][2], const pg8::Unit& u, int wr, int wc, int fr, int fq, LAS unsigned char* L, int wid, int lane) const {
        LAS bf16* K1 = (LAS bf16*)L; LAS bf16* K2 = (LAS bf16*)(L + TK_K2); LAS unsigned char* QH = L + TQ_QH;
        const int tid_ = wid * 64 + lane, r = lane & 31, hh = lane >> 5;
        { v4u kq[8];
#pragma unroll
          for (int q = 0; q < 8; ++q) kq[q] = ((const v4u*)KB)[tid_ + 512 * q];
          dump(acc, 0, QH, wr, wc, fr, fq);
#pragma unroll
          for (int q = 0; q < 8; ++q) { const int j = tid_ + 512 * q, n = (j >> 4) & 127, k8 = j & 15; *(LAS v4u*)(((j >> 11) ? K2 : K1) + n * TK_LDK + 8 * k8) = kq[q]; } }
        __syncthreads();
        const int t = u.pm * 256 + 32 * wid + r;
        float rstd;
        { const float4* sp = (const float4*)(SSQ + (size_t)t * 16); const float4 a = sp[0], b = sp[1], c = sp[2], d = sp[3];
          rstd = rsqrtf(((a.x + a.y + a.z + a.w) + (b.x + b.y + b.z + b.w) + (c.x + c.y + c.z + c.w) + (d.x + d.y + d.z + d.w)) * (1.f / 1024.f) + EPS); }
        const LAS unsigned char* qrow = QH + (32 * wid + r) * TQ_QP + 16 * hh;
        int key[64], list0[16];
        { bf16x8 qf[8];
#pragma unroll
          for (int kk = 0; kk < 8; ++kk) qf[kk] = *(const LAS bf16x8*)(qrow + 32 * kk);
          topk_half(qf, K1, r, hh, key);
#pragma unroll
          for (int i = 0; i < 16; ++i) list0[i] = key[i]; }
        __syncthreads();
        dump(acc, 1, QH, wr, wc, fr, fq);
        __syncthreads();
        { bf16x8 qf[8];
#pragma unroll
          for (int kk = 0; kk < 8; ++kk) qf[kk] = *(const LAS bf16x8*)(qrow + 32 * kk);
          topk_half(qf, K2, r, hh, key); }
        LAS int* scr = (LAS int*)(QH + 32 * wid * TQ_QP) + r * TK_SP;
        LDS_WAIT();
        if (hh == 0) {
#pragma unroll
            for (int i = 0; i < 16; ++i) { scr[i] = list0[i]; scr[16 + i] = key[i]; } }
        topk_finish(scr, hh, rstd, IDX, GATE, t, u.pn);
        __syncthreads();
    }
};

constexpr int AT_KP = 72, AT_VP = 264;
constexpr int AT_K = 0, AT_VT = 36864, AT_BT = 36864 + 33792;
__device__ __forceinline__ void attn_phase(Frame& F, const Ptrs& P) {
    const bf16* PROJ = (const bf16*)(P.ws + WS_PROJ); bf16* CAT = (bf16*)(P.ws + WS_XN);
    LAS unsigned char* L = F.lds + RING_OFF;
    LAS bf16* Ks = (LAS bf16*)(L + AT_K); LAS bf16* Vt = (LAS bf16*)(L + AT_VT); LAS float* btab = (LAS float*)(L + AT_BT);
    const int lane = lane_id(), tid_ = F.wave * 64 + lane, r = lane & 31, hh = lane >> 5;
    for (int u = F.vcu; u < 256; u += F.G) {
        const int hkv = u & 1, n = (u >> 1) & 31, b = u >> 6;
        const int trow0 = b * SEQ + n * 128;
        v4u kvq[4], vvq[4];
#pragma unroll
        for (int q = 0; q < 4; ++q) { const int i = tid_ + 512 * q, kj = i >> 3, ch = i & 7; const bool ok = (n > 0) || (kj >= 128);
            kvq[q] = (v4u){0u, 0u, 0u, 0u}; vvq[q] = (v4u){0u, 0u, 0u, 0u};
            if (ok) { const bf16* rowp = PROJ + (size_t)(trow0 - 128 + kj) * NPROJ + hkv * 64 + ch * 8; kvq[q] = *(const v4u*)(rowp + PJ_K); vvq[q] = *(const v4u*)(rowp + PJ_V); } }
#pragma unroll
        for (int q = 0; q < 4; ++q) {
            const int i = tid_ + 512 * q, kj = i >> 3, ch = i & 7;
            const v4u kv = kvq[q], vv = vvq[q];
            *(LAS v4u*)(Ks + kj * AT_KP + ch * 8) = kv;
            LAS bf16* vp = Vt + (ch * 8) * AT_VP + kj;
            vp[0] = (bf16)(vv.x & 0xffffu); vp[AT_VP] = (bf16)(vv.x >> 16); vp[2 * AT_VP] = (bf16)(vv.y & 0xffffu); vp[3 * AT_VP] = (bf16)(vv.y >> 16);
            vp[4 * AT_VP] = (bf16)(vv.z & 0xffffu); vp[5 * AT_VP] = (bf16)(vv.z >> 16); vp[6 * AT_VP] = (bf16)(vv.w & 0xffffu); vp[7 * AT_VP] = (bf16)(vv.w >> 16);
        }
        { const float* BT = (const float*)(P.ws + WS_BTAB) + hkv * 768;
          const float b0 = BT[tid_], b1 = (tid_ < 256) ? BT[512 + tid_] : 0.f;
          btab[tid_] = b0; if (tid_ < 256) btab[512 + tid_] = b1; }
        __syncthreads();
        const int g = F.wave & 3, h = hkv * 4 + g;
        const float sink2 = P.sinks[h] * LOG2E;
        bf16x8 qf[4], qfn[4];
#pragma unroll
        for (int kk = 0; kk < 4; ++kk) { qf[kk] = *(const bf16x8*)(PROJ + (size_t)(trow0 + 32 * ((F.wave >> 2) * 2) + r) * NPROJ + h * 64 + 16 * kk + 8 * hh);
            qfn[kk] = *(const bf16x8*)(PROJ + (size_t)(trow0 + 32 * ((F.wave >> 2) * 2 + 1) + r) * NPROJ + h * 64 + 16 * kk + 8 * hh); }
#pragma unroll 1
        for (int qq = 0; qq < 2; ++qq) {
            const int qt = (F.wave >> 2) * 2 + qq, t = trow0 + 32 * qt + r;
            f32x16 sc[5];
#pragma unroll
            for (int j = 0; j < 5; ++j) {
#pragma unroll
                for (int i = 0; i < 16; ++i) sc[j][i] = 0.f;
#pragma unroll
                for (int kk = 0; kk < 4; ++kk) { const bf16x8 a = *(const LAS bf16x8*)(Ks + (32 * (qt + j) + r) * AT_KP + 16 * kk + 8 * hh); sc[j] = MFMA32(a, qf[kk], sc[j]); }
            }
            float m = sink2;
            const LAS float* bt = btab + g * 192 + 160 + r - 4 * hh;
#pragma unroll
            for (int j = 0; j < 5; ++j) {
                const bool tile_ok = (n > 0) || (qt + j >= 4);
#pragma unroll
                for (int i = 0; i < 16; ++i) { const int dist = 128 + r - (32 * j + crow(i, hh));
                    const bool ok = tile_ok && (j == 0 ? dist < 128 : (j == 4 ? dist >= 0 : true));
                    const float s = sc[j][i] * (0.125f * LOG2E) + bt[-(32 * j + (i & 3) + 8 * (i >> 2))];
                    sc[j][i] = ok ? s : -INFINITY; m = fmaxf(m, sc[j][i]); }
            }
            m = max_halves(m);
            float l = 0.f;
#pragma unroll
            for (int j = 0; j < 5; ++j)
#pragma unroll
                for (int i = 0; i < 16; ++i) { sc[j][i] = exp2f(sc[j][i] - m); l += sc[j][i]; }
            l = sum_halves(l);
            l += exp2f(sink2 - m);
            const float inv = 1.f / l;
            f32x16 o[2];
#pragma unroll
            for (int i = 0; i < 16; ++i) { o[0][i] = 0.f; o[1][i] = 0.f; }
#pragma unroll
            for (int j = 0; j < 5; ++j)
#pragma unroll
                for (int sg = 0; sg < 2; ++sg) {
                    const bf16x8 pf = pack8(sc[j], sg);
#pragma unroll
                    for (int dt = 0; dt < 2; ++dt) {
                        const LAS bf16* vb = Vt + (32 * dt + r) * AT_VP + 32 * (qt + j) + 16 * sg + 4 * hh;
                        const s16x4 lo = *(const LAS s16x4*)(vb), hi = *(const LAS s16x4*)(vb + 8);
                        o[dt] = MFMA32(__builtin_shufflevector(lo, hi, 0, 1, 2, 3, 4, 5, 6, 7), pf, o[dt]);
                    }
                }
            bf16* op = CAT + (size_t)t * DM + h * 64 + 4 * hh;
#pragma unroll
            for (int dt = 0; dt < 2; ++dt)
#pragma unroll
                for (int g4 = 0; g4 < 4; ++g4)
                    *(unsigned long long*)(op + 32 * dt + 8 * g4) = (unsigned long long)cvtpk(o[dt][4 * g4] * inv, o[dt][4 * g4 + 1] * inv) | ((unsigned long long)cvtpk(o[dt][4 * g4 + 2] * inv, o[dt][4 * g4 + 3] * inv) << 32);
#pragma unroll
            for (int kk = 0; kk < 4; ++kk) qf[kk] = qfn[kk];
        }
        __syncthreads();
    }
}
struct Args { Ptrs p; };
__global__ void __launch_bounds__(NWAVES * 64, 2) hymba_fwd(Args args) {
    extern __shared__ __attribute__((aligned(16))) unsigned char lds[];
    const Ptrs& P = args.p;
    Frame F;
    F.lds = (LAS unsigned char*)lds;
    F.MISC = (volatile LAS unsigned*)(F.lds + MISC_OFF);
    F.wave = __builtin_amdgcn_readfirstlane(threadIdx.x >> 6);
    F.G = gridDim.x; { const int bx = blockIdx.x; F.vcu = (F.G % 8 == 0) ? (bx % 8) * (F.G / 8) + bx / 8 : bx; }
    F.ctl = (gu32*)(P.ws + WS_CTL);
    for (int u = threadIdx.x; u < (LDS_BYTES - LDSCTL_OFF) / 4; u += NWAVES * 64) ((LAS unsigned*)(F.lds + LDSCTL_OFF))[u] = 0u;
    __syncthreads();
    XcdBarrier bar = xcd_barrier_post((unsigned*)(F.ctl + CW_BAR), F.MISC + 8);
#define GRID_BAR() xcd_barrier(bar)

    bf16* XN = (bf16*)(P.ws + WS_XN); bf16* PROJ = (bf16*)(P.ws + WS_PROJ); bf16* HB = (bf16*)(P.ws + WS_ST);
    p0_prologue(F, P);
    GRID_BAR();
    { pg8::Gemm g{XN, (const bf16*)(P.ws + WS_WIN), T_, NPROJ, DM, F.wave}; pg8::StaticOrder S; S.init(T_, NPROJ, F.G, (int)blockIdx.x);
      pg8::EpiBf16<0> E{PROJ, NPROJ, nullptr, 0, 0, 1.f};
      pg8::gemm_phase<pg8::EpiBf16<0>, pg8::StaticOrder, PG8_ALIGN, PG8_SP2>(F.lds + RING_OFF, g, S, E); }
    if (F.G == 256 && blockIdx.x >= 64) p1_slack(F, P, ((int)blockIdx.x - 64) * NWAVES + F.wave, 192 * NWAVES);
    else if (F.G != 256) p1_slack(F, P, F.vcu * NWAVES + F.wave, F.G * NWAVES);
    GRID_BAR();
    ssd_s1(F, P);
    xcd_arrive(bar, F.MISC + 14);
    attn_phase(F, P);
    xcd_wait(bar, F.MISC + 14);
    ssd_s2(F, P);
    GRID_BAR();
    ssd_s3(F, P);
    GRID_BAR();
    { pg8::Gemm g{XN, (const bf16*)(P.ws + WS_WOUT), T_, DM, DM, F.wave}; pg8::StaticOrder S; S.init(T_, DM, F.G, (int)blockIdx.x);
      EpiResH E{P.x, HB, (float*)(P.ws + WS_SSQ)};
      pg8::gemm_phase<EpiResH, pg8::StaticOrder, PG8_ALIGN, PG8_SP2>(F.lds + RING_OFF, g, S, E); }
    GRID_BAR();
    { pg8::Gemm g{HB, (const bf16*)(P.ws + WS_WQ), T_, 2048, DM, F.wave}; pg8::StaticOrder S; S.init(T_, 2048, F.G, (int)blockIdx.x);
      EpiQTopk E{P.ws + WS_KEYB, (const float*)(P.ws + WS_SSQ), (int*)(P.ws + WS_IDX), (float*)(P.ws + WS_GATE)};
#pragma unroll 1
      for (int ui = 0; ui < 64; ++ui) { pg8::Unit u0; if (!S.next(ui, u0)) break;
          OneUnit S1{S, ui};
          pg8::gemm_phase<EpiQTopk, OneUnit, PG8_ALIGN, PG8_SP2>(F.lds + RING_OFF, g, S1, E); } }
    h_quant_rows(F, P);
    GRID_BAR();
    { const PeerPlace pp = peer_place(F);
      peer_down(F, P, pp); }
    GRID_BAR();
    peer_up_tm(F, P);
}

extern "C" void kernel_launch(void* const* d_in, const int* in_sizes, int n_in, void* d_out, int out_size, void* d_ws, size_t ws_size, hipStream_t stream) {
    static int grid = 0;
    if (grid == 0) {
        if (n_in != 19 || out_size != T_ * DM || ws_size < WS_END) { fprintf(stderr, "kernel_launch: unexpected shapes (n_in %d, out %d, ws %zu)\n", n_in, out_size, ws_size); grid = -1; return; }
        int dev = 0, cus = 0, per_cu = 0;
        if (hipGetDevice(&dev) != hipSuccess || hipDeviceGetAttribute(&cus, hipDeviceAttributeMultiprocessorCount, dev) != hipSuccess) { grid = -1; return; }
        if (hipFuncSetAttribute((const void*)hymba_fwd, hipFuncAttributeMaxDynamicSharedMemorySize, LDS_BYTES) != hipSuccess) { fprintf(stderr, "kernel_launch: hipFuncSetAttribute failed\n"); grid = -1; return; }
        if (hipOccupancyMaxActiveBlocksPerMultiprocessor(&per_cu, (const void*)hymba_fwd, NWAVES * 64, LDS_BYTES) != hipSuccess || per_cu < 1) { fprintf(stderr, "kernel_launch: occupancy query says %d blocks per CU\n", per_cu); grid = -1; (void)hipGetLastError(); return; }
        grid = cus;
    }
    if (grid < 0) return;
    (void)hipMemsetAsync((char*)d_ws + WS_CTL, 0, CTL_ZERO_BYTES, stream);
    Args a{};
    const float** pp = (const float**)&a.p;
    for (int i = 0; i < 19; ++i) pp[i] = (const float*)d_in[i];
    a.p.out = (float*)d_out; a.p.ws = (unsigned char*)d_ws;
    hipLaunchKernelGGL(hymba_fwd, dim3(grid), dim3(NWAVES * 64), LDS_BYTES, stream, a);
}
```

```cpp
#include <hip/hip_runtime.h>
#include <cstdio>
#include <cstdint>
#include <math.h>
namespace pg8 {
#define PG8_LAS __attribute__((address_space(3)))
typedef unsigned short bf16_t;
typedef short bf16x8 __attribute__((ext_vector_type(8)));
typedef float f32x4 __attribute__((ext_vector_type(4)));
typedef unsigned u32x4 __attribute__((ext_vector_type(4)));
constexpr int BM = 256, BK = 64, HALF = 128, HTB = HALF * BK * 2  , STAGE_BYTES = 8 * HTB, NXCD = 8, WGM = 8;

__host__ __device__ __forceinline__ int lds_byte(int r, int c) { const int st = (r >> 4) * 2 + (c >> 5), rr = r & 15, cc = c & 31, ob = rr * 64 + cc * 2; return st * 1024 + (ob ^ (((ob >> 9) & 1) << 5)); }
__host__ __device__ __forceinline__ void stage_rc(int b, int& R, int& C) { const int st = b / 1024, sb = b % 1024, swz = sb ^ (((sb >> 9) & 1) << 5); R = (st >> 1) * 16 + swz / 64; C = (st & 1) * 32 + (swz % 64) / 2; }
__host__ __device__ __forceinline__ int perm32(int rho) { const int n = rho >> 4, i = rho & 15; return 8 * (i >> 2) + 4 * n + (i & 3); }

struct Unit { int pm, pn; };
struct Gemm { const bf16_t* A; const bf16_t* Bt; int M, N, K, wave; };

struct StaticOrder {
    int nM, nN, nwg, G, c;
    __host__ __device__ void init(int M, int N, int G_, int c_) { nM = M / BM; nN = N / BM; nwg = nM * nN; G = G_; c = c_; }
    __host__ __device__ bool next(int i, Unit& u) const {
        const long L = (long)i * G + c; if (L >= nwg) return false;
        int wgid = (int)L; { const int q = nwg / NXCD, r = nwg % NXCD, xcd = wgid % NXCD, off = wgid / NXCD; wgid = (xcd < r ? xcd * (q + 1) : r * (q + 1) + (xcd - r) * q) + off; }
        const int nig = WGM * nN, gid = wgid / nig, fm = gid * WGM, gsz = (nM - fm) < WGM ? (nM - fm) : WGM;
        u.pm = fm + ((wgid % nig) % gsz); u.pn = (wgid % nig) / gsz; return true;
    }
    __device__ __forceinline__ void a_ready(const Unit&) const {}
    __device__ __forceinline__ void done(const Unit&) const {}
};

__device__ __forceinline__ unsigned cvt_pk_bf16(float lo, float hi) { unsigned r; asm volatile("v_cvt_pk_bf16_f32 %0, %1, %2" : "=v"(r) : "v"(lo), "v"(hi)); return r; }
typedef float f32x2 __attribute__((ext_vector_type(2)));
__device__ __forceinline__ f32x2 gelu_pk(f32x2 v) {
    const f32x2 av = __builtin_elementwise_abs(v), d = av * 0.2316418882f + 1.0f;
    f32x2 t; t.x = __builtin_amdgcn_rcpf(d.x); t.y = __builtin_amdgcn_rcpf(d.y);
    f32x2 q = t * 0.5307027145f + (-0.7265760135f); q = q * t + 0.7107068705f; q = q * t + (-0.142248368f); q = q * t + 0.127414796f; q = q * t;
    const f32x2 s = (v * v) * (-0.72134752044f);
    f32x2 e; e.x = __builtin_amdgcn_exp2f(s.x); e.y = __builtin_amdgcn_exp2f(s.y);
    const f32x2 m = v * (q * e), r = v - m;
    f32x2 o; o.x = v.x < 0.f ? m.x : r.x; o.y = v.y < 0.f ? m.y : r.y; return o;
}

template <int ACT  > struct EpiBf16 {
    static constexpr bool PERM = true, AFTER_DRAIN = false; static_assert(ACT == 0 || ACT == 1, "EpiBf16: ACT is 0 (none) or 1 (gelu_pk)");
    bf16_t* O; int ldc; const float* bias; int split_cols; size_t split_stride; float scale0;
    __device__ __forceinline__ void operator()(const f32x4 (&acc)[2][2][4][2], const Unit& u, int wr, int wc, int fr, int fq) const {
        const int row0 = u.pm * BM + wr * 64 + fr; int colt = u.pn * BM; bf16_t* base = O;
        float sc = 1.f; if (split_cols) { const int t = colt / split_cols; base += (size_t)t * split_stride; colt -= t * split_cols; if (t == 0) sc = scale0; }
        const int col0 = colt + wc * 32 + 8 * fq, bcol0 = u.pn * BM + wc * 32 + 8 * fq;
        f32x4 bv[2][2];
#pragma unroll
        for (int bj = 0; bj < 2; ++bj)
#pragma unroll
            for (int n = 0; n < 2; ++n) bv[bj][n] = bias ? *(const f32x4*)(bias + bcol0 + bj * HALF + 4 * n) : (f32x4){0.f, 0.f, 0.f, 0.f};
#pragma unroll
        for (int ai = 0; ai < 2; ++ai)
#pragma unroll
            for (int m = 0; m < 4; ++m) { bf16_t* rowp = base + (size_t)(row0 + ai * HALF + m * 16) * ldc + col0;
#pragma unroll
                for (int bj = 0; bj < 2; ++bj) { f32x4 v0 = acc[ai][bj][m][0] + bv[bj][0], v1 = acc[ai][bj][m][1] + bv[bj][1];
                    if (ACT == 1) { f32x2 a = gelu_pk((f32x2){v0[0], v0[1]}), b = gelu_pk((f32x2){v0[2], v0[3]}), c = gelu_pk((f32x2){v1[0], v1[1]}), d = gelu_pk((f32x2){v1[2], v1[3]});
                        v0 = (f32x4){a.x, a.y, b.x, b.y}; v1 = (f32x4){c.x, c.y, d.x, d.y}; }
                    v0 = v0 * sc; v1 = v1 * sc; u32x4 w; w.x = cvt_pk_bf16(v0[0], v0[1]); w.y = cvt_pk_bf16(v0[2], v0[3]); w.z = cvt_pk_bf16(v1[0], v1[1]); w.w = cvt_pk_bf16(v1[2], v1[3]);
                    *(u32x4*)(rowp + bj * HALF) = w; } }
    }
};
template <class Epi, class Sched, bool ALIGN_EPI = false, bool SP2 = false>
__device__ __forceinline__ void gemm_phase(PG8_LAS unsigned char* lds, const Gemm g, const Sched& S, const Epi& E) {
    int lane_l; asm volatile("v_mbcnt_lo_u32_b32 %0, -1, 0\n\tv_mbcnt_hi_u32_b32 %0, -1, %0" : "=v"(lane_l));
    const int wid = g.wave, lane = lane_l, tid = wid * 64 + lane,
              wr = wid >> 2, wc = wid & 3, fr = lane & 15, fq = lane >> 4;
    const int K = g.K, nt = K / BK;
    unsigned voffA[2], voffB[2];
#pragma unroll
    for (int i = 0; i < 2; ++i) { int R, C; stage_rc(tid * 16 + i * 8192, R, C); const int Rb = Epi::PERM ? ((R & ~31) + perm32(R & 31)) : R;
        voffA[i] = (unsigned)(R * K + C) * 2u; voffB[i] = (unsigned)(Rb * K + C) * 2u; }
    const size_t kstep = (size_t)(BK * 2);
    const size_t hstep = (size_t)HALF * K * 2;
    const size_t tstep = 2 * hstep;
    const unsigned ldsw = (unsigned)wid * 1024u;
    const int aoff = lds_byte(wr * 64 + fr, fq * 8), boff = lds_byte(wc * 32 + fr, fq * 8);
#define PG8_SA(b, h) (((b) * 2 + (h)) * HTB)
#define PG8_SB(b, h) ((4 + (b) * 2 + (h)) * HTB)
#define PG8_STAGE(bufoff, gbase, voff) do { _Pragma("unroll") for (int _i = 0; _i < 2; ++_i) \
        __builtin_amdgcn_global_load_lds((const unsigned*)((const char*)(gbase) + (voff)[_i]), (PG8_LAS unsigned*)(lds + (bufoff) + ldsw + _i * 8192), 16, 0, 0); } while (0)
#define PG8_LDA(dst, b, h) do { _Pragma("unroll") for (int m = 0; m < 4; ++m) _Pragma("unroll") for (int k = 0; k < 2; ++k) dst[m][k] = *(const PG8_LAS bf16x8*)(lds + PG8_SA(b, h) + aoff + m * 2048 + k * 1024); } while (0)
#define PG8_LDB(dst, b, h) do { _Pragma("unroll") for (int n = 0; n < 2; ++n) _Pragma("unroll") for (int k = 0; k < 2; ++k) dst[n][k] = *(const PG8_LAS bf16x8*)(lds + PG8_SB(b, h) + boff + n * 2048 + k * 1024); } while (0)
#define PG8_MMA(ai, bj, At, Bt) do { __builtin_amdgcn_s_setprio(1); _Pragma("unroll") for (int m = 0; m < 4; ++m) _Pragma("unroll") for (int n = 0; n < 2; ++n) _Pragma("unroll") for (int k = 0; k < 2; ++k) \
        acc[ai][bj][m][n] = __builtin_amdgcn_mfma_f32_16x16x32_bf16(Bt[n][k], At[m][k], acc[ai][bj][m][n], 0, 0, 0); __builtin_amdgcn_s_setprio(0); } while (0)
#define PG8_WAIT_V(n) asm volatile("s_waitcnt vmcnt(" #n ")" ::: "memory")
#define PG8_WAIT_L(n) asm volatile("s_waitcnt lgkmcnt(" #n ")" ::: "memory")
#define PG8_BAR __builtin_amdgcn_s_barrier()
#define PG8_SCHED __builtin_amdgcn_sched_barrier(0)
    Unit cur, nxt; int ui = 0;
    if (!S.next(0, cur)) return;
    f32x4 acc[2][2][4][2];
#pragma unroll
    for (int a = 0; a < 2; ++a)
#pragma unroll
        for (int b = 0; b < 2; ++b)
#pragma unroll
            for (int m = 0; m < 4; ++m)
#pragma unroll
                for (int n = 0; n < 2; ++n) acc[a][b][m][n] = (f32x4){0.f, 0.f, 0.f, 0.f};
    bf16x8 At[4][2], B0[2][2], B1[2][2];
    const char* cA = (const char*)g.A + (size_t)cur.pm * tstep; const char* cB = (const char*)g.Bt + (size_t)cur.pn * tstep;
    S.a_ready(cur);
    if constexpr (SP2) {
        PG8_STAGE(PG8_SB(0, 0), cB, voffB); PG8_STAGE(PG8_SB(0, 1), cB + hstep, voffB); PG8_STAGE(PG8_SA(0, 0), cA, voffA); PG8_STAGE(PG8_SA(0, 1), cA + hstep, voffA);
        if (wr == 1) PG8_BAR;
        PG8_WAIT_V(2); PG8_BAR;
        PG8_STAGE(PG8_SB(1, 0), cB + kstep, voffB); PG8_STAGE(PG8_SA(1, 0), cA + kstep, voffA); PG8_STAGE(PG8_SB(1, 1), cB + hstep + kstep, voffB);
        PG8_WAIT_V(6); PG8_BAR;
    } else {
        PG8_STAGE(PG8_SB(0, 0), cB, voffB); PG8_STAGE(PG8_SA(0, 0), cA, voffA); PG8_STAGE(PG8_SB(0, 1), cB + hstep, voffB); PG8_STAGE(PG8_SA(0, 1), cA + hstep, voffA);
        if (wr == 1) PG8_BAR;
        PG8_WAIT_V(4); PG8_BAR;
        PG8_STAGE(PG8_SB(1, 0), cB + kstep, voffB); PG8_STAGE(PG8_SA(1, 0), cA + kstep, voffA); PG8_STAGE(PG8_SB(1, 1), cB + hstep + kstep, voffB);
        PG8_WAIT_V(6); PG8_BAR;
    }
    for (;;) {
        const bool has_next = S.next(ui + 1, nxt);
        const char* nA = has_next ? (const char*)g.A + (size_t)nxt.pm * tstep : cA; const char* nB = has_next ? (const char*)g.Bt + (size_t)nxt.pn * tstep : cB;
        for (int t = 0; t < nt; t += 2) {
            const bool last = (t == nt - 2);
            const char* a1 = cA + (size_t)(t + 1) * kstep;
            const char* a2 = last ? nA : cA + (size_t)(t + 2) * kstep; const char* b2 = last ? nB : cB + (size_t)(t + 2) * kstep;
            const char* a3 = a2 + kstep; const char* b3 = b2 + kstep;
            if (last && has_next) S.a_ready(nxt);
            if constexpr (SP2) {
            PG8_LDB(B0, 0, 0); PG8_LDB(B1, 0, 1); PG8_SCHED; PG8_LDA(At, 0, 0); PG8_STAGE(PG8_SA(1, 1), a1 + hstep, voffA);
            PG8_WAIT_V(8); PG8_WAIT_L(0); PG8_BAR; PG8_MMA(0, 0, At, B0); PG8_MMA(0, 1, At, B1); PG8_BAR; PG8_SCHED;
            PG8_LDA(At, 0, 1); PG8_STAGE(PG8_SB(0, 0), b2, voffB); PG8_STAGE(PG8_SB(0, 1), b2 + hstep, voffB); PG8_STAGE(PG8_SA(0, 0), a2, voffA);
            PG8_WAIT_V(8); PG8_WAIT_L(0); PG8_BAR; PG8_MMA(1, 0, At, B0); PG8_MMA(1, 1, At, B1); PG8_BAR; PG8_SCHED;
            PG8_LDB(B0, 1, 0); PG8_LDB(B1, 1, 1); PG8_SCHED; PG8_LDA(At, 1, 0); PG8_STAGE(PG8_SA(0, 1), a2 + hstep, voffA);
            PG8_WAIT_V(8); PG8_WAIT_L(0); PG8_BAR; PG8_MMA(0, 0, At, B0); PG8_MMA(0, 1, At, B1); PG8_BAR; PG8_SCHED;
            PG8_LDA(At, 1, 1); PG8_STAGE(PG8_SB(1, 0), b3, voffB); PG8_STAGE(PG8_SB(1, 1), b3 + hstep, voffB); PG8_STAGE(PG8_SA(1, 0), a3, voffA);
            PG8_WAIT_V(8); PG8_WAIT_L(0); PG8_BAR; PG8_MMA(1, 0, At, B0); PG8_MMA(1, 1, At, B1); PG8_BAR; PG8_SCHED;
            } else {
            PG8_LDB(B0, 0, 0); PG8_SCHED; PG8_LDA(At, 0, 0); PG8_STAGE(PG8_SA(1, 1), a1 + hstep, voffA);
            PG8_WAIT_L(8); PG8_BAR; PG8_WAIT_L(0); PG8_MMA(0, 0, At, B0); PG8_BAR; PG8_SCHED;
            PG8_LDB(B1, 0, 1); PG8_STAGE(PG8_SB(0, 0), b2, voffB);
            PG8_BAR; PG8_WAIT_L(0); PG8_MMA(0, 1, At, B1); PG8_BAR;
            PG8_LDA(At, 0, 1); PG8_STAGE(PG8_SA(0, 0), a2, voffA);
            PG8_BAR; PG8_WAIT_L(0); PG8_MMA(1, 0, At, B0); PG8_BAR; PG8_SCHED;
            PG8_STAGE(PG8_SB(0, 1), b2 + hstep, voffB);
            PG8_WAIT_V(6); PG8_BAR; PG8_MMA(1, 1, At, B1); PG8_BAR;
            PG8_LDB(B0, 1, 0); PG8_SCHED; PG8_LDA(At, 1, 0); PG8_STAGE(PG8_SA(0, 1), a2 + hstep, voffA);
            PG8_WAIT_L(8); PG8_BAR; PG8_WAIT_L(0); PG8_MMA(0, 0, At, B0); PG8_BAR; PG8_SCHED;
            PG8_LDB(B1, 1, 1); PG8_STAGE(PG8_SB(1, 0), b3, voffB);
            PG8_BAR; PG8_WAIT_L(0); PG8_MMA(0, 1, At, B1); PG8_BAR;
            PG8_LDA(At, 1, 1); PG8_STAGE(PG8_SA(1, 0), a3, voffA);
            PG8_BAR; PG8_WAIT_L(0); PG8_MMA(1, 0, At, B0); PG8_BAR; PG8_SCHED;
            PG8_STAGE(PG8_SB(1, 1), b3 + hstep, voffB);
            PG8_WAIT_V(6); PG8_BAR; PG8_MMA(1, 1, At, B1); PG8_BAR;
            }
        }
        if constexpr (ALIGN_EPI) { if (wr == 0) PG8_BAR; }
        if constexpr (!Epi::AFTER_DRAIN) { E(acc, cur, wr, wc, fr, fq); S.done(cur); }
        if (!has_next) break;
#pragma unroll
        for (int a = 0; a < 2; ++a)
#pragma unroll
            for (int b = 0; b < 2; ++b)
#pragma unroll
                for (int m = 0; m < 4; ++m)
#pragma unroll
                    for (int n = 0; n < 2; ++n) acc[a][b][m][n] = (f32x4){0.f, 0.f, 0.f, 0.f};
        cur = nxt; cA = nA; cB = nB; ++ui;
        if constexpr (ALIGN_EPI) { if (wr == 1) PG8_BAR; }
    }
    PG8_WAIT_V(0);
    if constexpr (!ALIGN_EPI) { if (wr == 0) PG8_BAR; }
    PG8_BAR;
    if constexpr (Epi::AFTER_DRAIN) { E.fused(acc, cur, wr, wc, fr, fq, lds, wid, lane); S.done(cur); }
#undef PG8_SA
#undef PG8_SB
#undef PG8_STAGE
#undef PG8_LDA
#undef PG8_LDB
#undef PG8_MMA
#undef PG8_WAIT_V
#undef PG8_WAIT_L
#undef PG8_BAR
#undef PG8_SCHED
}
}

#ifndef PG8_SP2
#define PG8_SP2 true
#endif
#ifndef PG8_ALIGN
#define PG8_ALIGN true
#endif
#define GAS __attribute__((address_space(1)))
#define LAS __attribute__((address_space(3)))
typedef unsigned short bf16;
typedef unsigned v4u __attribute__((ext_vector_type(4)));
typedef float f32x4 __attribute__((ext_vector_type(4)));
typedef short bf16x8 __attribute__((ext_vector_type(8)));
typedef GAS unsigned gu32;
typedef GAS unsigned long long gu64;
#define RLX_AGENT __ATOMIC_RELAXED, __HIP_MEMORY_SCOPE_AGENT
#define LDS_WAIT() asm volatile("s_waitcnt lgkmcnt(0)" ::: "memory")
#define VM_WAIT() asm volatile("s_waitcnt vmcnt(0)" ::: "memory")
__device__ __forceinline__ unsigned long long rt() { return __builtin_amdgcn_s_memrealtime(); }
__device__ __forceinline__ unsigned f2bf(float f) { unsigned u = __builtin_bit_cast(unsigned, f); return (u + 0x7fffu + ((u >> 16) & 1u)) >> 16; }
__device__ __forceinline__ unsigned pk2(float lo, float hi) { return f2bf(lo) | (f2bf(hi) << 16); }

#define XB_TMO      128
#define XB_XCNT(j)  (256  + 64 * (j))
#define XB_XSUB(j)  (1280 + 64 * (j))
#define XB_XGEN(j)  (2304 + 64 * (j))
#define XB_TOP      3328
#define XB_TOPGEN   3392
#define XCD_BAR_WORDS 3456
#define XB_SPIN_CAP (1u << 22)

__device__ __forceinline__ unsigned xb_ld(unsigned* p)              { return __hip_atomic_load(p, __ATOMIC_RELAXED, __HIP_MEMORY_SCOPE_AGENT); }
__device__ __forceinline__ unsigned xb_add(unsigned* p, unsigned v) { return __hip_atomic_fetch_add(p, v, __ATOMIC_RELAXED, __HIP_MEMORY_SCOPE_AGENT); }
__device__ __forceinline__ unsigned xb_xcc_id() { return (unsigned)__builtin_amdgcn_s_getreg((3 << 11) | 20) & 0xFu; }
#define XB_SPIN(cond, bar) do { unsigned _sp = 0; while (cond) { __builtin_amdgcn_s_sleep(1); \
    if ((++_sp & 255u) == 0u) { if (xb_ld(&(bar)[XB_TMO])) break; if (_sp > XB_SPIN_CAP) { atomicAdd(&(bar)[XB_TMO], 1u); break; } } } } while (0)

struct XcdBarrier {
    unsigned* bar; unsigned x;
    volatile LAS unsigned* st;
};

__device__ __forceinline__ XcdBarrier xcd_barrier_post(unsigned* bar, volatile LAS unsigned* st) {
    XcdBarrier b; b.bar = bar; b.x = xb_xcc_id(); b.st = st;
    if (threadIdx.x == 0) (void)xb_add(&bar[XB_XCNT(b.x)], 1u);
    return b;
}
__device__ __forceinline__ void xcd_barrier_complete(unsigned* bar, unsigned x, unsigned& nloc, unsigned& nx) {
    const unsigned G = gridDim.x * gridDim.y * gridDim.z;
    unsigned sum, cnt, mine, sp = 0u;
    for (;;) {
        sum = 0u; cnt = 0u; mine = 0u;
#pragma unroll
        for (unsigned j = 0; j < 16; ++j) { const unsigned c = xb_ld(&bar[XB_XCNT(j)]); sum += c; cnt += (c > 0u) ? 1u : 0u; mine = (j == x) ? c : mine; }
        if (sum == G) break;
        __builtin_amdgcn_s_sleep(1);
        if ((++sp & 255u) == 0u) { if (xb_ld(&bar[XB_TMO])) break; if (sp > XB_SPIN_CAP) { atomicAdd(&bar[XB_TMO], 1u); break; } }
    }
    nloc = mine > 0u ? mine : 1u; nx = cnt > 0u ? cnt : 1u;
}

__device__ __forceinline__ void xcd_barrier(const XcdBarrier& b) {
    asm volatile("s_waitcnt vmcnt(0)" ::: "memory");
    __syncthreads();
    if (threadIdx.x == 0) {
        unsigned* bar = b.bar;
        __builtin_amdgcn_s_waitcnt(0);
        unsigned nloc = b.st[0], nx = b.st[1];
        if (nloc == 0u) { xcd_barrier_complete(bar, b.x, nloc, nx); b.st[0] = nloc; b.st[1] = nx; }
        const unsigned old = xb_add(&bar[XB_XSUB(b.x)], 1u);
        const unsigned gen = old / nloc;
        if (old + 1u == (gen + 1u) * nloc) {
            __builtin_amdgcn_fence(__ATOMIC_RELEASE, "agent");
            asm volatile("s_waitcnt vmcnt(0)" ::: "memory");
            const unsigned og = xb_add(&bar[XB_TOP], 1u);
            const unsigned tg = og / nx;
            if (og + 1u == (tg + 1u) * nx) xb_add(&bar[XB_TOPGEN], 1u);
            else XB_SPIN(xb_ld(&bar[XB_TOPGEN]) == tg, bar);
            __builtin_amdgcn_fence(__ATOMIC_ACQUIRE, "agent");
            asm volatile("s_waitcnt vmcnt(0)" ::: "memory");
        } else {
            XB_SPIN(xb_ld(&bar[XB_TOPGEN]) == gen, bar);
            __builtin_amdgcn_fence(__ATOMIC_ACQUIRE, "agent");
            asm volatile("s_waitcnt vmcnt(0)" ::: "memory");
        }
    }
    __syncthreads();
}

__device__ __forceinline__ void xcd_arrive(const XcdBarrier& b, volatile LAS unsigned* sx) {
    asm volatile("s_waitcnt vmcnt(0)" ::: "memory");
    __syncthreads();
    if (threadIdx.x == 0) {
        unsigned* bar = b.bar;
        __builtin_amdgcn_s_waitcnt(0);
        unsigned nloc = b.st[0], nx = b.st[1];
        if (nloc == 0u) { xcd_barrier_complete(bar, b.x, nloc, nx); b.st[0] = nloc; b.st[1] = nx; }
        const unsigned old = xb_add(&bar[XB_XSUB(b.x)], 1u);
        const unsigned gen = old / nloc;
        unsigned leader = 0u, key = gen;
        if (old + 1u == (gen + 1u) * nloc) {
            leader = 1u;
            __builtin_amdgcn_fence(__ATOMIC_RELEASE, "agent");
            asm volatile("s_waitcnt vmcnt(0)" ::: "memory");
            const unsigned og = xb_add(&bar[XB_TOP], 1u);
            const unsigned tg = og / nx; key = tg;
            if (og + 1u == (tg + 1u) * nx) xb_add(&bar[XB_TOPGEN], 1u);
        }
        sx[0] = leader; sx[1] = key;
    }
}
__device__ __forceinline__ void xcd_wait(const XcdBarrier& b, volatile LAS unsigned* sx) {
    if (threadIdx.x == 0) {
        unsigned* bar = b.bar;
        const unsigned leader = sx[0], key = sx[1];
        if (leader) {
            XB_SPIN(xb_ld(&bar[XB_TOPGEN]) == key, bar);
            __builtin_amdgcn_fence(__ATOMIC_ACQUIRE, "agent");
            asm volatile("s_waitcnt vmcnt(0)" ::: "memory");
        } else {
            XB_SPIN(xb_ld(&bar[XB_TOPGEN]) == key, bar);
            __builtin_amdgcn_fence(__ATOMIC_ACQUIRE, "agent");
            asm volatile("s_waitcnt vmcnt(0)" ::: "memory");
        }
    }
    __syncthreads();
}

constexpr int NWAVES = 8;
constexpr int T_ = 16384, SEQ = 4096, DM = 1024, NPROJ = 2304, INC = 2312;
constexpr int PJ_K = 512, PJ_V = 640, PJ_Z = 768, PJ_XBC = 1280;
constexpr float EPS = 1e-6f;
constexpr size_t MiB = 1u << 20;
constexpr size_t WS_CTL = 0, CTL_ZERO_BYTES = 1 * MiB;
constexpr size_t WS_KEYB = 1 * MiB + 256 * 1024;
constexpr size_t WS_BTAB = 1 * MiB + 384 * 1024;
constexpr size_t WS_SMALL = 1 * MiB;
constexpr size_t WS_WIN = 2 * MiB, WS_WOUT = 7 * MiB, WS_WQ = 9 * MiB;
constexpr size_t WS_ED = 13 * MiB, WS_EU = 29 * MiB;
constexpr size_t WS_XN = 77 * MiB;
constexpr size_t WS_PROJ = 109 * MiB;
constexpr size_t WS_ST = 181 * MiB;
constexpr size_t WS_IDX = 213 * MiB, WS_GATE = 221 * MiB, WS_SSQ = 229 * MiB, WS_END = 230 * MiB;
constexpr size_t DO_Y = 0, DO_DT = 41 * MiB;
constexpr size_t WS_CC = 230 * MiB, WS_DT = 238 * MiB, WS_EA = 239 * MiB, WS_CDEC = 240 * MiB, WS_PREV = WS_IDX;
constexpr size_t DO_YPF = 0, DO_YPLAIN = 32 * MiB;
constexpr size_t WS_PART = WS_PROJ;
constexpr size_t WS_H8 = WS_XN, WS_HS = WS_DT;
constexpr size_t WS_SSQ2 = WS_EA;
constexpr int CW_BAR = 4096, CW_RANK = 8192;
constexpr int RING_OFF = 0, RING_BYTES = 147456, LDSCTL_OFF = RING_BYTES, MISC_OFF = LDSCTL_OFF + 320, LDS_BYTES = 163840;

__constant__ unsigned char c_bucket[128] = {0, 1, 2, 3, 4, 5, 6, 7, 8, 9, 10, 11, 12, 13, 14, 15, 16, 16, 16, 17, 17, 18, 18, 18, 19, 19, 19, 20, 20, 20, 20, 21, 21, 21, 21, 22, 22, 22, 22, 22, 23, 23, 23, 23, 23, 23, 24, 24, 24, 24, 24, 24, 25, 25, 25, 25, 25, 25, 25, 26, 26, 26, 26, 26, 26, 26, 26, 27, 27, 27, 27, 27, 27, 27, 27, 27, 27, 28, 28, 28, 28, 28, 28, 28, 28, 28, 28, 29, 29, 29, 29, 29, 29, 29, 29, 29, 29, 29, 29, 30, 30, 30, 30, 30, 30, 30, 30, 30, 30, 30, 30, 30, 30, 31, 31, 31, 31, 31, 31, 31, 31, 31, 31, 31, 31, 31, 31, 31};

typedef float v16f __attribute__((ext_vector_type(16)));
typedef float v32f __attribute__((ext_vector_type(32)));
typedef unsigned v6u __attribute__((ext_vector_type(6)));
typedef _Float16 v32h __attribute__((ext_vector_type(32)));
struct Frame {
    LAS unsigned char* lds;
    volatile LAS unsigned* MISC;
    gu32* ctl;
    int wave, vcu, G;
};
__device__ __forceinline__ int lane_id() { int l; asm volatile("v_mbcnt_lo_u32_b32 %0, -1, 0\n\tv_mbcnt_hi_u32_b32 %0, -1, %0" : "=v"(l)); return l; }
__device__ __forceinline__ int opq(int x) { asm volatile("" : "+v"(x)); return x; }
template <int M> __device__ __forceinline__ float swz_xor(float v) { return __int_as_float(__builtin_amdgcn_ds_swizzle(__float_as_int(v), (M << 10) | 0x1F)); }
__device__ __forceinline__ float sum_halves(float v) { const auto r = __builtin_amdgcn_permlane32_swap(__float_as_uint(v), __float_as_uint(v), false, false); return __uint_as_float(r[0]) + __uint_as_float(r[1]); }
__device__ __forceinline__ float max_halves(float v) { const auto r = __builtin_amdgcn_permlane32_swap(__float_as_uint(v), __float_as_uint(v), false, false); return fmaxf(__uint_as_float(r[0]), __uint_as_float(r[1])); }
__device__ __forceinline__ int imax_halves(int v) { const auto r = __builtin_amdgcn_permlane32_swap((unsigned)v, (unsigned)v, false, false); return max((int)r[0], (int)r[1]); }
__device__ __forceinline__ float wave_sum(float v) {
    v += swz_xor<1>(v); v += swz_xor<2>(v); v += swz_xor<4>(v); v += swz_xor<8>(v); v += swz_xor<16>(v);
    return sum_halves(v);
}
__device__ __forceinline__ float bf2f(unsigned short b) { return __uint_as_float((unsigned)b << 16); }
__device__ __forceinline__ float bflo(unsigned w) { return __uint_as_float(w << 16); }
__device__ __forceinline__ float bfhi(unsigned w) { return __uint_as_float(w & 0xffff0000u); }
__device__ __forceinline__ float silu_f(float x) { return x / (1.f + __expf(-x)); }

__device__ __forceinline__ void p0_transpose_item(const float* W, int ldw, int K, int nblk, bf16* WT, const float* kscale, LAS float* scr, int item, int lane) {
    const int kb = item / nblk, nb = item % nblk, k0 = 64 * kb, n0 = 32 * nb;
    float ks_[32];
#pragma unroll
    for (int i = 0; i < 32; ++i) ks_[i] = kscale ? kscale[k0 + 2 * i + (lane >> 5)] : 1.f;
    float vv_[32];
#pragma unroll
    for (int i = 0; i < 32; ++i) vv_[i] = W[(size_t)(k0 + 2 * i + (lane >> 5)) * ldw + n0 + (lane & 31)];
#pragma unroll
    for (int i = 0; i < 32; ++i) scr[(2 * i + (lane >> 5)) * 33 + (lane & 31)] = vv_[i] * ks_[i];
#pragma unroll 1
    for (int i = 32; i < 32; ++i) { const int kk = 2 * i + (lane >> 5); float v = W[(size_t)(k0 + kk) * ldw + n0 + (lane & 31)]; if (kscale) v *= kscale[k0 + kk]; scr[kk * 33 + (lane & 31)] = v; }
    LDS_WAIT(); asm volatile("" ::: "memory");
    const int c = lane & 7;
#pragma unroll
    for (int j = 0; j < 4; ++j) { const int n = (lane >> 3) + 8 * j; const LAS float* s = scr + (8 * c) * 33 + n;
        v4u o; o.x = pk2(s[0 * 33], s[1 * 33]); o.y = pk2(s[2 * 33], s[3 * 33]); o.z = pk2(s[4 * 33], s[5 * 33]); o.w = pk2(s[6 * 33], s[7 * 33]);
        *(GAS v4u*)(WT + (size_t)(n0 + n) * K + k0 + 8 * c) = o; }
    LDS_WAIT(); asm volatile("" ::: "memory");
}
struct Ptrs {
    const float *x, *norm_mix, *w_in, *conv_w, *conv_b, *dt_bias, *a_log, *d_skip, *ssd_norm_w, *sinks, *w_out, *rel_bias, *norm_ffn, *w_query, *sk1, *sk2, *e_down, *e_up, *norm_final;
    float* out; unsigned char* ws;
};
constexpr int Q_SPLIT = 0;
__device__ __forceinline__ unsigned pack4_i8(float a, float b, float c, float d) {
    const int ia = __float2int_rn(a), ib = __float2int_rn(b), ic = __float2int_rn(c), id = __float2int_rn(d);
    return (unsigned)(ia & 0xff) | ((unsigned)(ib & 0xff) << 8) | ((unsigned)(ic & 0xff) << 16) | ((unsigned)(id & 0xff) << 24);
}
__device__ __forceinline__ unsigned pack8_i4(const float* v, float inv) {
    unsigned o = 0u;
#pragma unroll
    for (int i = 0; i < 8; ++i) { int q = __float2int_rn(v[i] * inv); q = q < -7 ? -7 : (q > 7 ? 7 : q); o |= ((unsigned)q & 15u) << (4 * i); }
    return o;
}
__device__ __forceinline__ void quant_fp8s(const Ptrs& P, int lane_, int r_lo, int r_hi, int w, int nw) {
    float* SC = (float*)(P.ws + WS_SMALL);
    int row = r_lo + w;
    if (row >= r_hi) return;
    float4 w4[4];
#pragma unroll
    for (int q = 0; q < 4; ++q) w4[q] = ((const float4*)P.norm_ffn)[4 * lane_ + q];
    float4 ba[4], bb[4];
#define QD_LOAD(B_, R_) do { const int rl_ = ((R_) < r_hi) ? (R_) : (r_lo + w); _Pragma("unroll") for (int q = 0; q < 4; ++q) B_[q] = ((const float4*)(P.e_down + (size_t)(rl_ & 16383) * DM) + 4 * lane_)[q]; } while (0)
#define QD_STORE() do { *(unsigned long long*)(P.ws + WS_ED + ((size_t)(lane_ >> 4) * 16384 + (prow & 16383)) * 128 + (lane_ & 15) * 8) = po; if (lane_ == 0) SC[prow] = psc; } while (0)
#define QD_WORK(B_, R_) do { float v[16]; \
        _Pragma("unroll") for (int q = 0; q < 4; ++q) { const float4 t = B_[q]; v[4 * q] = t.x * w4[q].x; v[4 * q + 1] = t.y * w4[q].y; v[4 * q + 2] = t.z * w4[q].z; v[4 * q + 3] = t.w * w4[q].w; } \
        float ss = 0.f; _Pragma("unroll") for (int q = 0; q < 16; ++q) ss = fmaf(v[q], v[q], ss); \
        const float sc = fmaxf(2.5f * sqrtf(wave_sum(ss) * (1.f / 1024.f)) * (1.f / 7.f), 1e-30f); const float inv = 1.f / sc; \
        po = (unsigned long long)pack8_i4(v, inv) | ((unsigned long long)pack8_i4(v + 8, inv) << 32); psc = sc; prow = (R_); } while (0)
    unsigned long long po; float psc; int prow;
    QD_LOAD(ba, row);
    QD_LOAD(bb, row + nw);
    __builtin_amdgcn_sched_barrier(0);
    QD_WORK(ba, row);
    row += nw;
    while (row < r_hi) {
        QD_STORE();
        QD_LOAD(ba, row + nw);
        __builtin_amdgcn_sched_barrier(0);
        QD_WORK(bb, row);
        __builtin_amdgcn_sched_barrier(0);
        row += nw; if (row >= r_hi) break;
        QD_STORE();
        QD_LOAD(bb, row + nw);
        __builtin_amdgcn_sched_barrier(0);
        QD_WORK(ba, row);
        __builtin_amdgcn_sched_barrier(0);
        row += nw;
    }
    QD_STORE();
#undef QD_LOAD
#undef QD_STORE
#undef QD_WORK
}
typedef float f32x2q __attribute__((ext_vector_type(2)));
__device__ __forceinline__ void quant_fp6u(const Ptrs& P, int lane_, int q_lo, int q_hi, int w, int nw) {
    float* SC = (float*)(P.ws + WS_SMALL);
    int e = 2 * q_lo + w; const int e_hi = 2 * q_hi;
    if (e >= e_hi) return;
    float4 ba[4], bb[4];
#define QU_LOAD(B_, E_) do { const int el_ = ((E_) < e_hi) ? (E_) : (2 * q_lo + w); _Pragma("unroll") for (int k = 0; k < 4; ++k) B_[k] = ((const float4*)(P.e_up + (size_t)el_ * DM) + 4 * lane_)[k]; } while (0)
#define QU_STORE() do { *(unsigned long long*)(P.ws + WS_EU + (size_t)pe * 512 + 8 * lane_) = po; if (lane_ == 0) SC[16384 + pe] = psc; } while (0)
#define QU_WORK(B_, E_) do { float v[16]; \
        _Pragma("unroll") for (int k = 0; k < 4; ++k) { const float4 t = B_[k]; v[4 * k] = t.x; v[4 * k + 1] = t.y; v[4 * k + 2] = t.z; v[4 * k + 3] = t.w; } \
        float am = 0.f; _Pragma("unroll") for (int k = 0; k < 16; ++k) am = fmaxf(am, fabsf(v[k])); \
        am = fmaxf(am, swz_xor<1>(am)); am = fmaxf(am, swz_xor<2>(am)); am = fmaxf(am, swz_xor<4>(am)); am = fmaxf(am, swz_xor<8>(am)); am = fmaxf(am, swz_xor<16>(am)); am = max_halves(am); \
        am = fmaxf(am, 1e-30f); const float inv = 6.0f / am; unsigned pk[2]; \
        _Pragma("unroll") for (int wd = 0; wd < 2; ++wd) { unsigned p4 = 0u; \
            p4 = __builtin_amdgcn_cvt_scalef32_pk_fp4_f32(p4, v[8 * wd] * inv, v[8 * wd + 1] * inv, 1.0f, 0); \
            p4 = __builtin_amdgcn_cvt_scalef32_pk_fp4_f32(p4, v[8 * wd + 2] * inv, v[8 * wd + 3] * inv, 1.0f, 1); \
            p4 = __builtin_amdgcn_cvt_scalef32_pk_fp4_f32(p4, v[8 * wd + 4] * inv, v[8 * wd + 5] * inv, 1.0f, 2); \
            p4 = __builtin_amdgcn_cvt_scalef32_pk_fp4_f32(p4, v[8 * wd + 6] * inv, v[8 * wd + 7] * inv, 1.0f, 3); \
            pk[wd] = p4; } \
        po = (unsigned long long)pk[0] | ((unsigned long long)pk[1] << 32); psc = am * (1.f / 6.0f); pe = (E_); } while (0)
    unsigned long long po; float psc; int pe;
    QU_LOAD(ba, e);
    QU_LOAD(bb, e + nw);
    __builtin_amdgcn_sched_barrier(0);
    QU_WORK(ba, e);
    __builtin_amdgcn_sched_barrier(0);
    e += nw;
    while (e < e_hi) {
        QU_STORE();
        QU_LOAD(ba, e + nw);
        __builtin_amdgcn_sched_barrier(0);
        QU_WORK(bb, e);
        __builtin_amdgcn_sched_barrier(0);
        e += nw; if (e >= e_hi) break;
        QU_STORE();
        QU_LOAD(bb, e + nw);
        __builtin_amdgcn_sched_barrier(0);
        QU_WORK(ba, e);
        __builtin_amdgcn_sched_barrier(0);
        e += nw;
    }
    QU_STORE();
#undef QU_LOAD
#undef QU_STORE
#undef QU_WORK
}
__device__ __forceinline__ void p0_prologue(Frame& F0, const Ptrs& P) {
    const Frame& F = F0; const int lane_ = lane_id(), tid_ = F.wave * 64 + lane_;
    LAS float* scr = (LAS float*)(F.lds + RING_OFF + F.wave * 16384);
    const int gw = F.vcu * NWAVES + F.wave, NGW = F.G * NWAVES;
    bf16* Win_t = (bf16*)(P.ws + WS_WIN); bf16* Wout_t = (bf16*)(P.ws + WS_WOUT); bf16* Wq_t = (bf16*)(P.ws + WS_WQ);
    constexpr int I_IN = 16 * 72;
    for (int it = gw; it < I_IN; it += NGW) p0_transpose_item(P.w_in, INC, DM, 72, Win_t, nullptr, scr, it, lane_);
    (void)Wout_t; (void)Wq_t;
    __syncthreads();
    { LAS float* Wdt = (LAS float*)(F.lds + RING_OFF);
      { float wd_[16];
#pragma unroll
        for (int q = 0; q < 16; ++q) { const int i = tid_ + 512 * q; wd_[q] = P.w_in[(size_t)(i >> 3) * INC + NPROJ + (i & 7)]; }
#pragma unroll
        for (int q = 0; q < 16; ++q) Wdt[tid_ + 512 * q] = wd_[q]; }
      __syncthreads();
      bf16* XN = (bf16*)(P.ws + WS_XN); float* DT = (float*)(P.ws + WS_DT);
      float4 nmw[4];
#pragma unroll
      for (int j = 0; j < 4; ++j) nmw[j] = ((const float4*)P.norm_mix)[j * 64 + lane_];
      float4 xnx[2][4];
      if (gw * 2 < T_) {
#pragma unroll
        for (int rr = 0; rr < 2; ++rr)
#pragma unroll
            for (int j = 0; j < 4; ++j) xnx[rr][j] = ((const float4*)(P.x + (size_t)(gw * 2 + rr) * DM))[j * 64 + lane_]; }
      for (int m0 = gw * 2; m0 < T_; m0 += NGW * 2) {
        float4 xv[2][4];
#pragma unroll
        for (int rr = 0; rr < 2; ++rr)
#pragma unroll
            for (int j = 0; j < 4; ++j) xv[rr][j] = xnx[rr][j];
        { const int mn = (m0 + NGW * 2 < T_) ? m0 + NGW * 2 : m0;
#pragma unroll
          for (int rr = 0; rr < 2; ++rr)
#pragma unroll
              for (int j = 0; j < 4; ++j) xnx[rr][j] = ((const float4*)(P.x + (size_t)(mn + rr) * DM))[j * 64 + lane_]; }
#pragma unroll
        for (int rr = 0; rr < 2; ++rr) { const int m = m0 + rr;
        float4 v[4]; float s = 0.f;
#pragma unroll
        for (int j = 0; j < 4; ++j) { v[j] = xv[rr][j]; s += v[j].x * v[j].x + v[j].y * v[j].y + v[j].z * v[j].z + v[j].w * v[j].w; }
        const float r = rsqrtf(wave_sum(s) * (1.f / 1024.f) + EPS);
        float d8[8];
#pragma unroll
        for (int q = 0; q < 8; ++q) d8[q] = 0.f;
        unsigned long long* o8 = (unsigned long long*)(XN + (size_t)m * DM);
#pragma unroll
        for (int j = 0; j < 4; ++j) { const float4 w = nmw[j];
            const float e0 = v[j].x * r * w.x, e1 = v[j].y * r * w.y, e2 = v[j].z * r * w.z, e3 = v[j].w * r * w.w;
            o8[j * 64 + lane_] = (unsigned long long)pk2(e0, e1) | ((unsigned long long)pk2(e2, e3) << 32);
            const float ev[4] = {e0, e1, e2, e3};
#pragma unroll
            for (int e = 0; e < 4; ++e) { const LAS f32x4* wr = (const LAS f32x4*)(Wdt + (size_t)(j * 256 + lane_ * 4 + e) * 8); const f32x4 w0 = wr[0], w1 = wr[1];
                d8[0] += ev[e] * w0.x; d8[1] += ev[e] * w0.y; d8[2] += ev[e] * w0.z; d8[3] += ev[e] * w0.w; d8[4] += ev[e] * w1.x; d8[5] += ev[e] * w1.y; d8[6] += ev[e] * w1.z; d8[7] += ev[e] * w1.w; } }
#pragma unroll
        for (int q = 0; q < 8; ++q) d8[q] = wave_sum(d8[q]);
        { float4* dp = (float4*)(DT + (size_t)m * 8) + (lane_ & 1); const float4 dv = (lane_ & 1) ? make_float4(d8[4], d8[5], d8[6], d8[7]) : make_float4(d8[0], d8[1], d8[2], d8[3]); *dp = dv; }
        }
      }
      __syncthreads(); }
}

__device__ __forceinline__ void p1_slack(Frame& F0, const Ptrs& P, int w, int nw) {
    const Frame& F = F0; const int lane_ = lane_id();
    LAS float* scr = (LAS float*)(F.lds + RING_OFF + F.wave * 16384);
    bf16* Wout_t = (bf16*)(P.ws + WS_WOUT); bf16* Wq_t = (bf16*)(P.ws + WS_WQ);
    constexpr int I_OUT = 16 * 32, I_Q = 16 * 64;
    for (int it = w; it < I_OUT + I_Q; it += nw) {
        if (it < I_OUT) p0_transpose_item(P.w_out, DM, DM, 32, Wout_t, nullptr, scr, it, lane_);
        else p0_transpose_item(P.w_query, 2048, DM, 64, Wq_t, P.norm_ffn, scr, it - I_OUT, lane_);
    }
    { unsigned long long* KB = (unsigned long long*)(P.ws + WS_KEYB);
      for (int i = w * 64 + lane_; i < 8192; i += nw * 64) { const float4 t = (i < 4096) ? ((const float4*)P.sk1)[i] : ((const float4*)P.sk2)[i - 4096];
          KB[i] = (unsigned long long)pk2(t.x, t.y) | ((unsigned long long)pk2(t.z, t.w) << 32); } }
    { float* BT = (float*)(P.ws + WS_BTAB);
      for (int i = w * 64 + lane_; i < 1536; i += nw * 64) { const int hkv = i / 768, rr = i % 768, gg = rr / 192, dist = rr % 192 - 32;
          BT[i] = (dist >= 0 && dist < 128) ? P.rel_bias[c_bucket[dist & 127] * 8 + hkv * 4 + gg] * 1.4426950408889634f : 0.f; } }
    quant_fp6u(P, lane_, 0, 8192, w, nw);
    quant_fp8s(P, lane_, 0, 16384, w, nw);
}
struct EpiResH {
    static constexpr bool PERM = false, AFTER_DRAIN = false;
    const float* X; bf16* HB; float* SSQ;
    __device__ __forceinline__ void ldx(pg8::f32x4 (&d)[4], int row, int col0) const {
#pragma unroll
        for (int bj = 0; bj < 2; ++bj)
#pragma unroll
            for (int n = 0; n < 2; ++n) d[bj * 2 + n] = *(const pg8::f32x4*)(X + (size_t)row * DM + col0 + bj * 128 + n * 16);
    }
    __device__ __forceinline__ void operator()(const pg8::f32x4 (&acc)[2][2][4][2], const pg8::Unit& u, int wr, int wc, int fr, int fq) const {
        const int row0 = u.pm * 256 + wr * 64 + fr, col0 = u.pn * 256 + wc * 32 + 4 * fq;
        pg8::f32x4 xq[2][4];
        ldx(xq[0], row0, col0);
#pragma unroll
        for (int g = 0; g < 8; ++g) { const int ai = g >> 2, m = g & 3, row = row0 + ai * 128 + m * 16;
            if (g + 1 < 8) ldx(xq[(g + 1) & 1], row0 + ((g + 1) >> 2) * 128 + ((g + 1) & 3) * 16, col0);
            float ss = 0.f;
#pragma unroll
            for (int bj = 0; bj < 2; ++bj)
#pragma unroll
                for (int n = 0; n < 2; ++n) { const size_t off = (size_t)row * DM + col0 + bj * 128 + n * 16;
                    const pg8::f32x4 h = acc[ai][bj][m][n] + xq[g & 1][bj * 2 + n];
                    ss += h[0] * h[0] + h[1] * h[1] + h[2] * h[2] + h[3] * h[3];
                    *(unsigned long long*)(HB + off) = (unsigned long long)pk2(h[0], h[1]) | ((unsigned long long)pk2(h[2], h[3]) << 32); }
            ss += swz_xor<16>(ss); ss = sum_halves(ss);
            if (fq == 0) SSQ[(size_t)row * 16 + u.pn * 4 + wc] = ss; }
    }
};

typedef float f32x16 __attribute__((ext_vector_type(16)));
typedef short s16x4 __attribute__((ext_vector_type(4)));
typedef float f32x2_t __attribute__((ext_vector_type(2)));
typedef __bf16 bf16x2_t __attribute__((ext_vector_type(2)));
#define MFMA32(a, b, c) __builtin_amdgcn_mfma_f32_32x32x16_bf16((a), (b), (c), 0, 0, 0)
__device__ __forceinline__ int crow(int reg, int h) { return (reg & 3) + 8 * (reg >> 2) + 4 * h; }
__device__ __forceinline__ unsigned cvtpk(float lo, float hi) { f32x2_t v = {lo, hi}; bf16x2_t b = __builtin_convertvector(v, bf16x2_t); return __builtin_bit_cast(unsigned, b); }
__device__ __forceinline__ bf16x8 pack8(const f32x16& x, int s) {
    v4u p; p.x = cvtpk(x[8 * s], x[8 * s + 1]); p.y = cvtpk(x[8 * s + 2], x[8 * s + 3]); p.z = cvtpk(x[8 * s + 4], x[8 * s + 5]); p.w = cvtpk(x[8 * s + 6], x[8 * s + 7]);
    return __builtin_bit_cast(bf16x8, p);
}
constexpr float LOG2E = 1.4426950408889634f;
constexpr int LDP = 136;
constexpr int S1_XT = 0, S1_XTW = 17408, S1_BSN = 34816, S1_CLN = 69632, S1_BNL = 104448, S1_F32 = 139264;

__device__ __forceinline__ float silu_fast(float x) { return x * __builtin_amdgcn_rcpf(1.f + __builtin_amdgcn_exp2f(-x * LOG2E)); }
__device__ __forceinline__ int swz_t(int row, int l) { return row * LDP + ((((l >> 3) ^ (row >> 3)) & 7) | ((l >> 3) & 8)) * 8 + (l & 7); }
#define S1_CONV8(A_, IT_) do { _Pragma("unroll") for (int e_ = 0; e_ < 8; ++e_) A_[e_] = bias[e_]; \
        _Pragma("unroll") for (int j_ = 0; j_ < 4; ++j_) { const v4u rw_ = raw[(IT_) + j_]; \
            A_[0] += w[j_][0] * bflo(rw_.x); A_[1] += w[j_][1] * bfhi(rw_.x); A_[2] += w[j_][2] * bflo(rw_.y); A_[3] += w[j_][3] * bfhi(rw_.y); \
            A_[4] += w[j_][4] * bflo(rw_.z); A_[5] += w[j_][5] * bfhi(rw_.z); A_[6] += w[j_][6] * bflo(rw_.w); A_[7] += w[j_][7] * bfhi(rw_.w); } \
        _Pragma("unroll") for (int e_ = 0; e_ < 8; ++e_) A_[e_] = silu_fast(A_[e_]); } while (0)
#define S1_LOADW(CHB_) do { _Pragma("unroll") for (int j_ = 0; j_ < 4; ++j_) { const float4 w0_ = *(const float4*)(P.conv_w + j_ * 1024 + (CHB_)), w1_ = *(const float4*)(P.conv_w + j_ * 1024 + (CHB_) + 4); \
            w[j_][0] = w0_.x; w[j_][1] = w0_.y; w[j_][2] = w0_.z; w[j_][3] = w0_.w; w[j_][4] = w1_.x; w[j_][5] = w1_.y; w[j_][6] = w1_.z; w[j_][7] = w1_.w; } \
        { const float4 b0_ = *(const float4*)(P.conv_b + (CHB_)), b1_ = *(const float4*)(P.conv_b + (CHB_) + 4); \
          bias[0] = b0_.x; bias[1] = b0_.y; bias[2] = b0_.z; bias[3] = b0_.w; bias[4] = b1_.x; bias[5] = b1_.y; bias[6] = b1_.z; bias[7] = b1_.w; } } while (0)
__device__ __forceinline__ void ssd_s1(Frame& F, const Ptrs& P) {
    const bf16* PROJ = (const bf16*)(P.ws + WS_PROJ); const float* DT = (const float*)(P.ws + WS_DT);
    float* EA = (float*)(P.ws + WS_EA); float* CDEC = (float*)(P.ws + WS_CDEC); bf16* CC = (bf16*)(P.ws + WS_CC);
    unsigned* ST = (unsigned*)(P.ws + WS_ST); unsigned* YPF = (unsigned*)((char*)P.out + DO_YPF);
    LAS unsigned char* L = F.lds + RING_OFF;
    LAS bf16* Xt = (LAS bf16*)(L + S1_XT); LAS bf16* Xtw = (LAS bf16*)(L + S1_XTW); LAS bf16* Bsn = (LAS bf16*)(L + S1_BSN); LAS bf16* Cln = (LAS bf16*)(L + S1_CLN); LAS bf16* Bnl = (LAS bf16*)(L + S1_BNL);
    LAS float* f32base = (LAS float*)(L + S1_F32);
    const int lane = lane_id(); const int tid_ = F.wave * 64 + lane;
    for (int ug = F.vcu; ug < 256; ug += F.G) {
        const int grp = ug & 1, c = (ug >> 1) & 31, b = ug >> 6, t0 = b * SEQ + c * 128;
        __syncthreads();
        if (F.wave < 4) {
            const int h = 4 * grp + F.wave, us = (b * 32 + c) * 8 + h;
            const float A = -__expf(P.a_log[h]), dtb = P.dt_bias[h];
            const int ln = opq(lane_id());
            LAS float* acum2 = f32base + F.wave * 384; LAS float* wv = acum2 + 128; LAS float* wend = wv + 128;
            const float x0 = DT[(size_t)(t0 + 2 * ln) * 8 + h] + dtb, x1 = DT[(size_t)(t0 + 2 * ln + 1) * 8 + h] + dtb;
            const float dt0 = fmaxf(x0, 0.f) + log1pf(__expf(-fabsf(x0))), dt1 = fmaxf(x1, 0.f) + log1pf(__expf(-fabsf(x1)));
            const float a0 = dt0 * A, a1 = dt1 * A;
            float s = a0 + a1;
#pragma unroll
            for (int o = 1; o < 64; o <<= 1) { const float v = __int_as_float(__builtin_amdgcn_ds_bpermute((ln - o) * 4, __float_as_int(s))); if (ln >= o) s += v; }
            const float ac1 = s, ac0 = s - a1, tot = __uint_as_float(__builtin_amdgcn_readlane(__float_as_uint(s), 63));
            acum2[2 * ln] = ac0 * LOG2E; acum2[2 * ln + 1] = ac1 * LOG2E;
            wv[2 * ln] = log2f(dt0) - ac0 * LOG2E; wv[2 * ln + 1] = log2f(dt1) - ac1 * LOG2E;
            wend[2 * ln] = dt0 * exp2f((tot - ac0) * LOG2E); wend[2 * ln + 1] = dt1 * exp2f((tot - ac1) * LOG2E);
            EA[(size_t)(t0 + 2 * ln) * 8 + h] = exp2f(ac0 * LOG2E); EA[(size_t)(t0 + 2 * ln + 1) * 8 + h] = exp2f(ac1 * LOG2E);
            if (ln == 0) CDEC[us] = exp2f(tot * LOG2E);
        }
        { const int tidc = opq(tid_);
          if (tidc < 440) {
            const int cg = tidc % 40, sg = tidc / 40, l0 = 12 * sg, h0 = 4 * grp;
            int chb; if (cg < 8) chb = h0 * 64 + cg * 8; else if (cg < 24) chb = 512 + grp * 128 + (cg - 8) * 8; else chb = 768 + grp * 128 + (cg - 24) * 8;
            v4u raw[15];
#pragma unroll
            for (int q = 0; q < 15; ++q) { const int ss = c * 128 + l0 - 3 + q; raw[q] = (v4u){0u, 0u, 0u, 0u};
                if (ss >= 0 && l0 - 3 + q < 128) raw[q] = *(const v4u*)(PROJ + (size_t)(b * SEQ + ss) * NPROJ + PJ_XBC + chb); }
            float w[4][8], bias[8]; S1_LOADW(chb);
#pragma unroll
            for (int it = 0; it < 12; it += 2) {
                const int l = l0 + it;
                if (l < 128) {
                    float a[8], a2[8]; S1_CONV8(a, it); S1_CONV8(a2, it + 1);
                    if (cg < 8) {
#pragma unroll
                        for (int e = 0; e < 8; ++e) *(LAS unsigned*)(Xt + swz_t(cg * 8 + e, l)) = cvtpk(a[e], a2[e]);
                    } else {
                        v4u o, o2; o.x = cvtpk(a[0], a[1]); o.y = cvtpk(a[2], a[3]); o.z = cvtpk(a[4], a[5]); o.w = cvtpk(a[6], a[7]);
                        o2.x = cvtpk(a2[0], a2[1]); o2.y = cvtpk(a2[2], a2[3]); o2.z = cvtpk(a2[4], a2[5]); o2.w = cvtpk(a2[6], a2[7]);
                        if (cg < 24) { const int n0 = (cg - 8) * 8; *(LAS v4u*)(Bsn + l * LDP + n0) = o; *(LAS v4u*)(Bsn + (l + 1) * LDP + n0) = o2;
#pragma unroll
                            for (int e = 0; e < 8; ++e) *(LAS unsigned*)(Bnl + swz_t(n0 + e, l)) = cvtpk(a[e], a2[e]);
                        } else { const int n0 = (cg - 24) * 8; *(LAS v4u*)(Cln + l * LDP + n0) = o; *(LAS v4u*)(Cln + (l + 1) * LDP + n0) = o2;
                            *(v4u*)(CC + (size_t)(t0 + l) * 256 + grp * 128 + n0) = o; *(v4u*)(CC + (size_t)(t0 + l + 1) * 256 + grp * 128 + n0) = o2; }
                    }
                }
            }
          } }
        __syncthreads();
#pragma unroll 1
        for (int hi = 0; hi < 4; ++hi) {
            const int h = 4 * grp + hi, u = (b * 32 + c) * 8 + h;
            const float Dh = P.d_skip[h];
            const LAS float* acum2 = f32base + hi * 384; const LAS float* wv = acum2 + 128; const LAS float* wend = wv + 128;
            const LAS bf16* Xc = (hi & 1) ? Xtw : Xt; LAS bf16* Xn = (hi & 1) ? Xt : Xtw;
            const int tidc = opq(tid_);
            const int cgn = tidc & 7, ln_ = 2 * (tidc >> 3), chn = (h + 1) * 64 + cgn * 8;
            v4u raw[5];
#pragma unroll
            for (int q = 0; q < 5; ++q) { const int ss = c * 128 + ln_ - 3 + q; raw[q] = (v4u){0u, 0u, 0u, 0u};
                if (hi < 3 && ss >= 0) raw[q] = *(const v4u*)(PROJ + (size_t)(b * SEQ + ss) * NPROJ + PJ_XBC + chn); }
            float4 wq4[4][2], bq4[2];
            { const int chw = (hi < 3) ? chn : chn - 64;
#pragma unroll
              for (int j = 0; j < 4; ++j) { wq4[j][0] = *(const float4*)(P.conv_w + j * 1024 + chw); wq4[j][1] = *(const float4*)(P.conv_w + j * 1024 + chw + 4); }
              bq4[0] = *(const float4*)(P.conv_b + chw); bq4[1] = *(const float4*)(P.conv_b + chw + 4); }
            const int ln3 = opq(lane), r = ln3 & 31, hh = ln3 >> 5;
            if (F.wave < 4) {
                const int pt = F.wave >> 1;
#pragma unroll 1
                for (int q = 0; q < 2; ++q) {
                    const int lt = (F.wave & 1) ? (1 + q) : (3 * q);
                    f32x16 yacc;
#pragma unroll
                    for (int i = 0; i < 16; ++i) yacc[i] = 0.f;
                    const float al = acum2[32 * lt + r];
                    bf16x8 cf[8];
#pragma unroll
                    for (int kk = 0; kk < 8; ++kk) cf[kk] = *(const LAS bf16x8*)(Cln + (32 * lt + r) * LDP + 16 * kk + 8 * hh);
#pragma unroll 1
                    for (int st = 0; st <= lt; ++st) {
                        bf16x8 bfr[8];
#pragma unroll
                        for (int kk = 0; kk < 8; ++kk) bfr[kk] = *(const LAS bf16x8*)(Bsn + (32 * st + r) * LDP + 16 * kk + 8 * hh);
                        f32x4 wq[4];
#pragma unroll
                        for (int g4 = 0; g4 < 4; ++g4) wq[g4] = *(const LAS f32x4*)(wv + 32 * st + 8 * g4 + 4 * hh);
                        s16x4 xlo[2], xhi[2];
#pragma unroll
                        for (int sg = 0; sg < 2; ++sg) { const int prow = 32 * pt + r, lb = 32 * st + 16 * sg;
                            xlo[sg] = *(const LAS s16x4*)(Xc + swz_t(prow, lb) + 4 * hh); xhi[sg] = *(const LAS s16x4*)(Xc + swz_t(prow, lb + 8) + 4 * hh); }
                        __builtin_amdgcn_sched_barrier(0);
                        f32x16 macc;
#pragma unroll
                        for (int i = 0; i < 16; ++i) macc[i] = 0.f;
#pragma unroll
                        for (int kk = 0; kk < 8; ++kk) macc = MFMA32(bfr[kk], cf[kk], macc);
#pragma unroll
                        for (int i = 0; i < 16; ++i) { const int sl = crow(i, hh);
                            float f = __builtin_amdgcn_exp2f(al + wq[i >> 2][i & 3]);
                            if (st == lt && sl > r) f = 0.f;
                            macc[i] *= f; }
#pragma unroll
                        for (int sg = 0; sg < 2; ++sg) {
                            const bf16x8 bfrag = pack8(macc, sg);
                            const bf16x8 afrag = __builtin_shufflevector(xlo[sg], xhi[sg], 0, 1, 2, 3, 4, 5, 6, 7);
                            yacc = MFMA32(afrag, bfrag, yacc);
                        }
                    }
                    unsigned short xs16[16];
#pragma unroll
                    for (int i = 0; i < 16; ++i) xs16[i] = *(const LAS unsigned short*)(Xc + swz_t(32 * pt + crow(i, hh), 32 * lt + r));
                    __builtin_amdgcn_sched_barrier(0);
#pragma unroll
                    for (int i = 0; i < 16; i += 2) {
                        const float y0 = yacc[i] + Dh * __uint_as_float((unsigned)xs16[i] << 16), y1 = yacc[i + 1] + Dh * __uint_as_float((unsigned)xs16[i + 1] << 16);
                        YPF[((((size_t)u * 4 + lt) * 2 + pt) * 8 + (i >> 1)) * 64 + ln3] = cvtpk(y0, y1); }
                }
            } else {
                const int nt = F.wave - 4;
                bf16x8 bb[8];
                { v4u braw[8]; f32x4 we[8][2];
#pragma unroll
                  for (int kk = 0; kk < 8; ++kk) { braw[kk] = *(const LAS v4u*)(Bnl + swz_t(32 * nt + r, 16 * kk + 8 * hh));
                      we[kk][0] = *(const LAS f32x4*)(wend + 16 * kk + 8 * hh); we[kk][1] = *(const LAS f32x4*)(wend + 16 * kk + 8 * hh + 4); }
#pragma unroll
                  for (int kk = 0; kk < 8; ++kk) { v4u o;
                      o.x = cvtpk(bflo(braw[kk].x) * we[kk][0][0], bfhi(braw[kk].x) * we[kk][0][1]); o.y = cvtpk(bflo(braw[kk].y) * we[kk][0][2], bfhi(braw[kk].y) * we[kk][0][3]);
                      o.z = cvtpk(bflo(braw[kk].z) * we[kk][1][0], bfhi(braw[kk].z) * we[kk][1][1]); o.w = cvtpk(bflo(braw[kk].w) * we[kk][1][2], bfhi(braw[kk].w) * we[kk][1][3]);
                      bb[kk] = __builtin_bit_cast(bf16x8, o); } }
#pragma unroll 1
                for (int pt = 0; pt < 2; ++pt) {
                    bf16x8 xa[8];
#pragma unroll
                    for (int kk = 0; kk < 8; ++kk) xa[kk] = *(const LAS bf16x8*)(Xc + swz_t(32 * pt + r, 16 * kk + 8 * hh));
                    __builtin_amdgcn_sched_barrier(0);
                    f32x16 sacc;
#pragma unroll
                    for (int i = 0; i < 16; ++i) sacc[i] = 0.f;
#pragma unroll
                    for (int kk = 0; kk < 8; ++kk) sacc = MFMA32(xa[kk], bb[kk], sacc);
#pragma unroll
                    for (int i = 0; i < 16; i += 2) ST[((size_t)u * 32 + 16 * pt + (crow(i, hh) >> 1)) * 128 + 32 * nt + r] = cvtpk(sacc[i], sacc[i + 1]);
                }
            }
            if (hi < 3) {
                const int cg = cgn, l = ln_;
                float w[4][8], bias[8];
#pragma unroll
                for (int j = 0; j < 4; ++j) { w[j][0] = wq4[j][0].x; w[j][1] = wq4[j][0].y; w[j][2] = wq4[j][0].z; w[j][3] = wq4[j][0].w; w[j][4] = wq4[j][1].x; w[j][5] = wq4[j][1].y; w[j][6] = wq4[j][1].z; w[j][7] = wq4[j][1].w; }
                bias[0] = bq4[0].x; bias[1] = bq4[0].y; bias[2] = bq4[0].z; bias[3] = bq4[0].w; bias[4] = bq4[1].x; bias[5] = bq4[1].y; bias[6] = bq4[1].z; bias[7] = bq4[1].w;
                float a[8], a2[8]; S1_CONV8(a, 0); S1_CONV8(a2, 1);
#pragma unroll
                for (int e = 0; e < 8; ++e) *(LAS unsigned*)(Xn + swz_t(cg * 8 + e, l)) = cvtpk(a[e], a2[e]);
            }
            __syncthreads();
        }
    }
}
__device__ __forceinline__ void ssd_s2(Frame& F, const Ptrs& P) {
    const unsigned* ST = (const unsigned*)(P.ws + WS_ST); const float* CDEC = (const float*)(P.ws + WS_CDEC); unsigned* PREV = (unsigned*)(P.ws + WS_PREV);
    for (int g = F.vcu * 512 + (F.wave * 64 + lane_id()); g < 65536; g += F.G * 512) {
        const int n2 = g & 63, p2 = (g >> 6) & 31, h = (g >> 11) & 7, b = g >> 14;
        uint2 st[32];
#pragma unroll
        for (int c = 0; c < 32; ++c) st[c] = *(const uint2*)(ST + ((size_t)(((b * 32 + c) * 8 + h) * 32 + p2)) * 128 + 2 * n2);
        float r00 = 0.f, r01 = 0.f, r10 = 0.f, r11 = 0.f;
#pragma unroll
        for (int c = 0; c < 32; ++c) { const size_t u = (size_t)((b * 32 + c) * 8 + h);
            PREV[((u * 64 + 2 * p2) * 128 + 2 * n2) >> 1] = cvtpk(r00, r01); PREV[((u * 64 + 2 * p2 + 1) * 128 + 2 * n2) >> 1] = cvtpk(r10, r11);
            const float d = CDEC[u];
            r00 = r00 * d + bflo(st[c].x); r10 = r10 * d + bfhi(st[c].x); r01 = r01 * d + bflo(st[c].y); r11 = r11 * d + bfhi(st[c].y); }
    }
}
__device__ __forceinline__ void ssd_s3(Frame& F, const Ptrs& P) {
    const bf16* CC = (const bf16*)(P.ws + WS_CC); const bf16* PREV = (const bf16*)(P.ws + WS_PREV); const float* EA = (const float*)(P.ws + WS_EA);
    const unsigned* YPF = (const unsigned*)((const char*)P.out + DO_YPF); const bf16* PROJ = (const bf16*)(P.ws + WS_PROJ); bf16* CAT = (bf16*)(P.ws + WS_XN);
    LAS float* red = (LAS float*)(F.lds + RING_OFF);
    const int lane = lane_id(), r = lane & 31, hh = lane >> 5, h = F.wave, grp = h >> 2;
    for (int v2 = F.vcu; v2 < 256; v2 += F.G) {
        const int lp = v2 & 1, c = (v2 >> 1) & 31, b = v2 >> 6;
        const size_t u = (size_t)((b * 32 + c) * 8 + h);
        bf16x8 af[2][8];
#pragma unroll
        for (int pt = 0; pt < 2; ++pt)
#pragma unroll
            for (int kk = 0; kk < 8; ++kk) af[pt][kk] = *(const bf16x8*)(PREV + (u * 64 + 32 * pt + r) * 128 + 16 * kk + 8 * hh);
#pragma unroll 1
        for (int li = 0; li < 2; ++li) {
            const int lt = 2 * lp + li;
            const int t = b * SEQ + c * 128 + lt * 32 + r;
            unsigned ypf[2][8]; unsigned long long zz[2][4];
#pragma unroll
            for (int pt = 0; pt < 2; ++pt) {
#pragma unroll
                for (int i = 0; i < 8; ++i) ypf[pt][i] = YPF[((((size_t)u * 4 + lt) * 2 + pt) * 8 + i) * 64 + lane];
#pragma unroll
                for (int g4 = 0; g4 < 4; ++g4) zz[pt][g4] = *(const unsigned long long*)(PROJ + (size_t)t * NPROJ + PJ_Z + h * 64 + 32 * pt + 8 * g4 + 4 * hh); }
            const float ea = EA[(size_t)t * 8 + h];
            bf16x8 bb[8];
#pragma unroll
            for (int kk = 0; kk < 8; ++kk) bb[kk] = *(const bf16x8*)(CC + (size_t)t * 256 + grp * 128 + 16 * kk + 8 * hh);
            f32x16 acc[2];
#pragma unroll
            for (int i = 0; i < 16; ++i) { acc[0][i] = 0.f; acc[1][i] = 0.f; }
#pragma unroll
            for (int kk = 0; kk < 8; ++kk) { acc[0] = MFMA32(af[0][kk], bb[kk], acc[0]); acc[1] = MFMA32(af[1][kk], bb[kk], acc[1]); }
            float ss = 0.f;
#pragma unroll
            for (int pt = 0; pt < 2; ++pt)
#pragma unroll
                for (int g4 = 0; g4 < 4; ++g4) {
                    const unsigned z01 = (unsigned)zz[pt][g4], z23 = (unsigned)(zz[pt][g4] >> 32);
                    const float zf[4] = {bflo(z01), bfhi(z01), bflo(z23), bfhi(z23)};
#pragma unroll
                    for (int e = 0; e < 4; ++e) { const int i = 4 * g4 + e;
                        const float y = acc[pt][i] * ea + ((i & 1) ? bfhi(ypf[pt][i >> 1]) : bflo(ypf[pt][i >> 1]));
                        const float yg = y * silu_fast(zf[e]); acc[pt][i] = yg; ss = fmaf(yg, yg, ss); }
                }
            ss = sum_halves(ss);
            LAS float* rd = red + li * 256;
            if (hh == 0) rd[h * 32 + r] = ss;
            __syncthreads();
            float tot = 0.f;
#pragma unroll
            for (int w = 0; w < 8; ++w) tot += rd[w * 32 + r];
            const float rn = rsqrtf(tot * (1.f / 512.f) + EPS);
#pragma unroll
            for (int pt = 0; pt < 2; ++pt)
#pragma unroll
                for (int g4 = 0; g4 < 4; ++g4) { const int ch = h * 64 + 32 * pt + 8 * g4 + 4 * hh;
                    const float4 w = *(const float4*)(P.ssd_norm_w + ch);
                    *(unsigned long long*)(CAT + (size_t)t * DM + 512 + ch) = (unsigned long long)cvtpk(acc[pt][4 * g4] * rn * w.x, acc[pt][4 * g4 + 1] * rn * w.y) | ((unsigned long long)cvtpk(acc[pt][4 * g4 + 2] * rn * w.z, acc[pt][4 * g4 + 3] * rn * w.w) << 32); }
        }
        __syncthreads();
    }
}
__device__ __forceinline__ float gelu_erf(float v) { return 0.5f * v * (1.f + erff(v * 0.70710678118654752f)); }
typedef float f32x2v __attribute__((ext_vector_type(2)));
#define CVT8(W, LO) __builtin_amdgcn_cvt_pk_f32_fp8((int)(W), LO)
template <int CTRL> __device__ __forceinline__ float dpp_f(float v) { return __int_as_float(__builtin_amdgcn_update_dpp(0, __float_as_int(v), CTRL, 0xF, 0xF, true)); }
__device__ __forceinline__ float sum8_dpp(float s) { s += dpp_f<0xB1>(s); s += dpp_f<0x4E>(s); s += dpp_f<0x141>(s); return s; }
struct PeerPlace { int vx, nx, rank, nloc; };
__device__ __forceinline__ PeerPlace peer_place(Frame& F) {
    __syncthreads();
    if (F.wave == 0 && lane_id() == 0) {
        unsigned* bar = (unsigned*)(F.ctl + CW_BAR); const unsigned x = xb_xcc_id();
        unsigned vx = 0, nx = 0;
        for (unsigned j = 0; j < 16; ++j) { const unsigned c = xb_ld(&bar[XB_XCNT(j)]); if (c) { if (j < x) ++vx; ++nx; } }
        const unsigned rank = xb_add((unsigned*)(F.ctl + CW_RANK) + 64 * x, 1u);
        F.MISC[10] = vx; F.MISC[11] = nx ? nx : 1u; F.MISC[12] = rank; F.MISC[13] = xb_ld(&bar[XB_XCNT(x)]);
    }
    __syncthreads();
    PeerPlace pp; pp.vx = (int)F.MISC[10]; pp.nx = (int)F.MISC[11]; pp.rank = (int)F.MISC[12]; pp.nloc = (int)F.MISC[13]; if (pp.nloc < 1) pp.nloc = 1;
    return pp;
}
__device__ __forceinline__ void h_quant_rows(Frame& F, const Ptrs& P) {
    const bf16* HB = (const bf16*)(P.ws + WS_ST); unsigned char* H8 = P.ws + WS_H8; float* HS = (float*)(P.ws + WS_HS);
    const int lane = lane_id();
    for (int t = F.vcu * NWAVES + F.wave; t < T_; t += F.G * NWAVES) {
        const v4u a0 = ((const v4u*)(HB + (size_t)t * DM))[2 * lane], a1 = ((const v4u*)(HB + (size_t)t * DM))[2 * lane + 1];
        float hf[16];
        hf[0] = bflo(a0.x); hf[1] = bfhi(a0.x); hf[2] = bflo(a0.y); hf[3] = bfhi(a0.y); hf[4] = bflo(a0.z); hf[5] = bfhi(a0.z); hf[6] = bflo(a0.w); hf[7] = bfhi(a0.w);
        hf[8] = bflo(a1.x); hf[9] = bfhi(a1.x); hf[10] = bflo(a1.y); hf[11] = bfhi(a1.y); hf[12] = bflo(a1.z); hf[13] = bfhi(a1.z); hf[14] = bflo(a1.w); hf[15] = bfhi(a1.w);
        float am = 0.f;
#pragma unroll
        for (int i = 0; i < 16; ++i) am = fmaxf(am, fabsf(hf[i]));
        am = fmaxf(am, dpp_f<0xB1>(am)); am = fmaxf(am, dpp_f<0x4E>(am)); am = fmaxf(am, dpp_f<0x141>(am)); am = fmaxf(am, dpp_f<0x140>(am)); am = fmaxf(am, 1e-30f);
        const float inv = 119.f / am;
        unsigned hi[2] = {0u, 0u}, lo[2] = {0u, 0u};
#pragma unroll
        for (int i = 0; i < 16; ++i) { const int q = __float2int_rn(hf[i] * inv); const int qh = (q + 8) >> 4, ql = q - 16 * qh;
            hi[i >> 3] |= ((unsigned)qh & 15u) << (4 * (i & 7)); lo[i >> 3] |= ((unsigned)ql & 15u) << (4 * (i & 7)); }
        unsigned char* dst = H8 + (size_t)t * 1024 + (lane >> 4) * 256 + (lane & 15) * 8;
        *(unsigned long long*)dst = (unsigned long long)hi[0] | ((unsigned long long)hi[1] << 32);
        *(unsigned long long*)(dst + 128) = (unsigned long long)lo[0] | ((unsigned long long)lo[1] << 32);
        if ((lane & 15) == 0) HS[(size_t)t * 8 + (lane >> 4)] = am * (1.f / 119.f);
    }
}
constexpr int PX_D = 16;
template <int CTRL> __device__ __forceinline__ int dpp_i(int v) { return __builtin_amdgcn_update_dpp(0, v, CTRL, 0xF, 0xF, true); }
#define PX_ISSUE(BUF, LO, HI) _Pragma("unroll") for (int b_ = 0; b_ < 8; ++b_) { const unsigned off_ = ((unsigned)__builtin_amdgcn_ds_bpermute((16 * (b_ & 3) + ps) * 4, (b_ & 4) ? (HI) : (LO)) << 7) | (unsigned)(dl << 5); \
        BUF[2 * b_] = *(const v4u*)(tab + off_); BUF[2 * b_ + 1] = *(const v4u*)(tab + off_ + 16); }
struct H4 { v4u h0, h1, l0, l1; };
#define PX_DOT8(Q, HH, HL) ah = __builtin_amdgcn_sdot8((int)(Q), (int)(HH), ah, false); al = __builtin_amdgcn_sdot8((int)(Q), (int)(HL), al, false);
__device__ __forceinline__ void peer_down_token(const v4u (&cur)[PX_D], const H4& h, const float hs, unsigned* prow, int dl, int ps) {
    int sm[8];
#pragma unroll
    for (int b = 0; b < 8; ++b) { const v4u q0 = cur[2 * b], q1 = cur[2 * b + 1];
        int ah = 0, al = 0;
        PX_DOT8(q0.x, h.h0.x, h.l0.x) PX_DOT8(q0.y, h.h0.y, h.l0.y) PX_DOT8(q0.z, h.h0.z, h.l0.z) PX_DOT8(q0.w, h.h0.w, h.l0.w)
        PX_DOT8(q1.x, h.h1.x, h.l1.x) PX_DOT8(q1.y, h.h1.y, h.l1.y) PX_DOT8(q1.z, h.h1.z, h.l1.z) PX_DOT8(q1.w, h.h1.w, h.l1.w)
        sm[b] = 16 * ah + al; }
    const bool c1 = (dl & 2) != 0, c0 = (dl & 1) != 0;
    int w4[4], w2[2];
#pragma unroll
    for (int k = 0; k < 4; ++k) { const int keep = c1 ? sm[4 + k] : sm[k], send = c1 ? sm[k] : sm[4 + k]; w4[k] = keep + dpp_i<0x4E>(send); }
#pragma unroll
    for (int k = 0; k < 2; ++k) { const int keep = c0 ? w4[2 + k] : w4[k], send = c0 ? w4[k] : w4[2 + k]; w2[k] = keep + dpp_i<0xB1>(send); }
    const float f0 = (float)w2[0] * hs, f1 = (float)w2[1] * hs;
    const float g0 = dpp_f<0x4E>(f0), g1 = dpp_f<0x4E>(f1);
    if (dl < 2) { prow[32 * dl + ps] = cvtpk(f0, g0); prow[32 * dl + 16 + ps] = cvtpk(f1, g1); }
}
__device__ __forceinline__ void peer_down(Frame& F, const Ptrs& P, const PeerPlace& pp) {
    const unsigned char* H8 = P.ws + WS_H8; const unsigned char* HSb = P.ws + WS_HS; const unsigned char* IDXb = P.ws + WS_IDX; unsigned char* PARTb = P.ws + WS_PART;
    const int lane = lane_id(), dl = lane & 3, ps = lane >> 2;
    const int tstep = pp.nloc * NWAVES;
    for (int u = pp.vx; u < 8; u += pp.nx) {
        const int s = u & 3, tend = ((u >> 2) + 1) * (T_ / 2), t0 = (u >> 2) * (T_ / 2) + pp.rank * NWAVES + F.wave;
        if (t0 >= tend) continue;
        const unsigned char* tab = P.ws + WS_ED + (size_t)s * 16384 * 128;
        const unsigned hoff = (unsigned)(s * 256 + dl * 32), ioff = (unsigned)lane * 4u;
        v4u bufA[PX_D], bufB[PX_D];
#define PD_CLAMP(T) ((T) < tend ? (T) : t0)
#define PD_META(H, HSC, TT) do { const unsigned char* hp_ = H8 + ((unsigned)(TT) * 1024u + hoff); H.h0 = *(const v4u*)hp_; H.h1 = *(const v4u*)(hp_ + 16); H.l0 = *(const v4u*)(hp_ + 128); H.l1 = *(const v4u*)(hp_ + 144); \
        HSC = *(const float*)(HSb + ((unsigned)(TT) * 32u + (unsigned)s * 4u)); } while (0)
#define PD_IDX(LO, HI, TT) do { LO = *(const int*)(IDXb + ((unsigned)(TT) * 512u + ioff)); HI = *(const int*)(IDXb + ((unsigned)(TT) * 512u + 256u + ioff)); } while (0)
        int nidx_lo, nidx_hi; PD_IDX(nidx_lo, nidx_hi, t0);
        PX_ISSUE(bufA, nidx_lo, nidx_hi);
        PD_IDX(nidx_lo, nidx_hi, PD_CLAMP(t0 + tstep));
        H4 ha, hb; float sa, sb; PD_META(ha, sa, t0);
        for (int t = t0; t < tend; t += 2 * tstep) {
            { const int tn = PD_CLAMP(t + tstep);
              PX_ISSUE(bufB, nidx_lo, nidx_hi); PD_IDX(nidx_lo, nidx_hi, PD_CLAMP(tn + tstep)); PD_META(hb, sb, tn);
              __builtin_amdgcn_sched_barrier(0);
              peer_down_token(bufA, ha, sa, (unsigned*)(PARTb + ((unsigned)(s * T_ + t) * 256u)), dl, ps);
              __builtin_amdgcn_sched_barrier(0); }
            if (t + tstep >= tend) break;
            { const int tc = t + tstep, tn = PD_CLAMP(tc + tstep);
              PX_ISSUE(bufA, nidx_lo, nidx_hi); PD_IDX(nidx_lo, nidx_hi, PD_CLAMP(tn + tstep)); PD_META(ha, sa, tn);
              __builtin_amdgcn_sched_barrier(0);
              peer_down_token(bufB, hb, sb, (unsigned*)(PARTb + ((unsigned)(s * T_ + tc) * 256u)), dl, ps);
              __builtin_amdgcn_sched_barrier(0); }
        }
    }
}
constexpr int PE_PD = 8;
#define PE_LOAD4(SLOT, IDV) SLOT = *(const v4u*)(EU + (((unsigned)(IDV) << 9) | l16))
#define PE_BP(ADDR, V) __builtin_amdgcn_ds_bpermute((ADDR), (V))
__device__ __forceinline__ void peer_up_tm(Frame& F, const Ptrs& P) {
    const bf16* HB = (const bf16*)(P.ws + WS_ST); const unsigned char* EU = P.ws + WS_EU;
    const int* IDX = (const int*)(P.ws + WS_IDX); const float* GATE = (const float*)(P.ws + WS_GATE); const unsigned* PART = (const unsigned*)(P.ws + WS_PART);
    const float* SCD = (const float*)(P.ws + WS_SMALL); const float* SCU = SCD + 16384;
    const int lane = lane_id(), l31 = lane & 31; const bool upper = lane >= 32;
    const unsigned l16 = (unsigned)l31 << 4;
    const int bp0 = upper ? 4 : 0;
    const int t0 = F.vcu * NWAVES + F.wave, tstep = F.G * NWAVES;
    if (t0 >= T_) return;
    float4 nfw[4];
#pragma unroll
    for (int k = 0; k < 4; ++k) nfw[k] = ((const float4*)(P.norm_final) + 8 * l31 + 4 * (lane >> 5))[k];
    int idx_lo = IDX[(size_t)t0 * 128 + lane], idx_hi = IDX[(size_t)t0 * 128 + 64 + lane];
    v4u hq[4];
#pragma unroll
    for (int k = 0; k < 4; ++k) hq[k] = ((const v4u*)(HB + (size_t)t0 * DM))[4 * l31 + k];
    float g_lo = GATE[(size_t)t0 * 128 + lane], g_hi = GATE[(size_t)t0 * 128 + 64 + lane];
    float pre_lo = 0.f, pre_hi = 0.f;
#pragma unroll
    for (int s = 0; s < 4; ++s) { const unsigned pp_ = PART[((size_t)s * T_ + t0) * 64 + lane]; pre_lo += bflo(pp_); pre_hi += bfhi(pp_); }
    float sdu_lo = SCD[idx_lo], sdu_hi = SCD[idx_hi], su_lo = SCU[idx_lo], su_hi = SCU[idx_hi];
    v4u ra[PE_PD];
#pragma unroll
    for (int j = 0; j < PE_PD; ++j) { const int id = PE_BP(bp0 + 8 * j, idx_lo); PE_LOAD4(ra[j], id); }
    int id_nx = PE_BP(bp0 + 8 * PE_PD, idx_lo);
    for (int t = t0; t < T_; t += tstep) {
        const int tn = (t + tstep < T_) ? t + tstep : t;
        const int nidx_lo = IDX[(size_t)tn * 128 + lane], nidx_hi = IDX[(size_t)tn * 128 + 64 + lane];
        v4u nh[4];
#pragma unroll
        for (int k = 0; k < 4; ++k) nh[k] = ((const v4u*)(HB + (size_t)tn * DM))[4 * l31 + k];
        const float ng_lo = GATE[(size_t)tn * 128 + lane], ng_hi = GATE[(size_t)tn * 128 + 64 + lane];
        unsigned npart[4];
#pragma unroll
        for (int s = 0; s < 4; ++s) npart[s] = PART[((size_t)s * T_ + tn) * 64 + lane];
        float ssq = 0.f;
#pragma unroll
        for (int k = 0; k < 4; ++k) { ssq = fmaf(bflo(hq[k].x), bflo(hq[k].x), ssq); ssq = fmaf(bfhi(hq[k].x), bfhi(hq[k].x), ssq); ssq = fmaf(bflo(hq[k].y), bflo(hq[k].y), ssq); ssq = fmaf(bfhi(hq[k].y), bfhi(hq[k].y), ssq);
            ssq = fmaf(bflo(hq[k].z), bflo(hq[k].z), ssq); ssq = fmaf(bfhi(hq[k].z), bfhi(hq[k].z), ssq); ssq = fmaf(bflo(hq[k].w), bflo(hq[k].w), ssq); ssq = fmaf(bfhi(hq[k].w), bfhi(hq[k].w), ssq); }
        ssq += swz_xor<1>(ssq); ssq += swz_xor<2>(ssq); ssq += swz_xor<4>(ssq); ssq += swz_xor<8>(ssq); ssq += swz_xor<16>(ssq);
        const float rstd = rsqrtf(ssq * (1.f / 1024.f) + EPS);
        const float act_lo = gelu_erf(pre_lo * sdu_lo * rstd) * g_lo * su_lo, act_hi = gelu_erf(pre_hi * sdu_hi * rstd) * g_hi * su_hi;
        float nsdu_lo = 0.f, nsdu_hi = 0.f, nsu_lo = 0.f, nsu_hi = 0.f;
        f32x2v acc[16];
#pragma unroll
        for (int i = 0; i < 16; ++i) acc[i] = (f32x2v){0.f, 0.f};
        float a_cur = __int_as_float(PE_BP(bp0, __float_as_int(act_lo)));
#pragma unroll
        for (int q = 0; q < 64; ++q) {
            const int qa = q + 1, ql = q + PE_PD + 1;
            float a_nx = 0.f;
            if (qa < 64) a_nx = __int_as_float(PE_BP(bp0 + 8 * (qa & 31), __float_as_int(qa < 32 ? act_lo : act_hi)));
            int id_n2;
            if (ql < 64) id_n2 = PE_BP(bp0 + 8 * (ql & 31), ql < 32 ? idx_lo : idx_hi);
            else id_n2 = PE_BP(bp0 + 8 * ((ql - 64) & 31), nidx_lo);
            __builtin_amdgcn_sched_barrier(0);
            { const f32x2v av = {a_cur, a_cur}; const v4u r = ra[q % PE_PD];
#define PE_FMA4(W, O) acc[O] = __builtin_elementwise_fma(av, (f32x2v)__builtin_amdgcn_cvt_scalef32_pk_f32_fp4(W, 1.0f, 0), acc[O]); acc[O + 1] = __builtin_elementwise_fma(av, (f32x2v)__builtin_amdgcn_cvt_scalef32_pk_f32_fp4(W, 1.0f, 1), acc[O + 1]); \
              acc[O + 2] = __builtin_elementwise_fma(av, (f32x2v)__builtin_amdgcn_cvt_scalef32_pk_f32_fp4(W, 1.0f, 2), acc[O + 2]); acc[O + 3] = __builtin_elementwise_fma(av, (f32x2v)__builtin_amdgcn_cvt_scalef32_pk_f32_fp4(W, 1.0f, 3), acc[O + 3]);
              PE_FMA4(r.x, 0) PE_FMA4(r.y, 4) PE_FMA4(r.z, 8) PE_FMA4(r.w, 12) }
            asm volatile("" : "+v"(acc[0]), "+v"(acc[1]), "+v"(acc[2]), "+v"(acc[3]), "+v"(acc[4]), "+v"(acc[5]), "+v"(acc[6]), "+v"(acc[7]));
            asm volatile("" : "+v"(acc[8]), "+v"(acc[9]), "+v"(acc[10]), "+v"(acc[11]), "+v"(acc[12]), "+v"(acc[13]), "+v"(acc[14]), "+v"(acc[15]));
            PE_LOAD4(ra[q % PE_PD], id_nx);
            if (q == 24) { nsdu_lo = SCD[nidx_lo]; nsdu_hi = SCD[nidx_hi]; nsu_lo = SCU[nidx_lo]; nsu_hi = SCU[nidx_hi]; }
            id_nx = id_n2; a_cur = a_nx;
            __builtin_amdgcn_sched_barrier(0);
        }
        { float a = 0.f, c = 0.f;
#pragma unroll
          for (int s = 0; s < 4; ++s) { a += bflo(npart[s]); c += bfhi(npart[s]); }
          pre_lo = a; pre_hi = c; }
        sdu_lo = nsdu_lo; sdu_hi = nsdu_hi; su_lo = nsu_lo; su_hi = nsu_hi;
        float y[32];
#pragma unroll
        for (int k = 0; k < 4; ++k) { y[8 * k] = bflo(hq[k].x); y[8 * k + 1] = bfhi(hq[k].x); y[8 * k + 2] = bflo(hq[k].y); y[8 * k + 3] = bfhi(hq[k].y); y[8 * k + 4] = bflo(hq[k].z); y[8 * k + 5] = bfhi(hq[k].z); y[8 * k + 6] = bflo(hq[k].w); y[8 * k + 7] = bfhi(hq[k].w); }
        float s2 = 0.f;
#pragma unroll
        for (int i = 0; i < 16; ++i) { y[2 * i] += sum_halves(acc[i][0]); y[2 * i + 1] += sum_halves(acc[i][1]); s2 = fmaf(y[2 * i], y[2 * i], s2); s2 = fmaf(y[2 * i + 1], y[2 * i + 1], s2); }
        s2 += swz_xor<1>(s2); s2 += swz_xor<2>(s2); s2 += swz_xor<4>(s2); s2 += swz_xor<8>(s2); s2 += swz_xor<16>(s2);
        const float r2 = rsqrtf(s2 * (1.f / 1024.f) + EPS);
        float4* o = (float4*)(P.out + (size_t)t * DM) + 8 * l31 + 4 * (lane >> 5);
#pragma unroll
        for (int k = 0; k < 4; ++k) { const float4 w = nfw[k];
            const float e0 = upper ? y[16 + 4 * k] : y[4 * k], e1 = upper ? y[17 + 4 * k] : y[4 * k + 1], e2 = upper ? y[18 + 4 * k] : y[4 * k + 2], e3 = upper ? y[19 + 4 * k] : y[4 * k + 3];
            o[k] = make_float4(e0 * r2 * w.x, e1 * r2 * w.y, e2 * r2 * w.z, e3 * r2 * w.w); }
        idx_lo = nidx_lo; idx_hi = nidx_hi; g_lo = ng_lo; g_hi = ng_hi;
#pragma unroll
        for (int k = 0; k < 4; ++k) hq[k] = nh[k];
    }
}
constexpr int TK_LDK = 136, TK_K2 = 34816, TK_SCR = 69632, TK_SP = 49;
__device__ __forceinline__ int mono_key(float x) { const int b = __float_as_int(x); return b ^ ((b >> 31) & 0x7fffffff); }
__device__ __forceinline__ float unmono(int m) { return __int_as_float(m ^ ((m >> 31) & 0x7fffffff)); }
__device__ __forceinline__ int max3i(int a, int b, int c) { return max(max(a, b), c); }
#define CEX(A, I, J) do { const int hi_ = max(A[I], A[J]), lo_ = min(A[I], A[J]); A[I] = hi_; A[J] = lo_; } while (0)
template <int N, int OFF, int K, int J, int LEN> struct BitonicStep {
    static __device__ __forceinline__ void run(int (&a)[LEN]) {
#pragma unroll
        for (int i = 0; i < N; ++i) { const int l = i ^ J; if (l > i) { if ((i & K) == 0) CEX(a, OFF + i, OFF + l); else CEX(a, OFF + l, OFF + i); } }
        if constexpr (J > 1) BitonicStep<N, OFF, K, (J >> 1), LEN>::run(a);
        else if constexpr (K < N) BitonicStep<N, OFF, (K << 1), K, LEN>::run(a);
    }
};
template <int N, int OFF, int LEN> __device__ __forceinline__ void bitonic_sort_desc(int (&a)[LEN]) { BitonicStep<N, OFF, 2, 1, LEN>::run(a); }
template <int OFF, int LEN> __device__ __forceinline__ void bitonic_merge16_desc(int (&a)[LEN]) { BitonicStep<16, OFF, 16, 8, LEN>::run(a); }
template <int OFF, int LEN> __device__ __forceinline__ void oem_sort16_desc(int (&a)[LEN]) {
    constexpr unsigned char Pn[63][2] = {{0, 1}, {2, 3}, {0, 2}, {1, 3}, {1, 2}, {4, 5}, {6, 7}, {4, 6}, {5, 7}, {5, 6}, {0, 4}, {2, 6}, {2, 4}, {1, 5}, {3, 7}, {3, 5}, {1, 2}, {3, 4}, {5, 6}, {8, 9}, {10, 11}, {8, 10}, {9, 11}, {9, 10}, {12, 13}, {14, 15}, {12, 14}, {13, 15}, {13, 14}, {8, 12}, {10, 14}, {10, 12}, {9, 13}, {11, 15}, {11, 13}, {9, 10}, {11, 12}, {13, 14}, {0, 8}, {4, 12}, {4, 8}, {2, 10}, {6, 14}, {6, 10}, {2, 4}, {6, 8}, {10, 12}, {1, 9}, {5, 13}, {5, 9}, {3, 11}, {7, 15}, {7, 11}, {3, 5}, {7, 9}, {11, 13}, {1, 2}, {3, 4}, {5, 6}, {7, 8}, {9, 10}, {11, 12}, {13, 14}};
#pragma unroll
    for (int k = 0; k < 63; ++k) CEX(a, OFF + Pn[k][0], OFF + Pn[k][1]);
}
template <int LEN> __device__ __forceinline__ void oem_sort32_desc(int (&a)[LEN]) {
    constexpr unsigned char Pn[191][2] = {{0, 1}, {2, 3}, {0, 2}, {1, 3}, {1, 2}, {4, 5}, {6, 7}, {4, 6}, {5, 7}, {5, 6}, {0, 4}, {2, 6}, {2, 4}, {1, 5}, {3, 7}, {3, 5}, {1, 2}, {3, 4}, {5, 6}, {8, 9}, {10, 11}, {8, 10}, {9, 11}, {9, 10}, {12, 13}, {14, 15}, {12, 14}, {13, 15}, {13, 14}, {8, 12}, {10, 14}, {10, 12}, {9, 13}, {11, 15}, {11, 13}, {9, 10}, {11, 12}, {13, 14}, {0, 8}, {4, 12}, {4, 8}, {2, 10}, {6, 14}, {6, 10}, {2, 4}, {6, 8}, {10, 12}, {1, 9}, {5, 13}, {5, 9}, {3, 11}, {7, 15}, {7, 11}, {3, 5}, {7, 9}, {11, 13}, {1, 2}, {3, 4}, {5, 6}, {7, 8}, {9, 10}, {11, 12}, {13, 14}, {16, 17}, {18, 19}, {16, 18}, {17, 19}, {17, 18}, {20, 21}, {22, 23}, {20, 22}, {21, 23}, {21, 22}, {16, 20}, {18, 22}, {18, 20}, {17, 21}, {19, 23}, {19, 21}, {17, 18}, {19, 20}, {21, 22}, {24, 25}, {26, 27}, {24, 26}, {25, 27}, {25, 26}, {28, 29}, {30, 31}, {28, 30}, {29, 31}, {29, 30}, {24, 28}, {26, 30}, {26, 28}, {25, 29}, {27, 31}, {27, 29}, {25, 26}, {27, 28}, {29, 30}, {16, 24}, {20, 28}, {20, 24}, {18, 26}, {22, 30}, {22, 26}, {18, 20}, {22, 24}, {26, 28}, {17, 25}, {21, 29}, {21, 25}, {19, 27}, {23, 31}, {23, 27}, {19, 21}, {23, 25}, {27, 29}, {17, 18}, {19, 20}, {21, 22}, {23, 24}, {25, 26}, {27, 28}, {29, 30}, {0, 16}, {8, 24}, {8, 16}, {4, 20}, {12, 28}, {12, 20}, {4, 8}, {12, 16}, {20, 24}, {2, 18}, {10, 26}, {10, 18}, {6, 22}, {14, 30}, {14, 22}, {6, 10}, {14, 18}, {22, 26}, {2, 4}, {6, 8}, {10, 12}, {14, 16}, {18, 20}, {22, 24}, {26, 28}, {1, 17}, {9, 25}, {9, 17}, {5, 21}, {13, 29}, {13, 21}, {5, 9}, {13, 17}, {21, 25}, {3, 19}, {11, 27}, {11, 19}, {7, 23}, {15, 31}, {15, 23}, {7, 11}, {15, 19}, {23, 27}, {3, 5}, {7, 9}, {11, 13}, {15, 17}, {19, 21}, {23, 25}, {27, 29}, {1, 2}, {3, 4}, {5, 6}, {7, 8}, {9, 10}, {11, 12}, {13, 14}, {15, 16}, {17, 18}, {19, 20}, {21, 22}, {23, 24}, {25, 26}, {27, 28}, {29, 30}};
#pragma unroll
    for (int k = 0; k < 191; ++k) CEX(a, Pn[k][0], Pn[k][1]);
}
template <int A, int B, int LEN> __device__ __forceinline__ void merge_top16(int (&a)[LEN]) {
#pragma unroll
    for (int i = 0; i < 16; ++i) a[A + i] = max(a[A + i], a[B + 15 - i]);
    bitonic_merge16_desc<A, LEN>(a);
}
template <int LEN> __device__ __forceinline__ void pair_top16(int (&a)[LEN]) {
    int lo[16], up[16];
#pragma unroll
    for (int i = 0; i < 16; ++i) { const auto rr = __builtin_amdgcn_permlane32_swap((unsigned)a[i], (unsigned)a[i], false, false); lo[i] = (int)rr[0]; up[i] = (int)rr[1]; }
#pragma unroll
    for (int i = 0; i < 16; ++i) a[i] = max(lo[i], up[15 - i]);
    bitonic_merge16_desc<0, LEN>(a);
}
__device__ __forceinline__ void topk_half(const bf16x8 (&qf)[8], const LAS bf16* Kh, int r, int hh, int (&key)[64]) {
#pragma unroll
    for (int nt = 0; nt < 4; ++nt) {
        f32x16 sc;
#pragma unroll
        for (int i = 0; i < 16; ++i) sc[i] = 0.f;
#pragma unroll
        for (int kk = 0; kk < 8; ++kk) { const bf16x8 a = *(const LAS bf16x8*)(Kh + (32 * nt + r) * TK_LDK + 16 * kk + 8 * hh); sc = MFMA32(a, qf[kk], sc); }
#pragma unroll
        for (int i = 0; i < 16; ++i) key[nt * 16 + i] = (mono_key(sc[i]) & ~127) | (127 - (32 * nt + crow(i, hh)));
    }
    oem_sort16_desc<0, 64>(key); oem_sort16_desc<16, 64>(key); oem_sort16_desc<32, 64>(key); oem_sort16_desc<48, 64>(key);
    merge_top16<0, 16, 64>(key); merge_top16<32, 48, 64>(key); merge_top16<0, 32, 64>(key);
    pair_top16<64>(key);
}
__device__ __forceinline__ void topk_finish(const LAS int* scr, int hh, float rstd, int* IDX, float* GATE, int t, int hd) {
    const LAS int* la = scr + hh * 16; const LAS int* lb = scr + (1 - hh) * 16;
    float va[4], vb[16];
#pragma unroll
    for (int i = 0; i < 4; ++i) va[i] = unmono(la[i] & ~127);
#pragma unroll
    for (int j = 0; j < 16; ++j) vb[j] = unmono(lb[j] & ~127);
    int ck[32];
    {
        int q = 0;
#pragma unroll
        for (int i = 0; i < 4; ++i)
#pragma unroll
            for (int j = i; j < 16; ++j) if ((i + 1) * (j + 1) <= 16) {
                const int pos = hh ? (j * 16 + i) : (i * 16 + j);
                int k = (mono_key(va[i] + vb[j]) & ~255) | (255 - pos);
                if (i == j && hh) k = (int)0x80000000;
                ck[q++] = k; }
#pragma unroll
        for (int i = 27; i < 32; ++i) ck[i] = (int)0x80000000;
    }
    oem_sort32_desc<32>(ck);
    pair_top16<32>(ck);
    const float vmax = unmono(ck[0] & ~255) * rstd;
    float ev[8]; int id[8]; float esum = 0.f; const int hm = -hh;
#pragma unroll
    for (int q = 0; q < 8; ++q) { const int wk = ck[q] ^ ((ck[q] ^ ck[8 + q]) & hm); const int pos = 255 - (wk & 255);
        const int n1 = 127 - (scr[pos >> 4] & 127), n2 = 127 - (scr[16 + (pos & 15)] & 127);
        id[q] = n1 * 128 + n2;
        ev[q] = exp2f((unmono(wk & ~255) * rstd - vmax) * LOG2E); esum += ev[q]; }
    esum = sum_halves(esum);
    const float inv = 1.f / esum;
    int4* ip = (int4*)(IDX + ((size_t)t * 8 + hd) * 16 + hh * 8); float4* gp = (float4*)(GATE + ((size_t)t * 8 + hd) * 16 + hh * 8);
    ip[0] = make_int4(id[0], id[1], id[2], id[3]); ip[1] = make_int4(id[4], id[5], id[6], id[7]);
    gp[0] = make_float4(ev[0] * inv, ev[1] * inv, ev[2] * inv, ev[3] * inv); gp[1] = make_float4(ev[4] * inv, ev[5] * inv, ev[6] * inv, ev[7] * inv);
}
constexpr int TQ_QH = 69632, TQ_QP = 272;
struct OneUnit { pg8::StaticOrder S; int i;
    __device__ __forceinline__ bool next(int j, pg8::Unit& u) const { return j == 0 ? S.next(i, u) : false; }
    __device__ __forceinline__ void a_ready(const pg8::Unit&) const {}
    __device__ __forceinline__ void done(const pg8::Unit&) const {}
};
struct EpiQTopk {
    static constexpr bool PERM = true, AFTER_DRAIN = true;
    const unsigned char* KB; const float* SSQ; int* IDX; float* GATE;
    __device__ __forceinline__ void dump(const pg8::f32x4 (&acc)[2][2][4][2], int bj, LAS unsigned char* QH, int wr, int wc, int fr, int fq) const {
#pragma unroll
        for (int ai = 0; ai < 2; ++ai)
#pragma unroll
            for (int m = 0; m < 4; ++m) { const pg8::f32x4 v0 = bj ? acc[ai][1][m][0] : acc[ai][0][m][0], v1 = bj ? acc[ai][1][m][1] : acc[ai][0][m][1];
                v4u w; w.x = cvtpk(v0[0], v0[1]); w.y = cvtpk(v0[2], v0[3]); w.z = cvtpk(v1[0], v1[1]); w.w = cvtpk(v1[2], v1[3]);
                *(LAS v4u*)(QH + (128 * ai + 64 * wr + 16 * m + fr) * TQ_QP + (32 * wc + 8 * fq) * 2) = w; }
    }
    __device__ __forceinline__ void fused(const pg8::f32x4 (&acc)[2][2][4][2], const pg8::Unit& u, int wr, int wc, int fr, int fq, LAS unsigned char* L, int wid, int lane) const {
        LAS bf16* K1 = (LAS bf16*)L; LAS bf16* K2 = (LAS bf16*)(L + TK_K2); LAS unsigned char* QH = L + TQ_QH;
        const int tid_ = wid * 64 + lane, r = lane & 31, hh = lane >> 5;
        { v4u kq[8];
#pragma unroll
          for (int q = 0; q < 8; ++q) kq[q] = ((const v4u*)KB)[tid_ + 512 * q];
          dump(acc, 0, QH, wr, wc, fr, fq);
#pragma unroll
          for (int q = 0; q < 8; ++q) { const int j = tid_ + 512 * q, n = (j >> 4) & 127, k8 = j & 15; *(LAS v4u*)(((j >> 11) ? K2 : K1) + n * TK_LDK + 8 * k8) = kq[q]; } }
        __syncthreads();
        const int t = u.pm * 256 + 32 * wid + r;
        float rstd;
        { const float4* sp = (const float4*)(SSQ + (size_t)t * 16); const float4 a = sp[0], b = sp[1], c = sp[2], d = sp[3];
          rstd = rsqrtf(((a.x + a.y + a.z + a.w) + (b.x + b.y + b.z + b.w) + (c.x + c.y + c.z + c.w) + (d.x + d.y + d.z + d.w)) * (1.f / 1024.f) + EPS); }
        const LAS unsigned char* qrow = QH + (32 * wid + r) * TQ_QP + 16 * hh;
        int key[64], list0[16];
        { bf16x8 qf[8];
#pragma unroll
          for (int kk = 0; kk < 8; ++kk) qf[kk] = *(const LAS bf16x8*)(qrow + 32 * kk);
          topk_half(qf, K1, r, hh, key);
#pragma unroll
          for (int i = 0; i < 16; ++i) list0[i] = key[i]; }
        __syncthreads();
        dump(acc, 1, QH, wr, wc, fr, fq);
        __syncthreads();
        { bf16x8 qf[8];
#pragma unroll
          for (int kk = 0; kk < 8; ++kk) qf[kk] = *(const LAS bf16x8*)(qrow + 32 * kk);
          topk_half(qf, K2, r, hh, key); }
        LAS int* scr = (LAS int*)(QH + 32 * wid * TQ_QP) + r * TK_SP;
        LDS_WAIT();
        if (hh == 0) {
#pragma unroll
            for (int i = 0; i < 16; ++i) { scr[i] = list0[i]; scr[16 + i] = key[i]; } }
        topk_finish(scr, hh, rstd, IDX, GATE, t, u.pn);
        __syncthreads();
    }
};

constexpr int AT_KP = 72, AT_VP = 264;
constexpr int AT_K = 0, AT_VT = 36864, AT_BT = 36864 + 33792;
__device__ __forceinline__ void attn_phase(Frame& F, const Ptrs& P) {
    const bf16* PROJ = (const bf16*)(P.ws + WS_PROJ); bf16* CAT = (bf16*)(P.ws + WS_XN);
    LAS unsigned char* L = F.lds + RING_OFF;
    LAS bf16* Ks = (LAS bf16*)(L + AT_K); LAS bf16* Vt = (LAS bf16*)(L + AT_VT); LAS float* btab = (LAS float*)(L + AT_BT);
    const int lane = lane_id(), tid_ = F.wave * 64 + lane, r = lane & 31, hh = lane >> 5;
    for (int u = F.vcu; u < 256; u += F.G) {
        const int hkv = u & 1, n = (u >> 1) & 31, b = u >> 6;
        const int trow0 = b * SEQ + n * 128;
        v4u kvq[4], vvq[4];
#pragma unroll
        for (int q = 0; q < 4; ++q) { const int i = tid_ + 512 * q, kj = i >> 3, ch = i & 7; const bool ok = (n > 0) || (kj >= 128);
            kvq[q] = (v4u){0u, 0u, 0u, 0u}; vvq[q] = (v4u){0u, 0u, 0u, 0u};
            if (ok) { const bf16* rowp = PROJ + (size_t)(trow0 - 128 + kj) * NPROJ + hkv * 64 + ch * 8; kvq[q] = *(const v4u*)(rowp + PJ_K); vvq[q] = *(const v4u*)(rowp + PJ_V); } }
#pragma unroll
        for (int q = 0; q < 4; ++q) {
            const int i = tid_ + 512 * q, kj = i >> 3, ch = i & 7;
            const v4u kv = kvq[q], vv = vvq[q];
            *(LAS v4u*)(Ks + kj * AT_KP + ch * 8) = kv;
            LAS bf16* vp = Vt + (ch * 8) * AT_VP + kj;
            vp[0] = (bf16)(vv.x & 0xffffu); vp[AT_VP] = (bf16)(vv.x >> 16); vp[2 * AT_VP] = (bf16)(vv.y & 0xffffu); vp[3 * AT_VP] = (bf16)(vv.y >> 16);
            vp[4 * AT_VP] = (bf16)(vv.z & 0xffffu); vp[5 * AT_VP] = (bf16)(vv.z >> 16); vp[6 * AT_VP] = (bf16)(vv.w & 0xffffu); vp[7 * AT_VP] = (bf16)(vv.w >> 16);
        }
        { const float* BT = (const float*)(P.ws + WS_BTAB) + hkv * 768;
          const float b0 = BT[tid_], b1 = (tid_ < 256) ? BT[512 + tid_] : 0.f;
          btab[tid_] = b0; if (tid_ < 256) btab[512 + tid_] = b1; }
        __syncthreads();
        const int g = F.wave & 3, h = hkv * 4 + g;
        const float sink2 = P.sinks[h] * LOG2E;
        bf16x8 qf[4], qfn[4];
#pragma unroll
        for (int kk = 0; kk < 4; ++kk) { qf[kk] = *(const bf16x8*)(PROJ + (size_t)(trow0 + 32 * ((F.wave >> 2) * 2) + r) * NPROJ + h * 64 + 16 * kk + 8 * hh);
            qfn[kk] = *(const bf16x8*)(PROJ + (size_t)(trow0 + 32 * ((F.wave >> 2) * 2 + 1) + r) * NPROJ + h * 64 + 16 * kk + 8 * hh); }
#pragma unroll 1
        for (int qq = 0; qq < 2; ++qq) {
            const int qt = (F.wave >> 2) * 2 + qq, t = trow0 + 32 * qt + r;
            f32x16 sc[5];
#pragma unroll
            for (int j = 0; j < 5; ++j) {
#pragma unroll
                for (int i = 0; i < 16; ++i) sc[j][i] = 0.f;
#pragma unroll
                for (int kk = 0; kk < 4; ++kk) { const bf16x8 a = *(const LAS bf16x8*)(Ks + (32 * (qt + j) + r) * AT_KP + 16 * kk + 8 * hh); sc[j] = MFMA32(a, qf[kk], sc[j]); }
            }
            float m = sink2;
            const LAS float* bt = btab + g * 192 + 160 + r - 4 * hh;
#pragma unroll
            for (int j = 0; j < 5; ++j) {
                const bool tile_ok = (n > 0) || (qt + j >= 4);
#pragma unroll
                for (int i = 0; i < 16; ++i) { const int dist = 128 + r - (32 * j + crow(i, hh));
                    const bool ok = tile_ok && (j == 0 ? dist < 128 : (j == 4 ? dist >= 0 : true));
                    const float s = sc[j][i] * (0.125f * LOG2E) + bt[-(32 * j + (i & 3) + 8 * (i >> 2))];
                    sc[j][i] = ok ? s : -INFINITY; m = fmaxf(m, sc[j][i]); }
            }
            m = max_halves(m);
            float l = 0.f;
#pragma unroll
            for (int j = 0; j < 5; ++j)
#pragma unroll
                for (int i = 0; i < 16; ++i) { sc[j][i] = exp2f(sc[j][i] - m); l += sc[j][i]; }
            l = sum_halves(l);
            l += exp2f(sink2 - m);
            const float inv = 1.f / l;
            f32x16 o[2];
#pragma unroll
            for (int i = 0; i < 16; ++i) { o[0][i] = 0.f; o[1][i] = 0.f; }
#pragma unroll
            for (int j = 0; j < 5; ++j)
#pragma unroll
                for (int sg = 0; sg < 2; ++sg) {
                    const bf16x8 pf = pack8(sc[j], sg);
#pragma unroll
                    for (int dt = 0; dt < 2; ++dt) {
                        const LAS bf16* vb = Vt + (32 * dt + r) * AT_VP + 32 * (qt + j) + 16 * sg + 4 * hh;
                        const s16x4 lo = *(const LAS s16x4*)(vb), hi = *(const LAS s16x4*)(vb + 8);
                        o[dt] = MFMA32(__builtin_shufflevector(lo, hi, 0, 1, 2, 3, 4, 5, 6, 7), pf, o[dt]);
                    }
                }
            bf16* op = CAT + (size_t)t * DM + h * 64 + 4 * hh;
#pragma unroll
            for (int dt = 0; dt < 2; ++dt)
#pragma unroll
                for (int g4 = 0; g4 < 4; ++g4)
                    *(unsigned long long*)(op + 32 * dt + 8 * g4) = (unsigned long long)cvtpk(o[dt][4 * g4] * inv, o[dt][4 * g4 + 1] * inv) | ((unsigned long long)cvtpk(o[dt][4 * g4 + 2] * inv, o[dt][4 * g4 + 3] * inv) << 32);
#pragma unroll
            for (int kk = 0; kk < 4; ++kk) qf[kk] = qfn[kk];
        }
        __syncthreads();
    }
}
struct Args { Ptrs p; };
__global__ void __launch_bounds__(NWAVES * 64, 2) hymba_fwd(Args args) {
    extern __shared__ __attribute__((aligned(16))) unsigned char lds[];
    const Ptrs& P = args.p;
    Frame F;
    F.lds = (LAS unsigned char*)lds;
    F.MISC = (volatile LAS unsigned*)(F.lds + MISC_OFF);
    F.wave = __builtin_amdgcn_readfirstlane(threadIdx.x >> 6);
    F.G = gridDim.x; { const int bx = blockIdx.x; F.vcu = (F.G % 8 == 0) ? (bx % 8) * (F.G / 8) + bx / 8 : bx; }
    F.ctl = (gu32*)(P.ws + WS_CTL);
    for (int u = threadIdx.x; u < (LDS_BYTES - LDSCTL_OFF) / 4; u += NWAVES * 64) ((LAS unsigned*)(F.lds + LDSCTL_OFF))[u] = 0u;
    __syncthreads();
    XcdBarrier bar = xcd_barrier_post((unsigned*)(F.ctl + CW_BAR), F.MISC + 8);
#define GRID_BAR() xcd_barrier(bar)

    bf16* XN = (bf16*)(P.ws + WS_XN); bf16* PROJ = (bf16*)(P.ws + WS_PROJ); bf16* HB = (bf16*)(P.ws + WS_ST);
    p0_prologue(F, P);
    GRID_BAR();
    { pg8::Gemm g{XN, (const bf16*)(P.ws + WS_WIN), T_, NPROJ, DM, F.wave}; pg8::StaticOrder S; S.init(T_, NPROJ, F.G, (int)blockIdx.x);
      pg8::EpiBf16<0> E{PROJ, NPROJ, nullptr, 0, 0, 1.f};
      pg8::gemm_phase<pg8::EpiBf16<0>, pg8::StaticOrder, PG8_ALIGN, PG8_SP2>(F.lds + RING_OFF, g, S, E); }
    if (F.G == 256 && blockIdx.x >= 64) p1_slack(F, P, ((int)blockIdx.x - 64) * NWAVES + F.wave, 192 * NWAVES);
    else if (F.G != 256) p1_slack(F, P, F.vcu * NWAVES + F.wave, F.G * NWAVES);
    GRID_BAR();
    ssd_s1(F, P);
    xcd_arrive(bar, F.MISC + 14);
    attn_phase(F, P);
    xcd_wait(bar, F.MISC + 14);
    ssd_s2(F, P);
    GRID_BAR();
    ssd_s3(F, P);
    GRID_BAR();
    { pg8::Gemm g{XN, (const bf16*)(P.ws + WS_WOUT), T_, DM, DM, F.wave}; pg8::StaticOrder S; S.init(T_, DM, F.G, (int)blockIdx.x);
      EpiResH E{P.x, HB, (float*)(P.ws + WS_SSQ)};
      pg8::gemm_phase<EpiResH, pg8::StaticOrder, PG8_ALIGN, PG8_SP2>(F.lds + RING_OFF, g, S, E); }
    GRID_BAR();
    { pg8::Gemm g{HB, (const bf16*)(P.ws + WS_WQ), T_, 2048, DM, F.wave}; pg8::StaticOrder S; S.init(T_, 2048, F.G, (int)blockIdx.x);
      EpiQTopk E{P.ws + WS_KEYB, (const float*)(P.ws + WS_SSQ), (int*)(P.ws + WS_IDX), (float*)(P.ws + WS_GATE)};
#pragma unroll 1
      for (int ui = 0; ui < 64; ++ui) { pg8::Unit u0; if (!S.next(ui, u0)) break;
          OneUnit S1{S, ui};
          pg8::gemm_phase<EpiQTopk, OneUnit, PG8_ALIGN, PG8_SP2>(F.lds + RING_OFF, g, S1, E); } }
    h_quant_rows(F, P);
    GRID_BAR();
    { const PeerPlace pp = peer_place(F);
      peer_down(F, P, pp); }
    GRID_BAR();
    peer_up_tm(F, P);
}

extern "C" void kernel_launch(void* const* d_in, const int* in_sizes, int n_in, void* d_out, int out_size, void* d_ws, size_t ws_size, hipStream_t stream) {
    static int grid = 0;
    if (grid == 0) {
        if (n_in != 19 || out_size != T_ * DM || ws_size < WS_END) { fprintf(stderr, "kernel_launch: unexpected shapes (n_in %d, out %d, ws %zu)\n", n_in, out_size, ws_size); grid = -1; return; }
        int dev = 0, cus = 0, per_cu = 0;
        if (hipGetDevice(&dev) != hipSuccess || hipDeviceGetAttribute(&cus, hipDeviceAttributeMultiprocessorCount, dev) != hipSuccess) { grid = -1; return; }
        if (hipFuncSetAttribute((const void*)hymba_fwd, hipFuncAttributeMaxDynamicSharedMemorySize, LDS_BYTES) != hipSuccess) { fprintf(stderr, "kernel_launch: hipFuncSetAttribute failed\n"); grid = -1; return; }
        if (hipOccupancyMaxActiveBlocksPerMultiprocessor(&per_cu, (const void*)hymba_fwd, NWAVES * 64, LDS_BYTES) != hipSuccess || per_cu < 1) { fprintf(stderr, "kernel_launch: occupancy query says %d blocks per CU\n", per_cu); grid = -1; (void)hipGetLastError(); return; }
        grid = cus;
    }
    if (grid < 0) return;
    (void)hipMemsetAsync((char*)d_ws + WS_CTL, 0, CTL_ZERO_BYTES, stream);
    Args a{};
    const float** pp = (const float**)&a.p;
    for (int i = 0; i < 19; ++i) pp[i] = (const float*)d_in[i];
    a.p.out = (float*)d_out; a.p.ws = (unsigned char*)d_ws;
    hipLaunchKernelGGL(hymba_fwd, dim3(grid), dim3(NWAVES * 64), LDS_BYTES, stream, a);
}
```

```cpp
#include <hip/hip_runtime.h>
#include <cstdio>
#include <cstdint>
#include <math.h>
namespace pg8 {
#define PG8_LAS __attribute__((address_space(3)))
typedef unsigned short bf16_t;
typedef short bf16x8 __attribute__((ext_vector_type(8)));
typedef float f32x4 __attribute__((ext_vector_type(4)));
typedef unsigned u32x4 __attribute__((ext_vector_type(4)));
constexpr int BM = 256, BK = 64, HALF = 128, HTB = HALF * BK * 2  , STAGE_BYTES = 8 * HTB, NXCD = 8, WGM = 8;

__host__ __device__ __forceinline__ int lds_byte(int r, int c) { const int st = (r >> 4) * 2 + (c >> 5), rr = r & 15, cc = c & 31, ob = rr * 64 + cc * 2; return st * 1024 + (ob ^ (((ob >> 9) & 1) << 5)); }
__host__ __device__ __forceinline__ void stage_rc(int b, int& R, int& C) { const int st = b / 1024, sb = b % 1024, swz = sb ^ (((sb >> 9) & 1) << 5); R = (st >> 1) * 16 + swz / 64; C = (st & 1) * 32 + (swz % 64) / 2; }
__host__ __device__ __forceinline__ int perm32(int rho) { const int n = rho >> 4, i = rho & 15; return 8 * (i >> 2) + 4 * n + (i & 3); }

struct Unit { int pm, pn; };
struct Gemm { const bf16_t* A; const bf16_t* Bt; int M, N, K, wave; };

struct StaticOrder {
    int nM, nN, nwg, G, c;
    __host__ __device__ void init(int M, int N, int G_, int c_) { nM = M / BM; nN = N / BM; nwg = nM * nN; G = G_; c = c_; }
    __host__ __device__ bool next(int i, Unit& u) const {
        const long L = (long)i * G + c; if (L >= nwg) return false;
        int wgid = (int)L; { const int q = nwg / NXCD, r = nwg % NXCD, xcd = wgid % NXCD, off = wgid / NXCD; wgid = (xcd < r ? xcd * (q + 1) : r * (q + 1) + (xcd - r) * q) + off; }
        const int nig = WGM * nN, gid = wgid / nig, fm = gid * WGM, gsz = (nM - fm) < WGM ? (nM - fm) : WGM;
        u.pm = fm + ((wgid % nig) % gsz); u.pn = (wgid % nig) / gsz; return true;
    }
    __device__ __forceinline__ void a_ready(const Unit&) const {}
    __device__ __forceinline__ void done(const Unit&) const {}
};

__device__ __forceinline__ unsigned cvt_pk_bf16(float lo, float hi) { unsigned r; asm volatile("v_cvt_pk_bf16_f32 %0, %1, %2" : "=v"(r) : "v"(lo), "v"(hi)); return r; }
typedef float f32x2 __attribute__((ext_vector_type(2)));
__device__ __forceinline__ f32x2 gelu_pk(f32x2 v) {
    const f32x2 av = __builtin_elementwise_abs(v), d = av * 0.2316418882f + 1.0f;
    f32x2 t; t.x = __builtin_amdgcn_rcpf(d.x); t.y = __builtin_amdgcn_rcpf(d.y);
    f32x2 q = t * 0.5307027145f + (-0.7265760135f); q = q * t + 0.7107068705f; q = q * t + (-0.142248368f); q = q * t + 0.127414796f; q = q * t;
    const f32x2 s = (v * v) * (-0.72134752044f);
    f32x2 e; e.x = __builtin_amdgcn_exp2f(s.x); e.y = __builtin_amdgcn_exp2f(s.y);
    const f32x2 m = v * (q * e), r = v - m;
    f32x2 o; o.x = v.x < 0.f ? m.x : r.x; o.y = v.y < 0.f ? m.y : r.y; return o;
}

template <int ACT  > struct EpiBf16 {
    static constexpr bool PERM = true, AFTER_DRAIN = false; static_assert(ACT == 0 || ACT == 1, "EpiBf16: ACT is 0 (none) or 1 (gelu_pk)");
    bf16_t* O; int ldc; const float* bias; int split_cols; size_t split_stride; float scale0;
    __device__ __forceinline__ void operator()(const f32x4 (&acc)[2][2][4][2], const Unit& u, int wr, int wc, int fr, int fq) const {
        const int row0 = u.pm * BM + wr * 64 + fr; int colt = u.pn * BM; bf16_t* base = O;
        float sc = 1.f; if (split_cols) { const int t = colt / split_cols; base += (size_t)t * split_stride; colt -= t * split_cols; if (t == 0) sc = scale0; }
        const int col0 = colt + wc * 32 + 8 * fq, bcol0 = u.pn * BM + wc * 32 + 8 * fq;
        f32x4 bv[2][2];
#pragma unroll
        for (int bj = 0; bj < 2; ++bj)
#pragma unroll
            for (int n = 0; n < 2; ++n) bv[bj][n] = bias ? *(const f32x4*)(bias + bcol0 + bj * HALF + 4 * n) : (f32x4){0.f, 0.f, 0.f, 0.f};
#pragma unroll
        for (int ai = 0; ai < 2; ++ai)
#pragma unroll
            for (int m = 0; m < 4; ++m) { bf16_t* rowp = base + (size_t)(row0 + ai * HALF + m * 16) * ldc + col0;
#pragma unroll
                for (int bj = 0; bj < 2; ++bj) { f32x4 v0 = acc[ai][bj][m][0] + bv[bj][0], v1 = acc[ai][bj][m][1] + bv[bj][1];
                    if (ACT == 1) { f32x2 a = gelu_pk((f32x2){v0[0], v0[1]}), b = gelu_pk((f32x2){v0[2], v0[3]}), c = gelu_pk((f32x2){v1[0], v1[1]}), d = gelu_pk((f32x2){v1[2], v1[3]});
                        v0 = (f32x4){a.x, a.y, b.x, b.y}; v1 = (f32x4){c.x, c.y, d.x, d.y}; }
                    v0 = v0 * sc; v1 = v1 * sc; u32x4 w; w.x = cvt_pk_bf16(v0[0], v0[1]); w.y = cvt_pk_bf16(v0[2], v0[3]); w.z = cvt_pk_bf16(v1[0], v1[1]); w.w = cvt_pk_bf16(v1[2], v1[3]);
                    *(u32x4*)(rowp + bj * HALF) = w; } }
    }
};
template <class Epi, class Sched, bool ALIGN_EPI = false, bool SP2 = false>
__device__ __forceinline__ void gemm_phase(PG8_LAS unsigned char* lds, const Gemm g, const Sched& S, const Epi& E) {
    int lane_l; asm volatile("v_mbcnt_lo_u32_b32 %0, -1, 0\n\tv_mbcnt_hi_u32_b32 %0, -1, %0" : "=v"(lane_l));
    const int wid = g.wave, lane = lane_l, tid = wid * 64 + lane,
              wr = wid >> 2, wc = wid & 3, fr = lane & 15, fq = lane >> 4;
    const int K = g.K, nt = K / BK;
    unsigned voffA[2], voffB[2];
#pragma unroll
    for (int i = 0; i < 2; ++i) { int R, C; stage_rc(tid * 16 + i * 8192, R, C); const int Rb = Epi::PERM ? ((R & ~31) + perm32(R & 31)) : R;
        voffA[i] = (unsigned)(R * K + C) * 2u; voffB[i] = (unsigned)(Rb * K + C) * 2u; }
    const size_t kstep = (size_t)(BK * 2);
    const size_t hstep = (size_t)HALF * K * 2;
    const size_t tstep = 2 * hstep;
    const unsigned ldsw = (unsigned)wid * 1024u;
    const int aoff = lds_byte(wr * 64 + fr, fq * 8), boff = lds_byte(wc * 32 + fr, fq * 8);
#define PG8_SA(b, h) (((b) * 2 + (h)) * HTB)
#define PG8_SB(b, h) ((4 + (b) * 2 + (h)) * HTB)
#define PG8_STAGE(bufoff, gbase, voff) do { _Pragma("unroll") for (int _i = 0; _i < 2; ++_i) \
        __builtin_amdgcn_global_load_lds((const unsigned*)((const char*)(gbase) + (voff)[_i]), (PG8_LAS unsigned*)(lds + (bufoff) + ldsw + _i * 8192), 16, 0, 0); } while (0)
#define PG8_LDA(dst, b, h) do { _Pragma("unroll") for (int m = 0; m < 4; ++m) _Pragma("unroll") for (int k = 0; k < 2; ++k) dst[m][k] = *(const PG8_LAS bf16x8*)(lds + PG8_SA(b, h) + aoff + m * 2048 + k * 1024); } while (0)
#define PG8_LDB(dst, b, h) do { _Pragma("unroll") for (int n = 0; n < 2; ++n) _Pragma("unroll") for (int k = 0; k < 2; ++k) dst[n][k] = *(const PG8_LAS bf16x8*)(lds + PG8_SB(b, h) + boff + n * 2048 + k * 1024); } while (0)
#define PG8_MMA(ai, bj, At, Bt) do { __builtin_amdgcn_s_setprio(1); _Pragma("unroll") for (int m = 0; m < 4; ++m) _Pragma("unroll") for (int n = 0; n < 2; ++n) _Pragma("unroll") for (int k = 0; k < 2; ++k) \
        acc[ai][bj][m][n] = __builtin_amdgcn_mfma_f32_16x16x32_bf16(Bt[n][k], At[m][k], acc[ai][bj][m][n], 0, 0, 0); __builtin_amdgcn_s_setprio(0); } while (0)
#define PG8_WAIT_V(n) asm volatile("s_waitcnt vmcnt(" #n ")" ::: "memory")
#define PG8_WAIT_L(n) asm volatile("s_waitcnt lgkmcnt(" #n ")" ::: "memory")
#define PG8_BAR __builtin_amdgcn_s_barrier()
#define PG8_SCHED __builtin_amdgcn_sched_barrier(0)
    Unit cur, nxt; int ui = 0;
    if (!S.next(0, cur)) return;
    f32x4 acc[2][2][4][2];
#pragma unroll
    for (int a = 0; a < 2; ++a)
#pragma unroll
        for (int b = 0; b < 2; ++b)
#pragma unroll
            for (int m = 0; m < 4; ++m)
#pragma unroll
                for (int n = 0; n < 2; ++n) acc[a][b][m][n] = (f32x4){0.f, 0.f, 0.f, 0.f};
    bf16x8 At[4][2], B0[2][2], B1[2][2];
    const char* cA = (const char*)g.A + (size_t)cur.pm * tstep; const char* cB = (const char*)g.Bt + (size_t)cur.pn * tstep;
    S.a_ready(cur);
    if constexpr (SP2) {
        PG8_STAGE(PG8_SB(0, 0), cB, voffB); PG8_STAGE(PG8_SB(0, 1), cB + hstep, voffB); PG8_STAGE(PG8_SA(0, 0), cA, voffA); PG8_STAGE(PG8_SA(0, 1), cA + hstep, voffA);
        if (wr == 1) PG8_BAR;
        PG8_WAIT_V(2); PG8_BAR;
        PG8_STAGE(PG8_SB(1, 0), cB + kstep, voffB); PG8_STAGE(PG8_SA(1, 0), cA + kstep, voffA); PG8_STAGE(PG8_SB(1, 1), cB + hstep + kstep, voffB);
        PG8_WAIT_V(6); PG8_BAR;
    } else {
        PG8_STAGE(PG8_SB(0, 0), cB, voffB); PG8_STAGE(PG8_SA(0, 0), cA, voffA); PG8_STAGE(PG8_SB(0, 1), cB + hstep, voffB); PG8_STAGE(PG8_SA(0, 1), cA + hstep, voffA);
        if (wr == 1) PG8_BAR;
        PG8_WAIT_V(4); PG8_BAR;
        PG8_STAGE(PG8_SB(1, 0), cB + kstep, voffB); PG8_STAGE(PG8_SA(1, 0), cA + kstep, voffA); PG8_STAGE(PG8_SB(1, 1), cB + hstep + kstep, voffB);
        PG8_WAIT_V(6); PG8_BAR;
    }
    for (;;) {
        const bool has_next = S.next(ui + 1, nxt);
        const char* nA = has_next ? (const char*)g.A + (size_t)nxt.pm * tstep : cA; const char* nB = has_next ? (const char*)g.Bt + (size_t)nxt.pn * tstep : cB;
        for (int t = 0; t < nt; t += 2) {
            const bool last = (t == nt - 2);
            const char* a1 = cA + (size_t)(t + 1) * kstep;
            const char* a2 = last ? nA : cA + (size_t)(t + 2) * kstep; const char* b2 = last ? nB : cB + (size_t)(t + 2) * kstep;
            const char* a3 = a2 + kstep; const char* b3 = b2 + kstep;
            if (last && has_next) S.a_ready(nxt);
            if constexpr (SP2) {
            PG8_LDB(B0, 0, 0); PG8_LDB(B1, 0, 1); PG8_SCHED; PG8_LDA(At, 0, 0); PG8_STAGE(PG8_SA(1, 1), a1 + hstep, voffA);
            PG8_WAIT_V(8); PG8_WAIT_L(0); PG8_BAR; PG8_MMA(0, 0, At, B0); PG8_MMA(0, 1, At, B1); PG8_BAR; PG8_SCHED;
            PG8_LDA(At, 0, 1); PG8_STAGE(PG8_SB(0, 0), b2, voffB); PG8_STAGE(PG8_SB(0, 1), b2 + hstep, voffB); PG8_STAGE(PG8_SA(0, 0), a2, voffA);
            PG8_WAIT_V(8); PG8_WAIT_L(0); PG8_BAR; PG8_MMA(1, 0, At, B0); PG8_MMA(1, 1, At, B1); PG8_BAR; PG8_SCHED;
            PG8_LDB(B0, 1, 0); PG8_LDB(B1, 1, 1); PG8_SCHED; PG8_LDA(At, 1, 0); PG8_STAGE(PG8_SA(0, 1), a2 + hstep, voffA);
            PG8_WAIT_V(8); PG8_WAIT_L(0); PG8_BAR; PG8_MMA(0, 0, At, B0); PG8_MMA(0, 1, At, B1); PG8_BAR; PG8_SCHED;
            PG8_LDA(At, 1, 1); PG8_STAGE(PG8_SB(1, 0), b3, voffB); PG8_STAGE(PG8_SB(1, 1), b3 + hstep, voffB); PG8_STAGE(PG8_SA(1, 0), a3, voffA);
            PG8_WAIT_V(8); PG8_WAIT_L(0); PG8_BAR; PG8_MMA(1, 0, At, B0); PG8_MMA(1, 1, At, B1); PG8_BAR; PG8_SCHED;
            } else {
            PG8_LDB(B0, 0, 0); PG8_SCHED; PG8_LDA(At, 0, 0); PG8_STAGE(PG8_SA(1, 1), a1 + hstep, voffA);
            PG8_WAIT_L(8); PG8_BAR; PG8_WAIT_L(0); PG8_MMA(0, 0, At, B0); PG8_BAR; PG8_SCHED;
            PG8_LDB(B1, 0, 1); PG8_STAGE(PG8_SB(0, 0), b2, voffB);
            PG8_BAR; PG8_WAIT_L(0); PG8_MMA(0, 1, At, B1); PG8_BAR;
            PG8_LDA(At, 0, 1); PG8_STAGE(PG8_SA(0, 0), a2, voffA);
            PG8_BAR; PG8_WAIT_L(0); PG8_MMA(1, 0, At, B0); PG8_BAR; PG8_SCHED;
            PG8_STAGE(PG8_SB(0, 1), b2 + hstep, voffB);
            PG8_WAIT_V(6); PG8_BAR; PG8_MMA(1, 1, At, B1); PG8_BAR;
            PG8_LDB(B0, 1, 0); PG8_SCHED; PG8_LDA(At, 1, 0); PG8_STAGE(PG8_SA(0, 1), a2 + hstep, voffA);
            PG8_WAIT_L(8); PG8_BAR; PG8_WAIT_L(0); PG8_MMA(0, 0, At, B0); PG8_BAR; PG8_SCHED;
            PG8_LDB(B1, 1, 1); PG8_STAGE(PG8_SB(1, 0), b3, voffB);
            PG8_BAR; PG8_WAIT_L(0); PG8_MMA(0, 1, At, B1); PG8_BAR;
            PG8_LDA(At, 1, 1); PG8_STAGE(PG8_SA(1, 0), a3, voffA);
            PG8_BAR; PG8_WAIT_L(0); PG8_MMA(1, 0, At, B0); PG8_BAR; PG8_SCHED;
            PG8_STAGE(PG8_SB(1, 1), b3 + hstep, voffB);
            PG8_WAIT_V(6); PG8_BAR; PG8_MMA(1, 1, At, B1); PG8_BAR;
            }
        }
        if constexpr (ALIGN_EPI) { if (wr == 0) PG8_BAR; }
        if constexpr (!Epi::AFTER_DRAIN) { E(acc, cur, wr, wc, fr, fq); S.done(cur); }
        if (!has_next) break;
#pragma unroll
        for (int a = 0; a < 2; ++a)
#pragma unroll
            for (int b = 0; b < 2; ++b)
#pragma unroll
                for (int m = 0; m < 4; ++m)
#pragma unroll
                    for (int n = 0; n < 2; ++n) acc[a][b][m][n] = (f32x4){0.f, 0.f, 0.f, 0.f};
        cur = nxt; cA = nA; cB = nB; ++ui;
        if constexpr (ALIGN_EPI) { if (wr == 1) PG8_BAR; }
    }
    PG8_WAIT_V(0);
    if constexpr (!ALIGN_EPI) { if (wr == 0) PG8_BAR; }
    PG8_BAR;
    if constexpr (Epi::AFTER_DRAIN) { E.fused(acc, cur, wr, wc, fr, fq, lds, wid, lane); S.done(cur); }
#undef PG8_SA
#undef PG8_SB
#undef PG8_STAGE
#undef PG8_LDA
#undef PG8_LDB
#undef PG8_MMA
#undef PG8_WAIT_V
#undef PG8_WAIT_L
#undef PG8_BAR
#undef PG8_SCHED
}
}

#ifndef PG8_SP2
#define PG8_SP2 true
#endif
#ifndef PG8_ALIGN
#define PG8_ALIGN true
#endif
#define GAS __attribute__((address_space(1)))
#define LAS __attribute__((address_space(3)))
typedef unsigned short bf16;
typedef unsigned v4u __attribute__((ext_vector_type(4)));
typedef float f32x4 __attribute__((ext_vector_type(4)));
typedef short bf16x8 __attribute__((ext_vector_type(8)));
typedef GAS unsigned gu32;
typedef GAS unsigned long long gu64;
#define RLX_AGENT __ATOMIC_RELAXED, __HIP_MEMORY_SCOPE_AGENT
#define LDS_WAIT() asm volatile("s_waitcnt lgkmcnt(0)" ::: "memory")
#define VM_WAIT() asm volatile("s_waitcnt vmcnt(0)" ::: "memory")
__device__ __forceinline__ unsigned long long rt() { return __builtin_amdgcn_s_memrealtime(); }
__device__ __forceinline__ unsigned f2bf(float f) { unsigned u = __builtin_bit_cast(unsigned, f); return (u + 0x7fffu + ((u >> 16) & 1u)) >> 16; }
__device__ __forceinline__ unsigned pk2(float lo, float hi) { return f2bf(lo) | (f2bf(hi) << 16); }

#define XB_TMO      128
#define XB_XCNT(j)  (256  + 64 * (j))
#define XB_XSUB(j)  (1280 + 64 * (j))
#define XB_XGEN(j)  (2304 + 64 * (j))
#define XB_TOP      3328
#define XB_TOPGEN   3392
#define XCD_BAR_WORDS 3456
#define XB_SPIN_CAP (1u << 22)

__device__ __forceinline__ unsigned xb_ld(unsigned* p)              { return __hip_atomic_load(p, __ATOMIC_RELAXED, __HIP_MEMORY_SCOPE_AGENT); }
__device__ __forceinline__ unsigned xb_add(unsigned* p, unsigned v) { return __hip_atomic_fetch_add(p, v, __ATOMIC_RELAXED, __HIP_MEMORY_SCOPE_AGENT); }
__device__ __forceinline__ unsigned xb_xcc_id() { return (unsigned)__builtin_amdgcn_s_getreg((3 << 11) | 20) & 0xFu; }
#define XB_SPIN(cond, bar) do { unsigned _sp = 0; while (cond) { __builtin_amdgcn_s_sleep(1); \
    if ((++_sp & 255u) == 0u) { if (xb_ld(&(bar)[XB_TMO])) break; if (_sp > XB_SPIN_CAP) { atomicAdd(&(bar)[XB_TMO], 1u); break; } } } } while (0)

struct XcdBarrier {
    unsigned* bar; unsigned x;
    volatile LAS unsigned* st;
};

__device__ __forceinline__ XcdBarrier xcd_barrier_post(unsigned* bar, volatile LAS unsigned* st) {
    XcdBarrier b; b.bar = bar; b.x = xb_xcc_id(); b.st = st;
    if (threadIdx.x == 0) (void)xb_add(&bar[XB_XCNT(b.x)], 1u);
    return b;
}
__device__ __forceinline__ void xcd_barrier_complete(unsigned* bar, unsigned x, unsigned& nloc, unsigned& nx) {
    const unsigned G = gridDim.x * gridDim.y * gridDim.z;
    unsigned sum, cnt, mine, sp = 0u;
    for (;;) {
        sum = 0u; cnt = 0u; mine = 0u;
#pragma unroll
        for (unsigned j = 0; j < 16; ++j) { const unsigned c = xb_ld(&bar[XB_XCNT(j)]); sum += c; cnt += (c > 0u) ? 1u : 0u; mine = (j == x) ? c : mine; }
        if (sum == G) break;
        __builtin_amdgcn_s_sleep(1);
        if ((++sp & 255u) == 0u) { if (xb_ld(&bar[XB_TMO])) break; if (sp > XB_SPIN_CAP) { atomicAdd(&bar[XB_TMO], 1u); break; } }
    }
    nloc = mine > 0u ? mine : 1u; nx = cnt > 0u ? cnt : 1u;
}

__device__ __forceinline__ void xcd_barrier(const XcdBarrier& b) {
    asm volatile("s_waitcnt vmcnt(0)" ::: "memory");
    __syncthreads();
    if (threadIdx.x == 0) {
        unsigned* bar = b.bar;
        __builtin_amdgcn_s_waitcnt(0);
        unsigned nloc = b.st[0], nx = b.st[1];
        if (nloc == 0u) { xcd_barrier_complete(bar, b.x, nloc, nx); b.st[0] = nloc; b.st[1] = nx; }
        const unsigned old = xb_add(&bar[XB_XSUB(b.x)], 1u);
        const unsigned gen = old / nloc;
        if (old + 1u == (gen + 1u) * nloc) {
            __builtin_amdgcn_fence(__ATOMIC_RELEASE, "agent");
            asm volatile("s_waitcnt vmcnt(0)" ::: "memory");
            const unsigned og = xb_add(&bar[XB_TOP], 1u);
            const unsigned tg = og / nx;
            if (og + 1u == (tg + 1u) * nx) xb_add(&bar[XB_TOPGEN], 1u);
            else XB_SPIN(xb_ld(&bar[XB_TOPGEN]) == tg, bar);
            __builtin_amdgcn_fence(__ATOMIC_ACQUIRE, "agent");
            asm volatile("s_waitcnt vmcnt(0)" ::: "memory");
        } else {
            XB_SPIN(xb_ld(&bar[XB_TOPGEN]) == gen, bar);
            __builtin_amdgcn_fence(__ATOMIC_ACQUIRE, "agent");
            asm volatile("s_waitcnt vmcnt(0)" ::: "memory");
        }
    }
    __syncthreads();
}

__device__ __forceinline__ void xcd_arrive(const XcdBarrier& b, volatile LAS unsigned* sx) {
    asm volatile("s_waitcnt vmcnt(0)" ::: "memory");
    __syncthreads();
    if (threadIdx.x == 0) {
        unsigned* bar = b.bar;
        __builtin_amdgcn_s_waitcnt(0);
        unsigned nloc = b.st[0], nx = b.st[1];
        if (nloc == 0u) { xcd_barrier_complete(bar, b.x, nloc, nx); b.st[0] = nloc; b.st[1] = nx; }
        const unsigned old = xb_add(&bar[XB_XSUB(b.x)], 1u);
        const unsigned gen = old / nloc;
        unsigned leader = 0u, key = gen;
        if (old + 1u == (gen + 1u) * nloc) {
            leader = 1u;
            __builtin_amdgcn_fence(__ATOMIC_RELEASE, "agent");
            asm volatile("s_waitcnt vmcnt(0)" ::: "memory");
            const unsigned og = xb_add(&bar[XB_TOP], 1u);
            const unsigned tg = og / nx; key = tg;
            if (og + 1u == (tg + 1u) * nx) xb_add(&bar[XB_TOPGEN], 1u);
        }
        sx[0] = leader; sx[1] = key;
    }
}
__device__ __forceinline__ void xcd_wait(const XcdBarrier& b, volatile LAS unsigned* sx) {
    if (threadIdx.x == 0) {
        unsigned* bar = b.bar;
        const unsigned leader = sx[0], key = sx[1];
        if (leader) {
            XB_SPIN(xb_ld(&bar[XB_TOPGEN]) == key, bar);
            __builtin_amdgcn_fence(__ATOMIC_ACQUIRE, "agent");
            asm volatile("s_waitcnt vmcnt(0)" ::: "memory");
        } else {
            XB_SPIN(xb_ld(&bar[XB_TOPGEN]) == key, bar);
            __builtin_amdgcn_fence(__ATOMIC_ACQUIRE, "agent");
            asm volatile("s_waitcnt vmcnt(0)" ::: "memory");
        }
    }
    __syncthreads();
}

constexpr int NWAVES = 8;
constexpr int T_ = 16384, SEQ = 4096, DM = 1024, NPROJ = 2304, INC = 2312;
constexpr int PJ_K = 512, PJ_V = 640, PJ_Z = 768, PJ_XBC = 1280;
constexpr float EPS = 1e-6f;
constexpr size_t MiB = 1u << 20;
constexpr size_t WS_CTL = 0, CTL_ZERO_BYTES = 65536;
constexpr size_t WS_KEYB = 1 * MiB + 256 * 1024;
constexpr size_t WS_BTAB = 1 * MiB + 384 * 1024;
constexpr size_t WS_SMALL = 1 * MiB;
constexpr size_t WS_WIN = 2 * MiB, WS_WOUT = 7 * MiB, WS_WQ = 9 * MiB;
constexpr size_t WS_ED = 13 * MiB, WS_EU = 29 * MiB;
constexpr size_t WS_XN = 77 * MiB;
constexpr size_t WS_PROJ = 109 * MiB;
constexpr size_t WS_ST = 181 * MiB;
constexpr size_t WS_IDX = 213 * MiB, WS_GATE = 221 * MiB, WS_SSQ = 229 * MiB, WS_END = 230 * MiB;
constexpr size_t DO_Y = 0, DO_DT = 41 * MiB;
constexpr size_t WS_CC = 230 * MiB, WS_DT = 238 * MiB, WS_EA = 239 * MiB, WS_CDEC = 240 * MiB, WS_PREV = WS_IDX;
constexpr size_t DO_YPF = 0, DO_CAT = 32 * MiB;
constexpr size_t WS_RINV = 1 * MiB + 512 * 1024;
constexpr size_t WS_PART = WS_PROJ;
constexpr size_t WS_H8 = WS_XN, WS_HS = WS_DT;
constexpr size_t WS_SSQ2 = WS_EA;
constexpr int CW_BAR = 4096, CW_RANK = 8192;
constexpr int RING_OFF = 0, RING_BYTES = 147456, LDSCTL_OFF = RING_BYTES, MISC_OFF = LDSCTL_OFF + 320, LDS_BYTES = 163840;

__constant__ unsigned char c_bucket[128] = {0, 1, 2, 3, 4, 5, 6, 7, 8, 9, 10, 11, 12, 13, 14, 15, 16, 16, 16, 17, 17, 18, 18, 18, 19, 19, 19, 20, 20, 20, 20, 21, 21, 21, 21, 22, 22, 22, 22, 22, 23, 23, 23, 23, 23, 23, 24, 24, 24, 24, 24, 24, 25, 25, 25, 25, 25, 25, 25, 26, 26, 26, 26, 26, 26, 26, 26, 27, 27, 27, 27, 27, 27, 27, 27, 27, 27, 28, 28, 28, 28, 28, 28, 28, 28, 28, 28, 29, 29, 29, 29, 29, 29, 29, 29, 29, 29, 29, 29, 30, 30, 30, 30, 30, 30, 30, 30, 30, 30, 30, 30, 30, 30, 31, 31, 31, 31, 31, 31, 31, 31, 31, 31, 31, 31, 31, 31, 31};

typedef float v16f __attribute__((ext_vector_type(16)));
typedef float v32f __attribute__((ext_vector_type(32)));
typedef unsigned v6u __attribute__((ext_vector_type(6)));
typedef _Float16 v32h __attribute__((ext_vector_type(32)));
struct Frame {
    LAS unsigned char* lds;
    volatile LAS unsigned* MISC;
    gu32* ctl;
    int wave, vcu, G;
};
__device__ __forceinline__ int lane_id() { int l; asm volatile("v_mbcnt_lo_u32_b32 %0, -1, 0\n\tv_mbcnt_hi_u32_b32 %0, -1, %0" : "=v"(l)); return l; }
__device__ __forceinline__ int opq(int x) { asm volatile("" : "+v"(x)); return x; }
template <int M> __device__ __forceinline__ float swz_xor(float v) { return __int_as_float(__builtin_amdgcn_ds_swizzle(__float_as_int(v), (M << 10) | 0x1F)); }
__device__ __forceinline__ float sum_halves(float v) { const auto r = __builtin_amdgcn_permlane32_swap(__float_as_uint(v), __float_as_uint(v), false, false); return __uint_as_float(r[0]) + __uint_as_float(r[1]); }
__device__ __forceinline__ float max_halves(float v) { const auto r = __builtin_amdgcn_permlane32_swap(__float_as_uint(v), __float_as_uint(v), false, false); return fmaxf(__uint_as_float(r[0]), __uint_as_float(r[1])); }
__device__ __forceinline__ int imax_halves(int v) { const auto r = __builtin_amdgcn_permlane32_swap((unsigned)v, (unsigned)v, false, false); return max((int)r[0], (int)r[1]); }
__device__ __forceinline__ float wave_sum(float v) {
    v += swz_xor<1>(v); v += swz_xor<2>(v); v += swz_xor<4>(v); v += swz_xor<8>(v); v += swz_xor<16>(v);
    return sum_halves(v);
}
__device__ __forceinline__ float bf2f(unsigned short b) { return __uint_as_float((unsigned)b << 16); }
__device__ __forceinline__ float bflo(unsigned w) { return __uint_as_float(w << 16); }
__device__ __forceinline__ float bfhi(unsigned w) { return __uint_as_float(w & 0xffff0000u); }
__device__ __forceinline__ float silu_f(float x) { return x / (1.f + __expf(-x)); }

__device__ __forceinline__ float4 ldnt4(const float* p) { const f32x4 v = __builtin_nontemporal_load((const f32x4*)p); return make_float4(v[0], v[1], v[2], v[3]); }
__device__ __forceinline__ void p0_transpose_item(const float* W, int ldw, int K, int nblk, bf16* WT, const float* kscale, LAS float* scr, int item, int lane) {
    const int kb = item / nblk, nb = item % nblk, k0 = 64 * kb, n0 = 32 * nb;
    float ks_[32];
#pragma unroll
    for (int i = 0; i < 32; ++i) ks_[i] = kscale ? kscale[k0 + 2 * i + (lane >> 5)] : 1.f;
    float vv_[32];
#pragma unroll
    for (int i = 0; i < 32; ++i) vv_[i] = __builtin_nontemporal_load(W + (size_t)(k0 + 2 * i + (lane >> 5)) * ldw + n0 + (lane & 31));
#pragma unroll
    for (int i = 0; i < 32; ++i) scr[(2 * i + (lane >> 5)) * 33 + (lane & 31)] = vv_[i] * ks_[i];
#pragma unroll 1
    for (int i = 32; i < 32; ++i) { const int kk = 2 * i + (lane >> 5); float v = W[(size_t)(k0 + kk) * ldw + n0 + (lane & 31)]; if (kscale) v *= kscale[k0 + kk]; scr[kk * 33 + (lane & 31)] = v; }
    LDS_WAIT(); asm volatile("" ::: "memory");
    const int c = lane & 7;
#pragma unroll
    for (int j = 0; j < 4; ++j) { const int n = (lane >> 3) + 8 * j; const LAS float* s = scr + (8 * c) * 33 + n;
        v4u o; o.x = pk2(s[0 * 33], s[1 * 33]); o.y = pk2(s[2 * 33], s[3 * 33]); o.z = pk2(s[4 * 33], s[5 * 33]); o.w = pk2(s[6 * 33], s[7 * 33]);
        *(GAS v4u*)(WT + (size_t)(n0 + n) * K + k0 + 8 * c) = o; }
    LDS_WAIT(); asm volatile("" ::: "memory");
}
struct Ptrs {
    const float *x, *norm_mix, *w_in, *conv_w, *conv_b, *dt_bias, *a_log, *d_skip, *ssd_norm_w, *sinks, *w_out, *rel_bias, *norm_ffn, *w_query, *sk1, *sk2, *e_down, *e_up, *norm_final;
    float* out; unsigned char* ws;
};
constexpr int Q_SPLIT = 0;
__device__ __forceinline__ unsigned pack4_i8(float a, float b, float c, float d) {
    const int ia = __float2int_rn(a), ib = __float2int_rn(b), ic = __float2int_rn(c), id = __float2int_rn(d);
    return (unsigned)(ia & 0xff) | ((unsigned)(ib & 0xff) << 8) | ((unsigned)(ic & 0xff) << 16) | ((unsigned)(id & 0xff) << 24);
}
__device__ __forceinline__ unsigned pack8_i4(const float* v, float inv) {
    unsigned o = 0u;
#pragma unroll
    for (int i = 0; i < 8; ++i) { int q = __float2int_rn(v[i] * inv); q = q < -7 ? -7 : (q > 7 ? 7 : q); o |= ((unsigned)q & 15u) << (4 * i); }
    return o;
}
__device__ __forceinline__ void quant_fp8s(const Ptrs& P, int lane_, int r_lo, int r_hi, int w, int nw) {
    float* SC = (float*)(P.ws + WS_SMALL);
    int row = r_lo + w;
    if (row >= r_hi) return;
    float4 w4[4];
#pragma unroll
    for (int q = 0; q < 4; ++q) w4[q] = ((const float4*)P.norm_ffn)[64 * q + lane_];
    float4 ba[4], bb[4];
#define QD_LOAD(B_, R_) do { const int rl_ = ((R_) < r_hi) ? (R_) : (r_lo + w); _Pragma("unroll") for (int q = 0; q < 4; ++q) B_[q] = ldnt4(P.e_down + (size_t)(rl_ & 16383) * DM + 4 * (64 * q + lane_)); } while (0)
#define QD_STORE() do { _Pragma("unroll") for (int q = 0; q < 4; ++q) *(unsigned short*)(P.ws + WS_ED + ((size_t)q * 16384 + (prow & 16383)) * 128 + lane_ * 2) = (unsigned short)(po >> (16 * q)); if (lane_ == 0) SC[2 * prow] = psc; } while (0)
#define QD_WORK(B_, R_) do { float v[16]; \
        _Pragma("unroll") for (int q = 0; q < 4; ++q) { const float4 t = B_[q]; v[4 * q] = t.x * w4[q].x; v[4 * q + 1] = t.y * w4[q].y; v[4 * q + 2] = t.z * w4[q].z; v[4 * q + 3] = t.w * w4[q].w; } \
        float ss = 0.f; _Pragma("unroll") for (int q = 0; q < 16; ++q) ss = fmaf(v[q], v[q], ss); \
        const float sc = fmaxf(2.5f * sqrtf(wave_sum(ss) * (1.f / 1024.f)) * (1.f / 7.f), 1e-30f); const float inv = 1.f / sc; \
        po = (unsigned long long)pack8_i4(v, inv) | ((unsigned long long)pack8_i4(v + 8, inv) << 32); psc = sc; prow = (R_); } while (0)
    unsigned long long po; float psc; int prow;
    QD_LOAD(ba, row);
    QD_LOAD(bb, row + nw);
    __builtin_amdgcn_sched_barrier(0);
    QD_WORK(ba, row);
    row += nw;
    while (row < r_hi) {
        QD_STORE();
        QD_LOAD(ba, row + nw);
        __builtin_amdgcn_sched_barrier(0);
        QD_WORK(bb, row);
        __builtin_amdgcn_sched_barrier(0);
        row += nw; if (row >= r_hi) break;
        QD_STORE();
        QD_LOAD(bb, row + nw);
        __builtin_amdgcn_sched_barrier(0);
        QD_WORK(ba, row);
        __builtin_amdgcn_sched_barrier(0);
        row += nw;
    }
    QD_STORE();
#undef QD_LOAD
#undef QD_STORE
#undef QD_WORK
}
typedef float f32x2q __attribute__((ext_vector_type(2)));
__device__ __forceinline__ void quant_fp6u(const Ptrs& P, int lane_, int q_lo, int q_hi, int w, int nw) {
    float* SC = (float*)(P.ws + WS_SMALL);
    int e = 2 * q_lo + w; const int e_hi = 2 * q_hi;
    if (e >= e_hi) return;
    float4 ba[4], bb[4];
#define QU_LOAD(B_, E_) do { const int el_ = ((E_) < e_hi) ? (E_) : (2 * q_lo + w); _Pragma("unroll") for (int k = 0; k < 4; ++k) B_[k] = ldnt4(P.e_up + (size_t)el_ * DM + 4 * (64 * k + lane_)); } while (0)
#define QU_STORE() do { _Pragma("unroll") for (int k = 0; k < 4; ++k) *(unsigned short*)(P.ws + WS_EU + (size_t)pe * 512 + 128 * k + 2 * lane_) = (unsigned short)(po >> (16 * k)); if (lane_ == 0) SC[2 * pe + 1] = psc; } while (0)
#define QU_WORK(B_, E_) do { float v[16]; \
        _Pragma("unroll") for (int k = 0; k < 4; ++k) { const float4 t = B_[k]; v[4 * k] = t.x; v[4 * k + 1] = t.y; v[4 * k + 2] = t.z; v[4 * k + 3] = t.w; } \
        float am = 0.f; _Pragma("unroll") for (int k = 0; k < 16; ++k) am = fmaxf(am, fabsf(v[k])); \
        am = fmaxf(am, swz_xor<1>(am)); am = fmaxf(am, swz_xor<2>(am)); am = fmaxf(am, swz_xor<4>(am)); am = fmaxf(am, swz_xor<8>(am)); am = fmaxf(am, swz_xor<16>(am)); am = max_halves(am); \
        am = fmaxf(am, 1e-30f); const float inv = 6.0f / am; unsigned pk[2]; \
        _Pragma("unroll") for (int wd = 0; wd < 2; ++wd) { unsigned p4 = 0u; \
            p4 = __builtin_amdgcn_cvt_scalef32_pk_fp4_f32(p4, v[8 * wd] * inv, v[8 * wd + 1] * inv, 1.0f, 0); \
            p4 = __builtin_amdgcn_cvt_scalef32_pk_fp4_f32(p4, v[8 * wd + 2] * inv, v[8 * wd + 3] * inv, 1.0f, 1); \
            p4 = __builtin_amdgcn_cvt_scalef32_pk_fp4_f32(p4, v[8 * wd + 4] * inv, v[8 * wd + 5] * inv, 1.0f, 2); \
            p4 = __builtin_amdgcn_cvt_scalef32_pk_fp4_f32(p4, v[8 * wd + 6] * inv, v[8 * wd + 7] * inv, 1.0f, 3); \
            pk[wd] = p4; } \
        po = (unsigned long long)pk[0] | ((unsigned long long)pk[1] << 32); psc = am * (1.f / 6.0f); pe = (E_); } while (0)
    unsigned long long po; float psc; int pe;
    QU_LOAD(ba, e);
    QU_LOAD(bb, e + nw);
    __builtin_amdgcn_sched_barrier(0);
    QU_WORK(ba, e);
    __builtin_amdgcn_sched_barrier(0);
    e += nw;
    while (e < e_hi) {
        QU_STORE();
        QU_LOAD(ba, e + nw);
        __builtin_amdgcn_sched_barrier(0);
        QU_WORK(bb, e);
        __builtin_amdgcn_sched_barrier(0);
        e += nw; if (e >= e_hi) break;
        QU_STORE();
        QU_LOAD(bb, e + nw);
        __builtin_amdgcn_sched_barrier(0);
        QU_WORK(ba, e);
        __builtin_amdgcn_sched_barrier(0);
        e += nw;
    }
    QU_STORE();
#undef QU_LOAD
#undef QU_STORE
#undef QU_WORK
}
__device__ __forceinline__ void p0_prologue(Frame& F0, const Ptrs& P) {
    const Frame& F = F0; const int lane_ = lane_id(), tid_ = F.wave * 64 + lane_;
    LAS float* scr = (LAS float*)(F.lds + RING_OFF + F.wave * 16384);
    const int gw = F.vcu * NWAVES + F.wave, NGW = F.G * NWAVES;
    bf16* Win_t = (bf16*)(P.ws + WS_WIN); bf16* Wout_t = (bf16*)(P.ws + WS_WOUT); bf16* Wq_t = (bf16*)(P.ws + WS_WQ);
    constexpr int I_IN = 16 * 72;
    for (int it = gw; it < I_IN; it += NGW) p0_transpose_item(P.w_in, INC, DM, 72, Win_t, nullptr, scr, it, lane_);
    (void)Wout_t; (void)Wq_t;
    __syncthreads();
    { LAS float* Wdt = (LAS float*)(F.lds + RING_OFF);
      { float wd_[16];
#pragma unroll
        for (int q = 0; q < 16; ++q) { const int i = tid_ + 512 * q; wd_[q] = P.w_in[(size_t)(i >> 3) * INC + NPROJ + (i & 7)]; }
#pragma unroll
        for (int q = 0; q < 16; ++q) Wdt[tid_ + 512 * q] = wd_[q]; }
      __syncthreads();
      bf16* XN = (bf16*)(P.ws + WS_XN); float* DT = (float*)(P.ws + WS_DT);
      float4 nmw[4];
#pragma unroll
      for (int j = 0; j < 4; ++j) nmw[j] = ((const float4*)P.norm_mix)[j * 64 + lane_];
      float4 xnx[2][4];
      if (gw * 2 < T_) {
#pragma unroll
        for (int rr = 0; rr < 2; ++rr)
#pragma unroll
            for (int j = 0; j < 4; ++j) xnx[rr][j] = ldnt4(P.x + (size_t)(gw * 2 + rr) * DM + 4 * (j * 64 + lane_)); }
      for (int m0 = gw * 2; m0 < T_; m0 += NGW * 2) {
        float4 xv[2][4];
#pragma unroll
        for (int rr = 0; rr < 2; ++rr)
#pragma unroll
            for (int j = 0; j < 4; ++j) xv[rr][j] = xnx[rr][j];
        { const int mn = (m0 + NGW * 2 < T_) ? m0 + NGW * 2 : m0;
#pragma unroll
          for (int rr = 0; rr < 2; ++rr)
#pragma unroll
              for (int j = 0; j < 4; ++j) xnx[rr][j] = ldnt4(P.x + (size_t)(mn + rr) * DM + 4 * (j * 64 + lane_)); }
#pragma unroll
        for (int rr = 0; rr < 2; ++rr) { const int m = m0 + rr;
        float4 v[4]; float s = 0.f;
#pragma unroll
        for (int j = 0; j < 4; ++j) { v[j] = xv[rr][j]; s += v[j].x * v[j].x + v[j].y * v[j].y + v[j].z * v[j].z + v[j].w * v[j].w; }
        const float r = rsqrtf(wave_sum(s) * (1.f / 1024.f) + EPS);
        ((float*)(P.ws + WS_RINV))[m] = 1.f / r;
        float d8[8];
#pragma unroll
        for (int q = 0; q < 8; ++q) d8[q] = 0.f;
        unsigned long long* o8 = (unsigned long long*)(XN + (size_t)m * DM);
#pragma unroll
        for (int j = 0; j < 4; ++j) { const float4 w = nmw[j];
            const float e0 = v[j].x * r * w.x, e1 = v[j].y * r * w.y, e2 = v[j].z * r * w.z, e3 = v[j].w * r * w.w;
            o8[j * 64 + lane_] = (unsigned long long)pk2(e0, e1) | ((unsigned long long)pk2(e2, e3) << 32);
            const float ev[4] = {e0, e1, e2, e3};
#pragma unroll
            for (int e = 0; e < 4; ++e) { const LAS f32x4* wr = (const LAS f32x4*)(Wdt + (size_t)(j * 256 + lane_ * 4 + e) * 8); const f32x4 w0 = wr[0], w1 = wr[1];
                d8[0] += ev[e] * w0.x; d8[1] += ev[e] * w0.y; d8[2] += ev[e] * w0.z; d8[3] += ev[e] * w0.w; d8[4] += ev[e] * w1.x; d8[5] += ev[e] * w1.y; d8[6] += ev[e] * w1.z; d8[7] += ev[e] * w1.w; } }
#pragma unroll
        for (int q = 0; q < 8; ++q) d8[q] = wave_sum(d8[q]);
        { float4* dp = (float4*)(DT + (size_t)m * 8) + (lane_ & 1); const float4 dv = (lane_ & 1) ? make_float4(d8[4], d8[5], d8[6], d8[7]) : make_float4(d8[0], d8[1], d8[2], d8[3]); *dp = dv; }
        }
      }
      __syncthreads(); }
}

__device__ __forceinline__ void p1_slack(Frame& F0, const Ptrs& P, int w, int nw) {
    const Frame& F = F0; const int lane_ = lane_id();
    LAS float* scr = (LAS float*)(F.lds + RING_OFF + F.wave * 16384);
    bf16* Wout_t = (bf16*)(P.ws + WS_WOUT); bf16* Wq_t = (bf16*)(P.ws + WS_WQ);
    constexpr int I_OUT = 16 * 32, I_Q = 16 * 64;
    for (int it = w; it < I_OUT + I_Q; it += nw) {
        if (it < I_OUT) p0_transpose_item(P.w_out, DM, DM, 32, Wout_t, nullptr, scr, it, lane_);
        else p0_transpose_item(P.w_query, 2048, DM, 64, Wq_t, P.norm_ffn, scr, it - I_OUT, lane_);
    }
    { unsigned long long* KB = (unsigned long long*)(P.ws + WS_KEYB);
      for (int i = w * 64 + lane_; i < 8192; i += nw * 64) { const float4 t = (i < 4096) ? ldnt4(P.sk1 + 4 * i) : ldnt4(P.sk2 + 4 * (i - 4096));
          KB[i] = (unsigned long long)pk2(t.x, t.y) | ((unsigned long long)pk2(t.z, t.w) << 32); } }
    { float* BT = (float*)(P.ws + WS_BTAB);
      for (int i = w * 64 + lane_; i < 1536; i += nw * 64) { const int hkv = i / 768, rr = i % 768, gg = rr / 192, dist = rr % 192 - 32;
          BT[i] = (dist >= 0 && dist < 128) ? P.rel_bias[c_bucket[dist & 127] * 8 + hkv * 4 + gg] * 1.4426950408889634f : 0.f; } }
    quant_fp6u(P, lane_, 0, 8192, w, nw);
    quant_fp8s(P, lane_, 0, 16384, w, nw);
}
struct EpiResH {
    static constexpr bool PERM = true, AFTER_DRAIN = false;
    const bf16* XNp; const float* RINV; const float* NMW; bf16* HB; float* SSQ;
    __device__ __forceinline__ void ldx(v4u (&d)[2], float& ri, int row, int col0) const {
        ri = RINV[row];
#pragma unroll
        for (int bj = 0; bj < 2; ++bj) d[bj] = *(const v4u*)(XNp + (size_t)row * DM + col0 + bj * 128);
    }
    __device__ __forceinline__ void operator()(const pg8::f32x4 (&acc)[2][2][4][2], const pg8::Unit& u, int wr, int wc, int fr, int fq) const {
        const int row0 = u.pm * 256 + wr * 64 + fr, col0 = u.pn * 256 + wc * 32 + 8 * fq;
        v4u xq[2][2]; float rq[2];
        ldx(xq[0], rq[0], row0, col0);
        pg8::f32x4 wi[4];
#pragma unroll
        for (int bj = 0; bj < 2; ++bj)
#pragma unroll
            for (int n = 0; n < 2; ++n) { const pg8::f32x4 w = *(const pg8::f32x4*)(NMW + col0 + bj * 128 + 4 * n);
                wi[bj * 2 + n] = (pg8::f32x4){__builtin_amdgcn_rcpf(w[0]), __builtin_amdgcn_rcpf(w[1]), __builtin_amdgcn_rcpf(w[2]), __builtin_amdgcn_rcpf(w[3])}; }
#pragma unroll
        for (int g = 0; g < 8; ++g) { const int ai = g >> 2, m = g & 3, row = row0 + ai * 128 + m * 16;
            if (g + 1 < 8) ldx(xq[(g + 1) & 1], rq[(g + 1) & 1], row0 + ((g + 1) >> 2) * 128 + ((g + 1) & 3) * 16, col0);
            float ss = 0.f; const float ri = rq[g & 1];
#pragma unroll
            for (int bj = 0; bj < 2; ++bj) { const v4u xb = xq[g & 1][bj];
                const pg8::f32x4 x0 = {bflo(xb.x), bfhi(xb.x), bflo(xb.y), bfhi(xb.y)}, x1 = {bflo(xb.z), bfhi(xb.z), bflo(xb.w), bfhi(xb.w)};
                const pg8::f32x4 h0 = acc[ai][bj][m][0] + x0 * (wi[bj * 2] * ri), h1 = acc[ai][bj][m][1] + x1 * (wi[bj * 2 + 1] * ri);
                ss += h0[0] * h0[0] + h0[1] * h0[1] + h0[2] * h0[2] + h0[3] * h0[3] + h1[0] * h1[0] + h1[1] * h1[1] + h1[2] * h1[2] + h1[3] * h1[3];
                *(v4u*)(HB + (size_t)row * DM + col0 + bj * 128) = (v4u){pk2(h0[0], h0[1]), pk2(h0[2], h0[3]), pk2(h1[0], h1[1]), pk2(h1[2], h1[3])}; }
            ss += swz_xor<16>(ss); ss = sum_halves(ss);
            if (fq == 0) SSQ[(size_t)row * 16 + u.pn * 4 + wc] = ss; }
    }
};


typedef float f32x16 __attribute__((ext_vector_type(16)));
typedef short s16x4 __attribute__((ext_vector_type(4)));
typedef float f32x2_t __attribute__((ext_vector_type(2)));
typedef __bf16 bf16x2_t __attribute__((ext_vector_type(2)));
#define MFMA32(a, b, c) __builtin_amdgcn_mfma_f32_32x32x16_bf16((a), (b), (c), 0, 0, 0)
__device__ __forceinline__ int crow(int reg, int h) { return (reg & 3) + 8 * (reg >> 2) + 4 * h; }
__device__ __forceinline__ unsigned cvtpk(float lo, float hi) { f32x2_t v = {lo, hi}; bf16x2_t b = __builtin_convertvector(v, bf16x2_t); return __builtin_bit_cast(unsigned, b); }
__device__ __forceinline__ bf16x8 pack8(const f32x16& x, int s) {
    v4u p; p.x = cvtpk(x[8 * s], x[8 * s + 1]); p.y = cvtpk(x[8 * s + 2], x[8 * s + 3]); p.z = cvtpk(x[8 * s + 4], x[8 * s + 5]); p.w = cvtpk(x[8 * s + 6], x[8 * s + 7]);
    return __builtin_bit_cast(bf16x8, p);
}
constexpr float LOG2E = 1.4426950408889634f;
constexpr int LDP = 136;
constexpr int S1_XT = 0, S1_XTW = 17408, S1_BSN = 34816, S1_CLN = 69632, S1_BNL = 104448, S1_F32 = 139264, S1_G = 34816, S1_X2 = 55296, S1_X3 = 72704;

__device__ __forceinline__ float silu_fast(float x) { return x * __builtin_amdgcn_rcpf(1.f + __builtin_amdgcn_exp2f(-x * LOG2E)); }
__device__ __forceinline__ int swz_t(int row, int l) { return row * LDP + ((((l >> 3) ^ (row >> 3)) & 7) | ((l >> 3) & 8)) * 8 + (l & 7); }
#define S1_CONV8(A_, IT_) do { _Pragma("unroll") for (int e_ = 0; e_ < 8; ++e_) A_[e_] = bias[e_]; \
        _Pragma("unroll") for (int j_ = 0; j_ < 4; ++j_) { const v4u rw_ = raw[(IT_) + j_]; \
            A_[0] += w[j_][0] * bflo(rw_.x); A_[1] += w[j_][1] * bfhi(rw_.x); A_[2] += w[j_][2] * bflo(rw_.y); A_[3] += w[j_][3] * bfhi(rw_.y); \
            A_[4] += w[j_][4] * bflo(rw_.z); A_[5] += w[j_][5] * bfhi(rw_.z); A_[6] += w[j_][6] * bflo(rw_.w); A_[7] += w[j_][7] * bfhi(rw_.w); } \
        _Pragma("unroll") for (int e_ = 0; e_ < 8; ++e_) A_[e_] = silu_fast(A_[e_]); } while (0)
#define S1_LOADW(CHB_) do { _Pragma("unroll") for (int j_ = 0; j_ < 4; ++j_) { const float4 w0_ = *(const float4*)(P.conv_w + j_ * 1024 + (CHB_)), w1_ = *(const float4*)(P.conv_w + j_ * 1024 + (CHB_) + 4); \
            w[j_][0] = w0_.x; w[j_][1] = w0_.y; w[j_][2] = w0_.z; w[j_][3] = w0_.w; w[j_][4] = w1_.x; w[j_][5] = w1_.y; w[j_][6] = w1_.z; w[j_][7] = w1_.w; } \
        { const float4 b0_ = *(const float4*)(P.conv_b + (CHB_)), b1_ = *(const float4*)(P.conv_b + (CHB_) + 4); \
          bias[0] = b0_.x; bias[1] = b0_.y; bias[2] = b0_.z; bias[3] = b0_.w; bias[4] = b1_.x; bias[5] = b1_.y; bias[6] = b1_.z; bias[7] = b1_.w; } } while (0)
__device__ __forceinline__ void ssd_s1(Frame& F, const Ptrs& P) {
    const bf16* PROJ = (const bf16*)(P.ws + WS_PROJ); const float* DT = (const float*)(P.ws + WS_DT);
    float* EA = (float*)(P.ws + WS_EA); float* CDEC = (float*)(P.ws + WS_CDEC); bf16* CC = (bf16*)(P.ws + WS_CC);
    unsigned* ST = (unsigned*)(P.ws + WS_ST); unsigned* YPF = (unsigned*)((char*)P.out + DO_YPF);
    LAS unsigned char* L = F.lds + RING_OFF;
    LAS bf16* Xt = (LAS bf16*)(L + S1_XT); LAS bf16* Xtw = (LAS bf16*)(L + S1_XTW); LAS bf16* Bsn = (LAS bf16*)(L + S1_BSN); LAS bf16* Cln = (LAS bf16*)(L + S1_CLN); LAS bf16* Bnl = (LAS bf16*)(L + S1_BNL);
    LAS float* f32base = (LAS float*)(L + S1_F32);
    const int lane = lane_id(); const int tid_ = F.wave * 64 + lane;
    for (int ug = F.vcu; ug < 256; ug += F.G) {
        const int grp = ug & 1, c = (ug >> 1) & 31, b = ug >> 6, t0 = b * SEQ + c * 128;
        __syncthreads();
        if (F.wave < 4) {
            const int h = 4 * grp + F.wave, us = (b * 32 + c) * 8 + h;
            const float A = -__expf(P.a_log[h]), dtb = P.dt_bias[h];
            const int ln = opq(lane_id());
            LAS float* acum2 = f32base + F.wave * 384; LAS float* wv = acum2 + 128; LAS float* wend = wv + 128;
            const float x0 = DT[(size_t)(t0 + 2 * ln) * 8 + h] + dtb, x1 = DT[(size_t)(t0 + 2 * ln + 1) * 8 + h] + dtb;
            const float dt0 = fmaxf(x0, 0.f) + log1pf(__expf(-fabsf(x0))), dt1 = fmaxf(x1, 0.f) + log1pf(__expf(-fabsf(x1)));
            const float a0 = dt0 * A, a1 = dt1 * A;
            float s = a0 + a1;
#pragma unroll
            for (int o = 1; o < 64; o <<= 1) { const float v = __int_as_float(__builtin_amdgcn_ds_bpermute((ln - o) * 4, __float_as_int(s))); if (ln >= o) s += v; }
            const float ac1 = s, ac0 = s - a1, tot = __uint_as_float(__builtin_amdgcn_readlane(__float_as_uint(s), 63));
            acum2[2 * ln] = ac0 * LOG2E; acum2[2 * ln + 1] = ac1 * LOG2E;
            wv[2 * ln] = log2f(dt0) - ac0 * LOG2E; wv[2 * ln + 1] = log2f(dt1) - ac1 * LOG2E;
            wend[2 * ln] = dt0 * exp2f((tot - ac0) * LOG2E); wend[2 * ln + 1] = dt1 * exp2f((tot - ac1) * LOG2E);
            EA[(size_t)(t0 + 2 * ln) * 8 + h] = exp2f(ac0 * LOG2E); EA[(size_t)(t0 + 2 * ln + 1) * 8 + h] = exp2f(ac1 * LOG2E);
            if (ln == 0) CDEC[us] = exp2f(tot * LOG2E);
        }
        { const int tidc = opq(tid_);
          if (tidc < 440) {
            const int cg = tidc % 40, sg = tidc / 40, l0 = 12 * sg, h0 = 4 * grp;
            int chb; if (cg < 8) chb = h0 * 64 + cg * 8; else if (cg < 24) chb = 512 + grp * 128 + (cg - 8) * 8; else chb = 768 + grp * 128 + (cg - 24) * 8;
            v4u raw[15];
#pragma unroll
            for (int q = 0; q < 15; ++q) { const int ss = c * 128 + l0 - 3 + q; raw[q] = (v4u){0u, 0u, 0u, 0u};
                if (ss >= 0 && l0 - 3 + q < 128) raw[q] = *(const v4u*)(PROJ + (size_t)(b * SEQ + ss) * NPROJ + PJ_XBC + chb); }
            float w[4][8], bias[8]; S1_LOADW(chb);
#pragma unroll
            for (int it = 0; it < 12; it += 2) {
                const int l = l0 + it;
                if (l < 128) {
                    float a[8], a2[8]; S1_CONV8(a, it); S1_CONV8(a2, it + 1);
                    if (cg < 8) {
#pragma unroll
                        for (int e = 0; e < 8; ++e) *(LAS unsigned*)(Xt + swz_t(cg * 8 + e, l)) = cvtpk(a[e], a2[e]);
                    } else {
                        v4u o, o2; o.x = cvtpk(a[0], a[1]); o.y = cvtpk(a[2], a[3]); o.z = cvtpk(a[4], a[5]); o.w = cvtpk(a[6], a[7]);
                        o2.x = cvtpk(a2[0], a2[1]); o2.y = cvtpk(a2[2], a2[3]); o2.z = cvtpk(a2[4], a2[5]); o2.w = cvtpk(a2[6], a2[7]);
                        if (cg < 24) { const int n0 = (cg - 8) * 8; *(LAS v4u*)(Bsn + l * LDP + n0) = o; *(LAS v4u*)(Bsn + (l + 1) * LDP + n0) = o2;
#pragma unroll
                            for (int e = 0; e < 8; ++e) *(LAS unsigned*)(Bnl + swz_t(n0 + e, l)) = cvtpk(a[e], a2[e]);
                        } else { const int n0 = (cg - 24) * 8; *(LAS v4u*)(Cln + l * LDP + n0) = o; *(LAS v4u*)(Cln + (l + 1) * LDP + n0) = o2;
                            *(v4u*)(CC + (size_t)(t0 + l) * 256 + grp * 128 + n0) = o; *(v4u*)(CC + (size_t)(t0 + l + 1) * 256 + grp * 128 + n0) = o2; }
                    }
                }
            }
          } }
        __syncthreads();
        { const int lg = opq(lane), rg = lg & 31, hg = lg >> 5;
          const int tidc = opq(tid_), cgn = tidc & 7, ln_ = 2 * (tidc >> 3);
          v4u rawh[3][5];
#pragma unroll
          for (int hd = 0; hd < 3; ++hd)
#pragma unroll
              for (int q = 0; q < 5; ++q) { const int ss = c * 128 + ln_ - 3 + q; rawh[hd][q] = (v4u){0u, 0u, 0u, 0u};
                  if (ss >= 0) rawh[hd][q] = *(const v4u*)(PROJ + (size_t)(b * SEQ + ss) * NPROJ + PJ_XBC + (4 * grp + 1 + hd) * 64 + cgn * 8); }
          f32x16 gt[2];
#pragma unroll
          for (int k2 = 0; k2 < 2; ++k2) {
              const int ti = F.wave + 8 * k2;
#pragma unroll
              for (int i = 0; i < 16; ++i) gt[k2][i] = 0.f;
              if (ti < 10) {
                  const int lt = (ti >= 6) ? 3 : (ti >= 3) ? 2 : (ti >= 1) ? 1 : 0, st = ti - lt * (lt + 1) / 2;
                  bf16x8 bfr[8], cfr[8];
#pragma unroll
                  for (int kk = 0; kk < 8; ++kk) { bfr[kk] = *(const LAS bf16x8*)(Bsn + (32 * st + rg) * LDP + 16 * kk + 8 * hg); cfr[kk] = *(const LAS bf16x8*)(Cln + (32 * lt + rg) * LDP + 16 * kk + 8 * hg); }
                  __builtin_amdgcn_sched_barrier(0);
#pragma unroll
                  for (int kk = 0; kk < 8; ++kk) gt[k2] = MFMA32(bfr[kk], cfr[kk], gt[k2]);
              } }
          __syncthreads();
          LAS v4u* GT = (LAS v4u*)(L + S1_G);
#pragma unroll
          for (int k2 = 0; k2 < 2; ++k2) { const int ti = F.wave + 8 * k2;
              if (ti < 10) {
#pragma unroll
                  for (int g8 = 0; g8 < 2; ++g8) GT[(ti * 2 + g8) * 64 + lg] = (v4u){cvtpk(gt[k2][8 * g8], gt[k2][8 * g8 + 1]), cvtpk(gt[k2][8 * g8 + 2], gt[k2][8 * g8 + 3]), cvtpk(gt[k2][8 * g8 + 4], gt[k2][8 * g8 + 5]), cvtpk(gt[k2][8 * g8 + 6], gt[k2][8 * g8 + 7])}; } }
#pragma unroll
          for (int hd = 0; hd < 3; ++hd) {
              const int chn = (4 * grp + 1 + hd) * 64 + cgn * 8;
              LAS bf16* Xn = (LAS bf16*)(L + (hd == 0 ? S1_XTW : (hd == 1 ? S1_X2 : S1_X3)));
              const v4u (&raw)[5] = rawh[hd];
              float w[4][8], bias[8]; S1_LOADW(chn);
              float a[8], a2[8]; S1_CONV8(a, 0); S1_CONV8(a2, 1);
#pragma unroll
              for (int e = 0; e < 8; ++e) *(LAS unsigned*)(Xn + swz_t(cgn * 8 + e, ln_)) = cvtpk(a[e], a2[e]);
          } }
        __syncthreads();
        { const int hi = F.wave >> 1, wa = F.wave & 1;
          const int h = 4 * grp + hi, u = (b * 32 + c) * 8 + h;
          const float Dh = P.d_skip[h];
          const LAS float* acum2 = f32base + hi * 384; const LAS float* wv = acum2 + 128; const LAS float* wend = wv + 128;
          const LAS bf16* Xc = (const LAS bf16*)(L + (hi == 0 ? S1_XT : (hi == 1 ? S1_XTW : (hi == 2 ? S1_X2 : S1_X3))));
          const int ln3 = opq(lane), r = ln3 & 31, hh = ln3 >> 5;
#pragma unroll 1
          for (int q = 0; q < 4; ++q) {
              const int lt = 3 - q, pt = (q & 1) ^ wa;
              f32x16 yacc;
#pragma unroll
              for (int i = 0; i < 16; ++i) yacc[i] = 0.f;
              const float al = acum2[32 * lt + r];
#pragma unroll 1
              for (int st = 0; st <= lt; ++st) {
                  v4u gq[2];
#pragma unroll
                  for (int g8 = 0; g8 < 2; ++g8) gq[g8] = ((const LAS v4u*)(L + S1_G))[((lt * (lt + 1) / 2 + st) * 2 + g8) * 64 + ln3];
                  f32x4 wq[4];
#pragma unroll
                  for (int g4 = 0; g4 < 4; ++g4) wq[g4] = *(const LAS f32x4*)(wv + 32 * st + 8 * g4 + 4 * hh);
                  s16x4 xlo[2], xhi[2];
#pragma unroll
                  for (int sg = 0; sg < 2; ++sg) { const int prow = 32 * pt + r, lb = 32 * st + 16 * sg;
                      xlo[sg] = *(const LAS s16x4*)(Xc + swz_t(prow, lb) + 4 * hh); xhi[sg] = *(const LAS s16x4*)(Xc + swz_t(prow, lb + 8) + 4 * hh); }
                  __builtin_amdgcn_sched_barrier(0);
                  const unsigned gw[8] = {gq[0].x, gq[0].y, gq[0].z, gq[0].w, gq[1].x, gq[1].y, gq[1].z, gq[1].w};
                  f32x16 macc;
#pragma unroll
                  for (int i = 0; i < 16; ++i) { const int sl = crow(i, hh);
                      float f = __builtin_amdgcn_exp2f(al + wq[i >> 2][i & 3]);
                      if (st == lt && sl > r) f = 0.f;
                      macc[i] = ((i & 1) ? bfhi(gw[i >> 1]) : bflo(gw[i >> 1])) * f; }
#pragma unroll
                  for (int sg = 0; sg < 2; ++sg) {
                      const bf16x8 bfrag = pack8(macc, sg);
                      const bf16x8 afrag = __builtin_shufflevector(xlo[sg], xhi[sg], 0, 1, 2, 3, 4, 5, 6, 7);
                      yacc = MFMA32(afrag, bfrag, yacc);
                  }
              }
              unsigned short xs16[16];
#pragma unroll
              for (int i = 0; i < 16; ++i) xs16[i] = *(const LAS unsigned short*)(Xc + swz_t(32 * pt + crow(i, hh), 32 * lt + r));
              __builtin_amdgcn_sched_barrier(0);
#pragma unroll
              for (int i = 0; i < 16; i += 2) {
                  const float y0 = yacc[i] + Dh * __uint_as_float((unsigned)xs16[i] << 16), y1 = yacc[i + 1] + Dh * __uint_as_float((unsigned)xs16[i + 1] << 16);
                  YPF[((((size_t)u * 4 + lt) * 2 + pt) * 8 + (i >> 1)) * 64 + ln3] = cvtpk(y0, y1); }
          }
#pragma unroll 1
          for (int n2 = 0; n2 < 2; ++n2) {
              const int nt = 2 * wa + n2;
              bf16x8 bb[8];
              { v4u braw[8]; f32x4 we[8][2];
#pragma unroll
                for (int kk = 0; kk < 8; ++kk) { braw[kk] = *(const LAS v4u*)(Bnl + swz_t(32 * nt + r, 16 * kk + 8 * hh));
                    we[kk][0] = *(const LAS f32x4*)(wend + 16 * kk + 8 * hh); we[kk][1] = *(const LAS f32x4*)(wend + 16 * kk + 8 * hh + 4); }
#pragma unroll
                for (int kk = 0; kk < 8; ++kk) { v4u o;
                    o.x = cvtpk(bflo(braw[kk].x) * we[kk][0][0], bfhi(braw[kk].x) * we[kk][0][1]); o.y = cvtpk(bflo(braw[kk].y) * we[kk][0][2], bfhi(braw[kk].y) * we[kk][0][3]);
                    o.z = cvtpk(bflo(braw[kk].z) * we[kk][1][0], bfhi(braw[kk].z) * we[kk][1][1]); o.w = cvtpk(bflo(braw[kk].w) * we[kk][1][2], bfhi(braw[kk].w) * we[kk][1][3]);
                    bb[kk] = __builtin_bit_cast(bf16x8, o); } }
#pragma unroll 1
              for (int pt = 0; pt < 2; ++pt) {
                  bf16x8 xa[8];
#pragma unroll
                  for (int kk = 0; kk < 8; ++kk) xa[kk] = *(const LAS bf16x8*)(Xc + swz_t(32 * pt + r, 16 * kk + 8 * hh));
                  __builtin_amdgcn_sched_barrier(0);
                  f32x16 sacc;
#pragma unroll
                  for (int i = 0; i < 16; ++i) sacc[i] = 0.f;
#pragma unroll
                  for (int kk = 0; kk < 8; ++kk) sacc = MFMA32(xa[kk], bb[kk], sacc);
#pragma unroll
                  for (int i = 0; i < 16; i += 2) ST[((size_t)u * 32 + 16 * pt + (crow(i, hh) >> 1)) * 128 + 32 * nt + r] = cvtpk(sacc[i], sacc[i + 1]);
              }
          } }
    }
}
__device__ __forceinline__ void ssd_s2(Frame& F, const Ptrs& P) {
    const unsigned* ST = (const unsigned*)(P.ws + WS_ST); const float* CDEC = (const float*)(P.ws + WS_CDEC); unsigned* PREV = (unsigned*)(P.ws + WS_PREV);
    const int n2 = lane_id(), rs = F.wave & 1, p2l = F.wave >> 1, sh = 16 * rs;
    for (int v = F.vcu; v < 256; v += F.G) {
        const int p2 = 4 * (v & 7) + p2l, h = (v >> 3) & 7, b = v >> 6;
        uint2 st[32];
#pragma unroll
        for (int c = 0; c < 32; ++c) st[c] = *(const uint2*)(ST + ((size_t)(((b * 32 + c) * 8 + h) * 32 + p2)) * 128 + 2 * n2);
        float r0 = 0.f, r1 = 0.f;
#pragma unroll
        for (int c = 0; c < 32; ++c) { const size_t u = (size_t)((b * 32 + c) * 8 + h);
            PREV[((u * 64 + 2 * p2 + rs) * 128 + 2 * n2) >> 1] = cvtpk(r0, r1);
            const float d = CDEC[u];
            r0 = r0 * d + __uint_as_float((st[c].x >> sh) << 16); r1 = r1 * d + __uint_as_float((st[c].y >> sh) << 16); }
    }
}
__device__ __forceinline__ void ssd_s3(Frame& F, const Ptrs& P) {
    const bf16* CC = (const bf16*)(P.ws + WS_CC); const bf16* PREV = (const bf16*)(P.ws + WS_PREV); const float* EA = (const float*)(P.ws + WS_EA);
    const unsigned* YPF = (const unsigned*)((const char*)P.out + DO_YPF); const bf16* PROJ = (const bf16*)(P.ws + WS_PROJ); bf16* CAT = (bf16*)((char*)P.out + DO_CAT);
    LAS float* red = (LAS float*)(F.lds + RING_OFF + 139264);
    LAS bf16* Pw = (LAS bf16*)(F.lds + RING_OFF + F.wave * 17408);
    const int lane = lane_id(), r = lane & 31, hh = lane >> 5, h = F.wave, grp = h >> 2;
    for (int v2 = F.vcu; v2 < 256; v2 += F.G) {
        const int lp = v2 & 1, c = (v2 >> 1) & 31, b = v2 >> 6;
        const size_t u = (size_t)((b * 32 + c) * 8 + h);
        bf16x8 af[2][8];
        { v4u pq[16];
#pragma unroll
          for (int q = 0; q < 16; ++q) pq[q] = *(const v4u*)(PREV + u * 8192 + q * 512 + lane * 8);
#pragma unroll
          for (int q = 0; q < 16; ++q) *(LAS v4u*)(Pw + (4 * q + (lane >> 4)) * LDP + (lane & 15) * 8) = pq[q];
          LDS_WAIT();
#pragma unroll
          for (int pt = 0; pt < 2; ++pt)
#pragma unroll
              for (int kk = 0; kk < 8; ++kk) af[pt][kk] = *(const LAS bf16x8*)(Pw + (32 * pt + r) * LDP + 16 * kk + 8 * hh);
          LDS_WAIT(); }
#pragma unroll 1
        for (int li = 0; li < 2; ++li) {
            const int lt = 2 * lp + li;
            const int t = b * SEQ + c * 128 + lt * 32 + r;
            unsigned ypf[2][8]; unsigned long long zz[2][4];
            const int t0_ = b * SEQ + c * 128 + lt * 32;
            v4u zq[4], cq[8];
#pragma unroll
            for (int q = 0; q < 4; ++q) zq[q] = *(const v4u*)(PROJ + (size_t)(t0_ + 8 * q + (lane >> 3)) * NPROJ + PJ_Z + h * 64 + (lane & 7) * 8);
#pragma unroll
            for (int q = 0; q < 8; ++q) cq[q] = *(const v4u*)(CC + (size_t)(t0_ + 4 * q + (lane >> 4)) * 256 + grp * 128 + (lane & 15) * 8);
#pragma unroll
            for (int pt = 0; pt < 2; ++pt)
#pragma unroll
                for (int i = 0; i < 8; ++i) ypf[pt][i] = YPF[((((size_t)u * 4 + lt) * 2 + pt) * 8 + i) * 64 + lane];
            const float ea = EA[(size_t)t * 8 + h];
            LAS bf16* Zw = Pw; LAS bf16* Cw = Pw + 32 * LDP;
#pragma unroll
            for (int q = 0; q < 4; ++q) *(LAS v4u*)(Zw + (8 * q + (lane >> 3)) * LDP + (lane & 7) * 8) = zq[q];
#pragma unroll
            for (int q = 0; q < 8; ++q) *(LAS v4u*)(Cw + (4 * q + (lane >> 4)) * LDP + (lane & 15) * 8) = cq[q];
            LDS_WAIT();
            bf16x8 bb[8];
#pragma unroll
            for (int kk = 0; kk < 8; ++kk) bb[kk] = *(const LAS bf16x8*)(Cw + r * LDP + 16 * kk + 8 * hh);
#pragma unroll
            for (int pt = 0; pt < 2; ++pt)
#pragma unroll
                for (int g4 = 0; g4 < 4; ++g4) zz[pt][g4] = *(const LAS unsigned long long*)(Zw + r * LDP + 32 * pt + 8 * g4 + 4 * hh);
            LDS_WAIT();
            f32x16 acc[2];
#pragma unroll
            for (int i = 0; i < 16; ++i) { acc[0][i] = 0.f; acc[1][i] = 0.f; }
#pragma unroll
            for (int kk = 0; kk < 8; ++kk) { acc[0] = MFMA32(af[0][kk], bb[kk], acc[0]); acc[1] = MFMA32(af[1][kk], bb[kk], acc[1]); }
            float ss = 0.f;
#pragma unroll
            for (int pt = 0; pt < 2; ++pt)
#pragma unroll
                for (int g4 = 0; g4 < 4; ++g4) {
                    const unsigned z01 = (unsigned)zz[pt][g4], z23 = (unsigned)(zz[pt][g4] >> 32);
                    const float zf[4] = {bflo(z01), bfhi(z01), bflo(z23), bfhi(z23)};
#pragma unroll
                    for (int e = 0; e < 4; ++e) { const int i = 4 * g4 + e;
                        const float y = acc[pt][i] * ea + ((i & 1) ? bfhi(ypf[pt][i >> 1]) : bflo(ypf[pt][i >> 1]));
                        const float yg = y * silu_fast(zf[e]); acc[pt][i] = yg; ss = fmaf(yg, yg, ss); }
                }
            ss = sum_halves(ss);
            LAS float* rd = red + li * 256;
            if (hh == 0) rd[h * 32 + r] = ss;
            __syncthreads();
            float tot = 0.f;
#pragma unroll
            for (int w = 0; w < 8; ++w) tot += rd[w * 32 + r];
            const float rn = rsqrtf(tot * (1.f / 512.f) + EPS);
#pragma unroll
            for (int pt = 0; pt < 2; ++pt)
#pragma unroll
                for (int g4 = 0; g4 < 4; ++g4) { const int ch = h * 64 + 32 * pt + 8 * g4 + 4 * hh;
                    const float4 w = *(const float4*)(P.ssd_norm_w + ch);
                    *(LAS unsigned long long*)(Zw + r * LDP + 32 * pt + 8 * g4 + 4 * hh) = (unsigned long long)cvtpk(acc[pt][4 * g4] * rn * w.x, acc[pt][4 * g4 + 1] * rn * w.y) | ((unsigned long long)cvtpk(acc[pt][4 * g4 + 2] * rn * w.z, acc[pt][4 * g4 + 3] * rn * w.w) << 32); }
            LDS_WAIT();
#pragma unroll
            for (int q = 0; q < 4; ++q) { const v4u o = *(const LAS v4u*)(Zw + (8 * q + (lane >> 3)) * LDP + (lane & 7) * 8);
                *(v4u*)(CAT + (size_t)(t0_ + 8 * q + (lane >> 3)) * DM + 512 + h * 64 + (lane & 7) * 8) = o; }
        }
        __syncthreads();
    }
}
__device__ __forceinline__ float gelu_erf(float v) { return 0.5f * v * (1.f + erff(v * 0.70710678118654752f)); }
typedef float f32x2v __attribute__((ext_vector_type(2)));
#define CVT8(W, LO) __builtin_amdgcn_cvt_pk_f32_fp8((int)(W), LO)
template <int CTRL> __device__ __forceinline__ float dpp_f(float v) { return __int_as_float(__builtin_amdgcn_update_dpp(0, __float_as_int(v), CTRL, 0xF, 0xF, true)); }
__device__ __forceinline__ float sum8_dpp(float s) { s += dpp_f<0xB1>(s); s += dpp_f<0x4E>(s); s += dpp_f<0x141>(s); return s; }
struct PeerPlace { int vx, nx, rank, nloc; };
__device__ __forceinline__ PeerPlace peer_place(Frame& F) {
    __syncthreads();
    if (F.wave == 0 && lane_id() == 0) {
        unsigned* bar = (unsigned*)(F.ctl + CW_BAR); const unsigned x = xb_xcc_id();
        unsigned vx = 0, nx = 0;
        for (unsigned j = 0; j < 16; ++j) { const unsigned c = xb_ld(&bar[XB_XCNT(j)]); if (c) { if (j < x) ++vx; ++nx; } }
        const unsigned rank = xb_add((unsigned*)(F.ctl + CW_RANK) + 64 * x, 1u);
        F.MISC[10] = vx; F.MISC[11] = nx ? nx : 1u; F.MISC[12] = rank; F.MISC[13] = xb_ld(&bar[XB_XCNT(x)]);
    }
    __syncthreads();
    PeerPlace pp; pp.vx = (int)F.MISC[10]; pp.nx = (int)F.MISC[11]; pp.rank = (int)F.MISC[12]; pp.nloc = (int)F.MISC[13]; if (pp.nloc < 1) pp.nloc = 1;
    return pp;
}
__device__ __forceinline__ void h_quant_rows(Frame& F, const Ptrs& P) {
    const bf16* HB = (const bf16*)(P.ws + WS_ST); unsigned char* H8 = P.ws + WS_H8; float* HS = (float*)(P.ws + WS_HS);
    const int lane = lane_id();
    for (int t = F.vcu * NWAVES + F.wave; t < T_; t += F.G * NWAVES) {
        const v4u a0 = ((const v4u*)(HB + (size_t)t * DM))[2 * lane], a1 = ((const v4u*)(HB + (size_t)t * DM))[2 * lane + 1];
        float hf[16];
        hf[0] = bflo(a0.x); hf[1] = bfhi(a0.x); hf[2] = bflo(a0.y); hf[3] = bfhi(a0.y); hf[4] = bflo(a0.z); hf[5] = bfhi(a0.z); hf[6] = bflo(a0.w); hf[7] = bfhi(a0.w);
        hf[8] = bflo(a1.x); hf[9] = bfhi(a1.x); hf[10] = bflo(a1.y); hf[11] = bfhi(a1.y); hf[12] = bflo(a1.z); hf[13] = bfhi(a1.z); hf[14] = bflo(a1.w); hf[15] = bfhi(a1.w);
        float am = 0.f;
#pragma unroll
        for (int i = 0; i < 16; ++i) am = fmaxf(am, fabsf(hf[i]));
        am = fmaxf(am, dpp_f<0xB1>(am)); am = fmaxf(am, dpp_f<0x4E>(am)); am = fmaxf(am, dpp_f<0x141>(am)); am = fmaxf(am, dpp_f<0x140>(am)); am = fmaxf(am, 1e-30f);
        const float inv = 119.f / am;
        unsigned hi[2] = {0u, 0u}, lo[2] = {0u, 0u};
#pragma unroll
        for (int i = 0; i < 16; ++i) { const int q = __float2int_rn(hf[i] * inv); const int qh = (q + 8) >> 4, ql = q - 16 * qh;
            hi[i >> 3] |= ((unsigned)qh & 15u) << (4 * (i & 7)); lo[i >> 3] |= ((unsigned)ql & 15u) << (4 * (i & 7)); }
        unsigned char* dst = H8 + (size_t)t * 1024 + (lane >> 4) * 256 + (lane & 15) * 8;
        *(unsigned long long*)dst = (unsigned long long)hi[0] | ((unsigned long long)hi[1] << 32);
        *(unsigned long long*)(dst + 128) = (unsigned long long)lo[0] | ((unsigned long long)lo[1] << 32);
        if ((lane & 15) == 0) HS[(size_t)t * 8 + (lane >> 4)] = am * (1.f / 119.f);
    }
}
constexpr int PX_D = 16;
template <int CTRL> __device__ __forceinline__ int dpp_i(int v) { return __builtin_amdgcn_update_dpp(0, v, CTRL, 0xF, 0xF, true); }
#define PX_ISSUE(BUF, LO, HI) _Pragma("unroll") for (int b_ = 0; b_ < 8; ++b_) { const unsigned off_ = ((unsigned)__builtin_amdgcn_ds_bpermute((16 * (b_ & 3) + ps) * 4, (b_ & 4) ? (HI) : (LO)) << 7) | (unsigned)(dl << 5); \
        BUF[2 * b_] = *(const v4u*)(tab + off_); BUF[2 * b_ + 1] = *(const v4u*)(tab + off_ + 16); }
struct H4 { v4u h0, h1, l0, l1; };
#define PX_DOT8(Q, HH, HL) ah = __builtin_amdgcn_sdot8((int)(Q), (int)(HH), ah, false); al = __builtin_amdgcn_sdot8((int)(Q), (int)(HL), al, false);
__device__ __forceinline__ void peer_down_token(const v4u (&cur)[PX_D], const H4& h, const float hs, unsigned* prow, int dl, int ps) {
    int sm[8];
#pragma unroll
    for (int b = 0; b < 8; ++b) { const v4u q0 = cur[2 * b], q1 = cur[2 * b + 1];
        int ah = 0, al = 0;
        PX_DOT8(q0.x, h.h0.x, h.l0.x) PX_DOT8(q0.y, h.h0.y, h.l0.y) PX_DOT8(q0.z, h.h0.z, h.l0.z) PX_DOT8(q0.w, h.h0.w, h.l0.w)
        PX_DOT8(q1.x, h.h1.x, h.l1.x) PX_DOT8(q1.y, h.h1.y, h.l1.y) PX_DOT8(q1.z, h.h1.z, h.l1.z) PX_DOT8(q1.w, h.h1.w, h.l1.w)
        sm[b] = 16 * ah + al; }
    const bool c1 = (dl & 2) != 0, c0 = (dl & 1) != 0;
    int w4[4], w2[2];
#pragma unroll
    for (int k = 0; k < 4; ++k) { const int keep = c1 ? sm[4 + k] : sm[k], send = c1 ? sm[k] : sm[4 + k]; w4[k] = keep + dpp_i<0x4E>(send); }
#pragma unroll
    for (int k = 0; k < 2; ++k) { const int keep = c0 ? w4[2 + k] : w4[k], send = c0 ? w4[k] : w4[2 + k]; w2[k] = keep + dpp_i<0xB1>(send); }
    const float f0 = (float)w2[0] * hs, f1 = (float)w2[1] * hs;
    const float g0 = dpp_f<0x4E>(f0), g1 = dpp_f<0x4E>(f1);
    if (dl < 2) { prow[32 * dl + ps] = cvtpk(f0, g0); prow[32 * dl + 16 + ps] = cvtpk(f1, g1); }
}
__device__ __forceinline__ int pd_claim(volatile LAS unsigned* cnt, int lane) {
    unsigned j = 0u;
    if (lane == 0) j = __hip_atomic_fetch_add((LAS unsigned*)cnt, 1u, __ATOMIC_RELAXED, __HIP_MEMORY_SCOPE_WORKGROUP);
    return __builtin_amdgcn_readfirstlane((int)j);
}
__device__ __forceinline__ void peer_down(Frame& F, const Ptrs& P, const PeerPlace& pp) {
    const unsigned char* H8 = P.ws + WS_H8; const unsigned char* HSb = P.ws + WS_HS; const unsigned char* IDXb = P.ws + WS_IDX; unsigned char* PARTb = P.ws + WS_PART;
    const int lane = lane_id(), dl = lane & 3, ps = lane >> 2;
    const int tstep = pp.nloc * NWAVES;
    volatile LAS unsigned* cnt = F.MISC + 16;
    for (int u = pp.vx; u < 8; u += pp.nx) {
        const int s = u & 3, tend = ((u >> 2) + 1) * (T_ / 2), tbase = (u >> 2) * (T_ / 2) + pp.rank * NWAVES;
        __syncthreads();
        if (F.wave == 0 && lane == 0) *cnt = 0u;
        __syncthreads();
        if (tbase >= tend) continue;
#define PD_TOK(J) ((tbase + ((J) & 7) + ((J) >> 3) * tstep) < tend ? (tbase + ((J) & 7) + ((J) >> 3) * tstep) : -1)
#define PD_SAFE(T) ((T) >= 0 ? (T) : tbase)
        int tA, tB, tC;
        { const int ja = pd_claim(cnt, lane); tA = PD_TOK(ja); const int jb = pd_claim(cnt, lane); tB = PD_TOK(jb); const int jc = pd_claim(cnt, lane); tC = PD_TOK(jc); }
        if (tA < 0) continue;
        const unsigned char* tab = P.ws + WS_ED + (size_t)s * 16384 * 128;
        const unsigned hoff = (unsigned)(s * 256 + dl * 32), ioff = (unsigned)lane * 4u;
        v4u bufA[PX_D], bufB[PX_D];
#define PD_META(H, HSC, TT) do { const unsigned char* hp_ = H8 + ((unsigned)(TT) * 1024u + hoff); H.h0 = *(const v4u*)hp_; H.h1 = *(const v4u*)(hp_ + 16); H.l0 = *(const v4u*)(hp_ + 128); H.l1 = *(const v4u*)(hp_ + 144); \
        HSC = *(const float*)(HSb + ((unsigned)(TT) * 32u + (unsigned)s * 4u)); } while (0)
#define PD_IDX(LO, HI, TT) do { LO = *(const int*)(IDXb + ((unsigned)(TT) * 512u + ioff)); HI = *(const int*)(IDXb + ((unsigned)(TT) * 512u + 256u + ioff)); } while (0)
        int nidx_lo, nidx_hi; PD_IDX(nidx_lo, nidx_hi, tA);
        PX_ISSUE(bufA, nidx_lo, nidx_hi);
        PD_IDX(nidx_lo, nidx_hi, PD_SAFE(tB));
        H4 ha, hb; float sa, sb; PD_META(ha, sa, tA);
        for (;;) {
            { const int jd = pd_claim(cnt, lane); const int tD = PD_TOK(jd);
              PX_ISSUE(bufB, nidx_lo, nidx_hi); PD_IDX(nidx_lo, nidx_hi, PD_SAFE(tC)); PD_META(hb, sb, PD_SAFE(tB));
              __builtin_amdgcn_sched_barrier(0);
              peer_down_token(bufA, ha, sa, (unsigned*)(PARTb + ((unsigned)(s * T_ + tA) * 256u)), dl, ps);
              __builtin_amdgcn_sched_barrier(0);
              tA = tB; tB = tC; tC = tD; }
            if (tA < 0) break;
            { const int jd = pd_claim(cnt, lane); const int tD = PD_TOK(jd);
              PX_ISSUE(bufA, nidx_lo, nidx_hi); PD_IDX(nidx_lo, nidx_hi, PD_SAFE(tC)); PD_META(ha, sa, PD_SAFE(tB));
              __builtin_amdgcn_sched_barrier(0);
              peer_down_token(bufB, hb, sb, (unsigned*)(PARTb + ((unsigned)(s * T_ + tA) * 256u)), dl, ps);
              __builtin_amdgcn_sched_barrier(0);
              tA = tB; tB = tC; tC = tD; }
            if (tA < 0) break;
        }
    }
}
constexpr int PE_PD = 16;
typedef int i32x8v __attribute__((ext_vector_type(8)));
#define PE_LOAD4(SLOT, IDV) SLOT = *(const v4u*)(EU + (((unsigned)(IDV) << 9) | l16))
#define PE_BP(ADDR, V) __builtin_amdgcn_ds_bpermute((ADDR), (V))
#define NTL(p) __builtin_nontemporal_load(p)
__device__ __forceinline__ void peer_up_tm(Frame& F, const Ptrs& P) {
    const unsigned short* HB = (const unsigned short*)(P.ws + WS_ST); const unsigned char* EU = P.ws + WS_EU;
    const int* IDX = (const int*)(P.ws + WS_IDX); const float* GATE = (const float*)(P.ws + WS_GATE); const unsigned* PART = (const unsigned*)(P.ws + WS_PART);
    const float2* SC2 = (const float2*)(P.ws + WS_SMALL);
    const int lane = lane_id(), l31 = lane & 31, hh = lane >> 5; const bool upper = lane >= 32;
    const unsigned l16 = (unsigned)l31 << 4;
    const int bp0 = upper ? 4 : 0;
    const int t0 = F.vcu * NWAVES + F.wave, tstep = F.G * NWAVES;
    if (t0 >= T_) return;
    unsigned bmask[4];
#pragma unroll
    for (int r = 0; r < 4; ++r) bmask[r] = (((l31 >> 4) == hh) && r == ((l31 & 15) >> 2)) ? (0xFFu << (8 * (l31 & 3))) : 0u;
    const int ebase = 128 * hh + l31;
#define EOFF(R) (32 * (((R) & 3) + 8 * ((R) >> 2)))
    float nfw[16];
#pragma unroll
    for (int r = 0; r < 16; ++r) nfw[r] = P.norm_final[ebase + EOFF(r)];
    int idx_lo = IDX[(size_t)t0 * 128 + lane], idx_hi = IDX[(size_t)t0 * 128 + 64 + lane];
    unsigned short hq[16];
#pragma unroll
    for (int r = 0; r < 16; ++r) hq[r] = (HB + (size_t)t0 * DM + ebase)[EOFF(r)];
    float g_lo = GATE[(size_t)t0 * 128 + lane], g_hi = GATE[(size_t)t0 * 128 + 64 + lane];
    float pre_lo = 0.f, pre_hi = 0.f;
#pragma unroll
    for (int s = 0; s < 4; ++s) { const unsigned pp_ = PART[((size_t)s * T_ + t0) * 64 + lane]; pre_lo += bflo(pp_); pre_hi += bfhi(pp_); }
    float sdu_lo, sdu_hi, su_lo, su_hi; { const float2 s0_ = SC2[idx_lo], s1_ = SC2[idx_hi]; sdu_lo = s0_.x; su_lo = s0_.y; sdu_hi = s1_.x; su_hi = s1_.y; }
    v4u ra[PE_PD];
#pragma unroll
    for (int j = 0; j < PE_PD; ++j) { const int id = PE_BP(bp0 + 8 * j, idx_lo); PE_LOAD4(ra[j], id); }
    int id_nx = PE_BP(bp0 + 8 * PE_PD, idx_lo);
    for (int t = t0; t < T_; t += tstep) {
        const int tn = (t + tstep < T_) ? t + tstep : t;
        const int nidx_lo = NTL(IDX + (size_t)tn * 128 + lane), nidx_hi = NTL(IDX + (size_t)tn * 128 + 64 + lane);
        unsigned short nh[16];
#pragma unroll
        for (int r = 0; r < 16; ++r) nh[r] = NTL(HB + (size_t)tn * DM + ebase + EOFF(r));
        const float ng_lo = NTL(GATE + (size_t)tn * 128 + lane), ng_hi = NTL(GATE + (size_t)tn * 128 + 64 + lane);
        unsigned npart[4];
#pragma unroll
        for (int s = 0; s < 4; ++s) npart[s] = NTL(PART + ((size_t)s * T_ + tn) * 64 + lane);
        float hv[16]; float ssq = 0.f;
#pragma unroll
        for (int r = 0; r < 16; ++r) { hv[r] = __uint_as_float((unsigned)hq[r] << 16); ssq = fmaf(hv[r], hv[r], ssq); }
        ssq += swz_xor<1>(ssq); ssq += swz_xor<2>(ssq); ssq += swz_xor<4>(ssq); ssq += swz_xor<8>(ssq); ssq += swz_xor<16>(ssq); ssq = sum_halves(ssq);
        const float rstd = rsqrtf(ssq * (1.f / 1024.f) + EPS);
        const float act_lo = gelu_erf(pre_lo * sdu_lo * rstd) * g_lo * su_lo * 128.f, act_hi = gelu_erf(pre_hi * sdu_hi * rstd) * g_hi * su_hi * 128.f;
        float nsdu_lo = 0.f, nsdu_hi = 0.f, nsu_lo = 0.f, nsu_hi = 0.f;
        f32x16 acc;
#pragma unroll
        for (int i = 0; i < 16; ++i) acc[i] = 0.f;
        float a_cur = __int_as_float(PE_BP(0, __float_as_int(act_lo))), a_cu1 = __int_as_float(PE_BP(4, __float_as_int(act_lo)));
#pragma unroll
        for (int q = 0; q < 64; ++q) {
            const int qa = q + 1, ql = q + PE_PD + 1;
            float a_nx = 0.f, a_nx1 = 0.f;
            if (qa < 64) { a_nx = __int_as_float(PE_BP(8 * (qa & 31), __float_as_int(qa < 32 ? act_lo : act_hi))); a_nx1 = __int_as_float(PE_BP(8 * (qa & 31) + 4, __float_as_int(qa < 32 ? act_lo : act_hi))); }
            int id_n2;
            if (ql < 64) id_n2 = PE_BP(bp0 + 8 * (ql & 31), ql < 32 ? idx_lo : idx_hi);
            else id_n2 = PE_BP(bp0 + 8 * ((ql - 64) & 31), nidx_lo);
            __builtin_amdgcn_sched_barrier(0);
            { const v4u r = ra[q % PE_PD];
              const unsigned c8 = (unsigned)__builtin_amdgcn_cvt_pk_fp8_f32(__builtin_amdgcn_fmed3f(a_cur, -440.f, 440.f), __builtin_amdgcn_fmed3f(a_cu1, -440.f, 440.f), 0, false);
              const unsigned b80 = __builtin_amdgcn_perm(c8, c8, 0u), b81 = __builtin_amdgcn_perm(c8, c8, 0x01010101u);
              const i32x8v Av = {(int)r.x, (int)r.y, (int)r.z, (int)r.w, 0, 0, 0, 0};
              const i32x8v Bv = {(int)(bmask[0] & b80), (int)(bmask[1] & b80), (int)(bmask[2] & b80), (int)(bmask[3] & b80), (int)(bmask[0] & b81), (int)(bmask[1] & b81), (int)(bmask[2] & b81), (int)(bmask[3] & b81)};
              acc = __builtin_amdgcn_mfma_scale_f32_32x32x64_f8f6f4(Av, Bv, acc, 4  , 0  , 0, 0x7f7f7f7f  , 0, 0x78787878  ); }
            PE_LOAD4(ra[q % PE_PD], id_nx);
            if (q == 24) { const float2 s0_ = SC2[nidx_lo], s1_ = SC2[nidx_hi]; nsdu_lo = s0_.x; nsu_lo = s0_.y; nsdu_hi = s1_.x; nsu_hi = s1_.y; }
            id_nx = id_n2; a_cur = a_nx; a_cu1 = a_nx1;
            __builtin_amdgcn_sched_barrier(0);
        }
        { float a = 0.f, c = 0.f;
#pragma unroll
          for (int s = 0; s < 4; ++s) { a += bflo(npart[s]); c += bfhi(npart[s]); }
          pre_lo = a; pre_hi = c; }
        sdu_lo = nsdu_lo; sdu_hi = nsdu_hi; su_lo = nsu_lo; su_hi = nsu_hi;
        float s2 = 0.f;
#pragma unroll
        for (int r = 0; r < 16; ++r) { hv[r] += acc[r]; s2 = fmaf(hv[r], hv[r], s2); }
        s2 += swz_xor<1>(s2); s2 += swz_xor<2>(s2); s2 += swz_xor<4>(s2); s2 += swz_xor<8>(s2); s2 += swz_xor<16>(s2); s2 = sum_halves(s2);
        const float r2 = rsqrtf(s2 * (1.f / 1024.f) + EPS);
        float* orow = P.out + (size_t)t * DM + ebase;
#pragma unroll
        for (int r = 0; r < 16; ++r) __builtin_nontemporal_store(hv[r] * r2 * nfw[r], orow + EOFF(r));
        idx_lo = nidx_lo; idx_hi = nidx_hi; g_lo = ng_lo; g_hi = ng_hi;
#pragma unroll
        for (int r = 0; r < 16; ++r) hq[r] = nh[r];
    }
}
constexpr int TK_LDK = 136, TK_K2 = 34816, TK_SCR = 69632, TK_SP = 49;
__device__ __forceinline__ int mono_key(float x) { const int b = __float_as_int(x); return b ^ ((b >> 31) & 0x7fffffff); }
__device__ __forceinline__ float unmono(int m) { return __int_as_float(m ^ ((m >> 31) & 0x7fffffff)); }
__device__ __forceinline__ int max3i(int a, int b, int c) { return max(max(a, b), c); }
__device__ __forceinline__ int kmax(int a, int b) { int r; asm("v_max_f32 %0, %1, %2" : "=v"(r) : "v"(a), "v"(b)); return r; }
__device__ __forceinline__ int kmin(int a, int b) { int r; asm("v_min_f32 %0, %1, %2" : "=v"(r) : "v"(a), "v"(b)); return r; }
#define CEX(A, I, J) do { const int hi_ = kmax(A[I], A[J]), lo_ = kmin(A[I], A[J]); A[I] = hi_; A[J] = lo_; } while (0)
template <int N, int OFF, int K, int J, int LEN> struct BitonicStep {
    static __device__ __forceinline__ void run(int (&a)[LEN]) {
#pragma unroll
        for (int i = 0; i < N; ++i) { const int l = i ^ J; if (l > i) { if ((i & K) == 0) CEX(a, OFF + i, OFF + l); else CEX(a, OFF + l, OFF + i); } }
        if constexpr (J > 1) BitonicStep<N, OFF, K, (J >> 1), LEN>::run(a);
        else if constexpr (K < N) BitonicStep<N, OFF, (K << 1), K, LEN>::run(a);
    }
};
template <int N, int OFF, int LEN> __device__ __forceinline__ void bitonic_sort_desc(int (&a)[LEN]) { BitonicStep<N, OFF, 2, 1, LEN>::run(a); }
template <int OFF, int LEN> __device__ __forceinline__ void bitonic_merge16_desc(int (&a)[LEN]) { BitonicStep<16, OFF, 16, 8, LEN>::run(a); }
template <int OFF, int LEN> __device__ __forceinline__ void oem_sort16_desc(int (&a)[LEN]) {
    constexpr unsigned char Pn[63][2] = {{0, 1}, {2, 3}, {0, 2}, {1, 3}, {1, 2}, {4, 5}, {6, 7}, {4, 6}, {5, 7}, {5, 6}, {0, 4}, {2, 6}, {2, 4}, {1, 5}, {3, 7}, {3, 5}, {1, 2}, {3, 4}, {5, 6}, {8, 9}, {10, 11}, {8, 10}, {9, 11}, {9, 10}, {12, 13}, {14, 15}, {12, 14}, {13, 15}, {13, 14}, {8, 12}, {10, 14}, {10, 12}, {9, 13}, {11, 15}, {11, 13}, {9, 10}, {11, 12}, {13, 14}, {0, 8}, {4, 12}, {4, 8}, {2, 10}, {6, 14}, {6, 10}, {2, 4}, {6, 8}, {10, 12}, {1, 9}, {5, 13}, {5, 9}, {3, 11}, {7, 15}, {7, 11}, {3, 5}, {7, 9}, {11, 13}, {1, 2}, {3, 4}, {5, 6}, {7, 8}, {9, 10}, {11, 12}, {13, 14}};
#pragma unroll
    for (int k = 0; k < 63; ++k) CEX(a, OFF + Pn[k][0], OFF + Pn[k][1]);
}
template <int LEN> __device__ __forceinline__ void oem_sort32_desc(int (&a)[LEN]) {
    constexpr unsigned char Pn[191][2] = {{0, 1}, {2, 3}, {0, 2}, {1, 3}, {1, 2}, {4, 5}, {6, 7}, {4, 6}, {5, 7}, {5, 6}, {0, 4}, {2, 6}, {2, 4}, {1, 5}, {3, 7}, {3, 5}, {1, 2}, {3, 4}, {5, 6}, {8, 9}, {10, 11}, {8, 10}, {9, 11}, {9, 10}, {12, 13}, {14, 15}, {12, 14}, {13, 15}, {13, 14}, {8, 12}, {10, 14}, {10, 12}, {9, 13}, {11, 15}, {11, 13}, {9, 10}, {11, 12}, {13, 14}, {0, 8}, {4, 12}, {4, 8}, {2, 10}, {6, 14}, {6, 10}, {2, 4}, {6, 8}, {10, 12}, {1, 9}, {5, 13}, {5, 9}, {3, 11}, {7, 15}, {7, 11}, {3, 5}, {7, 9}, {11, 13}, {1, 2}, {3, 4}, {5, 6}, {7, 8}, {9, 10}, {11, 12}, {13, 14}, {16, 17}, {18, 19}, {16, 18}, {17, 19}, {17, 18}, {20, 21}, {22, 23}, {20, 22}, {21, 23}, {21, 22}, {16, 20}, {18, 22}, {18, 20}, {17, 21}, {19, 23}, {19, 21}, {17, 18}, {19, 20}, {21, 22}, {24, 25}, {26, 27}, {24, 26}, {25, 27}, {25, 26}, {28, 29}, {30, 31}, {28, 30}, {29, 31}, {29, 30}, {24, 28}, {26, 30}, {26, 28}, {25, 29}, {27, 31}, {27, 29}, {25, 26}, {27, 28}, {29, 30}, {16, 24}, {20, 28}, {20, 24}, {18, 26}, {22, 30}, {22, 26}, {18, 20}, {22, 24}, {26, 28}, {17, 25}, {21, 29}, {21, 25}, {19, 27}, {23, 31}, {23, 27}, {19, 21}, {23, 25}, {27, 29}, {17, 18}, {19, 20}, {21, 22}, {23, 24}, {25, 26}, {27, 28}, {29, 30}, {0, 16}, {8, 24}, {8, 16}, {4, 20}, {12, 28}, {12, 20}, {4, 8}, {12, 16}, {20, 24}, {2, 18}, {10, 26}, {10, 18}, {6, 22}, {14, 30}, {14, 22}, {6, 10}, {14, 18}, {22, 26}, {2, 4}, {6, 8}, {10, 12}, {14, 16}, {18, 20}, {22, 24}, {26, 28}, {1, 17}, {9, 25}, {9, 17}, {5, 21}, {13, 29}, {13, 21}, {5, 9}, {13, 17}, {21, 25}, {3, 19}, {11, 27}, {11, 19}, {7, 23}, {15, 31}, {15, 23}, {7, 11}, {15, 19}, {23, 27}, {3, 5}, {7, 9}, {11, 13}, {15, 17}, {19, 21}, {23, 25}, {27, 29}, {1, 2}, {3, 4}, {5, 6}, {7, 8}, {9, 10}, {11, 12}, {13, 14}, {15, 16}, {17, 18}, {19, 20}, {21, 22}, {23, 24}, {25, 26}, {27, 28}, {29, 30}};
#pragma unroll
    for (int k = 0; k < 191; ++k) CEX(a, Pn[k][0], Pn[k][1]);
}
template <int A, int B, int LEN> __device__ __forceinline__ void merge_top16(int (&a)[LEN]) {
#pragma unroll
    for (int i = 0; i < 16; ++i) a[A + i] = kmax(a[A + i], a[B + 15 - i]);
    bitonic_merge16_desc<A, LEN>(a);
}
template <int LEN> __device__ __forceinline__ void pair_top16(int (&a)[LEN]) {
    int lo[16], up[16];
#pragma unroll
    for (int i = 0; i < 16; ++i) { const auto rr = __builtin_amdgcn_permlane32_swap((unsigned)a[i], (unsigned)a[i], false, false); lo[i] = (int)rr[0]; up[i] = (int)rr[1]; }
#pragma unroll
    for (int i = 0; i < 16; ++i) a[i] = kmax(lo[i], up[15 - i]);
    bitonic_merge16_desc<0, LEN>(a);
}
__device__ __forceinline__ void topk_half(const bf16x8 (&qf)[8], const LAS bf16* Kh, int r, int hh, int (&key)[64]) {
#pragma unroll
    for (int nt = 0; nt < 4; ++nt) {
        f32x16 sc;
#pragma unroll
        for (int i = 0; i < 16; ++i) sc[i] = 0.f;
#pragma unroll
        for (int kk = 0; kk < 8; ++kk) { const bf16x8 a = *(const LAS bf16x8*)(Kh + (32 * nt + r) * TK_LDK + 16 * kk + 8 * hh); sc = MFMA32(a, qf[kk], sc); }
#pragma unroll
        for (int i = 0; i < 16; ++i) key[nt * 16 + i] = (__float_as_int(sc[i]) & ~127) | (127 - (32 * nt + crow(i, hh)));
    }
    oem_sort16_desc<0, 64>(key); oem_sort16_desc<16, 64>(key); oem_sort16_desc<32, 64>(key); oem_sort16_desc<48, 64>(key);
    merge_top16<0, 16, 64>(key); merge_top16<32, 48, 64>(key); merge_top16<0, 32, 64>(key);
    pair_top16<64>(key);
}
__device__ __forceinline__ void topk_finish(const LAS int* scr, int hh, float rstd, int* IDX, float* GATE, int t, int hd) {
    const LAS int* la = scr + hh * 16; const LAS int* lb = scr + (1 - hh) * 16;
    float va[4], vb[16], vA[16];
#pragma unroll
    for (int i = 0; i < 4; ++i) va[i] = __int_as_float(la[i] & ~127);
#pragma unroll
    for (int j = 0; j < 16; ++j) { vb[j] = __int_as_float(lb[j] & ~127); vA[j] = __int_as_float(lb[j + hh] & ~127); }
    int ck[32];
#pragma unroll
    for (int k = 0; k < 16; ++k) { const int pos = hh ? ((k + 1) * 16) : k;
        int kk = (__float_as_int(va[0] + vA[k]) & ~255) | (255 - pos);
        if (k == 15) kk = hh ? (int)0xff800000 : kk;
        ck[k] = kk; }
    {
        int q = 16;
#pragma unroll
        for (int i = 1; i < 4; ++i)
#pragma unroll
            for (int j = i; j < 16; ++j) if ((i + 1) * (j + 1) <= 16) {
                const int pos = hh ? (j * 16 + i) : (i * 16 + j);
                int k = (__float_as_int(va[i] + vb[j]) & ~255) | (255 - pos);
                if (i == j && hh) k = (int)0xff800000;
                ck[q++] = k; }
#pragma unroll
        for (int i = 27; i < 32; ++i) ck[i] = (int)0xff800000;
    }
    oem_sort16_desc<16, 32>(ck);
    merge_top16<0, 16, 32>(ck);
    pair_top16<32>(ck);
    const float vmax = __int_as_float(ck[0] & ~255) * rstd;
    float ev[8]; int id[8]; float esum = 0.f; const int hm = -hh;
#pragma unroll
    for (int q = 0; q < 8; ++q) { const int wk = ck[q] ^ ((ck[q] ^ ck[8 + q]) & hm); const int pos = 255 - (wk & 255);
        const int n1 = 127 - (scr[pos >> 4] & 127), n2 = 127 - (scr[16 + (pos & 15)] & 127);
        id[q] = n1 * 128 + n2;
        ev[q] = exp2f((__int_as_float(wk & ~255) * rstd - vmax) * LOG2E); esum += ev[q]; }
    esum = sum_halves(esum);
    const float inv = 1.f / esum;
    int4* ip = (int4*)(IDX + ((size_t)t * 8 + hd) * 16 + hh * 8); float4* gp = (float4*)(GATE + ((size_t)t * 8 + hd) * 16 + hh * 8);
    ip[0] = make_int4(id[0], id[1], id[2], id[3]); ip[1] = make_int4(id[4], id[5], id[6], id[7]);
    gp[0] = make_float4(ev[0] * inv, ev[1] * inv, ev[2] * inv, ev[3] * inv); gp[1] = make_float4(ev[4] * inv, ev[5] * inv, ev[6] * inv, ev[7] * inv);
}
constexpr int TQ_QH = 69632, TQ_QP = 272;
struct OneUnit { pg8::StaticOrder S; int i;
    __device__ __forceinline__ bool next(int j, pg8::Unit& u) const { return j == 0 ? S.next(i, u) : false; }
    __device__ __forceinline__ void a_ready(const pg8::Unit&) const {}
    __device__ __forceinline__ void done(const pg8::Unit&) const {}
};
struct EpiQTopk {
    static constexpr bool PERM = true, AFTER_DRAIN = true;
    const unsigned char* KB; const float* SSQ; int* IDX; float* GATE;
    __device__ __forceinline__ void dump(const pg8::f32x4 (&acc)[2][2][4][2], int bj, LAS unsigned char* QH, int wr, int wc, int fr, int fq) const {
#pragma unroll
        for (int ai = 0; ai < 2; ++ai)
#pragma unroll
            for (int m = 0; m < 4; ++m) { const pg8::f32x4 v0 = bj ? acc[ai][1][m][0] : acc[ai][0][m][0], v1 = bj ? acc[ai][1][m][1] : acc[ai][0][m][1];
                v4u w; w.x = cvtpk(v0[0], v0[1]); w.y = cvtpk(v0[2], v0[3]); w.z = cvtpk(v1[0], v1[1]); w.w = cvtpk(v1[2], v1[3]);
                *(LAS v4u*)(QH + (128 * ai + 64 * wr + 16 * m + fr) * TQ_QP + (32 * wc + 8 * fq) * 2) = w; }
    }
    __device__ __forceinline__ void fused(const pg8::f32x4 (&acc)[2][2][4][2], const pg8::Unit& u, int wr, int wc, int fr, int fq, LAS unsigned char* L, int wid, int lane) const {
        LAS bf16* K1 = (LAS bf16*)L; LAS bf16* K2 = (LAS bf16*)(L + TK_K2); LAS unsigned char* QH = L + TQ_QH;
        const int tid_ = wid * 64 + lane, r = lane & 31, hh = lane >> 5;
        { v4u kq[8];
#pragma unroll
          for (int q = 0; q < 8; ++q) kq[q] = ((const v4u*)KB)[tid_ + 512 * q];
          dump(acc, 0, QH, wr, wc, fr, fq);
#pragma unroll
          for (int q = 0; q < 8; ++q) { const int j = tid_ + 512 * q, n = (j >> 4) & 127, k8 = j & 15; *(LAS v4u*)(((j >> 11) ? K2 : K1) + n * TK_LDK + 8 * k8) = kq[q]; } }
        __syncthreads();
        const int t = u.pm * 256 + 32 * wid + r;
        float rstd;
        { const float4* sp = (const float4*)(SSQ + (size_t)t * 16); const float4 a = sp[0], b = sp[1], c = sp[2], d = sp[3];
          rstd = rsqrtf(((a.x + a.y + a.z + a.w) + (b.x + b.y + b.z + b.w) + (c.x + c.y + c.z + c.w) + (d.x + d.y + d.z + d.w)) * (1.f / 1024.f) + EPS); }
        const LAS unsigned char* qrow = QH + (32 * wid + r) * TQ_QP + 16 * hh;
        int key[64], list0[16];
        { bf16x8 qf[8];
#pragma unroll
          for (int kk = 0; kk < 8; ++kk) qf[kk] = *(const LAS bf16x8*)(qrow + 32 * kk);
          topk_half(qf, K1, r, hh, key);
#pragma unroll
          for (int i = 0; i < 16; ++i) list0[i] = key[i]; }
        __syncthreads();
        dump(acc, 1, QH, wr, wc, fr, fq);
        __syncthreads();
        { bf16x8 qf[8];
#pragma unroll
          for (int kk = 0; kk < 8; ++kk) qf[kk] = *(const LAS bf16x8*)(qrow + 32 * kk);
          topk_half(qf, K2, r, hh, key); }
        LAS int* scr = (LAS int*)(QH + 32 * wid * TQ_QP) + r * TK_SP;
        LDS_WAIT();
        if (hh == 0) {
#pragma unroll
            for (int i = 0; i < 16; ++i) { scr[i] = list0[i]; scr[16 + i] = key[i]; } }
        topk_finish(scr, hh, rstd, IDX, GATE, t, u.pn);
        __syncthreads();
    }
};

constexpr int AT_KP = 72, AT_VP = 264;
constexpr int AT_K = 0, AT_VT = 36864, AT_BT = 36864 + 33792;
__device__ __forceinline__ void attn_phase(Frame& F, const Ptrs& P) {
    const bf16* PROJ = (const bf16*)(P.ws + WS_PROJ); bf16* CAT = (bf16*)((char*)P.out + DO_CAT);
    LAS unsigned char* L = F.lds + RING_OFF;
    LAS bf16* Ks = (LAS bf16*)(L + AT_K); LAS bf16* Vt = (LAS bf16*)(L + AT_VT); LAS float* btab = (LAS float*)(L + AT_BT);
    const int lane = lane_id(), tid_ = F.wave * 64 + lane, r = lane & 31, hh = lane >> 5;
    for (int u = F.vcu; u < 256; u += F.G) {
        const int hkv = u & 1, n = (u >> 1) & 31, b = u >> 6;
        const int trow0 = b * SEQ + n * 128;
        v4u kvq[4], vvq[4];
#pragma unroll
        for (int q = 0; q < 4; ++q) { const int i = tid_ + 512 * q, kj = i >> 3, ch = i & 7; const bool ok = (n > 0) || (kj >= 128);
            kvq[q] = (v4u){0u, 0u, 0u, 0u}; vvq[q] = (v4u){0u, 0u, 0u, 0u};
            if (ok) { const bf16* rowp = PROJ + (size_t)(trow0 - 128 + kj) * NPROJ + hkv * 64 + ch * 8; kvq[q] = *(const v4u*)(rowp + PJ_K); vvq[q] = *(const v4u*)(rowp + PJ_V); } }
#pragma unroll
        for (int q = 0; q < 4; ++q) {
            const int i = tid_ + 512 * q, kj = i >> 3, ch = i & 7;
            const v4u kv = kvq[q], vv = vvq[q];
            *(LAS v4u*)(Ks + kj * AT_KP + ch * 8) = kv;
            LAS bf16* vp = Vt + (ch * 8) * AT_VP + kj;
            vp[0] = (bf16)(vv.x & 0xffffu); vp[AT_VP] = (bf16)(vv.x >> 16); vp[2 * AT_VP] = (bf16)(vv.y & 0xffffu); vp[3 * AT_VP] = (bf16)(vv.y >> 16);
            vp[4 * AT_VP] = (bf16)(vv.z & 0xffffu); vp[5 * AT_VP] = (bf16)(vv.z >> 16); vp[6 * AT_VP] = (bf16)(vv.w & 0xffffu); vp[7 * AT_VP] = (bf16)(vv.w >> 16);
        }
        { const float* BT = (const float*)(P.ws + WS_BTAB) + hkv * 768;
          const float b0 = BT[tid_], b1 = (tid_ < 256) ? BT[512 + tid_] : 0.f;
          btab[tid_] = b0; if (tid_ < 256) btab[512 + tid_] = b1; }
        __syncthreads();
        const int g = F.wave & 3, h = hkv * 4 + g;
        const float sink2 = P.sinks[h] * LOG2E;
        bf16x8 qf[4], qfn[4];
#pragma unroll
        for (int kk = 0; kk < 4; ++kk) { qf[kk] = *(const bf16x8*)(PROJ + (size_t)(trow0 + 32 * ((F.wave >> 2) * 2) + r) * NPROJ + h * 64 + 16 * kk + 8 * hh);
            qfn[kk] = *(const bf16x8*)(PROJ + (size_t)(trow0 + 32 * ((F.wave >> 2) * 2 + 1) + r) * NPROJ + h * 64 + 16 * kk + 8 * hh); }
#pragma unroll 1
        for (int qq = 0; qq < 2; ++qq) {
            const int qt = (F.wave >> 2) * 2 + qq, t = trow0 + 32 * qt + r;
            f32x16 sc[5];
#pragma unroll
            for (int j = 0; j < 5; ++j) {
#pragma unroll
                for (int i = 0; i < 16; ++i) sc[j][i] = 0.f;
#pragma unroll
                for (int kk = 0; kk < 4; ++kk) { const bf16x8 a = *(const LAS bf16x8*)(Ks + (32 * (qt + j) + r) * AT_KP + 16 * kk + 8 * hh); sc[j] = MFMA32(a, qf[kk], sc[j]); }
            }
            float m = sink2;
            const LAS float* bt = btab + g * 192 + 160 + r - 4 * hh;
#pragma unroll
            for (int j = 0; j < 5; ++j) {
                const bool tile_ok = (n > 0) || (qt + j >= 4);
#pragma unroll
                for (int i = 0; i < 16; ++i) { const int dist = 128 + r - (32 * j + crow(i, hh));
                    const bool ok = tile_ok && (j == 0 ? dist < 128 : (j == 4 ? dist >= 0 : true));
                    const float s = sc[j][i] * (0.125f * LOG2E) + bt[-(32 * j + (i & 3) + 8 * (i >> 2))];
                    sc[j][i] = ok ? s : -INFINITY; m = fmaxf(m, sc[j][i]); }
            }
            m = max_halves(m);
            float l = 0.f;
#pragma unroll
            for (int j = 0; j < 5; ++j)
#pragma unroll
                for (int i = 0; i < 16; ++i) { sc[j][i] = __builtin_amdgcn_exp2f(sc[j][i] - m); l += sc[j][i]; }
            l = sum_halves(l);
            l += __builtin_amdgcn_exp2f(sink2 - m);
            const float inv = 1.f / l;
            f32x16 o[2];
#pragma unroll
            for (int i = 0; i < 16; ++i) { o[0][i] = 0.f; o[1][i] = 0.f; }
#pragma unroll
            for (int j = 0; j < 5; ++j)
#pragma unroll
                for (int sg = 0; sg < 2; ++sg) {
                    const bf16x8 pf = pack8(sc[j], sg);
#pragma unroll
                    for (int dt = 0; dt < 2; ++dt) {
                        const LAS bf16* vb = Vt + (32 * dt + r) * AT_VP + 32 * (qt + j) + 16 * sg + 4 * hh;
                        const s16x4 lo = *(const LAS s16x4*)(vb), hi = *(const LAS s16x4*)(vb + 8);
                        o[dt] = MFMA32(__builtin_shufflevector(lo, hi, 0, 1, 2, 3, 4, 5, 6, 7), pf, o[dt]);
                    }
                }
            bf16* op = CAT + (size_t)t * DM + h * 64 + 4 * hh;
#pragma unroll
            for (int dt = 0; dt < 2; ++dt)
#pragma unroll
                for (int g4 = 0; g4 < 4; ++g4)
                    *(unsigned long long*)(op + 32 * dt + 8 * g4) = (unsigned long long)cvtpk(o[dt][4 * g4] * inv, o[dt][4 * g4 + 1] * inv) | ((unsigned long long)cvtpk(o[dt][4 * g4 + 2] * inv, o[dt][4 * g4 + 3] * inv) << 32);
#pragma unroll
            for (int kk = 0; kk < 4; ++kk) qf[kk] = qfn[kk];
        }
        __syncthreads();
    }
}
struct Args { Ptrs p; };
__global__ void __launch_bounds__(NWAVES * 64, 2) hymba_fwd(Args args) {
    extern __shared__ __attribute__((aligned(16))) unsigned char lds[];
    const Ptrs& P = args.p;
    Frame F;
    F.lds = (LAS unsigned char*)lds;
    F.MISC = (volatile LAS unsigned*)(F.lds + MISC_OFF);
    F.wave = __builtin_amdgcn_readfirstlane(threadIdx.x >> 6);
    F.G = gridDim.x; { const int bx = blockIdx.x; F.vcu = (F.G % 8 == 0) ? (bx % 8) * (F.G / 8) + bx / 8 : bx; }
    F.ctl = (gu32*)(P.ws + WS_CTL);
    for (int u = threadIdx.x; u < (LDS_BYTES - LDSCTL_OFF) / 4; u += NWAVES * 64) ((LAS unsigned*)(F.lds + LDSCTL_OFF))[u] = 0u;
    __syncthreads();
    XcdBarrier bar = xcd_barrier_post((unsigned*)(F.ctl + CW_BAR), F.MISC + 8);
#define GRID_BAR() xcd_barrier(bar)

    bf16* XN = (bf16*)(P.ws + WS_XN); bf16* PROJ = (bf16*)(P.ws + WS_PROJ); bf16* HB = (bf16*)(P.ws + WS_ST);
    p0_prologue(F, P);
    GRID_BAR();
    const bool slackwg = (F.G == 256 && blockIdx.x >= 64); const int jx = ((int)blockIdx.x >> 3) & 7;
    const int spos = !slackwg ? -1 : (jx < 3 ? 0 : (jx < 5 ? 1 : 2));
    if (spos == 0) { p1_slack(F, P, ((int)blockIdx.x - 64) * NWAVES + F.wave, 192 * NWAVES); __syncthreads(); }
    { pg8::Gemm g{XN, (const bf16*)(P.ws + WS_WIN), T_, NPROJ, DM, F.wave}; pg8::StaticOrder S; S.init(T_, NPROJ, F.G, (int)blockIdx.x);
      pg8::EpiBf16<0> E{PROJ, NPROJ, nullptr, 0, 0, 1.f};
      if (spos == 1) {
          { OneUnit S1{S, 0}; pg8::gemm_phase<pg8::EpiBf16<0>, OneUnit, PG8_ALIGN, PG8_SP2>(F.lds + RING_OFF, g, S1, E); }
          __syncthreads();
          p1_slack(F, P, ((int)blockIdx.x - 64) * NWAVES + F.wave, 192 * NWAVES);
          __syncthreads();
          { OneUnit S1{S, 1}; pg8::gemm_phase<pg8::EpiBf16<0>, OneUnit, PG8_ALIGN, PG8_SP2>(F.lds + RING_OFF, g, S1, E); }
      } else pg8::gemm_phase<pg8::EpiBf16<0>, pg8::StaticOrder, PG8_ALIGN, PG8_SP2>(F.lds + RING_OFF, g, S, E); }
    if (spos == 2) p1_slack(F, P, ((int)blockIdx.x - 64) * NWAVES + F.wave, 192 * NWAVES);
    else if (F.G != 256) p1_slack(F, P, F.vcu * NWAVES + F.wave, F.G * NWAVES);
    GRID_BAR();
    ssd_s1(F, P);
    xcd_arrive(bar, F.MISC + 14);
    attn_phase(F, P);
    xcd_wait(bar, F.MISC + 14);
    ssd_s2(F, P);
    GRID_BAR();
    ssd_s3(F, P);
    GRID_BAR();
    { pg8::Gemm g{(const bf16*)((const char*)P.out + DO_CAT), (const bf16*)(P.ws + WS_WOUT), T_, DM, DM, F.wave}; pg8::StaticOrder S; S.init(T_, DM, F.G, (int)blockIdx.x);
      EpiResH E{XN, (const float*)(P.ws + WS_RINV), P.norm_mix, HB, (float*)(P.ws + WS_SSQ)};
      pg8::gemm_phase<EpiResH, pg8::StaticOrder, PG8_ALIGN, PG8_SP2>(F.lds + RING_OFF, g, S, E); }
    GRID_BAR();
    { pg8::Gemm g{HB, (const bf16*)(P.ws + WS_WQ), T_, 2048, DM, F.wave}; pg8::StaticOrder S; S.init(T_, 2048, F.G, (int)blockIdx.x);
      EpiQTopk E{P.ws + WS_KEYB, (const float*)(P.ws + WS_SSQ), (int*)(P.ws + WS_IDX), (float*)(P.ws + WS_GATE)};
#pragma unroll 1
      for (int ui = 0; ui < 64; ++ui) { pg8::Unit u0; if (!S.next(ui, u0)) break;
          OneUnit S1{S, ui};
          pg8::gemm_phase<EpiQTopk, OneUnit, PG8_ALIGN, PG8_SP2>(F.lds + RING_OFF, g, S1, E); } }
    h_quant_rows(F, P);
    GRID_BAR();
    { const PeerPlace pp = peer_place(F);
      peer_down(F, P, pp); }
    GRID_BAR();
    peer_up_tm(F, P);
}

extern "C" void kernel_launch(void* const* d_in, const int* in_sizes, int n_in, void* d_out, int out_size, void* d_ws, size_t ws_size, hipStream_t stream) {
    static int grid = 0;
    if (grid == 0) {
        if (n_in != 19 || out_size != T_ * DM || ws_size < WS_END) { fprintf(stderr, "kernel_launch: unexpected shapes (n_in %d, out %d, ws %zu)\n", n_in, out_size, ws_size); grid = -1; return; }
        int dev = 0, cus = 0, per_cu = 0;
        if (hipGetDevice(&dev) != hipSuccess || hipDeviceGetAttribute(&cus, hipDeviceAttributeMultiprocessorCount, dev) != hipSuccess) { grid = -1; return; }
        if (hipFuncSetAttribute((const void*)hymba_fwd, hipFuncAttributeMaxDynamicSharedMemorySize, LDS_BYTES) != hipSuccess) { fprintf(stderr, "kernel_launch: hipFuncSetAttribute failed\n"); grid = -1; return; }
        if (hipOccupancyMaxActiveBlocksPerMultiprocessor(&per_cu, (const void*)hymba_fwd, NWAVES * 64, LDS_BYTES) != hipSuccess || per_cu < 1) { fprintf(stderr, "kernel_launch: occupancy query says %d blocks per CU\n", per_cu); grid = -1; (void)hipGetLastError(); return; }
        grid = cus;
    }
    if (grid < 0) return;
    (void)hipMemsetAsync((char*)d_ws + WS_CTL, 0, CTL_ZERO_BYTES, stream);
    Args a{};
    const float** pp = (const float**)&a.p;
    for (int i = 0; i < 19; ++i) pp[i] = (const float*)d_in[i];
    a.p.out = (float*)d_out; a.p.ws = (unsigned char*)d_ws;
    hipLaunchKernelGGL(hymba_fwd, dim3(grid), dim3(NWAVES * 64), LDS_BYTES, stream, a);
}
```
